# Optimizing an MI355X kernel written in HIP

```python
import jax, jax.numpy as jnp
from jax import lax
import numpy as np

D_MODEL = 1024
BATCH = 2
SEQ = 8192
DEPTH = 2

HEAD_DIM = 64
A_HEADS = 8
DILATED_PATTERNS = ((128, 1), (512, 4), (2048, 16))
B_Q_HEADS = 8
B_KV_HEADS = 2
B_HALF_WINDOW = 128
ATTN_BLOCK = 128
ROPE_THETA = 10000.0
C_GROUPS = 4
C_GROUP_CH = 128
C_CHUNK = 128
C_WIDTH = C_GROUPS * C_GROUP_CH
D_HEADS = 8
D_WIDTH = D_HEADS * HEAD_DIM
D_DECAY_LORA = 64
D_AAA_LORA = 64
D_GATE_LORA = 128
GN_EPS = 64e-5
MEM_LEN = 256
MEM_HEADS = 4
MEM_HEAD_DIM = D_MODEL // MEM_HEADS
N_EXPERTS = 16
CAPACITY_FACTOR = 2
D_EXPERT = 2816

NORM_EPS = 1e-6
NEG_INF = -1e30
A_WIDTH = A_HEADS * HEAD_DIM
B_WIDTH = B_Q_HEADS * HEAD_DIM
B_KV_WIDTH = B_KV_HEADS * HEAD_DIM
MIX_WIDTH = A_WIDTH + B_WIDTH
EVEN_IN = 3 * A_WIDTH + B_WIDTH + 2 * B_KV_WIDTH
D_SHIFT_WIDTH = 3 * D_WIDTH + 2 * D_DECAY_LORA + 2 * D_AAA_LORA + D_GATE_LORA
ODD_IN = 2 * C_WIDTH + D_SHIFT_WIDTH

kernel_name = "hybrid_dilated_window_gmlp_rwkv7_ecmoe"


def rmsnorm(t, g):
    tf = t.astype(jnp.float32)
    y = tf * lax.rsqrt(jnp.mean(tf * tf, axis=-1, keepdims=True) + NORM_EPS) * g
    return y.astype(t.dtype)


def layernorm(t, g, b):
    tf = t.astype(jnp.float32)
    mu = jnp.mean(tf, axis=-1, keepdims=True)
    var = jnp.mean(jnp.square(tf - mu), axis=-1, keepdims=True)
    return ((tf - mu) * lax.rsqrt(var + 1e-5) * g + b).astype(t.dtype)


def split_cols(t, widths):
    offs = np.cumsum(widths)[:-1].tolist()
    return jnp.split(t, offs, axis=-1)


def rope_tables(seq_len, dh):
    inv = 1.0 / (ROPE_THETA ** (jnp.arange(0, dh, 2, dtype=jnp.float32) / dh))
    ang = jnp.arange(seq_len, dtype=jnp.float32)[:, None] * inv[None, :]
    ang = jnp.concatenate([ang, ang], axis=-1)
    return jnp.cos(ang), jnp.sin(ang)


def rotary(t, cos, sin):
    t1, t2 = jnp.split(t, 2, axis=-1)
    rot = jnp.concatenate([-t2, t1], axis=-1)
    return (t * cos[:, None, :] + rot * sin[:, None, :]).astype(t.dtype)


def banded_attention(q, k, v, half_window, block, sink_logit=None):
    B, G, L, Hq, dh = q.shape
    Hkv = k.shape[3]
    rep = Hq // Hkv
    nb = -(-L // block)
    Lp = nb * block
    span = block + 2 * half_window
    qp = jnp.pad(q, ((0, 0), (0, 0), (0, Lp - L), (0, 0), (0, 0))).reshape(B, G, nb, block, Hkv, rep, dh)
    pad = ((0, 0), (0, 0), (half_window, Lp - L + half_window), (0, 0), (0, 0))
    kp = jnp.pad(k, pad)
    vp = jnp.pad(v, pad)
    kidx = (jnp.arange(nb) * block)[:, None] + jnp.arange(span)[None, :]
    kb = kp[:, :, kidx]
    vb = vp[:, :, kidx]
    kpos = (kidx - half_window)[:, None, :]
    qpos = ((jnp.arange(nb) * block)[:, None] + jnp.arange(block)[None, :])[:, :, None]
    valid = (kpos >= 0) & (kpos < L) & (jnp.abs(kpos - qpos) <= half_window)
    s = jnp.einsum('bgnqhrd,bgnkhd->bgnhrqk', qp, kb, preferred_element_type=jnp.float32) * (dh ** -0.5)
    s = jnp.where(valid[None, None, :, None, None, :, :], s, NEG_INF)
    m = jnp.max(s, axis=-1, keepdims=True)
    if sink_logit is None:
        p = jnp.exp(s - m)
        denom = jnp.sum(p, axis=-1, keepdims=True)
    else:
        sk = sink_logit.astype(jnp.float32).reshape(Hkv, rep)[None, None, None, :, :, None, None]
        m = jnp.maximum(m, sk)
        p = jnp.exp(s - m)
        denom = jnp.sum(p, axis=-1, keepdims=True) + jnp.exp(sk - m)
    out = jnp.einsum('bgnhrqk,bgnkhd->bgnqhrd', (p / denom).astype(v.dtype), vb)
    out = out.reshape(B, G, Lp, Hq, dh)[:, :, :L]
    lse = (m + jnp.log(denom))[..., 0]
    lse = lse.transpose(0, 1, 2, 5, 3, 4).reshape(B, G, Lp, Hq)[:, :, :L]
    return out, lse


def dilated_window_attention(q, k, v):
    B, S, H, dh = q.shape
    outs, lses = [], []
    for window, dil in DILATED_PATTERNS:
        def to_res(t):
            return t.reshape(B, S // dil, dil, H, dh).transpose(0, 2, 1, 3, 4)
        o, lse = banded_attention(to_res(q), to_res(k), to_res(v), window // (2 * dil), ATTN_BLOCK)
        outs.append(o.transpose(0, 2, 1, 3, 4).reshape(B, S, H, dh))
        lses.append(lse.transpose(0, 2, 1, 3).reshape(B, S, H))
    wts = jax.nn.softmax(jnp.stack(lses), axis=0)
    return jnp.einsum('pbsh,pbshd->bshd', wts.astype(q.dtype), jnp.stack(outs))


def even_mixer(h, w_in, sink, w_out, cos, sin):
    B, S, _ = h.shape
    p = h @ w_in
    qa, ka, va, qb, kb, vb = split_cols(p, [A_WIDTH, A_WIDTH, A_WIDTH, B_WIDTH, B_KV_WIDTH, B_KV_WIDTH])
    heads = lambda t, n: t.reshape(B, S, n, HEAD_DIM)
    qa = rotary(heads(qa, A_HEADS), cos, sin)
    ka = rotary(heads(ka, A_HEADS), cos, sin)
    oa = dilated_window_attention(qa, ka, heads(va, A_HEADS))
    qb = rotary(heads(qb, B_Q_HEADS), cos, sin)
    kb = rotary(heads(kb, B_KV_HEADS), cos, sin)
    ob, _ = banded_attention(qb[:, None], kb[:, None], heads(vb, B_KV_HEADS)[:, None], B_HALF_WINDOW, ATTN_BLOCK, sink)
    y = jnp.concatenate([oa.reshape(B, S, A_WIDTH), ob[:, 0].reshape(B, S, B_WIDTH)], axis=-1)
    return y @ w_out


def spatial_gating(cu, cv, ln_g, ln_b, w_s, b_s):
    B, S, _ = cu.shape
    u = jax.nn.gelu(cu)
    v = layernorm(jax.nn.gelu(cv), ln_g, ln_b).reshape(B, S // C_CHUNK, C_CHUNK, C_GROUPS, C_GROUP_CH)
    s = jnp.einsum('gij,bnjgc->bnigc', w_s, v) + b_s.T[None, None, :, :, None]
    return u * s.reshape(B, S, C_WIDTH)


def centred_token_shift(f, mu):
    prev = jnp.pad(f[:, :-1], ((0, 0), (1, 0), (0, 0)))
    nxt = jnp.pad(f[:, 1:], ((0, 0), (0, 1), (0, 0)))
    return f + mu[0] * (prev - f) + mu[1] * (nxt - f)


def wkv7_scan(r, w, k, v, a, b):
    T, N, H, K = r.shape

    def step(state, inp):
        r_t, w_t, k_t, v_t, a_t, b_t = inp
        sa = jnp.einsum('nhvk,nhk->nhv', state, a_t)
        state = state * w_t[:, :, None, :] + sa[..., :, None] * b_t[..., None, :] + v_t[..., :, None] * k_t[..., None, :]
        return state, jnp.einsum('nhvk,nhk->nhv', state, r_t)

    s0 = jnp.zeros((N, H, K, K), jnp.float32)
    _, y = lax.scan(step, s0, (r, w, k, v, a, b))
    return y


def rwkv7_bidirectional(f, w0, w2, a0, a2, g2, k_k, k_a, r_k, ln_g, ln_b):
    B, S, _ = f.shape
    H, K = D_HEADS, HEAD_DIM
    r, k, v, hw, ha, hg = split_cols(f, [D_WIDTH, D_WIDTH, D_WIDTH, 2 * D_DECAY_LORA, 2 * D_AAA_LORA, D_GATE_LORA])
    hw = hw.reshape(B, S, 2, D_DECAY_LORA)
    ha = ha.reshape(B, S, 2, D_AAA_LORA)
    w_log = -jax.nn.softplus(-(w0 + jnp.einsum('bsdr,drc->bsdc', jnp.tanh(hw), w2))) - 0.5
    decay = jnp.exp(-jnp.exp(w_log.astype(jnp.float32)))
    a_lr = jax.nn.sigmoid(a0 + jnp.einsum('bsdr,drc->bsdc', ha, a2))
    g = jax.nn.sigmoid(hg) @ g2
    kk = (k * k_k).astype(jnp.float32).reshape(B, S, H, K)
    kk = (kk / jnp.maximum(jnp.linalg.norm(kk, axis=-1, keepdims=True), 1e-12)).reshape(B, S, D_WIDTH)
    k_dir = k[:, :, None, :] * (1.0 + (a_lr - 1.0) * k_a)

    def seq(t):
        both = jnp.concatenate([t[:, :, 0], jnp.flip(t[:, :, 1], axis=1)], axis=0)
        return both.astype(jnp.float32).reshape(2 * B, S, H, K).transpose(1, 0, 2, 3)

    def shared(t):
        return jnp.stack([t, t], axis=2)

    y = wkv7_scan(seq(shared(r)), seq(decay), seq(k_dir), seq(shared(v)), seq(shared(-kk)), seq(kk[:, :, None, :] * a_lr))
    y = y.transpose(1, 0, 2, 3)
    y = y[:B] + jnp.flip(y[B:], axis=1)
    mu = jnp.mean(y, axis=-1, keepdims=True)
    var = jnp.mean(jnp.square(y - mu), axis=-1, keepdims=True)
    y = ((y - mu) * lax.rsqrt(var + GN_EPS)).reshape(B, S, D_WIDTH) * ln_g + ln_b
    rk = jnp.sum(r[:, :, None, :] * k_dir, axis=2).reshape(B, S, H, K)
    bonus = jnp.sum(rk * r_k, axis=-1, keepdims=True) * v.reshape(B, S, H, K)
    return ((y + bonus.reshape(B, S, D_WIDTH)) * g).astype(f.dtype)


def odd_mixer(h, w_in, c_ln_g, c_ln_b, c_w_s, c_b_s, d_shift, d_w0, d_w2, d_a0, d_a2, d_g2, d_k_k, d_k_a, d_r_k, d_ln_g, d_ln_b, w_out):
    p = h @ w_in
    cu, cv, fd = split_cols(p, [C_WIDTH, C_WIDTH, D_SHIFT_WIDTH])
    yc = spatial_gating(cu, cv, c_ln_g, c_ln_b, c_w_s, c_b_s)
    yd = rwkv7_bidirectional(centred_token_shift(fd, d_shift), d_w0, d_w2, d_a0, d_a2, d_g2, d_k_k, d_k_a, d_r_k, d_ln_g, d_ln_b)
    return jnp.concatenate([yc, yd], axis=-1) @ w_out


def memory_cross_attention(h, m, wq, wkv, wo):
    B, S, _ = h.shape
    M = m.shape[1]
    q = (h @ wq).reshape(B, S, MEM_HEADS, MEM_HEAD_DIM)
    kv = (m @ wkv).reshape(B, M, 2, MEM_HEADS, MEM_HEAD_DIM)
    s = jnp.einsum('bshd,bmhd->bhsm', q, kv[:, :, 0], preferred_element_type=jnp.float32) * (MEM_HEAD_DIM ** -0.5)
    p = jax.nn.softmax(s, axis=-1).astype(h.dtype)
    o = jnp.einsum('bhsm,bmhd->bshd', p, kv[:, :, 1]).reshape(B, S, MEM_HEADS * MEM_HEAD_DIM)
    return o @ wo


def expert_choice_ffn(h, w_router, w_gate, w_up, w_down):
    B, N, _ = h.shape
    cap = max(1, CAPACITY_FACTOR * N // N_EXPERTS)
    aff = jax.nn.softmax((h @ w_router).astype(jnp.float32), axis=-1)
    gate, idx = lax.top_k(jnp.swapaxes(aff, 1, 2), cap)
    bidx = jnp.arange(B)[:, None, None]
    xe = h[bidx, idx]
    hid = jax.nn.silu(jnp.einsum('becd,edf->becf', xe, w_gate)) * jnp.einsum('becd,edf->becf', xe, w_up)
    ye = jnp.einsum('becf,efd->becd', hid, w_down) * gate[..., None].astype(h.dtype)
    return jnp.zeros_like(h).at[bidx, idx].add(ye)


def setup_inputs(seed: int = 0) -> dict:
    key = jax.random.key(seed)
    ks = iter(jax.random.split(key, 64))
    f32 = jnp.float32
    ne, no, nl = (DEPTH + 1) // 2, DEPTH // 2, DEPTH

    def nrm(shape, scale):
        return jax.random.normal(next(ks), shape, f32) * scale

    def gain(shape):
        return 1.0 + nrm(shape, 0.05)

    def unif(shape, lo, hi):
        return jax.random.uniform(next(ks), shape, f32, lo, hi)

    return {
        "x": nrm((BATCH, SEQ, D_MODEL), 1.0),
        "mem": nrm((BATCH, MEM_LEN, D_MODEL), 1.0),
        "e_norm": gain((ne, D_MODEL)),
        "e_w_in": nrm((ne, D_MODEL, EVEN_IN), D_MODEL ** -0.5),
        "e_sink": nrm((ne, B_Q_HEADS), 0.5),
        "e_w_out": nrm((ne, MIX_WIDTH, D_MODEL), MIX_WIDTH ** -0.5),
        "o_norm": gain((no, D_MODEL)),
        "o_w_in": nrm((no, D_MODEL, ODD_IN), D_MODEL ** -0.5),
        "c_ln_g": gain((no, C_WIDTH)),
        "c_ln_b": nrm((no, C_WIDTH), 0.02),
        "c_w_s": nrm((no, C_GROUPS, C_CHUNK, C_CHUNK), C_CHUNK ** -0.5),
        "c_b_s": gain((no, C_GROUPS, C_CHUNK)),
        "d_shift": unif((no, 2, D_SHIFT_WIDTH), 0.0, 0.5),
        "d_w0": unif((no, 2, D_WIDTH), -6.0, -1.0),
        "d_w2": nrm((no, 2, D_DECAY_LORA, D_WIDTH), 0.1 * D_DECAY_LORA ** -0.5),
        "d_a0": nrm((no, 2, D_WIDTH), 0.1),
        "d_a2": nrm((no, 2, D_AAA_LORA, D_WIDTH), 0.1 * D_AAA_LORA ** -0.5),
        "d_g2": nrm((no, D_GATE_LORA, D_WIDTH), D_GATE_LORA ** -0.5),
        "d_k_k": 0.85 + nrm((no, D_WIDTH), 0.05),
        "d_k_a": gain((no, D_WIDTH)),
        "d_r_k": nrm((no, D_HEADS, HEAD_DIM), 0.1),
        "d_ln_g": gain((no, D_WIDTH)),
        "d_ln_b": nrm((no, D_WIDTH), 0.02),
        "o_w_out": nrm((no, C_WIDTH + D_WIDTH, D_MODEL), (C_WIDTH + D_WIDTH) ** -0.5),
        "x_norm": gain((nl, D_MODEL)),
        "m_norm": gain((nl, D_MODEL)),
        "x_wq": nrm((nl, D_MODEL, MEM_HEADS * MEM_HEAD_DIM), D_MODEL ** -0.5),
        "x_wkv": nrm((nl, D_MODEL, 2 * MEM_HEADS * MEM_HEAD_DIM), D_MODEL ** -0.5),
        "x_wo": nrm((nl, MEM_HEADS * MEM_HEAD_DIM, D_MODEL), D_MODEL ** -0.5),
        "f_norm": gain((nl, D_MODEL)),
        "f_router": nrm((nl, D_MODEL, N_EXPERTS), D_MODEL ** -0.5),
        "f_w_gate": nrm((nl, N_EXPERTS, D_MODEL, D_EXPERT), D_MODEL ** -0.5),
        "f_w_up": nrm((nl, N_EXPERTS, D_MODEL, D_EXPERT), D_MODEL ** -0.5),
        "f_w_down": nrm((nl, N_EXPERTS, D_EXPERT, D_MODEL), D_EXPERT ** -0.5),
        "final_norm": gain((D_MODEL,)),
    }


def reference(x, mem, e_norm, e_w_in, e_sink, e_w_out, o_norm, o_w_in, c_ln_g, c_ln_b, c_w_s, c_b_s, d_shift, d_w0, d_w2, d_a0, d_a2, d_g2, d_k_k, d_k_a, d_r_k, d_ln_g, d_ln_b, o_w_out, x_norm, m_norm, x_wq, x_wkv, x_wo, f_norm, f_router, f_w_gate, f_w_up, f_w_down, final_norm):
    cos, sin = rope_tables(x.shape[1], HEAD_DIM)
    for layer in range(DEPTH):
        i = layer // 2
        if layer % 2 == 0:
            x = x + even_mixer(rmsnorm(x, e_norm[i]), e_w_in[i], e_sink[i], e_w_out[i], cos, sin)
        else:
            x = x + odd_mixer(rmsnorm(x, o_norm[i]), o_w_in[i], c_ln_g[i], c_ln_b[i], c_w_s[i], c_b_s[i], d_shift[i], d_w0[i], d_w2[i], d_a0[i], d_a2[i], d_g2[i], d_k_k[i], d_k_a[i], d_r_k[i], d_ln_g[i], d_ln_b[i], o_w_out[i])
        x = x + memory_cross_attention(rmsnorm(x, x_norm[layer]), rmsnorm(mem, m_norm[layer]), x_wq[layer], x_wkv[layer], x_wo[layer])
        x = x + expert_choice_ffn(rmsnorm(x, f_norm[layer]), f_router[layer], f_w_gate[layer], f_w_up[layer], f_w_down[layer])
    return rmsnorm(x, final_norm)
```

```cpp
#include <hip/hip_runtime.h>
#include <cstdio>
#include <cstdint>

#ifndef MK_MULTI
#define MK_MULTI 0
#endif

namespace {
constexpr int D = 1024, NB = 2, S = 8192, T = NB * S;
constexpr int EVEN_IN = 2304, ODD_IN = 2944, FD = 1920;
constexpr int MEM = 256, NE = 16, CAP = 1024, DE = 2816;
constexpr int NTH = 512;
constexpr size_t MiB = 1u << 20;
constexpr size_t WS_CTL = 0, CTL_BYTES = 1 * MiB;
constexpr size_t WS_ROPE = 1 * MiB;
constexpr size_t WS_AFF = 4 * MiB;
constexpr size_t WS_TOK = 5 * MiB;
constexpr size_t WS_GATE = 6 * MiB;
constexpr size_t WS_X = 8 * MiB;
constexpr size_t WS_H = 72 * MiB;
constexpr size_t WS_P = 136 * MiB;
constexpr size_t WS_Y = 320 * MiB;
constexpr size_t WS_Q = 384 * MiB;
constexpr size_t WS_KV = 448 * MiB;
constexpr size_t WS_MN = 452 * MiB;
constexpr size_t WS_DEC = 456 * MiB;
constexpr size_t WS_KD = 520 * MiB;
constexpr size_t WS_BB = 584 * MiB;
constexpr size_t WS_KK = 648 * MiB;
constexpr size_t WS_G = 680 * MiB;
constexpr size_t WS_YS = 712 * MiB;
constexpr size_t WS_GH = 136 * MiB;
constexpr size_t WS_HID = 488 * MiB;
constexpr size_t WS_END = 840 * MiB;
constexpr int CW_BAR = 4096;

constexpr int LDS_BYTES = 147456;
constexpr int LDS_BAR_OFF = LDS_BYTES - 64;

#define LAS __attribute__((address_space(3)))
#define XB_TMO      128
#define XB_XCNT(j)  (256  + 64 * (j))
#define XB_XSUB(j)  (1280 + 64 * (j))
#define XB_XGEN(j)  (2304 + 64 * (j))
#define XB_TOP      3328
#define XB_TOPGEN   3392
#define XCD_BAR_WORDS 3456
#define XB_SPIN_CAP (1u << 22)
__device__ __forceinline__ unsigned xb_ld(unsigned* p)              { return __hip_atomic_load(p, __ATOMIC_RELAXED, __HIP_MEMORY_SCOPE_AGENT); }
__device__ __forceinline__ unsigned xb_add(unsigned* p, unsigned v) { return __hip_atomic_fetch_add(p, v, __ATOMIC_RELAXED, __HIP_MEMORY_SCOPE_AGENT); }
__device__ __forceinline__ unsigned xb_xcc_id() { return (unsigned)__builtin_amdgcn_s_getreg((3 << 11) | 20) & 0xFu; }
#define XB_SPIN(cond, bar) do { unsigned _sp = 0; while (cond) { __builtin_amdgcn_s_sleep(1); \
    if ((++_sp & 255u) == 0u) { if (xb_ld(&(bar)[XB_TMO])) break; if (_sp > XB_SPIN_CAP) { atomicAdd(&(bar)[XB_TMO], 1u); break; } } } } while (0)
struct XcdBarrier { unsigned* bar; unsigned x; volatile LAS unsigned* st; };
__device__ __forceinline__ XcdBarrier xcd_barrier_post(unsigned* bar, volatile LAS unsigned* st) {
    XcdBarrier b; b.bar = bar; b.x = xb_xcc_id(); b.st = st;
    if (threadIdx.x == 0) (void)xb_add(&bar[XB_XCNT(b.x)], 1u);
    return b;
}
__device__ __forceinline__ void xcd_barrier_complete(unsigned* bar, unsigned x, unsigned& nloc, unsigned& nx) {
    const unsigned G = gridDim.x * gridDim.y * gridDim.z;
    unsigned sum, cnt, mine, sp = 0u;
    for (;;) {
        sum = 0u; cnt = 0u; mine = 0u;
#pragma unroll
        for (unsigned j = 0; j < 16; ++j) { const unsigned c = xb_ld(&bar[XB_XCNT(j)]); sum += c; cnt += (c > 0u) ? 1u : 0u; mine = (j == x) ? c : mine; }
        if (sum == G) break;
        __builtin_amdgcn_s_sleep(1);
        if ((++sp & 255u) == 0u) { if (xb_ld(&bar[XB_TMO])) break; if (sp > XB_SPIN_CAP) { atomicAdd(&bar[XB_TMO], 1u); break; } }
    }
    nloc = mine > 0u ? mine : 1u; nx = cnt > 0u ? cnt : 1u;
}
__device__ __forceinline__ void xcd_barrier(const XcdBarrier& b) {
    asm volatile("s_waitcnt vmcnt(0)" ::: "memory");
    __syncthreads();
    if (threadIdx.x == 0) {
        unsigned* bar = b.bar;
        __builtin_amdgcn_s_waitcnt(0);
        unsigned nloc = b.st[0], nx = b.st[1];
        if (nloc == 0u) { xcd_barrier_complete(bar, b.x, nloc, nx); b.st[0] = nloc; b.st[1] = nx; }
        const unsigned old = xb_add(&bar[XB_XSUB(b.x)], 1u);
        const unsigned gen = old / nloc;
        if (old + 1u == (gen + 1u) * nloc) {
            __builtin_amdgcn_fence(__ATOMIC_RELEASE, "agent");
            asm volatile("s_waitcnt vmcnt(0)" ::: "memory");
            const unsigned og = xb_add(&bar[XB_TOP], 1u);
            const unsigned tg = og / nx;
            if (og + 1u == (tg + 1u) * nx) xb_add(&bar[XB_TOPGEN], 1u);
            else XB_SPIN(xb_ld(&bar[XB_TOPGEN]) == tg, bar);
            __builtin_amdgcn_fence(__ATOMIC_ACQUIRE, "agent");
            xb_add(&bar[XB_XGEN(b.x)], 1u);
            asm volatile("s_waitcnt vmcnt(0)" ::: "memory");
        } else {
            XB_SPIN(xb_ld(&bar[XB_XGEN(b.x)]) == gen, bar);
            __builtin_amdgcn_fence(__ATOMIC_ACQUIRE, "agent");
            asm volatile("s_waitcnt vmcnt(0)" ::: "memory");
        }
    }
    __syncthreads();
}

__device__ __forceinline__ float wave_sum(float v) {
#pragma unroll
    for (int o = 32; o >= 1; o >>= 1) v += __shfl_xor(v, o);
    return v;
}
__device__ __forceinline__ float sigmoidf_(float x) { return 1.0f / (1.0f + expf(-x)); }
__device__ __forceinline__ float gelu_tanh(float x) { return 0.5f * x * (1.0f + tanhf(0.7978845608028654f * (x + 0.044715f * x * x * x))); }

struct Args { const float* in[35]; float* out; unsigned char* ws; int lo, hi; };

template <class RowA, class BSel, class Epi>
__device__ __forceinline__ void sgemm(float* lds, int M, int N, int K, int ldb, RowA rowA, BSel bsel, Epi epi) {
    float (*As)[132] = (float (*)[132])lds;
    float (*Bs)[68] = (float (*)[68])(lds + 16 * 132);
    const int tid = threadIdx.x, tx = tid & 15, ty = tid >> 4;
    const int ntn = N / 64, ntiles = (M / 128) * ntn;
    for (int tile = blockIdx.x; tile < ntiles; tile += gridDim.x) {
        const int tm = tile / ntn, tn = tile % ntn, m0 = tm * 128, n0 = tn * 64;
        const float* Bp = bsel(m0);
        const int ar = tid >> 2, ak = (tid & 3) * 4;
        const float* arow = rowA(m0 + ar);
        float acc[4][4];
#pragma unroll
        for (int i = 0; i < 4; ++i)
#pragma unroll
            for (int j = 0; j < 4; ++j) acc[i][j] = 0.f;
        for (int k0 = 0; k0 < K; k0 += 16) {
            const float4 av = *(const float4*)(arow + k0 + ak);
            float4 bv = make_float4(0.f, 0.f, 0.f, 0.f);
            if (tid < 256) bv = *(const float4*)(Bp + (size_t)(k0 + (tid >> 4)) * ldb + n0 + (tid & 15) * 4);
            __syncthreads();
            As[ak + 0][ar] = av.x; As[ak + 1][ar] = av.y; As[ak + 2][ar] = av.z; As[ak + 3][ar] = av.w;
            if (tid < 256) *(float4*)&Bs[tid >> 4][(tid & 15) * 4] = bv;
            __syncthreads();
#pragma unroll
            for (int kk = 0; kk < 16; ++kk) {
                const float4 a = *(const float4*)&As[kk][ty * 4];
                const float4 b = *(const float4*)&Bs[kk][tx * 4];
                const float aa[4] = {a.x, a.y, a.z, a.w}, bb[4] = {b.x, b.y, b.z, b.w};
#pragma unroll
                for (int i = 0; i < 4; ++i)
#pragma unroll
                    for (int j = 0; j < 4; ++j) acc[i][j] += aa[i] * bb[j];
            }
        }
#pragma unroll
        for (int i = 0; i < 4; ++i) epi(m0 + ty * 4 + i, n0 + tx * 4, make_float4(acc[i][0], acc[i][1], acc[i][2], acc[i][3]));
    }
}

__device__ __forceinline__ void rmsnorm_rows(const float* x, const float* g, float* out, int M) {
    const int lane = threadIdx.x & 63, gw = blockIdx.x * 8 + (threadIdx.x >> 6), ngw = gridDim.x * 8;
    for (int m = gw; m < M; m += ngw) {
        const float4* xr = (const float4*)(x + (size_t)m * D);
        float4 v[4]; float s = 0.f;
#pragma unroll
        for (int j = 0; j < 4; ++j) { v[j] = xr[lane + 64 * j]; s += v[j].x * v[j].x + v[j].y * v[j].y + v[j].z * v[j].z + v[j].w * v[j].w; }
        const float r = rsqrtf(wave_sum(s) * (1.0f / D) + 1e-6f);
        float4* o = (float4*)(out + (size_t)m * D);
#pragma unroll
        for (int j = 0; j < 4; ++j) { const float4 gg = ((const float4*)g)[lane + 64 * j];
            o[lane + 64 * j] = make_float4(v[j].x * r * gg.x, v[j].y * r * gg.y, v[j].z * r * gg.z, v[j].w * r * gg.w); }
    }
}

__device__ __forceinline__ void xattn_naive(const float* Q, const float* KV, float* Y) {
    const int lane = threadIdx.x & 63, gw = blockIdx.x * 8 + (threadIdx.x >> 6), ngw = gridDim.x * 8;
    for (int it = gw; it < T * 4; it += ngw) {
        const int tok = it >> 2, h = it & 3, b = tok / S;
        float4 q = *(const float4*)(Q + (size_t)tok * D + h * 256 + lane * 4);
        q.x *= 0.0625f; q.y *= 0.0625f; q.z *= 0.0625f; q.w *= 0.0625f;
        float m = -3.0e38f, l = 0.f; float4 acc = make_float4(0.f, 0.f, 0.f, 0.f);
        for (int j = 0; j < MEM; ++j) {
            const float* kr = KV + (size_t)(b * MEM + j) * 2048 + h * 256 + lane * 4;
            const float4 k = *(const float4*)kr, v = *(const float4*)(kr + 1024);
            const float sc = wave_sum(q.x * k.x + q.y * k.y + q.z * k.z + q.w * k.w);
            const float mn = fmaxf(m, sc), al = expf(m - mn), p = expf(sc - mn);
            l = l * al + p; acc.x = acc.x * al + p * v.x; acc.y = acc.y * al + p * v.y; acc.z = acc.z * al + p * v.z; acc.w = acc.w * al + p * v.w; m = mn;
        }
        const float inv = 1.0f / l;
        *(float4*)(Y + (size_t)tok * D + h * 256 + lane * 4) = make_float4(acc.x * inv, acc.y * inv, acc.z * inv, acc.w * inv);
    }
}

__device__ __forceinline__ int block_exscan(int v, int* sh, int* tot) {
    const int tid = threadIdx.x, lane = tid & 63, w = tid >> 6;
    int inc = v;
#pragma unroll
    for (int o = 1; o < 64; o <<= 1) { const int t = __shfl_up(inc, o); if (lane >= o) inc += t; }
    __syncthreads();
    if (lane == 63) sh[w] = inc;
    __syncthreads();
    int base = 0, total = 0;
#pragma unroll
    for (int i = 0; i < 8; ++i) { const int x = sh[i]; if (i < w) base += x; total += x; }
    *tot = total;
    return base + inc - v;
}

#define IN(k) (lo <= (k) && (k) < hi)
#define SEAM(k) do { if (IN(k) && IN((k) + 1)) xcd_barrier(bar); } while (0)
__device__ __forceinline__ int odd_phases(const Args& a, const XcdBarrier& bar, float* ldsf, int ph) {
    const int tid = threadIdx.x, lane = tid & 63, wave = tid >> 6;
    const int bid = blockIdx.x, nb = gridDim.x;
    const int gw = bid * 8 + wave, ngw = nb * 8;
    const int gt = bid * NTH + tid, ngt = nb * NTH;
    (void)gt; (void)ngt; (void)gw; (void)ngw; (void)lane; (void)wave;
    unsigned char* ws = a.ws;
    const int lo = a.lo, hi = a.hi;
    const float* x_in = a.in[0]; const float* mem = a.in[1]; (void)x_in; (void)mem;
    float* AFF = (float*)(ws + WS_AFF); int* TOK = (int*)(ws + WS_TOK); float* GATE = (float*)(ws + WS_GATE);
    float* X = (float*)(ws + WS_X); float* H = (float*)(ws + WS_H); float* P = (float*)(ws + WS_P);
    float* Y = (float*)(ws + WS_Y); float* Q = (float*)(ws + WS_Q); float* KV = (float*)(ws + WS_KV); float* MN = (float*)(ws + WS_MN);
    float* DEC = (float*)(ws + WS_DEC); float* KD = (float*)(ws + WS_KD); float* BB = (float*)(ws + WS_BB);
    float* KK = (float*)(ws + WS_KK); float* G = (float*)(ws + WS_G); float* YS = (float*)(ws + WS_YS);
    float* GH = (float*)(ws + WS_GH); float* HID = (float*)(ws + WS_HID);
    float* VN = H; float* RV = Q;
    (void)AFF; (void)TOK; (void)GATE; (void)X; (void)H; (void)P; (void)Y; (void)Q; (void)KV; (void)MN; (void)DEC; (void)KD; (void)BB; (void)KK; (void)G; (void)YS; (void)GH; (void)HID; (void)VN; (void)RV;
        if (IN(ph)) rmsnorm_rows(X, a.in[6], H, T);
        SEAM(ph); ++ph;
        if (IN(ph)) {
            const float* W = a.in[7];
            sgemm(ldsf, T, ODD_IN, D, ODD_IN, [&](int m) { return H + (size_t)m * D; }, [&](int) { return W; },
                  [&](int m, int n, float4 v) { *(float4*)(P + (size_t)m * ODD_IN + n) = v; });
        }
        SEAM(ph); ++ph;
        if (IN(ph)) {
            float* fsh = ldsf + wave * 2048;
            const float* mu = a.in[12];
            const float *w0 = a.in[13], *w2 = a.in[14], *a0 = a.in[15], *a2 = a.in[16], *g2 = a.in[17], *k_k = a.in[18], *k_a = a.in[19];
            const float *clg = a.in[8], *clb = a.in[9];
            for (int tok = gw; tok < T; tok += ngw) {
                const int s = tok % S;
                const float* pr = P + (size_t)tok * ODD_IN;
                {
                    float ge[8]; float sm = 0.f;
#pragma unroll
                    for (int j = 0; j < 8; ++j) { ge[j] = gelu_tanh(pr[512 + lane + 64 * j]); sm += ge[j]; }
                    const float mean = wave_sum(sm) * (1.0f / 512.f); float sq = 0.f;
#pragma unroll
                    for (int j = 0; j < 8; ++j) { const float d = ge[j] - mean; sq += d * d; }
                    const float rstd = rsqrtf(wave_sum(sq) * (1.0f / 512.f) + 1e-5f);
#pragma unroll
                    for (int j = 0; j < 8; ++j) { const int c = lane + 64 * j; VN[(size_t)tok * 512 + c] = (ge[j] - mean) * rstd * clg[c] + clb[c]; }
                }
                for (int c = lane; c < FD; c += 64) {
                    const float f = pr[1024 + c];
                    const float pv = s > 0 ? pr[1024 + c - ODD_IN] : 0.f;
                    const float nx = s < S - 1 ? pr[1024 + c + ODD_IN] : 0.f;
                    fsh[c] = f + mu[c] * (pv - f) + mu[FD + c] * (nx - f);
                }
                asm volatile("s_waitcnt lgkmcnt(0)" ::: "memory");
                asm volatile("" ::: "memory");
#pragma unroll 1
                for (int hd = 0; hd < 8; ++hd) {
                    const int c = lane + 64 * hd;
                    const float r = fsh[c], k = fsh[512 + c], v = fsh[1024 + c];
                    float wl[2], al[2], g = 0.f;
#pragma unroll
                    for (int d = 0; d < 2; ++d) { wl[d] = w0[d * 512 + c]; al[d] = a0[d * 512 + c]; }
                    for (int rr = 0; rr < 64; ++rr) {
#pragma unroll
                        for (int d = 0; d < 2; ++d) {
                            wl[d] += tanhf(fsh[1536 + d * 64 + rr]) * w2[(size_t)(d * 64 + rr) * 512 + c];
                            al[d] += fsh[1664 + d * 64 + rr] * a2[(size_t)(d * 64 + rr) * 512 + c];
                        }
                    }
                    for (int rr = 0; rr < 128; ++rr) g += sigmoidf_(fsh[1792 + rr]) * g2[(size_t)rr * 512 + c];
                    const float kk0 = k * k_k[c];
                    const float nrm = sqrtf(wave_sum(kk0 * kk0));
                    const float kk = kk0 / fmaxf(nrm, 1e-12f);
                    RV[(size_t)tok * D + c] = r; RV[(size_t)tok * D + 512 + c] = v;
                    KK[(size_t)tok * 512 + c] = kk; G[(size_t)tok * 512 + c] = g;
#pragma unroll
                    for (int d = 0; d < 2; ++d) {
                        const float xw = -wl[d];
                        const float sp = xw > 20.f ? xw : log1pf(expf(xw));
                        const float wlog = -sp - 0.5f;
                        const float alr = sigmoidf_(al[d]);
                        DEC[((size_t)d * T + tok) * 512 + c] = expf(-expf(wlog));
                        KD[((size_t)d * T + tok) * 512 + c] = k * (1.0f + (alr - 1.0f) * k_a[c]);
                        BB[((size_t)d * T + tok) * 512 + c] = kk * alr;
                    }
                }
                asm volatile("" ::: "memory");
            }
        }
        SEAM(ph); ++ph;
        if (IN(ph)) {
            const float *wsp = a.in[10], *bsp = a.in[11];
            for (int it = bid; it < NB * 64 * 4; it += nb) {
                const int g = it & 3, chunk = it >> 2;
                const int i = tid >> 2, cq = tid & 3;
                float acc[32];
#pragma unroll
                for (int c = 0; c < 32; ++c) acc[c] = 0.f;
                for (int j = 0; j < 128; ++j) {
                    const float w = wsp[(size_t)(g * 128 + i) * 128 + j];
                    const float4* vr = (const float4*)(VN + (size_t)(chunk * 128 + j) * 512 + g * 128 + cq * 32);
#pragma unroll
                    for (int c4 = 0; c4 < 8; ++c4) { const float4 v = vr[c4]; acc[c4 * 4] += w * v.x; acc[c4 * 4 + 1] += w * v.y; acc[c4 * 4 + 2] += w * v.z; acc[c4 * 4 + 3] += w * v.w; }
                }
                const float bias = bsp[g * 128 + i];
                const int tok = chunk * 128 + i;
#pragma unroll
                for (int c = 0; c < 32; ++c) {
                    const int col = g * 128 + cq * 32 + c;
                    Y[(size_t)tok * D + col] = gelu_tanh(P[(size_t)tok * ODD_IN + col]) * (acc[c] + bias);
                }
            }
        }
        SEAM(ph); ++ph;
        if (IN(ph)) {
            if (bid < 32 && tid < 256) {
                const int n = bid >> 3, h = bid & 7, dir = n >> 1, b = n & 1;
                const int j = tid >> 2, q = tid & 3;
                float st[16];
#pragma unroll
                for (int i = 0; i < 16; ++i) st[i] = 0.f;
                const int co = h * 64 + q * 16;
                for (int step = 0; step < S; ++step) {
                    const int s = dir ? S - 1 - step : step; const size_t tok = (size_t)b * S + s;
                    const float4* rp = (const float4*)(RV + tok * D + co);
                    const float4* wp = (const float4*)(DEC + ((size_t)dir * T + tok) * 512 + co);
                    const float4* kp = (const float4*)(KD + ((size_t)dir * T + tok) * 512 + co);
                    const float4* ap = (const float4*)(KK + tok * 512 + co);
                    const float4* bp = (const float4*)(BB + ((size_t)dir * T + tok) * 512 + co);
                    const float vj = RV[tok * D + 512 + h * 64 + j];
                    float rr[16], ww[16], kk[16], aa[16], bb[16];
#pragma unroll
                    for (int i = 0; i < 4; ++i) {
                        const float4 r4 = rp[i], w4 = wp[i], k4 = kp[i], a4 = ap[i], b4 = bp[i];
                        rr[4 * i] = r4.x; rr[4 * i + 1] = r4.y; rr[4 * i + 2] = r4.z; rr[4 * i + 3] = r4.w;
                        ww[4 * i] = w4.x; ww[4 * i + 1] = w4.y; ww[4 * i + 2] = w4.z; ww[4 * i + 3] = w4.w;
                        kk[4 * i] = k4.x; kk[4 * i + 1] = k4.y; kk[4 * i + 2] = k4.z; kk[4 * i + 3] = k4.w;
                        aa[4 * i] = -a4.x; aa[4 * i + 1] = -a4.y; aa[4 * i + 2] = -a4.z; aa[4 * i + 3] = -a4.w;
                        bb[4 * i] = b4.x; bb[4 * i + 1] = b4.y; bb[4 * i + 2] = b4.z; bb[4 * i + 3] = b4.w;
                    }
                    float sa = 0.f;
#pragma unroll
                    for (int i = 0; i < 16; ++i) sa += st[i] * aa[i];
                    sa += __shfl_xor(sa, 1); sa += __shfl_xor(sa, 2);
                    float y = 0.f;
#pragma unroll
                    for (int i = 0; i < 16; ++i) { st[i] = st[i] * ww[i] + sa * bb[i] + vj * kk[i]; y += st[i] * rr[i]; }
                    y += __shfl_xor(y, 1); y += __shfl_xor(y, 2);
                    if (q == 0) YS[((size_t)n * S + s) * 512 + h * 64 + j] = y;
                }
            }
        }
        SEAM(ph); ++ph;
        if (IN(ph)) {
            const float *r_k = a.in[20], *lng = a.in[21], *lnb = a.in[22];
            for (int it = gw; it < T * 8; it += ngw) {
                const int tok = it >> 3, h = it & 7, b = tok / S, s = tok % S, c = h * 64 + lane;
                const float y = YS[((size_t)b * S + s) * 512 + c] + YS[((size_t)(2 + b) * S + s) * 512 + c];
                const float mean = wave_sum(y) * (1.0f / 64.f); const float d = y - mean;
                const float var = wave_sum(d * d) * (1.0f / 64.f);
                const float yn = d * rsqrtf(var + 64e-5f) * lng[c] + lnb[c];
                const float r = RV[(size_t)tok * D + c], v = RV[(size_t)tok * D + 512 + c];
                const float rk = r * (KD[(size_t)tok * 512 + c] + KD[((size_t)T + tok) * 512 + c]);
                const float bonus = wave_sum(rk * r_k[c]) * v;
                Y[(size_t)tok * D + 512 + c] = (yn + bonus) * G[(size_t)tok * 512 + c];
            }
        }
        SEAM(ph); ++ph;
        if (IN(ph)) {
            const float* W = a.in[23];
            sgemm(ldsf, T, D, D, D, [&](int m) { return Y + (size_t)m * D; }, [&](int) { return W; },
                  [&](int m, int n, float4 v) { float4* xp = (float4*)(X + (size_t)m * D + n); const float4 r = *xp;
                      *xp = make_float4(r.x + v.x, r.y + v.y, r.z + v.z, r.w + v.w); });
        }
        SEAM(ph); ++ph;
    return ph;
}
template <int layer>
__device__ __forceinline__ int tail_phases(const Args& a, const XcdBarrier& bar, float* ldsf, int ph) {
    const int tid = threadIdx.x, lane = tid & 63, wave = tid >> 6;
    const int bid = blockIdx.x, nb = gridDim.x;
    const int gw = bid * 8 + wave, ngw = nb * 8;
    const int gt = bid * NTH + tid, ngt = nb * NTH;
    (void)gt; (void)ngt; (void)gw; (void)ngw; (void)lane; (void)wave;
    unsigned char* ws = a.ws;
    const int lo = a.lo, hi = a.hi;
    const float* x_in = a.in[0]; const float* mem = a.in[1]; (void)x_in; (void)mem;
    float* AFF = (float*)(ws + WS_AFF); int* TOK = (int*)(ws + WS_TOK); float* GATE = (float*)(ws + WS_GATE);
    float* X = (float*)(ws + WS_X); float* H = (float*)(ws + WS_H); float* P = (float*)(ws + WS_P);
    float* Y = (float*)(ws + WS_Y); float* Q = (float*)(ws + WS_Q); float* KV = (float*)(ws + WS_KV); float* MN = (float*)(ws + WS_MN);
    float* DEC = (float*)(ws + WS_DEC); float* KD = (float*)(ws + WS_KD); float* BB = (float*)(ws + WS_BB);
    float* KK = (float*)(ws + WS_KK); float* G = (float*)(ws + WS_G); float* YS = (float*)(ws + WS_YS);
    float* GH = (float*)(ws + WS_GH); float* HID = (float*)(ws + WS_HID);
    float* VN = H; float* RV = Q;
    (void)AFF; (void)TOK; (void)GATE; (void)X; (void)H; (void)P; (void)Y; (void)Q; (void)KV; (void)MN; (void)DEC; (void)KD; (void)BB; (void)KK; (void)G; (void)YS; (void)GH; (void)HID; (void)VN; (void)RV;
    if (IN(ph)) { rmsnorm_rows(X, a.in[24] + layer * D, H, T); rmsnorm_rows(mem, a.in[25] + layer * D, MN, NB * MEM); }
    SEAM(ph); ++ph;
    if (IN(ph)) {
        const float* Wq = a.in[26] + (size_t)layer * D * D; const float* Wkv = a.in[27] + (size_t)layer * D * 2048;
        sgemm(ldsf, T, D, D, D, [&](int m) { return H + (size_t)m * D; }, [&](int) { return Wq; },
              [&](int m, int n, float4 v) { *(float4*)(Q + (size_t)m * D + n) = v; });
        sgemm(ldsf, NB * MEM, 2048, D, 2048, [&](int m) { return MN + (size_t)m * D; }, [&](int) { return Wkv; },
              [&](int m, int n, float4 v) { *(float4*)(KV + (size_t)m * 2048 + n) = v; });
    }
    SEAM(ph); ++ph;
    if (IN(ph)) xattn_naive(Q, KV, Y);
    SEAM(ph); ++ph;
    if (IN(ph)) {
        const float* W = a.in[28] + (size_t)layer * D * D;
        sgemm(ldsf, T, D, D, D, [&](int m) { return Y + (size_t)m * D; }, [&](int) { return W; },
              [&](int m, int n, float4 v) { float4* xp = (float4*)(X + (size_t)m * D + n); const float4 r = *xp;
                  *xp = make_float4(r.x + v.x, r.y + v.y, r.z + v.z, r.w + v.w); });
    }
    SEAM(ph); ++ph;
    if (IN(ph)) {
        const float* g = a.in[29] + layer * D; const float* Wr = a.in[30] + (size_t)layer * D * NE;
        for (int m = gw; m < T; m += ngw) {
            const float4* xr = (const float4*)(X + (size_t)m * D);
            float4 v[4]; float s = 0.f;
#pragma unroll
            for (int j = 0; j < 4; ++j) { v[j] = xr[lane + 64 * j]; s += v[j].x * v[j].x + v[j].y * v[j].y + v[j].z * v[j].z + v[j].w * v[j].w; }
            const float r = rsqrtf(wave_sum(s) * (1.0f / D) + 1e-6f);
            float lg[16];
#pragma unroll
            for (int e = 0; e < 16; ++e) lg[e] = 0.f;
#pragma unroll
            for (int j = 0; j < 4; ++j) {
                const float4 gg = ((const float4*)g)[lane + 64 * j];
                const float4 hv = make_float4(v[j].x * r * gg.x, v[j].y * r * gg.y, v[j].z * r * gg.z, v[j].w * r * gg.w);
                ((float4*)(H + (size_t)m * D))[lane + 64 * j] = hv;
                const float hh[4] = {hv.x, hv.y, hv.z, hv.w};
#pragma unroll
                for (int q = 0; q < 4; ++q) {
                    const float4* wr = (const float4*)(Wr + (size_t)((lane + 64 * j) * 4 + q) * NE);
#pragma unroll
                    for (int e4 = 0; e4 < 4; ++e4) { const float4 w = wr[e4]; lg[e4 * 4] += hh[q] * w.x; lg[e4 * 4 + 1] += hh[q] * w.y; lg[e4 * 4 + 2] += hh[q] * w.z; lg[e4 * 4 + 3] += hh[q] * w.w; }
                }
            }
            float mx = -3.0e38f;
#pragma unroll
            for (int e = 0; e < 16; ++e) { lg[e] = wave_sum(lg[e]); mx = fmaxf(mx, lg[e]); }
            float den = 0.f;
#pragma unroll
            for (int e = 0; e < 16; ++e) { lg[e] = expf(lg[e] - mx); den += lg[e]; }
            float mine = 0.f;
#pragma unroll
            for (int e = 0; e < 16; ++e) if (lane == e) mine = lg[e] / den;
            if (lane < 16) AFF[(size_t)m * NE + lane] = mine;
        }
    }
    SEAM(ph); ++ph;
    if (IN(ph)) {
        unsigned* keys = (unsigned*)ldsf;
        int* hist = (int*)(ldsf + 8192);
        int* sh = hist + 256;
        for (int be = bid; be < NB * NE; be += nb) {
            const int b = be >> 4, e = be & 15;
            __syncthreads();
            for (int s = tid; s < S; s += NTH) keys[s] = __float_as_uint(AFF[(size_t)(b * S + s) * NE + e]);
            unsigned prefix = 0u; int krem = CAP;
            for (int pass = 3; pass >= 0; --pass) {
                __syncthreads();
                if (tid < 256) hist[tid] = 0;
                __syncthreads();
                const unsigned hmask = pass == 3 ? 0u : (0xFFFFFFFFu << (8 * (pass + 1)));
                for (int s = tid; s < S; s += NTH) { const unsigned k = keys[s]; if ((k & hmask) == prefix) atomicAdd(&hist[(k >> (8 * pass)) & 255u], 1); }
                __syncthreads();
                if (tid == 0) {
                    int cum = 0, bsel = 0;
                    for (int bb = 255; bb >= 0; --bb) { const int c = hist[bb]; if (cum + c >= krem) { bsel = bb; break; } cum += c; }
                    sh[8] = bsel; sh[9] = krem - cum;
                }
                __syncthreads();
                prefix |= ((unsigned)sh[8]) << (8 * pass); krem = sh[9];
            }
            const unsigned thr = prefix;
            int cg = 0, ce = 0;
            for (int i = 0; i < 16; ++i) { const unsigned k = keys[tid * 16 + i]; cg += (k > thr); ce += (k == thr); }
            int tot;
            const int eqbase = block_exscan(ce, sh, &tot);
            int eqr = eqbase, cs = 0;
            for (int i = 0; i < 16; ++i) { const unsigned k = keys[tid * 16 + i]; const bool sel = (k > thr) || (k == thr && eqr < krem); eqr += (k == thr); cs += sel; }
            const int sbase = block_exscan(cs, sh, &tot);
            int slot = sbase; eqr = eqbase;
            for (int i = 0; i < 16; ++i) {
                const int s = tid * 16 + i; const unsigned k = keys[s];
                const bool sel = (k > thr) || (k == thr && eqr < krem); eqr += (k == thr);
                if (sel) { TOK[be * CAP + slot] = b * S + s; GATE[be * CAP + slot] = __uint_as_float(k); ++slot; }
            }
        }
    }
    SEAM(ph); ++ph;
    if (IN(ph)) {
        const float* Wg = a.in[31] + (size_t)layer * NE * D * DE;
        sgemm(ldsf, NB * NE * CAP, DE, D, DE, [&](int m) { return H + (size_t)TOK[m] * D; }, [&](int m0) { return Wg + (size_t)((m0 >> 10) & 15) * D * DE; },
              [&](int m, int n, float4 v) { *(float4*)(GH + (size_t)m * DE + n) = v; });
    }
    SEAM(ph); ++ph;
    if (IN(ph)) {
        const float* Wu = a.in[32] + (size_t)layer * NE * D * DE;
        sgemm(ldsf, NB * NE * CAP, DE, D, DE, [&](int m) { return H + (size_t)TOK[m] * D; }, [&](int m0) { return Wu + (size_t)((m0 >> 10) & 15) * D * DE; },
              [&](int m, int n, float4 v) { const float4 g = *(const float4*)(GH + (size_t)m * DE + n);
                  *(float4*)(HID + (size_t)m * DE + n) = make_float4(g.x * sigmoidf_(g.x) * v.x, g.y * sigmoidf_(g.y) * v.y, g.z * sigmoidf_(g.z) * v.z, g.w * sigmoidf_(g.w) * v.w); });
    }
    SEAM(ph); ++ph;
    if (IN(ph)) {
        const float* Wd = a.in[33] + (size_t)layer * NE * DE * D;
        sgemm(ldsf, NB * NE * CAP, D, DE, D, [&](int m) { return HID + (size_t)m * DE; }, [&](int m0) { return Wd + (size_t)((m0 >> 10) & 15) * DE * D; },
              [&](int m, int n, float4 v) { const float gt_ = GATE[m]; float* xp = X + (size_t)TOK[m] * D + n;
                  atomicAdd(xp, v.x * gt_); atomicAdd(xp + 1, v.y * gt_); atomicAdd(xp + 2, v.z * gt_); atomicAdd(xp + 3, v.w * gt_); });
    }
    SEAM(ph); ++ph;
    return ph;
}
#undef IN
#undef SEAM

__global__ void __launch_bounds__(NTH, 2) mega(Args a) {
    extern __shared__ __attribute__((aligned(16))) unsigned char lds_raw[];
    float* ldsf = (float*)lds_raw;
    const int tid = threadIdx.x, lane = tid & 63, wave = tid >> 6;
    const int bid = blockIdx.x, nb = gridDim.x;
    const int gw = bid * 8 + wave, ngw = nb * 8;
    const int gt = bid * NTH + tid, ngt = nb * NTH;
    unsigned char* ws = a.ws;
    unsigned* ctl = (unsigned*)(ws + WS_CTL);
    volatile LAS unsigned* bst = (volatile LAS unsigned*)((LAS unsigned char*)lds_raw + LDS_BAR_OFF);
    if (tid < 4) bst[tid] = 0u;
    __syncthreads();
    XcdBarrier bar; bar.bar = ctl + CW_BAR; bar.x = 0; bar.st = bst;
    const int lo = a.lo, hi = a.hi;
    if (hi - lo > 1) bar = xcd_barrier_post(ctl + CW_BAR, bst);
#define IN(k) (lo <= (k) && (k) < hi)
#define SEAM(k) do { if (IN(k) && IN((k) + 1)) xcd_barrier(bar); } while (0)

    const float* x_in = a.in[0]; const float* mem = a.in[1];
    float* ropec = (float*)(ws + WS_ROPE); float* ropes = ropec + S * 32;
    float* AFF = (float*)(ws + WS_AFF); int* TOK = (int*)(ws + WS_TOK); float* GATE = (float*)(ws + WS_GATE);
    float* X = (float*)(ws + WS_X); float* H = (float*)(ws + WS_H); float* P = (float*)(ws + WS_P);
    float* Y = (float*)(ws + WS_Y); float* Q = (float*)(ws + WS_Q); float* KV = (float*)(ws + WS_KV); float* MN = (float*)(ws + WS_MN);
    float* DEC = (float*)(ws + WS_DEC); float* KD = (float*)(ws + WS_KD); float* BB = (float*)(ws + WS_BB);
    float* KK = (float*)(ws + WS_KK); float* G = (float*)(ws + WS_G); float* YS = (float*)(ws + WS_YS);
    float* GH = (float*)(ws + WS_GH); float* HID = (float*)(ws + WS_HID);
    float* VN = H; float* RV = Q;

    int ph = 0;
    if (IN(ph)) {
        for (int i = gt; i < S * 32; i += ngt) {
            const int s = i >> 5, f = i & 31;
            const float pw = (float)exp((double)((float)(2 * f) / 64.0f) * 9.210340371976184);
            const float invf = 1.0f / pw;
            const float angf = (float)s * invf;
            double xx = (double)angf;
            const double n = rint(xx * 0.15915494309189535);
            xx = (xx - n * 6.283185307179586) - n * 2.4492935982947064e-16;
            const double x2 = xx * xx;
            double cs = 1.0, sn = xx, tc = 1.0, tsn = xx;
#pragma unroll 1
            for (int k = 1; k <= 16; ++k) { tc *= -x2 / (double)((2 * k - 1) * (2 * k)); tsn *= -x2 / (double)((2 * k) * (2 * k + 1)); cs += tc; sn += tsn; }
            ropec[i] = (float)cs; ropes[i] = (float)sn;
        }
    }
    SEAM(ph); ++ph;

    if (IN(ph)) rmsnorm_rows(x_in, a.in[2], H, T);
    SEAM(ph); ++ph;
    if (IN(ph)) {
        const float* W = a.in[3];
        sgemm(ldsf, T, EVEN_IN, D, EVEN_IN, [&](int m) { return H + (size_t)m * D; }, [&](int) { return W; },
              [&](int m, int n, float4 v) { *(float4*)(P + (size_t)m * EVEN_IN + n) = v; });
    }
    SEAM(ph); ++ph;
    if (IN(ph)) {
        for (int i = gt; i < T * 26 * 32; i += ngt) {
            const int f = i & 31, hh = (i >> 5) % 26, tok = (i >> 5) / 26, s = tok % S;
            const int base = hh < 16 ? hh * 64 : 1536 + (hh - 16) * 64;
            float* p = P + (size_t)tok * EVEN_IN + base + f;
            const float c = ropec[s * 32 + f], sn = ropes[s * 32 + f], x1 = p[0], x2 = p[32];
            p[0] = x1 * c - x2 * sn; p[32] = x2 * c + x1 * sn;
        }
    }
    SEAM(ph); ++ph;
    if (IN(ph)) {
        const float* sink = a.in[4];
        for (int it = gw; it < T * 16; it += ngw) {
            const int tok = it >> 4, hh = it & 15, b = tok / S, s = tok % S;
            float m, l, acc = 0.f;
            if (hh < 8) {
                const float q = P[(size_t)tok * EVEN_IN + hh * 64 + lane] * 0.125f;
                m = -3.0e38f; l = 0.f;
                for (int pat = 0; pat < 3; ++pat) {
                    const int dil = pat == 0 ? 1 : (pat == 1 ? 4 : 16);
                    for (int j = -64; j <= 64; ++j) {
                        const int pos = s + j * dil;
                        if (pos < 0 || pos >= S) continue;
                        const float* kr = P + (size_t)(b * S + pos) * EVEN_IN + hh * 64 + lane;
                        const float sc = wave_sum(q * kr[512]);
                        const float mn = fmaxf(m, sc), al = expf(m - mn), p = expf(sc - mn);
                        l = l * al + p; acc = acc * al + p * kr[1024]; m = mn;
                    }
                }
                Y[(size_t)tok * D + hh * 64 + lane] = acc / l;
            } else {
                const int hq = hh - 8, kvh = hq >> 2;
                const float q = P[(size_t)tok * EVEN_IN + 1536 + hq * 64 + lane] * 0.125f;
                m = sink[hq]; l = 1.f;
                for (int j = -128; j <= 128; ++j) {
                    const int pos = s + j;
                    if (pos < 0 || pos >= S) continue;
                    const float* kr = P + (size_t)(b * S + pos) * EVEN_IN + 2048 + kvh * 64 + lane;
                    const float sc = wave_sum(q * kr[0]);
                    const float mn = fmaxf(m, sc), al = expf(m - mn), p = expf(sc - mn);
                    l = l * al + p; acc = acc * al + p * kr[128]; m = mn;
                }
                Y[(size_t)tok * D + 512 + hq * 64 + lane] = acc / l;
            }
        }
    }
    SEAM(ph); ++ph;
    if (IN(ph)) {
        const float* W = a.in[5];
        sgemm(ldsf, T, D, D, D, [&](int m) { return Y + (size_t)m * D; }, [&](int) { return W; },
              [&](int m, int n, float4 v) { const float4 r = *(const float4*)(x_in + (size_t)m * D + n);
                  *(float4*)(X + (size_t)m * D + n) = make_float4(r.x + v.x, r.y + v.y, r.z + v.z, r.w + v.w); });
    }
    SEAM(ph); ++ph;

    ph = tail_phases<0>(a, bar, ldsf, ph);
    ph = odd_phases(a, bar, ldsf, ph);
    ph = tail_phases<1>(a, bar, ldsf, ph);
    if (IN(ph)) rmsnorm_rows(X, a.in[34], a.out, T);
    ++ph;
#undef IN
#undef SEAM
}
constexpr int NPHASES = 1 + 5 + 2 * 9 + 7 + 1;
}

extern "C" void kernel_launch(void* const* d_in, const int* in_sizes, int n_in, void* d_out, int out_size, void* d_ws, size_t ws_size, hipStream_t stream) {
    static int grid = 0;
    if (grid == 0) {
        if (n_in != 35 || out_size != T * D || ws_size < WS_END) { fprintf(stderr, "kernel_launch: unexpected shapes n_in %d out %d ws %zu\n", n_in, out_size, ws_size); grid = -1; return; }
        int dev = 0, cus = 0, per_cu = 0;
        hipGetDevice(&dev); hipDeviceGetAttribute(&cus, hipDeviceAttributeMultiprocessorCount, dev);
        if (hipFuncSetAttribute((const void*)mega, hipFuncAttributeMaxDynamicSharedMemorySize, LDS_BYTES) != hipSuccess) { fprintf(stderr, "hipFuncSetAttribute failed\n"); grid = -1; return; }
        if (hipOccupancyMaxActiveBlocksPerMultiprocessor(&per_cu, (const void*)mega, NTH, LDS_BYTES) != hipSuccess || per_cu < 1) fprintf(stderr, "occupancy query: %d\n", per_cu);
        (void)hipGetLastError();
        grid = cus > 0 ? cus : 256;
    }
    if (grid < 0) return;
    hipMemsetAsync((char*)d_ws + WS_CTL, 0, CTL_BYTES, stream);
    Args a{};
    for (int i = 0; i < 35; ++i) a.in[i] = (const float*)d_in[i];
    a.out = (float*)d_out; a.ws = (unsigned char*)d_ws;
#if MK_MULTI
    for (int k = 0; k < NPHASES; ++k) { a.lo = k; a.hi = k + 1; hipLaunchKernelGGL(mega, dim3(grid), dim3(NTH), LDS_BYTES, stream, a); }
#else
    a.lo = 0; a.hi = NPHASES; hipLaunchKernelGGL(mega, dim3(grid), dim3(NTH), LDS_BYTES, stream, a);
#endif
}
```

```cpp
#include <hip/hip_runtime.h>
#include <cstdio>
#include <cstdint>

#ifndef MK_MULTI
#define MK_MULTI 0
#endif

namespace pg8 {
#define PG8_LAS __attribute__((address_space(3)))
typedef unsigned short bf16_t;
typedef short bf16x8 __attribute__((ext_vector_type(8)));
typedef float f32x4 __attribute__((ext_vector_type(4)));
typedef unsigned u32x4 __attribute__((ext_vector_type(4)));
constexpr int BM = 256, BK = 64, HALF = 128, HTB = HALF * BK * 2  , STAGE_BYTES = 8 * HTB, NXCD = 8, WGM = 8;

__host__ __device__ __forceinline__ int lds_byte(int r, int c) { const int st = (r >> 4) * 2 + (c >> 5), rr = r & 15, cc = c & 31, ob = rr * 64 + cc * 2; return st * 1024 + (ob ^ (((ob >> 9) & 1) << 5)); }
__host__ __device__ __forceinline__ void stage_rc(int b, int& R, int& C) { const int st = b / 1024, sb = b % 1024, swz = sb ^ (((sb >> 9) & 1) << 5); R = (st >> 1) * 16 + swz / 64; C = (st & 1) * 32 + (swz % 64) / 2; }
__host__ __device__ __forceinline__ int perm32(int rho) { const int n = rho >> 4, i = rho & 15; return 8 * (i >> 2) + 4 * n + (i & 3); }

struct Unit { int pm, pn; };
struct Gemm { const bf16_t* A; const bf16_t* Bt; int M, N, K; };

struct StaticOrder {
    int nM, nN, nwg, G, c;
    __host__ __device__ void init(int M, int N, int G_, int c_) { nM = M / BM; nN = N / BM; nwg = nM * nN; G = G_; c = c_; }
    __host__ __device__ bool next(int i, Unit& u) const {
        const long L = (long)i * G + c; if (L >= nwg) return false;
        int wgid = (int)L; { const int q = nwg / NXCD, r = nwg % NXCD, xcd = wgid % NXCD, off = wgid / NXCD; wgid = (xcd < r ? xcd * (q + 1) : r * (q + 1) + (xcd - r) * q) + off; }
        const int nig = WGM * nN, gid = wgid / nig, fm = gid * WGM, gsz = (nM - fm) < WGM ? (nM - fm) : WGM;
        u.pm = fm + ((wgid % nig) % gsz); u.pn = (wgid % nig) / gsz; return true;
    }
    __device__ __forceinline__ void a_ready(const Unit&) const {}
    __device__ __forceinline__ void done(const Unit&) const {}
};

typedef __bf16 bf16v2_t __attribute__((ext_vector_type(2)));
typedef float f32v2_t __attribute__((ext_vector_type(2)));
__device__ __forceinline__ unsigned cvt_pk_bf16(float lo, float hi) { const f32v2_t v = {lo, hi}; return __builtin_bit_cast(unsigned, __builtin_convertvector(v, bf16v2_t)); }
template <class Epi, class Sched, bool STAMP = false>
__device__ __forceinline__ void gemm_phase(PG8_LAS unsigned char* lds, const Gemm g, const Sched& S, const Epi& E, unsigned long long* stamps) {
    const int tid = threadIdx.x, wid = __builtin_amdgcn_readfirstlane(tid >> 6), lane = tid & 63, wr = wid >> 2, wc = wid & 3, fr = lane & 15, fq = lane >> 4;
    const int K = g.K, nt = K / BK;
    int ts_lo = 0, ts_hi = 0, nts = 0; const unsigned long long rt_entry = STAMP ? (unsigned long long)wall_clock64() : 0ull;
#define PG8_STAMP() do { if (STAMP && wid == 0 && nts < 64) { const unsigned long long _c = (unsigned long long)clock64(); \
        ts_lo = (lane == nts) ? (int)(unsigned)_c : ts_lo; ts_hi = (lane == nts) ? (int)(unsigned)(_c >> 32) : ts_hi; ++nts; } } while (0)
    PG8_STAMP();
    unsigned voffA[2], voffB[2];
#pragma unroll
    for (int i = 0; i < 2; ++i) { int R, C; stage_rc(tid * 16 + i * 8192, R, C); const int Rb = Epi::PERM ? ((R & ~31) + perm32(R & 31)) : R;
        voffA[i] = (unsigned)(R * K + C) * 2u; voffB[i] = (unsigned)(Rb * K + C) * 2u; }
    const size_t kstep = (size_t)(BK * 2);
    const size_t hstep = (size_t)HALF * K * 2;
    const size_t tstep = 2 * hstep;
    const unsigned ldsw = (unsigned)wid * 1024u;
    const int aoff = lds_byte(wr * 64 + fr, fq * 8), boff = lds_byte(wc * 32 + fr, fq * 8);
#define PG8_SA(b, h) (((b) * 2 + (h)) * HTB)
#define PG8_SB(b, h) ((4 + (b) * 2 + (h)) * HTB)
#define PG8_STAGE(bufoff, gbase, voff) do { _Pragma("unroll") for (int _i = 0; _i < 2; ++_i) \
        __builtin_amdgcn_global_load_lds((const unsigned*)((const char*)(gbase) + (voff)[_i]), (PG8_LAS unsigned*)(lds + (bufoff) + ldsw + _i * 8192), 16, 0, 0); } while (0)
#define PG8_LDA(dst, b, h) do { _Pragma("unroll") for (int m = 0; m < 4; ++m) _Pragma("unroll") for (int k = 0; k < 2; ++k) dst[m][k] = *(const PG8_LAS bf16x8*)(lds + PG8_SA(b, h) + aoff + m * 2048 + k * 1024); } while (0)
#define PG8_LDB(dst, b, h) do { _Pragma("unroll") for (int n = 0; n < 2; ++n) _Pragma("unroll") for (int k = 0; k < 2; ++k) dst[n][k] = *(const PG8_LAS bf16x8*)(lds + PG8_SB(b, h) + boff + n * 2048 + k * 1024); } while (0)
#define PG8_MMA(ai, bj, At, Bt) do { __builtin_amdgcn_s_setprio(1); _Pragma("unroll") for (int m = 0; m < 4; ++m) _Pragma("unroll") for (int n = 0; n < 2; ++n) _Pragma("unroll") for (int k = 0; k < 2; ++k) \
        acc[ai][bj][m][n] = __builtin_amdgcn_mfma_f32_16x16x32_bf16(Bt[n][k], At[m][k], acc[ai][bj][m][n], 0, 0, 0); __builtin_amdgcn_s_setprio(0); } while (0)
#define PG8_WAIT_V(n) asm volatile("s_waitcnt vmcnt(" #n ")" ::: "memory")
#define PG8_WAIT_L(n) asm volatile("s_waitcnt lgkmcnt(" #n ")" ::: "memory")
#define PG8_BAR __builtin_amdgcn_s_barrier()
#define PG8_SCHED __builtin_amdgcn_sched_barrier(0)
    Unit cur, nxt; int ui = 0;
    if (!S.next(0, cur)) return;
    f32x4 acc[2][2][4][2];
#pragma unroll
    for (int a = 0; a < 2; ++a)
#pragma unroll
        for (int b = 0; b < 2; ++b)
#pragma unroll
            for (int m = 0; m < 4; ++m)
#pragma unroll
                for (int n = 0; n < 2; ++n) acc[a][b][m][n] = (f32x4){0.f, 0.f, 0.f, 0.f};
    bf16x8 At[4][2], B0[2][2], B1[2][2];
    const char* cA = (const char*)g.A + (size_t)cur.pm * tstep; const char* cB = (const char*)g.Bt + (size_t)cur.pn * tstep;
    S.a_ready(cur);
    PG8_STAGE(PG8_SB(0, 0), cB, voffB); PG8_STAGE(PG8_SA(0, 0), cA, voffA); PG8_STAGE(PG8_SB(0, 1), cB + hstep, voffB); PG8_STAGE(PG8_SA(0, 1), cA + hstep, voffA);
    if (wr == 1) PG8_BAR;
    PG8_WAIT_V(4); PG8_BAR;
    PG8_STAGE(PG8_SB(1, 0), cB + kstep, voffB); PG8_STAGE(PG8_SA(1, 0), cA + kstep, voffA); PG8_STAGE(PG8_SB(1, 1), cB + hstep + kstep, voffB);
    PG8_WAIT_V(6); PG8_BAR;
    PG8_STAMP();
    for (;;) {
        const bool has_next = S.next(ui + 1, nxt);
        const char* nA = has_next ? (const char*)g.A + (size_t)nxt.pm * tstep : cA; const char* nB = has_next ? (const char*)g.Bt + (size_t)nxt.pn * tstep : cB;
        for (int t = 0; t < nt; t += 2) {
            const bool last = (t == nt - 2);
            const char* a1 = cA + (size_t)(t + 1) * kstep;
            const char* a2 = last ? nA : cA + (size_t)(t + 2) * kstep; const char* b2 = last ? nB : cB + (size_t)(t + 2) * kstep;
            const char* a3 = a2 + kstep; const char* b3 = b2 + kstep;
            if (last && has_next) S.a_ready(nxt);
            PG8_LDB(B0, 0, 0); PG8_SCHED; PG8_LDA(At, 0, 0); PG8_STAGE(PG8_SA(1, 1), a1 + hstep, voffA);
            PG8_WAIT_L(8); PG8_BAR; PG8_WAIT_L(0); PG8_MMA(0, 0, At, B0); PG8_BAR; PG8_SCHED;
            PG8_LDB(B1, 0, 1); PG8_STAGE(PG8_SB(0, 0), b2, voffB);
            PG8_BAR; PG8_WAIT_L(0); PG8_MMA(0, 1, At, B1); PG8_BAR;
            PG8_LDA(At, 0, 1); PG8_STAGE(PG8_SA(0, 0), a2, voffA);
            PG8_BAR; PG8_WAIT_L(0); PG8_MMA(1, 0, At, B0); PG8_BAR; PG8_SCHED;
            PG8_STAGE(PG8_SB(0, 1), b2 + hstep, voffB);
            PG8_WAIT_V(6); PG8_BAR; PG8_MMA(1, 1, At, B1); PG8_BAR;
            PG8_LDB(B0, 1, 0); PG8_SCHED; PG8_LDA(At, 1, 0); PG8_STAGE(PG8_SA(0, 1), a2 + hstep, voffA);
            PG8_WAIT_L(8); PG8_BAR; PG8_WAIT_L(0); PG8_MMA(0, 0, At, B0); PG8_BAR; PG8_SCHED;
            PG8_LDB(B1, 1, 1); PG8_STAGE(PG8_SB(1, 0), b3, voffB);
            PG8_BAR; PG8_WAIT_L(0); PG8_MMA(0, 1, At, B1); PG8_BAR;
            PG8_LDA(At, 1, 1); PG8_STAGE(PG8_SA(1, 0), a3, voffA);
            PG8_BAR; PG8_WAIT_L(0); PG8_MMA(1, 0, At, B0); PG8_BAR; PG8_SCHED;
            PG8_STAGE(PG8_SB(1, 1), b3 + hstep, voffB);
            PG8_WAIT_V(6); PG8_BAR; PG8_MMA(1, 1, At, B1); PG8_BAR;
        }
        PG8_STAMP();
        if constexpr (!Epi::AFTER_DRAIN) { E(acc, cur, wr, wc, fr, fq); S.done(cur); }
        PG8_STAMP();
        if (!has_next) break;
#pragma unroll
        for (int a = 0; a < 2; ++a)
#pragma unroll
            for (int b = 0; b < 2; ++b)
#pragma unroll
                for (int m = 0; m < 4; ++m)
#pragma unroll
                    for (int n = 0; n < 2; ++n) acc[a][b][m][n] = (f32x4){0.f, 0.f, 0.f, 0.f};
        cur = nxt; cA = nA; cB = nB; ++ui;
    }
    PG8_WAIT_V(0);
    if (wr == 0) PG8_BAR;
    PG8_BAR;
    if constexpr (Epi::AFTER_DRAIN) { E.fused(acc, cur, wr, wc, fr, fq, lds, wid, lane); S.done(cur); }
    PG8_STAMP();
    if (STAMP && wid == 0) { stamps[lane] = lane < nts ? (((unsigned long long)(unsigned)ts_hi << 32) | (unsigned)ts_lo) : 0ull;
        if (lane == 62) stamps[62] = rt_entry; if (lane == 63) stamps[63] = (unsigned long long)wall_clock64(); }
#undef PG8_STAMP
#undef PG8_SA
#undef PG8_SB
#undef PG8_STAGE
#undef PG8_LDA
#undef PG8_LDB
#undef PG8_MMA
#undef PG8_WAIT_V
#undef PG8_WAIT_L
#undef PG8_BAR
#undef PG8_SCHED
}
}


namespace {
using pg8::bf16_t; using pg8::f32x4;
constexpr int D = 1024, NB = 2, S = 8192, T = NB * S;
constexpr int EVEN_IN = 2304, ODD_IN = 2944, ODD_PAD = 3072, FD = 1920;
constexpr int MEM = 256, NE = 16, CAP = 1024, DE = 2816;
constexpr int NTH = 512;
constexpr size_t MiB = 1u << 20;
constexpr size_t WS_CTL = 0, CTL_BYTES = 1 * MiB;
constexpr size_t WS_ROPE = 1 * MiB;
constexpr size_t WS_AFF = 4 * MiB;
constexpr size_t WS_TOK = 5 * MiB;
constexpr size_t WS_GATE = 6 * MiB;
constexpr size_t WS_SLOT = 7 * MiB;
constexpr size_t WS_X = 8 * MiB;
constexpr size_t WS_H = 72 * MiB;
constexpr size_t WS_Y = 104 * MiB;
constexpr size_t WS_P = 136 * MiB;
constexpr size_t WS_Q = 320 * MiB;
constexpr size_t WS_KV = 384 * MiB;
constexpr size_t WS_MN = 388 * MiB;
constexpr size_t WS_DEC = 392 * MiB;
constexpr size_t WS_KD = 456 * MiB;
constexpr size_t WS_BB = 520 * MiB;
constexpr size_t WS_KK = 584 * MiB;
constexpr size_t WS_G = 616 * MiB;
constexpr size_t WS_YS = 648 * MiB;
constexpr size_t WS_RV = 712 * MiB;
constexpr size_t WS_VN = 776 * MiB;
constexpr size_t WS_QHA = 136 * MiB;
constexpr size_t WS_KHA = 152 * MiB;
constexpr size_t WS_QHB = 168 * MiB;
constexpr size_t WS_KHB = 184 * MiB;
constexpr size_t WS_PVB = 188 * MiB;
constexpr size_t WS_VTA = 208 * MiB;
constexpr size_t WS_VTB = 256 * MiB;
constexpr size_t WS_OA = 260 * MiB;
constexpr size_t WS_LSE = 308 * MiB;
constexpr size_t WS_QT = 136 * MiB;
constexpr size_t WS_YL = 200 * MiB;
constexpr size_t WS_PT = 264 * MiB;
constexpr size_t WS_RH = 296 * MiB;
constexpr size_t WS_S0 = 328 * MiB;
constexpr size_t WS_XE = 136 * MiB;
constexpr size_t WS_YE = 136 * MiB;
constexpr size_t WS_HID = 200 * MiB;
constexpr size_t WS_WEIN = 808 * MiB;
constexpr size_t WS_WEOUT = 813 * MiB;
constexpr size_t WS_WOIN = 815 * MiB;
constexpr size_t WS_WOOUT = 821 * MiB;
constexpr size_t WS_WQ = 823 * MiB;
constexpr size_t WS_WKV = 827 * MiB;
constexpr size_t WS_WO = 835 * MiB;
constexpr size_t WS_WGU = 840 * MiB;
constexpr size_t WS_WD = 1192 * MiB;
constexpr size_t WS_END = 1368 * MiB;
constexpr int CW_BAR = 4096;

constexpr int LDS_BYTES = 147456;
constexpr int LDS_BAR_OFF = LDS_BYTES - 64;

#define LAS __attribute__((address_space(3)))
#define XB_TMO      128
#define XB_XCNT(j)  (256  + 64 * (j))
#define XB_XSUB(j)  (1280 + 64 * (j))
#define XB_XGEN(j)  (2304 + 64 * (j))
#define XB_TOP      3328
#define XB_TOPGEN   3392
#define XCD_BAR_WORDS 3456
#define XB_SPIN_CAP (1u << 22)
__device__ __forceinline__ unsigned xb_ld(unsigned* p)              { return __hip_atomic_load(p, __ATOMIC_RELAXED, __HIP_MEMORY_SCOPE_AGENT); }
__device__ __forceinline__ unsigned xb_add(unsigned* p, unsigned v) { return __hip_atomic_fetch_add(p, v, __ATOMIC_RELAXED, __HIP_MEMORY_SCOPE_AGENT); }
__device__ __forceinline__ unsigned xb_xcc_id() { return (unsigned)__builtin_amdgcn_s_getreg((3 << 11) | 20) & 0xFu; }
#define XB_SPIN(cond, bar) do { unsigned _sp = 0; while (cond) { __builtin_amdgcn_s_sleep(1); \
    if ((++_sp & 255u) == 0u) { if (xb_ld(&(bar)[XB_TMO])) break; if (_sp > XB_SPIN_CAP) { atomicAdd(&(bar)[XB_TMO], 1u); break; } } } } while (0)
struct XcdBarrier { unsigned* bar; unsigned x; volatile LAS unsigned* st; };
__device__ __forceinline__ XcdBarrier xcd_barrier_post(unsigned* bar, volatile LAS unsigned* st) {
    XcdBarrier b; b.bar = bar; b.x = xb_xcc_id(); b.st = st;
    if (threadIdx.x == 0) (void)xb_add(&bar[XB_XCNT(b.x)], 1u);
    return b;
}
__device__ __forceinline__ void xcd_barrier_complete(unsigned* bar, unsigned x, unsigned& nloc, unsigned& nx) {
    const unsigned G = gridDim.x * gridDim.y * gridDim.z;
    unsigned sum, cnt, mine, sp = 0u;
    for (;;) {
        sum = 0u; cnt = 0u; mine = 0u;
#pragma unroll
        for (unsigned j = 0; j < 16; ++j) { const unsigned c = xb_ld(&bar[XB_XCNT(j)]); sum += c; cnt += (c > 0u) ? 1u : 0u; mine = (j == x) ? c : mine; }
        if (sum == G) break;
        __builtin_amdgcn_s_sleep(1);
        if ((++sp & 255u) == 0u) { if (xb_ld(&bar[XB_TMO])) break; if (sp > XB_SPIN_CAP) { atomicAdd(&bar[XB_TMO], 1u); break; } }
    }
    nloc = mine > 0u ? mine : 1u; nx = cnt > 0u ? cnt : 1u;
}
__device__ __forceinline__ void xcd_barrier(const XcdBarrier& b) {
    asm volatile("s_waitcnt vmcnt(0)" ::: "memory");
    __syncthreads();
    if (threadIdx.x == 0) {
        unsigned* bar = b.bar;
        __builtin_amdgcn_s_waitcnt(0);
        unsigned nloc = b.st[0], nx = b.st[1];
        if (nloc == 0u) { xcd_barrier_complete(bar, b.x, nloc, nx); b.st[0] = nloc; b.st[1] = nx; }
        const unsigned old = xb_add(&bar[XB_XSUB(b.x)], 1u);
        const unsigned gen = old / nloc;
        if (old + 1u == (gen + 1u) * nloc) {
            __builtin_amdgcn_fence(__ATOMIC_RELEASE, "agent");
            asm volatile("s_waitcnt vmcnt(0)" ::: "memory");
            const unsigned og = xb_add(&bar[XB_TOP], 1u);
            const unsigned tg = og / nx;
            if (og + 1u == (tg + 1u) * nx) xb_add(&bar[XB_TOPGEN], 1u);
            else XB_SPIN(xb_ld(&bar[XB_TOPGEN]) == tg, bar);
            __builtin_amdgcn_fence(__ATOMIC_ACQUIRE, "agent");
            xb_add(&bar[XB_XGEN(b.x)], 1u);
            asm volatile("s_waitcnt vmcnt(0)" ::: "memory");
        } else {
            XB_SPIN(xb_ld(&bar[XB_XGEN(b.x)]) == gen, bar);
            __builtin_amdgcn_fence(__ATOMIC_ACQUIRE, "agent");
            asm volatile("s_waitcnt vmcnt(0)" ::: "memory");
        }
    }
    __syncthreads();
}

__device__ __forceinline__ float wave_sum(float v) {
#pragma unroll
    for (int o = 32; o >= 1; o >>= 1) v += __shfl_xor(v, o);
    return v;
}
__device__ __forceinline__ float sigmoidf_(float x) { return 1.0f / (1.0f + expf(-x)); }
__device__ __forceinline__ float gelu_tanh(float x) { return 0.5f * x * (1.0f + tanhf(0.7978845608028654f * (x + 0.044715f * x * x * x))); }
__device__ __forceinline__ unsigned f2bf(float f) { unsigned u = __builtin_bit_cast(unsigned, f); return (u + 0x7fffu + ((u >> 16) & 1u)) >> 16; }
__device__ __forceinline__ unsigned pk2(float lo, float hi) { return pg8::cvt_pk_bf16(lo, hi); }
typedef unsigned v4u __attribute__((ext_vector_type(4)));
typedef unsigned v2u __attribute__((ext_vector_type(2)));

struct Args { const float* in[35]; float* out; unsigned char* ws; int lo, hi; };

struct EpiF32Store {
    static constexpr bool PERM = false, AFTER_DRAIN = false;
    float* C; int ldc; int nvalid;
    __device__ __forceinline__ void operator()(const f32x4 (&acc)[2][2][4][2], const pg8::Unit& u, int wr, int wc, int fr, int fq) const {
        const int row0 = u.pm * 256 + wr * 64 + fr, col0 = u.pn * 256 + wc * 32 + 4 * fq;
#pragma unroll
        for (int ai = 0; ai < 2; ++ai)
#pragma unroll
            for (int m = 0; m < 4; ++m) { float* rowp = C + (size_t)(row0 + ai * 128 + m * 16) * ldc + col0;
#pragma unroll
                for (int bj = 0; bj < 2; ++bj)
#pragma unroll
                    for (int n = 0; n < 2; ++n) if (col0 + bj * 128 + n * 16 < nvalid) *(f32x4*)(rowp + bj * 128 + n * 16) = acc[ai][bj][m][n]; }
    }
};
struct EpiResid {
    static constexpr bool PERM = false, AFTER_DRAIN = false;
    const float* base; float* out;
    __device__ __forceinline__ void operator()(const f32x4 (&acc)[2][2][4][2], const pg8::Unit& u, int wr, int wc, int fr, int fq) const {
        const int row0 = u.pm * 256 + wr * 64 + fr, col0 = u.pn * 256 + wc * 32 + 4 * fq;
#pragma unroll
        for (int ai = 0; ai < 2; ++ai)
#pragma unroll
            for (int m = 0; m < 4; ++m) { const size_t off = (size_t)(row0 + ai * 128 + m * 16) * D + col0;
#pragma unroll
                for (int bj = 0; bj < 2; ++bj)
#pragma unroll
                    for (int n = 0; n < 2; ++n) { const f32x4 b = *(const f32x4*)(base + off + bj * 128 + n * 16); *(f32x4*)(out + off + bj * 128 + n * 16) = b + acc[ai][bj][m][n]; } }
    }
};
struct EpiSiluMul {
    static constexpr bool PERM = false, AFTER_DRAIN = false;
    bf16_t* HIDp;
    __device__ __forceinline__ void operator()(const f32x4 (&acc)[2][2][4][2], const pg8::Unit& u, int wr, int wc, int fr, int fq) const {
        const int pnl = u.pn % 22;
        const int row0 = u.pm * 256 + wr * 64 + fr, col0 = pnl * 128 + wc * 32 + 4 * fq;
#pragma unroll
        for (int ai = 0; ai < 2; ++ai)
#pragma unroll
            for (int m = 0; m < 4; ++m) { bf16_t* rowp = HIDp + (size_t)(row0 + ai * 128 + m * 16) * DE + col0;
#pragma unroll
                for (int n = 0; n < 2; ++n) { const f32x4 g = acc[ai][0][m][n], up = acc[ai][1][m][n]; float h[4];
#pragma unroll
                    for (int j = 0; j < 4; ++j) h[j] = g[j] / (1.0f + __expf(-g[j])) * up[j];
                    v2u w; w.x = pk2(h[0], h[1]); w.y = pk2(h[2], h[3]); *(v2u*)(rowp + n * 16) = w; } }
    }
};
struct EpiYE {
    static constexpr bool PERM = true, AFTER_DRAIN = false;
    const float* GATE; bf16_t* YE;
    __device__ __forceinline__ void operator()(const f32x4 (&acc)[2][2][4][2], const pg8::Unit& u, int wr, int wc, int fr, int fq) const {
        const int pnl = u.pn & 3;
        const int row0 = u.pm * 256 + wr * 64 + fr, col0 = pnl * 256 + wc * 32 + 8 * fq;
#pragma unroll
        for (int ai = 0; ai < 2; ++ai)
#pragma unroll
            for (int m = 0; m < 4; ++m) { const int row = row0 + ai * 128 + m * 16; const float gt_ = GATE[row]; bf16_t* rowp = YE + (size_t)row * D + col0;
#pragma unroll
                for (int bj = 0; bj < 2; ++bj) { const f32x4 v0 = acc[ai][bj][m][0] * gt_, v1 = acc[ai][bj][m][1] * gt_;
                    v4u w; w.x = pg8::cvt_pk_bf16(v0[0], v0[1]); w.y = pg8::cvt_pk_bf16(v0[2], v0[3]); w.z = pg8::cvt_pk_bf16(v1[0], v1[1]); w.w = pg8::cvt_pk_bf16(v1[2], v1[3]);
                    *(v4u*)(rowp + bj * 128) = w; } }
    }
};
struct EpiBf16Store {
    static constexpr bool PERM = true, AFTER_DRAIN = false;
    bf16_t* O; int ldc; float scale;
    __device__ __forceinline__ void operator()(const f32x4 (&acc)[2][2][4][2], const pg8::Unit& u, int wr, int wc, int fr, int fq) const {
        const int row0 = u.pm * 256 + wr * 64 + fr, col0 = u.pn * 256 + wc * 32 + 8 * fq;
#pragma unroll
        for (int ai = 0; ai < 2; ++ai)
#pragma unroll
            for (int m = 0; m < 4; ++m) { bf16_t* rowp = O + (size_t)(row0 + ai * 128 + m * 16) * ldc + col0;
#pragma unroll
                for (int bj = 0; bj < 2; ++bj) { const f32x4 v0 = acc[ai][bj][m][0] * scale, v1 = acc[ai][bj][m][1] * scale;
                    v4u w; w.x = pg8::cvt_pk_bf16(v0[0], v0[1]); w.y = pg8::cvt_pk_bf16(v0[2], v0[3]); w.z = pg8::cvt_pk_bf16(v1[0], v1[1]); w.w = pg8::cvt_pk_bf16(v1[2], v1[3]);
                    *(v4u*)(rowp + bj * 128) = w; } }
    }
};
struct EpiKV {
    static constexpr bool PERM = false, AFTER_DRAIN = false;
    bf16_t* K; bf16_t* Vt;
    __device__ __forceinline__ void operator()(const f32x4 (&acc)[2][2][4][2], const pg8::Unit& u, int wr, int wc, int fr, int fq) const {
        const int row0 = u.pm * 256 + wr * 64 + fr, col0 = u.pn * 256 + wc * 32 + 4 * fq;
#pragma unroll
        for (int ai = 0; ai < 2; ++ai)
#pragma unroll
            for (int m = 0; m < 4; ++m) { const int row = row0 + ai * 128 + m * 16;
#pragma unroll
                for (int bj = 0; bj < 2; ++bj)
#pragma unroll
                    for (int n = 0; n < 2; ++n) { const int col = col0 + bj * 128 + n * 16; const f32x4 v = acc[ai][bj][m][n];
                        if (col < 1024) { v2u w; w.x = pk2(v[0], v[1]); w.y = pk2(v[2], v[3]); *(v2u*)(K + (size_t)row * 1024 + col) = w; }
                        else { const int b = row >> 8, mm = row & 255; bf16_t* vp = Vt + ((size_t)(b * 1024 + (col - 1024)) * 256 + mm);
#pragma unroll
                            for (int j = 0; j < 4; ++j) vp[(size_t)j * 256] = (bf16_t)f2bf(v[j]); } } }
    }
};

constexpr float QSCALE = 0.125f * 1.4426950408889634f;
struct EpiEven {
    static constexpr bool PERM = true, AFTER_DRAIN = false;
    const float* rc; const float* rs; bf16_t* QhA; bf16_t* KhA; bf16_t* QhB; bf16_t* KhB; bf16_t* PVb;
    __device__ __forceinline__ void operator()(const f32x4 (&acc)[2][2][4][2], const pg8::Unit& u, int wr, int wc, int fr, int fq) const {
        const int row0 = u.pm * 256 + wr * 64 + fr;
#pragma unroll
        for (int bj = 0; bj < 2; ++bj) {
            const int c0 = u.pn * 256 + bj * 128 + wc * 32 + 8 * fq;
            int kind; bf16_t* base; int stride; float sc = 1.0f;
            if (c0 < 512) { kind = 0; base = QhA + ((size_t)(c0 >> 6) * T) * 64 + (c0 & 63); stride = 64; sc = QSCALE; }
            else if (c0 < 1024) { kind = 0; base = KhA + ((size_t)((c0 - 512) >> 6) * T) * 64 + (c0 & 63); stride = 64; }
            else if (c0 < 1536) { kind = 1; base = PVb + (c0 - 1024); stride = 640; }
            else if (c0 < 2048) { kind = 0; base = QhB + ((size_t)((c0 - 1536) >> 6) * T) * 64 + (c0 & 63); stride = 64; sc = QSCALE; }
            else if (c0 < 2176) { kind = 0; base = KhB + ((size_t)((c0 - 2048) >> 6) * T) * 64 + (c0 & 63); stride = 64; }
            else { kind = 1; base = PVb + 512 + (c0 - 2176); stride = 640; }
            const int pi = (c0 & 63) >> 1;
#pragma unroll
            for (int ai = 0; ai < 2; ++ai)
#pragma unroll
                for (int m = 0; m < 4; ++m) {
                    const int tok = row0 + ai * 128 + m * 16;
                    const f32x4 v0 = acc[ai][bj][m][0], v1 = acc[ai][bj][m][1];
                    float y[8];
                    if (kind == 0) {
                        const int s = tok & (S - 1);
                        const f32x4 c4 = *(const f32x4*)(rc + s * 32 + pi), s4 = *(const f32x4*)(rs + s * 32 + pi);
                        y[0] = (v0[0] * c4[0] - v0[1] * s4[0]) * sc; y[1] = (v0[1] * c4[0] + v0[0] * s4[0]) * sc;
                        y[2] = (v0[2] * c4[1] - v0[3] * s4[1]) * sc; y[3] = (v0[3] * c4[1] + v0[2] * s4[1]) * sc;
                        y[4] = (v1[0] * c4[2] - v1[1] * s4[2]) * sc; y[5] = (v1[1] * c4[2] + v1[0] * s4[2]) * sc;
                        y[6] = (v1[2] * c4[3] - v1[3] * s4[3]) * sc; y[7] = (v1[3] * c4[3] + v1[2] * s4[3]) * sc;
                    } else { y[0] = v0[0]; y[1] = v0[1]; y[2] = v0[2]; y[3] = v0[3]; y[4] = v1[0]; y[5] = v1[1]; y[6] = v1[2]; y[7] = v1[3]; }
                    v4u w; w.x = pk2(y[0], y[1]); w.y = pk2(y[2], y[3]); w.z = pk2(y[4], y[5]); w.w = pk2(y[6], y[7]);
                    *(v4u*)(base + (size_t)tok * stride) = w;
                }
        }
    }
};
struct MoeOrder {
    int G, c, npairs;
    int per;
    __device__ __forceinline__ bool next(int i, pg8::Unit& u) const {
        const int x = c & 7, y = c >> 3, pml = y & 7, pnq = y >> 3;
        const int epn = i * 32 + x * 4 + pnq;
        if (epn >= npairs || c >= 256) return false;
        const int e = epn / per;
        u.pm = e * 8 + pml; u.pn = epn; return true;
    }
    __device__ __forceinline__ void a_ready(const pg8::Unit&) const {}
    __device__ __forceinline__ void done(const pg8::Unit&) const {}
};

template <class RowMap>
__device__ __forceinline__ void transpose_item(const float* W, int K, int N, bf16_t* WT, RowMap rm, LAS float* scr, int item, int lane) {
    const int nblk = N / 32, kb = item / nblk, nb_ = item % nblk, k0 = 64 * kb, n0 = 32 * nb_;
#pragma unroll 8
    for (int i = 0; i < 32; ++i) { const int kk = 2 * i + (lane >> 5); scr[kk * 33 + (lane & 31)] = W[(size_t)(k0 + kk) * N + n0 + (lane & 31)]; }
    asm volatile("s_waitcnt lgkmcnt(0)" ::: "memory");
    const int c = lane & 7;
#pragma unroll
    for (int j = 0; j < 4; ++j) { const int n = (lane >> 3) + 8 * j; const LAS float* s = scr + (8 * c) * 33 + n; const int rbase = rm(n0 + n) - n;
        v4u o; o.x = pk2(s[0 * 33], s[1 * 33]); o.y = pk2(s[2 * 33], s[3 * 33]); o.z = pk2(s[4 * 33], s[5 * 33]); o.w = pk2(s[6 * 33], s[7 * 33]);
        *(v4u*)(WT + (size_t)(rbase + n) * K + k0 + 8 * c) = o; }
    asm volatile("s_waitcnt lgkmcnt(0)" ::: "memory");
}

__device__ __forceinline__ void rmsnorm_rows_bf16(const float* x, const float* g, bf16_t* out, int M) {
    const int lane = threadIdx.x & 63, gw = blockIdx.x * 8 + (threadIdx.x >> 6), ngw = gridDim.x * 8;
    for (int m = gw; m < M; m += ngw) {
        const float4* xr = (const float4*)(x + (size_t)m * D);
        float4 v[4]; float s = 0.f;
#pragma unroll
        for (int j = 0; j < 4; ++j) { v[j] = xr[lane + 64 * j]; s += v[j].x * v[j].x + v[j].y * v[j].y + v[j].z * v[j].z + v[j].w * v[j].w; }
        const float r = rsqrtf(wave_sum(s) * (1.0f / D) + 1e-6f);
        v2u* o = (v2u*)(out + (size_t)m * D);
#pragma unroll
        for (int j = 0; j < 4; ++j) { const float4 gg = ((const float4*)g)[lane + 64 * j];
            v2u w; w.x = pk2(v[j].x * r * gg.x, v[j].y * r * gg.y); w.y = pk2(v[j].z * r * gg.z, v[j].w * r * gg.w); o[lane + 64 * j] = w; }
    }
}
__device__ __forceinline__ void rmsnorm_rows_f32(const float* x, const float* g, float* out, int M) {
    const int lane = threadIdx.x & 63, gw = blockIdx.x * 8 + (threadIdx.x >> 6), ngw = gridDim.x * 8;
    for (int m = gw; m < M; m += ngw) {
        const float4* xr = (const float4*)(x + (size_t)m * D);
        float4 v[4]; float s = 0.f;
#pragma unroll
        for (int j = 0; j < 4; ++j) { v[j] = xr[lane + 64 * j]; s += v[j].x * v[j].x + v[j].y * v[j].y + v[j].z * v[j].z + v[j].w * v[j].w; }
        const float r = rsqrtf(wave_sum(s) * (1.0f / D) + 1e-6f);
        float4* o = (float4*)(out + (size_t)m * D);
#pragma unroll
        for (int j = 0; j < 4; ++j) { const float4 gg = ((const float4*)g)[lane + 64 * j];
            o[lane + 64 * j] = make_float4(v[j].x * r * gg.x, v[j].y * r * gg.y, v[j].z * r * gg.z, v[j].w * r * gg.w); }
    }
}

__device__ __forceinline__ int block_exscan(int v, int* sh, int* tot) {
    const int tid = threadIdx.x, lane = tid & 63, w = tid >> 6;
    int inc = v;
#pragma unroll
    for (int o = 1; o < 64; o <<= 1) { const int t = __shfl_up(inc, o); if (lane >= o) inc += t; }
    __syncthreads();
    if (lane == 63) sh[w] = inc;
    __syncthreads();
    int base = 0, total = 0;
#pragma unroll
    for (int i = 0; i < 8; ++i) { const int x = sh[i]; if (i < w) base += x; total += x; }
    *tot = total;
    return base + inc - v;
}


typedef short bf16x8 __attribute__((ext_vector_type(8)));
typedef float f32x16 __attribute__((ext_vector_type(16)));
constexpr int MROW = 144;
constexpr int MBUF = 64 * MROW;
__device__ __forceinline__ bf16x8 frag_rm(const LAS unsigned char* M, int row0, int k0, int fr, int fq) {
    return *(const LAS bf16x8*)(M + (row0 + fr) * MROW + (k0 + 8 * fq) * 2);
}
__device__ __forceinline__ bf16x8 frag_cm(const LAS unsigned char* M, int k0, int col0, int fr, int fq) {
    const LAS unsigned short* p = (const LAS unsigned short*)(M + (k0 + 8 * fq) * MROW + (col0 + fr) * 2);
    bf16x8 v;
#pragma unroll
    for (int j = 0; j < 8; ++j) v[j] = (short)p[j * (MROW / 2)];
    return v;
}
__device__ __forceinline__ void tile_store_bf16(LAS unsigned char* M, int m0, int n0, int fr, int fq, const f32x4& c) {
    v2u w; w.x = pk2(c[0], c[1]); w.y = pk2(c[2], c[3]);
    *(LAS v2u*)(M + (m0 + fr) * MROW + (n0 + 4 * fq) * 2) = w;
}
#define MMA16(acc, lf, rf) acc = __builtin_amdgcn_mfma_f32_16x16x32_bf16(rf, lf, acc, 0, 0, 0)

__device__ __forceinline__ void scan_r1(const float* LWg, const float* RVg, const float* KDg, const float* KKg, const float* BBg,
                                        bf16_t* PT, float* QT, bf16_t* RH, float* YL, unsigned char* lds_raw) {
    LAS unsigned char* L = (LAS unsigned char*)lds_raw;
    LAS unsigned char* mAT = L + 0 * MBUF; LAS unsigned char* mRT = L + 1 * MBUF; LAS unsigned char* mBT = L + 2 * MBUF; LAS unsigned char* mKT = L + 3 * MBUF;
    LAS unsigned char* mV = L + 4 * MBUF; LAS unsigned char* mN0 = L + 5 * MBUF; LAS unsigned char* mN1 = L + 6 * MBUF; LAS unsigned char* mNAK = L + 7 * MBUF;
    LAS unsigned char* mNRB = L + 8 * MBUF; LAS unsigned char* mNRK = L + 9 * MBUF; LAS unsigned char* mT0 = L + 10 * MBUF; LAS unsigned char* mT1 = L + 11 * MBUF;
    LAS unsigned char* mW = L + 12 * MBUF;
    LAS float* LWs = (LAS float*)(L + 13 * MBUF);
    const int tid = threadIdx.x, lane = tid & 63, wave = tid >> 6, fr = lane & 15, fq = lane >> 4;
    const int tm = wave >> 1, tn0 = (wave & 1) * 2;
    const int m0 = tm * 16;
    for (int item = blockIdx.x; item < 4096; item += gridDim.x) {
        const int c = item & 127, h = (item >> 7) & 7, n = item >> 10, dir = n >> 1, b = n & 1;
        __syncthreads();
        const int t = tid >> 3, i0 = (tid & 7) * 8;
        const int pos = dir ? (S - 1 - (c * 64 + t)) : (c * 64 + t);
        const size_t tok = (size_t)b * S + pos;
        const size_t ch = (size_t)h * 64 + i0;
        float lw[8];
        { const float4 x0 = *(const float4*)(LWg + ((size_t)dir * T + tok) * 512 + ch), x1 = *(const float4*)(LWg + ((size_t)dir * T + tok) * 512 + ch + 4);
          lw[0] = x0.x; lw[1] = x0.y; lw[2] = x0.z; lw[3] = x0.w; lw[4] = x1.x; lw[5] = x1.y; lw[6] = x1.z; lw[7] = x1.w; }
#pragma unroll
        for (int j = 0; j < 8; ++j) LWs[t * 64 + i0 + j] = lw[j];
        __syncthreads();
        if (tid < 64) { float acc = 0.f; for (int tt = 0; tt < 64; ++tt) { acc += LWs[tt * 64 + tid]; LWs[tt * 64 + tid] = acc; } }
        __syncthreads();
        {
            float r[8], kd[8], kk[8], bb[8], vv[8];
            { const float4* p = (const float4*)(RVg + tok * D + ch); const float4 x0 = p[0], x1 = p[1]; r[0] = x0.x; r[1] = x0.y; r[2] = x0.z; r[3] = x0.w; r[4] = x1.x; r[5] = x1.y; r[6] = x1.z; r[7] = x1.w; }
            { const float4* p = (const float4*)(RVg + tok * D + 512 + ch); const float4 x0 = p[0], x1 = p[1]; vv[0] = x0.x; vv[1] = x0.y; vv[2] = x0.z; vv[3] = x0.w; vv[4] = x1.x; vv[5] = x1.y; vv[6] = x1.z; vv[7] = x1.w; }
            { const float4* p = (const float4*)(KDg + ((size_t)dir * T + tok) * 512 + ch); const float4 x0 = p[0], x1 = p[1]; kd[0] = x0.x; kd[1] = x0.y; kd[2] = x0.z; kd[3] = x0.w; kd[4] = x1.x; kd[5] = x1.y; kd[6] = x1.z; kd[7] = x1.w; }
            { const float4* p = (const float4*)(KKg + tok * 512 + ch); const float4 x0 = p[0], x1 = p[1]; kk[0] = x0.x; kk[1] = x0.y; kk[2] = x0.z; kk[3] = x0.w; kk[4] = x1.x; kk[5] = x1.y; kk[6] = x1.z; kk[7] = x1.w; }
            { const float4* p = (const float4*)(BBg + ((size_t)dir * T + tok) * 512 + ch); const float4 x0 = p[0], x1 = p[1]; bb[0] = x0.x; bb[1] = x0.y; bb[2] = x0.z; bb[3] = x0.w; bb[4] = x1.x; bb[5] = x1.y; bb[6] = x1.z; bb[7] = x1.w; }
            float at_[8], rt_[8], bt_[8], kt_[8];
#pragma unroll
            for (int j = 0; j < 8; ++j) {
                const float Lin = LWs[t * 64 + i0 + j], Lex = Lin - lw[j];
                const float ein = __expf(Lin), einv = __expf(-Lin);
                at_[j] = -kk[j] * __expf(Lex); rt_[j] = r[j] * ein; bt_[j] = bb[j] * einv; kt_[j] = kd[j] * einv;
            }
            v4u w;
            w.x = pk2(at_[0], at_[1]); w.y = pk2(at_[2], at_[3]); w.z = pk2(at_[4], at_[5]); w.w = pk2(at_[6], at_[7]); *(LAS v4u*)(mAT + t * MROW + i0 * 2) = w;
            w.x = pk2(rt_[0], rt_[1]); w.y = pk2(rt_[2], rt_[3]); w.z = pk2(rt_[4], rt_[5]); w.w = pk2(rt_[6], rt_[7]); *(LAS v4u*)(mRT + t * MROW + i0 * 2) = w;
            w.x = pk2(bt_[0], bt_[1]); w.y = pk2(bt_[2], bt_[3]); w.z = pk2(bt_[4], bt_[5]); w.w = pk2(bt_[6], bt_[7]); *(LAS v4u*)(mBT + t * MROW + i0 * 2) = w;
            w.x = pk2(kt_[0], kt_[1]); w.y = pk2(kt_[2], kt_[3]); w.z = pk2(kt_[4], kt_[5]); w.w = pk2(kt_[6], kt_[7]); *(LAS v4u*)(mKT + t * MROW + i0 * 2) = w;
            w.x = pk2(vv[0], vv[1]); w.y = pk2(vv[2], vv[3]); w.z = pk2(vv[4], vv[5]); w.w = pk2(vv[6], vv[7]); *(LAS v4u*)(mV + t * MROW + i0 * 2) = w;
        }
        __syncthreads();
        f32x4 Tacc[2];
        {
            bf16x8 la[2], lr[2];
#pragma unroll
            for (int ks = 0; ks < 2; ++ks) { la[ks] = frag_rm(mAT, m0, 32 * ks, fr, fq); lr[ks] = frag_rm(mRT, m0, 32 * ks, fr, fq); }
#pragma unroll
            for (int q = 0; q < 2; ++q) {
                const int n0 = (tn0 + q) * 16;
                f32x4 cab = {0.f, 0.f, 0.f, 0.f}, cak = cab, crb = cab, crk = cab;
#pragma unroll
                for (int ks = 0; ks < 2; ++ks) {
                    const bf16x8 rb_ = frag_rm(mBT, n0, 32 * ks, fr, fq), rk_ = frag_rm(mKT, n0, 32 * ks, fr, fq);
                    MMA16(cab, la[ks], rb_); MMA16(cak, la[ks], rk_); MMA16(crb, lr[ks], rb_); MMA16(crk, lr[ks], rk_);
                }
                const int tt = m0 + fr;
#pragma unroll
                for (int j = 0; j < 4; ++j) { const int ss = n0 + 4 * fq + j;
                    if (!(ss < tt)) { cab[j] = 0.f; cak[j] = 0.f; }
                    if (!(ss <= tt)) { crb[j] = 0.f; crk[j] = 0.f; } }
                tile_store_bf16(mN0, m0, n0, fr, fq, cab); tile_store_bf16(mNAK, m0, n0, fr, fq, cak);
                tile_store_bf16(mNRB, m0, n0, fr, fq, crb); tile_store_bf16(mNRK, m0, n0, fr, fq, crk);
#pragma unroll
                for (int j = 0; j < 4; ++j) cab[j] += ((n0 + 4 * fq + j) == tt) ? 1.f : 0.f;
                Tacc[q] = cab;
                tile_store_bf16(mT0, m0, n0, fr, fq, cab);
            }
        }
        __syncthreads();
        {
            bf16x8 lk[2], ln_[2];
#pragma unroll
            for (int ks = 0; ks < 2; ++ks) { lk[ks] = frag_rm(mNAK, m0, 32 * ks, fr, fq); ln_[ks] = frag_rm(mN0, m0, 32 * ks, fr, fq); }
#pragma unroll
            for (int q = 0; q < 2; ++q) {
                const int n0 = (tn0 + q) * 16;
                f32x4 cw = {0.f, 0.f, 0.f, 0.f}, cn = cw;
#pragma unroll
                for (int ks = 0; ks < 2; ++ks) { MMA16(cw, lk[ks], frag_cm(mV, 32 * ks, n0, fr, fq)); MMA16(cn, ln_[ks], frag_cm(mN0, 32 * ks, n0, fr, fq)); }
                tile_store_bf16(mW, m0, n0, fr, fq, cw); tile_store_bf16(mN1, m0, n0, fr, fq, cn);
            }
        }
        __syncthreads();
#pragma unroll
        for (int k = 1; k <= 5; ++k) {
            LAS unsigned char* Nk = (k & 1) ? mN1 : mN0; LAS unsigned char* Nn = (k & 1) ? mN0 : mN1;
            LAS unsigned char* Tk = ((k - 1) & 1) ? mT1 : mT0; LAS unsigned char* Tn = ((k - 1) & 1) ? mT0 : mT1;
            bf16x8 lt[2], ln_[2];
#pragma unroll
            for (int ks = 0; ks < 2; ++ks) { lt[ks] = frag_rm(Tk, m0, 32 * ks, fr, fq); ln_[ks] = frag_rm(Nk, m0, 32 * ks, fr, fq); }
#pragma unroll
            for (int q = 0; q < 2; ++q) {
                const int n0 = (tn0 + q) * 16;
                f32x4 cn = {0.f, 0.f, 0.f, 0.f};
#pragma unroll
                for (int ks = 0; ks < 2; ++ks) { const bf16x8 rn = frag_cm(Nk, 32 * ks, n0, fr, fq); MMA16(Tacc[q], lt[ks], rn); if (k < 5) MMA16(cn, ln_[ks], rn); }
                tile_store_bf16(Tn, m0, n0, fr, fq, Tacc[q]);
                if (k < 5) tile_store_bf16(Nn, m0, n0, fr, fq, cn);
            }
            __syncthreads();
        }
        {
            bf16x8 lt[2];
#pragma unroll
            for (int ks = 0; ks < 2; ++ks) lt[ks] = frag_rm(mT1, m0, 32 * ks, fr, fq);
#pragma unroll
            for (int q = 0; q < 2; ++q) {
                const int n0 = (tn0 + q) * 16;
                f32x4 ca = {0.f, 0.f, 0.f, 0.f}, cu = ca;
#pragma unroll
                for (int ks = 0; ks < 2; ++ks) { MMA16(ca, lt[ks], frag_cm(mAT, 32 * ks, n0, fr, fq)); MMA16(cu, lt[ks], frag_cm(mW, 32 * ks, n0, fr, fq)); }
                tile_store_bf16(mN0, m0, n0, fr, fq, ca); tile_store_bf16(mT0, m0, n0, fr, fq, cu);
            }
        }
        __syncthreads();
        LAS unsigned char* mAH = mN0; LAS unsigned char* mUL = mT0;
        {
            bf16x8 lrb[2], lrk[2], lb[2], lkt[2];
#pragma unroll
            for (int ks = 0; ks < 2; ++ks) { lrb[ks] = frag_rm(mNRB, m0, 32 * ks, fr, fq); lrk[ks] = frag_rm(mNRK, m0, 32 * ks, fr, fq);
                lb[ks] = frag_cm(mBT, 32 * ks, m0, fr, fq); lkt[ks] = frag_cm(mKT, 32 * ks, m0, fr, fq); }
            const float wc = __expf(LWs[63 * 64 + m0 + fr]);
#pragma unroll
            for (int q = 0; q < 2; ++q) {
                const int n0 = (tn0 + q) * 16;
                f32x4 crh = {0.f, 0.f, 0.f, 0.f}, cyl = crh, cp = crh, cq = crh;
#pragma unroll
                for (int ks = 0; ks < 2; ++ks) {
                    const bf16x8 ra = frag_cm(mAH, 32 * ks, n0, fr, fq), ru = frag_cm(mUL, 32 * ks, n0, fr, fq), rv = frag_cm(mV, 32 * ks, n0, fr, fq);
                    MMA16(crh, lrb[ks], ra); MMA16(cyl, lrb[ks], ru); MMA16(cyl, lrk[ks], rv);
                    MMA16(cp, lb[ks], ra); MMA16(cq, lb[ks], ru); MMA16(cq, lkt[ks], rv);
                }
                const size_t o = (size_t)item * 4096 + (size_t)(m0 + fr) * 64 + n0 + 4 * fq;
                { const LAS unsigned short* rp = (const LAS unsigned short*)(mRT + (m0 + fr) * MROW + (n0 + 4 * fq) * 2);
#pragma unroll
                  for (int j = 0; j < 4; ++j) crh[j] += __uint_as_float(((unsigned)rp[j]) << 16); }
                { v2u w; w.x = pk2(crh[0], crh[1]); w.y = pk2(crh[2], crh[3]); *(v2u*)(RH + o) = w; }
                *(f32x4*)(YL + o) = cyl;
#pragma unroll
                for (int j = 0; j < 4; ++j) { cp[j] = wc * (cp[j] + (((n0 + 4 * fq + j) == (m0 + fr)) ? 1.f : 0.f)); cq[j] *= wc; }
                { v2u w; w.x = pk2(cp[0], cp[1]); w.y = pk2(cp[2], cp[3]); *(v2u*)(PT + o) = w; }
                *(f32x4*)(QT + o) = cq;
            }
        }
    }
}

__device__ __forceinline__ bf16x8 pack_acc8(const f32x16& x, int s) {
    v4u p; p.x = pk2(x[8 * s], x[8 * s + 1]); p.y = pk2(x[8 * s + 2], x[8 * s + 3]); p.z = pk2(x[8 * s + 4], x[8 * s + 5]); p.w = pk2(x[8 * s + 6], x[8 * s + 7]);
    return __builtin_bit_cast(bf16x8, p);
}
__device__ __forceinline__ void scan_r2(const bf16_t* PT, const float* QT, bf16_t* S0) {
    const int tid = threadIdx.x, lane = tid & 63, wave = tid >> 6;
    if (blockIdx.x >= 32 || wave >= 2) return;
    const int r = lane & 31, h2 = lane >> 5, jb = wave;
    f32x16 st[2];
#pragma unroll
    for (int ib = 0; ib < 2; ++ib)
#pragma unroll
        for (int g = 0; g < 16; ++g) st[ib][g] = 0.f;
    for (int c = 0; c < 128; ++c) {
        const size_t item = (size_t)blockIdx.x * 128 + c;
        bf16_t* sp = S0 + item * 4096 + (size_t)(32 * jb + r) * 64;
#pragma unroll
        for (int ib = 0; ib < 2; ++ib)
#pragma unroll
            for (int g = 0; g < 4; ++g) { v2u w; w.x = pk2(st[ib][4 * g], st[ib][4 * g + 1]); w.y = pk2(st[ib][4 * g + 2], st[ib][4 * g + 3]); *(v2u*)(sp + 32 * ib + 8 * g + 4 * h2) = w; }
        f32x16 nw[2];
        const float* qp = QT + item * 4096 + 32 * jb + r;
#pragma unroll
        for (int ib = 0; ib < 2; ++ib)
#pragma unroll
            for (int g = 0; g < 16; ++g) nw[ib][g] = qp[(size_t)(32 * ib + (g & 3) + 8 * (g >> 2) + 4 * h2) * 64];
        const bf16_t* pp = PT + item * 4096;
#pragma unroll
        for (int kb = 0; kb < 2; ++kb)
#pragma unroll
            for (int s2 = 0; s2 < 2; ++s2) {
                const bf16x8 bfr = pack_acc8(st[kb], s2);
#pragma unroll
                for (int ib = 0; ib < 2; ++ib) {
                    const bf16_t* ap = pp + (size_t)(32 * ib + r) * 64 + 32 * kb + 16 * s2 + 4 * h2;
                    const v2u lo = *(const v2u*)ap, hi = *(const v2u*)(ap + 8);
                    v4u av; av.x = lo.x; av.y = lo.y; av.z = hi.x; av.w = hi.y;
                    nw[ib] = __builtin_amdgcn_mfma_f32_32x32x16_bf16(__builtin_bit_cast(bf16x8, av), bfr, nw[ib], 0, 0, 0);
                }
            }
        st[0] = nw[0]; st[1] = nw[1];
    }
}
__device__ __forceinline__ void scan_r3(const bf16_t* RH, const float* YL, const bf16_t* S0, const float* RVg, const float* KDg, const float* Gg,
                                        const float* r_k, const float* lng, const float* lnb, bf16_t* Y) {
    const int tid = threadIdx.x, lane = tid & 63, wave = tid >> 6, fr = lane & 15, fq = lane >> 4;
    const int tmw = wave & 3;
    for (int it2 = blockIdx.x * 2 + (wave >> 2); it2 < 2048; it2 += gridDim.x * 2) {
        const int b = it2 >> 10, h = (it2 >> 7) & 7, pc = it2 & 127;
        f32x4 acc[4];
#pragma unroll
        for (int q = 0; q < 4; ++q) acc[q] = (f32x4){0.f, 0.f, 0.f, 0.f};
#pragma unroll 1
        for (int dirn = 0; dirn < 2; ++dirn) {
            const size_t item = (size_t)((dirn * 2 + b) * 8 + h) * 128 + (dirn ? 127 - pc : pc);
            const int row = dirn ? 63 - (16 * tmw + fr) : 16 * tmw + fr;
            const bf16_t* rp = RH + item * 4096 + (size_t)row * 64;
            bf16x8 lf[2];
#pragma unroll
            for (int ks = 0; ks < 2; ++ks) lf[ks] = *(const bf16x8*)(rp + 32 * ks + 8 * fq);
#pragma unroll
            for (int q = 0; q < 4; ++q) {
                const bf16_t* sp = S0 + item * 4096 + (size_t)(16 * q + fr) * 64;
#pragma unroll
                for (int ks = 0; ks < 2; ++ks) { const bf16x8 rf = *(const bf16x8*)(sp + 32 * ks + 8 * fq); MMA16(acc[q], lf[ks], rf); }
                acc[q] += *(const f32x4*)(YL + item * 4096 + (size_t)row * 64 + 16 * q + 4 * fq);
            }
        }
        float sm = 0.f;
#pragma unroll
        for (int q = 0; q < 4; ++q) sm += (acc[q][0] + acc[q][1]) + (acc[q][2] + acc[q][3]);
        sm += __shfl_xor(sm, 16); sm += __shfl_xor(sm, 32);
        const float mean = sm * (1.0f / 64.f);
        float sq = 0.f;
#pragma unroll
        for (int q = 0; q < 4; ++q)
#pragma unroll
            for (int j = 0; j < 4; ++j) { const float d = acc[q][j] - mean; sq += d * d; }
        sq += __shfl_xor(sq, 16); sq += __shfl_xor(sq, 32);
        const float rstd = rsqrtf(sq * (1.0f / 64.f) + 64e-5f);
        const size_t tok = (size_t)b * S + pc * 64 + 16 * tmw + fr;
        float bon = 0.f; f32x4 vv[4];
#pragma unroll
        for (int q = 0; q < 4; ++q) {
            const int c = h * 64 + 16 * q + 4 * fq;
            const f32x4 r4 = *(const f32x4*)(RVg + tok * D + c), k0 = *(const f32x4*)(KDg + tok * 512 + c), k1 = *(const f32x4*)(KDg + ((size_t)T + tok) * 512 + c), rk4 = *(const f32x4*)(r_k + c);
            vv[q] = *(const f32x4*)(RVg + tok * D + 512 + c);
#pragma unroll
            for (int j = 0; j < 4; ++j) bon += r4[j] * (k0[j] + k1[j]) * rk4[j];
        }
        bon += __shfl_xor(bon, 16); bon += __shfl_xor(bon, 32);
#pragma unroll
        for (int q = 0; q < 4; ++q) {
            const int c = h * 64 + 16 * q + 4 * fq;
            const f32x4 g4 = *(const f32x4*)(Gg + tok * 512 + c), lg = *(const f32x4*)(lng + c), lb = *(const f32x4*)(lnb + c);
            float o[4];
#pragma unroll
            for (int j = 0; j < 4; ++j) o[j] = ((acc[q][j] - mean) * rstd * lg[j] + lb[j] + bon * vv[q][j]) * g4[j];
            v2u w; w.x = pk2(o[0], o[1]); w.y = pk2(o[2], o[3]);
            *(v2u*)(Y + tok * D + 512 + c) = w;
        }
    }
}


__device__ __forceinline__ bf16x8 pack8(float a0, float a1, float a2, float a3, float a4, float a5, float a6, float a7) {
    v4u p; p.x = pk2(a0, a1); p.y = pk2(a2, a3); p.z = pk2(a4, a5); p.w = pk2(a6, a7);
    return __builtin_bit_cast(bf16x8, p);
}
#define MMA32(acc, af, bf_) acc = __builtin_amdgcn_mfma_f32_32x32x16_bf16(af, bf_, acc, 0, 0, 0)
__device__ __forceinline__ void xattn_mfma(const bf16_t* Qb, const bf16_t* Kb, const bf16_t* Vt, bf16_t* Y) {
    const int lane = threadIdx.x & 63, r = lane & 31, h2 = lane >> 5;
    const int gw = blockIdx.x * 8 + (threadIdx.x >> 6), ngw = gridDim.x * 8;
    for (int it = gw; it < 2048; it += ngw) {
        const int tile = it & 255, h = (it >> 8) & 3, b = it >> 10;
        const size_t tok = (size_t)b * S + tile * 32 + r;
        bf16x8 qf[16];
#pragma unroll
        for (int ks = 0; ks < 16; ++ks) qf[ks] = *(const bf16x8*)(Qb + tok * D + h * 256 + 16 * ks + 8 * h2);
        f32x16 st[8];
#pragma unroll
        for (int kb = 0; kb < 8; ++kb) {
#pragma unroll
            for (int g = 0; g < 16; ++g) st[kb][g] = 0.f;
            const bf16_t* kp = Kb + (size_t)(b * MEM + 32 * kb + r) * 1024 + h * 256 + 8 * h2;
#pragma unroll
            for (int ks = 0; ks < 16; ++ks) { const bf16x8 kf = *(const bf16x8*)(kp + 16 * ks); MMA32(st[kb], kf, qf[ks]); }
        }
        float mx = -3.0e38f;
#pragma unroll
        for (int kb = 0; kb < 8; ++kb)
#pragma unroll
            for (int g = 0; g < 16; ++g) mx = fmaxf(mx, st[kb][g]);
        mx = fmaxf(mx, __shfl_xor(mx, 32));
        const float cs = 0.0625f * 1.4426950408889634f;
        float l = 0.f;
#pragma unroll
        for (int kb = 0; kb < 8; ++kb)
#pragma unroll
            for (int g = 0; g < 16; ++g) { const float p = __builtin_amdgcn_exp2f((st[kb][g] - mx) * cs); st[kb][g] = p; l += p; }
        l += __shfl_xor(l, 32);
        const float inv = 1.0f / l;
        bf16x8 pf[8][2];
#pragma unroll
        for (int kb = 0; kb < 8; ++kb)
#pragma unroll
            for (int s2 = 0; s2 < 2; ++s2)
                pf[kb][s2] = pack8(st[kb][8 * s2] * inv, st[kb][8 * s2 + 1] * inv, st[kb][8 * s2 + 2] * inv, st[kb][8 * s2 + 3] * inv,
                                   st[kb][8 * s2 + 4] * inv, st[kb][8 * s2 + 5] * inv, st[kb][8 * s2 + 6] * inv, st[kb][8 * s2 + 7] * inv);
#pragma unroll 1
        for (int db = 0; db < 8; ++db) {
            f32x16 acc;
#pragma unroll
            for (int g = 0; g < 16; ++g) acc[g] = 0.f;
            const bf16_t* vp = Vt + ((size_t)(b * 1024 + h * 256 + 32 * db + r)) * 256 + 4 * h2;
#pragma unroll
            for (int kb = 0; kb < 8; ++kb)
#pragma unroll
                for (int s2 = 0; s2 < 2; ++s2) {
                    const v2u lo = *(const v2u*)(vp + 32 * kb + 16 * s2), hi = *(const v2u*)(vp + 32 * kb + 16 * s2 + 8);
                    v4u av; av.x = lo.x; av.y = lo.y; av.z = hi.x; av.w = hi.y;
                    MMA32(acc, __builtin_bit_cast(bf16x8, av), pf[kb][s2]);
                }
            bf16_t* yp = Y + tok * D + h * 256 + 32 * db + 4 * h2;
#pragma unroll
            for (int g = 0; g < 4; ++g) { v2u w; w.x = pg8::cvt_pk_bf16(acc[4 * g], acc[4 * g + 1]); w.y = pg8::cvt_pk_bf16(acc[4 * g + 2], acc[4 * g + 3]); *(v2u*)(yp + 8 * g) = w; }
        }
    }
}


template <bool F32OUT>
__device__ __forceinline__ void combine_norm(float* X, const bf16_t* YE, const int* SLOT, const float* g, bf16_t* Hout, float* Fout) {
    const int lane = threadIdx.x & 63, gw = blockIdx.x * 8 + (threadIdx.x >> 6), ngw = gridDim.x * 8;
    for (int m = gw; m < T; m += ngw) {
        float4* xr = (float4*)(X + (size_t)m * D);
        float4 v[4];
#pragma unroll
        for (int j = 0; j < 4; ++j) v[j] = xr[lane + 64 * j];
        const int myslot = SLOT[(size_t)m * NE + (lane & 15)];
#pragma unroll
        for (int e = 0; e < 16; ++e) {
            const int row = __builtin_amdgcn_readlane(myslot, e);
            if (row >= 0) {
                const v2u* yp = (const v2u*)(YE + (size_t)row * D);
#pragma unroll
                for (int j = 0; j < 4; ++j) { const v2u w = yp[lane + 64 * j];
                    v[j].x += __uint_as_float(w.x << 16); v[j].y += __uint_as_float(w.x & 0xffff0000u); v[j].z += __uint_as_float(w.y << 16); v[j].w += __uint_as_float(w.y & 0xffff0000u); }
            }
        }
        float s = 0.f;
#pragma unroll
        for (int j = 0; j < 4; ++j) { if (!F32OUT) xr[lane + 64 * j] = v[j]; s += v[j].x * v[j].x + v[j].y * v[j].y + v[j].z * v[j].z + v[j].w * v[j].w; }
        const float r = rsqrtf(wave_sum(s) * (1.0f / D) + 1e-6f);
#pragma unroll
        for (int j = 0; j < 4; ++j) { const float4 gg = ((const float4*)g)[lane + 64 * j];
            if (F32OUT) ((float4*)(Fout + (size_t)m * D))[lane + 64 * j] = make_float4(v[j].x * r * gg.x, v[j].y * r * gg.y, v[j].z * r * gg.z, v[j].w * r * gg.w);
            else { v2u w; w.x = pk2(v[j].x * r * gg.x, v[j].y * r * gg.y); w.y = pk2(v[j].z * r * gg.z, v[j].w * r * gg.w); ((v2u*)(Hout + (size_t)m * D))[lane + 64 * j] = w; } }
    }
}


__device__ __forceinline__ void vtrans_pass(const bf16_t* PVb, bf16_t* VtA, bf16_t* VtB, unsigned char* lds_raw) {
    LAS unsigned char* L = (LAS unsigned char*)lds_raw;
    const int tid = threadIdx.x, lane = tid & 63, wave = tid >> 6;
    constexpr int RS = 136;
    for (int it = blockIdx.x; it < 640; it += gridDim.x) {
        const int vh = it % 10, tl = (it / 10) & 31, b = it / 320, s0 = tl * 256;
        __syncthreads();
        { const int tk = tid >> 1, half = tid & 1;
          const v4u* gp = (const v4u*)(PVb + (size_t)(b * S + s0 + tk) * 640 + vh * 64 + half * 32);
#pragma unroll
          for (int q = 0; q < 4; ++q) { const v4u x = gp[q]; LAS v2u* lp = (LAS v2u*)(L + tk * RS + half * 64 + q * 16); v2u a_; a_.x = x.x; a_.y = x.y; lp[0] = a_; a_.x = x.z; a_.y = x.w; lp[1] = a_; } }
        __syncthreads();
        const int npat = vh < 8 ? 3 : 1;
        for (int pat = 0; pat < npat; ++pat) {
            const int dd = pat == 0 ? 1 : (pat == 1 ? 4 : 16), seg = 256 / dd;
            const int o = 4 * lane, rho = o / seg, qq0 = o % seg;
            const size_t gpos = (size_t)b * S + (size_t)rho * (S / dd) + s0 / dd + qq0;
#pragma unroll
            for (int i = 0; i < 8; ++i) {
                const int d = wave * 8 + i;
                unsigned short x[4];
#pragma unroll
                for (int jj = 0; jj < 4; ++jj) x[jj] = *(const LAS unsigned short*)(L + ((qq0 + jj) * dd + rho) * RS + d * 2);
                v2u w; w.x = (unsigned)x[0] | ((unsigned)x[1] << 16); w.y = (unsigned)x[2] | ((unsigned)x[3] << 16);
                bf16_t* dst = vh < 8 ? (VtA + ((size_t)pat * 512 + vh * 64 + d) * T + gpos) : (VtB + ((size_t)(vh - 8) * 64 + d) * T + gpos);
                *(v2u*)dst = w;
            }
        }
    }
}

template <int NK, bool SINK>
__device__ __forceinline__ void attn_tile(const bf16_t* Qh, const bf16_t* Kh, const bf16_t* Vt, int dd, int Lr, int b, int rho, int q0, float sink2,
                                          bf16_t* Odst, int ostride, float* lsedst, int lane) {
    const int r = lane & 31, h2 = lane >> 5;
    const size_t qtok = (size_t)b * S + (size_t)(q0 + r) * dd + rho;
    bf16x8 qf[4];
#pragma unroll
    for (int ks = 0; ks < 4; ++ks) qf[ks] = *(const bf16x8*)(Qh + qtok * 64 + 16 * ks + 8 * h2);
    f32x16 o[2];
#pragma unroll
    for (int db = 0; db < 2; ++db)
#pragma unroll
        for (int g = 0; g < 16; ++g) o[db][g] = 0.f;
    float m = SINK ? sink2 : -1.0e30f, l = SINK ? 1.f : 0.f;
#pragma unroll 1
    for (int kb = -NK; kb <= NK; ++kb) {
        const int kq0 = q0 + 32 * kb;
        if (kq0 < 0 || kq0 >= Lr) continue;
        const size_t ktok = (size_t)b * S + (size_t)(kq0 + r) * dd + rho;
        f32x16 st;
#pragma unroll
        for (int g = 0; g < 16; ++g) st[g] = 0.f;
        const bf16_t* kp = Kh + ktok * 64 + 8 * h2;
#pragma unroll
        for (int ks = 0; ks < 4; ++ks) { const bf16x8 kf = *(const bf16x8*)(kp + 16 * ks); MMA32(st, kf, qf[ks]); }
        if (kb == -NK || kb == NK) {
#pragma unroll
            for (int g = 0; g < 16; ++g) { const int cr = (g & 3) + 8 * (g >> 2) + 4 * h2; const bool ok = (kb < 0) ? (cr >= r) : (cr <= r); st[g] = ok ? st[g] : -1.0e30f; }
        }
        float bm = st[0];
#pragma unroll
        for (int g = 1; g < 16; ++g) bm = fmaxf(bm, st[g]);
        bm = fmaxf(bm, __shfl_xor(bm, 32));
        const float mn = fmaxf(m, bm), al = __builtin_amdgcn_exp2f(m - mn);
        float ls = 0.f;
#pragma unroll
        for (int g = 0; g < 16; ++g) { st[g] = __builtin_amdgcn_exp2f(st[g] - mn); ls += st[g]; }
        ls += __shfl_xor(ls, 32);
        l = l * al + ls; m = mn;
#pragma unroll
        for (int db = 0; db < 2; ++db)
#pragma unroll
            for (int g = 0; g < 16; ++g) o[db][g] *= al;
        bf16x8 pf[2];
#pragma unroll
        for (int s2 = 0; s2 < 2; ++s2) pf[s2] = pack8(st[8 * s2], st[8 * s2 + 1], st[8 * s2 + 2], st[8 * s2 + 3], st[8 * s2 + 4], st[8 * s2 + 5], st[8 * s2 + 6], st[8 * s2 + 7]);
        const size_t kpos = (size_t)b * S + (size_t)rho * Lr + kq0;
#pragma unroll
        for (int db = 0; db < 2; ++db) {
            const bf16_t* vp = Vt + (size_t)(32 * db + r) * T + kpos + 4 * h2;
#pragma unroll
            for (int s2 = 0; s2 < 2; ++s2) {
                const v2u lo = *(const v2u*)(vp + 16 * s2), hi = *(const v2u*)(vp + 16 * s2 + 8);
                v4u av; av.x = lo.x; av.y = lo.y; av.z = hi.x; av.w = hi.y;
                MMA32(o[db], __builtin_bit_cast(bf16x8, av), pf[s2]);
            }
        }
    }
    const float inv = 1.0f / l;
#pragma unroll
    for (int db = 0; db < 2; ++db) {
        bf16_t* op = Odst + qtok * ostride + 32 * db + 4 * h2;
#pragma unroll
        for (int g = 0; g < 4; ++g) { v2u w; w.x = pk2(o[db][4 * g] * inv, o[db][4 * g + 1] * inv); w.y = pk2(o[db][4 * g + 2] * inv, o[db][4 * g + 3] * inv); *(v2u*)(op + 8 * g) = w; }
    }
    if (lsedst != nullptr && h2 == 0) lsedst[qtok * 8] = (m + __builtin_amdgcn_logf(l)) * 0.6931471805599453f;
}

__device__ __forceinline__ void attn_phase_even(const bf16_t* QhA, const bf16_t* KhA, const bf16_t* VtA, const bf16_t* QhB, const bf16_t* KhB, const bf16_t* VtB,
                                                const float* sink, bf16_t* OA, float* LSE, bf16_t* Y) {
    const int lane = threadIdx.x & 63, gw = blockIdx.x * 8 + (threadIdx.x >> 6), ngw = gridDim.x * 8;
    for (int it = gw; it < 12288 + 4096; it += ngw) {
        if (it < 12288) {
            const int p = it >> 12, rem = it & 4095, head = rem >> 9, rem2 = rem & 511, b = rem2 >> 8, rem3 = rem2 & 255;
            const int dd = p == 0 ? 1 : (p == 1 ? 4 : 16), tpr = 256 / dd, rho = rem3 / tpr, q0 = (rem3 % tpr) * 32;
            attn_tile<2, false>(QhA + (size_t)head * T * 64, KhA + (size_t)head * T * 64, VtA + ((size_t)p * 512 + head * 64) * T, dd, S / dd, b, rho, q0, 0.f,
                                OA + (size_t)p * T * 512 + head * 64, 512, LSE + (size_t)p * T * 8 + head, lane);
        } else {
            const int itb = it - 12288, hq = itb >> 9, rem2 = itb & 511, b = rem2 >> 8, q0 = (rem2 & 255) * 32, kvh = hq >> 2;
            attn_tile<4, true>(QhB + (size_t)hq * T * 64, KhB + (size_t)kvh * T * 64, VtB + (size_t)kvh * 64 * T, 1, S, b, 0, q0, sink[hq] * 1.4426950408889634f,
                               Y + 512 + hq * 64, D, nullptr, lane);
        }
    }
}
__device__ __forceinline__ void attn_combine(const bf16_t* OA, const float* LSE, bf16_t* Y) {
    const int gt = blockIdx.x * NTH + threadIdx.x, ngt = gridDim.x * NTH;
    for (int i = gt; i < T * 64; i += ngt) {
        const int tok = i >> 6, head = (i >> 3) & 7, c8 = i & 7;
        const float l0 = LSE[(size_t)tok * 8 + head], l1 = LSE[((size_t)T + tok) * 8 + head], l2 = LSE[((size_t)2 * T + tok) * 8 + head];
        const float mx = fmaxf(l0, fmaxf(l1, l2));
        float w0 = __expf(l0 - mx), w1 = __expf(l1 - mx), w2 = __expf(l2 - mx);
        const float inv = 1.0f / (w0 + w1 + w2); w0 *= inv; w1 *= inv; w2 *= inv;
        const size_t off = (size_t)tok * 512 + head * 64 + c8 * 8;
        const v4u x0 = *(const v4u*)(OA + off), x1 = *(const v4u*)(OA + (size_t)T * 512 + off), x2 = *(const v4u*)(OA + (size_t)2 * T * 512 + off);
        v4u w;
#pragma unroll
        for (int q = 0; q < 4; ++q) {
            const float lo = w0 * __uint_as_float(x0[q] << 16) + w1 * __uint_as_float(x1[q] << 16) + w2 * __uint_as_float(x2[q] << 16);
            const float hi = w0 * __uint_as_float(x0[q] & 0xffff0000u) + w1 * __uint_as_float(x1[q] & 0xffff0000u) + w2 * __uint_as_float(x2[q] & 0xffff0000u);
            w[q] = pk2(lo, hi);
        }
        *(v4u*)(Y + (size_t)tok * D + head * 64 + c8 * 8) = w;
    }
}

#define IN(k) (lo <= (k) && (k) < hi)
#define SEAM(k) do { if (IN(k) && IN((k) + 1)) xcd_barrier(bar); } while (0)
#define PROLOG \
    const int tid = threadIdx.x, lane = tid & 63, wave = tid >> 6; \
    const int bid = blockIdx.x, nb = gridDim.x; \
    const int gw = bid * 8 + wave, ngw = nb * 8; \
    const int gt = bid * NTH + tid, ngt = nb * NTH; \
    (void)gt; (void)ngt; (void)gw; (void)ngw; (void)lane; (void)wave; \
    unsigned char* ws = a.ws; \
    const int lo = a.lo, hi = a.hi; \
    float* ldsf = (float*)lds_raw; (void)ldsf; \
    PG8_LAS unsigned char* ldsp = (PG8_LAS unsigned char*)lds_raw; (void)ldsp; \
    const float* x_in = a.in[0]; const float* mem = a.in[1]; (void)x_in; (void)mem; \
    float* ropec = (float*)(ws + WS_ROPE); float* ropes = ropec + S * 32; (void)ropec; (void)ropes; \
    float* AFF = (float*)(ws + WS_AFF); int* TOK = (int*)(ws + WS_TOK); float* GATE = (float*)(ws + WS_GATE); \
    float* X = (float*)(ws + WS_X); bf16_t* H = (bf16_t*)(ws + WS_H); float* P = (float*)(ws + WS_P); \
    bf16_t* Y = (bf16_t*)(ws + WS_Y); bf16_t* Q = (bf16_t*)(ws + WS_Q); bf16_t* KV = (bf16_t*)(ws + WS_KV); bf16_t* MN = (bf16_t*)(ws + WS_MN); \
    float* DEC = (float*)(ws + WS_DEC); float* KD = (float*)(ws + WS_KD); float* BB = (float*)(ws + WS_BB); \
    float* KK = (float*)(ws + WS_KK); float* G = (float*)(ws + WS_G); float* YS = (float*)(ws + WS_YS); \
    float* RV = (float*)(ws + WS_RV); float* VN = (float*)(ws + WS_VN); \
    bf16_t* XE = (bf16_t*)(ws + WS_XE); bf16_t* HID = (bf16_t*)(ws + WS_HID); int* SLOT = (int*)(ws + WS_SLOT); bf16_t* YE = (bf16_t*)(ws + WS_YE); (void)SLOT; (void)YE; \
    (void)AFF; (void)TOK; (void)GATE; (void)X; (void)H; (void)P; (void)Y; (void)Q; (void)KV; (void)MN; (void)DEC; (void)KD; (void)BB; (void)KK; (void)G; (void)YS; (void)RV; (void)VN; (void)XE; (void)HID;

template <class Epi>
__device__ __forceinline__ void dense_gemm(PG8_LAS unsigned char* ldsp, const bf16_t* A, const bf16_t* Bt, int M, int N, int K, const Epi& E) {
    pg8::Gemm g{A, Bt, M, N, K}; pg8::StaticOrder So; So.init(M, N, (int)gridDim.x, (int)blockIdx.x);
    pg8::gemm_phase<Epi, pg8::StaticOrder, false>(ldsp, g, So, E, nullptr);
}

__device__ __forceinline__ int odd_phases(const Args& a, const XcdBarrier& bar, unsigned char* lds_raw, int ph) {
    PROLOG
    if (IN(ph)) combine_norm<false>(X, YE, SLOT, a.in[6], H, nullptr);
    SEAM(ph); ++ph;
    if (IN(ph)) dense_gemm(ldsp, H, (const bf16_t*)(ws + WS_WOIN), T, ODD_PAD, D, EpiF32Store{P, ODD_IN, ODD_IN});
    SEAM(ph); ++ph;
    if (IN(ph)) {
        float* fsh = ldsf + wave * 2048;
        const float* mu = a.in[12];
        const float *w0 = a.in[13], *w2 = a.in[14], *a0 = a.in[15], *a2 = a.in[16], *g2 = a.in[17], *k_k = a.in[18], *k_a = a.in[19];
        const float *clg = a.in[8], *clb = a.in[9];
        for (int tok = gw; tok < T; tok += ngw) {
            const int s = tok % S;
            const float* pr = P + (size_t)tok * ODD_IN;
            {
                float ge[8]; float sm = 0.f;
#pragma unroll
                for (int j = 0; j < 8; ++j) { ge[j] = gelu_tanh(pr[512 + lane + 64 * j]); sm += ge[j]; }
                const float mean = wave_sum(sm) * (1.0f / 512.f); float sq = 0.f;
#pragma unroll
                for (int j = 0; j < 8; ++j) { const float d = ge[j] - mean; sq += d * d; }
                const float rstd = rsqrtf(wave_sum(sq) * (1.0f / 512.f) + 1e-5f);
#pragma unroll
                for (int j = 0; j < 8; ++j) { const int c = lane + 64 * j; VN[(size_t)tok * 512 + c] = (ge[j] - mean) * rstd * clg[c] + clb[c]; }
            }
            for (int c = lane; c < FD; c += 64) {
                const float f = pr[1024 + c];
                const float pv = s > 0 ? pr[1024 + c - ODD_IN] : 0.f;
                const float nx = s < S - 1 ? pr[1024 + c + ODD_IN] : 0.f;
                fsh[c] = f + mu[c] * (pv - f) + mu[FD + c] * (nx - f);
            }
            asm volatile("s_waitcnt lgkmcnt(0)" ::: "memory");
#pragma unroll 1
            for (int hd = 0; hd < 8; ++hd) {
                const int c = lane + 64 * hd;
                const float r = fsh[c], k = fsh[512 + c], v = fsh[1024 + c];
                float wl[2], al[2], g = 0.f;
#pragma unroll
                for (int d = 0; d < 2; ++d) { wl[d] = w0[d * 512 + c]; al[d] = a0[d * 512 + c]; }
                for (int rr = 0; rr < 64; ++rr) {
#pragma unroll
                    for (int d = 0; d < 2; ++d) {
                        wl[d] += tanhf(fsh[1536 + d * 64 + rr]) * w2[(size_t)(d * 64 + rr) * 512 + c];
                        al[d] += fsh[1664 + d * 64 + rr] * a2[(size_t)(d * 64 + rr) * 512 + c];
                    }
                }
                for (int rr = 0; rr < 128; ++rr) g += sigmoidf_(fsh[1792 + rr]) * g2[(size_t)rr * 512 + c];
                const float kk0 = k * k_k[c];
                const float nrm = sqrtf(wave_sum(kk0 * kk0));
                const float kk = kk0 / fmaxf(nrm, 1e-12f);
                RV[(size_t)tok * D + c] = r; RV[(size_t)tok * D + 512 + c] = v;
                KK[(size_t)tok * 512 + c] = kk; G[(size_t)tok * 512 + c] = g;
#pragma unroll
                for (int d = 0; d < 2; ++d) {
                    const float xw = -wl[d];
                    const float sp = xw > 20.f ? xw : log1pf(expf(xw));
                    const float wlog = -sp - 0.5f;
                    const float alr = sigmoidf_(al[d]);
                    DEC[((size_t)d * T + tok) * 512 + c] = -expf(wlog);
                    KD[((size_t)d * T + tok) * 512 + c] = k * (1.0f + (alr - 1.0f) * k_a[c]);
                    BB[((size_t)d * T + tok) * 512 + c] = kk * alr;
                }
            }
            asm volatile("" ::: "memory");
        }
    }
    SEAM(ph); ++ph;
    if (IN(ph)) {
        const float *wsp = a.in[10], *bsp = a.in[11];
        for (int it = bid; it < NB * 64 * 4; it += nb) {
            const int g = it & 3, chunk = it >> 2;
            const int i = tid >> 2, cq = tid & 3;
            float acc[32];
#pragma unroll
            for (int c = 0; c < 32; ++c) acc[c] = 0.f;
            for (int j = 0; j < 128; ++j) {
                const float w = wsp[(size_t)(g * 128 + i) * 128 + j];
                const float4* vr = (const float4*)(VN + (size_t)(chunk * 128 + j) * 512 + g * 128 + cq * 32);
#pragma unroll
                for (int c4 = 0; c4 < 8; ++c4) { const float4 v = vr[c4]; acc[c4 * 4] += w * v.x; acc[c4 * 4 + 1] += w * v.y; acc[c4 * 4 + 2] += w * v.z; acc[c4 * 4 + 3] += w * v.w; }
            }
            const float bias = bsp[g * 128 + i];
            const int tok = chunk * 128 + i;
#pragma unroll
            for (int c = 0; c < 32; ++c) {
                const int col = g * 128 + cq * 32 + c;
                Y[(size_t)tok * D + col] = (bf16_t)f2bf(gelu_tanh(P[(size_t)tok * ODD_IN + col]) * (acc[c] + bias));
            }
        }
    }
    SEAM(ph); ++ph;
    if (IN(ph)) scan_r1(DEC, RV, KD, KK, BB, (bf16_t*)(ws + WS_PT), (float*)(ws + WS_QT), (bf16_t*)(ws + WS_RH), (float*)(ws + WS_YL), lds_raw);
    SEAM(ph); ++ph;
    if (IN(ph)) scan_r2((const bf16_t*)(ws + WS_PT), (const float*)(ws + WS_QT), (bf16_t*)(ws + WS_S0));
    SEAM(ph); ++ph;
    if (IN(ph)) scan_r3((const bf16_t*)(ws + WS_RH), (const float*)(ws + WS_YL), (const bf16_t*)(ws + WS_S0), RV, KD, G, a.in[20], a.in[21], a.in[22], Y);
    SEAM(ph); ++ph;
    if (IN(ph)) dense_gemm(ldsp, Y, (const bf16_t*)(ws + WS_WOOUT), T, D, D, EpiResid{X, X});
    SEAM(ph); ++ph;
    return ph;
}

template <int layer>
__device__ __forceinline__ int tail_phases(const Args& a, const XcdBarrier& bar, unsigned char* lds_raw, int ph) {
    PROLOG
    if (IN(ph)) { rmsnorm_rows_bf16(X, a.in[24] + layer * D, H, T); rmsnorm_rows_bf16(mem, a.in[25] + layer * D, MN, NB * MEM); }
    SEAM(ph); ++ph;
    if (IN(ph)) {
        dense_gemm(ldsp, H, (const bf16_t*)(ws + WS_WQ) + (size_t)layer * D * D, T, D, D, EpiBf16Store{Q, D, 1.0f});
        dense_gemm(ldsp, MN, (const bf16_t*)(ws + WS_WKV) + (size_t)layer * 2048 * D, NB * MEM, 2048, D, EpiKV{KV, KV + 512 * 1024});
    }
    SEAM(ph); ++ph;
    if (IN(ph)) xattn_mfma(Q, KV, KV + 512 * 1024, Y);
    SEAM(ph); ++ph;
    if (IN(ph)) dense_gemm(ldsp, Y, (const bf16_t*)(ws + WS_WO) + (size_t)layer * D * D, T, D, D, EpiResid{X, X});
    SEAM(ph); ++ph;
    if (IN(ph)) {
        const float* g = a.in[29] + layer * D; const float* Wr = a.in[30] + (size_t)layer * D * NE;
        for (int m = gw; m < T; m += ngw) {
            const float4* xr = (const float4*)(X + (size_t)m * D);
            float4 v[4]; float s = 0.f;
#pragma unroll
            for (int j = 0; j < 4; ++j) { v[j] = xr[lane + 64 * j]; s += v[j].x * v[j].x + v[j].y * v[j].y + v[j].z * v[j].z + v[j].w * v[j].w; }
            const float r = rsqrtf(wave_sum(s) * (1.0f / D) + 1e-6f);
            float lg[16];
#pragma unroll
            for (int e = 0; e < 16; ++e) lg[e] = 0.f;
#pragma unroll
            for (int j = 0; j < 4; ++j) {
                const float4 gg = ((const float4*)g)[lane + 64 * j];
                const float4 hv = make_float4(v[j].x * r * gg.x, v[j].y * r * gg.y, v[j].z * r * gg.z, v[j].w * r * gg.w);
                v2u w2_; w2_.x = pk2(hv.x, hv.y); w2_.y = pk2(hv.z, hv.w);
                ((v2u*)(H + (size_t)m * D))[lane + 64 * j] = w2_;
                const float hh[4] = {hv.x, hv.y, hv.z, hv.w};
#pragma unroll
                for (int q = 0; q < 4; ++q) {
                    const float4* wr = (const float4*)(Wr + (size_t)((lane + 64 * j) * 4 + q) * NE);
#pragma unroll
                    for (int e4 = 0; e4 < 4; ++e4) { const float4 w = wr[e4]; lg[e4 * 4] += hh[q] * w.x; lg[e4 * 4 + 1] += hh[q] * w.y; lg[e4 * 4 + 2] += hh[q] * w.z; lg[e4 * 4 + 3] += hh[q] * w.w; }
                }
            }
            float mx = -3.0e38f;
#pragma unroll
            for (int e = 0; e < 16; ++e) { lg[e] = wave_sum(lg[e]); mx = fmaxf(mx, lg[e]); }
            float den = 0.f;
#pragma unroll
            for (int e = 0; e < 16; ++e) { lg[e] = expf(lg[e] - mx); den += lg[e]; }
            float mine = 0.f;
#pragma unroll
            for (int e = 0; e < 16; ++e) if (lane == e) mine = lg[e] / den;
            if (lane < 16) { AFF[(size_t)m * NE + lane] = mine; SLOT[(size_t)m * NE + lane] = -1; }
        }
    }
    SEAM(ph); ++ph;
    if (IN(ph)) {
        unsigned* keys = (unsigned*)ldsf;
        int* hist = (int*)(ldsf + 8192);
        int* sh = hist + 256;
        for (int be = bid; be < NB * NE; be += nb) {
            const int b = be >> 4, e = be & 15, eb = e * 2 + b;
            __syncthreads();
            for (int s = tid; s < S; s += NTH) keys[s] = __float_as_uint(AFF[(size_t)(b * S + s) * NE + e]);
            unsigned prefix = 0u; int krem = CAP;
            for (int pass = 3; pass >= 0; --pass) {
                __syncthreads();
                if (tid < 256) hist[tid] = 0;
                __syncthreads();
                const unsigned hmask = pass == 3 ? 0u : (0xFFFFFFFFu << (8 * (pass + 1)));
                for (int s = tid; s < S; s += NTH) { const unsigned k = keys[s]; if ((k & hmask) == prefix) atomicAdd(&hist[(k >> (8 * pass)) & 255u], 1); }
                __syncthreads();
                if (tid == 0) {
                    int cum = 0, bsel = 0;
                    for (int bb = 255; bb >= 0; --bb) { const int c = hist[bb]; if (cum + c >= krem) { bsel = bb; break; } cum += c; }
                    sh[8] = bsel; sh[9] = krem - cum;
                }
                __syncthreads();
                prefix |= ((unsigned)sh[8]) << (8 * pass); krem = sh[9];
            }
            const unsigned thr = prefix;
            int ce = 0;
            for (int i = 0; i < 16; ++i) { const unsigned k = keys[tid * 16 + i]; ce += (k == thr); }
            int tot;
            const int eqbase = block_exscan(ce, sh, &tot);
            int eqr = eqbase, cs = 0;
            for (int i = 0; i < 16; ++i) { const unsigned k = keys[tid * 16 + i]; const bool sel = (k > thr) || (k == thr && eqr < krem); eqr += (k == thr); cs += sel; }
            const int sbase = block_exscan(cs, sh, &tot);
            int slot = sbase; eqr = eqbase;
            for (int i = 0; i < 16; ++i) {
                const int s = tid * 16 + i; const unsigned k = keys[s];
                const bool sel = (k > thr) || (k == thr && eqr < krem); eqr += (k == thr);
                if (sel) { TOK[eb * CAP + slot] = b * S + s; GATE[eb * CAP + slot] = __uint_as_float(k); SLOT[(size_t)(b * S + s) * NE + e] = eb * CAP + slot; ++slot; }
            }
        }
    }
    SEAM(ph); ++ph;
    if (IN(ph)) {
        for (int r = gw; r < NB * NE * CAP; r += ngw) {
            int rv_ = r; asm volatile("" : "+v"(rv_));
            const v4u* src = (const v4u*)(H + (size_t)TOK[rv_] * D); v4u* dst = (v4u*)(XE + (size_t)r * D);
            dst[lane] = src[lane]; dst[lane + 64] = src[lane + 64];
        }
    }
    SEAM(ph); ++ph;
    if (IN(ph)) {
        pg8::Gemm g{XE, (const bf16_t*)(ws + WS_WGU) + (size_t)layer * NE * 5632 * D, NB * NE * CAP, NE * 5632, D};
        MoeOrder So{(int)gridDim.x, (int)blockIdx.x, 16 * 22, 22};
        pg8::gemm_phase<EpiSiluMul, MoeOrder, false>(ldsp, g, So, EpiSiluMul{HID}, nullptr);
    }
    SEAM(ph); ++ph;
    if (IN(ph)) {
        pg8::Gemm g{HID, (const bf16_t*)(ws + WS_WD) + (size_t)layer * NE * D * DE, NB * NE * CAP, NE * D, DE};
        MoeOrder So{(int)gridDim.x, (int)blockIdx.x, 16 * 4, 4};
        pg8::gemm_phase<EpiYE, MoeOrder, false>(ldsp, g, So, EpiYE{GATE, YE}, nullptr);
    }
    SEAM(ph); ++ph;
    return ph;
}

__global__ void __launch_bounds__(NTH, 2) mega(Args a) {
    extern __shared__ __attribute__((aligned(16))) unsigned char lds_raw[];
    unsigned* ctl = (unsigned*)(a.ws + WS_CTL);
    volatile LAS unsigned* bst = (volatile LAS unsigned*)((LAS unsigned char*)lds_raw + LDS_BAR_OFF);
    if (threadIdx.x < 4) bst[threadIdx.x] = 0u;
    __syncthreads();
    XcdBarrier bar; bar.bar = ctl + CW_BAR; bar.x = 0; bar.st = bst;
    if (a.hi - a.lo > 1) bar = xcd_barrier_post(ctl + CW_BAR, bst);
    PROLOG

    int ph = 0;
    if (IN(ph)) {
        for (int i = gt; i < S * 32; i += ngt) {
            const int s = i >> 5, f = i & 31;
            const float pw = (float)exp((double)((float)(2 * f) / 64.0f) * 9.210340371976184);
            const float invf = 1.0f / pw;
            const float angf = (float)s * invf;
            double xx = (double)angf;
            const double n = rint(xx * 0.15915494309189535);
            xx = (xx - n * 6.283185307179586) - n * 2.4492935982947064e-16;
            const double x2 = xx * xx;
            double cs = 1.0, sn = xx, tc = 1.0, tsn = xx;
#pragma unroll 1
            for (int k = 1; k <= 16; ++k) { tc *= -x2 / (double)((2 * k - 1) * (2 * k)); tsn *= -x2 / (double)((2 * k) * (2 * k + 1)); cs += tc; sn += tsn; }
            ropec[i] = (float)cs; ropes[i] = (float)sn;
        }
        rmsnorm_rows_bf16(x_in, a.in[2], H, T);
        LAS float* scr = (LAS float*)((LAS unsigned char*)lds_raw + wave * 16384);
        auto ident = [](int n) { return n; };
        auto emap = [](int n) { const bool il = (n < 1024) || (n >= 1536 && n < 2176); const int j = n & 63; return il ? ((n & ~63) + (j < 32 ? 2 * j : 2 * (j - 32) + 1)) : n; };
        for (int it = gw; it < 16 * 72; it += ngw) transpose_item(a.in[3], D, EVEN_IN, (bf16_t*)(ws + WS_WEIN), emap, scr, it, lane);
        for (int it = gw; it < 16 * 32; it += ngw) transpose_item(a.in[5], D, D, (bf16_t*)(ws + WS_WEOUT), ident, scr, it, lane);
        for (int it = gw; it < 16 * 92; it += ngw) transpose_item(a.in[7], D, ODD_IN, (bf16_t*)(ws + WS_WOIN), ident, scr, it, lane);
        for (int it = gw; it < 16 * 32; it += ngw) transpose_item(a.in[23], D, D, (bf16_t*)(ws + WS_WOOUT), ident, scr, it, lane);
        for (int it = gw; it < 2 * 16 * 32; it += ngw) { const int l = it / 512, r = it % 512; transpose_item(a.in[26] + (size_t)l * D * D, D, D, (bf16_t*)(ws + WS_WQ) + (size_t)l * D * D, ident, scr, r, lane); }
        for (int it = gw; it < 2 * 16 * 64; it += ngw) { const int l = it / 1024, r = it % 1024; transpose_item(a.in[27] + (size_t)l * D * 2048, D, 2048, (bf16_t*)(ws + WS_WKV) + (size_t)l * 2048 * D, ident, scr, r, lane); }
        for (int it = gw; it < 2 * 16 * 32; it += ngw) { const int l = it / 512, r = it % 512; transpose_item(a.in[28] + (size_t)l * D * D, D, D, (bf16_t*)(ws + WS_WO) + (size_t)l * D * D, ident, scr, r, lane); }
        auto gmap = [](int n) { return (n >> 7) * 256 + (n & 127); };
        auto umap = [](int n) { return (n >> 7) * 256 + 128 + (n & 127); };
        for (int it = gw; it < 32 * 1408; it += ngw) { const int mt = it / 1408, r = it % 1408;
            transpose_item(a.in[31] + (size_t)mt * D * DE, D, DE, (bf16_t*)(ws + WS_WGU) + (size_t)mt * 5632 * D, gmap, scr, r, lane); }
        for (int it = gw; it < 32 * 1408; it += ngw) { const int mt = it / 1408, r = it % 1408;
            transpose_item(a.in[32] + (size_t)mt * D * DE, D, DE, (bf16_t*)(ws + WS_WGU) + (size_t)mt * 5632 * D, umap, scr, r, lane); }
        for (int it = gw; it < 32 * 1408; it += ngw) { const int mt = it / 1408, r = it % 1408;
            transpose_item(a.in[33] + (size_t)mt * DE * D, DE, D, (bf16_t*)(ws + WS_WD) + (size_t)mt * D * DE, ident, scr, r, lane); }
    }
    SEAM(ph); ++ph;

    if (IN(ph)) dense_gemm(ldsp, H, (const bf16_t*)(ws + WS_WEIN), T, EVEN_IN, D,
                           EpiEven{ropec, ropes, (bf16_t*)(ws + WS_QHA), (bf16_t*)(ws + WS_KHA), (bf16_t*)(ws + WS_QHB), (bf16_t*)(ws + WS_KHB), (bf16_t*)(ws + WS_PVB)});
    SEAM(ph); ++ph;
    if (IN(ph)) vtrans_pass((const bf16_t*)(ws + WS_PVB), (bf16_t*)(ws + WS_VTA), (bf16_t*)(ws + WS_VTB), lds_raw);
    SEAM(ph); ++ph;
    if (IN(ph)) attn_phase_even((const bf16_t*)(ws + WS_QHA), (const bf16_t*)(ws + WS_KHA), (const bf16_t*)(ws + WS_VTA), (const bf16_t*)(ws + WS_QHB), (const bf16_t*)(ws + WS_KHB),
                                (const bf16_t*)(ws + WS_VTB), a.in[4], (bf16_t*)(ws + WS_OA), (float*)(ws + WS_LSE), Y);
    SEAM(ph); ++ph;
    if (IN(ph)) attn_combine((const bf16_t*)(ws + WS_OA), (const float*)(ws + WS_LSE), Y);
    SEAM(ph); ++ph;
    if (IN(ph)) dense_gemm(ldsp, Y, (const bf16_t*)(ws + WS_WEOUT), T, D, D, EpiResid{x_in, X});
    SEAM(ph); ++ph;

    ph = tail_phases<0>(a, bar, lds_raw, ph);
    ph = odd_phases(a, bar, lds_raw, ph);
    ph = tail_phases<1>(a, bar, lds_raw, ph);

    if (IN(ph)) combine_norm<true>(X, YE, SLOT, a.in[34], nullptr, a.out);
    ++ph;
}
constexpr int NPHASES = 1 + 5 + 2 * 9 + 8 + 1;
#undef IN
#undef SEAM
}

extern "C" void kernel_launch(void* const* d_in, const int* in_sizes, int n_in, void* d_out, int out_size, void* d_ws, size_t ws_size, hipStream_t stream) {
    static int grid = 0;
    if (grid == 0) {
        if (n_in != 35 || out_size != T * D || ws_size < WS_END) { fprintf(stderr, "kernel_launch: unexpected shapes n_in %d out %d ws %zu (need %zu)\n", n_in, out_size, ws_size, (size_t)WS_END); grid = -1; return; }
        int dev = 0, cus = 0, per_cu = 0;
        (void)hipGetDevice(&dev); (void)hipDeviceGetAttribute(&cus, hipDeviceAttributeMultiprocessorCount, dev);
        if (hipFuncSetAttribute((const void*)mega, hipFuncAttributeMaxDynamicSharedMemorySize, LDS_BYTES) != hipSuccess) { fprintf(stderr, "hipFuncSetAttribute failed\n"); grid = -1; return; }
        if (hipOccupancyMaxActiveBlocksPerMultiprocessor(&per_cu, (const void*)mega, NTH, LDS_BYTES) != hipSuccess || per_cu < 1) fprintf(stderr, "occupancy query: %d\n", per_cu);
        (void)hipGetLastError();
        grid = cus > 0 ? cus : 256;
    }
    if (grid < 0) return;
    (void)hipMemsetAsync((char*)d_ws + WS_CTL, 0, CTL_BYTES, stream);
    Args a{};
    for (int i = 0; i < 35; ++i) a.in[i] = (const float*)d_in[i];
    a.out = (float*)d_out; a.ws = (unsigned char*)d_ws;
#if MK_MULTI
    for (int k = 0; k < NPHASES; ++k) { a.lo = k; a.hi = k + 1; hipLaunchKernelGGL(mega, dim3(grid), dim3(NTH), LDS_BYTES, stream, a); }
#else
    a.lo = 0; a.hi = NPHASES; hipLaunchKernelGGL(mega, dim3(grid), dim3(NTH), LDS_BYTES, stream, a);
#endif
}
```

```cpp
#include <hip/hip_runtime.h>
#include <cstdio>
#include <cstdint>

#ifndef PROBE_PHASE
#define PROBE_PHASE (-1)
#endif
#ifndef PROBE_REP
#define PROBE_REP 1
#endif
#ifndef MK_MULTI
#define MK_MULTI 0
#endif

__device__ __forceinline__ int tidx() { int t = threadIdx.x; asm volatile("" : "+v"(t)); return t; }
namespace pg8 {
#define PG8_LAS __attribute__((address_space(3)))
typedef unsigned short bf16_t;
typedef short bf16x8 __attribute__((ext_vector_type(8)));
typedef float f32x4 __attribute__((ext_vector_type(4)));
typedef unsigned u32x4 __attribute__((ext_vector_type(4)));
constexpr int BM = 256, BK = 64, HALF = 128, HTB = HALF * BK * 2  , STAGE_BYTES = 8 * HTB, NXCD = 8, WGM = 8;

__host__ __device__ __forceinline__ int lds_byte(int r, int c) { const int st = (r >> 4) * 2 + (c >> 5), rr = r & 15, cc = c & 31, ob = rr * 64 + cc * 2; return st * 1024 + (ob ^ (((ob >> 9) & 1) << 5)); }
__host__ __device__ __forceinline__ void stage_rc(int b, int& R, int& C) { const int st = b / 1024, sb = b % 1024, swz = sb ^ (((sb >> 9) & 1) << 5); R = (st >> 1) * 16 + swz / 64; C = (st & 1) * 32 + (swz % 64) / 2; }
__host__ __device__ __forceinline__ int perm32(int rho) { const int n = rho >> 4, i = rho & 15; return 8 * (i >> 2) + 4 * n + (i & 3); }

struct Unit { int pm, pn; };
struct Gemm { const bf16_t* A; const bf16_t* Bt; int M, N, K; };

struct StaticOrder {
    int nM, nN, nwg, G, c;
    __host__ __device__ void init(int M, int N, int G_, int c_) { nM = M / BM; nN = N / BM; nwg = nM * nN; G = G_; c = c_; }
    __host__ __device__ bool next(int i, Unit& u) const {
        const long L = (long)i * G + c; if (L >= nwg) return false;
        int wgid = (int)L; { const int q = nwg / NXCD, r = nwg % NXCD, xcd = wgid % NXCD, off = wgid / NXCD; wgid = (xcd < r ? xcd * (q + 1) : r * (q + 1) + (xcd - r) * q) + off; }
        const int nig = WGM * nN, gid = wgid / nig, fm = gid * WGM, gsz = (nM - fm) < WGM ? (nM - fm) : WGM;
        u.pm = fm + ((wgid % nig) % gsz); u.pn = (wgid % nig) / gsz; return true;
    }
    __device__ __forceinline__ void a_ready(const Unit&) const {}
    __device__ __forceinline__ void done(const Unit&) const {}
};

typedef __bf16 bf16v2_t __attribute__((ext_vector_type(2)));
typedef float f32v2_t __attribute__((ext_vector_type(2)));
__device__ __forceinline__ unsigned cvt_pk_bf16(float lo, float hi) { const f32v2_t v = {lo, hi}; return __builtin_bit_cast(unsigned, __builtin_convertvector(v, bf16v2_t)); }
template <class Epi, class Sched, bool STAMP = false>
__device__ __forceinline__ void gemm_phase(PG8_LAS unsigned char* lds, const Gemm g, const Sched& S, const Epi& E, unsigned long long* stamps) {
    const int tid = ::tidx(), wid = __builtin_amdgcn_readfirstlane(tid >> 6), lane = tid & 63, wr = wid >> 2, wc = wid & 3, fr = lane & 15, fq = lane >> 4;
    const int K = g.K, nt = K / BK;
    int ts_lo = 0, ts_hi = 0, nts = 0; const unsigned long long rt_entry = STAMP ? (unsigned long long)wall_clock64() : 0ull;
#define PG8_STAMP() do { if (STAMP && wid == 0 && nts < 64) { const unsigned long long _c = (unsigned long long)clock64(); \
        ts_lo = (lane == nts) ? (int)(unsigned)_c : ts_lo; ts_hi = (lane == nts) ? (int)(unsigned)(_c >> 32) : ts_hi; ++nts; } } while (0)
    PG8_STAMP();
    unsigned voffA[2], voffB[2];
#pragma unroll
    for (int i = 0; i < 2; ++i) { int R, C; stage_rc(tid * 16 + i * 8192, R, C); const int Rb = Epi::PERM ? ((R & ~31) + perm32(R & 31)) : R;
        voffA[i] = (unsigned)(R * K + C) * 2u; voffB[i] = (unsigned)(Rb * K + C) * 2u; }
    const size_t kstep = (size_t)(BK * 2);
    const size_t hstep = (size_t)HALF * K * 2;
    const size_t tstep = 2 * hstep;
    const unsigned ldsw = (unsigned)wid * 1024u;
    const int aoff = lds_byte(wr * 64 + fr, fq * 8), boff = lds_byte(wc * 32 + fr, fq * 8);
#define PG8_SA(b, h) (((b) * 2 + (h)) * HTB)
#define PG8_SB(b, h) ((4 + (b) * 2 + (h)) * HTB)
#define PG8_STAGE(bufoff, gbase, voff) do { _Pragma("unroll") for (int _i = 0; _i < 2; ++_i) \
        __builtin_amdgcn_global_load_lds((const unsigned*)((const char*)(gbase) + (voff)[_i]), (PG8_LAS unsigned*)(lds + (bufoff) + ldsw + _i * 8192), 16, 0, 0); } while (0)
#define PG8_LDA(dst, b, h) do { _Pragma("unroll") for (int m = 0; m < 4; ++m) _Pragma("unroll") for (int k = 0; k < 2; ++k) dst[m][k] = *(const PG8_LAS bf16x8*)(lds + PG8_SA(b, h) + aoff + m * 2048 + k * 1024); } while (0)
#define PG8_LDB(dst, b, h) do { _Pragma("unroll") for (int n = 0; n < 2; ++n) _Pragma("unroll") for (int k = 0; k < 2; ++k) dst[n][k] = *(const PG8_LAS bf16x8*)(lds + PG8_SB(b, h) + boff + n * 2048 + k * 1024); } while (0)
#define PG8_MMA(ai, bj, At, Bt) do { __builtin_amdgcn_s_setprio(1); _Pragma("unroll") for (int m = 0; m < 4; ++m) _Pragma("unroll") for (int n = 0; n < 2; ++n) _Pragma("unroll") for (int k = 0; k < 2; ++k) \
        acc[ai][bj][m][n] = __builtin_amdgcn_mfma_f32_16x16x32_bf16(Bt[n][k], At[m][k], acc[ai][bj][m][n], 0, 0, 0); __builtin_amdgcn_s_setprio(0); } while (0)
#define PG8_WAIT_V(n) asm volatile("s_waitcnt vmcnt(" #n ")" ::: "memory")
#define PG8_WAIT_L(n) asm volatile("s_waitcnt lgkmcnt(" #n ")" ::: "memory")
#define PG8_BAR __builtin_amdgcn_s_barrier()
#define PG8_SCHED __builtin_amdgcn_sched_barrier(0)
    Unit cur, nxt; int ui = 0;
    if (!S.next(0, cur)) return;
    f32x4 acc[2][2][4][2];
#pragma unroll
    for (int a = 0; a < 2; ++a)
#pragma unroll
        for (int b = 0; b < 2; ++b)
#pragma unroll
            for (int m = 0; m < 4; ++m)
#pragma unroll
                for (int n = 0; n < 2; ++n) acc[a][b][m][n] = (f32x4){0.f, 0.f, 0.f, 0.f};
    bf16x8 At[4][2], B0[2][2], B1[2][2];
    const char* cA = (const char*)g.A + (size_t)cur.pm * tstep; const char* cB = (const char*)g.Bt + (size_t)cur.pn * tstep;
    S.a_ready(cur);
    PG8_STAGE(PG8_SB(0, 0), cB, voffB); PG8_STAGE(PG8_SA(0, 0), cA, voffA); PG8_STAGE(PG8_SB(0, 1), cB + hstep, voffB); PG8_STAGE(PG8_SA(0, 1), cA + hstep, voffA);
    if (wr == 1) PG8_BAR;
    PG8_WAIT_V(4); PG8_BAR;
    PG8_STAGE(PG8_SB(1, 0), cB + kstep, voffB); PG8_STAGE(PG8_SA(1, 0), cA + kstep, voffA); PG8_STAGE(PG8_SB(1, 1), cB + hstep + kstep, voffB);
    PG8_WAIT_V(6); PG8_BAR;
    PG8_STAMP();
    for (;;) {
        const bool has_next = S.next(ui + 1, nxt);
        const char* nA = has_next ? (const char*)g.A + (size_t)nxt.pm * tstep : cA; const char* nB = has_next ? (const char*)g.Bt + (size_t)nxt.pn * tstep : cB;
        for (int t = 0; t < nt; t += 2) {
            const bool last = (t == nt - 2);
            const char* a1 = cA + (size_t)(t + 1) * kstep;
            const char* a2 = last ? nA : cA + (size_t)(t + 2) * kstep; const char* b2 = last ? nB : cB + (size_t)(t + 2) * kstep;
            const char* a3 = a2 + kstep; const char* b3 = b2 + kstep;
            if (last && has_next) S.a_ready(nxt);
            PG8_LDB(B0, 0, 0); PG8_SCHED; PG8_LDA(At, 0, 0); PG8_STAGE(PG8_SA(1, 1), a1 + hstep, voffA);
            PG8_WAIT_L(8); PG8_BAR; PG8_WAIT_L(0); PG8_MMA(0, 0, At, B0); PG8_BAR; PG8_SCHED;
            PG8_LDB(B1, 0, 1); PG8_STAGE(PG8_SB(0, 0), b2, voffB);
            PG8_BAR; PG8_WAIT_L(0); PG8_MMA(0, 1, At, B1); PG8_BAR;
            PG8_LDA(At, 0, 1); PG8_STAGE(PG8_SA(0, 0), a2, voffA);
            PG8_BAR; PG8_WAIT_L(0); PG8_MMA(1, 0, At, B0); PG8_BAR; PG8_SCHED;
            PG8_STAGE(PG8_SB(0, 1), b2 + hstep, voffB);
            PG8_WAIT_V(6); PG8_BAR; PG8_MMA(1, 1, At, B1); PG8_BAR;
            PG8_LDB(B0, 1, 0); PG8_SCHED; PG8_LDA(At, 1, 0); PG8_STAGE(PG8_SA(0, 1), a2 + hstep, voffA);
            PG8_WAIT_L(8); PG8_BAR; PG8_WAIT_L(0); PG8_MMA(0, 0, At, B0); PG8_BAR; PG8_SCHED;
            PG8_LDB(B1, 1, 1); PG8_STAGE(PG8_SB(1, 0), b3, voffB);
            PG8_BAR; PG8_WAIT_L(0); PG8_MMA(0, 1, At, B1); PG8_BAR;
            PG8_LDA(At, 1, 1); PG8_STAGE(PG8_SA(1, 0), a3, voffA);
            PG8_BAR; PG8_WAIT_L(0); PG8_MMA(1, 0, At, B0); PG8_BAR; PG8_SCHED;
            PG8_STAGE(PG8_SB(1, 1), b3 + hstep, voffB);
            PG8_WAIT_V(6); PG8_BAR; PG8_MMA(1, 1, At, B1); PG8_BAR;
        }
        PG8_STAMP();
        if constexpr (!Epi::AFTER_DRAIN) { E(acc, cur, wr, wc, fr, fq); S.done(cur); }
        PG8_STAMP();
        if (!has_next) break;
#pragma unroll
        for (int a = 0; a < 2; ++a)
#pragma unroll
            for (int b = 0; b < 2; ++b)
#pragma unroll
                for (int m = 0; m < 4; ++m)
#pragma unroll
                    for (int n = 0; n < 2; ++n) acc[a][b][m][n] = (f32x4){0.f, 0.f, 0.f, 0.f};
        cur = nxt; cA = nA; cB = nB; ++ui;
    }
    PG8_WAIT_V(0);
    if (wr == 0) PG8_BAR;
    PG8_BAR;
    if constexpr (Epi::AFTER_DRAIN) { E.fused(acc, cur, wr, wc, fr, fq, lds, wid, lane); S.done(cur); }
    PG8_STAMP();
    if (STAMP && wid == 0) { stamps[lane] = lane < nts ? (((unsigned long long)(unsigned)ts_hi << 32) | (unsigned)ts_lo) : 0ull;
        if (lane == 62) stamps[62] = rt_entry; if (lane == 63) stamps[63] = (unsigned long long)wall_clock64(); }
#undef PG8_STAMP
#undef PG8_SA
#undef PG8_SB
#undef PG8_STAGE
#undef PG8_LDA
#undef PG8_LDB
#undef PG8_MMA
#undef PG8_WAIT_V
#undef PG8_WAIT_L
#undef PG8_BAR
#undef PG8_SCHED
}
}


namespace {
using pg8::bf16_t; using pg8::f32x4;
constexpr int D = 1024, NB = 2, S = 8192, T = NB * S;
constexpr int EVEN_IN = 2304, ODD_IN = 2944, ODD_PAD = 3072, FD = 1920;
constexpr int MEM = 256, NE = 16, CAP = 1024, DE = 2816;
constexpr int NTH = 512;
constexpr size_t MiB = 1u << 20;
constexpr size_t WS_CTL = 0, CTL_BYTES = 1 * MiB;
constexpr size_t WS_ROPE = 1 * MiB;
constexpr size_t WS_AFF = 4 * MiB;
constexpr size_t WS_TOK = 5 * MiB;
constexpr size_t WS_GATE = 6 * MiB;
constexpr size_t WS_WRT = 3 * MiB;
constexpr size_t WS_SLOT = 7 * MiB;
constexpr size_t WS_X = 8 * MiB;
constexpr size_t WS_H = 72 * MiB;
constexpr size_t WS_Y = 104 * MiB;
constexpr size_t WS_P = 136 * MiB;
constexpr size_t WS_Q = 320 * MiB;
constexpr size_t WS_KV = 384 * MiB;
constexpr size_t WS_MN = 388 * MiB;
constexpr size_t WS_DEC = 392 * MiB;
constexpr size_t WS_KD = 456 * MiB;
constexpr size_t WS_BB = 520 * MiB;
constexpr size_t WS_KK = 584 * MiB;
constexpr size_t WS_G = 616 * MiB;
constexpr size_t WS_YS = 648 * MiB;
constexpr size_t WS_RV = 712 * MiB;
constexpr size_t WS_VN = 776 * MiB;
constexpr size_t WS_QHA = 136 * MiB;
constexpr size_t WS_KHA = 152 * MiB;
constexpr size_t WS_QHB = 168 * MiB;
constexpr size_t WS_KHB = 184 * MiB;
constexpr size_t WS_PVB = 188 * MiB;
constexpr size_t WS_VTA = 208 * MiB;
constexpr size_t WS_VTB = 256 * MiB;
constexpr size_t WS_OA = 260 * MiB;
constexpr size_t WS_LSE = 308 * MiB;
constexpr size_t WS_QT = 136 * MiB;
constexpr size_t WS_YL = 200 * MiB;
constexpr size_t WS_PT = 264 * MiB;
constexpr size_t WS_RH = 296 * MiB;
constexpr size_t WS_S0 = 328 * MiB;
constexpr size_t WS_XE = 136 * MiB;
constexpr size_t WS_YE = 136 * MiB;
constexpr size_t WS_HID = 200 * MiB;
constexpr size_t WS_KB = 360 * MiB;
constexpr size_t WS_F5 = 792 * MiB;
constexpr size_t WS_WSB = 804 * MiB;
constexpr size_t WS_WL = 805 * MiB;
constexpr size_t WS_WEIN = 808 * MiB;
constexpr size_t WS_WEOUT = 813 * MiB;
constexpr size_t WS_WOIN = 815 * MiB;
constexpr size_t WS_WOOUT = 821 * MiB;
constexpr size_t WS_WQ = 823 * MiB;
constexpr size_t WS_WKV = 827 * MiB;
constexpr size_t WS_WO = 835 * MiB;
constexpr size_t WS_WGU = 840 * MiB;
constexpr size_t WS_WD = 1192 * MiB;
constexpr size_t WS_END = 1368 * MiB;
constexpr int CW_BAR = 4096;

constexpr int LDS_BYTES = 147456;
constexpr int LDS_BAR_OFF = LDS_BYTES - 64;

#define LAS __attribute__((address_space(3)))
#define XB_TMO      128
#define XB_XCNT(j)  (256  + 64 * (j))
#define XB_XSUB(j)  (1280 + 64 * (j))
#define XB_XGEN(j)  (2304 + 64 * (j))
#define XB_TOP      3328
#define XB_TOPGEN   3392
#define XCD_BAR_WORDS 3456
#define XB_SPIN_CAP (1u << 22)
__device__ __forceinline__ unsigned xb_ld(unsigned* p)              { return __hip_atomic_load(p, __ATOMIC_RELAXED, __HIP_MEMORY_SCOPE_AGENT); }
__device__ __forceinline__ unsigned xb_add(unsigned* p, unsigned v) { return __hip_atomic_fetch_add(p, v, __ATOMIC_RELAXED, __HIP_MEMORY_SCOPE_AGENT); }
__device__ __forceinline__ unsigned xb_xcc_id() { return (unsigned)__builtin_amdgcn_s_getreg((3 << 11) | 20) & 0xFu; }
#define XB_SPIN(cond, bar) do { unsigned _sp = 0; while (cond) { __builtin_amdgcn_s_sleep(1); \
    if ((++_sp & 255u) == 0u) { if (xb_ld(&(bar)[XB_TMO])) break; if (_sp > XB_SPIN_CAP) { atomicAdd(&(bar)[XB_TMO], 1u); break; } } } } while (0)
struct XcdBarrier { unsigned* bar; unsigned x; volatile LAS unsigned* st; };
__device__ __forceinline__ XcdBarrier xcd_barrier_post(unsigned* bar, volatile LAS unsigned* st) {
    XcdBarrier b; b.bar = bar; b.x = xb_xcc_id(); b.st = st;
    if (threadIdx.x == 0) (void)xb_add(&bar[XB_XCNT(b.x)], 1u);
    return b;
}
__device__ __forceinline__ void xcd_barrier_complete(unsigned* bar, unsigned x, unsigned& nloc, unsigned& nx) {
    const unsigned G = gridDim.x * gridDim.y * gridDim.z;
    unsigned sum, cnt, mine, sp = 0u;
    for (;;) {
        sum = 0u; cnt = 0u; mine = 0u;
#pragma unroll
        for (unsigned j = 0; j < 16; ++j) { const unsigned c = xb_ld(&bar[XB_XCNT(j)]); sum += c; cnt += (c > 0u) ? 1u : 0u; mine = (j == x) ? c : mine; }
        if (sum == G) break;
        __builtin_amdgcn_s_sleep(1);
        if ((++sp & 255u) == 0u) { if (xb_ld(&bar[XB_TMO])) break; if (sp > XB_SPIN_CAP) { atomicAdd(&bar[XB_TMO], 1u); break; } }
    }
    nloc = mine > 0u ? mine : 1u; nx = cnt > 0u ? cnt : 1u;
}
__device__ __forceinline__ void xcd_barrier(const XcdBarrier& b) {
    asm volatile("s_waitcnt vmcnt(0)" ::: "memory");
    __syncthreads();
    if (threadIdx.x == 0) {
        unsigned* bar = b.bar;
        __builtin_amdgcn_s_waitcnt(0);
        unsigned nloc = b.st[0], nx = b.st[1];
        if (nloc == 0u) { xcd_barrier_complete(bar, b.x, nloc, nx); b.st[0] = nloc; b.st[1] = nx; }
        const unsigned old = xb_add(&bar[XB_XSUB(b.x)], 1u);
        const unsigned gen = old / nloc;
        if (old + 1u == (gen + 1u) * nloc) {
            __builtin_amdgcn_fence(__ATOMIC_RELEASE, "agent");
            asm volatile("s_waitcnt vmcnt(0)" ::: "memory");
            const unsigned og = xb_add(&bar[XB_TOP], 1u);
            const unsigned tg = og / nx;
            if (og + 1u == (tg + 1u) * nx) xb_add(&bar[XB_TOPGEN], 1u);
            else XB_SPIN(xb_ld(&bar[XB_TOPGEN]) == tg, bar);
            __builtin_amdgcn_fence(__ATOMIC_ACQUIRE, "agent");
            xb_add(&bar[XB_XGEN(b.x)], 1u);
            asm volatile("s_waitcnt vmcnt(0)" ::: "memory");
        } else {
            XB_SPIN(xb_ld(&bar[XB_XGEN(b.x)]) == gen, bar);
            __builtin_amdgcn_fence(__ATOMIC_ACQUIRE, "agent");
            asm volatile("s_waitcnt vmcnt(0)" ::: "memory");
        }
    }
    __syncthreads();
}

__device__ __forceinline__ float wave_sum(float v) {
#pragma unroll
    for (int o = 32; o >= 1; o >>= 1) v += __shfl_xor(v, o);
    return v;
}
__device__ __forceinline__ float sigmoidf_(float x) { return 1.0f / (1.0f + expf(-x)); }
__device__ __forceinline__ float gelu_tanh(float x) { return 0.5f * x * (1.0f + tanhf(0.7978845608028654f * (x + 0.044715f * x * x * x))); }
__device__ __forceinline__ unsigned f2bf(float f) { unsigned u = __builtin_bit_cast(unsigned, f); return (u + 0x7fffu + ((u >> 16) & 1u)) >> 16; }
__device__ __forceinline__ unsigned pk2(float lo, float hi) { return pg8::cvt_pk_bf16(lo, hi); }
__device__ __forceinline__ float bflo(unsigned w) { return __uint_as_float(w << 16); }
__device__ __forceinline__ float bfhi(unsigned w) { return __uint_as_float(w & 0xffff0000u); }
typedef unsigned v4u __attribute__((ext_vector_type(4)));
typedef unsigned v2u __attribute__((ext_vector_type(2)));

struct Args { const float* in[35]; float* out; unsigned char* ws; int lo, hi; };

struct EpiF32Store {
    static constexpr bool PERM = false, AFTER_DRAIN = false;
    float* C; int ldc; int nvalid;
    __device__ __forceinline__ void operator()(const f32x4 (&acc)[2][2][4][2], const pg8::Unit& u, int wr, int wc, int fr, int fq) const {
        const int row0 = u.pm * 256 + wr * 64 + fr, col0 = u.pn * 256 + wc * 32 + 4 * fq;
#pragma unroll
        for (int ai = 0; ai < 2; ++ai)
#pragma unroll
            for (int m = 0; m < 4; ++m) { float* rowp = C + (size_t)(row0 + ai * 128 + m * 16) * ldc + col0;
#pragma unroll
                for (int bj = 0; bj < 2; ++bj)
#pragma unroll
                    for (int n = 0; n < 2; ++n) if (col0 + bj * 128 + n * 16 < nvalid) *(f32x4*)(rowp + bj * 128 + n * 16) = acc[ai][bj][m][n]; }
    }
};
struct EpiResid {
    static constexpr bool PERM = false, AFTER_DRAIN = false;
    const float* base; float* out;
    __device__ __forceinline__ void operator()(const f32x4 (&acc)[2][2][4][2], const pg8::Unit& u, int wr, int wc, int fr, int fq) const {
        const int row0 = u.pm * 256 + wr * 64 + fr, col0 = u.pn * 256 + wc * 32 + 4 * fq;
#pragma unroll
        for (int ai = 0; ai < 2; ++ai)
#pragma unroll
            for (int m = 0; m < 4; ++m) { const size_t off = (size_t)(row0 + ai * 128 + m * 16) * D + col0;
#pragma unroll
                for (int bj = 0; bj < 2; ++bj)
#pragma unroll
                    for (int n = 0; n < 2; ++n) { const f32x4 b = *(const f32x4*)(base + off + bj * 128 + n * 16); *(f32x4*)(out + off + bj * 128 + n * 16) = b + acc[ai][bj][m][n]; } }
    }
};
struct EpiSiluMul {
    static constexpr bool PERM = false, AFTER_DRAIN = false;
    bf16_t* HIDp;
    __device__ __forceinline__ void operator()(const f32x4 (&acc)[2][2][4][2], const pg8::Unit& u, int wr, int wc, int fr, int fq) const {
        const int pnl = u.pn % 22;
        const int row0 = u.pm * 256 + wr * 64 + fr, col0 = pnl * 128 + wc * 32 + 4 * fq;
#pragma unroll
        for (int ai = 0; ai < 2; ++ai)
#pragma unroll
            for (int m = 0; m < 4; ++m) { bf16_t* rowp = HIDp + (size_t)(row0 + ai * 128 + m * 16) * DE + col0;
#pragma unroll
                for (int n = 0; n < 2; ++n) { const f32x4 g = acc[ai][0][m][n], up = acc[ai][1][m][n]; float h[4];
#pragma unroll
                    for (int j = 0; j < 4; ++j) h[j] = g[j] / (1.0f + __expf(-g[j])) * up[j];
                    v2u w; w.x = pk2(h[0], h[1]); w.y = pk2(h[2], h[3]); *(v2u*)(rowp + n * 16) = w; } }
    }
};
struct EpiYE {
    static constexpr bool PERM = true, AFTER_DRAIN = false;
    const float* GATE; bf16_t* YE;
    __device__ __forceinline__ void operator()(const f32x4 (&acc)[2][2][4][2], const pg8::Unit& u, int wr, int wc, int fr, int fq) const {
        const int pnl = u.pn & 3;
        const int row0 = u.pm * 256 + wr * 64 + fr, col0 = pnl * 256 + wc * 32 + 8 * fq;
#pragma unroll
        for (int ai = 0; ai < 2; ++ai)
#pragma unroll
            for (int m = 0; m < 4; ++m) { const int row = row0 + ai * 128 + m * 16; const float gt_ = GATE[row]; bf16_t* rowp = YE + (size_t)row * D + col0;
#pragma unroll
                for (int bj = 0; bj < 2; ++bj) { const f32x4 v0 = acc[ai][bj][m][0] * gt_, v1 = acc[ai][bj][m][1] * gt_;
                    v4u w; w.x = pg8::cvt_pk_bf16(v0[0], v0[1]); w.y = pg8::cvt_pk_bf16(v0[2], v0[3]); w.z = pg8::cvt_pk_bf16(v1[0], v1[1]); w.w = pg8::cvt_pk_bf16(v1[2], v1[3]);
                    *(v4u*)(rowp + bj * 128) = w; } }
    }
};
struct EpiBf16Store {
    static constexpr bool PERM = true, AFTER_DRAIN = false;
    bf16_t* O; int ldc; float scale;
    __device__ __forceinline__ void operator()(const f32x4 (&acc)[2][2][4][2], const pg8::Unit& u, int wr, int wc, int fr, int fq) const {
        const int row0 = u.pm * 256 + wr * 64 + fr, col0 = u.pn * 256 + wc * 32 + 8 * fq;
#pragma unroll
        for (int ai = 0; ai < 2; ++ai)
#pragma unroll
            for (int m = 0; m < 4; ++m) { bf16_t* rowp = O + (size_t)(row0 + ai * 128 + m * 16) * ldc + col0;
#pragma unroll
                for (int bj = 0; bj < 2; ++bj) { const f32x4 v0 = acc[ai][bj][m][0] * scale, v1 = acc[ai][bj][m][1] * scale;
                    v4u w; w.x = pg8::cvt_pk_bf16(v0[0], v0[1]); w.y = pg8::cvt_pk_bf16(v0[2], v0[3]); w.z = pg8::cvt_pk_bf16(v1[0], v1[1]); w.w = pg8::cvt_pk_bf16(v1[2], v1[3]);
                    *(v4u*)(rowp + bj * 128) = w; } }
    }
};
struct EpiKV {
    static constexpr bool PERM = false, AFTER_DRAIN = false;
    bf16_t* K; bf16_t* Vt;
    __device__ __forceinline__ void operator()(const f32x4 (&acc)[2][2][4][2], const pg8::Unit& u, int wr, int wc, int fr, int fq) const {
        const int row0 = u.pm * 256 + wr * 64 + fr, col0 = u.pn * 256 + wc * 32 + 4 * fq;
#pragma unroll
        for (int ai = 0; ai < 2; ++ai)
#pragma unroll
            for (int m = 0; m < 4; ++m) { const int row = row0 + ai * 128 + m * 16;
#pragma unroll
                for (int bj = 0; bj < 2; ++bj)
#pragma unroll
                    for (int n = 0; n < 2; ++n) { const int col = col0 + bj * 128 + n * 16; const f32x4 v = acc[ai][bj][m][n];
                        if (col < 1024) { v2u w; w.x = pk2(v[0], v[1]); w.y = pk2(v[2], v[3]); *(v2u*)(K + (size_t)row * 1024 + col) = w; }
                        else { const int b = row >> 8, mm = row & 255; bf16_t* vp = Vt + ((size_t)(b * 1024 + (col - 1024)) * 256 + mm);
#pragma unroll
                            for (int j = 0; j < 4; ++j) vp[(size_t)j * 256] = (bf16_t)f2bf(v[j]); } } }
    }
};

constexpr float QSCALE = 0.125f * 1.4426950408889634f;
struct EpiEven {
    static constexpr bool PERM = true, AFTER_DRAIN = false;
    const float* rc; const float* rs; bf16_t* QhA; bf16_t* KhA; bf16_t* QhB; bf16_t* KhB; bf16_t* PVb;
    __device__ __forceinline__ void operator()(const f32x4 (&acc)[2][2][4][2], const pg8::Unit& u, int wr, int wc, int fr, int fq) const {
        asm volatile("" : "+v"(fr), "+v"(fq));
        const int row0 = u.pm * 256 + wr * 64 + fr;
#pragma unroll
        for (int bj = 0; bj < 2; ++bj) {
            const int c0 = u.pn * 256 + bj * 128 + wc * 32 + 8 * fq;
            int kind; bf16_t* base; int stride; float sc = 1.0f;
            if (c0 < 512) { kind = 0; base = QhA + ((size_t)(c0 >> 6) * T) * 64 + (c0 & 63); stride = 64; sc = QSCALE; }
            else if (c0 < 1024) { kind = 0; base = KhA + ((size_t)((c0 - 512) >> 6) * T) * 64 + (c0 & 63); stride = 64; }
            else if (c0 < 1536) { kind = 1; base = PVb + (c0 - 1024); stride = 640; }
            else if (c0 < 2048) { kind = 0; base = QhB + ((size_t)((c0 - 1536) >> 6) * T) * 64 + (c0 & 63); stride = 64; sc = QSCALE; }
            else if (c0 < 2176) { kind = 0; base = KhB + ((size_t)((c0 - 2048) >> 6) * T) * 64 + (c0 & 63); stride = 64; }
            else { kind = 1; base = PVb + 512 + (c0 - 2176); stride = 640; }
            const int pi = (c0 & 63) >> 1;
#pragma unroll
            for (int ai = 0; ai < 2; ++ai)
#pragma unroll
                for (int m = 0; m < 4; ++m) {
                    const int tok = row0 + ai * 128 + m * 16;
                    const f32x4 v0 = acc[ai][bj][m][0], v1 = acc[ai][bj][m][1];
                    float y[8];
                    if (kind == 0) {
                        const int s = tok & (S - 1);
                        const f32x4 c4 = *(const f32x4*)(rc + s * 32 + pi), s4 = *(const f32x4*)(rs + s * 32 + pi);
                        y[0] = (v0[0] * c4[0] - v0[1] * s4[0]) * sc; y[1] = (v0[1] * c4[0] + v0[0] * s4[0]) * sc;
                        y[2] = (v0[2] * c4[1] - v0[3] * s4[1]) * sc; y[3] = (v0[3] * c4[1] + v0[2] * s4[1]) * sc;
                        y[4] = (v1[0] * c4[2] - v1[1] * s4[2]) * sc; y[5] = (v1[1] * c4[2] + v1[0] * s4[2]) * sc;
                        y[6] = (v1[2] * c4[3] - v1[3] * s4[3]) * sc; y[7] = (v1[3] * c4[3] + v1[2] * s4[3]) * sc;
                    } else { y[0] = v0[0]; y[1] = v0[1]; y[2] = v0[2]; y[3] = v0[3]; y[4] = v1[0]; y[5] = v1[1]; y[6] = v1[2]; y[7] = v1[3]; }
                    v4u w; w.x = pk2(y[0], y[1]); w.y = pk2(y[2], y[3]); w.z = pk2(y[4], y[5]); w.w = pk2(y[6], y[7]);
                    *(v4u*)(base + (size_t)tok * stride) = w;
                }
        }
    }
};

struct EpiLora {
    static constexpr bool PERM = false, AFTER_DRAIN = false;
    const float *w0, *a0, *k_a; const bf16_t *KB, *KK; bf16_t *LW, *KD, *BB, *G;
    __device__ __forceinline__ void operator()(const f32x4 (&acc)[2][2][4][2], const pg8::Unit& u, int wr, int wc, int fr, int fq) const {
        asm volatile("" : "+v"(fr), "+v"(fq));
        const int row0 = u.pm * 256 + wr * 64 + fr;
#pragma unroll
        for (int bj = 0; bj < 2; ++bj)
#pragma unroll
            for (int n = 0; n < 2; ++n) {
                const int c0 = u.pn * 256 + bj * 128 + wc * 32 + n * 16 + 4 * fq, sec = c0 >> 9, cc = c0 & 511;
#pragma unroll
                for (int ai = 0; ai < 2; ++ai)
#pragma unroll
                    for (int m = 0; m < 4; ++m) {
                        const size_t tok = row0 + ai * 128 + m * 16;
                        const f32x4 v = acc[ai][bj][m][n];
                        if (sec < 2) {
                            const f32x4 w = *(const f32x4*)(w0 + sec * 512 + cc); float o[4];
#pragma unroll
                            for (int j = 0; j < 4; ++j) { const float xw = -(w[j] + v[j]);
                                o[j] = -0.6065306597126334f / (1.0f + __expf(xw)); }
                            v2u ww; ww.x = pk2(o[0], o[1]); ww.y = pk2(o[2], o[3]);
                            *(v2u*)(LW + ((size_t)sec * T + tok) * 512 + cc) = ww;
                        } else if (sec < 4) {
                            const int d = sec - 2;
                            const f32x4 a_ = *(const f32x4*)(a0 + d * 512 + cc), ka = *(const f32x4*)(k_a + cc);
                            const v2u kw = *(const v2u*)(KB + tok * 512 + cc), kkw = *(const v2u*)(KK + tok * 512 + cc);
                            const float kv[4] = {bflo(kw.x), bfhi(kw.x), bflo(kw.y), bfhi(kw.y)}, kk[4] = {bflo(kkw.x), bfhi(kkw.x), bflo(kkw.y), bfhi(kkw.y)};
                            float okd[4], obb[4];
#pragma unroll
                            for (int j = 0; j < 4; ++j) { const float alr = 1.0f / (1.0f + __expf(-(a_[j] + v[j]))); okd[j] = kv[j] * (1.0f + (alr - 1.0f) * ka[j]); obb[j] = kk[j] * alr; }
                            v2u w1, w2_; w1.x = pk2(okd[0], okd[1]); w1.y = pk2(okd[2], okd[3]); w2_.x = pk2(obb[0], obb[1]); w2_.y = pk2(obb[2], obb[3]);
                            *(v2u*)(KD + ((size_t)d * T + tok) * 512 + cc) = w1; *(v2u*)(BB + ((size_t)d * T + tok) * 512 + cc) = w2_;
                        } else { v2u ww; ww.x = pk2(v[0], v[1]); ww.y = pk2(v[2], v[3]); *(v2u*)(G + tok * 512 + cc) = ww; }
                        __builtin_amdgcn_sched_barrier(0);
                    }
            }
    }
};
struct MoeOrder {
    int G, c, npairs;
    int per;
    __device__ __forceinline__ bool next(int i, pg8::Unit& u) const {
        const int x = c & 7, y = c >> 3, pml = y & 7, pnq = y >> 3;
        const int epn = i * 32 + x * 4 + pnq;
        if (epn >= npairs || c >= 256) return false;
        const int e = epn / per;
        u.pm = e * 8 + pml; u.pn = epn; return true;
    }
    __device__ __forceinline__ void a_ready(const pg8::Unit&) const {}
    __device__ __forceinline__ void done(const pg8::Unit&) const {}
};

template <class RowMap>
__device__ __forceinline__ void transpose_item(const float* W, int K, int N, bf16_t* WT, RowMap rm, LAS float* scr, int item, int lane) {
    const int nblk = N / 32, kb = item / nblk, nb_ = item % nblk, k0 = 64 * kb, n0 = 32 * nb_;
#pragma unroll 8
    for (int i = 0; i < 32; ++i) { const int kk = 2 * i + (lane >> 5); scr[kk * 33 + (lane & 31)] = W[(size_t)(k0 + kk) * N + n0 + (lane & 31)]; }
    asm volatile("s_waitcnt lgkmcnt(0)" ::: "memory");
    const int c = lane & 7;
#pragma unroll
    for (int j = 0; j < 4; ++j) { const int n = (lane >> 3) + 8 * j; const LAS float* s = scr + (8 * c) * 33 + n; const int rbase = rm(n0 + n) - n;
        v4u o; o.x = pk2(s[0 * 33], s[1 * 33]); o.y = pk2(s[2 * 33], s[3 * 33]); o.z = pk2(s[4 * 33], s[5 * 33]); o.w = pk2(s[6 * 33], s[7 * 33]);
        *(v4u*)(WT + (size_t)(rbase + n) * K + k0 + 8 * c) = o; }
    asm volatile("s_waitcnt lgkmcnt(0)" ::: "memory");
}

__device__ __forceinline__ void rmsnorm_rows_bf16(const float* x, const float* g, bf16_t* out, int M) {
    const int tix_ = tidx(); const int lane = tix_ & 63, gw = blockIdx.x * 8 + (tix_ >> 6), ngw = gridDim.x * 8;
    for (int m = gw; m < M; m += ngw) {
        const float4* xr = (const float4*)(x + (size_t)m * D);
        float4 v[4]; float s = 0.f;
#pragma unroll
        for (int j = 0; j < 4; ++j) { v[j] = xr[lane + 64 * j]; s += v[j].x * v[j].x + v[j].y * v[j].y + v[j].z * v[j].z + v[j].w * v[j].w; }
        const float r = rsqrtf(wave_sum(s) * (1.0f / D) + 1e-6f);
        v2u* o = (v2u*)(out + (size_t)m * D);
#pragma unroll
        for (int j = 0; j < 4; ++j) { const float4 gg = ((const float4*)g)[lane + 64 * j];
            v2u w; w.x = pk2(v[j].x * r * gg.x, v[j].y * r * gg.y); w.y = pk2(v[j].z * r * gg.z, v[j].w * r * gg.w); o[lane + 64 * j] = w; }
    }
}
__device__ __forceinline__ void rmsnorm_rows_f32(const float* x, const float* g, float* out, int M) {
    const int tix_ = tidx(); const int lane = tix_ & 63, gw = blockIdx.x * 8 + (tix_ >> 6), ngw = gridDim.x * 8;
    for (int m = gw; m < M; m += ngw) {
        const float4* xr = (const float4*)(x + (size_t)m * D);
        float4 v[4]; float s = 0.f;
#pragma unroll
        for (int j = 0; j < 4; ++j) { v[j] = xr[lane + 64 * j]; s += v[j].x * v[j].x + v[j].y * v[j].y + v[j].z * v[j].z + v[j].w * v[j].w; }
        const float r = rsqrtf(wave_sum(s) * (1.0f / D) + 1e-6f);
        float4* o = (float4*)(out + (size_t)m * D);
#pragma unroll
        for (int j = 0; j < 4; ++j) { const float4 gg = ((const float4*)g)[lane + 64 * j];
            o[lane + 64 * j] = make_float4(v[j].x * r * gg.x, v[j].y * r * gg.y, v[j].z * r * gg.z, v[j].w * r * gg.w); }
    }
}

__device__ __forceinline__ int block_exscan(int v, int* sh, int* tot) {
    const int tid = tidx(), lane = tid & 63, w = tid >> 6;
    int inc = v;
#pragma unroll
    for (int o = 1; o < 64; o <<= 1) { const int t = __shfl_up(inc, o); if (lane >= o) inc += t; }
    __syncthreads();
    if (lane == 63) sh[w] = inc;
    __syncthreads();
    int base = 0, total = 0;
#pragma unroll
    for (int i = 0; i < 8; ++i) { const int x = sh[i]; if (i < w) base += x; total += x; }
    *tot = total;
    return base + inc - v;
}


typedef short bf16x8 __attribute__((ext_vector_type(8)));
typedef float f32x16 __attribute__((ext_vector_type(16)));
constexpr int MROW = 144;
constexpr int MBUF = 64 * MROW;
__device__ __forceinline__ bf16x8 frag_rm(const LAS unsigned char* M, int row0, int k0, int fr, int fq) {
    return *(const LAS bf16x8*)(M + (row0 + fr) * MROW + (k0 + 8 * fq) * 2);
}
__device__ __forceinline__ bf16x8 frag_cm(const LAS unsigned char* M, int k0, int col0, int fr, int fq) {
    const LAS unsigned short* p = (const LAS unsigned short*)(M + (k0 + 8 * fq) * MROW + (col0 + fr) * 2);
    bf16x8 v;
#pragma unroll
    for (int j = 0; j < 8; ++j) v[j] = (short)p[j * (MROW / 2)];
    return v;
}
__device__ __forceinline__ void tile_store_bf16(LAS unsigned char* M, int m0, int n0, int fr, int fq, const f32x4& c) {
    v2u w; w.x = pk2(c[0], c[1]); w.y = pk2(c[2], c[3]);
    *(LAS v2u*)(M + (m0 + fr) * MROW + (n0 + 4 * fq) * 2) = w;
}
#define MMA16(acc, lf, rf) acc = __builtin_amdgcn_mfma_f32_16x16x32_bf16(rf, lf, acc, 0, 0, 0)

__device__ __forceinline__ void scan_r1(const bf16_t* LWg, const bf16_t* RVg, const bf16_t* KDg, const bf16_t* KKg, const bf16_t* BBg,
                                        bf16_t* PT, bf16_t* QT, bf16_t* RH, float* YL, unsigned char* lds_raw) {
    LAS unsigned char* L = (LAS unsigned char*)lds_raw;
    LAS unsigned char* mAT = L + 0 * MBUF; LAS unsigned char* mRT = L + 1 * MBUF; LAS unsigned char* mBT = L + 2 * MBUF; LAS unsigned char* mKT = L + 3 * MBUF;
    LAS unsigned char* mV = L + 4 * MBUF; LAS unsigned char* mN0 = L + 5 * MBUF; LAS unsigned char* mN1 = L + 6 * MBUF; LAS unsigned char* mNAK = L + 7 * MBUF;
    LAS unsigned char* mNRB = L + 8 * MBUF; LAS unsigned char* mNRK = L + 9 * MBUF; LAS unsigned char* mT0 = L + 10 * MBUF; LAS unsigned char* mT1 = L + 11 * MBUF;
    LAS unsigned char* mW = L + 12 * MBUF;
    LAS float* LWs = (LAS float*)(L + 13 * MBUF);
    const int tid = tidx(), lane = tid & 63, wave = tid >> 6, fr = lane & 15, fq = lane >> 4;
    const int tm = wave >> 1, tn0 = (wave & 1) * 2;
    const int m0 = tm * 16;
    for (int item = blockIdx.x; item < 4096; item += gridDim.x) {
        const int c = item & 127, h = (item >> 7) & 7, n = item >> 10, dir = n >> 1, b = n & 1;
        const int t = tid >> 3, i0 = (tid & 7) * 8;
        const int pos = dir ? (S - 1 - (c * 64 + t)) : (c * 64 + t);
        const size_t tok = (size_t)b * S + pos;
        const size_t ch = (size_t)h * 64 + i0;
        const v4u lw4 = *(const v4u*)(LWg + ((size_t)dir * T + tok) * 512 + ch);
        const v4u r4 = *(const v4u*)(RVg + tok * D + ch), v4 = *(const v4u*)(RVg + tok * D + 512 + ch);
        const v4u kd4 = *(const v4u*)(KDg + ((size_t)dir * T + tok) * 512 + ch), kk4 = *(const v4u*)(KKg + tok * 512 + ch), bb4 = *(const v4u*)(BBg + ((size_t)dir * T + tok) * 512 + ch);
        float lw[8], Lin[8];
#pragma unroll
        for (int q = 0; q < 4; ++q) { lw[2 * q] = bflo(lw4[q]); lw[2 * q + 1] = bfhi(lw4[q]); }
#pragma unroll
        for (int j = 0; j < 8; ++j) { float x = lw[j];
#pragma unroll
            for (int o = 8; o < 64; o <<= 1) { const float y = __shfl_up(x, o); if (lane >= o) x += y; }
            Lin[j] = x; }
        __syncthreads();
        if (lane >= 56) {
#pragma unroll
            for (int j = 0; j < 8; ++j) LWs[64 + wave * 64 + i0 + j] = Lin[j]; }
        __syncthreads();
        {
            float off[8];
#pragma unroll
            for (int j = 0; j < 8; ++j) off[j] = 0.f;
            for (int w = 0; w < 8; ++w) { if (w < wave) {
#pragma unroll
                for (int j = 0; j < 8; ++j) off[j] += LWs[64 + w * 64 + i0 + j]; } }
#pragma unroll
            for (int j = 0; j < 8; ++j) Lin[j] += off[j];
            if (t == 63) {
#pragma unroll
                for (int j = 0; j < 8; ++j) LWs[i0 + j] = Lin[j]; }
            float at_[8], rt_[8], bt_[8], kt_[8];
#pragma unroll
            for (int q = 0; q < 4; ++q) {
#pragma unroll
                for (int e = 0; e < 2; ++e) { const int j = 2 * q + e;
                    const float ein = __expf(Lin[j]), einv = __expf(-Lin[j]), eex = __expf(Lin[j] - lw[j]);
                    const float kkv = e ? bfhi(kk4[q]) : bflo(kk4[q]), rv_ = e ? bfhi(r4[q]) : bflo(r4[q]), bbv = e ? bfhi(bb4[q]) : bflo(bb4[q]), kdv = e ? bfhi(kd4[q]) : bflo(kd4[q]);
                    at_[j] = -kkv * eex; rt_[j] = rv_ * ein; bt_[j] = bbv * einv; kt_[j] = kdv * einv; }
            }
            v4u w;
            w.x = pk2(at_[0], at_[1]); w.y = pk2(at_[2], at_[3]); w.z = pk2(at_[4], at_[5]); w.w = pk2(at_[6], at_[7]); *(LAS v4u*)(mAT + t * MROW + i0 * 2) = w;
            w.x = pk2(rt_[0], rt_[1]); w.y = pk2(rt_[2], rt_[3]); w.z = pk2(rt_[4], rt_[5]); w.w = pk2(rt_[6], rt_[7]); *(LAS v4u*)(mRT + t * MROW + i0 * 2) = w;
            w.x = pk2(bt_[0], bt_[1]); w.y = pk2(bt_[2], bt_[3]); w.z = pk2(bt_[4], bt_[5]); w.w = pk2(bt_[6], bt_[7]); *(LAS v4u*)(mBT + t * MROW + i0 * 2) = w;
            w.x = pk2(kt_[0], kt_[1]); w.y = pk2(kt_[2], kt_[3]); w.z = pk2(kt_[4], kt_[5]); w.w = pk2(kt_[6], kt_[7]); *(LAS v4u*)(mKT + t * MROW + i0 * 2) = w;
            *(LAS v4u*)(mV + t * MROW + i0 * 2) = v4;
        }
        __syncthreads();
        f32x4 Tacc[2];
        {
            bf16x8 la[2], lr[2];
#pragma unroll
            for (int ks = 0; ks < 2; ++ks) { la[ks] = frag_rm(mAT, m0, 32 * ks, fr, fq); lr[ks] = frag_rm(mRT, m0, 32 * ks, fr, fq); }
#pragma unroll
            for (int q = 0; q < 2; ++q) {
                const int n0 = (tn0 + q) * 16;
                f32x4 cab = {0.f, 0.f, 0.f, 0.f}, cak = cab, crb = cab, crk = cab;
#pragma unroll
                for (int ks = 0; ks < 2; ++ks) {
                    const bf16x8 rb_ = frag_rm(mBT, n0, 32 * ks, fr, fq), rk_ = frag_rm(mKT, n0, 32 * ks, fr, fq);
                    MMA16(cab, la[ks], rb_); MMA16(cak, la[ks], rk_); MMA16(crb, lr[ks], rb_); MMA16(crk, lr[ks], rk_);
                }
                const int tt = m0 + fr;
#pragma unroll
                for (int j = 0; j < 4; ++j) { const int ss = n0 + 4 * fq + j;
                    if (!(ss < tt)) { cab[j] = 0.f; cak[j] = 0.f; }
                    if (!(ss <= tt)) { crb[j] = 0.f; crk[j] = 0.f; } }
                tile_store_bf16(mN0, m0, n0, fr, fq, cab); tile_store_bf16(mNAK, m0, n0, fr, fq, cak);
                tile_store_bf16(mNRB, m0, n0, fr, fq, crb); tile_store_bf16(mNRK, m0, n0, fr, fq, crk);
#pragma unroll
                for (int j = 0; j < 4; ++j) cab[j] += ((n0 + 4 * fq + j) == tt) ? 1.f : 0.f;
                Tacc[q] = cab;
                tile_store_bf16(mT0, m0, n0, fr, fq, cab);
            }
        }
        __syncthreads();
        {
            bf16x8 lk[2], ln_[2];
#pragma unroll
            for (int ks = 0; ks < 2; ++ks) { lk[ks] = frag_rm(mNAK, m0, 32 * ks, fr, fq); ln_[ks] = frag_rm(mN0, m0, 32 * ks, fr, fq); }
#pragma unroll
            for (int q = 0; q < 2; ++q) {
                const int n0 = (tn0 + q) * 16;
                f32x4 cw = {0.f, 0.f, 0.f, 0.f}, cn = cw;
#pragma unroll
                for (int ks = 0; ks < 2; ++ks) { MMA16(cw, lk[ks], frag_cm(mV, 32 * ks, n0, fr, fq)); MMA16(cn, ln_[ks], frag_cm(mN0, 32 * ks, n0, fr, fq)); }
                tile_store_bf16(mW, m0, n0, fr, fq, cw); tile_store_bf16(mN1, m0, n0, fr, fq, cn);
            }
        }
        __syncthreads();
#pragma unroll
        for (int k = 1; k <= 5; ++k) {
            LAS unsigned char* Nk = (k & 1) ? mN1 : mN0; LAS unsigned char* Nn = (k & 1) ? mN0 : mN1;
            LAS unsigned char* Tk = ((k - 1) & 1) ? mT1 : mT0; LAS unsigned char* Tn = ((k - 1) & 1) ? mT0 : mT1;
            bf16x8 lt[2], ln_[2];
#pragma unroll
            for (int ks = 0; ks < 2; ++ks) { lt[ks] = frag_rm(Tk, m0, 32 * ks, fr, fq); ln_[ks] = frag_rm(Nk, m0, 32 * ks, fr, fq); }
#pragma unroll
            for (int q = 0; q < 2; ++q) {
                const int n0 = (tn0 + q) * 16;
                f32x4 cn = {0.f, 0.f, 0.f, 0.f};
#pragma unroll
                for (int ks = 0; ks < 2; ++ks) { const bf16x8 rn = frag_cm(Nk, 32 * ks, n0, fr, fq); MMA16(Tacc[q], lt[ks], rn); if (k < 5) MMA16(cn, ln_[ks], rn); }
                tile_store_bf16(Tn, m0, n0, fr, fq, Tacc[q]);
                if (k < 5) tile_store_bf16(Nn, m0, n0, fr, fq, cn);
            }
            __syncthreads();
        }
        {
            bf16x8 lt[2];
#pragma unroll
            for (int ks = 0; ks < 2; ++ks) lt[ks] = frag_rm(mT1, m0, 32 * ks, fr, fq);
#pragma unroll
            for (int q = 0; q < 2; ++q) {
                const int n0 = (tn0 + q) * 16;
                f32x4 ca = {0.f, 0.f, 0.f, 0.f}, cu = ca;
#pragma unroll
                for (int ks = 0; ks < 2; ++ks) { MMA16(ca, lt[ks], frag_cm(mAT, 32 * ks, n0, fr, fq)); MMA16(cu, lt[ks], frag_cm(mW, 32 * ks, n0, fr, fq)); }
                tile_store_bf16(mN0, m0, n0, fr, fq, ca); tile_store_bf16(mT0, m0, n0, fr, fq, cu);
            }
        }
        __syncthreads();
        LAS unsigned char* mAH = mN0; LAS unsigned char* mUL = mT0;
        {
            bf16x8 lrb[2], lrk[2];
#pragma unroll
            for (int ks = 0; ks < 2; ++ks) { lrb[ks] = frag_rm(mNRB, m0, 32 * ks, fr, fq); lrk[ks] = frag_rm(mNRK, m0, 32 * ks, fr, fq); }
#pragma unroll 1
            for (int q = 0; q < 2; ++q) {
                const int n0 = (tn0 + q) * 16;
                f32x4 crh = {0.f, 0.f, 0.f, 0.f}, cyl = crh;
#pragma unroll
                for (int ks = 0; ks < 2; ++ks) {
                    const bf16x8 ra = frag_cm(mAH, 32 * ks, n0, fr, fq); MMA16(crh, lrb[ks], ra);
                    const bf16x8 ru = frag_cm(mUL, 32 * ks, n0, fr, fq); MMA16(cyl, lrb[ks], ru);
                    const bf16x8 rv = frag_cm(mV, 32 * ks, n0, fr, fq); MMA16(cyl, lrk[ks], rv);
                }
                const size_t o = (size_t)item * 4096 + (size_t)(m0 + fr) * 64 + n0 + 4 * fq;
                { const LAS unsigned short* rp = (const LAS unsigned short*)(mRT + (m0 + fr) * MROW + (n0 + 4 * fq) * 2);
#pragma unroll
                  for (int j = 0; j < 4; ++j) crh[j] += __uint_as_float(((unsigned)rp[j]) << 16); }
                { v2u w; w.x = pk2(crh[0], crh[1]); w.y = pk2(crh[2], crh[3]); *(v2u*)(RH + o) = w; }
                *(f32x4*)(YL + o) = cyl;
            }
        }
        {
            bf16x8 lb[2], lkt[2];
#pragma unroll
            for (int ks = 0; ks < 2; ++ks) { lb[ks] = frag_cm(mBT, 32 * ks, m0, fr, fq); lkt[ks] = frag_cm(mKT, 32 * ks, m0, fr, fq); }
            const float wc = __expf(LWs[m0 + fr]);
#pragma unroll 1
            for (int q = 0; q < 2; ++q) {
                const int n0 = (tn0 + q) * 16;
                f32x4 cp = {0.f, 0.f, 0.f, 0.f}, cq = cp;
#pragma unroll
                for (int ks = 0; ks < 2; ++ks) {
                    const bf16x8 ra = frag_cm(mAH, 32 * ks, n0, fr, fq); MMA16(cp, lb[ks], ra);
                    const bf16x8 ru = frag_cm(mUL, 32 * ks, n0, fr, fq); MMA16(cq, lb[ks], ru);
                    const bf16x8 rv = frag_cm(mV, 32 * ks, n0, fr, fq); MMA16(cq, lkt[ks], rv);
                }
                const size_t o = (size_t)item * 4096 + (size_t)(m0 + fr) * 64 + n0 + 4 * fq;
#pragma unroll
                for (int j = 0; j < 4; ++j) { cp[j] = wc * (cp[j] + (((n0 + 4 * fq + j) == (m0 + fr)) ? 1.f : 0.f)); cq[j] *= wc; }
                { v2u w; w.x = pk2(cp[0], cp[1]); w.y = pk2(cp[2], cp[3]); *(v2u*)(PT + o) = w; }
                { v2u w; w.x = pk2(cq[0], cq[1]); w.y = pk2(cq[2], cq[3]); *(v2u*)(QT + o) = w; }
            }
        }
    }
}

__device__ __forceinline__ bf16x8 pack_acc8(const f32x16& x, int s) {
    v4u p; p.x = pk2(x[8 * s], x[8 * s + 1]); p.y = pk2(x[8 * s + 2], x[8 * s + 3]); p.z = pk2(x[8 * s + 4], x[8 * s + 5]); p.w = pk2(x[8 * s + 6], x[8 * s + 7]);
    return __builtin_bit_cast(bf16x8, p);
}
__device__ __forceinline__ void scan_r2(const bf16_t* PT, const bf16_t* QT, bf16_t* S0, unsigned char* lds_raw) {
    LAS unsigned char* L = (LAS unsigned char*)lds_raw;
    constexpr int SLOT_B = MBUF + 8192;
    const int tid = tidx(), lane = tid & 63, wave = tid >> 6;
    const int r = lane & 31, h2 = lane >> 5, jb = wave;
    f32x16 st[2];
#pragma unroll
    for (int ib = 0; ib < 2; ++ib)
#pragma unroll
        for (int g = 0; g < 16; ++g) st[ib][g] = 0.f;
    const size_t item0 = (size_t)blockIdx.x * 128;
    v4u stage[16];
#pragma unroll
    for (int q = 0; q < 16; ++q) { const int p = tid + 512 * q, cc = p >> 10, w = p & 1023, mat = w >> 9, idx = w & 511;
        stage[q] = *(const v4u*)((mat ? QT : PT) + (item0 + cc) * 4096 + idx * 8); }
    for (int grp = 0; grp < 16; ++grp) {
        __syncthreads();
#pragma unroll
        for (int q = 0; q < 16; ++q) { const int p = tid + 512 * q, cc = p >> 10, w = p & 1023, mat = w >> 9, idx = w & 511;
            *(LAS v4u*)(L + cc * SLOT_B + (mat ? (MBUF + idx * 16) : ((idx >> 3) * MROW + (idx & 7) * 16))) = stage[q]; }
        __syncthreads();
        if (grp < 15) {
#pragma unroll
            for (int q = 0; q < 16; ++q) { const int p = tid + 512 * q, cc = p >> 10, w = p & 1023, mat = w >> 9, idx = w & 511;
                stage[q] = *(const v4u*)((mat ? QT : PT) + (item0 + (grp + 1) * 8 + cc) * 4096 + idx * 8); }
        }
        if (wave < 2) {
#pragma unroll 1
            for (int cc = 0; cc < 8; ++cc) {
                const size_t item = item0 + grp * 8 + cc;
                const LAS unsigned char* Pm = L + cc * SLOT_B; const LAS unsigned char* Qm = Pm + MBUF;
                bf16_t* sp = S0 + item * 4096 + (size_t)(32 * jb + r) * 64;
#pragma unroll
                for (int ib = 0; ib < 2; ++ib)
#pragma unroll
                    for (int g = 0; g < 4; ++g) { v2u w; w.x = pk2(st[ib][4 * g], st[ib][4 * g + 1]); w.y = pk2(st[ib][4 * g + 2], st[ib][4 * g + 3]); *(v2u*)(sp + 32 * ib + 8 * g + 4 * h2) = w; }
                f32x16 nw[2];
#pragma unroll
                for (int ib = 0; ib < 2; ++ib)
#pragma unroll
                    for (int g = 0; g < 16; ++g) nw[ib][g] = __uint_as_float(((unsigned)*(const LAS unsigned short*)(Qm + (32 * ib + (g & 3) + 8 * (g >> 2) + 4 * h2) * 128 + (32 * jb + r) * 2)) << 16);
#pragma unroll
                for (int kb = 0; kb < 2; ++kb)
#pragma unroll
                    for (int s2 = 0; s2 < 2; ++s2) {
                        const bf16x8 bfr = pack_acc8(st[kb], s2);
#pragma unroll
                        for (int ib = 0; ib < 2; ++ib) {
                            const LAS unsigned char* ap = Pm + (32 * ib + r) * MROW + (32 * kb + 16 * s2 + 4 * h2) * 2;
                            const v2u lo = *(const LAS v2u*)ap, hi = *(const LAS v2u*)(ap + 16);
                            v4u av; av.x = lo.x; av.y = lo.y; av.z = hi.x; av.w = hi.y;
                            nw[ib] = __builtin_amdgcn_mfma_f32_32x32x16_bf16(__builtin_bit_cast(bf16x8, av), bfr, nw[ib], 0, 0, 0);
                        }
                    }
                st[0] = nw[0]; st[1] = nw[1];
            }
        }
    }
}
__device__ __forceinline__ void scan_r3(const bf16_t* RH, const float* YL, const bf16_t* S0, const bf16_t* RVg, const bf16_t* KDg, const bf16_t* Gg,
                                        const float* r_k, const float* lng, const float* lnb, bf16_t* Y) {
    const int tid = tidx(), lane = tid & 63, wave = tid >> 6, fr = lane & 15, fq = lane >> 4;
    const int tmw = wave & 3;
    for (int it2 = blockIdx.x * 2 + (wave >> 2); it2 < 2048; it2 += gridDim.x * 2) {
        const int b = it2 >> 10, h = (it2 >> 7) & 7, pc = it2 & 127;
        f32x4 acc[4];
#pragma unroll
        for (int q = 0; q < 4; ++q) acc[q] = (f32x4){0.f, 0.f, 0.f, 0.f};
#pragma unroll 1
        for (int dirn = 0; dirn < 2; ++dirn) {
            const size_t item = (size_t)((dirn * 2 + b) * 8 + h) * 128 + (dirn ? 127 - pc : pc);
            const int row = dirn ? 63 - (16 * tmw + fr) : 16 * tmw + fr;
            const bf16_t* rp = RH + item * 4096 + (size_t)row * 64;
            bf16x8 lf[2];
#pragma unroll
            for (int ks = 0; ks < 2; ++ks) lf[ks] = *(const bf16x8*)(rp + 32 * ks + 8 * fq);
#pragma unroll
            for (int q = 0; q < 4; ++q) {
                const bf16_t* sp = S0 + item * 4096 + (size_t)(16 * q + fr) * 64;
#pragma unroll
                for (int ks = 0; ks < 2; ++ks) { const bf16x8 rf = *(const bf16x8*)(sp + 32 * ks + 8 * fq); MMA16(acc[q], lf[ks], rf); }
                acc[q] += *(const f32x4*)(YL + item * 4096 + (size_t)row * 64 + 16 * q + 4 * fq);
            }
        }
        float sm = 0.f;
#pragma unroll
        for (int q = 0; q < 4; ++q) sm += (acc[q][0] + acc[q][1]) + (acc[q][2] + acc[q][3]);
        sm += __shfl_xor(sm, 16); sm += __shfl_xor(sm, 32);
        const float mean = sm * (1.0f / 64.f);
        float sq = 0.f;
#pragma unroll
        for (int q = 0; q < 4; ++q)
#pragma unroll
            for (int j = 0; j < 4; ++j) { const float d = acc[q][j] - mean; sq += d * d; }
        sq += __shfl_xor(sq, 16); sq += __shfl_xor(sq, 32);
        const float rstd = rsqrtf(sq * (1.0f / 64.f) + 64e-5f);
        const size_t tok = (size_t)b * S + pc * 64 + 16 * tmw + fr;
        float bon = 0.f; f32x4 vv[4];
#pragma unroll
        for (int q = 0; q < 4; ++q) {
            const int c = h * 64 + 16 * q + 4 * fq;
            const v2u rw = *(const v2u*)(RVg + tok * D + c), k0 = *(const v2u*)(KDg + tok * 512 + c), k1 = *(const v2u*)(KDg + ((size_t)T + tok) * 512 + c), vw = *(const v2u*)(RVg + tok * D + 512 + c);
            const f32x4 rk4 = *(const f32x4*)(r_k + c);
            vv[q] = (f32x4){bflo(vw.x), bfhi(vw.x), bflo(vw.y), bfhi(vw.y)};
            bon += bflo(rw.x) * (bflo(k0.x) + bflo(k1.x)) * rk4[0] + bfhi(rw.x) * (bfhi(k0.x) + bfhi(k1.x)) * rk4[1] + bflo(rw.y) * (bflo(k0.y) + bflo(k1.y)) * rk4[2] + bfhi(rw.y) * (bfhi(k0.y) + bfhi(k1.y)) * rk4[3];
        }
        bon += __shfl_xor(bon, 16); bon += __shfl_xor(bon, 32);
#pragma unroll
        for (int q = 0; q < 4; ++q) {
            const int c = h * 64 + 16 * q + 4 * fq;
            const v2u gw_ = *(const v2u*)(Gg + tok * 512 + c); const f32x4 g4 = {bflo(gw_.x), bfhi(gw_.x), bflo(gw_.y), bfhi(gw_.y)}, lg = *(const f32x4*)(lng + c), lb = *(const f32x4*)(lnb + c);
            float o[4];
#pragma unroll
            for (int j = 0; j < 4; ++j) o[j] = ((acc[q][j] - mean) * rstd * lg[j] + lb[j] + bon * vv[q][j]) * g4[j];
            v2u w; w.x = pk2(o[0], o[1]); w.y = pk2(o[2], o[3]);
            *(v2u*)(Y + tok * D + 512 + c) = w;
        }
    }
}


__device__ __forceinline__ bf16x8 pack8(float a0, float a1, float a2, float a3, float a4, float a5, float a6, float a7) {
    v4u p; p.x = pk2(a0, a1); p.y = pk2(a2, a3); p.z = pk2(a4, a5); p.w = pk2(a6, a7);
    return __builtin_bit_cast(bf16x8, p);
}
#define MMA32(acc, af, bf_) acc = __builtin_amdgcn_mfma_f32_32x32x16_bf16(af, bf_, acc, 0, 0, 0)
__device__ __forceinline__ void xattn_mfma(const bf16_t* Qb, const bf16_t* Kb, const bf16_t* Vt, bf16_t* Y) {
    const int tix_ = tidx(); const int lane = tix_ & 63, r = lane & 31, h2 = lane >> 5;
    const int gw = blockIdx.x * 8 + (tix_ >> 6), ngw = gridDim.x * 8;
    for (int it = gw; it < 2048; it += ngw) {
        const int tile = it & 255, h = (it >> 8) & 3, b = it >> 10;
        const size_t tok = (size_t)b * S + tile * 32 + r;
        bf16x8 qf[16];
#pragma unroll
        for (int ks = 0; ks < 16; ++ks) qf[ks] = *(const bf16x8*)(Qb + tok * D + h * 256 + 16 * ks + 8 * h2);
        f32x16 st[8];
#pragma unroll
        for (int kb = 0; kb < 8; ++kb) {
#pragma unroll
            for (int g = 0; g < 16; ++g) st[kb][g] = 0.f;
            const bf16_t* kp = Kb + (size_t)(b * MEM + 32 * kb + r) * 1024 + h * 256 + 8 * h2;
#pragma unroll
            for (int ks = 0; ks < 16; ++ks) { const bf16x8 kf = *(const bf16x8*)(kp + 16 * ks); MMA32(st[kb], kf, qf[ks]); }
        }
        float mx = -3.0e38f;
#pragma unroll
        for (int kb = 0; kb < 8; ++kb)
#pragma unroll
            for (int g = 0; g < 16; ++g) mx = fmaxf(mx, st[kb][g]);
        mx = fmaxf(mx, __shfl_xor(mx, 32));
        const float cs = 0.0625f * 1.4426950408889634f;
        float l = 0.f;
#pragma unroll
        for (int kb = 0; kb < 8; ++kb)
#pragma unroll
            for (int g = 0; g < 16; ++g) { const float p = __builtin_amdgcn_exp2f((st[kb][g] - mx) * cs); st[kb][g] = p; l += p; }
        l += __shfl_xor(l, 32);
        const float inv = 1.0f / l;
        bf16x8 pf[8][2];
#pragma unroll
        for (int kb = 0; kb < 8; ++kb)
#pragma unroll
            for (int s2 = 0; s2 < 2; ++s2)
                pf[kb][s2] = pack8(st[kb][8 * s2] * inv, st[kb][8 * s2 + 1] * inv, st[kb][8 * s2 + 2] * inv, st[kb][8 * s2 + 3] * inv,
                                   st[kb][8 * s2 + 4] * inv, st[kb][8 * s2 + 5] * inv, st[kb][8 * s2 + 6] * inv, st[kb][8 * s2 + 7] * inv);
#pragma unroll 1
        for (int db = 0; db < 8; ++db) {
            f32x16 acc;
#pragma unroll
            for (int g = 0; g < 16; ++g) acc[g] = 0.f;
            const bf16_t* vp = Vt + ((size_t)(b * 1024 + h * 256 + 32 * db + r)) * 256 + 4 * h2;
#pragma unroll
            for (int kb = 0; kb < 8; ++kb)
#pragma unroll
                for (int s2 = 0; s2 < 2; ++s2) {
                    const v2u lo = *(const v2u*)(vp + 32 * kb + 16 * s2), hi = *(const v2u*)(vp + 32 * kb + 16 * s2 + 8);
                    v4u av; av.x = lo.x; av.y = lo.y; av.z = hi.x; av.w = hi.y;
                    MMA32(acc, __builtin_bit_cast(bf16x8, av), pf[kb][s2]);
                }
            bf16_t* yp = Y + tok * D + h * 256 + 32 * db + 4 * h2;
#pragma unroll
            for (int g = 0; g < 4; ++g) { v2u w; w.x = pg8::cvt_pk_bf16(acc[4 * g], acc[4 * g + 1]); w.y = pg8::cvt_pk_bf16(acc[4 * g + 2], acc[4 * g + 3]); *(v2u*)(yp + 8 * g) = w; }
        }
    }
}


template <bool F32OUT>
__device__ __forceinline__ void combine_norm(float* X, const bf16_t* YE, const int* SLOT, const float* g, bf16_t* Hout, float* Fout) {
    const int tix_ = tidx(); const int lane = tix_ & 63, gw = blockIdx.x * 8 + (tix_ >> 6), ngw = gridDim.x * 8;
    for (int m = gw; m < T; m += ngw) {
        float4* xr = (float4*)(X + (size_t)m * D);
        float4 v[4];
#pragma unroll
        for (int j = 0; j < 4; ++j) v[j] = xr[lane + 64 * j];
        const int myslot = SLOT[(size_t)m * NE + (lane & 15)];
#pragma unroll
        for (int e = 0; e < 16; ++e) {
            const int row = __builtin_amdgcn_readlane(myslot, e);
            if (row >= 0) {
                const v2u* yp = (const v2u*)(YE + (size_t)row * D);
#pragma unroll
                for (int j = 0; j < 4; ++j) { const v2u w = yp[lane + 64 * j];
                    v[j].x += __uint_as_float(w.x << 16); v[j].y += __uint_as_float(w.x & 0xffff0000u); v[j].z += __uint_as_float(w.y << 16); v[j].w += __uint_as_float(w.y & 0xffff0000u); }
            }
        }
        float s = 0.f;
#pragma unroll
        for (int j = 0; j < 4; ++j) { if (!F32OUT) xr[lane + 64 * j] = v[j]; s += v[j].x * v[j].x + v[j].y * v[j].y + v[j].z * v[j].z + v[j].w * v[j].w; }
        const float r = rsqrtf(wave_sum(s) * (1.0f / D) + 1e-6f);
#pragma unroll
        for (int j = 0; j < 4; ++j) { const float4 gg = ((const float4*)g)[lane + 64 * j];
            if (F32OUT) ((float4*)(Fout + (size_t)m * D))[lane + 64 * j] = make_float4(v[j].x * r * gg.x, v[j].y * r * gg.y, v[j].z * r * gg.z, v[j].w * r * gg.w);
            else { v2u w; w.x = pk2(v[j].x * r * gg.x, v[j].y * r * gg.y); w.y = pk2(v[j].z * r * gg.z, v[j].w * r * gg.w); ((v2u*)(Hout + (size_t)m * D))[lane + 64 * j] = w; } }
    }
}


__device__ __forceinline__ void vtrans_pass(const bf16_t* PVb, bf16_t* VtA, bf16_t* VtB, unsigned char* lds_raw) {
    LAS unsigned char* L = (LAS unsigned char*)lds_raw;
    const int tid = tidx(), lane = tid & 63, wave = tid >> 6;
    constexpr int RS = 136;
    for (int it = blockIdx.x; it < 640; it += gridDim.x) {
        const int vh = it % 10, tl = (it / 10) & 31, b = it / 320, s0 = tl * 256;
        __syncthreads();
        { const int tk = tid >> 1, half = tid & 1;
          const v4u* gp = (const v4u*)(PVb + (size_t)(b * S + s0 + tk) * 640 + vh * 64 + half * 32);
#pragma unroll
          for (int q = 0; q < 4; ++q) { const v4u x = gp[q]; LAS v2u* lp = (LAS v2u*)(L + tk * RS + half * 64 + q * 16); v2u a_; a_.x = x.x; a_.y = x.y; lp[0] = a_; a_.x = x.z; a_.y = x.w; lp[1] = a_; } }
        __syncthreads();
        const int npat = vh < 8 ? 3 : 1;
        for (int pat = 0; pat < npat; ++pat) {
            const int dd = pat == 0 ? 1 : (pat == 1 ? 4 : 16), seg = 256 / dd;
            const int o = 4 * lane, rho = o / seg, qq0 = o % seg;
            const size_t gpos = (size_t)b * S + (size_t)rho * (S / dd) + s0 / dd + qq0;
#pragma unroll
            for (int i = 0; i < 8; ++i) {
                const int d = wave * 8 + i;
                unsigned short x[4];
#pragma unroll
                for (int jj = 0; jj < 4; ++jj) x[jj] = *(const LAS unsigned short*)(L + ((qq0 + jj) * dd + rho) * RS + d * 2);
                v2u w; w.x = (unsigned)x[0] | ((unsigned)x[1] << 16); w.y = (unsigned)x[2] | ((unsigned)x[3] << 16);
                bf16_t* dst = vh < 8 ? (VtA + ((size_t)pat * 512 + vh * 64 + d) * T + gpos) : (VtB + ((size_t)(vh - 8) * 64 + d) * T + gpos);
                *(v2u*)dst = w;
            }
        }
    }
}

template <int NK, bool SINK>
__device__ __forceinline__ void attn_tile(const bf16_t* Qh, const bf16_t* Kh, const bf16_t* Vt, int dd, int Lr, int b, int rho, int q0, float sink2,
                                          bf16_t* Odst, int ostride, float* lsedst, int lane) {
    const int r = lane & 31, h2 = lane >> 5;
    const size_t qtok = (size_t)b * S + (size_t)(q0 + r) * dd + rho;
    bf16x8 qf[4];
#pragma unroll
    for (int ks = 0; ks < 4; ++ks) qf[ks] = *(const bf16x8*)(Qh + qtok * 64 + 16 * ks + 8 * h2);
    f32x16 o[2];
#pragma unroll
    for (int db = 0; db < 2; ++db)
#pragma unroll
        for (int g = 0; g < 16; ++g) o[db][g] = 0.f;
    float m = SINK ? sink2 : -1.0e30f, l = SINK ? 1.f : 0.f;
#pragma unroll 1
    for (int kb = -NK; kb <= NK; ++kb) {
        const int kq0 = q0 + 32 * kb;
        if (kq0 < 0 || kq0 >= Lr) continue;
        const size_t ktok = (size_t)b * S + (size_t)(kq0 + r) * dd + rho;
        f32x16 st;
#pragma unroll
        for (int g = 0; g < 16; ++g) st[g] = 0.f;
        const bf16_t* kp = Kh + ktok * 64 + 8 * h2;
#pragma unroll
        for (int ks = 0; ks < 4; ++ks) { const bf16x8 kf = *(const bf16x8*)(kp + 16 * ks); MMA32(st, kf, qf[ks]); }
        if (kb == -NK || kb == NK) {
#pragma unroll
            for (int g = 0; g < 16; ++g) { const int cr = (g & 3) + 8 * (g >> 2) + 4 * h2; const bool ok = (kb < 0) ? (cr >= r) : (cr <= r); st[g] = ok ? st[g] : -1.0e30f; }
        }
        float bm = st[0];
#pragma unroll
        for (int g = 1; g < 16; ++g) bm = fmaxf(bm, st[g]);
        bm = fmaxf(bm, __shfl_xor(bm, 32));
        const float mn = fmaxf(m, bm), al = __builtin_amdgcn_exp2f(m - mn);
        float ls = 0.f;
#pragma unroll
        for (int g = 0; g < 16; ++g) { st[g] = __builtin_amdgcn_exp2f(st[g] - mn); ls += st[g]; }
        ls += __shfl_xor(ls, 32);
        l = l * al + ls; m = mn;
#pragma unroll
        for (int db = 0; db < 2; ++db)
#pragma unroll
            for (int g = 0; g < 16; ++g) o[db][g] *= al;
        bf16x8 pf[2];
#pragma unroll
        for (int s2 = 0; s2 < 2; ++s2) pf[s2] = pack8(st[8 * s2], st[8 * s2 + 1], st[8 * s2 + 2], st[8 * s2 + 3], st[8 * s2 + 4], st[8 * s2 + 5], st[8 * s2 + 6], st[8 * s2 + 7]);
        const size_t kpos = (size_t)b * S + (size_t)rho * Lr + kq0;
#pragma unroll
        for (int db = 0; db < 2; ++db) {
            const bf16_t* vp = Vt + (size_t)(32 * db + r) * T + kpos + 4 * h2;
#pragma unroll
            for (int s2 = 0; s2 < 2; ++s2) {
                const v2u lo = *(const v2u*)(vp + 16 * s2), hi = *(const v2u*)(vp + 16 * s2 + 8);
                v4u av; av.x = lo.x; av.y = lo.y; av.z = hi.x; av.w = hi.y;
                MMA32(o[db], __builtin_bit_cast(bf16x8, av), pf[s2]);
            }
        }
    }
    const float inv = 1.0f / l;
#pragma unroll
    for (int db = 0; db < 2; ++db) {
        bf16_t* op = Odst + qtok * ostride + 32 * db + 4 * h2;
#pragma unroll
        for (int g = 0; g < 4; ++g) { v2u w; w.x = pk2(o[db][4 * g] * inv, o[db][4 * g + 1] * inv); w.y = pk2(o[db][4 * g + 2] * inv, o[db][4 * g + 3] * inv); *(v2u*)(op + 8 * g) = w; }
    }
    if (lsedst != nullptr && h2 == 0) lsedst[qtok * 8] = (m + __builtin_amdgcn_logf(l)) * 0.6931471805599453f;
}

__device__ __forceinline__ void attn_phase_even(const bf16_t* QhA, const bf16_t* KhA, const bf16_t* VtA, const bf16_t* QhB, const bf16_t* KhB, const bf16_t* VtB,
                                                const float* sink, bf16_t* OA, float* LSE, bf16_t* Y) {
    const int tix_ = tidx(); const int lane = tix_ & 63, gw = blockIdx.x * 8 + (tix_ >> 6), ngw = gridDim.x * 8;
    for (int it = gw; it < 12288 + 4096; it += ngw) {
        if (it < 12288) {
            const int p = it >> 12, rem = it & 4095, head = rem >> 9, rem2 = rem & 511, b = rem2 >> 8, rem3 = rem2 & 255;
            const int dd = p == 0 ? 1 : (p == 1 ? 4 : 16), tpr = 256 / dd, rho = rem3 / tpr, q0 = (rem3 % tpr) * 32;
            attn_tile<2, false>(QhA + (size_t)head * T * 64, KhA + (size_t)head * T * 64, VtA + ((size_t)p * 512 + head * 64) * T, dd, S / dd, b, rho, q0, 0.f,
                                OA + (size_t)p * T * 512 + head * 64, 512, LSE + (size_t)p * T * 8 + head, lane);
        } else {
            const int itb = it - 12288, hq = itb >> 9, rem2 = itb & 511, b = rem2 >> 8, q0 = (rem2 & 255) * 32, kvh = hq >> 2;
            attn_tile<4, true>(QhB + (size_t)hq * T * 64, KhB + (size_t)kvh * T * 64, VtB + (size_t)kvh * 64 * T, 1, S, b, 0, q0, sink[hq] * 1.4426950408889634f,
                               Y + 512 + hq * 64, D, nullptr, lane);
        }
    }
}
__device__ __forceinline__ void attn_combine(const bf16_t* OA, const float* LSE, bf16_t* Y) {
    const int gt = blockIdx.x * NTH + tidx(), ngt = gridDim.x * NTH;
    for (int i = gt; i < T * 64; i += ngt) {
        const int tok = i >> 6, head = (i >> 3) & 7, c8 = i & 7;
        const float l0 = LSE[(size_t)tok * 8 + head], l1 = LSE[((size_t)T + tok) * 8 + head], l2 = LSE[((size_t)2 * T + tok) * 8 + head];
        const float mx = fmaxf(l0, fmaxf(l1, l2));
        float w0 = __expf(l0 - mx), w1 = __expf(l1 - mx), w2 = __expf(l2 - mx);
        const float inv = 1.0f / (w0 + w1 + w2); w0 *= inv; w1 *= inv; w2 *= inv;
        const size_t off = (size_t)tok * 512 + head * 64 + c8 * 8;
        const v4u x0 = *(const v4u*)(OA + off), x1 = *(const v4u*)(OA + (size_t)T * 512 + off), x2 = *(const v4u*)(OA + (size_t)2 * T * 512 + off);
        v4u w;
#pragma unroll
        for (int q = 0; q < 4; ++q) {
            const float lo = w0 * __uint_as_float(x0[q] << 16) + w1 * __uint_as_float(x1[q] << 16) + w2 * __uint_as_float(x2[q] << 16);
            const float hi = w0 * __uint_as_float(x0[q] & 0xffff0000u) + w1 * __uint_as_float(x1[q] & 0xffff0000u) + w2 * __uint_as_float(x2[q] & 0xffff0000u);
            w[q] = pk2(lo, hi);
        }
        *(v4u*)(Y + (size_t)tok * D + head * 64 + c8 * 8) = w;
    }
}


__device__ __forceinline__ void odd_token_pass(const bf16_t* P, const float* mu, const float* k_k, const float* clg, const float* clb,
                                               bf16_t* VN, bf16_t* RV, bf16_t* KBf, bf16_t* KK, bf16_t* F5) {
    const int tix_ = tidx(); const int lane = tix_ & 63, gw = blockIdx.x * 8 + (tix_ >> 6), ngw = gridDim.x * 8;
    for (int tok = gw; tok < T; tok += ngw) {
        const int s = tok & (S - 1);
        const bf16_t* pr = P + (size_t)tok * ODD_PAD;
        {
            float ge[8]; float sm = 0.f;
#pragma unroll
            for (int jj = 0; jj < 4; ++jj) { const unsigned w = *(const unsigned*)(pr + 512 + 2 * lane + 128 * jj);
                ge[2 * jj] = gelu_tanh(__uint_as_float(w << 16)); ge[2 * jj + 1] = gelu_tanh(__uint_as_float(w & 0xffff0000u)); sm += ge[2 * jj] + ge[2 * jj + 1]; }
            const float mean = wave_sum(sm) * (1.0f / 512.f); float sq = 0.f;
#pragma unroll
            for (int j = 0; j < 8; ++j) { const float d = ge[j] - mean; sq += d * d; }
            const float rstd = rsqrtf(wave_sum(sq) * (1.0f / 512.f) + 1e-5f);
#pragma unroll
            for (int jj = 0; jj < 4; ++jj) { const int c = 2 * lane + 128 * jj; const float2 g2_ = *(const float2*)(clg + c), b2_ = *(const float2*)(clb + c);
                *(unsigned*)(VN + (size_t)tok * 512 + c) = pk2((ge[2 * jj] - mean) * rstd * g2_.x + b2_.x, (ge[2 * jj + 1] - mean) * rstd * g2_.y + b2_.y); }
        }
#pragma unroll 5
        for (int jj = 0; jj < 15; ++jj) {
            const int c = 2 * lane + 128 * jj;
            const unsigned wf = *(const unsigned*)(pr + 1024 + c);
            const unsigned wp = s > 0 ? *(const unsigned*)(pr + 1024 + c - ODD_PAD) : 0u;
            const unsigned wn = s < S - 1 ? *(const unsigned*)(pr + 1024 + c + ODD_PAD) : 0u;
            const float2 m0 = *(const float2*)(mu + c), m1 = *(const float2*)(mu + FD + c);
            const float f0 = __uint_as_float(wf << 16), f1 = __uint_as_float(wf & 0xffff0000u);
            const float x0 = f0 + m0.x * (__uint_as_float(wp << 16) - f0) + m1.x * (__uint_as_float(wn << 16) - f0);
            const float x1 = f1 + m0.y * (__uint_as_float(wp & 0xffff0000u) - f1) + m1.y * (__uint_as_float(wn & 0xffff0000u) - f1);
            if (jj < 4) *(unsigned*)(RV + (size_t)tok * D + c) = pk2(x0, x1);
            else if (jj < 8) {
                const int ck = c - 512;
                *(unsigned*)(KBf + (size_t)tok * 512 + ck) = pk2(x0, x1);
                const float2 kk_ = *(const float2*)(k_k + ck);
                const float a0_ = x0 * kk_.x, a1_ = x1 * kk_.y;
                float ss = a0_ * a0_ + a1_ * a1_;
#pragma unroll
                for (int o = 16; o >= 1; o >>= 1) ss += __shfl_xor(ss, o);
                const float inv = 1.0f / fmaxf(sqrtf(ss), 1e-12f);
                *(unsigned*)(KK + (size_t)tok * 512 + ck) = pk2(a0_ * inv, a1_ * inv);
            }
            else if (jj < 12) *(unsigned*)(RV + (size_t)tok * D + 512 + (c - 1024)) = pk2(x0, x1);
            else if (jj == 12) *(unsigned*)(F5 + (size_t)tok * 384 + (c - 1536)) = pk2(tanhf(x0), tanhf(x1));
            else if (jj == 13) *(unsigned*)(F5 + (size_t)tok * 384 + 128 + (c - 1664)) = pk2(x0, x1);
            else *(unsigned*)(F5 + (size_t)tok * 384 + 256 + (c - 1792)) = pk2(sigmoidf_(x0), sigmoidf_(x1));
        }
    }
}
__device__ __forceinline__ void gating_pass(const bf16_t* VN, const bf16_t* Wsb, const float* bsp, const bf16_t* P, bf16_t* Y, unsigned char* lds_raw) {
    LAS unsigned char* L = (LAS unsigned char*)lds_raw;
    constexpr int RS = 272;
    const int tid = tidx(), lane = tid & 63, wave = tid >> 6, fr = lane & 15, fq = lane >> 4;
    for (int it = blockIdx.x; it < 512; it += gridDim.x) {
        const int g = it & 3, chunk = it >> 2;
        __syncthreads();
        { const int j = tid >> 2, q4 = tid & 3;
          const v4u* gp = (const v4u*)(VN + (size_t)(chunk * 128 + j) * 512 + g * 128 + 32 * q4);
#pragma unroll
          for (int q = 0; q < 4; ++q) { const v4u x = gp[q];
#pragma unroll
              for (int e = 0; e < 4; ++e) { const int c = 32 * q4 + 8 * q + 2 * e;
                  *(LAS unsigned short*)(L + c * RS + 2 * j) = (unsigned short)(x[e] & 0xffffu); *(LAS unsigned short*)(L + (c + 1) * RS + 2 * j) = (unsigned short)(x[e] >> 16); } } }
        __syncthreads();
        bf16x8 lf[4];
#pragma unroll
        for (int ks = 0; ks < 4; ++ks) lf[ks] = *(const bf16x8*)(Wsb + (size_t)(g * 128 + 16 * wave + fr) * 128 + 32 * ks + 8 * fq);
        const int i = 16 * wave + fr; const size_t tok = (size_t)chunk * 128 + i;
        const float bias = bsp[g * 128 + i];
#pragma unroll
        for (int tn = 0; tn < 8; ++tn) {
            f32x4 acc = {0.f, 0.f, 0.f, 0.f};
#pragma unroll
            for (int ks = 0; ks < 4; ++ks) { const bf16x8 rf = *(const LAS bf16x8*)(L + (16 * tn + fr) * RS + (32 * ks + 8 * fq) * 2); MMA16(acc, lf[ks], rf); }
            const int c = g * 128 + 16 * tn + 4 * fq;
            const v2u uw = *(const v2u*)(P + tok * ODD_PAD + c);
            const float u0 = gelu_tanh(__uint_as_float(uw.x << 16)), u1 = gelu_tanh(__uint_as_float(uw.x & 0xffff0000u)), u2 = gelu_tanh(__uint_as_float(uw.y << 16)), u3 = gelu_tanh(__uint_as_float(uw.y & 0xffff0000u));
            v2u w; w.x = pk2(u0 * (acc[0] + bias), u1 * (acc[1] + bias)); w.y = pk2(u2 * (acc[2] + bias), u3 * (acc[3] + bias));
            *(v2u*)(Y + tok * D + c) = w;
        }
    }
}


__device__ __forceinline__ void router_pass(const float* X, const float* g, const float* WRT  , float* AFF, int* SLOT, bf16_t* H) {
    const int tix_ = tidx(); const int lane = tix_ & 63, fr = lane & 15, fq = lane >> 4;
    const int gw = blockIdx.x * 8 + (tix_ >> 6), ngw = gridDim.x * 8;
    for (int tile = gw; tile < T / 16; tile += ngw) {
        const float* xr = X + (size_t)(tile * 16 + fr) * D + 4 * fq;
        const float* wr = WRT + (size_t)fr * D + 4 * fq;
        f32x4 acc = {0.f, 0.f, 0.f, 0.f}; float ss = 0.f;
#pragma unroll 8
        for (int s = 0; s < 64; ++s) {
            const f32x4 xa = *(const f32x4*)(xr + 16 * s), wb = *(const f32x4*)(wr + 16 * s);
            ss += (xa[0] * xa[0] + xa[1] * xa[1]) + (xa[2] * xa[2] + xa[3] * xa[3]);
#pragma unroll
            for (int c = 0; c < 4; ++c) acc = __builtin_amdgcn_mfma_f32_16x16x4f32(xa[c], wb[c], acc, 0, 0, 0);
        }
        ss += __shfl_xor(ss, 16); ss += __shfl_xor(ss, 32);
        const float rstd = rsqrtf(ss * (1.0f / D) + 1e-6f);
        float aff[4];
#pragma unroll
        for (int jj = 0; jj < 4; ++jj) {
            const float lg = acc[jj] * __shfl(rstd, 4 * fq + jj);
            float mx = lg;
#pragma unroll
            for (int o = 1; o < 16; o <<= 1) mx = fmaxf(mx, __shfl_xor(mx, o));
            const float e = expf(lg - mx); float den = e;
#pragma unroll
            for (int o = 1; o < 16; o <<= 1) den += __shfl_xor(den, o);
            aff[jj] = e / den;
        }
#pragma unroll
        for (int jj = 0; jj < 4; ++jj) { const size_t o = (size_t)(tile * 16 + 4 * fq + jj) * NE + fr; AFF[o] = aff[jj]; SLOT[o] = -1; }
#pragma unroll 4
        for (int t = 0; t < 16; ++t) {
            const float rs = __shfl(rstd, t);
            const f32x4* xp = (const f32x4*)(X + (size_t)(tile * 16 + t) * D); v2u* hp = (v2u*)(H + (size_t)(tile * 16 + t) * D);
#pragma unroll
            for (int j = 0; j < 4; ++j) { const f32x4 v = xp[lane + 64 * j], gg = ((const f32x4*)g)[lane + 64 * j];
                v2u w; w.x = pk2(v[0] * rs * gg[0], v[1] * rs * gg[1]); w.y = pk2(v[2] * rs * gg[2], v[3] * rs * gg[3]); hp[lane + 64 * j] = w; }
        }
    }
}

#define IN(k) (lo <= (k) && (k) < hi)
#define REP_LOOP for (int rep_ = 0, nrep_ = ((ph == PROBE_PHASE) ? PROBE_REP : 1); rep_ < nrep_; ++rep_)
#define SEAM(k) do { if (IN(k) && IN((k) + 1)) xcd_barrier(bar); } while (0)
#define PROLOG \
    const int tid = tidx(), lane = tid & 63, wave = tid >> 6; \
    const int bid = blockIdx.x, nb = gridDim.x; \
    const int gw = bid * 8 + wave, ngw = nb * 8; \
    const int gt = bid * NTH + tid, ngt = nb * NTH; \
    (void)gt; (void)ngt; (void)gw; (void)ngw; (void)lane; (void)wave; \
    unsigned char* ws = a.ws; \
    const int lo = a.lo, hi = a.hi; \
    float* ldsf = (float*)lds_raw; (void)ldsf; \
    PG8_LAS unsigned char* ldsp = (PG8_LAS unsigned char*)lds_raw; (void)ldsp; \
    const float* x_in = a.in[0]; const float* mem = a.in[1]; (void)x_in; (void)mem; \
    float* ropec = (float*)(ws + WS_ROPE); float* ropes = ropec + S * 32; (void)ropec; (void)ropes; \
    float* AFF = (float*)(ws + WS_AFF); int* TOK = (int*)(ws + WS_TOK); float* GATE = (float*)(ws + WS_GATE); \
    float* X = (float*)(ws + WS_X); bf16_t* H = (bf16_t*)(ws + WS_H); bf16_t* P = (bf16_t*)(ws + WS_P); \
    bf16_t* Y = (bf16_t*)(ws + WS_Y); bf16_t* Q = (bf16_t*)(ws + WS_Q); bf16_t* KV = (bf16_t*)(ws + WS_KV); bf16_t* MN = (bf16_t*)(ws + WS_MN); \
    bf16_t* DEC = (bf16_t*)(ws + WS_DEC); bf16_t* KD = (bf16_t*)(ws + WS_KD); bf16_t* BB = (bf16_t*)(ws + WS_BB); \
    bf16_t* KK = (bf16_t*)(ws + WS_KK); bf16_t* G = (bf16_t*)(ws + WS_G); float* YS = (float*)(ws + WS_YS); \
    bf16_t* RV = (bf16_t*)(ws + WS_RV); bf16_t* VN = (bf16_t*)(ws + WS_VN); \
    bf16_t* XE = (bf16_t*)(ws + WS_XE); bf16_t* HID = (bf16_t*)(ws + WS_HID); int* SLOT = (int*)(ws + WS_SLOT); bf16_t* YE = (bf16_t*)(ws + WS_YE); (void)SLOT; (void)YE; \
    (void)AFF; (void)TOK; (void)GATE; (void)X; (void)H; (void)P; (void)Y; (void)Q; (void)KV; (void)MN; (void)DEC; (void)KD; (void)BB; (void)KK; (void)G; (void)YS; (void)RV; (void)VN; (void)XE; (void)HID;

template <class Epi>
__device__ __forceinline__ void dense_gemm(PG8_LAS unsigned char* ldsp, const bf16_t* A, const bf16_t* Bt, int M, int N, int K, const Epi& E) {
    asm volatile("" : "+s"(K));
    pg8::Gemm g{A, Bt, M, N, K}; pg8::StaticOrder So; So.init(M, N, (int)gridDim.x, (int)blockIdx.x);
    pg8::gemm_phase<Epi, pg8::StaticOrder, false>(ldsp, g, So, E, nullptr);
}

__device__ __forceinline__ int odd_phases(const Args& a, const XcdBarrier& bar, unsigned char* lds_raw, int ph) {
    PROLOG
    if (IN(ph)) combine_norm<false>(X, YE, SLOT, a.in[6], H, nullptr);
    SEAM(ph); ++ph;
    if (IN(ph)) dense_gemm(ldsp, H, (const bf16_t*)(ws + WS_WOIN), T, ODD_PAD, D, EpiBf16Store{P, ODD_PAD, 1.0f});
    SEAM(ph); ++ph;
    if (IN(ph)) REP_LOOP odd_token_pass(P, a.in[12], a.in[18], a.in[8], a.in[9], VN, RV, (bf16_t*)(ws + WS_KB), KK, (bf16_t*)(ws + WS_F5));
    SEAM(ph); ++ph;
    if (IN(ph)) REP_LOOP {
        gating_pass(VN, (const bf16_t*)(ws + WS_WSB), a.in[11], P, Y, lds_raw);
        __syncthreads();
        dense_gemm(ldsp, (const bf16_t*)(ws + WS_F5), (const bf16_t*)(ws + WS_WL), T, 2560, 384,
                   EpiLora{a.in[13], a.in[15], a.in[19], (const bf16_t*)(ws + WS_KB), KK, DEC, KD, BB, G});
    }
    SEAM(ph); ++ph;
    if (IN(ph)) REP_LOOP scan_r1(DEC, RV, KD, KK, BB, (bf16_t*)(ws + WS_PT), (bf16_t*)(ws + WS_QT), (bf16_t*)(ws + WS_RH), (float*)(ws + WS_YL), lds_raw);
    SEAM(ph); ++ph;
    if (IN(ph)) REP_LOOP {
        if (bid < 32) scan_r2((const bf16_t*)(ws + WS_PT), (const bf16_t*)(ws + WS_QT), (bf16_t*)(ws + WS_S0), lds_raw);
        else {
            LAS float* scr = (LAS float*)((LAS unsigned char*)lds_raw + wave * 16384);
            const int gw2 = (bid - 32) * 8 + wave, ngw2 = (nb - 32) * 8;
            auto ident = [](int n) { return n; };
            auto gmap = [](int n) { return (n >> 7) * 256 + (n & 127); };
            auto umap = [](int n) { return (n >> 7) * 256 + 128 + (n & 127); };
            for (int it = gw2; it < 16 * 1408; it += ngw2) { const int mt = 16 + it / 1408, r = it % 1408;
                transpose_item(a.in[31] + (size_t)mt * D * DE, D, DE, (bf16_t*)(ws + WS_WGU) + (size_t)mt * 5632 * D, gmap, scr, r, lane); }
            for (int it = gw2; it < 16 * 1408; it += ngw2) { const int mt = 16 + it / 1408, r = it % 1408;
                transpose_item(a.in[32] + (size_t)mt * D * DE, D, DE, (bf16_t*)(ws + WS_WGU) + (size_t)mt * 5632 * D, umap, scr, r, lane); }
            for (int it = gw2; it < 16 * 1408; it += ngw2) { const int mt = 16 + it / 1408, r = it % 1408;
                transpose_item(a.in[33] + (size_t)mt * DE * D, DE, D, (bf16_t*)(ws + WS_WD) + (size_t)mt * D * DE, ident, scr, r, lane); }
        }
    }
    SEAM(ph); ++ph;
    if (IN(ph)) REP_LOOP scan_r3((const bf16_t*)(ws + WS_RH), (const float*)(ws + WS_YL), (const bf16_t*)(ws + WS_S0), RV, KD, G, a.in[20], a.in[21], a.in[22], Y);
    SEAM(ph); ++ph;
    if (IN(ph)) dense_gemm(ldsp, Y, (const bf16_t*)(ws + WS_WOOUT), T, D, D, EpiResid{X, X});
    SEAM(ph); ++ph;
    return ph;
}

template <int layer>
__device__ __forceinline__ int tail_phases(const Args& a, const XcdBarrier& bar, unsigned char* lds_raw, int ph) {
    PROLOG
    if (IN(ph)) { rmsnorm_rows_bf16(X, a.in[24] + layer * D, H, T); rmsnorm_rows_bf16(mem, a.in[25] + layer * D, MN, NB * MEM); }
    SEAM(ph); ++ph;
    if (IN(ph)) {
        dense_gemm(ldsp, H, (const bf16_t*)(ws + WS_WQ) + (size_t)layer * D * D, T, D, D, EpiBf16Store{Q, D, 1.0f});
        dense_gemm(ldsp, MN, (const bf16_t*)(ws + WS_WKV) + (size_t)layer * 2048 * D, NB * MEM, 2048, D, EpiKV{KV, KV + 512 * 1024});
    }
    SEAM(ph); ++ph;
    if (IN(ph)) REP_LOOP xattn_mfma(Q, KV, KV + 512 * 1024, Y);
    SEAM(ph); ++ph;
    if (IN(ph)) dense_gemm(ldsp, Y, (const bf16_t*)(ws + WS_WO) + (size_t)layer * D * D, T, D, D, EpiResid{X, X});
    SEAM(ph); ++ph;
    if (IN(ph)) REP_LOOP router_pass(X, a.in[29] + layer * D, (const float*)(ws + WS_WRT) + (size_t)layer * NE * D, AFF, SLOT, H);
    SEAM(ph); ++ph;
    if (IN(ph)) REP_LOOP {
        unsigned* keys = (unsigned*)ldsf;
        int* hist = (int*)(ldsf + 8192);
        int* sh = hist + 256;
        for (int be = bid; be < NB * NE; be += nb) {
            const int b = be >> 4, e = be & 15, eb = e * 2 + b;
            __syncthreads();
            for (int s = tid; s < S; s += NTH) keys[s] = __float_as_uint(AFF[(size_t)(b * S + s) * NE + e]);
            unsigned prefix = 0u; int krem = CAP;
            for (int pass = 3; pass >= 0; --pass) {
                __syncthreads();
                if (tid < 256) hist[tid] = 0;
                __syncthreads();
                const unsigned hmask = pass == 3 ? 0u : (0xFFFFFFFFu << (8 * (pass + 1)));
                for (int s = tid; s < S; s += NTH) { const unsigned k = keys[s]; if ((k & hmask) == prefix) atomicAdd(&hist[(k >> (8 * pass)) & 255u], 1); }
                __syncthreads();
                if (tid == 0) {
                    int cum = 0, bsel = 0;
                    for (int bb = 255; bb >= 0; --bb) { const int c = hist[bb]; if (cum + c >= krem) { bsel = bb; break; } cum += c; }
                    sh[8] = bsel; sh[9] = krem - cum;
                }
                __syncthreads();
                prefix |= ((unsigned)sh[8]) << (8 * pass); krem = sh[9];
            }
            const unsigned thr = prefix;
            int ce = 0;
            for (int i = 0; i < 16; ++i) { const unsigned k = keys[tid * 16 + i]; ce += (k == thr); }
            int tot;
            const int eqbase = block_exscan(ce, sh, &tot);
            int eqr = eqbase, cs = 0;
            for (int i = 0; i < 16; ++i) { const unsigned k = keys[tid * 16 + i]; const bool sel = (k > thr) || (k == thr && eqr < krem); eqr += (k == thr); cs += sel; }
            const int sbase = block_exscan(cs, sh, &tot);
            int slot = sbase; eqr = eqbase;
            for (int i = 0; i < 16; ++i) {
                const int s = tid * 16 + i; const unsigned k = keys[s];
                const bool sel = (k > thr) || (k == thr && eqr < krem); eqr += (k == thr);
                if (sel) { TOK[eb * CAP + slot] = b * S + s; GATE[eb * CAP + slot] = __uint_as_float(k); SLOT[(size_t)(b * S + s) * NE + e] = eb * CAP + slot; ++slot; }
            }
        }
    }
    SEAM(ph); ++ph;
    if (IN(ph)) REP_LOOP {
        for (int r = gw; r < NB * NE * CAP; r += ngw) {
            int rv_ = r; asm volatile("" : "+v"(rv_));
            const v4u* src = (const v4u*)(H + (size_t)TOK[rv_] * D); v4u* dst = (v4u*)(XE + (size_t)r * D);
            dst[lane] = src[lane]; dst[lane + 64] = src[lane + 64];
        }
    }
    SEAM(ph); ++ph;
    if (IN(ph)) {
        pg8::Gemm g{XE, (const bf16_t*)(ws + WS_WGU) + (size_t)layer * NE * 5632 * D, NB * NE * CAP, NE * 5632, D};
        MoeOrder So{(int)gridDim.x, (int)blockIdx.x, 16 * 22, 22};
        pg8::gemm_phase<EpiSiluMul, MoeOrder, false>(ldsp, g, So, EpiSiluMul{HID}, nullptr);
    }
    SEAM(ph); ++ph;
    if (IN(ph)) {
        pg8::Gemm g{HID, (const bf16_t*)(ws + WS_WD) + (size_t)layer * NE * D * DE, NB * NE * CAP, NE * D, DE};
        MoeOrder So{(int)gridDim.x, (int)blockIdx.x, 16 * 4, 4};
        pg8::gemm_phase<EpiYE, MoeOrder, false>(ldsp, g, So, EpiYE{GATE, YE}, nullptr);
    }
    SEAM(ph); ++ph;
    return ph;
}

__global__ void __launch_bounds__(NTH, 2) mega(Args a) {
    extern __shared__ __attribute__((aligned(16))) unsigned char lds_raw[];
    unsigned* ctl = (unsigned*)(a.ws + WS_CTL);
    volatile LAS unsigned* bst = (volatile LAS unsigned*)((LAS unsigned char*)lds_raw + LDS_BAR_OFF);
    { const int t0_ = tidx(); if (t0_ < 4) bst[t0_] = 0u; }
    __syncthreads();
    XcdBarrier bar; bar.bar = ctl + CW_BAR; bar.x = 0; bar.st = bst;
    if (a.hi - a.lo > 1) bar = xcd_barrier_post(ctl + CW_BAR, bst);
    PROLOG

    int ph = 0;
    if (IN(ph)) REP_LOOP {
        for (int i = gt; i < S * 32; i += ngt) {
            const int s = i >> 5, f = i & 31;
            const float pw = (float)exp((double)((float)(2 * f) / 64.0f) * 9.210340371976184);
            const float invf = 1.0f / pw;
            const float angf = (float)s * invf;
            double xx = (double)angf;
            const double n = rint(xx * 0.15915494309189535);
            xx = (xx - n * 6.283185307179586) - n * 2.4492935982947064e-16;
            const double x2 = xx * xx;
            double cs = 1.0, sn = xx, tc = 1.0, tsn = xx;
#pragma unroll 1
            for (int k = 1; k <= 16; ++k) { tc *= -x2 / (double)((2 * k - 1) * (2 * k)); tsn *= -x2 / (double)((2 * k) * (2 * k + 1)); cs += tc; sn += tsn; }
            ropec[i] = (float)cs; ropes[i] = (float)sn;
        }
        rmsnorm_rows_bf16(x_in, a.in[2], H, T);
        LAS float* scr = (LAS float*)((LAS unsigned char*)lds_raw + wave * 16384);
        auto ident = [](int n) { return n; };
        auto emap = [](int n) { const bool il = (n < 1024) || (n >= 1536 && n < 2176); const int j = n & 63; return il ? ((n & ~63) + (j < 32 ? 2 * j : 2 * (j - 32) + 1)) : n; };
        for (int it = gw; it < 16 * 72; it += ngw) transpose_item(a.in[3], D, EVEN_IN, (bf16_t*)(ws + WS_WEIN), emap, scr, it, lane);
        for (int it = gw; it < 16 * 32; it += ngw) transpose_item(a.in[5], D, D, (bf16_t*)(ws + WS_WEOUT), ident, scr, it, lane);
        for (int it = gw; it < 16 * 92; it += ngw) transpose_item(a.in[7], D, ODD_IN, (bf16_t*)(ws + WS_WOIN), ident, scr, it, lane);
        for (int it = gw; it < 16 * 32; it += ngw) transpose_item(a.in[23], D, D, (bf16_t*)(ws + WS_WOOUT), ident, scr, it, lane);
        for (int it = gw; it < 2 * 16 * 32; it += ngw) { const int l = it / 512, r = it % 512; transpose_item(a.in[26] + (size_t)l * D * D, D, D, (bf16_t*)(ws + WS_WQ) + (size_t)l * D * D, ident, scr, r, lane); }
        for (int it = gw; it < 2 * 16 * 64; it += ngw) { const int l = it / 1024, r = it % 1024; transpose_item(a.in[27] + (size_t)l * D * 2048, D, 2048, (bf16_t*)(ws + WS_WKV) + (size_t)l * 2048 * D, ident, scr, r, lane); }
        for (int it = gw; it < 2 * 16 * 32; it += ngw) { const int l = it / 512, r = it % 512; transpose_item(a.in[28] + (size_t)l * D * D, D, D, (bf16_t*)(ws + WS_WO) + (size_t)l * D * D, ident, scr, r, lane); }
        { float* WRT = (float*)(ws + WS_WRT);
          for (int i = gt; i < 2 * NE * D; i += ngt) { const int l = i >> 14, e = (i >> 10) & 15, k = i & 1023; WRT[i] = a.in[29][l * D + k] * a.in[30][((size_t)l * D + k) * NE + e]; } }
        { bf16_t* Wsb = (bf16_t*)(ws + WS_WSB); const float* wsp = a.in[10];
          for (int i = gt; i < 4 * 128 * 128; i += ngt) Wsb[i] = (bf16_t)f2bf(wsp[i]);
          bf16_t* WL = (bf16_t*)(ws + WS_WL); const float *w2 = a.in[14], *a2 = a.in[16], *g2 = a.in[17];
          for (int i = gt; i < 2560 * 384; i += ngt) { const int n = i / 384, k = i % 384, sec = n >> 9, cc = n & 511; float v = 0.f;
              if (sec < 2) { if ((k >> 6) == sec) v = w2[(size_t)(sec * 64 + (k & 63)) * 512 + cc]; }
              else if (sec < 4) { if ((k >> 6) == sec) v = a2[(size_t)((sec - 2) * 64 + (k & 63)) * 512 + cc]; }
              else { if (k >= 256) v = g2[(size_t)(k - 256) * 512 + cc]; }
              WL[i] = (bf16_t)f2bf(v); } }
        auto gmap = [](int n) { return (n >> 7) * 256 + (n & 127); };
        auto umap = [](int n) { return (n >> 7) * 256 + 128 + (n & 127); };
        for (int it = gw; it < 16 * 1408; it += ngw) { const int mt = it / 1408, r = it % 1408;
            transpose_item(a.in[31] + (size_t)mt * D * DE, D, DE, (bf16_t*)(ws + WS_WGU) + (size_t)mt * 5632 * D, gmap, scr, r, lane); }
        for (int it = gw; it < 16 * 1408; it += ngw) { const int mt = it / 1408, r = it % 1408;
            transpose_item(a.in[32] + (size_t)mt * D * DE, D, DE, (bf16_t*)(ws + WS_WGU) + (size_t)mt * 5632 * D, umap, scr, r, lane); }
        for (int it = gw; it < 16 * 1408; it += ngw) { const int mt = it / 1408, r = it % 1408;
            transpose_item(a.in[33] + (size_t)mt * DE * D, DE, D, (bf16_t*)(ws + WS_WD) + (size_t)mt * D * DE, ident, scr, r, lane); }
    }
    SEAM(ph); ++ph;

    if (IN(ph)) dense_gemm(ldsp, H, (const bf16_t*)(ws + WS_WEIN), T, EVEN_IN, D,
                           EpiEven{ropec, ropes, (bf16_t*)(ws + WS_QHA), (bf16_t*)(ws + WS_KHA), (bf16_t*)(ws + WS_QHB), (bf16_t*)(ws + WS_KHB), (bf16_t*)(ws + WS_PVB)});
    SEAM(ph); ++ph;
    if (IN(ph)) REP_LOOP vtrans_pass((const bf16_t*)(ws + WS_PVB), (bf16_t*)(ws + WS_VTA), (bf16_t*)(ws + WS_VTB), lds_raw);
    SEAM(ph); ++ph;
    if (IN(ph)) REP_LOOP attn_phase_even((const bf16_t*)(ws + WS_QHA), (const bf16_t*)(ws + WS_KHA), (const bf16_t*)(ws + WS_VTA), (const bf16_t*)(ws + WS_QHB), (const bf16_t*)(ws + WS_KHB),
                                (const bf16_t*)(ws + WS_VTB), a.in[4], (bf16_t*)(ws + WS_OA), (float*)(ws + WS_LSE), Y);
    SEAM(ph); ++ph;
    if (IN(ph)) REP_LOOP attn_combine((const bf16_t*)(ws + WS_OA), (const float*)(ws + WS_LSE), Y);
    SEAM(ph); ++ph;
    if (IN(ph)) dense_gemm(ldsp, Y, (const bf16_t*)(ws + WS_WEOUT), T, D, D, EpiResid{x_in, X});
    SEAM(ph); ++ph;

    ph = tail_phases<0>(a, bar, lds_raw, ph);
    ph = odd_phases(a, bar, lds_raw, ph);
    ph = tail_phases<1>(a, bar, lds_raw, ph);

    if (IN(ph)) combine_norm<true>(X, YE, SLOT, a.in[34], nullptr, a.out);
    ++ph;
}
constexpr int NPHASES = 1 + 5 + 2 * 9 + 8 + 1;
#undef IN
#undef SEAM
}

extern "C" void kernel_launch(void* const* d_in, const int* in_sizes, int n_in, void* d_out, int out_size, void* d_ws, size_t ws_size, hipStream_t stream) {
    static int grid = 0;
    if (grid == 0) {
        if (n_in != 35 || out_size != T * D || ws_size < WS_END) { fprintf(stderr, "kernel_launch: unexpected shapes n_in %d out %d ws %zu (need %zu)\n", n_in, out_size, ws_size, (size_t)WS_END); grid = -1; return; }
        int dev = 0, cus = 0, per_cu = 0;
        (void)hipGetDevice(&dev); (void)hipDeviceGetAttribute(&cus, hipDeviceAttributeMultiprocessorCount, dev);
        if (hipFuncSetAttribute((const void*)mega, hipFuncAttributeMaxDynamicSharedMemorySize, LDS_BYTES) != hipSuccess) { fprintf(stderr, "hipFuncSetAttribute failed\n"); grid = -1; return; }
        if (hipOccupancyMaxActiveBlocksPerMultiprocessor(&per_cu, (const void*)mega, NTH, LDS_BYTES) != hipSuccess || per_cu < 1) fprintf(stderr, "occupancy query: %d\n", per_cu);
        (void)hipGetLastError();
        grid = cus > 0 ? cus : 256;
    }
    if (grid < 0) return;
    (void)hipMemsetAsync((char*)d_ws + WS_CTL, 0, CTL_BYTES, stream);
    Args a{};
    for (int i = 0; i < 35; ++i) a.in[i] = (const float*)d_in[i];
    a.out = (float*)d_out; a.ws = (unsigned char*)d_ws;
#if MK_MULTI
    for (int k = 0; k < NPHASES; ++k) { a.lo = k; a.hi = k + 1; hipLaunchKernelGGL(mega, dim3(grid), dim3(NTH), LDS_BYTES, stream, a); }
#else
    a.lo = 0; a.hi = NPHASES; hipLaunchKernelGGL(mega, dim3(grid), dim3(NTH), LDS_BYTES, stream, a);
#endif
}
```

```cpp
#include <hip/hip_runtime.h>
#include <cstdio>
#include <cstdint>

#ifndef PROBE_PHASE
#define PROBE_PHASE (-1)
#endif
#ifndef PROBE_REP
#define PROBE_REP 1
#endif
#ifndef MK_MULTI
#define MK_MULTI 0
#endif

__device__ __forceinline__ int tidx() { int t = threadIdx.x; asm volatile("" : "+v"(t)); return t; }
namespace pg8 {
#define PG8_LAS __attribute__((address_space(3)))
typedef unsigned short bf16_t;
typedef short bf16x8 __attribute__((ext_vector_type(8)));
typedef float f32x4 __attribute__((ext_vector_type(4)));
typedef unsigned u32x4 __attribute__((ext_vector_type(4)));
constexpr int BM = 256, BK = 64, HALF = 128, HTB = HALF * BK * 2  , STAGE_BYTES = 8 * HTB, NXCD = 8, WGM = 8;

__host__ __device__ __forceinline__ int lds_byte(int r, int c) { const int st = (r >> 4) * 2 + (c >> 5), rr = r & 15, cc = c & 31, ob = rr * 64 + cc * 2; return st * 1024 + (ob ^ (((ob >> 9) & 1) << 5)); }
__host__ __device__ __forceinline__ void stage_rc(int b, int& R, int& C) { const int st = b / 1024, sb = b % 1024, swz = sb ^ (((sb >> 9) & 1) << 5); R = (st >> 1) * 16 + swz / 64; C = (st & 1) * 32 + (swz % 64) / 2; }
__host__ __device__ __forceinline__ int perm32(int rho) { const int n = rho >> 4, i = rho & 15; return 8 * (i >> 2) + 4 * n + (i & 3); }

struct Unit { int pm, pn; };
struct Gemm { const bf16_t* A; const bf16_t* Bt; int M, N, K; };

struct StaticOrder {
    int nM, nN, nwg, G, c;
    __host__ __device__ void init(int M, int N, int G_, int c_) { nM = M / BM; nN = N / BM; nwg = nM * nN; G = G_; c = c_; }
    __host__ __device__ bool next(int i, Unit& u) const {
        const long L = (long)i * G + c; if (L >= nwg) return false;
        int wgid = (int)L; { const int q = nwg / NXCD, r = nwg % NXCD, xcd = wgid % NXCD, off = wgid / NXCD; wgid = (xcd < r ? xcd * (q + 1) : r * (q + 1) + (xcd - r) * q) + off; }
        const int nig = WGM * nN, gid = wgid / nig, fm = gid * WGM, gsz = (nM - fm) < WGM ? (nM - fm) : WGM;
        u.pm = fm + ((wgid % nig) % gsz); u.pn = (wgid % nig) / gsz; return true;
    }
    __device__ __forceinline__ void a_ready(const Unit&) const {}
    __device__ __forceinline__ void done(const Unit&) const {}
};

typedef __bf16 bf16v2_t __attribute__((ext_vector_type(2)));
typedef float f32v2_t __attribute__((ext_vector_type(2)));
__device__ __forceinline__ unsigned cvt_pk_bf16(float lo, float hi) { const f32v2_t v = {lo, hi}; return __builtin_bit_cast(unsigned, __builtin_convertvector(v, bf16v2_t)); }
typedef int i32x8 __attribute__((ext_vector_type(8)));
template <bool F8> __device__ __forceinline__ f32x4 mma_tile(const bf16x8 (&bfr)[2], const bf16x8 (&afr)[2], f32x4 acc) {
    if constexpr (F8) {
        typedef int i32x4_ __attribute__((ext_vector_type(4)));
        const i32x4_ b0 = __builtin_bit_cast(i32x4_, bfr[0]), b1 = __builtin_bit_cast(i32x4_, bfr[1]), a0 = __builtin_bit_cast(i32x4_, afr[0]), a1 = __builtin_bit_cast(i32x4_, afr[1]);
        const i32x8 bb = {b0[0], b0[1], b0[2], b0[3], b1[0], b1[1], b1[2], b1[3]}, aa = {a0[0], a0[1], a0[2], a0[3], a1[0], a1[1], a1[2], a1[3]};
        const int sc1 = 0x7f7f7f7f;
        asm volatile("v_mfma_scale_f32_16x16x128_f8f6f4 %0, %1, %2, %0, %3, %3 op_sel_hi:[0,0,0]" : "+v"(acc) : "v"(bb), "v"(aa), "v"(sc1));
        return acc;
    } else {
        acc = __builtin_amdgcn_mfma_f32_16x16x32_bf16(bfr[0], afr[0], acc, 0, 0, 0);
        return __builtin_amdgcn_mfma_f32_16x16x32_bf16(bfr[1], afr[1], acc, 0, 0, 0);
    }
}
template <class Epi, class Sched, bool STAMP = false, bool F8 = false>
__device__ __forceinline__ void gemm_phase(PG8_LAS unsigned char* lds, const Gemm g, const Sched& S, const Epi& E, unsigned long long* stamps) {
    const int tid = ::tidx(), wid = __builtin_amdgcn_readfirstlane(tid >> 6), lane = tid & 63, wr = wid >> 2, wc = wid & 3, fr = lane & 15, fq = lane >> 4;
    const int K = g.K, nt = K / BK;
    int ts_lo = 0, ts_hi = 0, nts = 0; const unsigned long long rt_entry = STAMP ? (unsigned long long)wall_clock64() : 0ull;
#define PG8_STAMP() do { if (STAMP && wid == 0 && nts < 64) { const unsigned long long _c = (unsigned long long)clock64(); \
        ts_lo = (lane == nts) ? (int)(unsigned)_c : ts_lo; ts_hi = (lane == nts) ? (int)(unsigned)(_c >> 32) : ts_hi; ++nts; } } while (0)
    PG8_STAMP();
    unsigned voffA[2], voffB[2];
#pragma unroll
    for (int i = 0; i < 2; ++i) { int R, C; stage_rc(tid * 16 + i * 8192, R, C); const int Rb = Epi::PERM ? ((R & ~31) + perm32(R & 31)) : R;
        voffA[i] = (unsigned)(R * K + C) * 2u; voffB[i] = (unsigned)(Rb * K + C) * 2u; }
    const size_t kstep = (size_t)(BK * 2);
    const size_t hstep = (size_t)HALF * K * 2;
    const size_t tstep = 2 * hstep;
    const unsigned ldsw = (unsigned)wid * 1024u;
    const int aoff = lds_byte(wr * 64 + fr, fq * 8), boff = lds_byte(wc * 32 + fr, fq * 8);
#define PG8_SA(b, h) (((b) * 2 + (h)) * HTB)
#define PG8_SB(b, h) ((4 + (b) * 2 + (h)) * HTB)
#define PG8_STAGE(bufoff, gbase, voff) do { _Pragma("unroll") for (int _i = 0; _i < 2; ++_i) \
        __builtin_amdgcn_global_load_lds((const unsigned*)((const char*)(gbase) + (voff)[_i]), (PG8_LAS unsigned*)(lds + (bufoff) + ldsw + _i * 8192), 16, 0, 0); } while (0)
#define PG8_LDA(dst, b, h) do { _Pragma("unroll") for (int m = 0; m < 4; ++m) _Pragma("unroll") for (int k = 0; k < 2; ++k) dst[m][k] = *(const PG8_LAS bf16x8*)(lds + PG8_SA(b, h) + aoff + m * 2048 + k * 1024); } while (0)
#define PG8_LDB(dst, b, h) do { _Pragma("unroll") for (int n = 0; n < 2; ++n) _Pragma("unroll") for (int k = 0; k < 2; ++k) dst[n][k] = *(const PG8_LAS bf16x8*)(lds + PG8_SB(b, h) + boff + n * 2048 + k * 1024); } while (0)
#define PG8_MMA(ai, bj, At, Bt) do { __builtin_amdgcn_s_setprio(1); _Pragma("unroll") for (int m = 0; m < 4; ++m) _Pragma("unroll") for (int n = 0; n < 2; ++n) \
        acc[ai][bj][m][n] = mma_tile<F8>(Bt[n], At[m], acc[ai][bj][m][n]); __builtin_amdgcn_s_setprio(0); } while (0)
#define PG8_WAIT_V(n) asm volatile("s_waitcnt vmcnt(" #n ")" ::: "memory")
#define PG8_WAIT_L(n) asm volatile("s_waitcnt lgkmcnt(" #n ")" ::: "memory")
#define PG8_BAR __builtin_amdgcn_s_barrier()
#define PG8_SCHED __builtin_amdgcn_sched_barrier(0)
    Unit cur, nxt; int ui = 0;
    if (!S.next(0, cur)) return;
    f32x4 acc[2][2][4][2];
#pragma unroll
    for (int a = 0; a < 2; ++a)
#pragma unroll
        for (int b = 0; b < 2; ++b)
#pragma unroll
            for (int m = 0; m < 4; ++m)
#pragma unroll
                for (int n = 0; n < 2; ++n) acc[a][b][m][n] = (f32x4){0.f, 0.f, 0.f, 0.f};
    bf16x8 At[4][2], B0[2][2], B1[2][2];
    const char* cA = (const char*)g.A + (size_t)cur.pm * tstep; const char* cB = (const char*)g.Bt + (size_t)cur.pn * tstep;
    S.a_ready(cur);
    PG8_STAGE(PG8_SB(0, 0), cB, voffB); PG8_STAGE(PG8_SA(0, 0), cA, voffA); PG8_STAGE(PG8_SB(0, 1), cB + hstep, voffB); PG8_STAGE(PG8_SA(0, 1), cA + hstep, voffA);
    if (wr == 1) PG8_BAR;
    PG8_WAIT_V(4); PG8_BAR;
    PG8_STAGE(PG8_SB(1, 0), cB + kstep, voffB); PG8_STAGE(PG8_SA(1, 0), cA + kstep, voffA); PG8_STAGE(PG8_SB(1, 1), cB + hstep + kstep, voffB);
    PG8_WAIT_V(6); PG8_BAR;
    PG8_STAMP();
    for (;;) {
        const bool has_next = S.next(ui + 1, nxt);
        const char* nA = has_next ? (const char*)g.A + (size_t)nxt.pm * tstep : cA; const char* nB = has_next ? (const char*)g.Bt + (size_t)nxt.pn * tstep : cB;
        for (int t = 0; t < nt; t += 2) {
            const bool last = (t == nt - 2);
            const char* a1 = cA + (size_t)(t + 1) * kstep;
            const char* a2 = last ? nA : cA + (size_t)(t + 2) * kstep; const char* b2 = last ? nB : cB + (size_t)(t + 2) * kstep;
            const char* a3 = a2 + kstep; const char* b3 = b2 + kstep;
            if (last && has_next) S.a_ready(nxt);
            PG8_LDB(B0, 0, 0); PG8_SCHED; PG8_LDA(At, 0, 0); PG8_STAGE(PG8_SA(1, 1), a1 + hstep, voffA);
            PG8_WAIT_L(8); PG8_BAR; PG8_WAIT_L(0); PG8_MMA(0, 0, At, B0); PG8_BAR; PG8_SCHED;
            PG8_LDB(B1, 0, 1); PG8_STAGE(PG8_SB(0, 0), b2, voffB);
            PG8_BAR; PG8_WAIT_L(0); PG8_MMA(0, 1, At, B1); PG8_BAR;
            PG8_LDA(At, 0, 1); PG8_STAGE(PG8_SA(0, 0), a2, voffA);
            PG8_BAR; PG8_WAIT_L(0); PG8_MMA(1, 0, At, B0); PG8_BAR; PG8_SCHED;
            PG8_STAGE(PG8_SB(0, 1), b2 + hstep, voffB);
            PG8_WAIT_V(6); PG8_BAR; PG8_MMA(1, 1, At, B1); PG8_BAR;
            PG8_LDB(B0, 1, 0); PG8_SCHED; PG8_LDA(At, 1, 0); PG8_STAGE(PG8_SA(0, 1), a2 + hstep, voffA);
            PG8_WAIT_L(8); PG8_BAR; PG8_WAIT_L(0); PG8_MMA(0, 0, At, B0); PG8_BAR; PG8_SCHED;
            PG8_LDB(B1, 1, 1); PG8_STAGE(PG8_SB(1, 0), b3, voffB);
            PG8_BAR; PG8_WAIT_L(0); PG8_MMA(0, 1, At, B1); PG8_BAR;
            PG8_LDA(At, 1, 1); PG8_STAGE(PG8_SA(1, 0), a3, voffA);
            PG8_BAR; PG8_WAIT_L(0); PG8_MMA(1, 0, At, B0); PG8_BAR; PG8_SCHED;
            PG8_STAGE(PG8_SB(1, 1), b3 + hstep, voffB);
            PG8_WAIT_V(6); PG8_BAR; PG8_MMA(1, 1, At, B1); PG8_BAR;
        }
        PG8_STAMP();
        if constexpr (!Epi::AFTER_DRAIN) { E(acc, cur, wr, wc, fr, fq); S.done(cur); }
        PG8_STAMP();
        if (!has_next) break;
#pragma unroll
        for (int a = 0; a < 2; ++a)
#pragma unroll
            for (int b = 0; b < 2; ++b)
#pragma unroll
                for (int m = 0; m < 4; ++m)
#pragma unroll
                    for (int n = 0; n < 2; ++n) acc[a][b][m][n] = (f32x4){0.f, 0.f, 0.f, 0.f};
        cur = nxt; cA = nA; cB = nB; ++ui;
    }
    PG8_WAIT_V(0);
    if (wr == 0) PG8_BAR;
    PG8_BAR;
    if constexpr (Epi::AFTER_DRAIN) { E.fused(acc, cur, wr, wc, fr, fq, lds, wid, lane); S.done(cur); }
    PG8_STAMP();
    if (STAMP && wid == 0) { stamps[lane] = lane < nts ? (((unsigned long long)(unsigned)ts_hi << 32) | (unsigned)ts_lo) : 0ull;
        if (lane == 62) stamps[62] = rt_entry; if (lane == 63) stamps[63] = (unsigned long long)wall_clock64(); }
#undef PG8_STAMP
#undef PG8_SA
#undef PG8_SB
#undef PG8_STAGE
#undef PG8_LDA
#undef PG8_LDB
#undef PG8_MMA
#undef PG8_WAIT_V
#undef PG8_WAIT_L
#undef PG8_BAR
#undef PG8_SCHED
}
}


namespace {
using pg8::bf16_t; using pg8::f32x4;
constexpr int D = 1024, NB = 2, S = 8192, T = NB * S;
constexpr int EVEN_IN = 2304, ODD_IN = 2944, ODD_PAD = 3072, FD = 1920;
constexpr int MEM = 256, NE = 16, CAP = 1024, DE = 2816;
constexpr int NTH = 512;
constexpr size_t MiB = 1u << 20;
constexpr size_t WS_CTL = 0, CTL_BYTES = 1 * MiB;
constexpr size_t WS_ROPE = 1 * MiB;
constexpr size_t WS_AFF = 4 * MiB;
constexpr size_t WS_TOK = 5 * MiB;
constexpr size_t WS_GATE = 6 * MiB;
constexpr size_t WS_WRT = 3 * MiB;
constexpr size_t WS_SLOT = 7 * MiB;
constexpr size_t WS_X = 8 * MiB;
constexpr size_t WS_H = 72 * MiB;
constexpr size_t WS_Y = 104 * MiB;
constexpr size_t WS_P = 136 * MiB;
constexpr size_t WS_Q = 320 * MiB;
constexpr size_t WS_KV = 384 * MiB;
constexpr size_t WS_MN = 388 * MiB;
constexpr size_t WS_DEC = 392 * MiB;
constexpr size_t WS_KD = 456 * MiB;
constexpr size_t WS_BB = 520 * MiB;
constexpr size_t WS_KK = 584 * MiB;
constexpr size_t WS_G = 616 * MiB;
constexpr size_t WS_YS = 648 * MiB;
constexpr size_t WS_RV = 712 * MiB;
constexpr size_t WS_VN = 776 * MiB;
constexpr size_t WS_QHA = 136 * MiB;
constexpr size_t WS_KHA = 152 * MiB;
constexpr size_t WS_QHB = 168 * MiB;
constexpr size_t WS_KHB = 184 * MiB;
constexpr size_t WS_PVB = 188 * MiB;
constexpr size_t WS_VTA = 208 * MiB;
constexpr size_t WS_VTB = 256 * MiB;
constexpr size_t WS_OA = 260 * MiB;
constexpr size_t WS_LSE = 308 * MiB;
constexpr size_t WS_QT = 136 * MiB;
constexpr size_t WS_YL = 200 * MiB;
constexpr size_t WS_PT = 264 * MiB;
constexpr size_t WS_RH = 296 * MiB;
constexpr size_t WS_S0 = 328 * MiB;
constexpr size_t WS_XE = 136 * MiB;
constexpr size_t WS_YE = 136 * MiB;
constexpr size_t WS_HID = 200 * MiB;
constexpr size_t WS_KB = 360 * MiB;
constexpr size_t WS_F5 = 792 * MiB;
constexpr size_t WS_WSB = 804 * MiB;
constexpr size_t WS_WL = 805 * MiB;
constexpr size_t WS_WEIN = 808 * MiB;
constexpr size_t WS_WEOUT = 813 * MiB;
constexpr size_t WS_WOIN = 815 * MiB;
constexpr size_t WS_WOOUT = 821 * MiB;
constexpr size_t WS_WQ = 823 * MiB;
constexpr size_t WS_WKV = 827 * MiB;
constexpr size_t WS_WO = 835 * MiB;
constexpr size_t WS_WGU = 840 * MiB;
constexpr size_t WS_WD = 1192 * MiB;
constexpr size_t WS_WGU8 = 840 * MiB;
constexpr size_t WS_WD8 = 1192 * MiB;
constexpr size_t WS_END = 1368 * MiB;
constexpr bool F8L0 = true;
constexpr float ASC8 = 16.f, GUSC8 = 128.f, HSC8 = 4.f, DSC8 = 256.f;
constexpr int CW_BAR = 4096;

constexpr int LDS_BYTES = 147456;
constexpr int LDS_BAR_OFF = LDS_BYTES - 64;

#define LAS __attribute__((address_space(3)))
#define XB_TMO      128
#define XB_XCNT(j)  (256  + 64 * (j))
#define XB_XSUB(j)  (1280 + 64 * (j))
#define XB_XGEN(j)  (2304 + 64 * (j))
#define XB_TOP      3328
#define XB_TOPGEN   3392
#define XCD_BAR_WORDS 3456
#define XB_SPIN_CAP (1u << 22)
__device__ __forceinline__ unsigned xb_ld(unsigned* p)              { return __hip_atomic_load(p, __ATOMIC_RELAXED, __HIP_MEMORY_SCOPE_AGENT); }
__device__ __forceinline__ unsigned xb_add(unsigned* p, unsigned v) { return __hip_atomic_fetch_add(p, v, __ATOMIC_RELAXED, __HIP_MEMORY_SCOPE_AGENT); }
__device__ __forceinline__ unsigned xb_xcc_id() { return (unsigned)__builtin_amdgcn_s_getreg((3 << 11) | 20) & 0xFu; }
#define XB_SPIN(cond, bar) do { unsigned _sp = 0; while (cond) { __builtin_amdgcn_s_sleep(1); \
    if ((++_sp & 255u) == 0u) { if (xb_ld(&(bar)[XB_TMO])) break; if (_sp > XB_SPIN_CAP) { atomicAdd(&(bar)[XB_TMO], 1u); break; } } } } while (0)
struct XcdBarrier { unsigned* bar; unsigned x; volatile LAS unsigned* st; };
__device__ __forceinline__ XcdBarrier xcd_barrier_post(unsigned* bar, volatile LAS unsigned* st) {
    XcdBarrier b; b.bar = bar; b.x = xb_xcc_id(); b.st = st;
    if (threadIdx.x == 0) (void)xb_add(&bar[XB_XCNT(b.x)], 1u);
    return b;
}
__device__ __forceinline__ void xcd_barrier_complete(unsigned* bar, unsigned x, unsigned& nloc, unsigned& nx) {
    const unsigned G = gridDim.x * gridDim.y * gridDim.z;
    unsigned sum, cnt, mine, sp = 0u;
    for (;;) {
        sum = 0u; cnt = 0u; mine = 0u;
#pragma unroll
        for (unsigned j = 0; j < 16; ++j) { const unsigned c = xb_ld(&bar[XB_XCNT(j)]); sum += c; cnt += (c > 0u) ? 1u : 0u; mine = (j == x) ? c : mine; }
        if (sum == G) break;
        __builtin_amdgcn_s_sleep(1);
        if ((++sp & 255u) == 0u) { if (xb_ld(&bar[XB_TMO])) break; if (sp > XB_SPIN_CAP) { atomicAdd(&bar[XB_TMO], 1u); break; } }
    }
    nloc = mine > 0u ? mine : 1u; nx = cnt > 0u ? cnt : 1u;
}
__device__ __forceinline__ void xcd_barrier(const XcdBarrier& b) {
    asm volatile("s_waitcnt vmcnt(0)" ::: "memory");
    __syncthreads();
    if (threadIdx.x == 0) {
        unsigned* bar = b.bar;
        __builtin_amdgcn_s_waitcnt(0);
        unsigned nloc = b.st[0], nx = b.st[1];
        if (nloc == 0u) { xcd_barrier_complete(bar, b.x, nloc, nx); b.st[0] = nloc; b.st[1] = nx; }
        const unsigned old = xb_add(&bar[XB_XSUB(b.x)], 1u);
        const unsigned gen = old / nloc;
        if (old + 1u == (gen + 1u) * nloc) {
            __builtin_amdgcn_fence(__ATOMIC_RELEASE, "agent");
            asm volatile("s_waitcnt vmcnt(0)" ::: "memory");
            const unsigned og = xb_add(&bar[XB_TOP], 1u);
            const unsigned tg = og / nx;
            if (og + 1u == (tg + 1u) * nx) xb_add(&bar[XB_TOPGEN], 1u);
            else XB_SPIN(xb_ld(&bar[XB_TOPGEN]) == tg, bar);
            __builtin_amdgcn_fence(__ATOMIC_ACQUIRE, "agent");
            xb_add(&bar[XB_XGEN(b.x)], 1u);
            asm volatile("s_waitcnt vmcnt(0)" ::: "memory");
        } else {
            XB_SPIN(xb_ld(&bar[XB_XGEN(b.x)]) == gen, bar);
            __builtin_amdgcn_fence(__ATOMIC_ACQUIRE, "agent");
            asm volatile("s_waitcnt vmcnt(0)" ::: "memory");
        }
    }
    __syncthreads();
}

__device__ __forceinline__ float wave_sum(float v) {
#pragma unroll
    for (int o = 32; o >= 1; o >>= 1) v += __shfl_xor(v, o);
    return v;
}
__device__ __forceinline__ float sigmoidf_(float x) { return 1.0f / (1.0f + expf(-x)); }
__device__ __forceinline__ float gelu_tanh(float x) { return 0.5f * x * (1.0f + tanhf(0.7978845608028654f * (x + 0.044715f * x * x * x))); }
__device__ __forceinline__ unsigned f2bf(float f) { unsigned u = __builtin_bit_cast(unsigned, f); return (u + 0x7fffu + ((u >> 16) & 1u)) >> 16; }
__device__ __forceinline__ unsigned pk2(float lo, float hi) { return pg8::cvt_pk_bf16(lo, hi); }
__device__ __forceinline__ float bflo(unsigned w) { return __uint_as_float(w << 16); }
__device__ __forceinline__ float bfhi(unsigned w) { return __uint_as_float(w & 0xffff0000u); }
typedef unsigned v4u __attribute__((ext_vector_type(4)));
typedef unsigned v2u __attribute__((ext_vector_type(2)));

struct Args { const float* in[35]; float* out; unsigned char* ws; int lo, hi; };

struct EpiF32Store {
    static constexpr bool PERM = false, AFTER_DRAIN = false;
    float* C; int ldc; int nvalid;
    __device__ __forceinline__ void operator()(const f32x4 (&acc)[2][2][4][2], const pg8::Unit& u, int wr, int wc, int fr, int fq) const {
        const int row0 = u.pm * 256 + wr * 64 + fr, col0 = u.pn * 256 + wc * 32 + 4 * fq;
#pragma unroll
        for (int ai = 0; ai < 2; ++ai)
#pragma unroll
            for (int m = 0; m < 4; ++m) { float* rowp = C + (size_t)(row0 + ai * 128 + m * 16) * ldc + col0;
#pragma unroll
                for (int bj = 0; bj < 2; ++bj)
#pragma unroll
                    for (int n = 0; n < 2; ++n) if (col0 + bj * 128 + n * 16 < nvalid) *(f32x4*)(rowp + bj * 128 + n * 16) = acc[ai][bj][m][n]; }
    }
};
struct EpiResid {
    static constexpr bool PERM = false, AFTER_DRAIN = false;
    const float* base; float* out;
    __device__ __forceinline__ void operator()(const f32x4 (&acc)[2][2][4][2], const pg8::Unit& u, int wr, int wc, int fr, int fq) const {
        const int row0 = u.pm * 256 + wr * 64 + fr, col0 = u.pn * 256 + wc * 32 + 4 * fq;
#pragma unroll
        for (int ai = 0; ai < 2; ++ai)
#pragma unroll
            for (int m = 0; m < 4; ++m) { const size_t off = (size_t)(row0 + ai * 128 + m * 16) * D + col0;
#pragma unroll
                for (int bj = 0; bj < 2; ++bj)
#pragma unroll
                    for (int n = 0; n < 2; ++n) { const f32x4 b = *(const f32x4*)(base + off + bj * 128 + n * 16); *(f32x4*)(out + off + bj * 128 + n * 16) = b + acc[ai][bj][m][n]; } }
    }
};
struct EpiSiluMul {
    static constexpr bool PERM = false, AFTER_DRAIN = false;
    bf16_t* HIDp;
    __device__ __forceinline__ void operator()(const f32x4 (&acc)[2][2][4][2], const pg8::Unit& u, int wr, int wc, int fr, int fq) const {
        const int pnl = u.pn % 22;
        const int row0 = u.pm * 256 + wr * 64 + fr, col0 = pnl * 128 + wc * 32 + 4 * fq;
#pragma unroll
        for (int ai = 0; ai < 2; ++ai)
#pragma unroll
            for (int m = 0; m < 4; ++m) { bf16_t* rowp = HIDp + (size_t)(row0 + ai * 128 + m * 16) * DE + col0;
#pragma unroll
                for (int n = 0; n < 2; ++n) { const f32x4 g = acc[ai][0][m][n], up = acc[ai][1][m][n]; float h[4];
#pragma unroll
                    for (int j = 0; j < 4; ++j) h[j] = g[j] / (1.0f + __expf(-g[j])) * up[j];
                    v2u w; w.x = pk2(h[0], h[1]); w.y = pk2(h[2], h[3]); *(v2u*)(rowp + n * 16) = w; } }
    }
};
struct EpiYE {
    static constexpr bool PERM = true, AFTER_DRAIN = false;
    const float* GATE; bf16_t* YE;
    __device__ __forceinline__ void operator()(const f32x4 (&acc)[2][2][4][2], const pg8::Unit& u, int wr, int wc, int fr, int fq) const {
        const int pnl = u.pn & 3;
        const int row0 = u.pm * 256 + wr * 64 + fr, col0 = pnl * 256 + wc * 32 + 8 * fq;
#pragma unroll
        for (int ai = 0; ai < 2; ++ai)
#pragma unroll
            for (int m = 0; m < 4; ++m) { const int row = row0 + ai * 128 + m * 16; const float gt_ = GATE[row]; bf16_t* rowp = YE + (size_t)row * D + col0;
#pragma unroll
                for (int bj = 0; bj < 2; ++bj) { const f32x4 v0 = acc[ai][bj][m][0] * gt_, v1 = acc[ai][bj][m][1] * gt_;
                    v4u w; w.x = pg8::cvt_pk_bf16(v0[0], v0[1]); w.y = pg8::cvt_pk_bf16(v0[2], v0[3]); w.z = pg8::cvt_pk_bf16(v1[0], v1[1]); w.w = pg8::cvt_pk_bf16(v1[2], v1[3]);
                    *(v4u*)(rowp + bj * 128) = w; } }
    }
};
struct EpiBf16Store {
    static constexpr bool PERM = true, AFTER_DRAIN = false;
    bf16_t* O; int ldc; float scale;
    __device__ __forceinline__ void operator()(const f32x4 (&acc)[2][2][4][2], const pg8::Unit& u, int wr, int wc, int fr, int fq) const {
        const int row0 = u.pm * 256 + wr * 64 + fr, col0 = u.pn * 256 + wc * 32 + 8 * fq;
#pragma unroll
        for (int ai = 0; ai < 2; ++ai)
#pragma unroll
            for (int m = 0; m < 4; ++m) { bf16_t* rowp = O + (size_t)(row0 + ai * 128 + m * 16) * ldc + col0;
#pragma unroll
                for (int bj = 0; bj < 2; ++bj) { const f32x4 v0 = acc[ai][bj][m][0] * scale, v1 = acc[ai][bj][m][1] * scale;
                    v4u w; w.x = pg8::cvt_pk_bf16(v0[0], v0[1]); w.y = pg8::cvt_pk_bf16(v0[2], v0[3]); w.z = pg8::cvt_pk_bf16(v1[0], v1[1]); w.w = pg8::cvt_pk_bf16(v1[2], v1[3]);
                    *(v4u*)(rowp + bj * 128) = w; } }
    }
};
struct EpiKV {
    static constexpr bool PERM = false, AFTER_DRAIN = false;
    bf16_t* K; bf16_t* Vt;
    __device__ __forceinline__ void operator()(const f32x4 (&acc)[2][2][4][2], const pg8::Unit& u, int wr, int wc, int fr, int fq) const {
        const int row0 = u.pm * 256 + wr * 64 + fr, col0 = u.pn * 256 + wc * 32 + 4 * fq;
#pragma unroll
        for (int ai = 0; ai < 2; ++ai)
#pragma unroll
            for (int m = 0; m < 4; ++m) { const int row = row0 + ai * 128 + m * 16;
#pragma unroll
                for (int bj = 0; bj < 2; ++bj)
#pragma unroll
                    for (int n = 0; n < 2; ++n) { const int col = col0 + bj * 128 + n * 16; const f32x4 v = acc[ai][bj][m][n];
                        if (col < 1024) { v2u w; w.x = pk2(v[0], v[1]); w.y = pk2(v[2], v[3]); *(v2u*)(K + (size_t)row * 1024 + col) = w; }
                        else { const int b = row >> 8, mm = row & 255; bf16_t* vp = Vt + ((size_t)(b * 1024 + (col - 1024)) * 256 + mm);
#pragma unroll
                            for (int j = 0; j < 4; ++j) vp[(size_t)j * 256] = (bf16_t)f2bf(v[j]); } } }
    }
};

constexpr float QSCALE = 0.125f * 1.4426950408889634f;
struct EpiEven {
    static constexpr bool PERM = true, AFTER_DRAIN = false;
    const float* rc; const float* rs; bf16_t* QhA; bf16_t* KhA; bf16_t* QhB; bf16_t* KhB; bf16_t* PVb;
    __device__ __forceinline__ void operator()(const f32x4 (&acc)[2][2][4][2], const pg8::Unit& u, int wr, int wc, int fr, int fq) const {
        asm volatile("" : "+v"(fr), "+v"(fq));
        const int row0 = u.pm * 256 + wr * 64 + fr;
#pragma unroll
        for (int bj = 0; bj < 2; ++bj) {
            const int c0 = u.pn * 256 + bj * 128 + wc * 32 + 8 * fq;
            int kind; bf16_t* base; int stride; float sc = 1.0f;
            if (c0 < 512) { kind = 0; base = QhA + ((size_t)(c0 >> 6) * T) * 64 + (c0 & 63); stride = 64; sc = QSCALE; }
            else if (c0 < 1024) { kind = 0; base = KhA + ((size_t)((c0 - 512) >> 6) * T) * 64 + (c0 & 63); stride = 64; }
            else if (c0 < 1536) { kind = 1; base = PVb + (c0 - 1024); stride = 640; }
            else if (c0 < 2048) { kind = 0; base = QhB + ((size_t)((c0 - 1536) >> 6) * T) * 64 + (c0 & 63); stride = 64; sc = QSCALE; }
            else if (c0 < 2176) { kind = 0; base = KhB + ((size_t)((c0 - 2048) >> 6) * T) * 64 + (c0 & 63); stride = 64; }
            else { kind = 1; base = PVb + 512 + (c0 - 2176); stride = 640; }
            const int pi = (c0 & 63) >> 1;
#pragma unroll
            for (int ai = 0; ai < 2; ++ai)
#pragma unroll
                for (int m = 0; m < 4; ++m) {
                    const int tok = row0 + ai * 128 + m * 16;
                    const f32x4 v0 = acc[ai][bj][m][0], v1 = acc[ai][bj][m][1];
                    float y[8];
                    if (kind == 0) {
                        const int s = tok & (S - 1);
                        const f32x4 c4 = *(const f32x4*)(rc + s * 32 + pi), s4 = *(const f32x4*)(rs + s * 32 + pi);
                        y[0] = (v0[0] * c4[0] - v0[1] * s4[0]) * sc; y[1] = (v0[1] * c4[0] + v0[0] * s4[0]) * sc;
                        y[2] = (v0[2] * c4[1] - v0[3] * s4[1]) * sc; y[3] = (v0[3] * c4[1] + v0[2] * s4[1]) * sc;
                        y[4] = (v1[0] * c4[2] - v1[1] * s4[2]) * sc; y[5] = (v1[1] * c4[2] + v1[0] * s4[2]) * sc;
                        y[6] = (v1[2] * c4[3] - v1[3] * s4[3]) * sc; y[7] = (v1[3] * c4[3] + v1[2] * s4[3]) * sc;
                    } else { y[0] = v0[0]; y[1] = v0[1]; y[2] = v0[2]; y[3] = v0[3]; y[4] = v1[0]; y[5] = v1[1]; y[6] = v1[2]; y[7] = v1[3]; }
                    v4u w; w.x = pk2(y[0], y[1]); w.y = pk2(y[2], y[3]); w.z = pk2(y[4], y[5]); w.w = pk2(y[6], y[7]);
                    *(v4u*)(base + (size_t)tok * stride) = w;
                }
        }
    }
};

struct EpiLora {
    static constexpr bool PERM = false, AFTER_DRAIN = false;
    const float *w0, *a0, *k_a; const bf16_t *KB, *KK; bf16_t *LW, *KD, *BB, *G;
    __device__ __forceinline__ void operator()(const f32x4 (&acc)[2][2][4][2], const pg8::Unit& u, int wr, int wc, int fr, int fq) const {
        asm volatile("" : "+v"(fr), "+v"(fq));
        const int row0 = u.pm * 256 + wr * 64 + fr;
#pragma unroll
        for (int bj = 0; bj < 2; ++bj)
#pragma unroll
            for (int n = 0; n < 2; ++n) {
                const int c0 = u.pn * 256 + bj * 128 + wc * 32 + n * 16 + 4 * fq, sec = c0 >> 9, cc = c0 & 511;
#pragma unroll
                for (int ai = 0; ai < 2; ++ai)
#pragma unroll
                    for (int m = 0; m < 4; ++m) {
                        const size_t tok = row0 + ai * 128 + m * 16;
                        const f32x4 v = acc[ai][bj][m][n];
                        if (sec < 2) {
                            const f32x4 w = *(const f32x4*)(w0 + sec * 512 + cc); float o[4];
#pragma unroll
                            for (int j = 0; j < 4; ++j) { const float xw = -(w[j] + v[j]);
                                o[j] = -0.6065306597126334f / (1.0f + __expf(xw)); }
                            v2u ww; ww.x = pk2(o[0], o[1]); ww.y = pk2(o[2], o[3]);
                            *(v2u*)(LW + ((size_t)sec * T + tok) * 512 + cc) = ww;
                        } else if (sec < 4) {
                            const int d = sec - 2;
                            const f32x4 a_ = *(const f32x4*)(a0 + d * 512 + cc), ka = *(const f32x4*)(k_a + cc);
                            const v2u kw = *(const v2u*)(KB + tok * 512 + cc), kkw = *(const v2u*)(KK + tok * 512 + cc);
                            const float kv[4] = {bflo(kw.x), bfhi(kw.x), bflo(kw.y), bfhi(kw.y)}, kk[4] = {bflo(kkw.x), bfhi(kkw.x), bflo(kkw.y), bfhi(kkw.y)};
                            float okd[4], obb[4];
#pragma unroll
                            for (int j = 0; j < 4; ++j) { const float alr = 1.0f / (1.0f + __expf(-(a_[j] + v[j]))); okd[j] = kv[j] * (1.0f + (alr - 1.0f) * ka[j]); obb[j] = kk[j] * alr; }
                            v2u w1, w2_; w1.x = pk2(okd[0], okd[1]); w1.y = pk2(okd[2], okd[3]); w2_.x = pk2(obb[0], obb[1]); w2_.y = pk2(obb[2], obb[3]);
                            *(v2u*)(KD + ((size_t)d * T + tok) * 512 + cc) = w1; *(v2u*)(BB + ((size_t)d * T + tok) * 512 + cc) = w2_;
                        } else { v2u ww; ww.x = pk2(v[0], v[1]); ww.y = pk2(v[2], v[3]); *(v2u*)(G + tok * 512 + cc) = ww; }
                        __builtin_amdgcn_sched_barrier(0);
                    }
            }
    }
};

__device__ __forceinline__ float clamp8(float x) { return __builtin_amdgcn_fmed3f(x, -448.f, 448.f); }
__device__ __forceinline__ unsigned pk4_fp8(float a, float b, float c, float d) {
    int w = 0; w = __builtin_amdgcn_cvt_pk_fp8_f32(clamp8(a), clamp8(b), w, false); w = __builtin_amdgcn_cvt_pk_fp8_f32(clamp8(c), clamp8(d), w, true); return (unsigned)w;
}
struct EpiSiluMul8 {
    static constexpr bool PERM = false, AFTER_DRAIN = false;
    unsigned char* HIDp;
    __device__ __forceinline__ void operator()(const f32x4 (&acc)[2][2][4][2], const pg8::Unit& u, int wr, int wc, int fr, int fq) const {
        asm volatile("s_nop 7\n\ts_nop 7\n\ts_nop 7"); __builtin_amdgcn_sched_barrier(0);
        const int pnl = u.pn % 22;
        const int row0 = u.pm * 256 + wr * 64 + fr, col0 = pnl * 128 + wc * 32 + 4 * fq;
        const float s1 = 1.0f / (ASC8 * GUSC8);
#pragma unroll
        for (int ai = 0; ai < 2; ++ai)
#pragma unroll
            for (int m = 0; m < 4; ++m) { unsigned char* rowp = HIDp + (size_t)(row0 + ai * 128 + m * 16) * DE + col0;
#pragma unroll
                for (int n = 0; n < 2; ++n) { const f32x4 g = acc[ai][0][m][n] * s1, up = acc[ai][1][m][n] * (s1 * HSC8); float h[4];
#pragma unroll
                    for (int j = 0; j < 4; ++j) h[j] = g[j] / (1.0f + __expf(-g[j])) * up[j];
                    *(unsigned*)(rowp + n * 16) = pk4_fp8(h[0], h[1], h[2], h[3]); } }
    }
};
struct EpiYE8 {
    static constexpr bool PERM = true, AFTER_DRAIN = false;
    const float* GATE; bf16_t* YE;
    __device__ __forceinline__ void operator()(const f32x4 (&acc)[2][2][4][2], const pg8::Unit& u, int wr, int wc, int fr, int fq) const {
        asm volatile("s_nop 7\n\ts_nop 7\n\ts_nop 7"); __builtin_amdgcn_sched_barrier(0);
        const int pnl = u.pn & 3;
        const int row0 = u.pm * 256 + wr * 64 + fr, col0 = pnl * 256 + wc * 32 + 8 * fq;
#pragma unroll
        for (int ai = 0; ai < 2; ++ai)
#pragma unroll
            for (int m = 0; m < 4; ++m) { const int row = row0 + ai * 128 + m * 16; const float gt_ = GATE[row] * (1.0f / (HSC8 * DSC8)); bf16_t* rowp = YE + (size_t)row * D + col0;
#pragma unroll
                for (int bj = 0; bj < 2; ++bj) { const f32x4 v0 = acc[ai][bj][m][0] * gt_, v1 = acc[ai][bj][m][1] * gt_;
                    v4u w; w.x = pk2(v0[0], v0[1]); w.y = pk2(v0[2], v0[3]); w.z = pk2(v1[0], v1[1]); w.w = pk2(v1[2], v1[3]);
                    *(v4u*)(rowp + bj * 128) = w; } }
    }
};
template <class RowMap>
__device__ __forceinline__ void transpose_item_fp8(const float* W, int K, int N, unsigned char* WT, RowMap rm, float sc, LAS float* scr, int item, int lane) {
    const int nblk = N / 64, kb = item / nblk, nb_ = item % nblk, k0 = 64 * kb, n0 = 64 * nb_;
    f32x4 ld[16];
#pragma unroll
    for (int i = 0; i < 16; ++i) ld[i] = *(const f32x4*)(W + (size_t)(k0 + 4 * i + (lane >> 4)) * N + n0 + 4 * (lane & 15));
#pragma unroll
    for (int i = 0; i < 16; ++i) { LAS float* p = scr + (4 * i + (lane >> 4)) * 65 + 4 * (lane & 15); p[0] = ld[i][0]; p[1] = ld[i][1]; p[2] = ld[i][2]; p[3] = ld[i][3]; }
    asm volatile("s_waitcnt lgkmcnt(0)" ::: "memory");
    const int c = lane & 3;
#pragma unroll
    for (int j = 0; j < 4; ++j) { const int n = (lane >> 2) + 16 * j; const LAS float* s = scr + (16 * c) * 65 + n;
        v4u o;
#pragma unroll
        for (int q = 0; q < 4; ++q) o[q] = pk4_fp8(s[(4 * q) * 65] * sc, s[(4 * q + 1) * 65] * sc, s[(4 * q + 2) * 65] * sc, s[(4 * q + 3) * 65] * sc);
        *(v4u*)(WT + (size_t)rm(n0 + n) * K + k0 + 16 * c) = o; }
    asm volatile("s_waitcnt lgkmcnt(0)" ::: "memory");
}
struct MoeOrder {
    int G, c, npairs;
    int per;
    __device__ __forceinline__ bool next(int i, pg8::Unit& u) const {
        const int x = c & 7, y = c >> 3, pml = y & 7, pnq = y >> 3;
        const int epn = i * 32 + x * 4 + pnq;
        if (epn >= npairs || c >= 256) return false;
        const int e = epn / per;
        u.pm = e * 8 + pml; u.pn = epn; return true;
    }
    __device__ __forceinline__ void a_ready(const pg8::Unit&) const {}
    __device__ __forceinline__ void done(const pg8::Unit&) const {}
};

template <class RowMap>
__device__ __forceinline__ void transpose_item(const float* W, int K, int N, bf16_t* WT, RowMap rm, LAS float* scr, int item, int lane) {
    const int nblk = N / 64, kb = item / nblk, nb_ = item % nblk, k0 = 64 * kb, n0 = 64 * nb_;
    f32x4 ld[16];
#pragma unroll
    for (int i = 0; i < 16; ++i) ld[i] = *(const f32x4*)(W + (size_t)(k0 + 4 * i + (lane >> 4)) * N + n0 + 4 * (lane & 15));
#pragma unroll
    for (int i = 0; i < 16; ++i) { LAS float* p = scr + (4 * i + (lane >> 4)) * 65 + 4 * (lane & 15); p[0] = ld[i][0]; p[1] = ld[i][1]; p[2] = ld[i][2]; p[3] = ld[i][3]; }
    asm volatile("s_waitcnt lgkmcnt(0)" ::: "memory");
    const int c = lane & 7;
#pragma unroll
    for (int j = 0; j < 8; ++j) { const int n = (lane >> 3) + 8 * j; const LAS float* s = scr + (8 * c) * 65 + n;
        v4u o; o.x = pk2(s[0 * 65], s[1 * 65]); o.y = pk2(s[2 * 65], s[3 * 65]); o.z = pk2(s[4 * 65], s[5 * 65]); o.w = pk2(s[6 * 65], s[7 * 65]);
        *(v4u*)(WT + (size_t)rm(n0 + n) * K + k0 + 8 * c) = o; }
    asm volatile("s_waitcnt lgkmcnt(0)" ::: "memory");
}

__device__ __forceinline__ void rmsnorm_rows_bf16(const float* x, const float* g, bf16_t* out, int M) {
    const int tix_ = tidx(); const int lane = tix_ & 63, gw = blockIdx.x * 8 + (tix_ >> 6), ngw = gridDim.x * 8;
    for (int m = gw; m < M; m += ngw) {
        const float4* xr = (const float4*)(x + (size_t)m * D);
        float4 v[4]; float s = 0.f;
#pragma unroll
        for (int j = 0; j < 4; ++j) { v[j] = xr[lane + 64 * j]; s += v[j].x * v[j].x + v[j].y * v[j].y + v[j].z * v[j].z + v[j].w * v[j].w; }
        const float r = rsqrtf(wave_sum(s) * (1.0f / D) + 1e-6f);
        v2u* o = (v2u*)(out + (size_t)m * D);
#pragma unroll
        for (int j = 0; j < 4; ++j) { const float4 gg = ((const float4*)g)[lane + 64 * j];
            v2u w; w.x = pk2(v[j].x * r * gg.x, v[j].y * r * gg.y); w.y = pk2(v[j].z * r * gg.z, v[j].w * r * gg.w); o[lane + 64 * j] = w; }
    }
}
__device__ __forceinline__ void rmsnorm_rows_f32(const float* x, const float* g, float* out, int M) {
    const int tix_ = tidx(); const int lane = tix_ & 63, gw = blockIdx.x * 8 + (tix_ >> 6), ngw = gridDim.x * 8;
    for (int m = gw; m < M; m += ngw) {
        const float4* xr = (const float4*)(x + (size_t)m * D);
        float4 v[4]; float s = 0.f;
#pragma unroll
        for (int j = 0; j < 4; ++j) { v[j] = xr[lane + 64 * j]; s += v[j].x * v[j].x + v[j].y * v[j].y + v[j].z * v[j].z + v[j].w * v[j].w; }
        const float r = rsqrtf(wave_sum(s) * (1.0f / D) + 1e-6f);
        float4* o = (float4*)(out + (size_t)m * D);
#pragma unroll
        for (int j = 0; j < 4; ++j) { const float4 gg = ((const float4*)g)[lane + 64 * j];
            o[lane + 64 * j] = make_float4(v[j].x * r * gg.x, v[j].y * r * gg.y, v[j].z * r * gg.z, v[j].w * r * gg.w); }
    }
}

__device__ __forceinline__ int block_exscan(int v, int* sh, int* tot) {
    const int tid = tidx(), lane = tid & 63, w = tid >> 6;
    int inc = v;
#pragma unroll
    for (int o = 1; o < 64; o <<= 1) { const int t = __shfl_up(inc, o); if (lane >= o) inc += t; }
    __syncthreads();
    if (lane == 63) sh[w] = inc;
    __syncthreads();
    int base = 0, total = 0;
#pragma unroll
    for (int i = 0; i < 8; ++i) { const int x = sh[i]; if (i < w) base += x; total += x; }
    *tot = total;
    return base + inc - v;
}


typedef short bf16x8 __attribute__((ext_vector_type(8)));
typedef float f32x16 __attribute__((ext_vector_type(16)));
constexpr int MROW = 144;
constexpr int MBUF = 64 * MROW;
__device__ __forceinline__ bf16x8 frag_rm(const LAS unsigned char* M, int row0, int k0, int fr, int fq) {
    return *(const LAS bf16x8*)(M + (row0 + fr) * MROW + (k0 + 8 * fq) * 2);
}
__device__ __forceinline__ bf16x8 frag_cm(const LAS unsigned char* M, int k0, int col0, int fr, int fq) {
    const LAS unsigned short* p = (const LAS unsigned short*)(M + (k0 + 8 * fq) * MROW + (col0 + fr) * 2);
    bf16x8 v;
#pragma unroll
    for (int j = 0; j < 8; ++j) v[j] = (short)p[j * (MROW / 2)];
    return v;
}
__device__ __forceinline__ void tile_store_bf16(LAS unsigned char* M, int m0, int n0, int fr, int fq, const f32x4& c) {
    v2u w; w.x = pk2(c[0], c[1]); w.y = pk2(c[2], c[3]);
    *(LAS v2u*)(M + (m0 + fr) * MROW + (n0 + 4 * fq) * 2) = w;
}
#define MMA16(acc, lf, rf) acc = __builtin_amdgcn_mfma_f32_16x16x32_bf16(rf, lf, acc, 0, 0, 0)

__device__ __forceinline__ void scan_r1(const bf16_t* LWg, const bf16_t* RVg, const bf16_t* KDg, const bf16_t* KKg, const bf16_t* BBg,
                                        bf16_t* PT, bf16_t* QT, bf16_t* RH, float* YL, unsigned char* lds_raw) {
    LAS unsigned char* L = (LAS unsigned char*)lds_raw;
    LAS unsigned char* mAT = L + 0 * MBUF; LAS unsigned char* mRT = L + 1 * MBUF; LAS unsigned char* mBT = L + 2 * MBUF; LAS unsigned char* mKT = L + 3 * MBUF;
    LAS unsigned char* mV = L + 4 * MBUF; LAS unsigned char* mN0 = L + 5 * MBUF; LAS unsigned char* mN1 = L + 6 * MBUF; LAS unsigned char* mNAK = L + 7 * MBUF;
    LAS unsigned char* mNRB = L + 8 * MBUF; LAS unsigned char* mNRK = L + 9 * MBUF; LAS unsigned char* mT0 = L + 10 * MBUF; LAS unsigned char* mT1 = L + 11 * MBUF;
    LAS unsigned char* mW = L + 12 * MBUF;
    LAS float* LWs = (LAS float*)(L + 13 * MBUF);
    const int tid = tidx(), lane = tid & 63, wave = tid >> 6, fr = lane & 15, fq = lane >> 4;
    const int tm = wave >> 1, tn0 = (wave & 1) * 2;
    const int m0 = tm * 16;
    for (int item = blockIdx.x; item < 4096; item += gridDim.x) {
        const int c = item & 127, h = (item >> 7) & 7, n = item >> 10, dir = n >> 1, b = n & 1;
        const int t = tid >> 3, i0 = (tid & 7) * 8;
        const int pos = dir ? (S - 1 - (c * 64 + t)) : (c * 64 + t);
        const size_t tok = (size_t)b * S + pos;
        const size_t ch = (size_t)h * 64 + i0;
        const v4u lw4 = *(const v4u*)(LWg + ((size_t)dir * T + tok) * 512 + ch);
        const v4u r4 = *(const v4u*)(RVg + tok * D + ch), v4 = *(const v4u*)(RVg + tok * D + 512 + ch);
        const v4u kd4 = *(const v4u*)(KDg + ((size_t)dir * T + tok) * 512 + ch), kk4 = *(const v4u*)(KKg + tok * 512 + ch), bb4 = *(const v4u*)(BBg + ((size_t)dir * T + tok) * 512 + ch);
        float lw[8], Lin[8];
#pragma unroll
        for (int q = 0; q < 4; ++q) { lw[2 * q] = bflo(lw4[q]); lw[2 * q + 1] = bfhi(lw4[q]); }
#pragma unroll
        for (int j = 0; j < 8; ++j) { float x = lw[j];
#pragma unroll
            for (int o = 8; o < 64; o <<= 1) { const float y = __shfl_up(x, o); if (lane >= o) x += y; }
            Lin[j] = x; }
        __syncthreads();
        if (lane >= 56) {
#pragma unroll
            for (int j = 0; j < 8; ++j) LWs[64 + wave * 64 + i0 + j] = Lin[j]; }
        __syncthreads();
        {
            float off[8];
#pragma unroll
            for (int j = 0; j < 8; ++j) off[j] = 0.f;
            for (int w = 0; w < 8; ++w) { if (w < wave) {
#pragma unroll
                for (int j = 0; j < 8; ++j) off[j] += LWs[64 + w * 64 + i0 + j]; } }
#pragma unroll
            for (int j = 0; j < 8; ++j) Lin[j] += off[j];
            if (t == 63) {
#pragma unroll
                for (int j = 0; j < 8; ++j) LWs[i0 + j] = Lin[j]; }
            float at_[8], rt_[8], bt_[8], kt_[8];
#pragma unroll
            for (int q = 0; q < 4; ++q) {
#pragma unroll
                for (int e = 0; e < 2; ++e) { const int j = 2 * q + e;
                    const float ein = __expf(Lin[j]), einv = __expf(-Lin[j]), eex = __expf(Lin[j] - lw[j]);
                    const float kkv = e ? bfhi(kk4[q]) : bflo(kk4[q]), rv_ = e ? bfhi(r4[q]) : bflo(r4[q]), bbv = e ? bfhi(bb4[q]) : bflo(bb4[q]), kdv = e ? bfhi(kd4[q]) : bflo(kd4[q]);
                    at_[j] = -kkv * eex; rt_[j] = rv_ * ein; bt_[j] = bbv * einv; kt_[j] = kdv * einv; }
            }
            v4u w;
            w.x = pk2(at_[0], at_[1]); w.y = pk2(at_[2], at_[3]); w.z = pk2(at_[4], at_[5]); w.w = pk2(at_[6], at_[7]); *(LAS v4u*)(mAT + t * MROW + i0 * 2) = w;
            w.x = pk2(rt_[0], rt_[1]); w.y = pk2(rt_[2], rt_[3]); w.z = pk2(rt_[4], rt_[5]); w.w = pk2(rt_[6], rt_[7]); *(LAS v4u*)(mRT + t * MROW + i0 * 2) = w;
            w.x = pk2(bt_[0], bt_[1]); w.y = pk2(bt_[2], bt_[3]); w.z = pk2(bt_[4], bt_[5]); w.w = pk2(bt_[6], bt_[7]); *(LAS v4u*)(mBT + t * MROW + i0 * 2) = w;
            w.x = pk2(kt_[0], kt_[1]); w.y = pk2(kt_[2], kt_[3]); w.z = pk2(kt_[4], kt_[5]); w.w = pk2(kt_[6], kt_[7]); *(LAS v4u*)(mKT + t * MROW + i0 * 2) = w;
            *(LAS v4u*)(mV + t * MROW + i0 * 2) = v4;
        }
        __syncthreads();
        f32x4 Tacc[2];
        {
            bf16x8 la[2], lr[2];
#pragma unroll
            for (int ks = 0; ks < 2; ++ks) { la[ks] = frag_rm(mAT, m0, 32 * ks, fr, fq); lr[ks] = frag_rm(mRT, m0, 32 * ks, fr, fq); }
#pragma unroll
            for (int q = 0; q < 2; ++q) {
                const int n0 = (tn0 + q) * 16;
                f32x4 cab = {0.f, 0.f, 0.f, 0.f}, cak = cab, crb = cab, crk = cab;
#pragma unroll
                for (int ks = 0; ks < 2; ++ks) {
                    const bf16x8 rb_ = frag_rm(mBT, n0, 32 * ks, fr, fq), rk_ = frag_rm(mKT, n0, 32 * ks, fr, fq);
                    MMA16(cab, la[ks], rb_); MMA16(cak, la[ks], rk_); MMA16(crb, lr[ks], rb_); MMA16(crk, lr[ks], rk_);
                }
                const int tt = m0 + fr;
#pragma unroll
                for (int j = 0; j < 4; ++j) { const int ss = n0 + 4 * fq + j;
                    if (!(ss < tt)) { cab[j] = 0.f; cak[j] = 0.f; }
                    if (!(ss <= tt)) { crb[j] = 0.f; crk[j] = 0.f; } }
                tile_store_bf16(mN0, m0, n0, fr, fq, cab); tile_store_bf16(mNAK, m0, n0, fr, fq, cak);
                tile_store_bf16(mNRB, m0, n0, fr, fq, crb); tile_store_bf16(mNRK, m0, n0, fr, fq, crk);
#pragma unroll
                for (int j = 0; j < 4; ++j) cab[j] += ((n0 + 4 * fq + j) == tt) ? 1.f : 0.f;
                Tacc[q] = cab;
                tile_store_bf16(mT0, m0, n0, fr, fq, cab);
            }
        }
        __syncthreads();
        {
            bf16x8 lk[2], ln_[2];
#pragma unroll
            for (int ks = 0; ks < 2; ++ks) { lk[ks] = frag_rm(mNAK, m0, 32 * ks, fr, fq); ln_[ks] = frag_rm(mN0, m0, 32 * ks, fr, fq); }
#pragma unroll
            for (int q = 0; q < 2; ++q) {
                const int n0 = (tn0 + q) * 16;
                f32x4 cw = {0.f, 0.f, 0.f, 0.f}, cn = cw;
#pragma unroll
                for (int ks = 0; ks < 2; ++ks) { MMA16(cw, lk[ks], frag_cm(mV, 32 * ks, n0, fr, fq)); MMA16(cn, ln_[ks], frag_cm(mN0, 32 * ks, n0, fr, fq)); }
                tile_store_bf16(mW, m0, n0, fr, fq, cw); tile_store_bf16(mN1, m0, n0, fr, fq, cn);
            }
        }
        __syncthreads();
#pragma unroll
        for (int k = 1; k <= 5; ++k) {
            LAS unsigned char* Nk = (k & 1) ? mN1 : mN0; LAS unsigned char* Nn = (k & 1) ? mN0 : mN1;
            LAS unsigned char* Tk = ((k - 1) & 1) ? mT1 : mT0; LAS unsigned char* Tn = ((k - 1) & 1) ? mT0 : mT1;
            bf16x8 lt[2], ln_[2];
#pragma unroll
            for (int ks = 0; ks < 2; ++ks) { lt[ks] = frag_rm(Tk, m0, 32 * ks, fr, fq); ln_[ks] = frag_rm(Nk, m0, 32 * ks, fr, fq); }
#pragma unroll
            for (int q = 0; q < 2; ++q) {
                const int n0 = (tn0 + q) * 16;
                f32x4 cn = {0.f, 0.f, 0.f, 0.f};
#pragma unroll
                for (int ks = 0; ks < 2; ++ks) { const bf16x8 rn = frag_cm(Nk, 32 * ks, n0, fr, fq); MMA16(Tacc[q], lt[ks], rn); if (k < 5) MMA16(cn, ln_[ks], rn); }
                tile_store_bf16(Tn, m0, n0, fr, fq, Tacc[q]);
                if (k < 5) tile_store_bf16(Nn, m0, n0, fr, fq, cn);
            }
            __syncthreads();
        }
        {
            bf16x8 lt[2];
#pragma unroll
            for (int ks = 0; ks < 2; ++ks) lt[ks] = frag_rm(mT1, m0, 32 * ks, fr, fq);
#pragma unroll
            for (int q = 0; q < 2; ++q) {
                const int n0 = (tn0 + q) * 16;
                f32x4 ca = {0.f, 0.f, 0.f, 0.f}, cu = ca;
#pragma unroll
                for (int ks = 0; ks < 2; ++ks) { MMA16(ca, lt[ks], frag_cm(mAT, 32 * ks, n0, fr, fq)); MMA16(cu, lt[ks], frag_cm(mW, 32 * ks, n0, fr, fq)); }
                tile_store_bf16(mN0, m0, n0, fr, fq, ca); tile_store_bf16(mT0, m0, n0, fr, fq, cu);
            }
        }
        __syncthreads();
        LAS unsigned char* mAH = mN0; LAS unsigned char* mUL = mT0;
        {
            bf16x8 lrb[2], lrk[2];
#pragma unroll
            for (int ks = 0; ks < 2; ++ks) { lrb[ks] = frag_rm(mNRB, m0, 32 * ks, fr, fq); lrk[ks] = frag_rm(mNRK, m0, 32 * ks, fr, fq); }
#pragma unroll 1
            for (int q = 0; q < 2; ++q) {
                const int n0 = (tn0 + q) * 16;
                f32x4 crh = {0.f, 0.f, 0.f, 0.f}, cyl = crh;
#pragma unroll
                for (int ks = 0; ks < 2; ++ks) {
                    const bf16x8 ra = frag_cm(mAH, 32 * ks, n0, fr, fq); MMA16(crh, lrb[ks], ra);
                    const bf16x8 ru = frag_cm(mUL, 32 * ks, n0, fr, fq); MMA16(cyl, lrb[ks], ru);
                    const bf16x8 rv = frag_cm(mV, 32 * ks, n0, fr, fq); MMA16(cyl, lrk[ks], rv);
                }
                const size_t o = (size_t)item * 4096 + (size_t)(m0 + fr) * 64 + n0 + 4 * fq;
                { const LAS unsigned short* rp = (const LAS unsigned short*)(mRT + (m0 + fr) * MROW + (n0 + 4 * fq) * 2);
#pragma unroll
                  for (int j = 0; j < 4; ++j) crh[j] += __uint_as_float(((unsigned)rp[j]) << 16); }
                { v2u w; w.x = pk2(crh[0], crh[1]); w.y = pk2(crh[2], crh[3]); *(v2u*)(RH + o) = w; }
                *(f32x4*)(YL + o) = cyl;
            }
        }
        {
            bf16x8 lb[2], lkt[2];
#pragma unroll
            for (int ks = 0; ks < 2; ++ks) { lb[ks] = frag_cm(mBT, 32 * ks, m0, fr, fq); lkt[ks] = frag_cm(mKT, 32 * ks, m0, fr, fq); }
            const float wc = __expf(LWs[m0 + fr]);
#pragma unroll 1
            for (int q = 0; q < 2; ++q) {
                const int n0 = (tn0 + q) * 16;
                f32x4 cp = {0.f, 0.f, 0.f, 0.f}, cq = cp;
#pragma unroll
                for (int ks = 0; ks < 2; ++ks) {
                    const bf16x8 ra = frag_cm(mAH, 32 * ks, n0, fr, fq); MMA16(cp, lb[ks], ra);
                    const bf16x8 ru = frag_cm(mUL, 32 * ks, n0, fr, fq); MMA16(cq, lb[ks], ru);
                    const bf16x8 rv = frag_cm(mV, 32 * ks, n0, fr, fq); MMA16(cq, lkt[ks], rv);
                }
                const size_t o = (size_t)item * 4096 + (size_t)(m0 + fr) * 64 + n0 + 4 * fq;
#pragma unroll
                for (int j = 0; j < 4; ++j) { cp[j] = wc * (cp[j] + (((n0 + 4 * fq + j) == (m0 + fr)) ? 1.f : 0.f)); cq[j] *= wc; }
                { v2u w; w.x = pk2(cp[0], cp[1]); w.y = pk2(cp[2], cp[3]); *(v2u*)(PT + o) = w; }
                { v2u w; w.x = pk2(cq[0], cq[1]); w.y = pk2(cq[2], cq[3]); *(v2u*)(QT + o) = w; }
            }
        }
    }
}

__device__ __forceinline__ bf16x8 pack_acc8(const f32x16& x, int s) {
    v4u p; p.x = pk2(x[8 * s], x[8 * s + 1]); p.y = pk2(x[8 * s + 2], x[8 * s + 3]); p.z = pk2(x[8 * s + 4], x[8 * s + 5]); p.w = pk2(x[8 * s + 6], x[8 * s + 7]);
    return __builtin_bit_cast(bf16x8, p);
}
__device__ __forceinline__ void scan_r2(const bf16_t* PT, const bf16_t* QT, bf16_t* S0, unsigned char* lds_raw) {
    LAS unsigned char* L = (LAS unsigned char*)lds_raw;
    constexpr int SLOT_B = MBUF + 8192;
    const int tid = tidx(), lane = tid & 63, wave = tid >> 6;
    const int r = lane & 31, h2 = lane >> 5, jb = wave;
    f32x16 st[2];
#pragma unroll
    for (int ib = 0; ib < 2; ++ib)
#pragma unroll
        for (int g = 0; g < 16; ++g) st[ib][g] = 0.f;
    const size_t item0 = (size_t)blockIdx.x * 128;
    v4u stage[16];
#pragma unroll
    for (int q = 0; q < 16; ++q) { const int p = tid + 512 * q, cc = p >> 10, w = p & 1023, mat = w >> 9, idx = w & 511;
        stage[q] = *(const v4u*)((mat ? QT : PT) + (item0 + cc) * 4096 + idx * 8); }
    for (int grp = 0; grp < 16; ++grp) {
        __syncthreads();
#pragma unroll
        for (int q = 0; q < 16; ++q) { const int p = tid + 512 * q, cc = p >> 10, w = p & 1023, mat = w >> 9, idx = w & 511;
            *(LAS v4u*)(L + cc * SLOT_B + (mat ? (MBUF + idx * 16) : ((idx >> 3) * MROW + (idx & 7) * 16))) = stage[q]; }
        __syncthreads();
        if (grp < 15) {
#pragma unroll
            for (int q = 0; q < 16; ++q) { const int p = tid + 512 * q, cc = p >> 10, w = p & 1023, mat = w >> 9, idx = w & 511;
                stage[q] = *(const v4u*)((mat ? QT : PT) + (item0 + (grp + 1) * 8 + cc) * 4096 + idx * 8); }
        }
        if (wave < 2) {
#pragma unroll 1
            for (int cc = 0; cc < 8; ++cc) {
                const size_t item = item0 + grp * 8 + cc;
                const LAS unsigned char* Pm = L + cc * SLOT_B; const LAS unsigned char* Qm = Pm + MBUF;
                bf16_t* sp = S0 + item * 4096 + (size_t)(32 * jb + r) * 64;
#pragma unroll
                for (int ib = 0; ib < 2; ++ib)
#pragma unroll
                    for (int g = 0; g < 4; ++g) { v2u w; w.x = pk2(st[ib][4 * g], st[ib][4 * g + 1]); w.y = pk2(st[ib][4 * g + 2], st[ib][4 * g + 3]); *(v2u*)(sp + 32 * ib + 8 * g + 4 * h2) = w; }
                f32x16 nw[2];
#pragma unroll
                for (int ib = 0; ib < 2; ++ib)
#pragma unroll
                    for (int g = 0; g < 16; ++g) nw[ib][g] = __uint_as_float(((unsigned)*(const LAS unsigned short*)(Qm + (32 * ib + (g & 3) + 8 * (g >> 2) + 4 * h2) * 128 + (32 * jb + r) * 2)) << 16);
#pragma unroll
                for (int kb = 0; kb < 2; ++kb)
#pragma unroll
                    for (int s2 = 0; s2 < 2; ++s2) {
                        const bf16x8 bfr = pack_acc8(st[kb], s2);
#pragma unroll
                        for (int ib = 0; ib < 2; ++ib) {
                            const LAS unsigned char* ap = Pm + (32 * ib + r) * MROW + (32 * kb + 16 * s2 + 4 * h2) * 2;
                            const v2u lo = *(const LAS v2u*)ap, hi = *(const LAS v2u*)(ap + 16);
                            v4u av; av.x = lo.x; av.y = lo.y; av.z = hi.x; av.w = hi.y;
                            nw[ib] = __builtin_amdgcn_mfma_f32_32x32x16_bf16(__builtin_bit_cast(bf16x8, av), bfr, nw[ib], 0, 0, 0);
                        }
                    }
                st[0] = nw[0]; st[1] = nw[1];
            }
        }
    }
}
__device__ __forceinline__ void scan_r3(const bf16_t* RH, const float* YL, const bf16_t* S0, const bf16_t* RVg, const bf16_t* KDg, const bf16_t* Gg,
                                        const float* r_k, const float* lng, const float* lnb, bf16_t* Y) {
    const int tid = tidx(), lane = tid & 63, wave = tid >> 6, fr = lane & 15, fq = lane >> 4;
    const int tmw = wave & 3;
    for (int it2 = blockIdx.x * 2 + (wave >> 2); it2 < 2048; it2 += gridDim.x * 2) {
        const int b = it2 >> 10, h = (it2 >> 7) & 7, pc = it2 & 127;
        f32x4 acc[4];
#pragma unroll
        for (int q = 0; q < 4; ++q) acc[q] = (f32x4){0.f, 0.f, 0.f, 0.f};
#pragma unroll 1
        for (int dirn = 0; dirn < 2; ++dirn) {
            const size_t item = (size_t)((dirn * 2 + b) * 8 + h) * 128 + (dirn ? 127 - pc : pc);
            const int row = dirn ? 63 - (16 * tmw + fr) : 16 * tmw + fr;
            const bf16_t* rp = RH + item * 4096 + (size_t)row * 64;
            bf16x8 lf[2];
#pragma unroll
            for (int ks = 0; ks < 2; ++ks) lf[ks] = *(const bf16x8*)(rp + 32 * ks + 8 * fq);
#pragma unroll
            for (int q = 0; q < 4; ++q) {
                const bf16_t* sp = S0 + item * 4096 + (size_t)(16 * q + fr) * 64;
#pragma unroll
                for (int ks = 0; ks < 2; ++ks) { const bf16x8 rf = *(const bf16x8*)(sp + 32 * ks + 8 * fq); MMA16(acc[q], lf[ks], rf); }
                acc[q] += *(const f32x4*)(YL + item * 4096 + (size_t)row * 64 + 16 * q + 4 * fq);
            }
        }
        float sm = 0.f;
#pragma unroll
        for (int q = 0; q < 4; ++q) sm += (acc[q][0] + acc[q][1]) + (acc[q][2] + acc[q][3]);
        sm += __shfl_xor(sm, 16); sm += __shfl_xor(sm, 32);
        const float mean = sm * (1.0f / 64.f);
        float sq = 0.f;
#pragma unroll
        for (int q = 0; q < 4; ++q)
#pragma unroll
            for (int j = 0; j < 4; ++j) { const float d = acc[q][j] - mean; sq += d * d; }
        sq += __shfl_xor(sq, 16); sq += __shfl_xor(sq, 32);
        const float rstd = rsqrtf(sq * (1.0f / 64.f) + 64e-5f);
        const size_t tok = (size_t)b * S + pc * 64 + 16 * tmw + fr;
        float bon = 0.f; f32x4 vv[4];
#pragma unroll
        for (int q = 0; q < 4; ++q) {
            const int c = h * 64 + 16 * q + 4 * fq;
            const v2u rw = *(const v2u*)(RVg + tok * D + c), k0 = *(const v2u*)(KDg + tok * 512 + c), k1 = *(const v2u*)(KDg + ((size_t)T + tok) * 512 + c), vw = *(const v2u*)(RVg + tok * D + 512 + c);
            const f32x4 rk4 = *(const f32x4*)(r_k + c);
            vv[q] = (f32x4){bflo(vw.x), bfhi(vw.x), bflo(vw.y), bfhi(vw.y)};
            bon += bflo(rw.x) * (bflo(k0.x) + bflo(k1.x)) * rk4[0] + bfhi(rw.x) * (bfhi(k0.x) + bfhi(k1.x)) * rk4[1] + bflo(rw.y) * (bflo(k0.y) + bflo(k1.y)) * rk4[2] + bfhi(rw.y) * (bfhi(k0.y) + bfhi(k1.y)) * rk4[3];
        }
        bon += __shfl_xor(bon, 16); bon += __shfl_xor(bon, 32);
#pragma unroll
        for (int q = 0; q < 4; ++q) {
            const int c = h * 64 + 16 * q + 4 * fq;
            const v2u gw_ = *(const v2u*)(Gg + tok * 512 + c); const f32x4 g4 = {bflo(gw_.x), bfhi(gw_.x), bflo(gw_.y), bfhi(gw_.y)}, lg = *(const f32x4*)(lng + c), lb = *(const f32x4*)(lnb + c);
            float o[4];
#pragma unroll
            for (int j = 0; j < 4; ++j) o[j] = ((acc[q][j] - mean) * rstd * lg[j] + lb[j] + bon * vv[q][j]) * g4[j];
            v2u w; w.x = pk2(o[0], o[1]); w.y = pk2(o[2], o[3]);
            *(v2u*)(Y + tok * D + 512 + c) = w;
        }
    }
}


__device__ __forceinline__ bf16x8 pack8(float a0, float a1, float a2, float a3, float a4, float a5, float a6, float a7) {
    v4u p; p.x = pk2(a0, a1); p.y = pk2(a2, a3); p.z = pk2(a4, a5); p.w = pk2(a6, a7);
    return __builtin_bit_cast(bf16x8, p);
}
#define MMA32(acc, af, bf_) acc = __builtin_amdgcn_mfma_f32_32x32x16_bf16(af, bf_, acc, 0, 0, 0)
__device__ __forceinline__ void xattn_mfma(const bf16_t* Qb, const bf16_t* Kb, const bf16_t* Vt, bf16_t* Y, unsigned char* lds_raw) {
    LAS unsigned char* L = (LAS unsigned char*)lds_raw;
    constexpr int KRS = 528, VRS = 520;
    const int tid = tidx(), lane = tid & 63, wave = tid >> 6, r = lane & 31, h2 = lane >> 5;
    for (int it = blockIdx.x; it < 256; it += gridDim.x) {
        const int qblk = it & 31, h = (it >> 5) & 3, b = it >> 7;
        const size_t tok = (size_t)b * S + qblk * 256 + wave * 32 + r;
        bf16x8 qf[16];
#pragma unroll
        for (int ks = 0; ks < 16; ++ks) qf[ks] = *(const bf16x8*)(Qb + tok * D + h * 256 + 16 * ks + 8 * h2);
        __syncthreads();
#pragma unroll
        for (int hf = 0; hf < 2; ++hf) {
            v4u stg[8];
#pragma unroll
            for (int q = 0; q < 8; ++q) { const int p = tid + 512 * (8 * hf + q); stg[q] = *(const v4u*)(Kb + (size_t)(b * MEM + (p >> 5)) * 1024 + h * 256 + (p & 31) * 8); }
#pragma unroll
            for (int q = 0; q < 8; ++q) { const int p = tid + 512 * (8 * hf + q); *(LAS v4u*)(L + (p >> 5) * KRS + (p & 31) * 16) = stg[q]; }
        }
        __syncthreads();
        float mx = -3.0e38f;
#pragma unroll 1
        for (int kb = 0; kb < 8; ++kb) {
            f32x16 st;
#pragma unroll
            for (int g = 0; g < 16; ++g) st[g] = 0.f;
            const LAS unsigned char* kp = L + (32 * kb + r) * KRS + 16 * h2;
#pragma unroll
            for (int ks = 0; ks < 16; ++ks) { const bf16x8 kf = *(const LAS bf16x8*)(kp + 32 * ks); MMA32(st, kf, qf[ks]); }
#pragma unroll
            for (int g = 0; g < 16; ++g) mx = fmaxf(mx, st[g]);
        }
        mx = fmaxf(mx, __shfl_xor(mx, 32));
        const float cs = 0.0625f * 1.4426950408889634f;
        float l = 0.f;
        bf16x8 pf[8][2];
#pragma unroll
        for (int kb = 0; kb < 8; ++kb) {
            f32x16 st;
#pragma unroll
            for (int g = 0; g < 16; ++g) st[g] = 0.f;
            const LAS unsigned char* kp = L + (32 * kb + r) * KRS + 16 * h2;
#pragma unroll
            for (int ks = 0; ks < 16; ++ks) { const bf16x8 kf = *(const LAS bf16x8*)(kp + 32 * ks); MMA32(st, kf, qf[ks]); }
#pragma unroll
            for (int g = 0; g < 16; ++g) { st[g] = __builtin_amdgcn_exp2f((st[g] - mx) * cs); l += st[g]; }
#pragma unroll
            for (int s2 = 0; s2 < 2; ++s2) pf[kb][s2] = pack8(st[8 * s2], st[8 * s2 + 1], st[8 * s2 + 2], st[8 * s2 + 3], st[8 * s2 + 4], st[8 * s2 + 5], st[8 * s2 + 6], st[8 * s2 + 7]);
            __builtin_amdgcn_sched_barrier(0);
        }
        l += __shfl_xor(l, 32);
        const float inv = 1.0f / l;
        __syncthreads();
#pragma unroll
        for (int hf = 0; hf < 2; ++hf) {
            v4u stg[8];
#pragma unroll
            for (int q = 0; q < 8; ++q) { const int p = tid + 512 * (8 * hf + q); stg[q] = *(const v4u*)(Vt + ((size_t)(b * 1024 + h * 256 + (p >> 5))) * 256 + (p & 31) * 8); }
#pragma unroll
            for (int q = 0; q < 8; ++q) { const int p = tid + 512 * (8 * hf + q); LAS v2u* lp = (LAS v2u*)(L + (p >> 5) * VRS + (p & 31) * 16);
                v2u a_; a_.x = stg[q].x; a_.y = stg[q].y; lp[0] = a_; a_.x = stg[q].z; a_.y = stg[q].w; lp[1] = a_; }
        }
        __syncthreads();
#pragma unroll 1
        for (int db = 0; db < 8; ++db) {
            f32x16 acc;
#pragma unroll
            for (int g = 0; g < 16; ++g) acc[g] = 0.f;
            const LAS unsigned char* vp = L + (32 * db + r) * VRS + 8 * h2;
#pragma unroll
            for (int kb = 0; kb < 8; ++kb)
#pragma unroll
                for (int s2 = 0; s2 < 2; ++s2) {
                    const v2u lo = *(const LAS v2u*)(vp + (32 * kb + 16 * s2) * 2), hi = *(const LAS v2u*)(vp + (32 * kb + 16 * s2 + 8) * 2);
                    v4u av; av.x = lo.x; av.y = lo.y; av.z = hi.x; av.w = hi.y;
                    MMA32(acc, __builtin_bit_cast(bf16x8, av), pf[kb][s2]);
                }
            int tl_ = tid; asm volatile("" : "+v"(tl_));
            bf16_t* yp = Y + ((size_t)b * S + qblk * 256 + (tl_ >> 6) * 32 + (tl_ & 31)) * D + h * 256 + 32 * db + 4 * ((tl_ >> 5) & 1);
#pragma unroll
            for (int g = 0; g < 4; ++g) { v2u w; w.x = pk2(acc[4 * g] * inv, acc[4 * g + 1] * inv); w.y = pk2(acc[4 * g + 2] * inv, acc[4 * g + 3] * inv); *(v2u*)(yp + 8 * g) = w; }
        }
    }
}
template <bool F32OUT>
__device__ __forceinline__ void combine_norm(float* X, const bf16_t* YE, const int* SLOT, const float* g, bf16_t* Hout, float* Fout) {
    const int tix_ = tidx(); const int lane = tix_ & 63, gw = blockIdx.x * 8 + (tix_ >> 6), ngw = gridDim.x * 8;
    for (int m = gw; m < T; m += ngw) {
        float4* xr = (float4*)(X + (size_t)m * D);
        float4 v[4];
#pragma unroll
        for (int j = 0; j < 4; ++j) v[j] = xr[lane + 64 * j];
        const int myslot = SLOT[(size_t)m * NE + (lane & 15)];
#pragma unroll
        for (int e = 0; e < 16; ++e) {
            const int row = __builtin_amdgcn_readlane(myslot, e);
            if (row >= 0) {
                const v2u* yp = (const v2u*)(YE + (size_t)row * D);
#pragma unroll
                for (int j = 0; j < 4; ++j) { const v2u w = yp[lane + 64 * j];
                    v[j].x += __uint_as_float(w.x << 16); v[j].y += __uint_as_float(w.x & 0xffff0000u); v[j].z += __uint_as_float(w.y << 16); v[j].w += __uint_as_float(w.y & 0xffff0000u); }
            }
        }
        float s = 0.f;
#pragma unroll
        for (int j = 0; j < 4; ++j) { if (!F32OUT) xr[lane + 64 * j] = v[j]; s += v[j].x * v[j].x + v[j].y * v[j].y + v[j].z * v[j].z + v[j].w * v[j].w; }
        const float r = rsqrtf(wave_sum(s) * (1.0f / D) + 1e-6f);
#pragma unroll
        for (int j = 0; j < 4; ++j) { const float4 gg = ((const float4*)g)[lane + 64 * j];
            if (F32OUT) ((float4*)(Fout + (size_t)m * D))[lane + 64 * j] = make_float4(v[j].x * r * gg.x, v[j].y * r * gg.y, v[j].z * r * gg.z, v[j].w * r * gg.w);
            else { v2u w; w.x = pk2(v[j].x * r * gg.x, v[j].y * r * gg.y); w.y = pk2(v[j].z * r * gg.z, v[j].w * r * gg.w); ((v2u*)(Hout + (size_t)m * D))[lane + 64 * j] = w; } }
    }
}


__device__ __forceinline__ void vtrans_pass(const bf16_t* PVb, bf16_t* VtA, bf16_t* VtB, unsigned char* lds_raw) {
    LAS unsigned char* L = (LAS unsigned char*)lds_raw;
    const int tid = tidx(), lane = tid & 63, wave = tid >> 6;
    constexpr int RS = 136;
    for (int it = blockIdx.x; it < 640; it += gridDim.x) {
        const int vh = it % 10, tl = (it / 10) & 31, b = it / 320, s0 = tl * 256;
        __syncthreads();
        { const int tk = tid >> 1, half = tid & 1;
          const v4u* gp = (const v4u*)(PVb + (size_t)(b * S + s0 + tk) * 640 + vh * 64 + half * 32);
#pragma unroll
          for (int q = 0; q < 4; ++q) { const v4u x = gp[q]; LAS v2u* lp = (LAS v2u*)(L + tk * RS + half * 64 + q * 16); v2u a_; a_.x = x.x; a_.y = x.y; lp[0] = a_; a_.x = x.z; a_.y = x.w; lp[1] = a_; } }
        __syncthreads();
        const int npat = vh < 8 ? 3 : 1;
        for (int pat = 0; pat < npat; ++pat) {
            const int dd = pat == 0 ? 1 : (pat == 1 ? 4 : 16), seg = 256 / dd;
            const int o = 4 * lane, rho = o / seg, qq0 = o % seg;
            const size_t gpos = (size_t)b * S + (size_t)rho * (S / dd) + s0 / dd + qq0;
#pragma unroll
            for (int i = 0; i < 8; ++i) {
                const int d = wave * 8 + i;
                unsigned short x[4];
#pragma unroll
                for (int jj = 0; jj < 4; ++jj) x[jj] = *(const LAS unsigned short*)(L + ((qq0 + jj) * dd + rho) * RS + d * 2);
                v2u w; w.x = (unsigned)x[0] | ((unsigned)x[1] << 16); w.y = (unsigned)x[2] | ((unsigned)x[3] << 16);
                bf16_t* dst = vh < 8 ? (VtA + ((size_t)pat * 512 + vh * 64 + d) * T + gpos) : (VtB + ((size_t)(vh - 8) * 64 + d) * T + gpos);
                *(v2u*)dst = w;
            }
        }
    }
}

template <int NK, bool SINK>
__device__ __forceinline__ void attn_tile(const bf16_t* Qh, const bf16_t* Kh, const bf16_t* Vt, int dd, int Lr, int b, int rho, int q0, float sink2,
                                          bf16_t* Odst, int ostride, float* lsedst, int lane) {
    const int r = lane & 31, h2 = lane >> 5;
    const size_t qtok = (size_t)b * S + (size_t)(q0 + r) * dd + rho;
    bf16x8 qf[4];
#pragma unroll
    for (int ks = 0; ks < 4; ++ks) qf[ks] = *(const bf16x8*)(Qh + qtok * 64 + 16 * ks + 8 * h2);
    f32x16 o[2];
#pragma unroll
    for (int db = 0; db < 2; ++db)
#pragma unroll
        for (int g = 0; g < 16; ++g) o[db][g] = 0.f;
    float m = SINK ? sink2 : -1.0e30f, l = SINK ? 1.f : 0.f;
#pragma unroll 1
    for (int kb = -NK; kb <= NK; ++kb) {
        const int kq0 = q0 + 32 * kb;
        if (kq0 < 0 || kq0 >= Lr) continue;
        const size_t ktok = (size_t)b * S + (size_t)(kq0 + r) * dd + rho;
        f32x16 st;
#pragma unroll
        for (int g = 0; g < 16; ++g) st[g] = 0.f;
        const bf16_t* kp = Kh + ktok * 64 + 8 * h2;
#pragma unroll
        for (int ks = 0; ks < 4; ++ks) { const bf16x8 kf = *(const bf16x8*)(kp + 16 * ks); MMA32(st, kf, qf[ks]); }
        if (kb == -NK || kb == NK) {
#pragma unroll
            for (int g = 0; g < 16; ++g) { const int cr = (g & 3) + 8 * (g >> 2) + 4 * h2; const bool ok = (kb < 0) ? (cr >= r) : (cr <= r); st[g] = ok ? st[g] : -1.0e30f; }
        }
        float bm = st[0];
#pragma unroll
        for (int g = 1; g < 16; ++g) bm = fmaxf(bm, st[g]);
        bm = fmaxf(bm, __shfl_xor(bm, 32));
        const float mn = fmaxf(m, bm), al = __builtin_amdgcn_exp2f(m - mn);
        float ls = 0.f;
#pragma unroll
        for (int g = 0; g < 16; ++g) { st[g] = __builtin_amdgcn_exp2f(st[g] - mn); ls += st[g]; }
        ls += __shfl_xor(ls, 32);
        l = l * al + ls; m = mn;
#pragma unroll
        for (int db = 0; db < 2; ++db)
#pragma unroll
            for (int g = 0; g < 16; ++g) o[db][g] *= al;
        bf16x8 pf[2];
#pragma unroll
        for (int s2 = 0; s2 < 2; ++s2) pf[s2] = pack8(st[8 * s2], st[8 * s2 + 1], st[8 * s2 + 2], st[8 * s2 + 3], st[8 * s2 + 4], st[8 * s2 + 5], st[8 * s2 + 6], st[8 * s2 + 7]);
        const size_t kpos = (size_t)b * S + (size_t)rho * Lr + kq0;
#pragma unroll
        for (int db = 0; db < 2; ++db) {
            const bf16_t* vp = Vt + (size_t)(32 * db + r) * T + kpos + 4 * h2;
#pragma unroll
            for (int s2 = 0; s2 < 2; ++s2) {
                const v2u lo = *(const v2u*)(vp + 16 * s2), hi = *(const v2u*)(vp + 16 * s2 + 8);
                v4u av; av.x = lo.x; av.y = lo.y; av.z = hi.x; av.w = hi.y;
                MMA32(o[db], __builtin_bit_cast(bf16x8, av), pf[s2]);
            }
        }
    }
    const float inv = 1.0f / l;
#pragma unroll
    for (int db = 0; db < 2; ++db) {
        bf16_t* op = Odst + qtok * ostride + 32 * db + 4 * h2;
#pragma unroll
        for (int g = 0; g < 4; ++g) { v2u w; w.x = pk2(o[db][4 * g] * inv, o[db][4 * g + 1] * inv); w.y = pk2(o[db][4 * g + 2] * inv, o[db][4 * g + 3] * inv); *(v2u*)(op + 8 * g) = w; }
    }
    if (lsedst != nullptr && h2 == 0) lsedst[qtok * 8] = (m + __builtin_amdgcn_logf(l)) * 0.6931471805599453f;
}

__device__ __forceinline__ void attn_phase_even(const bf16_t* QhA, const bf16_t* KhA, const bf16_t* VtA, const bf16_t* QhB, const bf16_t* KhB, const bf16_t* VtB,
                                                const float* sink, bf16_t* OA, float* LSE, bf16_t* Y) {
    const int tix_ = tidx(); const int lane = tix_ & 63, gw = blockIdx.x * 8 + (tix_ >> 6), ngw = gridDim.x * 8;
    for (int it = gw; it < 12288 + 4096; it += ngw) {
        if (it < 12288) {
            const int p = it >> 12, rem = it & 4095, head = rem >> 9, rem2 = rem & 511, b = rem2 >> 8, rem3 = rem2 & 255;
            const int dd = p == 0 ? 1 : (p == 1 ? 4 : 16), tpr = 256 / dd, rho = rem3 / tpr, q0 = (rem3 % tpr) * 32;
            attn_tile<2, false>(QhA + (size_t)head * T * 64, KhA + (size_t)head * T * 64, VtA + ((size_t)p * 512 + head * 64) * T, dd, S / dd, b, rho, q0, 0.f,
                                OA + (size_t)p * T * 512 + head * 64, 512, LSE + (size_t)p * T * 8 + head, lane);
        } else {
            const int itb = it - 12288, hq = itb >> 9, rem2 = itb & 511, b = rem2 >> 8, q0 = (rem2 & 255) * 32, kvh = hq >> 2;
            attn_tile<4, true>(QhB + (size_t)hq * T * 64, KhB + (size_t)kvh * T * 64, VtB + (size_t)kvh * 64 * T, 1, S, b, 0, q0, sink[hq] * 1.4426950408889634f,
                               Y + 512 + hq * 64, D, nullptr, lane);
        }
    }
}
__device__ __forceinline__ void attn_combine(const bf16_t* OA, const float* LSE, bf16_t* Y) {
    const int gt = blockIdx.x * NTH + tidx(), ngt = gridDim.x * NTH;
    for (int i = gt; i < T * 64; i += ngt) {
        const int tok = i >> 6, head = (i >> 3) & 7, c8 = i & 7;
        const float l0 = LSE[(size_t)tok * 8 + head], l1 = LSE[((size_t)T + tok) * 8 + head], l2 = LSE[((size_t)2 * T + tok) * 8 + head];
        const float mx = fmaxf(l0, fmaxf(l1, l2));
        float w0 = __expf(l0 - mx), w1 = __expf(l1 - mx), w2 = __expf(l2 - mx);
        const float inv = 1.0f / (w0 + w1 + w2); w0 *= inv; w1 *= inv; w2 *= inv;
        const size_t off = (size_t)tok * 512 + head * 64 + c8 * 8;
        const v4u x0 = *(const v4u*)(OA + off), x1 = *(const v4u*)(OA + (size_t)T * 512 + off), x2 = *(const v4u*)(OA + (size_t)2 * T * 512 + off);
        v4u w;
#pragma unroll
        for (int q = 0; q < 4; ++q) {
            const float lo = w0 * __uint_as_float(x0[q] << 16) + w1 * __uint_as_float(x1[q] << 16) + w2 * __uint_as_float(x2[q] << 16);
            const float hi = w0 * __uint_as_float(x0[q] & 0xffff0000u) + w1 * __uint_as_float(x1[q] & 0xffff0000u) + w2 * __uint_as_float(x2[q] & 0xffff0000u);
            w[q] = pk2(lo, hi);
        }
        *(v4u*)(Y + (size_t)tok * D + head * 64 + c8 * 8) = w;
    }
}


__device__ __forceinline__ void odd_token_pass(const bf16_t* P, const float* mu, const float* k_k, const float* clg, const float* clb,
                                               bf16_t* VN, bf16_t* RV, bf16_t* KBf, bf16_t* KK, bf16_t* F5) {
    const int tix_ = tidx(); const int lane = tix_ & 63, gw = blockIdx.x * 8 + (tix_ >> 6), ngw = gridDim.x * 8;
    for (int tok = gw; tok < T; tok += ngw) {
        const int s = tok & (S - 1);
        const bf16_t* pr = P + (size_t)tok * ODD_PAD;
        {
            float ge[8]; float sm = 0.f;
#pragma unroll
            for (int jj = 0; jj < 4; ++jj) { const unsigned w = *(const unsigned*)(pr + 512 + 2 * lane + 128 * jj);
                ge[2 * jj] = gelu_tanh(__uint_as_float(w << 16)); ge[2 * jj + 1] = gelu_tanh(__uint_as_float(w & 0xffff0000u)); sm += ge[2 * jj] + ge[2 * jj + 1]; }
            const float mean = wave_sum(sm) * (1.0f / 512.f); float sq = 0.f;
#pragma unroll
            for (int j = 0; j < 8; ++j) { const float d = ge[j] - mean; sq += d * d; }
            const float rstd = rsqrtf(wave_sum(sq) * (1.0f / 512.f) + 1e-5f);
#pragma unroll
            for (int jj = 0; jj < 4; ++jj) { const int c = 2 * lane + 128 * jj; const float2 g2_ = *(const float2*)(clg + c), b2_ = *(const float2*)(clb + c);
                *(unsigned*)(VN + (size_t)tok * 512 + c) = pk2((ge[2 * jj] - mean) * rstd * g2_.x + b2_.x, (ge[2 * jj + 1] - mean) * rstd * g2_.y + b2_.y); }
        }
#pragma unroll 5
        for (int jj = 0; jj < 15; ++jj) {
            const int c = 2 * lane + 128 * jj;
            const unsigned wf = *(const unsigned*)(pr + 1024 + c);
            const unsigned wp = s > 0 ? *(const unsigned*)(pr + 1024 + c - ODD_PAD) : 0u;
            const unsigned wn = s < S - 1 ? *(const unsigned*)(pr + 1024 + c + ODD_PAD) : 0u;
            const float2 m0 = *(const float2*)(mu + c), m1 = *(const float2*)(mu + FD + c);
            const float f0 = __uint_as_float(wf << 16), f1 = __uint_as_float(wf & 0xffff0000u);
            const float x0 = f0 + m0.x * (__uint_as_float(wp << 16) - f0) + m1.x * (__uint_as_float(wn << 16) - f0);
            const float x1 = f1 + m0.y * (__uint_as_float(wp & 0xffff0000u) - f1) + m1.y * (__uint_as_float(wn & 0xffff0000u) - f1);
            if (jj < 4) *(unsigned*)(RV + (size_t)tok * D + c) = pk2(x0, x1);
            else if (jj < 8) {
                const int ck = c - 512;
                *(unsigned*)(KBf + (size_t)tok * 512 + ck) = pk2(x0, x1);
                const float2 kk_ = *(const float2*)(k_k + ck);
                const float a0_ = x0 * kk_.x, a1_ = x1 * kk_.y;
                float ss = a0_ * a0_ + a1_ * a1_;
#pragma unroll
                for (int o = 16; o >= 1; o >>= 1) ss += __shfl_xor(ss, o);
                const float inv = 1.0f / fmaxf(sqrtf(ss), 1e-12f);
                *(unsigned*)(KK + (size_t)tok * 512 + ck) = pk2(a0_ * inv, a1_ * inv);
            }
            else if (jj < 12) *(unsigned*)(RV + (size_t)tok * D + 512 + (c - 1024)) = pk2(x0, x1);
            else if (jj == 12) *(unsigned*)(F5 + (size_t)tok * 384 + (c - 1536)) = pk2(tanhf(x0), tanhf(x1));
            else if (jj == 13) *(unsigned*)(F5 + (size_t)tok * 384 + 128 + (c - 1664)) = pk2(x0, x1);
            else *(unsigned*)(F5 + (size_t)tok * 384 + 256 + (c - 1792)) = pk2(sigmoidf_(x0), sigmoidf_(x1));
        }
    }
}
__device__ __forceinline__ void gating_pass(const bf16_t* VN, const bf16_t* Wsb, const float* bsp, const bf16_t* P, bf16_t* Y, unsigned char* lds_raw) {
    LAS unsigned char* L = (LAS unsigned char*)lds_raw;
    constexpr int RS = 272;
    const int tid = tidx(), lane = tid & 63, wave = tid >> 6, fr = lane & 15, fq = lane >> 4;
    for (int it = blockIdx.x; it < 512; it += gridDim.x) {
        const int g = it & 3, chunk = it >> 2;
        __syncthreads();
        { const int j = tid >> 2, q4 = tid & 3;
          const v4u* gp = (const v4u*)(VN + (size_t)(chunk * 128 + j) * 512 + g * 128 + 32 * q4);
#pragma unroll
          for (int q = 0; q < 4; ++q) { const v4u x = gp[q];
#pragma unroll
              for (int e = 0; e < 4; ++e) { const int c = 32 * q4 + 8 * q + 2 * e;
                  *(LAS unsigned short*)(L + c * RS + 2 * j) = (unsigned short)(x[e] & 0xffffu); *(LAS unsigned short*)(L + (c + 1) * RS + 2 * j) = (unsigned short)(x[e] >> 16); } } }
        __syncthreads();
        bf16x8 lf[4];
#pragma unroll
        for (int ks = 0; ks < 4; ++ks) lf[ks] = *(const bf16x8*)(Wsb + (size_t)(g * 128 + 16 * wave + fr) * 128 + 32 * ks + 8 * fq);
        const int i = 16 * wave + fr; const size_t tok = (size_t)chunk * 128 + i;
        const float bias = bsp[g * 128 + i];
#pragma unroll
        for (int tn = 0; tn < 8; ++tn) {
            f32x4 acc = {0.f, 0.f, 0.f, 0.f};
#pragma unroll
            for (int ks = 0; ks < 4; ++ks) { const bf16x8 rf = *(const LAS bf16x8*)(L + (16 * tn + fr) * RS + (32 * ks + 8 * fq) * 2); MMA16(acc, lf[ks], rf); }
            const int c = g * 128 + 16 * tn + 4 * fq;
            const v2u uw = *(const v2u*)(P + tok * ODD_PAD + c);
            const float u0 = gelu_tanh(__uint_as_float(uw.x << 16)), u1 = gelu_tanh(__uint_as_float(uw.x & 0xffff0000u)), u2 = gelu_tanh(__uint_as_float(uw.y << 16)), u3 = gelu_tanh(__uint_as_float(uw.y & 0xffff0000u));
            v2u w; w.x = pk2(u0 * (acc[0] + bias), u1 * (acc[1] + bias)); w.y = pk2(u2 * (acc[2] + bias), u3 * (acc[3] + bias));
            *(v2u*)(Y + tok * D + c) = w;
        }
    }
}


__device__ __forceinline__ void router_pass(const float* X, const float* g, const float* WRT  , float* AFF, int* SLOT, bf16_t* H) {
    const int tix_ = tidx(); const int lane = tix_ & 63, fr = lane & 15, fq = lane >> 4;
    const int gw = blockIdx.x * 8 + (tix_ >> 6), ngw = gridDim.x * 8;
    for (int tile = gw; tile < T / 16; tile += ngw) {
        const float* xr = X + (size_t)(tile * 16 + fr) * D + 4 * fq;
        const float* wr = WRT + (size_t)fr * D + 4 * fq;
        f32x4 acc = {0.f, 0.f, 0.f, 0.f}; float ss = 0.f;
#pragma unroll 8
        for (int s = 0; s < 64; ++s) {
            const f32x4 xa = *(const f32x4*)(xr + 16 * s), wb = *(const f32x4*)(wr + 16 * s);
            ss += (xa[0] * xa[0] + xa[1] * xa[1]) + (xa[2] * xa[2] + xa[3] * xa[3]);
#pragma unroll
            for (int c = 0; c < 4; ++c) acc = __builtin_amdgcn_mfma_f32_16x16x4f32(xa[c], wb[c], acc, 0, 0, 0);
        }
        ss += __shfl_xor(ss, 16); ss += __shfl_xor(ss, 32);
        const float rstd = rsqrtf(ss * (1.0f / D) + 1e-6f);
        float aff[4];
#pragma unroll
        for (int jj = 0; jj < 4; ++jj) {
            const float lg = acc[jj] * __shfl(rstd, 4 * fq + jj);
            float mx = lg;
#pragma unroll
            for (int o = 1; o < 16; o <<= 1) mx = fmaxf(mx, __shfl_xor(mx, o));
            const float e = expf(lg - mx); float den = e;
#pragma unroll
            for (int o = 1; o < 16; o <<= 1) den += __shfl_xor(den, o);
            aff[jj] = e / den;
        }
#pragma unroll
        for (int jj = 0; jj < 4; ++jj) { const size_t o = (size_t)(tile * 16 + 4 * fq + jj) * NE + fr; AFF[o] = aff[jj]; SLOT[o] = -1; }
#pragma unroll 4
        for (int t = 0; t < 16; ++t) {
            const float rs = __shfl(rstd, t);
            const f32x4* xp = (const f32x4*)(X + (size_t)(tile * 16 + t) * D); v2u* hp = (v2u*)(H + (size_t)(tile * 16 + t) * D);
#pragma unroll
            for (int j = 0; j < 4; ++j) { const f32x4 v = xp[lane + 64 * j], gg = ((const f32x4*)g)[lane + 64 * j];
                v2u w; w.x = pk2(v[0] * rs * gg[0], v[1] * rs * gg[1]); w.y = pk2(v[2] * rs * gg[2], v[3] * rs * gg[3]); hp[lane + 64 * j] = w; }
        }
    }
}

#define IN(k) (lo <= (k) && (k) < hi)
#define REP_LOOP for (int rep_ = 0, nrep_ = ((ph == PROBE_PHASE) ? PROBE_REP : 1); rep_ < nrep_; ++rep_)
#define SEAM(k) do { if (IN(k) && IN((k) + 1)) xcd_barrier(bar); } while (0)
#define PROLOG \
    const int tid = tidx(), lane = tid & 63, wave = tid >> 6; \
    const int bid = blockIdx.x, nb = gridDim.x; \
    const int gw = bid * 8 + wave, ngw = nb * 8; \
    const int gt = bid * NTH + tid, ngt = nb * NTH; \
    (void)gt; (void)ngt; (void)gw; (void)ngw; (void)lane; (void)wave; \
    unsigned char* ws = a.ws; \
    const int lo = a.lo, hi = a.hi; \
    float* ldsf = (float*)lds_raw; (void)ldsf; \
    PG8_LAS unsigned char* ldsp = (PG8_LAS unsigned char*)lds_raw; (void)ldsp; \
    const float* x_in = a.in[0]; const float* mem = a.in[1]; (void)x_in; (void)mem; \
    float* ropec = (float*)(ws + WS_ROPE); float* ropes = ropec + S * 32; (void)ropec; (void)ropes; \
    float* AFF = (float*)(ws + WS_AFF); int* TOK = (int*)(ws + WS_TOK); float* GATE = (float*)(ws + WS_GATE); \
    float* X = (float*)(ws + WS_X); bf16_t* H = (bf16_t*)(ws + WS_H); bf16_t* P = (bf16_t*)(ws + WS_P); \
    bf16_t* Y = (bf16_t*)(ws + WS_Y); bf16_t* Q = (bf16_t*)(ws + WS_Q); bf16_t* KV = (bf16_t*)(ws + WS_KV); bf16_t* MN = (bf16_t*)(ws + WS_MN); \
    bf16_t* DEC = (bf16_t*)(ws + WS_DEC); bf16_t* KD = (bf16_t*)(ws + WS_KD); bf16_t* BB = (bf16_t*)(ws + WS_BB); \
    bf16_t* KK = (bf16_t*)(ws + WS_KK); bf16_t* G = (bf16_t*)(ws + WS_G); float* YS = (float*)(ws + WS_YS); \
    bf16_t* RV = (bf16_t*)(ws + WS_RV); bf16_t* VN = (bf16_t*)(ws + WS_VN); \
    bf16_t* XE = (bf16_t*)(ws + WS_XE); bf16_t* HID = (bf16_t*)(ws + WS_HID); int* SLOT = (int*)(ws + WS_SLOT); bf16_t* YE = (bf16_t*)(ws + WS_YE); (void)SLOT; (void)YE; \
    (void)AFF; (void)TOK; (void)GATE; (void)X; (void)H; (void)P; (void)Y; (void)Q; (void)KV; (void)MN; (void)DEC; (void)KD; (void)BB; (void)KK; (void)G; (void)YS; (void)RV; (void)VN; (void)XE; (void)HID;

template <class Epi>
__device__ __forceinline__ void dense_gemm(PG8_LAS unsigned char* ldsp, const bf16_t* A, const bf16_t* Bt, int M, int N, int K, const Epi& E) {
    asm volatile("" : "+s"(K));
    pg8::Gemm g{A, Bt, M, N, K}; pg8::StaticOrder So; So.init(M, N, (int)gridDim.x, (int)blockIdx.x);
    pg8::gemm_phase<Epi, pg8::StaticOrder, false>(ldsp, g, So, E, nullptr);
}

__device__ __forceinline__ int odd_phases(const Args& a, const XcdBarrier& bar, unsigned char* lds_raw, int ph) {
    PROLOG
    if (IN(ph)) combine_norm<false>(X, YE, SLOT, a.in[6], H, nullptr);
    SEAM(ph); ++ph;
    if (IN(ph)) dense_gemm(ldsp, H, (const bf16_t*)(ws + WS_WOIN), T, ODD_PAD, D, EpiBf16Store{P, ODD_PAD, 1.0f});
    SEAM(ph); ++ph;
    if (IN(ph)) REP_LOOP odd_token_pass(P, a.in[12], a.in[18], a.in[8], a.in[9], VN, RV, (bf16_t*)(ws + WS_KB), KK, (bf16_t*)(ws + WS_F5));
    SEAM(ph); ++ph;
    if (IN(ph)) REP_LOOP {
        gating_pass(VN, (const bf16_t*)(ws + WS_WSB), a.in[11], P, Y, lds_raw);
        __syncthreads();
        dense_gemm(ldsp, (const bf16_t*)(ws + WS_F5), (const bf16_t*)(ws + WS_WL), T, 2560, 384,
                   EpiLora{a.in[13], a.in[15], a.in[19], (const bf16_t*)(ws + WS_KB), KK, DEC, KD, BB, G});
    }
    SEAM(ph); ++ph;
    if (IN(ph)) REP_LOOP scan_r1(DEC, RV, KD, KK, BB, (bf16_t*)(ws + WS_PT), (bf16_t*)(ws + WS_QT), (bf16_t*)(ws + WS_RH), (float*)(ws + WS_YL), lds_raw);
    SEAM(ph); ++ph;
    if (IN(ph)) REP_LOOP {
        if (bid < 32) scan_r2((const bf16_t*)(ws + WS_PT), (const bf16_t*)(ws + WS_QT), (bf16_t*)(ws + WS_S0), lds_raw);
        else {
            LAS float* scr = (LAS float*)((LAS unsigned char*)lds_raw + wave * 16896);
            const int gw2 = (bid - 32) * 8 + wave, ngw2 = (nb - 32) * 8;
            auto gmap = [](int n) { return (n >> 7) * 256 + (n & 127); };
            auto umap = [](int n) { return (n >> 7) * 256 + 128 + (n & 127); };
            for (int it = gw2; it < 16 * 704; it += ngw2) { const int e = it / 704, r = it % 704;
                transpose_item_fp8(a.in[31] + (size_t)(16 + e) * D * DE, D, DE, ws + WS_WGU8 + 176 * MiB + (size_t)e * 5632 * D, gmap, GUSC8, scr, r, lane); }
            for (int it = gw2; it < 16 * 704; it += ngw2) { const int e = it / 704, r = it % 704;
                transpose_item_fp8(a.in[32] + (size_t)(16 + e) * D * DE, D, DE, ws + WS_WGU8 + 176 * MiB + (size_t)e * 5632 * D, umap, GUSC8, scr, r, lane); }
        }
    }
    SEAM(ph); ++ph;
    if (IN(ph)) REP_LOOP scan_r3((const bf16_t*)(ws + WS_RH), (const float*)(ws + WS_YL), (const bf16_t*)(ws + WS_S0), RV, KD, G, a.in[20], a.in[21], a.in[22], Y);
    SEAM(ph); ++ph;
    if (IN(ph)) dense_gemm(ldsp, Y, (const bf16_t*)(ws + WS_WOOUT), T, D, D, EpiResid{X, X});
    SEAM(ph); ++ph;
    return ph;
}

template <int layer>
__device__ __forceinline__ int tail_phases(const Args& a, const XcdBarrier& bar, unsigned char* lds_raw, int ph) {
    PROLOG
    if (IN(ph)) { rmsnorm_rows_bf16(X, a.in[24] + layer * D, H, T); rmsnorm_rows_bf16(mem, a.in[25] + layer * D, MN, NB * MEM); }
    SEAM(ph); ++ph;
    if (IN(ph)) {
        dense_gemm(ldsp, H, (const bf16_t*)(ws + WS_WQ) + (size_t)layer * D * D, T, D, D, EpiBf16Store{Q, D, 1.0f});
        dense_gemm(ldsp, MN, (const bf16_t*)(ws + WS_WKV) + (size_t)layer * 2048 * D, NB * MEM, 2048, D, EpiKV{KV, KV + 512 * 1024});
    }
    SEAM(ph); ++ph;
    if (IN(ph)) REP_LOOP xattn_mfma(Q, KV, KV + 512 * 1024, Y, lds_raw);
    SEAM(ph); ++ph;
    if (IN(ph)) dense_gemm(ldsp, Y, (const bf16_t*)(ws + WS_WO) + (size_t)layer * D * D, T, D, D, EpiResid{X, X});
    SEAM(ph); ++ph;
    if (IN(ph)) REP_LOOP router_pass(X, a.in[29] + layer * D, (const float*)(ws + WS_WRT) + (size_t)layer * NE * D, AFF, SLOT, H);
    SEAM(ph); ++ph;
    if (IN(ph)) REP_LOOP {
        unsigned* keys = (unsigned*)ldsf;
        int* hist = (int*)(ldsf + 8192);
        int* sh = hist + 256;
        if (bid >= 32) {
            LAS float* scr = (LAS float*)((LAS unsigned char*)lds_raw + wave * 16896);
            const int gw2 = (bid - 32) * 8 + wave, ngw2 = (nb - 32) * 8;
            auto ident = [](int n) { return n; };
            for (int it = gw2; it < 16 * 704; it += ngw2) { const int mt = layer * 16 + it / 704, r = it % 704;
                if constexpr (layer == 1 || F8L0) transpose_item_fp8(a.in[33] + (size_t)mt * DE * D, DE, D, ws + WS_WD8 + (size_t)layer * 88 * MiB + (size_t)(mt - 16 * layer) * D * DE, ident, DSC8, scr, r, lane);
                else transpose_item(a.in[33] + (size_t)mt * DE * D, DE, D, (bf16_t*)(ws + WS_WD) + (size_t)mt * D * DE, ident, scr, r, lane); }
        }
        for (int be = bid; be < NB * NE && be < 32; be += nb) {
            const int b = be >> 4, e = be & 15, eb = e * 2 + b;
            __syncthreads();
            for (int s = tid; s < S; s += NTH) keys[s] = __float_as_uint(AFF[(size_t)(b * S + s) * NE + e]);
            unsigned prefix = 0u; int krem = CAP;
            for (int pass = 3; pass >= 0; --pass) {
                __syncthreads();
                if (tid < 256) hist[tid] = 0;
                __syncthreads();
                const unsigned hmask = pass == 3 ? 0u : (0xFFFFFFFFu << (8 * (pass + 1)));
                for (int s = tid; s < S; s += NTH) { const unsigned k = keys[s]; if ((k & hmask) == prefix) atomicAdd(&hist[(k >> (8 * pass)) & 255u], 1); }
                __syncthreads();
                if (tid == 0) {
                    int cum = 0, bsel = 0;
                    for (int bb = 255; bb >= 0; --bb) { const int c = hist[bb]; if (cum + c >= krem) { bsel = bb; break; } cum += c; }
                    sh[8] = bsel; sh[9] = krem - cum;
                }
                __syncthreads();
                prefix |= ((unsigned)sh[8]) << (8 * pass); krem = sh[9];
            }
            const unsigned thr = prefix;
            int ce = 0;
            for (int i = 0; i < 16; ++i) { const unsigned k = keys[tid * 16 + i]; ce += (k == thr); }
            int tot;
            const int eqbase = block_exscan(ce, sh, &tot);
            int eqr = eqbase, cs = 0;
            for (int i = 0; i < 16; ++i) { const unsigned k = keys[tid * 16 + i]; const bool sel = (k > thr) || (k == thr && eqr < krem); eqr += (k == thr); cs += sel; }
            const int sbase = block_exscan(cs, sh, &tot);
            int slot = sbase; eqr = eqbase;
            for (int i = 0; i < 16; ++i) {
                const int s = tid * 16 + i; const unsigned k = keys[s];
                const bool sel = (k > thr) || (k == thr && eqr < krem); eqr += (k == thr);
                if (sel) { TOK[eb * CAP + slot] = b * S + s; GATE[eb * CAP + slot] = __uint_as_float(k); SLOT[(size_t)(b * S + s) * NE + e] = eb * CAP + slot; ++slot; }
            }
        }
    }
    SEAM(ph); ++ph;
    if (IN(ph)) REP_LOOP {
        for (int r = gw; r < NB * NE * CAP; r += ngw) {
            int rv_ = r; asm volatile("" : "+v"(rv_));
            if constexpr (layer == 1 || F8L0) {
                const v4u* srcp = (const v4u*)(H + (size_t)TOK[rv_] * D) + 2 * lane; const v4u x0 = srcp[0], x1 = srcp[1];
                v4u o;
                o.x = pk4_fp8(bflo(x0.x) * ASC8, bfhi(x0.x) * ASC8, bflo(x0.y) * ASC8, bfhi(x0.y) * ASC8); o.y = pk4_fp8(bflo(x0.z) * ASC8, bfhi(x0.z) * ASC8, bflo(x0.w) * ASC8, bfhi(x0.w) * ASC8);
                o.z = pk4_fp8(bflo(x1.x) * ASC8, bfhi(x1.x) * ASC8, bflo(x1.y) * ASC8, bfhi(x1.y) * ASC8); o.w = pk4_fp8(bflo(x1.z) * ASC8, bfhi(x1.z) * ASC8, bflo(x1.w) * ASC8, bfhi(x1.w) * ASC8);
                ((v4u*)((unsigned char*)XE + (size_t)r * D))[lane] = o;
            } else {
                const v4u* srcp = (const v4u*)(H + (size_t)TOK[rv_] * D); v4u* dst = (v4u*)(XE + (size_t)r * D);
                dst[lane] = srcp[lane]; dst[lane + 64] = srcp[lane + 64];
            }
        }
    }
    SEAM(ph); ++ph;
    if (IN(ph)) {
        MoeOrder So{(int)gridDim.x, (int)blockIdx.x, 16 * 22, 22};
        if constexpr (layer == 1 || F8L0) {
            int Kg = D / 2; asm volatile("" : "+s"(Kg));
            pg8::Gemm g{XE, (const bf16_t*)(ws + WS_WGU8 + (size_t)layer * 176 * MiB), NB * NE * CAP, NE * 5632, Kg};
            pg8::gemm_phase<EpiSiluMul8, MoeOrder, false, true>(ldsp, g, So, EpiSiluMul8{(unsigned char*)HID}, nullptr);
        } else {
            pg8::Gemm g{XE, (const bf16_t*)(ws + WS_WGU) + (size_t)layer * NE * 5632 * D, NB * NE * CAP, NE * 5632, D};
            pg8::gemm_phase<EpiSiluMul, MoeOrder, false>(ldsp, g, So, EpiSiluMul{HID}, nullptr);
        }
    }
    SEAM(ph); ++ph;
    if (IN(ph)) {
        MoeOrder So{(int)gridDim.x, (int)blockIdx.x, 16 * 4, 4};
        if constexpr (layer == 1 || F8L0) {
            int Kg = DE / 2; asm volatile("" : "+s"(Kg));
            pg8::Gemm g{HID, (const bf16_t*)(ws + WS_WD8 + (size_t)layer * 88 * MiB), NB * NE * CAP, NE * D, Kg};
            pg8::gemm_phase<EpiYE8, MoeOrder, false, true>(ldsp, g, So, EpiYE8{GATE, YE}, nullptr);
        } else {
            pg8::Gemm g{HID, (const bf16_t*)(ws + WS_WD) + (size_t)layer * NE * D * DE, NB * NE * CAP, NE * D, DE};
            pg8::gemm_phase<EpiYE, MoeOrder, false>(ldsp, g, So, EpiYE{GATE, YE}, nullptr);
        }
    }
    SEAM(ph); ++ph;
    return ph;
}

__global__ void __launch_bounds__(NTH, 2) mega(Args a) {
    extern __shared__ __attribute__((aligned(16))) unsigned char lds_raw[];
    unsigned* ctl = (unsigned*)(a.ws + WS_CTL);
    volatile LAS unsigned* bst = (volatile LAS unsigned*)((LAS unsigned char*)lds_raw + LDS_BAR_OFF);
    { const int t0_ = tidx(); if (t0_ < 4) bst[t0_] = 0u; }
    __syncthreads();
    XcdBarrier bar; bar.bar = ctl + CW_BAR; bar.x = 0; bar.st = bst;
    if (a.hi - a.lo > 1) bar = xcd_barrier_post(ctl + CW_BAR, bst);
    PROLOG

    int ph = 0;
    if (IN(ph)) REP_LOOP {
        for (int i = gt; i < S * 32; i += ngt) {
            const int s = i >> 5, f = i & 31;
            const float pw = (float)exp((double)((float)(2 * f) / 64.0f) * 9.210340371976184);
            const float invf = 1.0f / pw;
            const float angf = (float)s * invf;
            double xx = (double)angf;
            const double n = rint(xx * 0.15915494309189535);
            xx = (xx - n * 6.283185307179586) - n * 2.4492935982947064e-16;
            const double x2 = xx * xx;
            double cs = 1.0, sn = xx, tc = 1.0, tsn = xx;
#pragma unroll 1
            for (int k = 1; k <= 16; ++k) { tc *= -x2 / (double)((2 * k - 1) * (2 * k)); tsn *= -x2 / (double)((2 * k) * (2 * k + 1)); cs += tc; sn += tsn; }
            ropec[i] = (float)cs; ropes[i] = (float)sn;
        }
        rmsnorm_rows_bf16(x_in, a.in[2], H, T);
        LAS float* scr = (LAS float*)((LAS unsigned char*)lds_raw + wave * 16896);
        auto ident = [](int n) { return n; };
        auto emap = [](int n) { const bool il = (n < 1024) || (n >= 1536 && n < 2176); const int j = n & 63; return il ? ((n & ~63) + (j < 32 ? 2 * j : 2 * (j - 32) + 1)) : n; };
        for (int it = gw; it < 16 * 36; it += ngw) transpose_item(a.in[3], D, EVEN_IN, (bf16_t*)(ws + WS_WEIN), emap, scr, it, lane);
        for (int it = gw; it < 16 * 16; it += ngw) transpose_item(a.in[5], D, D, (bf16_t*)(ws + WS_WEOUT), ident, scr, it, lane);
        for (int it = gw; it < 16 * 46; it += ngw) transpose_item(a.in[7], D, ODD_IN, (bf16_t*)(ws + WS_WOIN), ident, scr, it, lane);
        for (int it = gw; it < 16 * 16; it += ngw) transpose_item(a.in[23], D, D, (bf16_t*)(ws + WS_WOOUT), ident, scr, it, lane);
        for (int it = gw; it < 2 * 16 * 16; it += ngw) { const int l = it / 256, r = it % 256; transpose_item(a.in[26] + (size_t)l * D * D, D, D, (bf16_t*)(ws + WS_WQ) + (size_t)l * D * D, ident, scr, r, lane); }
        for (int it = gw; it < 2 * 16 * 32; it += ngw) { const int l = it / 512, r = it % 512; transpose_item(a.in[27] + (size_t)l * D * 2048, D, 2048, (bf16_t*)(ws + WS_WKV) + (size_t)l * 2048 * D, ident, scr, r, lane); }
        for (int it = gw; it < 2 * 16 * 16; it += ngw) { const int l = it / 256, r = it % 256; transpose_item(a.in[28] + (size_t)l * D * D, D, D, (bf16_t*)(ws + WS_WO) + (size_t)l * D * D, ident, scr, r, lane); }
        { float* WRT = (float*)(ws + WS_WRT);
          for (int i = gt; i < 2 * NE * D; i += ngt) { const int l = i >> 14, e = (i >> 10) & 15, k = i & 1023; WRT[i] = a.in[29][l * D + k] * a.in[30][((size_t)l * D + k) * NE + e]; } }
        { bf16_t* Wsb = (bf16_t*)(ws + WS_WSB); const float* wsp = a.in[10];
          for (int i = gt; i < 4 * 128 * 128; i += ngt) Wsb[i] = (bf16_t)f2bf(wsp[i]);
          bf16_t* WL = (bf16_t*)(ws + WS_WL); const float *w2 = a.in[14], *a2 = a.in[16], *g2 = a.in[17];
          for (int i = gt; i < 2560 * 384; i += ngt) { const int n = i / 384, k = i % 384, sec = n >> 9, cc = n & 511; float v = 0.f;
              if (sec < 2) { if ((k >> 6) == sec) v = w2[(size_t)(sec * 64 + (k & 63)) * 512 + cc]; }
              else if (sec < 4) { if ((k >> 6) == sec) v = a2[(size_t)((sec - 2) * 64 + (k & 63)) * 512 + cc]; }
              else { if (k >= 256) v = g2[(size_t)(k - 256) * 512 + cc]; }
              WL[i] = (bf16_t)f2bf(v); } }
        auto gmap = [](int n) { return (n >> 7) * 256 + (n & 127); };
        auto umap = [](int n) { return (n >> 7) * 256 + 128 + (n & 127); };
        for (int it = gw; it < 16 * 704; it += ngw) { const int mt = it / 704, r = it % 704;
            if constexpr (F8L0) transpose_item_fp8(a.in[31] + (size_t)mt * D * DE, D, DE, ws + WS_WGU8 + (size_t)mt * 5632 * D, gmap, GUSC8, scr, r, lane);
            else transpose_item(a.in[31] + (size_t)mt * D * DE, D, DE, (bf16_t*)(ws + WS_WGU) + (size_t)mt * 5632 * D, gmap, scr, r, lane); }
        for (int it = gw; it < 16 * 704; it += ngw) { const int mt = it / 704, r = it % 704;
            if constexpr (F8L0) transpose_item_fp8(a.in[32] + (size_t)mt * D * DE, D, DE, ws + WS_WGU8 + (size_t)mt * 5632 * D, umap, GUSC8, scr, r, lane);
            else transpose_item(a.in[32] + (size_t)mt * D * DE, D, DE, (bf16_t*)(ws + WS_WGU) + (size_t)mt * 5632 * D, umap, scr, r, lane); }
    }
    SEAM(ph); ++ph;

    if (IN(ph)) dense_gemm(ldsp, H, (const bf16_t*)(ws + WS_WEIN), T, EVEN_IN, D,
                           EpiEven{ropec, ropes, (bf16_t*)(ws + WS_QHA), (bf16_t*)(ws + WS_KHA), (bf16_t*)(ws + WS_QHB), (bf16_t*)(ws + WS_KHB), (bf16_t*)(ws + WS_PVB)});
    SEAM(ph); ++ph;
    if (IN(ph)) REP_LOOP vtrans_pass((const bf16_t*)(ws + WS_PVB), (bf16_t*)(ws + WS_VTA), (bf16_t*)(ws + WS_VTB), lds_raw);
    SEAM(ph); ++ph;
    if (IN(ph)) REP_LOOP attn_phase_even((const bf16_t*)(ws + WS_QHA), (const bf16_t*)(ws + WS_KHA), (const bf16_t*)(ws + WS_VTA), (const bf16_t*)(ws + WS_QHB), (const bf16_t*)(ws + WS_KHB),
                                (const bf16_t*)(ws + WS_VTB), a.in[4], (bf16_t*)(ws + WS_OA), (float*)(ws + WS_LSE), Y);
    SEAM(ph); ++ph;
    if (IN(ph)) REP_LOOP attn_combine((const bf16_t*)(ws + WS_OA), (const float*)(ws + WS_LSE), Y);
    SEAM(ph); ++ph;
    if (IN(ph)) dense_gemm(ldsp, Y, (const bf16_t*)(ws + WS_WEOUT), T, D, D, EpiResid{x_in, X});
    SEAM(ph); ++ph;

    ph = tail_phases<0>(a, bar, lds_raw, ph);
    ph = odd_phases(a, bar, lds_raw, ph);
    ph = tail_phases<1>(a, bar, lds_raw, ph);

    if (IN(ph)) combine_norm<true>(X, YE, SLOT, a.in[34], nullptr, a.out);
    ++ph;
}
constexpr int NPHASES = 1 + 5 + 2 * 9 + 8 + 1;
#undef IN
#undef SEAM
}

extern "C" void kernel_launch(void* const* d_in, const int* in_sizes, int n_in, void* d_out, int out_size, void* d_ws, size_t ws_size, hipStream_t stream) {
    static int grid = 0;
    if (grid == 0) {
        if (n_in != 35 || out_size != T * D || ws_size < WS_END) { fprintf(stderr, "kernel_launch: unexpected shapes n_in %d out %d ws %zu (need %zu)\n", n_in, out_size, ws_size, (size_t)WS_END); grid = -1; return; }
        int dev = 0, cus = 0, per_cu = 0;
        (void)hipGetDevice(&dev); (void)hipDeviceGetAttribute(&cus, hipDeviceAttributeMultiprocessorCount, dev);
        if (hipFuncSetAttribute((const void*)mega, hipFuncAttributeMaxDynamicSharedMemorySize, LDS_BYTES) != hipSuccess) { fprintf(stderr, "hipFuncSetAttribute failed\n"); grid = -1; return; }
        if (hipOccupancyMaxActiveBlocksPerMultiprocessor(&per_cu, (const void*)mega, NTH, LDS_BYTES) != hipSuccess || per_cu < 1) fprintf(stderr, "occupancy query: %d\n", per_cu);
        (void)hipGetLastError();
        grid = cus > 0 ? cus : 256;
    }
    if (grid < 0) return;
    (void)hipMemsetAsync((char*)d_ws + WS_CTL, 0, CTL_BYTES, stream);
    Args a{};
    for (int i = 0; i < 35; ++i) a.in[i] = (const float*)d_in[i];
    a.out = (float*)d_out; a.ws = (unsigned char*)d_ws;
#if MK_MULTI
    for (int k = 0; k < NPHASES; ++k) { a.lo = k; a.hi = k + 1; hipLaunchKernelGGL(mega, dim3(grid), dim3(NTH), LDS_BYTES, stream, a); }
#else
    a.lo = 0; a.hi = NPHASES; hipLaunchKernelGGL(mega, dim3(grid), dim3(NTH), LDS_BYTES, stream, a);
#endif
}
```

```cpp
#include <hip/hip_runtime.h>
#include <cstdio>
#include <cstdint>

#ifndef PROBE_PHASE
#define PROBE_PHASE (-1)
#endif
#ifndef PROBE_REP
#define PROBE_REP 1
#endif
#ifndef MK_MULTI
#define MK_MULTI 0
#endif

__device__ __forceinline__ int tidx() { int t = threadIdx.x; asm volatile("" : "+v"(t)); return t; }
namespace pg8 {
#define PG8_LAS __attribute__((address_space(3)))
typedef unsigned short bf16_t;
typedef short bf16x8 __attribute__((ext_vector_type(8)));
typedef float f32x4 __attribute__((ext_vector_type(4)));
typedef unsigned u32x4 __attribute__((ext_vector_type(4)));
constexpr int BM = 256, BK = 64, HALF = 128, HTB = HALF * BK * 2  , STAGE_BYTES = 8 * HTB, NXCD = 8, WGM = 8;

__host__ __device__ __forceinline__ int lds_byte(int r, int c) { const int st = (r >> 4) * 2 + (c >> 5), rr = r & 15, cc = c & 31, ob = rr * 64 + cc * 2; return st * 1024 + (ob ^ (((ob >> 9) & 1) << 5)); }
__host__ __device__ __forceinline__ void stage_rc(int b, int& R, int& C) { const int st = b / 1024, sb = b % 1024, swz = sb ^ (((sb >> 9) & 1) << 5); R = (st >> 1) * 16 + swz / 64; C = (st & 1) * 32 + (swz % 64) / 2; }
__host__ __device__ __forceinline__ int perm32(int rho) { const int n = rho >> 4, i = rho & 15; return 8 * (i >> 2) + 4 * n + (i & 3); }

struct Unit { int pm, pn; };
struct Gemm { const bf16_t* A; const bf16_t* Bt; int M, N, K; };

struct StaticOrder {
    int nM, nN, nwg, G, c;
    __host__ __device__ void init(int M, int N, int G_, int c_) { nM = M / BM; nN = N / BM; nwg = nM * nN; G = G_; c = c_; }
    __host__ __device__ bool next(int i, Unit& u) const {
        const long L = (long)i * G + c; if (L >= nwg) return false;
        int wgid = (int)L; { const int q = nwg / NXCD, r = nwg % NXCD, xcd = wgid % NXCD, off = wgid / NXCD; wgid = (xcd < r ? xcd * (q + 1) : r * (q + 1) + (xcd - r) * q) + off; }
        const int nig = WGM * nN, gid = wgid / nig, fm = gid * WGM, gsz = (nM - fm) < WGM ? (nM - fm) : WGM;
        u.pm = fm + ((wgid % nig) % gsz); u.pn = (wgid % nig) / gsz; return true;
    }
    __device__ __forceinline__ void a_ready(const Unit&) const {}
    __device__ __forceinline__ void done(const Unit&) const {}
};

typedef __bf16 bf16v2_t __attribute__((ext_vector_type(2)));
typedef float f32v2_t __attribute__((ext_vector_type(2)));
__device__ __forceinline__ unsigned cvt_pk_bf16(float lo, float hi) { const f32v2_t v = {lo, hi}; return __builtin_bit_cast(unsigned, __builtin_convertvector(v, bf16v2_t)); }
typedef int i32x8 __attribute__((ext_vector_type(8)));
template <bool F8> __device__ __forceinline__ f32x4 mma_tile(const bf16x8 (&bfr)[2], const bf16x8 (&afr)[2], f32x4 acc) {
    if constexpr (F8) {
        typedef int i32x4_ __attribute__((ext_vector_type(4)));
        const i32x4_ b0 = __builtin_bit_cast(i32x4_, bfr[0]), b1 = __builtin_bit_cast(i32x4_, bfr[1]), a0 = __builtin_bit_cast(i32x4_, afr[0]), a1 = __builtin_bit_cast(i32x4_, afr[1]);
        const i32x8 bb = {b0[0], b0[1], b0[2], b0[3], b1[0], b1[1], b1[2], b1[3]}, aa = {a0[0], a0[1], a0[2], a0[3], a1[0], a1[1], a1[2], a1[3]};
        const int sc1 = 0x7f7f7f7f;
        asm volatile("v_mfma_scale_f32_16x16x128_f8f6f4 %0, %1, %2, %0, %3, %3 op_sel_hi:[0,0,0]" : "+v"(acc) : "v"(bb), "v"(aa), "v"(sc1));
        return acc;
    } else {
        acc = __builtin_amdgcn_mfma_f32_16x16x32_bf16(bfr[0], afr[0], acc, 0, 0, 0);
        return __builtin_amdgcn_mfma_f32_16x16x32_bf16(bfr[1], afr[1], acc, 0, 0, 0);
    }
}
template <class Epi, class Sched, bool STAMP = false, bool F8 = false>
__device__ __forceinline__ void gemm_phase(PG8_LAS unsigned char* lds, const Gemm g, const Sched& S, const Epi& E, unsigned long long* stamps) {
    const int tid = ::tidx(), wid = __builtin_amdgcn_readfirstlane(tid >> 6), lane = tid & 63, wr = wid >> 2, wc = wid & 3, fr = lane & 15, fq = lane >> 4;
    const int K = g.K, nt = K / BK;
    int ts_lo = 0, ts_hi = 0, nts = 0; const unsigned long long rt_entry = STAMP ? (unsigned long long)wall_clock64() : 0ull;
#define PG8_STAMP() do { if (STAMP && wid == 0 && nts < 64) { const unsigned long long _c = (unsigned long long)clock64(); \
        ts_lo = (lane == nts) ? (int)(unsigned)_c : ts_lo; ts_hi = (lane == nts) ? (int)(unsigned)(_c >> 32) : ts_hi; ++nts; } } while (0)
    PG8_STAMP();
    unsigned voffA[2], voffB[2];
#pragma unroll
    for (int i = 0; i < 2; ++i) { int R, C; stage_rc(tid * 16 + i * 8192, R, C); const int Rb = Epi::PERM ? ((R & ~31) + perm32(R & 31)) : R;
        voffA[i] = (unsigned)(R * K + C) * 2u; voffB[i] = (unsigned)(Rb * K + C) * 2u; }
    const size_t kstep = (size_t)(BK * 2);
    const size_t hstep = (size_t)HALF * K * 2;
    const size_t tstep = 2 * hstep;
    const unsigned ldsw = (unsigned)wid * 1024u;
    const int aoff = lds_byte(wr * 64 + fr, fq * 8), boff = lds_byte(wc * 32 + fr, fq * 8);
#define PG8_SA(b, h) (((b) * 2 + (h)) * HTB)
#define PG8_SB(b, h) ((4 + (b) * 2 + (h)) * HTB)
#define PG8_STAGE(bufoff, gbase, voff) do { _Pragma("unroll") for (int _i = 0; _i < 2; ++_i) \
        __builtin_amdgcn_global_load_lds((const unsigned*)((const char*)(gbase) + (voff)[_i]), (PG8_LAS unsigned*)(lds + (bufoff) + ldsw + _i * 8192), 16, 0, 0); } while (0)
#define PG8_LDA(dst, b, h) do { _Pragma("unroll") for (int m = 0; m < 4; ++m) _Pragma("unroll") for (int k = 0; k < 2; ++k) dst[m][k] = *(const PG8_LAS bf16x8*)(lds + PG8_SA(b, h) + aoff + m * 2048 + k * 1024); } while (0)
#define PG8_LDB(dst, b, h) do { _Pragma("unroll") for (int n = 0; n < 2; ++n) _Pragma("unroll") for (int k = 0; k < 2; ++k) dst[n][k] = *(const PG8_LAS bf16x8*)(lds + PG8_SB(b, h) + boff + n * 2048 + k * 1024); } while (0)
#define PG8_MMA(ai, bj, At, Bt) do { __builtin_amdgcn_s_setprio(1); _Pragma("unroll") for (int m = 0; m < 4; ++m) _Pragma("unroll") for (int n = 0; n < 2; ++n) \
        acc[ai][bj][m][n] = mma_tile<F8>(Bt[n], At[m], acc[ai][bj][m][n]); __builtin_amdgcn_s_setprio(0); } while (0)
#define PG8_WAIT_V(n) asm volatile("s_waitcnt vmcnt(" #n ")" ::: "memory")
#define PG8_WAIT_L(n) asm volatile("s_waitcnt lgkmcnt(" #n ")" ::: "memory")
#define PG8_BAR __builtin_amdgcn_s_barrier()
#define PG8_SCHED __builtin_amdgcn_sched_barrier(0)
    Unit cur, nxt; int ui = 0;
    if (!S.next(0, cur)) return;
    f32x4 acc[2][2][4][2];
#pragma unroll
    for (int a = 0; a < 2; ++a)
#pragma unroll
        for (int b = 0; b < 2; ++b)
#pragma unroll
            for (int m = 0; m < 4; ++m)
#pragma unroll
                for (int n = 0; n < 2; ++n) acc[a][b][m][n] = (f32x4){0.f, 0.f, 0.f, 0.f};
    bf16x8 At[4][2], B0[2][2], B1[2][2];
    const char* cA = (const char*)g.A + (size_t)cur.pm * tstep; const char* cB = (const char*)g.Bt + (size_t)cur.pn * tstep;
    S.a_ready(cur);
    PG8_STAGE(PG8_SB(0, 0), cB, voffB); PG8_STAGE(PG8_SA(0, 0), cA, voffA); PG8_STAGE(PG8_SB(0, 1), cB + hstep, voffB); PG8_STAGE(PG8_SA(0, 1), cA + hstep, voffA);
    if (wr == 1) PG8_BAR;
    PG8_WAIT_V(4); PG8_BAR;
    PG8_STAGE(PG8_SB(1, 0), cB + kstep, voffB); PG8_STAGE(PG8_SA(1, 0), cA + kstep, voffA); PG8_STAGE(PG8_SB(1, 1), cB + hstep + kstep, voffB);
    PG8_WAIT_V(6); PG8_BAR;
    PG8_STAMP();
    for (;;) {
        const bool has_next = S.next(ui + 1, nxt);
        const char* nA = has_next ? (const char*)g.A + (size_t)nxt.pm * tstep : cA; const char* nB = has_next ? (const char*)g.Bt + (size_t)nxt.pn * tstep : cB;
        for (int t = 0; t < nt; t += 2) {
            const bool last = (t == nt - 2);
            const char* a1 = cA + (size_t)(t + 1) * kstep;
            const char* a2 = last ? nA : cA + (size_t)(t + 2) * kstep; const char* b2 = last ? nB : cB + (size_t)(t + 2) * kstep;
            const char* a3 = a2 + kstep; const char* b3 = b2 + kstep;
            if (last && has_next) S.a_ready(nxt);
            PG8_LDB(B0, 0, 0); PG8_SCHED; PG8_LDA(At, 0, 0); PG8_STAGE(PG8_SA(1, 1), a1 + hstep, voffA);
            PG8_WAIT_L(8); PG8_BAR; PG8_WAIT_L(0); PG8_MMA(0, 0, At, B0); PG8_BAR; PG8_SCHED;
            PG8_LDB(B1, 0, 1); PG8_STAGE(PG8_SB(0, 0), b2, voffB);
            PG8_BAR; PG8_WAIT_L(0); PG8_MMA(0, 1, At, B1); PG8_BAR;
            PG8_LDA(At, 0, 1); PG8_STAGE(PG8_SA(0, 0), a2, voffA);
            PG8_BAR; PG8_WAIT_L(0); PG8_MMA(1, 0, At, B0); PG8_BAR; PG8_SCHED;
            PG8_STAGE(PG8_SB(0, 1), b2 + hstep, voffB);
            PG8_WAIT_V(6); PG8_BAR; PG8_MMA(1, 1, At, B1); PG8_BAR;
            PG8_LDB(B0, 1, 0); PG8_SCHED; PG8_LDA(At, 1, 0); PG8_STAGE(PG8_SA(0, 1), a2 + hstep, voffA);
            PG8_WAIT_L(8); PG8_BAR; PG8_WAIT_L(0); PG8_MMA(0, 0, At, B0); PG8_BAR; PG8_SCHED;
            PG8_LDB(B1, 1, 1); PG8_STAGE(PG8_SB(1, 0), b3, voffB);
            PG8_BAR; PG8_WAIT_L(0); PG8_MMA(0, 1, At, B1); PG8_BAR;
            PG8_LDA(At, 1, 1); PG8_STAGE(PG8_SA(1, 0), a3, voffA);
            PG8_BAR; PG8_WAIT_L(0); PG8_MMA(1, 0, At, B0); PG8_BAR; PG8_SCHED;
            PG8_STAGE(PG8_SB(1, 1), b3 + hstep, voffB);
            PG8_WAIT_V(6); PG8_BAR; PG8_MMA(1, 1, At, B1); PG8_BAR;
        }
        PG8_STAMP();
        if constexpr (!Epi::AFTER_DRAIN) { E(acc, cur, wr, wc, fr, fq); S.done(cur); }
        PG8_STAMP();
        if (!has_next) break;
#pragma unroll
        for (int a = 0; a < 2; ++a)
#pragma unroll
            for (int b = 0; b < 2; ++b)
#pragma unroll
                for (int m = 0; m < 4; ++m)
#pragma unroll
                    for (int n = 0; n < 2; ++n) acc[a][b][m][n] = (f32x4){0.f, 0.f, 0.f, 0.f};
        cur = nxt; cA = nA; cB = nB; ++ui;
    }
    PG8_WAIT_V(0);
    if (wr == 0) PG8_BAR;
    PG8_BAR;
    if constexpr (Epi::AFTER_DRAIN) { E.fused(acc, cur, wr, wc, fr, fq, lds, wid, lane); S.done(cur); }
    PG8_STAMP();
    if (STAMP && wid == 0) { stamps[lane] = lane < nts ? (((unsigned long long)(unsigned)ts_hi << 32) | (unsigned)ts_lo) : 0ull;
        if (lane == 62) stamps[62] = rt_entry; if (lane == 63) stamps[63] = (unsigned long long)wall_clock64(); }
#undef PG8_STAMP
#undef PG8_SA
#undef PG8_SB
#undef PG8_STAGE
#undef PG8_LDA
#undef PG8_LDB
#undef PG8_MMA
#undef PG8_WAIT_V
#undef PG8_WAIT_L
#undef PG8_BAR
#undef PG8_SCHED
}
}


namespace {
using pg8::bf16_t; using pg8::f32x4;
constexpr int D = 1024, NB = 2, S = 8192, T = NB * S;
constexpr int EVEN_IN = 2304, ODD_IN = 2944, ODD_PAD = 3072, FD = 1920;
constexpr int MEM = 256, NE = 16, CAP = 1024, DE = 2816;
constexpr int NTH = 512;
constexpr size_t MiB = 1u << 20;
constexpr size_t WS_CTL = 0, CTL_BYTES = 1 * MiB;
constexpr size_t WS_ROPE = 1 * MiB;
constexpr size_t WS_AFF = 4 * MiB;
constexpr size_t WS_TOK = 5 * MiB;
constexpr size_t WS_GATE = 6 * MiB;
constexpr size_t WS_WRT = 3 * MiB;
constexpr size_t WS_SLOT = 7 * MiB;
constexpr size_t WS_X = 8 * MiB;
constexpr size_t WS_H = 72 * MiB;
constexpr size_t WS_Y = 104 * MiB;
constexpr size_t WS_P = 136 * MiB;
constexpr size_t WS_Q = 320 * MiB;
constexpr size_t WS_KV = 384 * MiB;
constexpr size_t WS_MN = 388 * MiB;
constexpr size_t WS_SSP = 390 * MiB;
constexpr size_t WS_DEC = 392 * MiB;
constexpr size_t WS_KD = 456 * MiB;
constexpr size_t WS_BB = 520 * MiB;
constexpr size_t WS_KK = 584 * MiB;
constexpr size_t WS_G = 616 * MiB;
constexpr size_t WS_YS = 648 * MiB;
constexpr size_t WS_RV = 712 * MiB;
constexpr size_t WS_VN = 776 * MiB;
constexpr size_t WS_QHA = 136 * MiB;
constexpr size_t WS_KHA = 152 * MiB;
constexpr size_t WS_QHB = 168 * MiB;
constexpr size_t WS_KHB = 184 * MiB;
constexpr size_t WS_PVB = 188 * MiB;
constexpr size_t WS_VTA = 208 * MiB;
constexpr size_t WS_VTB = 256 * MiB;
constexpr size_t WS_OA = 260 * MiB;
constexpr size_t WS_LSE = 308 * MiB;
constexpr size_t WS_QT = 136 * MiB;
constexpr size_t WS_YL = 200 * MiB;
constexpr size_t WS_PT = 264 * MiB;
constexpr size_t WS_RH = 296 * MiB;
constexpr size_t WS_S0 = 328 * MiB;
constexpr size_t WS_XE = 136 * MiB;
constexpr size_t WS_YE = 136 * MiB;
constexpr size_t WS_HID = 200 * MiB;
constexpr size_t WS_KB = 360 * MiB;
constexpr size_t WS_F5 = 792 * MiB;
constexpr size_t WS_WSB = 804 * MiB;
constexpr size_t WS_WL = 805 * MiB;
constexpr size_t WS_WEIN = 808 * MiB;
constexpr size_t WS_WEOUT = 813 * MiB;
constexpr size_t WS_WOIN = 815 * MiB;
constexpr size_t WS_WOOUT = 821 * MiB;
constexpr size_t WS_WQ = 823 * MiB;
constexpr size_t WS_WKV = 827 * MiB;
constexpr size_t WS_WO = 835 * MiB;
constexpr size_t WS_WGU = 840 * MiB;
constexpr size_t WS_WD = 1192 * MiB;
constexpr size_t WS_WGU8 = 840 * MiB;
constexpr size_t WS_WD8 = 1192 * MiB;
constexpr size_t WS_END = 1368 * MiB;
constexpr bool F8L0 = true;
constexpr float ASC8 = 16.f, GUSC8 = 128.f, HSC8 = 4.f, DSC8 = 256.f;
constexpr int CW_BAR = 4096;

constexpr int LDS_BYTES = 147456;
constexpr int LDS_BAR_OFF = LDS_BYTES - 64;

#define LAS __attribute__((address_space(3)))
#define XB_TMO      128
#define XB_XCNT(j)  (256  + 64 * (j))
#define XB_XSUB(j)  (1280 + 64 * (j))
#define XB_XGEN(j)  (2304 + 64 * (j))
#define XB_TOP      3328
#define XB_TOPGEN   3392
#define XCD_BAR_WORDS 3456
#define XB_SPIN_CAP (1u << 22)
__device__ __forceinline__ unsigned xb_ld(unsigned* p)              { return __hip_atomic_load(p, __ATOMIC_RELAXED, __HIP_MEMORY_SCOPE_AGENT); }
__device__ __forceinline__ unsigned xb_add(unsigned* p, unsigned v) { return __hip_atomic_fetch_add(p, v, __ATOMIC_RELAXED, __HIP_MEMORY_SCOPE_AGENT); }
__device__ __forceinline__ unsigned xb_xcc_id() { return (unsigned)__builtin_amdgcn_s_getreg((3 << 11) | 20) & 0xFu; }
#define XB_SPIN(cond, bar) do { unsigned _sp = 0; while (cond) { __builtin_amdgcn_s_sleep(1); \
    if ((++_sp & 255u) == 0u) { if (xb_ld(&(bar)[XB_TMO])) break; if (_sp > XB_SPIN_CAP) { atomicAdd(&(bar)[XB_TMO], 1u); break; } } } } while (0)
struct XcdBarrier { unsigned* bar; unsigned x; volatile LAS unsigned* st; };
__device__ __forceinline__ XcdBarrier xcd_barrier_post(unsigned* bar, volatile LAS unsigned* st) {
    XcdBarrier b; b.bar = bar; b.x = xb_xcc_id(); b.st = st;
    if (threadIdx.x == 0) (void)xb_add(&bar[XB_XCNT(b.x)], 1u);
    return b;
}
__device__ __forceinline__ void xcd_barrier_complete(unsigned* bar, unsigned x, unsigned& nloc, unsigned& nx) {
    const unsigned G = gridDim.x * gridDim.y * gridDim.z;
    unsigned sum, cnt, mine, sp = 0u;
    for (;;) {
        sum = 0u; cnt = 0u; mine = 0u;
#pragma unroll
        for (unsigned j = 0; j < 16; ++j) { const unsigned c = xb_ld(&bar[XB_XCNT(j)]); sum += c; cnt += (c > 0u) ? 1u : 0u; mine = (j == x) ? c : mine; }
        if (sum == G) break;
        __builtin_amdgcn_s_sleep(1);
        if ((++sp & 255u) == 0u) { if (xb_ld(&bar[XB_TMO])) break; if (sp > XB_SPIN_CAP) { atomicAdd(&bar[XB_TMO], 1u); break; } }
    }
    nloc = mine > 0u ? mine : 1u; nx = cnt > 0u ? cnt : 1u;
}
__device__ __forceinline__ void xcd_barrier(const XcdBarrier& b) {
    asm volatile("s_waitcnt vmcnt(0)" ::: "memory");
    __syncthreads();
    if (threadIdx.x == 0) {
        unsigned* bar = b.bar;
        __builtin_amdgcn_s_waitcnt(0);
        unsigned nloc = b.st[0], nx = b.st[1];
        if (nloc == 0u) { xcd_barrier_complete(bar, b.x, nloc, nx); b.st[0] = nloc; b.st[1] = nx; }
        const unsigned old = xb_add(&bar[XB_XSUB(b.x)], 1u);
        const unsigned gen = old / nloc;
        if (old + 1u == (gen + 1u) * nloc) {
            __builtin_amdgcn_fence(__ATOMIC_RELEASE, "agent");
            asm volatile("s_waitcnt vmcnt(0)" ::: "memory");
            const unsigned og = xb_add(&bar[XB_TOP], 1u);
            const unsigned tg = og / nx;
            if (og + 1u == (tg + 1u) * nx) xb_add(&bar[XB_TOPGEN], 1u);
            else XB_SPIN(xb_ld(&bar[XB_TOPGEN]) == tg, bar);
            __builtin_amdgcn_fence(__ATOMIC_ACQUIRE, "agent");
            xb_add(&bar[XB_XGEN(b.x)], 1u);
            asm volatile("s_waitcnt vmcnt(0)" ::: "memory");
        } else {
            XB_SPIN(xb_ld(&bar[XB_XGEN(b.x)]) == gen, bar);
            __builtin_amdgcn_fence(__ATOMIC_ACQUIRE, "agent");
            asm volatile("s_waitcnt vmcnt(0)" ::: "memory");
        }
    }
    __syncthreads();
}

__device__ __forceinline__ float wave_sum(float v) {
#pragma unroll
    for (int o = 32; o >= 1; o >>= 1) v += __shfl_xor(v, o);
    return v;
}
__device__ __forceinline__ float sigmoidf_(float x) { return 1.0f / (1.0f + expf(-x)); }
__device__ __forceinline__ float gelu_tanh(float x) { return 0.5f * x * (1.0f + tanhf(0.7978845608028654f * (x + 0.044715f * x * x * x))); }
__device__ __forceinline__ unsigned f2bf(float f) { unsigned u = __builtin_bit_cast(unsigned, f); return (u + 0x7fffu + ((u >> 16) & 1u)) >> 16; }
__device__ __forceinline__ unsigned pk2(float lo, float hi) { return pg8::cvt_pk_bf16(lo, hi); }
__device__ __forceinline__ float bflo(unsigned w) { return __uint_as_float(w << 16); }
__device__ __forceinline__ float bfhi(unsigned w) { return __uint_as_float(w & 0xffff0000u); }
typedef unsigned v4u __attribute__((ext_vector_type(4)));
typedef unsigned v2u __attribute__((ext_vector_type(2)));

struct Args { const float* in[35]; float* out; unsigned char* ws; int lo, hi; };

struct EpiF32Store {
    static constexpr bool PERM = false, AFTER_DRAIN = false;
    float* C; int ldc; int nvalid;
    __device__ __forceinline__ void operator()(const f32x4 (&acc)[2][2][4][2], const pg8::Unit& u, int wr, int wc, int fr, int fq) const {
        const int row0 = u.pm * 256 + wr * 64 + fr, col0 = u.pn * 256 + wc * 32 + 4 * fq;
#pragma unroll
        for (int ai = 0; ai < 2; ++ai)
#pragma unroll
            for (int m = 0; m < 4; ++m) { float* rowp = C + (size_t)(row0 + ai * 128 + m * 16) * ldc + col0;
#pragma unroll
                for (int bj = 0; bj < 2; ++bj)
#pragma unroll
                    for (int n = 0; n < 2; ++n) if (col0 + bj * 128 + n * 16 < nvalid) *(f32x4*)(rowp + bj * 128 + n * 16) = acc[ai][bj][m][n]; }
    }
};
struct EpiResid {
    static constexpr bool PERM = false, AFTER_DRAIN = false;
    const float* base; float* out;
    __device__ __forceinline__ void operator()(const f32x4 (&acc)[2][2][4][2], const pg8::Unit& u, int wr, int wc, int fr, int fq) const {
        const int row0 = u.pm * 256 + wr * 64 + fr, col0 = u.pn * 256 + wc * 32 + 4 * fq;
#pragma unroll
        for (int ai = 0; ai < 2; ++ai)
#pragma unroll
            for (int m = 0; m < 4; ++m) { const size_t off = (size_t)(row0 + ai * 128 + m * 16) * D + col0;
#pragma unroll
                for (int bj = 0; bj < 2; ++bj)
#pragma unroll
                    for (int n = 0; n < 2; ++n) { const f32x4 b = *(const f32x4*)(base + off + bj * 128 + n * 16); *(f32x4*)(out + off + bj * 128 + n * 16) = b + acc[ai][bj][m][n]; } }
    }
};
struct EpiSiluMul {
    static constexpr bool PERM = false, AFTER_DRAIN = false;
    bf16_t* HIDp;
    __device__ __forceinline__ void operator()(const f32x4 (&acc)[2][2][4][2], const pg8::Unit& u, int wr, int wc, int fr, int fq) const {
        const int pnl = u.pn % 22;
        const int row0 = u.pm * 256 + wr * 64 + fr, col0 = pnl * 128 + wc * 32 + 4 * fq;
#pragma unroll
        for (int ai = 0; ai < 2; ++ai)
#pragma unroll
            for (int m = 0; m < 4; ++m) { bf16_t* rowp = HIDp + (size_t)(row0 + ai * 128 + m * 16) * DE + col0;
#pragma unroll
                for (int n = 0; n < 2; ++n) { const f32x4 g = acc[ai][0][m][n], up = acc[ai][1][m][n]; float h[4];
#pragma unroll
                    for (int j = 0; j < 4; ++j) h[j] = g[j] / (1.0f + __expf(-g[j])) * up[j];
                    v2u w; w.x = pk2(h[0], h[1]); w.y = pk2(h[2], h[3]); *(v2u*)(rowp + n * 16) = w; } }
    }
};
struct EpiYE {
    static constexpr bool PERM = true, AFTER_DRAIN = false;
    const float* GATE; bf16_t* YE;
    __device__ __forceinline__ void operator()(const f32x4 (&acc)[2][2][4][2], const pg8::Unit& u, int wr, int wc, int fr, int fq) const {
        const int pnl = u.pn & 3;
        const int row0 = u.pm * 256 + wr * 64 + fr, col0 = pnl * 256 + wc * 32 + 8 * fq;
#pragma unroll
        for (int ai = 0; ai < 2; ++ai)
#pragma unroll
            for (int m = 0; m < 4; ++m) { const int row = row0 + ai * 128 + m * 16; const float gt_ = GATE[row]; bf16_t* rowp = YE + (size_t)row * D + col0;
#pragma unroll
                for (int bj = 0; bj < 2; ++bj) { const f32x4 v0 = acc[ai][bj][m][0] * gt_, v1 = acc[ai][bj][m][1] * gt_;
                    v4u w; w.x = pg8::cvt_pk_bf16(v0[0], v0[1]); w.y = pg8::cvt_pk_bf16(v0[2], v0[3]); w.z = pg8::cvt_pk_bf16(v1[0], v1[1]); w.w = pg8::cvt_pk_bf16(v1[2], v1[3]);
                    *(v4u*)(rowp + bj * 128) = w; } }
    }
};
struct EpiBf16Store {
    static constexpr bool PERM = true, AFTER_DRAIN = false;
    bf16_t* O; int ldc; float scale;
    __device__ __forceinline__ void operator()(const f32x4 (&acc)[2][2][4][2], const pg8::Unit& u, int wr, int wc, int fr, int fq) const {
        const int row0 = u.pm * 256 + wr * 64 + fr, col0 = u.pn * 256 + wc * 32 + 8 * fq;
#pragma unroll
        for (int ai = 0; ai < 2; ++ai)
#pragma unroll
            for (int m = 0; m < 4; ++m) { bf16_t* rowp = O + (size_t)(row0 + ai * 128 + m * 16) * ldc + col0;
#pragma unroll
                for (int bj = 0; bj < 2; ++bj) { const f32x4 v0 = acc[ai][bj][m][0] * scale, v1 = acc[ai][bj][m][1] * scale;
                    v4u w; w.x = pg8::cvt_pk_bf16(v0[0], v0[1]); w.y = pg8::cvt_pk_bf16(v0[2], v0[3]); w.z = pg8::cvt_pk_bf16(v1[0], v1[1]); w.w = pg8::cvt_pk_bf16(v1[2], v1[3]);
                    *(v4u*)(rowp + bj * 128) = w; } }
    }
};
struct EpiKV {
    static constexpr bool PERM = false, AFTER_DRAIN = false;
    bf16_t* K; bf16_t* Vt;
    __device__ __forceinline__ void operator()(const f32x4 (&acc)[2][2][4][2], const pg8::Unit& u, int wr, int wc, int fr, int fq) const {
        const int row0 = u.pm * 256 + wr * 64 + fr, col0 = u.pn * 256 + wc * 32 + 4 * fq;
#pragma unroll
        for (int ai = 0; ai < 2; ++ai)
#pragma unroll
            for (int m = 0; m < 4; ++m) { const int row = row0 + ai * 128 + m * 16;
#pragma unroll
                for (int bj = 0; bj < 2; ++bj)
#pragma unroll
                    for (int n = 0; n < 2; ++n) { const int col = col0 + bj * 128 + n * 16; const f32x4 v = acc[ai][bj][m][n];
                        if (col < 1024) { v2u w; w.x = pk2(v[0], v[1]); w.y = pk2(v[2], v[3]); *(v2u*)(K + (size_t)row * 1024 + col) = w; }
                        else { const int b = row >> 8, mm = row & 255; bf16_t* vp = Vt + ((size_t)(b * 1024 + (col - 1024)) * 256 + mm);
#pragma unroll
                            for (int j = 0; j < 4; ++j) vp[(size_t)j * 256] = (bf16_t)f2bf(v[j]); } } }
    }
};

constexpr float QSCALE = 0.125f * 1.4426950408889634f;
struct EpiEven {
    static constexpr bool PERM = true, AFTER_DRAIN = false;
    const float* rc; const float* rs; bf16_t* QhA; bf16_t* KhA; bf16_t* QhB; bf16_t* KhB; bf16_t* VhA; bf16_t* VhB;
    __device__ __forceinline__ void operator()(const f32x4 (&acc)[2][2][4][2], const pg8::Unit& u, int wr, int wc, int fr, int fq) const {
        asm volatile("" : "+v"(fr), "+v"(fq));
        const int row0 = u.pm * 256 + wr * 64 + fr;
#pragma unroll
        for (int bj = 0; bj < 2; ++bj) {
            const int c0 = u.pn * 256 + bj * 128 + wc * 32 + 8 * fq;
            int kind; bf16_t* base; int stride; float sc = 1.0f;
            if (c0 < 512) { kind = 0; base = QhA + ((size_t)(c0 >> 6) * T) * 64 + (c0 & 63); stride = 64; sc = QSCALE; }
            else if (c0 < 1024) { kind = 0; base = KhA + ((size_t)((c0 - 512) >> 6) * T) * 64 + (c0 & 63); stride = 64; }
            else if (c0 < 1536) { kind = 1; base = VhA + ((size_t)((c0 - 1024) >> 6) * T) * 64 + (c0 & 63); stride = 64; }
            else if (c0 < 2048) { kind = 0; base = QhB + ((size_t)((c0 - 1536) >> 6) * T) * 64 + (c0 & 63); stride = 64; sc = QSCALE; }
            else if (c0 < 2176) { kind = 0; base = KhB + ((size_t)((c0 - 2048) >> 6) * T) * 64 + (c0 & 63); stride = 64; }
            else { kind = 1; base = VhB + ((size_t)((c0 - 2176) >> 6) * T) * 64 + (c0 & 63); stride = 64; }
            const int pi = (c0 & 63) >> 1;
#pragma unroll
            for (int ai = 0; ai < 2; ++ai)
#pragma unroll
                for (int m = 0; m < 4; ++m) {
                    const int tok = row0 + ai * 128 + m * 16;
                    const f32x4 v0 = acc[ai][bj][m][0], v1 = acc[ai][bj][m][1];
                    float y[8];
                    if (kind == 0) {
                        const int s = tok & (S - 1);
                        const f32x4 c4 = *(const f32x4*)(rc + s * 32 + pi), s4 = *(const f32x4*)(rs + s * 32 + pi);
                        y[0] = (v0[0] * c4[0] - v0[1] * s4[0]) * sc; y[1] = (v0[1] * c4[0] + v0[0] * s4[0]) * sc;
                        y[2] = (v0[2] * c4[1] - v0[3] * s4[1]) * sc; y[3] = (v0[3] * c4[1] + v0[2] * s4[1]) * sc;
                        y[4] = (v1[0] * c4[2] - v1[1] * s4[2]) * sc; y[5] = (v1[1] * c4[2] + v1[0] * s4[2]) * sc;
                        y[6] = (v1[2] * c4[3] - v1[3] * s4[3]) * sc; y[7] = (v1[3] * c4[3] + v1[2] * s4[3]) * sc;
                    } else { y[0] = v0[0]; y[1] = v0[1]; y[2] = v0[2]; y[3] = v0[3]; y[4] = v1[0]; y[5] = v1[1]; y[6] = v1[2]; y[7] = v1[3]; }
                    v4u w; w.x = pk2(y[0], y[1]); w.y = pk2(y[2], y[3]); w.z = pk2(y[4], y[5]); w.w = pk2(y[6], y[7]);
                    *(v4u*)(base + (size_t)tok * stride) = w;
                }
        }
    }
};

struct EpiLora {
    static constexpr bool PERM = false, AFTER_DRAIN = false;
    const float *w0, *a0, *k_a; const bf16_t *KB, *KK; bf16_t *LW, *KD, *BB, *G;
    __device__ __forceinline__ void operator()(const f32x4 (&acc)[2][2][4][2], const pg8::Unit& u, int wr, int wc, int fr, int fq) const {
        asm volatile("" : "+v"(fr), "+v"(fq));
        const int row0 = u.pm * 256 + wr * 64 + fr;
#pragma unroll
        for (int bj = 0; bj < 2; ++bj)
#pragma unroll
            for (int n = 0; n < 2; ++n) {
                const int c0 = u.pn * 256 + bj * 128 + wc * 32 + n * 16 + 4 * fq, sec = c0 >> 9, cc = c0 & 511;
#pragma unroll
                for (int ai = 0; ai < 2; ++ai)
#pragma unroll
                    for (int m = 0; m < 4; ++m) {
                        const size_t tok = row0 + ai * 128 + m * 16;
                        const f32x4 v = acc[ai][bj][m][n];
                        if (sec < 2) {
                            const f32x4 w = *(const f32x4*)(w0 + sec * 512 + cc); float o[4];
#pragma unroll
                            for (int j = 0; j < 4; ++j) { const float xw = -(w[j] + v[j]);
                                o[j] = -0.6065306597126334f / (1.0f + __expf(xw)); }
                            v2u ww; ww.x = pk2(o[0], o[1]); ww.y = pk2(o[2], o[3]);
                            *(v2u*)(LW + ((size_t)sec * T + tok) * 512 + cc) = ww;
                        } else if (sec < 4) {
                            const int d = sec - 2;
                            const f32x4 a_ = *(const f32x4*)(a0 + d * 512 + cc), ka = *(const f32x4*)(k_a + cc);
                            const v2u kw = *(const v2u*)(KB + tok * 512 + cc), kkw = *(const v2u*)(KK + tok * 512 + cc);
                            const float kv[4] = {bflo(kw.x), bfhi(kw.x), bflo(kw.y), bfhi(kw.y)}, kk[4] = {bflo(kkw.x), bfhi(kkw.x), bflo(kkw.y), bfhi(kkw.y)};
                            float okd[4], obb[4];
#pragma unroll
                            for (int j = 0; j < 4; ++j) { const float alr = 1.0f / (1.0f + __expf(-(a_[j] + v[j]))); okd[j] = kv[j] * (1.0f + (alr - 1.0f) * ka[j]); obb[j] = kk[j] * alr; }
                            v2u w1, w2_; w1.x = pk2(okd[0], okd[1]); w1.y = pk2(okd[2], okd[3]); w2_.x = pk2(obb[0], obb[1]); w2_.y = pk2(obb[2], obb[3]);
                            *(v2u*)(KD + ((size_t)d * T + tok) * 512 + cc) = w1; *(v2u*)(BB + ((size_t)d * T + tok) * 512 + cc) = w2_;
                        } else { v2u ww; ww.x = pk2(v[0], v[1]); ww.y = pk2(v[2], v[3]); *(v2u*)(G + tok * 512 + cc) = ww; }
                        __builtin_amdgcn_sched_barrier(0);
                    }
            }
    }
};

__device__ __forceinline__ float clamp8(float x) { return __builtin_amdgcn_fmed3f(x, -448.f, 448.f); }
__device__ __forceinline__ unsigned pk4_fp8(float a, float b, float c, float d) {
    int w = 0; w = __builtin_amdgcn_cvt_pk_fp8_f32(clamp8(a), clamp8(b), w, false); w = __builtin_amdgcn_cvt_pk_fp8_f32(clamp8(c), clamp8(d), w, true); return (unsigned)w;
}
struct EpiSiluMul8 {
    static constexpr bool PERM = false, AFTER_DRAIN = false;
    unsigned char* HIDp;
    __device__ __forceinline__ void operator()(const f32x4 (&acc)[2][2][4][2], const pg8::Unit& u, int wr, int wc, int fr, int fq) const {
        asm volatile("s_nop 7\n\ts_nop 7\n\ts_nop 7"); __builtin_amdgcn_sched_barrier(0);
        const int pnl = u.pn % 22;
        const int row0 = u.pm * 256 + wr * 64 + fr, col0 = pnl * 128 + wc * 32 + 4 * fq;
        const float s1 = 1.0f / (ASC8 * GUSC8);
#pragma unroll
        for (int ai = 0; ai < 2; ++ai)
#pragma unroll
            for (int m = 0; m < 4; ++m) { unsigned char* rowp = HIDp + (size_t)(row0 + ai * 128 + m * 16) * DE + col0;
#pragma unroll
                for (int n = 0; n < 2; ++n) { const f32x4 g = acc[ai][0][m][n] * s1, up = acc[ai][1][m][n] * (s1 * HSC8); float h[4];
#pragma unroll
                    for (int j = 0; j < 4; ++j) h[j] = g[j] / (1.0f + __expf(-g[j])) * up[j];
                    *(unsigned*)(rowp + n * 16) = pk4_fp8(h[0], h[1], h[2], h[3]); } }
    }
};
struct EpiYE8 {
    static constexpr bool PERM = true, AFTER_DRAIN = false;
    const float* GATE; bf16_t* YE;
    __device__ __forceinline__ void operator()(const f32x4 (&acc)[2][2][4][2], const pg8::Unit& u, int wr, int wc, int fr, int fq) const {
        asm volatile("s_nop 7\n\ts_nop 7\n\ts_nop 7"); __builtin_amdgcn_sched_barrier(0);
        const int pnl = u.pn & 3;
        const int row0 = u.pm * 256 + wr * 64 + fr, col0 = pnl * 256 + wc * 32 + 8 * fq;
#pragma unroll
        for (int ai = 0; ai < 2; ++ai)
#pragma unroll
            for (int m = 0; m < 4; ++m) { const int row = row0 + ai * 128 + m * 16; const float gt_ = GATE[row] * (1.0f / (HSC8 * DSC8)); bf16_t* rowp = YE + (size_t)row * D + col0;
#pragma unroll
                for (int bj = 0; bj < 2; ++bj) { const f32x4 v0 = acc[ai][bj][m][0] * gt_, v1 = acc[ai][bj][m][1] * gt_;
                    v4u w; w.x = pk2(v0[0], v0[1]); w.y = pk2(v0[2], v0[3]); w.z = pk2(v1[0], v1[1]); w.w = pk2(v1[2], v1[3]);
                    *(v4u*)(rowp + bj * 128) = w; } }
    }
};
template <class RowMap>
__device__ __forceinline__ void transpose_item_fp8(const float* W, int K, int N, unsigned char* WT, RowMap rm, float sc, LAS float* scr, int item, int lane) {
    const int nblk = N / 64, kb = item / nblk, nb_ = item % nblk, k0 = 64 * kb, n0 = 64 * nb_;
    f32x4 ld[16];
#pragma unroll
    for (int i = 0; i < 16; ++i) ld[i] = *(const f32x4*)(W + (size_t)(k0 + 4 * i + (lane >> 4)) * N + n0 + 4 * (lane & 15));
#pragma unroll
    for (int i = 0; i < 16; ++i) { LAS float* p = scr + (4 * i + (lane >> 4)) * 65 + 4 * (lane & 15); p[0] = ld[i][0]; p[1] = ld[i][1]; p[2] = ld[i][2]; p[3] = ld[i][3]; }
    asm volatile("s_waitcnt lgkmcnt(0)" ::: "memory");
    const int c = lane & 3;
#pragma unroll
    for (int j = 0; j < 4; ++j) { const int n = (lane >> 2) + 16 * j; const LAS float* s = scr + (16 * c) * 65 + n;
        v4u o;
#pragma unroll
        for (int q = 0; q < 4; ++q) o[q] = pk4_fp8(s[(4 * q) * 65] * sc, s[(4 * q + 1) * 65] * sc, s[(4 * q + 2) * 65] * sc, s[(4 * q + 3) * 65] * sc);
        *(v4u*)(WT + (size_t)rm(n0 + n) * K + k0 + 16 * c) = o; }
    asm volatile("s_waitcnt lgkmcnt(0)" ::: "memory");
}

struct EpiResidN {
    static constexpr bool PERM = false, AFTER_DRAIN = false;
    const float* base; float* out; bf16_t* Xb; float* SSP;
    __device__ __forceinline__ void operator()(const f32x4 (&acc)[2][2][4][2], const pg8::Unit& u, int wr, int wc, int fr, int fq) const {
        asm volatile("" : "+v"(fr), "+v"(fq));
        const int row0 = u.pm * 256 + wr * 64 + fr, col0 = u.pn * 256 + wc * 32 + 4 * fq;
#pragma unroll
        for (int ai = 0; ai < 2; ++ai)
#pragma unroll
            for (int m = 0; m < 4; ++m) { const size_t row = row0 + ai * 128 + m * 16; const size_t off = row * D + col0; float ss = 0.f;
#pragma unroll
                for (int bj = 0; bj < 2; ++bj)
#pragma unroll
                    for (int n = 0; n < 2; ++n) { const f32x4 b = *(const f32x4*)(base + off + bj * 128 + n * 16); const f32x4 o = b + acc[ai][bj][m][n];
                        *(f32x4*)(out + off + bj * 128 + n * 16) = o;
                        v2u w; w.x = pk2(o[0], o[1]); w.y = pk2(o[2], o[3]); *(v2u*)(Xb + off + bj * 128 + n * 16) = w;
                        ss += (o[0] * o[0] + o[1] * o[1]) + (o[2] * o[2] + o[3] * o[3]); }
                ss += __shfl_xor(ss, 16); ss += __shfl_xor(ss, 32);
                if (fq == 0) SSP[row * 16 + u.pn * 4 + wc] = ss; }
    }
};
struct EpiBf16StoreRS {
    static constexpr bool PERM = true, AFTER_DRAIN = false;
    bf16_t* O; int ldc; const float* SSP;
    __device__ __forceinline__ void operator()(const f32x4 (&acc)[2][2][4][2], const pg8::Unit& u, int wr, int wc, int fr, int fq) const {
        asm volatile("" : "+v"(fr), "+v"(fq));
        const int row0 = u.pm * 256 + wr * 64 + fr, col0 = u.pn * 256 + wc * 32 + 8 * fq;
#pragma unroll
        for (int ai = 0; ai < 2; ++ai)
#pragma unroll
            for (int m = 0; m < 4; ++m) { const size_t row = row0 + ai * 128 + m * 16;
                const f32x4* sp = (const f32x4*)(SSP + row * 16); const f32x4 s0 = sp[0], s1 = sp[1], s2 = sp[2], s3 = sp[3];
                const float ss = (((s0[0] + s0[1]) + (s0[2] + s0[3])) + ((s1[0] + s1[1]) + (s1[2] + s1[3]))) + (((s2[0] + s2[1]) + (s2[2] + s2[3])) + ((s3[0] + s3[1]) + (s3[2] + s3[3])));
                const float rs = rsqrtf(ss * (1.0f / D) + 1e-6f);
                bf16_t* rowp = O + row * ldc + col0;
#pragma unroll
                for (int bj = 0; bj < 2; ++bj) { const f32x4 v0 = acc[ai][bj][m][0] * rs, v1 = acc[ai][bj][m][1] * rs;
                    v4u w; w.x = pk2(v0[0], v0[1]); w.y = pk2(v0[2], v0[3]); w.z = pk2(v1[0], v1[1]); w.w = pk2(v1[2], v1[3]);
                    *(v4u*)(rowp + bj * 128) = w; } }
    }
};
struct MoeOrder {
    int G, c, npairs;
    int per;
    __device__ __forceinline__ bool next(int i, pg8::Unit& u) const {
        const int x = c & 7, y = c >> 3, pml = y & 7, pnq = y >> 3;
        const int epn = i * 32 + x * 4 + pnq;
        if (epn >= npairs || c >= 256) return false;
        const int e = epn / per;
        u.pm = e * 8 + pml; u.pn = epn; return true;
    }
    __device__ __forceinline__ void a_ready(const pg8::Unit&) const {}
    __device__ __forceinline__ void done(const pg8::Unit&) const {}
};

template <class RowMap>
__device__ __forceinline__ void transpose_item(const float* W, int K, int N, bf16_t* WT, RowMap rm, LAS float* scr, int item, int lane, const float* kscale = nullptr) {
    const int nblk = N / 64, kb = item / nblk, nb_ = item % nblk, k0 = 64 * kb, n0 = 64 * nb_;
    f32x4 ld[16];
#pragma unroll
    for (int i = 0; i < 16; ++i) ld[i] = *(const f32x4*)(W + (size_t)(k0 + 4 * i + (lane >> 4)) * N + n0 + 4 * (lane & 15));
#pragma unroll
    for (int i = 0; i < 16; ++i) { LAS float* p = scr + (4 * i + (lane >> 4)) * 65 + 4 * (lane & 15); p[0] = ld[i][0]; p[1] = ld[i][1]; p[2] = ld[i][2]; p[3] = ld[i][3]; }
    asm volatile("s_waitcnt lgkmcnt(0)" ::: "memory");
    const int c = lane & 7;
    float ksc[8];
#pragma unroll
    for (int q = 0; q < 8; ++q) ksc[q] = kscale ? kscale[k0 + 8 * c + q] : 1.0f;
#pragma unroll
    for (int j = 0; j < 8; ++j) { const int n = (lane >> 3) + 8 * j; const LAS float* s = scr + (8 * c) * 65 + n;
        v4u o; o.x = pk2(s[0 * 65] * ksc[0], s[1 * 65] * ksc[1]); o.y = pk2(s[2 * 65] * ksc[2], s[3 * 65] * ksc[3]); o.z = pk2(s[4 * 65] * ksc[4], s[5 * 65] * ksc[5]); o.w = pk2(s[6 * 65] * ksc[6], s[7 * 65] * ksc[7]);
        *(v4u*)(WT + (size_t)rm(n0 + n) * K + k0 + 8 * c) = o; }
    asm volatile("s_waitcnt lgkmcnt(0)" ::: "memory");
}

__device__ __forceinline__ void rmsnorm_rows_bf16(const float* x, const float* g, bf16_t* out, int M) {
    const int tix_ = tidx(); const int lane = tix_ & 63, gw = blockIdx.x * 8 + (tix_ >> 6), ngw = gridDim.x * 8;
    for (int m = gw; m < M; m += ngw) {
        const float4* xr = (const float4*)(x + (size_t)m * D);
        float4 v[4]; float s = 0.f;
#pragma unroll
        for (int j = 0; j < 4; ++j) { v[j] = xr[lane + 64 * j]; s += v[j].x * v[j].x + v[j].y * v[j].y + v[j].z * v[j].z + v[j].w * v[j].w; }
        const float r = rsqrtf(wave_sum(s) * (1.0f / D) + 1e-6f);
        v2u* o = (v2u*)(out + (size_t)m * D);
#pragma unroll
        for (int j = 0; j < 4; ++j) { const float4 gg = ((const float4*)g)[lane + 64 * j];
            v2u w; w.x = pk2(v[j].x * r * gg.x, v[j].y * r * gg.y); w.y = pk2(v[j].z * r * gg.z, v[j].w * r * gg.w); o[lane + 64 * j] = w; }
    }
}
__device__ __forceinline__ void rmsnorm_rows_f32(const float* x, const float* g, float* out, int M) {
    const int tix_ = tidx(); const int lane = tix_ & 63, gw = blockIdx.x * 8 + (tix_ >> 6), ngw = gridDim.x * 8;
    for (int m = gw; m < M; m += ngw) {
        const float4* xr = (const float4*)(x + (size_t)m * D);
        float4 v[4]; float s = 0.f;
#pragma unroll
        for (int j = 0; j < 4; ++j) { v[j] = xr[lane + 64 * j]; s += v[j].x * v[j].x + v[j].y * v[j].y + v[j].z * v[j].z + v[j].w * v[j].w; }
        const float r = rsqrtf(wave_sum(s) * (1.0f / D) + 1e-6f);
        float4* o = (float4*)(out + (size_t)m * D);
#pragma unroll
        for (int j = 0; j < 4; ++j) { const float4 gg = ((const float4*)g)[lane + 64 * j];
            o[lane + 64 * j] = make_float4(v[j].x * r * gg.x, v[j].y * r * gg.y, v[j].z * r * gg.z, v[j].w * r * gg.w); }
    }
}

__device__ __forceinline__ int block_exscan(int v, int* sh, int* tot) {
    const int tid = tidx(), lane = tid & 63, w = tid >> 6;
    int inc = v;
#pragma unroll
    for (int o = 1; o < 64; o <<= 1) { const int t = __shfl_up(inc, o); if (lane >= o) inc += t; }
    __syncthreads();
    if (lane == 63) sh[w] = inc;
    __syncthreads();
    int base = 0, total = 0;
#pragma unroll
    for (int i = 0; i < 8; ++i) { const int x = sh[i]; if (i < w) base += x; total += x; }
    *tot = total;
    return base + inc - v;
}


typedef short bf16x8 __attribute__((ext_vector_type(8)));
typedef float f32x16 __attribute__((ext_vector_type(16)));
constexpr int MROW = 144;
constexpr int MBUF = 64 * MROW;
__device__ __forceinline__ bf16x8 frag_rm(const LAS unsigned char* M, int row0, int k0, int fr, int fq) {
    return *(const LAS bf16x8*)(M + (row0 + fr) * MROW + (k0 + 8 * fq) * 2);
}
__device__ __forceinline__ bf16x8 frag_cm(const LAS unsigned char* M, int k0, int col0, int fr, int fq) {
    const LAS unsigned short* p = (const LAS unsigned short*)(M + (k0 + 8 * fq) * MROW + (col0 + fr) * 2);
    bf16x8 v;
#pragma unroll
    for (int j = 0; j < 8; ++j) v[j] = (short)p[j * (MROW / 2)];
    return v;
}
__device__ __forceinline__ void tile_store_bf16(LAS unsigned char* M, int m0, int n0, int fr, int fq, const f32x4& c) {
    v2u w; w.x = pk2(c[0], c[1]); w.y = pk2(c[2], c[3]);
    *(LAS v2u*)(M + (m0 + fr) * MROW + (n0 + 4 * fq) * 2) = w;
}
#define MMA16(acc, lf, rf) acc = __builtin_amdgcn_mfma_f32_16x16x32_bf16(rf, lf, acc, 0, 0, 0)

__device__ __forceinline__ void scan_r1(const bf16_t* LWg, const bf16_t* RVg, const bf16_t* KDg, const bf16_t* KKg, const bf16_t* BBg,
                                        bf16_t* PT, bf16_t* QT, bf16_t* RH, float* YL, unsigned char* lds_raw) {
    LAS unsigned char* L = (LAS unsigned char*)lds_raw;
    LAS unsigned char* mAT = L + 0 * MBUF; LAS unsigned char* mRT = L + 1 * MBUF; LAS unsigned char* mBT = L + 2 * MBUF; LAS unsigned char* mKT = L + 3 * MBUF;
    LAS unsigned char* mV = L + 4 * MBUF; LAS unsigned char* mN0 = L + 5 * MBUF; LAS unsigned char* mN1 = L + 6 * MBUF; LAS unsigned char* mNAK = L + 7 * MBUF;
    LAS unsigned char* mNRB = L + 8 * MBUF; LAS unsigned char* mNRK = L + 9 * MBUF; LAS unsigned char* mT0 = L + 10 * MBUF; LAS unsigned char* mT1 = L + 11 * MBUF;
    LAS unsigned char* mW = L + 12 * MBUF;
    LAS float* LWs = (LAS float*)(L + 13 * MBUF);
    const int tid = tidx(), lane = tid & 63, wave = tid >> 6, fr = lane & 15, fq = lane >> 4;
    const int tm = wave >> 1, tn0 = (wave & 1) * 2;
    const int m0 = tm * 16;
    for (int item = blockIdx.x; item < 4096; item += gridDim.x) {
        const int c = item & 127, h = (item >> 7) & 7, n = item >> 10, dir = n >> 1, b = n & 1;
        const int t = tid >> 3, i0 = (tid & 7) * 8;
        const int pos = dir ? (S - 1 - (c * 64 + t)) : (c * 64 + t);
        const size_t tok = (size_t)b * S + pos;
        const size_t ch = (size_t)h * 64 + i0;
        const v4u lw4 = *(const v4u*)(LWg + ((size_t)dir * T + tok) * 512 + ch);
        const v4u r4 = *(const v4u*)(RVg + tok * D + ch), v4 = *(const v4u*)(RVg + tok * D + 512 + ch);
        const v4u kd4 = *(const v4u*)(KDg + ((size_t)dir * T + tok) * 512 + ch), kk4 = *(const v4u*)(KKg + tok * 512 + ch), bb4 = *(const v4u*)(BBg + ((size_t)dir * T + tok) * 512 + ch);
        float lw[8], Lin[8];
#pragma unroll
        for (int q = 0; q < 4; ++q) { lw[2 * q] = bflo(lw4[q]); lw[2 * q + 1] = bfhi(lw4[q]); }
#pragma unroll
        for (int j = 0; j < 8; ++j) { float x = lw[j];
#pragma unroll
            for (int o = 8; o < 64; o <<= 1) { const float y = __shfl_up(x, o); if (lane >= o) x += y; }
            Lin[j] = x; }
        __syncthreads();
        if (lane >= 56) {
#pragma unroll
            for (int j = 0; j < 8; ++j) LWs[64 + wave * 64 + i0 + j] = Lin[j]; }
        __syncthreads();
        {
            float off[8];
#pragma unroll
            for (int j = 0; j < 8; ++j) off[j] = 0.f;
            for (int w = 0; w < 8; ++w) { if (w < wave) {
#pragma unroll
                for (int j = 0; j < 8; ++j) off[j] += LWs[64 + w * 64 + i0 + j]; } }
#pragma unroll
            for (int j = 0; j < 8; ++j) Lin[j] += off[j];
            if (t == 63) {
#pragma unroll
                for (int j = 0; j < 8; ++j) LWs[i0 + j] = Lin[j]; }
            float at_[8], rt_[8], bt_[8], kt_[8];
#pragma unroll
            for (int q = 0; q < 4; ++q) {
#pragma unroll
                for (int e = 0; e < 2; ++e) { const int j = 2 * q + e;
                    const float ein = __expf(Lin[j]), einv = __expf(-Lin[j]), eex = __expf(Lin[j] - lw[j]);
                    const float kkv = e ? bfhi(kk4[q]) : bflo(kk4[q]), rv_ = e ? bfhi(r4[q]) : bflo(r4[q]), bbv = e ? bfhi(bb4[q]) : bflo(bb4[q]), kdv = e ? bfhi(kd4[q]) : bflo(kd4[q]);
                    at_[j] = -kkv * eex; rt_[j] = rv_ * ein; bt_[j] = bbv * einv; kt_[j] = kdv * einv; }
            }
            v4u w;
            w.x = pk2(at_[0], at_[1]); w.y = pk2(at_[2], at_[3]); w.z = pk2(at_[4], at_[5]); w.w = pk2(at_[6], at_[7]); *(LAS v4u*)(mAT + t * MROW + i0 * 2) = w;
            w.x = pk2(rt_[0], rt_[1]); w.y = pk2(rt_[2], rt_[3]); w.z = pk2(rt_[4], rt_[5]); w.w = pk2(rt_[6], rt_[7]); *(LAS v4u*)(mRT + t * MROW + i0 * 2) = w;
            w.x = pk2(bt_[0], bt_[1]); w.y = pk2(bt_[2], bt_[3]); w.z = pk2(bt_[4], bt_[5]); w.w = pk2(bt_[6], bt_[7]); *(LAS v4u*)(mBT + t * MROW + i0 * 2) = w;
            w.x = pk2(kt_[0], kt_[1]); w.y = pk2(kt_[2], kt_[3]); w.z = pk2(kt_[4], kt_[5]); w.w = pk2(kt_[6], kt_[7]); *(LAS v4u*)(mKT + t * MROW + i0 * 2) = w;
            *(LAS v4u*)(mV + t * MROW + i0 * 2) = v4;
        }
        __syncthreads();
        f32x4 Tacc[2];
        {
            bf16x8 la[2], lr[2];
#pragma unroll
            for (int ks = 0; ks < 2; ++ks) { la[ks] = frag_rm(mAT, m0, 32 * ks, fr, fq); lr[ks] = frag_rm(mRT, m0, 32 * ks, fr, fq); }
#pragma unroll
            for (int q = 0; q < 2; ++q) {
                const int n0 = (tn0 + q) * 16;
                f32x4 cab = {0.f, 0.f, 0.f, 0.f}, cak = cab, crb = cab, crk = cab;
#pragma unroll
                for (int ks = 0; ks < 2; ++ks) {
                    const bf16x8 rb_ = frag_rm(mBT, n0, 32 * ks, fr, fq), rk_ = frag_rm(mKT, n0, 32 * ks, fr, fq);
                    MMA16(cab, la[ks], rb_); MMA16(cak, la[ks], rk_); MMA16(crb, lr[ks], rb_); MMA16(crk, lr[ks], rk_);
                }
                const int tt = m0 + fr;
#pragma unroll
                for (int j = 0; j < 4; ++j) { const int ss = n0 + 4 * fq + j;
                    if (!(ss < tt)) { cab[j] = 0.f; cak[j] = 0.f; }
                    if (!(ss <= tt)) { crb[j] = 0.f; crk[j] = 0.f; } }
                tile_store_bf16(mN0, m0, n0, fr, fq, cab); tile_store_bf16(mNAK, m0, n0, fr, fq, cak);
                tile_store_bf16(mNRB, m0, n0, fr, fq, crb); tile_store_bf16(mNRK, m0, n0, fr, fq, crk);
#pragma unroll
                for (int j = 0; j < 4; ++j) cab[j] += ((n0 + 4 * fq + j) == tt) ? 1.f : 0.f;
                Tacc[q] = cab;
                tile_store_bf16(mT0, m0, n0, fr, fq, cab);
            }
        }
        __syncthreads();
        {
            bf16x8 lk[2], ln_[2];
#pragma unroll
            for (int ks = 0; ks < 2; ++ks) { lk[ks] = frag_rm(mNAK, m0, 32 * ks, fr, fq); ln_[ks] = frag_rm(mN0, m0, 32 * ks, fr, fq); }
#pragma unroll
            for (int q = 0; q < 2; ++q) {
                const int n0 = (tn0 + q) * 16;
                f32x4 cw = {0.f, 0.f, 0.f, 0.f}, cn = cw;
#pragma unroll
                for (int ks = 0; ks < 2; ++ks) { MMA16(cw, lk[ks], frag_cm(mV, 32 * ks, n0, fr, fq)); MMA16(cn, ln_[ks], frag_cm(mN0, 32 * ks, n0, fr, fq)); }
                tile_store_bf16(mW, m0, n0, fr, fq, cw); tile_store_bf16(mN1, m0, n0, fr, fq, cn);
            }
        }
        __syncthreads();
#pragma unroll
        for (int k = 1; k <= 5; ++k) {
            LAS unsigned char* Nk = (k & 1) ? mN1 : mN0; LAS unsigned char* Nn = (k & 1) ? mN0 : mN1;
            LAS unsigned char* Tk = ((k - 1) & 1) ? mT1 : mT0; LAS unsigned char* Tn = ((k - 1) & 1) ? mT0 : mT1;
            bf16x8 lt[2], ln_[2];
#pragma unroll
            for (int ks = 0; ks < 2; ++ks) { lt[ks] = frag_rm(Tk, m0, 32 * ks, fr, fq); ln_[ks] = frag_rm(Nk, m0, 32 * ks, fr, fq); }
#pragma unroll
            for (int q = 0; q < 2; ++q) {
                const int n0 = (tn0 + q) * 16;
                f32x4 cn = {0.f, 0.f, 0.f, 0.f};
#pragma unroll
                for (int ks = 0; ks < 2; ++ks) { const bf16x8 rn = frag_cm(Nk, 32 * ks, n0, fr, fq); MMA16(Tacc[q], lt[ks], rn); if (k < 5) MMA16(cn, ln_[ks], rn); }
                tile_store_bf16(Tn, m0, n0, fr, fq, Tacc[q]);
                if (k < 5) tile_store_bf16(Nn, m0, n0, fr, fq, cn);
            }
            __syncthreads();
        }
        {
            bf16x8 lt[2];
#pragma unroll
            for (int ks = 0; ks < 2; ++ks) lt[ks] = frag_rm(mT1, m0, 32 * ks, fr, fq);
#pragma unroll
            for (int q = 0; q < 2; ++q) {
                const int n0 = (tn0 + q) * 16;
                f32x4 ca = {0.f, 0.f, 0.f, 0.f}, cu = ca;
#pragma unroll
                for (int ks = 0; ks < 2; ++ks) { MMA16(ca, lt[ks], frag_cm(mAT, 32 * ks, n0, fr, fq)); MMA16(cu, lt[ks], frag_cm(mW, 32 * ks, n0, fr, fq)); }
                tile_store_bf16(mN0, m0, n0, fr, fq, ca); tile_store_bf16(mT0, m0, n0, fr, fq, cu);
            }
        }
        __syncthreads();
        LAS unsigned char* mAH = mN0; LAS unsigned char* mUL = mT0;
        {
            bf16x8 lrb[2], lrk[2];
#pragma unroll
            for (int ks = 0; ks < 2; ++ks) { lrb[ks] = frag_rm(mNRB, m0, 32 * ks, fr, fq); lrk[ks] = frag_rm(mNRK, m0, 32 * ks, fr, fq); }
#pragma unroll 1
            for (int q = 0; q < 2; ++q) {
                const int n0 = (tn0 + q) * 16;
                f32x4 crh = {0.f, 0.f, 0.f, 0.f}, cyl = crh;
#pragma unroll
                for (int ks = 0; ks < 2; ++ks) {
                    const bf16x8 ra = frag_cm(mAH, 32 * ks, n0, fr, fq); MMA16(crh, lrb[ks], ra);
                    const bf16x8 ru = frag_cm(mUL, 32 * ks, n0, fr, fq); MMA16(cyl, lrb[ks], ru);
                    const bf16x8 rv = frag_cm(mV, 32 * ks, n0, fr, fq); MMA16(cyl, lrk[ks], rv);
                }
                const size_t o = (size_t)item * 4096 + (size_t)(m0 + fr) * 64 + n0 + 4 * fq;
                { const LAS unsigned short* rp = (const LAS unsigned short*)(mRT + (m0 + fr) * MROW + (n0 + 4 * fq) * 2);
#pragma unroll
                  for (int j = 0; j < 4; ++j) crh[j] += __uint_as_float(((unsigned)rp[j]) << 16); }
                { v2u w; w.x = pk2(crh[0], crh[1]); w.y = pk2(crh[2], crh[3]); *(v2u*)(RH + o) = w; }
                *(f32x4*)(YL + o) = cyl;
            }
        }
        {
            bf16x8 lb[2], lkt[2];
#pragma unroll
            for (int ks = 0; ks < 2; ++ks) { lb[ks] = frag_cm(mBT, 32 * ks, m0, fr, fq); lkt[ks] = frag_cm(mKT, 32 * ks, m0, fr, fq); }
            const float wc = __expf(LWs[m0 + fr]);
#pragma unroll 1
            for (int q = 0; q < 2; ++q) {
                const int n0 = (tn0 + q) * 16;
                f32x4 cp = {0.f, 0.f, 0.f, 0.f}, cq = cp;
#pragma unroll
                for (int ks = 0; ks < 2; ++ks) {
                    const bf16x8 ra = frag_cm(mAH, 32 * ks, n0, fr, fq); MMA16(cp, lb[ks], ra);
                    const bf16x8 ru = frag_cm(mUL, 32 * ks, n0, fr, fq); MMA16(cq, lb[ks], ru);
                    const bf16x8 rv = frag_cm(mV, 32 * ks, n0, fr, fq); MMA16(cq, lkt[ks], rv);
                }
                const size_t o = (size_t)item * 4096 + (size_t)(m0 + fr) * 64 + n0 + 4 * fq;
#pragma unroll
                for (int j = 0; j < 4; ++j) { cp[j] = wc * (cp[j] + (((n0 + 4 * fq + j) == (m0 + fr)) ? 1.f : 0.f)); cq[j] *= wc; }
                { v2u w; w.x = pk2(cp[0], cp[1]); w.y = pk2(cp[2], cp[3]); *(v2u*)(PT + o) = w; }
                { v2u w; w.x = pk2(cq[0], cq[1]); w.y = pk2(cq[2], cq[3]); *(v2u*)(QT + o) = w; }
            }
        }
    }
}

__device__ __forceinline__ bf16x8 pack_acc8(const f32x16& x, int s) {
    v4u p; p.x = pk2(x[8 * s], x[8 * s + 1]); p.y = pk2(x[8 * s + 2], x[8 * s + 3]); p.z = pk2(x[8 * s + 4], x[8 * s + 5]); p.w = pk2(x[8 * s + 6], x[8 * s + 7]);
    return __builtin_bit_cast(bf16x8, p);
}
__device__ __forceinline__ void scan_r2(const bf16_t* PT, const bf16_t* QT, bf16_t* S0, unsigned char* lds_raw) {
    LAS unsigned char* L = (LAS unsigned char*)lds_raw;
    constexpr int SLOT_B = MBUF + 8192;
    const int tid = tidx(), lane = tid & 63, wave = tid >> 6;
    const int r = lane & 31, h2 = lane >> 5, jb = wave;
    f32x16 st[2];
#pragma unroll
    for (int ib = 0; ib < 2; ++ib)
#pragma unroll
        for (int g = 0; g < 16; ++g) st[ib][g] = 0.f;
    const size_t item0 = (size_t)blockIdx.x * 128;
    v4u stage[16];
#pragma unroll
    for (int q = 0; q < 16; ++q) { const int p = tid + 512 * q, cc = p >> 10, w = p & 1023, mat = w >> 9, idx = w & 511;
        stage[q] = *(const v4u*)((mat ? QT : PT) + (item0 + cc) * 4096 + idx * 8); }
    for (int grp = 0; grp < 16; ++grp) {
        __syncthreads();
#pragma unroll
        for (int q = 0; q < 16; ++q) { const int p = tid + 512 * q, cc = p >> 10, w = p & 1023, mat = w >> 9, idx = w & 511;
            *(LAS v4u*)(L + cc * SLOT_B + (mat ? (MBUF + idx * 16) : ((idx >> 3) * MROW + (idx & 7) * 16))) = stage[q]; }
        __syncthreads();
        if (grp < 15) {
#pragma unroll
            for (int q = 0; q < 16; ++q) { const int p = tid + 512 * q, cc = p >> 10, w = p & 1023, mat = w >> 9, idx = w & 511;
                stage[q] = *(const v4u*)((mat ? QT : PT) + (item0 + (grp + 1) * 8 + cc) * 4096 + idx * 8); }
        }
        if (wave < 2) {
#pragma unroll 1
            for (int cc = 0; cc < 8; ++cc) {
                const size_t item = item0 + grp * 8 + cc;
                const LAS unsigned char* Pm = L + cc * SLOT_B; const LAS unsigned char* Qm = Pm + MBUF;
                bf16_t* sp = S0 + item * 4096 + (size_t)(32 * jb + r) * 64;
#pragma unroll
                for (int ib = 0; ib < 2; ++ib)
#pragma unroll
                    for (int g = 0; g < 4; ++g) { v2u w; w.x = pk2(st[ib][4 * g], st[ib][4 * g + 1]); w.y = pk2(st[ib][4 * g + 2], st[ib][4 * g + 3]); *(v2u*)(sp + 32 * ib + 8 * g + 4 * h2) = w; }
                f32x16 nw[2];
#pragma unroll
                for (int ib = 0; ib < 2; ++ib)
#pragma unroll
                    for (int g = 0; g < 16; ++g) nw[ib][g] = __uint_as_float(((unsigned)*(const LAS unsigned short*)(Qm + (32 * ib + (g & 3) + 8 * (g >> 2) + 4 * h2) * 128 + (32 * jb + r) * 2)) << 16);
#pragma unroll
                for (int kb = 0; kb < 2; ++kb)
#pragma unroll
                    for (int s2 = 0; s2 < 2; ++s2) {
                        const bf16x8 bfr = pack_acc8(st[kb], s2);
#pragma unroll
                        for (int ib = 0; ib < 2; ++ib) {
                            const LAS unsigned char* ap = Pm + (32 * ib + r) * MROW + (32 * kb + 16 * s2 + 4 * h2) * 2;
                            const v2u lo = *(const LAS v2u*)ap, hi = *(const LAS v2u*)(ap + 16);
                            v4u av; av.x = lo.x; av.y = lo.y; av.z = hi.x; av.w = hi.y;
                            nw[ib] = __builtin_amdgcn_mfma_f32_32x32x16_bf16(__builtin_bit_cast(bf16x8, av), bfr, nw[ib], 0, 0, 0);
                        }
                    }
                st[0] = nw[0]; st[1] = nw[1];
            }
        }
    }
}
__device__ __forceinline__ void scan_r3(const bf16_t* RH, const float* YL, const bf16_t* S0, const bf16_t* RVg, const bf16_t* KDg, const bf16_t* Gg,
                                        const float* r_k, const float* lng, const float* lnb, bf16_t* Y) {
    const int tid = tidx(), lane = tid & 63, wave = tid >> 6, fr = lane & 15, fq = lane >> 4;
    const int tmw = wave & 3;
    for (int it2 = blockIdx.x * 2 + (wave >> 2); it2 < 2048; it2 += gridDim.x * 2) {
        const int b = it2 >> 10, h = (it2 >> 7) & 7, pc = it2 & 127;
        f32x4 acc[4];
#pragma unroll
        for (int q = 0; q < 4; ++q) acc[q] = (f32x4){0.f, 0.f, 0.f, 0.f};
#pragma unroll 1
        for (int dirn = 0; dirn < 2; ++dirn) {
            const size_t item = (size_t)((dirn * 2 + b) * 8 + h) * 128 + (dirn ? 127 - pc : pc);
            const int row = dirn ? 63 - (16 * tmw + fr) : 16 * tmw + fr;
            const bf16_t* rp = RH + item * 4096 + (size_t)row * 64;
            bf16x8 lf[2];
#pragma unroll
            for (int ks = 0; ks < 2; ++ks) lf[ks] = *(const bf16x8*)(rp + 32 * ks + 8 * fq);
#pragma unroll
            for (int q = 0; q < 4; ++q) {
                const bf16_t* sp = S0 + item * 4096 + (size_t)(16 * q + fr) * 64;
#pragma unroll
                for (int ks = 0; ks < 2; ++ks) { const bf16x8 rf = *(const bf16x8*)(sp + 32 * ks + 8 * fq); MMA16(acc[q], lf[ks], rf); }
                acc[q] += *(const f32x4*)(YL + item * 4096 + (size_t)row * 64 + 16 * q + 4 * fq);
            }
        }
        float sm = 0.f;
#pragma unroll
        for (int q = 0; q < 4; ++q) sm += (acc[q][0] + acc[q][1]) + (acc[q][2] + acc[q][3]);
        sm += __shfl_xor(sm, 16); sm += __shfl_xor(sm, 32);
        const float mean = sm * (1.0f / 64.f);
        float sq = 0.f;
#pragma unroll
        for (int q = 0; q < 4; ++q)
#pragma unroll
            for (int j = 0; j < 4; ++j) { const float d = acc[q][j] - mean; sq += d * d; }
        sq += __shfl_xor(sq, 16); sq += __shfl_xor(sq, 32);
        const float rstd = rsqrtf(sq * (1.0f / 64.f) + 64e-5f);
        const size_t tok = (size_t)b * S + pc * 64 + 16 * tmw + fr;
        float bon = 0.f; f32x4 vv[4];
#pragma unroll
        for (int q = 0; q < 4; ++q) {
            const int c = h * 64 + 16 * q + 4 * fq;
            const v2u rw = *(const v2u*)(RVg + tok * D + c), k0 = *(const v2u*)(KDg + tok * 512 + c), k1 = *(const v2u*)(KDg + ((size_t)T + tok) * 512 + c), vw = *(const v2u*)(RVg + tok * D + 512 + c);
            const f32x4 rk4 = *(const f32x4*)(r_k + c);
            vv[q] = (f32x4){bflo(vw.x), bfhi(vw.x), bflo(vw.y), bfhi(vw.y)};
            bon += bflo(rw.x) * (bflo(k0.x) + bflo(k1.x)) * rk4[0] + bfhi(rw.x) * (bfhi(k0.x) + bfhi(k1.x)) * rk4[1] + bflo(rw.y) * (bflo(k0.y) + bflo(k1.y)) * rk4[2] + bfhi(rw.y) * (bfhi(k0.y) + bfhi(k1.y)) * rk4[3];
        }
        bon += __shfl_xor(bon, 16); bon += __shfl_xor(bon, 32);
#pragma unroll
        for (int q = 0; q < 4; ++q) {
            const int c = h * 64 + 16 * q + 4 * fq;
            const v2u gw_ = *(const v2u*)(Gg + tok * 512 + c); const f32x4 g4 = {bflo(gw_.x), bfhi(gw_.x), bflo(gw_.y), bfhi(gw_.y)}, lg = *(const f32x4*)(lng + c), lb = *(const f32x4*)(lnb + c);
            float o[4];
#pragma unroll
            for (int j = 0; j < 4; ++j) o[j] = ((acc[q][j] - mean) * rstd * lg[j] + lb[j] + bon * vv[q][j]) * g4[j];
            v2u w; w.x = pk2(o[0], o[1]); w.y = pk2(o[2], o[3]);
            *(v2u*)(Y + tok * D + 512 + c) = w;
        }
    }
}


__device__ __forceinline__ bf16x8 pack8(float a0, float a1, float a2, float a3, float a4, float a5, float a6, float a7) {
    v4u p; p.x = pk2(a0, a1); p.y = pk2(a2, a3); p.z = pk2(a4, a5); p.w = pk2(a6, a7);
    return __builtin_bit_cast(bf16x8, p);
}
#define MMA32(acc, af, bf_) acc = __builtin_amdgcn_mfma_f32_32x32x16_bf16(af, bf_, acc, 0, 0, 0)
__device__ __forceinline__ void xattn_mfma(const bf16_t* Qb, const bf16_t* Kb, const bf16_t* Vt, bf16_t* Y, unsigned char* lds_raw) {
    LAS unsigned char* L = (LAS unsigned char*)lds_raw;
    constexpr int KRS = 528, VRS = 520;
    const int tid = tidx(), lane = tid & 63, wave = tid >> 6, r = lane & 31, h2 = lane >> 5;
    for (int it = blockIdx.x; it < 256; it += gridDim.x) {
        const int qblk = it & 31, h = (it >> 5) & 3, b = it >> 7;
        const size_t tok = (size_t)b * S + qblk * 256 + wave * 32 + r;
        bf16x8 qf[16];
#pragma unroll
        for (int ks = 0; ks < 16; ++ks) qf[ks] = *(const bf16x8*)(Qb + tok * D + h * 256 + 16 * ks + 8 * h2);
        __syncthreads();
#pragma unroll
        for (int hf = 0; hf < 2; ++hf) {
            v4u stg[8];
#pragma unroll
            for (int q = 0; q < 8; ++q) { const int p = tid + 512 * (8 * hf + q); stg[q] = *(const v4u*)(Kb + (size_t)(b * MEM + (p >> 5)) * 1024 + h * 256 + (p & 31) * 8); }
#pragma unroll
            for (int q = 0; q < 8; ++q) { const int p = tid + 512 * (8 * hf + q); *(LAS v4u*)(L + (p >> 5) * KRS + (p & 31) * 16) = stg[q]; }
        }
        __syncthreads();
        float mx = -3.0e38f;
#pragma unroll 1
        for (int kb = 0; kb < 8; ++kb) {
            f32x16 st;
#pragma unroll
            for (int g = 0; g < 16; ++g) st[g] = 0.f;
            const LAS unsigned char* kp = L + (32 * kb + r) * KRS + 16 * h2;
#pragma unroll
            for (int ks = 0; ks < 16; ++ks) { const bf16x8 kf = *(const LAS bf16x8*)(kp + 32 * ks); MMA32(st, kf, qf[ks]); }
#pragma unroll
            for (int g = 0; g < 16; ++g) mx = fmaxf(mx, st[g]);
        }
        mx = fmaxf(mx, __shfl_xor(mx, 32));
        const float cs = 0.0625f * 1.4426950408889634f;
        float l = 0.f;
        bf16x8 pf[8][2];
#pragma unroll
        for (int kb = 0; kb < 8; ++kb) {
            f32x16 st;
#pragma unroll
            for (int g = 0; g < 16; ++g) st[g] = 0.f;
            const LAS unsigned char* kp = L + (32 * kb + r) * KRS + 16 * h2;
#pragma unroll
            for (int ks = 0; ks < 16; ++ks) { const bf16x8 kf = *(const LAS bf16x8*)(kp + 32 * ks); MMA32(st, kf, qf[ks]); }
#pragma unroll
            for (int g = 0; g < 16; ++g) { st[g] = __builtin_amdgcn_exp2f((st[g] - mx) * cs); l += st[g]; }
#pragma unroll
            for (int s2 = 0; s2 < 2; ++s2) pf[kb][s2] = pack8(st[8 * s2], st[8 * s2 + 1], st[8 * s2 + 2], st[8 * s2 + 3], st[8 * s2 + 4], st[8 * s2 + 5], st[8 * s2 + 6], st[8 * s2 + 7]);
            __builtin_amdgcn_sched_barrier(0);
        }
        l += __shfl_xor(l, 32);
        const float inv = 1.0f / l;
        __syncthreads();
#pragma unroll
        for (int hf = 0; hf < 2; ++hf) {
            v4u stg[8];
#pragma unroll
            for (int q = 0; q < 8; ++q) { const int p = tid + 512 * (8 * hf + q); stg[q] = *(const v4u*)(Vt + ((size_t)(b * 1024 + h * 256 + (p >> 5))) * 256 + (p & 31) * 8); }
#pragma unroll
            for (int q = 0; q < 8; ++q) { const int p = tid + 512 * (8 * hf + q); LAS v2u* lp = (LAS v2u*)(L + (p >> 5) * VRS + (p & 31) * 16);
                v2u a_; a_.x = stg[q].x; a_.y = stg[q].y; lp[0] = a_; a_.x = stg[q].z; a_.y = stg[q].w; lp[1] = a_; }
        }
        __syncthreads();
#pragma unroll 1
        for (int db = 0; db < 8; ++db) {
            f32x16 acc;
#pragma unroll
            for (int g = 0; g < 16; ++g) acc[g] = 0.f;
            const LAS unsigned char* vp = L + (32 * db + r) * VRS + 8 * h2;
#pragma unroll
            for (int kb = 0; kb < 8; ++kb)
#pragma unroll
                for (int s2 = 0; s2 < 2; ++s2) {
                    const v2u lo = *(const LAS v2u*)(vp + (32 * kb + 16 * s2) * 2), hi = *(const LAS v2u*)(vp + (32 * kb + 16 * s2 + 8) * 2);
                    v4u av; av.x = lo.x; av.y = lo.y; av.z = hi.x; av.w = hi.y;
                    MMA32(acc, __builtin_bit_cast(bf16x8, av), pf[kb][s2]);
                }
            int tl_ = tid; asm volatile("" : "+v"(tl_));
            bf16_t* yp = Y + ((size_t)b * S + qblk * 256 + (tl_ >> 6) * 32 + (tl_ & 31)) * D + h * 256 + 32 * db + 4 * ((tl_ >> 5) & 1);
#pragma unroll
            for (int g = 0; g < 4; ++g) { v2u w; w.x = pk2(acc[4 * g] * inv, acc[4 * g + 1] * inv); w.y = pk2(acc[4 * g + 2] * inv, acc[4 * g + 3] * inv); *(v2u*)(yp + 8 * g) = w; }
        }
    }
}
template <bool F32OUT>
__device__ __forceinline__ void combine_norm(float* X, const bf16_t* YE, const int* SLOT, const float* g, bf16_t* Hout, float* Fout) {
    const int tix_ = tidx(); const int lane = tix_ & 63, gw = blockIdx.x * 8 + (tix_ >> 6), ngw = gridDim.x * 8;
    for (int m = gw; m < T; m += ngw) {
        float4* xr = (float4*)(X + (size_t)m * D);
        float4 v[4];
#pragma unroll
        for (int j = 0; j < 4; ++j) v[j] = xr[lane + 64 * j];
        const int myslot = SLOT[(size_t)m * NE + (lane & 15)];
#pragma unroll
        for (int e = 0; e < 16; ++e) {
            const int row = __builtin_amdgcn_readlane(myslot, e);
            if (row >= 0) {
                const v2u* yp = (const v2u*)(YE + (size_t)row * D);
#pragma unroll
                for (int j = 0; j < 4; ++j) { const v2u w = yp[lane + 64 * j];
                    v[j].x += __uint_as_float(w.x << 16); v[j].y += __uint_as_float(w.x & 0xffff0000u); v[j].z += __uint_as_float(w.y << 16); v[j].w += __uint_as_float(w.y & 0xffff0000u); }
            }
        }
        float s = 0.f;
#pragma unroll
        for (int j = 0; j < 4; ++j) { if (!F32OUT) xr[lane + 64 * j] = v[j]; s += v[j].x * v[j].x + v[j].y * v[j].y + v[j].z * v[j].z + v[j].w * v[j].w; }
        const float r = rsqrtf(wave_sum(s) * (1.0f / D) + 1e-6f);
#pragma unroll
        for (int j = 0; j < 4; ++j) { const float4 gg = ((const float4*)g)[lane + 64 * j];
            if (F32OUT) ((float4*)(Fout + (size_t)m * D))[lane + 64 * j] = make_float4(v[j].x * r * gg.x, v[j].y * r * gg.y, v[j].z * r * gg.z, v[j].w * r * gg.w);
            else { v2u w; w.x = pk2(v[j].x * r * gg.x, v[j].y * r * gg.y); w.y = pk2(v[j].z * r * gg.z, v[j].w * r * gg.w); ((v2u*)(Hout + (size_t)m * D))[lane + 64 * j] = w; } }
    }
}


template <int NK, bool SINK>
__device__ __forceinline__ void attn_block(const bf16_t* Qh, const bf16_t* Kh, const bf16_t* Vh, int dd, int Lr, int b, int rho, int q0b, float sink2,
                                           bf16_t* Odst, int ostride, float* lsedst, unsigned char* lds_raw) {
    constexpr int NKEY = 256 + 64 * NK, KRS = 144, VRS = NKEY * 2 + 8;
    LAS unsigned char* Ks = (LAS unsigned char*)lds_raw; LAS unsigned char* Vs = Ks + NKEY * KRS;
    const int tid = tidx(), lane = tid & 63, wave = tid >> 6, r = lane & 31, h2 = lane >> 5;
    const int kq_base = q0b - 32 * NK;
    __syncthreads();
#pragma unroll
    for (int i = 0; i < NKEY * 8 / 512; ++i) {
        const int p = tid + 512 * i, row = p >> 3, piece = p & 7, kq = kq_base + row;
        if (kq >= 0 && kq < Lr) {
            const size_t tokk = (size_t)b * S + (size_t)kq * dd + rho;
            const v4u kx = *(const v4u*)(Kh + tokk * 64 + piece * 8), vx = *(const v4u*)(Vh + tokk * 64 + piece * 8);
            *(LAS v4u*)(Ks + row * KRS + piece * 16) = kx;
            LAS unsigned char* vp = Vs + (piece * 8) * VRS + row * 2;
#pragma unroll
            for (int e = 0; e < 4; ++e) { *(LAS unsigned short*)(vp + (2 * e) * VRS) = (unsigned short)(vx[e] & 0xffffu); *(LAS unsigned short*)(vp + (2 * e + 1) * VRS) = (unsigned short)(vx[e] >> 16); }
        }
    }
    const int q0 = q0b + 32 * wave;
    const size_t qtok = (size_t)b * S + (size_t)(q0 + r) * dd + rho;
    bf16x8 qf[4];
#pragma unroll
    for (int ks = 0; ks < 4; ++ks) qf[ks] = *(const bf16x8*)(Qh + qtok * 64 + 16 * ks + 8 * h2);
    __syncthreads();
    f32x16 o[2];
#pragma unroll
    for (int db = 0; db < 2; ++db)
#pragma unroll
        for (int g = 0; g < 16; ++g) o[db][g] = 0.f;
    float m = SINK ? sink2 : -1.0e30f, l = SINK ? 1.f : 0.f;
    const int kb_lo = max(-NK, -(q0 >> 5)), kb_hi = min(NK, (Lr - 32 - q0) >> 5);
#pragma unroll 1
    for (int kb = kb_lo; kb <= kb_hi; ++kb) {
        const int kw0 = 32 * (wave + kb + NK);
        f32x16 st;
#pragma unroll
        for (int g = 0; g < 16; ++g) st[g] = 0.f;
        const LAS unsigned char* kp = Ks + (kw0 + r) * KRS + 16 * h2;
#pragma unroll
        for (int ks = 0; ks < 4; ++ks) { const bf16x8 kf = *(const LAS bf16x8*)(kp + 32 * ks); MMA32(st, kf, qf[ks]); }
        if (kb == -NK || kb == NK) {
#pragma unroll
            for (int g = 0; g < 16; ++g) { const int cr = (g & 3) + 8 * (g >> 2) + 4 * h2; const bool ok = (kb < 0) ? (cr >= r) : (cr <= r); st[g] = ok ? st[g] : -1.0e30f; }
        }
        float bm = st[0];
#pragma unroll
        for (int g = 1; g < 16; ++g) bm = fmaxf(bm, st[g]);
        bm = fmaxf(bm, __shfl_xor(bm, 32));
        const float mn = fmaxf(m, bm), al = __builtin_amdgcn_exp2f(m - mn);
        float ls = 0.f;
#pragma unroll
        for (int g = 0; g < 16; ++g) { st[g] = __builtin_amdgcn_exp2f(st[g] - mn); ls += st[g]; }
        ls += __shfl_xor(ls, 32);
        l = l * al + ls; m = mn;
#pragma unroll
        for (int db = 0; db < 2; ++db)
#pragma unroll
            for (int g = 0; g < 16; ++g) o[db][g] *= al;
        bf16x8 pf[2];
#pragma unroll
        for (int s2 = 0; s2 < 2; ++s2) pf[s2] = pack8(st[8 * s2], st[8 * s2 + 1], st[8 * s2 + 2], st[8 * s2 + 3], st[8 * s2 + 4], st[8 * s2 + 5], st[8 * s2 + 6], st[8 * s2 + 7]);
#pragma unroll
        for (int db = 0; db < 2; ++db) {
            const LAS unsigned char* vp = Vs + (32 * db + r) * VRS + (kw0 + 4 * h2) * 2;
#pragma unroll
            for (int s2 = 0; s2 < 2; ++s2) {
                const v2u lo = *(const LAS v2u*)(vp + 32 * s2), hi = *(const LAS v2u*)(vp + 32 * s2 + 16);
                v4u av; av.x = lo.x; av.y = lo.y; av.z = hi.x; av.w = hi.y;
                MMA32(o[db], __builtin_bit_cast(bf16x8, av), pf[s2]);
            }
        }
    }
    const float inv = 1.0f / l;
#pragma unroll
    for (int db = 0; db < 2; ++db) {
        bf16_t* op = Odst + qtok * ostride + 32 * db + 4 * h2;
#pragma unroll
        for (int g = 0; g < 4; ++g) { v2u w; w.x = pk2(o[db][4 * g] * inv, o[db][4 * g + 1] * inv); w.y = pk2(o[db][4 * g + 2] * inv, o[db][4 * g + 3] * inv); *(v2u*)(op + 8 * g) = w; }
    }
    if (lsedst != nullptr && h2 == 0) lsedst[qtok * 8] = (m + __builtin_amdgcn_logf(l)) * 0.6931471805599453f;
}

__device__ __forceinline__ void attn_phase_even(const bf16_t* QhA, const bf16_t* KhA, const bf16_t* VhA, const bf16_t* QhB, const bf16_t* KhB, const bf16_t* VhB,
                                                const float* sink, bf16_t* OA, float* LSE, bf16_t* Y, unsigned char* lds_raw) {
    for (int it = blockIdx.x; it < 2048; it += gridDim.x) {
        if (it < 512) {
            const int hq = it >> 6, rem2 = it & 63, b = rem2 >> 5, q0b = (rem2 & 31) * 256, kvh = hq >> 2;
            attn_block<4, true>(QhB + (size_t)hq * T * 64, KhB + (size_t)kvh * T * 64, VhB + (size_t)kvh * T * 64, 1, S, b, 0, q0b, sink[hq] * 1.4426950408889634f,
                                Y + 512 + hq * 64, D, nullptr, lds_raw);
        } else {
            const int ita = it - 512, p = ita >> 9, rem = ita & 511, head = rem >> 6, rem2 = rem & 63, b = rem2 >> 5, rem3 = rem2 & 31;
            const int dd = p == 0 ? 1 : (p == 1 ? 4 : 16), bpr = 32 / dd, rho = rem3 / bpr, q0b = (rem3 % bpr) * 256;
            attn_block<2, false>(QhA + (size_t)head * T * 64, KhA + (size_t)head * T * 64, VhA + (size_t)head * T * 64, dd, S / dd, b, rho, q0b, 0.f,
                                 OA + (size_t)p * T * 512 + head * 64, 512, LSE + (size_t)p * T * 8 + head, lds_raw);
        }
    }
}
__device__ __forceinline__ void attn_combine(const bf16_t* OA, const float* LSE, bf16_t* Y) {
    const int gt = blockIdx.x * NTH + tidx(), ngt = gridDim.x * NTH;
    for (int i = gt; i < T * 64; i += ngt) {
        const int tok = i >> 6, head = (i >> 3) & 7, c8 = i & 7;
        const float l0 = LSE[(size_t)tok * 8 + head], l1 = LSE[((size_t)T + tok) * 8 + head], l2 = LSE[((size_t)2 * T + tok) * 8 + head];
        const float mx = fmaxf(l0, fmaxf(l1, l2));
        float w0 = __expf(l0 - mx), w1 = __expf(l1 - mx), w2 = __expf(l2 - mx);
        const float inv = 1.0f / (w0 + w1 + w2); w0 *= inv; w1 *= inv; w2 *= inv;
        const size_t off = (size_t)tok * 512 + head * 64 + c8 * 8;
        const v4u x0 = *(const v4u*)(OA + off), x1 = *(const v4u*)(OA + (size_t)T * 512 + off), x2 = *(const v4u*)(OA + (size_t)2 * T * 512 + off);
        v4u w;
#pragma unroll
        for (int q = 0; q < 4; ++q) {
            const float lo = w0 * __uint_as_float(x0[q] << 16) + w1 * __uint_as_float(x1[q] << 16) + w2 * __uint_as_float(x2[q] << 16);
            const float hi = w0 * __uint_as_float(x0[q] & 0xffff0000u) + w1 * __uint_as_float(x1[q] & 0xffff0000u) + w2 * __uint_as_float(x2[q] & 0xffff0000u);
            w[q] = pk2(lo, hi);
        }
        *(v4u*)(Y + (size_t)tok * D + head * 64 + c8 * 8) = w;
    }
}


__device__ __forceinline__ void odd_token_pass(const bf16_t* P, const float* mu, const float* k_k, const float* clg, const float* clb,
                                               bf16_t* VN, bf16_t* RV, bf16_t* KBf, bf16_t* KK, bf16_t* F5) {
    const int tix_ = tidx(); const int lane = tix_ & 63, gw = blockIdx.x * 8 + (tix_ >> 6), ngw = gridDim.x * 8;
    for (int tok = gw; tok < T; tok += ngw) {
        const int s = tok & (S - 1);
        const bf16_t* pr = P + (size_t)tok * ODD_PAD;
        {
            float ge[8]; float sm = 0.f;
#pragma unroll
            for (int jj = 0; jj < 4; ++jj) { const unsigned w = *(const unsigned*)(pr + 512 + 2 * lane + 128 * jj);
                ge[2 * jj] = gelu_tanh(__uint_as_float(w << 16)); ge[2 * jj + 1] = gelu_tanh(__uint_as_float(w & 0xffff0000u)); sm += ge[2 * jj] + ge[2 * jj + 1]; }
            const float mean = wave_sum(sm) * (1.0f / 512.f); float sq = 0.f;
#pragma unroll
            for (int j = 0; j < 8; ++j) { const float d = ge[j] - mean; sq += d * d; }
            const float rstd = rsqrtf(wave_sum(sq) * (1.0f / 512.f) + 1e-5f);
#pragma unroll
            for (int jj = 0; jj < 4; ++jj) { const int c = 2 * lane + 128 * jj; const float2 g2_ = *(const float2*)(clg + c), b2_ = *(const float2*)(clb + c);
                *(unsigned*)(VN + (size_t)tok * 512 + c) = pk2((ge[2 * jj] - mean) * rstd * g2_.x + b2_.x, (ge[2 * jj + 1] - mean) * rstd * g2_.y + b2_.y); }
        }
#pragma unroll 5
        for (int jj = 0; jj < 15; ++jj) {
            const int c = 2 * lane + 128 * jj;
            const unsigned wf = *(const unsigned*)(pr + 1024 + c);
            const unsigned wp = s > 0 ? *(const unsigned*)(pr + 1024 + c - ODD_PAD) : 0u;
            const unsigned wn = s < S - 1 ? *(const unsigned*)(pr + 1024 + c + ODD_PAD) : 0u;
            const float2 m0 = *(const float2*)(mu + c), m1 = *(const float2*)(mu + FD + c);
            const float f0 = __uint_as_float(wf << 16), f1 = __uint_as_float(wf & 0xffff0000u);
            const float x0 = f0 + m0.x * (__uint_as_float(wp << 16) - f0) + m1.x * (__uint_as_float(wn << 16) - f0);
            const float x1 = f1 + m0.y * (__uint_as_float(wp & 0xffff0000u) - f1) + m1.y * (__uint_as_float(wn & 0xffff0000u) - f1);
            if (jj < 4) *(unsigned*)(RV + (size_t)tok * D + c) = pk2(x0, x1);
            else if (jj < 8) {
                const int ck = c - 512;
                *(unsigned*)(KBf + (size_t)tok * 512 + ck) = pk2(x0, x1);
                const float2 kk_ = *(const float2*)(k_k + ck);
                const float a0_ = x0 * kk_.x, a1_ = x1 * kk_.y;
                float ss = a0_ * a0_ + a1_ * a1_;
#pragma unroll
                for (int o = 16; o >= 1; o >>= 1) ss += __shfl_xor(ss, o);
                const float inv = 1.0f / fmaxf(sqrtf(ss), 1e-12f);
                *(unsigned*)(KK + (size_t)tok * 512 + ck) = pk2(a0_ * inv, a1_ * inv);
            }
            else if (jj < 12) *(unsigned*)(RV + (size_t)tok * D + 512 + (c - 1024)) = pk2(x0, x1);
            else if (jj == 12) *(unsigned*)(F5 + (size_t)tok * 384 + (c - 1536)) = pk2(tanhf(x0), tanhf(x1));
            else if (jj == 13) *(unsigned*)(F5 + (size_t)tok * 384 + 128 + (c - 1664)) = pk2(x0, x1);
            else *(unsigned*)(F5 + (size_t)tok * 384 + 256 + (c - 1792)) = pk2(sigmoidf_(x0), sigmoidf_(x1));
        }
    }
}
__device__ __forceinline__ void gating_pass(const bf16_t* VN, const bf16_t* Wsb, const float* bsp, const bf16_t* P, bf16_t* Y, unsigned char* lds_raw) {
    LAS unsigned char* L = (LAS unsigned char*)lds_raw;
    constexpr int RS = 272;
    const int tid = tidx(), lane = tid & 63, wave = tid >> 6, fr = lane & 15, fq = lane >> 4;
    for (int it = blockIdx.x; it < 512; it += gridDim.x) {
        const int g = it & 3, chunk = it >> 2;
        __syncthreads();
        { const int j = tid >> 2, q4 = tid & 3;
          const v4u* gp = (const v4u*)(VN + (size_t)(chunk * 128 + j) * 512 + g * 128 + 32 * q4);
#pragma unroll
          for (int q = 0; q < 4; ++q) { const v4u x = gp[q];
#pragma unroll
              for (int e = 0; e < 4; ++e) { const int c = 32 * q4 + 8 * q + 2 * e;
                  *(LAS unsigned short*)(L + c * RS + 2 * j) = (unsigned short)(x[e] & 0xffffu); *(LAS unsigned short*)(L + (c + 1) * RS + 2 * j) = (unsigned short)(x[e] >> 16); } } }
        __syncthreads();
        bf16x8 lf[4];
#pragma unroll
        for (int ks = 0; ks < 4; ++ks) lf[ks] = *(const bf16x8*)(Wsb + (size_t)(g * 128 + 16 * wave + fr) * 128 + 32 * ks + 8 * fq);
        const int i = 16 * wave + fr; const size_t tok = (size_t)chunk * 128 + i;
        const float bias = bsp[g * 128 + i];
#pragma unroll
        for (int tn = 0; tn < 8; ++tn) {
            f32x4 acc = {0.f, 0.f, 0.f, 0.f};
#pragma unroll
            for (int ks = 0; ks < 4; ++ks) { const bf16x8 rf = *(const LAS bf16x8*)(L + (16 * tn + fr) * RS + (32 * ks + 8 * fq) * 2); MMA16(acc, lf[ks], rf); }
            const int c = g * 128 + 16 * tn + 4 * fq;
            const v2u uw = *(const v2u*)(P + tok * ODD_PAD + c);
            const float u0 = gelu_tanh(__uint_as_float(uw.x << 16)), u1 = gelu_tanh(__uint_as_float(uw.x & 0xffff0000u)), u2 = gelu_tanh(__uint_as_float(uw.y << 16)), u3 = gelu_tanh(__uint_as_float(uw.y & 0xffff0000u));
            v2u w; w.x = pk2(u0 * (acc[0] + bias), u1 * (acc[1] + bias)); w.y = pk2(u2 * (acc[2] + bias), u3 * (acc[3] + bias));
            *(v2u*)(Y + tok * D + c) = w;
        }
    }
}


__device__ __forceinline__ void router_pass(const float* X, const float* g, const float* WRT  , float* AFF, int* SLOT, bf16_t* H) {
    const int tix_ = tidx(); const int lane = tix_ & 63, fr = lane & 15, fq = lane >> 4;
    const int gw = blockIdx.x * 8 + (tix_ >> 6), ngw = gridDim.x * 8;
    for (int tile = gw; tile < T / 16; tile += ngw) {
        const float* xr = X + (size_t)(tile * 16 + fr) * D + 4 * fq;
        const float* wr = WRT + (size_t)fr * D + 4 * fq;
        f32x4 acc = {0.f, 0.f, 0.f, 0.f}; float ss = 0.f;
#pragma unroll 8
        for (int s = 0; s < 64; ++s) {
            const f32x4 xa = *(const f32x4*)(xr + 16 * s), wb = *(const f32x4*)(wr + 16 * s);
            ss += (xa[0] * xa[0] + xa[1] * xa[1]) + (xa[2] * xa[2] + xa[3] * xa[3]);
#pragma unroll
            for (int c = 0; c < 4; ++c) acc = __builtin_amdgcn_mfma_f32_16x16x4f32(xa[c], wb[c], acc, 0, 0, 0);
        }
        ss += __shfl_xor(ss, 16); ss += __shfl_xor(ss, 32);
        const float rstd = rsqrtf(ss * (1.0f / D) + 1e-6f);
        float aff[4];
#pragma unroll
        for (int jj = 0; jj < 4; ++jj) {
            const float lg = acc[jj] * __shfl(rstd, 4 * fq + jj);
            float mx = lg;
#pragma unroll
            for (int o = 1; o < 16; o <<= 1) mx = fmaxf(mx, __shfl_xor(mx, o));
            const float e = expf(lg - mx); float den = e;
#pragma unroll
            for (int o = 1; o < 16; o <<= 1) den += __shfl_xor(den, o);
            aff[jj] = e / den;
        }
#pragma unroll
        for (int jj = 0; jj < 4; ++jj) { const size_t o = (size_t)(tile * 16 + 4 * fq + jj) * NE + fr; AFF[o] = aff[jj]; SLOT[o] = -1; }
#pragma unroll 4
        for (int t = 0; t < 16; ++t) {
            const float rs = __shfl(rstd, t);
            const f32x4* xp = (const f32x4*)(X + (size_t)(tile * 16 + t) * D); v2u* hp = (v2u*)(H + (size_t)(tile * 16 + t) * D);
#pragma unroll
            for (int j = 0; j < 4; ++j) { const f32x4 v = xp[lane + 64 * j], gg = ((const f32x4*)g)[lane + 64 * j];
                v2u w; w.x = pk2(v[0] * rs * gg[0], v[1] * rs * gg[1]); w.y = pk2(v[2] * rs * gg[2], v[3] * rs * gg[3]); hp[lane + 64 * j] = w; }
        }
    }
}

#define IN(k) (lo <= (k) && (k) < hi)
#define REP_LOOP for (int rep_ = 0, nrep_ = ((ph == PROBE_PHASE) ? PROBE_REP : 1); rep_ < nrep_; ++rep_)
#define SEAM(k) do { if (IN(k) && IN((k) + 1)) xcd_barrier(bar); } while (0)
#define PROLOG \
    const int tid = tidx(), lane = tid & 63, wave = tid >> 6; \
    const int bid = blockIdx.x, nb = gridDim.x; \
    const int gw = bid * 8 + wave, ngw = nb * 8; \
    const int gt = bid * NTH + tid, ngt = nb * NTH; \
    (void)gt; (void)ngt; (void)gw; (void)ngw; (void)lane; (void)wave; \
    unsigned char* ws = a.ws; \
    const int lo = a.lo, hi = a.hi; \
    float* ldsf = (float*)lds_raw; (void)ldsf; \
    PG8_LAS unsigned char* ldsp = (PG8_LAS unsigned char*)lds_raw; (void)ldsp; \
    const float* x_in = a.in[0]; const float* mem = a.in[1]; (void)x_in; (void)mem; \
    float* ropec = (float*)(ws + WS_ROPE); float* ropes = ropec + S * 32; (void)ropec; (void)ropes; \
    float* AFF = (float*)(ws + WS_AFF); int* TOK = (int*)(ws + WS_TOK); float* GATE = (float*)(ws + WS_GATE); \
    float* X = (float*)(ws + WS_X); bf16_t* H = (bf16_t*)(ws + WS_H); bf16_t* P = (bf16_t*)(ws + WS_P); \
    bf16_t* Y = (bf16_t*)(ws + WS_Y); bf16_t* Q = (bf16_t*)(ws + WS_Q); bf16_t* KV = (bf16_t*)(ws + WS_KV); bf16_t* MN = (bf16_t*)(ws + WS_MN); \
    bf16_t* DEC = (bf16_t*)(ws + WS_DEC); bf16_t* KD = (bf16_t*)(ws + WS_KD); bf16_t* BB = (bf16_t*)(ws + WS_BB); \
    bf16_t* KK = (bf16_t*)(ws + WS_KK); bf16_t* G = (bf16_t*)(ws + WS_G); float* YS = (float*)(ws + WS_YS); \
    bf16_t* RV = (bf16_t*)(ws + WS_RV); bf16_t* VN = (bf16_t*)(ws + WS_VN); \
    bf16_t* XE = (bf16_t*)(ws + WS_XE); bf16_t* HID = (bf16_t*)(ws + WS_HID); int* SLOT = (int*)(ws + WS_SLOT); bf16_t* YE = (bf16_t*)(ws + WS_YE); (void)SLOT; (void)YE; \
    (void)AFF; (void)TOK; (void)GATE; (void)X; (void)H; (void)P; (void)Y; (void)Q; (void)KV; (void)MN; (void)DEC; (void)KD; (void)BB; (void)KK; (void)G; (void)YS; (void)RV; (void)VN; (void)XE; (void)HID;

template <class Epi>
__device__ __forceinline__ void dense_gemm(PG8_LAS unsigned char* ldsp, const bf16_t* A, const bf16_t* Bt, int M, int N, int K, const Epi& E, int cshift = 0) {
    asm volatile("" : "+s"(K));
    pg8::Gemm g{A, Bt, M, N, K}; pg8::StaticOrder So; So.init(M, N, (int)gridDim.x, (int)((blockIdx.x + cshift) % gridDim.x));
    pg8::gemm_phase<Epi, pg8::StaticOrder, false>(ldsp, g, So, E, nullptr);
}

__device__ __forceinline__ int odd_phases(const Args& a, const XcdBarrier& bar, unsigned char* lds_raw, int ph) {
    PROLOG
    if (IN(ph)) combine_norm<false>(X, YE, SLOT, a.in[6], H, nullptr);
    SEAM(ph); ++ph;
    if (IN(ph)) dense_gemm(ldsp, H, (const bf16_t*)(ws + WS_WOIN), T, ODD_PAD, D, EpiBf16Store{P, ODD_PAD, 1.0f});
    SEAM(ph); ++ph;
    if (IN(ph)) REP_LOOP odd_token_pass(P, a.in[12], a.in[18], a.in[8], a.in[9], VN, RV, (bf16_t*)(ws + WS_KB), KK, (bf16_t*)(ws + WS_F5));
    SEAM(ph); ++ph;
    if (IN(ph)) REP_LOOP {
        gating_pass(VN, (const bf16_t*)(ws + WS_WSB), a.in[11], P, Y, lds_raw);
        __syncthreads();
        dense_gemm(ldsp, (const bf16_t*)(ws + WS_F5), (const bf16_t*)(ws + WS_WL), T, 2560, 384,
                   EpiLora{a.in[13], a.in[15], a.in[19], (const bf16_t*)(ws + WS_KB), KK, DEC, KD, BB, G});
    }
    SEAM(ph); ++ph;
    if (IN(ph)) REP_LOOP scan_r1(DEC, RV, KD, KK, BB, (bf16_t*)(ws + WS_PT), (bf16_t*)(ws + WS_QT), (bf16_t*)(ws + WS_RH), (float*)(ws + WS_YL), lds_raw);
    SEAM(ph); ++ph;
    if (IN(ph)) REP_LOOP {
        if (bid < 32) scan_r2((const bf16_t*)(ws + WS_PT), (const bf16_t*)(ws + WS_QT), (bf16_t*)(ws + WS_S0), lds_raw);
        else {
            LAS float* scr = (LAS float*)((LAS unsigned char*)lds_raw + wave * 16896);
            const int gw2 = (bid - 32) * 8 + wave, ngw2 = (nb - 32) * 8;
            auto gmap = [](int n) { return (n >> 7) * 256 + (n & 127); };
            auto umap = [](int n) { return (n >> 7) * 256 + 128 + (n & 127); };
            for (int it = gw2; it < 16 * 704; it += ngw2) { const int e = it / 704, r = it % 704;
                transpose_item_fp8(a.in[31] + (size_t)(16 + e) * D * DE, D, DE, ws + WS_WGU8 + 176 * MiB + (size_t)e * 5632 * D, gmap, GUSC8, scr, r, lane); }
            for (int it = gw2; it < 16 * 704; it += ngw2) { const int e = it / 704, r = it % 704;
                transpose_item_fp8(a.in[32] + (size_t)(16 + e) * D * DE, D, DE, ws + WS_WGU8 + 176 * MiB + (size_t)e * 5632 * D, umap, GUSC8, scr, r, lane); }
        }
    }
    SEAM(ph); ++ph;
    if (IN(ph)) REP_LOOP scan_r3((const bf16_t*)(ws + WS_RH), (const float*)(ws + WS_YL), (const bf16_t*)(ws + WS_S0), RV, KD, G, a.in[20], a.in[21], a.in[22], Y);
    SEAM(ph); ++ph;
    if (IN(ph)) dense_gemm(ldsp, Y, (const bf16_t*)(ws + WS_WOOUT), T, D, D, EpiResidN{X, X, H, (float*)(ws + WS_SSP)});
    SEAM(ph); ++ph;
    return ph;
}

template <int layer>
__device__ __forceinline__ int tail_phases(const Args& a, const XcdBarrier& bar, unsigned char* lds_raw, int ph) {
    PROLOG
    if (IN(ph)) {
        dense_gemm(ldsp, H, (const bf16_t*)(ws + WS_WQ) + (size_t)layer * D * D, T, D, D, EpiBf16StoreRS{Q, D, (const float*)(ws + WS_SSP)});
    }
    SEAM(ph); ++ph;
    if (IN(ph)) REP_LOOP xattn_mfma(Q, KV + (size_t)layer * 1024 * 1024, KV + (size_t)layer * 1024 * 1024 + 512 * 1024, Y, lds_raw);
    SEAM(ph); ++ph;
    if (IN(ph)) dense_gemm(ldsp, Y, (const bf16_t*)(ws + WS_WO) + (size_t)layer * D * D, T, D, D, EpiResid{X, X});
    SEAM(ph); ++ph;
    if (IN(ph)) REP_LOOP router_pass(X, a.in[29] + layer * D, (const float*)(ws + WS_WRT) + (size_t)layer * NE * D, AFF, SLOT, H);
    SEAM(ph); ++ph;
    if (IN(ph)) REP_LOOP {
        unsigned* keys = (unsigned*)ldsf;
        int* hist = (int*)(ldsf + 8192);
        int* sh = hist + 256;
        if (bid >= 32) {
            LAS float* scr = (LAS float*)((LAS unsigned char*)lds_raw + wave * 16896);
            const int gw2 = (bid - 32) * 8 + wave, ngw2 = (nb - 32) * 8;
            auto ident = [](int n) { return n; };
            for (int it = gw2; it < 16 * 704; it += ngw2) { const int mt = layer * 16 + it / 704, r = it % 704;
                if constexpr (layer == 1 || F8L0) transpose_item_fp8(a.in[33] + (size_t)mt * DE * D, DE, D, ws + WS_WD8 + (size_t)layer * 88 * MiB + (size_t)(mt - 16 * layer) * D * DE, ident, DSC8, scr, r, lane);
                else transpose_item(a.in[33] + (size_t)mt * DE * D, DE, D, (bf16_t*)(ws + WS_WD) + (size_t)mt * D * DE, ident, scr, r, lane); }
        }
        for (int be = bid; be < NB * NE && be < 32; be += nb) {
            const int b = be >> 4, e = be & 15, eb = e * 2 + b;
            __syncthreads();
            for (int s = tid; s < S; s += NTH) keys[s] = __float_as_uint(AFF[(size_t)(b * S + s) * NE + e]);
            unsigned prefix = 0u; int krem = CAP;
            for (int pass = 3; pass >= 0; --pass) {
                __syncthreads();
                if (tid < 256) hist[tid] = 0;
                __syncthreads();
                const unsigned hmask = pass == 3 ? 0u : (0xFFFFFFFFu << (8 * (pass + 1)));
                for (int s = tid; s < S; s += NTH) { const unsigned k = keys[s]; if ((k & hmask) == prefix) atomicAdd(&hist[(k >> (8 * pass)) & 255u], 1); }
                __syncthreads();
                if (tid == 0) {
                    int cum = 0, bsel = 0;
                    for (int bb = 255; bb >= 0; --bb) { const int c = hist[bb]; if (cum + c >= krem) { bsel = bb; break; } cum += c; }
                    sh[8] = bsel; sh[9] = krem - cum;
                }
                __syncthreads();
                prefix |= ((unsigned)sh[8]) << (8 * pass); krem = sh[9];
            }
            const unsigned thr = prefix;
            int ce = 0;
            for (int i = 0; i < 16; ++i) { const unsigned k = keys[tid * 16 + i]; ce += (k == thr); }
            int tot;
            const int eqbase = block_exscan(ce, sh, &tot);
            int eqr = eqbase, cs = 0;
            for (int i = 0; i < 16; ++i) { const unsigned k = keys[tid * 16 + i]; const bool sel = (k > thr) || (k == thr && eqr < krem); eqr += (k == thr); cs += sel; }
            const int sbase = block_exscan(cs, sh, &tot);
            int slot = sbase; eqr = eqbase;
            for (int i = 0; i < 16; ++i) {
                const int s = tid * 16 + i; const unsigned k = keys[s];
                const bool sel = (k > thr) || (k == thr && eqr < krem); eqr += (k == thr);
                if (sel) { TOK[eb * CAP + slot] = b * S + s; GATE[eb * CAP + slot] = __uint_as_float(k); SLOT[(size_t)(b * S + s) * NE + e] = eb * CAP + slot; ++slot; }
            }
        }
    }
    SEAM(ph); ++ph;
    if (IN(ph)) REP_LOOP {
        for (int r = gw; r < NB * NE * CAP; r += ngw) {
            int rv_ = r; asm volatile("" : "+v"(rv_));
            if constexpr (layer == 1 || F8L0) {
                const v4u* srcp = (const v4u*)(H + (size_t)TOK[rv_] * D) + 2 * lane; const v4u x0 = srcp[0], x1 = srcp[1];
                v4u o;
                o.x = pk4_fp8(bflo(x0.x) * ASC8, bfhi(x0.x) * ASC8, bflo(x0.y) * ASC8, bfhi(x0.y) * ASC8); o.y = pk4_fp8(bflo(x0.z) * ASC8, bfhi(x0.z) * ASC8, bflo(x0.w) * ASC8, bfhi(x0.w) * ASC8);
                o.z = pk4_fp8(bflo(x1.x) * ASC8, bfhi(x1.x) * ASC8, bflo(x1.y) * ASC8, bfhi(x1.y) * ASC8); o.w = pk4_fp8(bflo(x1.z) * ASC8, bfhi(x1.z) * ASC8, bflo(x1.w) * ASC8, bfhi(x1.w) * ASC8);
                ((v4u*)((unsigned char*)XE + (size_t)r * D))[lane] = o;
            } else {
                const v4u* srcp = (const v4u*)(H + (size_t)TOK[rv_] * D); v4u* dst = (v4u*)(XE + (size_t)r * D);
                dst[lane] = srcp[lane]; dst[lane + 64] = srcp[lane + 64];
            }
        }
    }
    SEAM(ph); ++ph;
    if (IN(ph)) {
        MoeOrder So{(int)gridDim.x, (int)blockIdx.x, 16 * 22, 22};
        if constexpr (layer == 1 || F8L0) {
            int Kg = D / 2; asm volatile("" : "+s"(Kg));
            pg8::Gemm g{XE, (const bf16_t*)(ws + WS_WGU8 + (size_t)layer * 176 * MiB), NB * NE * CAP, NE * 5632, Kg};
            pg8::gemm_phase<EpiSiluMul8, MoeOrder, false, true>(ldsp, g, So, EpiSiluMul8{(unsigned char*)HID}, nullptr);
        } else {
            pg8::Gemm g{XE, (const bf16_t*)(ws + WS_WGU) + (size_t)layer * NE * 5632 * D, NB * NE * CAP, NE * 5632, D};
            pg8::gemm_phase<EpiSiluMul, MoeOrder, false>(ldsp, g, So, EpiSiluMul{HID}, nullptr);
        }
    }
    SEAM(ph); ++ph;
    if (IN(ph)) {
        MoeOrder So{(int)gridDim.x, (int)blockIdx.x, 16 * 4, 4};
        if constexpr (layer == 1 || F8L0) {
            int Kg = DE / 2; asm volatile("" : "+s"(Kg));
            pg8::Gemm g{HID, (const bf16_t*)(ws + WS_WD8 + (size_t)layer * 88 * MiB), NB * NE * CAP, NE * D, Kg};
            pg8::gemm_phase<EpiYE8, MoeOrder, false, true>(ldsp, g, So, EpiYE8{GATE, YE}, nullptr);
        } else {
            pg8::Gemm g{HID, (const bf16_t*)(ws + WS_WD) + (size_t)layer * NE * D * DE, NB * NE * CAP, NE * D, DE};
            pg8::gemm_phase<EpiYE, MoeOrder, false>(ldsp, g, So, EpiYE{GATE, YE}, nullptr);
        }
    }
    SEAM(ph); ++ph;
    return ph;
}

__global__ void __launch_bounds__(NTH, 2) mega(Args a) {
    extern __shared__ __attribute__((aligned(16))) unsigned char lds_raw[];
    unsigned* ctl = (unsigned*)(a.ws + WS_CTL);
    volatile LAS unsigned* bst = (volatile LAS unsigned*)((LAS unsigned char*)lds_raw + LDS_BAR_OFF);
    { const int t0_ = tidx(); if (t0_ < 4) bst[t0_] = 0u; }
    __syncthreads();
    XcdBarrier bar; bar.bar = ctl + CW_BAR; bar.x = 0; bar.st = bst;
    if (a.hi - a.lo > 1) bar = xcd_barrier_post(ctl + CW_BAR, bst);
    PROLOG

    int ph = 0;
    if (IN(ph)) REP_LOOP {
        for (int i = gt; i < S * 32; i += ngt) {
            const int s = i >> 5, f = i & 31;
            const float pw = (float)exp((double)((float)(2 * f) / 64.0f) * 9.210340371976184);
            const float invf = 1.0f / pw;
            const float angf = (float)s * invf;
            double xx = (double)angf;
            const double n = rint(xx * 0.15915494309189535);
            xx = (xx - n * 6.283185307179586) - n * 2.4492935982947064e-16;
            const double x2 = xx * xx;
            double cs = 1.0, sn = xx, tc = 1.0, tsn = xx;
#pragma unroll 1
            for (int k = 1; k <= 16; ++k) { tc *= -x2 / (double)((2 * k - 1) * (2 * k)); tsn *= -x2 / (double)((2 * k) * (2 * k + 1)); cs += tc; sn += tsn; }
            ropec[i] = (float)cs; ropes[i] = (float)sn;
        }
        rmsnorm_rows_bf16(x_in, a.in[2], H, T);
        rmsnorm_rows_bf16(mem, a.in[25], MN, NB * MEM); rmsnorm_rows_bf16(mem, a.in[25] + D, MN + NB * MEM * D, NB * MEM);
        LAS float* scr = (LAS float*)((LAS unsigned char*)lds_raw + wave * 16896);
        auto ident = [](int n) { return n; };
        auto emap = [](int n) { const bool il = (n < 1024) || (n >= 1536 && n < 2176); const int j = n & 63; return il ? ((n & ~63) + (j < 32 ? 2 * j : 2 * (j - 32) + 1)) : n; };
        for (int it = gw; it < 16 * 36; it += ngw) transpose_item(a.in[3], D, EVEN_IN, (bf16_t*)(ws + WS_WEIN), emap, scr, it, lane);
        for (int it = gw; it < 16 * 16; it += ngw) transpose_item(a.in[5], D, D, (bf16_t*)(ws + WS_WEOUT), ident, scr, it, lane);
        for (int it = gw; it < 16 * 46; it += ngw) transpose_item(a.in[7], D, ODD_IN, (bf16_t*)(ws + WS_WOIN), ident, scr, it, lane);
        for (int it = gw; it < 16 * 16; it += ngw) transpose_item(a.in[23], D, D, (bf16_t*)(ws + WS_WOOUT), ident, scr, it, lane);
        for (int it = gw; it < 2 * 16 * 16; it += ngw) { const int l = it / 256, r = it % 256; transpose_item(a.in[26] + (size_t)l * D * D, D, D, (bf16_t*)(ws + WS_WQ) + (size_t)l * D * D, ident, scr, r, lane, a.in[24] + l * D); }
        for (int it = gw; it < 2 * 16 * 32; it += ngw) { const int l = it / 512, r = it % 512; transpose_item(a.in[27] + (size_t)l * D * 2048, D, 2048, (bf16_t*)(ws + WS_WKV) + (size_t)l * 2048 * D, ident, scr, r, lane); }
        for (int it = gw; it < 2 * 16 * 16; it += ngw) { const int l = it / 256, r = it % 256; transpose_item(a.in[28] + (size_t)l * D * D, D, D, (bf16_t*)(ws + WS_WO) + (size_t)l * D * D, ident, scr, r, lane); }
        { float* WRT = (float*)(ws + WS_WRT);
          for (int i = gt; i < 2 * NE * D; i += ngt) { const int l = i >> 14, e = (i >> 10) & 15, k = i & 1023; WRT[i] = a.in[29][l * D + k] * a.in[30][((size_t)l * D + k) * NE + e]; } }
        { bf16_t* Wsb = (bf16_t*)(ws + WS_WSB); const float* wsp = a.in[10];
          for (int i = gt; i < 4 * 128 * 128; i += ngt) Wsb[i] = (bf16_t)f2bf(wsp[i]);
          bf16_t* WL = (bf16_t*)(ws + WS_WL); const float *w2 = a.in[14], *a2 = a.in[16], *g2 = a.in[17];
          for (int i = gt; i < 2560 * 384; i += ngt) { const int n = i / 384, k = i % 384, sec = n >> 9, cc = n & 511; float v = 0.f;
              if (sec < 2) { if ((k >> 6) == sec) v = w2[(size_t)(sec * 64 + (k & 63)) * 512 + cc]; }
              else if (sec < 4) { if ((k >> 6) == sec) v = a2[(size_t)((sec - 2) * 64 + (k & 63)) * 512 + cc]; }
              else { if (k >= 256) v = g2[(size_t)(k - 256) * 512 + cc]; }
              WL[i] = (bf16_t)f2bf(v); } }
        auto gmap = [](int n) { return (n >> 7) * 256 + (n & 127); };
        auto umap = [](int n) { return (n >> 7) * 256 + 128 + (n & 127); };
        for (int it = gw; it < 16 * 704; it += ngw) { const int mt = it / 704, r = it % 704;
            if constexpr (F8L0) transpose_item_fp8(a.in[31] + (size_t)mt * D * DE, D, DE, ws + WS_WGU8 + (size_t)mt * 5632 * D, gmap, GUSC8, scr, r, lane);
            else transpose_item(a.in[31] + (size_t)mt * D * DE, D, DE, (bf16_t*)(ws + WS_WGU) + (size_t)mt * 5632 * D, gmap, scr, r, lane); }
        for (int it = gw; it < 16 * 704; it += ngw) { const int mt = it / 704, r = it % 704;
            if constexpr (F8L0) transpose_item_fp8(a.in[32] + (size_t)mt * D * DE, D, DE, ws + WS_WGU8 + (size_t)mt * 5632 * D, umap, GUSC8, scr, r, lane);
            else transpose_item(a.in[32] + (size_t)mt * D * DE, D, DE, (bf16_t*)(ws + WS_WGU) + (size_t)mt * 5632 * D, umap, scr, r, lane); }
    }
    SEAM(ph); ++ph;

    if (IN(ph)) dense_gemm(ldsp, H, (const bf16_t*)(ws + WS_WEIN), T, EVEN_IN, D,
                           EpiEven{ropec, ropes, (bf16_t*)(ws + WS_QHA), (bf16_t*)(ws + WS_KHA), (bf16_t*)(ws + WS_QHB), (bf16_t*)(ws + WS_KHB), (bf16_t*)(ws + WS_VTA), (bf16_t*)(ws + WS_VTB)});
    if (IN(ph)) {
        dense_gemm(ldsp, MN, (const bf16_t*)(ws + WS_WKV), NB * MEM, 2048, D, EpiKV{KV, KV + 512 * 1024}, 192);
        dense_gemm(ldsp, MN + NB * MEM * D, (const bf16_t*)(ws + WS_WKV) + (size_t)2048 * D, NB * MEM, 2048, D, EpiKV{KV + 1024 * 1024, KV + 1024 * 1024 + 512 * 1024}, 176);
    }
    SEAM(ph); ++ph;
    if (IN(ph)) REP_LOOP attn_phase_even((const bf16_t*)(ws + WS_QHA), (const bf16_t*)(ws + WS_KHA), (const bf16_t*)(ws + WS_VTA), (const bf16_t*)(ws + WS_QHB), (const bf16_t*)(ws + WS_KHB),
                                (const bf16_t*)(ws + WS_VTB), a.in[4], (bf16_t*)(ws + WS_OA), (float*)(ws + WS_LSE), Y, lds_raw);
    SEAM(ph); ++ph;
    if (IN(ph)) REP_LOOP attn_combine((const bf16_t*)(ws + WS_OA), (const float*)(ws + WS_LSE), Y);
    SEAM(ph); ++ph;
    if (IN(ph)) dense_gemm(ldsp, Y, (const bf16_t*)(ws + WS_WEOUT), T, D, D, EpiResidN{x_in, X, H, (float*)(ws + WS_SSP)});
    SEAM(ph); ++ph;

    ph = tail_phases<0>(a, bar, lds_raw, ph);
    ph = odd_phases(a, bar, lds_raw, ph);
    ph = tail_phases<1>(a, bar, lds_raw, ph);

    if (IN(ph)) combine_norm<true>(X, YE, SLOT, a.in[34], nullptr, a.out);
    ++ph;
}
constexpr int NPHASES = 1 + 4 + 2 * 8 + 8 + 1;
#undef IN
#undef SEAM
}

extern "C" void kernel_launch(void* const* d_in, const int* in_sizes, int n_in, void* d_out, int out_size, void* d_ws, size_t ws_size, hipStream_t stream) {
    static int grid = 0;
    if (grid == 0) {
        if (n_in != 35 || out_size != T * D || ws_size < WS_END) { fprintf(stderr, "kernel_launch: unexpected shapes n_in %d out %d ws %zu (need %zu)\n", n_in, out_size, ws_size, (size_t)WS_END); grid = -1; return; }
        int dev = 0, cus = 0, per_cu = 0;
        (void)hipGetDevice(&dev); (void)hipDeviceGetAttribute(&cus, hipDeviceAttributeMultiprocessorCount, dev);
        if (hipFuncSetAttribute((const void*)mega, hipFuncAttributeMaxDynamicSharedMemorySize, LDS_BYTES) != hipSuccess) { fprintf(stderr, "hipFuncSetAttribute failed\n"); grid = -1; return; }
        if (hipOccupancyMaxActiveBlocksPerMultiprocessor(&per_cu, (const void*)mega, NTH, LDS_BYTES) != hipSuccess || per_cu < 1) fprintf(stderr, "occupancy query: %d\n", per_cu);
        (void)hipGetLastError();
        grid = cus > 0 ? cus : 256;
    }
    if (grid < 0) return;
    (void)hipMemsetAsync((char*)d_ws + WS_CTL, 0, CTL_BYTES, stream);
    Args a{};
    for (int i = 0; i < 35; ++i) a.in[i] = (const float*)d_in[i];
    a.out = (float*)d_out; a.ws = (unsigned char*)d_ws;
#if MK_MULTI
    for (int k = 0; k < NPHASES; ++k) { a.lo = k; a.hi = k + 1; hipLaunchKernelGGL(mega, dim3(grid), dim3(NTH), LDS_BYTES, stream, a); }
#else
    a.lo = 0; a.hi = NPHASES; hipLaunchKernelGGL(mega, dim3(grid), dim3(NTH), LDS_BYTES, stream, a);
#endif
}
```

```cpp
#include <hip/hip_runtime.h>
#include <cstdio>
#include <cstdint>

#ifndef PROBE_PHASE
#define PROBE_PHASE (-1)
#endif
#ifndef PROBE_REP
#define PROBE_REP 1
#endif
#ifndef MK_MULTI
#define MK_MULTI 0
#endif

__device__ __forceinline__ int tidx() { int t = threadIdx.x; asm volatile("" : "+v"(t)); return t; }
namespace pg8 {
#define PG8_LAS __attribute__((address_space(3)))
typedef unsigned short bf16_t;
typedef short bf16x8 __attribute__((ext_vector_type(8)));
typedef float f32x4 __attribute__((ext_vector_type(4)));
typedef unsigned u32x4 __attribute__((ext_vector_type(4)));
constexpr int BM = 256, BK = 64, HALF = 128, HTB = HALF * BK * 2  , STAGE_BYTES = 8 * HTB, NXCD = 8, WGM = 8;

__host__ __device__ __forceinline__ int lds_byte(int r, int c) { const int st = (r >> 4) * 2 + (c >> 5), rr = r & 15, cc = c & 31, ob = rr * 64 + cc * 2; return st * 1024 + (ob ^ (((ob >> 9) & 1) << 5)); }
__host__ __device__ __forceinline__ void stage_rc(int b, int& R, int& C) { const int st = b / 1024, sb = b % 1024, swz = sb ^ (((sb >> 9) & 1) << 5); R = (st >> 1) * 16 + swz / 64; C = (st & 1) * 32 + (swz % 64) / 2; }
__host__ __device__ __forceinline__ int perm32(int rho) { const int n = rho >> 4, i = rho & 15; return 8 * (i >> 2) + 4 * n + (i & 3); }

struct Unit { int pm, pn; };
struct Gemm { const bf16_t* A; const bf16_t* Bt; int M, N, K; };

struct StaticOrder {
    int nM, nN, nwg, G, c;
    __host__ __device__ void init(int M, int N, int G_, int c_) { nM = M / BM; nN = N / BM; nwg = nM * nN; G = G_; c = c_; }
    __host__ __device__ bool next(int i, Unit& u) const {
        const long L = (long)i * G + c; if (L >= nwg) return false;
        int wgid = (int)L; { const int q = nwg / NXCD, r = nwg % NXCD, xcd = wgid % NXCD, off = wgid / NXCD; wgid = (xcd < r ? xcd * (q + 1) : r * (q + 1) + (xcd - r) * q) + off; }
        const int nig = WGM * nN, gid = wgid / nig, fm = gid * WGM, gsz = (nM - fm) < WGM ? (nM - fm) : WGM;
        u.pm = fm + ((wgid % nig) % gsz); u.pn = (wgid % nig) / gsz; return true;
    }
    __device__ __forceinline__ void a_ready(const Unit&) const {}
    __device__ __forceinline__ void done(const Unit&) const {}
};

typedef __bf16 bf16v2_t __attribute__((ext_vector_type(2)));
typedef float f32v2_t __attribute__((ext_vector_type(2)));
__device__ __forceinline__ unsigned cvt_pk_bf16(float lo, float hi) { const f32v2_t v = {lo, hi}; return __builtin_bit_cast(unsigned, __builtin_convertvector(v, bf16v2_t)); }
typedef int i32x8 __attribute__((ext_vector_type(8)));
template <bool F8> __device__ __forceinline__ f32x4 mma_tile(const bf16x8 (&bfr)[2], const bf16x8 (&afr)[2], f32x4 acc) {
    if constexpr (F8) {
        typedef int i32x4_ __attribute__((ext_vector_type(4)));
        const i32x4_ b0 = __builtin_bit_cast(i32x4_, bfr[0]), b1 = __builtin_bit_cast(i32x4_, bfr[1]), a0 = __builtin_bit_cast(i32x4_, afr[0]), a1 = __builtin_bit_cast(i32x4_, afr[1]);
        const i32x8 bb = {b0[0], b0[1], b0[2], b0[3], b1[0], b1[1], b1[2], b1[3]}, aa = {a0[0], a0[1], a0[2], a0[3], a1[0], a1[1], a1[2], a1[3]};
        const int sc1 = 0x7f7f7f7f;
        asm volatile("v_mfma_scale_f32_16x16x128_f8f6f4 %0, %1, %2, %0, %3, %3 op_sel_hi:[0,0,0]" : "+v"(acc) : "v"(bb), "v"(aa), "v"(sc1));
        return acc;
    } else {
        acc = __builtin_amdgcn_mfma_f32_16x16x32_bf16(bfr[0], afr[0], acc, 0, 0, 0);
        return __builtin_amdgcn_mfma_f32_16x16x32_bf16(bfr[1], afr[1], acc, 0, 0, 0);
    }
}
template <class Epi, class Sched, bool STAMP = false, bool F8 = false>
__device__ __forceinline__ void gemm_phase(PG8_LAS unsigned char* lds, const Gemm g, const Sched& S, const Epi& E, unsigned long long* stamps) {
    const int tid = ::tidx(), wid = __builtin_amdgcn_readfirstlane(tid >> 6), lane = tid & 63, wr = wid >> 2, wc = wid & 3, fr = lane & 15, fq = lane >> 4;
    const int K = g.K, nt = K / BK;
    int ts_lo = 0, ts_hi = 0, nts = 0; const unsigned long long rt_entry = STAMP ? (unsigned long long)wall_clock64() : 0ull;
#define PG8_STAMP() do { if (STAMP && wid == 0 && nts < 64) { const unsigned long long _c = (unsigned long long)clock64(); \
        ts_lo = (lane == nts) ? (int)(unsigned)_c : ts_lo; ts_hi = (lane == nts) ? (int)(unsigned)(_c >> 32) : ts_hi; ++nts; } } while (0)
    PG8_STAMP();
    unsigned voffA[2], voffB[2];
#pragma unroll
    for (int i = 0; i < 2; ++i) { int R, C; stage_rc(tid * 16 + i * 8192, R, C); const int Rb = Epi::PERM ? ((R & ~31) + perm32(R & 31)) : R;
        voffA[i] = (unsigned)(R * K + C) * 2u; voffB[i] = (unsigned)(Rb * K + C) * 2u; }
    const size_t kstep = (size_t)(BK * 2);
    const size_t hstep = (size_t)HALF * K * 2;
    const size_t tstep = 2 * hstep;
    const unsigned ldsw = (unsigned)wid * 1024u;
    const int aoff = lds_byte(wr * 64 + fr, fq * 8), boff = lds_byte(wc * 32 + fr, fq * 8);
#define PG8_SA(b, h) (((b) * 2 + (h)) * HTB)
#define PG8_SB(b, h) ((4 + (b) * 2 + (h)) * HTB)
#define PG8_STAGE(bufoff, gbase, voff) do { _Pragma("unroll") for (int _i = 0; _i < 2; ++_i) \
        __builtin_amdgcn_global_load_lds((const unsigned*)((const char*)(gbase) + (voff)[_i]), (PG8_LAS unsigned*)(lds + (bufoff) + ldsw + _i * 8192), 16, 0, 0); } while (0)
#define PG8_LDA(dst, b, h) do { _Pragma("unroll") for (int m = 0; m < 4; ++m) _Pragma("unroll") for (int k = 0; k < 2; ++k) dst[m][k] = *(const PG8_LAS bf16x8*)(lds + PG8_SA(b, h) + aoff + m * 2048 + k * 1024); } while (0)
#define PG8_LDB(dst, b, h) do { _Pragma("unroll") for (int n = 0; n < 2; ++n) _Pragma("unroll") for (int k = 0; k < 2; ++k) dst[n][k] = *(const PG8_LAS bf16x8*)(lds + PG8_SB(b, h) + boff + n * 2048 + k * 1024); } while (0)
#define PG8_MMA(ai, bj, At, Bt) do { __builtin_amdgcn_s_setprio(1); _Pragma("unroll") for (int m = 0; m < 4; ++m) _Pragma("unroll") for (int n = 0; n < 2; ++n) \
        acc[ai][bj][m][n] = mma_tile<F8>(Bt[n], At[m], acc[ai][bj][m][n]); __builtin_amdgcn_s_setprio(0); } while (0)
#define PG8_WAIT_V(n) asm volatile("s_waitcnt vmcnt(" #n ")" ::: "memory")
#define PG8_WAIT_L(n) asm volatile("s_waitcnt lgkmcnt(" #n ")" ::: "memory")
#define PG8_BAR __builtin_amdgcn_s_barrier()
#define PG8_SCHED __builtin_amdgcn_sched_barrier(0)
    Unit cur, nxt; int ui = 0;
    if (!S.next(0, cur)) return;
    f32x4 acc[2][2][4][2];
#pragma unroll
    for (int a = 0; a < 2; ++a)
#pragma unroll
        for (int b = 0; b < 2; ++b)
#pragma unroll
            for (int m = 0; m < 4; ++m)
#pragma unroll
                for (int n = 0; n < 2; ++n) acc[a][b][m][n] = (f32x4){0.f, 0.f, 0.f, 0.f};
    bf16x8 At[4][2], B0[2][2], B1[2][2];
    const char* cA = (const char*)g.A + (size_t)cur.pm * tstep; const char* cB = (const char*)g.Bt + (size_t)cur.pn * tstep;
    S.a_ready(cur);
    PG8_STAGE(PG8_SB(0, 0), cB, voffB); PG8_STAGE(PG8_SA(0, 0), cA, voffA); PG8_STAGE(PG8_SB(0, 1), cB + hstep, voffB); PG8_STAGE(PG8_SA(0, 1), cA + hstep, voffA);
    if (wr == 1) PG8_BAR;
    PG8_WAIT_V(4); PG8_BAR;
    PG8_STAGE(PG8_SB(1, 0), cB + kstep, voffB); PG8_STAGE(PG8_SA(1, 0), cA + kstep, voffA); PG8_STAGE(PG8_SB(1, 1), cB + hstep + kstep, voffB);
    PG8_WAIT_V(6); PG8_BAR;
    PG8_STAMP();
    for (;;) {
        const bool has_next = S.next(ui + 1, nxt);
        const char* nA = has_next ? (const char*)g.A + (size_t)nxt.pm * tstep : cA; const char* nB = has_next ? (const char*)g.Bt + (size_t)nxt.pn * tstep : cB;
        for (int t = 0; t < nt; t += 2) {
            const bool last = (t == nt - 2);
            const char* a1 = cA + (size_t)(t + 1) * kstep;
            const char* a2 = last ? nA : cA + (size_t)(t + 2) * kstep; const char* b2 = last ? nB : cB + (size_t)(t + 2) * kstep;
            const char* a3 = a2 + kstep; const char* b3 = b2 + kstep;
            if (last && has_next) S.a_ready(nxt);
            PG8_LDB(B0, 0, 0); PG8_SCHED; PG8_LDA(At, 0, 0); PG8_STAGE(PG8_SA(1, 1), a1 + hstep, voffA);
            PG8_WAIT_L(8); PG8_BAR; PG8_WAIT_L(0); PG8_MMA(0, 0, At, B0); PG8_BAR; PG8_SCHED;
            PG8_LDB(B1, 0, 1); PG8_STAGE(PG8_SB(0, 0), b2, voffB);
            PG8_BAR; PG8_WAIT_L(0); PG8_MMA(0, 1, At, B1); PG8_BAR;
            PG8_LDA(At, 0, 1); PG8_STAGE(PG8_SA(0, 0), a2, voffA);
            PG8_BAR; PG8_WAIT_L(0); PG8_MMA(1, 0, At, B0); PG8_BAR; PG8_SCHED;
            PG8_STAGE(PG8_SB(0, 1), b2 + hstep, voffB);
            PG8_WAIT_V(6); PG8_BAR; PG8_MMA(1, 1, At, B1); PG8_BAR;
            PG8_LDB(B0, 1, 0); PG8_SCHED; PG8_LDA(At, 1, 0); PG8_STAGE(PG8_SA(0, 1), a2 + hstep, voffA);
            PG8_WAIT_L(8); PG8_BAR; PG8_WAIT_L(0); PG8_MMA(0, 0, At, B0); PG8_BAR; PG8_SCHED;
            PG8_LDB(B1, 1, 1); PG8_STAGE(PG8_SB(1, 0), b3, voffB);
            PG8_BAR; PG8_WAIT_L(0); PG8_MMA(0, 1, At, B1); PG8_BAR;
            PG8_LDA(At, 1, 1); PG8_STAGE(PG8_SA(1, 0), a3, voffA);
            PG8_BAR; PG8_WAIT_L(0); PG8_MMA(1, 0, At, B0); PG8_BAR; PG8_SCHED;
            PG8_STAGE(PG8_SB(1, 1), b3 + hstep, voffB);
            PG8_WAIT_V(6); PG8_BAR; PG8_MMA(1, 1, At, B1); PG8_BAR;
        }
        PG8_STAMP();
        if constexpr (!Epi::AFTER_DRAIN) { E(acc, cur, wr, wc, fr, fq); S.done(cur); }
        PG8_STAMP();
        if (!has_next) break;
#pragma unroll
        for (int a = 0; a < 2; ++a)
#pragma unroll
            for (int b = 0; b < 2; ++b)
#pragma unroll
                for (int m = 0; m < 4; ++m)
#pragma unroll
                    for (int n = 0; n < 2; ++n) acc[a][b][m][n] = (f32x4){0.f, 0.f, 0.f, 0.f};
        cur = nxt; cA = nA; cB = nB; ++ui;
    }
    PG8_WAIT_V(0);
    if (wr == 0) PG8_BAR;
    PG8_BAR;
    if constexpr (Epi::AFTER_DRAIN) { E.fused(acc, cur, wr, wc, fr, fq, lds, wid, lane); S.done(cur); }
    PG8_STAMP();
    if (STAMP && wid == 0) { stamps[lane] = lane < nts ? (((unsigned long long)(unsigned)ts_hi << 32) | (unsigned)ts_lo) : 0ull;
        if (lane == 62) stamps[62] = rt_entry; if (lane == 63) stamps[63] = (unsigned long long)wall_clock64(); }
#undef PG8_STAMP
#undef PG8_SA
#undef PG8_SB
#undef PG8_STAGE
#undef PG8_LDA
#undef PG8_LDB
#undef PG8_MMA
#undef PG8_WAIT_V
#undef PG8_WAIT_L
#undef PG8_BAR
#undef PG8_SCHED
}
}


namespace {
using pg8::bf16_t; using pg8::f32x4;
constexpr int D = 1024, NB = 2, S = 8192, T = NB * S;
constexpr int EVEN_IN = 2304, ODD_IN = 2944, ODD_PAD = 3072, FD = 1920;
constexpr int MEM = 256, NE = 16, CAP = 1024, DE = 2816;
constexpr int NTH = 512;
constexpr size_t MiB = 1u << 20;
constexpr size_t WS_CTL = 0, CTL_BYTES = 1 * MiB;
constexpr size_t WS_ROPE = 1 * MiB;
constexpr size_t WS_AFF = 4 * MiB;
constexpr size_t WS_TOK = 5 * MiB;
constexpr size_t WS_GATE = 6 * MiB;
constexpr size_t WS_WRT = 3 * MiB;
constexpr size_t WS_SLOT = 7 * MiB;
constexpr size_t WS_X = 8 * MiB;
constexpr size_t WS_H = 72 * MiB;
constexpr size_t WS_Y = 104 * MiB;
constexpr size_t WS_P = 136 * MiB;
constexpr size_t WS_Q = 320 * MiB;
constexpr size_t WS_KV = 384 * MiB;
constexpr size_t WS_MN = 388 * MiB;
constexpr size_t WS_SSP = 390 * MiB;
constexpr size_t WS_DEC = 392 * MiB;
constexpr size_t WS_KD = 456 * MiB;
constexpr size_t WS_BB = 520 * MiB;
constexpr size_t WS_KK = 584 * MiB;
constexpr size_t WS_G = 616 * MiB;
constexpr size_t WS_YS = 648 * MiB;
constexpr size_t WS_RV = 712 * MiB;
constexpr size_t WS_VN = 776 * MiB;
constexpr size_t WS_QHA = 136 * MiB;
constexpr size_t WS_KHA = 152 * MiB;
constexpr size_t WS_QHB = 168 * MiB;
constexpr size_t WS_KHB = 184 * MiB;
constexpr size_t WS_PVB = 188 * MiB;
constexpr size_t WS_VTA = 208 * MiB;
constexpr size_t WS_VTB = 256 * MiB;
constexpr size_t WS_OA = 260 * MiB;
constexpr size_t WS_LSE = 308 * MiB;
constexpr size_t WS_QT = 136 * MiB;
constexpr size_t WS_YL = 200 * MiB;
constexpr size_t WS_PT = 264 * MiB;
constexpr size_t WS_RH = 296 * MiB;
constexpr size_t WS_S0 = 328 * MiB;
constexpr size_t WS_XE = 136 * MiB;
constexpr size_t WS_YE = 136 * MiB;
constexpr size_t WS_HID = 200 * MiB;
constexpr size_t WS_KB = 360 * MiB;
constexpr size_t WS_F5 = 792 * MiB;
constexpr size_t WS_WSB = 804 * MiB;
constexpr size_t WS_WL = 805 * MiB;
constexpr size_t WS_WEIN = 808 * MiB;
constexpr size_t WS_WEOUT = 813 * MiB;
constexpr size_t WS_WOIN = 815 * MiB;
constexpr size_t WS_WOOUT = 821 * MiB;
constexpr size_t WS_WQ = 823 * MiB;
constexpr size_t WS_WKV = 827 * MiB;
constexpr size_t WS_WO = 835 * MiB;
constexpr size_t WS_WGU = 840 * MiB;
constexpr size_t WS_WD = 1192 * MiB;
constexpr size_t WS_WGU8 = 840 * MiB;
constexpr size_t WS_WD8 = 1192 * MiB;
constexpr size_t WS_END = 1368 * MiB;
constexpr bool F8L0 = true;
constexpr float ASC8 = 16.f, GUSC8 = 128.f, HSC8 = 4.f, DSC8 = 256.f;
constexpr int CW_BAR = 4096;

constexpr int LDS_BYTES = 147456;
constexpr int LDS_BAR_OFF = LDS_BYTES - 64;

#define LAS __attribute__((address_space(3)))
#define XB_TMO      128
#define XB_XCNT(j)  (256  + 64 * (j))
#define XB_XSUB(j)  (1280 + 64 * (j))
#define XB_XGEN(j)  (2304 + 64 * (j))
#define XB_TOP      3328
#define XB_TOPGEN   3392
#define XCD_BAR_WORDS 3456
#define XB_SPIN_CAP (1u << 22)
__device__ __forceinline__ unsigned xb_ld(unsigned* p)              { return __hip_atomic_load(p, __ATOMIC_RELAXED, __HIP_MEMORY_SCOPE_AGENT); }
__device__ __forceinline__ unsigned xb_add(unsigned* p, unsigned v) { return __hip_atomic_fetch_add(p, v, __ATOMIC_RELAXED, __HIP_MEMORY_SCOPE_AGENT); }
__device__ __forceinline__ unsigned xb_xcc_id() { return (unsigned)__builtin_amdgcn_s_getreg((3 << 11) | 20) & 0xFu; }
#define XB_SPIN(cond, bar) do { unsigned _sp = 0; while (cond) { __builtin_amdgcn_s_sleep(1); \
    if ((++_sp & 255u) == 0u) { if (xb_ld(&(bar)[XB_TMO])) break; if (_sp > XB_SPIN_CAP) { atomicAdd(&(bar)[XB_TMO], 1u); break; } } } } while (0)
struct XcdBarrier { unsigned* bar; unsigned x; volatile LAS unsigned* st; };
__device__ __forceinline__ XcdBarrier xcd_barrier_post(unsigned* bar, volatile LAS unsigned* st) {
    XcdBarrier b; b.bar = bar; b.x = xb_xcc_id(); b.st = st;
    if (threadIdx.x == 0) (void)xb_add(&bar[XB_XCNT(b.x)], 1u);
    return b;
}
__device__ __forceinline__ void xcd_barrier_complete(unsigned* bar, unsigned x, unsigned& nloc, unsigned& nx) {
    const unsigned G = gridDim.x * gridDim.y * gridDim.z;
    unsigned sum, cnt, mine, sp = 0u;
    for (;;) {
        sum = 0u; cnt = 0u; mine = 0u;
#pragma unroll
        for (unsigned j = 0; j < 16; ++j) { const unsigned c = xb_ld(&bar[XB_XCNT(j)]); sum += c; cnt += (c > 0u) ? 1u : 0u; mine = (j == x) ? c : mine; }
        if (sum == G) break;
        __builtin_amdgcn_s_sleep(1);
        if ((++sp & 255u) == 0u) { if (xb_ld(&bar[XB_TMO])) break; if (sp > XB_SPIN_CAP) { atomicAdd(&bar[XB_TMO], 1u); break; } }
    }
    nloc = mine > 0u ? mine : 1u; nx = cnt > 0u ? cnt : 1u;
}
__device__ __forceinline__ void xcd_barrier(const XcdBarrier& b) {
    asm volatile("s_waitcnt vmcnt(0)" ::: "memory");
    __syncthreads();
    if (threadIdx.x == 0) {
        unsigned* bar = b.bar;
        __builtin_amdgcn_s_waitcnt(0);
        unsigned nloc = b.st[0], nx = b.st[1];
        if (nloc == 0u) { xcd_barrier_complete(bar, b.x, nloc, nx); b.st[0] = nloc; b.st[1] = nx; }
        const unsigned old = xb_add(&bar[XB_XSUB(b.x)], 1u);
        const unsigned gen = old / nloc;
        if (old + 1u == (gen + 1u) * nloc) {
            __builtin_amdgcn_fence(__ATOMIC_RELEASE, "agent");
            asm volatile("s_waitcnt vmcnt(0)" ::: "memory");
            const unsigned og = xb_add(&bar[XB_TOP], 1u);
            const unsigned tg = og / nx;
            if (og + 1u == (tg + 1u) * nx) xb_add(&bar[XB_TOPGEN], 1u);
            else XB_SPIN(xb_ld(&bar[XB_TOPGEN]) == tg, bar);
            __builtin_amdgcn_fence(__ATOMIC_ACQUIRE, "agent");
            xb_add(&bar[XB_XGEN(b.x)], 1u);
            asm volatile("s_waitcnt vmcnt(0)" ::: "memory");
        } else {
            XB_SPIN(xb_ld(&bar[XB_XGEN(b.x)]) == gen, bar);
            __builtin_amdgcn_fence(__ATOMIC_ACQUIRE, "agent");
            asm volatile("s_waitcnt vmcnt(0)" ::: "memory");
        }
    }
    __syncthreads();
}

__device__ __forceinline__ float wave_sum(float v) {
#pragma unroll
    for (int o = 32; o >= 1; o >>= 1) v += __shfl_xor(v, o);
    return v;
}
__device__ __forceinline__ float frcp(float x) { return __builtin_amdgcn_rcpf(x); }
__device__ __forceinline__ float sigmoidf_(float x) { return frcp(1.0f + __expf(-x)); }
__device__ __forceinline__ float tanhf_(float x) { return 2.0f * sigmoidf_(2.0f * x) - 1.0f; }
__device__ __forceinline__ float gelu_tanh(float x) { return x * sigmoidf_(1.5957691216057308f * (x + 0.044715f * x * x * x)); }
__device__ __forceinline__ unsigned f2bf(float f) { unsigned u = __builtin_bit_cast(unsigned, f); return (u + 0x7fffu + ((u >> 16) & 1u)) >> 16; }
__device__ __forceinline__ unsigned pk2(float lo, float hi) { return pg8::cvt_pk_bf16(lo, hi); }
__device__ __forceinline__ float bflo(unsigned w) { return __uint_as_float(w << 16); }
__device__ __forceinline__ float bfhi(unsigned w) { return __uint_as_float(w & 0xffff0000u); }
typedef unsigned v4u __attribute__((ext_vector_type(4)));
typedef unsigned v2u __attribute__((ext_vector_type(2)));

struct Args { const float* in[35]; float* out; unsigned char* ws; int lo, hi; };

struct EpiF32Store {
    static constexpr bool PERM = false, AFTER_DRAIN = false;
    float* C; int ldc; int nvalid;
    __device__ __forceinline__ void operator()(const f32x4 (&acc)[2][2][4][2], const pg8::Unit& u, int wr, int wc, int fr, int fq) const {
        const int row0 = u.pm * 256 + wr * 64 + fr, col0 = u.pn * 256 + wc * 32 + 4 * fq;
#pragma unroll
        for (int ai = 0; ai < 2; ++ai)
#pragma unroll
            for (int m = 0; m < 4; ++m) { float* rowp = C + (size_t)(row0 + ai * 128 + m * 16) * ldc + col0;
#pragma unroll
                for (int bj = 0; bj < 2; ++bj)
#pragma unroll
                    for (int n = 0; n < 2; ++n) if (col0 + bj * 128 + n * 16 < nvalid) *(f32x4*)(rowp + bj * 128 + n * 16) = acc[ai][bj][m][n]; }
    }
};
struct EpiResid {
    static constexpr bool PERM = false, AFTER_DRAIN = false;
    const float* base; float* out;
    __device__ __forceinline__ void operator()(const f32x4 (&acc)[2][2][4][2], const pg8::Unit& u, int wr, int wc, int fr, int fq) const {
        const int row0 = u.pm * 256 + wr * 64 + fr, col0 = u.pn * 256 + wc * 32 + 4 * fq;
#pragma unroll
        for (int ai = 0; ai < 2; ++ai)
#pragma unroll
            for (int m = 0; m < 4; ++m) { const size_t off = (size_t)(row0 + ai * 128 + m * 16) * D + col0;
#pragma unroll
                for (int bj = 0; bj < 2; ++bj)
#pragma unroll
                    for (int n = 0; n < 2; ++n) { const f32x4 b = *(const f32x4*)(base + off + bj * 128 + n * 16); *(f32x4*)(out + off + bj * 128 + n * 16) = b + acc[ai][bj][m][n]; } }
    }
};
struct EpiSiluMul {
    static constexpr bool PERM = false, AFTER_DRAIN = false;
    bf16_t* HIDp;
    __device__ __forceinline__ void operator()(const f32x4 (&acc)[2][2][4][2], const pg8::Unit& u, int wr, int wc, int fr, int fq) const {
        const int pnl = u.pn % 22;
        const int row0 = u.pm * 256 + wr * 64 + fr, col0 = pnl * 128 + wc * 32 + 4 * fq;
#pragma unroll
        for (int ai = 0; ai < 2; ++ai)
#pragma unroll
            for (int m = 0; m < 4; ++m) { bf16_t* rowp = HIDp + (size_t)(row0 + ai * 128 + m * 16) * DE + col0;
#pragma unroll
                for (int n = 0; n < 2; ++n) { const f32x4 g = acc[ai][0][m][n], up = acc[ai][1][m][n]; float h[4];
#pragma unroll
                    for (int j = 0; j < 4; ++j) h[j] = g[j] * frcp(1.0f + __expf(-g[j])) * up[j];
                    v2u w; w.x = pk2(h[0], h[1]); w.y = pk2(h[2], h[3]); *(v2u*)(rowp + n * 16) = w; } }
    }
};
struct EpiYE {
    static constexpr bool PERM = true, AFTER_DRAIN = false;
    const float* GATE; bf16_t* YE;
    __device__ __forceinline__ void operator()(const f32x4 (&acc)[2][2][4][2], const pg8::Unit& u, int wr, int wc, int fr, int fq) const {
        const int pnl = u.pn & 3;
        const int row0 = u.pm * 256 + wr * 64 + fr, col0 = pnl * 256 + wc * 32 + 8 * fq;
#pragma unroll
        for (int ai = 0; ai < 2; ++ai)
#pragma unroll
            for (int m = 0; m < 4; ++m) { const int row = row0 + ai * 128 + m * 16; const float gt_ = GATE[row]; bf16_t* rowp = YE + (size_t)row * D + col0;
#pragma unroll
                for (int bj = 0; bj < 2; ++bj) { const f32x4 v0 = acc[ai][bj][m][0] * gt_, v1 = acc[ai][bj][m][1] * gt_;
                    v4u w; w.x = pg8::cvt_pk_bf16(v0[0], v0[1]); w.y = pg8::cvt_pk_bf16(v0[2], v0[3]); w.z = pg8::cvt_pk_bf16(v1[0], v1[1]); w.w = pg8::cvt_pk_bf16(v1[2], v1[3]);
                    *(v4u*)(rowp + bj * 128) = w; } }
    }
};
struct EpiBf16Store {
    static constexpr bool PERM = true, AFTER_DRAIN = false;
    bf16_t* O; int ldc; float scale;
    __device__ __forceinline__ void operator()(const f32x4 (&acc)[2][2][4][2], const pg8::Unit& u, int wr, int wc, int fr, int fq) const {
        const int row0 = u.pm * 256 + wr * 64 + fr, col0 = u.pn * 256 + wc * 32 + 8 * fq;
#pragma unroll
        for (int ai = 0; ai < 2; ++ai)
#pragma unroll
            for (int m = 0; m < 4; ++m) { bf16_t* rowp = O + (size_t)(row0 + ai * 128 + m * 16) * ldc + col0;
#pragma unroll
                for (int bj = 0; bj < 2; ++bj) { const f32x4 v0 = acc[ai][bj][m][0] * scale, v1 = acc[ai][bj][m][1] * scale;
                    v4u w; w.x = pg8::cvt_pk_bf16(v0[0], v0[1]); w.y = pg8::cvt_pk_bf16(v0[2], v0[3]); w.z = pg8::cvt_pk_bf16(v1[0], v1[1]); w.w = pg8::cvt_pk_bf16(v1[2], v1[3]);
                    *(v4u*)(rowp + bj * 128) = w; } }
    }
};
struct EpiKV {
    static constexpr bool PERM = false, AFTER_DRAIN = false;
    bf16_t* K; bf16_t* Vt;
    __device__ __forceinline__ void operator()(const f32x4 (&acc)[2][2][4][2], const pg8::Unit& u, int wr, int wc, int fr, int fq) const {
        const int row0 = u.pm * 256 + wr * 64 + fr, col0 = u.pn * 256 + wc * 32 + 4 * fq;
#pragma unroll
        for (int ai = 0; ai < 2; ++ai)
#pragma unroll
            for (int m = 0; m < 4; ++m) { const int row = row0 + ai * 128 + m * 16;
#pragma unroll
                for (int bj = 0; bj < 2; ++bj)
#pragma unroll
                    for (int n = 0; n < 2; ++n) { const int col = col0 + bj * 128 + n * 16; const f32x4 v = acc[ai][bj][m][n];
                        if (col < 1024) { v2u w; w.x = pk2(v[0], v[1]); w.y = pk2(v[2], v[3]); *(v2u*)(K + (size_t)row * 1024 + col) = w; }
                        else { const int b = row >> 8, mm = row & 255; bf16_t* vp = Vt + ((size_t)(b * 1024 + (col - 1024)) * 256 + mm);
#pragma unroll
                            for (int j = 0; j < 4; ++j) vp[(size_t)j * 256] = (bf16_t)f2bf(v[j]); } } }
    }
};

constexpr float QSCALE = 0.125f * 1.4426950408889634f;
struct EpiEven {
    static constexpr bool PERM = true, AFTER_DRAIN = false;
    const float* rc; const float* rs; bf16_t* QhA; bf16_t* KhA; bf16_t* QhB; bf16_t* KhB; bf16_t* VhA; bf16_t* VhB;
    __device__ __forceinline__ void operator()(const f32x4 (&acc)[2][2][4][2], const pg8::Unit& u, int wr, int wc, int fr, int fq) const {
        asm volatile("" : "+v"(fr), "+v"(fq));
        const int row0 = u.pm * 256 + wr * 64 + fr;
#pragma unroll
        for (int bj = 0; bj < 2; ++bj) {
            const int c0 = u.pn * 256 + bj * 128 + wc * 32 + 8 * fq;
            int kind; bf16_t* base; int stride; float sc = 1.0f;
            if (c0 < 512) { kind = 0; base = QhA + ((size_t)(c0 >> 6) * T) * 64 + (c0 & 63); stride = 64; sc = QSCALE; }
            else if (c0 < 1024) { kind = 0; base = KhA + ((size_t)((c0 - 512) >> 6) * T) * 64 + (c0 & 63); stride = 64; }
            else if (c0 < 1536) { kind = 1; base = VhA + ((size_t)((c0 - 1024) >> 6) * T) * 64 + (c0 & 63); stride = 64; }
            else if (c0 < 2048) { kind = 0; base = QhB + ((size_t)((c0 - 1536) >> 6) * T) * 64 + (c0 & 63); stride = 64; sc = QSCALE; }
            else if (c0 < 2176) { kind = 0; base = KhB + ((size_t)((c0 - 2048) >> 6) * T) * 64 + (c0 & 63); stride = 64; }
            else { kind = 1; base = VhB + ((size_t)((c0 - 2176) >> 6) * T) * 64 + (c0 & 63); stride = 64; }
            const int pi = (c0 & 63) >> 1;
#pragma unroll
            for (int ai = 0; ai < 2; ++ai)
#pragma unroll
                for (int m = 0; m < 4; ++m) {
                    const int tok = row0 + ai * 128 + m * 16;
                    const f32x4 v0 = acc[ai][bj][m][0], v1 = acc[ai][bj][m][1];
                    float y[8];
                    if (kind == 0) {
                        const int s = tok & (S - 1);
                        const f32x4 c4 = *(const f32x4*)(rc + s * 32 + pi), s4 = *(const f32x4*)(rs + s * 32 + pi);
                        y[0] = (v0[0] * c4[0] - v0[1] * s4[0]) * sc; y[1] = (v0[1] * c4[0] + v0[0] * s4[0]) * sc;
                        y[2] = (v0[2] * c4[1] - v0[3] * s4[1]) * sc; y[3] = (v0[3] * c4[1] + v0[2] * s4[1]) * sc;
                        y[4] = (v1[0] * c4[2] - v1[1] * s4[2]) * sc; y[5] = (v1[1] * c4[2] + v1[0] * s4[2]) * sc;
                        y[6] = (v1[2] * c4[3] - v1[3] * s4[3]) * sc; y[7] = (v1[3] * c4[3] + v1[2] * s4[3]) * sc;
                    } else { y[0] = v0[0]; y[1] = v0[1]; y[2] = v0[2]; y[3] = v0[3]; y[4] = v1[0]; y[5] = v1[1]; y[6] = v1[2]; y[7] = v1[3]; }
                    v4u w; w.x = pk2(y[0], y[1]); w.y = pk2(y[2], y[3]); w.z = pk2(y[4], y[5]); w.w = pk2(y[6], y[7]);
                    *(v4u*)(base + (size_t)tok * stride) = w;
                }
        }
    }
};

struct EpiLora {
    static constexpr bool PERM = false, AFTER_DRAIN = false;
    const float *w0, *a0, *k_a; const bf16_t *KB, *KK; bf16_t *LW, *KD, *BB, *G;
    __device__ __forceinline__ void operator()(const f32x4 (&acc)[2][2][4][2], const pg8::Unit& u, int wr, int wc, int fr, int fq) const {
        asm volatile("" : "+v"(fr), "+v"(fq));
        const int row0 = u.pm * 256 + wr * 64 + fr;
#pragma unroll
        for (int bj = 0; bj < 2; ++bj)
#pragma unroll
            for (int n = 0; n < 2; ++n) {
                const int c0 = u.pn * 256 + bj * 128 + wc * 32 + n * 16 + 4 * fq, sec = c0 >> 9, cc = c0 & 511;
#pragma unroll
                for (int ai = 0; ai < 2; ++ai)
#pragma unroll
                    for (int m = 0; m < 4; ++m) {
                        const size_t tok = row0 + ai * 128 + m * 16;
                        const f32x4 v = acc[ai][bj][m][n];
                        if (sec < 2) {
                            const f32x4 w = *(const f32x4*)(w0 + sec * 512 + cc); float o[4];
#pragma unroll
                            for (int j = 0; j < 4; ++j) { const float xw = -(w[j] + v[j]);
                                o[j] = -0.6065306597126334f * frcp(1.0f + __expf(xw)); }
                            v2u ww; ww.x = pk2(o[0], o[1]); ww.y = pk2(o[2], o[3]);
                            *(v2u*)(LW + ((size_t)sec * T + tok) * 512 + cc) = ww;
                        } else if (sec < 4) {
                            const int d = sec - 2;
                            const f32x4 a_ = *(const f32x4*)(a0 + d * 512 + cc), ka = *(const f32x4*)(k_a + cc);
                            const v2u kw = *(const v2u*)(KB + tok * 512 + cc), kkw = *(const v2u*)(KK + tok * 512 + cc);
                            const float kv[4] = {bflo(kw.x), bfhi(kw.x), bflo(kw.y), bfhi(kw.y)}, kk[4] = {bflo(kkw.x), bfhi(kkw.x), bflo(kkw.y), bfhi(kkw.y)};
                            float okd[4], obb[4];
#pragma unroll
                            for (int j = 0; j < 4; ++j) { const float alr = frcp(1.0f + __expf(-(a_[j] + v[j]))); okd[j] = kv[j] * (1.0f + (alr - 1.0f) * ka[j]); obb[j] = kk[j] * alr; }
                            v2u w1, w2_; w1.x = pk2(okd[0], okd[1]); w1.y = pk2(okd[2], okd[3]); w2_.x = pk2(obb[0], obb[1]); w2_.y = pk2(obb[2], obb[3]);
                            *(v2u*)(KD + ((size_t)d * T + tok) * 512 + cc) = w1; *(v2u*)(BB + ((size_t)d * T + tok) * 512 + cc) = w2_;
                        } else { v2u ww; ww.x = pk2(v[0], v[1]); ww.y = pk2(v[2], v[3]); *(v2u*)(G + tok * 512 + cc) = ww; }
                        __builtin_amdgcn_sched_barrier(0);
                    }
            }
    }
};

__device__ __forceinline__ float clamp8(float x) { return __builtin_amdgcn_fmed3f(x, -448.f, 448.f); }
__device__ __forceinline__ unsigned pk4_fp8(float a, float b, float c, float d) {
    int w = 0; w = __builtin_amdgcn_cvt_pk_fp8_f32(clamp8(a), clamp8(b), w, false); w = __builtin_amdgcn_cvt_pk_fp8_f32(clamp8(c), clamp8(d), w, true); return (unsigned)w;
}
struct EpiSiluMul8 {
    static constexpr bool PERM = true, AFTER_DRAIN = false;
    unsigned char* HIDp;
    __device__ __forceinline__ void operator()(const f32x4 (&acc)[2][2][4][2], const pg8::Unit& u, int wr, int wc, int fr, int fq) const {
        asm volatile("s_nop 7\n\ts_nop 7\n\ts_nop 7"); __builtin_amdgcn_sched_barrier(0);
        const int pnl = u.pn % 22;
        const int row0 = u.pm * 256 + wr * 64 + fr, col0 = pnl * 128 + wc * 32 + 8 * fq;
        const float s1 = 1.0f / (ASC8 * GUSC8);
#pragma unroll
        for (int ai = 0; ai < 2; ++ai)
#pragma unroll
            for (int m = 0; m < 4; ++m) { unsigned char* rowp = HIDp + (size_t)(row0 + ai * 128 + m * 16) * DE + col0; float h[8];
#pragma unroll
                for (int n = 0; n < 2; ++n) { const f32x4 g = acc[ai][0][m][n] * s1, up = acc[ai][1][m][n] * (s1 * HSC8);
#pragma unroll
                    for (int j = 0; j < 4; ++j) h[4 * n + j] = g[j] * frcp(1.0f + __expf(-g[j])) * up[j]; }
                v2u w; w.x = pk4_fp8(h[0], h[1], h[2], h[3]); w.y = pk4_fp8(h[4], h[5], h[6], h[7]);
                *(v2u*)rowp = w; }
    }
};
struct EpiYE8 {
    static constexpr bool PERM = true, AFTER_DRAIN = false;
    const float* GATE; bf16_t* YE;
    __device__ __forceinline__ void operator()(const f32x4 (&acc)[2][2][4][2], const pg8::Unit& u, int wr, int wc, int fr, int fq) const {
        asm volatile("s_nop 7\n\ts_nop 7\n\ts_nop 7"); __builtin_amdgcn_sched_barrier(0);
        const int pnl = u.pn & 3;
        const int row0 = u.pm * 256 + wr * 64 + fr, col0 = pnl * 256 + wc * 32 + 8 * fq;
#pragma unroll
        for (int ai = 0; ai < 2; ++ai)
#pragma unroll
            for (int m = 0; m < 4; ++m) { const int row = row0 + ai * 128 + m * 16; const float gt_ = GATE[row] * (1.0f / (HSC8 * DSC8)); bf16_t* rowp = YE + (size_t)row * D + col0;
#pragma unroll
                for (int bj = 0; bj < 2; ++bj) { const f32x4 v0 = acc[ai][bj][m][0] * gt_, v1 = acc[ai][bj][m][1] * gt_;
                    v4u w; w.x = pk2(v0[0], v0[1]); w.y = pk2(v0[2], v0[3]); w.z = pk2(v1[0], v1[1]); w.w = pk2(v1[2], v1[3]);
                    *(v4u*)(rowp + bj * 128) = w; } }
    }
};
template <class RowMap>
__device__ __forceinline__ void transpose_item_fp8(const float* W, int K, int N, unsigned char* WT, RowMap rm, float sc, LAS float* scr, int item, int lane) {
    const int nblk = N / 64, kb = item / nblk, nb_ = item % nblk, k0 = 64 * kb, n0 = 64 * nb_;
    f32x4 ld[16];
#pragma unroll
    for (int i = 0; i < 16; ++i) ld[i] = *(const f32x4*)(W + (size_t)(k0 + 4 * i + (lane >> 4)) * N + n0 + 4 * (lane & 15));
#pragma unroll
    for (int i = 0; i < 16; ++i) { LAS float* p = scr + (4 * i + (lane >> 4)) * 65 + 4 * (lane & 15); p[0] = ld[i][0]; p[1] = ld[i][1]; p[2] = ld[i][2]; p[3] = ld[i][3]; }
    asm volatile("s_waitcnt lgkmcnt(0)" ::: "memory");
    const int c = lane & 3;
#pragma unroll
    for (int j = 0; j < 4; ++j) { const int n = (lane >> 2) + 16 * j; const LAS float* s = scr + (16 * c) * 65 + n;
        v4u o;
#pragma unroll
        for (int q = 0; q < 4; ++q) o[q] = pk4_fp8(s[(4 * q) * 65] * sc, s[(4 * q + 1) * 65] * sc, s[(4 * q + 2) * 65] * sc, s[(4 * q + 3) * 65] * sc);
        *(v4u*)(WT + (size_t)rm(n0 + n) * K + k0 + 16 * c) = o; }
    asm volatile("s_waitcnt lgkmcnt(0)" ::: "memory");
}

struct EpiResidN {
    static constexpr bool PERM = false, AFTER_DRAIN = false;
    const float* base; float* out; bf16_t* Xb; float* SSP;
    __device__ __forceinline__ void operator()(const f32x4 (&acc)[2][2][4][2], const pg8::Unit& u, int wr, int wc, int fr, int fq) const {
        asm volatile("" : "+v"(fr), "+v"(fq));
        const int row0 = u.pm * 256 + wr * 64 + fr, col0 = u.pn * 256 + wc * 32 + 4 * fq;
#pragma unroll
        for (int ai = 0; ai < 2; ++ai)
#pragma unroll
            for (int m = 0; m < 4; ++m) { const size_t row = row0 + ai * 128 + m * 16; const size_t off = row * D + col0; float ss = 0.f;
#pragma unroll
                for (int bj = 0; bj < 2; ++bj)
#pragma unroll
                    for (int n = 0; n < 2; ++n) { const f32x4 b = *(const f32x4*)(base + off + bj * 128 + n * 16); const f32x4 o = b + acc[ai][bj][m][n];
                        *(f32x4*)(out + off + bj * 128 + n * 16) = o;
                        v2u w; w.x = pk2(o[0], o[1]); w.y = pk2(o[2], o[3]); *(v2u*)(Xb + off + bj * 128 + n * 16) = w;
                        ss += (o[0] * o[0] + o[1] * o[1]) + (o[2] * o[2] + o[3] * o[3]); }
                ss += __shfl_xor(ss, 16); ss += __shfl_xor(ss, 32);
                if (fq == 0) SSP[row * 16 + u.pn * 4 + wc] = ss; }
    }
};
struct EpiBf16StoreRS {
    static constexpr bool PERM = true, AFTER_DRAIN = false;
    bf16_t* O; int ldc; const float* SSP;
    __device__ __forceinline__ void operator()(const f32x4 (&acc)[2][2][4][2], const pg8::Unit& u, int wr, int wc, int fr, int fq) const {
        asm volatile("" : "+v"(fr), "+v"(fq));
        const int row0 = u.pm * 256 + wr * 64 + fr, col0 = u.pn * 256 + wc * 32 + 8 * fq;
#pragma unroll
        for (int ai = 0; ai < 2; ++ai)
#pragma unroll
            for (int m = 0; m < 4; ++m) { const size_t row = row0 + ai * 128 + m * 16;
                const f32x4* sp = (const f32x4*)(SSP + row * 16); const f32x4 s0 = sp[0], s1 = sp[1], s2 = sp[2], s3 = sp[3];
                const float ss = (((s0[0] + s0[1]) + (s0[2] + s0[3])) + ((s1[0] + s1[1]) + (s1[2] + s1[3]))) + (((s2[0] + s2[1]) + (s2[2] + s2[3])) + ((s3[0] + s3[1]) + (s3[2] + s3[3])));
                const float rs = rsqrtf(ss * (1.0f / D) + 1e-6f);
                bf16_t* rowp = O + row * ldc + col0;
#pragma unroll
                for (int bj = 0; bj < 2; ++bj) { const f32x4 v0 = acc[ai][bj][m][0] * rs, v1 = acc[ai][bj][m][1] * rs;
                    v4u w; w.x = pk2(v0[0], v0[1]); w.y = pk2(v0[2], v0[3]); w.z = pk2(v1[0], v1[1]); w.w = pk2(v1[2], v1[3]);
                    *(v4u*)(rowp + bj * 128) = w; } }
    }
};
struct MoeOrder {
    int G, c, npairs;
    int per;
    __device__ __forceinline__ bool next(int i, pg8::Unit& u) const {
        const int x = c & 7, y = c >> 3, pml = y & 7, pnq = y >> 3;
        const int epn = i * 32 + x * 4 + pnq;
        if (epn >= npairs || c >= 256) return false;
        const int e = epn / per;
        u.pm = e * 8 + pml; u.pn = epn; return true;
    }
    __device__ __forceinline__ void a_ready(const pg8::Unit&) const {}
    __device__ __forceinline__ void done(const pg8::Unit&) const {}
};

template <class RowMap>
__device__ __forceinline__ void transpose_item(const float* W, int K, int N, bf16_t* WT, RowMap rm, LAS float* scr, int item, int lane, const float* kscale = nullptr) {
    const int nblk = N / 64, kb = item / nblk, nb_ = item % nblk, k0 = 64 * kb, n0 = 64 * nb_;
    f32x4 ld[16];
#pragma unroll
    for (int i = 0; i < 16; ++i) ld[i] = *(const f32x4*)(W + (size_t)(k0 + 4 * i + (lane >> 4)) * N + n0 + 4 * (lane & 15));
#pragma unroll
    for (int i = 0; i < 16; ++i) { LAS float* p = scr + (4 * i + (lane >> 4)) * 65 + 4 * (lane & 15); p[0] = ld[i][0]; p[1] = ld[i][1]; p[2] = ld[i][2]; p[3] = ld[i][3]; }
    asm volatile("s_waitcnt lgkmcnt(0)" ::: "memory");
    const int c = lane & 7;
    float ksc[8];
#pragma unroll
    for (int q = 0; q < 8; ++q) ksc[q] = kscale ? kscale[k0 + 8 * c + q] : 1.0f;
#pragma unroll
    for (int j = 0; j < 8; ++j) { const int n = (lane >> 3) + 8 * j; const LAS float* s = scr + (8 * c) * 65 + n;
        v4u o; o.x = pk2(s[0 * 65] * ksc[0], s[1 * 65] * ksc[1]); o.y = pk2(s[2 * 65] * ksc[2], s[3 * 65] * ksc[3]); o.z = pk2(s[4 * 65] * ksc[4], s[5 * 65] * ksc[5]); o.w = pk2(s[6 * 65] * ksc[6], s[7 * 65] * ksc[7]);
        *(v4u*)(WT + (size_t)rm(n0 + n) * K + k0 + 8 * c) = o; }
    asm volatile("s_waitcnt lgkmcnt(0)" ::: "memory");
}

__device__ __forceinline__ void rmsnorm_rows_bf16(const float* x, const float* g, bf16_t* out, int M) {
    const int tix_ = tidx(); const int lane = tix_ & 63, gw = blockIdx.x * 8 + (tix_ >> 6), ngw = gridDim.x * 8;
    for (int m = gw; m < M; m += ngw) {
        const float4* xr = (const float4*)(x + (size_t)m * D);
        float4 v[4]; float s = 0.f;
#pragma unroll
        for (int j = 0; j < 4; ++j) { v[j] = xr[lane + 64 * j]; s += v[j].x * v[j].x + v[j].y * v[j].y + v[j].z * v[j].z + v[j].w * v[j].w; }
        const float r = rsqrtf(wave_sum(s) * (1.0f / D) + 1e-6f);
        v2u* o = (v2u*)(out + (size_t)m * D);
#pragma unroll
        for (int j = 0; j < 4; ++j) { const float4 gg = ((const float4*)g)[lane + 64 * j];
            v2u w; w.x = pk2(v[j].x * r * gg.x, v[j].y * r * gg.y); w.y = pk2(v[j].z * r * gg.z, v[j].w * r * gg.w); o[lane + 64 * j] = w; }
    }
}
__device__ __forceinline__ void rmsnorm_rows_f32(const float* x, const float* g, float* out, int M) {
    const int tix_ = tidx(); const int lane = tix_ & 63, gw = blockIdx.x * 8 + (tix_ >> 6), ngw = gridDim.x * 8;
    for (int m = gw; m < M; m += ngw) {
        const float4* xr = (const float4*)(x + (size_t)m * D);
        float4 v[4]; float s = 0.f;
#pragma unroll
        for (int j = 0; j < 4; ++j) { v[j] = xr[lane + 64 * j]; s += v[j].x * v[j].x + v[j].y * v[j].y + v[j].z * v[j].z + v[j].w * v[j].w; }
        const float r = rsqrtf(wave_sum(s) * (1.0f / D) + 1e-6f);
        float4* o = (float4*)(out + (size_t)m * D);
#pragma unroll
        for (int j = 0; j < 4; ++j) { const float4 gg = ((const float4*)g)[lane + 64 * j];
            o[lane + 64 * j] = make_float4(v[j].x * r * gg.x, v[j].y * r * gg.y, v[j].z * r * gg.z, v[j].w * r * gg.w); }
    }
}

__device__ __forceinline__ int block_exscan(int v, int* sh, int* tot) {
    const int tid = tidx(), lane = tid & 63, w = tid >> 6;
    int inc = v;
#pragma unroll
    for (int o = 1; o < 64; o <<= 1) { const int t = __shfl_up(inc, o); if (lane >= o) inc += t; }
    __syncthreads();
    if (lane == 63) sh[w] = inc;
    __syncthreads();
    int base = 0, total = 0;
#pragma unroll
    for (int i = 0; i < 8; ++i) { const int x = sh[i]; if (i < w) base += x; total += x; }
    *tot = total;
    return base + inc - v;
}


typedef short bf16x8 __attribute__((ext_vector_type(8)));
typedef float f32x16 __attribute__((ext_vector_type(16)));
constexpr int MROW = 144;
constexpr int MBUF = 64 * MROW;
__device__ __forceinline__ bf16x8 frag_rm(const LAS unsigned char* M, int row0, int k0, int fr, int fq) {
    return *(const LAS bf16x8*)(M + (row0 + fr) * MROW + (k0 + 8 * fq) * 2);
}
__device__ __forceinline__ bf16x8 frag_cm(const LAS unsigned char* M, int k0, int col0, int fr, int fq) {
    const LAS unsigned short* p = (const LAS unsigned short*)(M + (k0 + 8 * fq) * MROW + (col0 + fr) * 2);
    bf16x8 v;
#pragma unroll
    for (int j = 0; j < 8; ++j) v[j] = (short)p[j * (MROW / 2)];
    return v;
}
__device__ __forceinline__ void tile_store_bf16(LAS unsigned char* M, int m0, int n0, int fr, int fq, const f32x4& c) {
    v2u w; w.x = pk2(c[0], c[1]); w.y = pk2(c[2], c[3]);
    *(LAS v2u*)(M + (m0 + fr) * MROW + (n0 + 4 * fq) * 2) = w;
}
#define MMA16(acc, lf, rf) acc = __builtin_amdgcn_mfma_f32_16x16x32_bf16(rf, lf, acc, 0, 0, 0)

__device__ __forceinline__ void tile_store_bf16_T(LAS unsigned char* M, int m0, int n0, int fr, int fq, const f32x4& c) {
    const unsigned w0 = pk2(c[0], c[1]), w1 = pk2(c[2], c[3]);
    LAS unsigned char* p = M + (n0 + 4 * fq) * MROW + (m0 + fr) * 2;
    *(LAS unsigned short*)(p) = (unsigned short)(w0 & 0xffffu); *(LAS unsigned short*)(p + MROW) = (unsigned short)(w0 >> 16);
    *(LAS unsigned short*)(p + 2 * MROW) = (unsigned short)(w1 & 0xffffu); *(LAS unsigned short*)(p + 3 * MROW) = (unsigned short)(w1 >> 16);
}
__device__ __forceinline__ void scan_r1(const bf16_t* LWg, const bf16_t* RVg, const bf16_t* KDg, const bf16_t* KKg, const bf16_t* BBg,
                                        bf16_t* PT, bf16_t* QT, bf16_t* RH, float* YL, unsigned char* lds_raw) {
    LAS unsigned char* L = (LAS unsigned char*)lds_raw;
#define SL(k) (L + (k) * MBUF)
    LAS float* LWs = (LAS float*)(L + 14 * MBUF);
    const int tid = tidx(), lane = tid & 63, wave = tid >> 6, fr = lane & 15, fq = lane >> 4;
    const int tm = wave >> 1, tn0 = (wave & 1) * 2;
    const int m0 = tm * 16;
    const int t = tid >> 3, i0 = (tid & 7) * 8;
    v4u lw4n, r4n, v4n, kd4n, kk4n, bb4n;
#define R1_LOAD(it_) do { const int c_ = (it_) & 127, h_ = ((it_) >> 7) & 7, n_ = (it_) >> 10, dir_ = n_ >> 1, b_ = n_ & 1; \
        const int pos_ = dir_ ? (S - 1 - (c_ * 64 + t)) : (c_ * 64 + t); const size_t tok_ = (size_t)b_ * S + pos_; const size_t ch_ = (size_t)h_ * 64 + i0; \
        lw4n = *(const v4u*)(LWg + ((size_t)dir_ * T + tok_) * 512 + ch_); r4n = *(const v4u*)(RVg + tok_ * D + ch_); v4n = *(const v4u*)(RVg + tok_ * D + 512 + ch_); \
        kd4n = *(const v4u*)(KDg + ((size_t)dir_ * T + tok_) * 512 + ch_); kk4n = *(const v4u*)(KKg + tok_ * 512 + ch_); bb4n = *(const v4u*)(BBg + ((size_t)dir_ * T + tok_) * 512 + ch_); } while (0)
    if ((int)blockIdx.x < 4096) R1_LOAD((int)blockIdx.x);
    for (int item = blockIdx.x; item < 4096; item += gridDim.x) {
        const v4u lw4 = lw4n, r4 = r4n, v4 = v4n, kd4 = kd4n, kk4 = kk4n, bb4 = bb4n;
        float lw[8], Lin[8];
#pragma unroll
        for (int q = 0; q < 4; ++q) { lw[2 * q] = bflo(lw4[q]); lw[2 * q + 1] = bfhi(lw4[q]); }
#pragma unroll
        for (int j = 0; j < 8; ++j) { float x = lw[j];
#pragma unroll
            for (int o = 8; o < 64; o <<= 1) { const float y = __shfl_up(x, o); if (lane >= o) x += y; }
            Lin[j] = x; }
        __syncthreads();
        if (lane >= 56) {
#pragma unroll
            for (int j = 0; j < 8; ++j) LWs[64 + wave * 64 + i0 + j] = Lin[j]; }
        __syncthreads();
        {
            float off[8];
#pragma unroll
            for (int j = 0; j < 8; ++j) off[j] = 0.f;
            for (int w = 0; w < 8; ++w) { if (w < wave) {
#pragma unroll
                for (int j = 0; j < 8; ++j) off[j] += LWs[64 + w * 64 + i0 + j]; } }
#pragma unroll
            for (int j = 0; j < 8; ++j) Lin[j] += off[j];
            if (t == 63) {
#pragma unroll
                for (int j = 0; j < 8; ++j) LWs[i0 + j] = Lin[j]; }
            float at_[8], rt_[8], bt_[8], kt_[8];
#pragma unroll
            for (int q = 0; q < 4; ++q) {
#pragma unroll
                for (int e = 0; e < 2; ++e) { const int j = 2 * q + e;
                    const float ein = __expf(Lin[j]), einv = __expf(-Lin[j]), eex = __expf(Lin[j] - lw[j]);
                    const float kkv = e ? bfhi(kk4[q]) : bflo(kk4[q]), rv_ = e ? bfhi(r4[q]) : bflo(r4[q]), bbv = e ? bfhi(bb4[q]) : bflo(bb4[q]), kdv = e ? bfhi(kd4[q]) : bflo(kd4[q]);
                    at_[j] = -kkv * eex; rt_[j] = rv_ * ein; bt_[j] = bbv * einv; kt_[j] = kdv * einv; }
            }
            v4u wa, wb, wk, w;
            wa.x = pk2(at_[0], at_[1]); wa.y = pk2(at_[2], at_[3]); wa.z = pk2(at_[4], at_[5]); wa.w = pk2(at_[6], at_[7]); *(LAS v4u*)(SL(0) + t * MROW + i0 * 2) = wa;
            w.x = pk2(rt_[0], rt_[1]); w.y = pk2(rt_[2], rt_[3]); w.z = pk2(rt_[4], rt_[5]); w.w = pk2(rt_[6], rt_[7]); *(LAS v4u*)(SL(2) + t * MROW + i0 * 2) = w;
            wb.x = pk2(bt_[0], bt_[1]); wb.y = pk2(bt_[2], bt_[3]); wb.z = pk2(bt_[4], bt_[5]); wb.w = pk2(bt_[6], bt_[7]); *(LAS v4u*)(SL(3) + t * MROW + i0 * 2) = wb;
            wk.x = pk2(kt_[0], kt_[1]); wk.y = pk2(kt_[2], kt_[3]); wk.z = pk2(kt_[4], kt_[5]); wk.w = pk2(kt_[6], kt_[7]); *(LAS v4u*)(SL(5) + t * MROW + i0 * 2) = wk;
#pragma unroll
            for (int q = 0; q < 4; ++q) {
                LAS unsigned char* pT = (LAS unsigned char*)0 + (i0 + 2 * q) * MROW + t * 2;
                *(LAS unsigned short*)(SL(1) + (size_t)pT) = (unsigned short)(wa[q] & 0xffffu); *(LAS unsigned short*)(SL(1) + (size_t)pT + MROW) = (unsigned short)(wa[q] >> 16);
                *(LAS unsigned short*)(SL(4) + (size_t)pT) = (unsigned short)(wb[q] & 0xffffu); *(LAS unsigned short*)(SL(4) + (size_t)pT + MROW) = (unsigned short)(wb[q] >> 16);
                *(LAS unsigned short*)(SL(6) + (size_t)pT) = (unsigned short)(wk[q] & 0xffffu); *(LAS unsigned short*)(SL(6) + (size_t)pT + MROW) = (unsigned short)(wk[q] >> 16);
                *(LAS unsigned short*)(SL(7) + (size_t)pT) = (unsigned short)(v4[q] & 0xffffu); *(LAS unsigned short*)(SL(7) + (size_t)pT + MROW) = (unsigned short)(v4[q] >> 16);
            }
        }
        if (item + (int)gridDim.x < 4096) R1_LOAD(item + (int)gridDim.x);
        __syncthreads();
        f32x4 Tacc[2];
        {
            bf16x8 la[2], lr[2];
#pragma unroll
            for (int ks = 0; ks < 2; ++ks) { la[ks] = frag_rm(SL(0), m0, 32 * ks, fr, fq); lr[ks] = frag_rm(SL(2), m0, 32 * ks, fr, fq); }
#pragma unroll
            for (int q = 0; q < 2; ++q) {
                const int n0 = (tn0 + q) * 16;
                f32x4 cab = {0.f, 0.f, 0.f, 0.f}, cak = cab, crb = cab, crk = cab;
#pragma unroll
                for (int ks = 0; ks < 2; ++ks) {
                    const bf16x8 rb_ = frag_rm(SL(3), n0, 32 * ks, fr, fq), rk_ = frag_rm(SL(5), n0, 32 * ks, fr, fq);
                    MMA16(cab, la[ks], rb_); MMA16(cak, la[ks], rk_); MMA16(crb, lr[ks], rb_); MMA16(crk, lr[ks], rk_);
                }
                const int tt = m0 + fr;
#pragma unroll
                for (int j = 0; j < 4; ++j) { const int ss = n0 + 4 * fq + j;
                    if (!(ss < tt)) { cab[j] = 0.f; cak[j] = 0.f; }
                    if (!(ss <= tt)) { crb[j] = 0.f; crk[j] = 0.f; } }
                tile_store_bf16(SL(8), m0, n0, fr, fq, cab); tile_store_bf16_T(SL(9), m0, n0, fr, fq, cab);
                tile_store_bf16(SL(10), m0, n0, fr, fq, cak);
                tile_store_bf16(SL(11), m0, n0, fr, fq, crb); tile_store_bf16(SL(12), m0, n0, fr, fq, crk);
#pragma unroll
                for (int j = 0; j < 4; ++j) cab[j] += ((n0 + 4 * fq + j) == tt) ? 1.f : 0.f;
                Tacc[q] = cab;
                tile_store_bf16(SL(13), m0, n0, fr, fq, cab);
            }
        }
        __syncthreads();
        {
            bf16x8 lk[2], ln_[2];
#pragma unroll
            for (int ks = 0; ks < 2; ++ks) { lk[ks] = frag_rm(SL(10), m0, 32 * ks, fr, fq); ln_[ks] = frag_rm(SL(8), m0, 32 * ks, fr, fq); }
#pragma unroll
            for (int q = 0; q < 2; ++q) {
                const int n0 = (tn0 + q) * 16;
                f32x4 cw = {0.f, 0.f, 0.f, 0.f}, cn = cw;
#pragma unroll
                for (int ks = 0; ks < 2; ++ks) { MMA16(cw, lk[ks], frag_rm(SL(7), n0, 32 * ks, fr, fq)); MMA16(cn, ln_[ks], frag_rm(SL(9), n0, 32 * ks, fr, fq)); }
                tile_store_bf16_T(SL(0), m0, n0, fr, fq, cw);
                tile_store_bf16(SL(3), m0, n0, fr, fq, cn); tile_store_bf16_T(SL(5), m0, n0, fr, fq, cn);
            }
        }
        __syncthreads();
#pragma unroll
        for (int k = 1; k <= 5; ++k) {
            LAS unsigned char* Nk = (k & 1) ? SL(3) : SL(8); LAS unsigned char* NkT = (k & 1) ? SL(5) : SL(9);
            LAS unsigned char* Nn = (k & 1) ? SL(8) : SL(3); LAS unsigned char* NnT = (k & 1) ? SL(9) : SL(5);
            LAS unsigned char* Tk = (k & 1) ? SL(13) : SL(10); LAS unsigned char* Tn = (k & 1) ? SL(10) : SL(13);
            bf16x8 lt[2], ln_[2];
#pragma unroll
            for (int ks = 0; ks < 2; ++ks) { lt[ks] = frag_rm(Tk, m0, 32 * ks, fr, fq); ln_[ks] = frag_rm(Nk, m0, 32 * ks, fr, fq); }
#pragma unroll
            for (int q = 0; q < 2; ++q) {
                const int n0 = (tn0 + q) * 16;
                f32x4 cn = {0.f, 0.f, 0.f, 0.f};
#pragma unroll
                for (int ks = 0; ks < 2; ++ks) { const bf16x8 rn = frag_rm(NkT, n0, 32 * ks, fr, fq); MMA16(Tacc[q], lt[ks], rn); if (k < 5) MMA16(cn, ln_[ks], rn); }
                tile_store_bf16(Tn, m0, n0, fr, fq, Tacc[q]);
                if (k < 5) { tile_store_bf16(Nn, m0, n0, fr, fq, cn); tile_store_bf16_T(NnT, m0, n0, fr, fq, cn); }
            }
            __syncthreads();
        }
        {
            bf16x8 lt[2];
#pragma unroll
            for (int ks = 0; ks < 2; ++ks) lt[ks] = frag_rm(SL(10), m0, 32 * ks, fr, fq);
#pragma unroll
            for (int q = 0; q < 2; ++q) {
                const int n0 = (tn0 + q) * 16;
                f32x4 ca = {0.f, 0.f, 0.f, 0.f}, cu = ca;
#pragma unroll
                for (int ks = 0; ks < 2; ++ks) { MMA16(ca, lt[ks], frag_rm(SL(1), n0, 32 * ks, fr, fq)); MMA16(cu, lt[ks], frag_rm(SL(0), n0, 32 * ks, fr, fq)); }
                tile_store_bf16_T(SL(8), m0, n0, fr, fq, ca); tile_store_bf16_T(SL(9), m0, n0, fr, fq, cu);
            }
        }
        __syncthreads();
        {
            bf16x8 lrb[2], lrk[2], lb[2], lkt[2];
#pragma unroll
            for (int ks = 0; ks < 2; ++ks) { lrb[ks] = frag_rm(SL(11), m0, 32 * ks, fr, fq); lrk[ks] = frag_rm(SL(12), m0, 32 * ks, fr, fq);
                lb[ks] = frag_rm(SL(4), m0, 32 * ks, fr, fq); lkt[ks] = frag_rm(SL(6), m0, 32 * ks, fr, fq); }
            const float wc = __expf(LWs[m0 + fr]);
#pragma unroll
            for (int q = 0; q < 2; ++q) {
                const int n0 = (tn0 + q) * 16;
                f32x4 crh = {0.f, 0.f, 0.f, 0.f}, cyl = crh, cp = crh, cq = crh;
#pragma unroll
                for (int ks = 0; ks < 2; ++ks) {
                    const bf16x8 ra = frag_rm(SL(8), n0, 32 * ks, fr, fq), ru = frag_rm(SL(9), n0, 32 * ks, fr, fq), rv = frag_rm(SL(7), n0, 32 * ks, fr, fq);
                    MMA16(crh, lrb[ks], ra); MMA16(cyl, lrb[ks], ru); MMA16(cyl, lrk[ks], rv);
                    MMA16(cp, lb[ks], ra); MMA16(cq, lb[ks], ru); MMA16(cq, lkt[ks], rv);
                }
                const size_t o = (size_t)item * 4096 + (size_t)(m0 + fr) * 64 + n0 + 4 * fq;
                { const LAS unsigned short* rp = (const LAS unsigned short*)(SL(2) + (m0 + fr) * MROW + (n0 + 4 * fq) * 2);
#pragma unroll
                  for (int j = 0; j < 4; ++j) crh[j] += __uint_as_float(((unsigned)rp[j]) << 16); }
                { v2u w; w.x = pk2(crh[0], crh[1]); w.y = pk2(crh[2], crh[3]); *(v2u*)(RH + o) = w; }
                *(f32x4*)(YL + o) = cyl;
#pragma unroll
                for (int j = 0; j < 4; ++j) { cp[j] = wc * (cp[j] + (((n0 + 4 * fq + j) == (m0 + fr)) ? 1.f : 0.f)); cq[j] *= wc; }
                { v2u w; w.x = pk2(cp[0], cp[1]); w.y = pk2(cp[2], cp[3]); *(v2u*)(PT + o) = w; }
                { v2u w; w.x = pk2(cq[0], cq[1]); w.y = pk2(cq[2], cq[3]); *(v2u*)(QT + o) = w; }
            }
        }
    }
#undef SL
}
#undef R1_LOAD

__device__ __forceinline__ bf16x8 pack_acc8(const f32x16& x, int s) {
    v4u p; p.x = pk2(x[8 * s], x[8 * s + 1]); p.y = pk2(x[8 * s + 2], x[8 * s + 3]); p.z = pk2(x[8 * s + 4], x[8 * s + 5]); p.w = pk2(x[8 * s + 6], x[8 * s + 7]);
    return __builtin_bit_cast(bf16x8, p);
}
__device__ __forceinline__ void scan_r2(const bf16_t* PT, const bf16_t* QT, bf16_t* S0, unsigned char* lds_raw) {
    LAS unsigned char* L = (LAS unsigned char*)lds_raw;
    constexpr int SLOT_B = MBUF + 8192;
    const int tid = tidx(), lane = tid & 63, wave = tid >> 6;
    const int r = lane & 31, h2 = lane >> 5, jb = wave;
    f32x16 st[2];
#pragma unroll
    for (int ib = 0; ib < 2; ++ib)
#pragma unroll
        for (int g = 0; g < 16; ++g) st[ib][g] = 0.f;
    const size_t item0 = (size_t)blockIdx.x * 128;
    v4u stage[16];
#pragma unroll
    for (int q = 0; q < 16; ++q) { const int p = tid + 512 * q, cc = p >> 10, w = p & 1023, mat = w >> 9, idx = w & 511;
        stage[q] = *(const v4u*)((mat ? QT : PT) + (item0 + cc) * 4096 + idx * 8); }
    for (int grp = 0; grp < 16; ++grp) {
        __syncthreads();
#pragma unroll
        for (int q = 0; q < 16; ++q) { const int p = tid + 512 * q, cc = p >> 10, w = p & 1023, mat = w >> 9, idx = w & 511;
            *(LAS v4u*)(L + cc * SLOT_B + (mat ? (MBUF + idx * 16) : ((idx >> 3) * MROW + (idx & 7) * 16))) = stage[q]; }
        __syncthreads();
        if (grp < 15) {
#pragma unroll
            for (int q = 0; q < 16; ++q) { const int p = tid + 512 * q, cc = p >> 10, w = p & 1023, mat = w >> 9, idx = w & 511;
                stage[q] = *(const v4u*)((mat ? QT : PT) + (item0 + (grp + 1) * 8 + cc) * 4096 + idx * 8); }
        }
        if (wave < 2) {
#pragma unroll 1
            for (int cc = 0; cc < 8; ++cc) {
                const size_t item = item0 + grp * 8 + cc;
                const LAS unsigned char* Pm = L + cc * SLOT_B; const LAS unsigned char* Qm = Pm + MBUF;
                bf16_t* sp = S0 + item * 4096 + (size_t)(32 * jb + r) * 64;
#pragma unroll
                for (int ib = 0; ib < 2; ++ib)
#pragma unroll
                    for (int g = 0; g < 4; ++g) { v2u w; w.x = pk2(st[ib][4 * g], st[ib][4 * g + 1]); w.y = pk2(st[ib][4 * g + 2], st[ib][4 * g + 3]); *(v2u*)(sp + 32 * ib + 8 * g + 4 * h2) = w; }
                f32x16 nw[2];
#pragma unroll
                for (int ib = 0; ib < 2; ++ib)
#pragma unroll
                    for (int g = 0; g < 16; ++g) nw[ib][g] = __uint_as_float(((unsigned)*(const LAS unsigned short*)(Qm + (32 * ib + (g & 3) + 8 * (g >> 2) + 4 * h2) * 128 + (32 * jb + r) * 2)) << 16);
#pragma unroll
                for (int kb = 0; kb < 2; ++kb)
#pragma unroll
                    for (int s2 = 0; s2 < 2; ++s2) {
                        const bf16x8 bfr = pack_acc8(st[kb], s2);
#pragma unroll
                        for (int ib = 0; ib < 2; ++ib) {
                            const LAS unsigned char* ap = Pm + (32 * ib + r) * MROW + (32 * kb + 16 * s2 + 4 * h2) * 2;
                            const v2u lo = *(const LAS v2u*)ap, hi = *(const LAS v2u*)(ap + 16);
                            v4u av; av.x = lo.x; av.y = lo.y; av.z = hi.x; av.w = hi.y;
                            nw[ib] = __builtin_amdgcn_mfma_f32_32x32x16_bf16(__builtin_bit_cast(bf16x8, av), bfr, nw[ib], 0, 0, 0);
                        }
                    }
                st[0] = nw[0]; st[1] = nw[1];
            }
        }
    }
}
__device__ __forceinline__ void scan_r3(const bf16_t* RH, const float* YL, const bf16_t* S0, const bf16_t* RVg, const bf16_t* KDg, const bf16_t* Gg,
                                        const float* r_k, const float* lng, const float* lnb, bf16_t* Y) {
    const int tid = tidx(), lane = tid & 63, wave = tid >> 6, fr = lane & 15, fq = lane >> 4;
    const int tmw = wave & 3;
    for (int it2 = blockIdx.x * 2 + (wave >> 2); it2 < 2048; it2 += gridDim.x * 2) {
        const int b = it2 >> 10, h = (it2 >> 7) & 7, pc = it2 & 127;
        f32x4 acc[4];
#pragma unroll
        for (int q = 0; q < 4; ++q) acc[q] = (f32x4){0.f, 0.f, 0.f, 0.f};
#pragma unroll 1
        for (int dirn = 0; dirn < 2; ++dirn) {
            const size_t item = (size_t)((dirn * 2 + b) * 8 + h) * 128 + (dirn ? 127 - pc : pc);
            const int row = dirn ? 63 - (16 * tmw + fr) : 16 * tmw + fr;
            const bf16_t* rp = RH + item * 4096 + (size_t)row * 64;
            bf16x8 lf[2];
#pragma unroll
            for (int ks = 0; ks < 2; ++ks) lf[ks] = *(const bf16x8*)(rp + 32 * ks + 8 * fq);
#pragma unroll
            for (int q = 0; q < 4; ++q) {
                const bf16_t* sp = S0 + item * 4096 + (size_t)(16 * q + fr) * 64;
#pragma unroll
                for (int ks = 0; ks < 2; ++ks) { const bf16x8 rf = *(const bf16x8*)(sp + 32 * ks + 8 * fq); MMA16(acc[q], lf[ks], rf); }
                acc[q] += *(const f32x4*)(YL + item * 4096 + (size_t)row * 64 + 16 * q + 4 * fq);
            }
        }
        float sm = 0.f;
#pragma unroll
        for (int q = 0; q < 4; ++q) sm += (acc[q][0] + acc[q][1]) + (acc[q][2] + acc[q][3]);
        sm += __shfl_xor(sm, 16); sm += __shfl_xor(sm, 32);
        const float mean = sm * (1.0f / 64.f);
        float sq = 0.f;
#pragma unroll
        for (int q = 0; q < 4; ++q)
#pragma unroll
            for (int j = 0; j < 4; ++j) { const float d = acc[q][j] - mean; sq += d * d; }
        sq += __shfl_xor(sq, 16); sq += __shfl_xor(sq, 32);
        const float rstd = rsqrtf(sq * (1.0f / 64.f) + 64e-5f);
        const size_t tok = (size_t)b * S + pc * 64 + 16 * tmw + fr;
        float bon = 0.f; f32x4 vv[4];
#pragma unroll
        for (int q = 0; q < 4; ++q) {
            const int c = h * 64 + 16 * q + 4 * fq;
            const v2u rw = *(const v2u*)(RVg + tok * D + c), k0 = *(const v2u*)(KDg + tok * 512 + c), k1 = *(const v2u*)(KDg + ((size_t)T + tok) * 512 + c), vw = *(const v2u*)(RVg + tok * D + 512 + c);
            const f32x4 rk4 = *(const f32x4*)(r_k + c);
            vv[q] = (f32x4){bflo(vw.x), bfhi(vw.x), bflo(vw.y), bfhi(vw.y)};
            bon += bflo(rw.x) * (bflo(k0.x) + bflo(k1.x)) * rk4[0] + bfhi(rw.x) * (bfhi(k0.x) + bfhi(k1.x)) * rk4[1] + bflo(rw.y) * (bflo(k0.y) + bflo(k1.y)) * rk4[2] + bfhi(rw.y) * (bfhi(k0.y) + bfhi(k1.y)) * rk4[3];
        }
        bon += __shfl_xor(bon, 16); bon += __shfl_xor(bon, 32);
#pragma unroll
        for (int q = 0; q < 4; ++q) {
            const int c = h * 64 + 16 * q + 4 * fq;
            const v2u gw_ = *(const v2u*)(Gg + tok * 512 + c); const f32x4 g4 = {bflo(gw_.x), bfhi(gw_.x), bflo(gw_.y), bfhi(gw_.y)}, lg = *(const f32x4*)(lng + c), lb = *(const f32x4*)(lnb + c);
            float o[4];
#pragma unroll
            for (int j = 0; j < 4; ++j) o[j] = ((acc[q][j] - mean) * rstd * lg[j] + lb[j] + bon * vv[q][j]) * g4[j];
            v2u w; w.x = pk2(o[0], o[1]); w.y = pk2(o[2], o[3]);
            *(v2u*)(Y + tok * D + 512 + c) = w;
        }
    }
}


__device__ __forceinline__ bf16x8 pack8(float a0, float a1, float a2, float a3, float a4, float a5, float a6, float a7) {
    v4u p; p.x = pk2(a0, a1); p.y = pk2(a2, a3); p.z = pk2(a4, a5); p.w = pk2(a6, a7);
    return __builtin_bit_cast(bf16x8, p);
}
#define MMA32(acc, af, bf_) acc = __builtin_amdgcn_mfma_f32_32x32x16_bf16(af, bf_, acc, 0, 0, 0)
__device__ __forceinline__ void xattn_mfma(const bf16_t* Qb, const bf16_t* Kb, const bf16_t* Vt, bf16_t* Y, unsigned char* lds_raw) {
    LAS unsigned char* L = (LAS unsigned char*)lds_raw;
    constexpr int KRS = 528, VRS = 520;
    const int tid = tidx(), lane = tid & 63, wave = tid >> 6, r = lane & 31, h2 = lane >> 5;
    for (int it = blockIdx.x; it < 256; it += gridDim.x) {
        const int qblk = it & 31, h = (it >> 5) & 3, b = it >> 7;
        const size_t tok = (size_t)b * S + qblk * 256 + wave * 32 + r;
        bf16x8 qf[16];
#pragma unroll
        for (int ks = 0; ks < 16; ++ks) qf[ks] = *(const bf16x8*)(Qb + tok * D + h * 256 + 16 * ks + 8 * h2);
        __syncthreads();
#pragma unroll
        for (int hf = 0; hf < 2; ++hf) {
            v4u stg[8];
#pragma unroll
            for (int q = 0; q < 8; ++q) { const int p = tid + 512 * (8 * hf + q); stg[q] = *(const v4u*)(Kb + (size_t)(b * MEM + (p >> 5)) * 1024 + h * 256 + (p & 31) * 8); }
#pragma unroll
            for (int q = 0; q < 8; ++q) { const int p = tid + 512 * (8 * hf + q); *(LAS v4u*)(L + (p >> 5) * KRS + (p & 31) * 16) = stg[q]; }
        }
        __syncthreads();
        float mx = -3.0e38f;
#pragma unroll 1
        for (int kb = 0; kb < 8; ++kb) {
            f32x16 st;
#pragma unroll
            for (int g = 0; g < 16; ++g) st[g] = 0.f;
            const LAS unsigned char* kp = L + (32 * kb + r) * KRS + 16 * h2;
#pragma unroll
            for (int ks = 0; ks < 16; ++ks) { const bf16x8 kf = *(const LAS bf16x8*)(kp + 32 * ks); MMA32(st, kf, qf[ks]); }
#pragma unroll
            for (int g = 0; g < 16; ++g) mx = fmaxf(mx, st[g]);
        }
        mx = fmaxf(mx, __shfl_xor(mx, 32));
        const float cs = 0.0625f * 1.4426950408889634f;
        float l = 0.f;
        bf16x8 pf[8][2];
#pragma unroll
        for (int kb = 0; kb < 8; ++kb) {
            f32x16 st;
#pragma unroll
            for (int g = 0; g < 16; ++g) st[g] = 0.f;
            const LAS unsigned char* kp = L + (32 * kb + r) * KRS + 16 * h2;
#pragma unroll
            for (int ks = 0; ks < 16; ++ks) { const bf16x8 kf = *(const LAS bf16x8*)(kp + 32 * ks); MMA32(st, kf, qf[ks]); }
#pragma unroll
            for (int g = 0; g < 16; ++g) { st[g] = __builtin_amdgcn_exp2f((st[g] - mx) * cs); l += st[g]; }
#pragma unroll
            for (int s2 = 0; s2 < 2; ++s2) pf[kb][s2] = pack8(st[8 * s2], st[8 * s2 + 1], st[8 * s2 + 2], st[8 * s2 + 3], st[8 * s2 + 4], st[8 * s2 + 5], st[8 * s2 + 6], st[8 * s2 + 7]);
            __builtin_amdgcn_sched_barrier(0);
        }
        l += __shfl_xor(l, 32);
        const float inv = 1.0f / l;
        __syncthreads();
#pragma unroll
        for (int hf = 0; hf < 2; ++hf) {
            v4u stg[8];
#pragma unroll
            for (int q = 0; q < 8; ++q) { const int p = tid + 512 * (8 * hf + q); stg[q] = *(const v4u*)(Vt + ((size_t)(b * 1024 + h * 256 + (p >> 5))) * 256 + (p & 31) * 8); }
#pragma unroll
            for (int q = 0; q < 8; ++q) { const int p = tid + 512 * (8 * hf + q); LAS v2u* lp = (LAS v2u*)(L + (p >> 5) * VRS + (p & 31) * 16);
                v2u a_; a_.x = stg[q].x; a_.y = stg[q].y; lp[0] = a_; a_.x = stg[q].z; a_.y = stg[q].w; lp[1] = a_; }
        }
        __syncthreads();
#pragma unroll 1
        for (int db = 0; db < 8; ++db) {
            f32x16 acc;
#pragma unroll
            for (int g = 0; g < 16; ++g) acc[g] = 0.f;
            const LAS unsigned char* vp = L + (32 * db + r) * VRS + 8 * h2;
#pragma unroll
            for (int kb = 0; kb < 8; ++kb)
#pragma unroll
                for (int s2 = 0; s2 < 2; ++s2) {
                    const v2u lo = *(const LAS v2u*)(vp + (32 * kb + 16 * s2) * 2), hi = *(const LAS v2u*)(vp + (32 * kb + 16 * s2 + 8) * 2);
                    v4u av; av.x = lo.x; av.y = lo.y; av.z = hi.x; av.w = hi.y;
                    MMA32(acc, __builtin_bit_cast(bf16x8, av), pf[kb][s2]);
                }
            int tl_ = tid; asm volatile("" : "+v"(tl_));
            bf16_t* yp = Y + ((size_t)b * S + qblk * 256 + (tl_ >> 6) * 32 + (tl_ & 31)) * D + h * 256 + 32 * db + 4 * ((tl_ >> 5) & 1);
#pragma unroll
            for (int g = 0; g < 4; ++g) { v2u w; w.x = pk2(acc[4 * g] * inv, acc[4 * g + 1] * inv); w.y = pk2(acc[4 * g + 2] * inv, acc[4 * g + 3] * inv); *(v2u*)(yp + 8 * g) = w; }
        }
    }
}
template <bool F32OUT>
__device__ __forceinline__ void combine_norm(float* X, const bf16_t* YE, const int* SLOT, const float* g, bf16_t* Hout, float* Fout) {
    const int tix_ = tidx(); const int lane = tix_ & 63, gw = blockIdx.x * 8 + (tix_ >> 6), ngw = gridDim.x * 8;
    for (int m = gw; m < T; m += ngw) {
        float4* xr = (float4*)(X + (size_t)m * D);
        float4 v[4];
#pragma unroll
        for (int j = 0; j < 4; ++j) v[j] = xr[lane + 64 * j];
        const int myslot = SLOT[(size_t)m * NE + (lane & 15)];
#pragma unroll
        for (int e = 0; e < 16; ++e) {
            const int row = __builtin_amdgcn_readlane(myslot, e);
            if (row >= 0) {
                const v2u* yp = (const v2u*)(YE + (size_t)row * D);
#pragma unroll
                for (int j = 0; j < 4; ++j) { const v2u w = yp[lane + 64 * j];
                    v[j].x += __uint_as_float(w.x << 16); v[j].y += __uint_as_float(w.x & 0xffff0000u); v[j].z += __uint_as_float(w.y << 16); v[j].w += __uint_as_float(w.y & 0xffff0000u); }
            }
        }
        float s = 0.f;
#pragma unroll
        for (int j = 0; j < 4; ++j) { if (!F32OUT) xr[lane + 64 * j] = v[j]; s += v[j].x * v[j].x + v[j].y * v[j].y + v[j].z * v[j].z + v[j].w * v[j].w; }
        const float r = rsqrtf(wave_sum(s) * (1.0f / D) + 1e-6f);
#pragma unroll
        for (int j = 0; j < 4; ++j) { const float4 gg = ((const float4*)g)[lane + 64 * j];
            if (F32OUT) ((float4*)(Fout + (size_t)m * D))[lane + 64 * j] = make_float4(v[j].x * r * gg.x, v[j].y * r * gg.y, v[j].z * r * gg.z, v[j].w * r * gg.w);
            else { v2u w; w.x = pk2(v[j].x * r * gg.x, v[j].y * r * gg.y); w.y = pk2(v[j].z * r * gg.z, v[j].w * r * gg.w); ((v2u*)(Hout + (size_t)m * D))[lane + 64 * j] = w; } }
    }
}


template <int NK, bool SINK>
__device__ __forceinline__ void attn_block(const bf16_t* Qh, const bf16_t* Kh, const bf16_t* Vh, int dd, int Lr, int b, int rho, int q0b, float sink2,
                                           bf16_t* Odst, int ostride, float* lsedst, unsigned char* lds_raw) {
    constexpr int NKEY = 256 + 64 * NK, KRS = 144, VRS = NKEY * 2 + 8;
    LAS unsigned char* Ks = (LAS unsigned char*)lds_raw; LAS unsigned char* Vs = Ks + NKEY * KRS;
    const int tid = tidx(), lane = tid & 63, wave = tid >> 6, r = lane & 31, h2 = lane >> 5;
    const int kq_base = q0b - 32 * NK;
    __syncthreads();
#pragma unroll
    for (int i = 0; i < NKEY * 8 / 512; ++i) {
        const int p = tid + 512 * i, row = p >> 3, piece = p & 7, kq = kq_base + row;
        if (kq >= 0 && kq < Lr) {
            const size_t tokk = (size_t)b * S + (size_t)kq * dd + rho;
            const v4u kx = *(const v4u*)(Kh + tokk * 64 + piece * 8), vx = *(const v4u*)(Vh + tokk * 64 + piece * 8);
            *(LAS v4u*)(Ks + row * KRS + piece * 16) = kx;
            LAS unsigned char* vp = Vs + (piece * 8) * VRS + row * 2;
#pragma unroll
            for (int e = 0; e < 4; ++e) { *(LAS unsigned short*)(vp + (2 * e) * VRS) = (unsigned short)(vx[e] & 0xffffu); *(LAS unsigned short*)(vp + (2 * e + 1) * VRS) = (unsigned short)(vx[e] >> 16); }
        }
    }
    const int q0 = q0b + 32 * wave;
    const size_t qtok = (size_t)b * S + (size_t)(q0 + r) * dd + rho;
    bf16x8 qf[4];
#pragma unroll
    for (int ks = 0; ks < 4; ++ks) qf[ks] = *(const bf16x8*)(Qh + qtok * 64 + 16 * ks + 8 * h2);
    __syncthreads();
    f32x16 o[2];
#pragma unroll
    for (int db = 0; db < 2; ++db)
#pragma unroll
        for (int g = 0; g < 16; ++g) o[db][g] = 0.f;
    float m = SINK ? sink2 : -1.0e30f, l = SINK ? 1.f : 0.f;
    const int kb_lo = max(-NK, -(q0 >> 5)), kb_hi = min(NK, (Lr - 32 - q0) >> 5);
#pragma unroll 1
    for (int kb = kb_lo; kb <= kb_hi; ++kb) {
        const int kw0 = 32 * (wave + kb + NK);
        f32x16 st;
#pragma unroll
        for (int g = 0; g < 16; ++g) st[g] = 0.f;
        const LAS unsigned char* kp = Ks + (kw0 + r) * KRS + 16 * h2;
#pragma unroll
        for (int ks = 0; ks < 4; ++ks) { const bf16x8 kf = *(const LAS bf16x8*)(kp + 32 * ks); MMA32(st, kf, qf[ks]); }
        if (kb == -NK || kb == NK) {
#pragma unroll
            for (int g = 0; g < 16; ++g) { const int cr = (g & 3) + 8 * (g >> 2) + 4 * h2; const bool ok = (kb < 0) ? (cr >= r) : (cr <= r); st[g] = ok ? st[g] : -1.0e30f; }
        }
        float bm = st[0];
#pragma unroll
        for (int g = 1; g < 16; ++g) bm = fmaxf(bm, st[g]);
        bm = fmaxf(bm, __shfl_xor(bm, 32));
        const float mn = fmaxf(m, bm), al = __builtin_amdgcn_exp2f(m - mn);
        float ls = 0.f;
#pragma unroll
        for (int g = 0; g < 16; ++g) { st[g] = __builtin_amdgcn_exp2f(st[g] - mn); ls += st[g]; }
        ls += __shfl_xor(ls, 32);
        l = l * al + ls; m = mn;
#pragma unroll
        for (int db = 0; db < 2; ++db)
#pragma unroll
            for (int g = 0; g < 16; ++g) o[db][g] *= al;
        bf16x8 pf[2];
#pragma unroll
        for (int s2 = 0; s2 < 2; ++s2) pf[s2] = pack8(st[8 * s2], st[8 * s2 + 1], st[8 * s2 + 2], st[8 * s2 + 3], st[8 * s2 + 4], st[8 * s2 + 5], st[8 * s2 + 6], st[8 * s2 + 7]);
#pragma unroll
        for (int db = 0; db < 2; ++db) {
            const LAS unsigned char* vp = Vs + (32 * db + r) * VRS + (kw0 + 4 * h2) * 2;
#pragma unroll
            for (int s2 = 0; s2 < 2; ++s2) {
                const v2u lo = *(const LAS v2u*)(vp + 32 * s2), hi = *(const LAS v2u*)(vp + 32 * s2 + 16);
                v4u av; av.x = lo.x; av.y = lo.y; av.z = hi.x; av.w = hi.y;
                MMA32(o[db], __builtin_bit_cast(bf16x8, av), pf[s2]);
            }
        }
    }
    const float inv = 1.0f / l;
#pragma unroll
    for (int db = 0; db < 2; ++db) {
        bf16_t* op = Odst + qtok * ostride + 32 * db + 4 * h2;
#pragma unroll
        for (int g = 0; g < 4; ++g) { v2u w; w.x = pk2(o[db][4 * g] * inv, o[db][4 * g + 1] * inv); w.y = pk2(o[db][4 * g + 2] * inv, o[db][4 * g + 3] * inv); *(v2u*)(op + 8 * g) = w; }
    }
    if (lsedst != nullptr && h2 == 0) lsedst[qtok * 8] = (m + __builtin_amdgcn_logf(l)) * 0.6931471805599453f;
}

__device__ __forceinline__ void attn_phase_even(const bf16_t* QhA, const bf16_t* KhA, const bf16_t* VhA, const bf16_t* QhB, const bf16_t* KhB, const bf16_t* VhB,
                                                const float* sink, bf16_t* OA, float* LSE, bf16_t* Y, unsigned char* lds_raw) {
    for (int it = blockIdx.x; it < 2048; it += gridDim.x) {
        if (it < 512) {
            const int hq = it >> 6, rem2 = it & 63, b = rem2 >> 5, q0b = (rem2 & 31) * 256, kvh = hq >> 2;
            attn_block<4, true>(QhB + (size_t)hq * T * 64, KhB + (size_t)kvh * T * 64, VhB + (size_t)kvh * T * 64, 1, S, b, 0, q0b, sink[hq] * 1.4426950408889634f,
                                Y + 512 + hq * 64, D, nullptr, lds_raw);
        } else {
            const int ita = it - 512, p = ita >> 9, rem = ita & 511, head = rem >> 6, rem2 = rem & 63, b = rem2 >> 5, rem3 = rem2 & 31;
            const int dd = p == 0 ? 1 : (p == 1 ? 4 : 16), bpr = 32 / dd, rho = rem3 / bpr, q0b = (rem3 % bpr) * 256;
            attn_block<2, false>(QhA + (size_t)head * T * 64, KhA + (size_t)head * T * 64, VhA + (size_t)head * T * 64, dd, S / dd, b, rho, q0b, 0.f,
                                 OA + (size_t)p * T * 512 + head * 64, 512, LSE + (size_t)p * T * 8 + head, lds_raw);
        }
    }
}
__device__ __forceinline__ void attn_combine(const bf16_t* OA, const float* LSE, bf16_t* Y) {
    const int gt = blockIdx.x * NTH + tidx(), ngt = gridDim.x * NTH;
    for (int i = gt; i < T * 64; i += ngt) {
        const int tok = i >> 6, head = (i >> 3) & 7, c8 = i & 7;
        const float l0 = LSE[(size_t)tok * 8 + head], l1 = LSE[((size_t)T + tok) * 8 + head], l2 = LSE[((size_t)2 * T + tok) * 8 + head];
        const float mx = fmaxf(l0, fmaxf(l1, l2));
        float w0 = __expf(l0 - mx), w1 = __expf(l1 - mx), w2 = __expf(l2 - mx);
        const float inv = 1.0f / (w0 + w1 + w2); w0 *= inv; w1 *= inv; w2 *= inv;
        const size_t off = (size_t)tok * 512 + head * 64 + c8 * 8;
        const v4u x0 = *(const v4u*)(OA + off), x1 = *(const v4u*)(OA + (size_t)T * 512 + off), x2 = *(const v4u*)(OA + (size_t)2 * T * 512 + off);
        v4u w;
#pragma unroll
        for (int q = 0; q < 4; ++q) {
            const float lo = w0 * __uint_as_float(x0[q] << 16) + w1 * __uint_as_float(x1[q] << 16) + w2 * __uint_as_float(x2[q] << 16);
            const float hi = w0 * __uint_as_float(x0[q] & 0xffff0000u) + w1 * __uint_as_float(x1[q] & 0xffff0000u) + w2 * __uint_as_float(x2[q] & 0xffff0000u);
            w[q] = pk2(lo, hi);
        }
        *(v4u*)(Y + (size_t)tok * D + head * 64 + c8 * 8) = w;
    }
}


__device__ __forceinline__ void odd_token_pass(const bf16_t* P, const float* mu, const float* k_k, const float* clg, const float* clb,
                                               bf16_t* VN, bf16_t* RV, bf16_t* KBf, bf16_t* KK, bf16_t* F5) {
    const int tix_ = tidx(); const int lane = tix_ & 63, gw = blockIdx.x * 8 + (tix_ >> 6), ngw = gridDim.x * 8;
    for (int tok = gw; tok < T; tok += ngw) {
        const int s = tok & (S - 1);
        const bf16_t* pr = P + (size_t)tok * ODD_PAD;
        {
            float ge[8]; float sm = 0.f;
#pragma unroll
            for (int jj = 0; jj < 4; ++jj) { const unsigned w = *(const unsigned*)(pr + 512 + 2 * lane + 128 * jj);
                ge[2 * jj] = gelu_tanh(__uint_as_float(w << 16)); ge[2 * jj + 1] = gelu_tanh(__uint_as_float(w & 0xffff0000u)); sm += ge[2 * jj] + ge[2 * jj + 1]; }
            const float mean = wave_sum(sm) * (1.0f / 512.f); float sq = 0.f;
#pragma unroll
            for (int j = 0; j < 8; ++j) { const float d = ge[j] - mean; sq += d * d; }
            const float rstd = rsqrtf(wave_sum(sq) * (1.0f / 512.f) + 1e-5f);
#pragma unroll
            for (int jj = 0; jj < 4; ++jj) { const int c = 2 * lane + 128 * jj; const float2 g2_ = *(const float2*)(clg + c), b2_ = *(const float2*)(clb + c);
                *(unsigned*)(VN + (size_t)tok * 512 + c) = pk2((ge[2 * jj] - mean) * rstd * g2_.x + b2_.x, (ge[2 * jj + 1] - mean) * rstd * g2_.y + b2_.y); }
        }
#pragma unroll
        for (int jj = 0; jj < 15; ++jj) {
            const int c = 2 * lane + 128 * jj;
            const unsigned wf = *(const unsigned*)(pr + 1024 + c);
            const unsigned wp = s > 0 ? *(const unsigned*)(pr + 1024 + c - ODD_PAD) : 0u;
            const unsigned wn = s < S - 1 ? *(const unsigned*)(pr + 1024 + c + ODD_PAD) : 0u;
            const float2 m0 = *(const float2*)(mu + c), m1 = *(const float2*)(mu + FD + c);
            const float f0 = __uint_as_float(wf << 16), f1 = __uint_as_float(wf & 0xffff0000u);
            const float x0 = f0 + m0.x * (__uint_as_float(wp << 16) - f0) + m1.x * (__uint_as_float(wn << 16) - f0);
            const float x1 = f1 + m0.y * (__uint_as_float(wp & 0xffff0000u) - f1) + m1.y * (__uint_as_float(wn & 0xffff0000u) - f1);
            if (jj < 4) *(unsigned*)(RV + (size_t)tok * D + c) = pk2(x0, x1);
            else if (jj < 8) {
                const int ck = c - 512;
                *(unsigned*)(KBf + (size_t)tok * 512 + ck) = pk2(x0, x1);
                const float2 kk_ = *(const float2*)(k_k + ck);
                const float a0_ = x0 * kk_.x, a1_ = x1 * kk_.y;
                float ss = a0_ * a0_ + a1_ * a1_;
#pragma unroll
                for (int o = 16; o >= 1; o >>= 1) ss += __shfl_xor(ss, o);
                const float inv = 1.0f / fmaxf(sqrtf(ss), 1e-12f);
                *(unsigned*)(KK + (size_t)tok * 512 + ck) = pk2(a0_ * inv, a1_ * inv);
            }
            else if (jj < 12) *(unsigned*)(RV + (size_t)tok * D + 512 + (c - 1024)) = pk2(x0, x1);
            else if (jj == 12) *(unsigned*)(F5 + (size_t)tok * 384 + (c - 1536)) = pk2(tanhf_(x0), tanhf_(x1));
            else if (jj == 13) *(unsigned*)(F5 + (size_t)tok * 384 + 128 + (c - 1664)) = pk2(x0, x1);
            else *(unsigned*)(F5 + (size_t)tok * 384 + 256 + (c - 1792)) = pk2(sigmoidf_(x0), sigmoidf_(x1));
        }
    }
}
__device__ __forceinline__ void gating_pass(const bf16_t* VN, const bf16_t* Wsb, const float* bsp, const bf16_t* P, bf16_t* Y, unsigned char* lds_raw) {
    LAS unsigned char* L = (LAS unsigned char*)lds_raw;
    constexpr int RS = 272;
    const int tid = tidx(), lane = tid & 63, wave = tid >> 6, fr = lane & 15, fq = lane >> 4;
    for (int it = blockIdx.x; it < 512; it += gridDim.x) {
        const int g = it & 3, chunk = it >> 2;
        __syncthreads();
        { const int j = tid >> 2, q4 = tid & 3;
          const v4u* gp = (const v4u*)(VN + (size_t)(chunk * 128 + j) * 512 + g * 128 + 32 * q4);
#pragma unroll
          for (int q = 0; q < 4; ++q) { const v4u x = gp[q];
#pragma unroll
              for (int e = 0; e < 4; ++e) { const int c = 32 * q4 + 8 * q + 2 * e;
                  *(LAS unsigned short*)(L + c * RS + 2 * j) = (unsigned short)(x[e] & 0xffffu); *(LAS unsigned short*)(L + (c + 1) * RS + 2 * j) = (unsigned short)(x[e] >> 16); } } }
        __syncthreads();
        bf16x8 lf[4];
#pragma unroll
        for (int ks = 0; ks < 4; ++ks) lf[ks] = *(const bf16x8*)(Wsb + (size_t)(g * 128 + 16 * wave + fr) * 128 + 32 * ks + 8 * fq);
        const int i = 16 * wave + fr; const size_t tok = (size_t)chunk * 128 + i;
        const float bias = bsp[g * 128 + i];
#pragma unroll
        for (int tn = 0; tn < 8; ++tn) {
            f32x4 acc = {0.f, 0.f, 0.f, 0.f};
#pragma unroll
            for (int ks = 0; ks < 4; ++ks) { const bf16x8 rf = *(const LAS bf16x8*)(L + (16 * tn + fr) * RS + (32 * ks + 8 * fq) * 2); MMA16(acc, lf[ks], rf); }
            const int c = g * 128 + 16 * tn + 4 * fq;
            const v2u uw = *(const v2u*)(P + tok * ODD_PAD + c);
            const float u0 = gelu_tanh(__uint_as_float(uw.x << 16)), u1 = gelu_tanh(__uint_as_float(uw.x & 0xffff0000u)), u2 = gelu_tanh(__uint_as_float(uw.y << 16)), u3 = gelu_tanh(__uint_as_float(uw.y & 0xffff0000u));
            v2u w; w.x = pk2(u0 * (acc[0] + bias), u1 * (acc[1] + bias)); w.y = pk2(u2 * (acc[2] + bias), u3 * (acc[3] + bias));
            *(v2u*)(Y + tok * D + c) = w;
        }
    }
}


__device__ __forceinline__ void router_pass(const float* X, const float* g, const float* WRT  , float* AFF, int* SLOT, bf16_t* H, unsigned char* lds_raw) {
    const int tix_ = tidx(); const int lane = tix_ & 63, wave = tix_ >> 6, fr = lane & 15, fq = lane >> 4;
    const int pair = wave >> 1, half = wave & 1;
    LAS float* xch = (LAS float*)lds_raw + pair * 512;
    for (int tile0 = blockIdx.x * 4; tile0 < T / 16; tile0 += gridDim.x * 4) {
        const int tile = tile0 + pair;
        const float* xr = X + (size_t)(tile * 16 + fr) * D + 4 * fq + 512 * half;
        const float* wr = WRT + (size_t)fr * D + 4 * fq + 512 * half;
        f32x4 acc = {0.f, 0.f, 0.f, 0.f}; float ss = 0.f;
#pragma unroll 8
        for (int s = 0; s < 32; ++s) {
            const f32x4 xa = *(const f32x4*)(xr + 16 * s), wb = *(const f32x4*)(wr + 16 * s);
            ss += (xa[0] * xa[0] + xa[1] * xa[1]) + (xa[2] * xa[2] + xa[3] * xa[3]);
#pragma unroll
            for (int c = 0; c < 4; ++c) acc = __builtin_amdgcn_mfma_f32_16x16x4f32(xa[c], wb[c], acc, 0, 0, 0);
        }
        ss += __shfl_xor(ss, 16); ss += __shfl_xor(ss, 32);
        __syncthreads();
        { LAS float* p = xch + half * 256 + lane * 4; p[0] = acc[0]; p[1] = acc[1]; p[2] = acc[2]; p[3] = acc[3]; }
        if (fq == 0) ((LAS float*)lds_raw + 2048 + pair * 32 + half * 16)[fr] = ss;
        __syncthreads();
        { const LAS float* p = xch + (half ^ 1) * 256 + lane * 4; acc[0] += p[0]; acc[1] += p[1]; acc[2] += p[2]; acc[3] += p[3]; }
        ss += ((const LAS float*)lds_raw + 2048 + pair * 32 + (half ^ 1) * 16)[fr];
        const float rstd = rsqrtf(ss * (1.0f / D) + 1e-6f);
        {
            float aff[4];
#pragma unroll
            for (int jj = 0; jj < 4; ++jj) {
                const float lg = acc[jj] * __shfl(rstd, 4 * fq + jj);
                float mx = lg;
#pragma unroll
                for (int o = 1; o < 16; o <<= 1) mx = fmaxf(mx, __shfl_xor(mx, o));
                const float e = expf(lg - mx); float den = e;
#pragma unroll
                for (int o = 1; o < 16; o <<= 1) den += __shfl_xor(den, o);
                aff[jj] = e / den;
            }
#pragma unroll
            for (int jj = 0; jj < 4; ++jj) { const size_t o = (size_t)(tile * 16 + 4 * fq + jj) * NE + fr; if ((fq >> 1) == half) { AFF[o] = aff[jj]; SLOT[o] = -1; } }
        }
#pragma unroll 4
        for (int tt = 0; tt < 8; ++tt) {
            const int t = 8 * half + tt;
            const float rs = __shfl(rstd, t);
            const f32x4* xp = (const f32x4*)(X + (size_t)(tile * 16 + t) * D); v2u* hp = (v2u*)(H + (size_t)(tile * 16 + t) * D);
#pragma unroll
            for (int j = 0; j < 4; ++j) { const f32x4 v = xp[lane + 64 * j], gg = ((const f32x4*)g)[lane + 64 * j];
                v2u w; w.x = pk2(v[0] * rs * gg[0], v[1] * rs * gg[1]); w.y = pk2(v[2] * rs * gg[2], v[3] * rs * gg[3]); hp[lane + 64 * j] = w; }
        }
    }
}

#define IN(k) (lo <= (k) && (k) < hi)
#define REP_LOOP for (int rep_ = 0, nrep_ = ((ph == PROBE_PHASE) ? PROBE_REP : 1); rep_ < nrep_; ++rep_)
#define SEAM(k) do { if (IN(k) && IN((k) + 1)) xcd_barrier(bar); } while (0)
#define PROLOG \
    const int tid = tidx(), lane = tid & 63, wave = tid >> 6; \
    const int bid = blockIdx.x, nb = gridDim.x; \
    const int gw = bid * 8 + wave, ngw = nb * 8; \
    const int gt = bid * NTH + tid, ngt = nb * NTH; \
    (void)gt; (void)ngt; (void)gw; (void)ngw; (void)lane; (void)wave; \
    unsigned char* ws = a.ws; \
    const int lo = a.lo, hi = a.hi; \
    float* ldsf = (float*)lds_raw; (void)ldsf; \
    PG8_LAS unsigned char* ldsp = (PG8_LAS unsigned char*)lds_raw; (void)ldsp; \
    const float* x_in = a.in[0]; const float* mem = a.in[1]; (void)x_in; (void)mem; \
    float* ropec = (float*)(ws + WS_ROPE); float* ropes = ropec + S * 32; (void)ropec; (void)ropes; \
    float* AFF = (float*)(ws + WS_AFF); int* TOK = (int*)(ws + WS_TOK); float* GATE = (float*)(ws + WS_GATE); \
    float* X = (float*)(ws + WS_X); bf16_t* H = (bf16_t*)(ws + WS_H); bf16_t* P = (bf16_t*)(ws + WS_P); \
    bf16_t* Y = (bf16_t*)(ws + WS_Y); bf16_t* Q = (bf16_t*)(ws + WS_Q); bf16_t* KV = (bf16_t*)(ws + WS_KV); bf16_t* MN = (bf16_t*)(ws + WS_MN); \
    bf16_t* DEC = (bf16_t*)(ws + WS_DEC); bf16_t* KD = (bf16_t*)(ws + WS_KD); bf16_t* BB = (bf16_t*)(ws + WS_BB); \
    bf16_t* KK = (bf16_t*)(ws + WS_KK); bf16_t* G = (bf16_t*)(ws + WS_G); float* YS = (float*)(ws + WS_YS); \
    bf16_t* RV = (bf16_t*)(ws + WS_RV); bf16_t* VN = (bf16_t*)(ws + WS_VN); \
    bf16_t* XE = (bf16_t*)(ws + WS_XE); bf16_t* HID = (bf16_t*)(ws + WS_HID); int* SLOT = (int*)(ws + WS_SLOT); bf16_t* YE = (bf16_t*)(ws + WS_YE); (void)SLOT; (void)YE; \
    (void)AFF; (void)TOK; (void)GATE; (void)X; (void)H; (void)P; (void)Y; (void)Q; (void)KV; (void)MN; (void)DEC; (void)KD; (void)BB; (void)KK; (void)G; (void)YS; (void)RV; (void)VN; (void)XE; (void)HID;

template <class Epi>
__device__ __forceinline__ void dense_gemm(PG8_LAS unsigned char* ldsp, const bf16_t* A, const bf16_t* Bt, int M, int N, int K, const Epi& E, int cshift = 0) {
    asm volatile("" : "+s"(K));
    pg8::Gemm g{A, Bt, M, N, K}; pg8::StaticOrder So; So.init(M, N, (int)gridDim.x, (int)((blockIdx.x + cshift) % gridDim.x));
    pg8::gemm_phase<Epi, pg8::StaticOrder, false>(ldsp, g, So, E, nullptr);
}

__device__ __forceinline__ int odd_phases(const Args& a, const XcdBarrier& bar, unsigned char* lds_raw, int ph) {
    PROLOG
    if (IN(ph)) combine_norm<false>(X, YE, SLOT, a.in[6], H, nullptr);
    SEAM(ph); ++ph;
    if (IN(ph)) dense_gemm(ldsp, H, (const bf16_t*)(ws + WS_WOIN), T, ODD_PAD, D, EpiBf16Store{P, ODD_PAD, 1.0f});
    SEAM(ph); ++ph;
    if (IN(ph)) REP_LOOP odd_token_pass(P, a.in[12], a.in[18], a.in[8], a.in[9], VN, RV, (bf16_t*)(ws + WS_KB), KK, (bf16_t*)(ws + WS_F5));
    SEAM(ph); ++ph;
    if (IN(ph)) REP_LOOP {
        gating_pass(VN, (const bf16_t*)(ws + WS_WSB), a.in[11], P, Y, lds_raw);
        __syncthreads();
        dense_gemm(ldsp, (const bf16_t*)(ws + WS_F5), (const bf16_t*)(ws + WS_WL), T, 2560, 384,
                   EpiLora{a.in[13], a.in[15], a.in[19], (const bf16_t*)(ws + WS_KB), KK, DEC, KD, BB, G});
    }
    SEAM(ph); ++ph;
    if (IN(ph)) REP_LOOP scan_r1(DEC, RV, KD, KK, BB, (bf16_t*)(ws + WS_PT), (bf16_t*)(ws + WS_QT), (bf16_t*)(ws + WS_RH), (float*)(ws + WS_YL), lds_raw);
    SEAM(ph); ++ph;
    if (IN(ph)) REP_LOOP {
        if (bid < 32) scan_r2((const bf16_t*)(ws + WS_PT), (const bf16_t*)(ws + WS_QT), (bf16_t*)(ws + WS_S0), lds_raw);
        else {
            LAS float* scr = (LAS float*)((LAS unsigned char*)lds_raw + wave * 16896);
            const int gw2 = (bid - 32) * 8 + wave, ngw2 = (nb - 32) * 8;
            auto gmap = [](int n) { return (n >> 7) * 256 + (n & 127); };
            auto umap = [](int n) { return (n >> 7) * 256 + 128 + (n & 127); };
            for (int it = gw2; it < 16 * 704; it += ngw2) { const int e = it / 704, r = it % 704;
                transpose_item_fp8(a.in[31] + (size_t)(16 + e) * D * DE, D, DE, ws + WS_WGU8 + 176 * MiB + (size_t)e * 5632 * D, gmap, GUSC8, scr, r, lane); }
            for (int it = gw2; it < 16 * 704; it += ngw2) { const int e = it / 704, r = it % 704;
                transpose_item_fp8(a.in[32] + (size_t)(16 + e) * D * DE, D, DE, ws + WS_WGU8 + 176 * MiB + (size_t)e * 5632 * D, umap, GUSC8, scr, r, lane); }
        }
    }
    SEAM(ph); ++ph;
    if (IN(ph)) REP_LOOP scan_r3((const bf16_t*)(ws + WS_RH), (const float*)(ws + WS_YL), (const bf16_t*)(ws + WS_S0), RV, KD, G, a.in[20], a.in[21], a.in[22], Y);
    SEAM(ph); ++ph;
    if (IN(ph)) dense_gemm(ldsp, Y, (const bf16_t*)(ws + WS_WOOUT), T, D, D, EpiResidN{X, X, H, (float*)(ws + WS_SSP)});
    SEAM(ph); ++ph;
    return ph;
}

template <int layer>
__device__ __forceinline__ int tail_phases(const Args& a, const XcdBarrier& bar, unsigned char* lds_raw, int ph) {
    PROLOG
    if (IN(ph)) {
        dense_gemm(ldsp, H, (const bf16_t*)(ws + WS_WQ) + (size_t)layer * D * D, T, D, D, EpiBf16StoreRS{Q, D, (const float*)(ws + WS_SSP)});
    }
    SEAM(ph); ++ph;
    if (IN(ph)) REP_LOOP xattn_mfma(Q, KV + (size_t)layer * 1024 * 1024, KV + (size_t)layer * 1024 * 1024 + 512 * 1024, Y, lds_raw);
    SEAM(ph); ++ph;
    if (IN(ph)) dense_gemm(ldsp, Y, (const bf16_t*)(ws + WS_WO) + (size_t)layer * D * D, T, D, D, EpiResid{X, X});
    SEAM(ph); ++ph;
    if (IN(ph)) REP_LOOP router_pass(X, a.in[29] + layer * D, (const float*)(ws + WS_WRT) + (size_t)layer * NE * D, AFF, SLOT, H, lds_raw);
    SEAM(ph); ++ph;
    if (IN(ph)) REP_LOOP {
        unsigned* keys = (unsigned*)ldsf;
        int* hist = (int*)(ldsf + 8192);
        int* sh = hist + 256;
        if (bid >= 32) {
            LAS float* scr = (LAS float*)((LAS unsigned char*)lds_raw + wave * 16896);
            const int gw2 = (bid - 32) * 8 + wave, ngw2 = (nb - 32) * 8;
            auto ident = [](int n) { return n; };
            for (int it = gw2; it < 16 * 704; it += ngw2) { const int mt = layer * 16 + it / 704, r = it % 704;
                if constexpr (layer == 1 || F8L0) transpose_item_fp8(a.in[33] + (size_t)mt * DE * D, DE, D, ws + WS_WD8 + (size_t)layer * 88 * MiB + (size_t)(mt - 16 * layer) * D * DE, ident, DSC8, scr, r, lane);
                else transpose_item(a.in[33] + (size_t)mt * DE * D, DE, D, (bf16_t*)(ws + WS_WD) + (size_t)mt * D * DE, ident, scr, r, lane); }
        }
        for (int be = bid; be < NB * NE && be < 32; be += nb) {
            const int b = be >> 4, e = be & 15, eb = e * 2 + b;
            __syncthreads();
            for (int s = tid; s < S; s += NTH) keys[s] = __float_as_uint(AFF[(size_t)(b * S + s) * NE + e]);
            unsigned prefix = 0u; int krem = CAP;
            for (int pass = 3; pass >= 0; --pass) {
                __syncthreads();
                if (tid < 256) hist[tid] = 0;
                __syncthreads();
                const unsigned hmask = pass == 3 ? 0u : (0xFFFFFFFFu << (8 * (pass + 1)));
                for (int s = tid; s < S; s += NTH) { const unsigned k = keys[s]; if ((k & hmask) == prefix) atomicAdd(&hist[(k >> (8 * pass)) & 255u], 1); }
                __syncthreads();
                if (tid == 0) {
                    int cum = 0, bsel = 0;
                    for (int bb = 255; bb >= 0; --bb) { const int c = hist[bb]; if (cum + c >= krem) { bsel = bb; break; } cum += c; }
                    sh[8] = bsel; sh[9] = krem - cum;
                }
                __syncthreads();
                prefix |= ((unsigned)sh[8]) << (8 * pass); krem = sh[9];
            }
            const unsigned thr = prefix;
            int ce = 0;
            for (int i = 0; i < 16; ++i) { const unsigned k = keys[tid * 16 + i]; ce += (k == thr); }
            int tot;
            const int eqbase = block_exscan(ce, sh, &tot);
            int eqr = eqbase, cs = 0;
            for (int i = 0; i < 16; ++i) { const unsigned k = keys[tid * 16 + i]; const bool sel = (k > thr) || (k == thr && eqr < krem); eqr += (k == thr); cs += sel; }
            const int sbase = block_exscan(cs, sh, &tot);
            int slot = sbase; eqr = eqbase;
            for (int i = 0; i < 16; ++i) {
                const int s = tid * 16 + i; const unsigned k = keys[s];
                const bool sel = (k > thr) || (k == thr && eqr < krem); eqr += (k == thr);
                if (sel) { TOK[eb * CAP + slot] = b * S + s; GATE[eb * CAP + slot] = __uint_as_float(k); SLOT[(size_t)(b * S + s) * NE + e] = eb * CAP + slot; ++slot; }
            }
        }
    }
    SEAM(ph); ++ph;
    if (IN(ph)) REP_LOOP {
        for (int r = gw; r < NB * NE * CAP; r += ngw) {
            int rv_ = r; asm volatile("" : "+v"(rv_));
            if constexpr (layer == 1 || F8L0) {
                const v4u* srcp = (const v4u*)(H + (size_t)TOK[rv_] * D) + 2 * lane; const v4u x0 = srcp[0], x1 = srcp[1];
                v4u o;
                o.x = pk4_fp8(bflo(x0.x) * ASC8, bfhi(x0.x) * ASC8, bflo(x0.y) * ASC8, bfhi(x0.y) * ASC8); o.y = pk4_fp8(bflo(x0.z) * ASC8, bfhi(x0.z) * ASC8, bflo(x0.w) * ASC8, bfhi(x0.w) * ASC8);
                o.z = pk4_fp8(bflo(x1.x) * ASC8, bfhi(x1.x) * ASC8, bflo(x1.y) * ASC8, bfhi(x1.y) * ASC8); o.w = pk4_fp8(bflo(x1.z) * ASC8, bfhi(x1.z) * ASC8, bflo(x1.w) * ASC8, bfhi(x1.w) * ASC8);
                ((v4u*)((unsigned char*)XE + (size_t)r * D))[lane] = o;
            } else {
                const v4u* srcp = (const v4u*)(H + (size_t)TOK[rv_] * D); v4u* dst = (v4u*)(XE + (size_t)r * D);
                dst[lane] = srcp[lane]; dst[lane + 64] = srcp[lane + 64];
            }
        }
    }
    SEAM(ph); ++ph;
    if (IN(ph)) {
        MoeOrder So{(int)gridDim.x, (int)blockIdx.x, 16 * 22, 22};
        if constexpr (layer == 1 || F8L0) {
            int Kg = D / 2; asm volatile("" : "+s"(Kg));
            pg8::Gemm g{XE, (const bf16_t*)(ws + WS_WGU8 + (size_t)layer * 176 * MiB), NB * NE * CAP, NE * 5632, Kg};
            pg8::gemm_phase<EpiSiluMul8, MoeOrder, false, true>(ldsp, g, So, EpiSiluMul8{(unsigned char*)HID}, nullptr);
        } else {
            pg8::Gemm g{XE, (const bf16_t*)(ws + WS_WGU) + (size_t)layer * NE * 5632 * D, NB * NE * CAP, NE * 5632, D};
            pg8::gemm_phase<EpiSiluMul, MoeOrder, false>(ldsp, g, So, EpiSiluMul{HID}, nullptr);
        }
    }
    SEAM(ph); ++ph;
    if (IN(ph)) {
        MoeOrder So{(int)gridDim.x, (int)blockIdx.x, 16 * 4, 4};
        if constexpr (layer == 1 || F8L0) {
            int Kg = DE / 2; asm volatile("" : "+s"(Kg));
            pg8::Gemm g{HID, (const bf16_t*)(ws + WS_WD8 + (size_t)layer * 88 * MiB), NB * NE * CAP, NE * D, Kg};
            pg8::gemm_phase<EpiYE8, MoeOrder, false, true>(ldsp, g, So, EpiYE8{GATE, YE}, nullptr);
        } else {
            pg8::Gemm g{HID, (const bf16_t*)(ws + WS_WD) + (size_t)layer * NE * D * DE, NB * NE * CAP, NE * D, DE};
            pg8::gemm_phase<EpiYE, MoeOrder, false>(ldsp, g, So, EpiYE{GATE, YE}, nullptr);
        }
    }
    SEAM(ph); ++ph;
    return ph;
}

__global__ void __launch_bounds__(NTH, 2) mega(Args a) {
    extern __shared__ __attribute__((aligned(16))) unsigned char lds_raw[];
    unsigned* ctl = (unsigned*)(a.ws + WS_CTL);
    volatile LAS unsigned* bst = (volatile LAS unsigned*)((LAS unsigned char*)lds_raw + LDS_BAR_OFF);
    { const int t0_ = tidx(); if (t0_ < 4) bst[t0_] = 0u; }
    __syncthreads();
    XcdBarrier bar; bar.bar = ctl + CW_BAR; bar.x = 0; bar.st = bst;
    if (a.hi - a.lo > 1) bar = xcd_barrier_post(ctl + CW_BAR, bst);
    PROLOG

    int ph = 0;
    if (IN(ph)) REP_LOOP {
        for (int i = gt; i < S * 32; i += ngt) {
            const int s = i >> 5, f = i & 31;
            const float pw = (float)exp((double)((float)(2 * f) / 64.0f) * 9.210340371976184);
            const float invf = 1.0f / pw;
            const float angf = (float)s * invf;
            double xx = (double)angf;
            const double n = rint(xx * 0.15915494309189535);
            xx = (xx - n * 6.283185307179586) - n * 2.4492935982947064e-16;
            const double x2 = xx * xx;
            double cs = 1.0, sn = xx, tc = 1.0, tsn = xx;
#pragma unroll 1
            for (int k = 1; k <= 16; ++k) { tc *= -x2 / (double)((2 * k - 1) * (2 * k)); tsn *= -x2 / (double)((2 * k) * (2 * k + 1)); cs += tc; sn += tsn; }
            ropec[i] = (float)cs; ropes[i] = (float)sn;
        }
        rmsnorm_rows_bf16(x_in, a.in[2], H, T);
        rmsnorm_rows_bf16(mem, a.in[25], MN, NB * MEM); rmsnorm_rows_bf16(mem, a.in[25] + D, MN + NB * MEM * D, NB * MEM);
        LAS float* scr = (LAS float*)((LAS unsigned char*)lds_raw + wave * 16896);
        auto ident = [](int n) { return n; };
        auto emap = [](int n) { const bool il = (n < 1024) || (n >= 1536 && n < 2176); const int j = n & 63; return il ? ((n & ~63) + (j < 32 ? 2 * j : 2 * (j - 32) + 1)) : n; };
        for (int it = gw; it < 16 * 36; it += ngw) transpose_item(a.in[3], D, EVEN_IN, (bf16_t*)(ws + WS_WEIN), emap, scr, it, lane);
        for (int it = gw; it < 16 * 16; it += ngw) transpose_item(a.in[5], D, D, (bf16_t*)(ws + WS_WEOUT), ident, scr, it, lane);
        for (int it = gw; it < 16 * 46; it += ngw) transpose_item(a.in[7], D, ODD_IN, (bf16_t*)(ws + WS_WOIN), ident, scr, it, lane);
        for (int it = gw; it < 16 * 16; it += ngw) transpose_item(a.in[23], D, D, (bf16_t*)(ws + WS_WOOUT), ident, scr, it, lane);
        for (int it = gw; it < 2 * 16 * 16; it += ngw) { const int l = it / 256, r = it % 256; transpose_item(a.in[26] + (size_t)l * D * D, D, D, (bf16_t*)(ws + WS_WQ) + (size_t)l * D * D, ident, scr, r, lane, a.in[24] + l * D); }
        for (int it = gw; it < 2 * 16 * 32; it += ngw) { const int l = it / 512, r = it % 512; transpose_item(a.in[27] + (size_t)l * D * 2048, D, 2048, (bf16_t*)(ws + WS_WKV) + (size_t)l * 2048 * D, ident, scr, r, lane); }
        for (int it = gw; it < 2 * 16 * 16; it += ngw) { const int l = it / 256, r = it % 256; transpose_item(a.in[28] + (size_t)l * D * D, D, D, (bf16_t*)(ws + WS_WO) + (size_t)l * D * D, ident, scr, r, lane); }
        { float* WRT = (float*)(ws + WS_WRT);
          for (int i = gt; i < 2 * NE * D; i += ngt) { const int l = i >> 14, e = (i >> 10) & 15, k = i & 1023; WRT[i] = a.in[29][l * D + k] * a.in[30][((size_t)l * D + k) * NE + e]; } }
        { bf16_t* Wsb = (bf16_t*)(ws + WS_WSB); const float* wsp = a.in[10];
          for (int i = gt; i < 4 * 128 * 128; i += ngt) Wsb[i] = (bf16_t)f2bf(wsp[i]);
          bf16_t* WL = (bf16_t*)(ws + WS_WL); const float *w2 = a.in[14], *a2 = a.in[16], *g2 = a.in[17];
          for (int i = gt; i < 2560 * 384; i += ngt) { const int n = i / 384, k = i % 384, sec = n >> 9, cc = n & 511; float v = 0.f;
              if (sec < 2) { if ((k >> 6) == sec) v = w2[(size_t)(sec * 64 + (k & 63)) * 512 + cc]; }
              else if (sec < 4) { if ((k >> 6) == sec) v = a2[(size_t)((sec - 2) * 64 + (k & 63)) * 512 + cc]; }
              else { if (k >= 256) v = g2[(size_t)(k - 256) * 512 + cc]; }
              WL[i] = (bf16_t)f2bf(v); } }
        auto gmap = [](int n) { return (n >> 7) * 256 + (n & 127); };
        auto umap = [](int n) { return (n >> 7) * 256 + 128 + (n & 127); };
        for (int it = gw; it < 16 * 704; it += ngw) { const int mt = it / 704, r = it % 704;
            if constexpr (F8L0) transpose_item_fp8(a.in[31] + (size_t)mt * D * DE, D, DE, ws + WS_WGU8 + (size_t)mt * 5632 * D, gmap, GUSC8, scr, r, lane);
            else transpose_item(a.in[31] + (size_t)mt * D * DE, D, DE, (bf16_t*)(ws + WS_WGU) + (size_t)mt * 5632 * D, gmap, scr, r, lane); }
        for (int it = gw; it < 16 * 704; it += ngw) { const int mt = it / 704, r = it % 704;
            if constexpr (F8L0) transpose_item_fp8(a.in[32] + (size_t)mt * D * DE, D, DE, ws + WS_WGU8 + (size_t)mt * 5632 * D, umap, GUSC8, scr, r, lane);
            else transpose_item(a.in[32] + (size_t)mt * D * DE, D, DE, (bf16_t*)(ws + WS_WGU) + (size_t)mt * 5632 * D, umap, scr, r, lane); }
    }
    SEAM(ph); ++ph;

    if (IN(ph)) dense_gemm(ldsp, H, (const bf16_t*)(ws + WS_WEIN), T, EVEN_IN, D,
                           EpiEven{ropec, ropes, (bf16_t*)(ws + WS_QHA), (bf16_t*)(ws + WS_KHA), (bf16_t*)(ws + WS_QHB), (bf16_t*)(ws + WS_KHB), (bf16_t*)(ws + WS_VTA), (bf16_t*)(ws + WS_VTB)});
    if (IN(ph)) {
        dense_gemm(ldsp, MN, (const bf16_t*)(ws + WS_WKV), NB * MEM, 2048, D, EpiKV{KV, KV + 512 * 1024}, 192);
        dense_gemm(ldsp, MN + NB * MEM * D, (const bf16_t*)(ws + WS_WKV) + (size_t)2048 * D, NB * MEM, 2048, D, EpiKV{KV + 1024 * 1024, KV + 1024 * 1024 + 512 * 1024}, 176);
    }
    SEAM(ph); ++ph;
    if (IN(ph)) REP_LOOP attn_phase_even((const bf16_t*)(ws + WS_QHA), (const bf16_t*)(ws + WS_KHA), (const bf16_t*)(ws + WS_VTA), (const bf16_t*)(ws + WS_QHB), (const bf16_t*)(ws + WS_KHB),
                                (const bf16_t*)(ws + WS_VTB), a.in[4], (bf16_t*)(ws + WS_OA), (float*)(ws + WS_LSE), Y, lds_raw);
    SEAM(ph); ++ph;
    if (IN(ph)) REP_LOOP attn_combine((const bf16_t*)(ws + WS_OA), (const float*)(ws + WS_LSE), Y);
    SEAM(ph); ++ph;
    if (IN(ph)) dense_gemm(ldsp, Y, (const bf16_t*)(ws + WS_WEOUT), T, D, D, EpiResidN{x_in, X, H, (float*)(ws + WS_SSP)});
    SEAM(ph); ++ph;

    ph = tail_phases<0>(a, bar, lds_raw, ph);
    ph = odd_phases(a, bar, lds_raw, ph);
    ph = tail_phases<1>(a, bar, lds_raw, ph);

    if (IN(ph)) combine_norm<true>(X, YE, SLOT, a.in[34], nullptr, a.out);
    ++ph;
}
constexpr int NPHASES = 1 + 4 + 2 * 8 + 8 + 1;
#undef IN
#undef SEAM
}

extern "C" void kernel_launch(void* const* d_in, const int* in_sizes, int n_in, void* d_out, int out_size, void* d_ws, size_t ws_size, hipStream_t stream) {
    static int grid = 0;
    if (grid == 0) {
        if (n_in != 35 || out_size != T * D || ws_size < WS_END) { fprintf(stderr, "kernel_launch: unexpected shapes n_in %d out %d ws %zu (need %zu)\n", n_in, out_size, ws_size, (size_t)WS_END); grid = -1; return; }
        int dev = 0, cus = 0, per_cu = 0;
        (void)hipGetDevice(&dev); (void)hipDeviceGetAttribute(&cus, hipDeviceAttributeMultiprocessorCount, dev);
        if (hipFuncSetAttribute((const void*)mega, hipFuncAttributeMaxDynamicSharedMemorySize, LDS_BYTES) != hipSuccess) { fprintf(stderr, "hipFuncSetAttribute failed\n"); grid = -1; return; }
        if (hipOccupancyMaxActiveBlocksPerMultiprocessor(&per_cu, (const void*)mega, NTH, LDS_BYTES) != hipSuccess || per_cu < 1) fprintf(stderr, "occupancy query: %d\n", per_cu);
        (void)hipGetLastError();
        grid = cus > 0 ? cus : 256;
    }
    if (grid < 0) return;
    (void)hipMemsetAsync((char*)d_ws + WS_CTL, 0, CTL_BYTES, stream);
    Args a{};
    for (int i = 0; i < 35; ++i) a.in[i] = (const float*)d_in[i];
    a.out = (float*)d_out; a.ws = (unsigned char*)d_ws;
#if MK_MULTI
    for (int k = 0; k < NPHASES; ++k) { a.lo = k; a.hi = k + 1; hipLaunchKernelGGL(mega, dim3(grid), dim3(NTH), LDS_BYTES, stream, a); }
#else
    a.lo = 0; a.hi = NPHASES; hipLaunchKernelGGL(mega, dim3(grid), dim3(NTH), LDS_BYTES, stream, a);
#endif
}
```

```cpp
#include <hip/hip_runtime.h>
#include <cstdio>
#include <cstdint>

#ifndef PROBE_PHASE
#define PROBE_PHASE (-1)
#endif
#ifndef PROBE_REP
#define PROBE_REP 1
#endif
#ifndef MK_MULTI
#define MK_MULTI 0
#endif

__device__ __forceinline__ int tidx() { int t = threadIdx.x; asm volatile("" : "+v"(t)); return t; }
namespace pg8 {
#define PG8_LAS __attribute__((address_space(3)))
typedef unsigned short bf16_t;
typedef short bf16x8 __attribute__((ext_vector_type(8)));
typedef float f32x4 __attribute__((ext_vector_type(4)));
typedef unsigned u32x4 __attribute__((ext_vector_type(4)));
constexpr int BM = 256, BK = 64, HALF = 128, HTB = HALF * BK * 2  , STAGE_BYTES = 8 * HTB, NXCD = 8, WGM = 8;

__host__ __device__ __forceinline__ int lds_byte(int r, int c) { const int st = (r >> 4) * 2 + (c >> 5), rr = r & 15, cc = c & 31, ob = rr * 64 + cc * 2; return st * 1024 + (ob ^ (((ob >> 9) & 1) << 5)); }
__host__ __device__ __forceinline__ void stage_rc(int b, int& R, int& C) { const int st = b / 1024, sb = b % 1024, swz = sb ^ (((sb >> 9) & 1) << 5); R = (st >> 1) * 16 + swz / 64; C = (st & 1) * 32 + (swz % 64) / 2; }
__host__ __device__ __forceinline__ int perm32(int rho) { const int n = rho >> 4, i = rho & 15; return 8 * (i >> 2) + 4 * n + (i & 3); }

struct Unit { int pm, pn; };
struct Gemm { const bf16_t* A; const bf16_t* Bt; int M, N, K; };

struct StaticOrder {
    int nM, nN, nwg, G, c;
    __host__ __device__ void init(int M, int N, int G_, int c_) { nM = M / BM; nN = N / BM; nwg = nM * nN; G = G_; c = c_; }
    __host__ __device__ bool next(int i, Unit& u) const {
        const long L = (long)i * G + c; if (L >= nwg) return false;
        int wgid = (int)L; { const int q = nwg / NXCD, r = nwg % NXCD, xcd = wgid % NXCD, off = wgid / NXCD; wgid = (xcd < r ? xcd * (q + 1) : r * (q + 1) + (xcd - r) * q) + off; }
        const int nig = WGM * nN, gid = wgid / nig, fm = gid * WGM, gsz = (nM - fm) < WGM ? (nM - fm) : WGM;
        u.pm = fm + ((wgid % nig) % gsz); u.pn = (wgid % nig) / gsz; return true;
    }
    __device__ __forceinline__ void a_ready(const Unit&) const {}
    __device__ __forceinline__ void done(const Unit&) const {}
};

typedef __bf16 bf16v2_t __attribute__((ext_vector_type(2)));
typedef float f32v2_t __attribute__((ext_vector_type(2)));
__device__ __forceinline__ unsigned cvt_pk_bf16(float lo, float hi) { const f32v2_t v = {lo, hi}; return __builtin_bit_cast(unsigned, __builtin_convertvector(v, bf16v2_t)); }
typedef int i32x8 __attribute__((ext_vector_type(8)));
template <bool F8> __device__ __forceinline__ f32x4 mma_tile(const bf16x8 (&bfr)[2], const bf16x8 (&afr)[2], f32x4 acc) {
    if constexpr (F8) {
        typedef int i32x4_ __attribute__((ext_vector_type(4)));
        const i32x4_ b0 = __builtin_bit_cast(i32x4_, bfr[0]), b1 = __builtin_bit_cast(i32x4_, bfr[1]), a0 = __builtin_bit_cast(i32x4_, afr[0]), a1 = __builtin_bit_cast(i32x4_, afr[1]);
        const i32x8 bb = {b0[0], b0[1], b0[2], b0[3], b1[0], b1[1], b1[2], b1[3]}, aa = {a0[0], a0[1], a0[2], a0[3], a1[0], a1[1], a1[2], a1[3]};
        const int sc1 = 0x7f7f7f7f;
        asm volatile("v_mfma_scale_f32_16x16x128_f8f6f4 %0, %1, %2, %0, %3, %3 op_sel_hi:[0,0,0]" : "+v"(acc) : "v"(bb), "v"(aa), "v"(sc1));
        return acc;
    } else {
        acc = __builtin_amdgcn_mfma_f32_16x16x32_bf16(bfr[0], afr[0], acc, 0, 0, 0);
        return __builtin_amdgcn_mfma_f32_16x16x32_bf16(bfr[1], afr[1], acc, 0, 0, 0);
    }
}
template <class Epi, class Sched, bool STAMP = false, bool F8 = false>
__device__ __forceinline__ void gemm_phase(PG8_LAS unsigned char* lds, const Gemm g, const Sched& S, const Epi& E, unsigned long long* stamps) {
    const int tid = ::tidx(), wid = __builtin_amdgcn_readfirstlane(tid >> 6), lane = tid & 63, wr = wid >> 2, wc = wid & 3, fr = lane & 15, fq = lane >> 4;
    const int K = g.K, nt = K / BK;
    int ts_lo = 0, ts_hi = 0, nts = 0; const unsigned long long rt_entry = STAMP ? (unsigned long long)wall_clock64() : 0ull;
#define PG8_STAMP() do { if (STAMP && wid == 0 && nts < 64) { const unsigned long long _c = (unsigned long long)clock64(); \
        ts_lo = (lane == nts) ? (int)(unsigned)_c : ts_lo; ts_hi = (lane == nts) ? (int)(unsigned)(_c >> 32) : ts_hi; ++nts; } } while (0)
    PG8_STAMP();
    unsigned voffA[2], voffB[2];
#pragma unroll
    for (int i = 0; i < 2; ++i) { int R, C; stage_rc(tid * 16 + i * 8192, R, C); const int Rb = Epi::PERM ? ((R & ~31) + perm32(R & 31)) : R;
        voffA[i] = (unsigned)(R * K + C) * 2u; voffB[i] = (unsigned)(Rb * K + C) * 2u; }
    const size_t kstep = (size_t)(BK * 2);
    const size_t hstep = (size_t)HALF * K * 2;
    const size_t tstep = 2 * hstep;
    const unsigned ldsw = (unsigned)wid * 1024u;
    const int aoff = lds_byte(wr * 64 + fr, fq * 8), boff = lds_byte(wc * 32 + fr, fq * 8);
#define PG8_SA(b, h) (((b) * 2 + (h)) * HTB)
#define PG8_SB(b, h) ((4 + (b) * 2 + (h)) * HTB)
#define PG8_STAGE(bufoff, gbase, voff) do { _Pragma("unroll") for (int _i = 0; _i < 2; ++_i) \
        __builtin_amdgcn_global_load_lds((const unsigned*)((const char*)(gbase) + (voff)[_i]), (PG8_LAS unsigned*)(lds + (bufoff) + ldsw + _i * 8192), 16, 0, 0); } while (0)
#define PG8_LDA(dst, b, h) do { _Pragma("unroll") for (int m = 0; m < 4; ++m) _Pragma("unroll") for (int k = 0; k < 2; ++k) dst[m][k] = *(const PG8_LAS bf16x8*)(lds + PG8_SA(b, h) + aoff + m * 2048 + k * 1024); } while (0)
#define PG8_LDB(dst, b, h) do { _Pragma("unroll") for (int n = 0; n < 2; ++n) _Pragma("unroll") for (int k = 0; k < 2; ++k) dst[n][k] = *(const PG8_LAS bf16x8*)(lds + PG8_SB(b, h) + boff + n * 2048 + k * 1024); } while (0)
#define PG8_MMA(ai, bj, At, Bt) do { __builtin_amdgcn_s_setprio(1); _Pragma("unroll") for (int m = 0; m < 4; ++m) _Pragma("unroll") for (int n = 0; n < 2; ++n) \
        acc[ai][bj][m][n] = mma_tile<F8>(Bt[n], At[m], acc[ai][bj][m][n]); __builtin_amdgcn_s_setprio(0); } while (0)
#define PG8_WAIT_V(n) asm volatile("s_waitcnt vmcnt(" #n ")" ::: "memory")
#define PG8_WAIT_L(n) asm volatile("s_waitcnt lgkmcnt(" #n ")" ::: "memory")
#define PG8_BAR __builtin_amdgcn_s_barrier()
#define PG8_SCHED __builtin_amdgcn_sched_barrier(0)
    Unit cur, nxt; int ui = 0;
    if (!S.next(0, cur)) return;
    f32x4 acc[2][2][4][2];
#pragma unroll
    for (int a = 0; a < 2; ++a)
#pragma unroll
        for (int b = 0; b < 2; ++b)
#pragma unroll
            for (int m = 0; m < 4; ++m)
#pragma unroll
                for (int n = 0; n < 2; ++n) acc[a][b][m][n] = (f32x4){0.f, 0.f, 0.f, 0.f};
    bf16x8 At[4][2], B0[2][2], B1[2][2];
    const char* cA = (const char*)g.A + (size_t)cur.pm * tstep; const char* cB = (const char*)g.Bt + (size_t)cur.pn * tstep;
    S.a_ready(cur);
    PG8_STAGE(PG8_SB(0, 0), cB, voffB); PG8_STAGE(PG8_SA(0, 0), cA, voffA); PG8_STAGE(PG8_SB(0, 1), cB + hstep, voffB); PG8_STAGE(PG8_SA(0, 1), cA + hstep, voffA);
    if (wr == 1) PG8_BAR;
    PG8_WAIT_V(4); PG8_BAR;
    PG8_STAGE(PG8_SB(1, 0), cB + kstep, voffB); PG8_STAGE(PG8_SA(1, 0), cA + kstep, voffA); PG8_STAGE(PG8_SB(1, 1), cB + hstep + kstep, voffB);
    PG8_WAIT_V(6); PG8_BAR;
    PG8_STAMP();
    for (;;) {
        const bool has_next = S.next(ui + 1, nxt);
        const char* nA = has_next ? (const char*)g.A + (size_t)nxt.pm * tstep : cA; const char* nB = has_next ? (const char*)g.Bt + (size_t)nxt.pn * tstep : cB;
        for (int t = 0; t < nt; t += 2) {
            const bool last = (t == nt - 2);
            const char* a1 = cA + (size_t)(t + 1) * kstep;
            const char* a2 = last ? nA : cA + (size_t)(t + 2) * kstep; const char* b2 = last ? nB : cB + (size_t)(t + 2) * kstep;
            const char* a3 = a2 + kstep; const char* b3 = b2 + kstep;
            if (last && has_next) S.a_ready(nxt);
            PG8_LDB(B0, 0, 0); PG8_SCHED; PG8_LDA(At, 0, 0); PG8_STAGE(PG8_SA(1, 1), a1 + hstep, voffA);
            PG8_WAIT_L(8); PG8_BAR; PG8_WAIT_L(0); PG8_MMA(0, 0, At, B0); PG8_BAR; PG8_SCHED;
            PG8_LDB(B1, 0, 1); PG8_STAGE(PG8_SB(0, 0), b2, voffB);
            PG8_BAR; PG8_WAIT_L(0); PG8_MMA(0, 1, At, B1); PG8_BAR;
            PG8_LDA(At, 0, 1); PG8_STAGE(PG8_SA(0, 0), a2, voffA);
            PG8_BAR; PG8_WAIT_L(0); PG8_MMA(1, 0, At, B0); PG8_BAR; PG8_SCHED;
            PG8_STAGE(PG8_SB(0, 1), b2 + hstep, voffB);
            PG8_WAIT_V(6); PG8_BAR; PG8_MMA(1, 1, At, B1); PG8_BAR;
            PG8_LDB(B0, 1, 0); PG8_SCHED; PG8_LDA(At, 1, 0); PG8_STAGE(PG8_SA(0, 1), a2 + hstep, voffA);
            PG8_WAIT_L(8); PG8_BAR; PG8_WAIT_L(0); PG8_MMA(0, 0, At, B0); PG8_BAR; PG8_SCHED;
            PG8_LDB(B1, 1, 1); PG8_STAGE(PG8_SB(1, 0), b3, voffB);
            PG8_BAR; PG8_WAIT_L(0); PG8_MMA(0, 1, At, B1); PG8_BAR;
            PG8_LDA(At, 1, 1); PG8_STAGE(PG8_SA(1, 0), a3, voffA);
            PG8_BAR; PG8_WAIT_L(0); PG8_MMA(1, 0, At, B0); PG8_BAR; PG8_SCHED;
            PG8_STAGE(PG8_SB(1, 1), b3 + hstep, voffB);
            PG8_WAIT_V(6); PG8_BAR; PG8_MMA(1, 1, At, B1); PG8_BAR;
        }
        PG8_STAMP();
        if constexpr (!Epi::AFTER_DRAIN) { E(acc, cur, wr, wc, fr, fq); S.done(cur); }
        PG8_STAMP();
        if (!has_next) break;
#pragma unroll
        for (int a = 0; a < 2; ++a)
#pragma unroll
            for (int b = 0; b < 2; ++b)
#pragma unroll
                for (int m = 0; m < 4; ++m)
#pragma unroll
                    for (int n = 0; n < 2; ++n) acc[a][b][m][n] = (f32x4){0.f, 0.f, 0.f, 0.f};
        cur = nxt; cA = nA; cB = nB; ++ui;
    }
    PG8_WAIT_V(0);
    if (wr == 0) PG8_BAR;
    PG8_BAR;
    if constexpr (Epi::AFTER_DRAIN) { E.fused(acc, cur, wr, wc, fr, fq, lds, wid, lane); S.done(cur); }
    PG8_STAMP();
    if (STAMP && wid == 0) { stamps[lane] = lane < nts ? (((unsigned long long)(unsigned)ts_hi << 32) | (unsigned)ts_lo) : 0ull;
        if (lane == 62) stamps[62] = rt_entry; if (lane == 63) stamps[63] = (unsigned long long)wall_clock64(); }
#undef PG8_STAMP
#undef PG8_SA
#undef PG8_SB
#undef PG8_STAGE
#undef PG8_LDA
#undef PG8_LDB
#undef PG8_MMA
#undef PG8_WAIT_V
#undef PG8_WAIT_L
#undef PG8_BAR
#undef PG8_SCHED
}
}


namespace {
using pg8::bf16_t; using pg8::f32x4;
constexpr int D = 1024, NB = 2, S = 8192, T = NB * S;
constexpr int EVEN_IN = 2304, ODD_IN = 2944, ODD_PAD = 3072, FD = 1920;
constexpr int MEM = 256, NE = 16, CAP = 1024, DE = 2816;
constexpr int NTH = 512;
constexpr size_t MiB = 1u << 20;
constexpr size_t WS_CTL = 0, CTL_BYTES = 1 * MiB;
constexpr size_t WS_ROPE = 1 * MiB;
constexpr size_t WS_AFF = 4 * MiB;
constexpr size_t WS_TOK = 5 * MiB;
constexpr size_t WS_GATE = 6 * MiB;
constexpr size_t WS_WRT = 3 * MiB;
constexpr size_t WS_SLOT = 7 * MiB;
constexpr size_t WS_X = 8 * MiB;
constexpr size_t WS_H = 72 * MiB;
constexpr size_t WS_Y = 104 * MiB;
constexpr size_t WS_P = 136 * MiB;
constexpr size_t WS_Q = 320 * MiB;
constexpr size_t WS_KV = 384 * MiB;
constexpr size_t WS_MN = 388 * MiB;
constexpr size_t WS_SSP = 390 * MiB;
constexpr size_t WS_DEC = 392 * MiB;
constexpr size_t WS_KD = 456 * MiB;
constexpr size_t WS_BB = 520 * MiB;
constexpr size_t WS_KK = 584 * MiB;
constexpr size_t WS_G = 616 * MiB;
constexpr size_t WS_YS = 648 * MiB;
constexpr size_t WS_RV = 712 * MiB;
constexpr size_t WS_VN = 776 * MiB;
constexpr size_t WS_QHA = 136 * MiB;
constexpr size_t WS_KHA = 152 * MiB;
constexpr size_t WS_QHB = 168 * MiB;
constexpr size_t WS_KHB = 184 * MiB;
constexpr size_t WS_PVB = 188 * MiB;
constexpr size_t WS_VTA = 208 * MiB;
constexpr size_t WS_VTB = 256 * MiB;
constexpr size_t WS_OA = 260 * MiB;
constexpr size_t WS_LSE = 308 * MiB;
constexpr size_t WS_QT = 136 * MiB;
constexpr size_t WS_YL = 200 * MiB;
constexpr size_t WS_PT = 264 * MiB;
constexpr size_t WS_RH = 296 * MiB;
constexpr size_t WS_S0 = 328 * MiB;
constexpr size_t WS_XE = 136 * MiB;
constexpr size_t WS_YE = 136 * MiB;
constexpr size_t WS_HID = 200 * MiB;
constexpr size_t WS_KB = 360 * MiB;
constexpr size_t WS_F5 = 792 * MiB;
constexpr size_t WS_WSB = 804 * MiB;
constexpr size_t WS_WL = 805 * MiB;
constexpr size_t WS_WEIN = 808 * MiB;
constexpr size_t WS_WEOUT = 813 * MiB;
constexpr size_t WS_WOIN = 815 * MiB;
constexpr size_t WS_WOOUT = 821 * MiB;
constexpr size_t WS_WQ = 823 * MiB;
constexpr size_t WS_WKV = 827 * MiB;
constexpr size_t WS_WO = 835 * MiB;
constexpr size_t WS_WGU = 840 * MiB;
constexpr size_t WS_WD = 1192 * MiB;
constexpr size_t WS_WGU8 = 840 * MiB;
constexpr size_t WS_WD8 = 1192 * MiB;
constexpr size_t WS_END = 1368 * MiB;
constexpr bool F8L0 = true;
constexpr float ASC8 = 16.f, GUSC8 = 128.f, HSC8 = 4.f, DSC8 = 256.f;
constexpr int CW_BAR = 4096;

constexpr int LDS_BYTES = 147456;
constexpr int LDS_BAR_OFF = LDS_BYTES - 64;

#define LAS __attribute__((address_space(3)))
#define XB_TMO      128
#define XB_XCNT(j)  (256  + 64 * (j))
#define XB_XSUB(j)  (1280 + 64 * (j))
#define XB_XGEN(j)  (2304 + 64 * (j))
#define XB_TOP      3328
#define XB_TOPGEN   3392
#define XCD_BAR_WORDS 3456
#define XB_SPIN_CAP (1u << 22)
__device__ __forceinline__ unsigned xb_ld(unsigned* p)              { return __hip_atomic_load(p, __ATOMIC_RELAXED, __HIP_MEMORY_SCOPE_AGENT); }
__device__ __forceinline__ unsigned xb_add(unsigned* p, unsigned v) { return __hip_atomic_fetch_add(p, v, __ATOMIC_RELAXED, __HIP_MEMORY_SCOPE_AGENT); }
__device__ __forceinline__ unsigned xb_xcc_id() { return (unsigned)__builtin_amdgcn_s_getreg((3 << 11) | 20) & 0xFu; }
#define XB_SPIN(cond, bar) do { unsigned _sp = 0; while (cond) { __builtin_amdgcn_s_sleep(1); \
    if ((++_sp & 255u) == 0u) { if (xb_ld(&(bar)[XB_TMO])) break; if (_sp > XB_SPIN_CAP) { atomicAdd(&(bar)[XB_TMO], 1u); break; } } } } while (0)
struct XcdBarrier { unsigned* bar; unsigned x; volatile LAS unsigned* st; };
__device__ __forceinline__ XcdBarrier xcd_barrier_post(unsigned* bar, volatile LAS unsigned* st) {
    XcdBarrier b; b.bar = bar; b.x = xb_xcc_id(); b.st = st;
    if (threadIdx.x == 0) (void)xb_add(&bar[XB_XCNT(b.x)], 1u);
    return b;
}
__device__ __forceinline__ void xcd_barrier_complete(unsigned* bar, unsigned x, unsigned& nloc, unsigned& nx) {
    const unsigned G = gridDim.x * gridDim.y * gridDim.z;
    unsigned sum, cnt, mine, sp = 0u;
    for (;;) {
        sum = 0u; cnt = 0u; mine = 0u;
#pragma unroll
        for (unsigned j = 0; j < 16; ++j) { const unsigned c = xb_ld(&bar[XB_XCNT(j)]); sum += c; cnt += (c > 0u) ? 1u : 0u; mine = (j == x) ? c : mine; }
        if (sum == G) break;
        __builtin_amdgcn_s_sleep(1);
        if ((++sp & 255u) == 0u) { if (xb_ld(&bar[XB_TMO])) break; if (sp > XB_SPIN_CAP) { atomicAdd(&bar[XB_TMO], 1u); break; } }
    }
    nloc = mine > 0u ? mine : 1u; nx = cnt > 0u ? cnt : 1u;
}
__device__ __forceinline__ void xcd_barrier(const XcdBarrier& b) {
    asm volatile("s_waitcnt vmcnt(0)" ::: "memory");
    __syncthreads();
    if (threadIdx.x == 0) {
        unsigned* bar = b.bar;
        __builtin_amdgcn_s_waitcnt(0);
        unsigned nloc = b.st[0], nx = b.st[1];
        if (nloc == 0u) { xcd_barrier_complete(bar, b.x, nloc, nx); b.st[0] = nloc; b.st[1] = nx; }
        const unsigned old = xb_add(&bar[XB_XSUB(b.x)], 1u);
        const unsigned gen = old / nloc;
        if (old + 1u == (gen + 1u) * nloc) {
            __builtin_amdgcn_fence(__ATOMIC_RELEASE, "agent");
            asm volatile("s_waitcnt vmcnt(0)" ::: "memory");
            const unsigned og = xb_add(&bar[XB_TOP], 1u);
            const unsigned tg = og / nx;
            if (og + 1u == (tg + 1u) * nx) xb_add(&bar[XB_TOPGEN], 1u);
            else XB_SPIN(xb_ld(&bar[XB_TOPGEN]) == tg, bar);
            __builtin_amdgcn_fence(__ATOMIC_ACQUIRE, "agent");
            xb_add(&bar[XB_XGEN(b.x)], 1u);
            asm volatile("s_waitcnt vmcnt(0)" ::: "memory");
        } else {
            XB_SPIN(xb_ld(&bar[XB_XGEN(b.x)]) == gen, bar);
            __builtin_amdgcn_fence(__ATOMIC_ACQUIRE, "agent");
            asm volatile("s_waitcnt vmcnt(0)" ::: "memory");
        }
    }
    __syncthreads();
}

__device__ __forceinline__ float wave_sum(float v) {
#pragma unroll
    for (int o = 32; o >= 1; o >>= 1) v += __shfl_xor(v, o);
    return v;
}
__device__ __forceinline__ float frcp(float x) { return __builtin_amdgcn_rcpf(x); }
__device__ __forceinline__ float sigmoidf_(float x) { return frcp(1.0f + __expf(-x)); }
__device__ __forceinline__ float tanhf_(float x) { return 2.0f * sigmoidf_(2.0f * x) - 1.0f; }
__device__ __forceinline__ float gelu_tanh(float x) { return x * sigmoidf_(1.5957691216057308f * (x + 0.044715f * x * x * x)); }
__device__ __forceinline__ unsigned f2bf(float f) { unsigned u = __builtin_bit_cast(unsigned, f); return (u + 0x7fffu + ((u >> 16) & 1u)) >> 16; }
__device__ __forceinline__ unsigned pk2(float lo, float hi) { return pg8::cvt_pk_bf16(lo, hi); }
__device__ __forceinline__ float bflo(unsigned w) { return __uint_as_float(w << 16); }
__device__ __forceinline__ float bfhi(unsigned w) { return __uint_as_float(w & 0xffff0000u); }
typedef unsigned v4u __attribute__((ext_vector_type(4)));
typedef unsigned v2u __attribute__((ext_vector_type(2)));

struct Args { const float* in[35]; float* out; unsigned char* ws; int lo, hi; };

struct EpiF32Store {
    static constexpr bool PERM = false, AFTER_DRAIN = false;
    float* C; int ldc; int nvalid;
    __device__ __forceinline__ void operator()(const f32x4 (&acc)[2][2][4][2], const pg8::Unit& u, int wr, int wc, int fr, int fq) const {
        const int row0 = u.pm * 256 + wr * 64 + fr, col0 = u.pn * 256 + wc * 32 + 4 * fq;
#pragma unroll
        for (int ai = 0; ai < 2; ++ai)
#pragma unroll
            for (int m = 0; m < 4; ++m) { float* rowp = C + (size_t)(row0 + ai * 128 + m * 16) * ldc + col0;
#pragma unroll
                for (int bj = 0; bj < 2; ++bj)
#pragma unroll
                    for (int n = 0; n < 2; ++n) if (col0 + bj * 128 + n * 16 < nvalid) *(f32x4*)(rowp + bj * 128 + n * 16) = acc[ai][bj][m][n]; }
    }
};
struct EpiResid {
    static constexpr bool PERM = false, AFTER_DRAIN = false;
    const float* base; float* out;
    __device__ __forceinline__ void operator()(const f32x4 (&acc)[2][2][4][2], const pg8::Unit& u, int wr, int wc, int fr, int fq) const {
        const int row0 = u.pm * 256 + wr * 64 + fr, col0 = u.pn * 256 + wc * 32 + 4 * fq;
#pragma unroll
        for (int ai = 0; ai < 2; ++ai)
#pragma unroll
            for (int m = 0; m < 4; ++m) { const size_t off = (size_t)(row0 + ai * 128 + m * 16) * D + col0;
#pragma unroll
                for (int bj = 0; bj < 2; ++bj)
#pragma unroll
                    for (int n = 0; n < 2; ++n) { const f32x4 b = *(const f32x4*)(base + off + bj * 128 + n * 16); *(f32x4*)(out + off + bj * 128 + n * 16) = b + acc[ai][bj][m][n]; } }
    }
};
struct EpiSiluMul {
    static constexpr bool PERM = false, AFTER_DRAIN = false;
    bf16_t* HIDp;
    __device__ __forceinline__ void operator()(const f32x4 (&acc)[2][2][4][2], const pg8::Unit& u, int wr, int wc, int fr, int fq) const {
        const int pnl = u.pn % 22;
        const int row0 = u.pm * 256 + wr * 64 + fr, col0 = pnl * 128 + wc * 32 + 4 * fq;
#pragma unroll
        for (int ai = 0; ai < 2; ++ai)
#pragma unroll
            for (int m = 0; m < 4; ++m) { bf16_t* rowp = HIDp + (size_t)(row0 + ai * 128 + m * 16) * DE + col0;
#pragma unroll
                for (int n = 0; n < 2; ++n) { const f32x4 g = acc[ai][0][m][n], up = acc[ai][1][m][n]; float h[4];
#pragma unroll
                    for (int j = 0; j < 4; ++j) h[j] = g[j] * frcp(1.0f + __expf(-g[j])) * up[j];
                    v2u w; w.x = pk2(h[0], h[1]); w.y = pk2(h[2], h[3]); *(v2u*)(rowp + n * 16) = w; } }
    }
};
struct EpiYE {
    static constexpr bool PERM = true, AFTER_DRAIN = false;
    const float* GATE; bf16_t* YE;
    __device__ __forceinline__ void operator()(const f32x4 (&acc)[2][2][4][2], const pg8::Unit& u, int wr, int wc, int fr, int fq) const {
        const int pnl = u.pn & 3;
        const int row0 = u.pm * 256 + wr * 64 + fr, col0 = pnl * 256 + wc * 32 + 8 * fq;
#pragma unroll
        for (int ai = 0; ai < 2; ++ai)
#pragma unroll
            for (int m = 0; m < 4; ++m) { const int row = row0 + ai * 128 + m * 16; const float gt_ = GATE[row]; bf16_t* rowp = YE + (size_t)row * D + col0;
#pragma unroll
                for (int bj = 0; bj < 2; ++bj) { const f32x4 v0 = acc[ai][bj][m][0] * gt_, v1 = acc[ai][bj][m][1] * gt_;
                    v4u w; w.x = pg8::cvt_pk_bf16(v0[0], v0[1]); w.y = pg8::cvt_pk_bf16(v0[2], v0[3]); w.z = pg8::cvt_pk_bf16(v1[0], v1[1]); w.w = pg8::cvt_pk_bf16(v1[2], v1[3]);
                    *(v4u*)(rowp + bj * 128) = w; } }
    }
};
struct EpiBf16Store {
    static constexpr bool PERM = true, AFTER_DRAIN = false;
    bf16_t* O; int ldc; float scale;
    __device__ __forceinline__ void operator()(const f32x4 (&acc)[2][2][4][2], const pg8::Unit& u, int wr, int wc, int fr, int fq) const {
        const int row0 = u.pm * 256 + wr * 64 + fr, col0 = u.pn * 256 + wc * 32 + 8 * fq;
#pragma unroll
        for (int ai = 0; ai < 2; ++ai)
#pragma unroll
            for (int m = 0; m < 4; ++m) { bf16_t* rowp = O + (size_t)(row0 + ai * 128 + m * 16) * ldc + col0;
#pragma unroll
                for (int bj = 0; bj < 2; ++bj) { const f32x4 v0 = acc[ai][bj][m][0] * scale, v1 = acc[ai][bj][m][1] * scale;
                    v4u w; w.x = pg8::cvt_pk_bf16(v0[0], v0[1]); w.y = pg8::cvt_pk_bf16(v0[2], v0[3]); w.z = pg8::cvt_pk_bf16(v1[0], v1[1]); w.w = pg8::cvt_pk_bf16(v1[2], v1[3]);
                    *(v4u*)(rowp + bj * 128) = w; } }
    }
};
struct EpiKV {
    static constexpr bool PERM = false, AFTER_DRAIN = false;
    bf16_t* K; bf16_t* Vt;
    __device__ __forceinline__ void operator()(const f32x4 (&acc)[2][2][4][2], const pg8::Unit& u, int wr, int wc, int fr, int fq) const {
        const int row0 = u.pm * 256 + wr * 64 + fr, col0 = u.pn * 256 + wc * 32 + 4 * fq;
#pragma unroll
        for (int ai = 0; ai < 2; ++ai)
#pragma unroll
            for (int m = 0; m < 4; ++m) { const int row = row0 + ai * 128 + m * 16;
#pragma unroll
                for (int bj = 0; bj < 2; ++bj)
#pragma unroll
                    for (int n = 0; n < 2; ++n) { const int col = col0 + bj * 128 + n * 16; const f32x4 v = acc[ai][bj][m][n];
                        if (col < 1024) { v2u w; w.x = pk2(v[0], v[1]); w.y = pk2(v[2], v[3]); *(v2u*)(K + (size_t)row * 1024 + col) = w; }
                        else { const int b = row >> 8, mm = row & 255; bf16_t* vp = Vt + ((size_t)(b * 1024 + (col - 1024)) * 256 + mm);
#pragma unroll
                            for (int j = 0; j < 4; ++j) vp[(size_t)j * 256] = (bf16_t)f2bf(v[j]); } } }
    }
};

constexpr float QSCALE = 0.125f * 1.4426950408889634f;
struct EpiEven {
    static constexpr bool PERM = true, AFTER_DRAIN = false;
    const float* rc; const float* rs; bf16_t* QhA; bf16_t* KhA; bf16_t* QhB; bf16_t* KhB; bf16_t* VhA; bf16_t* VhB;
    __device__ __forceinline__ void operator()(const f32x4 (&acc)[2][2][4][2], const pg8::Unit& u, int wr, int wc, int fr, int fq) const {
        asm volatile("" : "+v"(fr), "+v"(fq));
        const int row0 = u.pm * 256 + wr * 64 + fr;
#pragma unroll
        for (int bj = 0; bj < 2; ++bj) {
            const int c0 = u.pn * 256 + bj * 128 + wc * 32 + 8 * fq;
            int kind; bf16_t* base; int stride; float sc = 1.0f;
            if (c0 < 512) { kind = 0; base = QhA + ((size_t)(c0 >> 6) * T) * 64 + (c0 & 63); stride = 64; sc = QSCALE; }
            else if (c0 < 1024) { kind = 0; base = KhA + ((size_t)((c0 - 512) >> 6) * T) * 64 + (c0 & 63); stride = 64; }
            else if (c0 < 1536) { kind = 1; base = VhA + ((size_t)((c0 - 1024) >> 6) * T) * 64 + (c0 & 63); stride = 64; }
            else if (c0 < 2048) { kind = 0; base = QhB + ((size_t)((c0 - 1536) >> 6) * T) * 64 + (c0 & 63); stride = 64; sc = QSCALE; }
            else if (c0 < 2176) { kind = 0; base = KhB + ((size_t)((c0 - 2048) >> 6) * T) * 64 + (c0 & 63); stride = 64; }
            else { kind = 1; base = VhB + ((size_t)((c0 - 2176) >> 6) * T) * 64 + (c0 & 63); stride = 64; }
            const int pi = (c0 & 63) >> 1;
#pragma unroll
            for (int ai = 0; ai < 2; ++ai)
#pragma unroll
                for (int m = 0; m < 4; ++m) {
                    const int tok = row0 + ai * 128 + m * 16;
                    const f32x4 v0 = acc[ai][bj][m][0], v1 = acc[ai][bj][m][1];
                    float y[8];
                    if (kind == 0) {
                        const int s = tok & (S - 1);
                        const f32x4 c4 = *(const f32x4*)(rc + s * 32 + pi), s4 = *(const f32x4*)(rs + s * 32 + pi);
                        y[0] = (v0[0] * c4[0] - v0[1] * s4[0]) * sc; y[1] = (v0[1] * c4[0] + v0[0] * s4[0]) * sc;
                        y[2] = (v0[2] * c4[1] - v0[3] * s4[1]) * sc; y[3] = (v0[3] * c4[1] + v0[2] * s4[1]) * sc;
                        y[4] = (v1[0] * c4[2] - v1[1] * s4[2]) * sc; y[5] = (v1[1] * c4[2] + v1[0] * s4[2]) * sc;
                        y[6] = (v1[2] * c4[3] - v1[3] * s4[3]) * sc; y[7] = (v1[3] * c4[3] + v1[2] * s4[3]) * sc;
                    } else { y[0] = v0[0]; y[1] = v0[1]; y[2] = v0[2]; y[3] = v0[3]; y[4] = v1[0]; y[5] = v1[1]; y[6] = v1[2]; y[7] = v1[3]; }
                    v4u w; w.x = pk2(y[0], y[1]); w.y = pk2(y[2], y[3]); w.z = pk2(y[4], y[5]); w.w = pk2(y[6], y[7]);
                    *(v4u*)(base + (size_t)tok * stride) = w;
                }
        }
    }
};

struct EpiLora {
    static constexpr bool PERM = false, AFTER_DRAIN = false;
    const float *w0, *a0, *k_a; const bf16_t *KB, *KK; bf16_t *LW, *KD, *BB, *G;
    __device__ __forceinline__ void operator()(const f32x4 (&acc)[2][2][4][2], const pg8::Unit& u, int wr, int wc, int fr, int fq) const {
        asm volatile("" : "+v"(fr), "+v"(fq));
        const int row0 = u.pm * 256 + wr * 64 + fr;
#pragma unroll
        for (int bj = 0; bj < 2; ++bj)
#pragma unroll
            for (int n = 0; n < 2; ++n) {
                const int c0 = u.pn * 256 + bj * 128 + wc * 32 + n * 16 + 4 * fq, sec = c0 >> 9, cc = c0 & 511;
#pragma unroll
                for (int ai = 0; ai < 2; ++ai)
#pragma unroll
                    for (int m = 0; m < 4; ++m) {
                        const size_t tok = row0 + ai * 128 + m * 16;
                        const f32x4 v = acc[ai][bj][m][n];
                        if (sec < 2) {
                            const f32x4 w = *(const f32x4*)(w0 + sec * 512 + cc); float o[4];
#pragma unroll
                            for (int j = 0; j < 4; ++j) { const float xw = -(w[j] + v[j]);
                                o[j] = -0.6065306597126334f * frcp(1.0f + __expf(xw)); }
                            v2u ww; ww.x = pk2(o[0], o[1]); ww.y = pk2(o[2], o[3]);
                            *(v2u*)(LW + ((size_t)sec * T + tok) * 512 + cc) = ww;
                        } else if (sec < 4) {
                            const int d = sec - 2;
                            const f32x4 a_ = *(const f32x4*)(a0 + d * 512 + cc), ka = *(const f32x4*)(k_a + cc);
                            const v2u kw = *(const v2u*)(KB + tok * 512 + cc), kkw = *(const v2u*)(KK + tok * 512 + cc);
                            const float kv[4] = {bflo(kw.x), bfhi(kw.x), bflo(kw.y), bfhi(kw.y)}, kk[4] = {bflo(kkw.x), bfhi(kkw.x), bflo(kkw.y), bfhi(kkw.y)};
                            float okd[4], obb[4];
#pragma unroll
                            for (int j = 0; j < 4; ++j) { const float alr = frcp(1.0f + __expf(-(a_[j] + v[j]))); okd[j] = kv[j] * (1.0f + (alr - 1.0f) * ka[j]); obb[j] = kk[j] * alr; }
                            v2u w1, w2_; w1.x = pk2(okd[0], okd[1]); w1.y = pk2(okd[2], okd[3]); w2_.x = pk2(obb[0], obb[1]); w2_.y = pk2(obb[2], obb[3]);
                            *(v2u*)(KD + ((size_t)d * T + tok) * 512 + cc) = w1; *(v2u*)(BB + ((size_t)d * T + tok) * 512 + cc) = w2_;
                        } else { v2u ww; ww.x = pk2(v[0], v[1]); ww.y = pk2(v[2], v[3]); *(v2u*)(G + tok * 512 + cc) = ww; }
                        __builtin_amdgcn_sched_barrier(0);
                    }
            }
    }
};

__device__ __forceinline__ float clamp8(float x) { return __builtin_amdgcn_fmed3f(x, -448.f, 448.f); }
__device__ __forceinline__ unsigned pk4_fp8(float a, float b, float c, float d) {
    int w = 0; w = __builtin_amdgcn_cvt_pk_fp8_f32(clamp8(a), clamp8(b), w, false); w = __builtin_amdgcn_cvt_pk_fp8_f32(clamp8(c), clamp8(d), w, true); return (unsigned)w;
}
struct EpiSiluMul8 {
    static constexpr bool PERM = true, AFTER_DRAIN = false;
    unsigned char* HIDp;
    __device__ __forceinline__ void operator()(const f32x4 (&acc)[2][2][4][2], const pg8::Unit& u, int wr, int wc, int fr, int fq) const {
        asm volatile("s_nop 7\n\ts_nop 7\n\ts_nop 7"); __builtin_amdgcn_sched_barrier(0);
        const int pnl = u.pn % 22;
        const int row0 = u.pm * 256 + wr * 64 + fr, col0 = pnl * 128 + wc * 32 + 8 * fq;
        const float s1 = 1.0f / (ASC8 * GUSC8);
#pragma unroll
        for (int ai = 0; ai < 2; ++ai)
#pragma unroll
            for (int m = 0; m < 4; ++m) { unsigned char* rowp = HIDp + (size_t)(row0 + ai * 128 + m * 16) * DE + col0; float h[8];
#pragma unroll
                for (int n = 0; n < 2; ++n) { const f32x4 g = acc[ai][0][m][n] * s1, up = acc[ai][1][m][n] * (s1 * HSC8);
#pragma unroll
                    for (int j = 0; j < 4; ++j) h[4 * n + j] = g[j] * frcp(1.0f + __expf(-g[j])) * up[j]; }
                v2u w; w.x = pk4_fp8(h[0], h[1], h[2], h[3]); w.y = pk4_fp8(h[4], h[5], h[6], h[7]);
                *(v2u*)rowp = w; }
    }
};
struct EpiYE8 {
    static constexpr bool PERM = true, AFTER_DRAIN = false;
    const float* GATE; bf16_t* YE;
    __device__ __forceinline__ void operator()(const f32x4 (&acc)[2][2][4][2], const pg8::Unit& u, int wr, int wc, int fr, int fq) const {
        asm volatile("s_nop 7\n\ts_nop 7\n\ts_nop 7"); __builtin_amdgcn_sched_barrier(0);
        const int pnl = u.pn & 3;
        const int row0 = u.pm * 256 + wr * 64 + fr, col0 = pnl * 256 + wc * 32 + 8 * fq;
#pragma unroll
        for (int ai = 0; ai < 2; ++ai)
#pragma unroll
            for (int m = 0; m < 4; ++m) { const int row = row0 + ai * 128 + m * 16; const float gt_ = GATE[row] * (1.0f / (HSC8 * DSC8)); bf16_t* rowp = YE + (size_t)row * D + col0;
#pragma unroll
                for (int bj = 0; bj < 2; ++bj) { const f32x4 v0 = acc[ai][bj][m][0] * gt_, v1 = acc[ai][bj][m][1] * gt_;
                    v4u w; w.x = pk2(v0[0], v0[1]); w.y = pk2(v0[2], v0[3]); w.z = pk2(v1[0], v1[1]); w.w = pk2(v1[2], v1[3]);
                    *(v4u*)(rowp + bj * 128) = w; } }
    }
};
template <class RowMap>
__device__ __forceinline__ void transpose_item_fp8(const float* W, int K, int N, unsigned char* WT, RowMap rm, float sc, LAS float* scr, int item, int lane) {
    const int nblk = N / 64, kb = item / nblk, nb_ = item % nblk, k0 = 64 * kb, n0 = 64 * nb_;
    f32x4 ld[16];
#pragma unroll
    for (int i = 0; i < 16; ++i) ld[i] = *(const f32x4*)(W + (size_t)(k0 + 4 * i + (lane >> 4)) * N + n0 + 4 * (lane & 15));
#pragma unroll
    for (int i = 0; i < 16; ++i) { LAS float* p = scr + (4 * i + (lane >> 4)) * 65 + 4 * (lane & 15); p[0] = ld[i][0]; p[1] = ld[i][1]; p[2] = ld[i][2]; p[3] = ld[i][3]; }
    asm volatile("s_waitcnt lgkmcnt(0)" ::: "memory");
    const int c = lane & 3;
#pragma unroll
    for (int j = 0; j < 4; ++j) { const int n = (lane >> 2) + 16 * j; const LAS float* s = scr + (16 * c) * 65 + n;
        v4u o;
#pragma unroll
        for (int q = 0; q < 4; ++q) o[q] = pk4_fp8(s[(4 * q) * 65] * sc, s[(4 * q + 1) * 65] * sc, s[(4 * q + 2) * 65] * sc, s[(4 * q + 3) * 65] * sc);
        *(v4u*)(WT + (size_t)rm(n0 + n) * K + k0 + 16 * c) = o; }
    asm volatile("s_waitcnt lgkmcnt(0)" ::: "memory");
}

struct EpiResidN {
    static constexpr bool PERM = false, AFTER_DRAIN = false;
    const float* base; float* out; bf16_t* Xb; float* SSP;
    __device__ __forceinline__ void operator()(const f32x4 (&acc)[2][2][4][2], const pg8::Unit& u, int wr, int wc, int fr, int fq) const {
        asm volatile("" : "+v"(fr), "+v"(fq));
        const int row0 = u.pm * 256 + wr * 64 + fr, col0 = u.pn * 256 + wc * 32 + 4 * fq;
#pragma unroll
        for (int ai = 0; ai < 2; ++ai)
#pragma unroll
            for (int m = 0; m < 4; ++m) { const size_t row = row0 + ai * 128 + m * 16; const size_t off = row * D + col0; float ss = 0.f;
#pragma unroll
                for (int bj = 0; bj < 2; ++bj)
#pragma unroll
                    for (int n = 0; n < 2; ++n) { const f32x4 b = *(const f32x4*)(base + off + bj * 128 + n * 16); const f32x4 o = b + acc[ai][bj][m][n];
                        *(f32x4*)(out + off + bj * 128 + n * 16) = o;
                        v2u w; w.x = pk2(o[0], o[1]); w.y = pk2(o[2], o[3]); *(v2u*)(Xb + off + bj * 128 + n * 16) = w;
                        ss += (o[0] * o[0] + o[1] * o[1]) + (o[2] * o[2] + o[3] * o[3]); }
                ss += __shfl_xor(ss, 16); ss += __shfl_xor(ss, 32);
                if (fq == 0) SSP[row * 16 + u.pn * 4 + wc] = ss; }
    }
};
struct EpiBf16StoreRS {
    static constexpr bool PERM = true, AFTER_DRAIN = false;
    bf16_t* O; int ldc; const float* SSP;
    __device__ __forceinline__ void operator()(const f32x4 (&acc)[2][2][4][2], const pg8::Unit& u, int wr, int wc, int fr, int fq) const {
        asm volatile("" : "+v"(fr), "+v"(fq));
        const int row0 = u.pm * 256 + wr * 64 + fr, col0 = u.pn * 256 + wc * 32 + 8 * fq;
#pragma unroll
        for (int ai = 0; ai < 2; ++ai)
#pragma unroll
            for (int m = 0; m < 4; ++m) { const size_t row = row0 + ai * 128 + m * 16;
                const f32x4* sp = (const f32x4*)(SSP + row * 16); const f32x4 s0 = sp[0], s1 = sp[1], s2 = sp[2], s3 = sp[3];
                const float ss = (((s0[0] + s0[1]) + (s0[2] + s0[3])) + ((s1[0] + s1[1]) + (s1[2] + s1[3]))) + (((s2[0] + s2[1]) + (s2[2] + s2[3])) + ((s3[0] + s3[1]) + (s3[2] + s3[3])));
                const float rs = rsqrtf(ss * (1.0f / D) + 1e-6f);
                bf16_t* rowp = O + row * ldc + col0;
#pragma unroll
                for (int bj = 0; bj < 2; ++bj) { const f32x4 v0 = acc[ai][bj][m][0] * rs, v1 = acc[ai][bj][m][1] * rs;
                    v4u w; w.x = pk2(v0[0], v0[1]); w.y = pk2(v0[2], v0[3]); w.z = pk2(v1[0], v1[1]); w.w = pk2(v1[2], v1[3]);
                    *(v4u*)(rowp + bj * 128) = w; } }
    }
};
struct MoeOrder {
    int G, c, npairs;
    int per;
    __device__ __forceinline__ bool next(int i, pg8::Unit& u) const {
        const int x = c & 7, y = c >> 3, pml = y & 7, pnq = y >> 3;
        const int epn = i * 32 + x * 4 + pnq;
        if (epn >= npairs || c >= 256) return false;
        const int e = epn / per;
        u.pm = e * 8 + pml; u.pn = epn; return true;
    }
    __device__ __forceinline__ void a_ready(const pg8::Unit&) const {}
    __device__ __forceinline__ void done(const pg8::Unit&) const {}
};

struct XattnOrder {
    int c;
    __device__ __forceinline__ bool next(int i, pg8::Unit& u) const { if (i != 0 || c >= 256) return false; u.pm = (c >> 7) * 32 + (c & 31); u.pn = (c >> 5) & 3; return true; }
    __device__ __forceinline__ void a_ready(const pg8::Unit&) const {}
    __device__ __forceinline__ void done(const pg8::Unit&) const {}
};
template <class RowMap>
__device__ __forceinline__ void transpose_item(const float* W, int K, int N, bf16_t* WT, RowMap rm, LAS float* scr, int item, int lane, const float* kscale = nullptr) {
    const int nblk = N / 64, kb = item / nblk, nb_ = item % nblk, k0 = 64 * kb, n0 = 64 * nb_;
    f32x4 ld[16];
#pragma unroll
    for (int i = 0; i < 16; ++i) ld[i] = *(const f32x4*)(W + (size_t)(k0 + 4 * i + (lane >> 4)) * N + n0 + 4 * (lane & 15));
#pragma unroll
    for (int i = 0; i < 16; ++i) { LAS float* p = scr + (4 * i + (lane >> 4)) * 65 + 4 * (lane & 15); p[0] = ld[i][0]; p[1] = ld[i][1]; p[2] = ld[i][2]; p[3] = ld[i][3]; }
    asm volatile("s_waitcnt lgkmcnt(0)" ::: "memory");
    const int c = lane & 7;
    float ksc[8];
#pragma unroll
    for (int q = 0; q < 8; ++q) ksc[q] = kscale ? kscale[k0 + 8 * c + q] : 1.0f;
#pragma unroll
    for (int j = 0; j < 8; ++j) { const int n = (lane >> 3) + 8 * j; const LAS float* s = scr + (8 * c) * 65 + n;
        v4u o; o.x = pk2(s[0 * 65] * ksc[0], s[1 * 65] * ksc[1]); o.y = pk2(s[2 * 65] * ksc[2], s[3 * 65] * ksc[3]); o.z = pk2(s[4 * 65] * ksc[4], s[5 * 65] * ksc[5]); o.w = pk2(s[6 * 65] * ksc[6], s[7 * 65] * ksc[7]);
        *(v4u*)(WT + (size_t)rm(n0 + n) * K + k0 + 8 * c) = o; }
    asm volatile("s_waitcnt lgkmcnt(0)" ::: "memory");
}

__device__ __forceinline__ void rmsnorm_rows_bf16(const float* x, const float* g, bf16_t* out, int M) {
    const int tix_ = tidx(); const int lane = tix_ & 63, gw = blockIdx.x * 8 + (tix_ >> 6), ngw = gridDim.x * 8;
    for (int m = gw; m < M; m += ngw) {
        const float4* xr = (const float4*)(x + (size_t)m * D);
        float4 v[4]; float s = 0.f;
#pragma unroll
        for (int j = 0; j < 4; ++j) { v[j] = xr[lane + 64 * j]; s += v[j].x * v[j].x + v[j].y * v[j].y + v[j].z * v[j].z + v[j].w * v[j].w; }
        const float r = rsqrtf(wave_sum(s) * (1.0f / D) + 1e-6f);
        v2u* o = (v2u*)(out + (size_t)m * D);
#pragma unroll
        for (int j = 0; j < 4; ++j) { const float4 gg = ((const float4*)g)[lane + 64 * j];
            v2u w; w.x = pk2(v[j].x * r * gg.x, v[j].y * r * gg.y); w.y = pk2(v[j].z * r * gg.z, v[j].w * r * gg.w); o[lane + 64 * j] = w; }
    }
}
__device__ __forceinline__ void rmsnorm_rows_f32(const float* x, const float* g, float* out, int M) {
    const int tix_ = tidx(); const int lane = tix_ & 63, gw = blockIdx.x * 8 + (tix_ >> 6), ngw = gridDim.x * 8;
    for (int m = gw; m < M; m += ngw) {
        const float4* xr = (const float4*)(x + (size_t)m * D);
        float4 v[4]; float s = 0.f;
#pragma unroll
        for (int j = 0; j < 4; ++j) { v[j] = xr[lane + 64 * j]; s += v[j].x * v[j].x + v[j].y * v[j].y + v[j].z * v[j].z + v[j].w * v[j].w; }
        const float r = rsqrtf(wave_sum(s) * (1.0f / D) + 1e-6f);
        float4* o = (float4*)(out + (size_t)m * D);
#pragma unroll
        for (int j = 0; j < 4; ++j) { const float4 gg = ((const float4*)g)[lane + 64 * j];
            o[lane + 64 * j] = make_float4(v[j].x * r * gg.x, v[j].y * r * gg.y, v[j].z * r * gg.z, v[j].w * r * gg.w); }
    }
}

__device__ __forceinline__ int block_exscan(int v, int* sh, int* tot) {
    const int tid = tidx(), lane = tid & 63, w = tid >> 6;
    int inc = v;
#pragma unroll
    for (int o = 1; o < 64; o <<= 1) { const int t = __shfl_up(inc, o); if (lane >= o) inc += t; }
    __syncthreads();
    if (lane == 63) sh[w] = inc;
    __syncthreads();
    int base = 0, total = 0;
#pragma unroll
    for (int i = 0; i < 8; ++i) { const int x = sh[i]; if (i < w) base += x; total += x; }
    *tot = total;
    return base + inc - v;
}


typedef short bf16x8 __attribute__((ext_vector_type(8)));
typedef float f32x16 __attribute__((ext_vector_type(16)));
constexpr int MROW = 144;
constexpr int MBUF = 64 * MROW;
__device__ __forceinline__ bf16x8 frag_rm(const LAS unsigned char* M, int row0, int k0, int fr, int fq) {
    return *(const LAS bf16x8*)(M + (row0 + fr) * MROW + (k0 + 8 * fq) * 2);
}
__device__ __forceinline__ bf16x8 frag_cm(const LAS unsigned char* M, int k0, int col0, int fr, int fq) {
    const LAS unsigned short* p = (const LAS unsigned short*)(M + (k0 + 8 * fq) * MROW + (col0 + fr) * 2);
    bf16x8 v;
#pragma unroll
    for (int j = 0; j < 8; ++j) v[j] = (short)p[j * (MROW / 2)];
    return v;
}
__device__ __forceinline__ void tile_store_bf16(LAS unsigned char* M, int m0, int n0, int fr, int fq, const f32x4& c) {
    v2u w; w.x = pk2(c[0], c[1]); w.y = pk2(c[2], c[3]);
    *(LAS v2u*)(M + (m0 + fr) * MROW + (n0 + 4 * fq) * 2) = w;
}
#define MMA16(acc, lf, rf) acc = __builtin_amdgcn_mfma_f32_16x16x32_bf16(rf, lf, acc, 0, 0, 0)

__device__ __forceinline__ void tile_store_bf16_T(LAS unsigned char* M, int m0, int n0, int fr, int fq, const f32x4& c) {
    const unsigned w0 = pk2(c[0], c[1]), w1 = pk2(c[2], c[3]);
    LAS unsigned char* p = M + (n0 + 4 * fq) * MROW + (m0 + fr) * 2;
    *(LAS unsigned short*)(p) = (unsigned short)(w0 & 0xffffu); *(LAS unsigned short*)(p + MROW) = (unsigned short)(w0 >> 16);
    *(LAS unsigned short*)(p + 2 * MROW) = (unsigned short)(w1 & 0xffffu); *(LAS unsigned short*)(p + 3 * MROW) = (unsigned short)(w1 >> 16);
}
__device__ __forceinline__ void scan_r1(const bf16_t* LWg, const bf16_t* RVg, const bf16_t* KDg, const bf16_t* KKg, const bf16_t* BBg,
                                        bf16_t* PT, bf16_t* QT, bf16_t* RH, float* YL, unsigned char* lds_raw) {
    LAS unsigned char* L = (LAS unsigned char*)lds_raw;
#define SL(k) (L + (k) * MBUF)
    LAS float* LWs = (LAS float*)(L + 14 * MBUF);
    const int tid = tidx(), lane = tid & 63, wave = tid >> 6, fr = lane & 15, fq = lane >> 4;
    const int tm = wave >> 1, tn0 = (wave & 1) * 2;
    const int m0 = tm * 16;
    const int t = tid >> 3, i0 = (tid & 7) * 8;
    v4u lw4n, r4n, v4n, kd4n, kk4n, bb4n;
#define R1_LOAD(it_) do { const int c_ = (it_) & 127, h_ = ((it_) >> 7) & 7, n_ = (it_) >> 10, dir_ = n_ >> 1, b_ = n_ & 1; \
        const int pos_ = dir_ ? (S - 1 - (c_ * 64 + t)) : (c_ * 64 + t); const size_t tok_ = (size_t)b_ * S + pos_; const size_t ch_ = (size_t)h_ * 64 + i0; \
        lw4n = *(const v4u*)(LWg + ((size_t)dir_ * T + tok_) * 512 + ch_); r4n = *(const v4u*)(RVg + tok_ * D + ch_); v4n = *(const v4u*)(RVg + tok_ * D + 512 + ch_); \
        kd4n = *(const v4u*)(KDg + ((size_t)dir_ * T + tok_) * 512 + ch_); kk4n = *(const v4u*)(KKg + tok_ * 512 + ch_); bb4n = *(const v4u*)(BBg + ((size_t)dir_ * T + tok_) * 512 + ch_); } while (0)
    if ((int)blockIdx.x < 4096) R1_LOAD((int)blockIdx.x);
    for (int item = blockIdx.x; item < 4096; item += gridDim.x) {
        const v4u lw4 = lw4n, r4 = r4n, v4 = v4n, kd4 = kd4n, kk4 = kk4n, bb4 = bb4n;
        float lw[8], Lin[8];
#pragma unroll
        for (int q = 0; q < 4; ++q) { lw[2 * q] = bflo(lw4[q]); lw[2 * q + 1] = bfhi(lw4[q]); }
#pragma unroll
        for (int j = 0; j < 8; ++j) { float x = lw[j];
#pragma unroll
            for (int o = 8; o < 64; o <<= 1) { const float y = __shfl_up(x, o); if (lane >= o) x += y; }
            Lin[j] = x; }
        __syncthreads();
        if (lane >= 56) {
#pragma unroll
            for (int j = 0; j < 8; ++j) LWs[64 + wave * 64 + i0 + j] = Lin[j]; }
        __syncthreads();
        {
            float off[8];
#pragma unroll
            for (int j = 0; j < 8; ++j) off[j] = 0.f;
            for (int w = 0; w < 8; ++w) { if (w < wave) {
#pragma unroll
                for (int j = 0; j < 8; ++j) off[j] += LWs[64 + w * 64 + i0 + j]; } }
#pragma unroll
            for (int j = 0; j < 8; ++j) Lin[j] += off[j];
            if (t == 63) {
#pragma unroll
                for (int j = 0; j < 8; ++j) LWs[i0 + j] = Lin[j]; }
            float at_[8], rt_[8], bt_[8], kt_[8];
#pragma unroll
            for (int q = 0; q < 4; ++q) {
#pragma unroll
                for (int e = 0; e < 2; ++e) { const int j = 2 * q + e;
                    const float ein = __expf(Lin[j]), einv = __expf(-Lin[j]), eex = __expf(Lin[j] - lw[j]);
                    const float kkv = e ? bfhi(kk4[q]) : bflo(kk4[q]), rv_ = e ? bfhi(r4[q]) : bflo(r4[q]), bbv = e ? bfhi(bb4[q]) : bflo(bb4[q]), kdv = e ? bfhi(kd4[q]) : bflo(kd4[q]);
                    at_[j] = -kkv * eex; rt_[j] = rv_ * ein; bt_[j] = bbv * einv; kt_[j] = kdv * einv; }
            }
            v4u wa, wb, wk, w;
            wa.x = pk2(at_[0], at_[1]); wa.y = pk2(at_[2], at_[3]); wa.z = pk2(at_[4], at_[5]); wa.w = pk2(at_[6], at_[7]); *(LAS v4u*)(SL(0) + t * MROW + i0 * 2) = wa;
            w.x = pk2(rt_[0], rt_[1]); w.y = pk2(rt_[2], rt_[3]); w.z = pk2(rt_[4], rt_[5]); w.w = pk2(rt_[6], rt_[7]); *(LAS v4u*)(SL(2) + t * MROW + i0 * 2) = w;
            wb.x = pk2(bt_[0], bt_[1]); wb.y = pk2(bt_[2], bt_[3]); wb.z = pk2(bt_[4], bt_[5]); wb.w = pk2(bt_[6], bt_[7]); *(LAS v4u*)(SL(3) + t * MROW + i0 * 2) = wb;
            wk.x = pk2(kt_[0], kt_[1]); wk.y = pk2(kt_[2], kt_[3]); wk.z = pk2(kt_[4], kt_[5]); wk.w = pk2(kt_[6], kt_[7]); *(LAS v4u*)(SL(5) + t * MROW + i0 * 2) = wk;
#pragma unroll
            for (int q = 0; q < 4; ++q) {
                LAS unsigned char* pT = (LAS unsigned char*)0 + (i0 + 2 * q) * MROW + t * 2;
                *(LAS unsigned short*)(SL(1) + (size_t)pT) = (unsigned short)(wa[q] & 0xffffu); *(LAS unsigned short*)(SL(1) + (size_t)pT + MROW) = (unsigned short)(wa[q] >> 16);
                *(LAS unsigned short*)(SL(4) + (size_t)pT) = (unsigned short)(wb[q] & 0xffffu); *(LAS unsigned short*)(SL(4) + (size_t)pT + MROW) = (unsigned short)(wb[q] >> 16);
                *(LAS unsigned short*)(SL(6) + (size_t)pT) = (unsigned short)(wk[q] & 0xffffu); *(LAS unsigned short*)(SL(6) + (size_t)pT + MROW) = (unsigned short)(wk[q] >> 16);
                *(LAS unsigned short*)(SL(7) + (size_t)pT) = (unsigned short)(v4[q] & 0xffffu); *(LAS unsigned short*)(SL(7) + (size_t)pT + MROW) = (unsigned short)(v4[q] >> 16);
            }
        }
        if (item + (int)gridDim.x < 4096) R1_LOAD(item + (int)gridDim.x);
        __syncthreads();
        f32x4 Tacc[2];
        {
            bf16x8 la[2], lr[2];
#pragma unroll
            for (int ks = 0; ks < 2; ++ks) { la[ks] = frag_rm(SL(0), m0, 32 * ks, fr, fq); lr[ks] = frag_rm(SL(2), m0, 32 * ks, fr, fq); }
#pragma unroll
            for (int q = 0; q < 2; ++q) {
                const int n0 = (tn0 + q) * 16;
                f32x4 cab = {0.f, 0.f, 0.f, 0.f}, cak = cab, crb = cab, crk = cab;
#pragma unroll
                for (int ks = 0; ks < 2; ++ks) {
                    const bf16x8 rb_ = frag_rm(SL(3), n0, 32 * ks, fr, fq), rk_ = frag_rm(SL(5), n0, 32 * ks, fr, fq);
                    MMA16(cab, la[ks], rb_); MMA16(cak, la[ks], rk_); MMA16(crb, lr[ks], rb_); MMA16(crk, lr[ks], rk_);
                }
                const int tt = m0 + fr;
#pragma unroll
                for (int j = 0; j < 4; ++j) { const int ss = n0 + 4 * fq + j;
                    if (!(ss < tt)) { cab[j] = 0.f; cak[j] = 0.f; }
                    if (!(ss <= tt)) { crb[j] = 0.f; crk[j] = 0.f; } }
                tile_store_bf16(SL(8), m0, n0, fr, fq, cab); tile_store_bf16_T(SL(9), m0, n0, fr, fq, cab);
                tile_store_bf16(SL(10), m0, n0, fr, fq, cak);
                tile_store_bf16(SL(11), m0, n0, fr, fq, crb); tile_store_bf16(SL(12), m0, n0, fr, fq, crk);
#pragma unroll
                for (int j = 0; j < 4; ++j) cab[j] += ((n0 + 4 * fq + j) == tt) ? 1.f : 0.f;
                Tacc[q] = cab;
                tile_store_bf16(SL(13), m0, n0, fr, fq, cab);
            }
        }
        __syncthreads();
        {
            bf16x8 lk[2], ln_[2];
#pragma unroll
            for (int ks = 0; ks < 2; ++ks) { lk[ks] = frag_rm(SL(10), m0, 32 * ks, fr, fq); ln_[ks] = frag_rm(SL(8), m0, 32 * ks, fr, fq); }
#pragma unroll
            for (int q = 0; q < 2; ++q) {
                const int n0 = (tn0 + q) * 16;
                f32x4 cw = {0.f, 0.f, 0.f, 0.f}, cn = cw;
#pragma unroll
                for (int ks = 0; ks < 2; ++ks) { MMA16(cw, lk[ks], frag_rm(SL(7), n0, 32 * ks, fr, fq)); MMA16(cn, ln_[ks], frag_rm(SL(9), n0, 32 * ks, fr, fq)); }
                tile_store_bf16_T(SL(0), m0, n0, fr, fq, cw);
                tile_store_bf16(SL(3), m0, n0, fr, fq, cn); tile_store_bf16_T(SL(5), m0, n0, fr, fq, cn);
            }
        }
        __syncthreads();
#pragma unroll
        for (int k = 1; k <= 5; ++k) {
            LAS unsigned char* Nk = (k & 1) ? SL(3) : SL(8); LAS unsigned char* NkT = (k & 1) ? SL(5) : SL(9);
            LAS unsigned char* Nn = (k & 1) ? SL(8) : SL(3); LAS unsigned char* NnT = (k & 1) ? SL(9) : SL(5);
            LAS unsigned char* Tk = (k & 1) ? SL(13) : SL(10); LAS unsigned char* Tn = (k & 1) ? SL(10) : SL(13);
            bf16x8 lt[2], ln_[2];
#pragma unroll
            for (int ks = 0; ks < 2; ++ks) { lt[ks] = frag_rm(Tk, m0, 32 * ks, fr, fq); ln_[ks] = frag_rm(Nk, m0, 32 * ks, fr, fq); }
#pragma unroll
            for (int q = 0; q < 2; ++q) {
                const int n0 = (tn0 + q) * 16;
                f32x4 cn = {0.f, 0.f, 0.f, 0.f};
#pragma unroll
                for (int ks = 0; ks < 2; ++ks) { const bf16x8 rn = frag_rm(NkT, n0, 32 * ks, fr, fq); MMA16(Tacc[q], lt[ks], rn); if (k < 5) MMA16(cn, ln_[ks], rn); }
                tile_store_bf16(Tn, m0, n0, fr, fq, Tacc[q]);
                if (k < 5) { tile_store_bf16(Nn, m0, n0, fr, fq, cn); tile_store_bf16_T(NnT, m0, n0, fr, fq, cn); }
            }
            __syncthreads();
        }
        {
            bf16x8 lt[2];
#pragma unroll
            for (int ks = 0; ks < 2; ++ks) lt[ks] = frag_rm(SL(10), m0, 32 * ks, fr, fq);
#pragma unroll
            for (int q = 0; q < 2; ++q) {
                const int n0 = (tn0 + q) * 16;
                f32x4 ca = {0.f, 0.f, 0.f, 0.f}, cu = ca;
#pragma unroll
                for (int ks = 0; ks < 2; ++ks) { MMA16(ca, lt[ks], frag_rm(SL(1), n0, 32 * ks, fr, fq)); MMA16(cu, lt[ks], frag_rm(SL(0), n0, 32 * ks, fr, fq)); }
                tile_store_bf16_T(SL(8), m0, n0, fr, fq, ca); tile_store_bf16_T(SL(9), m0, n0, fr, fq, cu);
            }
        }
        __syncthreads();
        {
            bf16x8 lrb[2], lrk[2], lb[2], lkt[2];
#pragma unroll
            for (int ks = 0; ks < 2; ++ks) { lrb[ks] = frag_rm(SL(11), m0, 32 * ks, fr, fq); lrk[ks] = frag_rm(SL(12), m0, 32 * ks, fr, fq);
                lb[ks] = frag_rm(SL(4), m0, 32 * ks, fr, fq); lkt[ks] = frag_rm(SL(6), m0, 32 * ks, fr, fq); }
            const float wc = __expf(LWs[m0 + fr]);
#pragma unroll
            for (int q = 0; q < 2; ++q) {
                const int n0 = (tn0 + q) * 16;
                f32x4 crh = {0.f, 0.f, 0.f, 0.f}, cyl = crh, cp = crh, cq = crh;
#pragma unroll
                for (int ks = 0; ks < 2; ++ks) {
                    const bf16x8 ra = frag_rm(SL(8), n0, 32 * ks, fr, fq), ru = frag_rm(SL(9), n0, 32 * ks, fr, fq), rv = frag_rm(SL(7), n0, 32 * ks, fr, fq);
                    MMA16(crh, lrb[ks], ra); MMA16(cyl, lrb[ks], ru); MMA16(cyl, lrk[ks], rv);
                    MMA16(cp, lb[ks], ra); MMA16(cq, lb[ks], ru); MMA16(cq, lkt[ks], rv);
                }
                const size_t o = (size_t)item * 4096 + (size_t)(m0 + fr) * 64 + n0 + 4 * fq;
                { const LAS unsigned short* rp = (const LAS unsigned short*)(SL(2) + (m0 + fr) * MROW + (n0 + 4 * fq) * 2);
#pragma unroll
                  for (int j = 0; j < 4; ++j) crh[j] += __uint_as_float(((unsigned)rp[j]) << 16); }
                { v2u w; w.x = pk2(crh[0], crh[1]); w.y = pk2(crh[2], crh[3]); *(v2u*)(RH + o) = w; }
                *(f32x4*)(YL + o) = cyl;
#pragma unroll
                for (int j = 0; j < 4; ++j) { cp[j] = wc * (cp[j] + (((n0 + 4 * fq + j) == (m0 + fr)) ? 1.f : 0.f)); cq[j] *= wc; }
                { v2u w; w.x = pk2(cp[0], cp[1]); w.y = pk2(cp[2], cp[3]); *(v2u*)(PT + o) = w; }
                { v2u w; w.x = pk2(cq[0], cq[1]); w.y = pk2(cq[2], cq[3]); *(v2u*)(QT + o) = w; }
            }
        }
    }
#undef SL
}
#undef R1_LOAD

__device__ __forceinline__ bf16x8 pack_acc8(const f32x16& x, int s) {
    v4u p; p.x = pk2(x[8 * s], x[8 * s + 1]); p.y = pk2(x[8 * s + 2], x[8 * s + 3]); p.z = pk2(x[8 * s + 4], x[8 * s + 5]); p.w = pk2(x[8 * s + 6], x[8 * s + 7]);
    return __builtin_bit_cast(bf16x8, p);
}
__device__ __forceinline__ void scan_r2(const bf16_t* PT, const bf16_t* QT, bf16_t* S0, unsigned char* lds_raw) {
    LAS unsigned char* L = (LAS unsigned char*)lds_raw;
    constexpr int SLOT_B = MBUF + 8192;
    const int tid = tidx(), lane = tid & 63, wave = tid >> 6;
    const int r = lane & 31, h2 = lane >> 5, jb = wave;
    f32x16 st[2];
#pragma unroll
    for (int ib = 0; ib < 2; ++ib)
#pragma unroll
        for (int g = 0; g < 16; ++g) st[ib][g] = 0.f;
    const size_t item0 = (size_t)blockIdx.x * 128;
    v4u stage[16];
#pragma unroll
    for (int q = 0; q < 16; ++q) { const int p = tid + 512 * q, cc = p >> 10, w = p & 1023, mat = w >> 9, idx = w & 511;
        stage[q] = *(const v4u*)((mat ? QT : PT) + (item0 + cc) * 4096 + idx * 8); }
    for (int grp = 0; grp < 16; ++grp) {
        __syncthreads();
#pragma unroll
        for (int q = 0; q < 16; ++q) { const int p = tid + 512 * q, cc = p >> 10, w = p & 1023, mat = w >> 9, idx = w & 511;
            *(LAS v4u*)(L + cc * SLOT_B + (mat ? (MBUF + idx * 16) : ((idx >> 3) * MROW + (idx & 7) * 16))) = stage[q]; }
        __syncthreads();
        if (grp < 15) {
#pragma unroll
            for (int q = 0; q < 16; ++q) { const int p = tid + 512 * q, cc = p >> 10, w = p & 1023, mat = w >> 9, idx = w & 511;
                stage[q] = *(const v4u*)((mat ? QT : PT) + (item0 + (grp + 1) * 8 + cc) * 4096 + idx * 8); }
        }
        if (wave < 2) {
#pragma unroll 1
            for (int cc = 0; cc < 8; ++cc) {
                const size_t item = item0 + grp * 8 + cc;
                const LAS unsigned char* Pm = L + cc * SLOT_B; const LAS unsigned char* Qm = Pm + MBUF;
                bf16_t* sp = S0 + item * 4096 + (size_t)(32 * jb + r) * 64;
#pragma unroll
                for (int ib = 0; ib < 2; ++ib)
#pragma unroll
                    for (int g = 0; g < 4; ++g) { v2u w; w.x = pk2(st[ib][4 * g], st[ib][4 * g + 1]); w.y = pk2(st[ib][4 * g + 2], st[ib][4 * g + 3]); *(v2u*)(sp + 32 * ib + 8 * g + 4 * h2) = w; }
                f32x16 nw[2];
#pragma unroll
                for (int ib = 0; ib < 2; ++ib)
#pragma unroll
                    for (int g = 0; g < 16; ++g) nw[ib][g] = __uint_as_float(((unsigned)*(const LAS unsigned short*)(Qm + (32 * ib + (g & 3) + 8 * (g >> 2) + 4 * h2) * 128 + (32 * jb + r) * 2)) << 16);
#pragma unroll
                for (int kb = 0; kb < 2; ++kb)
#pragma unroll
                    for (int s2 = 0; s2 < 2; ++s2) {
                        const bf16x8 bfr = pack_acc8(st[kb], s2);
#pragma unroll
                        for (int ib = 0; ib < 2; ++ib) {
                            const LAS unsigned char* ap = Pm + (32 * ib + r) * MROW + (32 * kb + 16 * s2 + 4 * h2) * 2;
                            const v2u lo = *(const LAS v2u*)ap, hi = *(const LAS v2u*)(ap + 16);
                            v4u av; av.x = lo.x; av.y = lo.y; av.z = hi.x; av.w = hi.y;
                            nw[ib] = __builtin_amdgcn_mfma_f32_32x32x16_bf16(__builtin_bit_cast(bf16x8, av), bfr, nw[ib], 0, 0, 0);
                        }
                    }
                st[0] = nw[0]; st[1] = nw[1];
            }
        }
    }
}
__device__ __forceinline__ void scan_r3(const bf16_t* RH, const float* YL, const bf16_t* S0, const bf16_t* RVg, const bf16_t* KDg, const bf16_t* Gg,
                                        const float* r_k, const float* lng, const float* lnb, bf16_t* Y) {
    const int tid = tidx(), lane = tid & 63, wave = tid >> 6, fr = lane & 15, fq = lane >> 4;
    const int tmw = wave & 3;
    for (int it2 = blockIdx.x * 2 + (wave >> 2); it2 < 2048; it2 += gridDim.x * 2) {
        const int b = it2 >> 10, h = (it2 >> 7) & 7, pc = it2 & 127;
        f32x4 acc[4];
#pragma unroll
        for (int q = 0; q < 4; ++q) acc[q] = (f32x4){0.f, 0.f, 0.f, 0.f};
#pragma unroll 1
        for (int dirn = 0; dirn < 2; ++dirn) {
            const size_t item = (size_t)((dirn * 2 + b) * 8 + h) * 128 + (dirn ? 127 - pc : pc);
            const int row = dirn ? 63 - (16 * tmw + fr) : 16 * tmw + fr;
            const bf16_t* rp = RH + item * 4096 + (size_t)row * 64;
            bf16x8 lf[2];
#pragma unroll
            for (int ks = 0; ks < 2; ++ks) lf[ks] = *(const bf16x8*)(rp + 32 * ks + 8 * fq);
#pragma unroll
            for (int q = 0; q < 4; ++q) {
                const bf16_t* sp = S0 + item * 4096 + (size_t)(16 * q + fr) * 64;
#pragma unroll
                for (int ks = 0; ks < 2; ++ks) { const bf16x8 rf = *(const bf16x8*)(sp + 32 * ks + 8 * fq); MMA16(acc[q], lf[ks], rf); }
                acc[q] += *(const f32x4*)(YL + item * 4096 + (size_t)row * 64 + 16 * q + 4 * fq);
            }
        }
        float sm = 0.f;
#pragma unroll
        for (int q = 0; q < 4; ++q) sm += (acc[q][0] + acc[q][1]) + (acc[q][2] + acc[q][3]);
        sm += __shfl_xor(sm, 16); sm += __shfl_xor(sm, 32);
        const float mean = sm * (1.0f / 64.f);
        float sq = 0.f;
#pragma unroll
        for (int q = 0; q < 4; ++q)
#pragma unroll
            for (int j = 0; j < 4; ++j) { const float d = acc[q][j] - mean; sq += d * d; }
        sq += __shfl_xor(sq, 16); sq += __shfl_xor(sq, 32);
        const float rstd = rsqrtf(sq * (1.0f / 64.f) + 64e-5f);
        const size_t tok = (size_t)b * S + pc * 64 + 16 * tmw + fr;
        float bon = 0.f; f32x4 vv[4];
#pragma unroll
        for (int q = 0; q < 4; ++q) {
            const int c = h * 64 + 16 * q + 4 * fq;
            const v2u rw = *(const v2u*)(RVg + tok * D + c), k0 = *(const v2u*)(KDg + tok * 512 + c), k1 = *(const v2u*)(KDg + ((size_t)T + tok) * 512 + c), vw = *(const v2u*)(RVg + tok * D + 512 + c);
            const f32x4 rk4 = *(const f32x4*)(r_k + c);
            vv[q] = (f32x4){bflo(vw.x), bfhi(vw.x), bflo(vw.y), bfhi(vw.y)};
            bon += bflo(rw.x) * (bflo(k0.x) + bflo(k1.x)) * rk4[0] + bfhi(rw.x) * (bfhi(k0.x) + bfhi(k1.x)) * rk4[1] + bflo(rw.y) * (bflo(k0.y) + bflo(k1.y)) * rk4[2] + bfhi(rw.y) * (bfhi(k0.y) + bfhi(k1.y)) * rk4[3];
        }
        bon += __shfl_xor(bon, 16); bon += __shfl_xor(bon, 32);
#pragma unroll
        for (int q = 0; q < 4; ++q) {
            const int c = h * 64 + 16 * q + 4 * fq;
            const v2u gw_ = *(const v2u*)(Gg + tok * 512 + c); const f32x4 g4 = {bflo(gw_.x), bfhi(gw_.x), bflo(gw_.y), bfhi(gw_.y)}, lg = *(const f32x4*)(lng + c), lb = *(const f32x4*)(lnb + c);
            float o[4];
#pragma unroll
            for (int j = 0; j < 4; ++j) o[j] = ((acc[q][j] - mean) * rstd * lg[j] + lb[j] + bon * vv[q][j]) * g4[j];
            v2u w; w.x = pk2(o[0], o[1]); w.y = pk2(o[2], o[3]);
            *(v2u*)(Y + tok * D + 512 + c) = w;
        }
    }
}


__device__ __forceinline__ bf16x8 pack8(float a0, float a1, float a2, float a3, float a4, float a5, float a6, float a7) {
    v4u p; p.x = pk2(a0, a1); p.y = pk2(a2, a3); p.z = pk2(a4, a5); p.w = pk2(a6, a7);
    return __builtin_bit_cast(bf16x8, p);
}
#define MMA32(acc, af, bf_) acc = __builtin_amdgcn_mfma_f32_32x32x16_bf16(af, bf_, acc, 0, 0, 0)
__device__ __forceinline__ void xattn_mfma(const bf16_t* Qb, const bf16_t* Kb, const bf16_t* Vt, bf16_t* Y, unsigned char* lds_raw) {
    LAS unsigned char* L = (LAS unsigned char*)lds_raw;
    constexpr int KRS = 528, VRS = 520;
    const int tid = tidx(), lane = tid & 63, wave = tid >> 6, r = lane & 31, h2 = lane >> 5;
    for (int it = blockIdx.x; it < 256; it += gridDim.x) {
        const int qblk = it & 31, h = (it >> 5) & 3, b = it >> 7;
        const size_t tok = (size_t)b * S + qblk * 256 + wave * 32 + r;
        bf16x8 qf[16];
#pragma unroll
        for (int ks = 0; ks < 16; ++ks) qf[ks] = *(const bf16x8*)(Qb + tok * D + h * 256 + 16 * ks + 8 * h2);
        __syncthreads();
#pragma unroll
        for (int hf = 0; hf < 2; ++hf) {
            v4u stg[8];
#pragma unroll
            for (int q = 0; q < 8; ++q) { const int p = tid + 512 * (8 * hf + q); stg[q] = *(const v4u*)(Kb + (size_t)(b * MEM + (p >> 5)) * 1024 + h * 256 + (p & 31) * 8); }
#pragma unroll
            for (int q = 0; q < 8; ++q) { const int p = tid + 512 * (8 * hf + q); *(LAS v4u*)(L + (p >> 5) * KRS + (p & 31) * 16) = stg[q]; }
        }
        __syncthreads();
        float mx = -3.0e38f;
#pragma unroll 1
        for (int kb = 0; kb < 8; ++kb) {
            f32x16 st;
#pragma unroll
            for (int g = 0; g < 16; ++g) st[g] = 0.f;
            const LAS unsigned char* kp = L + (32 * kb + r) * KRS + 16 * h2;
#pragma unroll
            for (int ks = 0; ks < 16; ++ks) { const bf16x8 kf = *(const LAS bf16x8*)(kp + 32 * ks); MMA32(st, kf, qf[ks]); }
#pragma unroll
            for (int g = 0; g < 16; ++g) mx = fmaxf(mx, st[g]);
        }
        mx = fmaxf(mx, __shfl_xor(mx, 32));
        const float cs = 0.0625f * 1.4426950408889634f;
        float l = 0.f;
        bf16x8 pf[8][2];
#pragma unroll
        for (int kb = 0; kb < 8; ++kb) {
            f32x16 st;
#pragma unroll
            for (int g = 0; g < 16; ++g) st[g] = 0.f;
            const LAS unsigned char* kp = L + (32 * kb + r) * KRS + 16 * h2;
#pragma unroll
            for (int ks = 0; ks < 16; ++ks) { const bf16x8 kf = *(const LAS bf16x8*)(kp + 32 * ks); MMA32(st, kf, qf[ks]); }
#pragma unroll
            for (int g = 0; g < 16; ++g) { st[g] = __builtin_amdgcn_exp2f((st[g] - mx) * cs); l += st[g]; }
#pragma unroll
            for (int s2 = 0; s2 < 2; ++s2) pf[kb][s2] = pack8(st[8 * s2], st[8 * s2 + 1], st[8 * s2 + 2], st[8 * s2 + 3], st[8 * s2 + 4], st[8 * s2 + 5], st[8 * s2 + 6], st[8 * s2 + 7]);
            __builtin_amdgcn_sched_barrier(0);
        }
        l += __shfl_xor(l, 32);
        const float inv = 1.0f / l;
        __syncthreads();
#pragma unroll
        for (int hf = 0; hf < 2; ++hf) {
            v4u stg[8];
#pragma unroll
            for (int q = 0; q < 8; ++q) { const int p = tid + 512 * (8 * hf + q); stg[q] = *(const v4u*)(Vt + ((size_t)(b * 1024 + h * 256 + (p >> 5))) * 256 + (p & 31) * 8); }
#pragma unroll
            for (int q = 0; q < 8; ++q) { const int p = tid + 512 * (8 * hf + q); LAS v2u* lp = (LAS v2u*)(L + (p >> 5) * VRS + (p & 31) * 16);
                v2u a_; a_.x = stg[q].x; a_.y = stg[q].y; lp[0] = a_; a_.x = stg[q].z; a_.y = stg[q].w; lp[1] = a_; }
        }
        __syncthreads();
#pragma unroll 1
        for (int db = 0; db < 8; ++db) {
            f32x16 acc;
#pragma unroll
            for (int g = 0; g < 16; ++g) acc[g] = 0.f;
            const LAS unsigned char* vp = L + (32 * db + r) * VRS + 8 * h2;
#pragma unroll
            for (int kb = 0; kb < 8; ++kb)
#pragma unroll
                for (int s2 = 0; s2 < 2; ++s2) {
                    const v2u lo = *(const LAS v2u*)(vp + (32 * kb + 16 * s2) * 2), hi = *(const LAS v2u*)(vp + (32 * kb + 16 * s2 + 8) * 2);
                    v4u av; av.x = lo.x; av.y = lo.y; av.z = hi.x; av.w = hi.y;
                    MMA32(acc, __builtin_bit_cast(bf16x8, av), pf[kb][s2]);
                }
            int tl_ = tid; asm volatile("" : "+v"(tl_));
            bf16_t* yp = Y + ((size_t)b * S + qblk * 256 + (tl_ >> 6) * 32 + (tl_ & 31)) * D + h * 256 + 32 * db + 4 * ((tl_ >> 5) & 1);
#pragma unroll
            for (int g = 0; g < 4; ++g) { v2u w; w.x = pk2(acc[4 * g] * inv, acc[4 * g + 1] * inv); w.y = pk2(acc[4 * g + 2] * inv, acc[4 * g + 3] * inv); *(v2u*)(yp + 8 * g) = w; }
        }
    }
}
template <bool F32OUT>
__device__ __forceinline__ void combine_norm(float* X, const bf16_t* YE, const int* SLOT, const float* g, bf16_t* Hout, float* Fout) {
    const int tix_ = tidx(); const int lane = tix_ & 63, gw = blockIdx.x * 8 + (tix_ >> 6), ngw = gridDim.x * 8;
    for (int m = gw; m < T; m += ngw) {
        float4* xr = (float4*)(X + (size_t)m * D);
        float4 v[4];
#pragma unroll
        for (int j = 0; j < 4; ++j) v[j] = xr[lane + 64 * j];
        const int myslot = SLOT[(size_t)m * NE + (lane & 15)];
#pragma unroll
        for (int e = 0; e < 16; ++e) {
            const int row = __builtin_amdgcn_readlane(myslot, e);
            if (row >= 0) {
                const v2u* yp = (const v2u*)(YE + (size_t)row * D);
#pragma unroll
                for (int j = 0; j < 4; ++j) { const v2u w = yp[lane + 64 * j];
                    v[j].x += __uint_as_float(w.x << 16); v[j].y += __uint_as_float(w.x & 0xffff0000u); v[j].z += __uint_as_float(w.y << 16); v[j].w += __uint_as_float(w.y & 0xffff0000u); }
            }
        }
        float s = 0.f;
#pragma unroll
        for (int j = 0; j < 4; ++j) { if (!F32OUT) xr[lane + 64 * j] = v[j]; s += v[j].x * v[j].x + v[j].y * v[j].y + v[j].z * v[j].z + v[j].w * v[j].w; }
        const float r = rsqrtf(wave_sum(s) * (1.0f / D) + 1e-6f);
#pragma unroll
        for (int j = 0; j < 4; ++j) { const float4 gg = ((const float4*)g)[lane + 64 * j];
            if (F32OUT) ((float4*)(Fout + (size_t)m * D))[lane + 64 * j] = make_float4(v[j].x * r * gg.x, v[j].y * r * gg.y, v[j].z * r * gg.z, v[j].w * r * gg.w);
            else { v2u w; w.x = pk2(v[j].x * r * gg.x, v[j].y * r * gg.y); w.y = pk2(v[j].z * r * gg.z, v[j].w * r * gg.w); ((v2u*)(Hout + (size_t)m * D))[lane + 64 * j] = w; } }
    }
}


template <int NK, bool SINK>
__device__ __forceinline__ void attn_block(const bf16_t* Qh, const bf16_t* Kh, const bf16_t* Vh, int dd, int Lr, int b, int rho, int q0b, float sink2,
                                           bf16_t* Odst, int ostride, float* lsedst, unsigned char* lds_raw) {
    constexpr int NKEY = 256 + 64 * NK, KRS = 144, VRS = NKEY * 2 + 8;
    LAS unsigned char* Ks = (LAS unsigned char*)lds_raw; LAS unsigned char* Vs = Ks + NKEY * KRS;
    const int tid = tidx(), lane = tid & 63, wave = tid >> 6, r = lane & 31, h2 = lane >> 5;
    const int kq_base = q0b - 32 * NK;
    __syncthreads();
#pragma unroll
    for (int i = 0; i < NKEY * 8 / 512; ++i) {
        const int p = tid + 512 * i, row = p >> 3, piece = p & 7, kq = kq_base + row;
        if (kq >= 0 && kq < Lr) {
            const size_t tokk = (size_t)b * S + (size_t)kq * dd + rho;
            const v4u kx = *(const v4u*)(Kh + tokk * 64 + piece * 8), vx = *(const v4u*)(Vh + tokk * 64 + piece * 8);
            *(LAS v4u*)(Ks + row * KRS + piece * 16) = kx;
            LAS unsigned char* vp = Vs + (piece * 8) * VRS + row * 2;
#pragma unroll
            for (int e = 0; e < 4; ++e) { *(LAS unsigned short*)(vp + (2 * e) * VRS) = (unsigned short)(vx[e] & 0xffffu); *(LAS unsigned short*)(vp + (2 * e + 1) * VRS) = (unsigned short)(vx[e] >> 16); }
        }
    }
    const int q0 = q0b + 32 * wave;
    const size_t qtok = (size_t)b * S + (size_t)(q0 + r) * dd + rho;
    bf16x8 qf[4];
#pragma unroll
    for (int ks = 0; ks < 4; ++ks) qf[ks] = *(const bf16x8*)(Qh + qtok * 64 + 16 * ks + 8 * h2);
    __syncthreads();
    f32x16 o[2];
#pragma unroll
    for (int db = 0; db < 2; ++db)
#pragma unroll
        for (int g = 0; g < 16; ++g) o[db][g] = 0.f;
    float m = SINK ? sink2 : -1.0e30f, l = SINK ? 1.f : 0.f;
    const int kb_lo = max(-NK, -(q0 >> 5)), kb_hi = min(NK, (Lr - 32 - q0) >> 5);
#pragma unroll 1
    for (int kb = kb_lo; kb <= kb_hi; ++kb) {
        const int kw0 = 32 * (wave + kb + NK);
        f32x16 st;
#pragma unroll
        for (int g = 0; g < 16; ++g) st[g] = 0.f;
        const LAS unsigned char* kp = Ks + (kw0 + r) * KRS + 16 * h2;
#pragma unroll
        for (int ks = 0; ks < 4; ++ks) { const bf16x8 kf = *(const LAS bf16x8*)(kp + 32 * ks); MMA32(st, kf, qf[ks]); }
        if (kb == -NK || kb == NK) {
#pragma unroll
            for (int g = 0; g < 16; ++g) { const int cr = (g & 3) + 8 * (g >> 2) + 4 * h2; const bool ok = (kb < 0) ? (cr >= r) : (cr <= r); st[g] = ok ? st[g] : -1.0e30f; }
        }
        float bm = st[0];
#pragma unroll
        for (int g = 1; g < 16; ++g) bm = fmaxf(bm, st[g]);
        bm = fmaxf(bm, __shfl_xor(bm, 32));
        const float mn = fmaxf(m, bm), al = __builtin_amdgcn_exp2f(m - mn);
        float ls = 0.f;
#pragma unroll
        for (int g = 0; g < 16; ++g) { st[g] = __builtin_amdgcn_exp2f(st[g] - mn); ls += st[g]; }
        ls += __shfl_xor(ls, 32);
        l = l * al + ls; m = mn;
#pragma unroll
        for (int db = 0; db < 2; ++db)
#pragma unroll
            for (int g = 0; g < 16; ++g) o[db][g] *= al;
        bf16x8 pf[2];
#pragma unroll
        for (int s2 = 0; s2 < 2; ++s2) pf[s2] = pack8(st[8 * s2], st[8 * s2 + 1], st[8 * s2 + 2], st[8 * s2 + 3], st[8 * s2 + 4], st[8 * s2 + 5], st[8 * s2 + 6], st[8 * s2 + 7]);
#pragma unroll
        for (int db = 0; db < 2; ++db) {
            const LAS unsigned char* vp = Vs + (32 * db + r) * VRS + (kw0 + 4 * h2) * 2;
#pragma unroll
            for (int s2 = 0; s2 < 2; ++s2) {
                const v2u lo = *(const LAS v2u*)(vp + 32 * s2), hi = *(const LAS v2u*)(vp + 32 * s2 + 16);
                v4u av; av.x = lo.x; av.y = lo.y; av.z = hi.x; av.w = hi.y;
                MMA32(o[db], __builtin_bit_cast(bf16x8, av), pf[s2]);
            }
        }
    }
    const float inv = 1.0f / l;
#pragma unroll
    for (int db = 0; db < 2; ++db) {
        bf16_t* op = Odst + qtok * ostride + 32 * db + 4 * h2;
#pragma unroll
        for (int g = 0; g < 4; ++g) { v2u w; w.x = pk2(o[db][4 * g] * inv, o[db][4 * g + 1] * inv); w.y = pk2(o[db][4 * g + 2] * inv, o[db][4 * g + 3] * inv); *(v2u*)(op + 8 * g) = w; }
    }
    if (lsedst != nullptr && h2 == 0) lsedst[qtok * 8] = (m + __builtin_amdgcn_logf(l)) * 0.6931471805599453f;
}

__device__ __forceinline__ void attn_phase_even(const bf16_t* QhA, const bf16_t* KhA, const bf16_t* VhA, const bf16_t* QhB, const bf16_t* KhB, const bf16_t* VhB,
                                                const float* sink, bf16_t* OA, float* LSE, bf16_t* Y, unsigned char* lds_raw) {
    for (int it = blockIdx.x; it < 2048; it += gridDim.x) {
        if (it < 512) {
            const int hq = it >> 6, rem2 = it & 63, b = rem2 >> 5, q0b = (rem2 & 31) * 256, kvh = hq >> 2;
            attn_block<4, true>(QhB + (size_t)hq * T * 64, KhB + (size_t)kvh * T * 64, VhB + (size_t)kvh * T * 64, 1, S, b, 0, q0b, sink[hq] * 1.4426950408889634f,
                                Y + 512 + hq * 64, D, nullptr, lds_raw);
        } else {
            const int ita = it - 512, p = ita >> 9, rem = ita & 511, head = rem >> 6, rem2 = rem & 63, b = rem2 >> 5, rem3 = rem2 & 31;
            const int dd = p == 0 ? 1 : (p == 1 ? 4 : 16), bpr = 32 / dd, rho = rem3 / bpr, q0b = (rem3 % bpr) * 256;
            attn_block<2, false>(QhA + (size_t)head * T * 64, KhA + (size_t)head * T * 64, VhA + (size_t)head * T * 64, dd, S / dd, b, rho, q0b, 0.f,
                                 OA + (size_t)p * T * 512 + head * 64, 512, LSE + (size_t)p * T * 8 + head, lds_raw);
        }
    }
}
__device__ __forceinline__ void attn_combine(const bf16_t* OA, const float* LSE, bf16_t* Y) {
    const int gt = blockIdx.x * NTH + tidx(), ngt = gridDim.x * NTH;
    for (int i = gt; i < T * 64; i += ngt) {
        const int tok = i >> 6, head = (i >> 3) & 7, c8 = i & 7;
        const float l0 = LSE[(size_t)tok * 8 + head], l1 = LSE[((size_t)T + tok) * 8 + head], l2 = LSE[((size_t)2 * T + tok) * 8 + head];
        const float mx = fmaxf(l0, fmaxf(l1, l2));
        float w0 = __expf(l0 - mx), w1 = __expf(l1 - mx), w2 = __expf(l2 - mx);
        const float inv = 1.0f / (w0 + w1 + w2); w0 *= inv; w1 *= inv; w2 *= inv;
        const size_t off = (size_t)tok * 512 + head * 64 + c8 * 8;
        const v4u x0 = *(const v4u*)(OA + off), x1 = *(const v4u*)(OA + (size_t)T * 512 + off), x2 = *(const v4u*)(OA + (size_t)2 * T * 512 + off);
        v4u w;
#pragma unroll
        for (int q = 0; q < 4; ++q) {
            const float lo = w0 * __uint_as_float(x0[q] << 16) + w1 * __uint_as_float(x1[q] << 16) + w2 * __uint_as_float(x2[q] << 16);
            const float hi = w0 * __uint_as_float(x0[q] & 0xffff0000u) + w1 * __uint_as_float(x1[q] & 0xffff0000u) + w2 * __uint_as_float(x2[q] & 0xffff0000u);
            w[q] = pk2(lo, hi);
        }
        *(v4u*)(Y + (size_t)tok * D + head * 64 + c8 * 8) = w;
    }
}


__device__ __forceinline__ void odd_token_pass(const bf16_t* P, const float* mu, const float* k_k, const float* clg, const float* clb,
                                               bf16_t* VN, bf16_t* RV, bf16_t* KBf, bf16_t* KK, bf16_t* F5) {
    const int tix_ = tidx(); const int lane = tix_ & 63, gw = blockIdx.x * 8 + (tix_ >> 6), ngw = gridDim.x * 8;
    for (int tok = gw; tok < T; tok += ngw) {
        const int s = tok & (S - 1);
        const bf16_t* pr = P + (size_t)tok * ODD_PAD;
        {
            float ge[8]; float sm = 0.f;
#pragma unroll
            for (int jj = 0; jj < 4; ++jj) { const unsigned w = *(const unsigned*)(pr + 512 + 2 * lane + 128 * jj);
                ge[2 * jj] = gelu_tanh(__uint_as_float(w << 16)); ge[2 * jj + 1] = gelu_tanh(__uint_as_float(w & 0xffff0000u)); sm += ge[2 * jj] + ge[2 * jj + 1]; }
            const float mean = wave_sum(sm) * (1.0f / 512.f); float sq = 0.f;
#pragma unroll
            for (int j = 0; j < 8; ++j) { const float d = ge[j] - mean; sq += d * d; }
            const float rstd = rsqrtf(wave_sum(sq) * (1.0f / 512.f) + 1e-5f);
#pragma unroll
            for (int jj = 0; jj < 4; ++jj) { const int c = 2 * lane + 128 * jj; const float2 g2_ = *(const float2*)(clg + c), b2_ = *(const float2*)(clb + c);
                *(unsigned*)(VN + (size_t)tok * 512 + c) = pk2((ge[2 * jj] - mean) * rstd * g2_.x + b2_.x, (ge[2 * jj + 1] - mean) * rstd * g2_.y + b2_.y); }
        }
#pragma unroll
        for (int jj = 0; jj < 15; ++jj) {
            const int c = 2 * lane + 128 * jj;
            const unsigned wf = *(const unsigned*)(pr + 1024 + c);
            const unsigned wp = s > 0 ? *(const unsigned*)(pr + 1024 + c - ODD_PAD) : 0u;
            const unsigned wn = s < S - 1 ? *(const unsigned*)(pr + 1024 + c + ODD_PAD) : 0u;
            const float2 m0 = *(const float2*)(mu + c), m1 = *(const float2*)(mu + FD + c);
            const float f0 = __uint_as_float(wf << 16), f1 = __uint_as_float(wf & 0xffff0000u);
            const float x0 = f0 + m0.x * (__uint_as_float(wp << 16) - f0) + m1.x * (__uint_as_float(wn << 16) - f0);
            const float x1 = f1 + m0.y * (__uint_as_float(wp & 0xffff0000u) - f1) + m1.y * (__uint_as_float(wn & 0xffff0000u) - f1);
            if (jj < 4) *(unsigned*)(RV + (size_t)tok * D + c) = pk2(x0, x1);
            else if (jj < 8) {
                const int ck = c - 512;
                *(unsigned*)(KBf + (size_t)tok * 512 + ck) = pk2(x0, x1);
                const float2 kk_ = *(const float2*)(k_k + ck);
                const float a0_ = x0 * kk_.x, a1_ = x1 * kk_.y;
                float ss = a0_ * a0_ + a1_ * a1_;
#pragma unroll
                for (int o = 16; o >= 1; o >>= 1) ss += __shfl_xor(ss, o);
                const float inv = 1.0f / fmaxf(sqrtf(ss), 1e-12f);
                *(unsigned*)(KK + (size_t)tok * 512 + ck) = pk2(a0_ * inv, a1_ * inv);
            }
            else if (jj < 12) *(unsigned*)(RV + (size_t)tok * D + 512 + (c - 1024)) = pk2(x0, x1);
            else if (jj == 12) *(unsigned*)(F5 + (size_t)tok * 384 + (c - 1536)) = pk2(tanhf_(x0), tanhf_(x1));
            else if (jj == 13) *(unsigned*)(F5 + (size_t)tok * 384 + 128 + (c - 1664)) = pk2(x0, x1);
            else *(unsigned*)(F5 + (size_t)tok * 384 + 256 + (c - 1792)) = pk2(sigmoidf_(x0), sigmoidf_(x1));
        }
    }
}
__device__ __forceinline__ void gating_pass(const bf16_t* VN, const bf16_t* Wsb, const float* bsp, const bf16_t* P, bf16_t* Y, unsigned char* lds_raw) {
    LAS unsigned char* L = (LAS unsigned char*)lds_raw;
    constexpr int RS = 272;
    const int tid = tidx(), lane = tid & 63, wave = tid >> 6, fr = lane & 15, fq = lane >> 4;
    for (int it = blockIdx.x; it < 512; it += gridDim.x) {
        const int g = it & 3, chunk = it >> 2;
        __syncthreads();
        { const int j = tid >> 2, q4 = tid & 3;
          const v4u* gp = (const v4u*)(VN + (size_t)(chunk * 128 + j) * 512 + g * 128 + 32 * q4);
#pragma unroll
          for (int q = 0; q < 4; ++q) { const v4u x = gp[q];
#pragma unroll
              for (int e = 0; e < 4; ++e) { const int c = 32 * q4 + 8 * q + 2 * e;
                  *(LAS unsigned short*)(L + c * RS + 2 * j) = (unsigned short)(x[e] & 0xffffu); *(LAS unsigned short*)(L + (c + 1) * RS + 2 * j) = (unsigned short)(x[e] >> 16); } } }
        __syncthreads();
        bf16x8 lf[4];
#pragma unroll
        for (int ks = 0; ks < 4; ++ks) lf[ks] = *(const bf16x8*)(Wsb + (size_t)(g * 128 + 16 * wave + fr) * 128 + 32 * ks + 8 * fq);
        const int i = 16 * wave + fr; const size_t tok = (size_t)chunk * 128 + i;
        const float bias = bsp[g * 128 + i];
#pragma unroll
        for (int tn = 0; tn < 8; ++tn) {
            f32x4 acc = {0.f, 0.f, 0.f, 0.f};
#pragma unroll
            for (int ks = 0; ks < 4; ++ks) { const bf16x8 rf = *(const LAS bf16x8*)(L + (16 * tn + fr) * RS + (32 * ks + 8 * fq) * 2); MMA16(acc, lf[ks], rf); }
            const int c = g * 128 + 16 * tn + 4 * fq;
            const v2u uw = *(const v2u*)(P + tok * ODD_PAD + c);
            const float u0 = gelu_tanh(__uint_as_float(uw.x << 16)), u1 = gelu_tanh(__uint_as_float(uw.x & 0xffff0000u)), u2 = gelu_tanh(__uint_as_float(uw.y << 16)), u3 = gelu_tanh(__uint_as_float(uw.y & 0xffff0000u));
            v2u w; w.x = pk2(u0 * (acc[0] + bias), u1 * (acc[1] + bias)); w.y = pk2(u2 * (acc[2] + bias), u3 * (acc[3] + bias));
            *(v2u*)(Y + tok * D + c) = w;
        }
    }
}


__device__ __forceinline__ void router_pass(const float* X, const float* g, const float* WRT  , float* AFF, int* SLOT, bf16_t* H, unsigned char* lds_raw) {
    const int tix_ = tidx(); const int lane = tix_ & 63, wave = tix_ >> 6, fr = lane & 15, fq = lane >> 4;
    const int pair = wave >> 1, half = wave & 1;
    LAS float* xch = (LAS float*)lds_raw + pair * 512;
    for (int tile0 = blockIdx.x * 4; tile0 < T / 16; tile0 += gridDim.x * 4) {
        const int tile = tile0 + pair;
        const float* xr = X + (size_t)(tile * 16 + fr) * D + 4 * fq + 512 * half;
        const float* wr = WRT + (size_t)fr * D + 4 * fq + 512 * half;
        f32x4 acc = {0.f, 0.f, 0.f, 0.f}; float ss = 0.f;
#pragma unroll 8
        for (int s = 0; s < 32; ++s) {
            const f32x4 xa = *(const f32x4*)(xr + 16 * s), wb = *(const f32x4*)(wr + 16 * s);
            ss += (xa[0] * xa[0] + xa[1] * xa[1]) + (xa[2] * xa[2] + xa[3] * xa[3]);
#pragma unroll
            for (int c = 0; c < 4; ++c) acc = __builtin_amdgcn_mfma_f32_16x16x4f32(xa[c], wb[c], acc, 0, 0, 0);
        }
        ss += __shfl_xor(ss, 16); ss += __shfl_xor(ss, 32);
        __syncthreads();
        { LAS float* p = xch + half * 256 + lane * 4; p[0] = acc[0]; p[1] = acc[1]; p[2] = acc[2]; p[3] = acc[3]; }
        if (fq == 0) ((LAS float*)lds_raw + 2048 + pair * 32 + half * 16)[fr] = ss;
        __syncthreads();
        { const LAS float* p = xch + (half ^ 1) * 256 + lane * 4; acc[0] += p[0]; acc[1] += p[1]; acc[2] += p[2]; acc[3] += p[3]; }
        ss += ((const LAS float*)lds_raw + 2048 + pair * 32 + (half ^ 1) * 16)[fr];
        const float rstd = rsqrtf(ss * (1.0f / D) + 1e-6f);
        {
            float aff[4];
#pragma unroll
            for (int jj = 0; jj < 4; ++jj) {
                const float lg = acc[jj] * __shfl(rstd, 4 * fq + jj);
                float mx = lg;
#pragma unroll
                for (int o = 1; o < 16; o <<= 1) mx = fmaxf(mx, __shfl_xor(mx, o));
                const float e = expf(lg - mx); float den = e;
#pragma unroll
                for (int o = 1; o < 16; o <<= 1) den += __shfl_xor(den, o);
                aff[jj] = e / den;
            }
#pragma unroll
            for (int jj = 0; jj < 4; ++jj) { const size_t o = (size_t)(tile * 16 + 4 * fq + jj) * NE + fr; if ((fq >> 1) == half) { AFF[o] = aff[jj]; SLOT[o] = -1; } }
        }
#pragma unroll 4
        for (int tt = 0; tt < 8; ++tt) {
            const int t = 8 * half + tt;
            const float rs = __shfl(rstd, t);
            const f32x4* xp = (const f32x4*)(X + (size_t)(tile * 16 + t) * D); v2u* hp = (v2u*)(H + (size_t)(tile * 16 + t) * D);
#pragma unroll
            for (int j = 0; j < 4; ++j) { const f32x4 v = xp[lane + 64 * j], gg = ((const f32x4*)g)[lane + 64 * j];
                v2u w; w.x = pk2(v[0] * rs * gg[0], v[1] * rs * gg[1]); w.y = pk2(v[2] * rs * gg[2], v[3] * rs * gg[3]); hp[lane + 64 * j] = w; }
        }
    }
}


__device__ __forceinline__ void lora_pass(const bf16_t* F5, const bf16_t* WC, const float* w0, const float* a0, const float* k_a, const bf16_t* KB, const bf16_t* KK,
                                          bf16_t* LW, bf16_t* KD, bf16_t* BB, bf16_t* G, unsigned char* lds_raw) {
    LAS unsigned char* L = (LAS unsigned char*)lds_raw;
    constexpr int ARS = 784;
    const int tid = tidx(), lane = tid & 63, wave = tid >> 6, fr = lane & 15, fq = lane >> 4;
    for (int tile = blockIdx.x; tile < T / 64; tile += gridDim.x) {
        __syncthreads();
#pragma unroll
        for (int q = 0; q < 6; ++q) { const int p = tid + 512 * q, row = p / 48, piece = p % 48;
            *(LAS v4u*)(L + row * ARS + piece * 16) = *(const v4u*)(F5 + (size_t)(tile * 64 + row) * 384 + piece * 8); }
        __syncthreads();
#pragma unroll 1
        for (int sec = 0; sec < 5; ++sec) {
            const int K0 = sec * 64, nks = sec < 4 ? 2 : 4, wstride = sec < 4 ? 64 : 128;
            const bf16_t* Wp = WC + (size_t)sec * 512 * 64 + (size_t)(64 * wave) * wstride;
#pragma unroll 1
            for (int nh = 0; nh < 2; ++nh) {
            f32x4 acc[4][2];
#pragma unroll
            for (int tm = 0; tm < 4; ++tm)
#pragma unroll
                for (int tn = 0; tn < 2; ++tn) acc[tm][tn] = (f32x4){0.f, 0.f, 0.f, 0.f};
            for (int ks = 0; ks < nks; ++ks) {
                bf16x8 lf[4], rf[2];
#pragma unroll
                for (int tm = 0; tm < 4; ++tm) lf[tm] = *(const LAS bf16x8*)(L + (16 * tm + fr) * ARS + (K0 + 32 * ks + 8 * fq) * 2);
#pragma unroll
                for (int tn = 0; tn < 2; ++tn) rf[tn] = *(const bf16x8*)(Wp + (size_t)(16 * (2 * nh + tn) + fr) * wstride + 32 * ks + 8 * fq);
#pragma unroll
                for (int tm = 0; tm < 4; ++tm)
#pragma unroll
                    for (int tn = 0; tn < 2; ++tn) MMA16(acc[tm][tn], lf[tm], rf[tn]);
            }
#pragma unroll
            for (int tn = 0; tn < 2; ++tn) {
                const int cc = 64 * wave + 16 * (2 * nh + tn) + 4 * fq;
#pragma unroll
                for (int tm = 0; tm < 4; ++tm) {
                    const size_t tok = (size_t)tile * 64 + 16 * tm + fr; const f32x4 v = acc[tm][tn];
                    __builtin_amdgcn_sched_barrier(0);
                    if (sec < 2) {
                        const f32x4 w = *(const f32x4*)(w0 + sec * 512 + cc); float o[4];
#pragma unroll
                        for (int j = 0; j < 4; ++j) o[j] = -0.6065306597126334f * frcp(1.0f + __expf(-(w[j] + v[j])));
                        v2u ww; ww.x = pk2(o[0], o[1]); ww.y = pk2(o[2], o[3]);
                        *(v2u*)(LW + ((size_t)sec * T + tok) * 512 + cc) = ww;
                    } else if (sec < 4) {
                        const int d = sec - 2;
                        const f32x4 a_ = *(const f32x4*)(a0 + d * 512 + cc), ka = *(const f32x4*)(k_a + cc);
                        const v2u kw = *(const v2u*)(KB + tok * 512 + cc), kkw = *(const v2u*)(KK + tok * 512 + cc);
                        const float kv[4] = {bflo(kw.x), bfhi(kw.x), bflo(kw.y), bfhi(kw.y)}, kk[4] = {bflo(kkw.x), bfhi(kkw.x), bflo(kkw.y), bfhi(kkw.y)};
                        float okd[4], obb[4];
#pragma unroll
                        for (int j = 0; j < 4; ++j) { const float alr = frcp(1.0f + __expf(-(a_[j] + v[j]))); okd[j] = kv[j] * (1.0f + (alr - 1.0f) * ka[j]); obb[j] = kk[j] * alr; }
                        v2u w1, w2_; w1.x = pk2(okd[0], okd[1]); w1.y = pk2(okd[2], okd[3]); w2_.x = pk2(obb[0], obb[1]); w2_.y = pk2(obb[2], obb[3]);
                        *(v2u*)(KD + ((size_t)d * T + tok) * 512 + cc) = w1; *(v2u*)(BB + ((size_t)d * T + tok) * 512 + cc) = w2_;
                    } else { v2u ww; ww.x = pk2(v[0], v[1]); ww.y = pk2(v[2], v[3]); *(v2u*)(G + tok * 512 + cc) = ww; }
                }
            }
            }
        }
    }
}

#define IN(k) (lo <= (k) && (k) < hi)
#define REP_LOOP for (int rep_ = 0, nrep_ = ((ph == PROBE_PHASE) ? PROBE_REP : 1); rep_ < nrep_; ++rep_)
#define SEAM(k) do { if (IN(k) && IN((k) + 1)) xcd_barrier(bar); } while (0)
#define PROLOG \
    const int tid = tidx(), lane = tid & 63, wave = tid >> 6; \
    const int bid = blockIdx.x, nb = gridDim.x; \
    const int gw = bid * 8 + wave, ngw = nb * 8; \
    const int gt = bid * NTH + tid, ngt = nb * NTH; \
    (void)gt; (void)ngt; (void)gw; (void)ngw; (void)lane; (void)wave; \
    unsigned char* ws = a.ws; \
    const int lo = a.lo, hi = a.hi; \
    float* ldsf = (float*)lds_raw; (void)ldsf; \
    PG8_LAS unsigned char* ldsp = (PG8_LAS unsigned char*)lds_raw; (void)ldsp; \
    const float* x_in = a.in[0]; const float* mem = a.in[1]; (void)x_in; (void)mem; \
    float* ropec = (float*)(ws + WS_ROPE); float* ropes = ropec + S * 32; (void)ropec; (void)ropes; \
    float* AFF = (float*)(ws + WS_AFF); int* TOK = (int*)(ws + WS_TOK); float* GATE = (float*)(ws + WS_GATE); \
    float* X = (float*)(ws + WS_X); bf16_t* H = (bf16_t*)(ws + WS_H); bf16_t* P = (bf16_t*)(ws + WS_P); \
    bf16_t* Y = (bf16_t*)(ws + WS_Y); bf16_t* Q = (bf16_t*)(ws + WS_Q); bf16_t* KV = (bf16_t*)(ws + WS_KV); bf16_t* MN = (bf16_t*)(ws + WS_MN); \
    bf16_t* DEC = (bf16_t*)(ws + WS_DEC); bf16_t* KD = (bf16_t*)(ws + WS_KD); bf16_t* BB = (bf16_t*)(ws + WS_BB); \
    bf16_t* KK = (bf16_t*)(ws + WS_KK); bf16_t* G = (bf16_t*)(ws + WS_G); float* YS = (float*)(ws + WS_YS); \
    bf16_t* RV = (bf16_t*)(ws + WS_RV); bf16_t* VN = (bf16_t*)(ws + WS_VN); \
    bf16_t* XE = (bf16_t*)(ws + WS_XE); bf16_t* HID = (bf16_t*)(ws + WS_HID); int* SLOT = (int*)(ws + WS_SLOT); bf16_t* YE = (bf16_t*)(ws + WS_YE); (void)SLOT; (void)YE; \
    (void)AFF; (void)TOK; (void)GATE; (void)X; (void)H; (void)P; (void)Y; (void)Q; (void)KV; (void)MN; (void)DEC; (void)KD; (void)BB; (void)KK; (void)G; (void)YS; (void)RV; (void)VN; (void)XE; (void)HID;

template <class Epi>
__device__ __forceinline__ void dense_gemm(PG8_LAS unsigned char* ldsp, const bf16_t* A, const bf16_t* Bt, int M, int N, int K, const Epi& E, int cshift = 0) {
    asm volatile("" : "+s"(K));
    pg8::Gemm g{A, Bt, M, N, K}; pg8::StaticOrder So; So.init(M, N, (int)gridDim.x, (int)((blockIdx.x + cshift) % gridDim.x));
    pg8::gemm_phase<Epi, pg8::StaticOrder, false>(ldsp, g, So, E, nullptr);
}

__device__ __forceinline__ int odd_phases(const Args& a, const XcdBarrier& bar, unsigned char* lds_raw, int ph) {
    PROLOG
    if (IN(ph)) combine_norm<false>(X, YE, SLOT, a.in[6], H, nullptr);
    SEAM(ph); ++ph;
    if (IN(ph)) dense_gemm(ldsp, H, (const bf16_t*)(ws + WS_WOIN), T, ODD_PAD, D, EpiBf16Store{P, ODD_PAD, 1.0f});
    SEAM(ph); ++ph;
    if (IN(ph)) REP_LOOP odd_token_pass(P, a.in[12], a.in[18], a.in[8], a.in[9], VN, RV, (bf16_t*)(ws + WS_KB), KK, (bf16_t*)(ws + WS_F5));
    SEAM(ph); ++ph;
    if (IN(ph)) REP_LOOP {
        gating_pass(VN, (const bf16_t*)(ws + WS_WSB), a.in[11], P, Y, lds_raw);
        __syncthreads();
        lora_pass((const bf16_t*)(ws + WS_F5), (const bf16_t*)(ws + WS_WL), a.in[13], a.in[15], a.in[19], (const bf16_t*)(ws + WS_KB), KK, DEC, KD, BB, G, lds_raw);
    }
    SEAM(ph); ++ph;
    if (IN(ph)) REP_LOOP scan_r1(DEC, RV, KD, KK, BB, (bf16_t*)(ws + WS_PT), (bf16_t*)(ws + WS_QT), (bf16_t*)(ws + WS_RH), (float*)(ws + WS_YL), lds_raw);
    SEAM(ph); ++ph;
    if (IN(ph)) REP_LOOP {
        if (bid < 32) scan_r2((const bf16_t*)(ws + WS_PT), (const bf16_t*)(ws + WS_QT), (bf16_t*)(ws + WS_S0), lds_raw);
        else {
            LAS float* scr = (LAS float*)((LAS unsigned char*)lds_raw + wave * 16896);
            const int gw2 = (bid - 32) * 8 + wave, ngw2 = (nb - 32) * 8;
            auto gmap = [](int n) { return (n >> 7) * 256 + (n & 127); };
            auto umap = [](int n) { return (n >> 7) * 256 + 128 + (n & 127); };
            for (int it = gw2; it < 16 * 704; it += ngw2) { const int e = it / 704, r = it % 704;
                transpose_item_fp8(a.in[31] + (size_t)(16 + e) * D * DE, D, DE, ws + WS_WGU8 + 176 * MiB + (size_t)e * 5632 * D, gmap, GUSC8, scr, r, lane); }
            for (int it = gw2; it < 16 * 704; it += ngw2) { const int e = it / 704, r = it % 704;
                transpose_item_fp8(a.in[32] + (size_t)(16 + e) * D * DE, D, DE, ws + WS_WGU8 + 176 * MiB + (size_t)e * 5632 * D, umap, GUSC8, scr, r, lane); }
        }
    }
    SEAM(ph); ++ph;
    if (IN(ph)) REP_LOOP scan_r3((const bf16_t*)(ws + WS_RH), (const float*)(ws + WS_YL), (const bf16_t*)(ws + WS_S0), RV, KD, G, a.in[20], a.in[21], a.in[22], Y);
    SEAM(ph); ++ph;
    if (IN(ph)) dense_gemm(ldsp, Y, (const bf16_t*)(ws + WS_WOOUT), T, D, D, EpiResidN{X, X, H, (float*)(ws + WS_SSP)});
    SEAM(ph); ++ph;
    return ph;
}

template <int layer>
__device__ __forceinline__ int tail_phases(const Args& a, const XcdBarrier& bar, unsigned char* lds_raw, int ph) {
    PROLOG
    if (IN(ph)) REP_LOOP {
        int Kq = D; asm volatile("" : "+s"(Kq));
        pg8::Gemm g{H, (const bf16_t*)(ws + WS_WQ) + (size_t)layer * D * D, T, D, Kq}; XattnOrder So{(int)blockIdx.x};
        pg8::gemm_phase<EpiBf16StoreRS, XattnOrder, false>(ldsp, g, So, EpiBf16StoreRS{Q, D, (const float*)(ws + WS_SSP)}, nullptr);
        asm volatile("s_waitcnt vmcnt(0)" ::: "memory");
        __syncthreads();
        xattn_mfma(Q, KV + (size_t)layer * 1024 * 1024, KV + (size_t)layer * 1024 * 1024 + 512 * 1024, Y, lds_raw);
    }
    SEAM(ph); ++ph;
    if (IN(ph)) dense_gemm(ldsp, Y, (const bf16_t*)(ws + WS_WO) + (size_t)layer * D * D, T, D, D, EpiResid{X, X});
    SEAM(ph); ++ph;
    if (IN(ph)) REP_LOOP router_pass(X, a.in[29] + layer * D, (const float*)(ws + WS_WRT) + (size_t)layer * NE * D, AFF, SLOT, H, lds_raw);
    SEAM(ph); ++ph;
    if (IN(ph)) REP_LOOP {
        unsigned* keys = (unsigned*)ldsf;
        int* hist = (int*)(ldsf + 8192);
        int* sh = hist + 8 * 256;
        if (bid >= 32) {
            LAS float* scr = (LAS float*)((LAS unsigned char*)lds_raw + wave * 16896);
            const int gw2 = (bid - 32) * 8 + wave, ngw2 = (nb - 32) * 8;
            auto ident = [](int n) { return n; };
            for (int it = gw2; it < 16 * 704; it += ngw2) { const int mt = layer * 16 + it / 704, r = it % 704;
                if constexpr (layer == 1 || F8L0) transpose_item_fp8(a.in[33] + (size_t)mt * DE * D, DE, D, ws + WS_WD8 + (size_t)layer * 88 * MiB + (size_t)(mt - 16 * layer) * D * DE, ident, DSC8, scr, r, lane);
                else transpose_item(a.in[33] + (size_t)mt * DE * D, DE, D, (bf16_t*)(ws + WS_WD) + (size_t)mt * D * DE, ident, scr, r, lane); }
        }
        for (int be = bid; be < NB * NE && be < 32; be += nb) {
            const int b = be >> 4, e = be & 15, eb = e * 2 + b;
            __syncthreads();
            for (int s = tid; s < S; s += NTH) keys[s] = __float_as_uint(AFF[(size_t)(b * S + s) * NE + e]);
            unsigned prefix = 0u; int krem = CAP;
            for (int pass = 3; pass >= 0; --pass) {
                __syncthreads();
                for (int i = tid; i < 8 * 256; i += NTH) hist[i] = 0;
                __syncthreads();
                const unsigned hmask = pass == 3 ? 0u : (0xFFFFFFFFu << (8 * (pass + 1)));
                for (int s = tid; s < S; s += NTH) { const unsigned k = keys[s]; if ((k & hmask) == prefix) atomicAdd(&hist[wave * 256 + ((k >> (8 * pass)) & 255u)], 1); }
                __syncthreads();
                if (wave == 0) {
                    int c4[4], s4 = 0;
#pragma unroll
                    for (int j = 0; j < 4; ++j) { const int bin = 255 - (4 * lane + j); int c = 0;
#pragma unroll
                        for (int w = 0; w < 8; ++w) c += hist[w * 256 + bin];
                        c4[j] = c; s4 += c; }
                    int pre = s4;
#pragma unroll
                    for (int o = 1; o < 64; o <<= 1) { const int y = __shfl_up(pre, o); if (lane >= o) pre += y; }
                    const int excl = pre - s4;
                    if (excl < krem && krem <= pre) {
                        int cum = excl, bsel = 0, rem = 0; bool found = false;
#pragma unroll
                        for (int j = 0; j < 4; ++j) { if (!found && cum + c4[j] >= krem) { bsel = 255 - (4 * lane + j); rem = krem - cum; found = true; } if (!found) cum += c4[j]; }
                        sh[8] = bsel; sh[9] = rem;
                    }
                }
                __syncthreads();
                prefix |= ((unsigned)sh[8]) << (8 * pass); krem = sh[9];
            }
            const unsigned thr = prefix;
            int ce = 0;
            for (int i = 0; i < 16; ++i) { const unsigned k = keys[tid * 16 + i]; ce += (k == thr); }
            int tot;
            const int eqbase = block_exscan(ce, sh, &tot);
            int eqr = eqbase, cs = 0;
            for (int i = 0; i < 16; ++i) { const unsigned k = keys[tid * 16 + i]; const bool sel = (k > thr) || (k == thr && eqr < krem); eqr += (k == thr); cs += sel; }
            const int sbase = block_exscan(cs, sh, &tot);
            int slot = sbase; eqr = eqbase;
            for (int i = 0; i < 16; ++i) {
                const int s = tid * 16 + i; const unsigned k = keys[s];
                const bool sel = (k > thr) || (k == thr && eqr < krem); eqr += (k == thr);
                if (sel) { TOK[eb * CAP + slot] = b * S + s; GATE[eb * CAP + slot] = __uint_as_float(k); SLOT[(size_t)(b * S + s) * NE + e] = eb * CAP + slot; ++slot; }
            }
        }
    }
    SEAM(ph); ++ph;
    if (IN(ph)) REP_LOOP {
        for (int r = gw; r < NB * NE * CAP; r += ngw) {
            int rv_ = r; asm volatile("" : "+v"(rv_));
            if constexpr (layer == 1 || F8L0) {
                const v4u* srcp = (const v4u*)(H + (size_t)TOK[rv_] * D) + 2 * lane; const v4u x0 = srcp[0], x1 = srcp[1];
                v4u o;
                o.x = pk4_fp8(bflo(x0.x) * ASC8, bfhi(x0.x) * ASC8, bflo(x0.y) * ASC8, bfhi(x0.y) * ASC8); o.y = pk4_fp8(bflo(x0.z) * ASC8, bfhi(x0.z) * ASC8, bflo(x0.w) * ASC8, bfhi(x0.w) * ASC8);
                o.z = pk4_fp8(bflo(x1.x) * ASC8, bfhi(x1.x) * ASC8, bflo(x1.y) * ASC8, bfhi(x1.y) * ASC8); o.w = pk4_fp8(bflo(x1.z) * ASC8, bfhi(x1.z) * ASC8, bflo(x1.w) * ASC8, bfhi(x1.w) * ASC8);
                ((v4u*)((unsigned char*)XE + (size_t)r * D))[lane] = o;
            } else {
                const v4u* srcp = (const v4u*)(H + (size_t)TOK[rv_] * D); v4u* dst = (v4u*)(XE + (size_t)r * D);
                dst[lane] = srcp[lane]; dst[lane + 64] = srcp[lane + 64];
            }
        }
    }
    SEAM(ph); ++ph;
    if (IN(ph)) {
        MoeOrder So{(int)gridDim.x, (int)blockIdx.x, 16 * 22, 22};
        if constexpr (layer == 1 || F8L0) {
            int Kg = D / 2; asm volatile("" : "+s"(Kg));
            pg8::Gemm g{XE, (const bf16_t*)(ws + WS_WGU8 + (size_t)layer * 176 * MiB), NB * NE * CAP, NE * 5632, Kg};
            pg8::gemm_phase<EpiSiluMul8, MoeOrder, false, true>(ldsp, g, So, EpiSiluMul8{(unsigned char*)HID}, nullptr);
        } else {
            pg8::Gemm g{XE, (const bf16_t*)(ws + WS_WGU) + (size_t)layer * NE * 5632 * D, NB * NE * CAP, NE * 5632, D};
            pg8::gemm_phase<EpiSiluMul, MoeOrder, false>(ldsp, g, So, EpiSiluMul{HID}, nullptr);
        }
    }
    SEAM(ph); ++ph;
    if (IN(ph)) {
        MoeOrder So{(int)gridDim.x, (int)blockIdx.x, 16 * 4, 4};
        if constexpr (layer == 1 || F8L0) {
            int Kg = DE / 2; asm volatile("" : "+s"(Kg));
            pg8::Gemm g{HID, (const bf16_t*)(ws + WS_WD8 + (size_t)layer * 88 * MiB), NB * NE * CAP, NE * D, Kg};
            pg8::gemm_phase<EpiYE8, MoeOrder, false, true>(ldsp, g, So, EpiYE8{GATE, YE}, nullptr);
        } else {
            pg8::Gemm g{HID, (const bf16_t*)(ws + WS_WD) + (size_t)layer * NE * D * DE, NB * NE * CAP, NE * D, DE};
            pg8::gemm_phase<EpiYE, MoeOrder, false>(ldsp, g, So, EpiYE{GATE, YE}, nullptr);
        }
    }
    SEAM(ph); ++ph;
    return ph;
}

__global__ void __launch_bounds__(NTH, 2) mega(Args a) {
    extern __shared__ __attribute__((aligned(16))) unsigned char lds_raw[];
    unsigned* ctl = (unsigned*)(a.ws + WS_CTL);
    volatile LAS unsigned* bst = (volatile LAS unsigned*)((LAS unsigned char*)lds_raw + LDS_BAR_OFF);
    { const int t0_ = tidx(); if (t0_ < 4) bst[t0_] = 0u; }
    __syncthreads();
    XcdBarrier bar; bar.bar = ctl + CW_BAR; bar.x = 0; bar.st = bst;
    if (a.hi - a.lo > 1) bar = xcd_barrier_post(ctl + CW_BAR, bst);
    PROLOG

    int ph = 0;
    if (IN(ph)) REP_LOOP {
        for (int i = gt; i < S * 32; i += ngt) {
            const int s = i >> 5, f = i & 31;
            const float pw = (float)exp((double)((float)(2 * f) / 64.0f) * 9.210340371976184);
            const float invf = 1.0f / pw;
            const float angf = (float)s * invf;
            double xx = (double)angf;
            const double n = rint(xx * 0.15915494309189535);
            xx = (xx - n * 6.283185307179586) - n * 2.4492935982947064e-16;
            const double x2 = xx * xx;
            double cs = 1.0, sn = xx, tc = 1.0, tsn = xx;
#pragma unroll 1
            for (int k = 1; k <= 16; ++k) { tc *= -x2 / (double)((2 * k - 1) * (2 * k)); tsn *= -x2 / (double)((2 * k) * (2 * k + 1)); cs += tc; sn += tsn; }
            ropec[i] = (float)cs; ropes[i] = (float)sn;
        }
        rmsnorm_rows_bf16(x_in, a.in[2], H, T);
        rmsnorm_rows_bf16(mem, a.in[25], MN, NB * MEM); rmsnorm_rows_bf16(mem, a.in[25] + D, MN + NB * MEM * D, NB * MEM);
        LAS float* scr = (LAS float*)((LAS unsigned char*)lds_raw + wave * 16896);
        auto ident = [](int n) { return n; };
        auto emap = [](int n) { const bool il = (n < 1024) || (n >= 1536 && n < 2176); const int j = n & 63; return il ? ((n & ~63) + (j < 32 ? 2 * j : 2 * (j - 32) + 1)) : n; };
        for (int it = gw; it < 16 * 36; it += ngw) transpose_item(a.in[3], D, EVEN_IN, (bf16_t*)(ws + WS_WEIN), emap, scr, it, lane);
        for (int it = gw; it < 2 * 16 * 32; it += ngw) { const int l = it / 512, r = it % 512; transpose_item(a.in[27] + (size_t)l * D * 2048, D, 2048, (bf16_t*)(ws + WS_WKV) + (size_t)l * 2048 * D, ident, scr, r, lane); }
        { float* WRT = (float*)(ws + WS_WRT);
          for (int i = gt; i < 2 * NE * D; i += ngt) { const int l = i >> 14, e = (i >> 10) & 15, k = i & 1023; WRT[i] = a.in[29][l * D + k] * a.in[30][((size_t)l * D + k) * NE + e]; } }
        { bf16_t* Wsb = (bf16_t*)(ws + WS_WSB); const float* wsp = a.in[10];
          for (int i = gt; i < 4 * 128 * 128; i += ngt) Wsb[i] = (bf16_t)f2bf(wsp[i]);
          bf16_t* WL = (bf16_t*)(ws + WS_WL); const float *w2 = a.in[14], *a2 = a.in[16], *g2 = a.in[17];
          for (int i = gt; i < 4 * 512 * 64 + 512 * 128; i += ngt) { float v;
              if (i < 4 * 512 * 64) { const int sec = i >> 15, n = (i >> 6) & 511, k = i & 63; v = (sec < 2 ? w2 : a2)[(size_t)((sec & 1) * 64 + k) * 512 + n]; }
              else { const int j = i - 4 * 512 * 64, n = j >> 7, k = j & 127; v = g2[(size_t)k * 512 + n]; }
              WL[i] = (bf16_t)f2bf(v); } }
        auto gmap = [](int n) { return (n >> 7) * 256 + (n & 127); };
        auto umap = [](int n) { return (n >> 7) * 256 + 128 + (n & 127); };
        for (int it = 4096 + gw; it < 16 * 704; it += ngw) { const int mt = it / 704, r = it % 704;
            if constexpr (F8L0) transpose_item_fp8(a.in[31] + (size_t)mt * D * DE, D, DE, ws + WS_WGU8 + (size_t)mt * 5632 * D, gmap, GUSC8, scr, r, lane);
            else transpose_item(a.in[31] + (size_t)mt * D * DE, D, DE, (bf16_t*)(ws + WS_WGU) + (size_t)mt * 5632 * D, gmap, scr, r, lane); }
        for (int it = gw; it < 16 * 704; it += ngw) { const int mt = it / 704, r = it % 704;
            if constexpr (F8L0) transpose_item_fp8(a.in[32] + (size_t)mt * D * DE, D, DE, ws + WS_WGU8 + (size_t)mt * 5632 * D, umap, GUSC8, scr, r, lane);
            else transpose_item(a.in[32] + (size_t)mt * D * DE, D, DE, (bf16_t*)(ws + WS_WGU) + (size_t)mt * 5632 * D, umap, scr, r, lane); }
    }
    SEAM(ph); ++ph;

    if (IN(ph)) dense_gemm(ldsp, H, (const bf16_t*)(ws + WS_WEIN), T, EVEN_IN, D,
                           EpiEven{ropec, ropes, (bf16_t*)(ws + WS_QHA), (bf16_t*)(ws + WS_KHA), (bf16_t*)(ws + WS_QHB), (bf16_t*)(ws + WS_KHB), (bf16_t*)(ws + WS_VTA), (bf16_t*)(ws + WS_VTB)});
    if (IN(ph)) {
        dense_gemm(ldsp, MN, (const bf16_t*)(ws + WS_WKV), NB * MEM, 2048, D, EpiKV{KV, KV + 512 * 1024}, 192);
        dense_gemm(ldsp, MN + NB * MEM * D, (const bf16_t*)(ws + WS_WKV) + (size_t)2048 * D, NB * MEM, 2048, D, EpiKV{KV + 1024 * 1024, KV + 1024 * 1024 + 512 * 1024}, 176);
        if (bid >= 96) {
            __syncthreads();
            LAS float* scr = (LAS float*)((LAS unsigned char*)lds_raw + wave * 16896);
            const int gw3 = (bid - 96) * 8 + wave, ngw3 = (nb - 96) * 8;
            auto ident = [](int n) { return n; };
            auto gmap = [](int n) { return (n >> 7) * 256 + (n & 127); };
        for (int it = gw3; it < 16 * 16; it += ngw3) transpose_item(a.in[5], D, D, (bf16_t*)(ws + WS_WEOUT), ident, scr, it, lane);
        for (int it = gw3; it < 16 * 46; it += ngw3) transpose_item(a.in[7], D, ODD_IN, (bf16_t*)(ws + WS_WOIN), ident, scr, it, lane);
        for (int it = gw3; it < 16 * 16; it += ngw3) transpose_item(a.in[23], D, D, (bf16_t*)(ws + WS_WOOUT), ident, scr, it, lane);
        for (int it = gw3; it < 2 * 16 * 16; it += ngw3) { const int l = it / 256, r = it % 256; transpose_item(a.in[26] + (size_t)l * D * D, D, D, (bf16_t*)(ws + WS_WQ) + (size_t)l * D * D, ident, scr, r, lane, a.in[24] + l * D); }
        for (int it = gw3; it < 2 * 16 * 16; it += ngw3) { const int l = it / 256, r = it % 256; transpose_item(a.in[28] + (size_t)l * D * D, D, D, (bf16_t*)(ws + WS_WO) + (size_t)l * D * D, ident, scr, r, lane); }
            for (int it = gw3; it < 4096; it += ngw3) { const int mt = it / 704, r = it % 704;
                if constexpr (F8L0) transpose_item_fp8(a.in[31] + (size_t)mt * D * DE, D, DE, ws + WS_WGU8 + (size_t)mt * 5632 * D, gmap, GUSC8, scr, r, lane);
                else transpose_item(a.in[31] + (size_t)mt * D * DE, D, DE, (bf16_t*)(ws + WS_WGU) + (size_t)mt * 5632 * D, gmap, scr, r, lane); }
        }
    }
    SEAM(ph); ++ph;
    if (IN(ph)) REP_LOOP attn_phase_even((const bf16_t*)(ws + WS_QHA), (const bf16_t*)(ws + WS_KHA), (const bf16_t*)(ws + WS_VTA), (const bf16_t*)(ws + WS_QHB), (const bf16_t*)(ws + WS_KHB),
                                (const bf16_t*)(ws + WS_VTB), a.in[4], (bf16_t*)(ws + WS_OA), (float*)(ws + WS_LSE), Y, lds_raw);
    SEAM(ph); ++ph;
    if (IN(ph)) REP_LOOP attn_combine((const bf16_t*)(ws + WS_OA), (const float*)(ws + WS_LSE), Y);
    SEAM(ph); ++ph;
    if (IN(ph)) dense_gemm(ldsp, Y, (const bf16_t*)(ws + WS_WEOUT), T, D, D, EpiResidN{x_in, X, H, (float*)(ws + WS_SSP)});
    SEAM(ph); ++ph;

    ph = tail_phases<0>(a, bar, lds_raw, ph);
    ph = odd_phases(a, bar, lds_raw, ph);
    ph = tail_phases<1>(a, bar, lds_raw, ph);

    if (IN(ph)) combine_norm<true>(X, YE, SLOT, a.in[34], nullptr, a.out);
    ++ph;
}
constexpr int NPHASES = 1 + 4 + 2 * 7 + 8 + 1;
#undef IN
#undef SEAM
}

extern "C" void kernel_launch(void* const* d_in, const int* in_sizes, int n_in, void* d_out, int out_size, void* d_ws, size_t ws_size, hipStream_t stream) {
    static int grid = 0;
    if (grid == 0) {
        if (n_in != 35 || out_size != T * D || ws_size < WS_END) { fprintf(stderr, "kernel_launch: unexpected shapes n_in %d out %d ws %zu (need %zu)\n", n_in, out_size, ws_size, (size_t)WS_END); grid = -1; return; }
        int dev = 0, cus = 0, per_cu = 0;
        (void)hipGetDevice(&dev); (void)hipDeviceGetAttribute(&cus, hipDeviceAttributeMultiprocessorCount, dev);
        if (hipFuncSetAttribute((const void*)mega, hipFuncAttributeMaxDynamicSharedMemorySize, LDS_BYTES) != hipSuccess) { fprintf(stderr, "hipFuncSetAttribute failed\n"); grid = -1; return; }
        if (hipOccupancyMaxActiveBlocksPerMultiprocessor(&per_cu, (const void*)mega, NTH, LDS_BYTES) != hipSuccess || per_cu < 1) fprintf(stderr, "occupancy query: %d\n", per_cu);
        (void)hipGetLastError();
        grid = cus > 0 ? cus : 256;
    }
    if (grid < 0) return;
    (void)hipMemsetAsync((char*)d_ws + WS_CTL, 0, CTL_BYTES, stream);
    Args a{};
    for (int i = 0; i < 35; ++i) a.in[i] = (const float*)d_in[i];
    a.out = (float*)d_out; a.ws = (unsigned char*)d_ws;
#if MK_MULTI
    for (int k = 0; k < NPHASES; ++k) { a.lo = k; a.hi = k + 1; hipLaunchKernelGGL(mega, dim3(grid), dim3(NTH), LDS_BYTES, stream, a); }
#else
    a.lo = 0; a.hi = NPHASES; hipLaunchKernelGGL(mega, dim3(grid), dim3(NTH), LDS_BYTES, stream, a);
#endif
}
```

```cpp
#include <hip/hip_runtime.h>
#include <cstdio>
#include <cstdint>

#ifndef PROBE_PHASE
#define PROBE_PHASE (-1)
#endif
#ifndef PROBE_REP
#define PROBE_REP 1
#endif
#ifndef MK_MULTI
#define MK_MULTI 0
#endif

__device__ __forceinline__ int tidx() { int t = threadIdx.x; asm volatile("" : "+v"(t)); return t; }
namespace pg8 {
#define PG8_LAS __attribute__((address_space(3)))
typedef unsigned short bf16_t;
typedef short bf16x8 __attribute__((ext_vector_type(8)));
typedef float f32x4 __attribute__((ext_vector_type(4)));
typedef unsigned u32x4 __attribute__((ext_vector_type(4)));
constexpr int BM = 256, BK = 64, HALF = 128, HTB = HALF * BK * 2  , STAGE_BYTES = 8 * HTB, NXCD = 8, WGM = 8;

__host__ __device__ __forceinline__ int lds_byte(int r, int c) { const int st = (r >> 4) * 2 + (c >> 5), rr = r & 15, cc = c & 31, ob = rr * 64 + cc * 2; return st * 1024 + (ob ^ (((ob >> 9) & 1) << 5)); }
__host__ __device__ __forceinline__ void stage_rc(int b, int& R, int& C) { const int st = b / 1024, sb = b % 1024, swz = sb ^ (((sb >> 9) & 1) << 5); R = (st >> 1) * 16 + swz / 64; C = (st & 1) * 32 + (swz % 64) / 2; }
__host__ __device__ __forceinline__ int perm32(int rho) { const int n = rho >> 4, i = rho & 15; return 8 * (i >> 2) + 4 * n + (i & 3); }

struct Unit { int pm, pn; };
struct Gemm { const bf16_t* A; const bf16_t* Bt; int M, N, K; };

struct StaticOrder {
    int nM, nN, nwg, G, c;
    __host__ __device__ void init(int M, int N, int G_, int c_) { nM = M / BM; nN = N / BM; nwg = nM * nN; G = G_; c = c_; }
    __host__ __device__ bool next(int i, Unit& u) const {
        const long L = (long)i * G + c; if (L >= nwg) return false;
        int wgid = (int)L; { const int q = nwg / NXCD, r = nwg % NXCD, xcd = wgid % NXCD, off = wgid / NXCD; wgid = (xcd < r ? xcd * (q + 1) : r * (q + 1) + (xcd - r) * q) + off; }
        const int nig = WGM * nN, gid = wgid / nig, fm = gid * WGM, gsz = (nM - fm) < WGM ? (nM - fm) : WGM;
        u.pm = fm + ((wgid % nig) % gsz); u.pn = (wgid % nig) / gsz; return true;
    }
    __device__ __forceinline__ void a_ready(const Unit&) const {}
    __device__ __forceinline__ void done(const Unit&) const {}
};

typedef __bf16 bf16v2_t __attribute__((ext_vector_type(2)));
typedef float f32v2_t __attribute__((ext_vector_type(2)));
__device__ __forceinline__ unsigned cvt_pk_bf16(float lo, float hi) { const f32v2_t v = {lo, hi}; return __builtin_bit_cast(unsigned, __builtin_convertvector(v, bf16v2_t)); }
typedef int i32x8 __attribute__((ext_vector_type(8)));
template <bool F8> __device__ __forceinline__ f32x4 mma_tile(const bf16x8 (&bfr)[2], const bf16x8 (&afr)[2], f32x4 acc) {
    if constexpr (F8) {
        typedef int i32x4_ __attribute__((ext_vector_type(4)));
        const i32x4_ b0 = __builtin_bit_cast(i32x4_, bfr[0]), b1 = __builtin_bit_cast(i32x4_, bfr[1]), a0 = __builtin_bit_cast(i32x4_, afr[0]), a1 = __builtin_bit_cast(i32x4_, afr[1]);
        const i32x8 bb = {b0[0], b0[1], b0[2], b0[3], b1[0], b1[1], b1[2], b1[3]}, aa = {a0[0], a0[1], a0[2], a0[3], a1[0], a1[1], a1[2], a1[3]};
        const int sc1 = 0x7f7f7f7f;
        asm volatile("v_mfma_scale_f32_16x16x128_f8f6f4 %0, %1, %2, %0, %3, %3 op_sel_hi:[0,0,0]" : "+v"(acc) : "v"(bb), "v"(aa), "v"(sc1));
        return acc;
    } else {
        acc = __builtin_amdgcn_mfma_f32_16x16x32_bf16(bfr[0], afr[0], acc, 0, 0, 0);
        return __builtin_amdgcn_mfma_f32_16x16x32_bf16(bfr[1], afr[1], acc, 0, 0, 0);
    }
}
template <class Epi, class Sched, bool STAMP = false, bool F8 = false>
__device__ __forceinline__ void gemm_phase(PG8_LAS unsigned char* lds, const Gemm g, const Sched& S, const Epi& E, unsigned long long* stamps) {
    const int tid = ::tidx(), wid = __builtin_amdgcn_readfirstlane(tid >> 6), lane = tid & 63, wr = wid >> 2, wc = wid & 3, fr = lane & 15, fq = lane >> 4;
    const int K = g.K, nt = K / BK;
    int ts_lo = 0, ts_hi = 0, nts = 0; const unsigned long long rt_entry = STAMP ? (unsigned long long)wall_clock64() : 0ull;
#define PG8_STAMP() do { if (STAMP && wid == 0 && nts < 64) { const unsigned long long _c = (unsigned long long)clock64(); \
        ts_lo = (lane == nts) ? (int)(unsigned)_c : ts_lo; ts_hi = (lane == nts) ? (int)(unsigned)(_c >> 32) : ts_hi; ++nts; } } while (0)
    PG8_STAMP();
    unsigned voffA[2], voffB[2];
#pragma unroll
    for (int i = 0; i < 2; ++i) { int R, C; stage_rc(tid * 16 + i * 8192, R, C); const int Rb = Epi::PERM ? ((R & ~31) + perm32(R & 31)) : R;
        voffA[i] = (unsigned)(R * K + C) * 2u; voffB[i] = (unsigned)(Rb * K + C) * 2u; }
    const size_t kstep = (size_t)(BK * 2);
    const size_t hstep = (size_t)HALF * K * 2;
    const size_t tstep = 2 * hstep;
    const unsigned ldsw = (unsigned)wid * 1024u;
    const int aoff = lds_byte(wr * 64 + fr, fq * 8), boff = lds_byte(wc * 32 + fr, fq * 8);
#define PG8_SA(b, h) (((b) * 2 + (h)) * HTB)
#define PG8_SB(b, h) ((4 + (b) * 2 + (h)) * HTB)
#define PG8_STAGE(bufoff, gbase, voff) do { _Pragma("unroll") for (int _i = 0; _i < 2; ++_i) \
        __builtin_amdgcn_global_load_lds((const unsigned*)((const char*)(gbase) + (voff)[_i]), (PG8_LAS unsigned*)(lds + (bufoff) + ldsw + _i * 8192), 16, 0, 0); } while (0)
#define PG8_LDA(dst, b, h) do { _Pragma("unroll") for (int m = 0; m < 4; ++m) _Pragma("unroll") for (int k = 0; k < 2; ++k) dst[m][k] = *(const PG8_LAS bf16x8*)(lds + PG8_SA(b, h) + aoff + m * 2048 + k * 1024); } while (0)
#define PG8_LDB(dst, b, h) do { _Pragma("unroll") for (int n = 0; n < 2; ++n) _Pragma("unroll") for (int k = 0; k < 2; ++k) dst[n][k] = *(const PG8_LAS bf16x8*)(lds + PG8_SB(b, h) + boff + n * 2048 + k * 1024); } while (0)
#define PG8_MMA(ai, bj, At, Bt) do { __builtin_amdgcn_s_setprio(1); _Pragma("unroll") for (int m = 0; m < 4; ++m) _Pragma("unroll") for (int n = 0; n < 2; ++n) \
        acc[ai][bj][m][n] = mma_tile<F8>(Bt[n], At[m], acc[ai][bj][m][n]); __builtin_amdgcn_s_setprio(0); } while (0)
#define PG8_WAIT_V(n) asm volatile("s_waitcnt vmcnt(" #n ")" ::: "memory")
#define PG8_WAIT_L(n) asm volatile("s_waitcnt lgkmcnt(" #n ")" ::: "memory")
#define PG8_BAR __builtin_amdgcn_s_barrier()
#define PG8_SCHED __builtin_amdgcn_sched_barrier(0)
    Unit cur, nxt; int ui = 0;
    if (!S.next(0, cur)) return;
    f32x4 acc[2][2][4][2];
#pragma unroll
    for (int a = 0; a < 2; ++a)
#pragma unroll
        for (int b = 0; b < 2; ++b)
#pragma unroll
            for (int m = 0; m < 4; ++m)
#pragma unroll
                for (int n = 0; n < 2; ++n) acc[a][b][m][n] = (f32x4){0.f, 0.f, 0.f, 0.f};
    bf16x8 At[4][2], B0[2][2], B1[2][2];
    const char* cA = (const char*)g.A + (size_t)cur.pm * tstep; const char* cB = (const char*)g.Bt + (size_t)cur.pn * tstep;
    S.a_ready(cur);
    PG8_STAGE(PG8_SB(0, 0), cB, voffB); PG8_STAGE(PG8_SA(0, 0), cA, voffA); PG8_STAGE(PG8_SB(0, 1), cB + hstep, voffB); PG8_STAGE(PG8_SA(0, 1), cA + hstep, voffA);
    if (wr == 1) PG8_BAR;
    PG8_WAIT_V(4); PG8_BAR;
    PG8_STAGE(PG8_SB(1, 0), cB + kstep, voffB); PG8_STAGE(PG8_SA(1, 0), cA + kstep, voffA); PG8_STAGE(PG8_SB(1, 1), cB + hstep + kstep, voffB);
    PG8_WAIT_V(6); PG8_BAR;
    PG8_STAMP();
    for (;;) {
        const bool has_next = S.next(ui + 1, nxt);
        const char* nA = has_next ? (const char*)g.A + (size_t)nxt.pm * tstep : cA; const char* nB = has_next ? (const char*)g.Bt + (size_t)nxt.pn * tstep : cB;
        for (int t = 0; t < nt; t += 2) {
            const bool last = (t == nt - 2);
            const char* a1 = cA + (size_t)(t + 1) * kstep;
            const char* a2 = last ? nA : cA + (size_t)(t + 2) * kstep; const char* b2 = last ? nB : cB + (size_t)(t + 2) * kstep;
            const char* a3 = a2 + kstep; const char* b3 = b2 + kstep;
            if (last && has_next) S.a_ready(nxt);
            PG8_LDB(B0, 0, 0); PG8_SCHED; PG8_LDA(At, 0, 0); PG8_STAGE(PG8_SA(1, 1), a1 + hstep, voffA);
            PG8_WAIT_L(8); PG8_BAR; PG8_WAIT_L(0); PG8_MMA(0, 0, At, B0); PG8_BAR; PG8_SCHED;
            PG8_LDB(B1, 0, 1); PG8_STAGE(PG8_SB(0, 0), b2, voffB);
            PG8_BAR; PG8_WAIT_L(0); PG8_MMA(0, 1, At, B1); PG8_BAR;
            PG8_LDA(At, 0, 1); PG8_STAGE(PG8_SA(0, 0), a2, voffA);
            PG8_BAR; PG8_WAIT_L(0); PG8_MMA(1, 0, At, B0); PG8_BAR; PG8_SCHED;
            PG8_STAGE(PG8_SB(0, 1), b2 + hstep, voffB);
            PG8_WAIT_V(6); PG8_BAR; PG8_MMA(1, 1, At, B1); PG8_BAR;
            PG8_LDB(B0, 1, 0); PG8_SCHED; PG8_LDA(At, 1, 0); PG8_STAGE(PG8_SA(0, 1), a2 + hstep, voffA);
            PG8_WAIT_L(8); PG8_BAR; PG8_WAIT_L(0); PG8_MMA(0, 0, At, B0); PG8_BAR; PG8_SCHED;
            PG8_LDB(B1, 1, 1); PG8_STAGE(PG8_SB(1, 0), b3, voffB);
            PG8_BAR; PG8_WAIT_L(0); PG8_MMA(0, 1, At, B1); PG8_BAR;
            PG8_LDA(At, 1, 1); PG8_STAGE(PG8_SA(1, 0), a3, voffA);
            PG8_BAR; PG8_WAIT_L(0); PG8_MMA(1, 0, At, B0); PG8_BAR; PG8_SCHED;
            PG8_STAGE(PG8_SB(1, 1), b3 + hstep, voffB);
            PG8_WAIT_V(6); PG8_BAR; PG8_MMA(1, 1, At, B1); PG8_BAR;
        }
        PG8_STAMP();
        if constexpr (!Epi::AFTER_DRAIN) { E(acc, cur, wr, wc, fr, fq); S.done(cur); }
        PG8_STAMP();
        if (!has_next) break;
#pragma unroll
        for (int a = 0; a < 2; ++a)
#pragma unroll
            for (int b = 0; b < 2; ++b)
#pragma unroll
                for (int m = 0; m < 4; ++m)
#pragma unroll
                    for (int n = 0; n < 2; ++n) acc[a][b][m][n] = (f32x4){0.f, 0.f, 0.f, 0.f};
        cur = nxt; cA = nA; cB = nB; ++ui;
    }
    PG8_WAIT_V(0);
    if (wr == 0) PG8_BAR;
    PG8_BAR;
    if constexpr (Epi::AFTER_DRAIN) { E.fused(acc, cur, wr, wc, fr, fq, lds, wid, lane); S.done(cur); }
    PG8_STAMP();
    if (STAMP && wid == 0) { stamps[lane] = lane < nts ? (((unsigned long long)(unsigned)ts_hi << 32) | (unsigned)ts_lo) : 0ull;
        if (lane == 62) stamps[62] = rt_entry; if (lane == 63) stamps[63] = (unsigned long long)wall_clock64(); }
#undef PG8_STAMP
#undef PG8_SA
#undef PG8_SB
#undef PG8_STAGE
#undef PG8_LDA
#undef PG8_LDB
#undef PG8_MMA
#undef PG8_WAIT_V
#undef PG8_WAIT_L
#undef PG8_BAR
#undef PG8_SCHED
}
}


namespace {
using pg8::bf16_t; using pg8::f32x4;
constexpr int D = 1024, NB = 2, S = 8192, T = NB * S;
constexpr int EVEN_IN = 2304, ODD_IN = 2944, ODD_PAD = 3072, FD = 1920;
constexpr int MEM = 256, NE = 16, CAP = 1024, DE = 2816;
constexpr int NTH = 512;
constexpr size_t MiB = 1u << 20;
constexpr size_t WS_CTL = 0, CTL_BYTES = 1 * MiB;
constexpr size_t WS_ROPE = 1 * MiB;
constexpr size_t WS_AFF = 4 * MiB;
constexpr size_t WS_TOK = 5 * MiB;
constexpr size_t WS_GATE = 6 * MiB;
constexpr size_t WS_WRT = 3 * MiB;
constexpr size_t WS_SLOT = 7 * MiB;
constexpr size_t WS_X = 8 * MiB;
constexpr size_t WS_H = 72 * MiB;
constexpr size_t WS_Y = 104 * MiB;
constexpr size_t WS_P = 136 * MiB;
constexpr size_t WS_Q = 320 * MiB;
constexpr size_t WS_KV = 384 * MiB;
constexpr size_t WS_MN = 388 * MiB;
constexpr size_t WS_SSP = 390 * MiB;
constexpr size_t WS_DEC = 392 * MiB;
constexpr size_t WS_KD = 456 * MiB;
constexpr size_t WS_BB = 520 * MiB;
constexpr size_t WS_KK = 584 * MiB;
constexpr size_t WS_G = 616 * MiB;
constexpr size_t WS_YS = 648 * MiB;
constexpr size_t WS_RV = 712 * MiB;
constexpr size_t WS_VN = 776 * MiB;
constexpr size_t WS_QHA = 136 * MiB;
constexpr size_t WS_KHA = 152 * MiB;
constexpr size_t WS_QHB = 168 * MiB;
constexpr size_t WS_KHB = 184 * MiB;
constexpr size_t WS_PVB = 188 * MiB;
constexpr size_t WS_VTA = 208 * MiB;
constexpr size_t WS_VTB = 256 * MiB;
constexpr size_t WS_OA = 260 * MiB;
constexpr size_t WS_LSE = 308 * MiB;
constexpr size_t WS_QT = 136 * MiB;
constexpr size_t WS_YL = 200 * MiB;
constexpr size_t WS_PT = 264 * MiB;
constexpr size_t WS_RH = 296 * MiB;
constexpr size_t WS_S0 = 328 * MiB;
constexpr size_t WS_XE = 136 * MiB;
constexpr size_t WS_YE = 136 * MiB;
constexpr size_t WS_HID = 200 * MiB;
constexpr size_t WS_KB = 360 * MiB;
constexpr size_t WS_F5 = 792 * MiB;
constexpr size_t WS_WSB = 804 * MiB;
constexpr size_t WS_WL = 805 * MiB;
constexpr size_t WS_WEIN = 808 * MiB;
constexpr size_t WS_WEOUT = 813 * MiB;
constexpr size_t WS_WOIN = 815 * MiB;
constexpr size_t WS_WOOUT = 821 * MiB;
constexpr size_t WS_WQ = 823 * MiB;
constexpr size_t WS_WKV = 827 * MiB;
constexpr size_t WS_WO = 835 * MiB;
constexpr size_t WS_WGU = 840 * MiB;
constexpr size_t WS_WD = 1192 * MiB;
constexpr size_t WS_WGU8 = 840 * MiB;
constexpr size_t WS_WD8 = 1192 * MiB;
constexpr size_t WS_END = 1368 * MiB;
constexpr bool F8L0 = true;
constexpr float ASC8 = 16.f, GUSC8 = 128.f, HSC8 = 4.f, DSC8 = 256.f;
constexpr int CW_BAR = 4096;

constexpr int LDS_BYTES = 147456;
constexpr int LDS_BAR_OFF = LDS_BYTES - 64;

#define LAS __attribute__((address_space(3)))
#define XB_TMO      128
#define XB_XCNT(j)  (256  + 64 * (j))
#define XB_XSUB(j)  (1280 + 64 * (j))
#define XB_XGEN(j)  (2304 + 64 * (j))
#define XB_TOP      3328
#define XB_TOPGEN   3392
#define XCD_BAR_WORDS 3456
#define XB_SPIN_CAP (1u << 22)
__device__ __forceinline__ unsigned xb_ld(unsigned* p)              { return __hip_atomic_load(p, __ATOMIC_RELAXED, __HIP_MEMORY_SCOPE_AGENT); }
__device__ __forceinline__ unsigned xb_add(unsigned* p, unsigned v) { return __hip_atomic_fetch_add(p, v, __ATOMIC_RELAXED, __HIP_MEMORY_SCOPE_AGENT); }
__device__ __forceinline__ unsigned xb_xcc_id() { return (unsigned)__builtin_amdgcn_s_getreg((3 << 11) | 20) & 0xFu; }
#define XB_SPIN(cond, bar) do { unsigned _sp = 0; while (cond) { __builtin_amdgcn_s_sleep(1); \
    if ((++_sp & 255u) == 0u) { if (xb_ld(&(bar)[XB_TMO])) break; if (_sp > XB_SPIN_CAP) { atomicAdd(&(bar)[XB_TMO], 1u); break; } } } } while (0)
struct XcdBarrier { unsigned* bar; unsigned x; volatile LAS unsigned* st; };
__device__ __forceinline__ XcdBarrier xcd_barrier_post(unsigned* bar, volatile LAS unsigned* st) {
    XcdBarrier b; b.bar = bar; b.x = xb_xcc_id(); b.st = st;
    if (threadIdx.x == 0) (void)xb_add(&bar[XB_XCNT(b.x)], 1u);
    return b;
}
__device__ __forceinline__ void xcd_barrier_complete(unsigned* bar, unsigned x, unsigned& nloc, unsigned& nx) {
    const unsigned G = gridDim.x * gridDim.y * gridDim.z;
    unsigned sum, cnt, mine, sp = 0u;
    for (;;) {
        sum = 0u; cnt = 0u; mine = 0u;
#pragma unroll
        for (unsigned j = 0; j < 16; ++j) { const unsigned c = xb_ld(&bar[XB_XCNT(j)]); sum += c; cnt += (c > 0u) ? 1u : 0u; mine = (j == x) ? c : mine; }
        if (sum == G) break;
        __builtin_amdgcn_s_sleep(1);
        if ((++sp & 255u) == 0u) { if (xb_ld(&bar[XB_TMO])) break; if (sp > XB_SPIN_CAP) { atomicAdd(&bar[XB_TMO], 1u); break; } }
    }
    nloc = mine > 0u ? mine : 1u; nx = cnt > 0u ? cnt : 1u;
}
__device__ __forceinline__ void xcd_barrier(const XcdBarrier& b) {
    asm volatile("s_waitcnt vmcnt(0)" ::: "memory");
    __syncthreads();
    if (threadIdx.x == 0) {
        unsigned* bar = b.bar;
        __builtin_amdgcn_s_waitcnt(0);
        unsigned nloc = b.st[0], nx = b.st[1];
        if (nloc == 0u) { xcd_barrier_complete(bar, b.x, nloc, nx); b.st[0] = nloc; b.st[1] = nx; }
        const unsigned old = xb_add(&bar[XB_XSUB(b.x)], 1u);
        const unsigned gen = old / nloc;
        if (old + 1u == (gen + 1u) * nloc) {
            __builtin_amdgcn_fence(__ATOMIC_RELEASE, "agent");
            asm volatile("s_waitcnt vmcnt(0)" ::: "memory");
            const unsigned og = xb_add(&bar[XB_TOP], 1u);
            const unsigned tg = og / nx;
            if (og + 1u == (tg + 1u) * nx) xb_add(&bar[XB_TOPGEN], 1u);
            else XB_SPIN(xb_ld(&bar[XB_TOPGEN]) == tg, bar);
            __builtin_amdgcn_fence(__ATOMIC_ACQUIRE, "agent");
            xb_add(&bar[XB_XGEN(b.x)], 1u);
            asm volatile("s_waitcnt vmcnt(0)" ::: "memory");
        } else {
            XB_SPIN(xb_ld(&bar[XB_XGEN(b.x)]) == gen, bar);
            __builtin_amdgcn_fence(__ATOMIC_ACQUIRE, "agent");
            asm volatile("s_waitcnt vmcnt(0)" ::: "memory");
        }
    }
    __syncthreads();
}

__device__ __forceinline__ float wave_sum(float v) {
#pragma unroll
    for (int o = 32; o >= 1; o >>= 1) v += __shfl_xor(v, o);
    return v;
}
__device__ __forceinline__ float frcp(float x) { return __builtin_amdgcn_rcpf(x); }
__device__ __forceinline__ float sigmoidf_(float x) { return frcp(1.0f + __expf(-x)); }
__device__ __forceinline__ float tanhf_(float x) { return 2.0f * sigmoidf_(2.0f * x) - 1.0f; }
__device__ __forceinline__ float gelu_tanh(float x) { return x * sigmoidf_(1.5957691216057308f * (x + 0.044715f * x * x * x)); }
__device__ __forceinline__ unsigned f2bf(float f) { unsigned u = __builtin_bit_cast(unsigned, f); return (u + 0x7fffu + ((u >> 16) & 1u)) >> 16; }
__device__ __forceinline__ unsigned pk2(float lo, float hi) { return pg8::cvt_pk_bf16(lo, hi); }
__device__ __forceinline__ float bflo(unsigned w) { return __uint_as_float(w << 16); }
__device__ __forceinline__ float bfhi(unsigned w) { return __uint_as_float(w & 0xffff0000u); }
typedef unsigned v4u __attribute__((ext_vector_type(4)));
typedef unsigned v2u __attribute__((ext_vector_type(2)));

struct Args { const float* in[35]; float* out; unsigned char* ws; int lo, hi; };

struct EpiF32Store {
    static constexpr bool PERM = false, AFTER_DRAIN = false;
    float* C; int ldc; int nvalid;
    __device__ __forceinline__ void operator()(const f32x4 (&acc)[2][2][4][2], const pg8::Unit& u, int wr, int wc, int fr, int fq) const {
        const int row0 = u.pm * 256 + wr * 64 + fr, col0 = u.pn * 256 + wc * 32 + 4 * fq;
#pragma unroll
        for (int ai = 0; ai < 2; ++ai)
#pragma unroll
            for (int m = 0; m < 4; ++m) { float* rowp = C + (size_t)(row0 + ai * 128 + m * 16) * ldc + col0;
#pragma unroll
                for (int bj = 0; bj < 2; ++bj)
#pragma unroll
                    for (int n = 0; n < 2; ++n) if (col0 + bj * 128 + n * 16 < nvalid) *(f32x4*)(rowp + bj * 128 + n * 16) = acc[ai][bj][m][n]; }
    }
};
struct EpiResid {
    static constexpr bool PERM = false, AFTER_DRAIN = false;
    const float* base; float* out;
    __device__ __forceinline__ void operator()(const f32x4 (&acc)[2][2][4][2], const pg8::Unit& u, int wr, int wc, int fr, int fq) const {
        const int row0 = u.pm * 256 + wr * 64 + fr, col0 = u.pn * 256 + wc * 32 + 4 * fq;
#pragma unroll
        for (int ai = 0; ai < 2; ++ai)
#pragma unroll
            for (int m = 0; m < 4; ++m) { const size_t off = (size_t)(row0 + ai * 128 + m * 16) * D + col0;
#pragma unroll
                for (int bj = 0; bj < 2; ++bj)
#pragma unroll
                    for (int n = 0; n < 2; ++n) { const f32x4 b = *(const f32x4*)(base + off + bj * 128 + n * 16); *(f32x4*)(out + off + bj * 128 + n * 16) = b + acc[ai][bj][m][n]; } }
    }
};
struct EpiSiluMul {
    static constexpr bool PERM = false, AFTER_DRAIN = false;
    bf16_t* HIDp;
    __device__ __forceinline__ void operator()(const f32x4 (&acc)[2][2][4][2], const pg8::Unit& u, int wr, int wc, int fr, int fq) const {
        const int pnl = u.pn % 22;
        const int row0 = u.pm * 256 + wr * 64 + fr, col0 = pnl * 128 + wc * 32 + 4 * fq;
#pragma unroll
        for (int ai = 0; ai < 2; ++ai)
#pragma unroll
            for (int m = 0; m < 4; ++m) { bf16_t* rowp = HIDp + (size_t)(row0 + ai * 128 + m * 16) * DE + col0;
#pragma unroll
                for (int n = 0; n < 2; ++n) { const f32x4 g = acc[ai][0][m][n], up = acc[ai][1][m][n]; float h[4];
#pragma unroll
                    for (int j = 0; j < 4; ++j) h[j] = g[j] * frcp(1.0f + __expf(-g[j])) * up[j];
                    v2u w; w.x = pk2(h[0], h[1]); w.y = pk2(h[2], h[3]); *(v2u*)(rowp + n * 16) = w; } }
    }
};
struct EpiYE {
    static constexpr bool PERM = true, AFTER_DRAIN = false;
    const float* GATE; bf16_t* YE;
    __device__ __forceinline__ void operator()(const f32x4 (&acc)[2][2][4][2], const pg8::Unit& u, int wr, int wc, int fr, int fq) const {
        const int pnl = u.pn & 3;
        const int row0 = u.pm * 256 + wr * 64 + fr, col0 = pnl * 256 + wc * 32 + 8 * fq;
#pragma unroll
        for (int ai = 0; ai < 2; ++ai)
#pragma unroll
            for (int m = 0; m < 4; ++m) { const int row = row0 + ai * 128 + m * 16; const float gt_ = GATE[row]; bf16_t* rowp = YE + (size_t)row * D + col0;
#pragma unroll
                for (int bj = 0; bj < 2; ++bj) { const f32x4 v0 = acc[ai][bj][m][0] * gt_, v1 = acc[ai][bj][m][1] * gt_;
                    v4u w; w.x = pg8::cvt_pk_bf16(v0[0], v0[1]); w.y = pg8::cvt_pk_bf16(v0[2], v0[3]); w.z = pg8::cvt_pk_bf16(v1[0], v1[1]); w.w = pg8::cvt_pk_bf16(v1[2], v1[3]);
                    *(v4u*)(rowp + bj * 128) = w; } }
    }
};
struct EpiBf16Store {
    static constexpr bool PERM = true, AFTER_DRAIN = false;
    bf16_t* O; int ldc; float scale;
    __device__ __forceinline__ void operator()(const f32x4 (&acc)[2][2][4][2], const pg8::Unit& u, int wr, int wc, int fr, int fq) const {
        const int row0 = u.pm * 256 + wr * 64 + fr, col0 = u.pn * 256 + wc * 32 + 8 * fq;
#pragma unroll
        for (int ai = 0; ai < 2; ++ai)
#pragma unroll
            for (int m = 0; m < 4; ++m) { bf16_t* rowp = O + (size_t)(row0 + ai * 128 + m * 16) * ldc + col0;
#pragma unroll
                for (int bj = 0; bj < 2; ++bj) { const f32x4 v0 = acc[ai][bj][m][0] * scale, v1 = acc[ai][bj][m][1] * scale;
                    v4u w; w.x = pg8::cvt_pk_bf16(v0[0], v0[1]); w.y = pg8::cvt_pk_bf16(v0[2], v0[3]); w.z = pg8::cvt_pk_bf16(v1[0], v1[1]); w.w = pg8::cvt_pk_bf16(v1[2], v1[3]);
                    *(v4u*)(rowp + bj * 128) = w; } }
    }
};
struct EpiKV {
    static constexpr bool PERM = false, AFTER_DRAIN = false;
    bf16_t* K; bf16_t* Vt;
    __device__ __forceinline__ void operator()(const f32x4 (&acc)[2][2][4][2], const pg8::Unit& u, int wr, int wc, int fr, int fq) const {
        const int row0 = u.pm * 256 + wr * 64 + fr, col0 = u.pn * 256 + wc * 32 + 4 * fq;
#pragma unroll
        for (int ai = 0; ai < 2; ++ai)
#pragma unroll
            for (int m = 0; m < 4; ++m) { const int row = row0 + ai * 128 + m * 16;
#pragma unroll
                for (int bj = 0; bj < 2; ++bj)
#pragma unroll
                    for (int n = 0; n < 2; ++n) { const int col = col0 + bj * 128 + n * 16; const f32x4 v = acc[ai][bj][m][n];
                        if (col < 1024) { v2u w; w.x = pk2(v[0], v[1]); w.y = pk2(v[2], v[3]); *(v2u*)(K + (size_t)row * 1024 + col) = w; }
                        else { const int b = row >> 8, mm = row & 255; bf16_t* vp = Vt + ((size_t)(b * 1024 + (col - 1024)) * 256 + mm);
#pragma unroll
                            for (int j = 0; j < 4; ++j) vp[(size_t)j * 256] = (bf16_t)f2bf(v[j]); } } }
    }
};

constexpr float QSCALE = 0.125f * 1.4426950408889634f;
struct EpiEven {
    static constexpr bool PERM = true, AFTER_DRAIN = false;
    const float* rc; const float* rs; bf16_t* QhA; bf16_t* KhA; bf16_t* QhB; bf16_t* KhB; bf16_t* VhA; bf16_t* VhB;
    __device__ __forceinline__ void operator()(const f32x4 (&acc)[2][2][4][2], const pg8::Unit& u, int wr, int wc, int fr, int fq) const {
        asm volatile("" : "+v"(fr), "+v"(fq));
        const int row0 = u.pm * 256 + wr * 64 + fr;
#pragma unroll
        for (int bj = 0; bj < 2; ++bj) {
            const int c0 = u.pn * 256 + bj * 128 + wc * 32 + 8 * fq;
            int kind; bf16_t* base; int stride; float sc = 1.0f;
            if (c0 < 512) { kind = 0; base = QhA + ((size_t)(c0 >> 6) * T) * 64 + (c0 & 63); stride = 64; sc = QSCALE; }
            else if (c0 < 1024) { kind = 0; base = KhA + ((size_t)((c0 - 512) >> 6) * T) * 64 + (c0 & 63); stride = 64; }
            else if (c0 < 1536) { kind = 1; base = VhA + ((size_t)((c0 - 1024) >> 6) * T) * 64 + (c0 & 63); stride = 64; }
            else if (c0 < 2048) { kind = 0; base = QhB + ((size_t)((c0 - 1536) >> 6) * T) * 64 + (c0 & 63); stride = 64; sc = QSCALE; }
            else if (c0 < 2176) { kind = 0; base = KhB + ((size_t)((c0 - 2048) >> 6) * T) * 64 + (c0 & 63); stride = 64; }
            else { kind = 1; base = VhB + ((size_t)((c0 - 2176) >> 6) * T) * 64 + (c0 & 63); stride = 64; }
            const int pi = (c0 & 63) >> 1;
#pragma unroll
            for (int ai = 0; ai < 2; ++ai)
#pragma unroll
                for (int m = 0; m < 4; ++m) {
                    const int tok = row0 + ai * 128 + m * 16;
                    const f32x4 v0 = acc[ai][bj][m][0], v1 = acc[ai][bj][m][1];
                    float y[8];
                    if (kind == 0) {
                        const int s = tok & (S - 1);
                        const f32x4 c4 = *(const f32x4*)(rc + s * 32 + pi), s4 = *(const f32x4*)(rs + s * 32 + pi);
                        y[0] = (v0[0] * c4[0] - v0[1] * s4[0]) * sc; y[1] = (v0[1] * c4[0] + v0[0] * s4[0]) * sc;
                        y[2] = (v0[2] * c4[1] - v0[3] * s4[1]) * sc; y[3] = (v0[3] * c4[1] + v0[2] * s4[1]) * sc;
                        y[4] = (v1[0] * c4[2] - v1[1] * s4[2]) * sc; y[5] = (v1[1] * c4[2] + v1[0] * s4[2]) * sc;
                        y[6] = (v1[2] * c4[3] - v1[3] * s4[3]) * sc; y[7] = (v1[3] * c4[3] + v1[2] * s4[3]) * sc;
                    } else { y[0] = v0[0]; y[1] = v0[1]; y[2] = v0[2]; y[3] = v0[3]; y[4] = v1[0]; y[5] = v1[1]; y[6] = v1[2]; y[7] = v1[3]; }
                    v4u w; w.x = pk2(y[0], y[1]); w.y = pk2(y[2], y[3]); w.z = pk2(y[4], y[5]); w.w = pk2(y[6], y[7]);
                    *(v4u*)(base + (size_t)tok * stride) = w;
                }
        }
    }
};

struct EpiLora {
    static constexpr bool PERM = false, AFTER_DRAIN = false;
    const float *w0, *a0, *k_a; const bf16_t *KB, *KK; bf16_t *LW, *KD, *BB, *G;
    __device__ __forceinline__ void operator()(const f32x4 (&acc)[2][2][4][2], const pg8::Unit& u, int wr, int wc, int fr, int fq) const {
        asm volatile("" : "+v"(fr), "+v"(fq));
        const int row0 = u.pm * 256 + wr * 64 + fr;
#pragma unroll
        for (int bj = 0; bj < 2; ++bj)
#pragma unroll
            for (int n = 0; n < 2; ++n) {
                const int c0 = u.pn * 256 + bj * 128 + wc * 32 + n * 16 + 4 * fq, sec = c0 >> 9, cc = c0 & 511;
#pragma unroll
                for (int ai = 0; ai < 2; ++ai)
#pragma unroll
                    for (int m = 0; m < 4; ++m) {
                        const size_t tok = row0 + ai * 128 + m * 16;
                        const f32x4 v = acc[ai][bj][m][n];
                        if (sec < 2) {
                            const f32x4 w = *(const f32x4*)(w0 + sec * 512 + cc); float o[4];
#pragma unroll
                            for (int j = 0; j < 4; ++j) { const float xw = -(w[j] + v[j]);
                                o[j] = -0.6065306597126334f * frcp(1.0f + __expf(xw)); }
                            v2u ww; ww.x = pk2(o[0], o[1]); ww.y = pk2(o[2], o[3]);
                            *(v2u*)(LW + ((size_t)sec * T + tok) * 512 + cc) = ww;
                        } else if (sec < 4) {
                            const int d = sec - 2;
                            const f32x4 a_ = *(const f32x4*)(a0 + d * 512 + cc), ka = *(const f32x4*)(k_a + cc);
                            const v2u kw = *(const v2u*)(KB + tok * 512 + cc), kkw = *(const v2u*)(KK + tok * 512 + cc);
                            const float kv[4] = {bflo(kw.x), bfhi(kw.x), bflo(kw.y), bfhi(kw.y)}, kk[4] = {bflo(kkw.x), bfhi(kkw.x), bflo(kkw.y), bfhi(kkw.y)};
                            float okd[4], obb[4];
#pragma unroll
                            for (int j = 0; j < 4; ++j) { const float alr = frcp(1.0f + __expf(-(a_[j] + v[j]))); okd[j] = kv[j] * (1.0f + (alr - 1.0f) * ka[j]); obb[j] = kk[j] * alr; }
                            v2u w1, w2_; w1.x = pk2(okd[0], okd[1]); w1.y = pk2(okd[2], okd[3]); w2_.x = pk2(obb[0], obb[1]); w2_.y = pk2(obb[2], obb[3]);
                            *(v2u*)(KD + ((size_t)d * T + tok) * 512 + cc) = w1; *(v2u*)(BB + ((size_t)d * T + tok) * 512 + cc) = w2_;
                        } else { v2u ww; ww.x = pk2(v[0], v[1]); ww.y = pk2(v[2], v[3]); *(v2u*)(G + tok * 512 + cc) = ww; }
                        __builtin_amdgcn_sched_barrier(0);
                    }
            }
    }
};

__device__ __forceinline__ float clamp8(float x) { return __builtin_amdgcn_fmed3f(x, -448.f, 448.f); }
__device__ __forceinline__ unsigned pk4_fp8(float a, float b, float c, float d) {
    int w = 0; w = __builtin_amdgcn_cvt_pk_fp8_f32(clamp8(a), clamp8(b), w, false); w = __builtin_amdgcn_cvt_pk_fp8_f32(clamp8(c), clamp8(d), w, true); return (unsigned)w;
}
struct EpiSiluMul8 {
    static constexpr bool PERM = true, AFTER_DRAIN = false;
    unsigned char* HIDp;
    __device__ __forceinline__ void operator()(const f32x4 (&acc)[2][2][4][2], const pg8::Unit& u, int wr, int wc, int fr, int fq) const {
        asm volatile("s_nop 7\n\ts_nop 7\n\ts_nop 7"); __builtin_amdgcn_sched_barrier(0);
        const int pnl = u.pn % 22;
        const int row0 = u.pm * 256 + wr * 64 + fr, col0 = pnl * 128 + wc * 32 + 8 * fq;
        const float s1 = 1.0f / (ASC8 * GUSC8);
#pragma unroll
        for (int ai = 0; ai < 2; ++ai)
#pragma unroll
            for (int m = 0; m < 4; ++m) { unsigned char* rowp = HIDp + (size_t)(row0 + ai * 128 + m * 16) * DE + col0; float h[8];
#pragma unroll
                for (int n = 0; n < 2; ++n) { const f32x4 g = acc[ai][0][m][n] * s1, up = acc[ai][1][m][n] * (s1 * HSC8);
#pragma unroll
                    for (int j = 0; j < 4; ++j) h[4 * n + j] = g[j] * frcp(1.0f + __expf(-g[j])) * up[j]; }
                v2u w; w.x = pk4_fp8(h[0], h[1], h[2], h[3]); w.y = pk4_fp8(h[4], h[5], h[6], h[7]);
                *(v2u*)rowp = w; }
    }
};
struct EpiYE8 {
    static constexpr bool PERM = true, AFTER_DRAIN = false;
    const float* GATE; bf16_t* YE;
    __device__ __forceinline__ void operator()(const f32x4 (&acc)[2][2][4][2], const pg8::Unit& u, int wr, int wc, int fr, int fq) const {
        asm volatile("s_nop 7\n\ts_nop 7\n\ts_nop 7"); __builtin_amdgcn_sched_barrier(0);
        const int pnl = u.pn & 3;
        const int row0 = u.pm * 256 + wr * 64 + fr, col0 = pnl * 256 + wc * 32 + 8 * fq;
#pragma unroll
        for (int ai = 0; ai < 2; ++ai)
#pragma unroll
            for (int m = 0; m < 4; ++m) { const int row = row0 + ai * 128 + m * 16; const float gt_ = GATE[row] * (1.0f / (HSC8 * DSC8)); bf16_t* rowp = YE + (size_t)row * D + col0;
#pragma unroll
                for (int bj = 0; bj < 2; ++bj) { const f32x4 v0 = acc[ai][bj][m][0] * gt_, v1 = acc[ai][bj][m][1] * gt_;
                    v4u w; w.x = pk2(v0[0], v0[1]); w.y = pk2(v0[2], v0[3]); w.z = pk2(v1[0], v1[1]); w.w = pk2(v1[2], v1[3]);
                    *(v4u*)(rowp + bj * 128) = w; } }
    }
};
template <class RowMap>
__device__ __forceinline__ void transpose_item_fp8(const float* W, int K, int N, unsigned char* WT, RowMap rm, float sc, LAS float* scr, int item, int lane) {
    const int nblk = N / 64, kb = item / nblk, nb_ = item % nblk, k0 = 64 * kb, n0 = 64 * nb_;
    f32x4 ld[16];
#pragma unroll
    for (int i = 0; i < 16; ++i) ld[i] = *(const f32x4*)(W + (size_t)(k0 + 4 * i + (lane >> 4)) * N + n0 + 4 * (lane & 15));
#pragma unroll
    for (int i = 0; i < 16; ++i) { LAS float* p = scr + (4 * i + (lane >> 4)) * 65 + 4 * (lane & 15); p[0] = ld[i][0]; p[1] = ld[i][1]; p[2] = ld[i][2]; p[3] = ld[i][3]; }
    asm volatile("s_waitcnt lgkmcnt(0)" ::: "memory");
    const int c = lane & 3;
#pragma unroll
    for (int j = 0; j < 4; ++j) { const int n = (lane >> 2) + 16 * j; const LAS float* s = scr + (16 * c) * 65 + n;
        v4u o;
#pragma unroll
        for (int q = 0; q < 4; ++q) o[q] = pk4_fp8(s[(4 * q) * 65] * sc, s[(4 * q + 1) * 65] * sc, s[(4 * q + 2) * 65] * sc, s[(4 * q + 3) * 65] * sc);
        *(v4u*)(WT + (size_t)rm(n0 + n) * K + k0 + 16 * c) = o; }
    asm volatile("s_waitcnt lgkmcnt(0)" ::: "memory");
}

struct EpiResidN {
    static constexpr bool PERM = false, AFTER_DRAIN = false;
    const float* base; float* out; bf16_t* Xb; float* SSP;
    __device__ __forceinline__ void operator()(const f32x4 (&acc)[2][2][4][2], const pg8::Unit& u, int wr, int wc, int fr, int fq) const {
        asm volatile("" : "+v"(fr), "+v"(fq));
        const int row0 = u.pm * 256 + wr * 64 + fr, col0 = u.pn * 256 + wc * 32 + 4 * fq;
#pragma unroll
        for (int ai = 0; ai < 2; ++ai)
#pragma unroll
            for (int m = 0; m < 4; ++m) { const size_t row = row0 + ai * 128 + m * 16; const size_t off = row * D + col0; float ss = 0.f;
#pragma unroll
                for (int bj = 0; bj < 2; ++bj)
#pragma unroll
                    for (int n = 0; n < 2; ++n) { const f32x4 b = *(const f32x4*)(base + off + bj * 128 + n * 16); const f32x4 o = b + acc[ai][bj][m][n];
                        *(f32x4*)(out + off + bj * 128 + n * 16) = o;
                        v2u w; w.x = pk2(o[0], o[1]); w.y = pk2(o[2], o[3]); *(v2u*)(Xb + off + bj * 128 + n * 16) = w;
                        ss += (o[0] * o[0] + o[1] * o[1]) + (o[2] * o[2] + o[3] * o[3]); }
                ss += __shfl_xor(ss, 16); ss += __shfl_xor(ss, 32);
                if (fq == 0) SSP[row * 16 + u.pn * 4 + wc] = ss; }
    }
};
struct EpiBf16StoreRS {
    static constexpr bool PERM = true, AFTER_DRAIN = false;
    bf16_t* O; int ldc; const float* SSP;
    __device__ __forceinline__ void operator()(const f32x4 (&acc)[2][2][4][2], const pg8::Unit& u, int wr, int wc, int fr, int fq) const {
        asm volatile("" : "+v"(fr), "+v"(fq));
        const int row0 = u.pm * 256 + wr * 64 + fr, col0 = u.pn * 256 + wc * 32 + 8 * fq;
#pragma unroll
        for (int ai = 0; ai < 2; ++ai)
#pragma unroll
            for (int m = 0; m < 4; ++m) { const size_t row = row0 + ai * 128 + m * 16;
                const f32x4* sp = (const f32x4*)(SSP + row * 16); const f32x4 s0 = sp[0], s1 = sp[1], s2 = sp[2], s3 = sp[3];
                const float ss = (((s0[0] + s0[1]) + (s0[2] + s0[3])) + ((s1[0] + s1[1]) + (s1[2] + s1[3]))) + (((s2[0] + s2[1]) + (s2[2] + s2[3])) + ((s3[0] + s3[1]) + (s3[2] + s3[3])));
                const float rs = rsqrtf(ss * (1.0f / D) + 1e-6f);
                bf16_t* rowp = O + row * ldc + col0;
#pragma unroll
                for (int bj = 0; bj < 2; ++bj) { const f32x4 v0 = acc[ai][bj][m][0] * rs, v1 = acc[ai][bj][m][1] * rs;
                    v4u w; w.x = pk2(v0[0], v0[1]); w.y = pk2(v0[2], v0[3]); w.z = pk2(v1[0], v1[1]); w.w = pk2(v1[2], v1[3]);
                    *(v4u*)(rowp + bj * 128) = w; } }
    }
};
struct MoeOrder {
    int G, c, npairs;
    int per;
    __device__ __forceinline__ bool next(int i, pg8::Unit& u) const {
        const int x = c & 7, y = c >> 3, pml = y & 7, pnq = y >> 3;
        const int epn = i * 32 + x * 4 + pnq;
        if (epn >= npairs || c >= 256) return false;
        const int e = epn / per;
        u.pm = e * 8 + pml; u.pn = epn; return true;
    }
    __device__ __forceinline__ void a_ready(const pg8::Unit&) const {}
    __device__ __forceinline__ void done(const pg8::Unit&) const {}
};

struct XattnOrder {
    int c;
    __device__ __forceinline__ bool next(int i, pg8::Unit& u) const { if (i != 0 || c >= 256) return false; u.pm = (c >> 7) * 32 + (c & 31); u.pn = (c >> 5) & 3; return true; }
    __device__ __forceinline__ void a_ready(const pg8::Unit&) const {}
    __device__ __forceinline__ void done(const pg8::Unit&) const {}
};
template <class RowMap>
__device__ __forceinline__ void transpose_item(const float* W, int K, int N, bf16_t* WT, RowMap rm, LAS float* scr, int item, int lane, const float* kscale = nullptr) {
    const int nblk = N / 64, kb = item / nblk, nb_ = item % nblk, k0 = 64 * kb, n0 = 64 * nb_;
    f32x4 ld[16];
#pragma unroll
    for (int i = 0; i < 16; ++i) ld[i] = *(const f32x4*)(W + (size_t)(k0 + 4 * i + (lane >> 4)) * N + n0 + 4 * (lane & 15));
#pragma unroll
    for (int i = 0; i < 16; ++i) { LAS float* p = scr + (4 * i + (lane >> 4)) * 65 + 4 * (lane & 15); p[0] = ld[i][0]; p[1] = ld[i][1]; p[2] = ld[i][2]; p[3] = ld[i][3]; }
    asm volatile("s_waitcnt lgkmcnt(0)" ::: "memory");
    const int c = lane & 7;
    float ksc[8];
#pragma unroll
    for (int q = 0; q < 8; ++q) ksc[q] = kscale ? kscale[k0 + 8 * c + q] : 1.0f;
#pragma unroll
    for (int j = 0; j < 8; ++j) { const int n = (lane >> 3) + 8 * j; const LAS float* s = scr + (8 * c) * 65 + n;
        v4u o; o.x = pk2(s[0 * 65] * ksc[0], s[1 * 65] * ksc[1]); o.y = pk2(s[2 * 65] * ksc[2], s[3 * 65] * ksc[3]); o.z = pk2(s[4 * 65] * ksc[4], s[5 * 65] * ksc[5]); o.w = pk2(s[6 * 65] * ksc[6], s[7 * 65] * ksc[7]);
        *(v4u*)(WT + (size_t)rm(n0 + n) * K + k0 + 8 * c) = o; }
    asm volatile("s_waitcnt lgkmcnt(0)" ::: "memory");
}

__device__ __forceinline__ void rmsnorm_rows_bf16(const float* x, const float* g, bf16_t* out, int M) {
    const int tix_ = tidx(); const int lane = tix_ & 63, gw = blockIdx.x * 8 + (tix_ >> 6), ngw = gridDim.x * 8;
    for (int m = gw; m < M; m += ngw) {
        const float4* xr = (const float4*)(x + (size_t)m * D);
        float4 v[4]; float s = 0.f;
#pragma unroll
        for (int j = 0; j < 4; ++j) { v[j] = xr[lane + 64 * j]; s += v[j].x * v[j].x + v[j].y * v[j].y + v[j].z * v[j].z + v[j].w * v[j].w; }
        const float r = rsqrtf(wave_sum(s) * (1.0f / D) + 1e-6f);
        v2u* o = (v2u*)(out + (size_t)m * D);
#pragma unroll
        for (int j = 0; j < 4; ++j) { const float4 gg = ((const float4*)g)[lane + 64 * j];
            v2u w; w.x = pk2(v[j].x * r * gg.x, v[j].y * r * gg.y); w.y = pk2(v[j].z * r * gg.z, v[j].w * r * gg.w); o[lane + 64 * j] = w; }
    }
}
__device__ __forceinline__ void rmsnorm_rows_f32(const float* x, const float* g, float* out, int M) {
    const int tix_ = tidx(); const int lane = tix_ & 63, gw = blockIdx.x * 8 + (tix_ >> 6), ngw = gridDim.x * 8;
    for (int m = gw; m < M; m += ngw) {
        const float4* xr = (const float4*)(x + (size_t)m * D);
        float4 v[4]; float s = 0.f;
#pragma unroll
        for (int j = 0; j < 4; ++j) { v[j] = xr[lane + 64 * j]; s += v[j].x * v[j].x + v[j].y * v[j].y + v[j].z * v[j].z + v[j].w * v[j].w; }
        const float r = rsqrtf(wave_sum(s) * (1.0f / D) + 1e-6f);
        float4* o = (float4*)(out + (size_t)m * D);
#pragma unroll
        for (int j = 0; j < 4; ++j) { const float4 gg = ((const float4*)g)[lane + 64 * j];
            o[lane + 64 * j] = make_float4(v[j].x * r * gg.x, v[j].y * r * gg.y, v[j].z * r * gg.z, v[j].w * r * gg.w); }
    }
}

__device__ __forceinline__ int block_exscan(int v, int* sh, int* tot) {
    const int tid = tidx(), lane = tid & 63, w = tid >> 6;
    int inc = v;
#pragma unroll
    for (int o = 1; o < 64; o <<= 1) { const int t = __shfl_up(inc, o); if (lane >= o) inc += t; }
    __syncthreads();
    if (lane == 63) sh[w] = inc;
    __syncthreads();
    int base = 0, total = 0;
#pragma unroll
    for (int i = 0; i < 8; ++i) { const int x = sh[i]; if (i < w) base += x; total += x; }
    *tot = total;
    return base + inc - v;
}


typedef short bf16x8 __attribute__((ext_vector_type(8)));
typedef float f32x16 __attribute__((ext_vector_type(16)));
constexpr int MROW = 144;
constexpr int MBUF = 64 * MROW;
__device__ __forceinline__ bf16x8 frag_rm(const LAS unsigned char* M, int row0, int k0, int fr, int fq) {
    return *(const LAS bf16x8*)(M + (row0 + fr) * MROW + (k0 + 8 * fq) * 2);
}
__device__ __forceinline__ bf16x8 frag_cm(const LAS unsigned char* M, int k0, int col0, int fr, int fq) {
    const LAS unsigned short* p = (const LAS unsigned short*)(M + (k0 + 8 * fq) * MROW + (col0 + fr) * 2);
    bf16x8 v;
#pragma unroll
    for (int j = 0; j < 8; ++j) v[j] = (short)p[j * (MROW / 2)];
    return v;
}
__device__ __forceinline__ void tile_store_bf16(LAS unsigned char* M, int m0, int n0, int fr, int fq, const f32x4& c) {
    v2u w; w.x = pk2(c[0], c[1]); w.y = pk2(c[2], c[3]);
    *(LAS v2u*)(M + (m0 + fr) * MROW + (n0 + 4 * fq) * 2) = w;
}
#define MMA16(acc, lf, rf) acc = __builtin_amdgcn_mfma_f32_16x16x32_bf16(rf, lf, acc, 0, 0, 0)

__device__ __forceinline__ void tile_store_bf16_T(LAS unsigned char* M, int m0, int n0, int fr, int fq, const f32x4& c) {
    const unsigned w0 = pk2(c[0], c[1]), w1 = pk2(c[2], c[3]);
    LAS unsigned char* p = M + (n0 + 4 * fq) * MROW + (m0 + fr) * 2;
    *(LAS unsigned short*)(p) = (unsigned short)(w0 & 0xffffu); *(LAS unsigned short*)(p + MROW) = (unsigned short)(w0 >> 16);
    *(LAS unsigned short*)(p + 2 * MROW) = (unsigned short)(w1 & 0xffffu); *(LAS unsigned short*)(p + 3 * MROW) = (unsigned short)(w1 >> 16);
}
__device__ __forceinline__ void scan_r1(const bf16_t* LWg, const bf16_t* RVg, const bf16_t* KDg, const bf16_t* KKg, const bf16_t* BBg,
                                        bf16_t* PT, bf16_t* QT, bf16_t* RH, float* YL, unsigned char* lds_raw) {
    LAS unsigned char* L = (LAS unsigned char*)lds_raw;
#define SL(k) (L + (k) * MBUF)
    LAS float* LWs = (LAS float*)(L + 14 * MBUF);
    const int tid = tidx(), lane = tid & 63, wave = tid >> 6, fr = lane & 15, fq = lane >> 4;
    const int tm = wave >> 1, tn0 = (wave & 1) * 2;
    const int m0 = tm * 16;
    const int t = tid >> 3, i0 = (tid & 7) * 8;
    v4u lw4n, r4n, v4n, kd4n, kk4n, bb4n;
#define R1_LOAD(it_) do { const int c_ = (it_) & 127, h_ = ((it_) >> 7) & 7, n_ = (it_) >> 10, dir_ = n_ >> 1, b_ = n_ & 1; \
        const int pos_ = dir_ ? (S - 1 - (c_ * 64 + t)) : (c_ * 64 + t); const size_t tok_ = (size_t)b_ * S + pos_; const size_t ch_ = (size_t)h_ * 64 + i0; \
        lw4n = *(const v4u*)(LWg + ((size_t)dir_ * T + tok_) * 512 + ch_); r4n = *(const v4u*)(RVg + tok_ * D + ch_); v4n = *(const v4u*)(RVg + tok_ * D + 512 + ch_); \
        kd4n = *(const v4u*)(KDg + ((size_t)dir_ * T + tok_) * 512 + ch_); kk4n = *(const v4u*)(KKg + tok_ * 512 + ch_); bb4n = *(const v4u*)(BBg + ((size_t)dir_ * T + tok_) * 512 + ch_); } while (0)
    if ((int)blockIdx.x < 4096) R1_LOAD((int)blockIdx.x);
    for (int item = blockIdx.x; item < 4096; item += gridDim.x) {
        const v4u lw4 = lw4n, r4 = r4n, v4 = v4n, kd4 = kd4n, kk4 = kk4n, bb4 = bb4n;
        float lw[8], Lin[8];
#pragma unroll
        for (int q = 0; q < 4; ++q) { lw[2 * q] = bflo(lw4[q]); lw[2 * q + 1] = bfhi(lw4[q]); }
#pragma unroll
        for (int j = 0; j < 8; ++j) { float x = lw[j];
#pragma unroll
            for (int o = 8; o < 64; o <<= 1) { const float y = __shfl_up(x, o); if (lane >= o) x += y; }
            Lin[j] = x; }
        __syncthreads();
        if (lane >= 56) {
#pragma unroll
            for (int j = 0; j < 8; ++j) LWs[64 + wave * 64 + i0 + j] = Lin[j]; }
        __syncthreads();
        {
            float off[8];
#pragma unroll
            for (int j = 0; j < 8; ++j) off[j] = 0.f;
            for (int w = 0; w < 8; ++w) { if (w < wave) {
#pragma unroll
                for (int j = 0; j < 8; ++j) off[j] += LWs[64 + w * 64 + i0 + j]; } }
#pragma unroll
            for (int j = 0; j < 8; ++j) Lin[j] += off[j];
            if (t == 63) {
#pragma unroll
                for (int j = 0; j < 8; ++j) LWs[i0 + j] = Lin[j]; }
            float at_[8], rt_[8], bt_[8], kt_[8];
#pragma unroll
            for (int q = 0; q < 4; ++q) {
#pragma unroll
                for (int e = 0; e < 2; ++e) { const int j = 2 * q + e;
                    const float ein = __expf(Lin[j]), einv = __expf(-Lin[j]), eex = __expf(Lin[j] - lw[j]);
                    const float kkv = e ? bfhi(kk4[q]) : bflo(kk4[q]), rv_ = e ? bfhi(r4[q]) : bflo(r4[q]), bbv = e ? bfhi(bb4[q]) : bflo(bb4[q]), kdv = e ? bfhi(kd4[q]) : bflo(kd4[q]);
                    at_[j] = -kkv * eex; rt_[j] = rv_ * ein; bt_[j] = bbv * einv; kt_[j] = kdv * einv; }
            }
            v4u wa, wb, wk, w;
            wa.x = pk2(at_[0], at_[1]); wa.y = pk2(at_[2], at_[3]); wa.z = pk2(at_[4], at_[5]); wa.w = pk2(at_[6], at_[7]); *(LAS v4u*)(SL(0) + t * MROW + i0 * 2) = wa;
            w.x = pk2(rt_[0], rt_[1]); w.y = pk2(rt_[2], rt_[3]); w.z = pk2(rt_[4], rt_[5]); w.w = pk2(rt_[6], rt_[7]); *(LAS v4u*)(SL(2) + t * MROW + i0 * 2) = w;
            wb.x = pk2(bt_[0], bt_[1]); wb.y = pk2(bt_[2], bt_[3]); wb.z = pk2(bt_[4], bt_[5]); wb.w = pk2(bt_[6], bt_[7]); *(LAS v4u*)(SL(3) + t * MROW + i0 * 2) = wb;
            wk.x = pk2(kt_[0], kt_[1]); wk.y = pk2(kt_[2], kt_[3]); wk.z = pk2(kt_[4], kt_[5]); wk.w = pk2(kt_[6], kt_[7]); *(LAS v4u*)(SL(5) + t * MROW + i0 * 2) = wk;
#pragma unroll
            for (int q = 0; q < 4; ++q) {
                LAS unsigned char* pT = (LAS unsigned char*)0 + (i0 + 2 * q) * MROW + t * 2;
                *(LAS unsigned short*)(SL(1) + (size_t)pT) = (unsigned short)(wa[q] & 0xffffu); *(LAS unsigned short*)(SL(1) + (size_t)pT + MROW) = (unsigned short)(wa[q] >> 16);
                *(LAS unsigned short*)(SL(4) + (size_t)pT) = (unsigned short)(wb[q] & 0xffffu); *(LAS unsigned short*)(SL(4) + (size_t)pT + MROW) = (unsigned short)(wb[q] >> 16);
                *(LAS unsigned short*)(SL(6) + (size_t)pT) = (unsigned short)(wk[q] & 0xffffu); *(LAS unsigned short*)(SL(6) + (size_t)pT + MROW) = (unsigned short)(wk[q] >> 16);
                *(LAS unsigned short*)(SL(7) + (size_t)pT) = (unsigned short)(v4[q] & 0xffffu); *(LAS unsigned short*)(SL(7) + (size_t)pT + MROW) = (unsigned short)(v4[q] >> 16);
            }
        }
        if (item + (int)gridDim.x < 4096) R1_LOAD(item + (int)gridDim.x);
        __syncthreads();
        f32x4 Tacc[2];
        {
            bf16x8 la[2], lr[2];
#pragma unroll
            for (int ks = 0; ks < 2; ++ks) { la[ks] = frag_rm(SL(0), m0, 32 * ks, fr, fq); lr[ks] = frag_rm(SL(2), m0, 32 * ks, fr, fq); }
#pragma unroll
            for (int q = 0; q < 2; ++q) {
                const int n0 = (tn0 + q) * 16;
                f32x4 cab = {0.f, 0.f, 0.f, 0.f}, cak = cab, crb = cab, crk = cab;
#pragma unroll
                for (int ks = 0; ks < 2; ++ks) {
                    const bf16x8 rb_ = frag_rm(SL(3), n0, 32 * ks, fr, fq), rk_ = frag_rm(SL(5), n0, 32 * ks, fr, fq);
                    MMA16(cab, la[ks], rb_); MMA16(cak, la[ks], rk_); MMA16(crb, lr[ks], rb_); MMA16(crk, lr[ks], rk_);
                }
                const int tt = m0 + fr;
#pragma unroll
                for (int j = 0; j < 4; ++j) { const int ss = n0 + 4 * fq + j;
                    if (!(ss < tt)) { cab[j] = 0.f; cak[j] = 0.f; }
                    if (!(ss <= tt)) { crb[j] = 0.f; crk[j] = 0.f; } }
                tile_store_bf16(SL(8), m0, n0, fr, fq, cab); tile_store_bf16_T(SL(9), m0, n0, fr, fq, cab);
                tile_store_bf16(SL(10), m0, n0, fr, fq, cak);
                tile_store_bf16(SL(11), m0, n0, fr, fq, crb); tile_store_bf16(SL(12), m0, n0, fr, fq, crk);
#pragma unroll
                for (int j = 0; j < 4; ++j) cab[j] += ((n0 + 4 * fq + j) == tt) ? 1.f : 0.f;
                Tacc[q] = cab;
                tile_store_bf16(SL(13), m0, n0, fr, fq, cab);
            }
        }
        __syncthreads();
        {
            bf16x8 lk[2], ln_[2];
#pragma unroll
            for (int ks = 0; ks < 2; ++ks) { lk[ks] = frag_rm(SL(10), m0, 32 * ks, fr, fq); ln_[ks] = frag_rm(SL(8), m0, 32 * ks, fr, fq); }
#pragma unroll
            for (int q = 0; q < 2; ++q) {
                const int n0 = (tn0 + q) * 16;
                f32x4 cw = {0.f, 0.f, 0.f, 0.f}, cn = cw;
#pragma unroll
                for (int ks = 0; ks < 2; ++ks) { MMA16(cw, lk[ks], frag_rm(SL(7), n0, 32 * ks, fr, fq)); MMA16(cn, ln_[ks], frag_rm(SL(9), n0, 32 * ks, fr, fq)); }
                tile_store_bf16_T(SL(0), m0, n0, fr, fq, cw);
                tile_store_bf16(SL(3), m0, n0, fr, fq, cn); tile_store_bf16_T(SL(5), m0, n0, fr, fq, cn);
            }
        }
        __syncthreads();
#pragma unroll
        for (int k = 1; k <= 5; ++k) {
            LAS unsigned char* Nk = (k & 1) ? SL(3) : SL(8); LAS unsigned char* NkT = (k & 1) ? SL(5) : SL(9);
            LAS unsigned char* Nn = (k & 1) ? SL(8) : SL(3); LAS unsigned char* NnT = (k & 1) ? SL(9) : SL(5);
            LAS unsigned char* Tk = (k & 1) ? SL(13) : SL(10); LAS unsigned char* Tn = (k & 1) ? SL(10) : SL(13);
            bf16x8 lt[2], ln_[2];
#pragma unroll
            for (int ks = 0; ks < 2; ++ks) { lt[ks] = frag_rm(Tk, m0, 32 * ks, fr, fq); ln_[ks] = frag_rm(Nk, m0, 32 * ks, fr, fq); }
#pragma unroll
            for (int q = 0; q < 2; ++q) {
                const int n0 = (tn0 + q) * 16;
                f32x4 cn = {0.f, 0.f, 0.f, 0.f};
#pragma unroll
                for (int ks = 0; ks < 2; ++ks) { const bf16x8 rn = frag_rm(NkT, n0, 32 * ks, fr, fq); MMA16(Tacc[q], lt[ks], rn); if (k < 5) MMA16(cn, ln_[ks], rn); }
                tile_store_bf16(Tn, m0, n0, fr, fq, Tacc[q]);
                if (k < 5) { tile_store_bf16(Nn, m0, n0, fr, fq, cn); tile_store_bf16_T(NnT, m0, n0, fr, fq, cn); }
            }
            __syncthreads();
        }
        {
            bf16x8 lt[2];
#pragma unroll
            for (int ks = 0; ks < 2; ++ks) lt[ks] = frag_rm(SL(10), m0, 32 * ks, fr, fq);
#pragma unroll
            for (int q = 0; q < 2; ++q) {
                const int n0 = (tn0 + q) * 16;
                f32x4 ca = {0.f, 0.f, 0.f, 0.f}, cu = ca;
#pragma unroll
                for (int ks = 0; ks < 2; ++ks) { MMA16(ca, lt[ks], frag_rm(SL(1), n0, 32 * ks, fr, fq)); MMA16(cu, lt[ks], frag_rm(SL(0), n0, 32 * ks, fr, fq)); }
                tile_store_bf16_T(SL(8), m0, n0, fr, fq, ca); tile_store_bf16_T(SL(9), m0, n0, fr, fq, cu);
            }
        }
        __syncthreads();
        {
            bf16x8 lrb[2], lrk[2], lb[2], lkt[2];
#pragma unroll
            for (int ks = 0; ks < 2; ++ks) { lrb[ks] = frag_rm(SL(11), m0, 32 * ks, fr, fq); lrk[ks] = frag_rm(SL(12), m0, 32 * ks, fr, fq);
                lb[ks] = frag_rm(SL(4), m0, 32 * ks, fr, fq); lkt[ks] = frag_rm(SL(6), m0, 32 * ks, fr, fq); }
            const float wc = __expf(LWs[m0 + fr]);
#pragma unroll
            for (int q = 0; q < 2; ++q) {
                const int n0 = (tn0 + q) * 16;
                f32x4 crh = {0.f, 0.f, 0.f, 0.f}, cyl = crh, cp = crh, cq = crh;
#pragma unroll
                for (int ks = 0; ks < 2; ++ks) {
                    const bf16x8 ra = frag_rm(SL(8), n0, 32 * ks, fr, fq), ru = frag_rm(SL(9), n0, 32 * ks, fr, fq), rv = frag_rm(SL(7), n0, 32 * ks, fr, fq);
                    MMA16(crh, lrb[ks], ra); MMA16(cyl, lrb[ks], ru); MMA16(cyl, lrk[ks], rv);
                    MMA16(cp, lb[ks], ra); MMA16(cq, lb[ks], ru); MMA16(cq, lkt[ks], rv);
                }
                const size_t o = (size_t)item * 4096 + (size_t)(m0 + fr) * 64 + n0 + 4 * fq;
                { const LAS unsigned short* rp = (const LAS unsigned short*)(SL(2) + (m0 + fr) * MROW + (n0 + 4 * fq) * 2);
#pragma unroll
                  for (int j = 0; j < 4; ++j) crh[j] += __uint_as_float(((unsigned)rp[j]) << 16); }
                { v2u w; w.x = pk2(crh[0], crh[1]); w.y = pk2(crh[2], crh[3]); *(v2u*)(RH + o) = w; }
                *(f32x4*)(YL + o) = cyl;
#pragma unroll
                for (int j = 0; j < 4; ++j) { cp[j] = wc * (cp[j] + (((n0 + 4 * fq + j) == (m0 + fr)) ? 1.f : 0.f)); cq[j] *= wc; }
                { v2u w; w.x = pk2(cp[0], cp[1]); w.y = pk2(cp[2], cp[3]); *(v2u*)(PT + o) = w; }
                { v2u w; w.x = pk2(cq[0], cq[1]); w.y = pk2(cq[2], cq[3]); *(v2u*)(QT + o) = w; }
            }
        }
    }
#undef SL
}
#undef R1_LOAD

__device__ __forceinline__ bf16x8 pack_acc8(const f32x16& x, int s) {
    v4u p; p.x = pk2(x[8 * s], x[8 * s + 1]); p.y = pk2(x[8 * s + 2], x[8 * s + 3]); p.z = pk2(x[8 * s + 4], x[8 * s + 5]); p.w = pk2(x[8 * s + 6], x[8 * s + 7]);
    return __builtin_bit_cast(bf16x8, p);
}
__device__ __forceinline__ void scan_r2(const bf16_t* PT, const bf16_t* QT, bf16_t* S0, unsigned char* lds_raw) {
    LAS unsigned char* L = (LAS unsigned char*)lds_raw;
    constexpr int SLOT_B = MBUF + 8192;
    const int tid = tidx(), lane = tid & 63, wave = tid >> 6;
    const int r = lane & 31, h2 = lane >> 5, jb = wave;
    f32x16 st[2];
#pragma unroll
    for (int ib = 0; ib < 2; ++ib)
#pragma unroll
        for (int g = 0; g < 16; ++g) st[ib][g] = 0.f;
    const size_t item0 = (size_t)blockIdx.x * 128;
    v4u stage[16];
#pragma unroll
    for (int q = 0; q < 16; ++q) { const int p = tid + 512 * q, cc = p >> 10, w = p & 1023, mat = w >> 9, idx = w & 511;
        stage[q] = *(const v4u*)((mat ? QT : PT) + (item0 + cc) * 4096 + idx * 8); }
    for (int grp = 0; grp < 16; ++grp) {
        __syncthreads();
#pragma unroll
        for (int q = 0; q < 16; ++q) { const int p = tid + 512 * q, cc = p >> 10, w = p & 1023, mat = w >> 9, idx = w & 511;
            *(LAS v4u*)(L + cc * SLOT_B + (mat ? (MBUF + idx * 16) : ((idx >> 3) * MROW + (idx & 7) * 16))) = stage[q]; }
        __syncthreads();
        if (grp < 15) {
#pragma unroll
            for (int q = 0; q < 16; ++q) { const int p = tid + 512 * q, cc = p >> 10, w = p & 1023, mat = w >> 9, idx = w & 511;
                stage[q] = *(const v4u*)((mat ? QT : PT) + (item0 + (grp + 1) * 8 + cc) * 4096 + idx * 8); }
        }
        if (wave < 2) {
#pragma unroll 1
            for (int cc = 0; cc < 8; ++cc) {
                const size_t item = item0 + grp * 8 + cc;
                const LAS unsigned char* Pm = L + cc * SLOT_B; const LAS unsigned char* Qm = Pm + MBUF;
                bf16_t* sp = S0 + item * 4096 + (size_t)(32 * jb + r) * 64;
#pragma unroll
                for (int ib = 0; ib < 2; ++ib)
#pragma unroll
                    for (int g = 0; g < 4; ++g) { v2u w; w.x = pk2(st[ib][4 * g], st[ib][4 * g + 1]); w.y = pk2(st[ib][4 * g + 2], st[ib][4 * g + 3]); *(v2u*)(sp + 32 * ib + 8 * g + 4 * h2) = w; }
                f32x16 nw[2];
#pragma unroll
                for (int ib = 0; ib < 2; ++ib)
#pragma unroll
                    for (int g = 0; g < 16; ++g) nw[ib][g] = __uint_as_float(((unsigned)*(const LAS unsigned short*)(Qm + (32 * ib + (g & 3) + 8 * (g >> 2) + 4 * h2) * 128 + (32 * jb + r) * 2)) << 16);
#pragma unroll
                for (int kb = 0; kb < 2; ++kb)
#pragma unroll
                    for (int s2 = 0; s2 < 2; ++s2) {
                        const bf16x8 bfr = pack_acc8(st[kb], s2);
#pragma unroll
                        for (int ib = 0; ib < 2; ++ib) {
                            const LAS unsigned char* ap = Pm + (32 * ib + r) * MROW + (32 * kb + 16 * s2 + 4 * h2) * 2;
                            const v2u lo = *(const LAS v2u*)ap, hi = *(const LAS v2u*)(ap + 16);
                            v4u av; av.x = lo.x; av.y = lo.y; av.z = hi.x; av.w = hi.y;
                            nw[ib] = __builtin_amdgcn_mfma_f32_32x32x16_bf16(__builtin_bit_cast(bf16x8, av), bfr, nw[ib], 0, 0, 0);
                        }
                    }
                st[0] = nw[0]; st[1] = nw[1];
            }
        }
    }
}
__device__ __forceinline__ void scan_r3(const bf16_t* RH, const float* YL, const bf16_t* S0, const bf16_t* RVg, const bf16_t* KDg, const bf16_t* Gg,
                                        const float* r_k, const float* lng, const float* lnb, bf16_t* Y) {
    const int tid = tidx(), lane = tid & 63, wave = tid >> 6, fr = lane & 15, fq = lane >> 4;
    const int tmw = wave & 3;
    for (int it2 = blockIdx.x * 2 + (wave >> 2); it2 < 2048; it2 += gridDim.x * 2) {
        const int b = it2 >> 10, h = (it2 >> 7) & 7, pc = it2 & 127;
        f32x4 acc[4];
#pragma unroll
        for (int q = 0; q < 4; ++q) acc[q] = (f32x4){0.f, 0.f, 0.f, 0.f};
#pragma unroll 1
        for (int dirn = 0; dirn < 2; ++dirn) {
            const size_t item = (size_t)((dirn * 2 + b) * 8 + h) * 128 + (dirn ? 127 - pc : pc);
            const int row = dirn ? 63 - (16 * tmw + fr) : 16 * tmw + fr;
            const bf16_t* rp = RH + item * 4096 + (size_t)row * 64;
            bf16x8 lf[2];
#pragma unroll
            for (int ks = 0; ks < 2; ++ks) lf[ks] = *(const bf16x8*)(rp + 32 * ks + 8 * fq);
#pragma unroll
            for (int q = 0; q < 4; ++q) {
                const bf16_t* sp = S0 + item * 4096 + (size_t)(16 * q + fr) * 64;
#pragma unroll
                for (int ks = 0; ks < 2; ++ks) { const bf16x8 rf = *(const bf16x8*)(sp + 32 * ks + 8 * fq); MMA16(acc[q], lf[ks], rf); }
                acc[q] += *(const f32x4*)(YL + item * 4096 + (size_t)row * 64 + 16 * q + 4 * fq);
            }
        }
        float sm = 0.f;
#pragma unroll
        for (int q = 0; q < 4; ++q) sm += (acc[q][0] + acc[q][1]) + (acc[q][2] + acc[q][3]);
        sm += __shfl_xor(sm, 16); sm += __shfl_xor(sm, 32);
        const float mean = sm * (1.0f / 64.f);
        float sq = 0.f;
#pragma unroll
        for (int q = 0; q < 4; ++q)
#pragma unroll
            for (int j = 0; j < 4; ++j) { const float d = acc[q][j] - mean; sq += d * d; }
        sq += __shfl_xor(sq, 16); sq += __shfl_xor(sq, 32);
        const float rstd = rsqrtf(sq * (1.0f / 64.f) + 64e-5f);
        const size_t tok = (size_t)b * S + pc * 64 + 16 * tmw + fr;
        float bon = 0.f; f32x4 vv[4];
#pragma unroll
        for (int q = 0; q < 4; ++q) {
            const int c = h * 64 + 16 * q + 4 * fq;
            const v2u rw = *(const v2u*)(RVg + tok * D + c), k0 = *(const v2u*)(KDg + tok * 512 + c), k1 = *(const v2u*)(KDg + ((size_t)T + tok) * 512 + c), vw = *(const v2u*)(RVg + tok * D + 512 + c);
            const f32x4 rk4 = *(const f32x4*)(r_k + c);
            vv[q] = (f32x4){bflo(vw.x), bfhi(vw.x), bflo(vw.y), bfhi(vw.y)};
            bon += bflo(rw.x) * (bflo(k0.x) + bflo(k1.x)) * rk4[0] + bfhi(rw.x) * (bfhi(k0.x) + bfhi(k1.x)) * rk4[1] + bflo(rw.y) * (bflo(k0.y) + bflo(k1.y)) * rk4[2] + bfhi(rw.y) * (bfhi(k0.y) + bfhi(k1.y)) * rk4[3];
        }
        bon += __shfl_xor(bon, 16); bon += __shfl_xor(bon, 32);
#pragma unroll
        for (int q = 0; q < 4; ++q) {
            const int c = h * 64 + 16 * q + 4 * fq;
            const v2u gw_ = *(const v2u*)(Gg + tok * 512 + c); const f32x4 g4 = {bflo(gw_.x), bfhi(gw_.x), bflo(gw_.y), bfhi(gw_.y)}, lg = *(const f32x4*)(lng + c), lb = *(const f32x4*)(lnb + c);
            float o[4];
#pragma unroll
            for (int j = 0; j < 4; ++j) o[j] = ((acc[q][j] - mean) * rstd * lg[j] + lb[j] + bon * vv[q][j]) * g4[j];
            v2u w; w.x = pk2(o[0], o[1]); w.y = pk2(o[2], o[3]);
            *(v2u*)(Y + tok * D + 512 + c) = w;
        }
    }
}


__device__ __forceinline__ bf16x8 pack8(float a0, float a1, float a2, float a3, float a4, float a5, float a6, float a7) {
    v4u p; p.x = pk2(a0, a1); p.y = pk2(a2, a3); p.z = pk2(a4, a5); p.w = pk2(a6, a7);
    return __builtin_bit_cast(bf16x8, p);
}
#define MMA32(acc, af, bf_) acc = __builtin_amdgcn_mfma_f32_32x32x16_bf16(af, bf_, acc, 0, 0, 0)
__device__ __forceinline__ void xattn_mfma(const bf16_t* Qb, const bf16_t* Kb, const bf16_t* Vt, bf16_t* Y, unsigned char* lds_raw) {
    LAS unsigned char* L = (LAS unsigned char*)lds_raw;
    constexpr int KRS = 528, VRS = 520;
    const int tid = tidx(), lane = tid & 63, wave = tid >> 6, r = lane & 31, h2 = lane >> 5;
    for (int it = blockIdx.x; it < 256; it += gridDim.x) {
        const int qblk = it & 31, h = (it >> 5) & 3, b = it >> 7;
        const size_t tok = (size_t)b * S + qblk * 256 + wave * 32 + r;
        bf16x8 qf[16];
#pragma unroll
        for (int ks = 0; ks < 16; ++ks) qf[ks] = *(const bf16x8*)(Qb + tok * D + h * 256 + 16 * ks + 8 * h2);
        __syncthreads();
#pragma unroll
        for (int hf = 0; hf < 2; ++hf) {
            v4u stg[8];
#pragma unroll
            for (int q = 0; q < 8; ++q) { const int p = tid + 512 * (8 * hf + q); stg[q] = *(const v4u*)(Kb + (size_t)(b * MEM + (p >> 5)) * 1024 + h * 256 + (p & 31) * 8); }
#pragma unroll
            for (int q = 0; q < 8; ++q) { const int p = tid + 512 * (8 * hf + q); *(LAS v4u*)(L + (p >> 5) * KRS + (p & 31) * 16) = stg[q]; }
        }
        __syncthreads();
        float mx = -3.0e38f;
#pragma unroll 1
        for (int kb = 0; kb < 8; ++kb) {
            f32x16 st;
#pragma unroll
            for (int g = 0; g < 16; ++g) st[g] = 0.f;
            const LAS unsigned char* kp = L + (32 * kb + r) * KRS + 16 * h2;
#pragma unroll
            for (int ks = 0; ks < 16; ++ks) { const bf16x8 kf = *(const LAS bf16x8*)(kp + 32 * ks); MMA32(st, kf, qf[ks]); }
#pragma unroll
            for (int g = 0; g < 16; ++g) mx = fmaxf(mx, st[g]);
        }
        mx = fmaxf(mx, __shfl_xor(mx, 32));
        const float cs = 0.0625f * 1.4426950408889634f;
        float l = 0.f;
        bf16x8 pf[8][2];
#pragma unroll
        for (int kb = 0; kb < 8; ++kb) {
            f32x16 st;
#pragma unroll
            for (int g = 0; g < 16; ++g) st[g] = 0.f;
            const LAS unsigned char* kp = L + (32 * kb + r) * KRS + 16 * h2;
#pragma unroll
            for (int ks = 0; ks < 16; ++ks) { const bf16x8 kf = *(const LAS bf16x8*)(kp + 32 * ks); MMA32(st, kf, qf[ks]); }
#pragma unroll
            for (int g = 0; g < 16; ++g) { st[g] = __builtin_amdgcn_exp2f((st[g] - mx) * cs); l += st[g]; }
#pragma unroll
            for (int s2 = 0; s2 < 2; ++s2) pf[kb][s2] = pack8(st[8 * s2], st[8 * s2 + 1], st[8 * s2 + 2], st[8 * s2 + 3], st[8 * s2 + 4], st[8 * s2 + 5], st[8 * s2 + 6], st[8 * s2 + 7]);
            __builtin_amdgcn_sched_barrier(0);
        }
        l += __shfl_xor(l, 32);
        const float inv = 1.0f / l;
        __syncthreads();
#pragma unroll
        for (int hf = 0; hf < 2; ++hf) {
            v4u stg[8];
#pragma unroll
            for (int q = 0; q < 8; ++q) { const int p = tid + 512 * (8 * hf + q); stg[q] = *(const v4u*)(Vt + ((size_t)(b * 1024 + h * 256 + (p >> 5))) * 256 + (p & 31) * 8); }
#pragma unroll
            for (int q = 0; q < 8; ++q) { const int p = tid + 512 * (8 * hf + q); LAS v2u* lp = (LAS v2u*)(L + (p >> 5) * VRS + (p & 31) * 16);
                v2u a_; a_.x = stg[q].x; a_.y = stg[q].y; lp[0] = a_; a_.x = stg[q].z; a_.y = stg[q].w; lp[1] = a_; }
        }
        __syncthreads();
#pragma unroll 1
        for (int db = 0; db < 8; ++db) {
            f32x16 acc;
#pragma unroll
            for (int g = 0; g < 16; ++g) acc[g] = 0.f;
            const LAS unsigned char* vp = L + (32 * db + r) * VRS + 8 * h2;
#pragma unroll
            for (int kb = 0; kb < 8; ++kb)
#pragma unroll
                for (int s2 = 0; s2 < 2; ++s2) {
                    const v2u lo = *(const LAS v2u*)(vp + (32 * kb + 16 * s2) * 2), hi = *(const LAS v2u*)(vp + (32 * kb + 16 * s2 + 8) * 2);
                    v4u av; av.x = lo.x; av.y = lo.y; av.z = hi.x; av.w = hi.y;
                    MMA32(acc, __builtin_bit_cast(bf16x8, av), pf[kb][s2]);
                }
            int tl_ = tid; asm volatile("" : "+v"(tl_));
            bf16_t* yp = Y + ((size_t)b * S + qblk * 256 + (tl_ >> 6) * 32 + (tl_ & 31)) * D + h * 256 + 32 * db + 4 * ((tl_ >> 5) & 1);
#pragma unroll
            for (int g = 0; g < 4; ++g) { v2u w; w.x = pk2(acc[4 * g] * inv, acc[4 * g + 1] * inv); w.y = pk2(acc[4 * g + 2] * inv, acc[4 * g + 3] * inv); *(v2u*)(yp + 8 * g) = w; }
        }
    }
}
template <bool F32OUT>
__device__ __forceinline__ void combine_norm(float* X, const bf16_t* YE, const int* SLOT, const float* g, bf16_t* Hout, float* Fout) {
    const int tix_ = tidx(); const int lane = tix_ & 63, gw = blockIdx.x * 8 + (tix_ >> 6), ngw = gridDim.x * 8;
    for (int m = gw; m < T; m += ngw) {
        float4* xr = (float4*)(X + (size_t)m * D);
        float4 v[4];
#pragma unroll
        for (int j = 0; j < 4; ++j) v[j] = xr[lane + 64 * j];
        const int myslot = SLOT[(size_t)m * NE + (lane & 15)];
#pragma unroll
        for (int e = 0; e < 16; ++e) {
            const int row = __builtin_amdgcn_readlane(myslot, e);
            if (row >= 0) {
                const v2u* yp = (const v2u*)(YE + (size_t)row * D);
#pragma unroll
                for (int j = 0; j < 4; ++j) { const v2u w = yp[lane + 64 * j];
                    v[j].x += __uint_as_float(w.x << 16); v[j].y += __uint_as_float(w.x & 0xffff0000u); v[j].z += __uint_as_float(w.y << 16); v[j].w += __uint_as_float(w.y & 0xffff0000u); }
            }
        }
        float s = 0.f;
#pragma unroll
        for (int j = 0; j < 4; ++j) { if (!F32OUT) xr[lane + 64 * j] = v[j]; s += v[j].x * v[j].x + v[j].y * v[j].y + v[j].z * v[j].z + v[j].w * v[j].w; }
        const float r = rsqrtf(wave_sum(s) * (1.0f / D) + 1e-6f);
#pragma unroll
        for (int j = 0; j < 4; ++j) { const float4 gg = ((const float4*)g)[lane + 64 * j];
            if (F32OUT) ((float4*)(Fout + (size_t)m * D))[lane + 64 * j] = make_float4(v[j].x * r * gg.x, v[j].y * r * gg.y, v[j].z * r * gg.z, v[j].w * r * gg.w);
            else { v2u w; w.x = pk2(v[j].x * r * gg.x, v[j].y * r * gg.y); w.y = pk2(v[j].z * r * gg.z, v[j].w * r * gg.w); ((v2u*)(Hout + (size_t)m * D))[lane + 64 * j] = w; } }
    }
}


template <int NK, bool SINK>
__device__ __forceinline__ void attn_block(const bf16_t* Qh, const bf16_t* Kh, const bf16_t* Vh, int dd, int Lr, int b, int rho, int q0b, float sink2,
                                           bf16_t* Odst, int ostride, float* lsedst, unsigned char* lds_raw) {
    constexpr int NKEY = 256 + 64 * NK, KRS = 144, VRS = NKEY * 2 + 8;
    LAS unsigned char* Ks = (LAS unsigned char*)lds_raw; LAS unsigned char* Vs = Ks + NKEY * KRS;
    const int tid = tidx(), lane = tid & 63, wave = tid >> 6, r = lane & 31, h2 = lane >> 5;
    const int kq_base = q0b - 32 * NK;
    __syncthreads();
#pragma unroll
    for (int i = 0; i < NKEY * 8 / 512; ++i) {
        const int p = tid + 512 * i, row = p >> 3, piece = p & 7, kq = kq_base + row;
        if (kq >= 0 && kq < Lr) {
            const size_t tokk = (size_t)b * S + (size_t)kq * dd + rho;
            const v4u kx = *(const v4u*)(Kh + tokk * 64 + piece * 8), vx = *(const v4u*)(Vh + tokk * 64 + piece * 8);
            *(LAS v4u*)(Ks + row * KRS + piece * 16) = kx;
            LAS unsigned char* vp = Vs + (piece * 8) * VRS + row * 2;
#pragma unroll
            for (int e = 0; e < 4; ++e) { *(LAS unsigned short*)(vp + (2 * e) * VRS) = (unsigned short)(vx[e] & 0xffffu); *(LAS unsigned short*)(vp + (2 * e + 1) * VRS) = (unsigned short)(vx[e] >> 16); }
        }
    }
    const int q0 = q0b + 32 * wave;
    const size_t qtok = (size_t)b * S + (size_t)(q0 + r) * dd + rho;
    bf16x8 qf[4];
#pragma unroll
    for (int ks = 0; ks < 4; ++ks) qf[ks] = *(const bf16x8*)(Qh + qtok * 64 + 16 * ks + 8 * h2);
    __syncthreads();
    f32x16 o[2];
#pragma unroll
    for (int db = 0; db < 2; ++db)
#pragma unroll
        for (int g = 0; g < 16; ++g) o[db][g] = 0.f;
    float m = SINK ? sink2 : -1.0e30f, l = SINK ? 1.f : 0.f;
    const int kb_lo = max(-NK, -(q0 >> 5)), kb_hi = min(NK, (Lr - 32 - q0) >> 5);
#pragma unroll 1
    for (int kb = kb_lo; kb <= kb_hi; ++kb) {
        const int kw0 = 32 * (wave + kb + NK);
        f32x16 st;
#pragma unroll
        for (int g = 0; g < 16; ++g) st[g] = 0.f;
        const LAS unsigned char* kp = Ks + (kw0 + r) * KRS + 16 * h2;
#pragma unroll
        for (int ks = 0; ks < 4; ++ks) { const bf16x8 kf = *(const LAS bf16x8*)(kp + 32 * ks); MMA32(st, kf, qf[ks]); }
        if (kb == -NK || kb == NK) {
#pragma unroll
            for (int g = 0; g < 16; ++g) { const int cr = (g & 3) + 8 * (g >> 2) + 4 * h2; const bool ok = (kb < 0) ? (cr >= r) : (cr <= r); st[g] = ok ? st[g] : -1.0e30f; }
        }
        float bm = st[0];
#pragma unroll
        for (int g = 1; g < 16; ++g) bm = fmaxf(bm, st[g]);
        bm = fmaxf(bm, __shfl_xor(bm, 32));
        const float mn = fmaxf(m, bm), al = __builtin_amdgcn_exp2f(m - mn);
        float ls = 0.f;
#pragma unroll
        for (int g = 0; g < 16; ++g) { st[g] = __builtin_amdgcn_exp2f(st[g] - mn); ls += st[g]; }
        ls += __shfl_xor(ls, 32);
        l = l * al + ls; m = mn;
#pragma unroll
        for (int db = 0; db < 2; ++db)
#pragma unroll
            for (int g = 0; g < 16; ++g) o[db][g] *= al;
        bf16x8 pf[2];
#pragma unroll
        for (int s2 = 0; s2 < 2; ++s2) pf[s2] = pack8(st[8 * s2], st[8 * s2 + 1], st[8 * s2 + 2], st[8 * s2 + 3], st[8 * s2 + 4], st[8 * s2 + 5], st[8 * s2 + 6], st[8 * s2 + 7]);
#pragma unroll
        for (int db = 0; db < 2; ++db) {
            const LAS unsigned char* vp = Vs + (32 * db + r) * VRS + (kw0 + 4 * h2) * 2;
#pragma unroll
            for (int s2 = 0; s2 < 2; ++s2) {
                const v2u lo = *(const LAS v2u*)(vp + 32 * s2), hi = *(const LAS v2u*)(vp + 32 * s2 + 16);
                v4u av; av.x = lo.x; av.y = lo.y; av.z = hi.x; av.w = hi.y;
                MMA32(o[db], __builtin_bit_cast(bf16x8, av), pf[s2]);
            }
        }
    }
    const float inv = 1.0f / l;
#pragma unroll
    for (int db = 0; db < 2; ++db) {
        bf16_t* op = Odst + qtok * ostride + 32 * db + 4 * h2;
#pragma unroll
        for (int g = 0; g < 4; ++g) { v2u w; w.x = pk2(o[db][4 * g] * inv, o[db][4 * g + 1] * inv); w.y = pk2(o[db][4 * g + 2] * inv, o[db][4 * g + 3] * inv); *(v2u*)(op + 8 * g) = w; }
    }
    if (lsedst != nullptr && h2 == 0) lsedst[qtok * 8] = (m + __builtin_amdgcn_logf(l)) * 0.6931471805599453f;
}

__device__ __forceinline__ void attn_phase_even(const bf16_t* QhA, const bf16_t* KhA, const bf16_t* VhA, const bf16_t* QhB, const bf16_t* KhB, const bf16_t* VhB,
                                                const float* sink, bf16_t* OA, float* LSE, bf16_t* Y, unsigned char* lds_raw) {
    for (int it = blockIdx.x; it < 2048; it += gridDim.x) {
        if (it < 512) {
            const int hq = it >> 6, rem2 = it & 63, b = rem2 >> 5, q0b = (rem2 & 31) * 256, kvh = hq >> 2;
            attn_block<4, true>(QhB + (size_t)hq * T * 64, KhB + (size_t)kvh * T * 64, VhB + (size_t)kvh * T * 64, 1, S, b, 0, q0b, sink[hq] * 1.4426950408889634f,
                                Y + 512 + hq * 64, D, nullptr, lds_raw);
        } else {
            const int ita = it - 512, p = ita >> 9, rem = ita & 511, head = rem >> 6, rem2 = rem & 63, b = rem2 >> 5, rem3 = rem2 & 31;
            const int dd = p == 0 ? 1 : (p == 1 ? 4 : 16), bpr = 32 / dd, rho = rem3 / bpr, q0b = (rem3 % bpr) * 256;
            attn_block<2, false>(QhA + (size_t)head * T * 64, KhA + (size_t)head * T * 64, VhA + (size_t)head * T * 64, dd, S / dd, b, rho, q0b, 0.f,
                                 OA + (size_t)p * T * 512 + head * 64, 512, LSE + (size_t)p * T * 8 + head, lds_raw);
        }
    }
}
__device__ __forceinline__ void attn_combine(const bf16_t* OA, const float* LSE, bf16_t* Y) {
    const int gt = blockIdx.x * NTH + tidx(), ngt = gridDim.x * NTH;
    for (int i = gt; i < T * 64; i += ngt) {
        const int tok = i >> 6, head = (i >> 3) & 7, c8 = i & 7;
        const float l0 = LSE[(size_t)tok * 8 + head], l1 = LSE[((size_t)T + tok) * 8 + head], l2 = LSE[((size_t)2 * T + tok) * 8 + head];
        const float mx = fmaxf(l0, fmaxf(l1, l2));
        float w0 = __expf(l0 - mx), w1 = __expf(l1 - mx), w2 = __expf(l2 - mx);
        const float inv = 1.0f / (w0 + w1 + w2); w0 *= inv; w1 *= inv; w2 *= inv;
        const size_t off = (size_t)tok * 512 + head * 64 + c8 * 8;
        const v4u x0 = *(const v4u*)(OA + off), x1 = *(const v4u*)(OA + (size_t)T * 512 + off), x2 = *(const v4u*)(OA + (size_t)2 * T * 512 + off);
        v4u w;
#pragma unroll
        for (int q = 0; q < 4; ++q) {
            const float lo = w0 * __uint_as_float(x0[q] << 16) + w1 * __uint_as_float(x1[q] << 16) + w2 * __uint_as_float(x2[q] << 16);
            const float hi = w0 * __uint_as_float(x0[q] & 0xffff0000u) + w1 * __uint_as_float(x1[q] & 0xffff0000u) + w2 * __uint_as_float(x2[q] & 0xffff0000u);
            w[q] = pk2(lo, hi);
        }
        *(v4u*)(Y + (size_t)tok * D + head * 64 + c8 * 8) = w;
    }
}


__device__ __forceinline__ void odd_token_pass(const bf16_t* P, const float* mu, const float* k_k, const float* clg, const float* clb,
                                               bf16_t* VN, bf16_t* RV, bf16_t* KBf, bf16_t* KK, bf16_t* F5) {
    const int tix_ = tidx(); const int lane = tix_ & 63, gw = blockIdx.x * 8 + (tix_ >> 6), ngw = gridDim.x * 8;
    for (int tok = gw; tok < T; tok += ngw) {
        const int s = tok & (S - 1);
        const bf16_t* pr = P + (size_t)tok * ODD_PAD;
        {
            float ge[8]; float sm = 0.f;
#pragma unroll
            for (int jj = 0; jj < 4; ++jj) { const unsigned w = *(const unsigned*)(pr + 512 + 2 * lane + 128 * jj);
                ge[2 * jj] = gelu_tanh(__uint_as_float(w << 16)); ge[2 * jj + 1] = gelu_tanh(__uint_as_float(w & 0xffff0000u)); sm += ge[2 * jj] + ge[2 * jj + 1]; }
            const float mean = wave_sum(sm) * (1.0f / 512.f); float sq = 0.f;
#pragma unroll
            for (int j = 0; j < 8; ++j) { const float d = ge[j] - mean; sq += d * d; }
            const float rstd = rsqrtf(wave_sum(sq) * (1.0f / 512.f) + 1e-5f);
#pragma unroll
            for (int jj = 0; jj < 4; ++jj) { const int c = 2 * lane + 128 * jj; const float2 g2_ = *(const float2*)(clg + c), b2_ = *(const float2*)(clb + c);
                *(unsigned*)(VN + (size_t)tok * 512 + c) = pk2((ge[2 * jj] - mean) * rstd * g2_.x + b2_.x, (ge[2 * jj + 1] - mean) * rstd * g2_.y + b2_.y); }
        }
#pragma unroll
        for (int jj = 0; jj < 15; ++jj) {
            const int c = 2 * lane + 128 * jj;
            const unsigned wf = *(const unsigned*)(pr + 1024 + c);
            const unsigned wp = s > 0 ? *(const unsigned*)(pr + 1024 + c - ODD_PAD) : 0u;
            const unsigned wn = s < S - 1 ? *(const unsigned*)(pr + 1024 + c + ODD_PAD) : 0u;
            const float2 m0 = *(const float2*)(mu + c), m1 = *(const float2*)(mu + FD + c);
            const float f0 = __uint_as_float(wf << 16), f1 = __uint_as_float(wf & 0xffff0000u);
            const float x0 = f0 + m0.x * (__uint_as_float(wp << 16) - f0) + m1.x * (__uint_as_float(wn << 16) - f0);
            const float x1 = f1 + m0.y * (__uint_as_float(wp & 0xffff0000u) - f1) + m1.y * (__uint_as_float(wn & 0xffff0000u) - f1);
            if (jj < 4) *(unsigned*)(RV + (size_t)tok * D + c) = pk2(x0, x1);
            else if (jj < 8) {
                const int ck = c - 512;
                *(unsigned*)(KBf + (size_t)tok * 512 + ck) = pk2(x0, x1);
                const float2 kk_ = *(const float2*)(k_k + ck);
                const float a0_ = x0 * kk_.x, a1_ = x1 * kk_.y;
                float ss = a0_ * a0_ + a1_ * a1_;
#pragma unroll
                for (int o = 16; o >= 1; o >>= 1) ss += __shfl_xor(ss, o);
                const float inv = 1.0f / fmaxf(sqrtf(ss), 1e-12f);
                *(unsigned*)(KK + (size_t)tok * 512 + ck) = pk2(a0_ * inv, a1_ * inv);
            }
            else if (jj < 12) *(unsigned*)(RV + (size_t)tok * D + 512 + (c - 1024)) = pk2(x0, x1);
            else if (jj == 12) *(unsigned*)(F5 + (size_t)tok * 384 + (c - 1536)) = pk2(tanhf_(x0), tanhf_(x1));
            else if (jj == 13) *(unsigned*)(F5 + (size_t)tok * 384 + 128 + (c - 1664)) = pk2(x0, x1);
            else *(unsigned*)(F5 + (size_t)tok * 384 + 256 + (c - 1792)) = pk2(sigmoidf_(x0), sigmoidf_(x1));
        }
    }
}
__device__ __forceinline__ void gating_pass(const bf16_t* VN, const bf16_t* Wsb, const float* bsp, const bf16_t* P, bf16_t* Y, unsigned char* lds_raw) {
    LAS unsigned char* L = (LAS unsigned char*)lds_raw;
    constexpr int RS = 272;
    const int tid = tidx(), lane = tid & 63, wave = tid >> 6, fr = lane & 15, fq = lane >> 4;
    for (int it = blockIdx.x; it < 512; it += gridDim.x) {
        const int g = it & 3, chunk = it >> 2;
        __syncthreads();
        { const int j = tid >> 2, q4 = tid & 3;
          const v4u* gp = (const v4u*)(VN + (size_t)(chunk * 128 + j) * 512 + g * 128 + 32 * q4);
#pragma unroll
          for (int q = 0; q < 4; ++q) { const v4u x = gp[q];
#pragma unroll
              for (int e = 0; e < 4; ++e) { const int c = 32 * q4 + 8 * q + 2 * e;
                  *(LAS unsigned short*)(L + c * RS + 2 * j) = (unsigned short)(x[e] & 0xffffu); *(LAS unsigned short*)(L + (c + 1) * RS + 2 * j) = (unsigned short)(x[e] >> 16); } } }
        __syncthreads();
        bf16x8 lf[4];
#pragma unroll
        for (int ks = 0; ks < 4; ++ks) lf[ks] = *(const bf16x8*)(Wsb + (size_t)(g * 128 + 16 * wave + fr) * 128 + 32 * ks + 8 * fq);
        const int i = 16 * wave + fr; const size_t tok = (size_t)chunk * 128 + i;
        const float bias = bsp[g * 128 + i];
#pragma unroll
        for (int tn = 0; tn < 8; ++tn) {
            f32x4 acc = {0.f, 0.f, 0.f, 0.f};
#pragma unroll
            for (int ks = 0; ks < 4; ++ks) { const bf16x8 rf = *(const LAS bf16x8*)(L + (16 * tn + fr) * RS + (32 * ks + 8 * fq) * 2); MMA16(acc, lf[ks], rf); }
            const int c = g * 128 + 16 * tn + 4 * fq;
            const v2u uw = *(const v2u*)(P + tok * ODD_PAD + c);
            const float u0 = gelu_tanh(__uint_as_float(uw.x << 16)), u1 = gelu_tanh(__uint_as_float(uw.x & 0xffff0000u)), u2 = gelu_tanh(__uint_as_float(uw.y << 16)), u3 = gelu_tanh(__uint_as_float(uw.y & 0xffff0000u));
            v2u w; w.x = pk2(u0 * (acc[0] + bias), u1 * (acc[1] + bias)); w.y = pk2(u2 * (acc[2] + bias), u3 * (acc[3] + bias));
            *(v2u*)(Y + tok * D + c) = w;
        }
    }
}


__device__ __forceinline__ void router_pass(const float* X, const float* g, const float* WRT  , float* AFF, int* SLOT, bf16_t* H, unsigned char* lds_raw) {
    const int tix_ = tidx(); const int lane = tix_ & 63, wave = tix_ >> 6, fr = lane & 15, fq = lane >> 4;
    const int pair = wave >> 1, half = wave & 1;
    LAS float* xch = (LAS float*)lds_raw + pair * 512;
    for (int tile0 = blockIdx.x * 4; tile0 < T / 16; tile0 += gridDim.x * 4) {
        const int tile = tile0 + pair;
        const float* xr = X + (size_t)(tile * 16 + fr) * D + 4 * fq + 512 * half;
        const float* wr = WRT + (size_t)fr * D + 4 * fq + 512 * half;
        f32x4 acc = {0.f, 0.f, 0.f, 0.f}; float ss = 0.f;
#pragma unroll 8
        for (int s = 0; s < 32; ++s) {
            const f32x4 xa = *(const f32x4*)(xr + 16 * s), wb = *(const f32x4*)(wr + 16 * s);
            ss += (xa[0] * xa[0] + xa[1] * xa[1]) + (xa[2] * xa[2] + xa[3] * xa[3]);
#pragma unroll
            for (int c = 0; c < 4; ++c) acc = __builtin_amdgcn_mfma_f32_16x16x4f32(xa[c], wb[c], acc, 0, 0, 0);
        }
        ss += __shfl_xor(ss, 16); ss += __shfl_xor(ss, 32);
        __syncthreads();
        { LAS float* p = xch + half * 256 + lane * 4; p[0] = acc[0]; p[1] = acc[1]; p[2] = acc[2]; p[3] = acc[3]; }
        if (fq == 0) ((LAS float*)lds_raw + 2048 + pair * 32 + half * 16)[fr] = ss;
        __syncthreads();
        { const LAS float* p = xch + (half ^ 1) * 256 + lane * 4; acc[0] += p[0]; acc[1] += p[1]; acc[2] += p[2]; acc[3] += p[3]; }
        ss += ((const LAS float*)lds_raw + 2048 + pair * 32 + (half ^ 1) * 16)[fr];
        const float rstd = rsqrtf(ss * (1.0f / D) + 1e-6f);
        {
            float aff[4];
#pragma unroll
            for (int jj = 0; jj < 4; ++jj) {
                const float lg = acc[jj] * __shfl(rstd, 4 * fq + jj);
                float mx = lg;
#pragma unroll
                for (int o = 1; o < 16; o <<= 1) mx = fmaxf(mx, __shfl_xor(mx, o));
                const float e = expf(lg - mx); float den = e;
#pragma unroll
                for (int o = 1; o < 16; o <<= 1) den += __shfl_xor(den, o);
                aff[jj] = e / den;
            }
#pragma unroll
            for (int jj = 0; jj < 4; ++jj) { const size_t o = (size_t)(tile * 16 + 4 * fq + jj) * NE + fr; if ((fq >> 1) == half) { AFF[o] = aff[jj]; SLOT[o] = -1; } }
        }
#pragma unroll 4
        for (int tt = 0; tt < 8; ++tt) {
            const int t = 8 * half + tt;
            const float rs = __shfl(rstd, t);
            const f32x4* xp = (const f32x4*)(X + (size_t)(tile * 16 + t) * D); v2u* hp = (v2u*)(H + (size_t)(tile * 16 + t) * D);
#pragma unroll
            for (int j = 0; j < 4; ++j) { const f32x4 v = xp[lane + 64 * j], gg = ((const f32x4*)g)[lane + 64 * j];
                v2u w; w.x = pk2(v[0] * rs * gg[0], v[1] * rs * gg[1]); w.y = pk2(v[2] * rs * gg[2], v[3] * rs * gg[3]); hp[lane + 64 * j] = w; }
        }
    }
}


__device__ __forceinline__ void lora_pass(const bf16_t* F5, const bf16_t* WC, const float* w0, const float* a0, const float* k_a, const bf16_t* KB, const bf16_t* KK,
                                          bf16_t* LW, bf16_t* KD, bf16_t* BB, bf16_t* G, unsigned char* lds_raw) {
    LAS unsigned char* L = (LAS unsigned char*)lds_raw;
    constexpr int ARS = 784;
    const int tid = tidx(), lane = tid & 63, wave = tid >> 6, fr = lane & 15, fq = lane >> 4;
    for (int tile = blockIdx.x; tile < T / 64; tile += gridDim.x) {
        __syncthreads();
#pragma unroll
        for (int q = 0; q < 6; ++q) { const int p = tid + 512 * q, row = p / 48, piece = p % 48;
            *(LAS v4u*)(L + row * ARS + piece * 16) = *(const v4u*)(F5 + (size_t)(tile * 64 + row) * 384 + piece * 8); }
        __syncthreads();
#pragma unroll 1
        for (int sec = 0; sec < 5; ++sec) {
            const int K0 = sec * 64, nks = sec < 4 ? 2 : 4, wstride = sec < 4 ? 64 : 128;
            const bf16_t* Wp = WC + (size_t)sec * 512 * 64 + (size_t)(64 * wave) * wstride;
#pragma unroll 1
            for (int nh = 0; nh < 2; ++nh) {
            f32x4 acc[4][2];
#pragma unroll
            for (int tm = 0; tm < 4; ++tm)
#pragma unroll
                for (int tn = 0; tn < 2; ++tn) acc[tm][tn] = (f32x4){0.f, 0.f, 0.f, 0.f};
            for (int ks = 0; ks < nks; ++ks) {
                bf16x8 lf[4], rf[2];
#pragma unroll
                for (int tm = 0; tm < 4; ++tm) lf[tm] = *(const LAS bf16x8*)(L + (16 * tm + fr) * ARS + (K0 + 32 * ks + 8 * fq) * 2);
#pragma unroll
                for (int tn = 0; tn < 2; ++tn) rf[tn] = *(const bf16x8*)(Wp + (size_t)(16 * (2 * nh + tn) + fr) * wstride + 32 * ks + 8 * fq);
#pragma unroll
                for (int tm = 0; tm < 4; ++tm)
#pragma unroll
                    for (int tn = 0; tn < 2; ++tn) MMA16(acc[tm][tn], lf[tm], rf[tn]);
            }
#pragma unroll
            for (int tn = 0; tn < 2; ++tn) {
                const int cc = 64 * wave + 16 * (2 * nh + tn) + 4 * fq;
#pragma unroll
                for (int tm = 0; tm < 4; ++tm) {
                    const size_t tok = (size_t)tile * 64 + 16 * tm + fr; const f32x4 v = acc[tm][tn];
                    __builtin_amdgcn_sched_barrier(0);
                    if (sec < 2) {
                        const f32x4 w = *(const f32x4*)(w0 + sec * 512 + cc); float o[4];
#pragma unroll
                        for (int j = 0; j < 4; ++j) o[j] = -0.6065306597126334f * frcp(1.0f + __expf(-(w[j] + v[j])));
                        v2u ww; ww.x = pk2(o[0], o[1]); ww.y = pk2(o[2], o[3]);
                        *(v2u*)(LW + ((size_t)sec * T + tok) * 512 + cc) = ww;
                    } else if (sec < 4) {
                        const int d = sec - 2;
                        const f32x4 a_ = *(const f32x4*)(a0 + d * 512 + cc), ka = *(const f32x4*)(k_a + cc);
                        const v2u kw = *(const v2u*)(KB + tok * 512 + cc), kkw = *(const v2u*)(KK + tok * 512 + cc);
                        const float kv[4] = {bflo(kw.x), bfhi(kw.x), bflo(kw.y), bfhi(kw.y)}, kk[4] = {bflo(kkw.x), bfhi(kkw.x), bflo(kkw.y), bfhi(kkw.y)};
                        float okd[4], obb[4];
#pragma unroll
                        for (int j = 0; j < 4; ++j) { const float alr = frcp(1.0f + __expf(-(a_[j] + v[j]))); okd[j] = kv[j] * (1.0f + (alr - 1.0f) * ka[j]); obb[j] = kk[j] * alr; }
                        v2u w1, w2_; w1.x = pk2(okd[0], okd[1]); w1.y = pk2(okd[2], okd[3]); w2_.x = pk2(obb[0], obb[1]); w2_.y = pk2(obb[2], obb[3]);
                        *(v2u*)(KD + ((size_t)d * T + tok) * 512 + cc) = w1; *(v2u*)(BB + ((size_t)d * T + tok) * 512 + cc) = w2_;
                    } else { v2u ww; ww.x = pk2(v[0], v[1]); ww.y = pk2(v[2], v[3]); *(v2u*)(G + tok * 512 + cc) = ww; }
                }
            }
            }
        }
    }
}

#define IN(k) (lo <= (k) && (k) < hi)
#define REP_LOOP for (int rep_ = 0, nrep_ = ((ph == PROBE_PHASE) ? PROBE_REP : 1); rep_ < nrep_; ++rep_)
#define SEAM(k) do { if (IN(k) && IN((k) + 1)) xcd_barrier(bar); } while (0)
#define PROLOG \
    const int tid = tidx(), lane = tid & 63, wave = tid >> 6; \
    const int bid = blockIdx.x, nb = gridDim.x; \
    const int gw = bid * 8 + wave, ngw = nb * 8; \
    const int gt = bid * NTH + tid, ngt = nb * NTH; \
    (void)gt; (void)ngt; (void)gw; (void)ngw; (void)lane; (void)wave; \
    unsigned char* ws = a.ws; \
    const int lo = a.lo, hi = a.hi; \
    float* ldsf = (float*)lds_raw; (void)ldsf; \
    PG8_LAS unsigned char* ldsp = (PG8_LAS unsigned char*)lds_raw; (void)ldsp; \
    const float* x_in = a.in[0]; const float* mem = a.in[1]; (void)x_in; (void)mem; \
    float* ropec = (float*)(ws + WS_ROPE); float* ropes = ropec + S * 32; (void)ropec; (void)ropes; \
    float* AFF = (float*)(ws + WS_AFF); int* TOK = (int*)(ws + WS_TOK); float* GATE = (float*)(ws + WS_GATE); \
    float* X = (float*)(ws + WS_X); bf16_t* H = (bf16_t*)(ws + WS_H); bf16_t* P = (bf16_t*)(ws + WS_P); \
    bf16_t* Y = (bf16_t*)(ws + WS_Y); bf16_t* Q = (bf16_t*)(ws + WS_Q); bf16_t* KV = (bf16_t*)(ws + WS_KV); bf16_t* MN = (bf16_t*)(ws + WS_MN); \
    bf16_t* DEC = (bf16_t*)(ws + WS_DEC); bf16_t* KD = (bf16_t*)(ws + WS_KD); bf16_t* BB = (bf16_t*)(ws + WS_BB); \
    bf16_t* KK = (bf16_t*)(ws + WS_KK); bf16_t* G = (bf16_t*)(ws + WS_G); float* YS = (float*)(ws + WS_YS); \
    bf16_t* RV = (bf16_t*)(ws + WS_RV); bf16_t* VN = (bf16_t*)(ws + WS_VN); \
    bf16_t* XE = (bf16_t*)(ws + WS_XE); bf16_t* HID = (bf16_t*)(ws + WS_HID); int* SLOT = (int*)(ws + WS_SLOT); bf16_t* YE = (bf16_t*)(ws + WS_YE); (void)SLOT; (void)YE; \
    (void)AFF; (void)TOK; (void)GATE; (void)X; (void)H; (void)P; (void)Y; (void)Q; (void)KV; (void)MN; (void)DEC; (void)KD; (void)BB; (void)KK; (void)G; (void)YS; (void)RV; (void)VN; (void)XE; (void)HID;

template <class Epi>
__device__ __forceinline__ void dense_gemm(PG8_LAS unsigned char* ldsp, const bf16_t* A, const bf16_t* Bt, int M, int N, int K, const Epi& E, int cshift = 0) {
    asm volatile("" : "+s"(K));
    pg8::Gemm g{A, Bt, M, N, K}; pg8::StaticOrder So; So.init(M, N, (int)gridDim.x, (int)((blockIdx.x + cshift) % gridDim.x));
    pg8::gemm_phase<Epi, pg8::StaticOrder, false>(ldsp, g, So, E, nullptr);
}

__device__ __forceinline__ int odd_phases(const Args& a, const XcdBarrier& bar, unsigned char* lds_raw, int ph) {
    PROLOG
    if (IN(ph)) combine_norm<false>(X, YE, SLOT, a.in[6], H, nullptr);
    SEAM(ph); ++ph;
    if (IN(ph)) dense_gemm(ldsp, H, (const bf16_t*)(ws + WS_WOIN), T, ODD_PAD, D, EpiBf16Store{P, ODD_PAD, 1.0f});
    SEAM(ph); ++ph;
    if (IN(ph)) REP_LOOP odd_token_pass(P, a.in[12], a.in[18], a.in[8], a.in[9], VN, RV, (bf16_t*)(ws + WS_KB), KK, (bf16_t*)(ws + WS_F5));
    SEAM(ph); ++ph;
    if (IN(ph)) REP_LOOP {
        gating_pass(VN, (const bf16_t*)(ws + WS_WSB), a.in[11], P, Y, lds_raw);
        __syncthreads();
        lora_pass((const bf16_t*)(ws + WS_F5), (const bf16_t*)(ws + WS_WL), a.in[13], a.in[15], a.in[19], (const bf16_t*)(ws + WS_KB), KK, DEC, KD, BB, G, lds_raw);
    }
    SEAM(ph); ++ph;
    if (IN(ph)) REP_LOOP scan_r1(DEC, RV, KD, KK, BB, (bf16_t*)(ws + WS_PT), (bf16_t*)(ws + WS_QT), (bf16_t*)(ws + WS_RH), (float*)(ws + WS_YL), lds_raw);
    SEAM(ph); ++ph;
    if (IN(ph)) REP_LOOP {
        if (bid < 32) scan_r2((const bf16_t*)(ws + WS_PT), (const bf16_t*)(ws + WS_QT), (bf16_t*)(ws + WS_S0), lds_raw);
        else {
            LAS float* scr = (LAS float*)((LAS unsigned char*)lds_raw + wave * 16896);
            const int gw2 = (bid - 32) * 8 + wave, ngw2 = (nb - 32) * 8;
            auto gmap = [](int n) { return (n >> 7) * 256 + (n & 127); };
            auto umap = [](int n) { return (n >> 7) * 256 + 128 + (n & 127); };
            for (int it = gw2; it < 16 * 704; it += ngw2) { const int e = it / 704, r = it % 704;
                transpose_item_fp8(a.in[31] + (size_t)(16 + e) * D * DE, D, DE, ws + WS_WGU8 + 176 * MiB + (size_t)e * 5632 * D, gmap, GUSC8, scr, r, lane); }
            for (int it = gw2; it < 16 * 704; it += ngw2) { const int e = it / 704, r = it % 704;
                transpose_item_fp8(a.in[32] + (size_t)(16 + e) * D * DE, D, DE, ws + WS_WGU8 + 176 * MiB + (size_t)e * 5632 * D, umap, GUSC8, scr, r, lane); }
        }
    }
    SEAM(ph); ++ph;
    if (IN(ph)) REP_LOOP scan_r3((const bf16_t*)(ws + WS_RH), (const float*)(ws + WS_YL), (const bf16_t*)(ws + WS_S0), RV, KD, G, a.in[20], a.in[21], a.in[22], Y);
    SEAM(ph); ++ph;
    if (IN(ph)) dense_gemm(ldsp, Y, (const bf16_t*)(ws + WS_WOOUT), T, D, D, EpiResidN{X, X, H, (float*)(ws + WS_SSP)});
    SEAM(ph); ++ph;
    return ph;
}

template <int layer>
__device__ __forceinline__ int tail_phases(const Args& a, const XcdBarrier& bar, unsigned char* lds_raw, int ph) {
    PROLOG
    if (IN(ph)) REP_LOOP {
        int Kq = D; asm volatile("" : "+s"(Kq));
        pg8::Gemm g{H, (const bf16_t*)(ws + WS_WQ) + (size_t)layer * D * D, T, D, Kq}; XattnOrder So{(int)blockIdx.x};
        pg8::gemm_phase<EpiBf16StoreRS, XattnOrder, false>(ldsp, g, So, EpiBf16StoreRS{Q, D, (const float*)(ws + WS_SSP)}, nullptr);
        asm volatile("s_waitcnt vmcnt(0)" ::: "memory");
        __syncthreads();
        xattn_mfma(Q, KV + (size_t)layer * 1024 * 1024, KV + (size_t)layer * 1024 * 1024 + 512 * 1024, Y, lds_raw);
    }
    SEAM(ph); ++ph;
    if (IN(ph)) dense_gemm(ldsp, Y, (const bf16_t*)(ws + WS_WO) + (size_t)layer * D * D, T, D, D, EpiResid{X, X});
    SEAM(ph); ++ph;
    if (IN(ph)) REP_LOOP router_pass(X, a.in[29] + layer * D, (const float*)(ws + WS_WRT) + (size_t)layer * NE * D, AFF, SLOT, H, lds_raw);
    SEAM(ph); ++ph;
    if (IN(ph)) REP_LOOP {
        unsigned* keys = (unsigned*)ldsf;
        int* hist = (int*)(ldsf + 8192);
        int* sh = hist + 8 * 256;
        if (bid >= 32) {
            LAS float* scr = (LAS float*)((LAS unsigned char*)lds_raw + wave * 16896);
            const int gw2 = (bid - 32) * 8 + wave, ngw2 = (nb - 32) * 8;
            auto ident = [](int n) { return n; };
            if constexpr (layer == 0) {
                auto gmap = [](int n) { return (n >> 7) * 256 + (n & 127); };
                auto umap = [](int n) { return (n >> 7) * 256 + 128 + (n & 127); };
        for (int it = 4096 + gw2; it < 16 * 704; it += ngw2) { const int mt = it / 704, r = it % 704;
            if constexpr (F8L0) transpose_item_fp8(a.in[31] + (size_t)mt * D * DE, D, DE, ws + WS_WGU8 + (size_t)mt * 5632 * D, gmap, GUSC8, scr, r, lane);
            else transpose_item(a.in[31] + (size_t)mt * D * DE, D, DE, (bf16_t*)(ws + WS_WGU) + (size_t)mt * 5632 * D, gmap, scr, r, lane); }
        for (int it = gw2; it < 16 * 704; it += ngw2) { const int mt = it / 704, r = it % 704;
            if constexpr (F8L0) transpose_item_fp8(a.in[32] + (size_t)mt * D * DE, D, DE, ws + WS_WGU8 + (size_t)mt * 5632 * D, umap, GUSC8, scr, r, lane);
            else transpose_item(a.in[32] + (size_t)mt * D * DE, D, DE, (bf16_t*)(ws + WS_WGU) + (size_t)mt * 5632 * D, umap, scr, r, lane); }
            }
            for (int it = gw2; it < 16 * 704; it += ngw2) { const int mt = layer * 16 + it / 704, r = it % 704;
                if constexpr (layer == 1 || F8L0) transpose_item_fp8(a.in[33] + (size_t)mt * DE * D, DE, D, ws + WS_WD8 + (size_t)layer * 88 * MiB + (size_t)(mt - 16 * layer) * D * DE, ident, DSC8, scr, r, lane);
                else transpose_item(a.in[33] + (size_t)mt * DE * D, DE, D, (bf16_t*)(ws + WS_WD) + (size_t)mt * D * DE, ident, scr, r, lane); }
        }
        for (int be = bid; be < NB * NE && be < 32; be += nb) {
            const int b = be >> 4, e = be & 15, eb = e * 2 + b;
            __syncthreads();
            for (int s = tid; s < S; s += NTH) keys[s] = __float_as_uint(AFF[(size_t)(b * S + s) * NE + e]);
            unsigned prefix = 0u; int krem = CAP;
            for (int pass = 3; pass >= 0; --pass) {
                __syncthreads();
                for (int i = tid; i < 8 * 256; i += NTH) hist[i] = 0;
                __syncthreads();
                const unsigned hmask = pass == 3 ? 0u : (0xFFFFFFFFu << (8 * (pass + 1)));
                for (int s = tid; s < S; s += NTH) { const unsigned k = keys[s]; if ((k & hmask) == prefix) atomicAdd(&hist[wave * 256 + ((k >> (8 * pass)) & 255u)], 1); }
                __syncthreads();
                if (wave == 0) {
                    int c4[4], s4 = 0;
#pragma unroll
                    for (int j = 0; j < 4; ++j) { const int bin = 255 - (4 * lane + j); int c = 0;
#pragma unroll
                        for (int w = 0; w < 8; ++w) c += hist[w * 256 + bin];
                        c4[j] = c; s4 += c; }
                    int pre = s4;
#pragma unroll
                    for (int o = 1; o < 64; o <<= 1) { const int y = __shfl_up(pre, o); if (lane >= o) pre += y; }
                    const int excl = pre - s4;
                    if (excl < krem && krem <= pre) {
                        int cum = excl, bsel = 0, rem = 0; bool found = false;
#pragma unroll
                        for (int j = 0; j < 4; ++j) { if (!found && cum + c4[j] >= krem) { bsel = 255 - (4 * lane + j); rem = krem - cum; found = true; } if (!found) cum += c4[j]; }
                        sh[8] = bsel; sh[9] = rem;
                    }
                }
                __syncthreads();
                prefix |= ((unsigned)sh[8]) << (8 * pass); krem = sh[9];
            }
            const unsigned thr = prefix;
            int ce = 0;
            for (int i = 0; i < 16; ++i) { const unsigned k = keys[tid * 16 + i]; ce += (k == thr); }
            int tot;
            const int eqbase = block_exscan(ce, sh, &tot);
            int eqr = eqbase, cs = 0;
            for (int i = 0; i < 16; ++i) { const unsigned k = keys[tid * 16 + i]; const bool sel = (k > thr) || (k == thr && eqr < krem); eqr += (k == thr); cs += sel; }
            const int sbase = block_exscan(cs, sh, &tot);
            int slot = sbase; eqr = eqbase;
            for (int i = 0; i < 16; ++i) {
                const int s = tid * 16 + i; const unsigned k = keys[s];
                const bool sel = (k > thr) || (k == thr && eqr < krem); eqr += (k == thr);
                if (sel) { TOK[eb * CAP + slot] = b * S + s; GATE[eb * CAP + slot] = __uint_as_float(k); SLOT[(size_t)(b * S + s) * NE + e] = eb * CAP + slot; ++slot; }
            }
        }
    }
    SEAM(ph); ++ph;
    if (IN(ph)) REP_LOOP {
        for (int r = gw; r < NB * NE * CAP; r += ngw) {
            int rv_ = r; asm volatile("" : "+v"(rv_));
            if constexpr (layer == 1 || F8L0) {
                const v4u* srcp = (const v4u*)(H + (size_t)TOK[rv_] * D) + 2 * lane; const v4u x0 = srcp[0], x1 = srcp[1];
                v4u o;
                o.x = pk4_fp8(bflo(x0.x) * ASC8, bfhi(x0.x) * ASC8, bflo(x0.y) * ASC8, bfhi(x0.y) * ASC8); o.y = pk4_fp8(bflo(x0.z) * ASC8, bfhi(x0.z) * ASC8, bflo(x0.w) * ASC8, bfhi(x0.w) * ASC8);
                o.z = pk4_fp8(bflo(x1.x) * ASC8, bfhi(x1.x) * ASC8, bflo(x1.y) * ASC8, bfhi(x1.y) * ASC8); o.w = pk4_fp8(bflo(x1.z) * ASC8, bfhi(x1.z) * ASC8, bflo(x1.w) * ASC8, bfhi(x1.w) * ASC8);
                ((v4u*)((unsigned char*)XE + (size_t)r * D))[lane] = o;
            } else {
                const v4u* srcp = (const v4u*)(H + (size_t)TOK[rv_] * D); v4u* dst = (v4u*)(XE + (size_t)r * D);
                dst[lane] = srcp[lane]; dst[lane + 64] = srcp[lane + 64];
            }
        }
    }
    SEAM(ph); ++ph;
    if (IN(ph)) {
        MoeOrder So{(int)gridDim.x, (int)blockIdx.x, 16 * 22, 22};
        if constexpr (layer == 1 || F8L0) {
            int Kg = D / 2; asm volatile("" : "+s"(Kg));
            pg8::Gemm g{XE, (const bf16_t*)(ws + WS_WGU8 + (size_t)layer * 176 * MiB), NB * NE * CAP, NE * 5632, Kg};
            pg8::gemm_phase<EpiSiluMul8, MoeOrder, false, true>(ldsp, g, So, EpiSiluMul8{(unsigned char*)HID}, nullptr);
        } else {
            pg8::Gemm g{XE, (const bf16_t*)(ws + WS_WGU) + (size_t)layer * NE * 5632 * D, NB * NE * CAP, NE * 5632, D};
            pg8::gemm_phase<EpiSiluMul, MoeOrder, false>(ldsp, g, So, EpiSiluMul{HID}, nullptr);
        }
    }
    SEAM(ph); ++ph;
    if (IN(ph)) {
        MoeOrder So{(int)gridDim.x, (int)blockIdx.x, 16 * 4, 4};
        if constexpr (layer == 1 || F8L0) {
            int Kg = DE / 2; asm volatile("" : "+s"(Kg));
            pg8::Gemm g{HID, (const bf16_t*)(ws + WS_WD8 + (size_t)layer * 88 * MiB), NB * NE * CAP, NE * D, Kg};
            pg8::gemm_phase<EpiYE8, MoeOrder, false, true>(ldsp, g, So, EpiYE8{GATE, YE}, nullptr);
        } else {
            pg8::Gemm g{HID, (const bf16_t*)(ws + WS_WD) + (size_t)layer * NE * D * DE, NB * NE * CAP, NE * D, DE};
            pg8::gemm_phase<EpiYE, MoeOrder, false>(ldsp, g, So, EpiYE{GATE, YE}, nullptr);
        }
    }
    SEAM(ph); ++ph;
    return ph;
}

__global__ void __launch_bounds__(NTH, 2) mega(Args a) {
    extern __shared__ __attribute__((aligned(16))) unsigned char lds_raw[];
    unsigned* ctl = (unsigned*)(a.ws + WS_CTL);
    volatile LAS unsigned* bst = (volatile LAS unsigned*)((LAS unsigned char*)lds_raw + LDS_BAR_OFF);
    { const int t0_ = tidx(); if (t0_ < 4) bst[t0_] = 0u; }
    __syncthreads();
    XcdBarrier bar; bar.bar = ctl + CW_BAR; bar.x = 0; bar.st = bst;
    if (a.hi - a.lo > 1) bar = xcd_barrier_post(ctl + CW_BAR, bst);
    PROLOG

    int ph = 0;
    if (IN(ph)) REP_LOOP {
        for (int i = gt; i < S * 32; i += ngt) {
            const int s = i >> 5, f = i & 31;
            const float pw = (float)exp((double)((float)(2 * f) / 64.0f) * 9.210340371976184);
            const float invf = 1.0f / pw;
            const float angf = (float)s * invf;
            double xx = (double)angf;
            const double n = rint(xx * 0.15915494309189535);
            xx = (xx - n * 6.283185307179586) - n * 2.4492935982947064e-16;
            const double x2 = xx * xx;
            double cs = 1.0, sn = xx, tc = 1.0, tsn = xx;
#pragma unroll 1
            for (int k = 1; k <= 16; ++k) { tc *= -x2 / (double)((2 * k - 1) * (2 * k)); tsn *= -x2 / (double)((2 * k) * (2 * k + 1)); cs += tc; sn += tsn; }
            ropec[i] = (float)cs; ropes[i] = (float)sn;
        }
        rmsnorm_rows_bf16(x_in, a.in[2], H, T);
        rmsnorm_rows_bf16(mem, a.in[25], MN, NB * MEM); rmsnorm_rows_bf16(mem, a.in[25] + D, MN + NB * MEM * D, NB * MEM);
        LAS float* scr = (LAS float*)((LAS unsigned char*)lds_raw + wave * 16896);
        auto ident = [](int n) { return n; };
        auto emap = [](int n) { const bool il = (n < 1024) || (n >= 1536 && n < 2176); const int j = n & 63; return il ? ((n & ~63) + (j < 32 ? 2 * j : 2 * (j - 32) + 1)) : n; };
        for (int it = gw; it < 16 * 36; it += ngw) transpose_item(a.in[3], D, EVEN_IN, (bf16_t*)(ws + WS_WEIN), emap, scr, it, lane);
        for (int it = gw; it < 2 * 16 * 32; it += ngw) { const int l = it / 512, r = it % 512; transpose_item(a.in[27] + (size_t)l * D * 2048, D, 2048, (bf16_t*)(ws + WS_WKV) + (size_t)l * 2048 * D, ident, scr, r, lane); }
        { float* WRT = (float*)(ws + WS_WRT);
          for (int i = gt; i < 2 * NE * D; i += ngt) { const int l = i >> 14, e = (i >> 10) & 15, k = i & 1023; WRT[i] = a.in[29][l * D + k] * a.in[30][((size_t)l * D + k) * NE + e]; } }
        { bf16_t* Wsb = (bf16_t*)(ws + WS_WSB); const float* wsp = a.in[10];
          for (int i = gt; i < 4 * 128 * 128; i += ngt) Wsb[i] = (bf16_t)f2bf(wsp[i]);
          bf16_t* WL = (bf16_t*)(ws + WS_WL); const float *w2 = a.in[14], *a2 = a.in[16], *g2 = a.in[17];
          for (int i = gt; i < 4 * 512 * 64 + 512 * 128; i += ngt) { float v;
              if (i < 4 * 512 * 64) { const int sec = i >> 15, n = (i >> 6) & 511, k = i & 63; v = (sec < 2 ? w2 : a2)[(size_t)((sec & 1) * 64 + k) * 512 + n]; }
              else { const int j = i - 4 * 512 * 64, n = j >> 7, k = j & 127; v = g2[(size_t)k * 512 + n]; }
              WL[i] = (bf16_t)f2bf(v); } }
        auto gmap = [](int n) { return (n >> 7) * 256 + (n & 127); };
        auto umap = [](int n) { return (n >> 7) * 256 + 128 + (n & 127); };
    }
    SEAM(ph); ++ph;

    if (IN(ph)) dense_gemm(ldsp, H, (const bf16_t*)(ws + WS_WEIN), T, EVEN_IN, D,
                           EpiEven{ropec, ropes, (bf16_t*)(ws + WS_QHA), (bf16_t*)(ws + WS_KHA), (bf16_t*)(ws + WS_QHB), (bf16_t*)(ws + WS_KHB), (bf16_t*)(ws + WS_VTA), (bf16_t*)(ws + WS_VTB)});
    if (IN(ph)) {
        dense_gemm(ldsp, MN, (const bf16_t*)(ws + WS_WKV), NB * MEM, 2048, D, EpiKV{KV, KV + 512 * 1024}, 192);
        dense_gemm(ldsp, MN + NB * MEM * D, (const bf16_t*)(ws + WS_WKV) + (size_t)2048 * D, NB * MEM, 2048, D, EpiKV{KV + 1024 * 1024, KV + 1024 * 1024 + 512 * 1024}, 176);
        if (bid >= 96) {
            __syncthreads();
            LAS float* scr = (LAS float*)((LAS unsigned char*)lds_raw + wave * 16896);
            const int gw3 = (bid - 96) * 8 + wave, ngw3 = (nb - 96) * 8;
            auto ident = [](int n) { return n; };
            auto gmap = [](int n) { return (n >> 7) * 256 + (n & 127); };
        for (int it = gw3; it < 16 * 16; it += ngw3) transpose_item(a.in[5], D, D, (bf16_t*)(ws + WS_WEOUT), ident, scr, it, lane);
        for (int it = gw3; it < 16 * 46; it += ngw3) transpose_item(a.in[7], D, ODD_IN, (bf16_t*)(ws + WS_WOIN), ident, scr, it, lane);
        for (int it = gw3; it < 16 * 16; it += ngw3) transpose_item(a.in[23], D, D, (bf16_t*)(ws + WS_WOOUT), ident, scr, it, lane);
        for (int it = gw3; it < 2 * 16 * 16; it += ngw3) { const int l = it / 256, r = it % 256; transpose_item(a.in[26] + (size_t)l * D * D, D, D, (bf16_t*)(ws + WS_WQ) + (size_t)l * D * D, ident, scr, r, lane, a.in[24] + l * D); }
        for (int it = gw3; it < 2 * 16 * 16; it += ngw3) { const int l = it / 256, r = it % 256; transpose_item(a.in[28] + (size_t)l * D * D, D, D, (bf16_t*)(ws + WS_WO) + (size_t)l * D * D, ident, scr, r, lane); }
            for (int it = gw3; it < 4096; it += ngw3) { const int mt = it / 704, r = it % 704;
                if constexpr (F8L0) transpose_item_fp8(a.in[31] + (size_t)mt * D * DE, D, DE, ws + WS_WGU8 + (size_t)mt * 5632 * D, gmap, GUSC8, scr, r, lane);
                else transpose_item(a.in[31] + (size_t)mt * D * DE, D, DE, (bf16_t*)(ws + WS_WGU) + (size_t)mt * 5632 * D, gmap, scr, r, lane); }
        }
    }
    SEAM(ph); ++ph;
    if (IN(ph)) REP_LOOP attn_phase_even((const bf16_t*)(ws + WS_QHA), (const bf16_t*)(ws + WS_KHA), (const bf16_t*)(ws + WS_VTA), (const bf16_t*)(ws + WS_QHB), (const bf16_t*)(ws + WS_KHB),
                                (const bf16_t*)(ws + WS_VTB), a.in[4], (bf16_t*)(ws + WS_OA), (float*)(ws + WS_LSE), Y, lds_raw);
    SEAM(ph); ++ph;
    if (IN(ph)) REP_LOOP attn_combine((const bf16_t*)(ws + WS_OA), (const float*)(ws + WS_LSE), Y);
    SEAM(ph); ++ph;
    if (IN(ph)) dense_gemm(ldsp, Y, (const bf16_t*)(ws + WS_WEOUT), T, D, D, EpiResidN{x_in, X, H, (float*)(ws + WS_SSP)});
    SEAM(ph); ++ph;

    ph = tail_phases<0>(a, bar, lds_raw, ph);
    ph = odd_phases(a, bar, lds_raw, ph);
    ph = tail_phases<1>(a, bar, lds_raw, ph);

    if (IN(ph)) combine_norm<true>(X, YE, SLOT, a.in[34], nullptr, a.out);
    ++ph;
}
constexpr int NPHASES = 1 + 4 + 2 * 7 + 8 + 1;
#undef IN
#undef SEAM
}

extern "C" void kernel_launch(void* const* d_in, const int* in_sizes, int n_in, void* d_out, int out_size, void* d_ws, size_t ws_size, hipStream_t stream) {
    static int grid = 0;
    if (grid == 0) {
        if (n_in != 35 || out_size != T * D || ws_size < WS_END) { fprintf(stderr, "kernel_launch: unexpected shapes n_in %d out %d ws %zu (need %zu)\n", n_in, out_size, ws_size, (size_t)WS_END); grid = -1; return; }
        int dev = 0, cus = 0, per_cu = 0;
        (void)hipGetDevice(&dev); (void)hipDeviceGetAttribute(&cus, hipDeviceAttributeMultiprocessorCount, dev);
        if (hipFuncSetAttribute((const void*)mega, hipFuncAttributeMaxDynamicSharedMemorySize, LDS_BYTES) != hipSuccess) { fprintf(stderr, "hipFuncSetAttribute failed\n"); grid = -1; return; }
        if (hipOccupancyMaxActiveBlocksPerMultiprocessor(&per_cu, (const void*)mega, NTH, LDS_BYTES) != hipSuccess || per_cu < 1) fprintf(stderr, "occupancy query: %d\n", per_cu);
        (void)hipGetLastError();
        grid = cus > 0 ? cus : 256;
    }
    if (grid < 0) return;
    (void)hipMemsetAsync((char*)d_ws + WS_CTL, 0, CTL_BYTES, stream);
    Args a{};
    for (int i = 0; i < 35; ++i) a.in[i] = (const float*)d_in[i];
    a.out = (float*)d_out; a.ws = (unsigned char*)d_ws;
#if MK_MULTI
    for (int k = 0; k < NPHASES; ++k) { a.lo = k; a.hi = k + 1; hipLaunchKernelGGL(mega, dim3(grid), dim3(NTH), LDS_BYTES, stream, a); }
#else
    a.lo = 0; a.hi = NPHASES; hipLaunchKernelGGL(mega, dim3(grid), dim3(NTH), LDS_BYTES, stream, a);
#endif
}
```

```cpp
#include <hip/hip_runtime.h>
#include <cstdio>
#include <cstdint>

#ifndef PROBE_PHASE
#define PROBE_PHASE (-1)
#endif
#ifndef PROBE_REP
#define PROBE_REP 1
#endif
#ifndef MK_MULTI
#define MK_MULTI 0
#endif

__device__ __forceinline__ int tidx() { int t = threadIdx.x; asm volatile("" : "+v"(t)); return t; }
namespace pg8 {
#define PG8_LAS __attribute__((address_space(3)))
typedef unsigned short bf16_t;
typedef short bf16x8 __attribute__((ext_vector_type(8)));
typedef float f32x4 __attribute__((ext_vector_type(4)));
typedef unsigned u32x4 __attribute__((ext_vector_type(4)));
constexpr int BM = 256, BK = 64, HALF = 128, HTB = HALF * BK * 2  , STAGE_BYTES = 8 * HTB, NXCD = 8, WGM = 8;

__host__ __device__ __forceinline__ int lds_byte(int r, int c) { const int st = (r >> 4) * 2 + (c >> 5), rr = r & 15, cc = c & 31, ob = rr * 64 + cc * 2; return st * 1024 + (ob ^ (((ob >> 9) & 1) << 5)); }
__host__ __device__ __forceinline__ void stage_rc(int b, int& R, int& C) { const int st = b / 1024, sb = b % 1024, swz = sb ^ (((sb >> 9) & 1) << 5); R = (st >> 1) * 16 + swz / 64; C = (st & 1) * 32 + (swz % 64) / 2; }
__host__ __device__ __forceinline__ int perm32(int rho) { const int n = rho >> 4, i = rho & 15; return 8 * (i >> 2) + 4 * n + (i & 3); }

struct Unit { int pm, pn; };
struct Gemm { const bf16_t* A; const bf16_t* Bt; int M, N, K; };

struct StaticOrder {
    int nM, nN, nwg, G, c;
    __host__ __device__ void init(int M, int N, int G_, int c_) { nM = M / BM; nN = N / BM; nwg = nM * nN; G = G_; c = c_; }
    __host__ __device__ bool next(int i, Unit& u) const {
        const long L = (long)i * G + c; if (L >= nwg) return false;
        int wgid = (int)L; { const int q = nwg / NXCD, r = nwg % NXCD, xcd = wgid % NXCD, off = wgid / NXCD; wgid = (xcd < r ? xcd * (q + 1) : r * (q + 1) + (xcd - r) * q) + off; }
        const int nig = WGM * nN, gid = wgid / nig, fm = gid * WGM, gsz = (nM - fm) < WGM ? (nM - fm) : WGM;
        u.pm = fm + ((wgid % nig) % gsz); u.pn = (wgid % nig) / gsz; return true;
    }
    __device__ __forceinline__ void a_ready(const Unit&) const {}
    __device__ __forceinline__ void done(const Unit&) const {}
};

typedef __bf16 bf16v2_t __attribute__((ext_vector_type(2)));
typedef float f32v2_t __attribute__((ext_vector_type(2)));
__device__ __forceinline__ unsigned cvt_pk_bf16(float lo, float hi) { const f32v2_t v = {lo, hi}; return __builtin_bit_cast(unsigned, __builtin_convertvector(v, bf16v2_t)); }
typedef int i32x8 __attribute__((ext_vector_type(8)));
template <bool F8> __device__ __forceinline__ f32x4 mma_tile(const bf16x8 (&bfr)[2], const bf16x8 (&afr)[2], f32x4 acc) {
    if constexpr (F8) {
        typedef int i32x4_ __attribute__((ext_vector_type(4)));
        const i32x4_ b0 = __builtin_bit_cast(i32x4_, bfr[0]), b1 = __builtin_bit_cast(i32x4_, bfr[1]), a0 = __builtin_bit_cast(i32x4_, afr[0]), a1 = __builtin_bit_cast(i32x4_, afr[1]);
        const i32x8 bb = {b0[0], b0[1], b0[2], b0[3], b1[0], b1[1], b1[2], b1[3]}, aa = {a0[0], a0[1], a0[2], a0[3], a1[0], a1[1], a1[2], a1[3]};
        const int sc1 = 0x7f7f7f7f;
        asm volatile("v_mfma_scale_f32_16x16x128_f8f6f4 %0, %1, %2, %0, %3, %3 op_sel_hi:[0,0,0]" : "+v"(acc) : "v"(bb), "v"(aa), "v"(sc1));
        return acc;
    } else {
        acc = __builtin_amdgcn_mfma_f32_16x16x32_bf16(bfr[0], afr[0], acc, 0, 0, 0);
        return __builtin_amdgcn_mfma_f32_16x16x32_bf16(bfr[1], afr[1], acc, 0, 0, 0);
    }
}
template <class Epi, class Sched, bool STAMP = false, bool F8 = false>
__device__ __forceinline__ void gemm_phase(PG8_LAS unsigned char* lds, const Gemm g, const Sched& S, const Epi& E, unsigned long long* stamps) {
    const int tid = ::tidx(), wid = __builtin_amdgcn_readfirstlane(tid >> 6), lane = tid & 63, wr = wid >> 2, wc = wid & 3, fr = lane & 15, fq = lane >> 4;
    const int K = g.K, nt = K / BK;
    int ts_lo = 0, ts_hi = 0, nts = 0; const unsigned long long rt_entry = STAMP ? (unsigned long long)wall_clock64() : 0ull;
#define PG8_STAMP() do { if (STAMP && wid == 0 && nts < 64) { const unsigned long long _c = (unsigned long long)clock64(); \
        ts_lo = (lane == nts) ? (int)(unsigned)_c : ts_lo; ts_hi = (lane == nts) ? (int)(unsigned)(_c >> 32) : ts_hi; ++nts; } } while (0)
    PG8_STAMP();
    unsigned voffA[2], voffB[2];
#pragma unroll
    for (int i = 0; i < 2; ++i) { int R, C; stage_rc(tid * 16 + i * 8192, R, C); const int Rb = Epi::PERM ? ((R & ~31) + perm32(R & 31)) : R;
        voffA[i] = (unsigned)(R * K + C) * 2u; voffB[i] = (unsigned)(Rb * K + C) * 2u; }
    const size_t kstep = (size_t)(BK * 2);
    const size_t hstep = (size_t)HALF * K * 2;
    const size_t tstep = 2 * hstep;
    const unsigned ldsw = (unsigned)wid * 1024u;
    const int aoff = lds_byte(wr * 64 + fr, fq * 8), boff = lds_byte(wc * 32 + fr, fq * 8);
#define PG8_SA(b, h) (((b) * 2 + (h)) * HTB)
#define PG8_SB(b, h) ((4 + (b) * 2 + (h)) * HTB)
#define PG8_STAGE(bufoff, gbase, voff) do { _Pragma("unroll") for (int _i = 0; _i < 2; ++_i) \
        __builtin_amdgcn_global_load_lds((const unsigned*)((const char*)(gbase) + (voff)[_i]), (PG8_LAS unsigned*)(lds + (bufoff) + ldsw + _i * 8192), 16, 0, 0); } while (0)
#define PG8_LDA(dst, b, h) do { _Pragma("unroll") for (int m = 0; m < 4; ++m) _Pragma("unroll") for (int k = 0; k < 2; ++k) dst[m][k] = *(const PG8_LAS bf16x8*)(lds + PG8_SA(b, h) + aoff + m * 2048 + k * 1024); } while (0)
#define PG8_LDB(dst, b, h) do { _Pragma("unroll") for (int n = 0; n < 2; ++n) _Pragma("unroll") for (int k = 0; k < 2; ++k) dst[n][k] = *(const PG8_LAS bf16x8*)(lds + PG8_SB(b, h) + boff + n * 2048 + k * 1024); } while (0)
#define PG8_MMA(ai, bj, At, Bt) do { __builtin_amdgcn_s_setprio(1); _Pragma("unroll") for (int m = 0; m < 4; ++m) _Pragma("unroll") for (int n = 0; n < 2; ++n) \
        acc[ai][bj][m][n] = mma_tile<F8>(Bt[n], At[m], acc[ai][bj][m][n]); __builtin_amdgcn_s_setprio(0); } while (0)
#define PG8_WAIT_V(n) asm volatile("s_waitcnt vmcnt(" #n ")" ::: "memory")
#define PG8_WAIT_L(n) asm volatile("s_waitcnt lgkmcnt(" #n ")" ::: "memory")
#define PG8_BAR __builtin_amdgcn_s_barrier()
#define PG8_SCHED __builtin_amdgcn_sched_barrier(0)
    Unit cur, nxt; int ui = 0;
    if (!S.next(0, cur)) return;
    f32x4 acc[2][2][4][2];
#pragma unroll
    for (int a = 0; a < 2; ++a)
#pragma unroll
        for (int b = 0; b < 2; ++b)
#pragma unroll
            for (int m = 0; m < 4; ++m)
#pragma unroll
                for (int n = 0; n < 2; ++n) acc[a][b][m][n] = (f32x4){0.f, 0.f, 0.f, 0.f};
    bf16x8 At[4][2], B0[2][2], B1[2][2];
    const char* cA = (const char*)g.A + (size_t)cur.pm * tstep; const char* cB = (const char*)g.Bt + (size_t)cur.pn * tstep;
    S.a_ready(cur);
    PG8_STAGE(PG8_SB(0, 0), cB, voffB); PG8_STAGE(PG8_SA(0, 0), cA, voffA); PG8_STAGE(PG8_SB(0, 1), cB + hstep, voffB); PG8_STAGE(PG8_SA(0, 1), cA + hstep, voffA);
    if (wr == 1) PG8_BAR;
    PG8_WAIT_V(4); PG8_BAR;
    PG8_STAGE(PG8_SB(1, 0), cB + kstep, voffB); PG8_STAGE(PG8_SA(1, 0), cA + kstep, voffA); PG8_STAGE(PG8_SB(1, 1), cB + hstep + kstep, voffB);
    PG8_WAIT_V(6); PG8_BAR;
    PG8_STAMP();
    for (;;) {
        const bool has_next = S.next(ui + 1, nxt);
        const char* nA = has_next ? (const char*)g.A + (size_t)nxt.pm * tstep : cA; const char* nB = has_next ? (const char*)g.Bt + (size_t)nxt.pn * tstep : cB;
        for (int t = 0; t < nt; t += 2) {
            const bool last = (t == nt - 2);
            const char* a1 = cA + (size_t)(t + 1) * kstep;
            const char* a2 = last ? nA : cA + (size_t)(t + 2) * kstep; const char* b2 = last ? nB : cB + (size_t)(t + 2) * kstep;
            const char* a3 = a2 + kstep; const char* b3 = b2 + kstep;
            if (last && has_next) S.a_ready(nxt);
            PG8_LDB(B0, 0, 0); PG8_SCHED; PG8_LDA(At, 0, 0); PG8_STAGE(PG8_SA(1, 1), a1 + hstep, voffA);
            PG8_WAIT_L(8); PG8_BAR; PG8_WAIT_L(0); PG8_MMA(0, 0, At, B0); PG8_BAR; PG8_SCHED;
            PG8_LDB(B1, 0, 1); PG8_STAGE(PG8_SB(0, 0), b2, voffB);
            PG8_BAR; PG8_WAIT_L(0); PG8_MMA(0, 1, At, B1); PG8_BAR;
            PG8_LDA(At, 0, 1); PG8_STAGE(PG8_SA(0, 0), a2, voffA);
            PG8_BAR; PG8_WAIT_L(0); PG8_MMA(1, 0, At, B0); PG8_BAR; PG8_SCHED;
            PG8_STAGE(PG8_SB(0, 1), b2 + hstep, voffB);
            PG8_WAIT_V(6); PG8_BAR; PG8_MMA(1, 1, At, B1); PG8_BAR;
            PG8_LDB(B0, 1, 0); PG8_SCHED; PG8_LDA(At, 1, 0); PG8_STAGE(PG8_SA(0, 1), a2 + hstep, voffA);
            PG8_WAIT_L(8); PG8_BAR; PG8_WAIT_L(0); PG8_MMA(0, 0, At, B0); PG8_BAR; PG8_SCHED;
            PG8_LDB(B1, 1, 1); PG8_STAGE(PG8_SB(1, 0), b3, voffB);
            PG8_BAR; PG8_WAIT_L(0); PG8_MMA(0, 1, At, B1); PG8_BAR;
            PG8_LDA(At, 1, 1); PG8_STAGE(PG8_SA(1, 0), a3, voffA);
            PG8_BAR; PG8_WAIT_L(0); PG8_MMA(1, 0, At, B0); PG8_BAR; PG8_SCHED;
            PG8_STAGE(PG8_SB(1, 1), b3 + hstep, voffB);
            PG8_WAIT_V(6); PG8_BAR; PG8_MMA(1, 1, At, B1); PG8_BAR;
        }
        PG8_STAMP();
        if constexpr (!Epi::AFTER_DRAIN) { E(acc, cur, wr, wc, fr, fq); S.done(cur); }
        PG8_STAMP();
        if (!has_next) break;
#pragma unroll
        for (int a = 0; a < 2; ++a)
#pragma unroll
            for (int b = 0; b < 2; ++b)
#pragma unroll
                for (int m = 0; m < 4; ++m)
#pragma unroll
                    for (int n = 0; n < 2; ++n) acc[a][b][m][n] = (f32x4){0.f, 0.f, 0.f, 0.f};
        cur = nxt; cA = nA; cB = nB; ++ui;
    }
    PG8_WAIT_V(0);
    if (wr == 0) PG8_BAR;
    PG8_BAR;
    if constexpr (Epi::AFTER_DRAIN) { E.fused(acc, cur, wr, wc, fr, fq, lds, wid, lane); S.done(cur); }
    PG8_STAMP();
    if (STAMP && wid == 0) { stamps[lane] = lane < nts ? (((unsigned long long)(unsigned)ts_hi << 32) | (unsigned)ts_lo) : 0ull;
        if (lane == 62) stamps[62] = rt_entry; if (lane == 63) stamps[63] = (unsigned long long)wall_clock64(); }
#undef PG8_STAMP
#undef PG8_SA
#undef PG8_SB
#undef PG8_STAGE
#undef PG8_LDA
#undef PG8_LDB
#undef PG8_MMA
#undef PG8_WAIT_V
#undef PG8_WAIT_L
#undef PG8_BAR
#undef PG8_SCHED
}
}


namespace {
using pg8::bf16_t; using pg8::f32x4;
constexpr int D = 1024, NB = 2, S = 8192, T = NB * S;
constexpr int EVEN_IN = 2304, ODD_IN = 2944, ODD_PAD = 3072, FD = 1920;
constexpr int MEM = 256, NE = 16, CAP = 1024, DE = 2816;
constexpr int NTH = 512;
constexpr size_t MiB = 1u << 20;
constexpr size_t WS_CTL = 0, CTL_BYTES = 1 * MiB;
constexpr size_t WS_ROPE = 1 * MiB;
constexpr size_t WS_AFF = 4 * MiB;
constexpr size_t WS_TOK = 5 * MiB;
constexpr size_t WS_GATE = 6 * MiB;
constexpr size_t WS_WRT = 3 * MiB;
constexpr size_t WS_SLOT = 7 * MiB;
constexpr size_t WS_X = 8 * MiB;
constexpr size_t WS_H = 72 * MiB;
constexpr size_t WS_Y = 104 * MiB;
constexpr size_t WS_P = 136 * MiB;
constexpr size_t WS_Q = 320 * MiB;
constexpr size_t WS_KV = 384 * MiB;
constexpr size_t WS_MN = 388 * MiB;
constexpr size_t WS_SSP = 390 * MiB;
constexpr size_t WS_DEC = 392 * MiB;
constexpr size_t WS_KD = 456 * MiB;
constexpr size_t WS_BB = 520 * MiB;
constexpr size_t WS_KK = 584 * MiB;
constexpr size_t WS_G = 616 * MiB;
constexpr size_t WS_YS = 648 * MiB;
constexpr size_t WS_RV = 712 * MiB;
constexpr size_t WS_VN = 776 * MiB;
constexpr size_t WS_QHA = 136 * MiB;
constexpr size_t WS_KHA = 152 * MiB;
constexpr size_t WS_QHB = 168 * MiB;
constexpr size_t WS_KHB = 184 * MiB;
constexpr size_t WS_PVB = 188 * MiB;
constexpr size_t WS_VTA = 208 * MiB;
constexpr size_t WS_VTB = 256 * MiB;
constexpr size_t WS_OA = 260 * MiB;
constexpr size_t WS_LSE = 308 * MiB;
constexpr size_t WS_QT = 136 * MiB;
constexpr size_t WS_YL = 200 * MiB;
constexpr size_t WS_PT = 264 * MiB;
constexpr size_t WS_RH = 296 * MiB;
constexpr size_t WS_S0 = 328 * MiB;
constexpr size_t WS_XE = 136 * MiB;
constexpr size_t WS_YE = 136 * MiB;
constexpr size_t WS_HID = 200 * MiB;
constexpr size_t WS_KB = 360 * MiB;
constexpr size_t WS_F5 = 792 * MiB;
constexpr size_t WS_WSB = 804 * MiB;
constexpr size_t WS_WL = 805 * MiB;
constexpr size_t WS_WEIN = 808 * MiB;
constexpr size_t WS_WEOUT = 813 * MiB;
constexpr size_t WS_WOIN = 815 * MiB;
constexpr size_t WS_WOOUT = 821 * MiB;
constexpr size_t WS_WQ = 823 * MiB;
constexpr size_t WS_WKV = 827 * MiB;
constexpr size_t WS_WO = 835 * MiB;
constexpr size_t WS_WGU = 840 * MiB;
constexpr size_t WS_WD = 1192 * MiB;
constexpr size_t WS_WGU8 = 840 * MiB;
constexpr size_t WS_WD8 = 1192 * MiB;
constexpr size_t WS_END = 1368 * MiB;
constexpr bool F8L0 = true;
constexpr float ASC8 = 16.f, GUSC8 = 128.f, HSC8 = 4.f, DSC8 = 256.f;
constexpr int CW_BAR = 4096;

constexpr int LDS_BYTES = 147456;
constexpr int LDS_BAR_OFF = LDS_BYTES - 64;

#define LAS __attribute__((address_space(3)))
#define XB_TMO      128
#define XB_XCNT(j)  (256  + 64 * (j))
#define XB_XSUB(j)  (1280 + 64 * (j))
#define XB_XGEN(j)  (2304 + 64 * (j))
#define XB_TOP      3328
#define XB_TOPGEN   3392
#define XCD_BAR_WORDS 3456
#define XB_SPIN_CAP (1u << 22)
__device__ __forceinline__ unsigned xb_ld(unsigned* p)              { return __hip_atomic_load(p, __ATOMIC_RELAXED, __HIP_MEMORY_SCOPE_AGENT); }
__device__ __forceinline__ unsigned xb_add(unsigned* p, unsigned v) { return __hip_atomic_fetch_add(p, v, __ATOMIC_RELAXED, __HIP_MEMORY_SCOPE_AGENT); }
__device__ __forceinline__ unsigned xb_xcc_id() { return (unsigned)__builtin_amdgcn_s_getreg((3 << 11) | 20) & 0xFu; }
#define XB_SPIN(cond, bar) do { unsigned _sp = 0; while (cond) { __builtin_amdgcn_s_sleep(1); \
    if ((++_sp & 255u) == 0u) { if (xb_ld(&(bar)[XB_TMO])) break; if (_sp > XB_SPIN_CAP) { atomicAdd(&(bar)[XB_TMO], 1u); break; } } } } while (0)
struct XcdBarrier { unsigned* bar; unsigned x; volatile LAS unsigned* st; };
__device__ __forceinline__ XcdBarrier xcd_barrier_post(unsigned* bar, volatile LAS unsigned* st) {
    XcdBarrier b; b.bar = bar; b.x = xb_xcc_id(); b.st = st;
    if (threadIdx.x == 0) (void)xb_add(&bar[XB_XCNT(b.x)], 1u);
    return b;
}
__device__ __forceinline__ void xcd_barrier_complete(unsigned* bar, unsigned x, unsigned& nloc, unsigned& nx) {
    const unsigned G = gridDim.x * gridDim.y * gridDim.z;
    unsigned sum, cnt, mine, sp = 0u;
    for (;;) {
        sum = 0u; cnt = 0u; mine = 0u;
#pragma unroll
        for (unsigned j = 0; j < 16; ++j) { const unsigned c = xb_ld(&bar[XB_XCNT(j)]); sum += c; cnt += (c > 0u) ? 1u : 0u; mine = (j == x) ? c : mine; }
        if (sum == G) break;
        __builtin_amdgcn_s_sleep(1);
        if ((++sp & 255u) == 0u) { if (xb_ld(&bar[XB_TMO])) break; if (sp > XB_SPIN_CAP) { atomicAdd(&bar[XB_TMO], 1u); break; } }
    }
    nloc = mine > 0u ? mine : 1u; nx = cnt > 0u ? cnt : 1u;
}
__device__ __forceinline__ void xcd_barrier(const XcdBarrier& b) {
    asm volatile("s_waitcnt vmcnt(0)" ::: "memory");
    __syncthreads();
    if (threadIdx.x == 0) {
        unsigned* bar = b.bar;
        __builtin_amdgcn_s_waitcnt(0);
        unsigned nloc = b.st[0], nx = b.st[1];
        if (nloc == 0u) { xcd_barrier_complete(bar, b.x, nloc, nx); b.st[0] = nloc; b.st[1] = nx; }
        const unsigned old = xb_add(&bar[XB_XSUB(b.x)], 1u);
        const unsigned gen = old / nloc;
        if (old + 1u == (gen + 1u) * nloc) {
            __builtin_amdgcn_fence(__ATOMIC_RELEASE, "agent");
            asm volatile("s_waitcnt vmcnt(0)" ::: "memory");
            const unsigned og = xb_add(&bar[XB_TOP], 1u);
            const unsigned tg = og / nx;
            if (og + 1u == (tg + 1u) * nx) xb_add(&bar[XB_TOPGEN], 1u);
            else XB_SPIN(xb_ld(&bar[XB_TOPGEN]) == tg, bar);
            __builtin_amdgcn_fence(__ATOMIC_ACQUIRE, "agent");
            xb_add(&bar[XB_XGEN(b.x)], 1u);
            asm volatile("s_waitcnt vmcnt(0)" ::: "memory");
        } else {
            XB_SPIN(xb_ld(&bar[XB_XGEN(b.x)]) == gen, bar);
            __builtin_amdgcn_fence(__ATOMIC_ACQUIRE, "agent");
            asm volatile("s_waitcnt vmcnt(0)" ::: "memory");
        }
    }
    __syncthreads();
}

__device__ __forceinline__ float wave_sum(float v) {
#pragma unroll
    for (int o = 32; o >= 1; o >>= 1) v += __shfl_xor(v, o);
    return v;
}
__device__ __forceinline__ float frcp(float x) { return __builtin_amdgcn_rcpf(x); }
__device__ __forceinline__ float sigmoidf_(float x) { return frcp(1.0f + __expf(-x)); }
__device__ __forceinline__ float tanhf_(float x) { return 2.0f * sigmoidf_(2.0f * x) - 1.0f; }
__device__ __forceinline__ float gelu_tanh(float x) { return x * sigmoidf_(1.5957691216057308f * (x + 0.044715f * x * x * x)); }
__device__ __forceinline__ unsigned f2bf(float f) { unsigned u = __builtin_bit_cast(unsigned, f); return (u + 0x7fffu + ((u >> 16) & 1u)) >> 16; }
__device__ __forceinline__ unsigned pk2(float lo, float hi) { return pg8::cvt_pk_bf16(lo, hi); }
__device__ __forceinline__ float bflo(unsigned w) { return __uint_as_float(w << 16); }
__device__ __forceinline__ float bfhi(unsigned w) { return __uint_as_float(w & 0xffff0000u); }
typedef unsigned v4u __attribute__((ext_vector_type(4)));
typedef unsigned v2u __attribute__((ext_vector_type(2)));

struct Args { const float* in[35]; float* out; unsigned char* ws; int lo, hi; };

struct EpiF32Store {
    static constexpr bool PERM = false, AFTER_DRAIN = false;
    float* C; int ldc; int nvalid;
    __device__ __forceinline__ void operator()(const f32x4 (&acc)[2][2][4][2], const pg8::Unit& u, int wr, int wc, int fr, int fq) const {
        const int row0 = u.pm * 256 + wr * 64 + fr, col0 = u.pn * 256 + wc * 32 + 4 * fq;
#pragma unroll
        for (int ai = 0; ai < 2; ++ai)
#pragma unroll
            for (int m = 0; m < 4; ++m) { float* rowp = C + (size_t)(row0 + ai * 128 + m * 16) * ldc + col0;
#pragma unroll
                for (int bj = 0; bj < 2; ++bj)
#pragma unroll
                    for (int n = 0; n < 2; ++n) if (col0 + bj * 128 + n * 16 < nvalid) *(f32x4*)(rowp + bj * 128 + n * 16) = acc[ai][bj][m][n]; }
    }
};
struct EpiResid {
    static constexpr bool PERM = false, AFTER_DRAIN = false;
    const float* base; float* out;
    __device__ __forceinline__ void operator()(const f32x4 (&acc)[2][2][4][2], const pg8::Unit& u, int wr, int wc, int fr, int fq) const {
        const int row0 = u.pm * 256 + wr * 64 + fr, col0 = u.pn * 256 + wc * 32 + 4 * fq;
#pragma unroll
        for (int ai = 0; ai < 2; ++ai)
#pragma unroll
            for (int m = 0; m < 4; ++m) { const size_t off = (size_t)(row0 + ai * 128 + m * 16) * D + col0;
#pragma unroll
                for (int bj = 0; bj < 2; ++bj)
#pragma unroll
                    for (int n = 0; n < 2; ++n) { const f32x4 b = *(const f32x4*)(base + off + bj * 128 + n * 16); *(f32x4*)(out + off + bj * 128 + n * 16) = b + acc[ai][bj][m][n]; } }
    }
};
struct EpiSiluMul {
    static constexpr bool PERM = false, AFTER_DRAIN = false;
    bf16_t* HIDp;
    __device__ __forceinline__ void operator()(const f32x4 (&acc)[2][2][4][2], const pg8::Unit& u, int wr, int wc, int fr, int fq) const {
        const int pnl = u.pn % 22;
        const int row0 = u.pm * 256 + wr * 64 + fr, col0 = pnl * 128 + wc * 32 + 4 * fq;
#pragma unroll
        for (int ai = 0; ai < 2; ++ai)
#pragma unroll
            for (int m = 0; m < 4; ++m) { bf16_t* rowp = HIDp + (size_t)(row0 + ai * 128 + m * 16) * DE + col0;
#pragma unroll
                for (int n = 0; n < 2; ++n) { const f32x4 g = acc[ai][0][m][n], up = acc[ai][1][m][n]; float h[4];
#pragma unroll
                    for (int j = 0; j < 4; ++j) h[j] = g[j] * frcp(1.0f + __expf(-g[j])) * up[j];
                    v2u w; w.x = pk2(h[0], h[1]); w.y = pk2(h[2], h[3]); *(v2u*)(rowp + n * 16) = w; } }
    }
};
struct EpiYE {
    static constexpr bool PERM = true, AFTER_DRAIN = false;
    const float* GATE; bf16_t* YE;
    __device__ __forceinline__ void operator()(const f32x4 (&acc)[2][2][4][2], const pg8::Unit& u, int wr, int wc, int fr, int fq) const {
        const int pnl = u.pn & 3;
        const int row0 = u.pm * 256 + wr * 64 + fr, col0 = pnl * 256 + wc * 32 + 8 * fq;
#pragma unroll
        for (int ai = 0; ai < 2; ++ai)
#pragma unroll
            for (int m = 0; m < 4; ++m) { const int row = row0 + ai * 128 + m * 16; const float gt_ = GATE[row]; bf16_t* rowp = YE + (size_t)row * D + col0;
#pragma unroll
                for (int bj = 0; bj < 2; ++bj) { const f32x4 v0 = acc[ai][bj][m][0] * gt_, v1 = acc[ai][bj][m][1] * gt_;
                    v4u w; w.x = pg8::cvt_pk_bf16(v0[0], v0[1]); w.y = pg8::cvt_pk_bf16(v0[2], v0[3]); w.z = pg8::cvt_pk_bf16(v1[0], v1[1]); w.w = pg8::cvt_pk_bf16(v1[2], v1[3]);
                    *(v4u*)(rowp + bj * 128) = w; } }
    }
};
struct EpiBf16Store {
    static constexpr bool PERM = true, AFTER_DRAIN = false;
    bf16_t* O; int ldc; float scale;
    __device__ __forceinline__ void operator()(const f32x4 (&acc)[2][2][4][2], const pg8::Unit& u, int wr, int wc, int fr, int fq) const {
        const int row0 = u.pm * 256 + wr * 64 + fr, col0 = u.pn * 256 + wc * 32 + 8 * fq;
#pragma unroll
        for (int ai = 0; ai < 2; ++ai)
#pragma unroll
            for (int m = 0; m < 4; ++m) { bf16_t* rowp = O + (size_t)(row0 + ai * 128 + m * 16) * ldc + col0;
#pragma unroll
                for (int bj = 0; bj < 2; ++bj) { const f32x4 v0 = acc[ai][bj][m][0] * scale, v1 = acc[ai][bj][m][1] * scale;
                    v4u w; w.x = pg8::cvt_pk_bf16(v0[0], v0[1]); w.y = pg8::cvt_pk_bf16(v0[2], v0[3]); w.z = pg8::cvt_pk_bf16(v1[0], v1[1]); w.w = pg8::cvt_pk_bf16(v1[2], v1[3]);
                    *(v4u*)(rowp + bj * 128) = w; } }
    }
};
struct EpiKV {
    static constexpr bool PERM = false, AFTER_DRAIN = false;
    bf16_t* K; bf16_t* Vt;
    __device__ __forceinline__ void operator()(const f32x4 (&acc)[2][2][4][2], const pg8::Unit& u, int wr, int wc, int fr, int fq) const {
        const int row0 = u.pm * 256 + wr * 64 + fr, col0 = u.pn * 256 + wc * 32 + 4 * fq;
#pragma unroll
        for (int ai = 0; ai < 2; ++ai)
#pragma unroll
            for (int m = 0; m < 4; ++m) { const int row = row0 + ai * 128 + m * 16;
#pragma unroll
                for (int bj = 0; bj < 2; ++bj)
#pragma unroll
                    for (int n = 0; n < 2; ++n) { const int col = col0 + bj * 128 + n * 16; const f32x4 v = acc[ai][bj][m][n];
                        if (col < 1024) { v2u w; w.x = pk2(v[0], v[1]); w.y = pk2(v[2], v[3]); *(v2u*)(K + (size_t)row * 1024 + col) = w; }
                        else { const int b = row >> 8, mm = row & 255; bf16_t* vp = Vt + ((size_t)(b * 1024 + (col - 1024)) * 256 + mm);
#pragma unroll
                            for (int j = 0; j < 4; ++j) vp[(size_t)j * 256] = (bf16_t)f2bf(v[j]); } } }
    }
};

constexpr float QSCALE = 0.125f * 1.4426950408889634f;
struct EpiEven {
    static constexpr bool PERM = true, AFTER_DRAIN = false;
    const float* rc; const float* rs; bf16_t* QhA; bf16_t* KhA; bf16_t* QhB; bf16_t* KhB; bf16_t* VhA; bf16_t* VhB;
    __device__ __forceinline__ void operator()(const f32x4 (&acc)[2][2][4][2], const pg8::Unit& u, int wr, int wc, int fr, int fq) const {
        asm volatile("" : "+v"(fr), "+v"(fq));
        const int row0 = u.pm * 256 + wr * 64 + fr;
#pragma unroll
        for (int bj = 0; bj < 2; ++bj) {
            const int c0 = u.pn * 256 + bj * 128 + wc * 32 + 8 * fq;
            int kind; bf16_t* base; int stride; float sc = 1.0f;
            if (c0 < 512) { kind = 0; base = QhA + ((size_t)(c0 >> 6) * T) * 64 + (c0 & 63); stride = 64; sc = QSCALE; }
            else if (c0 < 1024) { kind = 0; base = KhA + ((size_t)((c0 - 512) >> 6) * T) * 64 + (c0 & 63); stride = 64; }
            else if (c0 < 1536) { kind = 1; base = VhA + ((size_t)((c0 - 1024) >> 6) * T) * 64 + (c0 & 63); stride = 64; }
            else if (c0 < 2048) { kind = 0; base = QhB + ((size_t)((c0 - 1536) >> 6) * T) * 64 + (c0 & 63); stride = 64; sc = QSCALE; }
            else if (c0 < 2176) { kind = 0; base = KhB + ((size_t)((c0 - 2048) >> 6) * T) * 64 + (c0 & 63); stride = 64; }
            else { kind = 1; base = VhB + ((size_t)((c0 - 2176) >> 6) * T) * 64 + (c0 & 63); stride = 64; }
            const int pi = (c0 & 63) >> 1;
#pragma unroll
            for (int ai = 0; ai < 2; ++ai)
#pragma unroll
                for (int m = 0; m < 4; ++m) {
                    const int tok = row0 + ai * 128 + m * 16;
                    const f32x4 v0 = acc[ai][bj][m][0], v1 = acc[ai][bj][m][1];
                    float y[8];
                    if (kind == 0) {
                        const int s = tok & (S - 1);
                        const f32x4 c4 = *(const f32x4*)(rc + s * 32 + pi), s4 = *(const f32x4*)(rs + s * 32 + pi);
                        y[0] = (v0[0] * c4[0] - v0[1] * s4[0]) * sc; y[1] = (v0[1] * c4[0] + v0[0] * s4[0]) * sc;
                        y[2] = (v0[2] * c4[1] - v0[3] * s4[1]) * sc; y[3] = (v0[3] * c4[1] + v0[2] * s4[1]) * sc;
                        y[4] = (v1[0] * c4[2] - v1[1] * s4[2]) * sc; y[5] = (v1[1] * c4[2] + v1[0] * s4[2]) * sc;
                        y[6] = (v1[2] * c4[3] - v1[3] * s4[3]) * sc; y[7] = (v1[3] * c4[3] + v1[2] * s4[3]) * sc;
                    } else { y[0] = v0[0]; y[1] = v0[1]; y[2] = v0[2]; y[3] = v0[3]; y[4] = v1[0]; y[5] = v1[1]; y[6] = v1[2]; y[7] = v1[3]; }
                    v4u w; w.x = pk2(y[0], y[1]); w.y = pk2(y[2], y[3]); w.z = pk2(y[4], y[5]); w.w = pk2(y[6], y[7]);
                    *(v4u*)(base + (size_t)tok * stride) = w;
                }
        }
    }
};

struct EpiLora {
    static constexpr bool PERM = false, AFTER_DRAIN = false;
    const float *w0, *a0, *k_a; const bf16_t *KB, *KK; bf16_t *LW, *KD, *BB, *G;
    __device__ __forceinline__ void operator()(const f32x4 (&acc)[2][2][4][2], const pg8::Unit& u, int wr, int wc, int fr, int fq) const {
        asm volatile("" : "+v"(fr), "+v"(fq));
        const int row0 = u.pm * 256 + wr * 64 + fr;
#pragma unroll
        for (int bj = 0; bj < 2; ++bj)
#pragma unroll
            for (int n = 0; n < 2; ++n) {
                const int c0 = u.pn * 256 + bj * 128 + wc * 32 + n * 16 + 4 * fq, sec = c0 >> 9, cc = c0 & 511;
#pragma unroll
                for (int ai = 0; ai < 2; ++ai)
#pragma unroll
                    for (int m = 0; m < 4; ++m) {
                        const size_t tok = row0 + ai * 128 + m * 16;
                        const f32x4 v = acc[ai][bj][m][n];
                        if (sec < 2) {
                            const f32x4 w = *(const f32x4*)(w0 + sec * 512 + cc); float o[4];
#pragma unroll
                            for (int j = 0; j < 4; ++j) { const float xw = -(w[j] + v[j]);
                                o[j] = -0.6065306597126334f * frcp(1.0f + __expf(xw)); }
                            v2u ww; ww.x = pk2(o[0], o[1]); ww.y = pk2(o[2], o[3]);
                            *(v2u*)(LW + ((size_t)sec * T + tok) * 512 + cc) = ww;
                        } else if (sec < 4) {
                            const int d = sec - 2;
                            const f32x4 a_ = *(const f32x4*)(a0 + d * 512 + cc), ka = *(const f32x4*)(k_a + cc);
                            const v2u kw = *(const v2u*)(KB + tok * 512 + cc), kkw = *(const v2u*)(KK + tok * 512 + cc);
                            const float kv[4] = {bflo(kw.x), bfhi(kw.x), bflo(kw.y), bfhi(kw.y)}, kk[4] = {bflo(kkw.x), bfhi(kkw.x), bflo(kkw.y), bfhi(kkw.y)};
                            float okd[4], obb[4];
#pragma unroll
                            for (int j = 0; j < 4; ++j) { const float alr = frcp(1.0f + __expf(-(a_[j] + v[j]))); okd[j] = kv[j] * (1.0f + (alr - 1.0f) * ka[j]); obb[j] = kk[j] * alr; }
                            v2u w1, w2_; w1.x = pk2(okd[0], okd[1]); w1.y = pk2(okd[2], okd[3]); w2_.x = pk2(obb[0], obb[1]); w2_.y = pk2(obb[2], obb[3]);
                            *(v2u*)(KD + ((size_t)d * T + tok) * 512 + cc) = w1; *(v2u*)(BB + ((size_t)d * T + tok) * 512 + cc) = w2_;
                        } else { v2u ww; ww.x = pk2(v[0], v[1]); ww.y = pk2(v[2], v[3]); *(v2u*)(G + tok * 512 + cc) = ww; }
                        __builtin_amdgcn_sched_barrier(0);
                    }
            }
    }
};

__device__ __forceinline__ float clamp8(float x) { return __builtin_amdgcn_fmed3f(x, -448.f, 448.f); }
__device__ __forceinline__ unsigned pk4_fp8(float a, float b, float c, float d) {
    int w = 0; w = __builtin_amdgcn_cvt_pk_fp8_f32(clamp8(a), clamp8(b), w, false); w = __builtin_amdgcn_cvt_pk_fp8_f32(clamp8(c), clamp8(d), w, true); return (unsigned)w;
}
struct EpiSiluMul8 {
    static constexpr bool PERM = true, AFTER_DRAIN = false;
    unsigned char* HIDp;
    __device__ __forceinline__ void operator()(const f32x4 (&acc)[2][2][4][2], const pg8::Unit& u, int wr, int wc, int fr, int fq) const {
        asm volatile("s_nop 7\n\ts_nop 7\n\ts_nop 7"); __builtin_amdgcn_sched_barrier(0);
        const int pnl = u.pn % 22;
        const int row0 = u.pm * 256 + wr * 64 + fr, col0 = pnl * 128 + wc * 32 + 8 * fq;
        const float s1 = 1.0f / (ASC8 * GUSC8);
#pragma unroll
        for (int ai = 0; ai < 2; ++ai)
#pragma unroll
            for (int m = 0; m < 4; ++m) { unsigned char* rowp = HIDp + (size_t)(row0 + ai * 128 + m * 16) * DE + col0; float h[8];
#pragma unroll
                for (int n = 0; n < 2; ++n) { const f32x4 g = acc[ai][0][m][n] * s1, up = acc[ai][1][m][n] * (s1 * HSC8);
#pragma unroll
                    for (int j = 0; j < 4; ++j) h[4 * n + j] = g[j] * frcp(1.0f + __expf(-g[j])) * up[j]; }
                v2u w; w.x = pk4_fp8(h[0], h[1], h[2], h[3]); w.y = pk4_fp8(h[4], h[5], h[6], h[7]);
                __builtin_nontemporal_store(w, (v2u*)rowp); }
    }
};
struct EpiYE8 {
    static constexpr bool PERM = true, AFTER_DRAIN = false;
    const float* GATE; bf16_t* YE;
    __device__ __forceinline__ void operator()(const f32x4 (&acc)[2][2][4][2], const pg8::Unit& u, int wr, int wc, int fr, int fq) const {
        asm volatile("s_nop 7\n\ts_nop 7\n\ts_nop 7"); __builtin_amdgcn_sched_barrier(0);
        const int pnl = u.pn & 3;
        const int row0 = u.pm * 256 + wr * 64 + fr, col0 = pnl * 256 + wc * 32 + 8 * fq;
#pragma unroll
        for (int ai = 0; ai < 2; ++ai)
#pragma unroll
            for (int m = 0; m < 4; ++m) { const int row = row0 + ai * 128 + m * 16; const float gt_ = GATE[row] * (1.0f / (HSC8 * DSC8)); bf16_t* rowp = YE + (size_t)row * D + col0;
#pragma unroll
                for (int bj = 0; bj < 2; ++bj) { const f32x4 v0 = acc[ai][bj][m][0] * gt_, v1 = acc[ai][bj][m][1] * gt_;
                    v4u w; w.x = pk2(v0[0], v0[1]); w.y = pk2(v0[2], v0[3]); w.z = pk2(v1[0], v1[1]); w.w = pk2(v1[2], v1[3]);
                    *(v4u*)(rowp + bj * 128) = w; } }
    }
};
template <class RowMap>
__device__ __forceinline__ void transpose_item_fp8(const float* W, int K, int N, unsigned char* WT, RowMap rm, float sc, LAS float* scr, int item, int lane) {
    const int nblk = N / 64, kb = item / nblk, nb_ = item % nblk, k0 = 64 * kb, n0 = 64 * nb_;
    f32x4 ld[16];
#pragma unroll
    for (int i = 0; i < 16; ++i) ld[i] = *(const f32x4*)(W + (size_t)(k0 + 4 * i + (lane >> 4)) * N + n0 + 4 * (lane & 15));
#pragma unroll
    for (int i = 0; i < 16; ++i) { LAS float* p = scr + (4 * i + (lane >> 4)) * 65 + 4 * (lane & 15); p[0] = ld[i][0]; p[1] = ld[i][1]; p[2] = ld[i][2]; p[3] = ld[i][3]; }
    asm volatile("s_waitcnt lgkmcnt(0)" ::: "memory");
    const int c = lane & 3;
#pragma unroll
    for (int j = 0; j < 4; ++j) { const int n = (lane >> 2) + 16 * j; const LAS float* s = scr + (16 * c) * 65 + n;
        v4u o;
#pragma unroll
        for (int q = 0; q < 4; ++q) o[q] = pk4_fp8(s[(4 * q) * 65] * sc, s[(4 * q + 1) * 65] * sc, s[(4 * q + 2) * 65] * sc, s[(4 * q + 3) * 65] * sc);
        *(v4u*)(WT + (size_t)rm(n0 + n) * K + k0 + 16 * c) = o; }
    asm volatile("s_waitcnt lgkmcnt(0)" ::: "memory");
}

struct EpiResidN {
    static constexpr bool PERM = false, AFTER_DRAIN = false;
    const float* base; float* out; bf16_t* Xb; float* SSP;
    __device__ __forceinline__ void operator()(const f32x4 (&acc)[2][2][4][2], const pg8::Unit& u, int wr, int wc, int fr, int fq) const {
        asm volatile("" : "+v"(fr), "+v"(fq));
        const int row0 = u.pm * 256 + wr * 64 + fr, col0 = u.pn * 256 + wc * 32 + 4 * fq;
#pragma unroll
        for (int ai = 0; ai < 2; ++ai)
#pragma unroll
            for (int m = 0; m < 4; ++m) { const size_t row = row0 + ai * 128 + m * 16; const size_t off = row * D + col0; float ss = 0.f;
#pragma unroll
                for (int bj = 0; bj < 2; ++bj)
#pragma unroll
                    for (int n = 0; n < 2; ++n) { const f32x4 b = *(const f32x4*)(base + off + bj * 128 + n * 16); const f32x4 o = b + acc[ai][bj][m][n];
                        *(f32x4*)(out + off + bj * 128 + n * 16) = o;
                        v2u w; w.x = pk2(o[0], o[1]); w.y = pk2(o[2], o[3]); *(v2u*)(Xb + off + bj * 128 + n * 16) = w;
                        ss += (o[0] * o[0] + o[1] * o[1]) + (o[2] * o[2] + o[3] * o[3]); }
                ss += __shfl_xor(ss, 16); ss += __shfl_xor(ss, 32);
                if (fq == 0) SSP[row * 16 + u.pn * 4 + wc] = ss; }
    }
};
struct EpiBf16StoreRS {
    static constexpr bool PERM = true, AFTER_DRAIN = false;
    bf16_t* O; int ldc; const float* SSP;
    __device__ __forceinline__ void operator()(const f32x4 (&acc)[2][2][4][2], const pg8::Unit& u, int wr, int wc, int fr, int fq) const {
        asm volatile("" : "+v"(fr), "+v"(fq));
        const int row0 = u.pm * 256 + wr * 64 + fr, col0 = u.pn * 256 + wc * 32 + 8 * fq;
#pragma unroll
        for (int ai = 0; ai < 2; ++ai)
#pragma unroll
            for (int m = 0; m < 4; ++m) { const size_t row = row0 + ai * 128 + m * 16;
                const f32x4* sp = (const f32x4*)(SSP + row * 16); const f32x4 s0 = sp[0], s1 = sp[1], s2 = sp[2], s3 = sp[3];
                const float ss = (((s0[0] + s0[1]) + (s0[2] + s0[3])) + ((s1[0] + s1[1]) + (s1[2] + s1[3]))) + (((s2[0] + s2[1]) + (s2[2] + s2[3])) + ((s3[0] + s3[1]) + (s3[2] + s3[3])));
                const float rs = rsqrtf(ss * (1.0f / D) + 1e-6f);
                bf16_t* rowp = O + row * ldc + col0;
#pragma unroll
                for (int bj = 0; bj < 2; ++bj) { const f32x4 v0 = acc[ai][bj][m][0] * rs, v1 = acc[ai][bj][m][1] * rs;
                    v4u w; w.x = pk2(v0[0], v0[1]); w.y = pk2(v0[2], v0[3]); w.z = pk2(v1[0], v1[1]); w.w = pk2(v1[2], v1[3]);
                    *(v4u*)(rowp + bj * 128) = w; } }
    }
};
struct MoeOrder {
    int G, c, npairs;
    int per;
    __device__ __forceinline__ bool next(int i, pg8::Unit& u) const {
        const int x = c & 7, y = c >> 3, pml = y & 7, pnq = y >> 3;
        const int epn = i * 32 + x * 4 + pnq;
        if (epn >= npairs || c >= 256) return false;
        const int e = epn / per;
        u.pm = e * 8 + pml; u.pn = epn; return true;
    }
    __device__ __forceinline__ void a_ready(const pg8::Unit&) const {}
    __device__ __forceinline__ void done(const pg8::Unit&) const {}
};

struct XattnOrder {
    int c;
    __device__ __forceinline__ bool next(int i, pg8::Unit& u) const { if (i != 0 || c >= 256) return false; u.pm = (c >> 7) * 32 + (c & 31); u.pn = (c >> 5) & 3; return true; }
    __device__ __forceinline__ void a_ready(const pg8::Unit&) const {}
    __device__ __forceinline__ void done(const pg8::Unit&) const {}
};
template <class RowMap>
__device__ __forceinline__ void transpose_item(const float* W, int K, int N, bf16_t* WT, RowMap rm, LAS float* scr, int item, int lane, const float* kscale = nullptr) {
    const int nblk = N / 64, kb = item / nblk, nb_ = item % nblk, k0 = 64 * kb, n0 = 64 * nb_;
    f32x4 ld[16];
#pragma unroll
    for (int i = 0; i < 16; ++i) ld[i] = *(const f32x4*)(W + (size_t)(k0 + 4 * i + (lane >> 4)) * N + n0 + 4 * (lane & 15));
#pragma unroll
    for (int i = 0; i < 16; ++i) { LAS float* p = scr + (4 * i + (lane >> 4)) * 65 + 4 * (lane & 15); p[0] = ld[i][0]; p[1] = ld[i][1]; p[2] = ld[i][2]; p[3] = ld[i][3]; }
    asm volatile("s_waitcnt lgkmcnt(0)" ::: "memory");
    const int c = lane & 7;
    float ksc[8];
#pragma unroll
    for (int q = 0; q < 8; ++q) ksc[q] = kscale ? kscale[k0 + 8 * c + q] : 1.0f;
#pragma unroll
    for (int j = 0; j < 8; ++j) { const int n = (lane >> 3) + 8 * j; const LAS float* s = scr + (8 * c) * 65 + n;
        v4u o; o.x = pk2(s[0 * 65] * ksc[0], s[1 * 65] * ksc[1]); o.y = pk2(s[2 * 65] * ksc[2], s[3 * 65] * ksc[3]); o.z = pk2(s[4 * 65] * ksc[4], s[5 * 65] * ksc[5]); o.w = pk2(s[6 * 65] * ksc[6], s[7 * 65] * ksc[7]);
        *(v4u*)(WT + (size_t)rm(n0 + n) * K + k0 + 8 * c) = o; }
    asm volatile("s_waitcnt lgkmcnt(0)" ::: "memory");
}

__device__ __forceinline__ void rmsnorm_rows_bf16(const float* x, const float* g, bf16_t* out, int M) {
    const int tix_ = tidx(); const int lane = tix_ & 63, gw = blockIdx.x * 8 + (tix_ >> 6), ngw = gridDim.x * 8;
    for (int m = gw; m < M; m += ngw) {
        const float4* xr = (const float4*)(x + (size_t)m * D);
        float4 v[4]; float s = 0.f;
#pragma unroll
        for (int j = 0; j < 4; ++j) { v[j] = xr[lane + 64 * j]; s += v[j].x * v[j].x + v[j].y * v[j].y + v[j].z * v[j].z + v[j].w * v[j].w; }
        const float r = rsqrtf(wave_sum(s) * (1.0f / D) + 1e-6f);
        v2u* o = (v2u*)(out + (size_t)m * D);
#pragma unroll
        for (int j = 0; j < 4; ++j) { const float4 gg = ((const float4*)g)[lane + 64 * j];
            v2u w; w.x = pk2(v[j].x * r * gg.x, v[j].y * r * gg.y); w.y = pk2(v[j].z * r * gg.z, v[j].w * r * gg.w); o[lane + 64 * j] = w; }
    }
}
__device__ __forceinline__ void rmsnorm_rows_f32(const float* x, const float* g, float* out, int M) {
    const int tix_ = tidx(); const int lane = tix_ & 63, gw = blockIdx.x * 8 + (tix_ >> 6), ngw = gridDim.x * 8;
    for (int m = gw; m < M; m += ngw) {
        const float4* xr = (const float4*)(x + (size_t)m * D);
        float4 v[4]; float s = 0.f;
#pragma unroll
        for (int j = 0; j < 4; ++j) { v[j] = xr[lane + 64 * j]; s += v[j].x * v[j].x + v[j].y * v[j].y + v[j].z * v[j].z + v[j].w * v[j].w; }
        const float r = rsqrtf(wave_sum(s) * (1.0f / D) + 1e-6f);
        float4* o = (float4*)(out + (size_t)m * D);
#pragma unroll
        for (int j = 0; j < 4; ++j) { const float4 gg = ((const float4*)g)[lane + 64 * j];
            o[lane + 64 * j] = make_float4(v[j].x * r * gg.x, v[j].y * r * gg.y, v[j].z * r * gg.z, v[j].w * r * gg.w); }
    }
}

__device__ __forceinline__ int block_exscan(int v, int* sh, int* tot) {
    const int tid = tidx(), lane = tid & 63, w = tid >> 6;
    int inc = v;
#pragma unroll
    for (int o = 1; o < 64; o <<= 1) { const int t = __shfl_up(inc, o); if (lane >= o) inc += t; }
    __syncthreads();
    if (lane == 63) sh[w] = inc;
    __syncthreads();
    int base = 0, total = 0;
#pragma unroll
    for (int i = 0; i < 8; ++i) { const int x = sh[i]; if (i < w) base += x; total += x; }
    *tot = total;
    return base + inc - v;
}


typedef short bf16x8 __attribute__((ext_vector_type(8)));
typedef float f32x16 __attribute__((ext_vector_type(16)));
constexpr int MROW = 144;
constexpr int MBUF = 64 * MROW;
__device__ __forceinline__ bf16x8 frag_rm(const LAS unsigned char* M, int row0, int k0, int fr, int fq) {
    return *(const LAS bf16x8*)(M + (row0 + fr) * MROW + (k0 + 8 * fq) * 2);
}
__device__ __forceinline__ bf16x8 frag_cm(const LAS unsigned char* M, int k0, int col0, int fr, int fq) {
    const LAS unsigned short* p = (const LAS unsigned short*)(M + (k0 + 8 * fq) * MROW + (col0 + fr) * 2);
    bf16x8 v;
#pragma unroll
    for (int j = 0; j < 8; ++j) v[j] = (short)p[j * (MROW / 2)];
    return v;
}
__device__ __forceinline__ void tile_store_bf16(LAS unsigned char* M, int m0, int n0, int fr, int fq, const f32x4& c) {
    v2u w; w.x = pk2(c[0], c[1]); w.y = pk2(c[2], c[3]);
    *(LAS v2u*)(M + (m0 + fr) * MROW + (n0 + 4 * fq) * 2) = w;
}
#define MMA16(acc, lf, rf) acc = __builtin_amdgcn_mfma_f32_16x16x32_bf16(rf, lf, acc, 0, 0, 0)

__device__ __forceinline__ void tile_store_bf16_T(LAS unsigned char* M, int m0, int n0, int fr, int fq, const f32x4& c) {
    const unsigned w0 = pk2(c[0], c[1]), w1 = pk2(c[2], c[3]);
    LAS unsigned char* p = M + (n0 + 4 * fq) * MROW + (m0 + fr) * 2;
    *(LAS unsigned short*)(p) = (unsigned short)(w0 & 0xffffu); *(LAS unsigned short*)(p + MROW) = (unsigned short)(w0 >> 16);
    *(LAS unsigned short*)(p + 2 * MROW) = (unsigned short)(w1 & 0xffffu); *(LAS unsigned short*)(p + 3 * MROW) = (unsigned short)(w1 >> 16);
}
__device__ __forceinline__ void scan_r1(const bf16_t* LWg, const bf16_t* RVg, const bf16_t* KDg, const bf16_t* KKg, const bf16_t* BBg,
                                        bf16_t* PT, bf16_t* QT, bf16_t* RH, float* YL, unsigned char* lds_raw) {
    LAS unsigned char* L = (LAS unsigned char*)lds_raw;
#define SL(k) (L + (k) * MBUF)
    LAS float* LWs = (LAS float*)(L + 14 * MBUF);
    const int tid = tidx(), lane = tid & 63, wave = tid >> 6, fr = lane & 15, fq = lane >> 4;
    const int tm = wave >> 1, tn0 = (wave & 1) * 2;
    const int m0 = tm * 16;
    const int t = tid >> 3, i0 = (tid & 7) * 8;
    v4u lw4n, r4n, v4n, kd4n, kk4n, bb4n;
#define R1_LOAD(it_) do { const int c_ = (it_) & 127, h_ = ((it_) >> 7) & 7, n_ = (it_) >> 10, dir_ = n_ >> 1, b_ = n_ & 1; \
        const int pos_ = dir_ ? (S - 1 - (c_ * 64 + t)) : (c_ * 64 + t); const size_t tok_ = (size_t)b_ * S + pos_; const size_t ch_ = (size_t)h_ * 64 + i0; \
        lw4n = *(const v4u*)(LWg + ((size_t)dir_ * T + tok_) * 512 + ch_); r4n = *(const v4u*)(RVg + tok_ * D + ch_); v4n = *(const v4u*)(RVg + tok_ * D + 512 + ch_); \
        kd4n = *(const v4u*)(KDg + ((size_t)dir_ * T + tok_) * 512 + ch_); kk4n = *(const v4u*)(KKg + tok_ * 512 + ch_); bb4n = *(const v4u*)(BBg + ((size_t)dir_ * T + tok_) * 512 + ch_); } while (0)
    if ((int)blockIdx.x < 4096) R1_LOAD((int)blockIdx.x);
    for (int item = blockIdx.x; item < 4096; item += gridDim.x) {
        const v4u lw4 = lw4n, r4 = r4n, v4 = v4n, kd4 = kd4n, kk4 = kk4n, bb4 = bb4n;
        float lw[8], Lin[8];
#pragma unroll
        for (int q = 0; q < 4; ++q) { lw[2 * q] = bflo(lw4[q]); lw[2 * q + 1] = bfhi(lw4[q]); }
#pragma unroll
        for (int j = 0; j < 8; ++j) { float x = lw[j];
#pragma unroll
            for (int o = 8; o < 64; o <<= 1) { const float y = __shfl_up(x, o); if (lane >= o) x += y; }
            Lin[j] = x; }
        __syncthreads();
        if (lane >= 56) {
#pragma unroll
            for (int j = 0; j < 8; ++j) LWs[64 + wave * 64 + i0 + j] = Lin[j]; }
        __syncthreads();
        {
            float off[8];
#pragma unroll
            for (int j = 0; j < 8; ++j) off[j] = 0.f;
            for (int w = 0; w < 8; ++w) { if (w < wave) {
#pragma unroll
                for (int j = 0; j < 8; ++j) off[j] += LWs[64 + w * 64 + i0 + j]; } }
#pragma unroll
            for (int j = 0; j < 8; ++j) Lin[j] += off[j];
            if (t == 63) {
#pragma unroll
                for (int j = 0; j < 8; ++j) LWs[i0 + j] = Lin[j]; }
            float at_[8], rt_[8], bt_[8], kt_[8];
#pragma unroll
            for (int q = 0; q < 4; ++q) {
#pragma unroll
                for (int e = 0; e < 2; ++e) { const int j = 2 * q + e;
                    const float ein = __expf(Lin[j]), einv = __expf(-Lin[j]), eex = __expf(Lin[j] - lw[j]);
                    const float kkv = e ? bfhi(kk4[q]) : bflo(kk4[q]), rv_ = e ? bfhi(r4[q]) : bflo(r4[q]), bbv = e ? bfhi(bb4[q]) : bflo(bb4[q]), kdv = e ? bfhi(kd4[q]) : bflo(kd4[q]);
                    at_[j] = -kkv * eex; rt_[j] = rv_ * ein; bt_[j] = bbv * einv; kt_[j] = kdv * einv; }
            }
            v4u wa, wb, wk, w;
            wa.x = pk2(at_[0], at_[1]); wa.y = pk2(at_[2], at_[3]); wa.z = pk2(at_[4], at_[5]); wa.w = pk2(at_[6], at_[7]); *(LAS v4u*)(SL(0) + t * MROW + i0 * 2) = wa;
            w.x = pk2(rt_[0], rt_[1]); w.y = pk2(rt_[2], rt_[3]); w.z = pk2(rt_[4], rt_[5]); w.w = pk2(rt_[6], rt_[7]); *(LAS v4u*)(SL(2) + t * MROW + i0 * 2) = w;
            wb.x = pk2(bt_[0], bt_[1]); wb.y = pk2(bt_[2], bt_[3]); wb.z = pk2(bt_[4], bt_[5]); wb.w = pk2(bt_[6], bt_[7]); *(LAS v4u*)(SL(3) + t * MROW + i0 * 2) = wb;
            wk.x = pk2(kt_[0], kt_[1]); wk.y = pk2(kt_[2], kt_[3]); wk.z = pk2(kt_[4], kt_[5]); wk.w = pk2(kt_[6], kt_[7]); *(LAS v4u*)(SL(5) + t * MROW + i0 * 2) = wk;
#pragma unroll
            for (int q = 0; q < 4; ++q) {
                LAS unsigned char* pT = (LAS unsigned char*)0 + (i0 + 2 * q) * MROW + t * 2;
                *(LAS unsigned short*)(SL(1) + (size_t)pT) = (unsigned short)(wa[q] & 0xffffu); *(LAS unsigned short*)(SL(1) + (size_t)pT + MROW) = (unsigned short)(wa[q] >> 16);
                *(LAS unsigned short*)(SL(4) + (size_t)pT) = (unsigned short)(wb[q] & 0xffffu); *(LAS unsigned short*)(SL(4) + (size_t)pT + MROW) = (unsigned short)(wb[q] >> 16);
                *(LAS unsigned short*)(SL(6) + (size_t)pT) = (unsigned short)(wk[q] & 0xffffu); *(LAS unsigned short*)(SL(6) + (size_t)pT + MROW) = (unsigned short)(wk[q] >> 16);
                *(LAS unsigned short*)(SL(7) + (size_t)pT) = (unsigned short)(v4[q] & 0xffffu); *(LAS unsigned short*)(SL(7) + (size_t)pT + MROW) = (unsigned short)(v4[q] >> 16);
            }
        }
        if (item + (int)gridDim.x < 4096) R1_LOAD(item + (int)gridDim.x);
        __syncthreads();
        f32x4 Tacc[2];
        {
            bf16x8 la[2], lr[2];
#pragma unroll
            for (int ks = 0; ks < 2; ++ks) { la[ks] = frag_rm(SL(0), m0, 32 * ks, fr, fq); lr[ks] = frag_rm(SL(2), m0, 32 * ks, fr, fq); }
#pragma unroll
            for (int q = 0; q < 2; ++q) {
                const int n0 = (tn0 + q) * 16;
                f32x4 cab = {0.f, 0.f, 0.f, 0.f}, cak = cab, crb = cab, crk = cab;
#pragma unroll
                for (int ks = 0; ks < 2; ++ks) {
                    const bf16x8 rb_ = frag_rm(SL(3), n0, 32 * ks, fr, fq), rk_ = frag_rm(SL(5), n0, 32 * ks, fr, fq);
                    MMA16(cab, la[ks], rb_); MMA16(cak, la[ks], rk_); MMA16(crb, lr[ks], rb_); MMA16(crk, lr[ks], rk_);
                }
                const int tt = m0 + fr;
#pragma unroll
                for (int j = 0; j < 4; ++j) { const int ss = n0 + 4 * fq + j;
                    if (!(ss < tt)) { cab[j] = 0.f; cak[j] = 0.f; }
                    if (!(ss <= tt)) { crb[j] = 0.f; crk[j] = 0.f; } }
                tile_store_bf16(SL(8), m0, n0, fr, fq, cab); tile_store_bf16_T(SL(9), m0, n0, fr, fq, cab);
                tile_store_bf16(SL(10), m0, n0, fr, fq, cak);
                tile_store_bf16(SL(11), m0, n0, fr, fq, crb); tile_store_bf16(SL(12), m0, n0, fr, fq, crk);
#pragma unroll
                for (int j = 0; j < 4; ++j) cab[j] += ((n0 + 4 * fq + j) == tt) ? 1.f : 0.f;
                Tacc[q] = cab;
                tile_store_bf16(SL(13), m0, n0, fr, fq, cab);
            }
        }
        __syncthreads();
        {
            bf16x8 lk[2], ln_[2];
#pragma unroll
            for (int ks = 0; ks < 2; ++ks) { lk[ks] = frag_rm(SL(10), m0, 32 * ks, fr, fq); ln_[ks] = frag_rm(SL(8), m0, 32 * ks, fr, fq); }
#pragma unroll
            for (int q = 0; q < 2; ++q) {
                const int n0 = (tn0 + q) * 16;
                f32x4 cw = {0.f, 0.f, 0.f, 0.f}, cn = cw;
#pragma unroll
                for (int ks = 0; ks < 2; ++ks) { MMA16(cw, lk[ks], frag_rm(SL(7), n0, 32 * ks, fr, fq)); MMA16(cn, ln_[ks], frag_rm(SL(9), n0, 32 * ks, fr, fq)); }
                tile_store_bf16_T(SL(0), m0, n0, fr, fq, cw);
                tile_store_bf16(SL(3), m0, n0, fr, fq, cn); tile_store_bf16_T(SL(5), m0, n0, fr, fq, cn);
            }
        }
        __syncthreads();
#pragma unroll
        for (int k = 1; k <= 5; ++k) {
            LAS unsigned char* Nk = (k & 1) ? SL(3) : SL(8); LAS unsigned char* NkT = (k & 1) ? SL(5) : SL(9);
            LAS unsigned char* Nn = (k & 1) ? SL(8) : SL(3); LAS unsigned char* NnT = (k & 1) ? SL(9) : SL(5);
            LAS unsigned char* Tk = (k & 1) ? SL(13) : SL(10); LAS unsigned char* Tn = (k & 1) ? SL(10) : SL(13);
            bf16x8 lt[2], ln_[2];
#pragma unroll
            for (int ks = 0; ks < 2; ++ks) { lt[ks] = frag_rm(Tk, m0, 32 * ks, fr, fq); ln_[ks] = frag_rm(Nk, m0, 32 * ks, fr, fq); }
#pragma unroll
            for (int q = 0; q < 2; ++q) {
                const int n0 = (tn0 + q) * 16;
                f32x4 cn = {0.f, 0.f, 0.f, 0.f};
#pragma unroll
                for (int ks = 0; ks < 2; ++ks) { const bf16x8 rn = frag_rm(NkT, n0, 32 * ks, fr, fq); MMA16(Tacc[q], lt[ks], rn); if (k < 5) MMA16(cn, ln_[ks], rn); }
                tile_store_bf16(Tn, m0, n0, fr, fq, Tacc[q]);
                if (k < 5) { tile_store_bf16(Nn, m0, n0, fr, fq, cn); tile_store_bf16_T(NnT, m0, n0, fr, fq, cn); }
            }
            __syncthreads();
        }
        {
            bf16x8 lt[2];
#pragma unroll
            for (int ks = 0; ks < 2; ++ks) lt[ks] = frag_rm(SL(10), m0, 32 * ks, fr, fq);
#pragma unroll
            for (int q = 0; q < 2; ++q) {
                const int n0 = (tn0 + q) * 16;
                f32x4 ca = {0.f, 0.f, 0.f, 0.f}, cu = ca;
#pragma unroll
                for (int ks = 0; ks < 2; ++ks) { MMA16(ca, lt[ks], frag_rm(SL(1), n0, 32 * ks, fr, fq)); MMA16(cu, lt[ks], frag_rm(SL(0), n0, 32 * ks, fr, fq)); }
                tile_store_bf16_T(SL(8), m0, n0, fr, fq, ca); tile_store_bf16_T(SL(9), m0, n0, fr, fq, cu);
            }
        }
        __syncthreads();
        {
            bf16x8 lrb[2], lrk[2], lb[2], lkt[2];
#pragma unroll
            for (int ks = 0; ks < 2; ++ks) { lrb[ks] = frag_rm(SL(11), m0, 32 * ks, fr, fq); lrk[ks] = frag_rm(SL(12), m0, 32 * ks, fr, fq);
                lb[ks] = frag_rm(SL(4), m0, 32 * ks, fr, fq); lkt[ks] = frag_rm(SL(6), m0, 32 * ks, fr, fq); }
            const float wc = __expf(LWs[m0 + fr]);
#pragma unroll
            for (int q = 0; q < 2; ++q) {
                const int n0 = (tn0 + q) * 16;
                f32x4 crh = {0.f, 0.f, 0.f, 0.f}, cyl = crh, cp = crh, cq = crh;
#pragma unroll
                for (int ks = 0; ks < 2; ++ks) {
                    const bf16x8 ra = frag_rm(SL(8), n0, 32 * ks, fr, fq), ru = frag_rm(SL(9), n0, 32 * ks, fr, fq), rv = frag_rm(SL(7), n0, 32 * ks, fr, fq);
                    MMA16(crh, lrb[ks], ra); MMA16(cyl, lrb[ks], ru); MMA16(cyl, lrk[ks], rv);
                    MMA16(cp, lb[ks], ra); MMA16(cq, lb[ks], ru); MMA16(cq, lkt[ks], rv);
                }
                const size_t o = (size_t)item * 4096 + (size_t)(m0 + fr) * 64 + n0 + 4 * fq;
                { const LAS unsigned short* rp = (const LAS unsigned short*)(SL(2) + (m0 + fr) * MROW + (n0 + 4 * fq) * 2);
#pragma unroll
                  for (int j = 0; j < 4; ++j) crh[j] += __uint_as_float(((unsigned)rp[j]) << 16); }
                { v2u w; w.x = pk2(crh[0], crh[1]); w.y = pk2(crh[2], crh[3]); *(v2u*)(RH + o) = w; }
                *(f32x4*)(YL + o) = cyl;
#pragma unroll
                for (int j = 0; j < 4; ++j) { cp[j] = wc * (cp[j] + (((n0 + 4 * fq + j) == (m0 + fr)) ? 1.f : 0.f)); cq[j] *= wc; }
                { v2u w; w.x = pk2(cp[0], cp[1]); w.y = pk2(cp[2], cp[3]); *(v2u*)(PT + o) = w; }
                { v2u w; w.x = pk2(cq[0], cq[1]); w.y = pk2(cq[2], cq[3]); *(v2u*)(QT + o) = w; }
            }
        }
    }
#undef SL
}
#undef R1_LOAD

__device__ __forceinline__ bf16x8 pack_acc8(const f32x16& x, int s) {
    v4u p; p.x = pk2(x[8 * s], x[8 * s + 1]); p.y = pk2(x[8 * s + 2], x[8 * s + 3]); p.z = pk2(x[8 * s + 4], x[8 * s + 5]); p.w = pk2(x[8 * s + 6], x[8 * s + 7]);
    return __builtin_bit_cast(bf16x8, p);
}
__device__ __forceinline__ void scan_r2(const bf16_t* PT, const bf16_t* QT, bf16_t* S0, unsigned char* lds_raw) {
    LAS unsigned char* L = (LAS unsigned char*)lds_raw;
    constexpr int SLOT_B = MBUF + 8192;
    const int tid = tidx(), lane = tid & 63, wave = tid >> 6;
    const int r = lane & 31, h2 = lane >> 5, jb = wave;
    f32x16 st[2];
#pragma unroll
    for (int ib = 0; ib < 2; ++ib)
#pragma unroll
        for (int g = 0; g < 16; ++g) st[ib][g] = 0.f;
    const size_t item0 = (size_t)blockIdx.x * 128;
    v4u stage[16];
#pragma unroll
    for (int q = 0; q < 16; ++q) { const int p = tid + 512 * q, cc = p >> 10, w = p & 1023, mat = w >> 9, idx = w & 511;
        stage[q] = *(const v4u*)((mat ? QT : PT) + (item0 + cc) * 4096 + idx * 8); }
    for (int grp = 0; grp < 16; ++grp) {
        __syncthreads();
#pragma unroll
        for (int q = 0; q < 16; ++q) { const int p = tid + 512 * q, cc = p >> 10, w = p & 1023, mat = w >> 9, idx = w & 511;
            *(LAS v4u*)(L + cc * SLOT_B + (mat ? (MBUF + idx * 16) : ((idx >> 3) * MROW + (idx & 7) * 16))) = stage[q]; }
        __syncthreads();
        if (grp < 15) {
#pragma unroll
            for (int q = 0; q < 16; ++q) { const int p = tid + 512 * q, cc = p >> 10, w = p & 1023, mat = w >> 9, idx = w & 511;
                stage[q] = *(const v4u*)((mat ? QT : PT) + (item0 + (grp + 1) * 8 + cc) * 4096 + idx * 8); }
        }
        if (wave < 2) {
#pragma unroll 1
            for (int cc = 0; cc < 8; ++cc) {
                const size_t item = item0 + grp * 8 + cc;
                const LAS unsigned char* Pm = L + cc * SLOT_B; const LAS unsigned char* Qm = Pm + MBUF;
                bf16_t* sp = S0 + item * 4096 + (size_t)(32 * jb + r) * 64;
#pragma unroll
                for (int ib = 0; ib < 2; ++ib)
#pragma unroll
                    for (int g = 0; g < 4; ++g) { v2u w; w.x = pk2(st[ib][4 * g], st[ib][4 * g + 1]); w.y = pk2(st[ib][4 * g + 2], st[ib][4 * g + 3]); *(v2u*)(sp + 32 * ib + 8 * g + 4 * h2) = w; }
                f32x16 nw[2];
#pragma unroll
                for (int ib = 0; ib < 2; ++ib)
#pragma unroll
                    for (int g = 0; g < 16; ++g) nw[ib][g] = __uint_as_float(((unsigned)*(const LAS unsigned short*)(Qm + (32 * ib + (g & 3) + 8 * (g >> 2) + 4 * h2) * 128 + (32 * jb + r) * 2)) << 16);
#pragma unroll
                for (int kb = 0; kb < 2; ++kb)
#pragma unroll
                    for (int s2 = 0; s2 < 2; ++s2) {
                        const bf16x8 bfr = pack_acc8(st[kb], s2);
#pragma unroll
                        for (int ib = 0; ib < 2; ++ib) {
                            const LAS unsigned char* ap = Pm + (32 * ib + r) * MROW + (32 * kb + 16 * s2 + 4 * h2) * 2;
                            const v2u lo = *(const LAS v2u*)ap, hi = *(const LAS v2u*)(ap + 16);
                            v4u av; av.x = lo.x; av.y = lo.y; av.z = hi.x; av.w = hi.y;
                            nw[ib] = __builtin_amdgcn_mfma_f32_32x32x16_bf16(__builtin_bit_cast(bf16x8, av), bfr, nw[ib], 0, 0, 0);
                        }
                    }
                st[0] = nw[0]; st[1] = nw[1];
            }
        }
    }
}
__device__ __forceinline__ void scan_r3(const bf16_t* RH, const float* YL, const bf16_t* S0, const bf16_t* RVg, const bf16_t* KDg, const bf16_t* Gg,
                                        const float* r_k, const float* lng, const float* lnb, bf16_t* Y) {
    const int tid = tidx(), lane = tid & 63, wave = tid >> 6, fr = lane & 15, fq = lane >> 4;
    const int tmw = wave & 3;
    for (int it2 = blockIdx.x * 2 + (wave >> 2); it2 < 2048; it2 += gridDim.x * 2) {
        const int b = it2 >> 10, h = (it2 >> 7) & 7, pc = it2 & 127;
        f32x4 acc[4];
#pragma unroll
        for (int q = 0; q < 4; ++q) acc[q] = (f32x4){0.f, 0.f, 0.f, 0.f};
#pragma unroll 1
        for (int dirn = 0; dirn < 2; ++dirn) {
            const size_t item = (size_t)((dirn * 2 + b) * 8 + h) * 128 + (dirn ? 127 - pc : pc);
            const int row = dirn ? 63 - (16 * tmw + fr) : 16 * tmw + fr;
            const bf16_t* rp = RH + item * 4096 + (size_t)row * 64;
            bf16x8 lf[2];
#pragma unroll
            for (int ks = 0; ks < 2; ++ks) lf[ks] = *(const bf16x8*)(rp + 32 * ks + 8 * fq);
#pragma unroll
            for (int q = 0; q < 4; ++q) {
                const bf16_t* sp = S0 + item * 4096 + (size_t)(16 * q + fr) * 64;
#pragma unroll
                for (int ks = 0; ks < 2; ++ks) { const bf16x8 rf = *(const bf16x8*)(sp + 32 * ks + 8 * fq); MMA16(acc[q], lf[ks], rf); }
                acc[q] += *(const f32x4*)(YL + item * 4096 + (size_t)row * 64 + 16 * q + 4 * fq);
            }
        }
        float sm = 0.f;
#pragma unroll
        for (int q = 0; q < 4; ++q) sm += (acc[q][0] + acc[q][1]) + (acc[q][2] + acc[q][3]);
        sm += __shfl_xor(sm, 16); sm += __shfl_xor(sm, 32);
        const float mean = sm * (1.0f / 64.f);
        float sq = 0.f;
#pragma unroll
        for (int q = 0; q < 4; ++q)
#pragma unroll
            for (int j = 0; j < 4; ++j) { const float d = acc[q][j] - mean; sq += d * d; }
        sq += __shfl_xor(sq, 16); sq += __shfl_xor(sq, 32);
        const float rstd = rsqrtf(sq * (1.0f / 64.f) + 64e-5f);
        const size_t tok = (size_t)b * S + pc * 64 + 16 * tmw + fr;
        float bon = 0.f; f32x4 vv[4];
#pragma unroll
        for (int q = 0; q < 4; ++q) {
            const int c = h * 64 + 16 * q + 4 * fq;
            const v2u rw = *(const v2u*)(RVg + tok * D + c), k0 = *(const v2u*)(KDg + tok * 512 + c), k1 = *(const v2u*)(KDg + ((size_t)T + tok) * 512 + c), vw = *(const v2u*)(RVg + tok * D + 512 + c);
            const f32x4 rk4 = *(const f32x4*)(r_k + c);
            vv[q] = (f32x4){bflo(vw.x), bfhi(vw.x), bflo(vw.y), bfhi(vw.y)};
            bon += bflo(rw.x) * (bflo(k0.x) + bflo(k1.x)) * rk4[0] + bfhi(rw.x) * (bfhi(k0.x) + bfhi(k1.x)) * rk4[1] + bflo(rw.y) * (bflo(k0.y) + bflo(k1.y)) * rk4[2] + bfhi(rw.y) * (bfhi(k0.y) + bfhi(k1.y)) * rk4[3];
        }
        bon += __shfl_xor(bon, 16); bon += __shfl_xor(bon, 32);
#pragma unroll
        for (int q = 0; q < 4; ++q) {
            const int c = h * 64 + 16 * q + 4 * fq;
            const v2u gw_ = *(const v2u*)(Gg + tok * 512 + c); const f32x4 g4 = {bflo(gw_.x), bfhi(gw_.x), bflo(gw_.y), bfhi(gw_.y)}, lg = *(const f32x4*)(lng + c), lb = *(const f32x4*)(lnb + c);
            float o[4];
#pragma unroll
            for (int j = 0; j < 4; ++j) o[j] = ((acc[q][j] - mean) * rstd * lg[j] + lb[j] + bon * vv[q][j]) * g4[j];
            v2u w; w.x = pk2(o[0], o[1]); w.y = pk2(o[2], o[3]);
            *(v2u*)(Y + tok * D + 512 + c) = w;
        }
    }
}


__device__ __forceinline__ bf16x8 pack8(float a0, float a1, float a2, float a3, float a4, float a5, float a6, float a7) {
    v4u p; p.x = pk2(a0, a1); p.y = pk2(a2, a3); p.z = pk2(a4, a5); p.w = pk2(a6, a7);
    return __builtin_bit_cast(bf16x8, p);
}
#define MMA32(acc, af, bf_) acc = __builtin_amdgcn_mfma_f32_32x32x16_bf16(af, bf_, acc, 0, 0, 0)
__device__ __forceinline__ void xattn_mfma(const bf16_t* Qb, const bf16_t* Kb, const bf16_t* Vt, bf16_t* Y, unsigned char* lds_raw) {
    LAS unsigned char* L = (LAS unsigned char*)lds_raw;
    constexpr int KRS = 528, VRS = 520;
    const int tid = tidx(), lane = tid & 63, wave = tid >> 6, r = lane & 31, h2 = lane >> 5;
    for (int it = blockIdx.x; it < 256; it += gridDim.x) {
        const int qblk = it & 31, h = (it >> 5) & 3, b = it >> 7;
        const size_t tok = (size_t)b * S + qblk * 256 + wave * 32 + r;
        bf16x8 qf[16];
#pragma unroll
        for (int ks = 0; ks < 16; ++ks) qf[ks] = *(const bf16x8*)(Qb + tok * D + h * 256 + 16 * ks + 8 * h2);
        __syncthreads();
#pragma unroll
        for (int hf = 0; hf < 2; ++hf) {
            v4u stg[8];
#pragma unroll
            for (int q = 0; q < 8; ++q) { const int p = tid + 512 * (8 * hf + q); stg[q] = *(const v4u*)(Kb + (size_t)(b * MEM + (p >> 5)) * 1024 + h * 256 + (p & 31) * 8); }
#pragma unroll
            for (int q = 0; q < 8; ++q) { const int p = tid + 512 * (8 * hf + q); *(LAS v4u*)(L + (p >> 5) * KRS + (p & 31) * 16) = stg[q]; }
        }
        __syncthreads();
        float mx = -3.0e38f;
#pragma unroll 1
        for (int kb = 0; kb < 8; ++kb) {
            f32x16 st;
#pragma unroll
            for (int g = 0; g < 16; ++g) st[g] = 0.f;
            const LAS unsigned char* kp = L + (32 * kb + r) * KRS + 16 * h2;
#pragma unroll
            for (int ks = 0; ks < 16; ++ks) { const bf16x8 kf = *(const LAS bf16x8*)(kp + 32 * ks); MMA32(st, kf, qf[ks]); }
#pragma unroll
            for (int g = 0; g < 16; ++g) mx = fmaxf(mx, st[g]);
        }
        mx = fmaxf(mx, __shfl_xor(mx, 32));
        const float cs = 0.0625f * 1.4426950408889634f;
        float l = 0.f;
        bf16x8 pf[8][2];
#pragma unroll
        for (int kb = 0; kb < 8; ++kb) {
            f32x16 st;
#pragma unroll
            for (int g = 0; g < 16; ++g) st[g] = 0.f;
            const LAS unsigned char* kp = L + (32 * kb + r) * KRS + 16 * h2;
#pragma unroll
            for (int ks = 0; ks < 16; ++ks) { const bf16x8 kf = *(const LAS bf16x8*)(kp + 32 * ks); MMA32(st, kf, qf[ks]); }
#pragma unroll
            for (int g = 0; g < 16; ++g) { st[g] = __builtin_amdgcn_exp2f((st[g] - mx) * cs); l += st[g]; }
#pragma unroll
            for (int s2 = 0; s2 < 2; ++s2) pf[kb][s2] = pack8(st[8 * s2], st[8 * s2 + 1], st[8 * s2 + 2], st[8 * s2 + 3], st[8 * s2 + 4], st[8 * s2 + 5], st[8 * s2 + 6], st[8 * s2 + 7]);
            __builtin_amdgcn_sched_barrier(0);
        }
        l += __shfl_xor(l, 32);
        const float inv = 1.0f / l;
        __syncthreads();
#pragma unroll
        for (int hf = 0; hf < 2; ++hf) {
            v4u stg[8];
#pragma unroll
            for (int q = 0; q < 8; ++q) { const int p = tid + 512 * (8 * hf + q); stg[q] = *(const v4u*)(Vt + ((size_t)(b * 1024 + h * 256 + (p >> 5))) * 256 + (p & 31) * 8); }
#pragma unroll
            for (int q = 0; q < 8; ++q) { const int p = tid + 512 * (8 * hf + q); LAS v2u* lp = (LAS v2u*)(L + (p >> 5) * VRS + (p & 31) * 16);
                v2u a_; a_.x = stg[q].x; a_.y = stg[q].y; lp[0] = a_; a_.x = stg[q].z; a_.y = stg[q].w; lp[1] = a_; }
        }
        __syncthreads();
#pragma unroll 1
        for (int db = 0; db < 8; ++db) {
            f32x16 acc;
#pragma unroll
            for (int g = 0; g < 16; ++g) acc[g] = 0.f;
            const LAS unsigned char* vp = L + (32 * db + r) * VRS + 8 * h2;
#pragma unroll
            for (int kb = 0; kb < 8; ++kb)
#pragma unroll
                for (int s2 = 0; s2 < 2; ++s2) {
                    const v2u lo = *(const LAS v2u*)(vp + (32 * kb + 16 * s2) * 2), hi = *(const LAS v2u*)(vp + (32 * kb + 16 * s2 + 8) * 2);
                    v4u av; av.x = lo.x; av.y = lo.y; av.z = hi.x; av.w = hi.y;
                    MMA32(acc, __builtin_bit_cast(bf16x8, av), pf[kb][s2]);
                }
            int tl_ = tid; asm volatile("" : "+v"(tl_));
            bf16_t* yp = Y + ((size_t)b * S + qblk * 256 + (tl_ >> 6) * 32 + (tl_ & 31)) * D + h * 256 + 32 * db + 4 * ((tl_ >> 5) & 1);
#pragma unroll
            for (int g = 0; g < 4; ++g) { v2u w; w.x = pk2(acc[4 * g] * inv, acc[4 * g + 1] * inv); w.y = pk2(acc[4 * g + 2] * inv, acc[4 * g + 3] * inv); *(v2u*)(yp + 8 * g) = w; }
        }
    }
}
template <bool F32OUT>
__device__ __forceinline__ void combine_norm(float* X, const bf16_t* YE, const int* SLOT, const float* g, bf16_t* Hout, float* Fout) {
    const int tix_ = tidx(); const int lane = tix_ & 63, gw = blockIdx.x * 8 + (tix_ >> 6), ngw = gridDim.x * 8;
    for (int m = gw; m < T; m += ngw) {
        float4* xr = (float4*)(X + (size_t)m * D);
        float4 v[4];
#pragma unroll
        for (int j = 0; j < 4; ++j) v[j] = xr[lane + 64 * j];
        const int myslot = SLOT[(size_t)m * NE + (lane & 15)];
#pragma unroll
        for (int e = 0; e < 16; ++e) {
            const int row = __builtin_amdgcn_readlane(myslot, e);
            if (row >= 0) {
                const v2u* yp = (const v2u*)(YE + (size_t)row * D);
#pragma unroll
                for (int j = 0; j < 4; ++j) { const v2u w = yp[lane + 64 * j];
                    v[j].x += __uint_as_float(w.x << 16); v[j].y += __uint_as_float(w.x & 0xffff0000u); v[j].z += __uint_as_float(w.y << 16); v[j].w += __uint_as_float(w.y & 0xffff0000u); }
            }
        }
        float s = 0.f;
#pragma unroll
        for (int j = 0; j < 4; ++j) { if (!F32OUT) xr[lane + 64 * j] = v[j]; s += v[j].x * v[j].x + v[j].y * v[j].y + v[j].z * v[j].z + v[j].w * v[j].w; }
        const float r = rsqrtf(wave_sum(s) * (1.0f / D) + 1e-6f);
#pragma unroll
        for (int j = 0; j < 4; ++j) { const float4 gg = ((const float4*)g)[lane + 64 * j];
            if (F32OUT) ((float4*)(Fout + (size_t)m * D))[lane + 64 * j] = make_float4(v[j].x * r * gg.x, v[j].y * r * gg.y, v[j].z * r * gg.z, v[j].w * r * gg.w);
            else { v2u w; w.x = pk2(v[j].x * r * gg.x, v[j].y * r * gg.y); w.y = pk2(v[j].z * r * gg.z, v[j].w * r * gg.w); ((v2u*)(Hout + (size_t)m * D))[lane + 64 * j] = w; } }
    }
}


template <int NK, bool SINK>
__device__ __forceinline__ void attn_block(const bf16_t* Qh, const bf16_t* Kh, const bf16_t* Vh, int dd, int Lr, int b, int rho, int q0b, float sink2,
                                           bf16_t* Odst, int ostride, float* lsedst, unsigned char* lds_raw) {
    constexpr int NKEY = 256 + 64 * NK, KRS = 144, VRS = NKEY * 2 + 8;
    LAS unsigned char* Ks = (LAS unsigned char*)lds_raw; LAS unsigned char* Vs = Ks + NKEY * KRS;
    const int tid = tidx(), lane = tid & 63, wave = tid >> 6, r = lane & 31, h2 = lane >> 5;
    const int kq_base = q0b - 32 * NK;
    __syncthreads();
#pragma unroll
    for (int i = 0; i < NKEY * 8 / 512; ++i) {
        const int p = tid + 512 * i, row = p >> 3, piece = p & 7, kq = kq_base + row;
        if (kq >= 0 && kq < Lr) {
            const size_t tokk = (size_t)b * S + (size_t)kq * dd + rho;
            const v4u kx = *(const v4u*)(Kh + tokk * 64 + piece * 8), vx = *(const v4u*)(Vh + tokk * 64 + piece * 8);
            *(LAS v4u*)(Ks + row * KRS + piece * 16) = kx;
            LAS unsigned char* vp = Vs + (piece * 8) * VRS + row * 2;
#pragma unroll
            for (int e = 0; e < 4; ++e) { *(LAS unsigned short*)(vp + (2 * e) * VRS) = (unsigned short)(vx[e] & 0xffffu); *(LAS unsigned short*)(vp + (2 * e + 1) * VRS) = (unsigned short)(vx[e] >> 16); }
        }
    }
    const int q0 = q0b + 32 * wave;
    const size_t qtok = (size_t)b * S + (size_t)(q0 + r) * dd + rho;
    bf16x8 qf[4];
#pragma unroll
    for (int ks = 0; ks < 4; ++ks) qf[ks] = *(const bf16x8*)(Qh + qtok * 64 + 16 * ks + 8 * h2);
    __syncthreads();
    f32x16 o[2];
#pragma unroll
    for (int db = 0; db < 2; ++db)
#pragma unroll
        for (int g = 0; g < 16; ++g) o[db][g] = 0.f;
    float m = SINK ? sink2 : -1.0e30f, l = SINK ? 1.f : 0.f;
    const int kb_lo = max(-NK, -(q0 >> 5)), kb_hi = min(NK, (Lr - 32 - q0) >> 5);
#pragma unroll 1
    for (int kb = kb_lo; kb <= kb_hi; ++kb) {
        const int kw0 = 32 * (wave + kb + NK);
        f32x16 st;
#pragma unroll
        for (int g = 0; g < 16; ++g) st[g] = 0.f;
        const LAS unsigned char* kp = Ks + (kw0 + r) * KRS + 16 * h2;
#pragma unroll
        for (int ks = 0; ks < 4; ++ks) { const bf16x8 kf = *(const LAS bf16x8*)(kp + 32 * ks); MMA32(st, kf, qf[ks]); }
        if (kb == -NK || kb == NK) {
#pragma unroll
            for (int g = 0; g < 16; ++g) { const int cr = (g & 3) + 8 * (g >> 2) + 4 * h2; const bool ok = (kb < 0) ? (cr >= r) : (cr <= r); st[g] = ok ? st[g] : -1.0e30f; }
        }
        float bm = st[0];
#pragma unroll
        for (int g = 1; g < 16; ++g) bm = fmaxf(bm, st[g]);
        bm = fmaxf(bm, __shfl_xor(bm, 32));
        const float mn = fmaxf(m, bm), al = __builtin_amdgcn_exp2f(m - mn);
        float ls = 0.f;
#pragma unroll
        for (int g = 0; g < 16; ++g) { st[g] = __builtin_amdgcn_exp2f(st[g] - mn); ls += st[g]; }
        ls += __shfl_xor(ls, 32);
        l = l * al + ls; m = mn;
#pragma unroll
        for (int db = 0; db < 2; ++db)
#pragma unroll
            for (int g = 0; g < 16; ++g) o[db][g] *= al;
        bf16x8 pf[2];
#pragma unroll
        for (int s2 = 0; s2 < 2; ++s2) pf[s2] = pack8(st[8 * s2], st[8 * s2 + 1], st[8 * s2 + 2], st[8 * s2 + 3], st[8 * s2 + 4], st[8 * s2 + 5], st[8 * s2 + 6], st[8 * s2 + 7]);
#pragma unroll
        for (int db = 0; db < 2; ++db) {
            const LAS unsigned char* vp = Vs + (32 * db + r) * VRS + (kw0 + 4 * h2) * 2;
#pragma unroll
            for (int s2 = 0; s2 < 2; ++s2) {
                const v2u lo = *(const LAS v2u*)(vp + 32 * s2), hi = *(const LAS v2u*)(vp + 32 * s2 + 16);
                v4u av; av.x = lo.x; av.y = lo.y; av.z = hi.x; av.w = hi.y;
                MMA32(o[db], __builtin_bit_cast(bf16x8, av), pf[s2]);
            }
        }
    }
    const float inv = 1.0f / l;
#pragma unroll
    for (int db = 0; db < 2; ++db) {
        bf16_t* op = Odst + qtok * ostride + 32 * db + 4 * h2;
#pragma unroll
        for (int g = 0; g < 4; ++g) { v2u w; w.x = pk2(o[db][4 * g] * inv, o[db][4 * g + 1] * inv); w.y = pk2(o[db][4 * g + 2] * inv, o[db][4 * g + 3] * inv); *(v2u*)(op + 8 * g) = w; }
    }
    if (lsedst != nullptr && h2 == 0) lsedst[qtok * 8] = (m + __builtin_amdgcn_logf(l)) * 0.6931471805599453f;
}

__device__ __forceinline__ void attn_phase_even(const bf16_t* QhA, const bf16_t* KhA, const bf16_t* VhA, const bf16_t* QhB, const bf16_t* KhB, const bf16_t* VhB,
                                                const float* sink, bf16_t* OA, float* LSE, bf16_t* Y, unsigned char* lds_raw) {
    for (int it = blockIdx.x; it < 2048; it += gridDim.x) {
        if (it < 512) {
            const int hq = it >> 6, rem2 = it & 63, b = rem2 >> 5, q0b = (rem2 & 31) * 256, kvh = hq >> 2;
            attn_block<4, true>(QhB + (size_t)hq * T * 64, KhB + (size_t)kvh * T * 64, VhB + (size_t)kvh * T * 64, 1, S, b, 0, q0b, sink[hq] * 1.4426950408889634f,
                                Y + 512 + hq * 64, D, nullptr, lds_raw);
        } else {
            const int ita = it - 512, p = ita >> 9, rem = ita & 511, head = rem >> 6, rem2 = rem & 63, b = rem2 >> 5, rem3 = rem2 & 31;
            const int dd = p == 0 ? 1 : (p == 1 ? 4 : 16), bpr = 32 / dd, rho = rem3 / bpr, q0b = (rem3 % bpr) * 256;
            attn_block<2, false>(QhA + (size_t)head * T * 64, KhA + (size_t)head * T * 64, VhA + (size_t)head * T * 64, dd, S / dd, b, rho, q0b, 0.f,
                                 OA + (size_t)p * T * 512 + head * 64, 512, LSE + (size_t)p * T * 8 + head, lds_raw);
        }
    }
}
__device__ __forceinline__ void attn_combine(const bf16_t* OA, const float* LSE, bf16_t* Y) {
    const int gt = blockIdx.x * NTH + tidx(), ngt = gridDim.x * NTH;
    for (int i = gt; i < T * 64; i += ngt) {
        const int tok = i >> 6, head = (i >> 3) & 7, c8 = i & 7;
        const float l0 = LSE[(size_t)tok * 8 + head], l1 = LSE[((size_t)T + tok) * 8 + head], l2 = LSE[((size_t)2 * T + tok) * 8 + head];
        const float mx = fmaxf(l0, fmaxf(l1, l2));
        float w0 = __expf(l0 - mx), w1 = __expf(l1 - mx), w2 = __expf(l2 - mx);
        const float inv = 1.0f / (w0 + w1 + w2); w0 *= inv; w1 *= inv; w2 *= inv;
        const size_t off = (size_t)tok * 512 + head * 64 + c8 * 8;
        const v4u x0 = *(const v4u*)(OA + off), x1 = *(const v4u*)(OA + (size_t)T * 512 + off), x2 = *(const v4u*)(OA + (size_t)2 * T * 512 + off);
        v4u w;
#pragma unroll
        for (int q = 0; q < 4; ++q) {
            const float lo = w0 * __uint_as_float(x0[q] << 16) + w1 * __uint_as_float(x1[q] << 16) + w2 * __uint_as_float(x2[q] << 16);
            const float hi = w0 * __uint_as_float(x0[q] & 0xffff0000u) + w1 * __uint_as_float(x1[q] & 0xffff0000u) + w2 * __uint_as_float(x2[q] & 0xffff0000u);
            w[q] = pk2(lo, hi);
        }
        *(v4u*)(Y + (size_t)tok * D + head * 64 + c8 * 8) = w;
    }
}


__device__ __forceinline__ void odd_token_pass(const bf16_t* P, const float* mu, const float* k_k, const float* clg, const float* clb,
                                               bf16_t* VN, bf16_t* RV, bf16_t* KBf, bf16_t* KK, bf16_t* F5) {
    const int tix_ = tidx(); const int lane = tix_ & 63, gw = blockIdx.x * 8 + (tix_ >> 6), ngw = gridDim.x * 8;
    for (int tok = gw; tok < T; tok += ngw) {
        const int s = tok & (S - 1);
        const bf16_t* pr = P + (size_t)tok * ODD_PAD;
        {
            float ge[8]; float sm = 0.f;
#pragma unroll
            for (int jj = 0; jj < 4; ++jj) { const unsigned w = *(const unsigned*)(pr + 512 + 2 * lane + 128 * jj);
                ge[2 * jj] = gelu_tanh(__uint_as_float(w << 16)); ge[2 * jj + 1] = gelu_tanh(__uint_as_float(w & 0xffff0000u)); sm += ge[2 * jj] + ge[2 * jj + 1]; }
            const float mean = wave_sum(sm) * (1.0f / 512.f); float sq = 0.f;
#pragma unroll
            for (int j = 0; j < 8; ++j) { const float d = ge[j] - mean; sq += d * d; }
            const float rstd = rsqrtf(wave_sum(sq) * (1.0f / 512.f) + 1e-5f);
#pragma unroll
            for (int jj = 0; jj < 4; ++jj) { const int c = 2 * lane + 128 * jj; const float2 g2_ = *(const float2*)(clg + c), b2_ = *(const float2*)(clb + c);
                *(unsigned*)(VN + (size_t)tok * 512 + c) = pk2((ge[2 * jj] - mean) * rstd * g2_.x + b2_.x, (ge[2 * jj + 1] - mean) * rstd * g2_.y + b2_.y); }
        }
#pragma unroll
        for (int jj = 0; jj < 15; ++jj) {
            const int c = 2 * lane + 128 * jj;
            const unsigned wf = *(const unsigned*)(pr + 1024 + c);
            const unsigned wp = s > 0 ? *(const unsigned*)(pr + 1024 + c - ODD_PAD) : 0u;
            const unsigned wn = s < S - 1 ? *(const unsigned*)(pr + 1024 + c + ODD_PAD) : 0u;
            const float2 m0 = *(const float2*)(mu + c), m1 = *(const float2*)(mu + FD + c);
            const float f0 = __uint_as_float(wf << 16), f1 = __uint_as_float(wf & 0xffff0000u);
            const float x0 = f0 + m0.x * (__uint_as_float(wp << 16) - f0) + m1.x * (__uint_as_float(wn << 16) - f0);
            const float x1 = f1 + m0.y * (__uint_as_float(wp & 0xffff0000u) - f1) + m1.y * (__uint_as_float(wn & 0xffff0000u) - f1);
            if (jj < 4) *(unsigned*)(RV + (size_t)tok * D + c) = pk2(x0, x1);
            else if (jj < 8) {
                const int ck = c - 512;
                *(unsigned*)(KBf + (size_t)tok * 512 + ck) = pk2(x0, x1);
                const float2 kk_ = *(const float2*)(k_k + ck);
                const float a0_ = x0 * kk_.x, a1_ = x1 * kk_.y;
                float ss = a0_ * a0_ + a1_ * a1_;
#pragma unroll
                for (int o = 16; o >= 1; o >>= 1) ss += __shfl_xor(ss, o);
                const float inv = 1.0f / fmaxf(sqrtf(ss), 1e-12f);
                *(unsigned*)(KK + (size_t)tok * 512 + ck) = pk2(a0_ * inv, a1_ * inv);
            }
            else if (jj < 12) *(unsigned*)(RV + (size_t)tok * D + 512 + (c - 1024)) = pk2(x0, x1);
            else if (jj == 12) *(unsigned*)(F5 + (size_t)tok * 384 + (c - 1536)) = pk2(tanhf_(x0), tanhf_(x1));
            else if (jj == 13) *(unsigned*)(F5 + (size_t)tok * 384 + 128 + (c - 1664)) = pk2(x0, x1);
            else *(unsigned*)(F5 + (size_t)tok * 384 + 256 + (c - 1792)) = pk2(sigmoidf_(x0), sigmoidf_(x1));
        }
    }
}
__device__ __forceinline__ void gating_pass(const bf16_t* VN, const bf16_t* Wsb, const float* bsp, const bf16_t* P, bf16_t* Y, unsigned char* lds_raw) {
    LAS unsigned char* L = (LAS unsigned char*)lds_raw;
    constexpr int RS = 272;
    const int tid = tidx(), lane = tid & 63, wave = tid >> 6, fr = lane & 15, fq = lane >> 4;
    for (int it = blockIdx.x; it < 512; it += gridDim.x) {
        const int g = it & 3, chunk = it >> 2;
        __syncthreads();
        { const int j = tid >> 2, q4 = tid & 3;
          const v4u* gp = (const v4u*)(VN + (size_t)(chunk * 128 + j) * 512 + g * 128 + 32 * q4);
#pragma unroll
          for (int q = 0; q < 4; ++q) { const v4u x = gp[q];
#pragma unroll
              for (int e = 0; e < 4; ++e) { const int c = 32 * q4 + 8 * q + 2 * e;
                  *(LAS unsigned short*)(L + c * RS + 2 * j) = (unsigned short)(x[e] & 0xffffu); *(LAS unsigned short*)(L + (c + 1) * RS + 2 * j) = (unsigned short)(x[e] >> 16); } } }
        __syncthreads();
        bf16x8 lf[4];
#pragma unroll
        for (int ks = 0; ks < 4; ++ks) lf[ks] = *(const bf16x8*)(Wsb + (size_t)(g * 128 + 16 * wave + fr) * 128 + 32 * ks + 8 * fq);
        const int i = 16 * wave + fr; const size_t tok = (size_t)chunk * 128 + i;
        const float bias = bsp[g * 128 + i];
#pragma unroll
        for (int tn = 0; tn < 8; ++tn) {
            f32x4 acc = {0.f, 0.f, 0.f, 0.f};
#pragma unroll
            for (int ks = 0; ks < 4; ++ks) { const bf16x8 rf = *(const LAS bf16x8*)(L + (16 * tn + fr) * RS + (32 * ks + 8 * fq) * 2); MMA16(acc, lf[ks], rf); }
            const int c = g * 128 + 16 * tn + 4 * fq;
            const v2u uw = *(const v2u*)(P + tok * ODD_PAD + c);
            const float u0 = gelu_tanh(__uint_as_float(uw.x << 16)), u1 = gelu_tanh(__uint_as_float(uw.x & 0xffff0000u)), u2 = gelu_tanh(__uint_as_float(uw.y << 16)), u3 = gelu_tanh(__uint_as_float(uw.y & 0xffff0000u));
            v2u w; w.x = pk2(u0 * (acc[0] + bias), u1 * (acc[1] + bias)); w.y = pk2(u2 * (acc[2] + bias), u3 * (acc[3] + bias));
            *(v2u*)(Y + tok * D + c) = w;
        }
    }
}


__device__ __forceinline__ void router_pass(const float* X, const float* g, const float* WRT  , float* AFF, int* SLOT, bf16_t* H, unsigned char* lds_raw) {
    const int tix_ = tidx(); const int lane = tix_ & 63, wave = tix_ >> 6, fr = lane & 15, fq = lane >> 4;
    const int pair = wave >> 1, half = wave & 1;
    LAS float* xch = (LAS float*)lds_raw + pair * 512;
    for (int tile0 = blockIdx.x * 4; tile0 < T / 16; tile0 += gridDim.x * 4) {
        const int tile = tile0 + pair;
        const float* xr = X + (size_t)(tile * 16 + fr) * D + 4 * fq + 512 * half;
        const float* wr = WRT + (size_t)fr * D + 4 * fq + 512 * half;
        f32x4 acc = {0.f, 0.f, 0.f, 0.f}; float ss = 0.f;
#pragma unroll 8
        for (int s = 0; s < 32; ++s) {
            const f32x4 xa = *(const f32x4*)(xr + 16 * s), wb = *(const f32x4*)(wr + 16 * s);
            ss += (xa[0] * xa[0] + xa[1] * xa[1]) + (xa[2] * xa[2] + xa[3] * xa[3]);
#pragma unroll
            for (int c = 0; c < 4; ++c) acc = __builtin_amdgcn_mfma_f32_16x16x4f32(xa[c], wb[c], acc, 0, 0, 0);
        }
        ss += __shfl_xor(ss, 16); ss += __shfl_xor(ss, 32);
        __syncthreads();
        { LAS float* p = xch + half * 256 + lane * 4; p[0] = acc[0]; p[1] = acc[1]; p[2] = acc[2]; p[3] = acc[3]; }
        if (fq == 0) ((LAS float*)lds_raw + 2048 + pair * 32 + half * 16)[fr] = ss;
        __syncthreads();
        { const LAS float* p = xch + (half ^ 1) * 256 + lane * 4; acc[0] += p[0]; acc[1] += p[1]; acc[2] += p[2]; acc[3] += p[3]; }
        ss += ((const LAS float*)lds_raw + 2048 + pair * 32 + (half ^ 1) * 16)[fr];
        const float rstd = rsqrtf(ss * (1.0f / D) + 1e-6f);
        {
            float aff[4];
#pragma unroll
            for (int jj = 0; jj < 4; ++jj) {
                const float lg = acc[jj] * __shfl(rstd, 4 * fq + jj);
                float mx = lg;
#pragma unroll
                for (int o = 1; o < 16; o <<= 1) mx = fmaxf(mx, __shfl_xor(mx, o));
                const float e = expf(lg - mx); float den = e;
#pragma unroll
                for (int o = 1; o < 16; o <<= 1) den += __shfl_xor(den, o);
                aff[jj] = e / den;
            }
#pragma unroll
            for (int jj = 0; jj < 4; ++jj) { const size_t o = (size_t)(tile * 16 + 4 * fq + jj) * NE + fr; if ((fq >> 1) == half) { AFF[o] = aff[jj]; SLOT[o] = -1; } }
        }
#pragma unroll 4
        for (int tt = 0; tt < 8; ++tt) {
            const int t = 8 * half + tt;
            const float rs = __shfl(rstd, t);
            const f32x4* xp = (const f32x4*)(X + (size_t)(tile * 16 + t) * D); v2u* hp = (v2u*)(H + (size_t)(tile * 16 + t) * D);
#pragma unroll
            for (int j = 0; j < 4; ++j) { const f32x4 v = xp[lane + 64 * j], gg = ((const f32x4*)g)[lane + 64 * j];
                v2u w; w.x = pk2(v[0] * rs * gg[0], v[1] * rs * gg[1]); w.y = pk2(v[2] * rs * gg[2], v[3] * rs * gg[3]); hp[lane + 64 * j] = w; }
        }
    }
}


__device__ __forceinline__ void lora_pass(const bf16_t* F5, const bf16_t* WC, const float* w0, const float* a0, const float* k_a, const bf16_t* KB, const bf16_t* KK,
                                          bf16_t* LW, bf16_t* KD, bf16_t* BB, bf16_t* G, unsigned char* lds_raw) {
    LAS unsigned char* L = (LAS unsigned char*)lds_raw;
    constexpr int ARS = 784;
    const int tid = tidx(), lane = tid & 63, wave = tid >> 6, fr = lane & 15, fq = lane >> 4;
    for (int tile = blockIdx.x; tile < T / 64; tile += gridDim.x) {
        __syncthreads();
#pragma unroll
        for (int q = 0; q < 6; ++q) { const int p = tid + 512 * q, row = p / 48, piece = p % 48;
            *(LAS v4u*)(L + row * ARS + piece * 16) = *(const v4u*)(F5 + (size_t)(tile * 64 + row) * 384 + piece * 8); }
        __syncthreads();
#pragma unroll 1
        for (int sec = 0; sec < 5; ++sec) {
            const int K0 = sec * 64, nks = sec < 4 ? 2 : 4, wstride = sec < 4 ? 64 : 128;
            const bf16_t* Wp = WC + (size_t)sec * 512 * 64 + (size_t)(64 * wave) * wstride;
#pragma unroll 1
            for (int nh = 0; nh < 2; ++nh) {
            f32x4 acc[4][2];
#pragma unroll
            for (int tm = 0; tm < 4; ++tm)
#pragma unroll
                for (int tn = 0; tn < 2; ++tn) acc[tm][tn] = (f32x4){0.f, 0.f, 0.f, 0.f};
            for (int ks = 0; ks < nks; ++ks) {
                bf16x8 lf[4], rf[2];
#pragma unroll
                for (int tm = 0; tm < 4; ++tm) lf[tm] = *(const LAS bf16x8*)(L + (16 * tm + fr) * ARS + (K0 + 32 * ks + 8 * fq) * 2);
#pragma unroll
                for (int tn = 0; tn < 2; ++tn) rf[tn] = *(const bf16x8*)(Wp + (size_t)(16 * (2 * nh + tn) + fr) * wstride + 32 * ks + 8 * fq);
#pragma unroll
                for (int tm = 0; tm < 4; ++tm)
#pragma unroll
                    for (int tn = 0; tn < 2; ++tn) MMA16(acc[tm][tn], lf[tm], rf[tn]);
            }
#pragma unroll
            for (int tn = 0; tn < 2; ++tn) {
                const int cc = 64 * wave + 16 * (2 * nh + tn) + 4 * fq;
#pragma unroll
                for (int tm = 0; tm < 4; ++tm) {
                    const size_t tok = (size_t)tile * 64 + 16 * tm + fr; const f32x4 v = acc[tm][tn];
                    __builtin_amdgcn_sched_barrier(0);
                    if (sec < 2) {
                        const f32x4 w = *(const f32x4*)(w0 + sec * 512 + cc); float o[4];
#pragma unroll
                        for (int j = 0; j < 4; ++j) o[j] = -0.6065306597126334f * frcp(1.0f + __expf(-(w[j] + v[j])));
                        v2u ww; ww.x = pk2(o[0], o[1]); ww.y = pk2(o[2], o[3]);
                        *(v2u*)(LW + ((size_t)sec * T + tok) * 512 + cc) = ww;
                    } else if (sec < 4) {
                        const int d = sec - 2;
                        const f32x4 a_ = *(const f32x4*)(a0 + d * 512 + cc), ka = *(const f32x4*)(k_a + cc);
                        const v2u kw = *(const v2u*)(KB + tok * 512 + cc), kkw = *(const v2u*)(KK + tok * 512 + cc);
                        const float kv[4] = {bflo(kw.x), bfhi(kw.x), bflo(kw.y), bfhi(kw.y)}, kk[4] = {bflo(kkw.x), bfhi(kkw.x), bflo(kkw.y), bfhi(kkw.y)};
                        float okd[4], obb[4];
#pragma unroll
                        for (int j = 0; j < 4; ++j) { const float alr = frcp(1.0f + __expf(-(a_[j] + v[j]))); okd[j] = kv[j] * (1.0f + (alr - 1.0f) * ka[j]); obb[j] = kk[j] * alr; }
                        v2u w1, w2_; w1.x = pk2(okd[0], okd[1]); w1.y = pk2(okd[2], okd[3]); w2_.x = pk2(obb[0], obb[1]); w2_.y = pk2(obb[2], obb[3]);
                        *(v2u*)(KD + ((size_t)d * T + tok) * 512 + cc) = w1; *(v2u*)(BB + ((size_t)d * T + tok) * 512 + cc) = w2_;
                    } else { v2u ww; ww.x = pk2(v[0], v[1]); ww.y = pk2(v[2], v[3]); *(v2u*)(G + tok * 512 + cc) = ww; }
                }
            }
            }
        }
    }
}

#define IN(k) (lo <= (k) && (k) < hi)
#define REP_LOOP for (int rep_ = 0, nrep_ = ((ph == PROBE_PHASE) ? PROBE_REP : 1); rep_ < nrep_; ++rep_)
#define SEAM(k) do { if (IN(k) && IN((k) + 1)) xcd_barrier(bar); } while (0)
#define PROLOG \
    const int tid = tidx(), lane = tid & 63, wave = tid >> 6; \
    const int bid = blockIdx.x, nb = gridDim.x; \
    const int gw = bid * 8 + wave, ngw = nb * 8; \
    const int gt = bid * NTH + tid, ngt = nb * NTH; \
    (void)gt; (void)ngt; (void)gw; (void)ngw; (void)lane; (void)wave; \
    unsigned char* ws = a.ws; \
    const int lo = a.lo, hi = a.hi; \
    float* ldsf = (float*)lds_raw; (void)ldsf; \
    PG8_LAS unsigned char* ldsp = (PG8_LAS unsigned char*)lds_raw; (void)ldsp; \
    const float* x_in = a.in[0]; const float* mem = a.in[1]; (void)x_in; (void)mem; \
    float* ropec = (float*)(ws + WS_ROPE); float* ropes = ropec + S * 32; (void)ropec; (void)ropes; \
    float* AFF = (float*)(ws + WS_AFF); int* TOK = (int*)(ws + WS_TOK); float* GATE = (float*)(ws + WS_GATE); \
    float* X = (float*)(ws + WS_X); bf16_t* H = (bf16_t*)(ws + WS_H); bf16_t* P = (bf16_t*)(ws + WS_P); \
    bf16_t* Y = (bf16_t*)(ws + WS_Y); bf16_t* Q = (bf16_t*)(ws + WS_Q); bf16_t* KV = (bf16_t*)(ws + WS_KV); bf16_t* MN = (bf16_t*)(ws + WS_MN); \
    bf16_t* DEC = (bf16_t*)(ws + WS_DEC); bf16_t* KD = (bf16_t*)(ws + WS_KD); bf16_t* BB = (bf16_t*)(ws + WS_BB); \
    bf16_t* KK = (bf16_t*)(ws + WS_KK); bf16_t* G = (bf16_t*)(ws + WS_G); float* YS = (float*)(ws + WS_YS); \
    bf16_t* RV = (bf16_t*)(ws + WS_RV); bf16_t* VN = (bf16_t*)(ws + WS_VN); \
    bf16_t* XE = (bf16_t*)(ws + WS_XE); bf16_t* HID = (bf16_t*)(ws + WS_HID); int* SLOT = (int*)(ws + WS_SLOT); bf16_t* YE = (bf16_t*)(ws + WS_YE); (void)SLOT; (void)YE; \
    (void)AFF; (void)TOK; (void)GATE; (void)X; (void)H; (void)P; (void)Y; (void)Q; (void)KV; (void)MN; (void)DEC; (void)KD; (void)BB; (void)KK; (void)G; (void)YS; (void)RV; (void)VN; (void)XE; (void)HID;

template <class Epi>
__device__ __forceinline__ void dense_gemm(PG8_LAS unsigned char* ldsp, const bf16_t* A, const bf16_t* Bt, int M, int N, int K, const Epi& E, int cshift = 0) {
    asm volatile("" : "+s"(K));
    pg8::Gemm g{A, Bt, M, N, K}; pg8::StaticOrder So; So.init(M, N, (int)gridDim.x, (int)((blockIdx.x + cshift) % gridDim.x));
    pg8::gemm_phase<Epi, pg8::StaticOrder, false>(ldsp, g, So, E, nullptr);
}

__device__ __forceinline__ int odd_phases(const Args& a, const XcdBarrier& bar, unsigned char* lds_raw, int ph) {
    PROLOG
    if (IN(ph)) combine_norm<false>(X, YE, SLOT, a.in[6], H, nullptr);
    SEAM(ph); ++ph;
    if (IN(ph)) dense_gemm(ldsp, H, (const bf16_t*)(ws + WS_WOIN), T, ODD_PAD, D, EpiBf16Store{P, ODD_PAD, 1.0f});
    SEAM(ph); ++ph;
    if (IN(ph)) REP_LOOP odd_token_pass(P, a.in[12], a.in[18], a.in[8], a.in[9], VN, RV, (bf16_t*)(ws + WS_KB), KK, (bf16_t*)(ws + WS_F5));
    SEAM(ph); ++ph;
    if (IN(ph)) REP_LOOP {
        gating_pass(VN, (const bf16_t*)(ws + WS_WSB), a.in[11], P, Y, lds_raw);
        __syncthreads();
        lora_pass((const bf16_t*)(ws + WS_F5), (const bf16_t*)(ws + WS_WL), a.in[13], a.in[15], a.in[19], (const bf16_t*)(ws + WS_KB), KK, DEC, KD, BB, G, lds_raw);
    }
    SEAM(ph); ++ph;
    if (IN(ph)) REP_LOOP scan_r1(DEC, RV, KD, KK, BB, (bf16_t*)(ws + WS_PT), (bf16_t*)(ws + WS_QT), (bf16_t*)(ws + WS_RH), (float*)(ws + WS_YL), lds_raw);
    SEAM(ph); ++ph;
    if (IN(ph)) REP_LOOP {
        if (bid < 32) scan_r2((const bf16_t*)(ws + WS_PT), (const bf16_t*)(ws + WS_QT), (bf16_t*)(ws + WS_S0), lds_raw);
        else {
            LAS float* scr = (LAS float*)((LAS unsigned char*)lds_raw + wave * 16896);
            const int gw2 = (bid - 32) * 8 + wave, ngw2 = (nb - 32) * 8;
            auto gmap = [](int n) { return (n >> 7) * 256 + (n & 127); };
            auto umap = [](int n) { return (n >> 7) * 256 + 128 + (n & 127); };
            for (int it = gw2; it < 16 * 704; it += ngw2) { const int e = it / 704, r = it % 704;
                transpose_item_fp8(a.in[31] + (size_t)(16 + e) * D * DE, D, DE, ws + WS_WGU8 + 176 * MiB + (size_t)e * 5632 * D, gmap, GUSC8, scr, r, lane); }
            for (int it = gw2; it < 16 * 704; it += ngw2) { const int e = it / 704, r = it % 704;
                transpose_item_fp8(a.in[32] + (size_t)(16 + e) * D * DE, D, DE, ws + WS_WGU8 + 176 * MiB + (size_t)e * 5632 * D, umap, GUSC8, scr, r, lane); }
        }
    }
    SEAM(ph); ++ph;
    if (IN(ph)) REP_LOOP scan_r3((const bf16_t*)(ws + WS_RH), (const float*)(ws + WS_YL), (const bf16_t*)(ws + WS_S0), RV, KD, G, a.in[20], a.in[21], a.in[22], Y);
    SEAM(ph); ++ph;
    if (IN(ph)) dense_gemm(ldsp, Y, (const bf16_t*)(ws + WS_WOOUT), T, D, D, EpiResidN{X, X, H, (float*)(ws + WS_SSP)});
    SEAM(ph); ++ph;
    return ph;
}

template <int layer>
__device__ __forceinline__ int tail_phases(const Args& a, const XcdBarrier& bar, unsigned char* lds_raw, int ph) {
    PROLOG
    if (IN(ph)) REP_LOOP {
        int Kq = D; asm volatile("" : "+s"(Kq));
        pg8::Gemm g{H, (const bf16_t*)(ws + WS_WQ) + (size_t)layer * D * D, T, D, Kq}; XattnOrder So{(int)blockIdx.x};
        pg8::gemm_phase<EpiBf16StoreRS, XattnOrder, false>(ldsp, g, So, EpiBf16StoreRS{Q, D, (const float*)(ws + WS_SSP)}, nullptr);
        asm volatile("s_waitcnt vmcnt(0)" ::: "memory");
        __syncthreads();
        xattn_mfma(Q, KV + (size_t)layer * 1024 * 1024, KV + (size_t)layer * 1024 * 1024 + 512 * 1024, Y, lds_raw);
    }
    SEAM(ph); ++ph;
    if (IN(ph)) dense_gemm(ldsp, Y, (const bf16_t*)(ws + WS_WO) + (size_t)layer * D * D, T, D, D, EpiResid{X, X});
    SEAM(ph); ++ph;
    if (IN(ph)) REP_LOOP router_pass(X, a.in[29] + layer * D, (const float*)(ws + WS_WRT) + (size_t)layer * NE * D, AFF, SLOT, H, lds_raw);
    SEAM(ph); ++ph;
    if (IN(ph)) REP_LOOP {
        unsigned* keys = (unsigned*)ldsf;
        int* hist = (int*)(ldsf + 8192);
        int* sh = hist + 8 * 256;
        if (bid >= 32) {
            LAS float* scr = (LAS float*)((LAS unsigned char*)lds_raw + wave * 16896);
            const int gw2 = (bid - 32) * 8 + wave, ngw2 = (nb - 32) * 8;
            auto ident = [](int n) { return n; };
            if constexpr (layer == 0) {
                auto gmap = [](int n) { return (n >> 7) * 256 + (n & 127); };
                auto umap = [](int n) { return (n >> 7) * 256 + 128 + (n & 127); };
        for (int it = 4096 + gw2; it < 16 * 704; it += ngw2) { const int mt = it / 704, r = it % 704;
            if constexpr (F8L0) transpose_item_fp8(a.in[31] + (size_t)mt * D * DE, D, DE, ws + WS_WGU8 + (size_t)mt * 5632 * D, gmap, GUSC8, scr, r, lane);
            else transpose_item(a.in[31] + (size_t)mt * D * DE, D, DE, (bf16_t*)(ws + WS_WGU) + (size_t)mt * 5632 * D, gmap, scr, r, lane); }
        for (int it = gw2; it < 16 * 704; it += ngw2) { const int mt = it / 704, r = it % 704;
            if constexpr (F8L0) transpose_item_fp8(a.in[32] + (size_t)mt * D * DE, D, DE, ws + WS_WGU8 + (size_t)mt * 5632 * D, umap, GUSC8, scr, r, lane);
            else transpose_item(a.in[32] + (size_t)mt * D * DE, D, DE, (bf16_t*)(ws + WS_WGU) + (size_t)mt * 5632 * D, umap, scr, r, lane); }
            }
            for (int it = gw2; it < 16 * 704; it += ngw2) { const int mt = layer * 16 + it / 704, r = it % 704;
                if constexpr (layer == 1 || F8L0) transpose_item_fp8(a.in[33] + (size_t)mt * DE * D, DE, D, ws + WS_WD8 + (size_t)layer * 88 * MiB + (size_t)(mt - 16 * layer) * D * DE, ident, DSC8, scr, r, lane);
                else transpose_item(a.in[33] + (size_t)mt * DE * D, DE, D, (bf16_t*)(ws + WS_WD) + (size_t)mt * D * DE, ident, scr, r, lane); }
        }
        for (int be = bid; be < NB * NE && be < 32; be += nb) {
            const int b = be >> 4, e = be & 15, eb = e * 2 + b;
            __syncthreads();
            for (int s = tid; s < S; s += NTH) keys[s] = __float_as_uint(AFF[(size_t)(b * S + s) * NE + e]);
            unsigned prefix = 0u; int krem = CAP;
            for (int pass = 3; pass >= 0; --pass) {
                __syncthreads();
                for (int i = tid; i < 8 * 256; i += NTH) hist[i] = 0;
                __syncthreads();
                const unsigned hmask = pass == 3 ? 0u : (0xFFFFFFFFu << (8 * (pass + 1)));
                for (int s = tid; s < S; s += NTH) { const unsigned k = keys[s]; if ((k & hmask) == prefix) atomicAdd(&hist[wave * 256 + ((k >> (8 * pass)) & 255u)], 1); }
                __syncthreads();
                if (wave == 0) {
                    int c4[4], s4 = 0;
#pragma unroll
                    for (int j = 0; j < 4; ++j) { const int bin = 255 - (4 * lane + j); int c = 0;
#pragma unroll
                        for (int w = 0; w < 8; ++w) c += hist[w * 256 + bin];
                        c4[j] = c; s4 += c; }
                    int pre = s4;
#pragma unroll
                    for (int o = 1; o < 64; o <<= 1) { const int y = __shfl_up(pre, o); if (lane >= o) pre += y; }
                    const int excl = pre - s4;
                    if (excl < krem && krem <= pre) {
                        int cum = excl, bsel = 0, rem = 0; bool found = false;
#pragma unroll
                        for (int j = 0; j < 4; ++j) { if (!found && cum + c4[j] >= krem) { bsel = 255 - (4 * lane + j); rem = krem - cum; found = true; } if (!found) cum += c4[j]; }
                        sh[8] = bsel; sh[9] = rem;
                    }
                }
                __syncthreads();
                prefix |= ((unsigned)sh[8]) << (8 * pass); krem = sh[9];
            }
            const unsigned thr = prefix;
            int ce = 0;
            for (int i = 0; i < 16; ++i) { const unsigned k = keys[tid * 16 + i]; ce += (k == thr); }
            int tot;
            const int eqbase = block_exscan(ce, sh, &tot);
            int eqr = eqbase, cs = 0;
            for (int i = 0; i < 16; ++i) { const unsigned k = keys[tid * 16 + i]; const bool sel = (k > thr) || (k == thr && eqr < krem); eqr += (k == thr); cs += sel; }
            const int sbase = block_exscan(cs, sh, &tot);
            int slot = sbase; eqr = eqbase;
            for (int i = 0; i < 16; ++i) {
                const int s = tid * 16 + i; const unsigned k = keys[s];
                const bool sel = (k > thr) || (k == thr && eqr < krem); eqr += (k == thr);
                if (sel) { TOK[eb * CAP + slot] = b * S + s; GATE[eb * CAP + slot] = __uint_as_float(k); SLOT[(size_t)(b * S + s) * NE + e] = eb * CAP + slot; ++slot; }
            }
        }
    }
    SEAM(ph); ++ph;
    if (IN(ph)) REP_LOOP {
        for (int r = gw; r < NB * NE * CAP; r += ngw) {
            int rv_ = r; asm volatile("" : "+v"(rv_));
            if constexpr (layer == 1 || F8L0) {
                const v4u* srcp = (const v4u*)(H + (size_t)TOK[rv_] * D) + 2 * lane; const v4u x0 = srcp[0], x1 = srcp[1];
                v4u o;
                o.x = pk4_fp8(bflo(x0.x) * ASC8, bfhi(x0.x) * ASC8, bflo(x0.y) * ASC8, bfhi(x0.y) * ASC8); o.y = pk4_fp8(bflo(x0.z) * ASC8, bfhi(x0.z) * ASC8, bflo(x0.w) * ASC8, bfhi(x0.w) * ASC8);
                o.z = pk4_fp8(bflo(x1.x) * ASC8, bfhi(x1.x) * ASC8, bflo(x1.y) * ASC8, bfhi(x1.y) * ASC8); o.w = pk4_fp8(bflo(x1.z) * ASC8, bfhi(x1.z) * ASC8, bflo(x1.w) * ASC8, bfhi(x1.w) * ASC8);
                ((v4u*)((unsigned char*)XE + (size_t)r * D))[lane] = o;
            } else {
                const v4u* srcp = (const v4u*)(H + (size_t)TOK[rv_] * D); v4u* dst = (v4u*)(XE + (size_t)r * D);
                dst[lane] = srcp[lane]; dst[lane + 64] = srcp[lane + 64];
            }
        }
    }
    SEAM(ph); ++ph;
    if (IN(ph)) {
        MoeOrder So{(int)gridDim.x, (int)blockIdx.x, 16 * 22, 22};
        if constexpr (layer == 1 || F8L0) {
            int Kg = D / 2; asm volatile("" : "+s"(Kg));
            pg8::Gemm g{XE, (const bf16_t*)(ws + WS_WGU8 + (size_t)layer * 176 * MiB), NB * NE * CAP, NE * 5632, Kg};
            pg8::gemm_phase<EpiSiluMul8, MoeOrder, false, true>(ldsp, g, So, EpiSiluMul8{(unsigned char*)HID}, nullptr);
        } else {
            pg8::Gemm g{XE, (const bf16_t*)(ws + WS_WGU) + (size_t)layer * NE * 5632 * D, NB * NE * CAP, NE * 5632, D};
            pg8::gemm_phase<EpiSiluMul, MoeOrder, false>(ldsp, g, So, EpiSiluMul{HID}, nullptr);
        }
    }
    SEAM(ph); ++ph;
    if (IN(ph)) {
        MoeOrder So{(int)gridDim.x, (int)blockIdx.x, 16 * 4, 4};
        if constexpr (layer == 1 || F8L0) {
            int Kg = DE / 2; asm volatile("" : "+s"(Kg));
            pg8::Gemm g{HID, (const bf16_t*)(ws + WS_WD8 + (size_t)layer * 88 * MiB), NB * NE * CAP, NE * D, Kg};
            pg8::gemm_phase<EpiYE8, MoeOrder, false, true>(ldsp, g, So, EpiYE8{GATE, YE}, nullptr);
        } else {
            pg8::Gemm g{HID, (const bf16_t*)(ws + WS_WD) + (size_t)layer * NE * D * DE, NB * NE * CAP, NE * D, DE};
            pg8::gemm_phase<EpiYE, MoeOrder, false>(ldsp, g, So, EpiYE{GATE, YE}, nullptr);
        }
    }
    SEAM(ph); ++ph;
    return ph;
}

__global__ void __launch_bounds__(NTH, 2) mega(Args a) {
    extern __shared__ __attribute__((aligned(16))) unsigned char lds_raw[];
    unsigned* ctl = (unsigned*)(a.ws + WS_CTL);
    volatile LAS unsigned* bst = (volatile LAS unsigned*)((LAS unsigned char*)lds_raw + LDS_BAR_OFF);
    { const int t0_ = tidx(); if (t0_ < 4) bst[t0_] = 0u; }
    __syncthreads();
    XcdBarrier bar; bar.bar = ctl + CW_BAR; bar.x = 0; bar.st = bst;
    if (a.hi - a.lo > 1) bar = xcd_barrier_post(ctl + CW_BAR, bst);
    PROLOG

    int ph = 0;
    if (IN(ph)) REP_LOOP {
        for (int i = gt; i < S * 32; i += ngt) {
            const int s = i >> 5, f = i & 31;
            const float pw = (float)exp((double)((float)(2 * f) / 64.0f) * 9.210340371976184);
            const float invf = 1.0f / pw;
            const float angf = (float)s * invf;
            double xx = (double)angf;
            const double n = rint(xx * 0.15915494309189535);
            xx = (xx - n * 6.283185307179586) - n * 2.4492935982947064e-16;
            const double x2 = xx * xx;
            double cs = 1.0, sn = xx, tc = 1.0, tsn = xx;
#pragma unroll 1
            for (int k = 1; k <= 16; ++k) { tc *= -x2 / (double)((2 * k - 1) * (2 * k)); tsn *= -x2 / (double)((2 * k) * (2 * k + 1)); cs += tc; sn += tsn; }
            ropec[i] = (float)cs; ropes[i] = (float)sn;
        }
        rmsnorm_rows_bf16(x_in, a.in[2], H, T);
        rmsnorm_rows_bf16(mem, a.in[25], MN, NB * MEM); rmsnorm_rows_bf16(mem, a.in[25] + D, MN + NB * MEM * D, NB * MEM);
        LAS float* scr = (LAS float*)((LAS unsigned char*)lds_raw + wave * 16896);
        auto ident = [](int n) { return n; };
        auto emap = [](int n) { const bool il = (n < 1024) || (n >= 1536 && n < 2176); const int j = n & 63; return il ? ((n & ~63) + (j < 32 ? 2 * j : 2 * (j - 32) + 1)) : n; };
        for (int it = gw; it < 16 * 36; it += ngw) transpose_item(a.in[3], D, EVEN_IN, (bf16_t*)(ws + WS_WEIN), emap, scr, it, lane);
        for (int it = gw; it < 2 * 16 * 32; it += ngw) { const int l = it / 512, r = it % 512; transpose_item(a.in[27] + (size_t)l * D * 2048, D, 2048, (bf16_t*)(ws + WS_WKV) + (size_t)l * 2048 * D, ident, scr, r, lane); }
        { float* WRT = (float*)(ws + WS_WRT);
          for (int i = gt; i < 2 * NE * D; i += ngt) { const int l = i >> 14, e = (i >> 10) & 15, k = i & 1023; WRT[i] = a.in[29][l * D + k] * a.in[30][((size_t)l * D + k) * NE + e]; } }
        { bf16_t* Wsb = (bf16_t*)(ws + WS_WSB); const float* wsp = a.in[10];
          for (int i = gt; i < 4 * 128 * 128; i += ngt) Wsb[i] = (bf16_t)f2bf(wsp[i]);
          bf16_t* WL = (bf16_t*)(ws + WS_WL); const float *w2 = a.in[14], *a2 = a.in[16], *g2 = a.in[17];
          for (int i = gt; i < 4 * 512 * 64 + 512 * 128; i += ngt) { float v;
              if (i < 4 * 512 * 64) { const int sec = i >> 15, n = (i >> 6) & 511, k = i & 63; v = (sec < 2 ? w2 : a2)[(size_t)((sec & 1) * 64 + k) * 512 + n]; }
              else { const int j = i - 4 * 512 * 64, n = j >> 7, k = j & 127; v = g2[(size_t)k * 512 + n]; }
              WL[i] = (bf16_t)f2bf(v); } }
        auto gmap = [](int n) { return (n >> 7) * 256 + (n & 127); };
        auto umap = [](int n) { return (n >> 7) * 256 + 128 + (n & 127); };
    }
    SEAM(ph); ++ph;

    if (IN(ph)) dense_gemm(ldsp, H, (const bf16_t*)(ws + WS_WEIN), T, EVEN_IN, D,
                           EpiEven{ropec, ropes, (bf16_t*)(ws + WS_QHA), (bf16_t*)(ws + WS_KHA), (bf16_t*)(ws + WS_QHB), (bf16_t*)(ws + WS_KHB), (bf16_t*)(ws + WS_VTA), (bf16_t*)(ws + WS_VTB)});
    if (IN(ph)) {
        dense_gemm(ldsp, MN, (const bf16_t*)(ws + WS_WKV), NB * MEM, 2048, D, EpiKV{KV, KV + 512 * 1024}, 192);
        dense_gemm(ldsp, MN + NB * MEM * D, (const bf16_t*)(ws + WS_WKV) + (size_t)2048 * D, NB * MEM, 2048, D, EpiKV{KV + 1024 * 1024, KV + 1024 * 1024 + 512 * 1024}, 176);
        if (bid >= 96) {
            __syncthreads();
            LAS float* scr = (LAS float*)((LAS unsigned char*)lds_raw + wave * 16896);
            const int gw3 = (bid - 96) * 8 + wave, ngw3 = (nb - 96) * 8;
            auto ident = [](int n) { return n; };
            auto gmap = [](int n) { return (n >> 7) * 256 + (n & 127); };
        for (int it = gw3; it < 16 * 16; it += ngw3) transpose_item(a.in[5], D, D, (bf16_t*)(ws + WS_WEOUT), ident, scr, it, lane);
        for (int it = gw3; it < 16 * 46; it += ngw3) transpose_item(a.in[7], D, ODD_IN, (bf16_t*)(ws + WS_WOIN), ident, scr, it, lane);
        for (int it = gw3; it < 16 * 16; it += ngw3) transpose_item(a.in[23], D, D, (bf16_t*)(ws + WS_WOOUT), ident, scr, it, lane);
        for (int it = gw3; it < 2 * 16 * 16; it += ngw3) { const int l = it / 256, r = it % 256; transpose_item(a.in[26] + (size_t)l * D * D, D, D, (bf16_t*)(ws + WS_WQ) + (size_t)l * D * D, ident, scr, r, lane, a.in[24] + l * D); }
        for (int it = gw3; it < 2 * 16 * 16; it += ngw3) { const int l = it / 256, r = it % 256; transpose_item(a.in[28] + (size_t)l * D * D, D, D, (bf16_t*)(ws + WS_WO) + (size_t)l * D * D, ident, scr, r, lane); }
            for (int it = gw3; it < 4096; it += ngw3) { const int mt = it / 704, r = it % 704;
                if constexpr (F8L0) transpose_item_fp8(a.in[31] + (size_t)mt * D * DE, D, DE, ws + WS_WGU8 + (size_t)mt * 5632 * D, gmap, GUSC8, scr, r, lane);
                else transpose_item(a.in[31] + (size_t)mt * D * DE, D, DE, (bf16_t*)(ws + WS_WGU) + (size_t)mt * 5632 * D, gmap, scr, r, lane); }
        }
    }
    SEAM(ph); ++ph;
    if (IN(ph)) REP_LOOP attn_phase_even((const bf16_t*)(ws + WS_QHA), (const bf16_t*)(ws + WS_KHA), (const bf16_t*)(ws + WS_VTA), (const bf16_t*)(ws + WS_QHB), (const bf16_t*)(ws + WS_KHB),
                                (const bf16_t*)(ws + WS_VTB), a.in[4], (bf16_t*)(ws + WS_OA), (float*)(ws + WS_LSE), Y, lds_raw);
    SEAM(ph); ++ph;
    if (IN(ph)) REP_LOOP attn_combine((const bf16_t*)(ws + WS_OA), (const float*)(ws + WS_LSE), Y);
    SEAM(ph); ++ph;
    if (IN(ph)) dense_gemm(ldsp, Y, (const bf16_t*)(ws + WS_WEOUT), T, D, D, EpiResidN{x_in, X, H, (float*)(ws + WS_SSP)});
    SEAM(ph); ++ph;

    ph = tail_phases<0>(a, bar, lds_raw, ph);
    ph = odd_phases(a, bar, lds_raw, ph);
    ph = tail_phases<1>(a, bar, lds_raw, ph);

    if (IN(ph)) combine_norm<true>(X, YE, SLOT, a.in[34], nullptr, a.out);
    ++ph;
}
constexpr int NPHASES = 1 + 4 + 2 * 7 + 8 + 1;
#undef IN
#undef SEAM
}

extern "C" void kernel_launch(void* const* d_in, const int* in_sizes, int n_in, void* d_out, int out_size, void* d_ws, size_t ws_size, hipStream_t stream) {
    static int grid = 0;
    if (grid == 0) {
        if (n_in != 35 || out_size != T * D || ws_size < WS_END) { fprintf(stderr, "kernel_launch: unexpected shapes n_in %d out %d ws %zu (need %zu)\n", n_in, out_size, ws_size, (size_t)WS_END); grid = -1; return; }
        int dev = 0, cus = 0, per_cu = 0;
        (void)hipGetDevice(&dev); (void)hipDeviceGetAttribute(&cus, hipDeviceAttributeMultiprocessorCount, dev);
        if (hipFuncSetAttribute((const void*)mega, hipFuncAttributeMaxDynamicSharedMemorySize, LDS_BYTES) != hipSuccess) { fprintf(stderr, "hipFuncSetAttribute failed\n"); grid = -1; return; }
        if (hipOccupancyMaxActiveBlocksPerMultiprocessor(&per_cu, (const void*)mega, NTH, LDS_BYTES) != hipSuccess || per_cu < 1) fprintf(stderr, "occupancy query: %d\n", per_cu);
        (void)hipGetLastError();
        grid = cus > 0 ? cus : 256;
    }
    if (grid < 0) return;
    (void)hipMemsetAsync((char*)d_ws + WS_CTL, 0, CTL_BYTES, stream);
    Args a{};
    for (int i = 0; i < 35; ++i) a.in[i] = (const float*)d_in[i];
    a.out = (float*)d_out; a.ws = (unsigned char*)d_ws;
#if MK_MULTI
    for (int k = 0; k < NPHASES; ++k) { a.lo = k; a.hi = k + 1; hipLaunchKernelGGL(mega, dim3(grid), dim3(NTH), LDS_BYTES, stream, a); }
#else
    a.lo = 0; a.hi = NPHASES; hipLaunchKernelGGL(mega, dim3(grid), dim3(NTH), LDS_BYTES, stream, a);
#endif
}
```

```cpp
#include <hip/hip_runtime.h>
#include <cstdio>
#include <cstdint>

#ifndef PROBE_PHASE
#define PROBE_PHASE (-1)
#endif
#ifndef PROBE_REP
#define PROBE_REP 1
#endif
#ifndef MK_MULTI
#define MK_MULTI 0
#endif

__device__ __forceinline__ int tidx() { int t = threadIdx.x; asm volatile("" : "+v"(t)); return t; }
namespace pg8 {
#define PG8_LAS __attribute__((address_space(3)))
typedef unsigned short bf16_t;
typedef short bf16x8 __attribute__((ext_vector_type(8)));
typedef float f32x4 __attribute__((ext_vector_type(4)));
typedef unsigned u32x4 __attribute__((ext_vector_type(4)));
constexpr int BM = 256, BK = 64, HALF = 128, HTB = HALF * BK * 2  , STAGE_BYTES = 8 * HTB, NXCD = 8, WGM = 8;

__host__ __device__ __forceinline__ int lds_byte(int r, int c) { const int st = (r >> 4) * 2 + (c >> 5), rr = r & 15, cc = c & 31, ob = rr * 64 + cc * 2; return st * 1024 + (ob ^ (((ob >> 9) & 1) << 5)); }
__host__ __device__ __forceinline__ void stage_rc(int b, int& R, int& C) { const int st = b / 1024, sb = b % 1024, swz = sb ^ (((sb >> 9) & 1) << 5); R = (st >> 1) * 16 + swz / 64; C = (st & 1) * 32 + (swz % 64) / 2; }
__host__ __device__ __forceinline__ int perm32(int rho) { const int n = rho >> 4, i = rho & 15; return 8 * (i >> 2) + 4 * n + (i & 3); }

struct Unit { int pm, pn; };
struct Gemm { const bf16_t* A; const bf16_t* Bt; int M, N, K; };

struct StaticOrder {
    int nM, nN, nwg, G, c;
    __host__ __device__ void init(int M, int N, int G_, int c_) { nM = M / BM; nN = N / BM; nwg = nM * nN; G = G_; c = c_; }
    __host__ __device__ bool next(int i, Unit& u) const {
        const long L = (long)i * G + c; if (L >= nwg) return false;
        int wgid = (int)L; { const int q = nwg / NXCD, r = nwg % NXCD, xcd = wgid % NXCD, off = wgid / NXCD; wgid = (xcd < r ? xcd * (q + 1) : r * (q + 1) + (xcd - r) * q) + off; }
        const int nig = WGM * nN, gid = wgid / nig, fm = gid * WGM, gsz = (nM - fm) < WGM ? (nM - fm) : WGM;
        u.pm = fm + ((wgid % nig) % gsz); u.pn = (wgid % nig) / gsz; return true;
    }
    __device__ __forceinline__ void a_ready(const Unit&) const {}
    __device__ __forceinline__ void done(const Unit&) const {}
};

typedef __bf16 bf16v2_t __attribute__((ext_vector_type(2)));
typedef float f32v2_t __attribute__((ext_vector_type(2)));
__device__ __forceinline__ unsigned cvt_pk_bf16(float lo, float hi) { const f32v2_t v = {lo, hi}; return __builtin_bit_cast(unsigned, __builtin_convertvector(v, bf16v2_t)); }
typedef int i32x8 __attribute__((ext_vector_type(8)));
template <bool F8> __device__ __forceinline__ f32x4 mma_tile(const bf16x8 (&bfr)[2], const bf16x8 (&afr)[2], f32x4 acc) {
    if constexpr (F8) {
        typedef int i32x4_ __attribute__((ext_vector_type(4)));
        const i32x4_ b0 = __builtin_bit_cast(i32x4_, bfr[0]), b1 = __builtin_bit_cast(i32x4_, bfr[1]), a0 = __builtin_bit_cast(i32x4_, afr[0]), a1 = __builtin_bit_cast(i32x4_, afr[1]);
        const i32x8 bb = {b0[0], b0[1], b0[2], b0[3], b1[0], b1[1], b1[2], b1[3]}, aa = {a0[0], a0[1], a0[2], a0[3], a1[0], a1[1], a1[2], a1[3]};
        const int sc1 = 0x7f7f7f7f;
        asm volatile("v_mfma_scale_f32_16x16x128_f8f6f4 %0, %1, %2, %0, %3, %3 op_sel_hi:[0,0,0]" : "+v"(acc) : "v"(bb), "v"(aa), "v"(sc1));
        return acc;
    } else {
        acc = __builtin_amdgcn_mfma_f32_16x16x32_bf16(bfr[0], afr[0], acc, 0, 0, 0);
        return __builtin_amdgcn_mfma_f32_16x16x32_bf16(bfr[1], afr[1], acc, 0, 0, 0);
    }
}
template <class Epi, class Sched, bool STAMP = false, bool F8 = false>
__device__ __forceinline__ void gemm_phase(PG8_LAS unsigned char* lds, const Gemm g, const Sched& S, const Epi& E, unsigned long long* stamps) {
    const int tid = ::tidx(), wid = __builtin_amdgcn_readfirstlane(tid >> 6), lane = tid & 63, wr = wid >> 2, wc = wid & 3, fr = lane & 15, fq = lane >> 4;
    const int K = g.K, nt = K / BK;
    int ts_lo = 0, ts_hi = 0, nts = 0; const unsigned long long rt_entry = STAMP ? (unsigned long long)wall_clock64() : 0ull;
#define PG8_STAMP() do { if (STAMP && wid == 0 && nts < 64) { const unsigned long long _c = (unsigned long long)clock64(); \
        ts_lo = (lane == nts) ? (int)(unsigned)_c : ts_lo; ts_hi = (lane == nts) ? (int)(unsigned)(_c >> 32) : ts_hi; ++nts; } } while (0)
    PG8_STAMP();
    unsigned voffA[2], voffB[2];
#pragma unroll
    for (int i = 0; i < 2; ++i) { int R, C; stage_rc(tid * 16 + i * 8192, R, C); const int Rb = Epi::PERM ? ((R & ~31) + perm32(R & 31)) : R;
        voffA[i] = (unsigned)(R * K + C) * 2u; voffB[i] = (unsigned)(Rb * K + C) * 2u; }
    const size_t kstep = (size_t)(BK * 2);
    const size_t hstep = (size_t)HALF * K * 2;
    const size_t tstep = 2 * hstep;
    const unsigned ldsw = (unsigned)wid * 1024u;
    const int aoff = lds_byte(wr * 64 + fr, fq * 8), boff = lds_byte(wc * 32 + fr, fq * 8);
#define PG8_SA(b, h) (((b) * 2 + (h)) * HTB)
#define PG8_SB(b, h) ((4 + (b) * 2 + (h)) * HTB)
#define PG8_STAGE(bufoff, gbase, voff) do { _Pragma("unroll") for (int _i = 0; _i < 2; ++_i) \
        __builtin_amdgcn_global_load_lds((const unsigned*)((const char*)(gbase) + (voff)[_i]), (PG8_LAS unsigned*)(lds + (bufoff) + ldsw + _i * 8192), 16, 0, 0); } while (0)
#define PG8_LDA(dst, b, h) do { _Pragma("unroll") for (int m = 0; m < 4; ++m) _Pragma("unroll") for (int k = 0; k < 2; ++k) dst[m][k] = *(const PG8_LAS bf16x8*)(lds + PG8_SA(b, h) + aoff + m * 2048 + k * 1024); } while (0)
#define PG8_LDB(dst, b, h) do { _Pragma("unroll") for (int n = 0; n < 2; ++n) _Pragma("unroll") for (int k = 0; k < 2; ++k) dst[n][k] = *(const PG8_LAS bf16x8*)(lds + PG8_SB(b, h) + boff + n * 2048 + k * 1024); } while (0)
#define PG8_MMA(ai, bj, At, Bt) do { __builtin_amdgcn_s_setprio(1); _Pragma("unroll") for (int m = 0; m < 4; ++m) _Pragma("unroll") for (int n = 0; n < 2; ++n) \
        acc[ai][bj][m][n] = mma_tile<F8>(Bt[n], At[m], acc[ai][bj][m][n]); __builtin_amdgcn_s_setprio(0); } while (0)
#define PG8_WAIT_V(n) asm volatile("s_waitcnt vmcnt(" #n ")" ::: "memory")
#define PG8_WAIT_L(n) asm volatile("s_waitcnt lgkmcnt(" #n ")" ::: "memory")
#define PG8_BAR __builtin_amdgcn_s_barrier()
#define PG8_SCHED __builtin_amdgcn_sched_barrier(0)
    Unit cur, nxt; int ui = 0;
    if (!S.next(0, cur)) return;
    f32x4 acc[2][2][4][2];
#pragma unroll
    for (int a = 0; a < 2; ++a)
#pragma unroll
        for (int b = 0; b < 2; ++b)
#pragma unroll
            for (int m = 0; m < 4; ++m)
#pragma unroll
                for (int n = 0; n < 2; ++n) acc[a][b][m][n] = (f32x4){0.f, 0.f, 0.f, 0.f};
    bf16x8 At[4][2], B0[2][2], B1[2][2];
    const char* cA = (const char*)g.A + (size_t)cur.pm * tstep; const char* cB = (const char*)g.Bt + (size_t)cur.pn * tstep;
    S.a_ready(cur);
    PG8_STAGE(PG8_SB(0, 0), cB, voffB); PG8_STAGE(PG8_SA(0, 0), cA, voffA); PG8_STAGE(PG8_SB(0, 1), cB + hstep, voffB); PG8_STAGE(PG8_SA(0, 1), cA + hstep, voffA);
    if (wr == 1) PG8_BAR;
    PG8_WAIT_V(4); PG8_BAR;
    PG8_STAGE(PG8_SB(1, 0), cB + kstep, voffB); PG8_STAGE(PG8_SA(1, 0), cA + kstep, voffA); PG8_STAGE(PG8_SB(1, 1), cB + hstep + kstep, voffB);
    PG8_WAIT_V(6); PG8_BAR;
    PG8_STAMP();
    for (;;) {
        const bool has_next = S.next(ui + 1, nxt);
        const char* nA = has_next ? (const char*)g.A + (size_t)nxt.pm * tstep : cA; const char* nB = has_next ? (const char*)g.Bt + (size_t)nxt.pn * tstep : cB;
        for (int t = 0; t < nt; t += 2) {
            const bool last = (t == nt - 2);
            const char* a1 = cA + (size_t)(t + 1) * kstep;
            const char* a2 = last ? nA : cA + (size_t)(t + 2) * kstep; const char* b2 = last ? nB : cB + (size_t)(t + 2) * kstep;
            const char* a3 = a2 + kstep; const char* b3 = b2 + kstep;
            if (last && has_next) S.a_ready(nxt);
            PG8_LDB(B0, 0, 0); PG8_SCHED; PG8_LDA(At, 0, 0); PG8_STAGE(PG8_SA(1, 1), a1 + hstep, voffA);
            PG8_WAIT_L(8); PG8_BAR; PG8_WAIT_L(0); PG8_MMA(0, 0, At, B0); PG8_BAR; PG8_SCHED;
            PG8_LDB(B1, 0, 1); PG8_STAGE(PG8_SB(0, 0), b2, voffB);
            PG8_BAR; PG8_WAIT_L(0); PG8_MMA(0, 1, At, B1); PG8_BAR;
            PG8_LDA(At, 0, 1); PG8_STAGE(PG8_SA(0, 0), a2, voffA);
            PG8_BAR; PG8_WAIT_L(0); PG8_MMA(1, 0, At, B0); PG8_BAR; PG8_SCHED;
            PG8_STAGE(PG8_SB(0, 1), b2 + hstep, voffB);
            PG8_WAIT_V(6); PG8_BAR; PG8_MMA(1, 1, At, B1); PG8_BAR;
            PG8_LDB(B0, 1, 0); PG8_SCHED; PG8_LDA(At, 1, 0); PG8_STAGE(PG8_SA(0, 1), a2 + hstep, voffA);
            PG8_WAIT_L(8); PG8_BAR; PG8_WAIT_L(0); PG8_MMA(0, 0, At, B0); PG8_BAR; PG8_SCHED;
            PG8_LDB(B1, 1, 1); PG8_STAGE(PG8_SB(1, 0), b3, voffB);
            PG8_BAR; PG8_WAIT_L(0); PG8_MMA(0, 1, At, B1); PG8_BAR;
            PG8_LDA(At, 1, 1); PG8_STAGE(PG8_SA(1, 0), a3, voffA);
            PG8_BAR; PG8_WAIT_L(0); PG8_MMA(1, 0, At, B0); PG8_BAR; PG8_SCHED;
            PG8_STAGE(PG8_SB(1, 1), b3 + hstep, voffB);
            PG8_WAIT_V(6); PG8_BAR; PG8_MMA(1, 1, At, B1); PG8_BAR;
        }
        PG8_STAMP();
        if constexpr (!Epi::AFTER_DRAIN) { E(acc, cur, wr, wc, fr, fq); S.done(cur); }
        PG8_STAMP();
        if (!has_next) break;
#pragma unroll
        for (int a = 0; a < 2; ++a)
#pragma unroll
            for (int b = 0; b < 2; ++b)
#pragma unroll
                for (int m = 0; m < 4; ++m)
#pragma unroll
                    for (int n = 0; n < 2; ++n) acc[a][b][m][n] = (f32x4){0.f, 0.f, 0.f, 0.f};
        cur = nxt; cA = nA; cB = nB; ++ui;
    }
    PG8_WAIT_V(0);
    if (wr == 0) PG8_BAR;
    PG8_BAR;
    if constexpr (Epi::AFTER_DRAIN) { E.fused(acc, cur, wr, wc, fr, fq, lds, wid, lane); S.done(cur); }
    PG8_STAMP();
    if (STAMP && wid == 0) { stamps[lane] = lane < nts ? (((unsigned long long)(unsigned)ts_hi << 32) | (unsigned)ts_lo) : 0ull;
        if (lane == 62) stamps[62] = rt_entry; if (lane == 63) stamps[63] = (unsigned long long)wall_clock64(); }
#undef PG8_STAMP
#undef PG8_SA
#undef PG8_SB
#undef PG8_STAGE
#undef PG8_LDA
#undef PG8_LDB
#undef PG8_MMA
#undef PG8_WAIT_V
#undef PG8_WAIT_L
#undef PG8_BAR
#undef PG8_SCHED
}
}


namespace {
using pg8::bf16_t; using pg8::f32x4;
constexpr int D = 1024, NB = 2, S = 8192, T = NB * S;
constexpr int EVEN_IN = 2304, ODD_IN = 2944, ODD_PAD = 3072, FD = 1920;
constexpr int MEM = 256, NE = 16, CAP = 1024, DE = 2816;
constexpr int NTH = 512;
constexpr size_t MiB = 1u << 20;
constexpr size_t WS_CTL = 0, CTL_BYTES = 1 * MiB;
constexpr size_t WS_ROPE = 1 * MiB;
constexpr size_t WS_AFF = 4 * MiB;
constexpr size_t WS_TOK = 5 * MiB;
constexpr size_t WS_GATE = 6 * MiB;
constexpr size_t WS_WRT = 3 * MiB;
constexpr size_t WS_SLOT = 7 * MiB;
constexpr size_t WS_X = 8 * MiB;
constexpr size_t WS_H = 72 * MiB;
constexpr size_t WS_Y = 104 * MiB;
constexpr size_t WS_P = 136 * MiB;
constexpr size_t WS_Q = 320 * MiB;
constexpr size_t WS_KV = 384 * MiB;
constexpr size_t WS_MN = 388 * MiB;
constexpr size_t WS_SSP = 390 * MiB;
constexpr size_t WS_DEC = 392 * MiB;
constexpr size_t WS_KD = 456 * MiB;
constexpr size_t WS_BB = 520 * MiB;
constexpr size_t WS_KK = 584 * MiB;
constexpr size_t WS_G = 616 * MiB;
constexpr size_t WS_YS = 648 * MiB;
constexpr size_t WS_RV = 712 * MiB;
constexpr size_t WS_VN = 776 * MiB;
constexpr size_t WS_QHA = 136 * MiB;
constexpr size_t WS_KHA = 152 * MiB;
constexpr size_t WS_QHB = 168 * MiB;
constexpr size_t WS_KHB = 184 * MiB;
constexpr size_t WS_PVB = 188 * MiB;
constexpr size_t WS_VTA = 208 * MiB;
constexpr size_t WS_VTB = 256 * MiB;
constexpr size_t WS_OA = 260 * MiB;
constexpr size_t WS_LSE = 308 * MiB;
constexpr size_t WS_QT = 136 * MiB;
constexpr size_t WS_YL = 200 * MiB;
constexpr size_t WS_PT = 264 * MiB;
constexpr size_t WS_RH = 296 * MiB;
constexpr size_t WS_S0 = 328 * MiB;
constexpr size_t WS_XE = 136 * MiB;
constexpr size_t WS_YE = 136 * MiB;
constexpr size_t WS_HID = 200 * MiB;
constexpr size_t WS_KB = 360 * MiB;
constexpr size_t WS_F5 = 792 * MiB;
constexpr size_t WS_WSB = 804 * MiB;
constexpr size_t WS_WL = 805 * MiB;
constexpr size_t WS_WEIN = 808 * MiB;
constexpr size_t WS_WEOUT = 813 * MiB;
constexpr size_t WS_WOIN = 815 * MiB;
constexpr size_t WS_WOOUT = 821 * MiB;
constexpr size_t WS_WQ = 823 * MiB;
constexpr size_t WS_WKV = 827 * MiB;
constexpr size_t WS_WO = 835 * MiB;
constexpr size_t WS_WGU = 840 * MiB;
constexpr size_t WS_WD = 1192 * MiB;
constexpr size_t WS_WGU8 = 840 * MiB;
constexpr size_t WS_WD8 = 1192 * MiB;
constexpr size_t WS_END = 1368 * MiB;
constexpr bool F8L0 = true;
constexpr float ASC8 = 16.f, GUSC8 = 128.f, HSC8 = 4.f, DSC8 = 256.f;
constexpr int CW_BAR = 4096;

constexpr int LDS_BYTES = 147456;
constexpr int LDS_BAR_OFF = LDS_BYTES - 64;

#define LAS __attribute__((address_space(3)))
#define XB_TMO      128
#define XB_XCNT(j)  (256  + 64 * (j))
#define XB_XSUB(j)  (1280 + 64 * (j))
#define XB_XGEN(j)  (2304 + 64 * (j))
#define XB_TOP      3328
#define XB_TOPGEN   3392
#define XCD_BAR_WORDS 3456
#define XB_SPIN_CAP (1u << 22)
__device__ __forceinline__ unsigned xb_ld(unsigned* p)              { return __hip_atomic_load(p, __ATOMIC_RELAXED, __HIP_MEMORY_SCOPE_AGENT); }
__device__ __forceinline__ unsigned xb_add(unsigned* p, unsigned v) { return __hip_atomic_fetch_add(p, v, __ATOMIC_RELAXED, __HIP_MEMORY_SCOPE_AGENT); }
__device__ __forceinline__ unsigned xb_xcc_id() { return (unsigned)__builtin_amdgcn_s_getreg((3 << 11) | 20) & 0xFu; }
#define XB_SPIN(cond, bar) do { unsigned _sp = 0; while (cond) { __builtin_amdgcn_s_sleep(1); \
    if ((++_sp & 255u) == 0u) { if (xb_ld(&(bar)[XB_TMO])) break; if (_sp > XB_SPIN_CAP) { atomicAdd(&(bar)[XB_TMO], 1u); break; } } } } while (0)
struct XcdBarrier { unsigned* bar; unsigned x; volatile LAS unsigned* st; };
__device__ __forceinline__ XcdBarrier xcd_barrier_post(unsigned* bar, volatile LAS unsigned* st) {
    XcdBarrier b; b.bar = bar; b.x = xb_xcc_id(); b.st = st;
    if (threadIdx.x == 0) (void)xb_add(&bar[XB_XCNT(b.x)], 1u);
    return b;
}
__device__ __forceinline__ void xcd_barrier_complete(unsigned* bar, unsigned x, unsigned& nloc, unsigned& nx) {
    const unsigned G = gridDim.x * gridDim.y * gridDim.z;
    unsigned sum, cnt, mine, sp = 0u;
    for (;;) {
        sum = 0u; cnt = 0u; mine = 0u;
#pragma unroll
        for (unsigned j = 0; j < 16; ++j) { const unsigned c = xb_ld(&bar[XB_XCNT(j)]); sum += c; cnt += (c > 0u) ? 1u : 0u; mine = (j == x) ? c : mine; }
        if (sum == G) break;
        __builtin_amdgcn_s_sleep(1);
        if ((++sp & 255u) == 0u) { if (xb_ld(&bar[XB_TMO])) break; if (sp > XB_SPIN_CAP) { atomicAdd(&bar[XB_TMO], 1u); break; } }
    }
    nloc = mine > 0u ? mine : 1u; nx = cnt > 0u ? cnt : 1u;
}
__device__ __forceinline__ void xcd_barrier(const XcdBarrier& b) {
    asm volatile("s_waitcnt vmcnt(0)" ::: "memory");
    __syncthreads();
    if (threadIdx.x == 0) {
        unsigned* bar = b.bar;
        __builtin_amdgcn_s_waitcnt(0);
        unsigned nloc = b.st[0], nx = b.st[1];
        if (nloc == 0u) { xcd_barrier_complete(bar, b.x, nloc, nx); b.st[0] = nloc; b.st[1] = nx; }
        const unsigned old = xb_add(&bar[XB_XSUB(b.x)], 1u);
        const unsigned gen = old / nloc;
        if (old + 1u == (gen + 1u) * nloc) {
            __builtin_amdgcn_fence(__ATOMIC_RELEASE, "agent");
            asm volatile("s_waitcnt vmcnt(0)" ::: "memory");
            const unsigned og = xb_add(&bar[XB_TOP], 1u);
            const unsigned tg = og / nx;
            if (og + 1u == (tg + 1u) * nx) xb_add(&bar[XB_TOPGEN], 1u);
            else XB_SPIN(xb_ld(&bar[XB_TOPGEN]) == tg, bar);
            __builtin_amdgcn_fence(__ATOMIC_ACQUIRE, "agent");
            xb_add(&bar[XB_XGEN(b.x)], 1u);
            asm volatile("s_waitcnt vmcnt(0)" ::: "memory");
        } else {
            XB_SPIN(xb_ld(&bar[XB_XGEN(b.x)]) == gen, bar);
            __builtin_amdgcn_fence(__ATOMIC_ACQUIRE, "agent");
            asm volatile("s_waitcnt vmcnt(0)" ::: "memory");
        }
    }
    __syncthreads();
}

__device__ __forceinline__ float wave_sum(float v) {
#pragma unroll
    for (int o = 32; o >= 1; o >>= 1) v += __shfl_xor(v, o);
    return v;
}
__device__ __forceinline__ float frcp(float x) { return __builtin_amdgcn_rcpf(x); }
__device__ __forceinline__ float sigmoidf_(float x) { return frcp(1.0f + __expf(-x)); }
__device__ __forceinline__ float tanhf_(float x) { return 2.0f * sigmoidf_(2.0f * x) - 1.0f; }
__device__ __forceinline__ float gelu_tanh(float x) { return x * sigmoidf_(1.5957691216057308f * (x + 0.044715f * x * x * x)); }
__device__ __forceinline__ unsigned f2bf(float f) { unsigned u = __builtin_bit_cast(unsigned, f); return (u + 0x7fffu + ((u >> 16) & 1u)) >> 16; }
__device__ __forceinline__ unsigned pk2(float lo, float hi) { return pg8::cvt_pk_bf16(lo, hi); }
__device__ __forceinline__ float bflo(unsigned w) { return __uint_as_float(w << 16); }
__device__ __forceinline__ float bfhi(unsigned w) { return __uint_as_float(w & 0xffff0000u); }
typedef unsigned v4u __attribute__((ext_vector_type(4)));
typedef unsigned v2u __attribute__((ext_vector_type(2)));

struct Args { const float* in[35]; float* out; unsigned char* ws; int lo, hi; };

struct EpiF32Store {
    static constexpr bool PERM = false, AFTER_DRAIN = false;
    float* C; int ldc; int nvalid;
    __device__ __forceinline__ void operator()(const f32x4 (&acc)[2][2][4][2], const pg8::Unit& u, int wr, int wc, int fr, int fq) const {
        const int row0 = u.pm * 256 + wr * 64 + fr, col0 = u.pn * 256 + wc * 32 + 4 * fq;
#pragma unroll
        for (int ai = 0; ai < 2; ++ai)
#pragma unroll
            for (int m = 0; m < 4; ++m) { float* rowp = C + (size_t)(row0 + ai * 128 + m * 16) * ldc + col0;
#pragma unroll
                for (int bj = 0; bj < 2; ++bj)
#pragma unroll
                    for (int n = 0; n < 2; ++n) if (col0 + bj * 128 + n * 16 < nvalid) *(f32x4*)(rowp + bj * 128 + n * 16) = acc[ai][bj][m][n]; }
    }
};
struct EpiResid {
    static constexpr bool PERM = false, AFTER_DRAIN = false;
    const float* base; float* out;
    __device__ __forceinline__ void operator()(const f32x4 (&acc)[2][2][4][2], const pg8::Unit& u, int wr, int wc, int fr, int fq) const {
        const int row0 = u.pm * 256 + wr * 64 + fr, col0 = u.pn * 256 + wc * 32 + 4 * fq;
#pragma unroll
        for (int ai = 0; ai < 2; ++ai)
#pragma unroll
            for (int m = 0; m < 4; ++m) { const size_t off = (size_t)(row0 + ai * 128 + m * 16) * D + col0;
#pragma unroll
                for (int bj = 0; bj < 2; ++bj)
#pragma unroll
                    for (int n = 0; n < 2; ++n) { const f32x4 b = *(const f32x4*)(base + off + bj * 128 + n * 16); *(f32x4*)(out + off + bj * 128 + n * 16) = b + acc[ai][bj][m][n]; } }
    }
};
struct EpiSiluMul {
    static constexpr bool PERM = false, AFTER_DRAIN = false;
    bf16_t* HIDp;
    __device__ __forceinline__ void operator()(const f32x4 (&acc)[2][2][4][2], const pg8::Unit& u, int wr, int wc, int fr, int fq) const {
        const int pnl = u.pn % 22;
        const int row0 = u.pm * 256 + wr * 64 + fr, col0 = pnl * 128 + wc * 32 + 4 * fq;
#pragma unroll
        for (int ai = 0; ai < 2; ++ai)
#pragma unroll
            for (int m = 0; m < 4; ++m) { bf16_t* rowp = HIDp + (size_t)(row0 + ai * 128 + m * 16) * DE + col0;
#pragma unroll
                for (int n = 0; n < 2; ++n) { const f32x4 g = acc[ai][0][m][n], up = acc[ai][1][m][n]; float h[4];
#pragma unroll
                    for (int j = 0; j < 4; ++j) h[j] = g[j] * frcp(1.0f + __expf(-g[j])) * up[j];
                    v2u w; w.x = pk2(h[0], h[1]); w.y = pk2(h[2], h[3]); *(v2u*)(rowp + n * 16) = w; } }
    }
};
struct EpiYE {
    static constexpr bool PERM = true, AFTER_DRAIN = false;
    const float* GATE; bf16_t* YE;
    __device__ __forceinline__ void operator()(const f32x4 (&acc)[2][2][4][2], const pg8::Unit& u, int wr, int wc, int fr, int fq) const {
        const int pnl = u.pn & 3;
        const int row0 = u.pm * 256 + wr * 64 + fr, col0 = pnl * 256 + wc * 32 + 8 * fq;
#pragma unroll
        for (int ai = 0; ai < 2; ++ai)
#pragma unroll
            for (int m = 0; m < 4; ++m) { const int row = row0 + ai * 128 + m * 16; const float gt_ = GATE[row]; bf16_t* rowp = YE + (size_t)row * D + col0;
#pragma unroll
                for (int bj = 0; bj < 2; ++bj) { const f32x4 v0 = acc[ai][bj][m][0] * gt_, v1 = acc[ai][bj][m][1] * gt_;
                    v4u w; w.x = pg8::cvt_pk_bf16(v0[0], v0[1]); w.y = pg8::cvt_pk_bf16(v0[2], v0[3]); w.z = pg8::cvt_pk_bf16(v1[0], v1[1]); w.w = pg8::cvt_pk_bf16(v1[2], v1[3]);
                    *(v4u*)(rowp + bj * 128) = w; } }
    }
};
struct EpiBf16Store {
    static constexpr bool PERM = true, AFTER_DRAIN = false;
    bf16_t* O; int ldc; float scale;
    __device__ __forceinline__ void operator()(const f32x4 (&acc)[2][2][4][2], const pg8::Unit& u, int wr, int wc, int fr, int fq) const {
        const int row0 = u.pm * 256 + wr * 64 + fr, col0 = u.pn * 256 + wc * 32 + 8 * fq;
#pragma unroll
        for (int ai = 0; ai < 2; ++ai)
#pragma unroll
            for (int m = 0; m < 4; ++m) { bf16_t* rowp = O + (size_t)(row0 + ai * 128 + m * 16) * ldc + col0;
#pragma unroll
                for (int bj = 0; bj < 2; ++bj) { const f32x4 v0 = acc[ai][bj][m][0] * scale, v1 = acc[ai][bj][m][1] * scale;
                    v4u w; w.x = pg8::cvt_pk_bf16(v0[0], v0[1]); w.y = pg8::cvt_pk_bf16(v0[2], v0[3]); w.z = pg8::cvt_pk_bf16(v1[0], v1[1]); w.w = pg8::cvt_pk_bf16(v1[2], v1[3]);
                    *(v4u*)(rowp + bj * 128) = w; } }
    }
};
struct EpiKV {
    static constexpr bool PERM = false, AFTER_DRAIN = false;
    bf16_t* K; bf16_t* Vt;
    __device__ __forceinline__ void operator()(const f32x4 (&acc)[2][2][4][2], const pg8::Unit& u, int wr, int wc, int fr, int fq) const {
        const int row0 = u.pm * 256 + wr * 64 + fr, col0 = u.pn * 256 + wc * 32 + 4 * fq;
#pragma unroll
        for (int ai = 0; ai < 2; ++ai)
#pragma unroll
            for (int m = 0; m < 4; ++m) { const int row = row0 + ai * 128 + m * 16;
#pragma unroll
                for (int bj = 0; bj < 2; ++bj)
#pragma unroll
                    for (int n = 0; n < 2; ++n) { const int col = col0 + bj * 128 + n * 16; const f32x4 v = acc[ai][bj][m][n];
                        if (col < 1024) { v2u w; w.x = pk2(v[0], v[1]); w.y = pk2(v[2], v[3]); *(v2u*)(K + (size_t)row * 1024 + col) = w; }
                        else { const int b = row >> 8, mm = row & 255; bf16_t* vp = Vt + ((size_t)(b * 1024 + (col - 1024)) * 256 + mm);
#pragma unroll
                            for (int j = 0; j < 4; ++j) vp[(size_t)j * 256] = (bf16_t)f2bf(v[j]); } } }
    }
};

constexpr float QSCALE = 0.125f * 1.4426950408889634f;
struct EpiEven {
    static constexpr bool PERM = true, AFTER_DRAIN = false;
    const float* rc; const float* rs; bf16_t* QhA; bf16_t* KhA; bf16_t* QhB; bf16_t* KhB; bf16_t* VhA; bf16_t* VhB;
    __device__ __forceinline__ void operator()(const f32x4 (&acc)[2][2][4][2], const pg8::Unit& u, int wr, int wc, int fr, int fq) const {
        asm volatile("" : "+v"(fr), "+v"(fq));
        const int row0 = u.pm * 256 + wr * 64 + fr;
#pragma unroll
        for (int bj = 0; bj < 2; ++bj) {
            const int c0 = u.pn * 256 + bj * 128 + wc * 32 + 8 * fq;
            int kind; bf16_t* base; int stride; float sc = 1.0f;
            if (c0 < 512) { kind = 0; base = QhA + ((size_t)(c0 >> 6) * T) * 64 + (c0 & 63); stride = 64; sc = QSCALE; }
            else if (c0 < 1024) { kind = 0; base = KhA + ((size_t)((c0 - 512) >> 6) * T) * 64 + (c0 & 63); stride = 64; }
            else if (c0 < 1536) { kind = 1; base = VhA + ((size_t)((c0 - 1024) >> 6) * T) * 64 + (c0 & 63); stride = 64; }
            else if (c0 < 2048) { kind = 0; base = QhB + ((size_t)((c0 - 1536) >> 6) * T) * 64 + (c0 & 63); stride = 64; sc = QSCALE; }
            else if (c0 < 2176) { kind = 0; base = KhB + ((size_t)((c0 - 2048) >> 6) * T) * 64 + (c0 & 63); stride = 64; }
            else { kind = 1; base = VhB + ((size_t)((c0 - 2176) >> 6) * T) * 64 + (c0 & 63); stride = 64; }
            const int pi = (c0 & 63) >> 1;
#pragma unroll
            for (int ai = 0; ai < 2; ++ai)
#pragma unroll
                for (int m = 0; m < 4; ++m) {
                    const int tok = row0 + ai * 128 + m * 16;
                    const f32x4 v0 = acc[ai][bj][m][0], v1 = acc[ai][bj][m][1];
                    float y[8];
                    if (kind == 0) {
                        const int s = tok & (S - 1);
                        const f32x4 c4 = *(const f32x4*)(rc + s * 32 + pi), s4 = *(const f32x4*)(rs + s * 32 + pi);
                        y[0] = (v0[0] * c4[0] - v0[1] * s4[0]) * sc; y[1] = (v0[1] * c4[0] + v0[0] * s4[0]) * sc;
                        y[2] = (v0[2] * c4[1] - v0[3] * s4[1]) * sc; y[3] = (v0[3] * c4[1] + v0[2] * s4[1]) * sc;
                        y[4] = (v1[0] * c4[2] - v1[1] * s4[2]) * sc; y[5] = (v1[1] * c4[2] + v1[0] * s4[2]) * sc;
                        y[6] = (v1[2] * c4[3] - v1[3] * s4[3]) * sc; y[7] = (v1[3] * c4[3] + v1[2] * s4[3]) * sc;
                    } else { y[0] = v0[0]; y[1] = v0[1]; y[2] = v0[2]; y[3] = v0[3]; y[4] = v1[0]; y[5] = v1[1]; y[6] = v1[2]; y[7] = v1[3]; }
                    v4u w; w.x = pk2(y[0], y[1]); w.y = pk2(y[2], y[3]); w.z = pk2(y[4], y[5]); w.w = pk2(y[6], y[7]);
                    *(v4u*)(base + (size_t)tok * stride) = w;
                }
        }
    }
};

struct EpiLora {
    static constexpr bool PERM = false, AFTER_DRAIN = false;
    const float *w0, *a0, *k_a; const bf16_t *KB, *KK; bf16_t *LW, *KD, *BB, *G;
    __device__ __forceinline__ void operator()(const f32x4 (&acc)[2][2][4][2], const pg8::Unit& u, int wr, int wc, int fr, int fq) const {
        asm volatile("" : "+v"(fr), "+v"(fq));
        const int row0 = u.pm * 256 + wr * 64 + fr;
#pragma unroll
        for (int bj = 0; bj < 2; ++bj)
#pragma unroll
            for (int n = 0; n < 2; ++n) {
                const int c0 = u.pn * 256 + bj * 128 + wc * 32 + n * 16 + 4 * fq, sec = c0 >> 9, cc = c0 & 511;
#pragma unroll
                for (int ai = 0; ai < 2; ++ai)
#pragma unroll
                    for (int m = 0; m < 4; ++m) {
                        const size_t tok = row0 + ai * 128 + m * 16;
                        const f32x4 v = acc[ai][bj][m][n];
                        if (sec < 2) {
                            const f32x4 w = *(const f32x4*)(w0 + sec * 512 + cc); float o[4];
#pragma unroll
                            for (int j = 0; j < 4; ++j) { const float xw = -(w[j] + v[j]);
                                o[j] = -0.6065306597126334f * frcp(1.0f + __expf(xw)); }
                            v2u ww; ww.x = pk2(o[0], o[1]); ww.y = pk2(o[2], o[3]);
                            *(v2u*)(LW + ((size_t)sec * T + tok) * 512 + cc) = ww;
                        } else if (sec < 4) {
                            const int d = sec - 2;
                            const f32x4 a_ = *(const f32x4*)(a0 + d * 512 + cc), ka = *(const f32x4*)(k_a + cc);
                            const v2u kw = *(const v2u*)(KB + tok * 512 + cc), kkw = *(const v2u*)(KK + tok * 512 + cc);
                            const float kv[4] = {bflo(kw.x), bfhi(kw.x), bflo(kw.y), bfhi(kw.y)}, kk[4] = {bflo(kkw.x), bfhi(kkw.x), bflo(kkw.y), bfhi(kkw.y)};
                            float okd[4], obb[4];
#pragma unroll
                            for (int j = 0; j < 4; ++j) { const float alr = frcp(1.0f + __expf(-(a_[j] + v[j]))); okd[j] = kv[j] * (1.0f + (alr - 1.0f) * ka[j]); obb[j] = kk[j] * alr; }
                            v2u w1, w2_; w1.x = pk2(okd[0], okd[1]); w1.y = pk2(okd[2], okd[3]); w2_.x = pk2(obb[0], obb[1]); w2_.y = pk2(obb[2], obb[3]);
                            *(v2u*)(KD + ((size_t)d * T + tok) * 512 + cc) = w1; *(v2u*)(BB + ((size_t)d * T + tok) * 512 + cc) = w2_;
                        } else { v2u ww; ww.x = pk2(v[0], v[1]); ww.y = pk2(v[2], v[3]); *(v2u*)(G + tok * 512 + cc) = ww; }
                        __builtin_amdgcn_sched_barrier(0);
                    }
            }
    }
};

__device__ __forceinline__ float clamp8(float x) { return __builtin_amdgcn_fmed3f(x, -448.f, 448.f); }
__device__ __forceinline__ unsigned pk4_fp8(float a, float b, float c, float d) {
    int w = 0; w = __builtin_amdgcn_cvt_pk_fp8_f32(clamp8(a), clamp8(b), w, false); w = __builtin_amdgcn_cvt_pk_fp8_f32(clamp8(c), clamp8(d), w, true); return (unsigned)w;
}
struct EpiSiluMul8 {
    static constexpr bool PERM = true, AFTER_DRAIN = false;
    unsigned char* HIDp;
    __device__ __forceinline__ void operator()(const f32x4 (&acc)[2][2][4][2], const pg8::Unit& u, int wr, int wc, int fr, int fq) const {
        asm volatile("s_nop 7\n\ts_nop 7\n\ts_nop 7"); __builtin_amdgcn_sched_barrier(0);
        const int pnl = u.pn % 22;
        const int row0 = u.pm * 256 + wr * 64 + fr, col0 = pnl * 128 + wc * 32 + 8 * fq;
        const float s1 = 1.0f / (ASC8 * GUSC8);
#pragma unroll
        for (int ai = 0; ai < 2; ++ai)
#pragma unroll
            for (int m = 0; m < 4; ++m) { unsigned char* rowp = HIDp + (size_t)(row0 + ai * 128 + m * 16) * DE + col0; float h[8];
#pragma unroll
                for (int n = 0; n < 2; ++n) { const f32x4 g = acc[ai][0][m][n] * s1, up = acc[ai][1][m][n] * (s1 * HSC8);
#pragma unroll
                    for (int j = 0; j < 4; ++j) h[4 * n + j] = g[j] * frcp(1.0f + __expf(-g[j])) * up[j]; }
                v2u w; w.x = pk4_fp8(h[0], h[1], h[2], h[3]); w.y = pk4_fp8(h[4], h[5], h[6], h[7]);
                __builtin_nontemporal_store(w, (v2u*)rowp); }
    }
};
struct EpiYE8 {
    static constexpr bool PERM = true, AFTER_DRAIN = false;
    const float* GATE; bf16_t* YE;
    __device__ __forceinline__ void operator()(const f32x4 (&acc)[2][2][4][2], const pg8::Unit& u, int wr, int wc, int fr, int fq) const {
        asm volatile("s_nop 7\n\ts_nop 7\n\ts_nop 7"); __builtin_amdgcn_sched_barrier(0);
        const int pnl = u.pn & 3;
        const int row0 = u.pm * 256 + wr * 64 + fr, col0 = pnl * 256 + wc * 32 + 8 * fq;
#pragma unroll
        for (int ai = 0; ai < 2; ++ai)
#pragma unroll
            for (int m = 0; m < 4; ++m) { const int row = row0 + ai * 128 + m * 16; const float gt_ = GATE[row] * (1.0f / (HSC8 * DSC8)); bf16_t* rowp = YE + (size_t)row * D + col0;
#pragma unroll
                for (int bj = 0; bj < 2; ++bj) { const f32x4 v0 = acc[ai][bj][m][0] * gt_, v1 = acc[ai][bj][m][1] * gt_;
                    v4u w; w.x = pk2(v0[0], v0[1]); w.y = pk2(v0[2], v0[3]); w.z = pk2(v1[0], v1[1]); w.w = pk2(v1[2], v1[3]);
                    *(v4u*)(rowp + bj * 128) = w; } }
    }
};
template <class RowMap>
__device__ __forceinline__ void transpose_item_fp8(const float* W, int K, int N, unsigned char* WT, RowMap rm, float sc, LAS float* scr, int item, int lane) {
    const int nblk = N / 64, kb = item / nblk, nb_ = item % nblk, k0 = 64 * kb, n0 = 64 * nb_;
    f32x4 ld[16];
#pragma unroll
    for (int i = 0; i < 16; ++i) ld[i] = *(const f32x4*)(W + (size_t)(k0 + 4 * i + (lane >> 4)) * N + n0 + 4 * (lane & 15));
#pragma unroll
    for (int i = 0; i < 16; ++i) { LAS float* p = scr + (4 * i + (lane >> 4)) * 65 + 4 * (lane & 15); p[0] = ld[i][0]; p[1] = ld[i][1]; p[2] = ld[i][2]; p[3] = ld[i][3]; }
    asm volatile("s_waitcnt lgkmcnt(0)" ::: "memory");
    const int c = lane & 3;
#pragma unroll
    for (int j = 0; j < 4; ++j) { const int n = (lane >> 2) + 16 * j; const LAS float* s = scr + (16 * c) * 65 + n;
        v4u o;
#pragma unroll
        for (int q = 0; q < 4; ++q) o[q] = pk4_fp8(s[(4 * q) * 65] * sc, s[(4 * q + 1) * 65] * sc, s[(4 * q + 2) * 65] * sc, s[(4 * q + 3) * 65] * sc);
        *(v4u*)(WT + (size_t)rm(n0 + n) * K + k0 + 16 * c) = o; }
    asm volatile("s_waitcnt lgkmcnt(0)" ::: "memory");
}

struct EpiResidN {
    static constexpr bool PERM = false, AFTER_DRAIN = false;
    const float* base; float* out; bf16_t* Xb; float* SSP;
    __device__ __forceinline__ void operator()(const f32x4 (&acc)[2][2][4][2], const pg8::Unit& u, int wr, int wc, int fr, int fq) const {
        asm volatile("" : "+v"(fr), "+v"(fq));
        const int row0 = u.pm * 256 + wr * 64 + fr, col0 = u.pn * 256 + wc * 32 + 4 * fq;
#pragma unroll
        for (int ai = 0; ai < 2; ++ai)
#pragma unroll
            for (int m = 0; m < 4; ++m) { const size_t row = row0 + ai * 128 + m * 16; const size_t off = row * D + col0; float ss = 0.f;
#pragma unroll
                for (int bj = 0; bj < 2; ++bj)
#pragma unroll
                    for (int n = 0; n < 2; ++n) { const f32x4 b = *(const f32x4*)(base + off + bj * 128 + n * 16); const f32x4 o = b + acc[ai][bj][m][n];
                        *(f32x4*)(out + off + bj * 128 + n * 16) = o;
                        v2u w; w.x = pk2(o[0], o[1]); w.y = pk2(o[2], o[3]); *(v2u*)(Xb + off + bj * 128 + n * 16) = w;
                        ss += (o[0] * o[0] + o[1] * o[1]) + (o[2] * o[2] + o[3] * o[3]); }
                ss += __shfl_xor(ss, 16); ss += __shfl_xor(ss, 32);
                if (fq == 0) SSP[row * 16 + u.pn * 4 + wc] = ss; }
    }
};
struct EpiBf16StoreRS {
    static constexpr bool PERM = true, AFTER_DRAIN = false;
    bf16_t* O; int ldc; const float* SSP;
    __device__ __forceinline__ void operator()(const f32x4 (&acc)[2][2][4][2], const pg8::Unit& u, int wr, int wc, int fr, int fq) const {
        asm volatile("" : "+v"(fr), "+v"(fq));
        const int row0 = u.pm * 256 + wr * 64 + fr, col0 = u.pn * 256 + wc * 32 + 8 * fq;
#pragma unroll
        for (int ai = 0; ai < 2; ++ai)
#pragma unroll
            for (int m = 0; m < 4; ++m) { const size_t row = row0 + ai * 128 + m * 16;
                const f32x4* sp = (const f32x4*)(SSP + row * 16); const f32x4 s0 = sp[0], s1 = sp[1], s2 = sp[2], s3 = sp[3];
                const float ss = (((s0[0] + s0[1]) + (s0[2] + s0[3])) + ((s1[0] + s1[1]) + (s1[2] + s1[3]))) + (((s2[0] + s2[1]) + (s2[2] + s2[3])) + ((s3[0] + s3[1]) + (s3[2] + s3[3])));
                const float rs = rsqrtf(ss * (1.0f / D) + 1e-6f);
                bf16_t* rowp = O + row * ldc + col0;
#pragma unroll
                for (int bj = 0; bj < 2; ++bj) { const f32x4 v0 = acc[ai][bj][m][0] * rs, v1 = acc[ai][bj][m][1] * rs;
                    v4u w; w.x = pk2(v0[0], v0[1]); w.y = pk2(v0[2], v0[3]); w.z = pk2(v1[0], v1[1]); w.w = pk2(v1[2], v1[3]);
                    *(v4u*)(rowp + bj * 128) = w; } }
    }
};
struct MoeOrder {
    int G, c, npairs;
    int per;
    __device__ __forceinline__ bool next(int i, pg8::Unit& u) const {
        const int x = c & 7, y = c >> 3, pml = y & 7, pnq = y >> 3;
        const int epn = i * 32 + x * 4 + pnq;
        if (epn >= npairs || c >= 256) return false;
        const int e = epn / per;
        u.pm = e * 8 + pml; u.pn = epn; return true;
    }
    __device__ __forceinline__ void a_ready(const pg8::Unit&) const {}
    __device__ __forceinline__ void done(const pg8::Unit&) const {}
};

struct XattnOrder {
    int c;
    __device__ __forceinline__ bool next(int i, pg8::Unit& u) const { if (i != 0 || c >= 256) return false; u.pm = (c >> 7) * 32 + (c & 31); u.pn = (c >> 5) & 3; return true; }
    __device__ __forceinline__ void a_ready(const pg8::Unit&) const {}
    __device__ __forceinline__ void done(const pg8::Unit&) const {}
};
template <class RowMap>
__device__ __forceinline__ void transpose_item(const float* W, int K, int N, bf16_t* WT, RowMap rm, LAS float* scr, int item, int lane, const float* kscale = nullptr) {
    const int nblk = N / 64, kb = item / nblk, nb_ = item % nblk, k0 = 64 * kb, n0 = 64 * nb_;
    f32x4 ld[16];
#pragma unroll
    for (int i = 0; i < 16; ++i) ld[i] = *(const f32x4*)(W + (size_t)(k0 + 4 * i + (lane >> 4)) * N + n0 + 4 * (lane & 15));
#pragma unroll
    for (int i = 0; i < 16; ++i) { LAS float* p = scr + (4 * i + (lane >> 4)) * 65 + 4 * (lane & 15); p[0] = ld[i][0]; p[1] = ld[i][1]; p[2] = ld[i][2]; p[3] = ld[i][3]; }
    asm volatile("s_waitcnt lgkmcnt(0)" ::: "memory");
    const int c = lane & 7;
    float ksc[8];
#pragma unroll
    for (int q = 0; q < 8; ++q) ksc[q] = kscale ? kscale[k0 + 8 * c + q] : 1.0f;
#pragma unroll
    for (int j = 0; j < 8; ++j) { const int n = (lane >> 3) + 8 * j; const LAS float* s = scr + (8 * c) * 65 + n;
        v4u o; o.x = pk2(s[0 * 65] * ksc[0], s[1 * 65] * ksc[1]); o.y = pk2(s[2 * 65] * ksc[2], s[3 * 65] * ksc[3]); o.z = pk2(s[4 * 65] * ksc[4], s[5 * 65] * ksc[5]); o.w = pk2(s[6 * 65] * ksc[6], s[7 * 65] * ksc[7]);
        *(v4u*)(WT + (size_t)rm(n0 + n) * K + k0 + 8 * c) = o; }
    asm volatile("s_waitcnt lgkmcnt(0)" ::: "memory");
}

__device__ __forceinline__ void rmsnorm_rows_bf16(const float* x, const float* g, bf16_t* out, int M) {
    const int tix_ = tidx(); const int lane = tix_ & 63, gw = blockIdx.x * 8 + (tix_ >> 6), ngw = gridDim.x * 8;
    for (int m = gw; m < M; m += ngw) {
        const float4* xr = (const float4*)(x + (size_t)m * D);
        float4 v[4]; float s = 0.f;
#pragma unroll
        for (int j = 0; j < 4; ++j) { v[j] = xr[lane + 64 * j]; s += v[j].x * v[j].x + v[j].y * v[j].y + v[j].z * v[j].z + v[j].w * v[j].w; }
        const float r = rsqrtf(wave_sum(s) * (1.0f / D) + 1e-6f);
        v2u* o = (v2u*)(out + (size_t)m * D);
#pragma unroll
        for (int j = 0; j < 4; ++j) { const float4 gg = ((const float4*)g)[lane + 64 * j];
            v2u w; w.x = pk2(v[j].x * r * gg.x, v[j].y * r * gg.y); w.y = pk2(v[j].z * r * gg.z, v[j].w * r * gg.w); o[lane + 64 * j] = w; }
    }
}
__device__ __forceinline__ void rmsnorm_rows_f32(const float* x, const float* g, float* out, int M) {
    const int tix_ = tidx(); const int lane = tix_ & 63, gw = blockIdx.x * 8 + (tix_ >> 6), ngw = gridDim.x * 8;
    for (int m = gw; m < M; m += ngw) {
        const float4* xr = (const float4*)(x + (size_t)m * D);
        float4 v[4]; float s = 0.f;
#pragma unroll
        for (int j = 0; j < 4; ++j) { v[j] = xr[lane + 64 * j]; s += v[j].x * v[j].x + v[j].y * v[j].y + v[j].z * v[j].z + v[j].w * v[j].w; }
        const float r = rsqrtf(wave_sum(s) * (1.0f / D) + 1e-6f);
        float4* o = (float4*)(out + (size_t)m * D);
#pragma unroll
        for (int j = 0; j < 4; ++j) { const float4 gg = ((const float4*)g)[lane + 64 * j];
            o[lane + 64 * j] = make_float4(v[j].x * r * gg.x, v[j].y * r * gg.y, v[j].z * r * gg.z, v[j].w * r * gg.w); }
    }
}

__device__ __forceinline__ int block_exscan(int v, int* sh, int* tot) {
    const int tid = tidx(), lane = tid & 63, w = tid >> 6;
    int inc = v;
#pragma unroll
    for (int o = 1; o < 64; o <<= 1) { const int t = __shfl_up(inc, o); if (lane >= o) inc += t; }
    __syncthreads();
    if (lane == 63) sh[w] = inc;
    __syncthreads();
    int base = 0, total = 0;
#pragma unroll
    for (int i = 0; i < 8; ++i) { const int x = sh[i]; if (i < w) base += x; total += x; }
    *tot = total;
    return base + inc - v;
}


typedef short bf16x8 __attribute__((ext_vector_type(8)));
typedef float f32x16 __attribute__((ext_vector_type(16)));
constexpr int MROW = 144;
constexpr int MBUF = 64 * MROW;
__device__ __forceinline__ bf16x8 frag_rm(const LAS unsigned char* M, int row0, int k0, int fr, int fq) {
    return *(const LAS bf16x8*)(M + (row0 + fr) * MROW + (k0 + 8 * fq) * 2);
}
__device__ __forceinline__ bf16x8 frag_cm(const LAS unsigned char* M, int k0, int col0, int fr, int fq) {
    const LAS unsigned short* p = (const LAS unsigned short*)(M + (k0 + 8 * fq) * MROW + (col0 + fr) * 2);
    bf16x8 v;
#pragma unroll
    for (int j = 0; j < 8; ++j) v[j] = (short)p[j * (MROW / 2)];
    return v;
}
__device__ __forceinline__ void tile_store_bf16(LAS unsigned char* M, int m0, int n0, int fr, int fq, const f32x4& c) {
    v2u w; w.x = pk2(c[0], c[1]); w.y = pk2(c[2], c[3]);
    *(LAS v2u*)(M + (m0 + fr) * MROW + (n0 + 4 * fq) * 2) = w;
}
#define MMA16(acc, lf, rf) acc = __builtin_amdgcn_mfma_f32_16x16x32_bf16(rf, lf, acc, 0, 0, 0)

__device__ __forceinline__ void tile_store_bf16_T(LAS unsigned char* M, int m0, int n0, int fr, int fq, const f32x4& c) {
    const unsigned w0 = pk2(c[0], c[1]), w1 = pk2(c[2], c[3]);
    LAS unsigned char* p = M + (n0 + 4 * fq) * MROW + (m0 + fr) * 2;
    *(LAS unsigned short*)(p) = (unsigned short)(w0 & 0xffffu); *(LAS unsigned short*)(p + MROW) = (unsigned short)(w0 >> 16);
    *(LAS unsigned short*)(p + 2 * MROW) = (unsigned short)(w1 & 0xffffu); *(LAS unsigned short*)(p + 3 * MROW) = (unsigned short)(w1 >> 16);
}
__device__ __forceinline__ void scan_r1(const bf16_t* LWg, const bf16_t* RVg, const bf16_t* KDg, const bf16_t* KKg, const bf16_t* BBg,
                                        bf16_t* PT, bf16_t* QT, bf16_t* RH, float* YL, unsigned char* lds_raw) {
    LAS unsigned char* L = (LAS unsigned char*)lds_raw;
#define SL(k) (L + (k) * MBUF)
    LAS float* LWs = (LAS float*)(L + 14 * MBUF);
    const int tid = tidx(), lane = tid & 63, wave = tid >> 6, fr = lane & 15, fq = lane >> 4;
    const int tm = wave >> 1, tn0 = (wave & 1) * 2;
    const int m0 = tm * 16;
    const int t = tid >> 3, i0 = (tid & 7) * 8;
    v4u lw4n, r4n, v4n, kd4n, kk4n, bb4n;
#define R1_LOAD(it_) do { const int c_ = (it_) & 127, h_ = ((it_) >> 7) & 7, n_ = (it_) >> 10, dir_ = n_ >> 1, b_ = n_ & 1; \
        const int pos_ = dir_ ? (S - 1 - (c_ * 64 + t)) : (c_ * 64 + t); const size_t tok_ = (size_t)b_ * S + pos_; const size_t ch_ = (size_t)h_ * 64 + i0; \
        lw4n = *(const v4u*)(LWg + ((size_t)dir_ * T + tok_) * 512 + ch_); r4n = *(const v4u*)(RVg + tok_ * D + ch_); v4n = *(const v4u*)(RVg + tok_ * D + 512 + ch_); \
        kd4n = *(const v4u*)(KDg + ((size_t)dir_ * T + tok_) * 512 + ch_); kk4n = *(const v4u*)(KKg + tok_ * 512 + ch_); bb4n = *(const v4u*)(BBg + ((size_t)dir_ * T + tok_) * 512 + ch_); } while (0)
    if ((int)blockIdx.x < 4096) R1_LOAD((int)blockIdx.x);
    for (int item = blockIdx.x; item < 4096; item += gridDim.x) {
        const v4u lw4 = lw4n, r4 = r4n, v4 = v4n, kd4 = kd4n, kk4 = kk4n, bb4 = bb4n;
        float lw[8], Lin[8];
#pragma unroll
        for (int q = 0; q < 4; ++q) { lw[2 * q] = bflo(lw4[q]); lw[2 * q + 1] = bfhi(lw4[q]); }
#pragma unroll
        for (int j = 0; j < 8; ++j) { float x = lw[j];
#pragma unroll
            for (int o = 8; o < 64; o <<= 1) { const float y = __shfl_up(x, o); if (lane >= o) x += y; }
            Lin[j] = x; }
        __syncthreads();
        if (lane >= 56) {
#pragma unroll
            for (int j = 0; j < 8; ++j) LWs[64 + wave * 64 + i0 + j] = Lin[j]; }
        __syncthreads();
        {
            float off[8];
#pragma unroll
            for (int j = 0; j < 8; ++j) off[j] = 0.f;
            for (int w = 0; w < 8; ++w) { if (w < wave) {
#pragma unroll
                for (int j = 0; j < 8; ++j) off[j] += LWs[64 + w * 64 + i0 + j]; } }
#pragma unroll
            for (int j = 0; j < 8; ++j) Lin[j] += off[j];
            if (t == 63) {
#pragma unroll
                for (int j = 0; j < 8; ++j) LWs[i0 + j] = Lin[j]; }
            float at_[8], rt_[8], bt_[8], kt_[8];
#pragma unroll
            for (int q = 0; q < 4; ++q) {
#pragma unroll
                for (int e = 0; e < 2; ++e) { const int j = 2 * q + e;
                    const float ein = __expf(Lin[j]), einv = __expf(-Lin[j]), eex = __expf(Lin[j] - lw[j]);
                    const float kkv = e ? bfhi(kk4[q]) : bflo(kk4[q]), rv_ = e ? bfhi(r4[q]) : bflo(r4[q]), bbv = e ? bfhi(bb4[q]) : bflo(bb4[q]), kdv = e ? bfhi(kd4[q]) : bflo(kd4[q]);
                    at_[j] = -kkv * eex; rt_[j] = rv_ * ein; bt_[j] = bbv * einv; kt_[j] = kdv * einv; }
            }
            v4u wa, wb, wk, w;
            wa.x = pk2(at_[0], at_[1]); wa.y = pk2(at_[2], at_[3]); wa.z = pk2(at_[4], at_[5]); wa.w = pk2(at_[6], at_[7]); *(LAS v4u*)(SL(0) + t * MROW + i0 * 2) = wa;
            w.x = pk2(rt_[0], rt_[1]); w.y = pk2(rt_[2], rt_[3]); w.z = pk2(rt_[4], rt_[5]); w.w = pk2(rt_[6], rt_[7]); *(LAS v4u*)(SL(2) + t * MROW + i0 * 2) = w;
            wb.x = pk2(bt_[0], bt_[1]); wb.y = pk2(bt_[2], bt_[3]); wb.z = pk2(bt_[4], bt_[5]); wb.w = pk2(bt_[6], bt_[7]); *(LAS v4u*)(SL(3) + t * MROW + i0 * 2) = wb;
            wk.x = pk2(kt_[0], kt_[1]); wk.y = pk2(kt_[2], kt_[3]); wk.z = pk2(kt_[4], kt_[5]); wk.w = pk2(kt_[6], kt_[7]); *(LAS v4u*)(SL(5) + t * MROW + i0 * 2) = wk;
#pragma unroll
            for (int q = 0; q < 4; ++q) {
                LAS unsigned char* pT = (LAS unsigned char*)0 + (i0 + 2 * q) * MROW + t * 2;
                *(LAS unsigned short*)(SL(1) + (size_t)pT) = (unsigned short)(wa[q] & 0xffffu); *(LAS unsigned short*)(SL(1) + (size_t)pT + MROW) = (unsigned short)(wa[q] >> 16);
                *(LAS unsigned short*)(SL(4) + (size_t)pT) = (unsigned short)(wb[q] & 0xffffu); *(LAS unsigned short*)(SL(4) + (size_t)pT + MROW) = (unsigned short)(wb[q] >> 16);
                *(LAS unsigned short*)(SL(6) + (size_t)pT) = (unsigned short)(wk[q] & 0xffffu); *(LAS unsigned short*)(SL(6) + (size_t)pT + MROW) = (unsigned short)(wk[q] >> 16);
                *(LAS unsigned short*)(SL(7) + (size_t)pT) = (unsigned short)(v4[q] & 0xffffu); *(LAS unsigned short*)(SL(7) + (size_t)pT + MROW) = (unsigned short)(v4[q] >> 16);
            }
        }
        if (item + (int)gridDim.x < 4096) R1_LOAD(item + (int)gridDim.x);
        __syncthreads();
        f32x4 Tacc[2];
        {
            bf16x8 la[2], lr[2];
#pragma unroll
            for (int ks = 0; ks < 2; ++ks) { la[ks] = frag_rm(SL(0), m0, 32 * ks, fr, fq); lr[ks] = frag_rm(SL(2), m0, 32 * ks, fr, fq); }
#pragma unroll
            for (int q = 0; q < 2; ++q) {
                const int n0 = (tn0 + q) * 16;
                f32x4 cab = {0.f, 0.f, 0.f, 0.f}, cak = cab, crb = cab, crk = cab;
#pragma unroll
                for (int ks = 0; ks < 2; ++ks) {
                    const bf16x8 rb_ = frag_rm(SL(3), n0, 32 * ks, fr, fq), rk_ = frag_rm(SL(5), n0, 32 * ks, fr, fq);
                    MMA16(cab, la[ks], rb_); MMA16(cak, la[ks], rk_); MMA16(crb, lr[ks], rb_); MMA16(crk, lr[ks], rk_);
                }
                const int tt = m0 + fr;
#pragma unroll
                for (int j = 0; j < 4; ++j) { const int ss = n0 + 4 * fq + j;
                    if (!(ss < tt)) { cab[j] = 0.f; cak[j] = 0.f; }
                    if (!(ss <= tt)) { crb[j] = 0.f; crk[j] = 0.f; } }
                tile_store_bf16(SL(8), m0, n0, fr, fq, cab); tile_store_bf16_T(SL(9), m0, n0, fr, fq, cab);
                tile_store_bf16(SL(10), m0, n0, fr, fq, cak);
                tile_store_bf16(SL(11), m0, n0, fr, fq, crb); tile_store_bf16(SL(12), m0, n0, fr, fq, crk);
#pragma unroll
                for (int j = 0; j < 4; ++j) cab[j] += ((n0 + 4 * fq + j) == tt) ? 1.f : 0.f;
                Tacc[q] = cab;
                tile_store_bf16(SL(13), m0, n0, fr, fq, cab);
            }
        }
        __syncthreads();
        {
            bf16x8 lk[2], ln_[2];
#pragma unroll
            for (int ks = 0; ks < 2; ++ks) { lk[ks] = frag_rm(SL(10), m0, 32 * ks, fr, fq); ln_[ks] = frag_rm(SL(8), m0, 32 * ks, fr, fq); }
#pragma unroll
            for (int q = 0; q < 2; ++q) {
                const int n0 = (tn0 + q) * 16;
                f32x4 cw = {0.f, 0.f, 0.f, 0.f}, cn = cw;
#pragma unroll
                for (int ks = 0; ks < 2; ++ks) { MMA16(cw, lk[ks], frag_rm(SL(7), n0, 32 * ks, fr, fq)); MMA16(cn, ln_[ks], frag_rm(SL(9), n0, 32 * ks, fr, fq)); }
                tile_store_bf16_T(SL(0), m0, n0, fr, fq, cw);
                tile_store_bf16(SL(3), m0, n0, fr, fq, cn); tile_store_bf16_T(SL(5), m0, n0, fr, fq, cn);
            }
        }
        __syncthreads();
#pragma unroll
        for (int k = 1; k <= 5; ++k) {
            LAS unsigned char* Nk = (k & 1) ? SL(3) : SL(8); LAS unsigned char* NkT = (k & 1) ? SL(5) : SL(9);
            LAS unsigned char* Nn = (k & 1) ? SL(8) : SL(3); LAS unsigned char* NnT = (k & 1) ? SL(9) : SL(5);
            LAS unsigned char* Tk = (k & 1) ? SL(13) : SL(10); LAS unsigned char* Tn = (k & 1) ? SL(10) : SL(13);
            bf16x8 lt[2], ln_[2];
#pragma unroll
            for (int ks = 0; ks < 2; ++ks) { lt[ks] = frag_rm(Tk, m0, 32 * ks, fr, fq); ln_[ks] = frag_rm(Nk, m0, 32 * ks, fr, fq); }
#pragma unroll
            for (int q = 0; q < 2; ++q) {
                const int n0 = (tn0 + q) * 16;
                f32x4 cn = {0.f, 0.f, 0.f, 0.f};
#pragma unroll
                for (int ks = 0; ks < 2; ++ks) { const bf16x8 rn = frag_rm(NkT, n0, 32 * ks, fr, fq); MMA16(Tacc[q], lt[ks], rn); if (k < 5) MMA16(cn, ln_[ks], rn); }
                tile_store_bf16(Tn, m0, n0, fr, fq, Tacc[q]);
                if (k < 5) { tile_store_bf16(Nn, m0, n0, fr, fq, cn); tile_store_bf16_T(NnT, m0, n0, fr, fq, cn); }
            }
            __syncthreads();
        }
        {
            bf16x8 lt[2];
#pragma unroll
            for (int ks = 0; ks < 2; ++ks) lt[ks] = frag_rm(SL(10), m0, 32 * ks, fr, fq);
#pragma unroll
            for (int q = 0; q < 2; ++q) {
                const int n0 = (tn0 + q) * 16;
                f32x4 ca = {0.f, 0.f, 0.f, 0.f}, cu = ca;
#pragma unroll
                for (int ks = 0; ks < 2; ++ks) { MMA16(ca, lt[ks], frag_rm(SL(1), n0, 32 * ks, fr, fq)); MMA16(cu, lt[ks], frag_rm(SL(0), n0, 32 * ks, fr, fq)); }
                tile_store_bf16_T(SL(8), m0, n0, fr, fq, ca); tile_store_bf16_T(SL(9), m0, n0, fr, fq, cu);
            }
        }
        __syncthreads();
        {
            bf16x8 lrb[2], lrk[2], lb[2], lkt[2];
#pragma unroll
            for (int ks = 0; ks < 2; ++ks) { lrb[ks] = frag_rm(SL(11), m0, 32 * ks, fr, fq); lrk[ks] = frag_rm(SL(12), m0, 32 * ks, fr, fq);
                lb[ks] = frag_rm(SL(4), m0, 32 * ks, fr, fq); lkt[ks] = frag_rm(SL(6), m0, 32 * ks, fr, fq); }
            const float wc = __expf(LWs[m0 + fr]);
#pragma unroll
            for (int q = 0; q < 2; ++q) {
                const int n0 = (tn0 + q) * 16;
                f32x4 crh = {0.f, 0.f, 0.f, 0.f}, cyl = crh, cp = crh, cq = crh;
#pragma unroll
                for (int ks = 0; ks < 2; ++ks) {
                    const bf16x8 ra = frag_rm(SL(8), n0, 32 * ks, fr, fq), ru = frag_rm(SL(9), n0, 32 * ks, fr, fq), rv = frag_rm(SL(7), n0, 32 * ks, fr, fq);
                    MMA16(crh, lrb[ks], ra); MMA16(cyl, lrb[ks], ru); MMA16(cyl, lrk[ks], rv);
                    MMA16(cp, lb[ks], ra); MMA16(cq, lb[ks], ru); MMA16(cq, lkt[ks], rv);
                }
                const size_t o = (size_t)item * 4096 + (size_t)(m0 + fr) * 64 + n0 + 4 * fq;
                { const LAS unsigned short* rp = (const LAS unsigned short*)(SL(2) + (m0 + fr) * MROW + (n0 + 4 * fq) * 2);
#pragma unroll
                  for (int j = 0; j < 4; ++j) crh[j] += __uint_as_float(((unsigned)rp[j]) << 16); }
                { v2u w; w.x = pk2(crh[0], crh[1]); w.y = pk2(crh[2], crh[3]); *(v2u*)(RH + o) = w; }
                *(f32x4*)(YL + o) = cyl;
#pragma unroll
                for (int j = 0; j < 4; ++j) { cp[j] = wc * (cp[j] + (((n0 + 4 * fq + j) == (m0 + fr)) ? 1.f : 0.f)); cq[j] *= wc; }
                { v2u w; w.x = pk2(cp[0], cp[1]); w.y = pk2(cp[2], cp[3]); *(v2u*)(PT + o) = w; }
                { v2u w; w.x = pk2(cq[0], cq[1]); w.y = pk2(cq[2], cq[3]); *(v2u*)(QT + o) = w; }
            }
        }
    }
#undef SL
}
#undef R1_LOAD

__device__ __forceinline__ bf16x8 pack_acc8(const f32x16& x, int s) {
    v4u p; p.x = pk2(x[8 * s], x[8 * s + 1]); p.y = pk2(x[8 * s + 2], x[8 * s + 3]); p.z = pk2(x[8 * s + 4], x[8 * s + 5]); p.w = pk2(x[8 * s + 6], x[8 * s + 7]);
    return __builtin_bit_cast(bf16x8, p);
}
__device__ __forceinline__ void scan_r2(const bf16_t* PT, const bf16_t* QT, bf16_t* S0, unsigned char* lds_raw) {
    LAS unsigned char* L = (LAS unsigned char*)lds_raw;
    constexpr int SLOT_B = MBUF + 8192;
    const int tid = tidx(), lane = tid & 63, wave = tid >> 6;
    const int r = lane & 31, h2 = lane >> 5, jb = wave;
    f32x16 st[2];
#pragma unroll
    for (int ib = 0; ib < 2; ++ib)
#pragma unroll
        for (int g = 0; g < 16; ++g) st[ib][g] = 0.f;
    const size_t item0 = (size_t)blockIdx.x * 128;
    v4u stage[16];
#pragma unroll
    for (int q = 0; q < 16; ++q) { const int p = tid + 512 * q, cc = p >> 10, w = p & 1023, mat = w >> 9, idx = w & 511;
        stage[q] = *(const v4u*)((mat ? QT : PT) + (item0 + cc) * 4096 + idx * 8); }
    for (int grp = 0; grp < 16; ++grp) {
        __syncthreads();
#pragma unroll
        for (int q = 0; q < 16; ++q) { const int p = tid + 512 * q, cc = p >> 10, w = p & 1023, mat = w >> 9, idx = w & 511;
            *(LAS v4u*)(L + cc * SLOT_B + (mat ? (MBUF + idx * 16) : ((idx >> 3) * MROW + (idx & 7) * 16))) = stage[q]; }
        __syncthreads();
        if (grp < 15) {
#pragma unroll
            for (int q = 0; q < 16; ++q) { const int p = tid + 512 * q, cc = p >> 10, w = p & 1023, mat = w >> 9, idx = w & 511;
                stage[q] = *(const v4u*)((mat ? QT : PT) + (item0 + (grp + 1) * 8 + cc) * 4096 + idx * 8); }
        }
        if (wave < 2) {
#pragma unroll 1
            for (int cc = 0; cc < 8; ++cc) {
                const size_t item = item0 + grp * 8 + cc;
                const LAS unsigned char* Pm = L + cc * SLOT_B; const LAS unsigned char* Qm = Pm + MBUF;
                bf16_t* sp = S0 + item * 4096 + (size_t)(32 * jb + r) * 64;
#pragma unroll
                for (int ib = 0; ib < 2; ++ib)
#pragma unroll
                    for (int g = 0; g < 4; ++g) { v2u w; w.x = pk2(st[ib][4 * g], st[ib][4 * g + 1]); w.y = pk2(st[ib][4 * g + 2], st[ib][4 * g + 3]); *(v2u*)(sp + 32 * ib + 8 * g + 4 * h2) = w; }
                f32x16 nw[2];
#pragma unroll
                for (int ib = 0; ib < 2; ++ib)
#pragma unroll
                    for (int g = 0; g < 16; ++g) nw[ib][g] = __uint_as_float(((unsigned)*(const LAS unsigned short*)(Qm + (32 * ib + (g & 3) + 8 * (g >> 2) + 4 * h2) * 128 + (32 * jb + r) * 2)) << 16);
#pragma unroll
                for (int kb = 0; kb < 2; ++kb)
#pragma unroll
                    for (int s2 = 0; s2 < 2; ++s2) {
                        const bf16x8 bfr = pack_acc8(st[kb], s2);
#pragma unroll
                        for (int ib = 0; ib < 2; ++ib) {
                            const LAS unsigned char* ap = Pm + (32 * ib + r) * MROW + (32 * kb + 16 * s2 + 4 * h2) * 2;
                            const v2u lo = *(const LAS v2u*)ap, hi = *(const LAS v2u*)(ap + 16);
                            v4u av; av.x = lo.x; av.y = lo.y; av.z = hi.x; av.w = hi.y;
                            nw[ib] = __builtin_amdgcn_mfma_f32_32x32x16_bf16(__builtin_bit_cast(bf16x8, av), bfr, nw[ib], 0, 0, 0);
                        }
                    }
                st[0] = nw[0]; st[1] = nw[1];
            }
        }
    }
}
__device__ __forceinline__ void scan_r3(const bf16_t* RH, const float* YL, const bf16_t* S0, const bf16_t* RVg, const bf16_t* KDg, const bf16_t* Gg,
                                        const float* r_k, const float* lng, const float* lnb, bf16_t* Y) {
    const int tid = tidx(), lane = tid & 63, wave = tid >> 6, fr = lane & 15, fq = lane >> 4;
    const int tmw = wave & 3;
    for (int it2 = blockIdx.x * 2 + (wave >> 2); it2 < 2048; it2 += gridDim.x * 2) {
        const int b = it2 >> 10, h = (it2 >> 7) & 7, pc = it2 & 127;
        f32x4 acc[4];
#pragma unroll
        for (int q = 0; q < 4; ++q) acc[q] = (f32x4){0.f, 0.f, 0.f, 0.f};
#pragma unroll 1
        for (int dirn = 0; dirn < 2; ++dirn) {
            const size_t item = (size_t)((dirn * 2 + b) * 8 + h) * 128 + (dirn ? 127 - pc : pc);
            const int row = dirn ? 63 - (16 * tmw + fr) : 16 * tmw + fr;
            const bf16_t* rp = RH + item * 4096 + (size_t)row * 64;
            bf16x8 lf[2];
#pragma unroll
            for (int ks = 0; ks < 2; ++ks) lf[ks] = *(const bf16x8*)(rp + 32 * ks + 8 * fq);
#pragma unroll
            for (int q = 0; q < 4; ++q) {
                const bf16_t* sp = S0 + item * 4096 + (size_t)(16 * q + fr) * 64;
#pragma unroll
                for (int ks = 0; ks < 2; ++ks) { const bf16x8 rf = *(const bf16x8*)(sp + 32 * ks + 8 * fq); MMA16(acc[q], lf[ks], rf); }
                acc[q] += *(const f32x4*)(YL + item * 4096 + (size_t)row * 64 + 16 * q + 4 * fq);
            }
        }
        float sm = 0.f;
#pragma unroll
        for (int q = 0; q < 4; ++q) sm += (acc[q][0] + acc[q][1]) + (acc[q][2] + acc[q][3]);
        sm += __shfl_xor(sm, 16); sm += __shfl_xor(sm, 32);
        const float mean = sm * (1.0f / 64.f);
        float sq = 0.f;
#pragma unroll
        for (int q = 0; q < 4; ++q)
#pragma unroll
            for (int j = 0; j < 4; ++j) { const float d = acc[q][j] - mean; sq += d * d; }
        sq += __shfl_xor(sq, 16); sq += __shfl_xor(sq, 32);
        const float rstd = rsqrtf(sq * (1.0f / 64.f) + 64e-5f);
        const size_t tok = (size_t)b * S + pc * 64 + 16 * tmw + fr;
        float bon = 0.f; f32x4 vv[4];
#pragma unroll
        for (int q = 0; q < 4; ++q) {
            const int c = h * 64 + 16 * q + 4 * fq;
            const v2u rw = *(const v2u*)(RVg + tok * D + c), k0 = *(const v2u*)(KDg + tok * 512 + c), k1 = *(const v2u*)(KDg + ((size_t)T + tok) * 512 + c), vw = *(const v2u*)(RVg + tok * D + 512 + c);
            const f32x4 rk4 = *(const f32x4*)(r_k + c);
            vv[q] = (f32x4){bflo(vw.x), bfhi(vw.x), bflo(vw.y), bfhi(vw.y)};
            bon += bflo(rw.x) * (bflo(k0.x) + bflo(k1.x)) * rk4[0] + bfhi(rw.x) * (bfhi(k0.x) + bfhi(k1.x)) * rk4[1] + bflo(rw.y) * (bflo(k0.y) + bflo(k1.y)) * rk4[2] + bfhi(rw.y) * (bfhi(k0.y) + bfhi(k1.y)) * rk4[3];
        }
        bon += __shfl_xor(bon, 16); bon += __shfl_xor(bon, 32);
#pragma unroll
        for (int q = 0; q < 4; ++q) {
            const int c = h * 64 + 16 * q + 4 * fq;
            const v2u gw_ = *(const v2u*)(Gg + tok * 512 + c); const f32x4 g4 = {bflo(gw_.x), bfhi(gw_.x), bflo(gw_.y), bfhi(gw_.y)}, lg = *(const f32x4*)(lng + c), lb = *(const f32x4*)(lnb + c);
            float o[4];
#pragma unroll
            for (int j = 0; j < 4; ++j) o[j] = ((acc[q][j] - mean) * rstd * lg[j] + lb[j] + bon * vv[q][j]) * g4[j];
            v2u w; w.x = pk2(o[0], o[1]); w.y = pk2(o[2], o[3]);
            *(v2u*)(Y + tok * D + 512 + c) = w;
        }
    }
}


__device__ __forceinline__ bf16x8 pack8(float a0, float a1, float a2, float a3, float a4, float a5, float a6, float a7) {
    v4u p; p.x = pk2(a0, a1); p.y = pk2(a2, a3); p.z = pk2(a4, a5); p.w = pk2(a6, a7);
    return __builtin_bit_cast(bf16x8, p);
}
#define MMA32(acc, af, bf_) acc = __builtin_amdgcn_mfma_f32_32x32x16_bf16(af, bf_, acc, 0, 0, 0)
__device__ __forceinline__ void xattn_mfma(const bf16_t* Qb, const bf16_t* Kb, const bf16_t* Vt, bf16_t* Y, unsigned char* lds_raw) {
    LAS unsigned char* L = (LAS unsigned char*)lds_raw;
    constexpr int KRS = 528, VRS = 520;
    const int tid = tidx(), lane = tid & 63, wave = tid >> 6, r = lane & 31, h2 = lane >> 5;
    for (int it = blockIdx.x; it < 256; it += gridDim.x) {
        const int qblk = it & 31, h = (it >> 5) & 3, b = it >> 7;
        const size_t tok = (size_t)b * S + qblk * 256 + wave * 32 + r;
        bf16x8 qf[16];
#pragma unroll
        for (int ks = 0; ks < 16; ++ks) qf[ks] = *(const bf16x8*)(Qb + tok * D + h * 256 + 16 * ks + 8 * h2);
        __syncthreads();
#pragma unroll
        for (int hf = 0; hf < 2; ++hf) {
            v4u stg[8];
#pragma unroll
            for (int q = 0; q < 8; ++q) { const int p = tid + 512 * (8 * hf + q); stg[q] = *(const v4u*)(Kb + (size_t)(b * MEM + (p >> 5)) * 1024 + h * 256 + (p & 31) * 8); }
#pragma unroll
            for (int q = 0; q < 8; ++q) { const int p = tid + 512 * (8 * hf + q); *(LAS v4u*)(L + (p >> 5) * KRS + (p & 31) * 16) = stg[q]; }
        }
        __syncthreads();
        float mx = -3.0e38f;
#pragma unroll 1
        for (int kb = 0; kb < 8; ++kb) {
            f32x16 st;
#pragma unroll
            for (int g = 0; g < 16; ++g) st[g] = 0.f;
            const LAS unsigned char* kp = L + (32 * kb + r) * KRS + 16 * h2;
#pragma unroll
            for (int ks = 0; ks < 16; ++ks) { const bf16x8 kf = *(const LAS bf16x8*)(kp + 32 * ks); MMA32(st, kf, qf[ks]); }
#pragma unroll
            for (int g = 0; g < 16; ++g) mx = fmaxf(mx, st[g]);
        }
        mx = fmaxf(mx, __shfl_xor(mx, 32));
        const float cs = 0.0625f * 1.4426950408889634f;
        float l = 0.f;
        bf16x8 pf[8][2];
#pragma unroll
        for (int kb = 0; kb < 8; ++kb) {
            f32x16 st;
#pragma unroll
            for (int g = 0; g < 16; ++g) st[g] = 0.f;
            const LAS unsigned char* kp = L + (32 * kb + r) * KRS + 16 * h2;
#pragma unroll
            for (int ks = 0; ks < 16; ++ks) { const bf16x8 kf = *(const LAS bf16x8*)(kp + 32 * ks); MMA32(st, kf, qf[ks]); }
#pragma unroll
            for (int g = 0; g < 16; ++g) { st[g] = __builtin_amdgcn_exp2f((st[g] - mx) * cs); l += st[g]; }
#pragma unroll
            for (int s2 = 0; s2 < 2; ++s2) pf[kb][s2] = pack8(st[8 * s2], st[8 * s2 + 1], st[8 * s2 + 2], st[8 * s2 + 3], st[8 * s2 + 4], st[8 * s2 + 5], st[8 * s2 + 6], st[8 * s2 + 7]);
            __builtin_amdgcn_sched_barrier(0);
        }
        l += __shfl_xor(l, 32);
        const float inv = 1.0f / l;
        __syncthreads();
#pragma unroll
        for (int hf = 0; hf < 2; ++hf) {
            v4u stg[8];
#pragma unroll
            for (int q = 0; q < 8; ++q) { const int p = tid + 512 * (8 * hf + q); stg[q] = *(const v4u*)(Vt + ((size_t)(b * 1024 + h * 256 + (p >> 5))) * 256 + (p & 31) * 8); }
#pragma unroll
            for (int q = 0; q < 8; ++q) { const int p = tid + 512 * (8 * hf + q); LAS v2u* lp = (LAS v2u*)(L + (p >> 5) * VRS + (p & 31) * 16);
                v2u a_; a_.x = stg[q].x; a_.y = stg[q].y; lp[0] = a_; a_.x = stg[q].z; a_.y = stg[q].w; lp[1] = a_; }
        }
        __syncthreads();
#pragma unroll 1
        for (int db = 0; db < 8; ++db) {
            f32x16 acc;
#pragma unroll
            for (int g = 0; g < 16; ++g) acc[g] = 0.f;
            const LAS unsigned char* vp = L + (32 * db + r) * VRS + 8 * h2;
#pragma unroll
            for (int kb = 0; kb < 8; ++kb)
#pragma unroll
                for (int s2 = 0; s2 < 2; ++s2) {
                    const v2u lo = *(const LAS v2u*)(vp + (32 * kb + 16 * s2) * 2), hi = *(const LAS v2u*)(vp + (32 * kb + 16 * s2 + 8) * 2);
                    v4u av; av.x = lo.x; av.y = lo.y; av.z = hi.x; av.w = hi.y;
                    MMA32(acc, __builtin_bit_cast(bf16x8, av), pf[kb][s2]);
                }
            int tl_ = tid; asm volatile("" : "+v"(tl_));
            bf16_t* yp = Y + ((size_t)b * S + qblk * 256 + (tl_ >> 6) * 32 + (tl_ & 31)) * D + h * 256 + 32 * db + 4 * ((tl_ >> 5) & 1);
#pragma unroll
            for (int g = 0; g < 4; ++g) { v2u w; w.x = pk2(acc[4 * g] * inv, acc[4 * g + 1] * inv); w.y = pk2(acc[4 * g + 2] * inv, acc[4 * g + 3] * inv); *(v2u*)(yp + 8 * g) = w; }
        }
    }
}
template <bool F32OUT>
__device__ __forceinline__ void combine_norm(float* X, const bf16_t* YE, const int* SLOT, const float* g, bf16_t* Hout, float* Fout) {
    const int tix_ = tidx(); const int lane = tix_ & 63, gw = blockIdx.x * 8 + (tix_ >> 6), ngw = gridDim.x * 8;
    float4 gc[4];
#pragma unroll
    for (int j = 0; j < 4; ++j) gc[j] = ((const float4*)g)[lane + 64 * j];
    for (int m = gw; m < T; m += ngw) {
        float4* xr = (float4*)(X + (size_t)m * D);
        float4 v[4];
#pragma unroll
        for (int j = 0; j < 4; ++j) v[j] = xr[lane + 64 * j];
        const int myslot = SLOT[(size_t)m * NE + (lane & 15)];
#pragma unroll
        for (int e = 0; e < 16; ++e) {
            const int row = __builtin_amdgcn_readlane(myslot, e);
            if (row >= 0) {
                const v2u* yp = (const v2u*)(YE + (size_t)row * D);
#pragma unroll
                for (int j = 0; j < 4; ++j) { const v2u w = yp[lane + 64 * j];
                    v[j].x += __uint_as_float(w.x << 16); v[j].y += __uint_as_float(w.x & 0xffff0000u); v[j].z += __uint_as_float(w.y << 16); v[j].w += __uint_as_float(w.y & 0xffff0000u); }
            }
        }
        float s = 0.f;
#pragma unroll
        for (int j = 0; j < 4; ++j) { if (!F32OUT) xr[lane + 64 * j] = v[j]; s += v[j].x * v[j].x + v[j].y * v[j].y + v[j].z * v[j].z + v[j].w * v[j].w; }
        const float r = rsqrtf(wave_sum(s) * (1.0f / D) + 1e-6f);
#pragma unroll
        for (int j = 0; j < 4; ++j) { const float4 gg = gc[j];
            if (F32OUT) ((float4*)(Fout + (size_t)m * D))[lane + 64 * j] = make_float4(v[j].x * r * gg.x, v[j].y * r * gg.y, v[j].z * r * gg.z, v[j].w * r * gg.w);
            else { v2u w; w.x = pk2(v[j].x * r * gg.x, v[j].y * r * gg.y); w.y = pk2(v[j].z * r * gg.z, v[j].w * r * gg.w); ((v2u*)(Hout + (size_t)m * D))[lane + 64 * j] = w; } }
    }
}


template <int NK, bool SINK>
__device__ __forceinline__ void attn_block(const bf16_t* Qh, const bf16_t* Kh, const bf16_t* Vh, int dd, int Lr, int b, int rho, int q0b, float sink2,
                                           bf16_t* Odst, int ostride, float* lsedst, unsigned char* lds_raw) {
    constexpr int NKEY = 256 + 64 * NK, KRS = 144, VRS = NKEY * 2 + 8;
    LAS unsigned char* Ks = (LAS unsigned char*)lds_raw; LAS unsigned char* Vs = Ks + NKEY * KRS;
    const int tid = tidx(), lane = tid & 63, wave = tid >> 6, r = lane & 31, h2 = lane >> 5;
    const int kq_base = q0b - 32 * NK;
    __syncthreads();
#pragma unroll
    for (int i = 0; i < NKEY * 8 / 512; ++i) {
        const int p = tid + 512 * i, row = p >> 3, piece = p & 7, kq = kq_base + row;
        if (kq >= 0 && kq < Lr) {
            const size_t tokk = (size_t)b * S + (size_t)kq * dd + rho;
            const v4u kx = *(const v4u*)(Kh + tokk * 64 + piece * 8), vx = *(const v4u*)(Vh + tokk * 64 + piece * 8);
            *(LAS v4u*)(Ks + row * KRS + piece * 16) = kx;
            LAS unsigned char* vp = Vs + (piece * 8) * VRS + row * 2;
#pragma unroll
            for (int e = 0; e < 4; ++e) { *(LAS unsigned short*)(vp + (2 * e) * VRS) = (unsigned short)(vx[e] & 0xffffu); *(LAS unsigned short*)(vp + (2 * e + 1) * VRS) = (unsigned short)(vx[e] >> 16); }
        }
    }
    const int q0 = q0b + 32 * wave;
    const size_t qtok = (size_t)b * S + (size_t)(q0 + r) * dd + rho;
    bf16x8 qf[4];
#pragma unroll
    for (int ks = 0; ks < 4; ++ks) qf[ks] = *(const bf16x8*)(Qh + qtok * 64 + 16 * ks + 8 * h2);
    __syncthreads();
    f32x16 o[2];
#pragma unroll
    for (int db = 0; db < 2; ++db)
#pragma unroll
        for (int g = 0; g < 16; ++g) o[db][g] = 0.f;
    float m = SINK ? sink2 : -1.0e30f, l = SINK ? 1.f : 0.f;
    const int kb_lo = max(-NK, -(q0 >> 5)), kb_hi = min(NK, (Lr - 32 - q0) >> 5);
#pragma unroll 1
    for (int kb = kb_lo; kb <= kb_hi; ++kb) {
        const int kw0 = 32 * (wave + kb + NK);
        f32x16 st;
#pragma unroll
        for (int g = 0; g < 16; ++g) st[g] = 0.f;
        const LAS unsigned char* kp = Ks + (kw0 + r) * KRS + 16 * h2;
#pragma unroll
        for (int ks = 0; ks < 4; ++ks) { const bf16x8 kf = *(const LAS bf16x8*)(kp + 32 * ks); MMA32(st, kf, qf[ks]); }
        if (kb == -NK || kb == NK) {
#pragma unroll
            for (int g = 0; g < 16; ++g) { const int cr = (g & 3) + 8 * (g >> 2) + 4 * h2; const bool ok = (kb < 0) ? (cr >= r) : (cr <= r); st[g] = ok ? st[g] : -1.0e30f; }
        }
        float bm = st[0];
#pragma unroll
        for (int g = 1; g < 16; ++g) bm = fmaxf(bm, st[g]);
        bm = fmaxf(bm, __shfl_xor(bm, 32));
        const float mn = fmaxf(m, bm), al = __builtin_amdgcn_exp2f(m - mn);
        float ls = 0.f;
#pragma unroll
        for (int g = 0; g < 16; ++g) { st[g] = __builtin_amdgcn_exp2f(st[g] - mn); ls += st[g]; }
        ls += __shfl_xor(ls, 32);
        l = l * al + ls; m = mn;
#pragma unroll
        for (int db = 0; db < 2; ++db)
#pragma unroll
            for (int g = 0; g < 16; ++g) o[db][g] *= al;
        bf16x8 pf[2];
#pragma unroll
        for (int s2 = 0; s2 < 2; ++s2) pf[s2] = pack8(st[8 * s2], st[8 * s2 + 1], st[8 * s2 + 2], st[8 * s2 + 3], st[8 * s2 + 4], st[8 * s2 + 5], st[8 * s2 + 6], st[8 * s2 + 7]);
#pragma unroll
        for (int db = 0; db < 2; ++db) {
            const LAS unsigned char* vp = Vs + (32 * db + r) * VRS + (kw0 + 4 * h2) * 2;
#pragma unroll
            for (int s2 = 0; s2 < 2; ++s2) {
                const v2u lo = *(const LAS v2u*)(vp + 32 * s2), hi = *(const LAS v2u*)(vp + 32 * s2 + 16);
                v4u av; av.x = lo.x; av.y = lo.y; av.z = hi.x; av.w = hi.y;
                MMA32(o[db], __builtin_bit_cast(bf16x8, av), pf[s2]);
            }
        }
    }
    const float inv = 1.0f / l;
#pragma unroll
    for (int db = 0; db < 2; ++db) {
        bf16_t* op = Odst + qtok * ostride + 32 * db + 4 * h2;
#pragma unroll
        for (int g = 0; g < 4; ++g) { v2u w; w.x = pk2(o[db][4 * g] * inv, o[db][4 * g + 1] * inv); w.y = pk2(o[db][4 * g + 2] * inv, o[db][4 * g + 3] * inv); *(v2u*)(op + 8 * g) = w; }
    }
    if (lsedst != nullptr && h2 == 0) lsedst[qtok * 8] = (m + __builtin_amdgcn_logf(l)) * 0.6931471805599453f;
}

__device__ __forceinline__ void attn_phase_even(const bf16_t* QhA, const bf16_t* KhA, const bf16_t* VhA, const bf16_t* QhB, const bf16_t* KhB, const bf16_t* VhB,
                                                const float* sink, bf16_t* OA, float* LSE, bf16_t* Y, unsigned char* lds_raw) {
    for (int it = blockIdx.x; it < 2048; it += gridDim.x) {
        if (it < 512) {
            const int hq = it >> 6, rem2 = it & 63, b = rem2 >> 5, q0b = (rem2 & 31) * 256, kvh = hq >> 2;
            attn_block<4, true>(QhB + (size_t)hq * T * 64, KhB + (size_t)kvh * T * 64, VhB + (size_t)kvh * T * 64, 1, S, b, 0, q0b, sink[hq] * 1.4426950408889634f,
                                Y + 512 + hq * 64, D, nullptr, lds_raw);
        } else {
            const int ita = it - 512, p = ita >> 9, rem = ita & 511, head = rem >> 6, rem2 = rem & 63, b = rem2 >> 5, rem3 = rem2 & 31;
            const int dd = p == 0 ? 1 : (p == 1 ? 4 : 16), bpr = 32 / dd, rho = rem3 / bpr, q0b = (rem3 % bpr) * 256;
            attn_block<2, false>(QhA + (size_t)head * T * 64, KhA + (size_t)head * T * 64, VhA + (size_t)head * T * 64, dd, S / dd, b, rho, q0b, 0.f,
                                 OA + (size_t)p * T * 512 + head * 64, 512, LSE + (size_t)p * T * 8 + head, lds_raw);
        }
    }
}
__device__ __forceinline__ void attn_combine(const bf16_t* OA, const float* LSE, bf16_t* Y) {
    const int gt = blockIdx.x * NTH + tidx(), ngt = gridDim.x * NTH;
    for (int i = gt; i < T * 64; i += ngt) {
        const int tok = i >> 6, head = (i >> 3) & 7, c8 = i & 7;
        const float l0 = LSE[(size_t)tok * 8 + head], l1 = LSE[((size_t)T + tok) * 8 + head], l2 = LSE[((size_t)2 * T + tok) * 8 + head];
        const float mx = fmaxf(l0, fmaxf(l1, l2));
        float w0 = __expf(l0 - mx), w1 = __expf(l1 - mx), w2 = __expf(l2 - mx);
        const float inv = 1.0f / (w0 + w1 + w2); w0 *= inv; w1 *= inv; w2 *= inv;
        const size_t off = (size_t)tok * 512 + head * 64 + c8 * 8;
        const v4u x0 = *(const v4u*)(OA + off), x1 = *(const v4u*)(OA + (size_t)T * 512 + off), x2 = *(const v4u*)(OA + (size_t)2 * T * 512 + off);
        v4u w;
#pragma unroll
        for (int q = 0; q < 4; ++q) {
            const float lo = w0 * __uint_as_float(x0[q] << 16) + w1 * __uint_as_float(x1[q] << 16) + w2 * __uint_as_float(x2[q] << 16);
            const float hi = w0 * __uint_as_float(x0[q] & 0xffff0000u) + w1 * __uint_as_float(x1[q] & 0xffff0000u) + w2 * __uint_as_float(x2[q] & 0xffff0000u);
            w[q] = pk2(lo, hi);
        }
        *(v4u*)(Y + (size_t)tok * D + head * 64 + c8 * 8) = w;
    }
}


__device__ __forceinline__ void odd_token_pass(const bf16_t* P, const float* mu, const float* k_k, const float* clg, const float* clb,
                                               bf16_t* VN, bf16_t* RV, bf16_t* KBf, bf16_t* KK, bf16_t* F5) {
    const int tix_ = tidx(); const int lane = tix_ & 63, gw = blockIdx.x * 8 + (tix_ >> 6), ngw = gridDim.x * 8;
    float2 m0c[15], m1c[15], kkc[4], lgc[4], lbc[4];
#pragma unroll
    for (int jj = 0; jj < 15; ++jj) { const int c = 2 * lane + 128 * jj; m0c[jj] = *(const float2*)(mu + c); m1c[jj] = *(const float2*)(mu + FD + c); }
#pragma unroll
    for (int jj = 0; jj < 4; ++jj) { const int c = 2 * lane + 128 * jj; kkc[jj] = *(const float2*)(k_k + c); lgc[jj] = *(const float2*)(clg + c); lbc[jj] = *(const float2*)(clb + c); }
    for (int tok = gw; tok < T; tok += ngw) {
        const int s = tok & (S - 1);
        const bf16_t* pr = P + (size_t)tok * ODD_PAD;
        {
            float ge[8]; float sm = 0.f;
#pragma unroll
            for (int jj = 0; jj < 4; ++jj) { const unsigned w = *(const unsigned*)(pr + 512 + 2 * lane + 128 * jj);
                ge[2 * jj] = gelu_tanh(__uint_as_float(w << 16)); ge[2 * jj + 1] = gelu_tanh(__uint_as_float(w & 0xffff0000u)); sm += ge[2 * jj] + ge[2 * jj + 1]; }
            const float mean = wave_sum(sm) * (1.0f / 512.f); float sq = 0.f;
#pragma unroll
            for (int j = 0; j < 8; ++j) { const float d = ge[j] - mean; sq += d * d; }
            const float rstd = rsqrtf(wave_sum(sq) * (1.0f / 512.f) + 1e-5f);
#pragma unroll
            for (int jj = 0; jj < 4; ++jj) { const int c = 2 * lane + 128 * jj;
                *(unsigned*)(VN + (size_t)tok * 512 + c) = pk2((ge[2 * jj] - mean) * rstd * lgc[jj].x + lbc[jj].x, (ge[2 * jj + 1] - mean) * rstd * lgc[jj].y + lbc[jj].y); }
        }
#pragma unroll
        for (int jj = 0; jj < 15; ++jj) {
            const int c = 2 * lane + 128 * jj;
            const unsigned wf = *(const unsigned*)(pr + 1024 + c);
            const unsigned wp = s > 0 ? *(const unsigned*)(pr + 1024 + c - ODD_PAD) : 0u;
            const unsigned wn = s < S - 1 ? *(const unsigned*)(pr + 1024 + c + ODD_PAD) : 0u;
            const float2 m0 = m0c[jj], m1 = m1c[jj];
            const float f0 = __uint_as_float(wf << 16), f1 = __uint_as_float(wf & 0xffff0000u);
            const float x0 = f0 + m0.x * (__uint_as_float(wp << 16) - f0) + m1.x * (__uint_as_float(wn << 16) - f0);
            const float x1 = f1 + m0.y * (__uint_as_float(wp & 0xffff0000u) - f1) + m1.y * (__uint_as_float(wn & 0xffff0000u) - f1);
            if (jj < 4) *(unsigned*)(RV + (size_t)tok * D + c) = pk2(x0, x1);
            else if (jj < 8) {
                const int ck = c - 512;
                *(unsigned*)(KBf + (size_t)tok * 512 + ck) = pk2(x0, x1);
                const float2 kk_ = kkc[jj - 4];
                const float a0_ = x0 * kk_.x, a1_ = x1 * kk_.y;
                float ss = a0_ * a0_ + a1_ * a1_;
#pragma unroll
                for (int o = 16; o >= 1; o >>= 1) ss += __shfl_xor(ss, o);
                const float inv = 1.0f / fmaxf(sqrtf(ss), 1e-12f);
                *(unsigned*)(KK + (size_t)tok * 512 + ck) = pk2(a0_ * inv, a1_ * inv);
            }
            else if (jj < 12) *(unsigned*)(RV + (size_t)tok * D + 512 + (c - 1024)) = pk2(x0, x1);
            else if (jj == 12) *(unsigned*)(F5 + (size_t)tok * 384 + (c - 1536)) = pk2(tanhf_(x0), tanhf_(x1));
            else if (jj == 13) *(unsigned*)(F5 + (size_t)tok * 384 + 128 + (c - 1664)) = pk2(x0, x1);
            else *(unsigned*)(F5 + (size_t)tok * 384 + 256 + (c - 1792)) = pk2(sigmoidf_(x0), sigmoidf_(x1));
        }
    }
}
__device__ __forceinline__ void gating_pass(const bf16_t* VN, const bf16_t* Wsb, const float* bsp, const bf16_t* P, bf16_t* Y, unsigned char* lds_raw) {
    LAS unsigned char* L = (LAS unsigned char*)lds_raw;
    constexpr int RS = 272;
    const int tid = tidx(), lane = tid & 63, wave = tid >> 6, fr = lane & 15, fq = lane >> 4;
    for (int it = blockIdx.x; it < 512; it += gridDim.x) {
        const int g = it & 3, chunk = it >> 2;
        __syncthreads();
        { const int j = tid >> 2, q4 = tid & 3;
          const v4u* gp = (const v4u*)(VN + (size_t)(chunk * 128 + j) * 512 + g * 128 + 32 * q4);
#pragma unroll
          for (int q = 0; q < 4; ++q) { const v4u x = gp[q];
#pragma unroll
              for (int e = 0; e < 4; ++e) { const int c = 32 * q4 + 8 * q + 2 * e;
                  *(LAS unsigned short*)(L + c * RS + 2 * j) = (unsigned short)(x[e] & 0xffffu); *(LAS unsigned short*)(L + (c + 1) * RS + 2 * j) = (unsigned short)(x[e] >> 16); } } }
        __syncthreads();
        bf16x8 lf[4];
#pragma unroll
        for (int ks = 0; ks < 4; ++ks) lf[ks] = *(const bf16x8*)(Wsb + (size_t)(g * 128 + 16 * wave + fr) * 128 + 32 * ks + 8 * fq);
        const int i = 16 * wave + fr; const size_t tok = (size_t)chunk * 128 + i;
        const float bias = bsp[g * 128 + i];
#pragma unroll
        for (int tn = 0; tn < 8; ++tn) {
            f32x4 acc = {0.f, 0.f, 0.f, 0.f};
#pragma unroll
            for (int ks = 0; ks < 4; ++ks) { const bf16x8 rf = *(const LAS bf16x8*)(L + (16 * tn + fr) * RS + (32 * ks + 8 * fq) * 2); MMA16(acc, lf[ks], rf); }
            const int c = g * 128 + 16 * tn + 4 * fq;
            const v2u uw = *(const v2u*)(P + tok * ODD_PAD + c);
            const float u0 = gelu_tanh(__uint_as_float(uw.x << 16)), u1 = gelu_tanh(__uint_as_float(uw.x & 0xffff0000u)), u2 = gelu_tanh(__uint_as_float(uw.y << 16)), u3 = gelu_tanh(__uint_as_float(uw.y & 0xffff0000u));
            v2u w; w.x = pk2(u0 * (acc[0] + bias), u1 * (acc[1] + bias)); w.y = pk2(u2 * (acc[2] + bias), u3 * (acc[3] + bias));
            *(v2u*)(Y + tok * D + c) = w;
        }
    }
}


__device__ __forceinline__ void router_pass(const float* X, const float* g, const float* WRT  , float* AFF, int* SLOT, bf16_t* H, unsigned char* lds_raw) {
    const int tix_ = tidx(); const int lane = tix_ & 63, wave = tix_ >> 6, fr = lane & 15, fq = lane >> 4;
    const int pair = wave >> 1, half = wave & 1;
    f32x4 gcr[4];
#pragma unroll
    for (int j = 0; j < 4; ++j) gcr[j] = ((const f32x4*)g)[lane + 64 * j];
    LAS float* xch = (LAS float*)lds_raw + pair * 512;
    for (int tile0 = blockIdx.x * 4; tile0 < T / 16; tile0 += gridDim.x * 4) {
        const int tile = tile0 + pair;
        const float* xr = X + (size_t)(tile * 16 + fr) * D + 4 * fq + 512 * half;
        const float* wr = WRT + (size_t)fr * D + 4 * fq + 512 * half;
        f32x4 acc = {0.f, 0.f, 0.f, 0.f}; float ss = 0.f;
#pragma unroll 8
        for (int s = 0; s < 32; ++s) {
            const f32x4 xa = *(const f32x4*)(xr + 16 * s), wb = *(const f32x4*)(wr + 16 * s);
            ss += (xa[0] * xa[0] + xa[1] * xa[1]) + (xa[2] * xa[2] + xa[3] * xa[3]);
#pragma unroll
            for (int c = 0; c < 4; ++c) acc = __builtin_amdgcn_mfma_f32_16x16x4f32(xa[c], wb[c], acc, 0, 0, 0);
        }
        ss += __shfl_xor(ss, 16); ss += __shfl_xor(ss, 32);
        __syncthreads();
        { LAS float* p = xch + half * 256 + lane * 4; p[0] = acc[0]; p[1] = acc[1]; p[2] = acc[2]; p[3] = acc[3]; }
        if (fq == 0) ((LAS float*)lds_raw + 2048 + pair * 32 + half * 16)[fr] = ss;
        __syncthreads();
        { const LAS float* p = xch + (half ^ 1) * 256 + lane * 4; acc[0] += p[0]; acc[1] += p[1]; acc[2] += p[2]; acc[3] += p[3]; }
        ss += ((const LAS float*)lds_raw + 2048 + pair * 32 + (half ^ 1) * 16)[fr];
        const float rstd = rsqrtf(ss * (1.0f / D) + 1e-6f);
        {
            float aff[4];
#pragma unroll
            for (int jj = 0; jj < 4; ++jj) {
                const float lg = acc[jj] * __shfl(rstd, 4 * fq + jj);
                float mx = lg;
#pragma unroll
                for (int o = 1; o < 16; o <<= 1) mx = fmaxf(mx, __shfl_xor(mx, o));
                const float e = expf(lg - mx); float den = e;
#pragma unroll
                for (int o = 1; o < 16; o <<= 1) den += __shfl_xor(den, o);
                aff[jj] = e / den;
            }
#pragma unroll
            for (int jj = 0; jj < 4; ++jj) { const size_t o = (size_t)(tile * 16 + 4 * fq + jj) * NE + fr; if ((fq >> 1) == half) { AFF[o] = aff[jj]; SLOT[o] = -1; } }
        }
#pragma unroll 4
        for (int tt = 0; tt < 8; ++tt) {
            const int t = 8 * half + tt;
            const float rs = __shfl(rstd, t);
            const f32x4* xp = (const f32x4*)(X + (size_t)(tile * 16 + t) * D); v2u* hp = (v2u*)(H + (size_t)(tile * 16 + t) * D);
#pragma unroll
            for (int j = 0; j < 4; ++j) { const f32x4 v = xp[lane + 64 * j], gg = gcr[j];
                v2u w; w.x = pk2(v[0] * rs * gg[0], v[1] * rs * gg[1]); w.y = pk2(v[2] * rs * gg[2], v[3] * rs * gg[3]); hp[lane + 64 * j] = w; }
        }
    }
}


__device__ __forceinline__ void lora_pass(const bf16_t* F5, const bf16_t* WC, const float* w0, const float* a0, const float* k_a, const bf16_t* KB, const bf16_t* KK,
                                          bf16_t* LW, bf16_t* KD, bf16_t* BB, bf16_t* G, unsigned char* lds_raw) {
    LAS unsigned char* L = (LAS unsigned char*)lds_raw;
    constexpr int ARS = 784;
    const int tid = tidx(), lane = tid & 63, wave = tid >> 6, fr = lane & 15, fq = lane >> 4;
    for (int tile = blockIdx.x; tile < T / 64; tile += gridDim.x) {
        __syncthreads();
#pragma unroll
        for (int q = 0; q < 6; ++q) { const int p = tid + 512 * q, row = p / 48, piece = p % 48;
            *(LAS v4u*)(L + row * ARS + piece * 16) = *(const v4u*)(F5 + (size_t)(tile * 64 + row) * 384 + piece * 8); }
        __syncthreads();
#pragma unroll 1
        for (int sec = 0; sec < 5; ++sec) {
            const int K0 = sec * 64, nks = sec < 4 ? 2 : 4, wstride = sec < 4 ? 64 : 128;
            const bf16_t* Wp = WC + (size_t)sec * 512 * 64 + (size_t)(64 * wave) * wstride;
#pragma unroll 1
            for (int nh = 0; nh < 2; ++nh) {
            f32x4 acc[4][2];
#pragma unroll
            for (int tm = 0; tm < 4; ++tm)
#pragma unroll
                for (int tn = 0; tn < 2; ++tn) acc[tm][tn] = (f32x4){0.f, 0.f, 0.f, 0.f};
            for (int ks = 0; ks < nks; ++ks) {
                bf16x8 lf[4], rf[2];
#pragma unroll
                for (int tm = 0; tm < 4; ++tm) lf[tm] = *(const LAS bf16x8*)(L + (16 * tm + fr) * ARS + (K0 + 32 * ks + 8 * fq) * 2);
#pragma unroll
                for (int tn = 0; tn < 2; ++tn) rf[tn] = *(const bf16x8*)(Wp + (size_t)(16 * (2 * nh + tn) + fr) * wstride + 32 * ks + 8 * fq);
#pragma unroll
                for (int tm = 0; tm < 4; ++tm)
#pragma unroll
                    for (int tn = 0; tn < 2; ++tn) MMA16(acc[tm][tn], lf[tm], rf[tn]);
            }
#pragma unroll
            for (int tn = 0; tn < 2; ++tn) {
                const int cc = 64 * wave + 16 * (2 * nh + tn) + 4 * fq;
#pragma unroll
                for (int tm = 0; tm < 4; ++tm) {
                    const size_t tok = (size_t)tile * 64 + 16 * tm + fr; const f32x4 v = acc[tm][tn];
                    __builtin_amdgcn_sched_barrier(0);
                    if (sec < 2) {
                        const f32x4 w = *(const f32x4*)(w0 + sec * 512 + cc); float o[4];
#pragma unroll
                        for (int j = 0; j < 4; ++j) o[j] = -0.6065306597126334f * frcp(1.0f + __expf(-(w[j] + v[j])));
                        v2u ww; ww.x = pk2(o[0], o[1]); ww.y = pk2(o[2], o[3]);
                        *(v2u*)(LW + ((size_t)sec * T + tok) * 512 + cc) = ww;
                    } else if (sec < 4) {
                        const int d = sec - 2;
                        const f32x4 a_ = *(const f32x4*)(a0 + d * 512 + cc), ka = *(const f32x4*)(k_a + cc);
                        const v2u kw = *(const v2u*)(KB + tok * 512 + cc), kkw = *(const v2u*)(KK + tok * 512 + cc);
                        const float kv[4] = {bflo(kw.x), bfhi(kw.x), bflo(kw.y), bfhi(kw.y)}, kk[4] = {bflo(kkw.x), bfhi(kkw.x), bflo(kkw.y), bfhi(kkw.y)};
                        float okd[4], obb[4];
#pragma unroll
                        for (int j = 0; j < 4; ++j) { const float alr = frcp(1.0f + __expf(-(a_[j] + v[j]))); okd[j] = kv[j] * (1.0f + (alr - 1.0f) * ka[j]); obb[j] = kk[j] * alr; }
                        v2u w1, w2_; w1.x = pk2(okd[0], okd[1]); w1.y = pk2(okd[2], okd[3]); w2_.x = pk2(obb[0], obb[1]); w2_.y = pk2(obb[2], obb[3]);
                        *(v2u*)(KD + ((size_t)d * T + tok) * 512 + cc) = w1; *(v2u*)(BB + ((size_t)d * T + tok) * 512 + cc) = w2_;
                    } else { v2u ww; ww.x = pk2(v[0], v[1]); ww.y = pk2(v[2], v[3]); *(v2u*)(G + tok * 512 + cc) = ww; }
                }
            }
            }
        }
    }
}

#define IN(k) (lo <= (k) && (k) < hi)
#define REP_LOOP for (int rep_ = 0, nrep_ = ((ph == PROBE_PHASE) ? PROBE_REP : 1); rep_ < nrep_; ++rep_)
#define SEAM(k) do { if (IN(k) && IN((k) + 1)) xcd_barrier(bar); } while (0)
#define PROLOG \
    const int tid = tidx(), lane = tid & 63, wave = tid >> 6; \
    const int bid = blockIdx.x, nb = gridDim.x; \
    const int gw = bid * 8 + wave, ngw = nb * 8; \
    const int gt = bid * NTH + tid, ngt = nb * NTH; \
    (void)gt; (void)ngt; (void)gw; (void)ngw; (void)lane; (void)wave; \
    unsigned char* ws = a.ws; \
    const int lo = a.lo, hi = a.hi; \
    float* ldsf = (float*)lds_raw; (void)ldsf; \
    PG8_LAS unsigned char* ldsp = (PG8_LAS unsigned char*)lds_raw; (void)ldsp; \
    const float* x_in = a.in[0]; const float* mem = a.in[1]; (void)x_in; (void)mem; \
    float* ropec = (float*)(ws + WS_ROPE); float* ropes = ropec + S * 32; (void)ropec; (void)ropes; \
    float* AFF = (float*)(ws + WS_AFF); int* TOK = (int*)(ws + WS_TOK); float* GATE = (float*)(ws + WS_GATE); \
    float* X = (float*)(ws + WS_X); bf16_t* H = (bf16_t*)(ws + WS_H); bf16_t* P = (bf16_t*)(ws + WS_P); \
    bf16_t* Y = (bf16_t*)(ws + WS_Y); bf16_t* Q = (bf16_t*)(ws + WS_Q); bf16_t* KV = (bf16_t*)(ws + WS_KV); bf16_t* MN = (bf16_t*)(ws + WS_MN); \
    bf16_t* DEC = (bf16_t*)(ws + WS_DEC); bf16_t* KD = (bf16_t*)(ws + WS_KD); bf16_t* BB = (bf16_t*)(ws + WS_BB); \
    bf16_t* KK = (bf16_t*)(ws + WS_KK); bf16_t* G = (bf16_t*)(ws + WS_G); float* YS = (float*)(ws + WS_YS); \
    bf16_t* RV = (bf16_t*)(ws + WS_RV); bf16_t* VN = (bf16_t*)(ws + WS_VN); \
    bf16_t* XE = (bf16_t*)(ws + WS_XE); bf16_t* HID = (bf16_t*)(ws + WS_HID); int* SLOT = (int*)(ws + WS_SLOT); bf16_t* YE = (bf16_t*)(ws + WS_YE); (void)SLOT; (void)YE; \
    (void)AFF; (void)TOK; (void)GATE; (void)X; (void)H; (void)P; (void)Y; (void)Q; (void)KV; (void)MN; (void)DEC; (void)KD; (void)BB; (void)KK; (void)G; (void)YS; (void)RV; (void)VN; (void)XE; (void)HID;

template <class Epi>
__device__ __forceinline__ void dense_gemm(PG8_LAS unsigned char* ldsp, const bf16_t* A, const bf16_t* Bt, int M, int N, int K, const Epi& E, int cshift = 0) {
    asm volatile("" : "+s"(K));
    pg8::Gemm g{A, Bt, M, N, K}; pg8::StaticOrder So; So.init(M, N, (int)gridDim.x, (int)((blockIdx.x + cshift) % gridDim.x));
    pg8::gemm_phase<Epi, pg8::StaticOrder, false>(ldsp, g, So, E, nullptr);
}

__device__ __forceinline__ int odd_phases(const Args& a, const XcdBarrier& bar, unsigned char* lds_raw, int ph) {
    PROLOG
    if (IN(ph)) combine_norm<false>(X, YE, SLOT, a.in[6], H, nullptr);
    SEAM(ph); ++ph;
    if (IN(ph)) dense_gemm(ldsp, H, (const bf16_t*)(ws + WS_WOIN), T, ODD_PAD, D, EpiBf16Store{P, ODD_PAD, 1.0f});
    SEAM(ph); ++ph;
    if (IN(ph)) REP_LOOP odd_token_pass(P, a.in[12], a.in[18], a.in[8], a.in[9], VN, RV, (bf16_t*)(ws + WS_KB), KK, (bf16_t*)(ws + WS_F5));
    SEAM(ph); ++ph;
    if (IN(ph)) REP_LOOP {
        gating_pass(VN, (const bf16_t*)(ws + WS_WSB), a.in[11], P, Y, lds_raw);
        __syncthreads();
        lora_pass((const bf16_t*)(ws + WS_F5), (const bf16_t*)(ws + WS_WL), a.in[13], a.in[15], a.in[19], (const bf16_t*)(ws + WS_KB), KK, DEC, KD, BB, G, lds_raw);
    }
    SEAM(ph); ++ph;
    if (IN(ph)) REP_LOOP scan_r1(DEC, RV, KD, KK, BB, (bf16_t*)(ws + WS_PT), (bf16_t*)(ws + WS_QT), (bf16_t*)(ws + WS_RH), (float*)(ws + WS_YL), lds_raw);
    SEAM(ph); ++ph;
    if (IN(ph)) REP_LOOP {
        if (bid < 32) scan_r2((const bf16_t*)(ws + WS_PT), (const bf16_t*)(ws + WS_QT), (bf16_t*)(ws + WS_S0), lds_raw);
        else {
            LAS float* scr = (LAS float*)((LAS unsigned char*)lds_raw + wave * 16896);
            const int gw2 = (bid - 32) * 8 + wave, ngw2 = (nb - 32) * 8;
            auto gmap = [](int n) { return (n >> 7) * 256 + (n & 127); };
            auto umap = [](int n) { return (n >> 7) * 256 + 128 + (n & 127); };
            for (int it = gw2; it < 16 * 704; it += ngw2) { const int e = it / 704, r = it % 704;
                transpose_item_fp8(a.in[31] + (size_t)(16 + e) * D * DE, D, DE, ws + WS_WGU8 + 176 * MiB + (size_t)e * 5632 * D, gmap, GUSC8, scr, r, lane); }
            for (int it = gw2; it < 16 * 704; it += ngw2) { const int e = it / 704, r = it % 704;
                transpose_item_fp8(a.in[32] + (size_t)(16 + e) * D * DE, D, DE, ws + WS_WGU8 + 176 * MiB + (size_t)e * 5632 * D, umap, GUSC8, scr, r, lane); }
        }
    }
    SEAM(ph); ++ph;
    if (IN(ph)) REP_LOOP scan_r3((const bf16_t*)(ws + WS_RH), (const float*)(ws + WS_YL), (const bf16_t*)(ws + WS_S0), RV, KD, G, a.in[20], a.in[21], a.in[22], Y);
    SEAM(ph); ++ph;
    if (IN(ph)) dense_gemm(ldsp, Y, (const bf16_t*)(ws + WS_WOOUT), T, D, D, EpiResidN{X, X, H, (float*)(ws + WS_SSP)});
    SEAM(ph); ++ph;
    return ph;
}

template <int layer>
__device__ __forceinline__ int tail_phases(const Args& a, const XcdBarrier& bar, unsigned char* lds_raw, int ph) {
    PROLOG
    if (IN(ph)) REP_LOOP {
        int Kq = D; asm volatile("" : "+s"(Kq));
        pg8::Gemm g{H, (const bf16_t*)(ws + WS_WQ) + (size_t)layer * D * D, T, D, Kq}; XattnOrder So{(int)blockIdx.x};
        pg8::gemm_phase<EpiBf16StoreRS, XattnOrder, false>(ldsp, g, So, EpiBf16StoreRS{Q, D, (const float*)(ws + WS_SSP)}, nullptr);
        asm volatile("s_waitcnt vmcnt(0)" ::: "memory");
        __syncthreads();
        xattn_mfma(Q, KV + (size_t)layer * 1024 * 1024, KV + (size_t)layer * 1024 * 1024 + 512 * 1024, Y, lds_raw);
    }
    SEAM(ph); ++ph;
    if (IN(ph)) dense_gemm(ldsp, Y, (const bf16_t*)(ws + WS_WO) + (size_t)layer * D * D, T, D, D, EpiResid{X, X});
    SEAM(ph); ++ph;
    if (IN(ph)) REP_LOOP router_pass(X, a.in[29] + layer * D, (const float*)(ws + WS_WRT) + (size_t)layer * NE * D, AFF, SLOT, H, lds_raw);
    SEAM(ph); ++ph;
    if (IN(ph)) REP_LOOP {
        unsigned* keys = (unsigned*)ldsf;
        int* hist = (int*)(ldsf + 8192);
        int* sh = hist + 8 * 256;
        if (bid >= 32) {
            LAS float* scr = (LAS float*)((LAS unsigned char*)lds_raw + wave * 16896);
            const int gw2 = (bid - 32) * 8 + wave, ngw2 = (nb - 32) * 8;
            auto ident = [](int n) { return n; };
            if constexpr (layer == 0) {
                auto gmap = [](int n) { return (n >> 7) * 256 + (n & 127); };
                auto umap = [](int n) { return (n >> 7) * 256 + 128 + (n & 127); };
        for (int it = 4096 + gw2; it < 16 * 704; it += ngw2) { const int mt = it / 704, r = it % 704;
            if constexpr (F8L0) transpose_item_fp8(a.in[31] + (size_t)mt * D * DE, D, DE, ws + WS_WGU8 + (size_t)mt * 5632 * D, gmap, GUSC8, scr, r, lane);
            else transpose_item(a.in[31] + (size_t)mt * D * DE, D, DE, (bf16_t*)(ws + WS_WGU) + (size_t)mt * 5632 * D, gmap, scr, r, lane); }
        for (int it = gw2; it < 16 * 704; it += ngw2) { const int mt = it / 704, r = it % 704;
            if constexpr (F8L0) transpose_item_fp8(a.in[32] + (size_t)mt * D * DE, D, DE, ws + WS_WGU8 + (size_t)mt * 5632 * D, umap, GUSC8, scr, r, lane);
            else transpose_item(a.in[32] + (size_t)mt * D * DE, D, DE, (bf16_t*)(ws + WS_WGU) + (size_t)mt * 5632 * D, umap, scr, r, lane); }
            }
            for (int it = gw2; it < 16 * 704; it += ngw2) { const int mt = layer * 16 + it / 704, r = it % 704;
                if constexpr (layer == 1 || F8L0) transpose_item_fp8(a.in[33] + (size_t)mt * DE * D, DE, D, ws + WS_WD8 + (size_t)layer * 88 * MiB + (size_t)(mt - 16 * layer) * D * DE, ident, DSC8, scr, r, lane);
                else transpose_item(a.in[33] + (size_t)mt * DE * D, DE, D, (bf16_t*)(ws + WS_WD) + (size_t)mt * D * DE, ident, scr, r, lane); }
        }
        for (int be = bid; be < NB * NE && be < 32; be += nb) {
            const int b = be >> 4, e = be & 15, eb = e * 2 + b;
            __syncthreads();
            for (int s = tid; s < S; s += NTH) keys[s] = __float_as_uint(AFF[(size_t)(b * S + s) * NE + e]);
            unsigned prefix = 0u; int krem = CAP;
            for (int pass = 3; pass >= 0; --pass) {
                __syncthreads();
                for (int i = tid; i < 8 * 256; i += NTH) hist[i] = 0;
                __syncthreads();
                const unsigned hmask = pass == 3 ? 0u : (0xFFFFFFFFu << (8 * (pass + 1)));
                for (int s = tid; s < S; s += NTH) { const unsigned k = keys[s]; if ((k & hmask) == prefix) atomicAdd(&hist[wave * 256 + ((k >> (8 * pass)) & 255u)], 1); }
                __syncthreads();
                if (wave == 0) {
                    int c4[4], s4 = 0;
#pragma unroll
                    for (int j = 0; j < 4; ++j) { const int bin = 255 - (4 * lane + j); int c = 0;
#pragma unroll
                        for (int w = 0; w < 8; ++w) c += hist[w * 256 + bin];
                        c4[j] = c; s4 += c; }
                    int pre = s4;
#pragma unroll
                    for (int o = 1; o < 64; o <<= 1) { const int y = __shfl_up(pre, o); if (lane >= o) pre += y; }
                    const int excl = pre - s4;
                    if (excl < krem && krem <= pre) {
                        int cum = excl, bsel = 0, rem = 0; bool found = false;
#pragma unroll
                        for (int j = 0; j < 4; ++j) { if (!found && cum + c4[j] >= krem) { bsel = 255 - (4 * lane + j); rem = krem - cum; found = true; } if (!found) cum += c4[j]; }
                        sh[8] = bsel; sh[9] = rem;
                    }
                }
                __syncthreads();
                prefix |= ((unsigned)sh[8]) << (8 * pass); krem = sh[9];
            }
            const unsigned thr = prefix;
            int ce = 0;
            for (int i = 0; i < 16; ++i) { const unsigned k = keys[tid * 16 + i]; ce += (k == thr); }
            int tot;
            const int eqbase = block_exscan(ce, sh, &tot);
            int eqr = eqbase, cs = 0;
            for (int i = 0; i < 16; ++i) { const unsigned k = keys[tid * 16 + i]; const bool sel = (k > thr) || (k == thr && eqr < krem); eqr += (k == thr); cs += sel; }
            const int sbase = block_exscan(cs, sh, &tot);
            int slot = sbase; eqr = eqbase;
            for (int i = 0; i < 16; ++i) {
                const int s = tid * 16 + i; const unsigned k = keys[s];
                const bool sel = (k > thr) || (k == thr && eqr < krem); eqr += (k == thr);
                if (sel) { TOK[eb * CAP + slot] = b * S + s; GATE[eb * CAP + slot] = __uint_as_float(k); SLOT[(size_t)(b * S + s) * NE + e] = eb * CAP + slot; ++slot; }
            }
        }
    }
    SEAM(ph); ++ph;
    if (IN(ph)) REP_LOOP {
        for (int r = gw; r < NB * NE * CAP; r += ngw) {
            int rv_ = r; asm volatile("" : "+v"(rv_));
            if constexpr (layer == 1 || F8L0) {
                const v4u* srcp = (const v4u*)(H + (size_t)TOK[rv_] * D) + 2 * lane; const v4u x0 = srcp[0], x1 = srcp[1];
                v4u o;
                o.x = pk4_fp8(bflo(x0.x) * ASC8, bfhi(x0.x) * ASC8, bflo(x0.y) * ASC8, bfhi(x0.y) * ASC8); o.y = pk4_fp8(bflo(x0.z) * ASC8, bfhi(x0.z) * ASC8, bflo(x0.w) * ASC8, bfhi(x0.w) * ASC8);
                o.z = pk4_fp8(bflo(x1.x) * ASC8, bfhi(x1.x) * ASC8, bflo(x1.y) * ASC8, bfhi(x1.y) * ASC8); o.w = pk4_fp8(bflo(x1.z) * ASC8, bfhi(x1.z) * ASC8, bflo(x1.w) * ASC8, bfhi(x1.w) * ASC8);
                ((v4u*)((unsigned char*)XE + (size_t)r * D))[lane] = o;
            } else {
                const v4u* srcp = (const v4u*)(H + (size_t)TOK[rv_] * D); v4u* dst = (v4u*)(XE + (size_t)r * D);
                dst[lane] = srcp[lane]; dst[lane + 64] = srcp[lane + 64];
            }
        }
    }
    SEAM(ph); ++ph;
    if (IN(ph)) {
        MoeOrder So{(int)gridDim.x, (int)blockIdx.x, 16 * 22, 22};
        if constexpr (layer == 1 || F8L0) {
            int Kg = D / 2; asm volatile("" : "+s"(Kg));
            pg8::Gemm g{XE, (const bf16_t*)(ws + WS_WGU8 + (size_t)layer * 176 * MiB), NB * NE * CAP, NE * 5632, Kg};
            pg8::gemm_phase<EpiSiluMul8, MoeOrder, false, true>(ldsp, g, So, EpiSiluMul8{(unsigned char*)HID}, nullptr);
        } else {
            pg8::Gemm g{XE, (const bf16_t*)(ws + WS_WGU) + (size_t)layer * NE * 5632 * D, NB * NE * CAP, NE * 5632, D};
            pg8::gemm_phase<EpiSiluMul, MoeOrder, false>(ldsp, g, So, EpiSiluMul{HID}, nullptr);
        }
    }
    SEAM(ph); ++ph;
    if (IN(ph)) {
        MoeOrder So{(int)gridDim.x, (int)blockIdx.x, 16 * 4, 4};
        if constexpr (layer == 1 || F8L0) {
            int Kg = DE / 2; asm volatile("" : "+s"(Kg));
            pg8::Gemm g{HID, (const bf16_t*)(ws + WS_WD8 + (size_t)layer * 88 * MiB), NB * NE * CAP, NE * D, Kg};
            pg8::gemm_phase<EpiYE8, MoeOrder, false, true>(ldsp, g, So, EpiYE8{GATE, YE}, nullptr);
        } else {
            pg8::Gemm g{HID, (const bf16_t*)(ws + WS_WD) + (size_t)layer * NE * D * DE, NB * NE * CAP, NE * D, DE};
            pg8::gemm_phase<EpiYE, MoeOrder, false>(ldsp, g, So, EpiYE{GATE, YE}, nullptr);
        }
    }
    SEAM(ph); ++ph;
    return ph;
}

__global__ void __launch_bounds__(NTH, 2) mega(Args a) {
    extern __shared__ __attribute__((aligned(16))) unsigned char lds_raw[];
    unsigned* ctl = (unsigned*)(a.ws + WS_CTL);
    volatile LAS unsigned* bst = (volatile LAS unsigned*)((LAS unsigned char*)lds_raw + LDS_BAR_OFF);
    { const int t0_ = tidx(); if (t0_ < 4) bst[t0_] = 0u; }
    __syncthreads();
    XcdBarrier bar; bar.bar = ctl + CW_BAR; bar.x = 0; bar.st = bst;
    if (a.hi - a.lo > 1) bar = xcd_barrier_post(ctl + CW_BAR, bst);
    PROLOG

    int ph = 0;
    if (IN(ph)) REP_LOOP {
        for (int i = gt; i < S * 32; i += ngt) {
            const int s = i >> 5, f = i & 31;
            const float pw = (float)exp((double)((float)(2 * f) / 64.0f) * 9.210340371976184);
            const float invf = 1.0f / pw;
            const float angf = (float)s * invf;
            double xx = (double)angf;
            const double n = rint(xx * 0.15915494309189535);
            xx = (xx - n * 6.283185307179586) - n * 2.4492935982947064e-16;
            const double x2 = xx * xx;
            double cs = 1.0, sn = xx, tc = 1.0, tsn = xx;
#pragma unroll 1
            for (int k = 1; k <= 16; ++k) { tc *= -x2 / (double)((2 * k - 1) * (2 * k)); tsn *= -x2 / (double)((2 * k) * (2 * k + 1)); cs += tc; sn += tsn; }
            ropec[i] = (float)cs; ropes[i] = (float)sn;
        }
        rmsnorm_rows_bf16(x_in, a.in[2], H, T);
        rmsnorm_rows_bf16(mem, a.in[25], MN, NB * MEM); rmsnorm_rows_bf16(mem, a.in[25] + D, MN + NB * MEM * D, NB * MEM);
        LAS float* scr = (LAS float*)((LAS unsigned char*)lds_raw + wave * 16896);
        auto ident = [](int n) { return n; };
        auto emap = [](int n) { const bool il = (n < 1024) || (n >= 1536 && n < 2176); const int j = n & 63; return il ? ((n & ~63) + (j < 32 ? 2 * j : 2 * (j - 32) + 1)) : n; };
        for (int it = gw; it < 16 * 36; it += ngw) transpose_item(a.in[3], D, EVEN_IN, (bf16_t*)(ws + WS_WEIN), emap, scr, it, lane);
        for (int it = gw; it < 2 * 16 * 32; it += ngw) { const int l = it / 512, r = it % 512; transpose_item(a.in[27] + (size_t)l * D * 2048, D, 2048, (bf16_t*)(ws + WS_WKV) + (size_t)l * 2048 * D, ident, scr, r, lane); }
        { float* WRT = (float*)(ws + WS_WRT);
          for (int i = gt; i < 2 * NE * D; i += ngt) { const int l = i >> 14, e = (i >> 10) & 15, k = i & 1023; WRT[i] = a.in[29][l * D + k] * a.in[30][((size_t)l * D + k) * NE + e]; } }
        { bf16_t* Wsb = (bf16_t*)(ws + WS_WSB); const float* wsp = a.in[10];
          for (int i = gt; i < 4 * 128 * 128; i += ngt) Wsb[i] = (bf16_t)f2bf(wsp[i]);
          bf16_t* WL = (bf16_t*)(ws + WS_WL); const float *w2 = a.in[14], *a2 = a.in[16], *g2 = a.in[17];
          for (int i = gt; i < 4 * 512 * 64 + 512 * 128; i += ngt) { float v;
              if (i < 4 * 512 * 64) { const int sec = i >> 15, n = (i >> 6) & 511, k = i & 63; v = (sec < 2 ? w2 : a2)[(size_t)((sec & 1) * 64 + k) * 512 + n]; }
              else { const int j = i - 4 * 512 * 64, n = j >> 7, k = j & 127; v = g2[(size_t)k * 512 + n]; }
              WL[i] = (bf16_t)f2bf(v); } }
        auto gmap = [](int n) { return (n >> 7) * 256 + (n & 127); };
        auto umap = [](int n) { return (n >> 7) * 256 + 128 + (n & 127); };
    }
    SEAM(ph); ++ph;

    if (IN(ph)) dense_gemm(ldsp, H, (const bf16_t*)(ws + WS_WEIN), T, EVEN_IN, D,
                           EpiEven{ropec, ropes, (bf16_t*)(ws + WS_QHA), (bf16_t*)(ws + WS_KHA), (bf16_t*)(ws + WS_QHB), (bf16_t*)(ws + WS_KHB), (bf16_t*)(ws + WS_VTA), (bf16_t*)(ws + WS_VTB)});
    if (IN(ph)) {
        dense_gemm(ldsp, MN, (const bf16_t*)(ws + WS_WKV), NB * MEM, 2048, D, EpiKV{KV, KV + 512 * 1024}, 192);
        dense_gemm(ldsp, MN + NB * MEM * D, (const bf16_t*)(ws + WS_WKV) + (size_t)2048 * D, NB * MEM, 2048, D, EpiKV{KV + 1024 * 1024, KV + 1024 * 1024 + 512 * 1024}, 176);
        if (bid >= 96) {
            __syncthreads();
            LAS float* scr = (LAS float*)((LAS unsigned char*)lds_raw + wave * 16896);
            const int gw3 = (bid - 96) * 8 + wave, ngw3 = (nb - 96) * 8;
            auto ident = [](int n) { return n; };
            auto gmap = [](int n) { return (n >> 7) * 256 + (n & 127); };
        for (int it = gw3; it < 16 * 16; it += ngw3) transpose_item(a.in[5], D, D, (bf16_t*)(ws + WS_WEOUT), ident, scr, it, lane);
        for (int it = gw3; it < 16 * 46; it += ngw3) transpose_item(a.in[7], D, ODD_IN, (bf16_t*)(ws + WS_WOIN), ident, scr, it, lane);
        for (int it = gw3; it < 16 * 16; it += ngw3) transpose_item(a.in[23], D, D, (bf16_t*)(ws + WS_WOOUT), ident, scr, it, lane);
        for (int it = gw3; it < 2 * 16 * 16; it += ngw3) { const int l = it / 256, r = it % 256; transpose_item(a.in[26] + (size_t)l * D * D, D, D, (bf16_t*)(ws + WS_WQ) + (size_t)l * D * D, ident, scr, r, lane, a.in[24] + l * D); }
        for (int it = gw3; it < 2 * 16 * 16; it += ngw3) { const int l = it / 256, r = it % 256; transpose_item(a.in[28] + (size_t)l * D * D, D, D, (bf16_t*)(ws + WS_WO) + (size_t)l * D * D, ident, scr, r, lane); }
            for (int it = gw3; it < 4096; it += ngw3) { const int mt = it / 704, r = it % 704;
                if constexpr (F8L0) transpose_item_fp8(a.in[31] + (size_t)mt * D * DE, D, DE, ws + WS_WGU8 + (size_t)mt * 5632 * D, gmap, GUSC8, scr, r, lane);
                else transpose_item(a.in[31] + (size_t)mt * D * DE, D, DE, (bf16_t*)(ws + WS_WGU) + (size_t)mt * 5632 * D, gmap, scr, r, lane); }
        }
    }
    SEAM(ph); ++ph;
    if (IN(ph)) REP_LOOP attn_phase_even((const bf16_t*)(ws + WS_QHA), (const bf16_t*)(ws + WS_KHA), (const bf16_t*)(ws + WS_VTA), (const bf16_t*)(ws + WS_QHB), (const bf16_t*)(ws + WS_KHB),
                                (const bf16_t*)(ws + WS_VTB), a.in[4], (bf16_t*)(ws + WS_OA), (float*)(ws + WS_LSE), Y, lds_raw);
    SEAM(ph); ++ph;
    if (IN(ph)) REP_LOOP attn_combine((const bf16_t*)(ws + WS_OA), (const float*)(ws + WS_LSE), Y);
    SEAM(ph); ++ph;
    if (IN(ph)) dense_gemm(ldsp, Y, (const bf16_t*)(ws + WS_WEOUT), T, D, D, EpiResidN{x_in, X, H, (float*)(ws + WS_SSP)});
    SEAM(ph); ++ph;

    ph = tail_phases<0>(a, bar, lds_raw, ph);
    ph = odd_phases(a, bar, lds_raw, ph);
    ph = tail_phases<1>(a, bar, lds_raw, ph);

    if (IN(ph)) combine_norm<true>(X, YE, SLOT, a.in[34], nullptr, a.out);
    ++ph;
}
constexpr int NPHASES = 1 + 4 + 2 * 7 + 8 + 1;
#undef IN
#undef SEAM
}

extern "C" void kernel_launch(void* const* d_in, const int* in_sizes, int n_in, void* d_out, int out_size, void* d_ws, size_t ws_size, hipStream_t stream) {
    static int grid = 0;
    if (grid == 0) {
        if (n_in != 35 || out_size != T * D || ws_size < WS_END) { fprintf(stderr, "kernel_launch: unexpected shapes n_in %d out %d ws %zu (need %zu)\n", n_in, out_size, ws_size, (size_t)WS_END); grid = -1; return; }
        int dev = 0, cus = 0, per_cu = 0;
        (void)hipGetDevice(&dev); (void)hipDeviceGetAttribute(&cus, hipDeviceAttributeMultiprocessorCount, dev);
        if (hipFuncSetAttribute((const void*)mega, hipFuncAttributeMaxDynamicSharedMemorySize, LDS_BYTES) != hipSuccess) { fprintf(stderr, "hipFuncSetAttribute failed\n"); grid = -1; return; }
        if (hipOccupancyMaxActiveBlocksPerMultiprocessor(&per_cu, (const void*)mega, NTH, LDS_BYTES) != hipSuccess || per_cu < 1) fprintf(stderr, "occupancy query: %d\n", per_cu);
        (void)hipGetLastError();
        grid = cus > 0 ? cus : 256;
    }
    if (grid < 0) return;
    (void)hipMemsetAsync((char*)d_ws + WS_CTL, 0, CTL_BYTES, stream);
    Args a{};
    for (int i = 0; i < 35; ++i) a.in[i] = (const float*)d_in[i];
    a.out = (float*)d_out; a.ws = (unsigned char*)d_ws;
#if MK_MULTI
    for (int k = 0; k < NPHASES; ++k) { a.lo = k; a.hi = k + 1; hipLaunchKernelGGL(mega, dim3(grid), dim3(NTH), LDS_BYTES, stream, a); }
#else
    a.lo = 0; a.hi = NPHASES; hipLaunchKernelGGL(mega, dim3(grid), dim3(NTH), LDS_BYTES, stream, a);
#endif
}
```

```cpp
#include <hip/hip_runtime.h>
#include <cstdio>
#include <cstdint>

#ifndef PROBE_PHASE
#define PROBE_PHASE (-1)
#endif
#ifndef PROBE_REP
#define PROBE_REP 1
#endif
#ifndef MK_MULTI
#define MK_MULTI 0
#endif

__device__ __forceinline__ int tidx() { int t = threadIdx.x; asm volatile("" : "+v"(t)); return t; }
namespace pg8 {
#define PG8_LAS __attribute__((address_space(3)))
typedef unsigned short bf16_t;
typedef short bf16x8 __attribute__((ext_vector_type(8)));
typedef float f32x4 __attribute__((ext_vector_type(4)));
typedef unsigned u32x4 __attribute__((ext_vector_type(4)));
constexpr int BM = 256, BK = 64, HALF = 128, HTB = HALF * BK * 2  , STAGE_BYTES = 8 * HTB, NXCD = 8, WGM = 8;

__host__ __device__ __forceinline__ int lds_byte(int r, int c) { const int st = (r >> 4) * 2 + (c >> 5), rr = r & 15, cc = c & 31, ob = rr * 64 + cc * 2; return st * 1024 + (ob ^ (((ob >> 9) & 1) << 5)); }
__host__ __device__ __forceinline__ void stage_rc(int b, int& R, int& C) { const int st = b / 1024, sb = b % 1024, swz = sb ^ (((sb >> 9) & 1) << 5); R = (st >> 1) * 16 + swz / 64; C = (st & 1) * 32 + (swz % 64) / 2; }
__host__ __device__ __forceinline__ int perm32(int rho) { const int n = rho >> 4, i = rho & 15; return 8 * (i >> 2) + 4 * n + (i & 3); }

struct Unit { int pm, pn; };
struct Gemm { const bf16_t* A; const bf16_t* Bt; int M, N, K; };

struct StaticOrder {
    int nM, nN, nwg, G, c;
    __host__ __device__ void init(int M, int N, int G_, int c_) { nM = M / BM; nN = N / BM; nwg = nM * nN; G = G_; c = c_; }
    __host__ __device__ bool next(int i, Unit& u) const {
        const long L = (long)i * G + c; if (L >= nwg) return false;
        int wgid = (int)L; { const int q = nwg / NXCD, r = nwg % NXCD, xcd = wgid % NXCD, off = wgid / NXCD; wgid = (xcd < r ? xcd * (q + 1) : r * (q + 1) + (xcd - r) * q) + off; }
        const int nig = WGM * nN, gid = wgid / nig, fm = gid * WGM, gsz = (nM - fm) < WGM ? (nM - fm) : WGM;
        u.pm = fm + ((wgid % nig) % gsz); u.pn = (wgid % nig) / gsz; return true;
    }
    __device__ __forceinline__ void a_ready(const Unit&) const {}
    __device__ __forceinline__ void done(const Unit&) const {}
};

typedef __bf16 bf16v2_t __attribute__((ext_vector_type(2)));
typedef float f32v2_t __attribute__((ext_vector_type(2)));
__device__ __forceinline__ unsigned cvt_pk_bf16(float lo, float hi) { const f32v2_t v = {lo, hi}; return __builtin_bit_cast(unsigned, __builtin_convertvector(v, bf16v2_t)); }
typedef int i32x8 __attribute__((ext_vector_type(8)));
template <bool F8> __device__ __forceinline__ f32x4 mma_tile(const bf16x8 (&bfr)[2], const bf16x8 (&afr)[2], f32x4 acc) {
    if constexpr (F8) {
        typedef int i32x4_ __attribute__((ext_vector_type(4)));
        const i32x4_ b0 = __builtin_bit_cast(i32x4_, bfr[0]), b1 = __builtin_bit_cast(i32x4_, bfr[1]), a0 = __builtin_bit_cast(i32x4_, afr[0]), a1 = __builtin_bit_cast(i32x4_, afr[1]);
        const i32x8 bb = {b0[0], b0[1], b0[2], b0[3], b1[0], b1[1], b1[2], b1[3]}, aa = {a0[0], a0[1], a0[2], a0[3], a1[0], a1[1], a1[2], a1[3]};
        const int sc1 = 0x7f7f7f7f;
        asm volatile("v_mfma_scale_f32_16x16x128_f8f6f4 %0, %1, %2, %0, %3, %3 op_sel_hi:[0,0,0]" : "+v"(acc) : "v"(bb), "v"(aa), "v"(sc1));
        return acc;
    } else {
        acc = __builtin_amdgcn_mfma_f32_16x16x32_bf16(bfr[0], afr[0], acc, 0, 0, 0);
        return __builtin_amdgcn_mfma_f32_16x16x32_bf16(bfr[1], afr[1], acc, 0, 0, 0);
    }
}
template <class Epi, class Sched, bool STAMP = false, bool F8 = false>
__device__ __forceinline__ void gemm_phase(PG8_LAS unsigned char* lds, const Gemm g, const Sched& S, const Epi& E, unsigned long long* stamps) {
    const int tid = ::tidx(), wid = __builtin_amdgcn_readfirstlane(tid >> 6), lane = tid & 63, wr = wid >> 2, wc = wid & 3, fr = lane & 15, fq = lane >> 4;
    const int K = g.K, nt = K / BK;
    int ts_lo = 0, ts_hi = 0, nts = 0; const unsigned long long rt_entry = STAMP ? (unsigned long long)wall_clock64() : 0ull;
#define PG8_STAMP() do { if (STAMP && wid == 0 && nts < 64) { const unsigned long long _c = (unsigned long long)clock64(); \
        ts_lo = (lane == nts) ? (int)(unsigned)_c : ts_lo; ts_hi = (lane == nts) ? (int)(unsigned)(_c >> 32) : ts_hi; ++nts; } } while (0)
    PG8_STAMP();
    unsigned voffA[2], voffB[2];
#pragma unroll
    for (int i = 0; i < 2; ++i) { int R, C; stage_rc(tid * 16 + i * 8192, R, C); const int Rb = Epi::PERM ? ((R & ~31) + perm32(R & 31)) : R;
        voffA[i] = (unsigned)(R * K + C) * 2u; voffB[i] = (unsigned)(Rb * K + C) * 2u; }
    const size_t kstep = (size_t)(BK * 2);
    const size_t hstep = (size_t)HALF * K * 2;
    const size_t tstep = 2 * hstep;
    const unsigned ldsw = (unsigned)wid * 1024u;
    const int aoff = lds_byte(wr * 64 + fr, fq * 8), boff = lds_byte(wc * 32 + fr, fq * 8);
#define PG8_SA(b, h) (((b) * 2 + (h)) * HTB)
#define PG8_SB(b, h) ((4 + (b) * 2 + (h)) * HTB)
#define PG8_STAGE(bufoff, gbase, voff) do { _Pragma("unroll") for (int _i = 0; _i < 2; ++_i) \
        __builtin_amdgcn_global_load_lds((const unsigned*)((const char*)(gbase) + (voff)[_i]), (PG8_LAS unsigned*)(lds + (bufoff) + ldsw + _i * 8192), 16, 0, 0); } while (0)
#define PG8_LDA(dst, b, h) do { _Pragma("unroll") for (int m = 0; m < 4; ++m) _Pragma("unroll") for (int k = 0; k < 2; ++k) dst[m][k] = *(const PG8_LAS bf16x8*)(lds + PG8_SA(b, h) + aoff + m * 2048 + k * 1024); } while (0)
#define PG8_LDB(dst, b, h) do { _Pragma("unroll") for (int n = 0; n < 2; ++n) _Pragma("unroll") for (int k = 0; k < 2; ++k) dst[n][k] = *(const PG8_LAS bf16x8*)(lds + PG8_SB(b, h) + boff + n * 2048 + k * 1024); } while (0)
#define PG8_MMA(ai, bj, At, Bt) do { __builtin_amdgcn_s_setprio(1); _Pragma("unroll") for (int m = 0; m < 4; ++m) _Pragma("unroll") for (int n = 0; n < 2; ++n) \
        acc[ai][bj][m][n] = mma_tile<F8>(Bt[n], At[m], acc[ai][bj][m][n]); __builtin_amdgcn_s_setprio(0); } while (0)
#define PG8_WAIT_V(n) asm volatile("s_waitcnt vmcnt(" #n ")" ::: "memory")
#define PG8_WAIT_L(n) asm volatile("s_waitcnt lgkmcnt(" #n ")" ::: "memory")
#define PG8_BAR __builtin_amdgcn_s_barrier()
#define PG8_SCHED __builtin_amdgcn_sched_barrier(0)
    Unit cur, nxt; int ui = 0;
    if (!S.next(0, cur)) return;
    f32x4 acc[2][2][4][2];
#pragma unroll
    for (int a = 0; a < 2; ++a)
#pragma unroll
        for (int b = 0; b < 2; ++b)
#pragma unroll
            for (int m = 0; m < 4; ++m)
#pragma unroll
                for (int n = 0; n < 2; ++n) acc[a][b][m][n] = (f32x4){0.f, 0.f, 0.f, 0.f};
    bf16x8 At[4][2], B0[2][2], B1[2][2];
    const char* cA = (const char*)g.A + (size_t)cur.pm * tstep; const char* cB = (const char*)g.Bt + (size_t)cur.pn * tstep;
    S.a_ready(cur);
    PG8_STAGE(PG8_SB(0, 0), cB, voffB); PG8_STAGE(PG8_SA(0, 0), cA, voffA); PG8_STAGE(PG8_SB(0, 1), cB + hstep, voffB); PG8_STAGE(PG8_SA(0, 1), cA + hstep, voffA);
    if (wr == 1) PG8_BAR;
    PG8_WAIT_V(4); PG8_BAR;
    PG8_STAGE(PG8_SB(1, 0), cB + kstep, voffB); PG8_STAGE(PG8_SA(1, 0), cA + kstep, voffA); PG8_STAGE(PG8_SB(1, 1), cB + hstep + kstep, voffB);
    PG8_WAIT_V(6); PG8_BAR;
    PG8_STAMP();
    for (;;) {
        const bool has_next = S.next(ui + 1, nxt);
        const char* nA = has_next ? (const char*)g.A + (size_t)nxt.pm * tstep : cA; const char* nB = has_next ? (const char*)g.Bt + (size_t)nxt.pn * tstep : cB;
        for (int t = 0; t < nt; t += 2) {
            const bool last = (t == nt - 2);
            const char* a1 = cA + (size_t)(t + 1) * kstep;
            const char* a2 = last ? nA : cA + (size_t)(t + 2) * kstep; const char* b2 = last ? nB : cB + (size_t)(t + 2) * kstep;
            const char* a3 = a2 + kstep; const char* b3 = b2 + kstep;
            if (last && has_next) S.a_ready(nxt);
            PG8_LDB(B0, 0, 0); PG8_SCHED; PG8_LDA(At, 0, 0); PG8_STAGE(PG8_SA(1, 1), a1 + hstep, voffA);
            PG8_WAIT_L(8); PG8_BAR; PG8_WAIT_L(0); PG8_MMA(0, 0, At, B0); PG8_BAR; PG8_SCHED;
            PG8_LDB(B1, 0, 1); PG8_STAGE(PG8_SB(0, 0), b2, voffB);
            PG8_BAR; PG8_WAIT_L(0); PG8_MMA(0, 1, At, B1); PG8_BAR;
            PG8_LDA(At, 0, 1); PG8_STAGE(PG8_SA(0, 0), a2, voffA);
            PG8_BAR; PG8_WAIT_L(0); PG8_MMA(1, 0, At, B0); PG8_BAR; PG8_SCHED;
            PG8_STAGE(PG8_SB(0, 1), b2 + hstep, voffB);
            PG8_WAIT_V(6); PG8_BAR; PG8_MMA(1, 1, At, B1); PG8_BAR;
            PG8_LDB(B0, 1, 0); PG8_SCHED; PG8_LDA(At, 1, 0); PG8_STAGE(PG8_SA(0, 1), a2 + hstep, voffA);
            PG8_WAIT_L(8); PG8_BAR; PG8_WAIT_L(0); PG8_MMA(0, 0, At, B0); PG8_BAR; PG8_SCHED;
            PG8_LDB(B1, 1, 1); PG8_STAGE(PG8_SB(1, 0), b3, voffB);
            PG8_BAR; PG8_WAIT_L(0); PG8_MMA(0, 1, At, B1); PG8_BAR;
            PG8_LDA(At, 1, 1); PG8_STAGE(PG8_SA(1, 0), a3, voffA);
            PG8_BAR; PG8_WAIT_L(0); PG8_MMA(1, 0, At, B0); PG8_BAR; PG8_SCHED;
            PG8_STAGE(PG8_SB(1, 1), b3 + hstep, voffB);
            PG8_WAIT_V(6); PG8_BAR; PG8_MMA(1, 1, At, B1); PG8_BAR;
        }
        PG8_STAMP();
        if constexpr (!Epi::AFTER_DRAIN) { E(acc, cur, wr, wc, fr, fq); S.done(cur); }
        PG8_STAMP();
        if (!has_next) break;
#pragma unroll
        for (int a = 0; a < 2; ++a)
#pragma unroll
            for (int b = 0; b < 2; ++b)
#pragma unroll
                for (int m = 0; m < 4; ++m)
#pragma unroll
                    for (int n = 0; n < 2; ++n) acc[a][b][m][n] = (f32x4){0.f, 0.f, 0.f, 0.f};
        cur = nxt; cA = nA; cB = nB; ++ui;
    }
    PG8_WAIT_V(0);
    if (wr == 0) PG8_BAR;
    PG8_BAR;
    if constexpr (Epi::AFTER_DRAIN) { E.fused(acc, cur, wr, wc, fr, fq, lds, wid, lane); S.done(cur); }
    PG8_STAMP();
    if (STAMP && wid == 0) { stamps[lane] = lane < nts ? (((unsigned long long)(unsigned)ts_hi << 32) | (unsigned)ts_lo) : 0ull;
        if (lane == 62) stamps[62] = rt_entry; if (lane == 63) stamps[63] = (unsigned long long)wall_clock64(); }
#undef PG8_STAMP
#undef PG8_SA
#undef PG8_SB
#undef PG8_STAGE
#undef PG8_LDA
#undef PG8_LDB
#undef PG8_MMA
#undef PG8_WAIT_V
#undef PG8_WAIT_L
#undef PG8_BAR
#undef PG8_SCHED
}
}


namespace {
using pg8::bf16_t; using pg8::f32x4;
constexpr int D = 1024, NB = 2, S = 8192, T = NB * S;
constexpr int EVEN_IN = 2304, ODD_IN = 2944, ODD_PAD = 3072, FD = 1920;
constexpr int MEM = 256, NE = 16, CAP = 1024, DE = 2816;
constexpr int NTH = 512;
constexpr size_t MiB = 1u << 20;
constexpr size_t WS_CTL = 0, CTL_BYTES = 1 * MiB;
constexpr size_t WS_ROPE = 1 * MiB;
constexpr size_t WS_AFF = 4 * MiB;
constexpr size_t WS_TOK = 5 * MiB;
constexpr size_t WS_GATE = 6 * MiB;
constexpr size_t WS_WRT = 3 * MiB;
constexpr size_t WS_SLOT = 7 * MiB;
constexpr size_t WS_X = 8 * MiB;
constexpr size_t WS_H = 72 * MiB;
constexpr size_t WS_Y = 104 * MiB;
constexpr size_t WS_P = 136 * MiB;
constexpr size_t WS_Q = 320 * MiB;
constexpr size_t WS_KV = 384 * MiB;
constexpr size_t WS_MN = 388 * MiB;
constexpr size_t WS_SSP = 390 * MiB;
constexpr size_t WS_DEC = 392 * MiB;
constexpr size_t WS_KD = 456 * MiB;
constexpr size_t WS_BB = 520 * MiB;
constexpr size_t WS_KK = 584 * MiB;
constexpr size_t WS_G = 616 * MiB;
constexpr size_t WS_YS = 648 * MiB;
constexpr size_t WS_RV = 712 * MiB;
constexpr size_t WS_VN = 776 * MiB;
constexpr size_t WS_QHA = 136 * MiB;
constexpr size_t WS_KHA = 152 * MiB;
constexpr size_t WS_QHB = 168 * MiB;
constexpr size_t WS_KHB = 184 * MiB;
constexpr size_t WS_PVB = 188 * MiB;
constexpr size_t WS_VTA = 208 * MiB;
constexpr size_t WS_VTB = 256 * MiB;
constexpr size_t WS_OA = 260 * MiB;
constexpr size_t WS_LSE = 308 * MiB;
constexpr size_t WS_QT = 136 * MiB;
constexpr size_t WS_YL = 200 * MiB;
constexpr size_t WS_PT = 264 * MiB;
constexpr size_t WS_RH = 296 * MiB;
constexpr size_t WS_S0 = 328 * MiB;
constexpr size_t WS_XE = 136 * MiB;
constexpr size_t WS_YE = 136 * MiB;
constexpr size_t WS_HID = 200 * MiB;
constexpr size_t WS_KB = 360 * MiB;
constexpr size_t WS_F5 = 792 * MiB;
constexpr size_t WS_WSB = 804 * MiB;
constexpr size_t WS_WL = 805 * MiB;
constexpr size_t WS_WEIN = 808 * MiB;
constexpr size_t WS_WEOUT = 813 * MiB;
constexpr size_t WS_WOIN = 815 * MiB;
constexpr size_t WS_WOOUT = 821 * MiB;
constexpr size_t WS_WQ = 823 * MiB;
constexpr size_t WS_WKV = 827 * MiB;
constexpr size_t WS_WO = 835 * MiB;
constexpr size_t WS_WGU = 840 * MiB;
constexpr size_t WS_WD = 1192 * MiB;
constexpr size_t WS_WGU8 = 840 * MiB;
constexpr size_t WS_WD8 = 1192 * MiB;
constexpr size_t WS_END = 1368 * MiB;
constexpr bool F8L0 = true;
constexpr float ASC8 = 16.f, GUSC8 = 128.f, HSC8 = 4.f, DSC8 = 256.f;
constexpr int CW_BAR = 4096;

constexpr int LDS_BYTES = 147456;
constexpr int LDS_BAR_OFF = LDS_BYTES - 64;

#define LAS __attribute__((address_space(3)))
#define XB_TMO      128
#define XB_XCNT(j)  (256  + 64 * (j))
#define XB_XSUB(j)  (1280 + 64 * (j))
#define XB_XGEN(j)  (2304 + 64 * (j))
#define XB_TOP      3328
#define XB_TOPGEN   3392
#define XCD_BAR_WORDS 3456
#define XB_SPIN_CAP (1u << 22)
__device__ __forceinline__ unsigned xb_ld(unsigned* p)              { return __hip_atomic_load(p, __ATOMIC_RELAXED, __HIP_MEMORY_SCOPE_AGENT); }
__device__ __forceinline__ unsigned xb_add(unsigned* p, unsigned v) { return __hip_atomic_fetch_add(p, v, __ATOMIC_RELAXED, __HIP_MEMORY_SCOPE_AGENT); }
__device__ __forceinline__ unsigned xb_xcc_id() { return (unsigned)__builtin_amdgcn_s_getreg((3 << 11) | 20) & 0xFu; }
#define XB_SPIN(cond, bar) do { unsigned _sp = 0; while (cond) { __builtin_amdgcn_s_sleep(1); \
    if ((++_sp & 255u) == 0u) { if (xb_ld(&(bar)[XB_TMO])) break; if (_sp > XB_SPIN_CAP) { atomicAdd(&(bar)[XB_TMO], 1u); break; } } } } while (0)
struct XcdBarrier { unsigned* bar; unsigned x; volatile LAS unsigned* st; };
__device__ __forceinline__ XcdBarrier xcd_barrier_post(unsigned* bar, volatile LAS unsigned* st) {
    XcdBarrier b; b.bar = bar; b.x = xb_xcc_id(); b.st = st;
    if (threadIdx.x == 0) (void)xb_add(&bar[XB_XCNT(b.x)], 1u);
    return b;
}
__device__ __forceinline__ void xcd_barrier_complete(unsigned* bar, unsigned x, unsigned& nloc, unsigned& nx) {
    const unsigned G = gridDim.x * gridDim.y * gridDim.z;
    unsigned sum, cnt, mine, sp = 0u;
    for (;;) {
        sum = 0u; cnt = 0u; mine = 0u;
#pragma unroll
        for (unsigned j = 0; j < 16; ++j) { const unsigned c = xb_ld(&bar[XB_XCNT(j)]); sum += c; cnt += (c > 0u) ? 1u : 0u; mine = (j == x) ? c : mine; }
        if (sum == G) break;
        __builtin_amdgcn_s_sleep(1);
        if ((++sp & 255u) == 0u) { if (xb_ld(&bar[XB_TMO])) break; if (sp > XB_SPIN_CAP) { atomicAdd(&bar[XB_TMO], 1u); break; } }
    }
    nloc = mine > 0u ? mine : 1u; nx = cnt > 0u ? cnt : 1u;
}
__device__ __forceinline__ void xcd_barrier(const XcdBarrier& b) {
    asm volatile("s_waitcnt vmcnt(0)" ::: "memory");
    __syncthreads();
    if (threadIdx.x == 0) {
        unsigned* bar = b.bar;
        __builtin_amdgcn_s_waitcnt(0);
        unsigned nloc = b.st[0], nx = b.st[1];
        if (nloc == 0u) { xcd_barrier_complete(bar, b.x, nloc, nx); b.st[0] = nloc; b.st[1] = nx; }
        const unsigned old = xb_add(&bar[XB_XSUB(b.x)], 1u);
        const unsigned gen = old / nloc;
        if (old + 1u == (gen + 1u) * nloc) {
            __builtin_amdgcn_fence(__ATOMIC_RELEASE, "agent");
            asm volatile("s_waitcnt vmcnt(0)" ::: "memory");
            const unsigned og = xb_add(&bar[XB_TOP], 1u);
            const unsigned tg = og / nx;
            if (og + 1u == (tg + 1u) * nx) xb_add(&bar[XB_TOPGEN], 1u);
            else XB_SPIN(xb_ld(&bar[XB_TOPGEN]) == tg, bar);
            __builtin_amdgcn_fence(__ATOMIC_ACQUIRE, "agent");
            xb_add(&bar[XB_XGEN(b.x)], 1u);
            asm volatile("s_waitcnt vmcnt(0)" ::: "memory");
        } else {
            XB_SPIN(xb_ld(&bar[XB_XGEN(b.x)]) == gen, bar);
            __builtin_amdgcn_fence(__ATOMIC_ACQUIRE, "agent");
            asm volatile("s_waitcnt vmcnt(0)" ::: "memory");
        }
    }
    __syncthreads();
}

__device__ __forceinline__ float wave_sum(float v) {
#pragma unroll
    for (int o = 32; o >= 1; o >>= 1) v += __shfl_xor(v, o);
    return v;
}
__device__ __forceinline__ float frcp(float x) { return __builtin_amdgcn_rcpf(x); }
__device__ __forceinline__ float sigmoidf_(float x) { return frcp(1.0f + __expf(-x)); }
__device__ __forceinline__ float tanhf_(float x) { return 2.0f * sigmoidf_(2.0f * x) - 1.0f; }
__device__ __forceinline__ float gelu_tanh(float x) { return x * sigmoidf_(1.5957691216057308f * (x + 0.044715f * x * x * x)); }
__device__ __forceinline__ unsigned f2bf(float f) { unsigned u = __builtin_bit_cast(unsigned, f); return (u + 0x7fffu + ((u >> 16) & 1u)) >> 16; }
__device__ __forceinline__ unsigned pk2(float lo, float hi) { return pg8::cvt_pk_bf16(lo, hi); }
__device__ __forceinline__ float bflo(unsigned w) { return __uint_as_float(w << 16); }
__device__ __forceinline__ float bfhi(unsigned w) { return __uint_as_float(w & 0xffff0000u); }
typedef unsigned v4u __attribute__((ext_vector_type(4)));
typedef unsigned v2u __attribute__((ext_vector_type(2)));

struct Args { const float* in[35]; float* out; unsigned char* ws; int lo, hi; };

struct EpiF32Store {
    static constexpr bool PERM = false, AFTER_DRAIN = false;
    float* C; int ldc; int nvalid;
    __device__ __forceinline__ void operator()(const f32x4 (&acc)[2][2][4][2], const pg8::Unit& u, int wr, int wc, int fr, int fq) const {
        const int row0 = u.pm * 256 + wr * 64 + fr, col0 = u.pn * 256 + wc * 32 + 4 * fq;
#pragma unroll
        for (int ai = 0; ai < 2; ++ai)
#pragma unroll
            for (int m = 0; m < 4; ++m) { float* rowp = C + (size_t)(row0 + ai * 128 + m * 16) * ldc + col0;
#pragma unroll
                for (int bj = 0; bj < 2; ++bj)
#pragma unroll
                    for (int n = 0; n < 2; ++n) if (col0 + bj * 128 + n * 16 < nvalid) *(f32x4*)(rowp + bj * 128 + n * 16) = acc[ai][bj][m][n]; }
    }
};
struct EpiResid {
    static constexpr bool PERM = false, AFTER_DRAIN = false;
    const float* base; float* out;
    __device__ __forceinline__ void operator()(const f32x4 (&acc)[2][2][4][2], const pg8::Unit& u, int wr, int wc, int fr, int fq) const {
        const int row0 = u.pm * 256 + wr * 64 + fr, col0 = u.pn * 256 + wc * 32 + 4 * fq;
#pragma unroll
        for (int ai = 0; ai < 2; ++ai)
#pragma unroll
            for (int m = 0; m < 4; ++m) { const size_t off = (size_t)(row0 + ai * 128 + m * 16) * D + col0;
#pragma unroll
                for (int bj = 0; bj < 2; ++bj)
#pragma unroll
                    for (int n = 0; n < 2; ++n) { const f32x4 b = *(const f32x4*)(base + off + bj * 128 + n * 16); *(f32x4*)(out + off + bj * 128 + n * 16) = b + acc[ai][bj][m][n]; } }
    }
};
struct EpiSiluMul {
    static constexpr bool PERM = false, AFTER_DRAIN = false;
    bf16_t* HIDp;
    __device__ __forceinline__ void operator()(const f32x4 (&acc)[2][2][4][2], const pg8::Unit& u, int wr, int wc, int fr, int fq) const {
        const int pnl = u.pn % 22;
        const int row0 = u.pm * 256 + wr * 64 + fr, col0 = pnl * 128 + wc * 32 + 4 * fq;
#pragma unroll
        for (int ai = 0; ai < 2; ++ai)
#pragma unroll
            for (int m = 0; m < 4; ++m) { bf16_t* rowp = HIDp + (size_t)(row0 + ai * 128 + m * 16) * DE + col0;
#pragma unroll
                for (int n = 0; n < 2; ++n) { const f32x4 g = acc[ai][0][m][n], up = acc[ai][1][m][n]; float h[4];
#pragma unroll
                    for (int j = 0; j < 4; ++j) h[j] = g[j] * frcp(1.0f + __expf(-g[j])) * up[j];
                    v2u w; w.x = pk2(h[0], h[1]); w.y = pk2(h[2], h[3]); *(v2u*)(rowp + n * 16) = w; } }
    }
};
struct EpiYE {
    static constexpr bool PERM = true, AFTER_DRAIN = false;
    const float* GATE; bf16_t* YE;
    __device__ __forceinline__ void operator()(const f32x4 (&acc)[2][2][4][2], const pg8::Unit& u, int wr, int wc, int fr, int fq) const {
        const int pnl = u.pn & 3;
        const int row0 = u.pm * 256 + wr * 64 + fr, col0 = pnl * 256 + wc * 32 + 8 * fq;
#pragma unroll
        for (int ai = 0; ai < 2; ++ai)
#pragma unroll
            for (int m = 0; m < 4; ++m) { const int row = row0 + ai * 128 + m * 16; const float gt_ = GATE[row]; bf16_t* rowp = YE + (size_t)row * D + col0;
#pragma unroll
                for (int bj = 0; bj < 2; ++bj) { const f32x4 v0 = acc[ai][bj][m][0] * gt_, v1 = acc[ai][bj][m][1] * gt_;
                    v4u w; w.x = pg8::cvt_pk_bf16(v0[0], v0[1]); w.y = pg8::cvt_pk_bf16(v0[2], v0[3]); w.z = pg8::cvt_pk_bf16(v1[0], v1[1]); w.w = pg8::cvt_pk_bf16(v1[2], v1[3]);
                    *(v4u*)(rowp + bj * 128) = w; } }
    }
};
struct EpiBf16Store {
    static constexpr bool PERM = true, AFTER_DRAIN = false;
    bf16_t* O; int ldc; float scale;
    __device__ __forceinline__ void operator()(const f32x4 (&acc)[2][2][4][2], const pg8::Unit& u, int wr, int wc, int fr, int fq) const {
        const int row0 = u.pm * 256 + wr * 64 + fr, col0 = u.pn * 256 + wc * 32 + 8 * fq;
#pragma unroll
        for (int ai = 0; ai < 2; ++ai)
#pragma unroll
            for (int m = 0; m < 4; ++m) { bf16_t* rowp = O + (size_t)(row0 + ai * 128 + m * 16) * ldc + col0;
#pragma unroll
                for (int bj = 0; bj < 2; ++bj) { const f32x4 v0 = acc[ai][bj][m][0] * scale, v1 = acc[ai][bj][m][1] * scale;
                    v4u w; w.x = pg8::cvt_pk_bf16(v0[0], v0[1]); w.y = pg8::cvt_pk_bf16(v0[2], v0[3]); w.z = pg8::cvt_pk_bf16(v1[0], v1[1]); w.w = pg8::cvt_pk_bf16(v1[2], v1[3]);
                    *(v4u*)(rowp + bj * 128) = w; } }
    }
};
struct EpiKV {
    static constexpr bool PERM = false, AFTER_DRAIN = false;
    bf16_t* K; bf16_t* Vt;
    __device__ __forceinline__ void operator()(const f32x4 (&acc)[2][2][4][2], const pg8::Unit& u, int wr, int wc, int fr, int fq) const {
        const int row0 = u.pm * 256 + wr * 64 + fr, col0 = u.pn * 256 + wc * 32 + 4 * fq;
#pragma unroll
        for (int ai = 0; ai < 2; ++ai)
#pragma unroll
            for (int m = 0; m < 4; ++m) { const int row = row0 + ai * 128 + m * 16;
#pragma unroll
                for (int bj = 0; bj < 2; ++bj)
#pragma unroll
                    for (int n = 0; n < 2; ++n) { const int col = col0 + bj * 128 + n * 16; const f32x4 v = acc[ai][bj][m][n];
                        if (col < 1024) { v2u w; w.x = pk2(v[0], v[1]); w.y = pk2(v[2], v[3]); *(v2u*)(K + (size_t)row * 1024 + col) = w; }
                        else { const int b = row >> 8, mm = row & 255; bf16_t* vp = Vt + ((size_t)(b * 1024 + (col - 1024)) * 256 + mm);
#pragma unroll
                            for (int j = 0; j < 4; ++j) vp[(size_t)j * 256] = (bf16_t)f2bf(v[j]); } } }
    }
};

constexpr float QSCALE = 0.125f * 1.4426950408889634f;
struct EpiEven {
    static constexpr bool PERM = true, AFTER_DRAIN = false;
    const float* rc; const float* rs; bf16_t* QhA; bf16_t* KhA; bf16_t* QhB; bf16_t* KhB; bf16_t* VhA; bf16_t* VhB;
    __device__ __forceinline__ void operator()(const f32x4 (&acc)[2][2][4][2], const pg8::Unit& u, int wr, int wc, int fr, int fq) const {
        asm volatile("" : "+v"(fr), "+v"(fq));
        const int row0 = u.pm * 256 + wr * 64 + fr;
#pragma unroll
        for (int bj = 0; bj < 2; ++bj) {
            const int c0 = u.pn * 256 + bj * 128 + wc * 32 + 8 * fq;
            int kind; bf16_t* base; int stride; float sc = 1.0f;
            if (c0 < 512) { kind = 0; base = QhA + ((size_t)(c0 >> 6) * T) * 64 + (c0 & 63); stride = 64; sc = QSCALE; }
            else if (c0 < 1024) { kind = 0; base = KhA + ((size_t)((c0 - 512) >> 6) * T) * 64 + (c0 & 63); stride = 64; }
            else if (c0 < 1536) { kind = 1; base = VhA + ((size_t)((c0 - 1024) >> 6) * T) * 64 + (c0 & 63); stride = 64; }
            else if (c0 < 2048) { kind = 0; base = QhB + ((size_t)((c0 - 1536) >> 6) * T) * 64 + (c0 & 63); stride = 64; sc = QSCALE; }
            else if (c0 < 2176) { kind = 0; base = KhB + ((size_t)((c0 - 2048) >> 6) * T) * 64 + (c0 & 63); stride = 64; }
            else { kind = 1; base = VhB + ((size_t)((c0 - 2176) >> 6) * T) * 64 + (c0 & 63); stride = 64; }
            const int pi = (c0 & 63) >> 1;
#pragma unroll
            for (int ai = 0; ai < 2; ++ai)
#pragma unroll
                for (int m = 0; m < 4; ++m) {
                    const int tok = row0 + ai * 128 + m * 16;
                    const f32x4 v0 = acc[ai][bj][m][0], v1 = acc[ai][bj][m][1];
                    float y[8];
                    if (kind == 0) {
                        const int s = tok & (S - 1);
                        const f32x4 c4 = *(const f32x4*)(rc + s * 32 + pi), s4 = *(const f32x4*)(rs + s * 32 + pi);
                        y[0] = (v0[0] * c4[0] - v0[1] * s4[0]) * sc; y[1] = (v0[1] * c4[0] + v0[0] * s4[0]) * sc;
                        y[2] = (v0[2] * c4[1] - v0[3] * s4[1]) * sc; y[3] = (v0[3] * c4[1] + v0[2] * s4[1]) * sc;
                        y[4] = (v1[0] * c4[2] - v1[1] * s4[2]) * sc; y[5] = (v1[1] * c4[2] + v1[0] * s4[2]) * sc;
                        y[6] = (v1[2] * c4[3] - v1[3] * s4[3]) * sc; y[7] = (v1[3] * c4[3] + v1[2] * s4[3]) * sc;
                    } else { y[0] = v0[0]; y[1] = v0[1]; y[2] = v0[2]; y[3] = v0[3]; y[4] = v1[0]; y[5] = v1[1]; y[6] = v1[2]; y[7] = v1[3]; }
                    v4u w; w.x = pk2(y[0], y[1]); w.y = pk2(y[2], y[3]); w.z = pk2(y[4], y[5]); w.w = pk2(y[6], y[7]);
                    *(v4u*)(base + (size_t)tok * stride) = w;
                }
        }
    }
};

struct EpiLora {
    static constexpr bool PERM = false, AFTER_DRAIN = false;
    const float *w0, *a0, *k_a; const bf16_t *KB, *KK; bf16_t *LW, *KD, *BB, *G;
    __device__ __forceinline__ void operator()(const f32x4 (&acc)[2][2][4][2], const pg8::Unit& u, int wr, int wc, int fr, int fq) const {
        asm volatile("" : "+v"(fr), "+v"(fq));
        const int row0 = u.pm * 256 + wr * 64 + fr;
#pragma unroll
        for (int bj = 0; bj < 2; ++bj)
#pragma unroll
            for (int n = 0; n < 2; ++n) {
                const int c0 = u.pn * 256 + bj * 128 + wc * 32 + n * 16 + 4 * fq, sec = c0 >> 9, cc = c0 & 511;
#pragma unroll
                for (int ai = 0; ai < 2; ++ai)
#pragma unroll
                    for (int m = 0; m < 4; ++m) {
                        const size_t tok = row0 + ai * 128 + m * 16;
                        const f32x4 v = acc[ai][bj][m][n];
                        if (sec < 2) {
                            const f32x4 w = *(const f32x4*)(w0 + sec * 512 + cc); float o[4];
#pragma unroll
                            for (int j = 0; j < 4; ++j) { const float xw = -(w[j] + v[j]);
                                o[j] = -0.6065306597126334f * frcp(1.0f + __expf(xw)); }
                            v2u ww; ww.x = pk2(o[0], o[1]); ww.y = pk2(o[2], o[3]);
                            *(v2u*)(LW + ((size_t)sec * T + tok) * 512 + cc) = ww;
                        } else if (sec < 4) {
                            const int d = sec - 2;
                            const f32x4 a_ = *(const f32x4*)(a0 + d * 512 + cc), ka = *(const f32x4*)(k_a + cc);
                            const v2u kw = *(const v2u*)(KB + tok * 512 + cc), kkw = *(const v2u*)(KK + tok * 512 + cc);
                            const float kv[4] = {bflo(kw.x), bfhi(kw.x), bflo(kw.y), bfhi(kw.y)}, kk[4] = {bflo(kkw.x), bfhi(kkw.x), bflo(kkw.y), bfhi(kkw.y)};
                            float okd[4], obb[4];
#pragma unroll
                            for (int j = 0; j < 4; ++j) { const float alr = frcp(1.0f + __expf(-(a_[j] + v[j]))); okd[j] = kv[j] * (1.0f + (alr - 1.0f) * ka[j]); obb[j] = kk[j] * alr; }
                            v2u w1, w2_; w1.x = pk2(okd[0], okd[1]); w1.y = pk2(okd[2], okd[3]); w2_.x = pk2(obb[0], obb[1]); w2_.y = pk2(obb[2], obb[3]);
                            *(v2u*)(KD + ((size_t)d * T + tok) * 512 + cc) = w1; *(v2u*)(BB + ((size_t)d * T + tok) * 512 + cc) = w2_;
                        } else { v2u ww; ww.x = pk2(v[0], v[1]); ww.y = pk2(v[2], v[3]); *(v2u*)(G + tok * 512 + cc) = ww; }
                        __builtin_amdgcn_sched_barrier(0);
                    }
            }
    }
};

__device__ __forceinline__ float clamp8(float x) { return __builtin_amdgcn_fmed3f(x, -448.f, 448.f); }
__device__ __forceinline__ unsigned pk4_fp8(float a, float b, float c, float d) {
    int w = 0; w = __builtin_amdgcn_cvt_pk_fp8_f32(clamp8(a), clamp8(b), w, false); w = __builtin_amdgcn_cvt_pk_fp8_f32(clamp8(c), clamp8(d), w, true); return (unsigned)w;
}
struct EpiSiluMul8 {
    static constexpr bool PERM = true, AFTER_DRAIN = false;
    unsigned char* HIDp;
    __device__ __forceinline__ void operator()(const f32x4 (&acc)[2][2][4][2], const pg8::Unit& u, int wr, int wc, int fr, int fq) const {
        asm volatile("s_nop 7\n\ts_nop 7\n\ts_nop 7"); __builtin_amdgcn_sched_barrier(0);
        const int pnl = u.pn % 22;
        const int row0 = u.pm * 256 + wr * 64 + fr, col0 = pnl * 128 + wc * 32 + 8 * fq;
        const float s1 = 1.0f / (ASC8 * GUSC8);
#pragma unroll
        for (int ai = 0; ai < 2; ++ai)
#pragma unroll
            for (int m = 0; m < 4; ++m) { unsigned char* rowp = HIDp + (size_t)(row0 + ai * 128 + m * 16) * DE + col0; float h[8];
#pragma unroll
                for (int n = 0; n < 2; ++n) { const f32x4 g = acc[ai][0][m][n] * s1, up = acc[ai][1][m][n] * (s1 * HSC8);
#pragma unroll
                    for (int j = 0; j < 4; ++j) h[4 * n + j] = g[j] * frcp(1.0f + __expf(-g[j])) * up[j]; }
                v2u w; w.x = pk4_fp8(h[0], h[1], h[2], h[3]); w.y = pk4_fp8(h[4], h[5], h[6], h[7]);
                __builtin_nontemporal_store(w, (v2u*)rowp); }
    }
};
struct EpiYE8 {
    static constexpr bool PERM = true, AFTER_DRAIN = false;
    const float* GATE; bf16_t* YE;
    __device__ __forceinline__ void operator()(const f32x4 (&acc)[2][2][4][2], const pg8::Unit& u, int wr, int wc, int fr, int fq) const {
        asm volatile("s_nop 7\n\ts_nop 7\n\ts_nop 7"); __builtin_amdgcn_sched_barrier(0);
        const int pnl = u.pn & 3;
        const int row0 = u.pm * 256 + wr * 64 + fr, col0 = pnl * 256 + wc * 32 + 8 * fq;
#pragma unroll
        for (int ai = 0; ai < 2; ++ai)
#pragma unroll
            for (int m = 0; m < 4; ++m) { const int row = row0 + ai * 128 + m * 16; const float gt_ = GATE[row] * (1.0f / (HSC8 * DSC8)); bf16_t* rowp = YE + (size_t)row * D + col0;
#pragma unroll
                for (int bj = 0; bj < 2; ++bj) { const f32x4 v0 = acc[ai][bj][m][0] * gt_, v1 = acc[ai][bj][m][1] * gt_;
                    v4u w; w.x = pk2(v0[0], v0[1]); w.y = pk2(v0[2], v0[3]); w.z = pk2(v1[0], v1[1]); w.w = pk2(v1[2], v1[3]);
                    *(v4u*)(rowp + bj * 128) = w; } }
    }
};
template <class RowMap>
__device__ __forceinline__ void transpose_item_fp8(const float* W, int K, int N, unsigned char* WT, RowMap rm, float sc, LAS float* scr, int item, int lane) {
    const int nblk = N / 64, kb = item / nblk, nb_ = item % nblk, k0 = 64 * kb, n0 = 64 * nb_;
    f32x4 ld[16];
#pragma unroll
    for (int i = 0; i < 16; ++i) ld[i] = *(const f32x4*)(W + (size_t)(k0 + 4 * i + (lane >> 4)) * N + n0 + 4 * (lane & 15));
#pragma unroll
    for (int i = 0; i < 16; ++i) { LAS float* p = scr + (4 * i + (lane >> 4)) * 65 + 4 * (lane & 15); p[0] = ld[i][0]; p[1] = ld[i][1]; p[2] = ld[i][2]; p[3] = ld[i][3]; }
    asm volatile("s_waitcnt lgkmcnt(0)" ::: "memory");
    const int c = lane & 3;
#pragma unroll
    for (int j = 0; j < 4; ++j) { const int n = (lane >> 2) + 16 * j; const LAS float* s = scr + (16 * c) * 65 + n;
        v4u o;
#pragma unroll
        for (int q = 0; q < 4; ++q) o[q] = pk4_fp8(s[(4 * q) * 65] * sc, s[(4 * q + 1) * 65] * sc, s[(4 * q + 2) * 65] * sc, s[(4 * q + 3) * 65] * sc);
        *(v4u*)(WT + (size_t)rm(n0 + n) * K + k0 + 16 * c) = o; }
    asm volatile("s_waitcnt lgkmcnt(0)" ::: "memory");
}

struct EpiResidN {
    static constexpr bool PERM = false, AFTER_DRAIN = false;
    const float* base; float* out; bf16_t* Xb; float* SSP;
    __device__ __forceinline__ void operator()(const f32x4 (&acc)[2][2][4][2], const pg8::Unit& u, int wr, int wc, int fr, int fq) const {
        asm volatile("" : "+v"(fr), "+v"(fq));
        const int row0 = u.pm * 256 + wr * 64 + fr, col0 = u.pn * 256 + wc * 32 + 4 * fq;
#pragma unroll
        for (int ai = 0; ai < 2; ++ai)
#pragma unroll
            for (int m = 0; m < 4; ++m) { const size_t row = row0 + ai * 128 + m * 16; const size_t off = row * D + col0; float ss = 0.f;
#pragma unroll
                for (int bj = 0; bj < 2; ++bj)
#pragma unroll
                    for (int n = 0; n < 2; ++n) { const f32x4 b = *(const f32x4*)(base + off + bj * 128 + n * 16); const f32x4 o = b + acc[ai][bj][m][n];
                        *(f32x4*)(out + off + bj * 128 + n * 16) = o;
                        v2u w; w.x = pk2(o[0], o[1]); w.y = pk2(o[2], o[3]); *(v2u*)(Xb + off + bj * 128 + n * 16) = w;
                        ss += (o[0] * o[0] + o[1] * o[1]) + (o[2] * o[2] + o[3] * o[3]); }
                ss += __shfl_xor(ss, 16); ss += __shfl_xor(ss, 32);
                if (fq == 0) SSP[row * 16 + u.pn * 4 + wc] = ss; }
    }
};
struct EpiBf16StoreRS {
    static constexpr bool PERM = true, AFTER_DRAIN = false;
    bf16_t* O; int ldc; const float* SSP;
    __device__ __forceinline__ void operator()(const f32x4 (&acc)[2][2][4][2], const pg8::Unit& u, int wr, int wc, int fr, int fq) const {
        asm volatile("" : "+v"(fr), "+v"(fq));
        const int row0 = u.pm * 256 + wr * 64 + fr, col0 = u.pn * 256 + wc * 32 + 8 * fq;
#pragma unroll
        for (int ai = 0; ai < 2; ++ai)
#pragma unroll
            for (int m = 0; m < 4; ++m) { const size_t row = row0 + ai * 128 + m * 16;
                const f32x4* sp = (const f32x4*)(SSP + row * 16); const f32x4 s0 = sp[0], s1 = sp[1], s2 = sp[2], s3 = sp[3];
                const float ss = (((s0[0] + s0[1]) + (s0[2] + s0[3])) + ((s1[0] + s1[1]) + (s1[2] + s1[3]))) + (((s2[0] + s2[1]) + (s2[2] + s2[3])) + ((s3[0] + s3[1]) + (s3[2] + s3[3])));
                const float rs = rsqrtf(ss * (1.0f / D) + 1e-6f);
                bf16_t* rowp = O + row * ldc + col0;
#pragma unroll
                for (int bj = 0; bj < 2; ++bj) { const f32x4 v0 = acc[ai][bj][m][0] * rs, v1 = acc[ai][bj][m][1] * rs;
                    v4u w; w.x = pk2(v0[0], v0[1]); w.y = pk2(v0[2], v0[3]); w.z = pk2(v1[0], v1[1]); w.w = pk2(v1[2], v1[3]);
                    *(v4u*)(rowp + bj * 128) = w; } }
    }
};
struct MoeOrder {
    int G, c, npairs;
    int per;
    __device__ __forceinline__ bool next(int i, pg8::Unit& u) const {
        const int x = c & 7, y = c >> 3, pml = y & 7, pnq = y >> 3;
        const int epn = i * 32 + x * 4 + pnq;
        if (epn >= npairs || c >= 256) return false;
        const int e = epn / per;
        u.pm = e * 8 + pml; u.pn = epn; return true;
    }
    __device__ __forceinline__ void a_ready(const pg8::Unit&) const {}
    __device__ __forceinline__ void done(const pg8::Unit&) const {}
};

struct XattnOrder {
    int c;
    __device__ __forceinline__ bool next(int i, pg8::Unit& u) const { if (i != 0 || c >= 256) return false; u.pm = (c >> 7) * 32 + (c & 31); u.pn = (c >> 5) & 3; return true; }
    __device__ __forceinline__ void a_ready(const pg8::Unit&) const {}
    __device__ __forceinline__ void done(const pg8::Unit&) const {}
};
template <class RowMap>
__device__ __forceinline__ void transpose_item(const float* W, int K, int N, bf16_t* WT, RowMap rm, LAS float* scr, int item, int lane, const float* kscale = nullptr) {
    const int nblk = N / 64, kb = item / nblk, nb_ = item % nblk, k0 = 64 * kb, n0 = 64 * nb_;
    f32x4 ld[16];
#pragma unroll
    for (int i = 0; i < 16; ++i) ld[i] = *(const f32x4*)(W + (size_t)(k0 + 4 * i + (lane >> 4)) * N + n0 + 4 * (lane & 15));
#pragma unroll
    for (int i = 0; i < 16; ++i) { LAS float* p = scr + (4 * i + (lane >> 4)) * 65 + 4 * (lane & 15); p[0] = ld[i][0]; p[1] = ld[i][1]; p[2] = ld[i][2]; p[3] = ld[i][3]; }
    asm volatile("s_waitcnt lgkmcnt(0)" ::: "memory");
    const int c = lane & 7;
    float ksc[8];
#pragma unroll
    for (int q = 0; q < 8; ++q) ksc[q] = kscale ? kscale[k0 + 8 * c + q] : 1.0f;
#pragma unroll
    for (int j = 0; j < 8; ++j) { const int n = (lane >> 3) + 8 * j; const LAS float* s = scr + (8 * c) * 65 + n;
        v4u o; o.x = pk2(s[0 * 65] * ksc[0], s[1 * 65] * ksc[1]); o.y = pk2(s[2 * 65] * ksc[2], s[3 * 65] * ksc[3]); o.z = pk2(s[4 * 65] * ksc[4], s[5 * 65] * ksc[5]); o.w = pk2(s[6 * 65] * ksc[6], s[7 * 65] * ksc[7]);
        *(v4u*)(WT + (size_t)rm(n0 + n) * K + k0 + 8 * c) = o; }
    asm volatile("s_waitcnt lgkmcnt(0)" ::: "memory");
}

__device__ __forceinline__ void rmsnorm_rows_bf16(const float* x, const float* g, bf16_t* out, int M) {
    const int tix_ = tidx(); const int lane = tix_ & 63, gw = blockIdx.x * 8 + (tix_ >> 6), ngw = gridDim.x * 8;
    for (int m = gw; m < M; m += ngw) {
        const float4* xr = (const float4*)(x + (size_t)m * D);
        float4 v[4]; float s = 0.f;
#pragma unroll
        for (int j = 0; j < 4; ++j) { v[j] = xr[lane + 64 * j]; s += v[j].x * v[j].x + v[j].y * v[j].y + v[j].z * v[j].z + v[j].w * v[j].w; }
        const float r = rsqrtf(wave_sum(s) * (1.0f / D) + 1e-6f);
        v2u* o = (v2u*)(out + (size_t)m * D);
#pragma unroll
        for (int j = 0; j < 4; ++j) { const float4 gg = ((const float4*)g)[lane + 64 * j];
            v2u w; w.x = pk2(v[j].x * r * gg.x, v[j].y * r * gg.y); w.y = pk2(v[j].z * r * gg.z, v[j].w * r * gg.w); o[lane + 64 * j] = w; }
    }
}
__device__ __forceinline__ void rmsnorm_rows_f32(const float* x, const float* g, float* out, int M) {
    const int tix_ = tidx(); const int lane = tix_ & 63, gw = blockIdx.x * 8 + (tix_ >> 6), ngw = gridDim.x * 8;
    for (int m = gw; m < M; m += ngw) {
        const float4* xr = (const float4*)(x + (size_t)m * D);
        float4 v[4]; float s = 0.f;
#pragma unroll
        for (int j = 0; j < 4; ++j) { v[j] = xr[lane + 64 * j]; s += v[j].x * v[j].x + v[j].y * v[j].y + v[j].z * v[j].z + v[j].w * v[j].w; }
        const float r = rsqrtf(wave_sum(s) * (1.0f / D) + 1e-6f);
        float4* o = (float4*)(out + (size_t)m * D);
#pragma unroll
        for (int j = 0; j < 4; ++j) { const float4 gg = ((const float4*)g)[lane + 64 * j];
            o[lane + 64 * j] = make_float4(v[j].x * r * gg.x, v[j].y * r * gg.y, v[j].z * r * gg.z, v[j].w * r * gg.w); }
    }
}

__device__ __forceinline__ int block_exscan(int v, int* sh, int* tot) {
    const int tid = tidx(), lane = tid & 63, w = tid >> 6;
    int inc = v;
#pragma unroll
    for (int o = 1; o < 64; o <<= 1) { const int t = __shfl_up(inc, o); if (lane >= o) inc += t; }
    __syncthreads();
    if (lane == 63) sh[w] = inc;
    __syncthreads();
    int base = 0, total = 0;
#pragma unroll
    for (int i = 0; i < 8; ++i) { const int x = sh[i]; if (i < w) base += x; total += x; }
    *tot = total;
    return base + inc - v;
}


typedef short bf16x8 __attribute__((ext_vector_type(8)));
typedef float f32x16 __attribute__((ext_vector_type(16)));
constexpr int MROW = 144;
constexpr int MBUF = 64 * MROW;
__device__ __forceinline__ bf16x8 frag_rm(const LAS unsigned char* M, int row0, int k0, int fr, int fq) {
    return *(const LAS bf16x8*)(M + (row0 + fr) * MROW + (k0 + 8 * fq) * 2);
}
__device__ __forceinline__ bf16x8 frag_cm(const LAS unsigned char* M, int k0, int col0, int fr, int fq) {
    const LAS unsigned short* p = (const LAS unsigned short*)(M + (k0 + 8 * fq) * MROW + (col0 + fr) * 2);
    bf16x8 v;
#pragma unroll
    for (int j = 0; j < 8; ++j) v[j] = (short)p[j * (MROW / 2)];
    return v;
}
__device__ __forceinline__ void tile_store_bf16(LAS unsigned char* M, int m0, int n0, int fr, int fq, const f32x4& c) {
    v2u w; w.x = pk2(c[0], c[1]); w.y = pk2(c[2], c[3]);
    *(LAS v2u*)(M + (m0 + fr) * MROW + (n0 + 4 * fq) * 2) = w;
}
#define MMA16(acc, lf, rf) acc = __builtin_amdgcn_mfma_f32_16x16x32_bf16(rf, lf, acc, 0, 0, 0)

__device__ __forceinline__ void tile_store_bf16_T(LAS unsigned char* M, int m0, int n0, int fr, int fq, const f32x4& c) {
    const unsigned w0 = pk2(c[0], c[1]), w1 = pk2(c[2], c[3]);
    LAS unsigned char* p = M + (n0 + 4 * fq) * MROW + (m0 + fr) * 2;
    *(LAS unsigned short*)(p) = (unsigned short)(w0 & 0xffffu); *(LAS unsigned short*)(p + MROW) = (unsigned short)(w0 >> 16);
    *(LAS unsigned short*)(p + 2 * MROW) = (unsigned short)(w1 & 0xffffu); *(LAS unsigned short*)(p + 3 * MROW) = (unsigned short)(w1 >> 16);
}
__device__ __forceinline__ void scan_r1(const bf16_t* LWg, const bf16_t* RVg, const bf16_t* KDg, const bf16_t* KKg, const bf16_t* BBg,
                                        bf16_t* PT, bf16_t* QT, bf16_t* RH, float* YL, unsigned char* lds_raw) {
    LAS unsigned char* L = (LAS unsigned char*)lds_raw;
#define SL(k) (L + (k) * MBUF)
    LAS float* LWs = (LAS float*)(L + 14 * MBUF);
    const int tid = tidx(), lane = tid & 63, wave = tid >> 6, fr = lane & 15, fq = lane >> 4;
    const int tm = wave >> 1, tn0 = (wave & 1) * 2;
    const int m0 = tm * 16;
    const int t = tid >> 3, i0 = (tid & 7) * 8;
    v4u lw4n, r4n, v4n, kd4n, kk4n, bb4n;
#define R1_LOAD(it_) do { const int c_ = (it_) & 127, h_ = ((it_) >> 7) & 7, n_ = (it_) >> 10, dir_ = n_ >> 1, b_ = n_ & 1; \
        const int pos_ = dir_ ? (S - 1 - (c_ * 64 + t)) : (c_ * 64 + t); const size_t tok_ = (size_t)b_ * S + pos_; const size_t ch_ = (size_t)h_ * 64 + i0; \
        lw4n = *(const v4u*)(LWg + ((size_t)dir_ * T + tok_) * 512 + ch_); r4n = *(const v4u*)(RVg + tok_ * D + ch_); v4n = *(const v4u*)(RVg + tok_ * D + 512 + ch_); \
        kd4n = *(const v4u*)(KDg + ((size_t)dir_ * T + tok_) * 512 + ch_); kk4n = *(const v4u*)(KKg + tok_ * 512 + ch_); bb4n = *(const v4u*)(BBg + ((size_t)dir_ * T + tok_) * 512 + ch_); } while (0)
    if ((int)blockIdx.x < 4096) R1_LOAD((int)blockIdx.x);
    for (int item = blockIdx.x; item < 4096; item += gridDim.x) {
        const v4u lw4 = lw4n, r4 = r4n, v4 = v4n, kd4 = kd4n, kk4 = kk4n, bb4 = bb4n;
        float lw[8], Lin[8];
#pragma unroll
        for (int q = 0; q < 4; ++q) { lw[2 * q] = bflo(lw4[q]); lw[2 * q + 1] = bfhi(lw4[q]); }
#pragma unroll
        for (int j = 0; j < 8; ++j) { float x = lw[j];
#pragma unroll
            for (int o = 8; o < 64; o <<= 1) { const float y = __shfl_up(x, o); if (lane >= o) x += y; }
            Lin[j] = x; }
        __syncthreads();
        if (lane >= 56) {
#pragma unroll
            for (int j = 0; j < 8; ++j) LWs[64 + wave * 64 + i0 + j] = Lin[j]; }
        __syncthreads();
        {
            float off[8];
#pragma unroll
            for (int j = 0; j < 8; ++j) off[j] = 0.f;
            for (int w = 0; w < 8; ++w) { if (w < wave) {
#pragma unroll
                for (int j = 0; j < 8; ++j) off[j] += LWs[64 + w * 64 + i0 + j]; } }
#pragma unroll
            for (int j = 0; j < 8; ++j) Lin[j] += off[j];
            if (t == 63) {
#pragma unroll
                for (int j = 0; j < 8; ++j) LWs[i0 + j] = Lin[j]; }
            float at_[8], rt_[8], bt_[8], kt_[8];
#pragma unroll
            for (int q = 0; q < 4; ++q) {
#pragma unroll
                for (int e = 0; e < 2; ++e) { const int j = 2 * q + e;
                    const float ein = __expf(Lin[j]), einv = __expf(-Lin[j]), eex = __expf(Lin[j] - lw[j]);
                    const float kkv = e ? bfhi(kk4[q]) : bflo(kk4[q]), rv_ = e ? bfhi(r4[q]) : bflo(r4[q]), bbv = e ? bfhi(bb4[q]) : bflo(bb4[q]), kdv = e ? bfhi(kd4[q]) : bflo(kd4[q]);
                    at_[j] = -kkv * eex; rt_[j] = rv_ * ein; bt_[j] = bbv * einv; kt_[j] = kdv * einv; }
            }
            v4u wa, wb, wk, w;
            wa.x = pk2(at_[0], at_[1]); wa.y = pk2(at_[2], at_[3]); wa.z = pk2(at_[4], at_[5]); wa.w = pk2(at_[6], at_[7]); *(LAS v4u*)(SL(0) + t * MROW + i0 * 2) = wa;
            w.x = pk2(rt_[0], rt_[1]); w.y = pk2(rt_[2], rt_[3]); w.z = pk2(rt_[4], rt_[5]); w.w = pk2(rt_[6], rt_[7]); *(LAS v4u*)(SL(2) + t * MROW + i0 * 2) = w;
            wb.x = pk2(bt_[0], bt_[1]); wb.y = pk2(bt_[2], bt_[3]); wb.z = pk2(bt_[4], bt_[5]); wb.w = pk2(bt_[6], bt_[7]); *(LAS v4u*)(SL(3) + t * MROW + i0 * 2) = wb;
            wk.x = pk2(kt_[0], kt_[1]); wk.y = pk2(kt_[2], kt_[3]); wk.z = pk2(kt_[4], kt_[5]); wk.w = pk2(kt_[6], kt_[7]); *(LAS v4u*)(SL(5) + t * MROW + i0 * 2) = wk;
#pragma unroll
            for (int q = 0; q < 4; ++q) {
                LAS unsigned char* pT = (LAS unsigned char*)0 + (i0 + 2 * q) * MROW + t * 2;
                *(LAS unsigned short*)(SL(1) + (size_t)pT) = (unsigned short)(wa[q] & 0xffffu); *(LAS unsigned short*)(SL(1) + (size_t)pT + MROW) = (unsigned short)(wa[q] >> 16);
                *(LAS unsigned short*)(SL(4) + (size_t)pT) = (unsigned short)(wb[q] & 0xffffu); *(LAS unsigned short*)(SL(4) + (size_t)pT + MROW) = (unsigned short)(wb[q] >> 16);
                *(LAS unsigned short*)(SL(6) + (size_t)pT) = (unsigned short)(wk[q] & 0xffffu); *(LAS unsigned short*)(SL(6) + (size_t)pT + MROW) = (unsigned short)(wk[q] >> 16);
                *(LAS unsigned short*)(SL(7) + (size_t)pT) = (unsigned short)(v4[q] & 0xffffu); *(LAS unsigned short*)(SL(7) + (size_t)pT + MROW) = (unsigned short)(v4[q] >> 16);
            }
        }
        if (item + (int)gridDim.x < 4096) R1_LOAD(item + (int)gridDim.x);
        __syncthreads();
        f32x4 Tacc[2];
        {
            bf16x8 la[2], lr[2];
#pragma unroll
            for (int ks = 0; ks < 2; ++ks) { la[ks] = frag_rm(SL(0), m0, 32 * ks, fr, fq); lr[ks] = frag_rm(SL(2), m0, 32 * ks, fr, fq); }
#pragma unroll
            for (int q = 0; q < 2; ++q) {
                const int n0 = (tn0 + q) * 16;
                f32x4 cab = {0.f, 0.f, 0.f, 0.f}, cak = cab, crb = cab, crk = cab;
#pragma unroll
                for (int ks = 0; ks < 2; ++ks) {
                    const bf16x8 rb_ = frag_rm(SL(3), n0, 32 * ks, fr, fq), rk_ = frag_rm(SL(5), n0, 32 * ks, fr, fq);
                    MMA16(cab, la[ks], rb_); MMA16(cak, la[ks], rk_); MMA16(crb, lr[ks], rb_); MMA16(crk, lr[ks], rk_);
                }
                const int tt = m0 + fr;
#pragma unroll
                for (int j = 0; j < 4; ++j) { const int ss = n0 + 4 * fq + j;
                    if (!(ss < tt)) { cab[j] = 0.f; cak[j] = 0.f; }
                    if (!(ss <= tt)) { crb[j] = 0.f; crk[j] = 0.f; } }
                tile_store_bf16(SL(8), m0, n0, fr, fq, cab); tile_store_bf16_T(SL(9), m0, n0, fr, fq, cab);
                tile_store_bf16(SL(10), m0, n0, fr, fq, cak);
                tile_store_bf16(SL(11), m0, n0, fr, fq, crb); tile_store_bf16(SL(12), m0, n0, fr, fq, crk);
#pragma unroll
                for (int j = 0; j < 4; ++j) cab[j] += ((n0 + 4 * fq + j) == tt) ? 1.f : 0.f;
                Tacc[q] = cab;
                tile_store_bf16(SL(13), m0, n0, fr, fq, cab);
            }
        }
        __syncthreads();
        {
            bf16x8 lk[2], ln_[2];
#pragma unroll
            for (int ks = 0; ks < 2; ++ks) { lk[ks] = frag_rm(SL(10), m0, 32 * ks, fr, fq); ln_[ks] = frag_rm(SL(8), m0, 32 * ks, fr, fq); }
#pragma unroll
            for (int q = 0; q < 2; ++q) {
                const int n0 = (tn0 + q) * 16;
                f32x4 cw = {0.f, 0.f, 0.f, 0.f}, cn = cw;
#pragma unroll
                for (int ks = 0; ks < 2; ++ks) { MMA16(cw, lk[ks], frag_rm(SL(7), n0, 32 * ks, fr, fq)); MMA16(cn, ln_[ks], frag_rm(SL(9), n0, 32 * ks, fr, fq)); }
                tile_store_bf16_T(SL(0), m0, n0, fr, fq, cw);
                tile_store_bf16(SL(3), m0, n0, fr, fq, cn); tile_store_bf16_T(SL(5), m0, n0, fr, fq, cn);
            }
        }
        __syncthreads();
#pragma unroll
        for (int k = 1; k <= 5; ++k) {
            LAS unsigned char* Nk = (k & 1) ? SL(3) : SL(8); LAS unsigned char* NkT = (k & 1) ? SL(5) : SL(9);
            LAS unsigned char* Nn = (k & 1) ? SL(8) : SL(3); LAS unsigned char* NnT = (k & 1) ? SL(9) : SL(5);
            LAS unsigned char* Tk = (k & 1) ? SL(13) : SL(10); LAS unsigned char* Tn = (k & 1) ? SL(10) : SL(13);
            bf16x8 lt[2], ln_[2];
#pragma unroll
            for (int ks = 0; ks < 2; ++ks) { lt[ks] = frag_rm(Tk, m0, 32 * ks, fr, fq); ln_[ks] = frag_rm(Nk, m0, 32 * ks, fr, fq); }
#pragma unroll
            for (int q = 0; q < 2; ++q) {
                const int n0 = (tn0 + q) * 16;
                f32x4 cn = {0.f, 0.f, 0.f, 0.f};
#pragma unroll
                for (int ks = 0; ks < 2; ++ks) { const bf16x8 rn = frag_rm(NkT, n0, 32 * ks, fr, fq); MMA16(Tacc[q], lt[ks], rn); if (k < 5) MMA16(cn, ln_[ks], rn); }
                tile_store_bf16(Tn, m0, n0, fr, fq, Tacc[q]);
                if (k < 5) { tile_store_bf16(Nn, m0, n0, fr, fq, cn); tile_store_bf16_T(NnT, m0, n0, fr, fq, cn); }
            }
            __syncthreads();
        }
        {
            bf16x8 lt[2];
#pragma unroll
            for (int ks = 0; ks < 2; ++ks) lt[ks] = frag_rm(SL(10), m0, 32 * ks, fr, fq);
#pragma unroll
            for (int q = 0; q < 2; ++q) {
                const int n0 = (tn0 + q) * 16;
                f32x4 ca = {0.f, 0.f, 0.f, 0.f}, cu = ca;
#pragma unroll
                for (int ks = 0; ks < 2; ++ks) { MMA16(ca, lt[ks], frag_rm(SL(1), n0, 32 * ks, fr, fq)); MMA16(cu, lt[ks], frag_rm(SL(0), n0, 32 * ks, fr, fq)); }
                tile_store_bf16_T(SL(8), m0, n0, fr, fq, ca); tile_store_bf16_T(SL(9), m0, n0, fr, fq, cu);
            }
        }
        __syncthreads();
        {
            bf16x8 lrb[2], lrk[2], lb[2], lkt[2];
#pragma unroll
            for (int ks = 0; ks < 2; ++ks) { lrb[ks] = frag_rm(SL(11), m0, 32 * ks, fr, fq); lrk[ks] = frag_rm(SL(12), m0, 32 * ks, fr, fq);
                lb[ks] = frag_rm(SL(4), m0, 32 * ks, fr, fq); lkt[ks] = frag_rm(SL(6), m0, 32 * ks, fr, fq); }
            const float wc = __expf(LWs[m0 + fr]);
#pragma unroll
            for (int q = 0; q < 2; ++q) {
                const int n0 = (tn0 + q) * 16;
                f32x4 crh = {0.f, 0.f, 0.f, 0.f}, cyl = crh, cp = crh, cq = crh;
#pragma unroll
                for (int ks = 0; ks < 2; ++ks) {
                    const bf16x8 ra = frag_rm(SL(8), n0, 32 * ks, fr, fq), ru = frag_rm(SL(9), n0, 32 * ks, fr, fq), rv = frag_rm(SL(7), n0, 32 * ks, fr, fq);
                    MMA16(crh, lrb[ks], ra); MMA16(cyl, lrb[ks], ru); MMA16(cyl, lrk[ks], rv);
                    MMA16(cp, lb[ks], ra); MMA16(cq, lb[ks], ru); MMA16(cq, lkt[ks], rv);
                }
                const size_t o = (size_t)item * 4096 + (size_t)(m0 + fr) * 64 + n0 + 4 * fq;
                { const LAS unsigned short* rp = (const LAS unsigned short*)(SL(2) + (m0 + fr) * MROW + (n0 + 4 * fq) * 2);
#pragma unroll
                  for (int j = 0; j < 4; ++j) crh[j] += __uint_as_float(((unsigned)rp[j]) << 16); }
                { v2u w; w.x = pk2(crh[0], crh[1]); w.y = pk2(crh[2], crh[3]); *(v2u*)(RH + o) = w; }
                *(f32x4*)(YL + o) = cyl;
#pragma unroll
                for (int j = 0; j < 4; ++j) { cp[j] = wc * (cp[j] + (((n0 + 4 * fq + j) == (m0 + fr)) ? 1.f : 0.f)); cq[j] *= wc; }
                { v2u w; w.x = pk2(cp[0], cp[1]); w.y = pk2(cp[2], cp[3]); *(v2u*)(PT + o) = w; }
                { v2u w; w.x = pk2(cq[0], cq[1]); w.y = pk2(cq[2], cq[3]); *(v2u*)(QT + o) = w; }
            }
        }
    }
#undef SL
}
#undef R1_LOAD

__device__ __forceinline__ bf16x8 pack_acc8(const f32x16& x, int s) {
    v4u p; p.x = pk2(x[8 * s], x[8 * s + 1]); p.y = pk2(x[8 * s + 2], x[8 * s + 3]); p.z = pk2(x[8 * s + 4], x[8 * s + 5]); p.w = pk2(x[8 * s + 6], x[8 * s + 7]);
    return __builtin_bit_cast(bf16x8, p);
}
__device__ __forceinline__ void scan_r2(const bf16_t* PT, const bf16_t* QT, bf16_t* S0, unsigned char* lds_raw) {
    LAS unsigned char* L = (LAS unsigned char*)lds_raw;
    constexpr int SLOT_B = MBUF + 8192;
    const int tid = tidx(), lane = tid & 63, wave = tid >> 6;
    const int r = lane & 31, h2 = lane >> 5, jb = wave;
    f32x16 st[2];
#pragma unroll
    for (int ib = 0; ib < 2; ++ib)
#pragma unroll
        for (int g = 0; g < 16; ++g) st[ib][g] = 0.f;
    const size_t item0 = (size_t)blockIdx.x * 128;
    v4u stage[16];
#pragma unroll
    for (int q = 0; q < 16; ++q) { const int p = tid + 512 * q, cc = p >> 10, w = p & 1023, mat = w >> 9, idx = w & 511;
        stage[q] = *(const v4u*)((mat ? QT : PT) + (item0 + cc) * 4096 + idx * 8); }
    for (int grp = 0; grp < 16; ++grp) {
        __syncthreads();
#pragma unroll
        for (int q = 0; q < 16; ++q) { const int p = tid + 512 * q, cc = p >> 10, w = p & 1023, mat = w >> 9, idx = w & 511;
            *(LAS v4u*)(L + cc * SLOT_B + (mat ? (MBUF + idx * 16) : ((idx >> 3) * MROW + (idx & 7) * 16))) = stage[q]; }
        __syncthreads();
        if (grp < 15) {
#pragma unroll
            for (int q = 0; q < 16; ++q) { const int p = tid + 512 * q, cc = p >> 10, w = p & 1023, mat = w >> 9, idx = w & 511;
                stage[q] = *(const v4u*)((mat ? QT : PT) + (item0 + (grp + 1) * 8 + cc) * 4096 + idx * 8); }
        }
        if (wave < 2) {
#pragma unroll 1
            for (int cc = 0; cc < 8; ++cc) {
                const size_t item = item0 + grp * 8 + cc;
                const LAS unsigned char* Pm = L + cc * SLOT_B; const LAS unsigned char* Qm = Pm + MBUF;
                bf16_t* sp = S0 + item * 4096 + (size_t)(32 * jb + r) * 64;
#pragma unroll
                for (int ib = 0; ib < 2; ++ib)
#pragma unroll
                    for (int g = 0; g < 4; ++g) { v2u w; w.x = pk2(st[ib][4 * g], st[ib][4 * g + 1]); w.y = pk2(st[ib][4 * g + 2], st[ib][4 * g + 3]); *(v2u*)(sp + 32 * ib + 8 * g + 4 * h2) = w; }
                f32x16 nw[2];
#pragma unroll
                for (int ib = 0; ib < 2; ++ib)
#pragma unroll
                    for (int g = 0; g < 16; ++g) nw[ib][g] = __uint_as_float(((unsigned)*(const LAS unsigned short*)(Qm + (32 * ib + (g & 3) + 8 * (g >> 2) + 4 * h2) * 128 + (32 * jb + r) * 2)) << 16);
#pragma unroll
                for (int kb = 0; kb < 2; ++kb)
#pragma unroll
                    for (int s2 = 0; s2 < 2; ++s2) {
                        const bf16x8 bfr = pack_acc8(st[kb], s2);
#pragma unroll
                        for (int ib = 0; ib < 2; ++ib) {
                            const LAS unsigned char* ap = Pm + (32 * ib + r) * MROW + (32 * kb + 16 * s2 + 4 * h2) * 2;
                            const v2u lo = *(const LAS v2u*)ap, hi = *(const LAS v2u*)(ap + 16);
                            v4u av; av.x = lo.x; av.y = lo.y; av.z = hi.x; av.w = hi.y;
                            nw[ib] = __builtin_amdgcn_mfma_f32_32x32x16_bf16(__builtin_bit_cast(bf16x8, av), bfr, nw[ib], 0, 0, 0);
                        }
                    }
                st[0] = nw[0]; st[1] = nw[1];
            }
        }
    }
}
__device__ __forceinline__ void scan_r3(const bf16_t* RH, const float* YL, const bf16_t* S0, const bf16_t* RVg, const bf16_t* KDg, const bf16_t* Gg,
                                        const float* r_k, const float* lng, const float* lnb, bf16_t* Y) {
    const int tid = tidx(), lane = tid & 63, wave = tid >> 6, fr = lane & 15, fq = lane >> 4;
    const int tmw = wave & 3;
    for (int it2 = blockIdx.x * 2 + (wave >> 2); it2 < 2048; it2 += gridDim.x * 2) {
        const int b = it2 >> 10, h = (it2 >> 7) & 7, pc = it2 & 127;
        f32x4 acc[4];
#pragma unroll
        for (int q = 0; q < 4; ++q) acc[q] = (f32x4){0.f, 0.f, 0.f, 0.f};
#pragma unroll 1
        for (int dirn = 0; dirn < 2; ++dirn) {
            const size_t item = (size_t)((dirn * 2 + b) * 8 + h) * 128 + (dirn ? 127 - pc : pc);
            const int row = dirn ? 63 - (16 * tmw + fr) : 16 * tmw + fr;
            const bf16_t* rp = RH + item * 4096 + (size_t)row * 64;
            bf16x8 lf[2];
#pragma unroll
            for (int ks = 0; ks < 2; ++ks) lf[ks] = *(const bf16x8*)(rp + 32 * ks + 8 * fq);
#pragma unroll
            for (int q = 0; q < 4; ++q) {
                const bf16_t* sp = S0 + item * 4096 + (size_t)(16 * q + fr) * 64;
#pragma unroll
                for (int ks = 0; ks < 2; ++ks) { const bf16x8 rf = *(const bf16x8*)(sp + 32 * ks + 8 * fq); MMA16(acc[q], lf[ks], rf); }
                acc[q] += *(const f32x4*)(YL + item * 4096 + (size_t)row * 64 + 16 * q + 4 * fq);
            }
        }
        float sm = 0.f;
#pragma unroll
        for (int q = 0; q < 4; ++q) sm += (acc[q][0] + acc[q][1]) + (acc[q][2] + acc[q][3]);
        sm += __shfl_xor(sm, 16); sm += __shfl_xor(sm, 32);
        const float mean = sm * (1.0f / 64.f);
        float sq = 0.f;
#pragma unroll
        for (int q = 0; q < 4; ++q)
#pragma unroll
            for (int j = 0; j < 4; ++j) { const float d = acc[q][j] - mean; sq += d * d; }
        sq += __shfl_xor(sq, 16); sq += __shfl_xor(sq, 32);
        const float rstd = rsqrtf(sq * (1.0f / 64.f) + 64e-5f);
        const size_t tok = (size_t)b * S + pc * 64 + 16 * tmw + fr;
        float bon = 0.f; f32x4 vv[4];
#pragma unroll
        for (int q = 0; q < 4; ++q) {
            const int c = h * 64 + 16 * q + 4 * fq;
            const v2u rw = *(const v2u*)(RVg + tok * D + c), k0 = *(const v2u*)(KDg + tok * 512 + c), k1 = *(const v2u*)(KDg + ((size_t)T + tok) * 512 + c), vw = *(const v2u*)(RVg + tok * D + 512 + c);
            const f32x4 rk4 = *(const f32x4*)(r_k + c);
            vv[q] = (f32x4){bflo(vw.x), bfhi(vw.x), bflo(vw.y), bfhi(vw.y)};
            bon += bflo(rw.x) * (bflo(k0.x) + bflo(k1.x)) * rk4[0] + bfhi(rw.x) * (bfhi(k0.x) + bfhi(k1.x)) * rk4[1] + bflo(rw.y) * (bflo(k0.y) + bflo(k1.y)) * rk4[2] + bfhi(rw.y) * (bfhi(k0.y) + bfhi(k1.y)) * rk4[3];
        }
        bon += __shfl_xor(bon, 16); bon += __shfl_xor(bon, 32);
#pragma unroll
        for (int q = 0; q < 4; ++q) {
            const int c = h * 64 + 16 * q + 4 * fq;
            const v2u gw_ = *(const v2u*)(Gg + tok * 512 + c); const f32x4 g4 = {bflo(gw_.x), bfhi(gw_.x), bflo(gw_.y), bfhi(gw_.y)}, lg = *(const f32x4*)(lng + c), lb = *(const f32x4*)(lnb + c);
            float o[4];
#pragma unroll
            for (int j = 0; j < 4; ++j) o[j] = ((acc[q][j] - mean) * rstd * lg[j] + lb[j] + bon * vv[q][j]) * g4[j];
            v2u w; w.x = pk2(o[0], o[1]); w.y = pk2(o[2], o[3]);
            *(v2u*)(Y + tok * D + 512 + c) = w;
        }
    }
}


__device__ __forceinline__ bf16x8 pack8(float a0, float a1, float a2, float a3, float a4, float a5, float a6, float a7) {
    v4u p; p.x = pk2(a0, a1); p.y = pk2(a2, a3); p.z = pk2(a4, a5); p.w = pk2(a6, a7);
    return __builtin_bit_cast(bf16x8, p);
}
#define MMA32(acc, af, bf_) acc = __builtin_amdgcn_mfma_f32_32x32x16_bf16(af, bf_, acc, 0, 0, 0)
__device__ __forceinline__ void xattn_mfma(const bf16_t* Qb, const bf16_t* Kb, const bf16_t* Vt, bf16_t* Y, unsigned char* lds_raw) {
    LAS unsigned char* L = (LAS unsigned char*)lds_raw;
    constexpr int KRS = 528, VRS = 520;
    const int tid = tidx(), lane = tid & 63, wave = tid >> 6, r = lane & 31, h2 = lane >> 5;
    for (int it = blockIdx.x; it < 256; it += gridDim.x) {
        const int qblk = it & 31, h = (it >> 5) & 3, b = it >> 7;
        const size_t tok = (size_t)b * S + qblk * 256 + wave * 32 + r;
        bf16x8 qf[16];
#pragma unroll
        for (int ks = 0; ks < 16; ++ks) qf[ks] = *(const bf16x8*)(Qb + tok * D + h * 256 + 16 * ks + 8 * h2);
        __syncthreads();
#pragma unroll
        for (int hf = 0; hf < 2; ++hf) {
            v4u stg[8];
#pragma unroll
            for (int q = 0; q < 8; ++q) { const int p = tid + 512 * (8 * hf + q); stg[q] = *(const v4u*)(Kb + (size_t)(b * MEM + (p >> 5)) * 1024 + h * 256 + (p & 31) * 8); }
#pragma unroll
            for (int q = 0; q < 8; ++q) { const int p = tid + 512 * (8 * hf + q); *(LAS v4u*)(L + (p >> 5) * KRS + (p & 31) * 16) = stg[q]; }
        }
        __syncthreads();
        float mx = -3.0e38f;
#pragma unroll 1
        for (int kb = 0; kb < 8; ++kb) {
            f32x16 st;
#pragma unroll
            for (int g = 0; g < 16; ++g) st[g] = 0.f;
            const LAS unsigned char* kp = L + (32 * kb + r) * KRS + 16 * h2;
#pragma unroll
            for (int ks = 0; ks < 16; ++ks) { const bf16x8 kf = *(const LAS bf16x8*)(kp + 32 * ks); MMA32(st, kf, qf[ks]); }
#pragma unroll
            for (int g = 0; g < 16; ++g) mx = fmaxf(mx, st[g]);
        }
        mx = fmaxf(mx, __shfl_xor(mx, 32));
        const float cs = 0.0625f * 1.4426950408889634f;
        float l = 0.f;
        bf16x8 pf[8][2];
#pragma unroll
        for (int kb = 0; kb < 8; ++kb) {
            f32x16 st;
#pragma unroll
            for (int g = 0; g < 16; ++g) st[g] = 0.f;
            const LAS unsigned char* kp = L + (32 * kb + r) * KRS + 16 * h2;
#pragma unroll
            for (int ks = 0; ks < 16; ++ks) { const bf16x8 kf = *(const LAS bf16x8*)(kp + 32 * ks); MMA32(st, kf, qf[ks]); }
#pragma unroll
            for (int g = 0; g < 16; ++g) { st[g] = __builtin_amdgcn_exp2f((st[g] - mx) * cs); l += st[g]; }
#pragma unroll
            for (int s2 = 0; s2 < 2; ++s2) pf[kb][s2] = pack8(st[8 * s2], st[8 * s2 + 1], st[8 * s2 + 2], st[8 * s2 + 3], st[8 * s2 + 4], st[8 * s2 + 5], st[8 * s2 + 6], st[8 * s2 + 7]);
            __builtin_amdgcn_sched_barrier(0);
        }
        l += __shfl_xor(l, 32);
        const float inv = 1.0f / l;
        __syncthreads();
#pragma unroll
        for (int hf = 0; hf < 2; ++hf) {
            v4u stg[8];
#pragma unroll
            for (int q = 0; q < 8; ++q) { const int p = tid + 512 * (8 * hf + q); stg[q] = *(const v4u*)(Vt + ((size_t)(b * 1024 + h * 256 + (p >> 5))) * 256 + (p & 31) * 8); }
#pragma unroll
            for (int q = 0; q < 8; ++q) { const int p = tid + 512 * (8 * hf + q); LAS v2u* lp = (LAS v2u*)(L + (p >> 5) * VRS + (p & 31) * 16);
                v2u a_; a_.x = stg[q].x; a_.y = stg[q].y; lp[0] = a_; a_.x = stg[q].z; a_.y = stg[q].w; lp[1] = a_; }
        }
        __syncthreads();
#pragma unroll 1
        for (int db = 0; db < 8; ++db) {
            f32x16 acc;
#pragma unroll
            for (int g = 0; g < 16; ++g) acc[g] = 0.f;
            const LAS unsigned char* vp = L + (32 * db + r) * VRS + 8 * h2;
#pragma unroll
            for (int kb = 0; kb < 8; ++kb)
#pragma unroll
                for (int s2 = 0; s2 < 2; ++s2) {
                    const v2u lo = *(const LAS v2u*)(vp + (32 * kb + 16 * s2) * 2), hi = *(const LAS v2u*)(vp + (32 * kb + 16 * s2 + 8) * 2);
                    v4u av; av.x = lo.x; av.y = lo.y; av.z = hi.x; av.w = hi.y;
                    MMA32(acc, __builtin_bit_cast(bf16x8, av), pf[kb][s2]);
                }
            int tl_ = tid; asm volatile("" : "+v"(tl_));
            bf16_t* yp = Y + ((size_t)b * S + qblk * 256 + (tl_ >> 6) * 32 + (tl_ & 31)) * D + h * 256 + 32 * db + 4 * ((tl_ >> 5) & 1);
#pragma unroll
            for (int g = 0; g < 4; ++g) { v2u w; w.x = pk2(acc[4 * g] * inv, acc[4 * g + 1] * inv); w.y = pk2(acc[4 * g + 2] * inv, acc[4 * g + 3] * inv); *(v2u*)(yp + 8 * g) = w; }
        }
    }
}
template <bool F32OUT>
__device__ __forceinline__ void combine_norm(float* X, const bf16_t* YE, const int* SLOT, const float* g, bf16_t* Hout, float* Fout) {
    const int tix_ = tidx(); const int lane = tix_ & 63, gw = blockIdx.x * 8 + (tix_ >> 6), ngw = gridDim.x * 8;
    float4 gc[4];
#pragma unroll
    for (int j = 0; j < 4; ++j) gc[j] = ((const float4*)g)[lane + 64 * j];
    for (int m = gw; m < T; m += ngw) {
        float4* xr = (float4*)(X + (size_t)m * D);
        float4 v[4];
#pragma unroll
        for (int j = 0; j < 4; ++j) v[j] = xr[lane + 64 * j];
        const int myslot = SLOT[(size_t)m * NE + (lane & 15)];
#pragma unroll
        for (int e = 0; e < 16; ++e) {
            const int row = __builtin_amdgcn_readlane(myslot, e);
            if (row >= 0) {
                const v2u* yp = (const v2u*)(YE + (size_t)row * D);
#pragma unroll
                for (int j = 0; j < 4; ++j) { const v2u w = yp[lane + 64 * j];
                    v[j].x += __uint_as_float(w.x << 16); v[j].y += __uint_as_float(w.x & 0xffff0000u); v[j].z += __uint_as_float(w.y << 16); v[j].w += __uint_as_float(w.y & 0xffff0000u); }
            }
        }
        float s = 0.f;
#pragma unroll
        for (int j = 0; j < 4; ++j) { if (!F32OUT) xr[lane + 64 * j] = v[j]; s += v[j].x * v[j].x + v[j].y * v[j].y + v[j].z * v[j].z + v[j].w * v[j].w; }
        const float r = rsqrtf(wave_sum(s) * (1.0f / D) + 1e-6f);
#pragma unroll
        for (int j = 0; j < 4; ++j) { const float4 gg = gc[j];
            if (F32OUT) ((float4*)(Fout + (size_t)m * D))[lane + 64 * j] = make_float4(v[j].x * r * gg.x, v[j].y * r * gg.y, v[j].z * r * gg.z, v[j].w * r * gg.w);
            else { v2u w; w.x = pk2(v[j].x * r * gg.x, v[j].y * r * gg.y); w.y = pk2(v[j].z * r * gg.z, v[j].w * r * gg.w); ((v2u*)(Hout + (size_t)m * D))[lane + 64 * j] = w; } }
    }
}


template <int NK, bool SINK>
__device__ __forceinline__ void attn_block(const bf16_t* Qh, const bf16_t* Kh, const bf16_t* Vh, int dd, int Lr, int b, int rho, int q0b, float sink2,
                                           bf16_t* Odst, int ostride, float* lsedst, unsigned char* lds_raw) {
    constexpr int NKEY = 256 + 64 * NK, KRS = 144, VRS = NKEY * 2 + 8;
    LAS unsigned char* Ks = (LAS unsigned char*)lds_raw; LAS unsigned char* Vs = Ks + NKEY * KRS;
    const int tid = tidx(), lane = tid & 63, wave = tid >> 6, r = lane & 31, h2 = lane >> 5;
    const int kq_base = q0b - 32 * NK;
    __syncthreads();
#pragma unroll
    for (int i = 0; i < NKEY * 8 / 512; ++i) {
        const int p = tid + 512 * i, row = p >> 3, piece = p & 7, kq = kq_base + row;
        if (kq >= 0 && kq < Lr) {
            const size_t tokk = (size_t)b * S + (size_t)kq * dd + rho;
            const v4u kx = *(const v4u*)(Kh + tokk * 64 + piece * 8), vx = *(const v4u*)(Vh + tokk * 64 + piece * 8);
            *(LAS v4u*)(Ks + row * KRS + piece * 16) = kx;
            LAS unsigned char* vp = Vs + (piece * 8) * VRS + row * 2;
#pragma unroll
            for (int e = 0; e < 4; ++e) { *(LAS unsigned short*)(vp + (2 * e) * VRS) = (unsigned short)(vx[e] & 0xffffu); *(LAS unsigned short*)(vp + (2 * e + 1) * VRS) = (unsigned short)(vx[e] >> 16); }
        }
    }
    const int q0 = q0b + 32 * wave;
    const size_t qtok = (size_t)b * S + (size_t)(q0 + r) * dd + rho;
    bf16x8 qf[4];
#pragma unroll
    for (int ks = 0; ks < 4; ++ks) qf[ks] = *(const bf16x8*)(Qh + qtok * 64 + 16 * ks + 8 * h2);
    __syncthreads();
    f32x16 o[2];
#pragma unroll
    for (int db = 0; db < 2; ++db)
#pragma unroll
        for (int g = 0; g < 16; ++g) o[db][g] = 0.f;
    float m = SINK ? sink2 : -1.0e30f, l = SINK ? 1.f : 0.f;
    const int kb_lo = max(-NK, -(q0 >> 5)), kb_hi = min(NK, (Lr - 32 - q0) >> 5);
#pragma unroll 1
    for (int kb = kb_lo; kb <= kb_hi; ++kb) {
        const int kw0 = 32 * (wave + kb + NK);
        f32x16 st;
#pragma unroll
        for (int g = 0; g < 16; ++g) st[g] = 0.f;
        const LAS unsigned char* kp = Ks + (kw0 + r) * KRS + 16 * h2;
#pragma unroll
        for (int ks = 0; ks < 4; ++ks) { const bf16x8 kf = *(const LAS bf16x8*)(kp + 32 * ks); MMA32(st, kf, qf[ks]); }
        if (kb == -NK || kb == NK) {
#pragma unroll
            for (int g = 0; g < 16; ++g) { const int cr = (g & 3) + 8 * (g >> 2) + 4 * h2; const bool ok = (kb < 0) ? (cr >= r) : (cr <= r); st[g] = ok ? st[g] : -1.0e30f; }
        }
        float bm = st[0];
#pragma unroll
        for (int g = 1; g < 16; ++g) bm = fmaxf(bm, st[g]);
        bm = fmaxf(bm, __shfl_xor(bm, 32));
        const float mn = fmaxf(m, bm), al = __builtin_amdgcn_exp2f(m - mn);
        float ls = 0.f;
#pragma unroll
        for (int g = 0; g < 16; ++g) { st[g] = __builtin_amdgcn_exp2f(st[g] - mn); ls += st[g]; }
        ls += __shfl_xor(ls, 32);
        l = l * al + ls; m = mn;
#pragma unroll
        for (int db = 0; db < 2; ++db)
#pragma unroll
            for (int g = 0; g < 16; ++g) o[db][g] *= al;
        bf16x8 pf[2];
#pragma unroll
        for (int s2 = 0; s2 < 2; ++s2) pf[s2] = pack8(st[8 * s2], st[8 * s2 + 1], st[8 * s2 + 2], st[8 * s2 + 3], st[8 * s2 + 4], st[8 * s2 + 5], st[8 * s2 + 6], st[8 * s2 + 7]);
#pragma unroll
        for (int db = 0; db < 2; ++db) {
            const LAS unsigned char* vp = Vs + (32 * db + r) * VRS + (kw0 + 4 * h2) * 2;
#pragma unroll
            for (int s2 = 0; s2 < 2; ++s2) {
                const v2u lo = *(const LAS v2u*)(vp + 32 * s2), hi = *(const LAS v2u*)(vp + 32 * s2 + 16);
                v4u av; av.x = lo.x; av.y = lo.y; av.z = hi.x; av.w = hi.y;
                MMA32(o[db], __builtin_bit_cast(bf16x8, av), pf[s2]);
            }
        }
    }
    const float inv = 1.0f / l;
#pragma unroll
    for (int db = 0; db < 2; ++db) {
        bf16_t* op = Odst + qtok * ostride + 32 * db + 4 * h2;
#pragma unroll
        for (int g = 0; g < 4; ++g) { v2u w; w.x = pk2(o[db][4 * g] * inv, o[db][4 * g + 1] * inv); w.y = pk2(o[db][4 * g + 2] * inv, o[db][4 * g + 3] * inv); *(v2u*)(op + 8 * g) = w; }
    }
    if (lsedst != nullptr && h2 == 0) lsedst[qtok * 8] = (m + __builtin_amdgcn_logf(l)) * 0.6931471805599453f;
}

__device__ __forceinline__ void attn_phase_even(const bf16_t* QhA, const bf16_t* KhA, const bf16_t* VhA, const bf16_t* QhB, const bf16_t* KhB, const bf16_t* VhB,
                                                const float* sink, bf16_t* OA, float* LSE, bf16_t* Y, unsigned char* lds_raw) {
    for (int it = blockIdx.x; it < 2048; it += gridDim.x) {
        if (it < 512) {
            const int hq = it >> 6, rem2 = it & 63, b = rem2 >> 5, q0b = (rem2 & 31) * 256, kvh = hq >> 2;
            attn_block<4, true>(QhB + (size_t)hq * T * 64, KhB + (size_t)kvh * T * 64, VhB + (size_t)kvh * T * 64, 1, S, b, 0, q0b, sink[hq] * 1.4426950408889634f,
                                Y + 512 + hq * 64, D, nullptr, lds_raw);
        } else {
            const int ita = it - 512, p = ita >> 9, rem = ita & 511, head = rem >> 6, rem2 = rem & 63, b = rem2 >> 5, rem3 = rem2 & 31;
            const int dd = p == 0 ? 1 : (p == 1 ? 4 : 16), bpr = 32 / dd, rho = rem3 / bpr, q0b = (rem3 % bpr) * 256;
            attn_block<2, false>(QhA + (size_t)head * T * 64, KhA + (size_t)head * T * 64, VhA + (size_t)head * T * 64, dd, S / dd, b, rho, q0b, 0.f,
                                 OA + (size_t)p * T * 512 + head * 64, 512, LSE + (size_t)p * T * 8 + head, lds_raw);
        }
    }
}
__device__ __forceinline__ void attn_combine(const bf16_t* OA, const float* LSE, bf16_t* Y) {
    const int gt = blockIdx.x * NTH + tidx(), ngt = gridDim.x * NTH;
    for (int i = gt; i < T * 64; i += ngt) {
        const int tok = i >> 6, head = (i >> 3) & 7, c8 = i & 7;
        const float l0 = LSE[(size_t)tok * 8 + head], l1 = LSE[((size_t)T + tok) * 8 + head], l2 = LSE[((size_t)2 * T + tok) * 8 + head];
        const float mx = fmaxf(l0, fmaxf(l1, l2));
        float w0 = __expf(l0 - mx), w1 = __expf(l1 - mx), w2 = __expf(l2 - mx);
        const float inv = 1.0f / (w0 + w1 + w2); w0 *= inv; w1 *= inv; w2 *= inv;
        const size_t off = (size_t)tok * 512 + head * 64 + c8 * 8;
        const v4u x0 = *(const v4u*)(OA + off), x1 = *(const v4u*)(OA + (size_t)T * 512 + off), x2 = *(const v4u*)(OA + (size_t)2 * T * 512 + off);
        v4u w;
#pragma unroll
        for (int q = 0; q < 4; ++q) {
            const float lo = w0 * __uint_as_float(x0[q] << 16) + w1 * __uint_as_float(x1[q] << 16) + w2 * __uint_as_float(x2[q] << 16);
            const float hi = w0 * __uint_as_float(x0[q] & 0xffff0000u) + w1 * __uint_as_float(x1[q] & 0xffff0000u) + w2 * __uint_as_float(x2[q] & 0xffff0000u);
            w[q] = pk2(lo, hi);
        }
        *(v4u*)(Y + (size_t)tok * D + head * 64 + c8 * 8) = w;
    }
}


__device__ __forceinline__ void odd_token_pass(const bf16_t* P, const float* mu, const float* k_k, const float* clg, const float* clb,
                                               bf16_t* VN, bf16_t* RV, bf16_t* KBf, bf16_t* KK, bf16_t* F5) {
    const int tix_ = tidx(); const int lane = tix_ & 63, gw = blockIdx.x * 8 + (tix_ >> 6), ngw = gridDim.x * 8;
    float2 m0c[15], m1c[15], kkc[4], lgc[4], lbc[4];
#pragma unroll
    for (int jj = 0; jj < 15; ++jj) { const int c = 2 * lane + 128 * jj; m0c[jj] = *(const float2*)(mu + c); m1c[jj] = *(const float2*)(mu + FD + c); }
#pragma unroll
    for (int jj = 0; jj < 4; ++jj) { const int c = 2 * lane + 128 * jj; kkc[jj] = *(const float2*)(k_k + c); lgc[jj] = *(const float2*)(clg + c); lbc[jj] = *(const float2*)(clb + c); }
    unsigned wcur[15], wnxt[15], wprv[15];
    for (int tok0 = gw * 8; tok0 < T; tok0 += ngw * 8)
    for (int ti = 0; ti < 8; ++ti) {
        const int tok = tok0 + ti;
        const int s = tok & (S - 1);
        const bf16_t* pr = P + (size_t)tok * ODD_PAD;
        if (ti == 0) {
#pragma unroll
            for (int jj = 0; jj < 15; ++jj) { const int c = 2 * lane + 128 * jj; wcur[jj] = *(const unsigned*)(pr + 1024 + c); wprv[jj] = s > 0 ? *(const unsigned*)(pr + 1024 + c - ODD_PAD) : 0u; }
        } else {
#pragma unroll
            for (int jj = 0; jj < 15; ++jj) { wprv[jj] = s > 0 ? wcur[jj] : 0u; wcur[jj] = wnxt[jj]; }
        }
#pragma unroll
        for (int jj = 0; jj < 15; ++jj) { const int c = 2 * lane + 128 * jj; wnxt[jj] = *(const unsigned*)(pr + 1024 + c + (tok + 1 < T ? ODD_PAD : 0)); }
        {
            float ge[8]; float sm = 0.f;
#pragma unroll
            for (int jj = 0; jj < 4; ++jj) { const unsigned w = *(const unsigned*)(pr + 512 + 2 * lane + 128 * jj);
                ge[2 * jj] = gelu_tanh(__uint_as_float(w << 16)); ge[2 * jj + 1] = gelu_tanh(__uint_as_float(w & 0xffff0000u)); sm += ge[2 * jj] + ge[2 * jj + 1]; }
            const float mean = wave_sum(sm) * (1.0f / 512.f); float sq = 0.f;
#pragma unroll
            for (int j = 0; j < 8; ++j) { const float d = ge[j] - mean; sq += d * d; }
            const float rstd = rsqrtf(wave_sum(sq) * (1.0f / 512.f) + 1e-5f);
#pragma unroll
            for (int jj = 0; jj < 4; ++jj) { const int c = 2 * lane + 128 * jj;
                *(unsigned*)(VN + (size_t)tok * 512 + c) = pk2((ge[2 * jj] - mean) * rstd * lgc[jj].x + lbc[jj].x, (ge[2 * jj + 1] - mean) * rstd * lgc[jj].y + lbc[jj].y); }
        }
#pragma unroll
        for (int jj = 0; jj < 15; ++jj) {
            const int c = 2 * lane + 128 * jj;
            const unsigned wf = wcur[jj];
            const unsigned wp = wprv[jj];
            const unsigned wn = s < S - 1 ? wnxt[jj] : 0u;
            const float2 m0 = m0c[jj], m1 = m1c[jj];
            const float f0 = __uint_as_float(wf << 16), f1 = __uint_as_float(wf & 0xffff0000u);
            const float x0 = f0 + m0.x * (__uint_as_float(wp << 16) - f0) + m1.x * (__uint_as_float(wn << 16) - f0);
            const float x1 = f1 + m0.y * (__uint_as_float(wp & 0xffff0000u) - f1) + m1.y * (__uint_as_float(wn & 0xffff0000u) - f1);
            if (jj < 4) *(unsigned*)(RV + (size_t)tok * D + c) = pk2(x0, x1);
            else if (jj < 8) {
                const int ck = c - 512;
                *(unsigned*)(KBf + (size_t)tok * 512 + ck) = pk2(x0, x1);
                const float2 kk_ = kkc[jj - 4];
                const float a0_ = x0 * kk_.x, a1_ = x1 * kk_.y;
                float ss = a0_ * a0_ + a1_ * a1_;
#pragma unroll
                for (int o = 16; o >= 1; o >>= 1) ss += __shfl_xor(ss, o);
                const float inv = 1.0f / fmaxf(sqrtf(ss), 1e-12f);
                *(unsigned*)(KK + (size_t)tok * 512 + ck) = pk2(a0_ * inv, a1_ * inv);
            }
            else if (jj < 12) *(unsigned*)(RV + (size_t)tok * D + 512 + (c - 1024)) = pk2(x0, x1);
            else if (jj == 12) *(unsigned*)(F5 + (size_t)tok * 384 + (c - 1536)) = pk2(tanhf_(x0), tanhf_(x1));
            else if (jj == 13) *(unsigned*)(F5 + (size_t)tok * 384 + 128 + (c - 1664)) = pk2(x0, x1);
            else *(unsigned*)(F5 + (size_t)tok * 384 + 256 + (c - 1792)) = pk2(sigmoidf_(x0), sigmoidf_(x1));
        }
    }
}
__device__ __forceinline__ void gating_pass(const bf16_t* VN, const bf16_t* Wsb, const float* bsp, const bf16_t* P, bf16_t* Y, unsigned char* lds_raw) {
    LAS unsigned char* L = (LAS unsigned char*)lds_raw;
    constexpr int RS = 272;
    const int tid = tidx(), lane = tid & 63, wave = tid >> 6, fr = lane & 15, fq = lane >> 4;
    for (int it = blockIdx.x; it < 512; it += gridDim.x) {
        const int g = it & 3, chunk = it >> 2;
        __syncthreads();
        { const int j = tid >> 2, q4 = tid & 3;
          const v4u* gp = (const v4u*)(VN + (size_t)(chunk * 128 + j) * 512 + g * 128 + 32 * q4);
#pragma unroll
          for (int q = 0; q < 4; ++q) { const v4u x = gp[q];
#pragma unroll
              for (int e = 0; e < 4; ++e) { const int c = 32 * q4 + 8 * q + 2 * e;
                  *(LAS unsigned short*)(L + c * RS + 2 * j) = (unsigned short)(x[e] & 0xffffu); *(LAS unsigned short*)(L + (c + 1) * RS + 2 * j) = (unsigned short)(x[e] >> 16); } } }
        __syncthreads();
        bf16x8 lf[4];
#pragma unroll
        for (int ks = 0; ks < 4; ++ks) lf[ks] = *(const bf16x8*)(Wsb + (size_t)(g * 128 + 16 * wave + fr) * 128 + 32 * ks + 8 * fq);
        const int i = 16 * wave + fr; const size_t tok = (size_t)chunk * 128 + i;
        const float bias = bsp[g * 128 + i];
#pragma unroll
        for (int tn = 0; tn < 8; ++tn) {
            f32x4 acc = {0.f, 0.f, 0.f, 0.f};
#pragma unroll
            for (int ks = 0; ks < 4; ++ks) { const bf16x8 rf = *(const LAS bf16x8*)(L + (16 * tn + fr) * RS + (32 * ks + 8 * fq) * 2); MMA16(acc, lf[ks], rf); }
            const int c = g * 128 + 16 * tn + 4 * fq;
            const v2u uw = *(const v2u*)(P + tok * ODD_PAD + c);
            const float u0 = gelu_tanh(__uint_as_float(uw.x << 16)), u1 = gelu_tanh(__uint_as_float(uw.x & 0xffff0000u)), u2 = gelu_tanh(__uint_as_float(uw.y << 16)), u3 = gelu_tanh(__uint_as_float(uw.y & 0xffff0000u));
            v2u w; w.x = pk2(u0 * (acc[0] + bias), u1 * (acc[1] + bias)); w.y = pk2(u2 * (acc[2] + bias), u3 * (acc[3] + bias));
            *(v2u*)(Y + tok * D + c) = w;
        }
    }
}


__device__ __forceinline__ void router_pass(const float* X, const float* g, const float* WRT  , float* AFF, int* SLOT, bf16_t* H, unsigned char* lds_raw) {
    const int tix_ = tidx(); const int lane = tix_ & 63, wave = tix_ >> 6, fr = lane & 15, fq = lane >> 4;
    const int pair = wave >> 1, half = wave & 1;
    f32x4 gcr[4];
#pragma unroll
    for (int j = 0; j < 4; ++j) gcr[j] = ((const f32x4*)g)[lane + 64 * j];
    LAS float* xch = (LAS float*)lds_raw + pair * 512;
    for (int tile0 = blockIdx.x * 4; tile0 < T / 16; tile0 += gridDim.x * 4) {
        const int tile = tile0 + pair;
        const float* xr = X + (size_t)(tile * 16 + fr) * D + 4 * fq + 512 * half;
        const float* wr = WRT + (size_t)fr * D + 4 * fq + 512 * half;
        f32x4 acc = {0.f, 0.f, 0.f, 0.f}; float ss = 0.f;
#pragma unroll 8
        for (int s = 0; s < 32; ++s) {
            const f32x4 xa = *(const f32x4*)(xr + 16 * s), wb = *(const f32x4*)(wr + 16 * s);
            ss += (xa[0] * xa[0] + xa[1] * xa[1]) + (xa[2] * xa[2] + xa[3] * xa[3]);
#pragma unroll
            for (int c = 0; c < 4; ++c) acc = __builtin_amdgcn_mfma_f32_16x16x4f32(xa[c], wb[c], acc, 0, 0, 0);
        }
        ss += __shfl_xor(ss, 16); ss += __shfl_xor(ss, 32);
        __syncthreads();
        { LAS float* p = xch + half * 256 + lane * 4; p[0] = acc[0]; p[1] = acc[1]; p[2] = acc[2]; p[3] = acc[3]; }
        if (fq == 0) ((LAS float*)lds_raw + 2048 + pair * 32 + half * 16)[fr] = ss;
        __syncthreads();
        { const LAS float* p = xch + (half ^ 1) * 256 + lane * 4; acc[0] += p[0]; acc[1] += p[1]; acc[2] += p[2]; acc[3] += p[3]; }
        ss += ((const LAS float*)lds_raw + 2048 + pair * 32 + (half ^ 1) * 16)[fr];
        const float rstd = rsqrtf(ss * (1.0f / D) + 1e-6f);
        {
            float aff[4];
#pragma unroll
            for (int jj = 0; jj < 4; ++jj) {
                const float lg = acc[jj] * __shfl(rstd, 4 * fq + jj);
                float mx = lg;
#pragma unroll
                for (int o = 1; o < 16; o <<= 1) mx = fmaxf(mx, __shfl_xor(mx, o));
                const float e = expf(lg - mx); float den = e;
#pragma unroll
                for (int o = 1; o < 16; o <<= 1) den += __shfl_xor(den, o);
                aff[jj] = e / den;
            }
#pragma unroll
            for (int jj = 0; jj < 4; ++jj) { const size_t o = (size_t)(tile * 16 + 4 * fq + jj) * NE + fr; if ((fq >> 1) == half) { AFF[o] = aff[jj]; SLOT[o] = -1; } }
        }
#pragma unroll 4
        for (int tt = 0; tt < 8; ++tt) {
            const int t = 8 * half + tt;
            const float rs = __shfl(rstd, t);
            const f32x4* xp = (const f32x4*)(X + (size_t)(tile * 16 + t) * D); v2u* hp = (v2u*)(H + (size_t)(tile * 16 + t) * D);
#pragma unroll
            for (int j = 0; j < 4; ++j) { const f32x4 v = xp[lane + 64 * j], gg = gcr[j];
                v2u w; w.x = pk2(v[0] * rs * gg[0], v[1] * rs * gg[1]); w.y = pk2(v[2] * rs * gg[2], v[3] * rs * gg[3]); hp[lane + 64 * j] = w; }
        }
    }
}


__device__ __forceinline__ void lora_pass(const bf16_t* F5, const bf16_t* WC, const float* w0, const float* a0, const float* k_a, const bf16_t* KB, const bf16_t* KK,
                                          bf16_t* LW, bf16_t* KD, bf16_t* BB, bf16_t* G, unsigned char* lds_raw) {
    LAS unsigned char* L = (LAS unsigned char*)lds_raw;
    constexpr int ARS = 784;
    const int tid = tidx(), lane = tid & 63, wave = tid >> 6, fr = lane & 15, fq = lane >> 4;
    for (int tile = blockIdx.x; tile < T / 64; tile += gridDim.x) {
        __syncthreads();
#pragma unroll
        for (int q = 0; q < 6; ++q) { const int p = tid + 512 * q, row = p / 48, piece = p % 48;
            *(LAS v4u*)(L + row * ARS + piece * 16) = *(const v4u*)(F5 + (size_t)(tile * 64 + row) * 384 + piece * 8); }
        __syncthreads();
#pragma unroll 1
        for (int sec = 0; sec < 5; ++sec) {
            const int K0 = sec * 64, nks = sec < 4 ? 2 : 4, wstride = sec < 4 ? 64 : 128;
            const bf16_t* Wp = WC + (size_t)sec * 512 * 64 + (size_t)(64 * wave) * wstride;
#pragma unroll 1
            for (int nh = 0; nh < 2; ++nh) {
            f32x4 acc[4][2];
#pragma unroll
            for (int tm = 0; tm < 4; ++tm)
#pragma unroll
                for (int tn = 0; tn < 2; ++tn) acc[tm][tn] = (f32x4){0.f, 0.f, 0.f, 0.f};
            for (int ks = 0; ks < nks; ++ks) {
                bf16x8 lf[4], rf[2];
#pragma unroll
                for (int tm = 0; tm < 4; ++tm) lf[tm] = *(const LAS bf16x8*)(L + (16 * tm + fr) * ARS + (K0 + 32 * ks + 8 * fq) * 2);
#pragma unroll
                for (int tn = 0; tn < 2; ++tn) rf[tn] = *(const bf16x8*)(Wp + (size_t)(16 * (2 * nh + tn) + fr) * wstride + 32 * ks + 8 * fq);
#pragma unroll
                for (int tm = 0; tm < 4; ++tm)
#pragma unroll
                    for (int tn = 0; tn < 2; ++tn) MMA16(acc[tm][tn], lf[tm], rf[tn]);
            }
#pragma unroll
            for (int tn = 0; tn < 2; ++tn) {
                const int cc = 64 * wave + 16 * (2 * nh + tn) + 4 * fq;
#pragma unroll
                for (int tm = 0; tm < 4; ++tm) {
                    const size_t tok = (size_t)tile * 64 + 16 * tm + fr; const f32x4 v = acc[tm][tn];
                    __builtin_amdgcn_sched_barrier(0);
                    if (sec < 2) {
                        const f32x4 w = *(const f32x4*)(w0 + sec * 512 + cc); float o[4];
#pragma unroll
                        for (int j = 0; j < 4; ++j) o[j] = -0.6065306597126334f * frcp(1.0f + __expf(-(w[j] + v[j])));
                        v2u ww; ww.x = pk2(o[0], o[1]); ww.y = pk2(o[2], o[3]);
                        *(v2u*)(LW + ((size_t)sec * T + tok) * 512 + cc) = ww;
                    } else if (sec < 4) {
                        const int d = sec - 2;
                        const f32x4 a_ = *(const f32x4*)(a0 + d * 512 + cc), ka = *(const f32x4*)(k_a + cc);
                        const v2u kw = *(const v2u*)(KB + tok * 512 + cc), kkw = *(const v2u*)(KK + tok * 512 + cc);
                        const float kv[4] = {bflo(kw.x), bfhi(kw.x), bflo(kw.y), bfhi(kw.y)}, kk[4] = {bflo(kkw.x), bfhi(kkw.x), bflo(kkw.y), bfhi(kkw.y)};
                        float okd[4], obb[4];
#pragma unroll
                        for (int j = 0; j < 4; ++j) { const float alr = frcp(1.0f + __expf(-(a_[j] + v[j]))); okd[j] = kv[j] * (1.0f + (alr - 1.0f) * ka[j]); obb[j] = kk[j] * alr; }
                        v2u w1, w2_; w1.x = pk2(okd[0], okd[1]); w1.y = pk2(okd[2], okd[3]); w2_.x = pk2(obb[0], obb[1]); w2_.y = pk2(obb[2], obb[3]);
                        *(v2u*)(KD + ((size_t)d * T + tok) * 512 + cc) = w1; *(v2u*)(BB + ((size_t)d * T + tok) * 512 + cc) = w2_;
                    } else { v2u ww; ww.x = pk2(v[0], v[1]); ww.y = pk2(v[2], v[3]); *(v2u*)(G + tok * 512 + cc) = ww; }
                }
            }
            }
        }
    }
}

#define IN(k) (lo <= (k) && (k) < hi)
#define REP_LOOP for (int rep_ = 0, nrep_ = ((ph == PROBE_PHASE) ? PROBE_REP : 1); rep_ < nrep_; ++rep_)
#define SEAM(k) do { if (IN(k) && IN((k) + 1)) xcd_barrier(bar); } while (0)
#define PROLOG \
    const int tid = tidx(), lane = tid & 63, wave = tid >> 6; \
    const int bid = blockIdx.x, nb = gridDim.x; \
    const int gw = bid * 8 + wave, ngw = nb * 8; \
    const int gt = bid * NTH + tid, ngt = nb * NTH; \
    (void)gt; (void)ngt; (void)gw; (void)ngw; (void)lane; (void)wave; \
    unsigned char* ws = a.ws; \
    const int lo = a.lo, hi = a.hi; \
    float* ldsf = (float*)lds_raw; (void)ldsf; \
    PG8_LAS unsigned char* ldsp = (PG8_LAS unsigned char*)lds_raw; (void)ldsp; \
    const float* x_in = a.in[0]; const float* mem = a.in[1]; (void)x_in; (void)mem; \
    float* ropec = (float*)(ws + WS_ROPE); float* ropes = ropec + S * 32; (void)ropec; (void)ropes; \
    float* AFF = (float*)(ws + WS_AFF); int* TOK = (int*)(ws + WS_TOK); float* GATE = (float*)(ws + WS_GATE); \
    float* X = (float*)(ws + WS_X); bf16_t* H = (bf16_t*)(ws + WS_H); bf16_t* P = (bf16_t*)(ws + WS_P); \
    bf16_t* Y = (bf16_t*)(ws + WS_Y); bf16_t* Q = (bf16_t*)(ws + WS_Q); bf16_t* KV = (bf16_t*)(ws + WS_KV); bf16_t* MN = (bf16_t*)(ws + WS_MN); \
    bf16_t* DEC = (bf16_t*)(ws + WS_DEC); bf16_t* KD = (bf16_t*)(ws + WS_KD); bf16_t* BB = (bf16_t*)(ws + WS_BB); \
    bf16_t* KK = (bf16_t*)(ws + WS_KK); bf16_t* G = (bf16_t*)(ws + WS_G); float* YS = (float*)(ws + WS_YS); \
    bf16_t* RV = (bf16_t*)(ws + WS_RV); bf16_t* VN = (bf16_t*)(ws + WS_VN); \
    bf16_t* XE = (bf16_t*)(ws + WS_XE); bf16_t* HID = (bf16_t*)(ws + WS_HID); int* SLOT = (int*)(ws + WS_SLOT); bf16_t* YE = (bf16_t*)(ws + WS_YE); (void)SLOT; (void)YE; \
    (void)AFF; (void)TOK; (void)GATE; (void)X; (void)H; (void)P; (void)Y; (void)Q; (void)KV; (void)MN; (void)DEC; (void)KD; (void)BB; (void)KK; (void)G; (void)YS; (void)RV; (void)VN; (void)XE; (void)HID;

template <class Epi>
__device__ __forceinline__ void dense_gemm(PG8_LAS unsigned char* ldsp, const bf16_t* A, const bf16_t* Bt, int M, int N, int K, const Epi& E, int cshift = 0) {
    asm volatile("" : "+s"(K));
    pg8::Gemm g{A, Bt, M, N, K}; pg8::StaticOrder So; So.init(M, N, (int)gridDim.x, (int)((blockIdx.x + cshift) % gridDim.x));
    pg8::gemm_phase<Epi, pg8::StaticOrder, false>(ldsp, g, So, E, nullptr);
}

__device__ __forceinline__ int odd_phases(const Args& a, const XcdBarrier& bar, unsigned char* lds_raw, int ph) {
    PROLOG
    if (IN(ph)) combine_norm<false>(X, YE, SLOT, a.in[6], H, nullptr);
    SEAM(ph); ++ph;
    if (IN(ph)) dense_gemm(ldsp, H, (const bf16_t*)(ws + WS_WOIN), T, ODD_PAD, D, EpiBf16Store{P, ODD_PAD, 1.0f});
    SEAM(ph); ++ph;
    if (IN(ph)) REP_LOOP odd_token_pass(P, a.in[12], a.in[18], a.in[8], a.in[9], VN, RV, (bf16_t*)(ws + WS_KB), KK, (bf16_t*)(ws + WS_F5));
    SEAM(ph); ++ph;
    if (IN(ph)) REP_LOOP {
        gating_pass(VN, (const bf16_t*)(ws + WS_WSB), a.in[11], P, Y, lds_raw);
        __syncthreads();
        lora_pass((const bf16_t*)(ws + WS_F5), (const bf16_t*)(ws + WS_WL), a.in[13], a.in[15], a.in[19], (const bf16_t*)(ws + WS_KB), KK, DEC, KD, BB, G, lds_raw);
    }
    SEAM(ph); ++ph;
    if (IN(ph)) REP_LOOP scan_r1(DEC, RV, KD, KK, BB, (bf16_t*)(ws + WS_PT), (bf16_t*)(ws + WS_QT), (bf16_t*)(ws + WS_RH), (float*)(ws + WS_YL), lds_raw);
    SEAM(ph); ++ph;
    if (IN(ph)) REP_LOOP {
        if (bid < 32) scan_r2((const bf16_t*)(ws + WS_PT), (const bf16_t*)(ws + WS_QT), (bf16_t*)(ws + WS_S0), lds_raw);
        else {
            LAS float* scr = (LAS float*)((LAS unsigned char*)lds_raw + wave * 16896);
            const int gw2 = (bid - 32) * 8 + wave, ngw2 = (nb - 32) * 8;
            auto gmap = [](int n) { return (n >> 7) * 256 + (n & 127); };
            auto umap = [](int n) { return (n >> 7) * 256 + 128 + (n & 127); };
            for (int it = gw2; it < 16 * 704; it += ngw2) { const int e = it / 704, r = it % 704;
                transpose_item_fp8(a.in[31] + (size_t)(16 + e) * D * DE, D, DE, ws + WS_WGU8 + 176 * MiB + (size_t)e * 5632 * D, gmap, GUSC8, scr, r, lane); }
            for (int it = gw2; it < 16 * 704; it += ngw2) { const int e = it / 704, r = it % 704;
                transpose_item_fp8(a.in[32] + (size_t)(16 + e) * D * DE, D, DE, ws + WS_WGU8 + 176 * MiB + (size_t)e * 5632 * D, umap, GUSC8, scr, r, lane); }
        }
    }
    SEAM(ph); ++ph;
    if (IN(ph)) REP_LOOP scan_r3((const bf16_t*)(ws + WS_RH), (const float*)(ws + WS_YL), (const bf16_t*)(ws + WS_S0), RV, KD, G, a.in[20], a.in[21], a.in[22], Y);
    SEAM(ph); ++ph;
    if (IN(ph)) dense_gemm(ldsp, Y, (const bf16_t*)(ws + WS_WOOUT), T, D, D, EpiResidN{X, X, H, (float*)(ws + WS_SSP)});
    SEAM(ph); ++ph;
    return ph;
}

template <int layer>
__device__ __forceinline__ int tail_phases(const Args& a, const XcdBarrier& bar, unsigned char* lds_raw, int ph) {
    PROLOG
    if (IN(ph)) REP_LOOP {
        int Kq = D; asm volatile("" : "+s"(Kq));
        pg8::Gemm g{H, (const bf16_t*)(ws + WS_WQ) + (size_t)layer * D * D, T, D, Kq}; XattnOrder So{(int)blockIdx.x};
        pg8::gemm_phase<EpiBf16StoreRS, XattnOrder, false>(ldsp, g, So, EpiBf16StoreRS{Q, D, (const float*)(ws + WS_SSP)}, nullptr);
        asm volatile("s_waitcnt vmcnt(0)" ::: "memory");
        __syncthreads();
        xattn_mfma(Q, KV + (size_t)layer * 1024 * 1024, KV + (size_t)layer * 1024 * 1024 + 512 * 1024, Y, lds_raw);
    }
    SEAM(ph); ++ph;
    if (IN(ph)) dense_gemm(ldsp, Y, (const bf16_t*)(ws + WS_WO) + (size_t)layer * D * D, T, D, D, EpiResid{X, X});
    SEAM(ph); ++ph;
    if (IN(ph)) REP_LOOP router_pass(X, a.in[29] + layer * D, (const float*)(ws + WS_WRT) + (size_t)layer * NE * D, AFF, SLOT, H, lds_raw);
    SEAM(ph); ++ph;
    if (IN(ph)) REP_LOOP {
        unsigned* keys = (unsigned*)ldsf;
        int* hist = (int*)(ldsf + 8192);
        int* sh = hist + 8 * 256;
        if (bid >= 32) {
            LAS float* scr = (LAS float*)((LAS unsigned char*)lds_raw + wave * 16896);
            const int gw2 = (bid - 32) * 8 + wave, ngw2 = (nb - 32) * 8;
            auto ident = [](int n) { return n; };
            if constexpr (layer == 0) {
                auto gmap = [](int n) { return (n >> 7) * 256 + (n & 127); };
                auto umap = [](int n) { return (n >> 7) * 256 + 128 + (n & 127); };
        for (int it = 4096 + gw2; it < 16 * 704; it += ngw2) { const int mt = it / 704, r = it % 704;
            if constexpr (F8L0) transpose_item_fp8(a.in[31] + (size_t)mt * D * DE, D, DE, ws + WS_WGU8 + (size_t)mt * 5632 * D, gmap, GUSC8, scr, r, lane);
            else transpose_item(a.in[31] + (size_t)mt * D * DE, D, DE, (bf16_t*)(ws + WS_WGU) + (size_t)mt * 5632 * D, gmap, scr, r, lane); }
        for (int it = gw2; it < 16 * 704; it += ngw2) { const int mt = it / 704, r = it % 704;
            if constexpr (F8L0) transpose_item_fp8(a.in[32] + (size_t)mt * D * DE, D, DE, ws + WS_WGU8 + (size_t)mt * 5632 * D, umap, GUSC8, scr, r, lane);
            else transpose_item(a.in[32] + (size_t)mt * D * DE, D, DE, (bf16_t*)(ws + WS_WGU) + (size_t)mt * 5632 * D, umap, scr, r, lane); }
            }
            for (int it = gw2; it < 16 * 704; it += ngw2) { const int mt = layer * 16 + it / 704, r = it % 704;
                if constexpr (layer == 1 || F8L0) transpose_item_fp8(a.in[33] + (size_t)mt * DE * D, DE, D, ws + WS_WD8 + (size_t)layer * 88 * MiB + (size_t)(mt - 16 * layer) * D * DE, ident, DSC8, scr, r, lane);
                else transpose_item(a.in[33] + (size_t)mt * DE * D, DE, D, (bf16_t*)(ws + WS_WD) + (size_t)mt * D * DE, ident, scr, r, lane); }
        }
        for (int be = bid; be < NB * NE && be < 32; be += nb) {
            const int b = be >> 4, e = be & 15, eb = e * 2 + b;
            __syncthreads();
            for (int s = tid; s < S; s += NTH) keys[s] = __float_as_uint(AFF[(size_t)(b * S + s) * NE + e]);
            unsigned prefix = 0u; int krem = CAP;
            for (int pass = 3; pass >= 0; --pass) {
                __syncthreads();
                for (int i = tid; i < 8 * 256; i += NTH) hist[i] = 0;
                __syncthreads();
                const unsigned hmask = pass == 3 ? 0u : (0xFFFFFFFFu << (8 * (pass + 1)));
                for (int s = tid; s < S; s += NTH) { const unsigned k = keys[s]; if ((k & hmask) == prefix) atomicAdd(&hist[wave * 256 + ((k >> (8 * pass)) & 255u)], 1); }
                __syncthreads();
                if (wave == 0) {
                    int c4[4], s4 = 0;
#pragma unroll
                    for (int j = 0; j < 4; ++j) { const int bin = 255 - (4 * lane + j); int c = 0;
#pragma unroll
                        for (int w = 0; w < 8; ++w) c += hist[w * 256 + bin];
                        c4[j] = c; s4 += c; }
                    int pre = s4;
#pragma unroll
                    for (int o = 1; o < 64; o <<= 1) { const int y = __shfl_up(pre, o); if (lane >= o) pre += y; }
                    const int excl = pre - s4;
                    if (excl < krem && krem <= pre) {
                        int cum = excl, bsel = 0, rem = 0; bool found = false;
#pragma unroll
                        for (int j = 0; j < 4; ++j) { if (!found && cum + c4[j] >= krem) { bsel = 255 - (4 * lane + j); rem = krem - cum; found = true; } if (!found) cum += c4[j]; }
                        sh[8] = bsel; sh[9] = rem;
                    }
                }
                __syncthreads();
                prefix |= ((unsigned)sh[8]) << (8 * pass); krem = sh[9];
            }
            const unsigned thr = prefix;
            int ce = 0;
            for (int i = 0; i < 16; ++i) { const unsigned k = keys[tid * 16 + i]; ce += (k == thr); }
            int tot;
            const int eqbase = block_exscan(ce, sh, &tot);
            int eqr = eqbase, cs = 0;
            for (int i = 0; i < 16; ++i) { const unsigned k = keys[tid * 16 + i]; const bool sel = (k > thr) || (k == thr && eqr < krem); eqr += (k == thr); cs += sel; }
            const int sbase = block_exscan(cs, sh, &tot);
            int slot = sbase; eqr = eqbase;
            for (int i = 0; i < 16; ++i) {
                const int s = tid * 16 + i; const unsigned k = keys[s];
                const bool sel = (k > thr) || (k == thr && eqr < krem); eqr += (k == thr);
                if (sel) { TOK[eb * CAP + slot] = b * S + s; GATE[eb * CAP + slot] = __uint_as_float(k); SLOT[(size_t)(b * S + s) * NE + e] = eb * CAP + slot; ++slot; }
            }
        }
    }
    SEAM(ph); ++ph;
    if (IN(ph)) REP_LOOP {
        for (int r = gw; r < NB * NE * CAP; r += ngw) {
            int rv_ = r; asm volatile("" : "+v"(rv_));
            if constexpr (layer == 1 || F8L0) {
                const v4u* srcp = (const v4u*)(H + (size_t)TOK[rv_] * D) + 2 * lane; const v4u x0 = srcp[0], x1 = srcp[1];
                v4u o;
                o.x = pk4_fp8(bflo(x0.x) * ASC8, bfhi(x0.x) * ASC8, bflo(x0.y) * ASC8, bfhi(x0.y) * ASC8); o.y = pk4_fp8(bflo(x0.z) * ASC8, bfhi(x0.z) * ASC8, bflo(x0.w) * ASC8, bfhi(x0.w) * ASC8);
                o.z = pk4_fp8(bflo(x1.x) * ASC8, bfhi(x1.x) * ASC8, bflo(x1.y) * ASC8, bfhi(x1.y) * ASC8); o.w = pk4_fp8(bflo(x1.z) * ASC8, bfhi(x1.z) * ASC8, bflo(x1.w) * ASC8, bfhi(x1.w) * ASC8);
                ((v4u*)((unsigned char*)XE + (size_t)r * D))[lane] = o;
            } else {
                const v4u* srcp = (const v4u*)(H + (size_t)TOK[rv_] * D); v4u* dst = (v4u*)(XE + (size_t)r * D);
                dst[lane] = srcp[lane]; dst[lane + 64] = srcp[lane + 64];
            }
        }
    }
    SEAM(ph); ++ph;
    if (IN(ph)) {
        MoeOrder So{(int)gridDim.x, (int)blockIdx.x, 16 * 22, 22};
        if constexpr (layer == 1 || F8L0) {
            int Kg = D / 2; asm volatile("" : "+s"(Kg));
            pg8::Gemm g{XE, (const bf16_t*)(ws + WS_WGU8 + (size_t)layer * 176 * MiB), NB * NE * CAP, NE * 5632, Kg};
            pg8::gemm_phase<EpiSiluMul8, MoeOrder, false, true>(ldsp, g, So, EpiSiluMul8{(unsigned char*)HID}, nullptr);
        } else {
            pg8::Gemm g{XE, (const bf16_t*)(ws + WS_WGU) + (size_t)layer * NE * 5632 * D, NB * NE * CAP, NE * 5632, D};
            pg8::gemm_phase<EpiSiluMul, MoeOrder, false>(ldsp, g, So, EpiSiluMul{HID}, nullptr);
        }
    }
    SEAM(ph); ++ph;
    if (IN(ph)) {
        MoeOrder So{(int)gridDim.x, (int)blockIdx.x, 16 * 4, 4};
        if constexpr (layer == 1 || F8L0) {
            int Kg = DE / 2; asm volatile("" : "+s"(Kg));
            pg8::Gemm g{HID, (const bf16_t*)(ws + WS_WD8 + (size_t)layer * 88 * MiB), NB * NE * CAP, NE * D, Kg};
            pg8::gemm_phase<EpiYE8, MoeOrder, false, true>(ldsp, g, So, EpiYE8{GATE, YE}, nullptr);
        } else {
            pg8::Gemm g{HID, (const bf16_t*)(ws + WS_WD) + (size_t)layer * NE * D * DE, NB * NE * CAP, NE * D, DE};
            pg8::gemm_phase<EpiYE, MoeOrder, false>(ldsp, g, So, EpiYE{GATE, YE}, nullptr);
        }
    }
    SEAM(ph); ++ph;
    return ph;
}

__global__ void __launch_bounds__(NTH, 2) mega(Args a) {
    extern __shared__ __attribute__((aligned(16))) unsigned char lds_raw[];
    unsigned* ctl = (unsigned*)(a.ws + WS_CTL);
    volatile LAS unsigned* bst = (volatile LAS unsigned*)((LAS unsigned char*)lds_raw + LDS_BAR_OFF);
    { const int t0_ = tidx(); if (t0_ < 4) bst[t0_] = 0u; }
    __syncthreads();
    XcdBarrier bar; bar.bar = ctl + CW_BAR; bar.x = 0; bar.st = bst;
    if (a.hi - a.lo > 1) bar = xcd_barrier_post(ctl + CW_BAR, bst);
    PROLOG

    int ph = 0;
    if (IN(ph)) REP_LOOP {
        for (int i = gt; i < S * 32; i += ngt) {
            const int s = i >> 5, f = i & 31;
            const float pw = (float)exp((double)((float)(2 * f) / 64.0f) * 9.210340371976184);
            const float invf = 1.0f / pw;
            const float angf = (float)s * invf;
            double xx = (double)angf;
            const double n = rint(xx * 0.15915494309189535);
            xx = (xx - n * 6.283185307179586) - n * 2.4492935982947064e-16;
            const double x2 = xx * xx;
            double cs = 1.0, sn = xx, tc = 1.0, tsn = xx;
#pragma unroll 1
            for (int k = 1; k <= 16; ++k) { tc *= -x2 / (double)((2 * k - 1) * (2 * k)); tsn *= -x2 / (double)((2 * k) * (2 * k + 1)); cs += tc; sn += tsn; }
            ropec[i] = (float)cs; ropes[i] = (float)sn;
        }
        rmsnorm_rows_bf16(x_in, a.in[2], H, T);
        rmsnorm_rows_bf16(mem, a.in[25], MN, NB * MEM); rmsnorm_rows_bf16(mem, a.in[25] + D, MN + NB * MEM * D, NB * MEM);
        LAS float* scr = (LAS float*)((LAS unsigned char*)lds_raw + wave * 16896);
        auto ident = [](int n) { return n; };
        auto emap = [](int n) { const bool il = (n < 1024) || (n >= 1536 && n < 2176); const int j = n & 63; return il ? ((n & ~63) + (j < 32 ? 2 * j : 2 * (j - 32) + 1)) : n; };
        for (int it = gw; it < 16 * 36; it += ngw) transpose_item(a.in[3], D, EVEN_IN, (bf16_t*)(ws + WS_WEIN), emap, scr, it, lane);
        for (int it = gw; it < 2 * 16 * 32; it += ngw) { const int l = it / 512, r = it % 512; transpose_item(a.in[27] + (size_t)l * D * 2048, D, 2048, (bf16_t*)(ws + WS_WKV) + (size_t)l * 2048 * D, ident, scr, r, lane); }
        { float* WRT = (float*)(ws + WS_WRT);
          for (int i = gt; i < 2 * NE * D; i += ngt) { const int l = i >> 14, e = (i >> 10) & 15, k = i & 1023; WRT[i] = a.in[29][l * D + k] * a.in[30][((size_t)l * D + k) * NE + e]; } }
        { bf16_t* Wsb = (bf16_t*)(ws + WS_WSB); const float* wsp = a.in[10];
          for (int i = gt; i < 4 * 128 * 128; i += ngt) Wsb[i] = (bf16_t)f2bf(wsp[i]);
          bf16_t* WL = (bf16_t*)(ws + WS_WL); const float *w2 = a.in[14], *a2 = a.in[16], *g2 = a.in[17];
          for (int i = gt; i < 4 * 512 * 64 + 512 * 128; i += ngt) { float v;
              if (i < 4 * 512 * 64) { const int sec = i >> 15, n = (i >> 6) & 511, k = i & 63; v = (sec < 2 ? w2 : a2)[(size_t)((sec & 1) * 64 + k) * 512 + n]; }
              else { const int j = i - 4 * 512 * 64, n = j >> 7, k = j & 127; v = g2[(size_t)k * 512 + n]; }
              WL[i] = (bf16_t)f2bf(v); } }
        auto gmap = [](int n) { return (n >> 7) * 256 + (n & 127); };
        auto umap = [](int n) { return (n >> 7) * 256 + 128 + (n & 127); };
    }
    SEAM(ph); ++ph;

    if (IN(ph)) dense_gemm(ldsp, H, (const bf16_t*)(ws + WS_WEIN), T, EVEN_IN, D,
                           EpiEven{ropec, ropes, (bf16_t*)(ws + WS_QHA), (bf16_t*)(ws + WS_KHA), (bf16_t*)(ws + WS_QHB), (bf16_t*)(ws + WS_KHB), (bf16_t*)(ws + WS_VTA), (bf16_t*)(ws + WS_VTB)});
    if (IN(ph)) {
        dense_gemm(ldsp, MN, (const bf16_t*)(ws + WS_WKV), NB * MEM, 2048, D, EpiKV{KV, KV + 512 * 1024}, 192);
        dense_gemm(ldsp, MN + NB * MEM * D, (const bf16_t*)(ws + WS_WKV) + (size_t)2048 * D, NB * MEM, 2048, D, EpiKV{KV + 1024 * 1024, KV + 1024 * 1024 + 512 * 1024}, 176);
        if (bid >= 96) {
            __syncthreads();
            LAS float* scr = (LAS float*)((LAS unsigned char*)lds_raw + wave * 16896);
            const int gw3 = (bid - 96) * 8 + wave, ngw3 = (nb - 96) * 8;
            auto ident = [](int n) { return n; };
            auto gmap = [](int n) { return (n >> 7) * 256 + (n & 127); };
        for (int it = gw3; it < 16 * 16; it += ngw3) transpose_item(a.in[5], D, D, (bf16_t*)(ws + WS_WEOUT), ident, scr, it, lane);
        for (int it = gw3; it < 16 * 46; it += ngw3) transpose_item(a.in[7], D, ODD_IN, (bf16_t*)(ws + WS_WOIN), ident, scr, it, lane);
        for (int it = gw3; it < 16 * 16; it += ngw3) transpose_item(a.in[23], D, D, (bf16_t*)(ws + WS_WOOUT), ident, scr, it, lane);
        for (int it = gw3; it < 2 * 16 * 16; it += ngw3) { const int l = it / 256, r = it % 256; transpose_item(a.in[26] + (size_t)l * D * D, D, D, (bf16_t*)(ws + WS_WQ) + (size_t)l * D * D, ident, scr, r, lane, a.in[24] + l * D); }
        for (int it = gw3; it < 2 * 16 * 16; it += ngw3) { const int l = it / 256, r = it % 256; transpose_item(a.in[28] + (size_t)l * D * D, D, D, (bf16_t*)(ws + WS_WO) + (size_t)l * D * D, ident, scr, r, lane); }
            for (int it = gw3; it < 4096; it += ngw3) { const int mt = it / 704, r = it % 704;
                if constexpr (F8L0) transpose_item_fp8(a.in[31] + (size_t)mt * D * DE, D, DE, ws + WS_WGU8 + (size_t)mt * 5632 * D, gmap, GUSC8, scr, r, lane);
                else transpose_item(a.in[31] + (size_t)mt * D * DE, D, DE, (bf16_t*)(ws + WS_WGU) + (size_t)mt * 5632 * D, gmap, scr, r, lane); }
        }
    }
    SEAM(ph); ++ph;
    if (IN(ph)) REP_LOOP attn_phase_even((const bf16_t*)(ws + WS_QHA), (const bf16_t*)(ws + WS_KHA), (const bf16_t*)(ws + WS_VTA), (const bf16_t*)(ws + WS_QHB), (const bf16_t*)(ws + WS_KHB),
                                (const bf16_t*)(ws + WS_VTB), a.in[4], (bf16_t*)(ws + WS_OA), (float*)(ws + WS_LSE), Y, lds_raw);
    SEAM(ph); ++ph;
    if (IN(ph)) REP_LOOP attn_combine((const bf16_t*)(ws + WS_OA), (const float*)(ws + WS_LSE), Y);
    SEAM(ph); ++ph;
    if (IN(ph)) dense_gemm(ldsp, Y, (const bf16_t*)(ws + WS_WEOUT), T, D, D, EpiResidN{x_in, X, H, (float*)(ws + WS_SSP)});
    SEAM(ph); ++ph;

    ph = tail_phases<0>(a, bar, lds_raw, ph);
    ph = odd_phases(a, bar, lds_raw, ph);
    ph = tail_phases<1>(a, bar, lds_raw, ph);

    if (IN(ph)) combine_norm<true>(X, YE, SLOT, a.in[34], nullptr, a.out);
    ++ph;
}
constexpr int NPHASES = 1 + 4 + 2 * 7 + 8 + 1;
#undef IN
#undef SEAM
}

extern "C" void kernel_launch(void* const* d_in, const int* in_sizes, int n_in, void* d_out, int out_size, void* d_ws, size_t ws_size, hipStream_t stream) {
    static int grid = 0;
    if (grid == 0) {
        if (n_in != 35 || out_size != T * D || ws_size < WS_END) { fprintf(stderr, "kernel_launch: unexpected shapes n_in %d out %d ws %zu (need %zu)\n", n_in, out_size, ws_size, (size_t)WS_END); grid = -1; return; }
        int dev = 0, cus = 0, per_cu = 0;
        (void)hipGetDevice(&dev); (void)hipDeviceGetAttribute(&cus, hipDeviceAttributeMultiprocessorCount, dev);
        if (hipFuncSetAttribute((const void*)mega, hipFuncAttributeMaxDynamicSharedMemorySize, LDS_BYTES) != hipSuccess) { fprintf(stderr, "hipFuncSetAttribute failed\n"); grid = -1; return; }
        if (hipOccupancyMaxActiveBlocksPerMultiprocessor(&per_cu, (const void*)mega, NTH, LDS_BYTES) != hipSuccess || per_cu < 1) fprintf(stderr, "occupancy query: %d\n", per_cu);
        (void)hipGetLastError();
        grid = cus > 0 ? cus : 256;
    }
    if (grid < 0) return;
    (void)hipMemsetAsync((char*)d_ws + WS_CTL, 0, CTL_BYTES, stream);
    Args a{};
    for (int i = 0; i < 35; ++i) a.in[i] = (const float*)d_in[i];
    a.out = (float*)d_out; a.ws = (unsigned char*)d_ws;
#if MK_MULTI
    for (int k = 0; k < NPHASES; ++k) { a.lo = k; a.hi = k + 1; hipLaunchKernelGGL(mega, dim3(grid), dim3(NTH), LDS_BYTES, stream, a); }
#else
    a.lo = 0; a.hi = NPHASES; hipLaunchKernelGGL(mega, dim3(grid), dim3(NTH), LDS_BYTES, stream, a);
#endif
}
```

```cpp
#include <hip/hip_runtime.h>
#include <cstdio>
#include <cstdint>

#ifndef PROBE_PHASE
#define PROBE_PHASE (-1)
#endif
#ifndef PROBE_REP
#define PROBE_REP 1
#endif
#ifndef MK_MULTI
#define MK_MULTI 0
#endif

__device__ __forceinline__ int tidx() { int t = threadIdx.x; asm volatile("" : "+v"(t)); return t; }
namespace pg8 {
#define PG8_LAS __attribute__((address_space(3)))
typedef unsigned short bf16_t;
typedef short bf16x8 __attribute__((ext_vector_type(8)));
typedef float f32x4 __attribute__((ext_vector_type(4)));
typedef unsigned u32x4 __attribute__((ext_vector_type(4)));
constexpr int BM = 256, BK = 64, HALF = 128, HTB = HALF * BK * 2  , STAGE_BYTES = 8 * HTB, NXCD = 8, WGM = 8;

__host__ __device__ __forceinline__ int lds_byte(int r, int c) { const int st = (r >> 4) * 2 + (c >> 5), rr = r & 15, cc = c & 31, ob = rr * 64 + cc * 2; return st * 1024 + (ob ^ (((ob >> 9) & 1) << 5)); }
__host__ __device__ __forceinline__ void stage_rc(int b, int& R, int& C) { const int st = b / 1024, sb = b % 1024, swz = sb ^ (((sb >> 9) & 1) << 5); R = (st >> 1) * 16 + swz / 64; C = (st & 1) * 32 + (swz % 64) / 2; }
__host__ __device__ __forceinline__ int perm32(int rho) { const int n = rho >> 4, i = rho & 15; return 8 * (i >> 2) + 4 * n + (i & 3); }

struct Unit { int pm, pn; };
struct Gemm { const bf16_t* A; const bf16_t* Bt; int M, N, K; };

struct StaticOrder {
    int nM, nN, nwg, G, c;
    __host__ __device__ void init(int M, int N, int G_, int c_) { nM = M / BM; nN = N / BM; nwg = nM * nN; G = G_; c = c_; }
    __host__ __device__ bool next(int i, Unit& u) const {
        const long L = (long)i * G + c; if (L >= nwg) return false;
        int wgid = (int)L; { const int q = nwg / NXCD, r = nwg % NXCD, xcd = wgid % NXCD, off = wgid / NXCD; wgid = (xcd < r ? xcd * (q + 1) : r * (q + 1) + (xcd - r) * q) + off; }
        const int nig = WGM * nN, gid = wgid / nig, fm = gid * WGM, gsz = (nM - fm) < WGM ? (nM - fm) : WGM;
        u.pm = fm + ((wgid % nig) % gsz); u.pn = (wgid % nig) / gsz; return true;
    }
    __device__ __forceinline__ void a_ready(const Unit&) const {}
    __device__ __forceinline__ void done(const Unit&) const {}
};

typedef __bf16 bf16v2_t __attribute__((ext_vector_type(2)));
typedef float f32v2_t __attribute__((ext_vector_type(2)));
__device__ __forceinline__ unsigned cvt_pk_bf16(float lo, float hi) { const f32v2_t v = {lo, hi}; return __builtin_bit_cast(unsigned, __builtin_convertvector(v, bf16v2_t)); }
typedef int i32x8 __attribute__((ext_vector_type(8)));
template <bool F8> __device__ __forceinline__ f32x4 mma_tile(const bf16x8 (&bfr)[2], const bf16x8 (&afr)[2], f32x4 acc) {
    if constexpr (F8) {
        typedef int i32x4_ __attribute__((ext_vector_type(4)));
        const i32x4_ b0 = __builtin_bit_cast(i32x4_, bfr[0]), b1 = __builtin_bit_cast(i32x4_, bfr[1]), a0 = __builtin_bit_cast(i32x4_, afr[0]), a1 = __builtin_bit_cast(i32x4_, afr[1]);
        const i32x8 bb = {b0[0], b0[1], b0[2], b0[3], b1[0], b1[1], b1[2], b1[3]}, aa = {a0[0], a0[1], a0[2], a0[3], a1[0], a1[1], a1[2], a1[3]};
        const int sc1 = 0x7f7f7f7f;
        asm volatile("v_mfma_scale_f32_16x16x128_f8f6f4 %0, %1, %2, %0, %3, %3 op_sel_hi:[0,0,0]" : "+v"(acc) : "v"(bb), "v"(aa), "v"(sc1));
        return acc;
    } else {
        acc = __builtin_amdgcn_mfma_f32_16x16x32_bf16(bfr[0], afr[0], acc, 0, 0, 0);
        return __builtin_amdgcn_mfma_f32_16x16x32_bf16(bfr[1], afr[1], acc, 0, 0, 0);
    }
}
template <class Epi, class Sched, bool STAMP = false, bool F8 = false>
__device__ __forceinline__ void gemm_phase(PG8_LAS unsigned char* lds, const Gemm g, const Sched& S, const Epi& E, unsigned long long* stamps) {
    const int tid = ::tidx(), wid = __builtin_amdgcn_readfirstlane(tid >> 6), lane = tid & 63, wr = wid >> 2, wc = wid & 3, fr = lane & 15, fq = lane >> 4;
    const int K = g.K, nt = K / BK;
    int ts_lo = 0, ts_hi = 0, nts = 0; const unsigned long long rt_entry = STAMP ? (unsigned long long)wall_clock64() : 0ull;
#define PG8_STAMP() do { if (STAMP && wid == 0 && nts < 64) { const unsigned long long _c = (unsigned long long)clock64(); \
        ts_lo = (lane == nts) ? (int)(unsigned)_c : ts_lo; ts_hi = (lane == nts) ? (int)(unsigned)(_c >> 32) : ts_hi; ++nts; } } while (0)
    PG8_STAMP();
    unsigned voffA[2], voffB[2];
#pragma unroll
    for (int i = 0; i < 2; ++i) { int R, C; stage_rc(tid * 16 + i * 8192, R, C); const int Rb = Epi::PERM ? ((R & ~31) + perm32(R & 31)) : R;
        voffA[i] = (unsigned)(R * K + C) * 2u; voffB[i] = (unsigned)(Rb * K + C) * 2u; }
    const size_t kstep = (size_t)(BK * 2);
    const size_t hstep = (size_t)HALF * K * 2;
    const size_t tstep = 2 * hstep;
    const unsigned ldsw = (unsigned)wid * 1024u;
    const int aoff = lds_byte(wr * 64 + fr, fq * 8), boff = lds_byte(wc * 32 + fr, fq * 8);
#define PG8_SA(b, h) (((b) * 2 + (h)) * HTB)
#define PG8_SB(b, h) ((4 + (b) * 2 + (h)) * HTB)
#define PG8_STAGE(bufoff, gbase, voff) do { _Pragma("unroll") for (int _i = 0; _i < 2; ++_i) \
        __builtin_amdgcn_global_load_lds((const unsigned*)((const char*)(gbase) + (voff)[_i]), (PG8_LAS unsigned*)(lds + (bufoff) + ldsw + _i * 8192), 16, 0, 0); } while (0)
#define PG8_LDA(dst, b, h) do { _Pragma("unroll") for (int m = 0; m < 4; ++m) _Pragma("unroll") for (int k = 0; k < 2; ++k) dst[m][k] = *(const PG8_LAS bf16x8*)(lds + PG8_SA(b, h) + aoff + m * 2048 + k * 1024); } while (0)
#define PG8_LDB(dst, b, h) do { _Pragma("unroll") for (int n = 0; n < 2; ++n) _Pragma("unroll") for (int k = 0; k < 2; ++k) dst[n][k] = *(const PG8_LAS bf16x8*)(lds + PG8_SB(b, h) + boff + n * 2048 + k * 1024); } while (0)
#define PG8_MMA(ai, bj, At, Bt) do { __builtin_amdgcn_s_setprio(1); _Pragma("unroll") for (int m = 0; m < 4; ++m) _Pragma("unroll") for (int n = 0; n < 2; ++n) \
        acc[ai][bj][m][n] = mma_tile<F8>(Bt[n], At[m], acc[ai][bj][m][n]); __builtin_amdgcn_s_setprio(0); } while (0)
#define PG8_WAIT_V(n) asm volatile("s_waitcnt vmcnt(" #n ")" ::: "memory")
#define PG8_WAIT_L(n) asm volatile("s_waitcnt lgkmcnt(" #n ")" ::: "memory")
#define PG8_BAR __builtin_amdgcn_s_barrier()
#define PG8_SCHED __builtin_amdgcn_sched_barrier(0)
    Unit cur, nxt; int ui = 0;
    if (!S.next(0, cur)) return;
    f32x4 acc[2][2][4][2];
#pragma unroll
    for (int a = 0; a < 2; ++a)
#pragma unroll
        for (int b = 0; b < 2; ++b)
#pragma unroll
            for (int m = 0; m < 4; ++m)
#pragma unroll
                for (int n = 0; n < 2; ++n) acc[a][b][m][n] = (f32x4){0.f, 0.f, 0.f, 0.f};
    bf16x8 At[4][2], B0[2][2], B1[2][2];
    const char* cA = (const char*)g.A + (size_t)cur.pm * tstep; const char* cB = (const char*)g.Bt + (size_t)cur.pn * tstep;
    S.a_ready(cur);
    PG8_STAGE(PG8_SB(0, 0), cB, voffB); PG8_STAGE(PG8_SA(0, 0), cA, voffA); PG8_STAGE(PG8_SB(0, 1), cB + hstep, voffB); PG8_STAGE(PG8_SA(0, 1), cA + hstep, voffA);
    if (wr == 1) PG8_BAR;
    PG8_WAIT_V(4); PG8_BAR;
    PG8_STAGE(PG8_SB(1, 0), cB + kstep, voffB); PG8_STAGE(PG8_SA(1, 0), cA + kstep, voffA); PG8_STAGE(PG8_SB(1, 1), cB + hstep + kstep, voffB);
    PG8_WAIT_V(6); PG8_BAR;
    PG8_STAMP();
    for (;;) {
        const bool has_next = S.next(ui + 1, nxt);
        const char* nA = has_next ? (const char*)g.A + (size_t)nxt.pm * tstep : cA; const char* nB = has_next ? (const char*)g.Bt + (size_t)nxt.pn * tstep : cB;
        for (int t = 0; t < nt; t += 2) {
            const bool last = (t == nt - 2);
            const char* a1 = cA + (size_t)(t + 1) * kstep;
            const char* a2 = last ? nA : cA + (size_t)(t + 2) * kstep; const char* b2 = last ? nB : cB + (size_t)(t + 2) * kstep;
            const char* a3 = a2 + kstep; const char* b3 = b2 + kstep;
            if (last && has_next) S.a_ready(nxt);
            PG8_LDB(B0, 0, 0); PG8_SCHED; PG8_LDA(At, 0, 0); PG8_STAGE(PG8_SA(1, 1), a1 + hstep, voffA);
            PG8_WAIT_L(8); PG8_BAR; PG8_WAIT_L(0); PG8_MMA(0, 0, At, B0); PG8_BAR; PG8_SCHED;
            PG8_LDB(B1, 0, 1); PG8_STAGE(PG8_SB(0, 0), b2, voffB);
            PG8_BAR; PG8_WAIT_L(0); PG8_MMA(0, 1, At, B1); PG8_BAR;
            PG8_LDA(At, 0, 1); PG8_STAGE(PG8_SA(0, 0), a2, voffA);
            PG8_BAR; PG8_WAIT_L(0); PG8_MMA(1, 0, At, B0); PG8_BAR; PG8_SCHED;
            PG8_STAGE(PG8_SB(0, 1), b2 + hstep, voffB);
            PG8_WAIT_V(6); PG8_BAR; PG8_MMA(1, 1, At, B1); PG8_BAR;
            PG8_LDB(B0, 1, 0); PG8_SCHED; PG8_LDA(At, 1, 0); PG8_STAGE(PG8_SA(0, 1), a2 + hstep, voffA);
            PG8_WAIT_L(8); PG8_BAR; PG8_WAIT_L(0); PG8_MMA(0, 0, At, B0); PG8_BAR; PG8_SCHED;
            PG8_LDB(B1, 1, 1); PG8_STAGE(PG8_SB(1, 0), b3, voffB);
            PG8_BAR; PG8_WAIT_L(0); PG8_MMA(0, 1, At, B1); PG8_BAR;
            PG8_LDA(At, 1, 1); PG8_STAGE(PG8_SA(1, 0), a3, voffA);
            PG8_BAR; PG8_WAIT_L(0); PG8_MMA(1, 0, At, B0); PG8_BAR; PG8_SCHED;
            PG8_STAGE(PG8_SB(1, 1), b3 + hstep, voffB);
            PG8_WAIT_V(6); PG8_BAR; PG8_MMA(1, 1, At, B1); PG8_BAR;
        }
        PG8_STAMP();
        if constexpr (!Epi::AFTER_DRAIN) { E(acc, cur, wr, wc, fr, fq); S.done(cur); }
        PG8_STAMP();
        if (!has_next) break;
#pragma unroll
        for (int a = 0; a < 2; ++a)
#pragma unroll
            for (int b = 0; b < 2; ++b)
#pragma unroll
                for (int m = 0; m < 4; ++m)
#pragma unroll
                    for (int n = 0; n < 2; ++n) acc[a][b][m][n] = (f32x4){0.f, 0.f, 0.f, 0.f};
        cur = nxt; cA = nA; cB = nB; ++ui;
    }
    PG8_WAIT_V(0);
    if (wr == 0) PG8_BAR;
    PG8_BAR;
    if constexpr (Epi::AFTER_DRAIN) { E.fused(acc, cur, wr, wc, fr, fq, lds, wid, lane); S.done(cur); }
    PG8_STAMP();
    if (STAMP && wid == 0) { stamps[lane] = lane < nts ? (((unsigned long long)(unsigned)ts_hi << 32) | (unsigned)ts_lo) : 0ull;
        if (lane == 62) stamps[62] = rt_entry; if (lane == 63) stamps[63] = (unsigned long long)wall_clock64(); }
#undef PG8_STAMP
#undef PG8_SA
#undef PG8_SB
#undef PG8_STAGE
#undef PG8_LDA
#undef PG8_LDB
#undef PG8_MMA
#undef PG8_WAIT_V
#undef PG8_WAIT_L
#undef PG8_BAR
#undef PG8_SCHED
}
}


namespace {
using pg8::bf16_t; using pg8::f32x4;
constexpr int D = 1024, NB = 2, S = 8192, T = NB * S;
constexpr int EVEN_IN = 2304, ODD_IN = 2944, ODD_PAD = 3072, FD = 1920;
constexpr int MEM = 256, NE = 16, CAP = 1024, DE = 2816;
constexpr int NTH = 512;
constexpr size_t MiB = 1u << 20;
constexpr size_t WS_CTL = 0, CTL_BYTES = 1 * MiB;
constexpr size_t WS_ROPE = 1 * MiB;
constexpr size_t WS_AFF = 4 * MiB;
constexpr size_t WS_TOK = 5 * MiB;
constexpr size_t WS_GATE = 6 * MiB;
constexpr size_t WS_WRT = 3 * MiB;
constexpr size_t WS_SLOT = 7 * MiB;
constexpr size_t WS_X = 8 * MiB;
constexpr size_t WS_H = 72 * MiB;
constexpr size_t WS_Y = 104 * MiB;
constexpr size_t WS_P = 136 * MiB;
constexpr size_t WS_Q = 320 * MiB;
constexpr size_t WS_KV = 384 * MiB;
constexpr size_t WS_MN = 388 * MiB;
constexpr size_t WS_SSP = 390 * MiB;
constexpr size_t WS_DEC = 392 * MiB;
constexpr size_t WS_KD = 456 * MiB;
constexpr size_t WS_BB = 520 * MiB;
constexpr size_t WS_KK = 584 * MiB;
constexpr size_t WS_G = 616 * MiB;
constexpr size_t WS_YS = 648 * MiB;
constexpr size_t WS_RV = 712 * MiB;
constexpr size_t WS_VN = 776 * MiB;
constexpr size_t WS_QHA = 136 * MiB;
constexpr size_t WS_KHA = 152 * MiB;
constexpr size_t WS_QHB = 168 * MiB;
constexpr size_t WS_KHB = 184 * MiB;
constexpr size_t WS_PVB = 188 * MiB;
constexpr size_t WS_VTA = 208 * MiB;
constexpr size_t WS_VTB = 256 * MiB;
constexpr size_t WS_OA = 260 * MiB;
constexpr size_t WS_LSE = 308 * MiB;
constexpr size_t WS_QT = 136 * MiB;
constexpr size_t WS_YL = 200 * MiB;
constexpr size_t WS_PT = 264 * MiB;
constexpr size_t WS_RH = 296 * MiB;
constexpr size_t WS_S0 = 328 * MiB;
constexpr size_t WS_XE = 136 * MiB;
constexpr size_t WS_YE = 136 * MiB;
constexpr size_t WS_HID = 200 * MiB;
constexpr size_t WS_KB = 360 * MiB;
constexpr size_t WS_F5 = 792 * MiB;
constexpr size_t WS_WSB = 804 * MiB;
constexpr size_t WS_WL = 805 * MiB;
constexpr size_t WS_WEIN = 808 * MiB;
constexpr size_t WS_WEOUT = 813 * MiB;
constexpr size_t WS_WOIN = 815 * MiB;
constexpr size_t WS_WOOUT = 821 * MiB;
constexpr size_t WS_WQ = 823 * MiB;
constexpr size_t WS_WKV = 827 * MiB;
constexpr size_t WS_WO = 835 * MiB;
constexpr size_t WS_WGU = 840 * MiB;
constexpr size_t WS_WD = 1192 * MiB;
constexpr size_t WS_WGU8 = 840 * MiB;
constexpr size_t WS_WD8 = 1192 * MiB;
constexpr size_t WS_END = 1368 * MiB;
constexpr bool F8L0 = true;
constexpr float ASC8 = 16.f, GUSC8 = 128.f, HSC8 = 4.f, DSC8 = 256.f;
constexpr int CW_BAR = 4096;

constexpr int LDS_BYTES = 147456;
constexpr int LDS_BAR_OFF = LDS_BYTES - 64;

#define LAS __attribute__((address_space(3)))
#define XB_TMO      128
#define XB_XCNT(j)  (256  + 64 * (j))
#define XB_XSUB(j)  (1280 + 64 * (j))
#define XB_XGEN(j)  (2304 + 64 * (j))
#define XB_TOP      3328
#define XB_TOPGEN   3392
#define XCD_BAR_WORDS 3456
#define XB_SPIN_CAP (1u << 22)
__device__ __forceinline__ unsigned xb_ld(unsigned* p)              { return __hip_atomic_load(p, __ATOMIC_RELAXED, __HIP_MEMORY_SCOPE_AGENT); }
__device__ __forceinline__ unsigned xb_add(unsigned* p, unsigned v) { return __hip_atomic_fetch_add(p, v, __ATOMIC_RELAXED, __HIP_MEMORY_SCOPE_AGENT); }
__device__ __forceinline__ unsigned xb_xcc_id() { return (unsigned)__builtin_amdgcn_s_getreg((3 << 11) | 20) & 0xFu; }
#define XB_SPIN(cond, bar) do { unsigned _sp = 0; while (cond) { __builtin_amdgcn_s_sleep(1); \
    if ((++_sp & 255u) == 0u) { if (xb_ld(&(bar)[XB_TMO])) break; if (_sp > XB_SPIN_CAP) { atomicAdd(&(bar)[XB_TMO], 1u); break; } } } } while (0)
struct XcdBarrier { unsigned* bar; unsigned x; volatile LAS unsigned* st; };
__device__ __forceinline__ XcdBarrier xcd_barrier_post(unsigned* bar, volatile LAS unsigned* st) {
    XcdBarrier b; b.bar = bar; b.x = xb_xcc_id(); b.st = st;
    if (threadIdx.x == 0) (void)xb_add(&bar[XB_XCNT(b.x)], 1u);
    return b;
}
__device__ __forceinline__ void xcd_barrier_complete(unsigned* bar, unsigned x, unsigned& nloc, unsigned& nx) {
    const unsigned G = gridDim.x * gridDim.y * gridDim.z;
    unsigned sum, cnt, mine, sp = 0u;
    for (;;) {
        sum = 0u; cnt = 0u; mine = 0u;
#pragma unroll
        for (unsigned j = 0; j < 16; ++j) { const unsigned c = xb_ld(&bar[XB_XCNT(j)]); sum += c; cnt += (c > 0u) ? 1u : 0u; mine = (j == x) ? c : mine; }
        if (sum == G) break;
        __builtin_amdgcn_s_sleep(1);
        if ((++sp & 255u) == 0u) { if (xb_ld(&bar[XB_TMO])) break; if (sp > XB_SPIN_CAP) { atomicAdd(&bar[XB_TMO], 1u); break; } }
    }
    nloc = mine > 0u ? mine : 1u; nx = cnt > 0u ? cnt : 1u;
}
__device__ __forceinline__ void xcd_barrier(const XcdBarrier& b) {
    asm volatile("s_waitcnt vmcnt(0)" ::: "memory");
    __syncthreads();
    if (threadIdx.x == 0) {
        unsigned* bar = b.bar;
        __builtin_amdgcn_s_waitcnt(0);
        unsigned nloc = b.st[0], nx = b.st[1];
        if (nloc == 0u) { xcd_barrier_complete(bar, b.x, nloc, nx); b.st[0] = nloc; b.st[1] = nx; }
        const unsigned old = xb_add(&bar[XB_XSUB(b.x)], 1u);
        const unsigned gen = old / nloc;
        if (old + 1u == (gen + 1u) * nloc) {
            __builtin_amdgcn_fence(__ATOMIC_RELEASE, "agent");
            asm volatile("s_waitcnt vmcnt(0)" ::: "memory");
            const unsigned og = xb_add(&bar[XB_TOP], 1u);
            const unsigned tg = og / nx;
            if (og + 1u == (tg + 1u) * nx) xb_add(&bar[XB_TOPGEN], 1u);
            else XB_SPIN(xb_ld(&bar[XB_TOPGEN]) == tg, bar);
            __builtin_amdgcn_fence(__ATOMIC_ACQUIRE, "agent");
            xb_add(&bar[XB_XGEN(b.x)], 1u);
            asm volatile("s_waitcnt vmcnt(0)" ::: "memory");
        } else {
            XB_SPIN(xb_ld(&bar[XB_XGEN(b.x)]) == gen, bar);
            __builtin_amdgcn_fence(__ATOMIC_ACQUIRE, "agent");
            asm volatile("s_waitcnt vmcnt(0)" ::: "memory");
        }
    }
    __syncthreads();
}

__device__ __forceinline__ float wave_sum(float v) {
#pragma unroll
    for (int o = 32; o >= 1; o >>= 1) v += __shfl_xor(v, o);
    return v;
}
__device__ __forceinline__ float frcp(float x) { return __builtin_amdgcn_rcpf(x); }
__device__ __forceinline__ float sigmoidf_(float x) { return frcp(1.0f + __expf(-x)); }
__device__ __forceinline__ float tanhf_(float x) { return 2.0f * sigmoidf_(2.0f * x) - 1.0f; }
__device__ __forceinline__ float gelu_tanh(float x) { return x * sigmoidf_(1.5957691216057308f * (x + 0.044715f * x * x * x)); }
__device__ __forceinline__ unsigned f2bf(float f) { unsigned u = __builtin_bit_cast(unsigned, f); return (u + 0x7fffu + ((u >> 16) & 1u)) >> 16; }
__device__ __forceinline__ unsigned pk2(float lo, float hi) { return pg8::cvt_pk_bf16(lo, hi); }
__device__ __forceinline__ float bflo(unsigned w) { return __uint_as_float(w << 16); }
__device__ __forceinline__ float bfhi(unsigned w) { return __uint_as_float(w & 0xffff0000u); }
typedef unsigned v4u __attribute__((ext_vector_type(4)));
typedef unsigned v2u __attribute__((ext_vector_type(2)));

struct Args { const float* in[35]; float* out; unsigned char* ws; int lo, hi; };

struct EpiF32Store {
    static constexpr bool PERM = false, AFTER_DRAIN = false;
    float* C; int ldc; int nvalid;
    __device__ __forceinline__ void operator()(const f32x4 (&acc)[2][2][4][2], const pg8::Unit& u, int wr, int wc, int fr, int fq) const {
        const int row0 = u.pm * 256 + wr * 64 + fr, col0 = u.pn * 256 + wc * 32 + 4 * fq;
#pragma unroll
        for (int ai = 0; ai < 2; ++ai)
#pragma unroll
            for (int m = 0; m < 4; ++m) { float* rowp = C + (size_t)(row0 + ai * 128 + m * 16) * ldc + col0;
#pragma unroll
                for (int bj = 0; bj < 2; ++bj)
#pragma unroll
                    for (int n = 0; n < 2; ++n) if (col0 + bj * 128 + n * 16 < nvalid) *(f32x4*)(rowp + bj * 128 + n * 16) = acc[ai][bj][m][n]; }
    }
};
struct EpiResid {
    static constexpr bool PERM = false, AFTER_DRAIN = false;
    const float* base; float* out;
    __device__ __forceinline__ void operator()(const f32x4 (&acc)[2][2][4][2], const pg8::Unit& u, int wr, int wc, int fr, int fq) const {
        const int row0 = u.pm * 256 + wr * 64 + fr, col0 = u.pn * 256 + wc * 32 + 4 * fq;
#pragma unroll
        for (int ai = 0; ai < 2; ++ai)
#pragma unroll
            for (int m = 0; m < 4; ++m) { const size_t off = (size_t)(row0 + ai * 128 + m * 16) * D + col0;
#pragma unroll
                for (int bj = 0; bj < 2; ++bj)
#pragma unroll
                    for (int n = 0; n < 2; ++n) { const f32x4 b = *(const f32x4*)(base + off + bj * 128 + n * 16); *(f32x4*)(out + off + bj * 128 + n * 16) = b + acc[ai][bj][m][n]; } }
    }
};
struct EpiSiluMul {
    static constexpr bool PERM = false, AFTER_DRAIN = false;
    bf16_t* HIDp;
    __device__ __forceinline__ void operator()(const f32x4 (&acc)[2][2][4][2], const pg8::Unit& u, int wr, int wc, int fr, int fq) const {
        const int pnl = u.pn % 22;
        const int row0 = u.pm * 256 + wr * 64 + fr, col0 = pnl * 128 + wc * 32 + 4 * fq;
#pragma unroll
        for (int ai = 0; ai < 2; ++ai)
#pragma unroll
            for (int m = 0; m < 4; ++m) { bf16_t* rowp = HIDp + (size_t)(row0 + ai * 128 + m * 16) * DE + col0;
#pragma unroll
                for (int n = 0; n < 2; ++n) { const f32x4 g = acc[ai][0][m][n], up = acc[ai][1][m][n]; float h[4];
#pragma unroll
                    for (int j = 0; j < 4; ++j) h[j] = g[j] * frcp(1.0f + __expf(-g[j])) * up[j];
                    v2u w; w.x = pk2(h[0], h[1]); w.y = pk2(h[2], h[3]); *(v2u*)(rowp + n * 16) = w; } }
    }
};
struct EpiYE {
    static constexpr bool PERM = true, AFTER_DRAIN = false;
    const float* GATE; bf16_t* YE;
    __device__ __forceinline__ void operator()(const f32x4 (&acc)[2][2][4][2], const pg8::Unit& u, int wr, int wc, int fr, int fq) const {
        const int pnl = u.pn & 3;
        const int row0 = u.pm * 256 + wr * 64 + fr, col0 = pnl * 256 + wc * 32 + 8 * fq;
#pragma unroll
        for (int ai = 0; ai < 2; ++ai)
#pragma unroll
            for (int m = 0; m < 4; ++m) { const int row = row0 + ai * 128 + m * 16; const float gt_ = GATE[row]; bf16_t* rowp = YE + (size_t)row * D + col0;
#pragma unroll
                for (int bj = 0; bj < 2; ++bj) { const f32x4 v0 = acc[ai][bj][m][0] * gt_, v1 = acc[ai][bj][m][1] * gt_;
                    v4u w; w.x = pg8::cvt_pk_bf16(v0[0], v0[1]); w.y = pg8::cvt_pk_bf16(v0[2], v0[3]); w.z = pg8::cvt_pk_bf16(v1[0], v1[1]); w.w = pg8::cvt_pk_bf16(v1[2], v1[3]);
                    *(v4u*)(rowp + bj * 128) = w; } }
    }
};
struct EpiBf16Store {
    static constexpr bool PERM = true, AFTER_DRAIN = false;
    bf16_t* O; int ldc; float scale;
    __device__ __forceinline__ void operator()(const f32x4 (&acc)[2][2][4][2], const pg8::Unit& u, int wr, int wc, int fr, int fq) const {
        const int row0 = u.pm * 256 + wr * 64 + fr, col0 = u.pn * 256 + wc * 32 + 8 * fq;
#pragma unroll
        for (int ai = 0; ai < 2; ++ai)
#pragma unroll
            for (int m = 0; m < 4; ++m) { bf16_t* rowp = O + (size_t)(row0 + ai * 128 + m * 16) * ldc + col0;
#pragma unroll
                for (int bj = 0; bj < 2; ++bj) { const f32x4 v0 = acc[ai][bj][m][0] * scale, v1 = acc[ai][bj][m][1] * scale;
                    v4u w; w.x = pg8::cvt_pk_bf16(v0[0], v0[1]); w.y = pg8::cvt_pk_bf16(v0[2], v0[3]); w.z = pg8::cvt_pk_bf16(v1[0], v1[1]); w.w = pg8::cvt_pk_bf16(v1[2], v1[3]);
                    *(v4u*)(rowp + bj * 128) = w; } }
    }
};
struct EpiKV {
    static constexpr bool PERM = false, AFTER_DRAIN = false;
    bf16_t* K; bf16_t* Vt;
    __device__ __forceinline__ void operator()(const f32x4 (&acc)[2][2][4][2], const pg8::Unit& u, int wr, int wc, int fr, int fq) const {
        const int row0 = u.pm * 256 + wr * 64 + fr, col0 = u.pn * 256 + wc * 32 + 4 * fq;
#pragma unroll
        for (int ai = 0; ai < 2; ++ai)
#pragma unroll
            for (int m = 0; m < 4; ++m) { const int row = row0 + ai * 128 + m * 16;
#pragma unroll
                for (int bj = 0; bj < 2; ++bj)
#pragma unroll
                    for (int n = 0; n < 2; ++n) { const int col = col0 + bj * 128 + n * 16; const f32x4 v = acc[ai][bj][m][n];
                        if (col < 1024) { v2u w; w.x = pk2(v[0], v[1]); w.y = pk2(v[2], v[3]); *(v2u*)(K + (size_t)row * 1024 + col) = w; }
                        else { const int b = row >> 8, mm = row & 255; bf16_t* vp = Vt + ((size_t)(b * 1024 + (col - 1024)) * 256 + mm);
#pragma unroll
                            for (int j = 0; j < 4; ++j) vp[(size_t)j * 256] = (bf16_t)f2bf(v[j]); } } }
    }
};

constexpr float QSCALE = 0.125f * 1.4426950408889634f;
struct EpiEven {
    static constexpr bool PERM = true, AFTER_DRAIN = false;
    const float* rc; const float* rs; bf16_t* QhA; bf16_t* KhA; bf16_t* QhB; bf16_t* KhB; bf16_t* VhA; bf16_t* VhB;
    __device__ __forceinline__ void operator()(const f32x4 (&acc)[2][2][4][2], const pg8::Unit& u, int wr, int wc, int fr, int fq) const {
        asm volatile("" : "+v"(fr), "+v"(fq));
        const int row0 = u.pm * 256 + wr * 64 + fr;
#pragma unroll
        for (int bj = 0; bj < 2; ++bj) {
            const int c0 = u.pn * 256 + bj * 128 + wc * 32 + 8 * fq;
            int kind; bf16_t* base; int stride; float sc = 1.0f;
            if (c0 < 512) { kind = 0; base = QhA + ((size_t)(c0 >> 6) * T) * 64 + (c0 & 63); stride = 64; sc = QSCALE; }
            else if (c0 < 1024) { kind = 0; base = KhA + ((size_t)((c0 - 512) >> 6) * T) * 64 + (c0 & 63); stride = 64; }
            else if (c0 < 1536) { kind = 1; base = VhA + ((size_t)((c0 - 1024) >> 6) * T) * 64 + (c0 & 63); stride = 64; }
            else if (c0 < 2048) { kind = 0; base = QhB + ((size_t)((c0 - 1536) >> 6) * T) * 64 + (c0 & 63); stride = 64; sc = QSCALE; }
            else if (c0 < 2176) { kind = 0; base = KhB + ((size_t)((c0 - 2048) >> 6) * T) * 64 + (c0 & 63); stride = 64; }
            else { kind = 1; base = VhB + ((size_t)((c0 - 2176) >> 6) * T) * 64 + (c0 & 63); stride = 64; }
            const int pi = (c0 & 63) >> 1;
#pragma unroll
            for (int ai = 0; ai < 2; ++ai)
#pragma unroll
                for (int m = 0; m < 4; ++m) {
                    const int tok = row0 + ai * 128 + m * 16;
                    const f32x4 v0 = acc[ai][bj][m][0], v1 = acc[ai][bj][m][1];
                    float y[8];
                    if (kind == 0) {
                        const int s = tok & (S - 1);
                        const f32x4 c4 = *(const f32x4*)(rc + s * 32 + pi), s4 = *(const f32x4*)(rs + s * 32 + pi);
                        y[0] = (v0[0] * c4[0] - v0[1] * s4[0]) * sc; y[1] = (v0[1] * c4[0] + v0[0] * s4[0]) * sc;
                        y[2] = (v0[2] * c4[1] - v0[3] * s4[1]) * sc; y[3] = (v0[3] * c4[1] + v0[2] * s4[1]) * sc;
                        y[4] = (v1[0] * c4[2] - v1[1] * s4[2]) * sc; y[5] = (v1[1] * c4[2] + v1[0] * s4[2]) * sc;
                        y[6] = (v1[2] * c4[3] - v1[3] * s4[3]) * sc; y[7] = (v1[3] * c4[3] + v1[2] * s4[3]) * sc;
                    } else { y[0] = v0[0]; y[1] = v0[1]; y[2] = v0[2]; y[3] = v0[3]; y[4] = v1[0]; y[5] = v1[1]; y[6] = v1[2]; y[7] = v1[3]; }
                    v4u w; w.x = pk2(y[0], y[1]); w.y = pk2(y[2], y[3]); w.z = pk2(y[4], y[5]); w.w = pk2(y[6], y[7]);
                    *(v4u*)(base + (size_t)tok * stride) = w;
                }
        }
    }
};

struct EpiLora {
    static constexpr bool PERM = false, AFTER_DRAIN = false;
    const float *w0, *a0, *k_a; const bf16_t *KB, *KK; bf16_t *LW, *KD, *BB, *G;
    __device__ __forceinline__ void operator()(const f32x4 (&acc)[2][2][4][2], const pg8::Unit& u, int wr, int wc, int fr, int fq) const {
        asm volatile("" : "+v"(fr), "+v"(fq));
        const int row0 = u.pm * 256 + wr * 64 + fr;
#pragma unroll
        for (int bj = 0; bj < 2; ++bj)
#pragma unroll
            for (int n = 0; n < 2; ++n) {
                const int c0 = u.pn * 256 + bj * 128 + wc * 32 + n * 16 + 4 * fq, sec = c0 >> 9, cc = c0 & 511;
#pragma unroll
                for (int ai = 0; ai < 2; ++ai)
#pragma unroll
                    for (int m = 0; m < 4; ++m) {
                        const size_t tok = row0 + ai * 128 + m * 16;
                        const f32x4 v = acc[ai][bj][m][n];
                        if (sec < 2) {
                            const f32x4 w = *(const f32x4*)(w0 + sec * 512 + cc); float o[4];
#pragma unroll
                            for (int j = 0; j < 4; ++j) { const float xw = -(w[j] + v[j]);
                                o[j] = -0.6065306597126334f * frcp(1.0f + __expf(xw)); }
                            v2u ww; ww.x = pk2(o[0], o[1]); ww.y = pk2(o[2], o[3]);
                            *(v2u*)(LW + ((size_t)sec * T + tok) * 512 + cc) = ww;
                        } else if (sec < 4) {
                            const int d = sec - 2;
                            const f32x4 a_ = *(const f32x4*)(a0 + d * 512 + cc), ka = *(const f32x4*)(k_a + cc);
                            const v2u kw = *(const v2u*)(KB + tok * 512 + cc), kkw = *(const v2u*)(KK + tok * 512 + cc);
                            const float kv[4] = {bflo(kw.x), bfhi(kw.x), bflo(kw.y), bfhi(kw.y)}, kk[4] = {bflo(kkw.x), bfhi(kkw.x), bflo(kkw.y), bfhi(kkw.y)};
                            float okd[4], obb[4];
#pragma unroll
                            for (int j = 0; j < 4; ++j) { const float alr = frcp(1.0f + __expf(-(a_[j] + v[j]))); okd[j] = kv[j] * (1.0f + (alr - 1.0f) * ka[j]); obb[j] = kk[j] * alr; }
                            v2u w1, w2_; w1.x = pk2(okd[0], okd[1]); w1.y = pk2(okd[2], okd[3]); w2_.x = pk2(obb[0], obb[1]); w2_.y = pk2(obb[2], obb[3]);
                            *(v2u*)(KD + ((size_t)d * T + tok) * 512 + cc) = w1; *(v2u*)(BB + ((size_t)d * T + tok) * 512 + cc) = w2_;
                        } else { v2u ww; ww.x = pk2(v[0], v[1]); ww.y = pk2(v[2], v[3]); *(v2u*)(G + tok * 512 + cc) = ww; }
                        __builtin_amdgcn_sched_barrier(0);
                    }
            }
    }
};

__device__ __forceinline__ float clamp8(float x) { return __builtin_amdgcn_fmed3f(x, -448.f, 448.f); }
__device__ __forceinline__ unsigned pk4_fp8(float a, float b, float c, float d) {
    int w = 0; w = __builtin_amdgcn_cvt_pk_fp8_f32(clamp8(a), clamp8(b), w, false); w = __builtin_amdgcn_cvt_pk_fp8_f32(clamp8(c), clamp8(d), w, true); return (unsigned)w;
}
struct EpiSiluMul8 {
    static constexpr bool PERM = true, AFTER_DRAIN = false;
    unsigned char* HIDp;
    __device__ __forceinline__ void operator()(const f32x4 (&acc)[2][2][4][2], const pg8::Unit& u, int wr, int wc, int fr, int fq) const {
        asm volatile("s_nop 7\n\ts_nop 7\n\ts_nop 7"); __builtin_amdgcn_sched_barrier(0);
        const int pnl = u.pn % 22;
        const int row0 = u.pm * 256 + wr * 64 + fr, col0 = pnl * 128 + wc * 32 + 8 * fq;
        const float s1 = 1.0f / (ASC8 * GUSC8);
#pragma unroll
        for (int ai = 0; ai < 2; ++ai)
#pragma unroll
            for (int m = 0; m < 4; ++m) { unsigned char* rowp = HIDp + (size_t)(row0 + ai * 128 + m * 16) * DE + col0; float h[8];
#pragma unroll
                for (int n = 0; n < 2; ++n) { const f32x4 g = acc[ai][0][m][n] * s1, up = acc[ai][1][m][n] * (s1 * HSC8);
#pragma unroll
                    for (int j = 0; j < 4; ++j) h[4 * n + j] = g[j] * frcp(1.0f + __expf(-g[j])) * up[j]; }
                v2u w; w.x = pk4_fp8(h[0], h[1], h[2], h[3]); w.y = pk4_fp8(h[4], h[5], h[6], h[7]);
                __builtin_nontemporal_store(w, (v2u*)rowp); }
    }
};
struct EpiYE8 {
    static constexpr bool PERM = true, AFTER_DRAIN = false;
    const float* GATE; bf16_t* YE;
    __device__ __forceinline__ void operator()(const f32x4 (&acc)[2][2][4][2], const pg8::Unit& u, int wr, int wc, int fr, int fq) const {
        asm volatile("s_nop 7\n\ts_nop 7\n\ts_nop 7"); __builtin_amdgcn_sched_barrier(0);
        const int pnl = u.pn & 3;
        const int row0 = u.pm * 256 + wr * 64 + fr, col0 = pnl * 256 + wc * 32 + 8 * fq;
#pragma unroll
        for (int ai = 0; ai < 2; ++ai)
#pragma unroll
            for (int m = 0; m < 4; ++m) { const int row = row0 + ai * 128 + m * 16; const float gt_ = GATE[row] * (1.0f / (HSC8 * DSC8)); bf16_t* rowp = YE + (size_t)row * D + col0;
#pragma unroll
                for (int bj = 0; bj < 2; ++bj) { const f32x4 v0 = acc[ai][bj][m][0] * gt_, v1 = acc[ai][bj][m][1] * gt_;
                    v4u w; w.x = pk2(v0[0], v0[1]); w.y = pk2(v0[2], v0[3]); w.z = pk2(v1[0], v1[1]); w.w = pk2(v1[2], v1[3]);
                    *(v4u*)(rowp + bj * 128) = w; } }
    }
};
template <class RowMap>
__device__ __forceinline__ void transpose_item_fp8(const float* W, int K, int N, unsigned char* WT, RowMap rm, float sc, LAS float* scr, int item, int lane) {
    const int nblk = N / 64, kb = item / nblk, nb_ = item % nblk, k0 = 64 * kb, n0 = 64 * nb_;
    f32x4 ld[16];
#pragma unroll
    for (int i = 0; i < 16; ++i) ld[i] = *(const f32x4*)(W + (size_t)(k0 + 4 * i + (lane >> 4)) * N + n0 + 4 * (lane & 15));
#pragma unroll
    for (int i = 0; i < 16; ++i) { LAS float* p = scr + (4 * i + (lane >> 4)) * 65 + 4 * (lane & 15); p[0] = ld[i][0]; p[1] = ld[i][1]; p[2] = ld[i][2]; p[3] = ld[i][3]; }
    asm volatile("s_waitcnt lgkmcnt(0)" ::: "memory");
    const int c = lane & 3;
#pragma unroll
    for (int j = 0; j < 4; ++j) { const int n = (lane >> 2) + 16 * j; const LAS float* s = scr + (16 * c) * 65 + n;
        v4u o;
#pragma unroll
        for (int q = 0; q < 4; ++q) o[q] = pk4_fp8(s[(4 * q) * 65] * sc, s[(4 * q + 1) * 65] * sc, s[(4 * q + 2) * 65] * sc, s[(4 * q + 3) * 65] * sc);
        *(v4u*)(WT + (size_t)rm(n0 + n) * K + k0 + 16 * c) = o; }
    asm volatile("s_waitcnt lgkmcnt(0)" ::: "memory");
}

struct EpiResidN {
    static constexpr bool PERM = false, AFTER_DRAIN = false;
    const float* base; float* out; bf16_t* Xb; float* SSP;
    __device__ __forceinline__ void operator()(const f32x4 (&acc)[2][2][4][2], const pg8::Unit& u, int wr, int wc, int fr, int fq) const {
        asm volatile("" : "+v"(fr), "+v"(fq));
        const int row0 = u.pm * 256 + wr * 64 + fr, col0 = u.pn * 256 + wc * 32 + 4 * fq;
#pragma unroll
        for (int ai = 0; ai < 2; ++ai)
#pragma unroll
            for (int m = 0; m < 4; ++m) { const size_t row = row0 + ai * 128 + m * 16; const size_t off = row * D + col0; float ss = 0.f;
#pragma unroll
                for (int bj = 0; bj < 2; ++bj)
#pragma unroll
                    for (int n = 0; n < 2; ++n) { const f32x4 b = *(const f32x4*)(base + off + bj * 128 + n * 16); const f32x4 o = b + acc[ai][bj][m][n];
                        *(f32x4*)(out + off + bj * 128 + n * 16) = o;
                        v2u w; w.x = pk2(o[0], o[1]); w.y = pk2(o[2], o[3]); *(v2u*)(Xb + off + bj * 128 + n * 16) = w;
                        ss += (o[0] * o[0] + o[1] * o[1]) + (o[2] * o[2] + o[3] * o[3]); }
                ss += __shfl_xor(ss, 16); ss += __shfl_xor(ss, 32);
                if (fq == 0) SSP[row * 16 + u.pn * 4 + wc] = ss; }
    }
};
struct EpiBf16StoreRS {
    static constexpr bool PERM = true, AFTER_DRAIN = false;
    bf16_t* O; int ldc; const float* SSP;
    __device__ __forceinline__ void operator()(const f32x4 (&acc)[2][2][4][2], const pg8::Unit& u, int wr, int wc, int fr, int fq) const {
        asm volatile("" : "+v"(fr), "+v"(fq));
        const int row0 = u.pm * 256 + wr * 64 + fr, col0 = u.pn * 256 + wc * 32 + 8 * fq;
#pragma unroll
        for (int ai = 0; ai < 2; ++ai)
#pragma unroll
            for (int m = 0; m < 4; ++m) { const size_t row = row0 + ai * 128 + m * 16;
                const f32x4* sp = (const f32x4*)(SSP + row * 16); const f32x4 s0 = sp[0], s1 = sp[1], s2 = sp[2], s3 = sp[3];
                const float ss = (((s0[0] + s0[1]) + (s0[2] + s0[3])) + ((s1[0] + s1[1]) + (s1[2] + s1[3]))) + (((s2[0] + s2[1]) + (s2[2] + s2[3])) + ((s3[0] + s3[1]) + (s3[2] + s3[3])));
                const float rs = rsqrtf(ss * (1.0f / D) + 1e-6f);
                bf16_t* rowp = O + row * ldc + col0;
#pragma unroll
                for (int bj = 0; bj < 2; ++bj) { const f32x4 v0 = acc[ai][bj][m][0] * rs, v1 = acc[ai][bj][m][1] * rs;
                    v4u w; w.x = pk2(v0[0], v0[1]); w.y = pk2(v0[2], v0[3]); w.z = pk2(v1[0], v1[1]); w.w = pk2(v1[2], v1[3]);
                    *(v4u*)(rowp + bj * 128) = w; } }
    }
};
struct MoeOrder {
    int G, c, npairs;
    int per;
    __device__ __forceinline__ bool next(int i, pg8::Unit& u) const {
        const int x = c & 7, y = c >> 3, pml = y & 7, pnq = y >> 3;
        const int epn = i * 32 + x * 4 + pnq;
        if (epn >= npairs || c >= 256) return false;
        const int e = epn / per;
        u.pm = e * 8 + pml; u.pn = epn; return true;
    }
    __device__ __forceinline__ void a_ready(const pg8::Unit&) const {}
    __device__ __forceinline__ void done(const pg8::Unit&) const {}
};

struct XattnOrder {
    int c;
    __device__ __forceinline__ bool next(int i, pg8::Unit& u) const { if (i != 0 || c >= 256) return false; u.pm = (c >> 7) * 32 + (c & 31); u.pn = (c >> 5) & 3; return true; }
    __device__ __forceinline__ void a_ready(const pg8::Unit&) const {}
    __device__ __forceinline__ void done(const pg8::Unit&) const {}
};
template <class RowMap>
__device__ __forceinline__ void transpose_item(const float* W, int K, int N, bf16_t* WT, RowMap rm, LAS float* scr, int item, int lane, const float* kscale = nullptr) {
    const int nblk = N / 64, kb = item / nblk, nb_ = item % nblk, k0 = 64 * kb, n0 = 64 * nb_;
    f32x4 ld[16];
#pragma unroll
    for (int i = 0; i < 16; ++i) ld[i] = *(const f32x4*)(W + (size_t)(k0 + 4 * i + (lane >> 4)) * N + n0 + 4 * (lane & 15));
#pragma unroll
    for (int i = 0; i < 16; ++i) { LAS float* p = scr + (4 * i + (lane >> 4)) * 65 + 4 * (lane & 15); p[0] = ld[i][0]; p[1] = ld[i][1]; p[2] = ld[i][2]; p[3] = ld[i][3]; }
    asm volatile("s_waitcnt lgkmcnt(0)" ::: "memory");
    const int c = lane & 7;
    float ksc[8];
#pragma unroll
    for (int q = 0; q < 8; ++q) ksc[q] = kscale ? kscale[k0 + 8 * c + q] : 1.0f;
#pragma unroll
    for (int j = 0; j < 8; ++j) { const int n = (lane >> 3) + 8 * j; const LAS float* s = scr + (8 * c) * 65 + n;
        v4u o; o.x = pk2(s[0 * 65] * ksc[0], s[1 * 65] * ksc[1]); o.y = pk2(s[2 * 65] * ksc[2], s[3 * 65] * ksc[3]); o.z = pk2(s[4 * 65] * ksc[4], s[5 * 65] * ksc[5]); o.w = pk2(s[6 * 65] * ksc[6], s[7 * 65] * ksc[7]);
        *(v4u*)(WT + (size_t)rm(n0 + n) * K + k0 + 8 * c) = o; }
    asm volatile("s_waitcnt lgkmcnt(0)" ::: "memory");
}

__device__ __forceinline__ void rmsnorm_rows_bf16(const float* x, const float* g, bf16_t* out, int M) {
    const int tix_ = tidx(); const int lane = tix_ & 63, gw = blockIdx.x * 8 + (tix_ >> 6), ngw = gridDim.x * 8;
    for (int m = gw; m < M; m += ngw) {
        const float4* xr = (const float4*)(x + (size_t)m * D);
        float4 v[4]; float s = 0.f;
#pragma unroll
        for (int j = 0; j < 4; ++j) { v[j] = xr[lane + 64 * j]; s += v[j].x * v[j].x + v[j].y * v[j].y + v[j].z * v[j].z + v[j].w * v[j].w; }
        const float r = rsqrtf(wave_sum(s) * (1.0f / D) + 1e-6f);
        v2u* o = (v2u*)(out + (size_t)m * D);
#pragma unroll
        for (int j = 0; j < 4; ++j) { const float4 gg = ((const float4*)g)[lane + 64 * j];
            v2u w; w.x = pk2(v[j].x * r * gg.x, v[j].y * r * gg.y); w.y = pk2(v[j].z * r * gg.z, v[j].w * r * gg.w); o[lane + 64 * j] = w; }
    }
}
__device__ __forceinline__ void rmsnorm_rows_f32(const float* x, const float* g, float* out, int M) {
    const int tix_ = tidx(); const int lane = tix_ & 63, gw = blockIdx.x * 8 + (tix_ >> 6), ngw = gridDim.x * 8;
    for (int m = gw; m < M; m += ngw) {
        const float4* xr = (const float4*)(x + (size_t)m * D);
        float4 v[4]; float s = 0.f;
#pragma unroll
        for (int j = 0; j < 4; ++j) { v[j] = xr[lane + 64 * j]; s += v[j].x * v[j].x + v[j].y * v[j].y + v[j].z * v[j].z + v[j].w * v[j].w; }
        const float r = rsqrtf(wave_sum(s) * (1.0f / D) + 1e-6f);
        float4* o = (float4*)(out + (size_t)m * D);
#pragma unroll
        for (int j = 0; j < 4; ++j) { const float4 gg = ((const float4*)g)[lane + 64 * j];
            o[lane + 64 * j] = make_float4(v[j].x * r * gg.x, v[j].y * r * gg.y, v[j].z * r * gg.z, v[j].w * r * gg.w); }
    }
}

__device__ __forceinline__ int block_exscan(int v, int* sh, int* tot) {
    const int tid = tidx(), lane = tid & 63, w = tid >> 6;
    int inc = v;
#pragma unroll
    for (int o = 1; o < 64; o <<= 1) { const int t = __shfl_up(inc, o); if (lane >= o) inc += t; }
    __syncthreads();
    if (lane == 63) sh[w] = inc;
    __syncthreads();
    int base = 0, total = 0;
#pragma unroll
    for (int i = 0; i < 8; ++i) { const int x = sh[i]; if (i < w) base += x; total += x; }
    *tot = total;
    return base + inc - v;
}


typedef short bf16x8 __attribute__((ext_vector_type(8)));
typedef float f32x16 __attribute__((ext_vector_type(16)));
constexpr int MROW = 144;
constexpr int MBUF = 64 * MROW;
__device__ __forceinline__ bf16x8 frag_rm(const LAS unsigned char* M, int row0, int k0, int fr, int fq) {
    return *(const LAS bf16x8*)(M + (row0 + fr) * MROW + (k0 + 8 * fq) * 2);
}
__device__ __forceinline__ bf16x8 frag_cm(const LAS unsigned char* M, int k0, int col0, int fr, int fq) {
    const LAS unsigned short* p = (const LAS unsigned short*)(M + (k0 + 8 * fq) * MROW + (col0 + fr) * 2);
    bf16x8 v;
#pragma unroll
    for (int j = 0; j < 8; ++j) v[j] = (short)p[j * (MROW / 2)];
    return v;
}
__device__ __forceinline__ void tile_store_bf16(LAS unsigned char* M, int m0, int n0, int fr, int fq, const f32x4& c) {
    v2u w; w.x = pk2(c[0], c[1]); w.y = pk2(c[2], c[3]);
    *(LAS v2u*)(M + (m0 + fr) * MROW + (n0 + 4 * fq) * 2) = w;
}
#define MMA16(acc, lf, rf) acc = __builtin_amdgcn_mfma_f32_16x16x32_bf16(rf, lf, acc, 0, 0, 0)

__device__ __forceinline__ void tile_store_bf16_T(LAS unsigned char* M, int m0, int n0, int fr, int fq, const f32x4& c) {
    const unsigned w0 = pk2(c[0], c[1]), w1 = pk2(c[2], c[3]);
    LAS unsigned char* p = M + (n0 + 4 * fq) * MROW + (m0 + fr) * 2;
    *(LAS unsigned short*)(p) = (unsigned short)(w0 & 0xffffu); *(LAS unsigned short*)(p + MROW) = (unsigned short)(w0 >> 16);
    *(LAS unsigned short*)(p + 2 * MROW) = (unsigned short)(w1 & 0xffffu); *(LAS unsigned short*)(p + 3 * MROW) = (unsigned short)(w1 >> 16);
}
__device__ __forceinline__ void scan_r1(const bf16_t* LWg, const bf16_t* RVg, const bf16_t* KDg, const bf16_t* KKg, const bf16_t* BBg,
                                        bf16_t* PT, bf16_t* QT, bf16_t* RH, bf16_t* YL, unsigned char* lds_raw) {
    LAS unsigned char* L = (LAS unsigned char*)lds_raw;
#define SL(k) (L + (k) * MBUF)
    LAS float* LWs = (LAS float*)(L + 14 * MBUF);
    const int tid = tidx(), lane = tid & 63, wave = tid >> 6, fr = lane & 15, fq = lane >> 4;
    const int tm = wave >> 1, tn0 = (wave & 1) * 2;
    const int m0 = tm * 16;
    const int t = tid >> 3, i0 = (tid & 7) * 8;
    v4u lw4n, r4n, v4n, kd4n, kk4n, bb4n;
#define R1_LOAD(it_) do { const int c_ = (it_) & 127, h_ = ((it_) >> 7) & 7, n_ = (it_) >> 10, dir_ = n_ >> 1, b_ = n_ & 1; \
        const int pos_ = dir_ ? (S - 1 - (c_ * 64 + t)) : (c_ * 64 + t); const size_t tok_ = (size_t)b_ * S + pos_; const size_t ch_ = (size_t)h_ * 64 + i0; \
        lw4n = *(const v4u*)(LWg + ((size_t)dir_ * T + tok_) * 512 + ch_); r4n = *(const v4u*)(RVg + tok_ * D + ch_); v4n = *(const v4u*)(RVg + tok_ * D + 512 + ch_); \
        kd4n = *(const v4u*)(KDg + ((size_t)dir_ * T + tok_) * 512 + ch_); kk4n = *(const v4u*)(KKg + tok_ * 512 + ch_); bb4n = *(const v4u*)(BBg + ((size_t)dir_ * T + tok_) * 512 + ch_); } while (0)
    if ((int)blockIdx.x < 4096) R1_LOAD((int)blockIdx.x);
    for (int item = blockIdx.x; item < 4096; item += gridDim.x) {
        const v4u lw4 = lw4n, r4 = r4n, v4 = v4n, kd4 = kd4n, kk4 = kk4n, bb4 = bb4n;
        float lw[8], Lin[8];
#pragma unroll
        for (int q = 0; q < 4; ++q) { lw[2 * q] = bflo(lw4[q]); lw[2 * q + 1] = bfhi(lw4[q]); }
#pragma unroll
        for (int j = 0; j < 8; ++j) { float x = lw[j];
#pragma unroll
            for (int o = 8; o < 64; o <<= 1) { const float y = __shfl_up(x, o); if (lane >= o) x += y; }
            Lin[j] = x; }
        __syncthreads();
        if (lane >= 56) {
#pragma unroll
            for (int j = 0; j < 8; ++j) LWs[64 + wave * 64 + i0 + j] = Lin[j]; }
        __syncthreads();
        {
            float off[8];
#pragma unroll
            for (int j = 0; j < 8; ++j) off[j] = 0.f;
            for (int w = 0; w < 8; ++w) { if (w < wave) {
#pragma unroll
                for (int j = 0; j < 8; ++j) off[j] += LWs[64 + w * 64 + i0 + j]; } }
#pragma unroll
            for (int j = 0; j < 8; ++j) Lin[j] += off[j];
            if (t == 63) {
#pragma unroll
                for (int j = 0; j < 8; ++j) LWs[i0 + j] = Lin[j]; }
            float at_[8], rt_[8], bt_[8], kt_[8];
#pragma unroll
            for (int q = 0; q < 4; ++q) {
#pragma unroll
                for (int e = 0; e < 2; ++e) { const int j = 2 * q + e;
                    const float ein = __expf(Lin[j]), einv = __expf(-Lin[j]), eex = __expf(Lin[j] - lw[j]);
                    const float kkv = e ? bfhi(kk4[q]) : bflo(kk4[q]), rv_ = e ? bfhi(r4[q]) : bflo(r4[q]), bbv = e ? bfhi(bb4[q]) : bflo(bb4[q]), kdv = e ? bfhi(kd4[q]) : bflo(kd4[q]);
                    at_[j] = -kkv * eex; rt_[j] = rv_ * ein; bt_[j] = bbv * einv; kt_[j] = kdv * einv; }
            }
            v4u wa, wb, wk, w;
            wa.x = pk2(at_[0], at_[1]); wa.y = pk2(at_[2], at_[3]); wa.z = pk2(at_[4], at_[5]); wa.w = pk2(at_[6], at_[7]); *(LAS v4u*)(SL(0) + t * MROW + i0 * 2) = wa;
            w.x = pk2(rt_[0], rt_[1]); w.y = pk2(rt_[2], rt_[3]); w.z = pk2(rt_[4], rt_[5]); w.w = pk2(rt_[6], rt_[7]); *(LAS v4u*)(SL(2) + t * MROW + i0 * 2) = w;
            wb.x = pk2(bt_[0], bt_[1]); wb.y = pk2(bt_[2], bt_[3]); wb.z = pk2(bt_[4], bt_[5]); wb.w = pk2(bt_[6], bt_[7]); *(LAS v4u*)(SL(3) + t * MROW + i0 * 2) = wb;
            wk.x = pk2(kt_[0], kt_[1]); wk.y = pk2(kt_[2], kt_[3]); wk.z = pk2(kt_[4], kt_[5]); wk.w = pk2(kt_[6], kt_[7]); *(LAS v4u*)(SL(5) + t * MROW + i0 * 2) = wk;
#pragma unroll
            for (int q = 0; q < 4; ++q) {
                LAS unsigned char* pT = (LAS unsigned char*)0 + (i0 + 2 * q) * MROW + t * 2;
                *(LAS unsigned short*)(SL(1) + (size_t)pT) = (unsigned short)(wa[q] & 0xffffu); *(LAS unsigned short*)(SL(1) + (size_t)pT + MROW) = (unsigned short)(wa[q] >> 16);
                *(LAS unsigned short*)(SL(4) + (size_t)pT) = (unsigned short)(wb[q] & 0xffffu); *(LAS unsigned short*)(SL(4) + (size_t)pT + MROW) = (unsigned short)(wb[q] >> 16);
                *(LAS unsigned short*)(SL(6) + (size_t)pT) = (unsigned short)(wk[q] & 0xffffu); *(LAS unsigned short*)(SL(6) + (size_t)pT + MROW) = (unsigned short)(wk[q] >> 16);
                *(LAS unsigned short*)(SL(7) + (size_t)pT) = (unsigned short)(v4[q] & 0xffffu); *(LAS unsigned short*)(SL(7) + (size_t)pT + MROW) = (unsigned short)(v4[q] >> 16);
            }
        }
        if (item + (int)gridDim.x < 4096) R1_LOAD(item + (int)gridDim.x);
        __syncthreads();
        f32x4 Tacc[2];
        {
            bf16x8 la[2], lr[2];
#pragma unroll
            for (int ks = 0; ks < 2; ++ks) { la[ks] = frag_rm(SL(0), m0, 32 * ks, fr, fq); lr[ks] = frag_rm(SL(2), m0, 32 * ks, fr, fq); }
#pragma unroll
            for (int q = 0; q < 2; ++q) {
                const int n0 = (tn0 + q) * 16;
                f32x4 cab = {0.f, 0.f, 0.f, 0.f}, cak = cab, crb = cab, crk = cab;
#pragma unroll
                for (int ks = 0; ks < 2; ++ks) {
                    const bf16x8 rb_ = frag_rm(SL(3), n0, 32 * ks, fr, fq), rk_ = frag_rm(SL(5), n0, 32 * ks, fr, fq);
                    MMA16(cab, la[ks], rb_); MMA16(cak, la[ks], rk_); MMA16(crb, lr[ks], rb_); MMA16(crk, lr[ks], rk_);
                }
                const int tt = m0 + fr;
#pragma unroll
                for (int j = 0; j < 4; ++j) { const int ss = n0 + 4 * fq + j;
                    if (!(ss < tt)) { cab[j] = 0.f; cak[j] = 0.f; }
                    if (!(ss <= tt)) { crb[j] = 0.f; crk[j] = 0.f; } }
                tile_store_bf16(SL(8), m0, n0, fr, fq, cab); tile_store_bf16_T(SL(9), m0, n0, fr, fq, cab);
                tile_store_bf16(SL(10), m0, n0, fr, fq, cak);
                tile_store_bf16(SL(11), m0, n0, fr, fq, crb); tile_store_bf16(SL(12), m0, n0, fr, fq, crk);
#pragma unroll
                for (int j = 0; j < 4; ++j) cab[j] += ((n0 + 4 * fq + j) == tt) ? 1.f : 0.f;
                Tacc[q] = cab;
                tile_store_bf16(SL(13), m0, n0, fr, fq, cab);
            }
        }
        __syncthreads();
        {
            bf16x8 lk[2], ln_[2];
#pragma unroll
            for (int ks = 0; ks < 2; ++ks) { lk[ks] = frag_rm(SL(10), m0, 32 * ks, fr, fq); ln_[ks] = frag_rm(SL(8), m0, 32 * ks, fr, fq); }
#pragma unroll
            for (int q = 0; q < 2; ++q) {
                const int n0 = (tn0 + q) * 16;
                f32x4 cw = {0.f, 0.f, 0.f, 0.f}, cn = cw;
#pragma unroll
                for (int ks = 0; ks < 2; ++ks) { MMA16(cw, lk[ks], frag_rm(SL(7), n0, 32 * ks, fr, fq)); MMA16(cn, ln_[ks], frag_rm(SL(9), n0, 32 * ks, fr, fq)); }
                tile_store_bf16_T(SL(0), m0, n0, fr, fq, cw);
                tile_store_bf16(SL(3), m0, n0, fr, fq, cn); tile_store_bf16_T(SL(5), m0, n0, fr, fq, cn);
            }
        }
        __syncthreads();
#pragma unroll
        for (int k = 1; k <= 5; ++k) {
            LAS unsigned char* Nk = (k & 1) ? SL(3) : SL(8); LAS unsigned char* NkT = (k & 1) ? SL(5) : SL(9);
            LAS unsigned char* Nn = (k & 1) ? SL(8) : SL(3); LAS unsigned char* NnT = (k & 1) ? SL(9) : SL(5);
            LAS unsigned char* Tk = (k & 1) ? SL(13) : SL(10); LAS unsigned char* Tn = (k & 1) ? SL(10) : SL(13);
            bf16x8 lt[2], ln_[2];
#pragma unroll
            for (int ks = 0; ks < 2; ++ks) { lt[ks] = frag_rm(Tk, m0, 32 * ks, fr, fq); ln_[ks] = frag_rm(Nk, m0, 32 * ks, fr, fq); }
#pragma unroll
            for (int q = 0; q < 2; ++q) {
                const int n0 = (tn0 + q) * 16;
                f32x4 cn = {0.f, 0.f, 0.f, 0.f};
#pragma unroll
                for (int ks = 0; ks < 2; ++ks) { const bf16x8 rn = frag_rm(NkT, n0, 32 * ks, fr, fq); MMA16(Tacc[q], lt[ks], rn); if (k < 5) MMA16(cn, ln_[ks], rn); }
                tile_store_bf16(Tn, m0, n0, fr, fq, Tacc[q]);
                if (k < 5) { tile_store_bf16(Nn, m0, n0, fr, fq, cn); tile_store_bf16_T(NnT, m0, n0, fr, fq, cn); }
            }
            __syncthreads();
        }
        {
            bf16x8 lt[2];
#pragma unroll
            for (int ks = 0; ks < 2; ++ks) lt[ks] = frag_rm(SL(10), m0, 32 * ks, fr, fq);
#pragma unroll
            for (int q = 0; q < 2; ++q) {
                const int n0 = (tn0 + q) * 16;
                f32x4 ca = {0.f, 0.f, 0.f, 0.f}, cu = ca;
#pragma unroll
                for (int ks = 0; ks < 2; ++ks) { MMA16(ca, lt[ks], frag_rm(SL(1), n0, 32 * ks, fr, fq)); MMA16(cu, lt[ks], frag_rm(SL(0), n0, 32 * ks, fr, fq)); }
                tile_store_bf16_T(SL(8), m0, n0, fr, fq, ca); tile_store_bf16_T(SL(9), m0, n0, fr, fq, cu);
            }
        }
        __syncthreads();
        {
            bf16x8 lrb[2], lrk[2], lb[2], lkt[2];
#pragma unroll
            for (int ks = 0; ks < 2; ++ks) { lrb[ks] = frag_rm(SL(11), m0, 32 * ks, fr, fq); lrk[ks] = frag_rm(SL(12), m0, 32 * ks, fr, fq);
                lb[ks] = frag_rm(SL(4), m0, 32 * ks, fr, fq); lkt[ks] = frag_rm(SL(6), m0, 32 * ks, fr, fq); }
            const float wc = __expf(LWs[m0 + fr]);
#pragma unroll
            for (int q = 0; q < 2; ++q) {
                const int n0 = (tn0 + q) * 16;
                f32x4 crh = {0.f, 0.f, 0.f, 0.f}, cyl = crh, cp = crh, cq = crh;
#pragma unroll
                for (int ks = 0; ks < 2; ++ks) {
                    const bf16x8 ra = frag_rm(SL(8), n0, 32 * ks, fr, fq), ru = frag_rm(SL(9), n0, 32 * ks, fr, fq), rv = frag_rm(SL(7), n0, 32 * ks, fr, fq);
                    MMA16(crh, lrb[ks], ra); MMA16(cyl, lrb[ks], ru); MMA16(cyl, lrk[ks], rv);
                    MMA16(cp, lb[ks], ra); MMA16(cq, lb[ks], ru); MMA16(cq, lkt[ks], rv);
                }
                const size_t o = (size_t)item * 4096 + (size_t)(m0 + fr) * 64 + n0 + 4 * fq;
                { const LAS unsigned short* rp = (const LAS unsigned short*)(SL(2) + (m0 + fr) * MROW + (n0 + 4 * fq) * 2);
#pragma unroll
                  for (int j = 0; j < 4; ++j) crh[j] += __uint_as_float(((unsigned)rp[j]) << 16); }
                { v2u w; w.x = pk2(crh[0], crh[1]); w.y = pk2(crh[2], crh[3]); *(v2u*)(RH + o) = w; }
                { v2u w; w.x = pk2(cyl[0], cyl[1]); w.y = pk2(cyl[2], cyl[3]); *(v2u*)(YL + o) = w; }
#pragma unroll
                for (int j = 0; j < 4; ++j) { cp[j] = wc * (cp[j] + (((n0 + 4 * fq + j) == (m0 + fr)) ? 1.f : 0.f)); cq[j] *= wc; }
                { v2u w; w.x = pk2(cp[0], cp[1]); w.y = pk2(cp[2], cp[3]); *(v2u*)(PT + o) = w; }
                { v2u w; w.x = pk2(cq[0], cq[1]); w.y = pk2(cq[2], cq[3]); *(v2u*)(QT + o) = w; }
            }
        }
    }
#undef SL
}
#undef R1_LOAD

__device__ __forceinline__ bf16x8 pack_acc8(const f32x16& x, int s) {
    v4u p; p.x = pk2(x[8 * s], x[8 * s + 1]); p.y = pk2(x[8 * s + 2], x[8 * s + 3]); p.z = pk2(x[8 * s + 4], x[8 * s + 5]); p.w = pk2(x[8 * s + 6], x[8 * s + 7]);
    return __builtin_bit_cast(bf16x8, p);
}
__device__ __forceinline__ void scan_r2(const bf16_t* PT, const bf16_t* QT, bf16_t* S0, unsigned char* lds_raw) {
    LAS unsigned char* L = (LAS unsigned char*)lds_raw;
    constexpr int SLOT_B = MBUF + 8192;
    const int tid = tidx(), lane = tid & 63, wave = tid >> 6;
    const int r = lane & 31, h2 = lane >> 5, jb = wave;
    f32x16 st[2];
#pragma unroll
    for (int ib = 0; ib < 2; ++ib)
#pragma unroll
        for (int g = 0; g < 16; ++g) st[ib][g] = 0.f;
    const size_t item0 = (size_t)blockIdx.x * 128;
    v4u stage[16];
#pragma unroll
    for (int q = 0; q < 16; ++q) { const int p = tid + 512 * q, cc = p >> 10, w = p & 1023, mat = w >> 9, idx = w & 511;
        stage[q] = *(const v4u*)((mat ? QT : PT) + (item0 + cc) * 4096 + idx * 8); }
    for (int grp = 0; grp < 16; ++grp) {
        __syncthreads();
#pragma unroll
        for (int q = 0; q < 16; ++q) { const int p = tid + 512 * q, cc = p >> 10, w = p & 1023, mat = w >> 9, idx = w & 511;
            *(LAS v4u*)(L + cc * SLOT_B + (mat ? (MBUF + idx * 16) : ((idx >> 3) * MROW + (idx & 7) * 16))) = stage[q]; }
        __syncthreads();
        if (grp < 15) {
#pragma unroll
            for (int q = 0; q < 16; ++q) { const int p = tid + 512 * q, cc = p >> 10, w = p & 1023, mat = w >> 9, idx = w & 511;
                stage[q] = *(const v4u*)((mat ? QT : PT) + (item0 + (grp + 1) * 8 + cc) * 4096 + idx * 8); }
        }
        if (wave < 2) {
#pragma unroll 1
            for (int cc = 0; cc < 8; ++cc) {
                const size_t item = item0 + grp * 8 + cc;
                const LAS unsigned char* Pm = L + cc * SLOT_B; const LAS unsigned char* Qm = Pm + MBUF;
                bf16_t* sp = S0 + item * 4096 + (size_t)(32 * jb + r) * 64;
#pragma unroll
                for (int ib = 0; ib < 2; ++ib)
#pragma unroll
                    for (int g = 0; g < 4; ++g) { v2u w; w.x = pk2(st[ib][4 * g], st[ib][4 * g + 1]); w.y = pk2(st[ib][4 * g + 2], st[ib][4 * g + 3]); *(v2u*)(sp + 32 * ib + 8 * g + 4 * h2) = w; }
                f32x16 nw[2];
#pragma unroll
                for (int ib = 0; ib < 2; ++ib)
#pragma unroll
                    for (int g = 0; g < 16; ++g) nw[ib][g] = __uint_as_float(((unsigned)*(const LAS unsigned short*)(Qm + (32 * ib + (g & 3) + 8 * (g >> 2) + 4 * h2) * 128 + (32 * jb + r) * 2)) << 16);
#pragma unroll
                for (int kb = 0; kb < 2; ++kb)
#pragma unroll
                    for (int s2 = 0; s2 < 2; ++s2) {
                        const bf16x8 bfr = pack_acc8(st[kb], s2);
#pragma unroll
                        for (int ib = 0; ib < 2; ++ib) {
                            const LAS unsigned char* ap = Pm + (32 * ib + r) * MROW + (32 * kb + 16 * s2 + 4 * h2) * 2;
                            const v2u lo = *(const LAS v2u*)ap, hi = *(const LAS v2u*)(ap + 16);
                            v4u av; av.x = lo.x; av.y = lo.y; av.z = hi.x; av.w = hi.y;
                            nw[ib] = __builtin_amdgcn_mfma_f32_32x32x16_bf16(__builtin_bit_cast(bf16x8, av), bfr, nw[ib], 0, 0, 0);
                        }
                    }
                st[0] = nw[0]; st[1] = nw[1];
            }
        }
    }
}
__device__ __forceinline__ void scan_r3(const bf16_t* RH, const bf16_t* YL, const bf16_t* S0, const bf16_t* RVg, const bf16_t* KDg, const bf16_t* Gg,
                                        const float* r_k, const float* lng, const float* lnb, bf16_t* Y) {
    const int tid = tidx(), lane = tid & 63, wave = tid >> 6, fr = lane & 15, fq = lane >> 4;
    const int tmw = wave & 3;
    for (int it2 = blockIdx.x * 2 + (wave >> 2); it2 < 2048; it2 += gridDim.x * 2) {
        const int b = it2 >> 10, h = (it2 >> 7) & 7, pc = it2 & 127;
        f32x4 acc[4];
#pragma unroll
        for (int q = 0; q < 4; ++q) acc[q] = (f32x4){0.f, 0.f, 0.f, 0.f};
#pragma unroll 1
        for (int dirn = 0; dirn < 2; ++dirn) {
            const size_t item = (size_t)((dirn * 2 + b) * 8 + h) * 128 + (dirn ? 127 - pc : pc);
            const int row = dirn ? 63 - (16 * tmw + fr) : 16 * tmw + fr;
            const bf16_t* rp = RH + item * 4096 + (size_t)row * 64;
            bf16x8 lf[2];
#pragma unroll
            for (int ks = 0; ks < 2; ++ks) lf[ks] = *(const bf16x8*)(rp + 32 * ks + 8 * fq);
#pragma unroll
            for (int q = 0; q < 4; ++q) {
                const bf16_t* sp = S0 + item * 4096 + (size_t)(16 * q + fr) * 64;
#pragma unroll
                for (int ks = 0; ks < 2; ++ks) { const bf16x8 rf = *(const bf16x8*)(sp + 32 * ks + 8 * fq); MMA16(acc[q], lf[ks], rf); }
                { const v2u yw = *(const v2u*)(YL + item * 4096 + (size_t)row * 64 + 16 * q + 4 * fq); acc[q] += (f32x4){bflo(yw.x), bfhi(yw.x), bflo(yw.y), bfhi(yw.y)}; }
            }
        }
        float sm = 0.f;
#pragma unroll
        for (int q = 0; q < 4; ++q) sm += (acc[q][0] + acc[q][1]) + (acc[q][2] + acc[q][3]);
        sm += __shfl_xor(sm, 16); sm += __shfl_xor(sm, 32);
        const float mean = sm * (1.0f / 64.f);
        float sq = 0.f;
#pragma unroll
        for (int q = 0; q < 4; ++q)
#pragma unroll
            for (int j = 0; j < 4; ++j) { const float d = acc[q][j] - mean; sq += d * d; }
        sq += __shfl_xor(sq, 16); sq += __shfl_xor(sq, 32);
        const float rstd = rsqrtf(sq * (1.0f / 64.f) + 64e-5f);
        const size_t tok = (size_t)b * S + pc * 64 + 16 * tmw + fr;
        float bon = 0.f; f32x4 vv[4];
#pragma unroll
        for (int q = 0; q < 4; ++q) {
            const int c = h * 64 + 16 * q + 4 * fq;
            const v2u rw = *(const v2u*)(RVg + tok * D + c), k0 = *(const v2u*)(KDg + tok * 512 + c), k1 = *(const v2u*)(KDg + ((size_t)T + tok) * 512 + c), vw = *(const v2u*)(RVg + tok * D + 512 + c);
            const f32x4 rk4 = *(const f32x4*)(r_k + c);
            vv[q] = (f32x4){bflo(vw.x), bfhi(vw.x), bflo(vw.y), bfhi(vw.y)};
            bon += bflo(rw.x) * (bflo(k0.x) + bflo(k1.x)) * rk4[0] + bfhi(rw.x) * (bfhi(k0.x) + bfhi(k1.x)) * rk4[1] + bflo(rw.y) * (bflo(k0.y) + bflo(k1.y)) * rk4[2] + bfhi(rw.y) * (bfhi(k0.y) + bfhi(k1.y)) * rk4[3];
        }
        bon += __shfl_xor(bon, 16); bon += __shfl_xor(bon, 32);
#pragma unroll
        for (int q = 0; q < 4; ++q) {
            const int c = h * 64 + 16 * q + 4 * fq;
            const v2u gw_ = *(const v2u*)(Gg + tok * 512 + c); const f32x4 g4 = {bflo(gw_.x), bfhi(gw_.x), bflo(gw_.y), bfhi(gw_.y)}, lg = *(const f32x4*)(lng + c), lb = *(const f32x4*)(lnb + c);
            float o[4];
#pragma unroll
            for (int j = 0; j < 4; ++j) o[j] = ((acc[q][j] - mean) * rstd * lg[j] + lb[j] + bon * vv[q][j]) * g4[j];
            v2u w; w.x = pk2(o[0], o[1]); w.y = pk2(o[2], o[3]);
            *(v2u*)(Y + tok * D + 512 + c) = w;
        }
    }
}


__device__ __forceinline__ bf16x8 pack8(float a0, float a1, float a2, float a3, float a4, float a5, float a6, float a7) {
    v4u p; p.x = pk2(a0, a1); p.y = pk2(a2, a3); p.z = pk2(a4, a5); p.w = pk2(a6, a7);
    return __builtin_bit_cast(bf16x8, p);
}
#define MMA32(acc, af, bf_) acc = __builtin_amdgcn_mfma_f32_32x32x16_bf16(af, bf_, acc, 0, 0, 0)
__device__ __forceinline__ void xattn_mfma(const bf16_t* Qb, const bf16_t* Kb, const bf16_t* Vt, bf16_t* Y, unsigned char* lds_raw) {
    LAS unsigned char* L = (LAS unsigned char*)lds_raw;
    constexpr int KRS = 528, VRS = 520;
    const int tid = tidx(), lane = tid & 63, wave = tid >> 6, r = lane & 31, h2 = lane >> 5;
    for (int it = blockIdx.x; it < 256; it += gridDim.x) {
        const int qblk = it & 31, h = (it >> 5) & 3, b = it >> 7;
        const size_t tok = (size_t)b * S + qblk * 256 + wave * 32 + r;
        bf16x8 qf[16];
#pragma unroll
        for (int ks = 0; ks < 16; ++ks) qf[ks] = *(const bf16x8*)(Qb + tok * D + h * 256 + 16 * ks + 8 * h2);
        __syncthreads();
#pragma unroll
        for (int hf = 0; hf < 2; ++hf) {
            v4u stg[8];
#pragma unroll
            for (int q = 0; q < 8; ++q) { const int p = tid + 512 * (8 * hf + q); stg[q] = *(const v4u*)(Kb + (size_t)(b * MEM + (p >> 5)) * 1024 + h * 256 + (p & 31) * 8); }
#pragma unroll
            for (int q = 0; q < 8; ++q) { const int p = tid + 512 * (8 * hf + q); *(LAS v4u*)(L + (p >> 5) * KRS + (p & 31) * 16) = stg[q]; }
        }
        __syncthreads();
        float mx = -3.0e38f;
#pragma unroll 1
        for (int kb = 0; kb < 8; ++kb) {
            f32x16 st;
#pragma unroll
            for (int g = 0; g < 16; ++g) st[g] = 0.f;
            const LAS unsigned char* kp = L + (32 * kb + r) * KRS + 16 * h2;
#pragma unroll
            for (int ks = 0; ks < 16; ++ks) { const bf16x8 kf = *(const LAS bf16x8*)(kp + 32 * ks); MMA32(st, kf, qf[ks]); }
#pragma unroll
            for (int g = 0; g < 16; ++g) mx = fmaxf(mx, st[g]);
        }
        mx = fmaxf(mx, __shfl_xor(mx, 32));
        const float cs = 0.0625f * 1.4426950408889634f;
        float l = 0.f;
        bf16x8 pf[8][2];
#pragma unroll
        for (int kb = 0; kb < 8; ++kb) {
            f32x16 st;
#pragma unroll
            for (int g = 0; g < 16; ++g) st[g] = 0.f;
            const LAS unsigned char* kp = L + (32 * kb + r) * KRS + 16 * h2;
#pragma unroll
            for (int ks = 0; ks < 16; ++ks) { const bf16x8 kf = *(const LAS bf16x8*)(kp + 32 * ks); MMA32(st, kf, qf[ks]); }
#pragma unroll
            for (int g = 0; g < 16; ++g) { st[g] = __builtin_amdgcn_exp2f((st[g] - mx) * cs); l += st[g]; }
#pragma unroll
            for (int s2 = 0; s2 < 2; ++s2) pf[kb][s2] = pack8(st[8 * s2], st[8 * s2 + 1], st[8 * s2 + 2], st[8 * s2 + 3], st[8 * s2 + 4], st[8 * s2 + 5], st[8 * s2 + 6], st[8 * s2 + 7]);
            __builtin_amdgcn_sched_barrier(0);
        }
        l += __shfl_xor(l, 32);
        const float inv = 1.0f / l;
        __syncthreads();
#pragma unroll
        for (int hf = 0; hf < 2; ++hf) {
            v4u stg[8];
#pragma unroll
            for (int q = 0; q < 8; ++q) { const int p = tid + 512 * (8 * hf + q); stg[q] = *(const v4u*)(Vt + ((size_t)(b * 1024 + h * 256 + (p >> 5))) * 256 + (p & 31) * 8); }
#pragma unroll
            for (int q = 0; q < 8; ++q) { const int p = tid + 512 * (8 * hf + q); LAS v2u* lp = (LAS v2u*)(L + (p >> 5) * VRS + (p & 31) * 16);
                v2u a_; a_.x = stg[q].x; a_.y = stg[q].y; lp[0] = a_; a_.x = stg[q].z; a_.y = stg[q].w; lp[1] = a_; }
        }
        __syncthreads();
#pragma unroll 1
        for (int db = 0; db < 8; ++db) {
            f32x16 acc;
#pragma unroll
            for (int g = 0; g < 16; ++g) acc[g] = 0.f;
            const LAS unsigned char* vp = L + (32 * db + r) * VRS + 8 * h2;
#pragma unroll
            for (int kb = 0; kb < 8; ++kb)
#pragma unroll
                for (int s2 = 0; s2 < 2; ++s2) {
                    const v2u lo = *(const LAS v2u*)(vp + (32 * kb + 16 * s2) * 2), hi = *(const LAS v2u*)(vp + (32 * kb + 16 * s2 + 8) * 2);
                    v4u av; av.x = lo.x; av.y = lo.y; av.z = hi.x; av.w = hi.y;
                    MMA32(acc, __builtin_bit_cast(bf16x8, av), pf[kb][s2]);
                }
            int tl_ = tid; asm volatile("" : "+v"(tl_));
            bf16_t* yp = Y + ((size_t)b * S + qblk * 256 + (tl_ >> 6) * 32 + (tl_ & 31)) * D + h * 256 + 32 * db + 4 * ((tl_ >> 5) & 1);
#pragma unroll
            for (int g = 0; g < 4; ++g) { v2u w; w.x = pk2(acc[4 * g] * inv, acc[4 * g + 1] * inv); w.y = pk2(acc[4 * g + 2] * inv, acc[4 * g + 3] * inv); *(v2u*)(yp + 8 * g) = w; }
        }
    }
}
template <bool F32OUT>
__device__ __forceinline__ void combine_norm(float* X, const bf16_t* YE, const int* SLOT, const float* g, bf16_t* Hout, float* Fout) {
    const int tix_ = tidx(); const int lane = tix_ & 63, gw = blockIdx.x * 8 + (tix_ >> 6), ngw = gridDim.x * 8;
    float4 gc[4];
#pragma unroll
    for (int j = 0; j < 4; ++j) gc[j] = ((const float4*)g)[lane + 64 * j];
    for (int m = gw; m < T; m += ngw) {
        float4* xr = (float4*)(X + (size_t)m * D);
        float4 v[4];
#pragma unroll
        for (int j = 0; j < 4; ++j) v[j] = xr[lane + 64 * j];
        const int myslot = SLOT[(size_t)m * NE + (lane & 15)];
#pragma unroll
        for (int e = 0; e < 16; ++e) {
            const int row = __builtin_amdgcn_readlane(myslot, e);
            if (row >= 0) {
                const v2u* yp = (const v2u*)(YE + (size_t)row * D);
#pragma unroll
                for (int j = 0; j < 4; ++j) { const v2u w = yp[lane + 64 * j];
                    v[j].x += __uint_as_float(w.x << 16); v[j].y += __uint_as_float(w.x & 0xffff0000u); v[j].z += __uint_as_float(w.y << 16); v[j].w += __uint_as_float(w.y & 0xffff0000u); }
            }
        }
        float s = 0.f;
#pragma unroll
        for (int j = 0; j < 4; ++j) { if (!F32OUT) xr[lane + 64 * j] = v[j]; s += v[j].x * v[j].x + v[j].y * v[j].y + v[j].z * v[j].z + v[j].w * v[j].w; }
        const float r = rsqrtf(wave_sum(s) * (1.0f / D) + 1e-6f);
#pragma unroll
        for (int j = 0; j < 4; ++j) { const float4 gg = gc[j];
            if (F32OUT) ((float4*)(Fout + (size_t)m * D))[lane + 64 * j] = make_float4(v[j].x * r * gg.x, v[j].y * r * gg.y, v[j].z * r * gg.z, v[j].w * r * gg.w);
            else { v2u w; w.x = pk2(v[j].x * r * gg.x, v[j].y * r * gg.y); w.y = pk2(v[j].z * r * gg.z, v[j].w * r * gg.w); ((v2u*)(Hout + (size_t)m * D))[lane + 64 * j] = w; } }
    }
}


template <int NK, bool SINK>
__device__ __forceinline__ void attn_block(const bf16_t* Qh, const bf16_t* Kh, const bf16_t* Vh, int dd, int Lr, int b, int rho, int q0b, float sink2,
                                           bf16_t* Odst, int ostride, float* lsedst, unsigned char* lds_raw) {
    constexpr int NKEY = 256 + 64 * NK, KRS = 144, VRS = NKEY * 2 + 8;
    LAS unsigned char* Ks = (LAS unsigned char*)lds_raw; LAS unsigned char* Vs = Ks + NKEY * KRS;
    const int tid = tidx(), lane = tid & 63, wave = tid >> 6, r = lane & 31, h2 = lane >> 5;
    const int kq_base = q0b - 32 * NK;
    __syncthreads();
#pragma unroll
    for (int i = 0; i < NKEY * 8 / 512; ++i) {
        const int p = tid + 512 * i, row = p >> 3, piece = p & 7, kq = kq_base + row;
        if (kq >= 0 && kq < Lr) {
            const size_t tokk = (size_t)b * S + (size_t)kq * dd + rho;
            const v4u kx = *(const v4u*)(Kh + tokk * 64 + piece * 8), vx = *(const v4u*)(Vh + tokk * 64 + piece * 8);
            *(LAS v4u*)(Ks + row * KRS + piece * 16) = kx;
            LAS unsigned char* vp = Vs + (piece * 8) * VRS + row * 2;
#pragma unroll
            for (int e = 0; e < 4; ++e) { *(LAS unsigned short*)(vp + (2 * e) * VRS) = (unsigned short)(vx[e] & 0xffffu); *(LAS unsigned short*)(vp + (2 * e + 1) * VRS) = (unsigned short)(vx[e] >> 16); }
        }
    }
    const int q0 = q0b + 32 * wave;
    const size_t qtok = (size_t)b * S + (size_t)(q0 + r) * dd + rho;
    bf16x8 qf[4];
#pragma unroll
    for (int ks = 0; ks < 4; ++ks) qf[ks] = *(const bf16x8*)(Qh + qtok * 64 + 16 * ks + 8 * h2);
    __syncthreads();
    f32x16 o[2];
#pragma unroll
    for (int db = 0; db < 2; ++db)
#pragma unroll
        for (int g = 0; g < 16; ++g) o[db][g] = 0.f;
    float m = SINK ? sink2 : -1.0e30f, l = SINK ? 1.f : 0.f;
    const int kb_lo = max(-NK, -(q0 >> 5)), kb_hi = min(NK, (Lr - 32 - q0) >> 5);
#pragma unroll 1
    for (int kb = kb_lo; kb <= kb_hi; ++kb) {
        const int kw0 = 32 * (wave + kb + NK);
        f32x16 st;
#pragma unroll
        for (int g = 0; g < 16; ++g) st[g] = 0.f;
        const LAS unsigned char* kp = Ks + (kw0 + r) * KRS + 16 * h2;
#pragma unroll
        for (int ks = 0; ks < 4; ++ks) { const bf16x8 kf = *(const LAS bf16x8*)(kp + 32 * ks); MMA32(st, kf, qf[ks]); }
        if (kb == -NK || kb == NK) {
#pragma unroll
            for (int g = 0; g < 16; ++g) { const int cr = (g & 3) + 8 * (g >> 2) + 4 * h2; const bool ok = (kb < 0) ? (cr >= r) : (cr <= r); st[g] = ok ? st[g] : -1.0e30f; }
        }
        float bm = st[0];
#pragma unroll
        for (int g = 1; g < 16; ++g) bm = fmaxf(bm, st[g]);
        bm = fmaxf(bm, __shfl_xor(bm, 32));
        const float mn = fmaxf(m, bm), al = __builtin_amdgcn_exp2f(m - mn);
        float ls = 0.f;
#pragma unroll
        for (int g = 0; g < 16; ++g) { st[g] = __builtin_amdgcn_exp2f(st[g] - mn); ls += st[g]; }
        ls += __shfl_xor(ls, 32);
        l = l * al + ls; m = mn;
#pragma unroll
        for (int db = 0; db < 2; ++db)
#pragma unroll
            for (int g = 0; g < 16; ++g) o[db][g] *= al;
        bf16x8 pf[2];
#pragma unroll
        for (int s2 = 0; s2 < 2; ++s2) pf[s2] = pack8(st[8 * s2], st[8 * s2 + 1], st[8 * s2 + 2], st[8 * s2 + 3], st[8 * s2 + 4], st[8 * s2 + 5], st[8 * s2 + 6], st[8 * s2 + 7]);
#pragma unroll
        for (int db = 0; db < 2; ++db) {
            const LAS unsigned char* vp = Vs + (32 * db + r) * VRS + (kw0 + 4 * h2) * 2;
#pragma unroll
            for (int s2 = 0; s2 < 2; ++s2) {
                const v2u lo = *(const LAS v2u*)(vp + 32 * s2), hi = *(const LAS v2u*)(vp + 32 * s2 + 16);
                v4u av; av.x = lo.x; av.y = lo.y; av.z = hi.x; av.w = hi.y;
                MMA32(o[db], __builtin_bit_cast(bf16x8, av), pf[s2]);
            }
        }
    }
    const float inv = 1.0f / l;
#pragma unroll
    for (int db = 0; db < 2; ++db) {
        bf16_t* op = Odst + qtok * ostride + 32 * db + 4 * h2;
#pragma unroll
        for (int g = 0; g < 4; ++g) { v2u w; w.x = pk2(o[db][4 * g] * inv, o[db][4 * g + 1] * inv); w.y = pk2(o[db][4 * g + 2] * inv, o[db][4 * g + 3] * inv); *(v2u*)(op + 8 * g) = w; }
    }
    if (lsedst != nullptr && h2 == 0) lsedst[qtok * 8] = (m + __builtin_amdgcn_logf(l)) * 0.6931471805599453f;
}

__device__ __forceinline__ void attn_phase_even(const bf16_t* QhA, const bf16_t* KhA, const bf16_t* VhA, const bf16_t* QhB, const bf16_t* KhB, const bf16_t* VhB,
                                                const float* sink, bf16_t* OA, float* LSE, bf16_t* Y, unsigned char* lds_raw) {
    for (int it = blockIdx.x; it < 2048; it += gridDim.x) {
        if (it < 512) {
            const int hq = it >> 6, rem2 = it & 63, b = rem2 >> 5, q0b = (rem2 & 31) * 256, kvh = hq >> 2;
            attn_block<4, true>(QhB + (size_t)hq * T * 64, KhB + (size_t)kvh * T * 64, VhB + (size_t)kvh * T * 64, 1, S, b, 0, q0b, sink[hq] * 1.4426950408889634f,
                                Y + 512 + hq * 64, D, nullptr, lds_raw);
        } else {
            const int ita = it - 512, p = ita >> 9, rem = ita & 511, head = rem >> 6, rem2 = rem & 63, b = rem2 >> 5, rem3 = rem2 & 31;
            const int dd = p == 0 ? 1 : (p == 1 ? 4 : 16), bpr = 32 / dd, rho = rem3 / bpr, q0b = (rem3 % bpr) * 256;
            attn_block<2, false>(QhA + (size_t)head * T * 64, KhA + (size_t)head * T * 64, VhA + (size_t)head * T * 64, dd, S / dd, b, rho, q0b, 0.f,
                                 OA + (size_t)p * T * 512 + head * 64, 512, LSE + (size_t)p * T * 8 + head, lds_raw);
        }
    }
}
__device__ __forceinline__ void attn_combine(const bf16_t* OA, const float* LSE, bf16_t* Y) {
    const int gt = blockIdx.x * NTH + tidx(), ngt = gridDim.x * NTH;
    for (int i = gt; i < T * 64; i += ngt) {
        const int tok = i >> 6, head = (i >> 3) & 7, c8 = i & 7;
        const float l0 = LSE[(size_t)tok * 8 + head], l1 = LSE[((size_t)T + tok) * 8 + head], l2 = LSE[((size_t)2 * T + tok) * 8 + head];
        const float mx = fmaxf(l0, fmaxf(l1, l2));
        float w0 = __expf(l0 - mx), w1 = __expf(l1 - mx), w2 = __expf(l2 - mx);
        const float inv = 1.0f / (w0 + w1 + w2); w0 *= inv; w1 *= inv; w2 *= inv;
        const size_t off = (size_t)tok * 512 + head * 64 + c8 * 8;
        const v4u x0 = *(const v4u*)(OA + off), x1 = *(const v4u*)(OA + (size_t)T * 512 + off), x2 = *(const v4u*)(OA + (size_t)2 * T * 512 + off);
        v4u w;
#pragma unroll
        for (int q = 0; q < 4; ++q) {
            const float lo = w0 * __uint_as_float(x0[q] << 16) + w1 * __uint_as_float(x1[q] << 16) + w2 * __uint_as_float(x2[q] << 16);
            const float hi = w0 * __uint_as_float(x0[q] & 0xffff0000u) + w1 * __uint_as_float(x1[q] & 0xffff0000u) + w2 * __uint_as_float(x2[q] & 0xffff0000u);
            w[q] = pk2(lo, hi);
        }
        *(v4u*)(Y + (size_t)tok * D + head * 64 + c8 * 8) = w;
    }
}


__device__ __forceinline__ void odd_token_pass(const bf16_t* P, const float* mu, const float* k_k, const float* clg, const float* clb,
                                               bf16_t* VN, bf16_t* RV, bf16_t* KBf, bf16_t* KK, bf16_t* F5) {
    const int tix_ = tidx(); const int lane = tix_ & 63, gw = blockIdx.x * 8 + (tix_ >> 6), ngw = gridDim.x * 8;
    float2 m0c[15], m1c[15], kkc[4], lgc[4], lbc[4];
#pragma unroll
    for (int jj = 0; jj < 15; ++jj) { const int c = 2 * lane + 128 * jj; m0c[jj] = *(const float2*)(mu + c); m1c[jj] = *(const float2*)(mu + FD + c); }
#pragma unroll
    for (int jj = 0; jj < 4; ++jj) { const int c = 2 * lane + 128 * jj; kkc[jj] = *(const float2*)(k_k + c); lgc[jj] = *(const float2*)(clg + c); lbc[jj] = *(const float2*)(clb + c); }
    unsigned wcur[15], wnxt[15], wprv[15];
    for (int tok0 = gw * 8; tok0 < T; tok0 += ngw * 8)
    for (int ti = 0; ti < 8; ++ti) {
        const int tok = tok0 + ti;
        const int s = tok & (S - 1);
        const bf16_t* pr = P + (size_t)tok * ODD_PAD;
        if (ti == 0) {
#pragma unroll
            for (int jj = 0; jj < 15; ++jj) { const int c = 2 * lane + 128 * jj; wcur[jj] = *(const unsigned*)(pr + 1024 + c); wprv[jj] = s > 0 ? *(const unsigned*)(pr + 1024 + c - ODD_PAD) : 0u; }
        } else {
#pragma unroll
            for (int jj = 0; jj < 15; ++jj) { wprv[jj] = s > 0 ? wcur[jj] : 0u; wcur[jj] = wnxt[jj]; }
        }
#pragma unroll
        for (int jj = 0; jj < 15; ++jj) { const int c = 2 * lane + 128 * jj; wnxt[jj] = *(const unsigned*)(pr + 1024 + c + (tok + 1 < T ? ODD_PAD : 0)); }
        {
            float ge[8]; float sm = 0.f;
#pragma unroll
            for (int jj = 0; jj < 4; ++jj) { const unsigned w = *(const unsigned*)(pr + 512 + 2 * lane + 128 * jj);
                ge[2 * jj] = gelu_tanh(__uint_as_float(w << 16)); ge[2 * jj + 1] = gelu_tanh(__uint_as_float(w & 0xffff0000u)); sm += ge[2 * jj] + ge[2 * jj + 1]; }
            const float mean = wave_sum(sm) * (1.0f / 512.f); float sq = 0.f;
#pragma unroll
            for (int j = 0; j < 8; ++j) { const float d = ge[j] - mean; sq += d * d; }
            const float rstd = rsqrtf(wave_sum(sq) * (1.0f / 512.f) + 1e-5f);
#pragma unroll
            for (int jj = 0; jj < 4; ++jj) { const int c = 2 * lane + 128 * jj;
                *(unsigned*)(VN + (size_t)tok * 512 + c) = pk2((ge[2 * jj] - mean) * rstd * lgc[jj].x + lbc[jj].x, (ge[2 * jj + 1] - mean) * rstd * lgc[jj].y + lbc[jj].y); }
        }
#pragma unroll
        for (int jj = 0; jj < 15; ++jj) {
            const int c = 2 * lane + 128 * jj;
            const unsigned wf = wcur[jj];
            const unsigned wp = wprv[jj];
            const unsigned wn = s < S - 1 ? wnxt[jj] : 0u;
            const float2 m0 = m0c[jj], m1 = m1c[jj];
            const float f0 = __uint_as_float(wf << 16), f1 = __uint_as_float(wf & 0xffff0000u);
            const float x0 = f0 + m0.x * (__uint_as_float(wp << 16) - f0) + m1.x * (__uint_as_float(wn << 16) - f0);
            const float x1 = f1 + m0.y * (__uint_as_float(wp & 0xffff0000u) - f1) + m1.y * (__uint_as_float(wn & 0xffff0000u) - f1);
            if (jj < 4) *(unsigned*)(RV + (size_t)tok * D + c) = pk2(x0, x1);
            else if (jj < 8) {
                const int ck = c - 512;
                *(unsigned*)(KBf + (size_t)tok * 512 + ck) = pk2(x0, x1);
                const float2 kk_ = kkc[jj - 4];
                const float a0_ = x0 * kk_.x, a1_ = x1 * kk_.y;
                float ss = a0_ * a0_ + a1_ * a1_;
#pragma unroll
                for (int o = 16; o >= 1; o >>= 1) ss += __shfl_xor(ss, o);
                const float inv = 1.0f / fmaxf(sqrtf(ss), 1e-12f);
                *(unsigned*)(KK + (size_t)tok * 512 + ck) = pk2(a0_ * inv, a1_ * inv);
            }
            else if (jj < 12) *(unsigned*)(RV + (size_t)tok * D + 512 + (c - 1024)) = pk2(x0, x1);
            else if (jj == 12) *(unsigned*)(F5 + (size_t)tok * 384 + (c - 1536)) = pk2(tanhf_(x0), tanhf_(x1));
            else if (jj == 13) *(unsigned*)(F5 + (size_t)tok * 384 + 128 + (c - 1664)) = pk2(x0, x1);
            else *(unsigned*)(F5 + (size_t)tok * 384 + 256 + (c - 1792)) = pk2(sigmoidf_(x0), sigmoidf_(x1));
        }
    }
}
__device__ __forceinline__ void gating_pass(const bf16_t* VN, const bf16_t* Wsb, const float* bsp, const bf16_t* P, bf16_t* Y, unsigned char* lds_raw) {
    LAS unsigned char* L = (LAS unsigned char*)lds_raw;
    constexpr int RS = 272;
    const int tid = tidx(), lane = tid & 63, wave = tid >> 6, fr = lane & 15, fq = lane >> 4;
    for (int it = blockIdx.x; it < 512; it += gridDim.x) {
        const int g = it & 3, chunk = it >> 2;
        __syncthreads();
        { const int j = tid >> 2, q4 = tid & 3;
          const v4u* gp = (const v4u*)(VN + (size_t)(chunk * 128 + j) * 512 + g * 128 + 32 * q4);
#pragma unroll
          for (int q = 0; q < 4; ++q) { const v4u x = gp[q];
#pragma unroll
              for (int e = 0; e < 4; ++e) { const int c = 32 * q4 + 8 * q + 2 * e;
                  *(LAS unsigned short*)(L + c * RS + 2 * j) = (unsigned short)(x[e] & 0xffffu); *(LAS unsigned short*)(L + (c + 1) * RS + 2 * j) = (unsigned short)(x[e] >> 16); } } }
        __syncthreads();
        bf16x8 lf[4];
#pragma unroll
        for (int ks = 0; ks < 4; ++ks) lf[ks] = *(const bf16x8*)(Wsb + (size_t)(g * 128 + 16 * wave + fr) * 128 + 32 * ks + 8 * fq);
        const int i = 16 * wave + fr; const size_t tok = (size_t)chunk * 128 + i;
        const float bias = bsp[g * 128 + i];
#pragma unroll
        for (int tn = 0; tn < 8; ++tn) {
            f32x4 acc = {0.f, 0.f, 0.f, 0.f};
#pragma unroll
            for (int ks = 0; ks < 4; ++ks) { const bf16x8 rf = *(const LAS bf16x8*)(L + (16 * tn + fr) * RS + (32 * ks + 8 * fq) * 2); MMA16(acc, lf[ks], rf); }
            const int c = g * 128 + 16 * tn + 4 * fq;
            const v2u uw = *(const v2u*)(P + tok * ODD_PAD + c);
            const float u0 = gelu_tanh(__uint_as_float(uw.x << 16)), u1 = gelu_tanh(__uint_as_float(uw.x & 0xffff0000u)), u2 = gelu_tanh(__uint_as_float(uw.y << 16)), u3 = gelu_tanh(__uint_as_float(uw.y & 0xffff0000u));
            v2u w; w.x = pk2(u0 * (acc[0] + bias), u1 * (acc[1] + bias)); w.y = pk2(u2 * (acc[2] + bias), u3 * (acc[3] + bias));
            *(v2u*)(Y + tok * D + c) = w;
        }
    }
}


__device__ __forceinline__ void router_pass(const float* X, const float* g, const float* WRT  , float* AFF, int* SLOT, bf16_t* H, unsigned char* lds_raw) {
    const int tix_ = tidx(); const int lane = tix_ & 63, wave = tix_ >> 6, fr = lane & 15, fq = lane >> 4;
    const int pair = wave >> 1, half = wave & 1;
    f32x4 gcr[4];
#pragma unroll
    for (int j = 0; j < 4; ++j) gcr[j] = ((const f32x4*)g)[lane + 64 * j];
    LAS float* xch = (LAS float*)lds_raw + pair * 512;
    for (int tile0 = blockIdx.x * 4; tile0 < T / 16; tile0 += gridDim.x * 4) {
        const int tile = tile0 + pair;
        const float* xr = X + (size_t)(tile * 16 + fr) * D + 4 * fq + 512 * half;
        const float* wr = WRT + (size_t)fr * D + 4 * fq + 512 * half;
        f32x4 acc = {0.f, 0.f, 0.f, 0.f}; float ss = 0.f;
#pragma unroll 8
        for (int s = 0; s < 32; ++s) {
            const f32x4 xa = *(const f32x4*)(xr + 16 * s), wb = *(const f32x4*)(wr + 16 * s);
            ss += (xa[0] * xa[0] + xa[1] * xa[1]) + (xa[2] * xa[2] + xa[3] * xa[3]);
#pragma unroll
            for (int c = 0; c < 4; ++c) acc = __builtin_amdgcn_mfma_f32_16x16x4f32(xa[c], wb[c], acc, 0, 0, 0);
        }
        ss += __shfl_xor(ss, 16); ss += __shfl_xor(ss, 32);
        __syncthreads();
        { LAS float* p = xch + half * 256 + lane * 4; p[0] = acc[0]; p[1] = acc[1]; p[2] = acc[2]; p[3] = acc[3]; }
        if (fq == 0) ((LAS float*)lds_raw + 2048 + pair * 32 + half * 16)[fr] = ss;
        __syncthreads();
        { const LAS float* p = xch + (half ^ 1) * 256 + lane * 4; acc[0] += p[0]; acc[1] += p[1]; acc[2] += p[2]; acc[3] += p[3]; }
        ss += ((const LAS float*)lds_raw + 2048 + pair * 32 + (half ^ 1) * 16)[fr];
        const float rstd = rsqrtf(ss * (1.0f / D) + 1e-6f);
        {
            float aff[4];
#pragma unroll
            for (int jj = 0; jj < 4; ++jj) {
                const float lg = acc[jj] * __shfl(rstd, 4 * fq + jj);
                float mx = lg;
#pragma unroll
                for (int o = 1; o < 16; o <<= 1) mx = fmaxf(mx, __shfl_xor(mx, o));
                const float e = expf(lg - mx); float den = e;
#pragma unroll
                for (int o = 1; o < 16; o <<= 1) den += __shfl_xor(den, o);
                aff[jj] = e / den;
            }
#pragma unroll
            for (int jj = 0; jj < 4; ++jj) { const size_t o = (size_t)(tile * 16 + 4 * fq + jj) * NE + fr; if ((fq >> 1) == half) { AFF[o] = aff[jj]; SLOT[o] = -1; } }
        }
#pragma unroll 4
        for (int tt = 0; tt < 8; ++tt) {
            const int t = 8 * half + tt;
            const float rs = __shfl(rstd, t);
            const f32x4* xp = (const f32x4*)(X + (size_t)(tile * 16 + t) * D); v2u* hp = (v2u*)(H + (size_t)(tile * 16 + t) * D);
#pragma unroll
            for (int j = 0; j < 4; ++j) { const f32x4 v = xp[lane + 64 * j], gg = gcr[j];
                v2u w; w.x = pk2(v[0] * rs * gg[0], v[1] * rs * gg[1]); w.y = pk2(v[2] * rs * gg[2], v[3] * rs * gg[3]); hp[lane + 64 * j] = w; }
        }
    }
}


__device__ __forceinline__ void lora_pass(const bf16_t* F5, const bf16_t* WC, const float* w0, const float* a0, const float* k_a, const bf16_t* KB, const bf16_t* KK,
                                          bf16_t* LW, bf16_t* KD, bf16_t* BB, bf16_t* G, unsigned char* lds_raw) {
    LAS unsigned char* L = (LAS unsigned char*)lds_raw;
    constexpr int ARS = 784;
    const int tid = tidx(), lane = tid & 63, wave = tid >> 6, fr = lane & 15, fq = lane >> 4;
    for (int tile = blockIdx.x; tile < T / 64; tile += gridDim.x) {
        __syncthreads();
#pragma unroll
        for (int q = 0; q < 6; ++q) { const int p = tid + 512 * q, row = p / 48, piece = p % 48;
            *(LAS v4u*)(L + row * ARS + piece * 16) = *(const v4u*)(F5 + (size_t)(tile * 64 + row) * 384 + piece * 8); }
        __syncthreads();
#pragma unroll 1
        for (int sec = 0; sec < 5; ++sec) {
            const int K0 = sec * 64, nks = sec < 4 ? 2 : 4, wstride = sec < 4 ? 64 : 128;
            const bf16_t* Wp = WC + (size_t)sec * 512 * 64 + (size_t)(64 * wave) * wstride;
#pragma unroll 1
            for (int nh = 0; nh < 2; ++nh) {
            f32x4 acc[4][2];
#pragma unroll
            for (int tm = 0; tm < 4; ++tm)
#pragma unroll
                for (int tn = 0; tn < 2; ++tn) acc[tm][tn] = (f32x4){0.f, 0.f, 0.f, 0.f};
            for (int ks = 0; ks < nks; ++ks) {
                bf16x8 lf[4], rf[2];
#pragma unroll
                for (int tm = 0; tm < 4; ++tm) lf[tm] = *(const LAS bf16x8*)(L + (16 * tm + fr) * ARS + (K0 + 32 * ks + 8 * fq) * 2);
#pragma unroll
                for (int tn = 0; tn < 2; ++tn) rf[tn] = *(const bf16x8*)(Wp + (size_t)(16 * (2 * nh + tn) + fr) * wstride + 32 * ks + 8 * fq);
#pragma unroll
                for (int tm = 0; tm < 4; ++tm)
#pragma unroll
                    for (int tn = 0; tn < 2; ++tn) MMA16(acc[tm][tn], lf[tm], rf[tn]);
            }
            f32x4 cw[2], cka[2]; v2u kw[4][2], kkw[4][2];
#pragma unroll
            for (int tn = 0; tn < 2; ++tn) {
                const int cc = 64 * wave + 16 * (2 * nh + tn) + 4 * fq;
                cw[tn] = (sec < 2) ? *(const f32x4*)(w0 + sec * 512 + cc) : ((sec < 4) ? *(const f32x4*)(a0 + (sec - 2) * 512 + cc) : (f32x4){0.f, 0.f, 0.f, 0.f});
                cka[tn] = *(const f32x4*)(k_a + cc);
#pragma unroll
                for (int tm = 0; tm < 4; ++tm) { const size_t tok = (size_t)tile * 64 + 16 * tm + fr;
                    if (sec >= 2 && sec < 4) { kw[tm][tn] = *(const v2u*)(KB + tok * 512 + cc); kkw[tm][tn] = *(const v2u*)(KK + tok * 512 + cc); } else { kw[tm][tn] = (v2u){0u, 0u}; kkw[tm][tn] = (v2u){0u, 0u}; } }
            }
#pragma unroll
            for (int tn = 0; tn < 2; ++tn) {
                const int cc = 64 * wave + 16 * (2 * nh + tn) + 4 * fq;
#pragma unroll
                for (int tm = 0; tm < 4; ++tm) {
                    const size_t tok = (size_t)tile * 64 + 16 * tm + fr; const f32x4 v = acc[tm][tn];
                    if (sec < 2) {
                        float o[4];
#pragma unroll
                        for (int j = 0; j < 4; ++j) o[j] = -0.6065306597126334f * frcp(1.0f + __expf(-(cw[tn][j] + v[j])));
                        v2u ww; ww.x = pk2(o[0], o[1]); ww.y = pk2(o[2], o[3]);
                        *(v2u*)(LW + ((size_t)sec * T + tok) * 512 + cc) = ww;
                    } else if (sec < 4) {
                        const int d = sec - 2;
                        const float kv[4] = {bflo(kw[tm][tn].x), bfhi(kw[tm][tn].x), bflo(kw[tm][tn].y), bfhi(kw[tm][tn].y)}, kk[4] = {bflo(kkw[tm][tn].x), bfhi(kkw[tm][tn].x), bflo(kkw[tm][tn].y), bfhi(kkw[tm][tn].y)};
                        float okd[4], obb[4];
#pragma unroll
                        for (int j = 0; j < 4; ++j) { const float alr = frcp(1.0f + __expf(-(cw[tn][j] + v[j]))); okd[j] = kv[j] * (1.0f + (alr - 1.0f) * cka[tn][j]); obb[j] = kk[j] * alr; }
                        v2u w1, w2_; w1.x = pk2(okd[0], okd[1]); w1.y = pk2(okd[2], okd[3]); w2_.x = pk2(obb[0], obb[1]); w2_.y = pk2(obb[2], obb[3]);
                        *(v2u*)(KD + ((size_t)d * T + tok) * 512 + cc) = w1; *(v2u*)(BB + ((size_t)d * T + tok) * 512 + cc) = w2_;
                    } else { v2u ww; ww.x = pk2(v[0], v[1]); ww.y = pk2(v[2], v[3]); *(v2u*)(G + tok * 512 + cc) = ww; }
                }
            }
            }
        }
    }
}

#define IN(k) (lo <= (k) && (k) < hi)
#define REP_LOOP for (int rep_ = 0, nrep_ = ((ph == PROBE_PHASE) ? PROBE_REP : 1); rep_ < nrep_; ++rep_)
#define SEAM(k) do { if (IN(k) && IN((k) + 1)) xcd_barrier(bar); } while (0)
#define PROLOG \
    const int tid = tidx(), lane = tid & 63, wave = tid >> 6; \
    const int bid = blockIdx.x, nb = gridDim.x; \
    const int gw = bid * 8 + wave, ngw = nb * 8; \
    const int gt = bid * NTH + tid, ngt = nb * NTH; \
    (void)gt; (void)ngt; (void)gw; (void)ngw; (void)lane; (void)wave; \
    unsigned char* ws = a.ws; \
    const int lo = a.lo, hi = a.hi; \
    float* ldsf = (float*)lds_raw; (void)ldsf; \
    PG8_LAS unsigned char* ldsp = (PG8_LAS unsigned char*)lds_raw; (void)ldsp; \
    const float* x_in = a.in[0]; const float* mem = a.in[1]; (void)x_in; (void)mem; \
    float* ropec = (float*)(ws + WS_ROPE); float* ropes = ropec + S * 32; (void)ropec; (void)ropes; \
    float* AFF = (float*)(ws + WS_AFF); int* TOK = (int*)(ws + WS_TOK); float* GATE = (float*)(ws + WS_GATE); \
    float* X = (float*)(ws + WS_X); bf16_t* H = (bf16_t*)(ws + WS_H); bf16_t* P = (bf16_t*)(ws + WS_P); \
    bf16_t* Y = (bf16_t*)(ws + WS_Y); bf16_t* Q = (bf16_t*)(ws + WS_Q); bf16_t* KV = (bf16_t*)(ws + WS_KV); bf16_t* MN = (bf16_t*)(ws + WS_MN); \
    bf16_t* DEC = (bf16_t*)(ws + WS_DEC); bf16_t* KD = (bf16_t*)(ws + WS_KD); bf16_t* BB = (bf16_t*)(ws + WS_BB); \
    bf16_t* KK = (bf16_t*)(ws + WS_KK); bf16_t* G = (bf16_t*)(ws + WS_G); float* YS = (float*)(ws + WS_YS); \
    bf16_t* RV = (bf16_t*)(ws + WS_RV); bf16_t* VN = (bf16_t*)(ws + WS_VN); \
    bf16_t* XE = (bf16_t*)(ws + WS_XE); bf16_t* HID = (bf16_t*)(ws + WS_HID); int* SLOT = (int*)(ws + WS_SLOT); bf16_t* YE = (bf16_t*)(ws + WS_YE); (void)SLOT; (void)YE; \
    (void)AFF; (void)TOK; (void)GATE; (void)X; (void)H; (void)P; (void)Y; (void)Q; (void)KV; (void)MN; (void)DEC; (void)KD; (void)BB; (void)KK; (void)G; (void)YS; (void)RV; (void)VN; (void)XE; (void)HID;

template <class Epi>
__device__ __forceinline__ void dense_gemm(PG8_LAS unsigned char* ldsp, const bf16_t* A, const bf16_t* Bt, int M, int N, int K, const Epi& E, int cshift = 0) {
    asm volatile("" : "+s"(K));
    pg8::Gemm g{A, Bt, M, N, K}; pg8::StaticOrder So; So.init(M, N, (int)gridDim.x, (int)((blockIdx.x + cshift) % gridDim.x));
    pg8::gemm_phase<Epi, pg8::StaticOrder, false>(ldsp, g, So, E, nullptr);
}

__device__ __forceinline__ int odd_phases(const Args& a, const XcdBarrier& bar, unsigned char* lds_raw, int ph) {
    PROLOG
    if (IN(ph)) combine_norm<false>(X, YE, SLOT, a.in[6], H, nullptr);
    SEAM(ph); ++ph;
    if (IN(ph)) dense_gemm(ldsp, H, (const bf16_t*)(ws + WS_WOIN), T, ODD_PAD, D, EpiBf16Store{P, ODD_PAD, 1.0f});
    SEAM(ph); ++ph;
    if (IN(ph)) REP_LOOP odd_token_pass(P, a.in[12], a.in[18], a.in[8], a.in[9], VN, RV, (bf16_t*)(ws + WS_KB), KK, (bf16_t*)(ws + WS_F5));
    SEAM(ph); ++ph;
    if (IN(ph)) REP_LOOP {
        gating_pass(VN, (const bf16_t*)(ws + WS_WSB), a.in[11], P, Y, lds_raw);
        __syncthreads();
        lora_pass((const bf16_t*)(ws + WS_F5), (const bf16_t*)(ws + WS_WL), a.in[13], a.in[15], a.in[19], (const bf16_t*)(ws + WS_KB), KK, DEC, KD, BB, G, lds_raw);
    }
    SEAM(ph); ++ph;
    if (IN(ph)) REP_LOOP scan_r1(DEC, RV, KD, KK, BB, (bf16_t*)(ws + WS_PT), (bf16_t*)(ws + WS_QT), (bf16_t*)(ws + WS_RH), (bf16_t*)(ws + WS_YL), lds_raw);
    SEAM(ph); ++ph;
    if (IN(ph)) REP_LOOP {
        if (bid < 32) scan_r2((const bf16_t*)(ws + WS_PT), (const bf16_t*)(ws + WS_QT), (bf16_t*)(ws + WS_S0), lds_raw);
        else {
            LAS float* scr = (LAS float*)((LAS unsigned char*)lds_raw + wave * 16896);
            const int gw2 = (bid - 32) * 8 + wave, ngw2 = (nb - 32) * 8;
            auto gmap = [](int n) { return (n >> 7) * 256 + (n & 127); };
            auto umap = [](int n) { return (n >> 7) * 256 + 128 + (n & 127); };
            for (int it = gw2; it < 16 * 704; it += ngw2) { const int e = it / 704, r = it % 704;
                transpose_item_fp8(a.in[31] + (size_t)(16 + e) * D * DE, D, DE, ws + WS_WGU8 + 176 * MiB + (size_t)e * 5632 * D, gmap, GUSC8, scr, r, lane); }
            for (int it = gw2; it < 16 * 704; it += ngw2) { const int e = it / 704, r = it % 704;
                transpose_item_fp8(a.in[32] + (size_t)(16 + e) * D * DE, D, DE, ws + WS_WGU8 + 176 * MiB + (size_t)e * 5632 * D, umap, GUSC8, scr, r, lane); }
        }
    }
    SEAM(ph); ++ph;
    if (IN(ph)) REP_LOOP scan_r3((const bf16_t*)(ws + WS_RH), (const bf16_t*)(ws + WS_YL), (const bf16_t*)(ws + WS_S0), RV, KD, G, a.in[20], a.in[21], a.in[22], Y);
    SEAM(ph); ++ph;
    if (IN(ph)) dense_gemm(ldsp, Y, (const bf16_t*)(ws + WS_WOOUT), T, D, D, EpiResidN{X, X, H, (float*)(ws + WS_SSP)});
    SEAM(ph); ++ph;
    return ph;
}

template <int layer>
__device__ __forceinline__ int tail_phases(const Args& a, const XcdBarrier& bar, unsigned char* lds_raw, int ph) {
    PROLOG
    if (IN(ph)) REP_LOOP {
        int Kq = D; asm volatile("" : "+s"(Kq));
        pg8::Gemm g{H, (const bf16_t*)(ws + WS_WQ) + (size_t)layer * D * D, T, D, Kq}; XattnOrder So{(int)blockIdx.x};
        pg8::gemm_phase<EpiBf16StoreRS, XattnOrder, false>(ldsp, g, So, EpiBf16StoreRS{Q, D, (const float*)(ws + WS_SSP)}, nullptr);
        asm volatile("s_waitcnt vmcnt(0)" ::: "memory");
        __syncthreads();
        xattn_mfma(Q, KV + (size_t)layer * 1024 * 1024, KV + (size_t)layer * 1024 * 1024 + 512 * 1024, Y, lds_raw);
    }
    SEAM(ph); ++ph;
    if (IN(ph)) dense_gemm(ldsp, Y, (const bf16_t*)(ws + WS_WO) + (size_t)layer * D * D, T, D, D, EpiResid{X, X});
    SEAM(ph); ++ph;
    if (IN(ph)) REP_LOOP router_pass(X, a.in[29] + layer * D, (const float*)(ws + WS_WRT) + (size_t)layer * NE * D, AFF, SLOT, H, lds_raw);
    SEAM(ph); ++ph;
    if (IN(ph)) REP_LOOP {
        unsigned* keys = (unsigned*)ldsf;
        int* hist = (int*)(ldsf + 8192);
        int* sh = hist + 8 * 256;
        if (bid >= 32) {
            LAS float* scr = (LAS float*)((LAS unsigned char*)lds_raw + wave * 16896);
            const int gw2 = (bid - 32) * 8 + wave, ngw2 = (nb - 32) * 8;
            auto ident = [](int n) { return n; };
            if constexpr (layer == 0) {
                auto gmap = [](int n) { return (n >> 7) * 256 + (n & 127); };
                auto umap = [](int n) { return (n >> 7) * 256 + 128 + (n & 127); };
        for (int it = 4096 + gw2; it < 16 * 704; it += ngw2) { const int mt = it / 704, r = it % 704;
            if constexpr (F8L0) transpose_item_fp8(a.in[31] + (size_t)mt * D * DE, D, DE, ws + WS_WGU8 + (size_t)mt * 5632 * D, gmap, GUSC8, scr, r, lane);
            else transpose_item(a.in[31] + (size_t)mt * D * DE, D, DE, (bf16_t*)(ws + WS_WGU) + (size_t)mt * 5632 * D, gmap, scr, r, lane); }
        for (int it = gw2; it < 16 * 704; it += ngw2) { const int mt = it / 704, r = it % 704;
            if constexpr (F8L0) transpose_item_fp8(a.in[32] + (size_t)mt * D * DE, D, DE, ws + WS_WGU8 + (size_t)mt * 5632 * D, umap, GUSC8, scr, r, lane);
            else transpose_item(a.in[32] + (size_t)mt * D * DE, D, DE, (bf16_t*)(ws + WS_WGU) + (size_t)mt * 5632 * D, umap, scr, r, lane); }
            }
            for (int it = gw2; it < 16 * 704; it += ngw2) { const int mt = layer * 16 + it / 704, r = it % 704;
                if constexpr (layer == 1 || F8L0) transpose_item_fp8(a.in[33] + (size_t)mt * DE * D, DE, D, ws + WS_WD8 + (size_t)layer * 88 * MiB + (size_t)(mt - 16 * layer) * D * DE, ident, DSC8, scr, r, lane);
                else transpose_item(a.in[33] + (size_t)mt * DE * D, DE, D, (bf16_t*)(ws + WS_WD) + (size_t)mt * D * DE, ident, scr, r, lane); }
        }
        for (int be = bid; be < NB * NE && be < 32; be += nb) {
            const int b = be >> 4, e = be & 15, eb = e * 2 + b;
            __syncthreads();
            for (int s = tid; s < S; s += NTH) keys[s] = __float_as_uint(AFF[(size_t)(b * S + s) * NE + e]);
            unsigned prefix = 0u; int krem = CAP;
            for (int pass = 3; pass >= 0; --pass) {
                __syncthreads();
                for (int i = tid; i < 8 * 256; i += NTH) hist[i] = 0;
                __syncthreads();
                const unsigned hmask = pass == 3 ? 0u : (0xFFFFFFFFu << (8 * (pass + 1)));
                for (int s = tid; s < S; s += NTH) { const unsigned k = keys[s]; if ((k & hmask) == prefix) atomicAdd(&hist[wave * 256 + ((k >> (8 * pass)) & 255u)], 1); }
                __syncthreads();
                if (wave == 0) {
                    int c4[4], s4 = 0;
#pragma unroll
                    for (int j = 0; j < 4; ++j) { const int bin = 255 - (4 * lane + j); int c = 0;
#pragma unroll
                        for (int w = 0; w < 8; ++w) c += hist[w * 256 + bin];
                        c4[j] = c; s4 += c; }
                    int pre = s4;
#pragma unroll
                    for (int o = 1; o < 64; o <<= 1) { const int y = __shfl_up(pre, o); if (lane >= o) pre += y; }
                    const int excl = pre - s4;
                    if (excl < krem && krem <= pre) {
                        int cum = excl, bsel = 0, rem = 0; bool found = false;
#pragma unroll
                        for (int j = 0; j < 4; ++j) { if (!found && cum + c4[j] >= krem) { bsel = 255 - (4 * lane + j); rem = krem - cum; found = true; } if (!found) cum += c4[j]; }
                        sh[8] = bsel; sh[9] = rem;
                    }
                }
                __syncthreads();
                prefix |= ((unsigned)sh[8]) << (8 * pass); krem = sh[9];
            }
            const unsigned thr = prefix;
            int ce = 0;
            for (int i = 0; i < 16; ++i) { const unsigned k = keys[tid * 16 + i]; ce += (k == thr); }
            int tot;
            const int eqbase = block_exscan(ce, sh, &tot);
            int eqr = eqbase, cs = 0;
            for (int i = 0; i < 16; ++i) { const unsigned k = keys[tid * 16 + i]; const bool sel = (k > thr) || (k == thr && eqr < krem); eqr += (k == thr); cs += sel; }
            const int sbase = block_exscan(cs, sh, &tot);
            int slot = sbase; eqr = eqbase;
            for (int i = 0; i < 16; ++i) {
                const int s = tid * 16 + i; const unsigned k = keys[s];
                const bool sel = (k > thr) || (k == thr && eqr < krem); eqr += (k == thr);
                if (sel) { TOK[eb * CAP + slot] = b * S + s; GATE[eb * CAP + slot] = __uint_as_float(k); SLOT[(size_t)(b * S + s) * NE + e] = eb * CAP + slot; ++slot; }
            }
        }
    }
    SEAM(ph); ++ph;
    if (IN(ph)) REP_LOOP {
        for (int r = gw; r < NB * NE * CAP; r += ngw) {
            int rv_ = r; asm volatile("" : "+v"(rv_));
            if constexpr (layer == 1 || F8L0) {
                const v4u* srcp = (const v4u*)(H + (size_t)TOK[rv_] * D) + 2 * lane; const v4u x0 = srcp[0], x1 = srcp[1];
                v4u o;
                o.x = pk4_fp8(bflo(x0.x) * ASC8, bfhi(x0.x) * ASC8, bflo(x0.y) * ASC8, bfhi(x0.y) * ASC8); o.y = pk4_fp8(bflo(x0.z) * ASC8, bfhi(x0.z) * ASC8, bflo(x0.w) * ASC8, bfhi(x0.w) * ASC8);
                o.z = pk4_fp8(bflo(x1.x) * ASC8, bfhi(x1.x) * ASC8, bflo(x1.y) * ASC8, bfhi(x1.y) * ASC8); o.w = pk4_fp8(bflo(x1.z) * ASC8, bfhi(x1.z) * ASC8, bflo(x1.w) * ASC8, bfhi(x1.w) * ASC8);
                ((v4u*)((unsigned char*)XE + (size_t)r * D))[lane] = o;
            } else {
                const v4u* srcp = (const v4u*)(H + (size_t)TOK[rv_] * D); v4u* dst = (v4u*)(XE + (size_t)r * D);
                dst[lane] = srcp[lane]; dst[lane + 64] = srcp[lane + 64];
            }
        }
    }
    SEAM(ph); ++ph;
    if (IN(ph)) {
        MoeOrder So{(int)gridDim.x, (int)blockIdx.x, 16 * 22, 22};
        if constexpr (layer == 1 || F8L0) {
            int Kg = D / 2; asm volatile("" : "+s"(Kg));
            pg8::Gemm g{XE, (const bf16_t*)(ws + WS_WGU8 + (size_t)layer * 176 * MiB), NB * NE * CAP, NE * 5632, Kg};
            pg8::gemm_phase<EpiSiluMul8, MoeOrder, false, true>(ldsp, g, So, EpiSiluMul8{(unsigned char*)HID}, nullptr);
        } else {
            pg8::Gemm g{XE, (const bf16_t*)(ws + WS_WGU) + (size_t)layer * NE * 5632 * D, NB * NE * CAP, NE * 5632, D};
            pg8::gemm_phase<EpiSiluMul, MoeOrder, false>(ldsp, g, So, EpiSiluMul{HID}, nullptr);
        }
    }
    SEAM(ph); ++ph;
    if (IN(ph)) {
        MoeOrder So{(int)gridDim.x, (int)blockIdx.x, 16 * 4, 4};
        if constexpr (layer == 1 || F8L0) {
            int Kg = DE / 2; asm volatile("" : "+s"(Kg));
            pg8::Gemm g{HID, (const bf16_t*)(ws + WS_WD8 + (size_t)layer * 88 * MiB), NB * NE * CAP, NE * D, Kg};
            pg8::gemm_phase<EpiYE8, MoeOrder, false, true>(ldsp, g, So, EpiYE8{GATE, YE}, nullptr);
        } else {
            pg8::Gemm g{HID, (const bf16_t*)(ws + WS_WD) + (size_t)layer * NE * D * DE, NB * NE * CAP, NE * D, DE};
            pg8::gemm_phase<EpiYE, MoeOrder, false>(ldsp, g, So, EpiYE{GATE, YE}, nullptr);
        }
    }
    SEAM(ph); ++ph;
    return ph;
}

__global__ void __launch_bounds__(NTH, 2) mega(Args a) {
    extern __shared__ __attribute__((aligned(16))) unsigned char lds_raw[];
    unsigned* ctl = (unsigned*)(a.ws + WS_CTL);
    volatile LAS unsigned* bst = (volatile LAS unsigned*)((LAS unsigned char*)lds_raw + LDS_BAR_OFF);
    { const int t0_ = tidx(); if (t0_ < 4) bst[t0_] = 0u; }
    __syncthreads();
    XcdBarrier bar; bar.bar = ctl + CW_BAR; bar.x = 0; bar.st = bst;
    if (a.hi - a.lo > 1) bar = xcd_barrier_post(ctl + CW_BAR, bst);
    PROLOG

    int ph = 0;
    if (IN(ph)) REP_LOOP {
        for (int i = gt; i < S * 32; i += ngt) {
            const int s = i >> 5, f = i & 31;
            const float pw = (float)exp((double)((float)(2 * f) / 64.0f) * 9.210340371976184);
            const float invf = 1.0f / pw;
            const float angf = (float)s * invf;
            double xx = (double)angf;
            const double n = rint(xx * 0.15915494309189535);
            xx = (xx - n * 6.283185307179586) - n * 2.4492935982947064e-16;
            const double x2 = xx * xx;
            double cs = 1.0, sn = xx, tc = 1.0, tsn = xx;
#pragma unroll 1
            for (int k = 1; k <= 16; ++k) { tc *= -x2 / (double)((2 * k - 1) * (2 * k)); tsn *= -x2 / (double)((2 * k) * (2 * k + 1)); cs += tc; sn += tsn; }
            ropec[i] = (float)cs; ropes[i] = (float)sn;
        }
        rmsnorm_rows_bf16(x_in, a.in[2], H, T);
        rmsnorm_rows_bf16(mem, a.in[25], MN, NB * MEM); rmsnorm_rows_bf16(mem, a.in[25] + D, MN + NB * MEM * D, NB * MEM);
        LAS float* scr = (LAS float*)((LAS unsigned char*)lds_raw + wave * 16896);
        auto ident = [](int n) { return n; };
        auto emap = [](int n) { const bool il = (n < 1024) || (n >= 1536 && n < 2176); const int j = n & 63; return il ? ((n & ~63) + (j < 32 ? 2 * j : 2 * (j - 32) + 1)) : n; };
        for (int it = gw; it < 16 * 36; it += ngw) transpose_item(a.in[3], D, EVEN_IN, (bf16_t*)(ws + WS_WEIN), emap, scr, it, lane);
        for (int it = gw; it < 2 * 16 * 32; it += ngw) { const int l = it / 512, r = it % 512; transpose_item(a.in[27] + (size_t)l * D * 2048, D, 2048, (bf16_t*)(ws + WS_WKV) + (size_t)l * 2048 * D, ident, scr, r, lane); }
        { float* WRT = (float*)(ws + WS_WRT);
          for (int i = gt; i < 2 * NE * D; i += ngt) { const int l = i >> 14, e = (i >> 10) & 15, k = i & 1023; WRT[i] = a.in[29][l * D + k] * a.in[30][((size_t)l * D + k) * NE + e]; } }
        { bf16_t* Wsb = (bf16_t*)(ws + WS_WSB); const float* wsp = a.in[10];
          for (int i = gt; i < 4 * 128 * 128; i += ngt) Wsb[i] = (bf16_t)f2bf(wsp[i]);
          bf16_t* WL = (bf16_t*)(ws + WS_WL); const float *w2 = a.in[14], *a2 = a.in[16], *g2 = a.in[17];
          for (int i = gt; i < 4 * 512 * 64 + 512 * 128; i += ngt) { float v;
              if (i < 4 * 512 * 64) { const int sec = i >> 15, n = (i >> 6) & 511, k = i & 63; v = (sec < 2 ? w2 : a2)[(size_t)((sec & 1) * 64 + k) * 512 + n]; }
              else { const int j = i - 4 * 512 * 64, n = j >> 7, k = j & 127; v = g2[(size_t)k * 512 + n]; }
              WL[i] = (bf16_t)f2bf(v); } }
        auto gmap = [](int n) { return (n >> 7) * 256 + (n & 127); };
        auto umap = [](int n) { return (n >> 7) * 256 + 128 + (n & 127); };
    }
    SEAM(ph); ++ph;

    if (IN(ph)) dense_gemm(ldsp, H, (const bf16_t*)(ws + WS_WEIN), T, EVEN_IN, D,
                           EpiEven{ropec, ropes, (bf16_t*)(ws + WS_QHA), (bf16_t*)(ws + WS_KHA), (bf16_t*)(ws + WS_QHB), (bf16_t*)(ws + WS_KHB), (bf16_t*)(ws + WS_VTA), (bf16_t*)(ws + WS_VTB)});
    if (IN(ph)) {
        dense_gemm(ldsp, MN, (const bf16_t*)(ws + WS_WKV), NB * MEM, 2048, D, EpiKV{KV, KV + 512 * 1024}, 192);
        dense_gemm(ldsp, MN + NB * MEM * D, (const bf16_t*)(ws + WS_WKV) + (size_t)2048 * D, NB * MEM, 2048, D, EpiKV{KV + 1024 * 1024, KV + 1024 * 1024 + 512 * 1024}, 176);
        if (bid >= 96) {
            __syncthreads();
            LAS float* scr = (LAS float*)((LAS unsigned char*)lds_raw + wave * 16896);
            const int gw3 = (bid - 96) * 8 + wave, ngw3 = (nb - 96) * 8;
            auto ident = [](int n) { return n; };
            auto gmap = [](int n) { return (n >> 7) * 256 + (n & 127); };
        for (int it = gw3; it < 16 * 16; it += ngw3) transpose_item(a.in[5], D, D, (bf16_t*)(ws + WS_WEOUT), ident, scr, it, lane);
        for (int it = gw3; it < 16 * 46; it += ngw3) transpose_item(a.in[7], D, ODD_IN, (bf16_t*)(ws + WS_WOIN), ident, scr, it, lane);
        for (int it = gw3; it < 16 * 16; it += ngw3) transpose_item(a.in[23], D, D, (bf16_t*)(ws + WS_WOOUT), ident, scr, it, lane);
        for (int it = gw3; it < 2 * 16 * 16; it += ngw3) { const int l = it / 256, r = it % 256; transpose_item(a.in[26] + (size_t)l * D * D, D, D, (bf16_t*)(ws + WS_WQ) + (size_t)l * D * D, ident, scr, r, lane, a.in[24] + l * D); }
        for (int it = gw3; it < 2 * 16 * 16; it += ngw3) { const int l = it / 256, r = it % 256; transpose_item(a.in[28] + (size_t)l * D * D, D, D, (bf16_t*)(ws + WS_WO) + (size_t)l * D * D, ident, scr, r, lane); }
            for (int it = gw3; it < 4096; it += ngw3) { const int mt = it / 704, r = it % 704;
                if constexpr (F8L0) transpose_item_fp8(a.in[31] + (size_t)mt * D * DE, D, DE, ws + WS_WGU8 + (size_t)mt * 5632 * D, gmap, GUSC8, scr, r, lane);
                else transpose_item(a.in[31] + (size_t)mt * D * DE, D, DE, (bf16_t*)(ws + WS_WGU) + (size_t)mt * 5632 * D, gmap, scr, r, lane); }
        }
    }
    SEAM(ph); ++ph;
    if (IN(ph)) REP_LOOP attn_phase_even((const bf16_t*)(ws + WS_QHA), (const bf16_t*)(ws + WS_KHA), (const bf16_t*)(ws + WS_VTA), (const bf16_t*)(ws + WS_QHB), (const bf16_t*)(ws + WS_KHB),
                                (const bf16_t*)(ws + WS_VTB), a.in[4], (bf16_t*)(ws + WS_OA), (float*)(ws + WS_LSE), Y, lds_raw);
    SEAM(ph); ++ph;
    if (IN(ph)) REP_LOOP attn_combine((const bf16_t*)(ws + WS_OA), (const float*)(ws + WS_LSE), Y);
    SEAM(ph); ++ph;
    if (IN(ph)) dense_gemm(ldsp, Y, (const bf16_t*)(ws + WS_WEOUT), T, D, D, EpiResidN{x_in, X, H, (float*)(ws + WS_SSP)});
    SEAM(ph); ++ph;

    ph = tail_phases<0>(a, bar, lds_raw, ph);
    ph = odd_phases(a, bar, lds_raw, ph);
    ph = tail_phases<1>(a, bar, lds_raw, ph);

    if (IN(ph)) combine_norm<true>(X, YE, SLOT, a.in[34], nullptr, a.out);
    ++ph;
}
constexpr int NPHASES = 1 + 4 + 2 * 7 + 8 + 1;
#undef IN
#undef SEAM
}

extern "C" void kernel_launch(void* const* d_in, const int* in_sizes, int n_in, void* d_out, int out_size, void* d_ws, size_t ws_size, hipStream_t stream) {
    static int grid = 0;
    if (grid == 0) {
        if (n_in != 35 || out_size != T * D || ws_size < WS_END) { fprintf(stderr, "kernel_launch: unexpected shapes n_in %d out %d ws %zu (need %zu)\n", n_in, out_size, ws_size, (size_t)WS_END); grid = -1; return; }
        int dev = 0, cus = 0, per_cu = 0;
        (void)hipGetDevice(&dev); (void)hipDeviceGetAttribute(&cus, hipDeviceAttributeMultiprocessorCount, dev);
        if (hipFuncSetAttribute((const void*)mega, hipFuncAttributeMaxDynamicSharedMemorySize, LDS_BYTES) != hipSuccess) { fprintf(stderr, "hipFuncSetAttribute failed\n"); grid = -1; return; }
        if (hipOccupancyMaxActiveBlocksPerMultiprocessor(&per_cu, (const void*)mega, NTH, LDS_BYTES) != hipSuccess || per_cu < 1) fprintf(stderr, "occupancy query: %d\n", per_cu);
        (void)hipGetLastError();
        grid = cus > 0 ? cus : 256;
    }
    if (grid < 0) return;
    (void)hipMemsetAsync((char*)d_ws + WS_CTL, 0, CTL_BYTES, stream);
    Args a{};
    for (int i = 0; i < 35; ++i) a.in[i] = (const float*)d_in[i];
    a.out = (float*)d_out; a.ws = (unsigned char*)d_ws;
#if MK_MULTI
    for (int k = 0; k < NPHASES; ++k) { a.lo = k; a.hi = k + 1; hipLaunchKernelGGL(mega, dim3(grid), dim3(NTH), LDS_BYTES, stream, a); }
#else
    a.lo = 0; a.hi = NPHASES; hipLaunchKernelGGL(mega, dim3(grid), dim3(NTH), LDS_BYTES, stream, a);
#endif
}
```

```cpp
#include <hip/hip_runtime.h>
#include <cstdio>
#include <cstdint>

#ifndef PROBE_PHASE
#define PROBE_PHASE (-1)
#endif
#ifndef PROBE_REP
#define PROBE_REP 1
#endif
#ifndef MK_MULTI
#define MK_MULTI 0
#endif

__device__ __forceinline__ int tidx() { int t = threadIdx.x; asm volatile("" : "+v"(t)); return t; }
namespace pg8 {
#define PG8_LAS __attribute__((address_space(3)))
typedef unsigned short bf16_t;
typedef short bf16x8 __attribute__((ext_vector_type(8)));
typedef float f32x4 __attribute__((ext_vector_type(4)));
typedef unsigned u32x4 __attribute__((ext_vector_type(4)));
constexpr int BM = 256, BK = 64, HALF = 128, HTB = HALF * BK * 2  , STAGE_BYTES = 8 * HTB, NXCD = 8, WGM = 8;

__host__ __device__ __forceinline__ int lds_byte(int r, int c) { const int st = (r >> 4) * 2 + (c >> 5), rr = r & 15, cc = c & 31, ob = rr * 64 + cc * 2; return st * 1024 + (ob ^ (((ob >> 9) & 1) << 5)); }
__host__ __device__ __forceinline__ void stage_rc(int b, int& R, int& C) { const int st = b / 1024, sb = b % 1024, swz = sb ^ (((sb >> 9) & 1) << 5); R = (st >> 1) * 16 + swz / 64; C = (st & 1) * 32 + (swz % 64) / 2; }
__host__ __device__ __forceinline__ int perm32(int rho) { const int n = rho >> 4, i = rho & 15; return 8 * (i >> 2) + 4 * n + (i & 3); }

struct Unit { int pm, pn; };
struct Gemm { const bf16_t* A; const bf16_t* Bt; int M, N, K; const int* rowidx = nullptr; };

struct StaticOrder {
    int nM, nN, nwg, G, c;
    __host__ __device__ void init(int M, int N, int G_, int c_) { nM = M / BM; nN = N / BM; nwg = nM * nN; G = G_; c = c_; }
    __host__ __device__ bool next(int i, Unit& u) const {
        const long L = (long)i * G + c; if (L >= nwg) return false;
        int wgid = (int)L; { const int q = nwg / NXCD, r = nwg % NXCD, xcd = wgid % NXCD, off = wgid / NXCD; wgid = (xcd < r ? xcd * (q + 1) : r * (q + 1) + (xcd - r) * q) + off; }
        const int nig = WGM * nN, gid = wgid / nig, fm = gid * WGM, gsz = (nM - fm) < WGM ? (nM - fm) : WGM;
        u.pm = fm + ((wgid % nig) % gsz); u.pn = (wgid % nig) / gsz; return true;
    }
    __device__ __forceinline__ void a_ready(const Unit&) const {}
    __device__ __forceinline__ void done(const Unit&) const {}
};

typedef __bf16 bf16v2_t __attribute__((ext_vector_type(2)));
typedef float f32v2_t __attribute__((ext_vector_type(2)));
__device__ __forceinline__ unsigned cvt_pk_bf16(float lo, float hi) { const f32v2_t v = {lo, hi}; return __builtin_bit_cast(unsigned, __builtin_convertvector(v, bf16v2_t)); }
typedef int i32x8 __attribute__((ext_vector_type(8)));
template <bool F8> __device__ __forceinline__ f32x4 mma_tile(const bf16x8 (&bfr)[2], const bf16x8 (&afr)[2], f32x4 acc) {
    if constexpr (F8) {
        typedef int i32x4_ __attribute__((ext_vector_type(4)));
        const i32x4_ b0 = __builtin_bit_cast(i32x4_, bfr[0]), b1 = __builtin_bit_cast(i32x4_, bfr[1]), a0 = __builtin_bit_cast(i32x4_, afr[0]), a1 = __builtin_bit_cast(i32x4_, afr[1]);
        const i32x8 bb = {b0[0], b0[1], b0[2], b0[3], b1[0], b1[1], b1[2], b1[3]}, aa = {a0[0], a0[1], a0[2], a0[3], a1[0], a1[1], a1[2], a1[3]};
        const int sc1 = 0x7f7f7f7f;
        asm volatile("v_mfma_scale_f32_16x16x128_f8f6f4 %0, %1, %2, %0, %3, %3 op_sel_hi:[0,0,0]" : "+v"(acc) : "v"(bb), "v"(aa), "v"(sc1));
        return acc;
    } else {
        acc = __builtin_amdgcn_mfma_f32_16x16x32_bf16(bfr[0], afr[0], acc, 0, 0, 0);
        return __builtin_amdgcn_mfma_f32_16x16x32_bf16(bfr[1], afr[1], acc, 0, 0, 0);
    }
}
template <class Epi, class Sched, bool STAMP = false, bool F8 = false, bool GATHER = false>
__device__ __forceinline__ void gemm_phase(PG8_LAS unsigned char* lds, const Gemm g, const Sched& S, const Epi& E, unsigned long long* stamps) {
    const int tid = ::tidx(), wid = __builtin_amdgcn_readfirstlane(tid >> 6), lane = tid & 63, wr = wid >> 2, wc = wid & 3, fr = lane & 15, fq = lane >> 4;
    const int K = g.K, nt = K / BK;
    int ts_lo = 0, ts_hi = 0, nts = 0; const unsigned long long rt_entry = STAMP ? (unsigned long long)wall_clock64() : 0ull;
#define PG8_STAMP() do { if (STAMP && wid == 0 && nts < 64) { const unsigned long long _c = (unsigned long long)clock64(); \
        ts_lo = (lane == nts) ? (int)(unsigned)_c : ts_lo; ts_hi = (lane == nts) ? (int)(unsigned)(_c >> 32) : ts_hi; ++nts; } } while (0)
    PG8_STAMP();
    unsigned voffA[2], voffB[2]; int rA[2]; unsigned c2A[2];
#pragma unroll
    for (int i = 0; i < 2; ++i) { int R, C; stage_rc(tid * 16 + i * 8192, R, C); const int Rb = Epi::PERM ? ((R & ~31) + perm32(R & 31)) : R;
        voffA[i] = (unsigned)(R * K + C) * 2u; voffB[i] = (unsigned)(Rb * K + C) * 2u; rA[i] = R; c2A[i] = (unsigned)C * 2u; }
    unsigned gaC[2][2], gaN[2][2];
#define PG8_GATHER_OFFS(dst, pm_) do { _Pragma("unroll") for (int _h = 0; _h < 2; ++_h) _Pragma("unroll") for (int _i = 0; _i < 2; ++_i) \
        dst[_h][_i] = (unsigned)g.rowidx[(pm_) * BM + _h * HALF + rA[_i]] * (unsigned)(K * 2) + c2A[_i]; } while (0)
#define PG8_STAGE_A(bufoff, base, half, usenext) do { if constexpr (GATHER) { unsigned _v[2]; _v[0] = (usenext) ? gaN[half][0] : gaC[half][0]; _v[1] = (usenext) ? gaN[half][1] : gaC[half][1]; PG8_STAGE(bufoff, base, _v); } \
        else PG8_STAGE(bufoff, (base) + (half) * hstep, voffA); } while (0)
    const size_t kstep = (size_t)(BK * 2);
    const size_t hstep = (size_t)HALF * K * 2;
    const size_t tstep = 2 * hstep;
    const unsigned ldsw = (unsigned)wid * 1024u;
    const int aoff = lds_byte(wr * 64 + fr, fq * 8), boff = lds_byte(wc * 32 + fr, fq * 8);
#define PG8_SA(b, h) (((b) * 2 + (h)) * HTB)
#define PG8_SB(b, h) ((4 + (b) * 2 + (h)) * HTB)
#define PG8_STAGE(bufoff, gbase, voff) do { _Pragma("unroll") for (int _i = 0; _i < 2; ++_i) \
        __builtin_amdgcn_global_load_lds((const unsigned*)((const char*)(gbase) + (voff)[_i]), (PG8_LAS unsigned*)(lds + (bufoff) + ldsw + _i * 8192), 16, 0, 0); } while (0)
#define PG8_LDA(dst, b, h) do { _Pragma("unroll") for (int m = 0; m < 4; ++m) _Pragma("unroll") for (int k = 0; k < 2; ++k) dst[m][k] = *(const PG8_LAS bf16x8*)(lds + PG8_SA(b, h) + aoff + m * 2048 + k * 1024); } while (0)
#define PG8_LDB(dst, b, h) do { _Pragma("unroll") for (int n = 0; n < 2; ++n) _Pragma("unroll") for (int k = 0; k < 2; ++k) dst[n][k] = *(const PG8_LAS bf16x8*)(lds + PG8_SB(b, h) + boff + n * 2048 + k * 1024); } while (0)
#define PG8_MMA(ai, bj, At, Bt) do { __builtin_amdgcn_s_setprio(1); _Pragma("unroll") for (int m = 0; m < 4; ++m) _Pragma("unroll") for (int n = 0; n < 2; ++n) \
        acc[ai][bj][m][n] = mma_tile<F8>(Bt[n], At[m], acc[ai][bj][m][n]); __builtin_amdgcn_s_setprio(0); } while (0)
#define PG8_WAIT_V(n) asm volatile("s_waitcnt vmcnt(" #n ")" ::: "memory")
#define PG8_WAIT_L(n) asm volatile("s_waitcnt lgkmcnt(" #n ")" ::: "memory")
#define PG8_BAR __builtin_amdgcn_s_barrier()
#define PG8_SCHED __builtin_amdgcn_sched_barrier(0)
    Unit cur, nxt; int ui = 0;
    if (!S.next(0, cur)) return;
    f32x4 acc[2][2][4][2];
#pragma unroll
    for (int a = 0; a < 2; ++a)
#pragma unroll
        for (int b = 0; b < 2; ++b)
#pragma unroll
            for (int m = 0; m < 4; ++m)
#pragma unroll
                for (int n = 0; n < 2; ++n) acc[a][b][m][n] = (f32x4){0.f, 0.f, 0.f, 0.f};
    bf16x8 At[4][2], B0[2][2], B1[2][2];
    const char* cA = GATHER ? (const char*)g.A : (const char*)g.A + (size_t)cur.pm * tstep; const char* cB = (const char*)g.Bt + (size_t)cur.pn * tstep;
    if constexpr (GATHER) { PG8_GATHER_OFFS(gaC, cur.pm); _Pragma("unroll") for (int _h = 0; _h < 2; ++_h) _Pragma("unroll") for (int _i = 0; _i < 2; ++_i) gaN[_h][_i] = gaC[_h][_i]; }
    S.a_ready(cur);
    PG8_STAGE(PG8_SB(0, 0), cB, voffB); PG8_STAGE_A(PG8_SA(0, 0), cA, 0, false); PG8_STAGE(PG8_SB(0, 1), cB + hstep, voffB); PG8_STAGE_A(PG8_SA(0, 1), cA, 1, false);
    if (wr == 1) PG8_BAR;
    PG8_WAIT_V(4); PG8_BAR;
    PG8_STAGE(PG8_SB(1, 0), cB + kstep, voffB); PG8_STAGE_A(PG8_SA(1, 0), cA + kstep, 0, false); PG8_STAGE(PG8_SB(1, 1), cB + hstep + kstep, voffB);
    PG8_WAIT_V(6); PG8_BAR;
    PG8_STAMP();
    for (;;) {
        const bool has_next = S.next(ui + 1, nxt);
        const char* nA = GATHER ? (const char*)g.A : (has_next ? (const char*)g.A + (size_t)nxt.pm * tstep : cA); const char* nB = has_next ? (const char*)g.Bt + (size_t)nxt.pn * tstep : cB;
        if constexpr (GATHER) { if (has_next) PG8_GATHER_OFFS(gaN, nxt.pm); }
        for (int t = 0; t < nt; t += 2) {
            const bool last = (t == nt - 2);
            const char* a1 = cA + (size_t)(t + 1) * kstep;
            const char* a2 = last ? nA : cA + (size_t)(t + 2) * kstep; const char* b2 = last ? nB : cB + (size_t)(t + 2) * kstep;
            const char* a3 = a2 + kstep; const char* b3 = b2 + kstep;
            if (last && has_next) S.a_ready(nxt);
            PG8_LDB(B0, 0, 0); PG8_SCHED; PG8_LDA(At, 0, 0); PG8_STAGE_A(PG8_SA(1, 1), a1, 1, false);
            PG8_WAIT_L(8); PG8_BAR; PG8_WAIT_L(0); PG8_MMA(0, 0, At, B0); PG8_BAR; PG8_SCHED;
            PG8_LDB(B1, 0, 1); PG8_STAGE(PG8_SB(0, 0), b2, voffB);
            PG8_BAR; PG8_WAIT_L(0); PG8_MMA(0, 1, At, B1); PG8_BAR;
            PG8_LDA(At, 0, 1); PG8_STAGE_A(PG8_SA(0, 0), a2, 0, last);
            PG8_BAR; PG8_WAIT_L(0); PG8_MMA(1, 0, At, B0); PG8_BAR; PG8_SCHED;
            PG8_STAGE(PG8_SB(0, 1), b2 + hstep, voffB);
            PG8_WAIT_V(6); PG8_BAR; PG8_MMA(1, 1, At, B1); PG8_BAR;
            PG8_LDB(B0, 1, 0); PG8_SCHED; PG8_LDA(At, 1, 0); PG8_STAGE_A(PG8_SA(0, 1), a2, 1, last);
            PG8_WAIT_L(8); PG8_BAR; PG8_WAIT_L(0); PG8_MMA(0, 0, At, B0); PG8_BAR; PG8_SCHED;
            PG8_LDB(B1, 1, 1); PG8_STAGE(PG8_SB(1, 0), b3, voffB);
            PG8_BAR; PG8_WAIT_L(0); PG8_MMA(0, 1, At, B1); PG8_BAR;
            PG8_LDA(At, 1, 1); PG8_STAGE_A(PG8_SA(1, 0), a3, 0, last);
            PG8_BAR; PG8_WAIT_L(0); PG8_MMA(1, 0, At, B0); PG8_BAR; PG8_SCHED;
            PG8_STAGE(PG8_SB(1, 1), b3 + hstep, voffB);
            PG8_WAIT_V(6); PG8_BAR; PG8_MMA(1, 1, At, B1); PG8_BAR;
        }
        PG8_STAMP();
        if constexpr (!Epi::AFTER_DRAIN) { E(acc, cur, wr, wc, fr, fq); S.done(cur); }
        PG8_STAMP();
        if (!has_next) break;
#pragma unroll
        for (int a = 0; a < 2; ++a)
#pragma unroll
            for (int b = 0; b < 2; ++b)
#pragma unroll
                for (int m = 0; m < 4; ++m)
#pragma unroll
                    for (int n = 0; n < 2; ++n) acc[a][b][m][n] = (f32x4){0.f, 0.f, 0.f, 0.f};
        cur = nxt; cA = nA; cB = nB; ++ui;
        if constexpr (GATHER) { _Pragma("unroll") for (int _h = 0; _h < 2; ++_h) _Pragma("unroll") for (int _i = 0; _i < 2; ++_i) gaC[_h][_i] = gaN[_h][_i]; }
    }
    PG8_WAIT_V(0);
    if (wr == 0) PG8_BAR;
    PG8_BAR;
    if constexpr (Epi::AFTER_DRAIN) { E.fused(acc, cur, wr, wc, fr, fq, lds, wid, lane); S.done(cur); }
    PG8_STAMP();
    if (STAMP && wid == 0) { stamps[lane] = lane < nts ? (((unsigned long long)(unsigned)ts_hi << 32) | (unsigned)ts_lo) : 0ull;
        if (lane == 62) stamps[62] = rt_entry; if (lane == 63) stamps[63] = (unsigned long long)wall_clock64(); }
#undef PG8_STAMP
#undef PG8_SA
#undef PG8_SB
#undef PG8_STAGE
#undef PG8_STAGE_A
#undef PG8_GATHER_OFFS
#undef PG8_LDA
#undef PG8_LDB
#undef PG8_MMA
#undef PG8_WAIT_V
#undef PG8_WAIT_L
#undef PG8_BAR
#undef PG8_SCHED
}
}


namespace {
using pg8::bf16_t; using pg8::f32x4;
constexpr int D = 1024, NB = 2, S = 8192, T = NB * S;
constexpr int EVEN_IN = 2304, ODD_IN = 2944, ODD_PAD = 3072, FD = 1920;
constexpr int MEM = 256, NE = 16, CAP = 1024, DE = 2816;
constexpr int NTH = 512;
constexpr size_t MiB = 1u << 20;
constexpr size_t WS_CTL = 0, CTL_BYTES = 1 * MiB;
constexpr size_t WS_ROPE = 1 * MiB;
constexpr size_t WS_AFF = 4 * MiB;
constexpr size_t WS_TOK = 5 * MiB;
constexpr size_t WS_GATE = 6 * MiB;
constexpr size_t WS_WRT = 3 * MiB;
constexpr size_t WS_SLOT = 7 * MiB;
constexpr size_t WS_X = 8 * MiB;
constexpr size_t WS_H = 72 * MiB;
constexpr size_t WS_Y = 104 * MiB;
constexpr size_t WS_P = 136 * MiB;
constexpr size_t WS_Q = 320 * MiB;
constexpr size_t WS_KV = 384 * MiB;
constexpr size_t WS_MN = 388 * MiB;
constexpr size_t WS_SSP = 390 * MiB;
constexpr size_t WS_DEC = 392 * MiB;
constexpr size_t WS_KD = 456 * MiB;
constexpr size_t WS_BB = 520 * MiB;
constexpr size_t WS_KK = 584 * MiB;
constexpr size_t WS_G = 616 * MiB;
constexpr size_t WS_YS = 648 * MiB;
constexpr size_t WS_RV = 712 * MiB;
constexpr size_t WS_VN = 776 * MiB;
constexpr size_t WS_QHA = 136 * MiB;
constexpr size_t WS_KHA = 152 * MiB;
constexpr size_t WS_QHB = 168 * MiB;
constexpr size_t WS_KHB = 184 * MiB;
constexpr size_t WS_PVB = 188 * MiB;
constexpr size_t WS_VTA = 208 * MiB;
constexpr size_t WS_VTB = 256 * MiB;
constexpr size_t WS_OA = 260 * MiB;
constexpr size_t WS_LSE = 308 * MiB;
constexpr size_t WS_QT = 136 * MiB;
constexpr size_t WS_YL = 200 * MiB;
constexpr size_t WS_PT = 264 * MiB;
constexpr size_t WS_RH = 296 * MiB;
constexpr size_t WS_S0 = 328 * MiB;
constexpr size_t WS_XE = 136 * MiB;
constexpr size_t WS_YE = 136 * MiB;
constexpr size_t WS_HID = 200 * MiB;
constexpr size_t WS_KB = 360 * MiB;
constexpr size_t WS_F5 = 792 * MiB;
constexpr size_t WS_WSB = 804 * MiB;
constexpr size_t WS_WL = 805 * MiB;
constexpr size_t WS_WEIN = 808 * MiB;
constexpr size_t WS_WEOUT = 813 * MiB;
constexpr size_t WS_WOIN = 815 * MiB;
constexpr size_t WS_WOOUT = 821 * MiB;
constexpr size_t WS_WQ = 823 * MiB;
constexpr size_t WS_WKV = 827 * MiB;
constexpr size_t WS_WO = 835 * MiB;
constexpr size_t WS_WGU = 840 * MiB;
constexpr size_t WS_WD = 1192 * MiB;
constexpr size_t WS_WGU8 = 840 * MiB;
constexpr size_t WS_WD8 = 1192 * MiB;
constexpr size_t WS_END = 1368 * MiB;
constexpr bool F8L0 = true;
constexpr float ASC8 = 16.f, GUSC8 = 128.f, HSC8 = 4.f, DSC8 = 256.f;
constexpr int CW_BAR = 4096;

constexpr int LDS_BYTES = 147456;
constexpr int LDS_BAR_OFF = LDS_BYTES - 64;

#define LAS __attribute__((address_space(3)))
#define XB_TMO      128
#define XB_XCNT(j)  (256  + 64 * (j))
#define XB_XSUB(j)  (1280 + 64 * (j))
#define XB_XGEN(j)  (2304 + 64 * (j))
#define XB_TOP      3328
#define XB_TOPGEN   3392
#define XCD_BAR_WORDS 3456
#define XB_SPIN_CAP (1u << 22)
__device__ __forceinline__ unsigned xb_ld(unsigned* p)              { return __hip_atomic_load(p, __ATOMIC_RELAXED, __HIP_MEMORY_SCOPE_AGENT); }
__device__ __forceinline__ unsigned xb_add(unsigned* p, unsigned v) { return __hip_atomic_fetch_add(p, v, __ATOMIC_RELAXED, __HIP_MEMORY_SCOPE_AGENT); }
__device__ __forceinline__ unsigned xb_xcc_id() { return (unsigned)__builtin_amdgcn_s_getreg((3 << 11) | 20) & 0xFu; }
#define XB_SPIN(cond, bar) do { unsigned _sp = 0; while (cond) { __builtin_amdgcn_s_sleep(1); \
    if ((++_sp & 255u) == 0u) { if (xb_ld(&(bar)[XB_TMO])) break; if (_sp > XB_SPIN_CAP) { atomicAdd(&(bar)[XB_TMO], 1u); break; } } } } while (0)
struct XcdBarrier { unsigned* bar; unsigned x; volatile LAS unsigned* st; };
__device__ __forceinline__ XcdBarrier xcd_barrier_post(unsigned* bar, volatile LAS unsigned* st) {
    XcdBarrier b; b.bar = bar; b.x = xb_xcc_id(); b.st = st;
    if (threadIdx.x == 0) (void)xb_add(&bar[XB_XCNT(b.x)], 1u);
    return b;
}
__device__ __forceinline__ void xcd_barrier_complete(unsigned* bar, unsigned x, unsigned& nloc, unsigned& nx) {
    const unsigned G = gridDim.x * gridDim.y * gridDim.z;
    unsigned sum, cnt, mine, sp = 0u;
    for (;;) {
        sum = 0u; cnt = 0u; mine = 0u;
#pragma unroll
        for (unsigned j = 0; j < 16; ++j) { const unsigned c = xb_ld(&bar[XB_XCNT(j)]); sum += c; cnt += (c > 0u) ? 1u : 0u; mine = (j == x) ? c : mine; }
        if (sum == G) break;
        __builtin_amdgcn_s_sleep(1);
        if ((++sp & 255u) == 0u) { if (xb_ld(&bar[XB_TMO])) break; if (sp > XB_SPIN_CAP) { atomicAdd(&bar[XB_TMO], 1u); break; } }
    }
    nloc = mine > 0u ? mine : 1u; nx = cnt > 0u ? cnt : 1u;
}
__device__ __forceinline__ void xcd_barrier(const XcdBarrier& b) {
    asm volatile("s_waitcnt vmcnt(0)" ::: "memory");
    __syncthreads();
    if (threadIdx.x == 0) {
        unsigned* bar = b.bar;
        __builtin_amdgcn_s_waitcnt(0);
        unsigned nloc = b.st[0], nx = b.st[1];
        if (nloc == 0u) { xcd_barrier_complete(bar, b.x, nloc, nx); b.st[0] = nloc; b.st[1] = nx; }
        const unsigned old = xb_add(&bar[XB_XSUB(b.x)], 1u);
        const unsigned gen = old / nloc;
        if (old + 1u == (gen + 1u) * nloc) {
            __builtin_amdgcn_fence(__ATOMIC_RELEASE, "agent");
            asm volatile("s_waitcnt vmcnt(0)" ::: "memory");
            const unsigned og = xb_add(&bar[XB_TOP], 1u);
            const unsigned tg = og / nx;
            if (og + 1u == (tg + 1u) * nx) xb_add(&bar[XB_TOPGEN], 1u);
            else XB_SPIN(xb_ld(&bar[XB_TOPGEN]) == tg, bar);
            __builtin_amdgcn_fence(__ATOMIC_ACQUIRE, "agent");
            xb_add(&bar[XB_XGEN(b.x)], 1u);
            asm volatile("s_waitcnt vmcnt(0)" ::: "memory");
        } else {
            XB_SPIN(xb_ld(&bar[XB_XGEN(b.x)]) == gen, bar);
            __builtin_amdgcn_fence(__ATOMIC_ACQUIRE, "agent");
            asm volatile("s_waitcnt vmcnt(0)" ::: "memory");
        }
    }
    __syncthreads();
}

__device__ __forceinline__ float wave_sum(float v) {
#pragma unroll
    for (int o = 32; o >= 1; o >>= 1) v += __shfl_xor(v, o);
    return v;
}
__device__ __forceinline__ float frcp(float x) { return __builtin_amdgcn_rcpf(x); }
__device__ __forceinline__ float sigmoidf_(float x) { return frcp(1.0f + __expf(-x)); }
__device__ __forceinline__ float tanhf_(float x) { return 2.0f * sigmoidf_(2.0f * x) - 1.0f; }
__device__ __forceinline__ float gelu_tanh(float x) { return x * sigmoidf_(1.5957691216057308f * (x + 0.044715f * x * x * x)); }
__device__ __forceinline__ unsigned f2bf(float f) { unsigned u = __builtin_bit_cast(unsigned, f); return (u + 0x7fffu + ((u >> 16) & 1u)) >> 16; }
__device__ __forceinline__ unsigned pk2(float lo, float hi) { return pg8::cvt_pk_bf16(lo, hi); }
__device__ __forceinline__ float bflo(unsigned w) { return __uint_as_float(w << 16); }
__device__ __forceinline__ float bfhi(unsigned w) { return __uint_as_float(w & 0xffff0000u); }
typedef unsigned v4u __attribute__((ext_vector_type(4)));
typedef unsigned v2u __attribute__((ext_vector_type(2)));

struct Args { const float* in[35]; float* out; unsigned char* ws; int lo, hi; };

struct EpiF32Store {
    static constexpr bool PERM = false, AFTER_DRAIN = false;
    float* C; int ldc; int nvalid;
    __device__ __forceinline__ void operator()(const f32x4 (&acc)[2][2][4][2], const pg8::Unit& u, int wr, int wc, int fr, int fq) const {
        const int row0 = u.pm * 256 + wr * 64 + fr, col0 = u.pn * 256 + wc * 32 + 4 * fq;
#pragma unroll
        for (int ai = 0; ai < 2; ++ai)
#pragma unroll
            for (int m = 0; m < 4; ++m) { float* rowp = C + (size_t)(row0 + ai * 128 + m * 16) * ldc + col0;
#pragma unroll
                for (int bj = 0; bj < 2; ++bj)
#pragma unroll
                    for (int n = 0; n < 2; ++n) if (col0 + bj * 128 + n * 16 < nvalid) *(f32x4*)(rowp + bj * 128 + n * 16) = acc[ai][bj][m][n]; }
    }
};
struct EpiResid {
    static constexpr bool PERM = false, AFTER_DRAIN = false;
    const float* base; float* out;
    __device__ __forceinline__ void operator()(const f32x4 (&acc)[2][2][4][2], const pg8::Unit& u, int wr, int wc, int fr, int fq) const {
        const int row0 = u.pm * 256 + wr * 64 + fr, col0 = u.pn * 256 + wc * 32 + 4 * fq;
#pragma unroll
        for (int ai = 0; ai < 2; ++ai)
#pragma unroll
            for (int m = 0; m < 4; ++m) { const size_t off = (size_t)(row0 + ai * 128 + m * 16) * D + col0;
#pragma unroll
                for (int bj = 0; bj < 2; ++bj)
#pragma unroll
                    for (int n = 0; n < 2; ++n) { const f32x4 b = *(const f32x4*)(base + off + bj * 128 + n * 16); *(f32x4*)(out + off + bj * 128 + n * 16) = b + acc[ai][bj][m][n]; } }
    }
};
struct EpiSiluMul {
    static constexpr bool PERM = false, AFTER_DRAIN = false;
    bf16_t* HIDp;
    __device__ __forceinline__ void operator()(const f32x4 (&acc)[2][2][4][2], const pg8::Unit& u, int wr, int wc, int fr, int fq) const {
        const int pnl = u.pn % 22;
        const int row0 = u.pm * 256 + wr * 64 + fr, col0 = pnl * 128 + wc * 32 + 4 * fq;
#pragma unroll
        for (int ai = 0; ai < 2; ++ai)
#pragma unroll
            for (int m = 0; m < 4; ++m) { bf16_t* rowp = HIDp + (size_t)(row0 + ai * 128 + m * 16) * DE + col0;
#pragma unroll
                for (int n = 0; n < 2; ++n) { const f32x4 g = acc[ai][0][m][n], up = acc[ai][1][m][n]; float h[4];
#pragma unroll
                    for (int j = 0; j < 4; ++j) h[j] = g[j] * frcp(1.0f + __expf(-g[j])) * up[j];
                    v2u w; w.x = pk2(h[0], h[1]); w.y = pk2(h[2], h[3]); *(v2u*)(rowp + n * 16) = w; } }
    }
};
struct EpiYE {
    static constexpr bool PERM = true, AFTER_DRAIN = false;
    const float* GATE; bf16_t* YE;
    __device__ __forceinline__ void operator()(const f32x4 (&acc)[2][2][4][2], const pg8::Unit& u, int wr, int wc, int fr, int fq) const {
        const int pnl = u.pn & 3;
        const int row0 = u.pm * 256 + wr * 64 + fr, col0 = pnl * 256 + wc * 32 + 8 * fq;
#pragma unroll
        for (int ai = 0; ai < 2; ++ai)
#pragma unroll
            for (int m = 0; m < 4; ++m) { const int row = row0 + ai * 128 + m * 16; const float gt_ = GATE[row]; bf16_t* rowp = YE + (size_t)row * D + col0;
#pragma unroll
                for (int bj = 0; bj < 2; ++bj) { const f32x4 v0 = acc[ai][bj][m][0] * gt_, v1 = acc[ai][bj][m][1] * gt_;
                    v4u w; w.x = pg8::cvt_pk_bf16(v0[0], v0[1]); w.y = pg8::cvt_pk_bf16(v0[2], v0[3]); w.z = pg8::cvt_pk_bf16(v1[0], v1[1]); w.w = pg8::cvt_pk_bf16(v1[2], v1[3]);
                    *(v4u*)(rowp + bj * 128) = w; } }
    }
};
struct EpiBf16Store {
    static constexpr bool PERM = true, AFTER_DRAIN = false;
    bf16_t* O; int ldc; float scale;
    __device__ __forceinline__ void operator()(const f32x4 (&acc)[2][2][4][2], const pg8::Unit& u, int wr, int wc, int fr, int fq) const {
        const int row0 = u.pm * 256 + wr * 64 + fr, col0 = u.pn * 256 + wc * 32 + 8 * fq;
#pragma unroll
        for (int ai = 0; ai < 2; ++ai)
#pragma unroll
            for (int m = 0; m < 4; ++m) { bf16_t* rowp = O + (size_t)(row0 + ai * 128 + m * 16) * ldc + col0;
#pragma unroll
                for (int bj = 0; bj < 2; ++bj) { const f32x4 v0 = acc[ai][bj][m][0] * scale, v1 = acc[ai][bj][m][1] * scale;
                    v4u w; w.x = pg8::cvt_pk_bf16(v0[0], v0[1]); w.y = pg8::cvt_pk_bf16(v0[2], v0[3]); w.z = pg8::cvt_pk_bf16(v1[0], v1[1]); w.w = pg8::cvt_pk_bf16(v1[2], v1[3]);
                    *(v4u*)(rowp + bj * 128) = w; } }
    }
};
struct EpiKV {
    static constexpr bool PERM = false, AFTER_DRAIN = false;
    bf16_t* K; bf16_t* Vt;
    __device__ __forceinline__ void operator()(const f32x4 (&acc)[2][2][4][2], const pg8::Unit& u, int wr, int wc, int fr, int fq) const {
        const int row0 = u.pm * 256 + wr * 64 + fr, col0 = u.pn * 256 + wc * 32 + 4 * fq;
#pragma unroll
        for (int ai = 0; ai < 2; ++ai)
#pragma unroll
            for (int m = 0; m < 4; ++m) { const int row = row0 + ai * 128 + m * 16;
#pragma unroll
                for (int bj = 0; bj < 2; ++bj)
#pragma unroll
                    for (int n = 0; n < 2; ++n) { const int col = col0 + bj * 128 + n * 16; const f32x4 v = acc[ai][bj][m][n];
                        if (col < 1024) { v2u w; w.x = pk2(v[0], v[1]); w.y = pk2(v[2], v[3]); *(v2u*)(K + (size_t)row * 1024 + col) = w; }
                        else { const int b = row >> 8, mm = row & 255; bf16_t* vp = Vt + ((size_t)(b * 1024 + (col - 1024)) * 256 + mm);
#pragma unroll
                            for (int j = 0; j < 4; ++j) vp[(size_t)j * 256] = (bf16_t)f2bf(v[j]); } } }
    }
};

constexpr float QSCALE = 0.125f * 1.4426950408889634f;
struct EpiEven {
    static constexpr bool PERM = true, AFTER_DRAIN = false;
    const float* rc; const float* rs; bf16_t* QhA; bf16_t* KhA; bf16_t* QhB; bf16_t* KhB; bf16_t* VhA; bf16_t* VhB;
    __device__ __forceinline__ void operator()(const f32x4 (&acc)[2][2][4][2], const pg8::Unit& u, int wr, int wc, int fr, int fq) const {
        asm volatile("" : "+v"(fr), "+v"(fq));
        const int row0 = u.pm * 256 + wr * 64 + fr;
#pragma unroll
        for (int bj = 0; bj < 2; ++bj) {
            const int c0 = u.pn * 256 + bj * 128 + wc * 32 + 8 * fq;
            int kind; bf16_t* base; int stride; float sc = 1.0f;
            if (c0 < 512) { kind = 0; base = QhA + ((size_t)(c0 >> 6) * T) * 64 + (c0 & 63); stride = 64; sc = QSCALE; }
            else if (c0 < 1024) { kind = 0; base = KhA + ((size_t)((c0 - 512) >> 6) * T) * 64 + (c0 & 63); stride = 64; }
            else if (c0 < 1536) { kind = 1; base = VhA + ((size_t)((c0 - 1024) >> 6) * T) * 64 + (c0 & 63); stride = 64; }
            else if (c0 < 2048) { kind = 0; base = QhB + ((size_t)((c0 - 1536) >> 6) * T) * 64 + (c0 & 63); stride = 64; sc = QSCALE; }
            else if (c0 < 2176) { kind = 0; base = KhB + ((size_t)((c0 - 2048) >> 6) * T) * 64 + (c0 & 63); stride = 64; }
            else { kind = 1; base = VhB + ((size_t)((c0 - 2176) >> 6) * T) * 64 + (c0 & 63); stride = 64; }
            const int pi = (c0 & 63) >> 1;
#pragma unroll
            for (int ai = 0; ai < 2; ++ai)
#pragma unroll
                for (int m = 0; m < 4; ++m) {
                    const int tok = row0 + ai * 128 + m * 16;
                    const f32x4 v0 = acc[ai][bj][m][0], v1 = acc[ai][bj][m][1];
                    float y[8];
                    if (kind == 0) {
                        const int s = tok & (S - 1);
                        const f32x4 c4 = *(const f32x4*)(rc + s * 32 + pi), s4 = *(const f32x4*)(rs + s * 32 + pi);
                        y[0] = (v0[0] * c4[0] - v0[1] * s4[0]) * sc; y[1] = (v0[1] * c4[0] + v0[0] * s4[0]) * sc;
                        y[2] = (v0[2] * c4[1] - v0[3] * s4[1]) * sc; y[3] = (v0[3] * c4[1] + v0[2] * s4[1]) * sc;
                        y[4] = (v1[0] * c4[2] - v1[1] * s4[2]) * sc; y[5] = (v1[1] * c4[2] + v1[0] * s4[2]) * sc;
                        y[6] = (v1[2] * c4[3] - v1[3] * s4[3]) * sc; y[7] = (v1[3] * c4[3] + v1[2] * s4[3]) * sc;
                    } else { y[0] = v0[0]; y[1] = v0[1]; y[2] = v0[2]; y[3] = v0[3]; y[4] = v1[0]; y[5] = v1[1]; y[6] = v1[2]; y[7] = v1[3]; }
                    v4u w; w.x = pk2(y[0], y[1]); w.y = pk2(y[2], y[3]); w.z = pk2(y[4], y[5]); w.w = pk2(y[6], y[7]);
                    *(v4u*)(base + (size_t)tok * stride) = w;
                }
        }
    }
};

struct EpiLora {
    static constexpr bool PERM = false, AFTER_DRAIN = false;
    const float *w0, *a0, *k_a; const bf16_t *KB, *KK; bf16_t *LW, *KD, *BB, *G;
    __device__ __forceinline__ void operator()(const f32x4 (&acc)[2][2][4][2], const pg8::Unit& u, int wr, int wc, int fr, int fq) const {
        asm volatile("" : "+v"(fr), "+v"(fq));
        const int row0 = u.pm * 256 + wr * 64 + fr;
#pragma unroll
        for (int bj = 0; bj < 2; ++bj)
#pragma unroll
            for (int n = 0; n < 2; ++n) {
                const int c0 = u.pn * 256 + bj * 128 + wc * 32 + n * 16 + 4 * fq, sec = c0 >> 9, cc = c0 & 511;
#pragma unroll
                for (int ai = 0; ai < 2; ++ai)
#pragma unroll
                    for (int m = 0; m < 4; ++m) {
                        const size_t tok = row0 + ai * 128 + m * 16;
                        const f32x4 v = acc[ai][bj][m][n];
                        if (sec < 2) {
                            const f32x4 w = *(const f32x4*)(w0 + sec * 512 + cc); float o[4];
#pragma unroll
                            for (int j = 0; j < 4; ++j) { const float xw = -(w[j] + v[j]);
                                o[j] = -0.6065306597126334f * frcp(1.0f + __expf(xw)); }
                            v2u ww; ww.x = pk2(o[0], o[1]); ww.y = pk2(o[2], o[3]);
                            *(v2u*)(LW + ((size_t)sec * T + tok) * 512 + cc) = ww;
                        } else if (sec < 4) {
                            const int d = sec - 2;
                            const f32x4 a_ = *(const f32x4*)(a0 + d * 512 + cc), ka = *(const f32x4*)(k_a + cc);
                            const v2u kw = *(const v2u*)(KB + tok * 512 + cc), kkw = *(const v2u*)(KK + tok * 512 + cc);
                            const float kv[4] = {bflo(kw.x), bfhi(kw.x), bflo(kw.y), bfhi(kw.y)}, kk[4] = {bflo(kkw.x), bfhi(kkw.x), bflo(kkw.y), bfhi(kkw.y)};
                            float okd[4], obb[4];
#pragma unroll
                            for (int j = 0; j < 4; ++j) { const float alr = frcp(1.0f + __expf(-(a_[j] + v[j]))); okd[j] = kv[j] * (1.0f + (alr - 1.0f) * ka[j]); obb[j] = kk[j] * alr; }
                            v2u w1, w2_; w1.x = pk2(okd[0], okd[1]); w1.y = pk2(okd[2], okd[3]); w2_.x = pk2(obb[0], obb[1]); w2_.y = pk2(obb[2], obb[3]);
                            *(v2u*)(KD + ((size_t)d * T + tok) * 512 + cc) = w1; *(v2u*)(BB + ((size_t)d * T + tok) * 512 + cc) = w2_;
                        } else { v2u ww; ww.x = pk2(v[0], v[1]); ww.y = pk2(v[2], v[3]); *(v2u*)(G + tok * 512 + cc) = ww; }
                        __builtin_amdgcn_sched_barrier(0);
                    }
            }
    }
};

__device__ __forceinline__ float clamp8(float x) { return __builtin_amdgcn_fmed3f(x, -448.f, 448.f); }
__device__ __forceinline__ unsigned pk4_fp8(float a, float b, float c, float d) {
    int w = 0; w = __builtin_amdgcn_cvt_pk_fp8_f32(clamp8(a), clamp8(b), w, false); w = __builtin_amdgcn_cvt_pk_fp8_f32(clamp8(c), clamp8(d), w, true); return (unsigned)w;
}
struct EpiSiluMul8 {
    static constexpr bool PERM = true, AFTER_DRAIN = false;
    unsigned char* HIDp;
    __device__ __forceinline__ void operator()(const f32x4 (&acc)[2][2][4][2], const pg8::Unit& u, int wr, int wc, int fr, int fq) const {
        asm volatile("s_nop 7\n\ts_nop 7\n\ts_nop 7"); __builtin_amdgcn_sched_barrier(0);
        const int pnl = u.pn % 22;
        const int row0 = u.pm * 256 + wr * 64 + fr, col0 = pnl * 128 + wc * 32 + 8 * fq;
        const float s1 = 1.0f / (ASC8 * GUSC8);
#pragma unroll
        for (int ai = 0; ai < 2; ++ai)
#pragma unroll
            for (int m = 0; m < 4; ++m) { unsigned char* rowp = HIDp + (size_t)(row0 + ai * 128 + m * 16) * DE + col0; float h[8];
#pragma unroll
                for (int n = 0; n < 2; ++n) { const f32x4 g = acc[ai][0][m][n] * s1, up = acc[ai][1][m][n] * (s1 * HSC8);
#pragma unroll
                    for (int j = 0; j < 4; ++j) h[4 * n + j] = g[j] * frcp(1.0f + __expf(-g[j])) * up[j]; }
                v2u w; w.x = pk4_fp8(h[0], h[1], h[2], h[3]); w.y = pk4_fp8(h[4], h[5], h[6], h[7]);
                __builtin_nontemporal_store(w, (v2u*)rowp); }
    }
};
struct EpiYE8 {
    static constexpr bool PERM = true, AFTER_DRAIN = false;
    const float* GATE; bf16_t* YE;
    __device__ __forceinline__ void operator()(const f32x4 (&acc)[2][2][4][2], const pg8::Unit& u, int wr, int wc, int fr, int fq) const {
        asm volatile("s_nop 7\n\ts_nop 7\n\ts_nop 7"); __builtin_amdgcn_sched_barrier(0);
        const int pnl = u.pn & 3;
        const int row0 = u.pm * 256 + wr * 64 + fr, col0 = pnl * 256 + wc * 32 + 8 * fq;
#pragma unroll
        for (int ai = 0; ai < 2; ++ai)
#pragma unroll
            for (int m = 0; m < 4; ++m) { const int row = row0 + ai * 128 + m * 16; const float gt_ = GATE[row] * (1.0f / (HSC8 * DSC8)); bf16_t* rowp = YE + (size_t)row * D + col0;
#pragma unroll
                for (int bj = 0; bj < 2; ++bj) { const f32x4 v0 = acc[ai][bj][m][0] * gt_, v1 = acc[ai][bj][m][1] * gt_;
                    v4u w; w.x = pk2(v0[0], v0[1]); w.y = pk2(v0[2], v0[3]); w.z = pk2(v1[0], v1[1]); w.w = pk2(v1[2], v1[3]);
                    *(v4u*)(rowp + bj * 128) = w; } }
    }
};
template <class RowMap>
__device__ __forceinline__ void transpose_item_fp8(const float* W, int K, int N, unsigned char* WT, RowMap rm, float sc, LAS float* scr, int item, int lane) {
    const int nblk = N / 64, kb = item / nblk, nb_ = item % nblk, k0 = 64 * kb, n0 = 64 * nb_;
    f32x4 ld[16];
#pragma unroll
    for (int i = 0; i < 16; ++i) ld[i] = *(const f32x4*)(W + (size_t)(k0 + 4 * i + (lane >> 4)) * N + n0 + 4 * (lane & 15));
#pragma unroll
    for (int i = 0; i < 16; ++i) { LAS float* p = scr + (4 * i + (lane >> 4)) * 65 + 4 * (lane & 15); p[0] = ld[i][0]; p[1] = ld[i][1]; p[2] = ld[i][2]; p[3] = ld[i][3]; }
    asm volatile("s_waitcnt lgkmcnt(0)" ::: "memory");
    const int c = lane & 3;
#pragma unroll
    for (int j = 0; j < 4; ++j) { const int n = (lane >> 2) + 16 * j; const LAS float* s = scr + (16 * c) * 65 + n;
        v4u o;
#pragma unroll
        for (int q = 0; q < 4; ++q) o[q] = pk4_fp8(s[(4 * q) * 65] * sc, s[(4 * q + 1) * 65] * sc, s[(4 * q + 2) * 65] * sc, s[(4 * q + 3) * 65] * sc);
        *(v4u*)(WT + (size_t)rm(n0 + n) * K + k0 + 16 * c) = o; }
    asm volatile("s_waitcnt lgkmcnt(0)" ::: "memory");
}

struct EpiResidN {
    static constexpr bool PERM = false, AFTER_DRAIN = false;
    const float* base; float* out; bf16_t* Xb; float* SSP;
    __device__ __forceinline__ void operator()(const f32x4 (&acc)[2][2][4][2], const pg8::Unit& u, int wr, int wc, int fr, int fq) const {
        asm volatile("" : "+v"(fr), "+v"(fq));
        const int row0 = u.pm * 256 + wr * 64 + fr, col0 = u.pn * 256 + wc * 32 + 4 * fq;
#pragma unroll
        for (int ai = 0; ai < 2; ++ai)
#pragma unroll
            for (int m = 0; m < 4; ++m) { const size_t row = row0 + ai * 128 + m * 16; const size_t off = row * D + col0; float ss = 0.f;
#pragma unroll
                for (int bj = 0; bj < 2; ++bj)
#pragma unroll
                    for (int n = 0; n < 2; ++n) { const f32x4 b = *(const f32x4*)(base + off + bj * 128 + n * 16); const f32x4 o = b + acc[ai][bj][m][n];
                        *(f32x4*)(out + off + bj * 128 + n * 16) = o;
                        v2u w; w.x = pk2(o[0], o[1]); w.y = pk2(o[2], o[3]); *(v2u*)(Xb + off + bj * 128 + n * 16) = w;
                        ss += (o[0] * o[0] + o[1] * o[1]) + (o[2] * o[2] + o[3] * o[3]); }
                ss += __shfl_xor(ss, 16); ss += __shfl_xor(ss, 32);
                if (fq == 0) SSP[row * 16 + u.pn * 4 + wc] = ss; }
    }
};
struct EpiBf16StoreRS {
    static constexpr bool PERM = true, AFTER_DRAIN = false;
    bf16_t* O; int ldc; const float* SSP;
    __device__ __forceinline__ void operator()(const f32x4 (&acc)[2][2][4][2], const pg8::Unit& u, int wr, int wc, int fr, int fq) const {
        asm volatile("" : "+v"(fr), "+v"(fq));
        const int row0 = u.pm * 256 + wr * 64 + fr, col0 = u.pn * 256 + wc * 32 + 8 * fq;
#pragma unroll
        for (int ai = 0; ai < 2; ++ai)
#pragma unroll
            for (int m = 0; m < 4; ++m) { const size_t row = row0 + ai * 128 + m * 16;
                const f32x4* sp = (const f32x4*)(SSP + row * 16); const f32x4 s0 = sp[0], s1 = sp[1], s2 = sp[2], s3 = sp[3];
                const float ss = (((s0[0] + s0[1]) + (s0[2] + s0[3])) + ((s1[0] + s1[1]) + (s1[2] + s1[3]))) + (((s2[0] + s2[1]) + (s2[2] + s2[3])) + ((s3[0] + s3[1]) + (s3[2] + s3[3])));
                const float rs = rsqrtf(ss * (1.0f / D) + 1e-6f);
                bf16_t* rowp = O + row * ldc + col0;
#pragma unroll
                for (int bj = 0; bj < 2; ++bj) { const f32x4 v0 = acc[ai][bj][m][0] * rs, v1 = acc[ai][bj][m][1] * rs;
                    v4u w; w.x = pk2(v0[0], v0[1]); w.y = pk2(v0[2], v0[3]); w.z = pk2(v1[0], v1[1]); w.w = pk2(v1[2], v1[3]);
                    *(v4u*)(rowp + bj * 128) = w; } }
    }
};
struct MoeOrder {
    int G, c, npairs;
    int per;
    __device__ __forceinline__ bool next(int i, pg8::Unit& u) const {
        const int x = c & 7, y = c >> 3, pml = y & 7, pnq = y >> 3;
        const int epn = i * 32 + x * 4 + pnq;
        if (epn >= npairs || c >= 256) return false;
        const int e = epn / per;
        u.pm = e * 8 + pml; u.pn = epn; return true;
    }
    __device__ __forceinline__ void a_ready(const pg8::Unit&) const {}
    __device__ __forceinline__ void done(const pg8::Unit&) const {}
};

struct XattnOrder {
    int c;
    __device__ __forceinline__ bool next(int i, pg8::Unit& u) const { if (i != 0 || c >= 256) return false; u.pm = (c >> 7) * 32 + (c & 31); u.pn = (c >> 5) & 3; return true; }
    __device__ __forceinline__ void a_ready(const pg8::Unit&) const {}
    __device__ __forceinline__ void done(const pg8::Unit&) const {}
};
template <class RowMap>
__device__ __forceinline__ void transpose_item(const float* W, int K, int N, bf16_t* WT, RowMap rm, LAS float* scr, int item, int lane, const float* kscale = nullptr) {
    const int nblk = N / 64, kb = item / nblk, nb_ = item % nblk, k0 = 64 * kb, n0 = 64 * nb_;
    f32x4 ld[16];
#pragma unroll
    for (int i = 0; i < 16; ++i) ld[i] = *(const f32x4*)(W + (size_t)(k0 + 4 * i + (lane >> 4)) * N + n0 + 4 * (lane & 15));
#pragma unroll
    for (int i = 0; i < 16; ++i) { LAS float* p = scr + (4 * i + (lane >> 4)) * 65 + 4 * (lane & 15); p[0] = ld[i][0]; p[1] = ld[i][1]; p[2] = ld[i][2]; p[3] = ld[i][3]; }
    asm volatile("s_waitcnt lgkmcnt(0)" ::: "memory");
    const int c = lane & 7;
    float ksc[8];
#pragma unroll
    for (int q = 0; q < 8; ++q) ksc[q] = kscale ? kscale[k0 + 8 * c + q] : 1.0f;
#pragma unroll
    for (int j = 0; j < 8; ++j) { const int n = (lane >> 3) + 8 * j; const LAS float* s = scr + (8 * c) * 65 + n;
        v4u o; o.x = pk2(s[0 * 65] * ksc[0], s[1 * 65] * ksc[1]); o.y = pk2(s[2 * 65] * ksc[2], s[3 * 65] * ksc[3]); o.z = pk2(s[4 * 65] * ksc[4], s[5 * 65] * ksc[5]); o.w = pk2(s[6 * 65] * ksc[6], s[7 * 65] * ksc[7]);
        *(v4u*)(WT + (size_t)rm(n0 + n) * K + k0 + 8 * c) = o; }
    asm volatile("s_waitcnt lgkmcnt(0)" ::: "memory");
}

__device__ __forceinline__ void rmsnorm_rows_bf16(const float* x, const float* g, bf16_t* out, int M) {
    const int tix_ = tidx(); const int lane = tix_ & 63, gw = blockIdx.x * 8 + (tix_ >> 6), ngw = gridDim.x * 8;
    for (int m = gw; m < M; m += ngw) {
        const float4* xr = (const float4*)(x + (size_t)m * D);
        float4 v[4]; float s = 0.f;
#pragma unroll
        for (int j = 0; j < 4; ++j) { v[j] = xr[lane + 64 * j]; s += v[j].x * v[j].x + v[j].y * v[j].y + v[j].z * v[j].z + v[j].w * v[j].w; }
        const float r = rsqrtf(wave_sum(s) * (1.0f / D) + 1e-6f);
        v2u* o = (v2u*)(out + (size_t)m * D);
#pragma unroll
        for (int j = 0; j < 4; ++j) { const float4 gg = ((const float4*)g)[lane + 64 * j];
            v2u w; w.x = pk2(v[j].x * r * gg.x, v[j].y * r * gg.y); w.y = pk2(v[j].z * r * gg.z, v[j].w * r * gg.w); o[lane + 64 * j] = w; }
    }
}
__device__ __forceinline__ void rmsnorm_rows_f32(const float* x, const float* g, float* out, int M) {
    const int tix_ = tidx(); const int lane = tix_ & 63, gw = blockIdx.x * 8 + (tix_ >> 6), ngw = gridDim.x * 8;
    for (int m = gw; m < M; m += ngw) {
        const float4* xr = (const float4*)(x + (size_t)m * D);
        float4 v[4]; float s = 0.f;
#pragma unroll
        for (int j = 0; j < 4; ++j) { v[j] = xr[lane + 64 * j]; s += v[j].x * v[j].x + v[j].y * v[j].y + v[j].z * v[j].z + v[j].w * v[j].w; }
        const float r = rsqrtf(wave_sum(s) * (1.0f / D) + 1e-6f);
        float4* o = (float4*)(out + (size_t)m * D);
#pragma unroll
        for (int j = 0; j < 4; ++j) { const float4 gg = ((const float4*)g)[lane + 64 * j];
            o[lane + 64 * j] = make_float4(v[j].x * r * gg.x, v[j].y * r * gg.y, v[j].z * r * gg.z, v[j].w * r * gg.w); }
    }
}

__device__ __forceinline__ int block_exscan(int v, int* sh, int* tot) {
    const int tid = tidx(), lane = tid & 63, w = tid >> 6;
    int inc = v;
#pragma unroll
    for (int o = 1; o < 64; o <<= 1) { const int t = __shfl_up(inc, o); if (lane >= o) inc += t; }
    __syncthreads();
    if (lane == 63) sh[w] = inc;
    __syncthreads();
    int base = 0, total = 0;
#pragma unroll
    for (int i = 0; i < 8; ++i) { const int x = sh[i]; if (i < w) base += x; total += x; }
    *tot = total;
    return base + inc - v;
}


typedef short bf16x8 __attribute__((ext_vector_type(8)));
typedef float f32x16 __attribute__((ext_vector_type(16)));
constexpr int MROW = 144;
constexpr int MBUF = 64 * MROW;
__device__ __forceinline__ bf16x8 frag_rm(const LAS unsigned char* M, int row0, int k0, int fr, int fq) {
    return *(const LAS bf16x8*)(M + (row0 + fr) * MROW + (k0 + 8 * fq) * 2);
}
__device__ __forceinline__ bf16x8 frag_cm(const LAS unsigned char* M, int k0, int col0, int fr, int fq) {
    const LAS unsigned short* p = (const LAS unsigned short*)(M + (k0 + 8 * fq) * MROW + (col0 + fr) * 2);
    bf16x8 v;
#pragma unroll
    for (int j = 0; j < 8; ++j) v[j] = (short)p[j * (MROW / 2)];
    return v;
}
__device__ __forceinline__ void tile_store_bf16(LAS unsigned char* M, int m0, int n0, int fr, int fq, const f32x4& c) {
    v2u w; w.x = pk2(c[0], c[1]); w.y = pk2(c[2], c[3]);
    *(LAS v2u*)(M + (m0 + fr) * MROW + (n0 + 4 * fq) * 2) = w;
}
#define MMA16(acc, lf, rf) acc = __builtin_amdgcn_mfma_f32_16x16x32_bf16(rf, lf, acc, 0, 0, 0)

__device__ __forceinline__ void tile_store_bf16_T(LAS unsigned char* M, int m0, int n0, int fr, int fq, const f32x4& c) {
    const unsigned w0 = pk2(c[0], c[1]), w1 = pk2(c[2], c[3]);
    LAS unsigned char* p = M + (n0 + 4 * fq) * MROW + (m0 + fr) * 2;
    *(LAS unsigned short*)(p) = (unsigned short)(w0 & 0xffffu); *(LAS unsigned short*)(p + MROW) = (unsigned short)(w0 >> 16);
    *(LAS unsigned short*)(p + 2 * MROW) = (unsigned short)(w1 & 0xffffu); *(LAS unsigned short*)(p + 3 * MROW) = (unsigned short)(w1 >> 16);
}
__device__ __forceinline__ void scan_r1(const bf16_t* LWg, const bf16_t* RVg, const bf16_t* KDg, const bf16_t* KKg, const bf16_t* BBg,
                                        bf16_t* PT, bf16_t* QT, bf16_t* RH, bf16_t* YL, unsigned char* lds_raw) {
    LAS unsigned char* L = (LAS unsigned char*)lds_raw;
#define SL(k) (L + (k) * MBUF)
    LAS float* LWs = (LAS float*)(L + 14 * MBUF);
    const int tid = tidx(), lane = tid & 63, wave = tid >> 6, fr = lane & 15, fq = lane >> 4;
    const int tm = wave >> 1, tn0 = (wave & 1) * 2;
    const int m0 = tm * 16;
    const int t = tid >> 3, i0 = (tid & 7) * 8;
    v4u lw4n, r4n, v4n, kd4n, kk4n, bb4n;
#define R1_LOAD(it_) do { const int c_ = (it_) & 127, h_ = ((it_) >> 7) & 7, n_ = (it_) >> 10, dir_ = n_ >> 1, b_ = n_ & 1; \
        const int pos_ = dir_ ? (S - 1 - (c_ * 64 + t)) : (c_ * 64 + t); const size_t tok_ = (size_t)b_ * S + pos_; const size_t ch_ = (size_t)h_ * 64 + i0; \
        lw4n = *(const v4u*)(LWg + ((size_t)dir_ * T + tok_) * 512 + ch_); r4n = *(const v4u*)(RVg + tok_ * D + ch_); v4n = *(const v4u*)(RVg + tok_ * D + 512 + ch_); \
        kd4n = *(const v4u*)(KDg + ((size_t)dir_ * T + tok_) * 512 + ch_); kk4n = *(const v4u*)(KKg + tok_ * 512 + ch_); bb4n = *(const v4u*)(BBg + ((size_t)dir_ * T + tok_) * 512 + ch_); } while (0)
    if ((int)blockIdx.x < 4096) R1_LOAD((int)blockIdx.x);
    for (int item = blockIdx.x; item < 4096; item += gridDim.x) {
        const v4u lw4 = lw4n, r4 = r4n, v4 = v4n, kd4 = kd4n, kk4 = kk4n, bb4 = bb4n;
        float lw[8], Lin[8];
#pragma unroll
        for (int q = 0; q < 4; ++q) { lw[2 * q] = bflo(lw4[q]); lw[2 * q + 1] = bfhi(lw4[q]); }
#pragma unroll
        for (int j = 0; j < 8; ++j) { float x = lw[j];
#pragma unroll
            for (int o = 8; o < 64; o <<= 1) { const float y = __shfl_up(x, o); if (lane >= o) x += y; }
            Lin[j] = x; }
        __syncthreads();
        if (lane >= 56) {
#pragma unroll
            for (int j = 0; j < 8; ++j) LWs[64 + wave * 64 + i0 + j] = Lin[j]; }
        __syncthreads();
        {
            float off[8];
#pragma unroll
            for (int j = 0; j < 8; ++j) off[j] = 0.f;
            for (int w = 0; w < 8; ++w) { if (w < wave) {
#pragma unroll
                for (int j = 0; j < 8; ++j) off[j] += LWs[64 + w * 64 + i0 + j]; } }
#pragma unroll
            for (int j = 0; j < 8; ++j) Lin[j] += off[j];
            if (t == 63) {
#pragma unroll
                for (int j = 0; j < 8; ++j) LWs[i0 + j] = Lin[j]; }
            float at_[8], rt_[8], bt_[8], kt_[8];
#pragma unroll
            for (int q = 0; q < 4; ++q) {
#pragma unroll
                for (int e = 0; e < 2; ++e) { const int j = 2 * q + e;
                    const float ein = __expf(Lin[j]), einv = __expf(-Lin[j]), eex = __expf(Lin[j] - lw[j]);
                    const float kkv = e ? bfhi(kk4[q]) : bflo(kk4[q]), rv_ = e ? bfhi(r4[q]) : bflo(r4[q]), bbv = e ? bfhi(bb4[q]) : bflo(bb4[q]), kdv = e ? bfhi(kd4[q]) : bflo(kd4[q]);
                    at_[j] = -kkv * eex; rt_[j] = rv_ * ein; bt_[j] = bbv * einv; kt_[j] = kdv * einv; }
            }
            v4u wa, wb, wk, w;
            wa.x = pk2(at_[0], at_[1]); wa.y = pk2(at_[2], at_[3]); wa.z = pk2(at_[4], at_[5]); wa.w = pk2(at_[6], at_[7]); *(LAS v4u*)(SL(0) + t * MROW + i0 * 2) = wa;
            w.x = pk2(rt_[0], rt_[1]); w.y = pk2(rt_[2], rt_[3]); w.z = pk2(rt_[4], rt_[5]); w.w = pk2(rt_[6], rt_[7]); *(LAS v4u*)(SL(2) + t * MROW + i0 * 2) = w;
            wb.x = pk2(bt_[0], bt_[1]); wb.y = pk2(bt_[2], bt_[3]); wb.z = pk2(bt_[4], bt_[5]); wb.w = pk2(bt_[6], bt_[7]); *(LAS v4u*)(SL(3) + t * MROW + i0 * 2) = wb;
            wk.x = pk2(kt_[0], kt_[1]); wk.y = pk2(kt_[2], kt_[3]); wk.z = pk2(kt_[4], kt_[5]); wk.w = pk2(kt_[6], kt_[7]); *(LAS v4u*)(SL(5) + t * MROW + i0 * 2) = wk;
#pragma unroll
            for (int q = 0; q < 4; ++q) {
                LAS unsigned char* pT = (LAS unsigned char*)0 + (i0 + 2 * q) * MROW + t * 2;
                *(LAS unsigned short*)(SL(1) + (size_t)pT) = (unsigned short)(wa[q] & 0xffffu); *(LAS unsigned short*)(SL(1) + (size_t)pT + MROW) = (unsigned short)(wa[q] >> 16);
                *(LAS unsigned short*)(SL(4) + (size_t)pT) = (unsigned short)(wb[q] & 0xffffu); *(LAS unsigned short*)(SL(4) + (size_t)pT + MROW) = (unsigned short)(wb[q] >> 16);
                *(LAS unsigned short*)(SL(6) + (size_t)pT) = (unsigned short)(wk[q] & 0xffffu); *(LAS unsigned short*)(SL(6) + (size_t)pT + MROW) = (unsigned short)(wk[q] >> 16);
                *(LAS unsigned short*)(SL(7) + (size_t)pT) = (unsigned short)(v4[q] & 0xffffu); *(LAS unsigned short*)(SL(7) + (size_t)pT + MROW) = (unsigned short)(v4[q] >> 16);
            }
        }
        if (item + (int)gridDim.x < 4096) R1_LOAD(item + (int)gridDim.x);
        __syncthreads();
        f32x4 Tacc[2];
        {
            bf16x8 la[2], lr[2];
#pragma unroll
            for (int ks = 0; ks < 2; ++ks) { la[ks] = frag_rm(SL(0), m0, 32 * ks, fr, fq); lr[ks] = frag_rm(SL(2), m0, 32 * ks, fr, fq); }
#pragma unroll
            for (int q = 0; q < 2; ++q) {
                const int n0 = (tn0 + q) * 16;
                f32x4 cab = {0.f, 0.f, 0.f, 0.f}, cak = cab, crb = cab, crk = cab;
#pragma unroll
                for (int ks = 0; ks < 2; ++ks) {
                    const bf16x8 rb_ = frag_rm(SL(3), n0, 32 * ks, fr, fq), rk_ = frag_rm(SL(5), n0, 32 * ks, fr, fq);
                    MMA16(cab, la[ks], rb_); MMA16(cak, la[ks], rk_); MMA16(crb, lr[ks], rb_); MMA16(crk, lr[ks], rk_);
                }
                const int tt = m0 + fr;
#pragma unroll
                for (int j = 0; j < 4; ++j) { const int ss = n0 + 4 * fq + j;
                    if (!(ss < tt)) { cab[j] = 0.f; cak[j] = 0.f; }
                    if (!(ss <= tt)) { crb[j] = 0.f; crk[j] = 0.f; } }
                tile_store_bf16(SL(8), m0, n0, fr, fq, cab); tile_store_bf16_T(SL(9), m0, n0, fr, fq, cab);
                tile_store_bf16(SL(10), m0, n0, fr, fq, cak);
                tile_store_bf16(SL(11), m0, n0, fr, fq, crb); tile_store_bf16(SL(12), m0, n0, fr, fq, crk);
#pragma unroll
                for (int j = 0; j < 4; ++j) cab[j] += ((n0 + 4 * fq + j) == tt) ? 1.f : 0.f;
                Tacc[q] = cab;
                tile_store_bf16(SL(13), m0, n0, fr, fq, cab);
            }
        }
        __syncthreads();
        {
            bf16x8 lk[2], ln_[2];
#pragma unroll
            for (int ks = 0; ks < 2; ++ks) { lk[ks] = frag_rm(SL(10), m0, 32 * ks, fr, fq); ln_[ks] = frag_rm(SL(8), m0, 32 * ks, fr, fq); }
#pragma unroll
            for (int q = 0; q < 2; ++q) {
                const int n0 = (tn0 + q) * 16;
                f32x4 cw = {0.f, 0.f, 0.f, 0.f}, cn = cw;
#pragma unroll
                for (int ks = 0; ks < 2; ++ks) { MMA16(cw, lk[ks], frag_rm(SL(7), n0, 32 * ks, fr, fq)); MMA16(cn, ln_[ks], frag_rm(SL(9), n0, 32 * ks, fr, fq)); }
                tile_store_bf16_T(SL(0), m0, n0, fr, fq, cw);
                tile_store_bf16(SL(3), m0, n0, fr, fq, cn); tile_store_bf16_T(SL(5), m0, n0, fr, fq, cn);
            }
        }
        __syncthreads();
#pragma unroll
        for (int k = 1; k <= 5; ++k) {
            LAS unsigned char* Nk = (k & 1) ? SL(3) : SL(8); LAS unsigned char* NkT = (k & 1) ? SL(5) : SL(9);
            LAS unsigned char* Nn = (k & 1) ? SL(8) : SL(3); LAS unsigned char* NnT = (k & 1) ? SL(9) : SL(5);
            LAS unsigned char* Tk = (k & 1) ? SL(13) : SL(10); LAS unsigned char* Tn = (k & 1) ? SL(10) : SL(13);
            bf16x8 lt[2], ln_[2];
#pragma unroll
            for (int ks = 0; ks < 2; ++ks) { lt[ks] = frag_rm(Tk, m0, 32 * ks, fr, fq); ln_[ks] = frag_rm(Nk, m0, 32 * ks, fr, fq); }
#pragma unroll
            for (int q = 0; q < 2; ++q) {
                const int n0 = (tn0 + q) * 16;
                f32x4 cn = {0.f, 0.f, 0.f, 0.f};
#pragma unroll
                for (int ks = 0; ks < 2; ++ks) { const bf16x8 rn = frag_rm(NkT, n0, 32 * ks, fr, fq); MMA16(Tacc[q], lt[ks], rn); if (k < 5) MMA16(cn, ln_[ks], rn); }
                tile_store_bf16(Tn, m0, n0, fr, fq, Tacc[q]);
                if (k < 5) { tile_store_bf16(Nn, m0, n0, fr, fq, cn); tile_store_bf16_T(NnT, m0, n0, fr, fq, cn); }
            }
            __syncthreads();
        }
        {
            bf16x8 lt[2];
#pragma unroll
            for (int ks = 0; ks < 2; ++ks) lt[ks] = frag_rm(SL(10), m0, 32 * ks, fr, fq);
#pragma unroll
            for (int q = 0; q < 2; ++q) {
                const int n0 = (tn0 + q) * 16;
                f32x4 ca = {0.f, 0.f, 0.f, 0.f}, cu = ca;
#pragma unroll
                for (int ks = 0; ks < 2; ++ks) { MMA16(ca, lt[ks], frag_rm(SL(1), n0, 32 * ks, fr, fq)); MMA16(cu, lt[ks], frag_rm(SL(0), n0, 32 * ks, fr, fq)); }
                tile_store_bf16_T(SL(8), m0, n0, fr, fq, ca); tile_store_bf16_T(SL(9), m0, n0, fr, fq, cu);
            }
        }
        __syncthreads();
        {
            bf16x8 lrb[2], lrk[2], lb[2], lkt[2];
#pragma unroll
            for (int ks = 0; ks < 2; ++ks) { lrb[ks] = frag_rm(SL(11), m0, 32 * ks, fr, fq); lrk[ks] = frag_rm(SL(12), m0, 32 * ks, fr, fq);
                lb[ks] = frag_rm(SL(4), m0, 32 * ks, fr, fq); lkt[ks] = frag_rm(SL(6), m0, 32 * ks, fr, fq); }
            const float wc = __expf(LWs[m0 + fr]);
#pragma unroll
            for (int q = 0; q < 2; ++q) {
                const int n0 = (tn0 + q) * 16;
                f32x4 crh = {0.f, 0.f, 0.f, 0.f}, cyl = crh, cp = crh, cq = crh;
#pragma unroll
                for (int ks = 0; ks < 2; ++ks) {
                    const bf16x8 ra = frag_rm(SL(8), n0, 32 * ks, fr, fq), ru = frag_rm(SL(9), n0, 32 * ks, fr, fq), rv = frag_rm(SL(7), n0, 32 * ks, fr, fq);
                    MMA16(crh, lrb[ks], ra); MMA16(cyl, lrb[ks], ru); MMA16(cyl, lrk[ks], rv);
                    MMA16(cp, lb[ks], ra); MMA16(cq, lb[ks], ru); MMA16(cq, lkt[ks], rv);
                }
                const size_t o = (size_t)item * 4096 + (size_t)(m0 + fr) * 64 + n0 + 4 * fq;
                { const LAS unsigned short* rp = (const LAS unsigned short*)(SL(2) + (m0 + fr) * MROW + (n0 + 4 * fq) * 2);
#pragma unroll
                  for (int j = 0; j < 4; ++j) crh[j] += __uint_as_float(((unsigned)rp[j]) << 16); }
                { v2u w; w.x = pk2(crh[0], crh[1]); w.y = pk2(crh[2], crh[3]); *(v2u*)(RH + o) = w; }
                { v2u w; w.x = pk2(cyl[0], cyl[1]); w.y = pk2(cyl[2], cyl[3]); *(v2u*)(YL + o) = w; }
#pragma unroll
                for (int j = 0; j < 4; ++j) { cp[j] = wc * (cp[j] + (((n0 + 4 * fq + j) == (m0 + fr)) ? 1.f : 0.f)); cq[j] *= wc; }
                { v2u w; w.x = pk2(cp[0], cp[1]); w.y = pk2(cp[2], cp[3]); *(v2u*)(PT + o) = w; }
                { v2u w; w.x = pk2(cq[0], cq[1]); w.y = pk2(cq[2], cq[3]); *(v2u*)(QT + o) = w; }
            }
        }
    }
#undef SL
}
#undef R1_LOAD

__device__ __forceinline__ bf16x8 pack_acc8(const f32x16& x, int s) {
    v4u p; p.x = pk2(x[8 * s], x[8 * s + 1]); p.y = pk2(x[8 * s + 2], x[8 * s + 3]); p.z = pk2(x[8 * s + 4], x[8 * s + 5]); p.w = pk2(x[8 * s + 6], x[8 * s + 7]);
    return __builtin_bit_cast(bf16x8, p);
}
__device__ __forceinline__ void scan_r2(const bf16_t* PT, const bf16_t* QT, bf16_t* S0, unsigned char* lds_raw) {
    LAS unsigned char* L = (LAS unsigned char*)lds_raw;
    constexpr int SLOT_B = MBUF + 8192;
    const int tid = tidx(), lane = tid & 63, wave = tid >> 6;
    const int r = lane & 31, h2 = lane >> 5, jb = wave;
    f32x16 st[2];
#pragma unroll
    for (int ib = 0; ib < 2; ++ib)
#pragma unroll
        for (int g = 0; g < 16; ++g) st[ib][g] = 0.f;
    const size_t item0 = (size_t)blockIdx.x * 128;
    v4u stage[16];
#pragma unroll
    for (int q = 0; q < 16; ++q) { const int p = tid + 512 * q, cc = p >> 10, w = p & 1023, mat = w >> 9, idx = w & 511;
        stage[q] = *(const v4u*)((mat ? QT : PT) + (item0 + cc) * 4096 + idx * 8); }
    for (int grp = 0; grp < 16; ++grp) {
        __syncthreads();
#pragma unroll
        for (int q = 0; q < 16; ++q) { const int p = tid + 512 * q, cc = p >> 10, w = p & 1023, mat = w >> 9, idx = w & 511;
            *(LAS v4u*)(L + cc * SLOT_B + (mat ? (MBUF + idx * 16) : ((idx >> 3) * MROW + (idx & 7) * 16))) = stage[q]; }
        __syncthreads();
        if (grp < 15) {
#pragma unroll
            for (int q = 0; q < 16; ++q) { const int p = tid + 512 * q, cc = p >> 10, w = p & 1023, mat = w >> 9, idx = w & 511;
                stage[q] = *(const v4u*)((mat ? QT : PT) + (item0 + (grp + 1) * 8 + cc) * 4096 + idx * 8); }
        }
        if (wave < 2) {
#pragma unroll
            for (int cc = 0; cc < 8; ++cc) {
                const size_t item = item0 + grp * 8 + cc;
                const LAS unsigned char* Pm = L + cc * SLOT_B; const LAS unsigned char* Qm = Pm + MBUF;
                bf16_t* sp = S0 + item * 4096 + (size_t)(32 * jb + r) * 64;
#pragma unroll
                for (int ib = 0; ib < 2; ++ib)
#pragma unroll
                    for (int g = 0; g < 4; ++g) { v2u w; w.x = pk2(st[ib][4 * g], st[ib][4 * g + 1]); w.y = pk2(st[ib][4 * g + 2], st[ib][4 * g + 3]); *(v2u*)(sp + 32 * ib + 8 * g + 4 * h2) = w; }
                f32x16 nw[2];
#pragma unroll
                for (int ib = 0; ib < 2; ++ib)
#pragma unroll
                    for (int g = 0; g < 16; ++g) nw[ib][g] = __uint_as_float(((unsigned)*(const LAS unsigned short*)(Qm + (32 * ib + (g & 3) + 8 * (g >> 2) + 4 * h2) * 128 + (32 * jb + r) * 2)) << 16);
#pragma unroll
                for (int kb = 0; kb < 2; ++kb)
#pragma unroll
                    for (int s2 = 0; s2 < 2; ++s2) {
                        const bf16x8 bfr = pack_acc8(st[kb], s2);
#pragma unroll
                        for (int ib = 0; ib < 2; ++ib) {
                            const LAS unsigned char* ap = Pm + (32 * ib + r) * MROW + (32 * kb + 16 * s2 + 4 * h2) * 2;
                            const v2u lo = *(const LAS v2u*)ap, hi = *(const LAS v2u*)(ap + 16);
                            v4u av; av.x = lo.x; av.y = lo.y; av.z = hi.x; av.w = hi.y;
                            nw[ib] = __builtin_amdgcn_mfma_f32_32x32x16_bf16(__builtin_bit_cast(bf16x8, av), bfr, nw[ib], 0, 0, 0);
                        }
                    }
                st[0] = nw[0]; st[1] = nw[1];
            }
        }
    }
}
__device__ __forceinline__ void scan_r3(const bf16_t* RH, const bf16_t* YL, const bf16_t* S0, const bf16_t* RVg, const bf16_t* KDg, const bf16_t* Gg,
                                        const float* r_k, const float* lng, const float* lnb, bf16_t* Y) {
    const int tid = tidx(), lane = tid & 63, wave = tid >> 6, fr = lane & 15, fq = lane >> 4;
    const int tmw = wave & 3;
    for (int it2 = blockIdx.x * 2 + (wave >> 2); it2 < 2048; it2 += gridDim.x * 2) {
        const int b = it2 >> 10, h = (it2 >> 7) & 7, pc = it2 & 127;
        f32x4 acc[4];
#pragma unroll
        for (int q = 0; q < 4; ++q) acc[q] = (f32x4){0.f, 0.f, 0.f, 0.f};
#pragma unroll 1
        for (int dirn = 0; dirn < 2; ++dirn) {
            const size_t item = (size_t)((dirn * 2 + b) * 8 + h) * 128 + (dirn ? 127 - pc : pc);
            const int row = dirn ? 63 - (16 * tmw + fr) : 16 * tmw + fr;
            const bf16_t* rp = RH + item * 4096 + (size_t)row * 64;
            bf16x8 lf[2];
#pragma unroll
            for (int ks = 0; ks < 2; ++ks) lf[ks] = *(const bf16x8*)(rp + 32 * ks + 8 * fq);
#pragma unroll
            for (int q = 0; q < 4; ++q) {
                const bf16_t* sp = S0 + item * 4096 + (size_t)(16 * q + fr) * 64;
#pragma unroll
                for (int ks = 0; ks < 2; ++ks) { const bf16x8 rf = *(const bf16x8*)(sp + 32 * ks + 8 * fq); MMA16(acc[q], lf[ks], rf); }
                { const v2u yw = *(const v2u*)(YL + item * 4096 + (size_t)row * 64 + 16 * q + 4 * fq); acc[q] += (f32x4){bflo(yw.x), bfhi(yw.x), bflo(yw.y), bfhi(yw.y)}; }
            }
        }
        float sm = 0.f;
#pragma unroll
        for (int q = 0; q < 4; ++q) sm += (acc[q][0] + acc[q][1]) + (acc[q][2] + acc[q][3]);
        sm += __shfl_xor(sm, 16); sm += __shfl_xor(sm, 32);
        const float mean = sm * (1.0f / 64.f);
        float sq = 0.f;
#pragma unroll
        for (int q = 0; q < 4; ++q)
#pragma unroll
            for (int j = 0; j < 4; ++j) { const float d = acc[q][j] - mean; sq += d * d; }
        sq += __shfl_xor(sq, 16); sq += __shfl_xor(sq, 32);
        const float rstd = rsqrtf(sq * (1.0f / 64.f) + 64e-5f);
        const size_t tok = (size_t)b * S + pc * 64 + 16 * tmw + fr;
        float bon = 0.f; f32x4 vv[4];
#pragma unroll
        for (int q = 0; q < 4; ++q) {
            const int c = h * 64 + 16 * q + 4 * fq;
            const v2u rw = *(const v2u*)(RVg + tok * D + c), k0 = *(const v2u*)(KDg + tok * 512 + c), k1 = *(const v2u*)(KDg + ((size_t)T + tok) * 512 + c), vw = *(const v2u*)(RVg + tok * D + 512 + c);
            const f32x4 rk4 = *(const f32x4*)(r_k + c);
            vv[q] = (f32x4){bflo(vw.x), bfhi(vw.x), bflo(vw.y), bfhi(vw.y)};
            bon += bflo(rw.x) * (bflo(k0.x) + bflo(k1.x)) * rk4[0] + bfhi(rw.x) * (bfhi(k0.x) + bfhi(k1.x)) * rk4[1] + bflo(rw.y) * (bflo(k0.y) + bflo(k1.y)) * rk4[2] + bfhi(rw.y) * (bfhi(k0.y) + bfhi(k1.y)) * rk4[3];
        }
        bon += __shfl_xor(bon, 16); bon += __shfl_xor(bon, 32);
#pragma unroll
        for (int q = 0; q < 4; ++q) {
            const int c = h * 64 + 16 * q + 4 * fq;
            const v2u gw_ = *(const v2u*)(Gg + tok * 512 + c); const f32x4 g4 = {bflo(gw_.x), bfhi(gw_.x), bflo(gw_.y), bfhi(gw_.y)}, lg = *(const f32x4*)(lng + c), lb = *(const f32x4*)(lnb + c);
            float o[4];
#pragma unroll
            for (int j = 0; j < 4; ++j) o[j] = ((acc[q][j] - mean) * rstd * lg[j] + lb[j] + bon * vv[q][j]) * g4[j];
            v2u w; w.x = pk2(o[0], o[1]); w.y = pk2(o[2], o[3]);
            *(v2u*)(Y + tok * D + 512 + c) = w;
        }
    }
}


__device__ __forceinline__ bf16x8 pack8(float a0, float a1, float a2, float a3, float a4, float a5, float a6, float a7) {
    v4u p; p.x = pk2(a0, a1); p.y = pk2(a2, a3); p.z = pk2(a4, a5); p.w = pk2(a6, a7);
    return __builtin_bit_cast(bf16x8, p);
}
#define MMA32(acc, af, bf_) acc = __builtin_amdgcn_mfma_f32_32x32x16_bf16(af, bf_, acc, 0, 0, 0)
__device__ __forceinline__ void xattn_mfma(const bf16_t* Qb, const bf16_t* Kb, const bf16_t* Vt, bf16_t* Y, unsigned char* lds_raw) {
    LAS unsigned char* L = (LAS unsigned char*)lds_raw;
    constexpr int KRS = 528, VRS = 520;
    const int tid = tidx(), lane = tid & 63, wave = tid >> 6, r = lane & 31, h2 = lane >> 5;
    for (int it = blockIdx.x; it < 256; it += gridDim.x) {
        const int qblk = it & 31, h = (it >> 5) & 3, b = it >> 7;
        const size_t tok = (size_t)b * S + qblk * 256 + wave * 32 + r;
        bf16x8 qf[16];
#pragma unroll
        for (int ks = 0; ks < 16; ++ks) qf[ks] = *(const bf16x8*)(Qb + tok * D + h * 256 + 16 * ks + 8 * h2);
        __syncthreads();
#pragma unroll
        for (int hf = 0; hf < 2; ++hf) {
            v4u stg[8];
#pragma unroll
            for (int q = 0; q < 8; ++q) { const int p = tid + 512 * (8 * hf + q); stg[q] = *(const v4u*)(Kb + (size_t)(b * MEM + (p >> 5)) * 1024 + h * 256 + (p & 31) * 8); }
#pragma unroll
            for (int q = 0; q < 8; ++q) { const int p = tid + 512 * (8 * hf + q); *(LAS v4u*)(L + (p >> 5) * KRS + (p & 31) * 16) = stg[q]; }
        }
        __syncthreads();
        float mx = -3.0e38f;
#pragma unroll 1
        for (int kb = 0; kb < 8; ++kb) {
            f32x16 st;
#pragma unroll
            for (int g = 0; g < 16; ++g) st[g] = 0.f;
            const LAS unsigned char* kp = L + (32 * kb + r) * KRS + 16 * h2;
#pragma unroll
            for (int ks = 0; ks < 16; ++ks) { const bf16x8 kf = *(const LAS bf16x8*)(kp + 32 * ks); MMA32(st, kf, qf[ks]); }
#pragma unroll
            for (int g = 0; g < 16; ++g) mx = fmaxf(mx, st[g]);
        }
        mx = fmaxf(mx, __shfl_xor(mx, 32));
        const float cs = 0.0625f * 1.4426950408889634f;
        float l = 0.f;
        bf16x8 pf[8][2];
#pragma unroll
        for (int kb = 0; kb < 8; ++kb) {
            f32x16 st;
#pragma unroll
            for (int g = 0; g < 16; ++g) st[g] = 0.f;
            const LAS unsigned char* kp = L + (32 * kb + r) * KRS + 16 * h2;
#pragma unroll
            for (int ks = 0; ks < 16; ++ks) { const bf16x8 kf = *(const LAS bf16x8*)(kp + 32 * ks); MMA32(st, kf, qf[ks]); }
#pragma unroll
            for (int g = 0; g < 16; ++g) { st[g] = __builtin_amdgcn_exp2f((st[g] - mx) * cs); l += st[g]; }
#pragma unroll
            for (int s2 = 0; s2 < 2; ++s2) pf[kb][s2] = pack8(st[8 * s2], st[8 * s2 + 1], st[8 * s2 + 2], st[8 * s2 + 3], st[8 * s2 + 4], st[8 * s2 + 5], st[8 * s2 + 6], st[8 * s2 + 7]);
            __builtin_amdgcn_sched_barrier(0);
        }
        l += __shfl_xor(l, 32);
        const float inv = 1.0f / l;
        __syncthreads();
#pragma unroll
        for (int hf = 0; hf < 2; ++hf) {
            v4u stg[8];
#pragma unroll
            for (int q = 0; q < 8; ++q) { const int p = tid + 512 * (8 * hf + q); stg[q] = *(const v4u*)(Vt + ((size_t)(b * 1024 + h * 256 + (p >> 5))) * 256 + (p & 31) * 8); }
#pragma unroll
            for (int q = 0; q < 8; ++q) { const int p = tid + 512 * (8 * hf + q); LAS v2u* lp = (LAS v2u*)(L + (p >> 5) * VRS + (p & 31) * 16);
                v2u a_; a_.x = stg[q].x; a_.y = stg[q].y; lp[0] = a_; a_.x = stg[q].z; a_.y = stg[q].w; lp[1] = a_; }
        }
        __syncthreads();
#pragma unroll 1
        for (int db = 0; db < 8; ++db) {
            f32x16 acc;
#pragma unroll
            for (int g = 0; g < 16; ++g) acc[g] = 0.f;
            const LAS unsigned char* vp = L + (32 * db + r) * VRS + 8 * h2;
#pragma unroll
            for (int kb = 0; kb < 8; ++kb)
#pragma unroll
                for (int s2 = 0; s2 < 2; ++s2) {
                    const v2u lo = *(const LAS v2u*)(vp + (32 * kb + 16 * s2) * 2), hi = *(const LAS v2u*)(vp + (32 * kb + 16 * s2 + 8) * 2);
                    v4u av; av.x = lo.x; av.y = lo.y; av.z = hi.x; av.w = hi.y;
                    MMA32(acc, __builtin_bit_cast(bf16x8, av), pf[kb][s2]);
                }
            int tl_ = tid; asm volatile("" : "+v"(tl_));
            bf16_t* yp = Y + ((size_t)b * S + qblk * 256 + (tl_ >> 6) * 32 + (tl_ & 31)) * D + h * 256 + 32 * db + 4 * ((tl_ >> 5) & 1);
#pragma unroll
            for (int g = 0; g < 4; ++g) { v2u w; w.x = pk2(acc[4 * g] * inv, acc[4 * g + 1] * inv); w.y = pk2(acc[4 * g + 2] * inv, acc[4 * g + 3] * inv); *(v2u*)(yp + 8 * g) = w; }
        }
    }
}
template <bool F32OUT>
__device__ __forceinline__ void combine_norm(float* X, const bf16_t* YE, const int* SLOT, const float* g, bf16_t* Hout, float* Fout) {
    const int tix_ = tidx(); const int lane = tix_ & 63, gw = blockIdx.x * 8 + (tix_ >> 6), ngw = gridDim.x * 8;
    float4 gc[4];
#pragma unroll
    for (int j = 0; j < 4; ++j) gc[j] = ((const float4*)g)[lane + 64 * j];
    for (int m = gw; m < T; m += ngw) {
        float4* xr = (float4*)(X + (size_t)m * D);
        float4 v[4];
#pragma unroll
        for (int j = 0; j < 4; ++j) v[j] = xr[lane + 64 * j];
        const int myslot = SLOT[(size_t)m * NE + (lane & 15)];
#pragma unroll
        for (int e = 0; e < 16; ++e) {
            const int row = __builtin_amdgcn_readlane(myslot, e);
            if (row >= 0) {
                const v2u* yp = (const v2u*)(YE + (size_t)row * D);
#pragma unroll
                for (int j = 0; j < 4; ++j) { const v2u w = yp[lane + 64 * j];
                    v[j].x += __uint_as_float(w.x << 16); v[j].y += __uint_as_float(w.x & 0xffff0000u); v[j].z += __uint_as_float(w.y << 16); v[j].w += __uint_as_float(w.y & 0xffff0000u); }
            }
        }
        float s = 0.f;
#pragma unroll
        for (int j = 0; j < 4; ++j) { if (!F32OUT) xr[lane + 64 * j] = v[j]; s += v[j].x * v[j].x + v[j].y * v[j].y + v[j].z * v[j].z + v[j].w * v[j].w; }
        const float r = rsqrtf(wave_sum(s) * (1.0f / D) + 1e-6f);
#pragma unroll
        for (int j = 0; j < 4; ++j) { const float4 gg = gc[j];
            if (F32OUT) ((float4*)(Fout + (size_t)m * D))[lane + 64 * j] = make_float4(v[j].x * r * gg.x, v[j].y * r * gg.y, v[j].z * r * gg.z, v[j].w * r * gg.w);
            else { v2u w; w.x = pk2(v[j].x * r * gg.x, v[j].y * r * gg.y); w.y = pk2(v[j].z * r * gg.z, v[j].w * r * gg.w); ((v2u*)(Hout + (size_t)m * D))[lane + 64 * j] = w; } }
    }
}


template <int NK, bool SINK>
__device__ __forceinline__ void attn_block(const bf16_t* Qh, const bf16_t* Kh, const bf16_t* Vh, int dd, int Lr, int b, int rho, int q0b, float sink2,
                                           bf16_t* Odst, int ostride, float* lsedst, unsigned char* lds_raw) {
    constexpr int NKEY = 256 + 64 * NK, KRS = 144, VRS = NKEY * 2 + 8;
    LAS unsigned char* Ks = (LAS unsigned char*)lds_raw; LAS unsigned char* Vs = Ks + NKEY * KRS;
    const int tid = tidx(), lane = tid & 63, wave = tid >> 6, r = lane & 31, h2 = lane >> 5;
    const int kq_base = q0b - 32 * NK;
    __syncthreads();
#pragma unroll
    for (int i = 0; i < NKEY * 8 / 512; ++i) {
        const int p = tid + 512 * i, row = p >> 3, piece = p & 7, kq = kq_base + row;
        if (kq >= 0 && kq < Lr) {
            const size_t tokk = (size_t)b * S + (size_t)kq * dd + rho;
            const v4u kx = *(const v4u*)(Kh + tokk * 64 + piece * 8), vx = *(const v4u*)(Vh + tokk * 64 + piece * 8);
            *(LAS v4u*)(Ks + row * KRS + piece * 16) = kx;
            LAS unsigned char* vp = Vs + (piece * 8) * VRS + row * 2;
#pragma unroll
            for (int e = 0; e < 4; ++e) { *(LAS unsigned short*)(vp + (2 * e) * VRS) = (unsigned short)(vx[e] & 0xffffu); *(LAS unsigned short*)(vp + (2 * e + 1) * VRS) = (unsigned short)(vx[e] >> 16); }
        }
    }
    const int q0 = q0b + 32 * wave;
    const size_t qtok = (size_t)b * S + (size_t)(q0 + r) * dd + rho;
    bf16x8 qf[4];
#pragma unroll
    for (int ks = 0; ks < 4; ++ks) qf[ks] = *(const bf16x8*)(Qh + qtok * 64 + 16 * ks + 8 * h2);
    __syncthreads();
    f32x16 o[2];
#pragma unroll
    for (int db = 0; db < 2; ++db)
#pragma unroll
        for (int g = 0; g < 16; ++g) o[db][g] = 0.f;
    float m = SINK ? sink2 : -1.0e30f, l = SINK ? 1.f : 0.f;
    const int kb_lo = max(-NK, -(q0 >> 5)), kb_hi = min(NK, (Lr - 32 - q0) >> 5);
#pragma unroll 1
    for (int kb = kb_lo; kb <= kb_hi; ++kb) {
        const int kw0 = 32 * (wave + kb + NK);
        f32x16 st;
#pragma unroll
        for (int g = 0; g < 16; ++g) st[g] = 0.f;
        const LAS unsigned char* kp = Ks + (kw0 + r) * KRS + 16 * h2;
#pragma unroll
        for (int ks = 0; ks < 4; ++ks) { const bf16x8 kf = *(const LAS bf16x8*)(kp + 32 * ks); MMA32(st, kf, qf[ks]); }
        if (kb == -NK || kb == NK) {
#pragma unroll
            for (int g = 0; g < 16; ++g) { const int cr = (g & 3) + 8 * (g >> 2) + 4 * h2; const bool ok = (kb < 0) ? (cr >= r) : (cr <= r); st[g] = ok ? st[g] : -1.0e30f; }
        }
        float bm = st[0];
#pragma unroll
        for (int g = 1; g < 16; ++g) bm = fmaxf(bm, st[g]);
        bm = fmaxf(bm, __shfl_xor(bm, 32));
        const float mn = fmaxf(m, bm), al = __builtin_amdgcn_exp2f(m - mn);
        float ls = 0.f;
#pragma unroll
        for (int g = 0; g < 16; ++g) { st[g] = __builtin_amdgcn_exp2f(st[g] - mn); ls += st[g]; }
        ls += __shfl_xor(ls, 32);
        l = l * al + ls; m = mn;
#pragma unroll
        for (int db = 0; db < 2; ++db)
#pragma unroll
            for (int g = 0; g < 16; ++g) o[db][g] *= al;
        bf16x8 pf[2];
#pragma unroll
        for (int s2 = 0; s2 < 2; ++s2) pf[s2] = pack8(st[8 * s2], st[8 * s2 + 1], st[8 * s2 + 2], st[8 * s2 + 3], st[8 * s2 + 4], st[8 * s2 + 5], st[8 * s2 + 6], st[8 * s2 + 7]);
#pragma unroll
        for (int db = 0; db < 2; ++db) {
            const LAS unsigned char* vp = Vs + (32 * db + r) * VRS + (kw0 + 4 * h2) * 2;
#pragma unroll
            for (int s2 = 0; s2 < 2; ++s2) {
                const v2u lo = *(const LAS v2u*)(vp + 32 * s2), hi = *(const LAS v2u*)(vp + 32 * s2 + 16);
                v4u av; av.x = lo.x; av.y = lo.y; av.z = hi.x; av.w = hi.y;
                MMA32(o[db], __builtin_bit_cast(bf16x8, av), pf[s2]);
            }
        }
    }
    const float inv = 1.0f / l;
#pragma unroll
    for (int db = 0; db < 2; ++db) {
        bf16_t* op = Odst + qtok * ostride + 32 * db + 4 * h2;
#pragma unroll
        for (int g = 0; g < 4; ++g) { v2u w; w.x = pk2(o[db][4 * g] * inv, o[db][4 * g + 1] * inv); w.y = pk2(o[db][4 * g + 2] * inv, o[db][4 * g + 3] * inv); *(v2u*)(op + 8 * g) = w; }
    }
    if (lsedst != nullptr && h2 == 0) lsedst[qtok * 8] = (m + __builtin_amdgcn_logf(l)) * 0.6931471805599453f;
}

__device__ __forceinline__ void attn_phase_even(const bf16_t* QhA, const bf16_t* KhA, const bf16_t* VhA, const bf16_t* QhB, const bf16_t* KhB, const bf16_t* VhB,
                                                const float* sink, bf16_t* OA, float* LSE, bf16_t* Y, unsigned char* lds_raw) {
    for (int it = blockIdx.x; it < 2048; it += gridDim.x) {
        if (it < 512) {
            const int hq = it >> 6, rem2 = it & 63, b = rem2 >> 5, q0b = (rem2 & 31) * 256, kvh = hq >> 2;
            attn_block<4, true>(QhB + (size_t)hq * T * 64, KhB + (size_t)kvh * T * 64, VhB + (size_t)kvh * T * 64, 1, S, b, 0, q0b, sink[hq] * 1.4426950408889634f,
                                Y + 512 + hq * 64, D, nullptr, lds_raw);
        } else {
            const int ita = it - 512, p = ita >> 9, rem = ita & 511, head = rem >> 6, rem2 = rem & 63, b = rem2 >> 5, rem3 = rem2 & 31;
            const int dd = p == 0 ? 1 : (p == 1 ? 4 : 16), bpr = 32 / dd, rho = rem3 / bpr, q0b = (rem3 % bpr) * 256;
            attn_block<2, false>(QhA + (size_t)head * T * 64, KhA + (size_t)head * T * 64, VhA + (size_t)head * T * 64, dd, S / dd, b, rho, q0b, 0.f,
                                 OA + (size_t)p * T * 512 + head * 64, 512, LSE + (size_t)p * T * 8 + head, lds_raw);
        }
    }
}
__device__ __forceinline__ void attn_combine(const bf16_t* OA, const float* LSE, bf16_t* Y) {
    const int gt = blockIdx.x * NTH + tidx(), ngt = gridDim.x * NTH;
    for (int i = gt; i < T * 64; i += ngt) {
        const int tok = i >> 6, head = (i >> 3) & 7, c8 = i & 7;
        const float l0 = LSE[(size_t)tok * 8 + head], l1 = LSE[((size_t)T + tok) * 8 + head], l2 = LSE[((size_t)2 * T + tok) * 8 + head];
        const float mx = fmaxf(l0, fmaxf(l1, l2));
        float w0 = __expf(l0 - mx), w1 = __expf(l1 - mx), w2 = __expf(l2 - mx);
        const float inv = 1.0f / (w0 + w1 + w2); w0 *= inv; w1 *= inv; w2 *= inv;
        const size_t off = (size_t)tok * 512 + head * 64 + c8 * 8;
        const v4u x0 = *(const v4u*)(OA + off), x1 = *(const v4u*)(OA + (size_t)T * 512 + off), x2 = *(const v4u*)(OA + (size_t)2 * T * 512 + off);
        v4u w;
#pragma unroll
        for (int q = 0; q < 4; ++q) {
            const float lo = w0 * __uint_as_float(x0[q] << 16) + w1 * __uint_as_float(x1[q] << 16) + w2 * __uint_as_float(x2[q] << 16);
            const float hi = w0 * __uint_as_float(x0[q] & 0xffff0000u) + w1 * __uint_as_float(x1[q] & 0xffff0000u) + w2 * __uint_as_float(x2[q] & 0xffff0000u);
            w[q] = pk2(lo, hi);
        }
        *(v4u*)(Y + (size_t)tok * D + head * 64 + c8 * 8) = w;
    }
}


__device__ __forceinline__ void odd_token_pass(const bf16_t* P, const float* mu, const float* k_k, const float* clg, const float* clb,
                                               bf16_t* VN, bf16_t* RV, bf16_t* KBf, bf16_t* KK, bf16_t* F5) {
    const int tix_ = tidx(); const int lane = tix_ & 63, gw = blockIdx.x * 8 + (tix_ >> 6), ngw = gridDim.x * 8;
    float2 m0c[15], m1c[15], kkc[4], lgc[4], lbc[4];
#pragma unroll
    for (int jj = 0; jj < 15; ++jj) { const int c = 2 * lane + 128 * jj; m0c[jj] = *(const float2*)(mu + c); m1c[jj] = *(const float2*)(mu + FD + c); }
#pragma unroll
    for (int jj = 0; jj < 4; ++jj) { const int c = 2 * lane + 128 * jj; kkc[jj] = *(const float2*)(k_k + c); lgc[jj] = *(const float2*)(clg + c); lbc[jj] = *(const float2*)(clb + c); }
    unsigned wcur[15], wnxt[15], wprv[15];
    for (int tok0 = gw * 8; tok0 < T; tok0 += ngw * 8)
    for (int ti = 0; ti < 8; ++ti) {
        const int tok = tok0 + ti;
        const int s = tok & (S - 1);
        const bf16_t* pr = P + (size_t)tok * ODD_PAD;
        if (ti == 0) {
#pragma unroll
            for (int jj = 0; jj < 15; ++jj) { const int c = 2 * lane + 128 * jj; wcur[jj] = *(const unsigned*)(pr + 1024 + c); wprv[jj] = s > 0 ? *(const unsigned*)(pr + 1024 + c - ODD_PAD) : 0u; }
        } else {
#pragma unroll
            for (int jj = 0; jj < 15; ++jj) { wprv[jj] = s > 0 ? wcur[jj] : 0u; wcur[jj] = wnxt[jj]; }
        }
#pragma unroll
        for (int jj = 0; jj < 15; ++jj) { const int c = 2 * lane + 128 * jj; wnxt[jj] = *(const unsigned*)(pr + 1024 + c + (tok + 1 < T ? ODD_PAD : 0)); }
        {
            float ge[8]; float sm = 0.f;
#pragma unroll
            for (int jj = 0; jj < 4; ++jj) { const unsigned w = *(const unsigned*)(pr + 512 + 2 * lane + 128 * jj);
                ge[2 * jj] = gelu_tanh(__uint_as_float(w << 16)); ge[2 * jj + 1] = gelu_tanh(__uint_as_float(w & 0xffff0000u)); sm += ge[2 * jj] + ge[2 * jj + 1]; }
            const float mean = wave_sum(sm) * (1.0f / 512.f); float sq = 0.f;
#pragma unroll
            for (int j = 0; j < 8; ++j) { const float d = ge[j] - mean; sq += d * d; }
            const float rstd = rsqrtf(wave_sum(sq) * (1.0f / 512.f) + 1e-5f);
#pragma unroll
            for (int jj = 0; jj < 4; ++jj) { const int c = 2 * lane + 128 * jj;
                *(unsigned*)(VN + (size_t)tok * 512 + c) = pk2((ge[2 * jj] - mean) * rstd * lgc[jj].x + lbc[jj].x, (ge[2 * jj + 1] - mean) * rstd * lgc[jj].y + lbc[jj].y); }
        }
#pragma unroll
        for (int jj = 0; jj < 15; ++jj) {
            const int c = 2 * lane + 128 * jj;
            const unsigned wf = wcur[jj];
            const unsigned wp = wprv[jj];
            const unsigned wn = s < S - 1 ? wnxt[jj] : 0u;
            const float2 m0 = m0c[jj], m1 = m1c[jj];
            const float f0 = __uint_as_float(wf << 16), f1 = __uint_as_float(wf & 0xffff0000u);
            const float x0 = f0 + m0.x * (__uint_as_float(wp << 16) - f0) + m1.x * (__uint_as_float(wn << 16) - f0);
            const float x1 = f1 + m0.y * (__uint_as_float(wp & 0xffff0000u) - f1) + m1.y * (__uint_as_float(wn & 0xffff0000u) - f1);
            if (jj < 4) *(unsigned*)(RV + (size_t)tok * D + c) = pk2(x0, x1);
            else if (jj < 8) {
                const int ck = c - 512;
                *(unsigned*)(KBf + (size_t)tok * 512 + ck) = pk2(x0, x1);
                const float2 kk_ = kkc[jj - 4];
                const float a0_ = x0 * kk_.x, a1_ = x1 * kk_.y;
                float ss = a0_ * a0_ + a1_ * a1_;
#pragma unroll
                for (int o = 16; o >= 1; o >>= 1) ss += __shfl_xor(ss, o);
                const float inv = 1.0f / fmaxf(sqrtf(ss), 1e-12f);
                *(unsigned*)(KK + (size_t)tok * 512 + ck) = pk2(a0_ * inv, a1_ * inv);
            }
            else if (jj < 12) *(unsigned*)(RV + (size_t)tok * D + 512 + (c - 1024)) = pk2(x0, x1);
            else if (jj == 12) *(unsigned*)(F5 + (size_t)tok * 384 + (c - 1536)) = pk2(tanhf_(x0), tanhf_(x1));
            else if (jj == 13) *(unsigned*)(F5 + (size_t)tok * 384 + 128 + (c - 1664)) = pk2(x0, x1);
            else *(unsigned*)(F5 + (size_t)tok * 384 + 256 + (c - 1792)) = pk2(sigmoidf_(x0), sigmoidf_(x1));
        }
    }
}
__device__ __forceinline__ void gating_pass(const bf16_t* VN, const bf16_t* Wsb, const float* bsp, const bf16_t* P, bf16_t* Y, unsigned char* lds_raw) {
    LAS unsigned char* L = (LAS unsigned char*)lds_raw;
    constexpr int RS = 272;
    const int tid = tidx(), lane = tid & 63, wave = tid >> 6, fr = lane & 15, fq = lane >> 4;
    for (int it = blockIdx.x; it < 512; it += gridDim.x) {
        const int g = it & 3, chunk = it >> 2;
        __syncthreads();
        { const int j = tid >> 2, q4 = tid & 3;
          const v4u* gp = (const v4u*)(VN + (size_t)(chunk * 128 + j) * 512 + g * 128 + 32 * q4);
#pragma unroll
          for (int q = 0; q < 4; ++q) { const v4u x = gp[q];
#pragma unroll
              for (int e = 0; e < 4; ++e) { const int c = 32 * q4 + 8 * q + 2 * e;
                  *(LAS unsigned short*)(L + c * RS + 2 * j) = (unsigned short)(x[e] & 0xffffu); *(LAS unsigned short*)(L + (c + 1) * RS + 2 * j) = (unsigned short)(x[e] >> 16); } } }
        __syncthreads();
        bf16x8 lf[4];
#pragma unroll
        for (int ks = 0; ks < 4; ++ks) lf[ks] = *(const bf16x8*)(Wsb + (size_t)(g * 128 + 16 * wave + fr) * 128 + 32 * ks + 8 * fq);
        const int i = 16 * wave + fr; const size_t tok = (size_t)chunk * 128 + i;
        const float bias = bsp[g * 128 + i];
#pragma unroll
        for (int tn = 0; tn < 8; ++tn) {
            f32x4 acc = {0.f, 0.f, 0.f, 0.f};
#pragma unroll
            for (int ks = 0; ks < 4; ++ks) { const bf16x8 rf = *(const LAS bf16x8*)(L + (16 * tn + fr) * RS + (32 * ks + 8 * fq) * 2); MMA16(acc, lf[ks], rf); }
            const int c = g * 128 + 16 * tn + 4 * fq;
            const v2u uw = *(const v2u*)(P + tok * ODD_PAD + c);
            const float u0 = gelu_tanh(__uint_as_float(uw.x << 16)), u1 = gelu_tanh(__uint_as_float(uw.x & 0xffff0000u)), u2 = gelu_tanh(__uint_as_float(uw.y << 16)), u3 = gelu_tanh(__uint_as_float(uw.y & 0xffff0000u));
            v2u w; w.x = pk2(u0 * (acc[0] + bias), u1 * (acc[1] + bias)); w.y = pk2(u2 * (acc[2] + bias), u3 * (acc[3] + bias));
            *(v2u*)(Y + tok * D + c) = w;
        }
    }
}


__device__ __forceinline__ void router_pass(const float* X, const float* g, const float* WRT  , float* AFF, int* SLOT, bf16_t* H, unsigned char* lds_raw) {
    const int tix_ = tidx(); const int lane = tix_ & 63, wave = tix_ >> 6, fr = lane & 15, fq = lane >> 4;
    const int pair = wave >> 1, half = wave & 1;
    f32x4 gcr[4];
#pragma unroll
    for (int j = 0; j < 4; ++j) gcr[j] = ((const f32x4*)g)[lane + 64 * j];
    LAS float* xch = (LAS float*)lds_raw + pair * 512;
    for (int tile0 = blockIdx.x * 4; tile0 < T / 16; tile0 += gridDim.x * 4) {
        const int tile = tile0 + pair;
        const float* xr = X + (size_t)(tile * 16 + fr) * D + 4 * fq + 512 * half;
        const float* wr = WRT + (size_t)fr * D + 4 * fq + 512 * half;
        f32x4 acc = {0.f, 0.f, 0.f, 0.f}; float ss = 0.f;
#pragma unroll 8
        for (int s = 0; s < 32; ++s) {
            const f32x4 xa = *(const f32x4*)(xr + 16 * s), wb = *(const f32x4*)(wr + 16 * s);
            ss += (xa[0] * xa[0] + xa[1] * xa[1]) + (xa[2] * xa[2] + xa[3] * xa[3]);
#pragma unroll
            for (int c = 0; c < 4; ++c) acc = __builtin_amdgcn_mfma_f32_16x16x4f32(xa[c], wb[c], acc, 0, 0, 0);
        }
        ss += __shfl_xor(ss, 16); ss += __shfl_xor(ss, 32);
        __syncthreads();
        { LAS float* p = xch + half * 256 + lane * 4; p[0] = acc[0]; p[1] = acc[1]; p[2] = acc[2]; p[3] = acc[3]; }
        if (fq == 0) ((LAS float*)lds_raw + 2048 + pair * 32 + half * 16)[fr] = ss;
        __syncthreads();
        { const LAS float* p = xch + (half ^ 1) * 256 + lane * 4; acc[0] += p[0]; acc[1] += p[1]; acc[2] += p[2]; acc[3] += p[3]; }
        ss += ((const LAS float*)lds_raw + 2048 + pair * 32 + (half ^ 1) * 16)[fr];
        const float rstd = rsqrtf(ss * (1.0f / D) + 1e-6f);
        {
            float aff[4];
#pragma unroll
            for (int jj = 0; jj < 4; ++jj) {
                const float lg = acc[jj] * __shfl(rstd, 4 * fq + jj);
                float mx = lg;
#pragma unroll
                for (int o = 1; o < 16; o <<= 1) mx = fmaxf(mx, __shfl_xor(mx, o));
                const float e = expf(lg - mx); float den = e;
#pragma unroll
                for (int o = 1; o < 16; o <<= 1) den += __shfl_xor(den, o);
                aff[jj] = e / den;
            }
#pragma unroll
            for (int jj = 0; jj < 4; ++jj) { const size_t o = (size_t)(tile * 16 + 4 * fq + jj) * NE + fr; if ((fq >> 1) == half) { AFF[o] = aff[jj]; SLOT[o] = -1; } }
        }
#pragma unroll 4
        for (int tt = 0; tt < 8; ++tt) {
            const int t = 8 * half + tt;
            const float rs = __shfl(rstd, t);
            const f32x4* xp = (const f32x4*)(X + (size_t)(tile * 16 + t) * D); unsigned* hp = (unsigned*)((unsigned char*)H + (size_t)(tile * 16 + t) * D);
            const float rs8 = rs * ASC8;
#pragma unroll
            for (int j = 0; j < 4; ++j) { const f32x4 v = xp[lane + 64 * j], gg = gcr[j];
                hp[lane + 64 * j] = pk4_fp8(v[0] * rs8 * gg[0], v[1] * rs8 * gg[1], v[2] * rs8 * gg[2], v[3] * rs8 * gg[3]); }
        }
    }
}


__device__ __forceinline__ void lora_pass(const bf16_t* F5, const bf16_t* WC, const float* w0, const float* a0, const float* k_a, const bf16_t* KB, const bf16_t* KK,
                                          bf16_t* LW, bf16_t* KD, bf16_t* BB, bf16_t* G, unsigned char* lds_raw) {
    LAS unsigned char* L = (LAS unsigned char*)lds_raw;
    constexpr int ARS = 784;
    const int tid = tidx(), lane = tid & 63, wave = tid >> 6, fr = lane & 15, fq = lane >> 4;
    for (int tile = blockIdx.x; tile < T / 64; tile += gridDim.x) {
        __syncthreads();
#pragma unroll
        for (int q = 0; q < 6; ++q) { const int p = tid + 512 * q, row = p / 48, piece = p % 48;
            *(LAS v4u*)(L + row * ARS + piece * 16) = *(const v4u*)(F5 + (size_t)(tile * 64 + row) * 384 + piece * 8); }
        __syncthreads();
#pragma unroll 1
        for (int sec = 0; sec < 5; ++sec) {
            const int K0 = sec * 64, nks = sec < 4 ? 2 : 4, wstride = sec < 4 ? 64 : 128;
            const bf16_t* Wp = WC + (size_t)sec * 512 * 64 + (size_t)(64 * wave) * wstride;
#pragma unroll 1
            for (int nh = 0; nh < 2; ++nh) {
            f32x4 acc[4][2];
#pragma unroll
            for (int tm = 0; tm < 4; ++tm)
#pragma unroll
                for (int tn = 0; tn < 2; ++tn) acc[tm][tn] = (f32x4){0.f, 0.f, 0.f, 0.f};
            for (int ks = 0; ks < nks; ++ks) {
                bf16x8 lf[4], rf[2];
#pragma unroll
                for (int tm = 0; tm < 4; ++tm) lf[tm] = *(const LAS bf16x8*)(L + (16 * tm + fr) * ARS + (K0 + 32 * ks + 8 * fq) * 2);
#pragma unroll
                for (int tn = 0; tn < 2; ++tn) rf[tn] = *(const bf16x8*)(Wp + (size_t)(16 * (2 * nh + tn) + fr) * wstride + 32 * ks + 8 * fq);
#pragma unroll
                for (int tm = 0; tm < 4; ++tm)
#pragma unroll
                    for (int tn = 0; tn < 2; ++tn) MMA16(acc[tm][tn], lf[tm], rf[tn]);
            }
            f32x4 cw[2], cka[2]; v2u kw[4][2], kkw[4][2];
#pragma unroll
            for (int tn = 0; tn < 2; ++tn) {
                const int cc = 64 * wave + 16 * (2 * nh + tn) + 4 * fq;
                cw[tn] = (sec < 2) ? *(const f32x4*)(w0 + sec * 512 + cc) : ((sec < 4) ? *(const f32x4*)(a0 + (sec - 2) * 512 + cc) : (f32x4){0.f, 0.f, 0.f, 0.f});
                cka[tn] = *(const f32x4*)(k_a + cc);
#pragma unroll
                for (int tm = 0; tm < 4; ++tm) { const size_t tok = (size_t)tile * 64 + 16 * tm + fr;
                    if (sec >= 2 && sec < 4) { kw[tm][tn] = *(const v2u*)(KB + tok * 512 + cc); kkw[tm][tn] = *(const v2u*)(KK + tok * 512 + cc); } else { kw[tm][tn] = (v2u){0u, 0u}; kkw[tm][tn] = (v2u){0u, 0u}; } }
            }
#pragma unroll
            for (int tn = 0; tn < 2; ++tn) {
                const int cc = 64 * wave + 16 * (2 * nh + tn) + 4 * fq;
#pragma unroll
                for (int tm = 0; tm < 4; ++tm) {
                    const size_t tok = (size_t)tile * 64 + 16 * tm + fr; const f32x4 v = acc[tm][tn];
                    if (sec < 2) {
                        float o[4];
#pragma unroll
                        for (int j = 0; j < 4; ++j) o[j] = -0.6065306597126334f * frcp(1.0f + __expf(-(cw[tn][j] + v[j])));
                        v2u ww; ww.x = pk2(o[0], o[1]); ww.y = pk2(o[2], o[3]);
                        *(v2u*)(LW + ((size_t)sec * T + tok) * 512 + cc) = ww;
                    } else if (sec < 4) {
                        const int d = sec - 2;
                        const float kv[4] = {bflo(kw[tm][tn].x), bfhi(kw[tm][tn].x), bflo(kw[tm][tn].y), bfhi(kw[tm][tn].y)}, kk[4] = {bflo(kkw[tm][tn].x), bfhi(kkw[tm][tn].x), bflo(kkw[tm][tn].y), bfhi(kkw[tm][tn].y)};
                        float okd[4], obb[4];
#pragma unroll
                        for (int j = 0; j < 4; ++j) { const float alr = frcp(1.0f + __expf(-(cw[tn][j] + v[j]))); okd[j] = kv[j] * (1.0f + (alr - 1.0f) * cka[tn][j]); obb[j] = kk[j] * alr; }
                        v2u w1, w2_; w1.x = pk2(okd[0], okd[1]); w1.y = pk2(okd[2], okd[3]); w2_.x = pk2(obb[0], obb[1]); w2_.y = pk2(obb[2], obb[3]);
                        *(v2u*)(KD + ((size_t)d * T + tok) * 512 + cc) = w1; *(v2u*)(BB + ((size_t)d * T + tok) * 512 + cc) = w2_;
                    } else { v2u ww; ww.x = pk2(v[0], v[1]); ww.y = pk2(v[2], v[3]); *(v2u*)(G + tok * 512 + cc) = ww; }
                }
            }
            }
        }
    }
}

#define IN(k) (lo <= (k) && (k) < hi)
#define REP_LOOP for (int rep_ = 0, nrep_ = ((ph == PROBE_PHASE) ? PROBE_REP : 1); rep_ < nrep_; ++rep_)
#define SEAM(k) do { if (IN(k) && IN((k) + 1)) xcd_barrier(bar); } while (0)
#define PROLOG \
    const int tid = tidx(), lane = tid & 63, wave = tid >> 6; \
    const int bid = blockIdx.x, nb = gridDim.x; \
    const int gw = bid * 8 + wave, ngw = nb * 8; \
    const int gt = bid * NTH + tid, ngt = nb * NTH; \
    (void)gt; (void)ngt; (void)gw; (void)ngw; (void)lane; (void)wave; \
    unsigned char* ws = a.ws; \
    const int lo = a.lo, hi = a.hi; \
    float* ldsf = (float*)lds_raw; (void)ldsf; \
    PG8_LAS unsigned char* ldsp = (PG8_LAS unsigned char*)lds_raw; (void)ldsp; \
    const float* x_in = a.in[0]; const float* mem = a.in[1]; (void)x_in; (void)mem; \
    float* ropec = (float*)(ws + WS_ROPE); float* ropes = ropec + S * 32; (void)ropec; (void)ropes; \
    float* AFF = (float*)(ws + WS_AFF); int* TOK = (int*)(ws + WS_TOK); float* GATE = (float*)(ws + WS_GATE); \
    float* X = (float*)(ws + WS_X); bf16_t* H = (bf16_t*)(ws + WS_H); bf16_t* P = (bf16_t*)(ws + WS_P); \
    bf16_t* Y = (bf16_t*)(ws + WS_Y); bf16_t* Q = (bf16_t*)(ws + WS_Q); bf16_t* KV = (bf16_t*)(ws + WS_KV); bf16_t* MN = (bf16_t*)(ws + WS_MN); \
    bf16_t* DEC = (bf16_t*)(ws + WS_DEC); bf16_t* KD = (bf16_t*)(ws + WS_KD); bf16_t* BB = (bf16_t*)(ws + WS_BB); \
    bf16_t* KK = (bf16_t*)(ws + WS_KK); bf16_t* G = (bf16_t*)(ws + WS_G); float* YS = (float*)(ws + WS_YS); \
    bf16_t* RV = (bf16_t*)(ws + WS_RV); bf16_t* VN = (bf16_t*)(ws + WS_VN); \
    bf16_t* XE = (bf16_t*)(ws + WS_XE); bf16_t* HID = (bf16_t*)(ws + WS_HID); int* SLOT = (int*)(ws + WS_SLOT); bf16_t* YE = (bf16_t*)(ws + WS_YE); (void)SLOT; (void)YE; \
    (void)AFF; (void)TOK; (void)GATE; (void)X; (void)H; (void)P; (void)Y; (void)Q; (void)KV; (void)MN; (void)DEC; (void)KD; (void)BB; (void)KK; (void)G; (void)YS; (void)RV; (void)VN; (void)XE; (void)HID;

template <class Epi>
__device__ __forceinline__ void dense_gemm(PG8_LAS unsigned char* ldsp, const bf16_t* A, const bf16_t* Bt, int M, int N, int K, const Epi& E, int cshift = 0) {
    asm volatile("" : "+s"(K));
    pg8::Gemm g{A, Bt, M, N, K}; pg8::StaticOrder So; So.init(M, N, (int)gridDim.x, (int)((blockIdx.x + cshift) % gridDim.x));
    pg8::gemm_phase<Epi, pg8::StaticOrder, false>(ldsp, g, So, E, nullptr);
}

__device__ __forceinline__ int odd_phases(const Args& a, const XcdBarrier& bar, unsigned char* lds_raw, int ph) {
    PROLOG
    if (IN(ph)) combine_norm<false>(X, YE, SLOT, a.in[6], H, nullptr);
    SEAM(ph); ++ph;
    if (IN(ph)) dense_gemm(ldsp, H, (const bf16_t*)(ws + WS_WOIN), T, ODD_PAD, D, EpiBf16Store{P, ODD_PAD, 1.0f});
    SEAM(ph); ++ph;
    if (IN(ph)) REP_LOOP odd_token_pass(P, a.in[12], a.in[18], a.in[8], a.in[9], VN, RV, (bf16_t*)(ws + WS_KB), KK, (bf16_t*)(ws + WS_F5));
    SEAM(ph); ++ph;
    if (IN(ph)) REP_LOOP {
        gating_pass(VN, (const bf16_t*)(ws + WS_WSB), a.in[11], P, Y, lds_raw);
        __syncthreads();
        lora_pass((const bf16_t*)(ws + WS_F5), (const bf16_t*)(ws + WS_WL), a.in[13], a.in[15], a.in[19], (const bf16_t*)(ws + WS_KB), KK, DEC, KD, BB, G, lds_raw);
    }
    SEAM(ph); ++ph;
    if (IN(ph)) REP_LOOP scan_r1(DEC, RV, KD, KK, BB, (bf16_t*)(ws + WS_PT), (bf16_t*)(ws + WS_QT), (bf16_t*)(ws + WS_RH), (bf16_t*)(ws + WS_YL), lds_raw);
    SEAM(ph); ++ph;
    if (IN(ph)) REP_LOOP {
        if (bid < 32) scan_r2((const bf16_t*)(ws + WS_PT), (const bf16_t*)(ws + WS_QT), (bf16_t*)(ws + WS_S0), lds_raw);
        else {
            LAS float* scr = (LAS float*)((LAS unsigned char*)lds_raw + wave * 16896);
            const int gw2 = (bid - 32) * 8 + wave, ngw2 = (nb - 32) * 8;
            auto gmap = [](int n) { return (n >> 7) * 256 + (n & 127); };
            auto umap = [](int n) { return (n >> 7) * 256 + 128 + (n & 127); };
            for (int it = gw2; it < 16 * 704; it += ngw2) { const int e = it / 704, r = it % 704;
                transpose_item_fp8(a.in[31] + (size_t)(16 + e) * D * DE, D, DE, ws + WS_WGU8 + 176 * MiB + (size_t)e * 5632 * D, gmap, GUSC8, scr, r, lane); }
            for (int it = gw2; it < 16 * 704; it += ngw2) { const int e = it / 704, r = it % 704;
                transpose_item_fp8(a.in[32] + (size_t)(16 + e) * D * DE, D, DE, ws + WS_WGU8 + 176 * MiB + (size_t)e * 5632 * D, umap, GUSC8, scr, r, lane); }
        }
    }
    SEAM(ph); ++ph;
    if (IN(ph)) REP_LOOP scan_r3((const bf16_t*)(ws + WS_RH), (const bf16_t*)(ws + WS_YL), (const bf16_t*)(ws + WS_S0), RV, KD, G, a.in[20], a.in[21], a.in[22], Y);
    SEAM(ph); ++ph;
    if (IN(ph)) dense_gemm(ldsp, Y, (const bf16_t*)(ws + WS_WOOUT), T, D, D, EpiResidN{X, X, H, (float*)(ws + WS_SSP)});
    SEAM(ph); ++ph;
    return ph;
}

template <int layer>
__device__ __forceinline__ int tail_phases(const Args& a, const XcdBarrier& bar, unsigned char* lds_raw, int ph) {
    PROLOG
    if (IN(ph)) REP_LOOP {
        int Kq = D; asm volatile("" : "+s"(Kq));
        pg8::Gemm g{H, (const bf16_t*)(ws + WS_WQ) + (size_t)layer * D * D, T, D, Kq}; XattnOrder So{(int)blockIdx.x};
        pg8::gemm_phase<EpiBf16StoreRS, XattnOrder, false>(ldsp, g, So, EpiBf16StoreRS{Q, D, (const float*)(ws + WS_SSP)}, nullptr);
        asm volatile("s_waitcnt vmcnt(0)" ::: "memory");
        __syncthreads();
        xattn_mfma(Q, KV + (size_t)layer * 1024 * 1024, KV + (size_t)layer * 1024 * 1024 + 512 * 1024, Y, lds_raw);
    }
    SEAM(ph); ++ph;
    if (IN(ph)) dense_gemm(ldsp, Y, (const bf16_t*)(ws + WS_WO) + (size_t)layer * D * D, T, D, D, EpiResid{X, X});
    SEAM(ph); ++ph;
    if (IN(ph)) REP_LOOP router_pass(X, a.in[29] + layer * D, (const float*)(ws + WS_WRT) + (size_t)layer * NE * D, AFF, SLOT, H, lds_raw);
    SEAM(ph); ++ph;
    if (IN(ph)) REP_LOOP {
        unsigned* keys = (unsigned*)ldsf;
        int* hist = (int*)(ldsf + 8192);
        int* sh = hist + 8 * 256;
        if (bid >= 32) {
            LAS float* scr = (LAS float*)((LAS unsigned char*)lds_raw + wave * 16896);
            const int gw2 = (bid - 32) * 8 + wave, ngw2 = (nb - 32) * 8;
            auto ident = [](int n) { return n; };
            if constexpr (layer == 0) {
                auto gmap = [](int n) { return (n >> 7) * 256 + (n & 127); };
                auto umap = [](int n) { return (n >> 7) * 256 + 128 + (n & 127); };
        for (int it = 4096 + gw2; it < 16 * 704; it += ngw2) { const int mt = it / 704, r = it % 704;
            if constexpr (F8L0) transpose_item_fp8(a.in[31] + (size_t)mt * D * DE, D, DE, ws + WS_WGU8 + (size_t)mt * 5632 * D, gmap, GUSC8, scr, r, lane);
            else transpose_item(a.in[31] + (size_t)mt * D * DE, D, DE, (bf16_t*)(ws + WS_WGU) + (size_t)mt * 5632 * D, gmap, scr, r, lane); }
        for (int it = gw2; it < 16 * 704; it += ngw2) { const int mt = it / 704, r = it % 704;
            if constexpr (F8L0) transpose_item_fp8(a.in[32] + (size_t)mt * D * DE, D, DE, ws + WS_WGU8 + (size_t)mt * 5632 * D, umap, GUSC8, scr, r, lane);
            else transpose_item(a.in[32] + (size_t)mt * D * DE, D, DE, (bf16_t*)(ws + WS_WGU) + (size_t)mt * 5632 * D, umap, scr, r, lane); }
            }
            for (int it = gw2; it < 16 * 704; it += ngw2) { const int mt = layer * 16 + it / 704, r = it % 704;
                if constexpr (layer == 1 || F8L0) transpose_item_fp8(a.in[33] + (size_t)mt * DE * D, DE, D, ws + WS_WD8 + (size_t)layer * 88 * MiB + (size_t)(mt - 16 * layer) * D * DE, ident, DSC8, scr, r, lane);
                else transpose_item(a.in[33] + (size_t)mt * DE * D, DE, D, (bf16_t*)(ws + WS_WD) + (size_t)mt * D * DE, ident, scr, r, lane); }
        }
        for (int be = bid; be < NB * NE && be < 32; be += nb) {
            const int b = be >> 4, e = be & 15, eb = e * 2 + b;
            __syncthreads();
            for (int s = tid; s < S; s += NTH) keys[s] = __float_as_uint(AFF[(size_t)(b * S + s) * NE + e]);
            unsigned prefix = 0u; int krem = CAP;
            for (int pass = 3; pass >= 0; --pass) {
                __syncthreads();
                for (int i = tid; i < 8 * 256; i += NTH) hist[i] = 0;
                __syncthreads();
                const unsigned hmask = pass == 3 ? 0u : (0xFFFFFFFFu << (8 * (pass + 1)));
                for (int s = tid; s < S; s += NTH) { const unsigned k = keys[s]; if ((k & hmask) == prefix) atomicAdd(&hist[wave * 256 + ((k >> (8 * pass)) & 255u)], 1); }
                __syncthreads();
                if (wave == 0) {
                    int c4[4], s4 = 0;
#pragma unroll
                    for (int j = 0; j < 4; ++j) { const int bin = 255 - (4 * lane + j); int c = 0;
#pragma unroll
                        for (int w = 0; w < 8; ++w) c += hist[w * 256 + bin];
                        c4[j] = c; s4 += c; }
                    int pre = s4;
#pragma unroll
                    for (int o = 1; o < 64; o <<= 1) { const int y = __shfl_up(pre, o); if (lane >= o) pre += y; }
                    const int excl = pre - s4;
                    if (excl < krem && krem <= pre) {
                        int cum = excl, bsel = 0, rem = 0; bool found = false;
#pragma unroll
                        for (int j = 0; j < 4; ++j) { if (!found && cum + c4[j] >= krem) { bsel = 255 - (4 * lane + j); rem = krem - cum; found = true; } if (!found) cum += c4[j]; }
                        sh[8] = bsel; sh[9] = rem;
                    }
                }
                __syncthreads();
                prefix |= ((unsigned)sh[8]) << (8 * pass); krem = sh[9];
            }
            const unsigned thr = prefix;
            int ce = 0;
            for (int i = 0; i < 16; ++i) { const unsigned k = keys[tid * 16 + i]; ce += (k == thr); }
            int tot;
            const int eqbase = block_exscan(ce, sh, &tot);
            int eqr = eqbase, cs = 0;
            for (int i = 0; i < 16; ++i) { const unsigned k = keys[tid * 16 + i]; const bool sel = (k > thr) || (k == thr && eqr < krem); eqr += (k == thr); cs += sel; }
            const int sbase = block_exscan(cs, sh, &tot);
            int slot = sbase; eqr = eqbase;
            for (int i = 0; i < 16; ++i) {
                const int s = tid * 16 + i; const unsigned k = keys[s];
                const bool sel = (k > thr) || (k == thr && eqr < krem); eqr += (k == thr);
                if (sel) { TOK[eb * CAP + slot] = b * S + s; GATE[eb * CAP + slot] = __uint_as_float(k); SLOT[(size_t)(b * S + s) * NE + e] = eb * CAP + slot; ++slot; }
            }
        }
    }
    SEAM(ph); ++ph;
    if (IN(ph)) {
        MoeOrder So{(int)gridDim.x, (int)blockIdx.x, 16 * 22, 22};
        if constexpr (layer == 1 || F8L0) {
            int Kg = D / 2; asm volatile("" : "+s"(Kg));
            pg8::Gemm g{H, (const bf16_t*)(ws + WS_WGU8 + (size_t)layer * 176 * MiB), NB * NE * CAP, NE * 5632, Kg, TOK};
            pg8::gemm_phase<EpiSiluMul8, MoeOrder, false, true, true>(ldsp, g, So, EpiSiluMul8{(unsigned char*)HID}, nullptr);
        } else {
            pg8::Gemm g{XE, (const bf16_t*)(ws + WS_WGU) + (size_t)layer * NE * 5632 * D, NB * NE * CAP, NE * 5632, D};
            pg8::gemm_phase<EpiSiluMul, MoeOrder, false>(ldsp, g, So, EpiSiluMul{HID}, nullptr);
        }
    }
    SEAM(ph); ++ph;
    if (IN(ph)) {
        MoeOrder So{(int)gridDim.x, (int)blockIdx.x, 16 * 4, 4};
        if constexpr (layer == 1 || F8L0) {
            int Kg = DE / 2; asm volatile("" : "+s"(Kg));
            pg8::Gemm g{HID, (const bf16_t*)(ws + WS_WD8 + (size_t)layer * 88 * MiB), NB * NE * CAP, NE * D, Kg};
            pg8::gemm_phase<EpiYE8, MoeOrder, false, true>(ldsp, g, So, EpiYE8{GATE, YE}, nullptr);
        } else {
            pg8::Gemm g{HID, (const bf16_t*)(ws + WS_WD) + (size_t)layer * NE * D * DE, NB * NE * CAP, NE * D, DE};
            pg8::gemm_phase<EpiYE, MoeOrder, false>(ldsp, g, So, EpiYE{GATE, YE}, nullptr);
        }
    }
    SEAM(ph); ++ph;
    return ph;
}

__global__ void __launch_bounds__(NTH, 2) mega(Args a) {
    extern __shared__ __attribute__((aligned(16))) unsigned char lds_raw[];
    unsigned* ctl = (unsigned*)(a.ws + WS_CTL);
    volatile LAS unsigned* bst = (volatile LAS unsigned*)((LAS unsigned char*)lds_raw + LDS_BAR_OFF);
    { const int t0_ = tidx(); if (t0_ < 4) bst[t0_] = 0u; }
    __syncthreads();
    XcdBarrier bar; bar.bar = ctl + CW_BAR; bar.x = 0; bar.st = bst;
    if (a.hi - a.lo > 1) bar = xcd_barrier_post(ctl + CW_BAR, bst);
    PROLOG

    int ph = 0;
    if (IN(ph)) REP_LOOP {
        for (int i = gt; i < S * 32; i += ngt) {
            const int s = i >> 5, f = i & 31;
            const float pw = (float)exp((double)((float)(2 * f) / 64.0f) * 9.210340371976184);
            const float invf = 1.0f / pw;
            const float angf = (float)s * invf;
            double xx = (double)angf;
            const double n = rint(xx * 0.15915494309189535);
            xx = (xx - n * 6.283185307179586) - n * 2.4492935982947064e-16;
            const double x2 = xx * xx;
            double cs = 1.0, sn = xx, tc = 1.0, tsn = xx;
#pragma unroll 1
            for (int k = 1; k <= 16; ++k) { tc *= -x2 / (double)((2 * k - 1) * (2 * k)); tsn *= -x2 / (double)((2 * k) * (2 * k + 1)); cs += tc; sn += tsn; }
            ropec[i] = (float)cs; ropes[i] = (float)sn;
        }
        rmsnorm_rows_bf16(x_in, a.in[2], H, T);
        rmsnorm_rows_bf16(mem, a.in[25], MN, NB * MEM); rmsnorm_rows_bf16(mem, a.in[25] + D, MN + NB * MEM * D, NB * MEM);
        LAS float* scr = (LAS float*)((LAS unsigned char*)lds_raw + wave * 16896);
        auto ident = [](int n) { return n; };
        auto emap = [](int n) { const bool il = (n < 1024) || (n >= 1536 && n < 2176); const int j = n & 63; return il ? ((n & ~63) + (j < 32 ? 2 * j : 2 * (j - 32) + 1)) : n; };
        for (int it = gw; it < 16 * 36; it += ngw) transpose_item(a.in[3], D, EVEN_IN, (bf16_t*)(ws + WS_WEIN), emap, scr, it, lane);
        for (int it = gw; it < 2 * 16 * 32; it += ngw) { const int l = it / 512, r = it % 512; transpose_item(a.in[27] + (size_t)l * D * 2048, D, 2048, (bf16_t*)(ws + WS_WKV) + (size_t)l * 2048 * D, ident, scr, r, lane); }
        { float* WRT = (float*)(ws + WS_WRT);
          for (int i = gt; i < 2 * NE * D; i += ngt) { const int l = i >> 14, e = (i >> 10) & 15, k = i & 1023; WRT[i] = a.in[29][l * D + k] * a.in[30][((size_t)l * D + k) * NE + e]; } }
        { bf16_t* Wsb = (bf16_t*)(ws + WS_WSB); const float* wsp = a.in[10];
          for (int i = gt; i < 4 * 128 * 128; i += ngt) Wsb[i] = (bf16_t)f2bf(wsp[i]);
          bf16_t* WL = (bf16_t*)(ws + WS_WL); const float *w2 = a.in[14], *a2 = a.in[16], *g2 = a.in[17];
          for (int i = gt; i < 4 * 512 * 64 + 512 * 128; i += ngt) { float v;
              if (i < 4 * 512 * 64) { const int sec = i >> 15, n = (i >> 6) & 511, k = i & 63; v = (sec < 2 ? w2 : a2)[(size_t)((sec & 1) * 64 + k) * 512 + n]; }
              else { const int j = i - 4 * 512 * 64, n = j >> 7, k = j & 127; v = g2[(size_t)k * 512 + n]; }
              WL[i] = (bf16_t)f2bf(v); } }
        auto gmap = [](int n) { return (n >> 7) * 256 + (n & 127); };
        auto umap = [](int n) { return (n >> 7) * 256 + 128 + (n & 127); };
    }
    SEAM(ph); ++ph;

    if (IN(ph)) dense_gemm(ldsp, H, (const bf16_t*)(ws + WS_WEIN), T, EVEN_IN, D,
                           EpiEven{ropec, ropes, (bf16_t*)(ws + WS_QHA), (bf16_t*)(ws + WS_KHA), (bf16_t*)(ws + WS_QHB), (bf16_t*)(ws + WS_KHB), (bf16_t*)(ws + WS_VTA), (bf16_t*)(ws + WS_VTB)});
    if (IN(ph)) {
        dense_gemm(ldsp, MN, (const bf16_t*)(ws + WS_WKV), NB * MEM, 2048, D, EpiKV{KV, KV + 512 * 1024}, 192);
        dense_gemm(ldsp, MN + NB * MEM * D, (const bf16_t*)(ws + WS_WKV) + (size_t)2048 * D, NB * MEM, 2048, D, EpiKV{KV + 1024 * 1024, KV + 1024 * 1024 + 512 * 1024}, 176);
        if (bid >= 96) {
            __syncthreads();
            LAS float* scr = (LAS float*)((LAS unsigned char*)lds_raw + wave * 16896);
            const int gw3 = (bid - 96) * 8 + wave, ngw3 = (nb - 96) * 8;
            auto ident = [](int n) { return n; };
            auto gmap = [](int n) { return (n >> 7) * 256 + (n & 127); };
        for (int it = gw3; it < 16 * 16; it += ngw3) transpose_item(a.in[5], D, D, (bf16_t*)(ws + WS_WEOUT), ident, scr, it, lane);
        for (int it = gw3; it < 16 * 46; it += ngw3) transpose_item(a.in[7], D, ODD_IN, (bf16_t*)(ws + WS_WOIN), ident, scr, it, lane);
        for (int it = gw3; it < 16 * 16; it += ngw3) transpose_item(a.in[23], D, D, (bf16_t*)(ws + WS_WOOUT), ident, scr, it, lane);
        for (int it = gw3; it < 2 * 16 * 16; it += ngw3) { const int l = it / 256, r = it % 256; transpose_item(a.in[26] + (size_t)l * D * D, D, D, (bf16_t*)(ws + WS_WQ) + (size_t)l * D * D, ident, scr, r, lane, a.in[24] + l * D); }
        for (int it = gw3; it < 2 * 16 * 16; it += ngw3) { const int l = it / 256, r = it % 256; transpose_item(a.in[28] + (size_t)l * D * D, D, D, (bf16_t*)(ws + WS_WO) + (size_t)l * D * D, ident, scr, r, lane); }
            for (int it = gw3; it < 4096; it += ngw3) { const int mt = it / 704, r = it % 704;
                if constexpr (F8L0) transpose_item_fp8(a.in[31] + (size_t)mt * D * DE, D, DE, ws + WS_WGU8 + (size_t)mt * 5632 * D, gmap, GUSC8, scr, r, lane);
                else transpose_item(a.in[31] + (size_t)mt * D * DE, D, DE, (bf16_t*)(ws + WS_WGU) + (size_t)mt * 5632 * D, gmap, scr, r, lane); }
        }
    }
    SEAM(ph); ++ph;
    if (IN(ph)) REP_LOOP attn_phase_even((const bf16_t*)(ws + WS_QHA), (const bf16_t*)(ws + WS_KHA), (const bf16_t*)(ws + WS_VTA), (const bf16_t*)(ws + WS_QHB), (const bf16_t*)(ws + WS_KHB),
                                (const bf16_t*)(ws + WS_VTB), a.in[4], (bf16_t*)(ws + WS_OA), (float*)(ws + WS_LSE), Y, lds_raw);
    SEAM(ph); ++ph;
    if (IN(ph)) REP_LOOP attn_combine((const bf16_t*)(ws + WS_OA), (const float*)(ws + WS_LSE), Y);
    SEAM(ph); ++ph;
    if (IN(ph)) dense_gemm(ldsp, Y, (const bf16_t*)(ws + WS_WEOUT), T, D, D, EpiResidN{x_in, X, H, (float*)(ws + WS_SSP)});
    SEAM(ph); ++ph;

    ph = tail_phases<0>(a, bar, lds_raw, ph);
    ph = odd_phases(a, bar, lds_raw, ph);
    ph = tail_phases<1>(a, bar, lds_raw, ph);

    if (IN(ph)) combine_norm<true>(X, YE, SLOT, a.in[34], nullptr, a.out);
    ++ph;
}
constexpr int NPHASES = 1 + 4 + 2 * 6 + 8 + 1;
#undef IN
#undef SEAM
}

extern "C" void kernel_launch(void* const* d_in, const int* in_sizes, int n_in, void* d_out, int out_size, void* d_ws, size_t ws_size, hipStream_t stream) {
    static int grid = 0;
    if (grid == 0) {
        if (n_in != 35 || out_size != T * D || ws_size < WS_END) { fprintf(stderr, "kernel_launch: unexpected shapes n_in %d out %d ws %zu (need %zu)\n", n_in, out_size, ws_size, (size_t)WS_END); grid = -1; return; }
        int dev = 0, cus = 0, per_cu = 0;
        (void)hipGetDevice(&dev); (void)hipDeviceGetAttribute(&cus, hipDeviceAttributeMultiprocessorCount, dev);
        if (hipFuncSetAttribute((const void*)mega, hipFuncAttributeMaxDynamicSharedMemorySize, LDS_BYTES) != hipSuccess) { fprintf(stderr, "hipFuncSetAttribute failed\n"); grid = -1; return; }
        if (hipOccupancyMaxActiveBlocksPerMultiprocessor(&per_cu, (const void*)mega, NTH, LDS_BYTES) != hipSuccess || per_cu < 1) fprintf(stderr, "occupancy query: %d\n", per_cu);
        (void)hipGetLastError();
        grid = cus > 0 ? cus : 256;
    }
    if (grid < 0) return;
    (void)hipMemsetAsync((char*)d_ws + WS_CTL, 0, CTL_BYTES, stream);
    Args a{};
    for (int i = 0; i < 35; ++i) a.in[i] = (const float*)d_in[i];
    a.out = (float*)d_out; a.ws = (unsigned char*)d_ws;
#if MK_MULTI
    for (int k = 0; k < NPHASES; ++k) { a.lo = k; a.hi = k + 1; hipLaunchKernelGGL(mega, dim3(grid), dim3(NTH), LDS_BYTES, stream, a); }
#else
    a.lo = 0; a.hi = NPHASES; hipLaunchKernelGGL(mega, dim3(grid), dim3(NTH), LDS_BYTES, stream, a);
#endif
}
```

```cpp
#include <hip/hip_runtime.h>
#include <cstdio>
#include <cstdint>

#ifndef PROBE_PHASE
#define PROBE_PHASE (-1)
#endif
#ifndef PROBE_REP
#define PROBE_REP 1
#endif
#ifndef MK_MULTI
#define MK_MULTI 0
#endif

__device__ __forceinline__ int tidx() { int t = threadIdx.x; asm volatile("" : "+v"(t)); return t; }
namespace pg8 {
#define PG8_LAS __attribute__((address_space(3)))
typedef unsigned short bf16_t;
typedef short bf16x8 __attribute__((ext_vector_type(8)));
typedef float f32x4 __attribute__((ext_vector_type(4)));
typedef unsigned u32x4 __attribute__((ext_vector_type(4)));
constexpr int BM = 256, BK = 64, HALF = 128, HTB = HALF * BK * 2  , STAGE_BYTES = 8 * HTB, NXCD = 8, WGM = 8;

__host__ __device__ __forceinline__ int lds_byte(int r, int c) { const int st = (r >> 4) * 2 + (c >> 5), rr = r & 15, cc = c & 31, ob = rr * 64 + cc * 2; return st * 1024 + (ob ^ (((ob >> 9) & 1) << 5)); }
__host__ __device__ __forceinline__ void stage_rc(int b, int& R, int& C) { const int st = b / 1024, sb = b % 1024, swz = sb ^ (((sb >> 9) & 1) << 5); R = (st >> 1) * 16 + swz / 64; C = (st & 1) * 32 + (swz % 64) / 2; }
__host__ __device__ __forceinline__ int perm32(int rho) { const int n = rho >> 4, i = rho & 15; return 8 * (i >> 2) + 4 * n + (i & 3); }

struct Unit { int pm, pn; };
struct Gemm { const bf16_t* A; const bf16_t* Bt; int M, N, K; const int* rowidx = nullptr; };

struct StaticOrder {
    int nM, nN, nwg, G, c;
    __host__ __device__ void init(int M, int N, int G_, int c_) { nM = M / BM; nN = N / BM; nwg = nM * nN; G = G_; c = c_; }
    __host__ __device__ bool next(int i, Unit& u) const {
        const long L = (long)i * G + c; if (L >= nwg) return false;
        int wgid = (int)L; { const int q = nwg / NXCD, r = nwg % NXCD, xcd = wgid % NXCD, off = wgid / NXCD; wgid = (xcd < r ? xcd * (q + 1) : r * (q + 1) + (xcd - r) * q) + off; }
        const int nig = WGM * nN, gid = wgid / nig, fm = gid * WGM, gsz = (nM - fm) < WGM ? (nM - fm) : WGM;
        u.pm = fm + ((wgid % nig) % gsz); u.pn = (wgid % nig) / gsz; return true;
    }
    __device__ __forceinline__ void a_ready(const Unit&) const {}
    __device__ __forceinline__ void done(const Unit&) const {}
};

typedef __bf16 bf16v2_t __attribute__((ext_vector_type(2)));
typedef float f32v2_t __attribute__((ext_vector_type(2)));
__device__ __forceinline__ unsigned cvt_pk_bf16(float lo, float hi) { const f32v2_t v = {lo, hi}; return __builtin_bit_cast(unsigned, __builtin_convertvector(v, bf16v2_t)); }
typedef int i32x8 __attribute__((ext_vector_type(8)));
template <bool F8> __device__ __forceinline__ f32x4 mma_tile(const bf16x8 (&bfr)[2], const bf16x8 (&afr)[2], f32x4 acc) {
    if constexpr (F8) {
        typedef int i32x4_ __attribute__((ext_vector_type(4)));
        const i32x4_ b0 = __builtin_bit_cast(i32x4_, bfr[0]), b1 = __builtin_bit_cast(i32x4_, bfr[1]), a0 = __builtin_bit_cast(i32x4_, afr[0]), a1 = __builtin_bit_cast(i32x4_, afr[1]);
        const i32x8 bb = {b0[0], b0[1], b0[2], b0[3], b1[0], b1[1], b1[2], b1[3]}, aa = {a0[0], a0[1], a0[2], a0[3], a1[0], a1[1], a1[2], a1[3]};
        const int sc1 = 0x7f7f7f7f;
        asm volatile("v_mfma_scale_f32_16x16x128_f8f6f4 %0, %1, %2, %0, %3, %3 op_sel_hi:[0,0,0]" : "+v"(acc) : "v"(bb), "v"(aa), "v"(sc1));
        return acc;
    } else {
        acc = __builtin_amdgcn_mfma_f32_16x16x32_bf16(bfr[0], afr[0], acc, 0, 0, 0);
        return __builtin_amdgcn_mfma_f32_16x16x32_bf16(bfr[1], afr[1], acc, 0, 0, 0);
    }
}
template <class Epi, class Sched, bool STAMP = false, bool F8 = false, bool GATHER = false>
__device__ __forceinline__ void gemm_phase(PG8_LAS unsigned char* lds, const Gemm g, const Sched& S, const Epi& E, unsigned long long* stamps) {
    const int tid = ::tidx(), wid = __builtin_amdgcn_readfirstlane(tid >> 6), lane = tid & 63, wr = wid >> 2, wc = wid & 3, fr = lane & 15, fq = lane >> 4;
    const int K = g.K, nt = K / BK;
    int ts_lo = 0, ts_hi = 0, nts = 0; const unsigned long long rt_entry = STAMP ? (unsigned long long)wall_clock64() : 0ull;
#define PG8_STAMP() do { if (STAMP && wid == 0 && nts < 64) { const unsigned long long _c = (unsigned long long)clock64(); \
        ts_lo = (lane == nts) ? (int)(unsigned)_c : ts_lo; ts_hi = (lane == nts) ? (int)(unsigned)(_c >> 32) : ts_hi; ++nts; } } while (0)
    PG8_STAMP();
    unsigned voffA[2], voffB[2]; int rA[2]; unsigned c2A[2];
#pragma unroll
    for (int i = 0; i < 2; ++i) { int R, C; stage_rc(tid * 16 + i * 8192, R, C); const int Rb = Epi::PERM ? ((R & ~31) + perm32(R & 31)) : R;
        voffA[i] = (unsigned)(R * K + C) * 2u; voffB[i] = (unsigned)(Rb * K + C) * 2u; rA[i] = R; c2A[i] = (unsigned)C * 2u; }
    unsigned gaC[2][2], gaN[2][2];
#define PG8_GATHER_OFFS(dst, pm_) do { _Pragma("unroll") for (int _h = 0; _h < 2; ++_h) _Pragma("unroll") for (int _i = 0; _i < 2; ++_i) \
        dst[_h][_i] = (unsigned)g.rowidx[(pm_) * BM + _h * HALF + rA[_i]] * (unsigned)(K * 2) + c2A[_i]; } while (0)
#define PG8_STAGE_A(bufoff, base, half, usenext) do { if constexpr (GATHER) { unsigned _v[2]; _v[0] = (usenext) ? gaN[half][0] : gaC[half][0]; _v[1] = (usenext) ? gaN[half][1] : gaC[half][1]; PG8_STAGE(bufoff, base, _v); } \
        else PG8_STAGE(bufoff, (base) + (half) * hstep, voffA); } while (0)
    const size_t kstep = (size_t)(BK * 2);
    const size_t hstep = (size_t)HALF * K * 2;
    const size_t tstep = 2 * hstep;
    const unsigned ldsw = (unsigned)wid * 1024u;
    const int aoff = lds_byte(wr * 64 + fr, fq * 8), boff = lds_byte(wc * 32 + fr, fq * 8);
#define PG8_SA(b, h) (((b) * 2 + (h)) * HTB)
#define PG8_SB(b, h) ((4 + (b) * 2 + (h)) * HTB)
#define PG8_STAGE(bufoff, gbase, voff) do { _Pragma("unroll") for (int _i = 0; _i < 2; ++_i) \
        __builtin_amdgcn_global_load_lds((const unsigned*)((const char*)(gbase) + (voff)[_i]), (PG8_LAS unsigned*)(lds + (bufoff) + ldsw + _i * 8192), 16, 0, 0); } while (0)
#define PG8_LDA(dst, b, h) do { _Pragma("unroll") for (int m = 0; m < 4; ++m) _Pragma("unroll") for (int k = 0; k < 2; ++k) dst[m][k] = *(const PG8_LAS bf16x8*)(lds + PG8_SA(b, h) + aoff + m * 2048 + k * 1024); } while (0)
#define PG8_LDB(dst, b, h) do { _Pragma("unroll") for (int n = 0; n < 2; ++n) _Pragma("unroll") for (int k = 0; k < 2; ++k) dst[n][k] = *(const PG8_LAS bf16x8*)(lds + PG8_SB(b, h) + boff + n * 2048 + k * 1024); } while (0)
#define PG8_MMA(ai, bj, At, Bt) do { __builtin_amdgcn_s_setprio(1); _Pragma("unroll") for (int m = 0; m < 4; ++m) _Pragma("unroll") for (int n = 0; n < 2; ++n) \
        acc[ai][bj][m][n] = mma_tile<F8>(Bt[n], At[m], acc[ai][bj][m][n]); __builtin_amdgcn_s_setprio(0); } while (0)
#define PG8_WAIT_V(n) asm volatile("s_waitcnt vmcnt(" #n ")" ::: "memory")
#define PG8_WAIT_L(n) asm volatile("s_waitcnt lgkmcnt(" #n ")" ::: "memory")
#define PG8_BAR __builtin_amdgcn_s_barrier()
#define PG8_SCHED __builtin_amdgcn_sched_barrier(0)
    Unit cur, nxt; int ui = 0;
    if (!S.next(0, cur)) return;
    f32x4 acc[2][2][4][2];
#pragma unroll
    for (int a = 0; a < 2; ++a)
#pragma unroll
        for (int b = 0; b < 2; ++b)
#pragma unroll
            for (int m = 0; m < 4; ++m)
#pragma unroll
                for (int n = 0; n < 2; ++n) acc[a][b][m][n] = (f32x4){0.f, 0.f, 0.f, 0.f};
    bf16x8 At[4][2], B0[2][2], B1[2][2];
    const char* cA = GATHER ? (const char*)g.A : (const char*)g.A + (size_t)cur.pm * tstep; const char* cB = (const char*)g.Bt + (size_t)cur.pn * tstep;
    if constexpr (GATHER) { PG8_GATHER_OFFS(gaC, cur.pm); _Pragma("unroll") for (int _h = 0; _h < 2; ++_h) _Pragma("unroll") for (int _i = 0; _i < 2; ++_i) gaN[_h][_i] = gaC[_h][_i]; }
    S.a_ready(cur);
    PG8_STAGE(PG8_SB(0, 0), cB, voffB); PG8_STAGE_A(PG8_SA(0, 0), cA, 0, false); PG8_STAGE(PG8_SB(0, 1), cB + hstep, voffB); PG8_STAGE_A(PG8_SA(0, 1), cA, 1, false);
    if (wr == 1) PG8_BAR;
    PG8_WAIT_V(4); PG8_BAR;
    PG8_STAGE(PG8_SB(1, 0), cB + kstep, voffB); PG8_STAGE_A(PG8_SA(1, 0), cA + kstep, 0, false); PG8_STAGE(PG8_SB(1, 1), cB + hstep + kstep, voffB);
    PG8_WAIT_V(6); PG8_BAR;
    PG8_STAMP();
    for (;;) {
        const bool has_next = S.next(ui + 1, nxt);
        const char* nA = GATHER ? (const char*)g.A : (has_next ? (const char*)g.A + (size_t)nxt.pm * tstep : cA); const char* nB = has_next ? (const char*)g.Bt + (size_t)nxt.pn * tstep : cB;
        if constexpr (GATHER) { if (has_next) PG8_GATHER_OFFS(gaN, nxt.pm); }
        for (int t = 0; t < nt; t += 2) {
            const bool last = (t == nt - 2);
            const char* a1 = cA + (size_t)(t + 1) * kstep;
            const char* a2 = last ? nA : cA + (size_t)(t + 2) * kstep; const char* b2 = last ? nB : cB + (size_t)(t + 2) * kstep;
            const char* a3 = a2 + kstep; const char* b3 = b2 + kstep;
            if (last && has_next) S.a_ready(nxt);
            PG8_LDB(B0, 0, 0); PG8_SCHED; PG8_LDA(At, 0, 0); PG8_STAGE_A(PG8_SA(1, 1), a1, 1, false);
            PG8_WAIT_L(8); PG8_BAR; PG8_WAIT_L(0); PG8_MMA(0, 0, At, B0); PG8_BAR; PG8_SCHED;
            PG8_LDB(B1, 0, 1); PG8_STAGE(PG8_SB(0, 0), b2, voffB);
            PG8_BAR; PG8_WAIT_L(0); PG8_MMA(0, 1, At, B1); PG8_BAR;
            PG8_LDA(At, 0, 1); PG8_STAGE_A(PG8_SA(0, 0), a2, 0, last);
            PG8_BAR; PG8_WAIT_L(0); PG8_MMA(1, 0, At, B0); PG8_BAR; PG8_SCHED;
            PG8_STAGE(PG8_SB(0, 1), b2 + hstep, voffB);
            PG8_WAIT_V(6); PG8_BAR; PG8_MMA(1, 1, At, B1); PG8_BAR;
            PG8_LDB(B0, 1, 0); PG8_SCHED; PG8_LDA(At, 1, 0); PG8_STAGE_A(PG8_SA(0, 1), a2, 1, last);
            PG8_WAIT_L(8); PG8_BAR; PG8_WAIT_L(0); PG8_MMA(0, 0, At, B0); PG8_BAR; PG8_SCHED;
            PG8_LDB(B1, 1, 1); PG8_STAGE(PG8_SB(1, 0), b3, voffB);
            PG8_BAR; PG8_WAIT_L(0); PG8_MMA(0, 1, At, B1); PG8_BAR;
            PG8_LDA(At, 1, 1); PG8_STAGE_A(PG8_SA(1, 0), a3, 0, last);
            PG8_BAR; PG8_WAIT_L(0); PG8_MMA(1, 0, At, B0); PG8_BAR; PG8_SCHED;
            PG8_STAGE(PG8_SB(1, 1), b3 + hstep, voffB);
            PG8_WAIT_V(6); PG8_BAR; PG8_MMA(1, 1, At, B1); PG8_BAR;
        }
        PG8_STAMP();
        if constexpr (!Epi::AFTER_DRAIN) { E(acc, cur, wr, wc, fr, fq); S.done(cur); }
        PG8_STAMP();
        if (!has_next) break;
#pragma unroll
        for (int a = 0; a < 2; ++a)
#pragma unroll
            for (int b = 0; b < 2; ++b)
#pragma unroll
                for (int m = 0; m < 4; ++m)
#pragma unroll
                    for (int n = 0; n < 2; ++n) acc[a][b][m][n] = (f32x4){0.f, 0.f, 0.f, 0.f};
        cur = nxt; cA = nA; cB = nB; ++ui;
        if constexpr (GATHER) { _Pragma("unroll") for (int _h = 0; _h < 2; ++_h) _Pragma("unroll") for (int _i = 0; _i < 2; ++_i) gaC[_h][_i] = gaN[_h][_i]; }
    }
    PG8_WAIT_V(0);
    if (wr == 0) PG8_BAR;
    PG8_BAR;
    if constexpr (Epi::AFTER_DRAIN) { E.fused(acc, cur, wr, wc, fr, fq, lds, wid, lane); S.done(cur); }
    PG8_STAMP();
    if (STAMP && wid == 0) { stamps[lane] = lane < nts ? (((unsigned long long)(unsigned)ts_hi << 32) | (unsigned)ts_lo) : 0ull;
        if (lane == 62) stamps[62] = rt_entry; if (lane == 63) stamps[63] = (unsigned long long)wall_clock64(); }
#undef PG8_STAMP
#undef PG8_SA
#undef PG8_SB
#undef PG8_STAGE
#undef PG8_STAGE_A
#undef PG8_GATHER_OFFS
#undef PG8_LDA
#undef PG8_LDB
#undef PG8_MMA
#undef PG8_WAIT_V
#undef PG8_WAIT_L
#undef PG8_BAR
#undef PG8_SCHED
}
}


namespace {
using pg8::bf16_t; using pg8::f32x4;
constexpr int D = 1024, NB = 2, S = 8192, T = NB * S;
constexpr int EVEN_IN = 2304, ODD_IN = 2944, ODD_PAD = 3072, FD = 1920;
constexpr int MEM = 256, NE = 16, CAP = 1024, DE = 2816;
constexpr int NTH = 512;
constexpr size_t MiB = 1u << 20;
constexpr size_t WS_CTL = 0, CTL_BYTES = 1 * MiB;
constexpr size_t WS_ROPE = 1 * MiB;
constexpr size_t WS_AFF = 4 * MiB;
constexpr size_t WS_TOK = 5 * MiB;
constexpr size_t WS_GATE = 6 * MiB;
constexpr size_t WS_WRT = 3 * MiB;
constexpr size_t WS_SLOT = 7 * MiB;
constexpr size_t WS_X = 8 * MiB;
constexpr size_t WS_H = 72 * MiB;
constexpr size_t WS_Y = 104 * MiB;
constexpr size_t WS_P = 136 * MiB;
constexpr size_t WS_Q = 320 * MiB;
constexpr size_t WS_KV = 384 * MiB;
constexpr size_t WS_MN = 388 * MiB;
constexpr size_t WS_SSP = 390 * MiB;
constexpr size_t WS_DEC = 392 * MiB;
constexpr size_t WS_KD = 456 * MiB;
constexpr size_t WS_BB = 520 * MiB;
constexpr size_t WS_KK = 584 * MiB;
constexpr size_t WS_G = 616 * MiB;
constexpr size_t WS_YS = 648 * MiB;
constexpr size_t WS_RV = 712 * MiB;
constexpr size_t WS_VN = 776 * MiB;
constexpr size_t WS_QHA = 136 * MiB;
constexpr size_t WS_KHA = 152 * MiB;
constexpr size_t WS_QHB = 168 * MiB;
constexpr size_t WS_KHB = 184 * MiB;
constexpr size_t WS_PVB = 188 * MiB;
constexpr size_t WS_VTA = 208 * MiB;
constexpr size_t WS_VTB = 256 * MiB;
constexpr size_t WS_OA = 260 * MiB;
constexpr size_t WS_LSE = 308 * MiB;
constexpr size_t WS_QT = 136 * MiB;
constexpr size_t WS_YL = 200 * MiB;
constexpr size_t WS_PT = 264 * MiB;
constexpr size_t WS_RH = 296 * MiB;
constexpr size_t WS_S0 = 328 * MiB;
constexpr size_t WS_XE = 136 * MiB;
constexpr size_t WS_YE = 136 * MiB;
constexpr size_t WS_HID = 200 * MiB;
constexpr size_t WS_KB = 360 * MiB;
constexpr size_t WS_F5 = 792 * MiB;
constexpr size_t WS_WSB = 804 * MiB;
constexpr size_t WS_WL = 805 * MiB;
constexpr size_t WS_WEIN = 808 * MiB;
constexpr size_t WS_WEOUT = 813 * MiB;
constexpr size_t WS_WOIN = 815 * MiB;
constexpr size_t WS_WOOUT = 821 * MiB;
constexpr size_t WS_WQ = 823 * MiB;
constexpr size_t WS_WKV = 827 * MiB;
constexpr size_t WS_WO = 835 * MiB;
constexpr size_t WS_WGU = 840 * MiB;
constexpr size_t WS_WD = 1192 * MiB;
constexpr size_t WS_WGU8 = 840 * MiB;
constexpr size_t WS_WD8 = 1192 * MiB;
constexpr size_t WS_END = 1368 * MiB;
constexpr bool F8L0 = true;
constexpr float ASC8 = 16.f, GUSC8 = 128.f, HSC8 = 4.f, DSC8 = 256.f;
constexpr int CW_BAR = 4096;

constexpr int LDS_BYTES = 147456;
constexpr int LDS_BAR_OFF = LDS_BYTES - 64;

#define LAS __attribute__((address_space(3)))
#define XB_TMO      128
#define XB_XCNT(j)  (256  + 64 * (j))
#define XB_XSUB(j)  (1280 + 64 * (j))
#define XB_XGEN(j)  (2304 + 64 * (j))
#define XB_TOP      3328
#define XB_TOPGEN   3392
#define XCD_BAR_WORDS 3456
#define XB_SPIN_CAP (1u << 22)
__device__ __forceinline__ unsigned xb_ld(unsigned* p)              { return __hip_atomic_load(p, __ATOMIC_RELAXED, __HIP_MEMORY_SCOPE_AGENT); }
__device__ __forceinline__ unsigned xb_add(unsigned* p, unsigned v) { return __hip_atomic_fetch_add(p, v, __ATOMIC_RELAXED, __HIP_MEMORY_SCOPE_AGENT); }
__device__ __forceinline__ unsigned xb_xcc_id() { return (unsigned)__builtin_amdgcn_s_getreg((3 << 11) | 20) & 0xFu; }
#define XB_SPIN(cond, bar) do { unsigned _sp = 0; while (cond) { __builtin_amdgcn_s_sleep(1); \
    if ((++_sp & 255u) == 0u) { if (xb_ld(&(bar)[XB_TMO])) break; if (_sp > XB_SPIN_CAP) { atomicAdd(&(bar)[XB_TMO], 1u); break; } } } } while (0)
struct XcdBarrier { unsigned* bar; unsigned x; volatile LAS unsigned* st; };
__device__ __forceinline__ XcdBarrier xcd_barrier_post(unsigned* bar, volatile LAS unsigned* st) {
    XcdBarrier b; b.bar = bar; b.x = xb_xcc_id(); b.st = st;
    if (threadIdx.x == 0) (void)xb_add(&bar[XB_XCNT(b.x)], 1u);
    return b;
}
__device__ __forceinline__ void xcd_barrier_complete(unsigned* bar, unsigned x, unsigned& nloc, unsigned& nx) {
    const unsigned G = gridDim.x * gridDim.y * gridDim.z;
    unsigned sum, cnt, mine, sp = 0u;
    for (;;) {
        sum = 0u; cnt = 0u; mine = 0u;
#pragma unroll
        for (unsigned j = 0; j < 16; ++j) { const unsigned c = xb_ld(&bar[XB_XCNT(j)]); sum += c; cnt += (c > 0u) ? 1u : 0u; mine = (j == x) ? c : mine; }
        if (sum == G) break;
        __builtin_amdgcn_s_sleep(1);
        if ((++sp & 255u) == 0u) { if (xb_ld(&bar[XB_TMO])) break; if (sp > XB_SPIN_CAP) { atomicAdd(&bar[XB_TMO], 1u); break; } }
    }
    nloc = mine > 0u ? mine : 1u; nx = cnt > 0u ? cnt : 1u;
}
__device__ __forceinline__ void xcd_barrier(const XcdBarrier& b) {
    asm volatile("s_waitcnt vmcnt(0)" ::: "memory");
    __syncthreads();
    if (threadIdx.x == 0) {
        unsigned* bar = b.bar;
        __builtin_amdgcn_s_waitcnt(0);
        unsigned nloc = b.st[0], nx = b.st[1];
        if (nloc == 0u) { xcd_barrier_complete(bar, b.x, nloc, nx); b.st[0] = nloc; b.st[1] = nx; }
        const unsigned old = xb_add(&bar[XB_XSUB(b.x)], 1u);
        const unsigned gen = old / nloc;
        if (old + 1u == (gen + 1u) * nloc) {
            __builtin_amdgcn_fence(__ATOMIC_RELEASE, "agent");
            asm volatile("s_waitcnt vmcnt(0)" ::: "memory");
            const unsigned og = xb_add(&bar[XB_TOP], 1u);
            const unsigned tg = og / nx;
            if (og + 1u == (tg + 1u) * nx) xb_add(&bar[XB_TOPGEN], 1u);
            else XB_SPIN(xb_ld(&bar[XB_TOPGEN]) == tg, bar);
            __builtin_amdgcn_fence(__ATOMIC_ACQUIRE, "agent");
            xb_add(&bar[XB_XGEN(b.x)], 1u);
            asm volatile("s_waitcnt vmcnt(0)" ::: "memory");
        } else {
            XB_SPIN(xb_ld(&bar[XB_XGEN(b.x)]) == gen, bar);
            __builtin_amdgcn_fence(__ATOMIC_ACQUIRE, "agent");
            asm volatile("s_waitcnt vmcnt(0)" ::: "memory");
        }
    }
    __syncthreads();
}

__device__ __forceinline__ float wave_sum(float v) {
#pragma unroll
    for (int o = 32; o >= 1; o >>= 1) v += __shfl_xor(v, o);
    return v;
}
__device__ __forceinline__ float frcp(float x) { return __builtin_amdgcn_rcpf(x); }
__device__ __forceinline__ float sigmoidf_(float x) { return frcp(1.0f + __expf(-x)); }
__device__ __forceinline__ float tanhf_(float x) { return 2.0f * sigmoidf_(2.0f * x) - 1.0f; }
__device__ __forceinline__ float gelu_tanh(float x) { return x * sigmoidf_(1.5957691216057308f * (x + 0.044715f * x * x * x)); }
__device__ __forceinline__ unsigned f2bf(float f) { unsigned u = __builtin_bit_cast(unsigned, f); return (u + 0x7fffu + ((u >> 16) & 1u)) >> 16; }
__device__ __forceinline__ unsigned pk2(float lo, float hi) { return pg8::cvt_pk_bf16(lo, hi); }
__device__ __forceinline__ float bflo(unsigned w) { return __uint_as_float(w << 16); }
__device__ __forceinline__ float bfhi(unsigned w) { return __uint_as_float(w & 0xffff0000u); }
typedef unsigned v4u __attribute__((ext_vector_type(4)));
typedef unsigned v2u __attribute__((ext_vector_type(2)));

struct Args { const float* in[35]; float* out; unsigned char* ws; int lo, hi; };

struct EpiF32Store {
    static constexpr bool PERM = false, AFTER_DRAIN = false;
    float* C; int ldc; int nvalid;
    __device__ __forceinline__ void operator()(const f32x4 (&acc)[2][2][4][2], const pg8::Unit& u, int wr, int wc, int fr, int fq) const {
        const int row0 = u.pm * 256 + wr * 64 + fr, col0 = u.pn * 256 + wc * 32 + 4 * fq;
#pragma unroll
        for (int ai = 0; ai < 2; ++ai)
#pragma unroll
            for (int m = 0; m < 4; ++m) { float* rowp = C + (size_t)(row0 + ai * 128 + m * 16) * ldc + col0;
#pragma unroll
                for (int bj = 0; bj < 2; ++bj)
#pragma unroll
                    for (int n = 0; n < 2; ++n) if (col0 + bj * 128 + n * 16 < nvalid) *(f32x4*)(rowp + bj * 128 + n * 16) = acc[ai][bj][m][n]; }
    }
};
struct EpiResid {
    static constexpr bool PERM = false, AFTER_DRAIN = false;
    const float* base; float* out;
    __device__ __forceinline__ void operator()(const f32x4 (&acc)[2][2][4][2], const pg8::Unit& u, int wr, int wc, int fr, int fq) const {
        const int row0 = u.pm * 256 + wr * 64 + fr, col0 = u.pn * 256 + wc * 32 + 4 * fq;
#pragma unroll
        for (int ai = 0; ai < 2; ++ai)
#pragma unroll
            for (int m = 0; m < 4; ++m) { const size_t off = (size_t)(row0 + ai * 128 + m * 16) * D + col0;
#pragma unroll
                for (int bj = 0; bj < 2; ++bj)
#pragma unroll
                    for (int n = 0; n < 2; ++n) { const f32x4 b = *(const f32x4*)(base + off + bj * 128 + n * 16); *(f32x4*)(out + off + bj * 128 + n * 16) = b + acc[ai][bj][m][n]; } }
    }
};
struct EpiSiluMul {
    static constexpr bool PERM = false, AFTER_DRAIN = false;
    bf16_t* HIDp;
    __device__ __forceinline__ void operator()(const f32x4 (&acc)[2][2][4][2], const pg8::Unit& u, int wr, int wc, int fr, int fq) const {
        const int pnl = u.pn % 22;
        const int row0 = u.pm * 256 + wr * 64 + fr, col0 = pnl * 128 + wc * 32 + 4 * fq;
#pragma unroll
        for (int ai = 0; ai < 2; ++ai)
#pragma unroll
            for (int m = 0; m < 4; ++m) { bf16_t* rowp = HIDp + (size_t)(row0 + ai * 128 + m * 16) * DE + col0;
#pragma unroll
                for (int n = 0; n < 2; ++n) { const f32x4 g = acc[ai][0][m][n], up = acc[ai][1][m][n]; float h[4];
#pragma unroll
                    for (int j = 0; j < 4; ++j) h[j] = g[j] * frcp(1.0f + __expf(-g[j])) * up[j];
                    v2u w; w.x = pk2(h[0], h[1]); w.y = pk2(h[2], h[3]); *(v2u*)(rowp + n * 16) = w; } }
    }
};
struct EpiYE {
    static constexpr bool PERM = true, AFTER_DRAIN = false;
    const float* GATE; bf16_t* YE;
    __device__ __forceinline__ void operator()(const f32x4 (&acc)[2][2][4][2], const pg8::Unit& u, int wr, int wc, int fr, int fq) const {
        const int pnl = u.pn & 3;
        const int row0 = u.pm * 256 + wr * 64 + fr, col0 = pnl * 256 + wc * 32 + 8 * fq;
#pragma unroll
        for (int ai = 0; ai < 2; ++ai)
#pragma unroll
            for (int m = 0; m < 4; ++m) { const int row = row0 + ai * 128 + m * 16; const float gt_ = GATE[row]; bf16_t* rowp = YE + (size_t)row * D + col0;
#pragma unroll
                for (int bj = 0; bj < 2; ++bj) { const f32x4 v0 = acc[ai][bj][m][0] * gt_, v1 = acc[ai][bj][m][1] * gt_;
                    v4u w; w.x = pg8::cvt_pk_bf16(v0[0], v0[1]); w.y = pg8::cvt_pk_bf16(v0[2], v0[3]); w.z = pg8::cvt_pk_bf16(v1[0], v1[1]); w.w = pg8::cvt_pk_bf16(v1[2], v1[3]);
                    *(v4u*)(rowp + bj * 128) = w; } }
    }
};
struct EpiBf16Store {
    static constexpr bool PERM = true, AFTER_DRAIN = false;
    bf16_t* O; int ldc; float scale;
    __device__ __forceinline__ void operator()(const f32x4 (&acc)[2][2][4][2], const pg8::Unit& u, int wr, int wc, int fr, int fq) const {
        const int row0 = u.pm * 256 + wr * 64 + fr, col0 = u.pn * 256 + wc * 32 + 8 * fq;
#pragma unroll
        for (int ai = 0; ai < 2; ++ai)
#pragma unroll
            for (int m = 0; m < 4; ++m) { bf16_t* rowp = O + (size_t)(row0 + ai * 128 + m * 16) * ldc + col0;
#pragma unroll
                for (int bj = 0; bj < 2; ++bj) { const f32x4 v0 = acc[ai][bj][m][0] * scale, v1 = acc[ai][bj][m][1] * scale;
                    v4u w; w.x = pg8::cvt_pk_bf16(v0[0], v0[1]); w.y = pg8::cvt_pk_bf16(v0[2], v0[3]); w.z = pg8::cvt_pk_bf16(v1[0], v1[1]); w.w = pg8::cvt_pk_bf16(v1[2], v1[3]);
                    *(v4u*)(rowp + bj * 128) = w; } }
    }
};
struct EpiKV {
    static constexpr bool PERM = false, AFTER_DRAIN = false;
    bf16_t* K; bf16_t* Vt;
    __device__ __forceinline__ void operator()(const f32x4 (&acc)[2][2][4][2], const pg8::Unit& u, int wr, int wc, int fr, int fq) const {
        const int row0 = u.pm * 256 + wr * 64 + fr, col0 = u.pn * 256 + wc * 32 + 4 * fq;
#pragma unroll
        for (int ai = 0; ai < 2; ++ai)
#pragma unroll
            for (int m = 0; m < 4; ++m) { const int row = row0 + ai * 128 + m * 16;
#pragma unroll
                for (int bj = 0; bj < 2; ++bj)
#pragma unroll
                    for (int n = 0; n < 2; ++n) { const int col = col0 + bj * 128 + n * 16; const f32x4 v = acc[ai][bj][m][n];
                        if (col < 1024) { v2u w; w.x = pk2(v[0], v[1]); w.y = pk2(v[2], v[3]); *(v2u*)(K + (size_t)row * 1024 + col) = w; }
                        else { const int b = row >> 8, mm = row & 255; bf16_t* vp = Vt + ((size_t)(b * 1024 + (col - 1024)) * 256 + mm);
#pragma unroll
                            for (int j = 0; j < 4; ++j) vp[(size_t)j * 256] = (bf16_t)f2bf(v[j]); } } }
    }
};

constexpr float QSCALE = 0.125f * 1.4426950408889634f;
struct EpiEven {
    static constexpr bool PERM = true, AFTER_DRAIN = false;
    const float* rc; const float* rs; bf16_t* QhA; bf16_t* KhA; bf16_t* QhB; bf16_t* KhB; bf16_t* VhA; bf16_t* VhB;
    __device__ __forceinline__ void operator()(const f32x4 (&acc)[2][2][4][2], const pg8::Unit& u, int wr, int wc, int fr, int fq) const {
        asm volatile("" : "+v"(fr), "+v"(fq));
        const int row0 = u.pm * 256 + wr * 64 + fr;
#pragma unroll
        for (int bj = 0; bj < 2; ++bj) {
            const int c0 = u.pn * 256 + bj * 128 + wc * 32 + 8 * fq;
            int kind; bf16_t* base; int stride; float sc = 1.0f;
            if (c0 < 512) { kind = 0; base = QhA + ((size_t)(c0 >> 6) * T) * 64 + (c0 & 63); stride = 64; sc = QSCALE; }
            else if (c0 < 1024) { kind = 0; base = KhA + ((size_t)((c0 - 512) >> 6) * T) * 64 + (c0 & 63); stride = 64; }
            else if (c0 < 1536) { kind = 1; base = VhA + ((size_t)((c0 - 1024) >> 6) * T) * 64 + (c0 & 63); stride = 64; }
            else if (c0 < 2048) { kind = 0; base = QhB + ((size_t)((c0 - 1536) >> 6) * T) * 64 + (c0 & 63); stride = 64; sc = QSCALE; }
            else if (c0 < 2176) { kind = 0; base = KhB + ((size_t)((c0 - 2048) >> 6) * T) * 64 + (c0 & 63); stride = 64; }
            else { kind = 1; base = VhB + ((size_t)((c0 - 2176) >> 6) * T) * 64 + (c0 & 63); stride = 64; }
            const int pi = (c0 & 63) >> 1;
#pragma unroll
            for (int ai = 0; ai < 2; ++ai)
#pragma unroll
                for (int m = 0; m < 4; ++m) {
                    const int tok = row0 + ai * 128 + m * 16;
                    const f32x4 v0 = acc[ai][bj][m][0], v1 = acc[ai][bj][m][1];
                    float y[8];
                    if (kind == 0) {
                        const int s = tok & (S - 1);
                        const f32x4 c4 = *(const f32x4*)(rc + s * 32 + pi), s4 = *(const f32x4*)(rs + s * 32 + pi);
                        y[0] = (v0[0] * c4[0] - v0[1] * s4[0]) * sc; y[1] = (v0[1] * c4[0] + v0[0] * s4[0]) * sc;
                        y[2] = (v0[2] * c4[1] - v0[3] * s4[1]) * sc; y[3] = (v0[3] * c4[1] + v0[2] * s4[1]) * sc;
                        y[4] = (v1[0] * c4[2] - v1[1] * s4[2]) * sc; y[5] = (v1[1] * c4[2] + v1[0] * s4[2]) * sc;
                        y[6] = (v1[2] * c4[3] - v1[3] * s4[3]) * sc; y[7] = (v1[3] * c4[3] + v1[2] * s4[3]) * sc;
                    } else { y[0] = v0[0]; y[1] = v0[1]; y[2] = v0[2]; y[3] = v0[3]; y[4] = v1[0]; y[5] = v1[1]; y[6] = v1[2]; y[7] = v1[3]; }
                    v4u w; w.x = pk2(y[0], y[1]); w.y = pk2(y[2], y[3]); w.z = pk2(y[4], y[5]); w.w = pk2(y[6], y[7]);
                    *(v4u*)(base + (size_t)tok * stride) = w;
                }
        }
    }
};

struct EpiLora {
    static constexpr bool PERM = false, AFTER_DRAIN = false;
    const float *w0, *a0, *k_a; const bf16_t *KB, *KK; bf16_t *LW, *KD, *BB, *G;
    __device__ __forceinline__ void operator()(const f32x4 (&acc)[2][2][4][2], const pg8::Unit& u, int wr, int wc, int fr, int fq) const {
        asm volatile("" : "+v"(fr), "+v"(fq));
        const int row0 = u.pm * 256 + wr * 64 + fr;
#pragma unroll
        for (int bj = 0; bj < 2; ++bj)
#pragma unroll
            for (int n = 0; n < 2; ++n) {
                const int c0 = u.pn * 256 + bj * 128 + wc * 32 + n * 16 + 4 * fq, sec = c0 >> 9, cc = c0 & 511;
#pragma unroll
                for (int ai = 0; ai < 2; ++ai)
#pragma unroll
                    for (int m = 0; m < 4; ++m) {
                        const size_t tok = row0 + ai * 128 + m * 16;
                        const f32x4 v = acc[ai][bj][m][n];
                        if (sec < 2) {
                            const f32x4 w = *(const f32x4*)(w0 + sec * 512 + cc); float o[4];
#pragma unroll
                            for (int j = 0; j < 4; ++j) { const float xw = -(w[j] + v[j]);
                                o[j] = -0.6065306597126334f * frcp(1.0f + __expf(xw)); }
                            v2u ww; ww.x = pk2(o[0], o[1]); ww.y = pk2(o[2], o[3]);
                            *(v2u*)(LW + ((size_t)sec * T + tok) * 512 + cc) = ww;
                        } else if (sec < 4) {
                            const int d = sec - 2;
                            const f32x4 a_ = *(const f32x4*)(a0 + d * 512 + cc), ka = *(const f32x4*)(k_a + cc);
                            const v2u kw = *(const v2u*)(KB + tok * 512 + cc), kkw = *(const v2u*)(KK + tok * 512 + cc);
                            const float kv[4] = {bflo(kw.x), bfhi(kw.x), bflo(kw.y), bfhi(kw.y)}, kk[4] = {bflo(kkw.x), bfhi(kkw.x), bflo(kkw.y), bfhi(kkw.y)};
                            float okd[4], obb[4];
#pragma unroll
                            for (int j = 0; j < 4; ++j) { const float alr = frcp(1.0f + __expf(-(a_[j] + v[j]))); okd[j] = kv[j] * (1.0f + (alr - 1.0f) * ka[j]); obb[j] = kk[j] * alr; }
                            v2u w1, w2_; w1.x = pk2(okd[0], okd[1]); w1.y = pk2(okd[2], okd[3]); w2_.x = pk2(obb[0], obb[1]); w2_.y = pk2(obb[2], obb[3]);
                            *(v2u*)(KD + ((size_t)d * T + tok) * 512 + cc) = w1; *(v2u*)(BB + ((size_t)d * T + tok) * 512 + cc) = w2_;
                        } else { v2u ww; ww.x = pk2(v[0], v[1]); ww.y = pk2(v[2], v[3]); *(v2u*)(G + tok * 512 + cc) = ww; }
                        __builtin_amdgcn_sched_barrier(0);
                    }
            }
    }
};

__device__ __forceinline__ float clamp8(float x) { return __builtin_amdgcn_fmed3f(x, -448.f, 448.f); }
__device__ __forceinline__ unsigned pk4_fp8(float a, float b, float c, float d) {
    int w = 0; w = __builtin_amdgcn_cvt_pk_fp8_f32(clamp8(a), clamp8(b), w, false); w = __builtin_amdgcn_cvt_pk_fp8_f32(clamp8(c), clamp8(d), w, true); return (unsigned)w;
}
struct EpiSiluMul8 {
    static constexpr bool PERM = true, AFTER_DRAIN = false;
    unsigned char* HIDp;
    __device__ __forceinline__ void operator()(const f32x4 (&acc)[2][2][4][2], const pg8::Unit& u, int wr, int wc, int fr, int fq) const {
        asm volatile("s_nop 7\n\ts_nop 7\n\ts_nop 7"); __builtin_amdgcn_sched_barrier(0);
        const int pnl = u.pn % 22;
        const int row0 = u.pm * 256 + wr * 64 + fr, col0 = pnl * 128 + wc * 32 + 8 * fq;
        const float s1 = 1.0f / (ASC8 * GUSC8);
#pragma unroll
        for (int ai = 0; ai < 2; ++ai)
#pragma unroll
            for (int m = 0; m < 4; ++m) { unsigned char* rowp = HIDp + (size_t)(row0 + ai * 128 + m * 16) * DE + col0; float h[8];
#pragma unroll
                for (int n = 0; n < 2; ++n) { const f32x4 g = acc[ai][0][m][n] * s1, up = acc[ai][1][m][n] * (s1 * HSC8);
#pragma unroll
                    for (int j = 0; j < 4; ++j) h[4 * n + j] = g[j] * frcp(1.0f + __expf(-g[j])) * up[j]; }
                v2u w; w.x = pk4_fp8(h[0], h[1], h[2], h[3]); w.y = pk4_fp8(h[4], h[5], h[6], h[7]);
                __builtin_nontemporal_store(w, (v2u*)rowp); }
    }
};
struct EpiYE8 {
    static constexpr bool PERM = true, AFTER_DRAIN = false;
    const float* GATE; bf16_t* YE;
    __device__ __forceinline__ void operator()(const f32x4 (&acc)[2][2][4][2], const pg8::Unit& u, int wr, int wc, int fr, int fq) const {
        asm volatile("s_nop 7\n\ts_nop 7\n\ts_nop 7"); __builtin_amdgcn_sched_barrier(0);
        const int pnl = u.pn & 3;
        const int row0 = u.pm * 256 + wr * 64 + fr, col0 = pnl * 256 + wc * 32 + 8 * fq;
#pragma unroll
        for (int ai = 0; ai < 2; ++ai)
#pragma unroll
            for (int m = 0; m < 4; ++m) { const int row = row0 + ai * 128 + m * 16; const float gt_ = GATE[row] * (1.0f / (HSC8 * DSC8)); bf16_t* rowp = YE + (size_t)row * D + col0;
#pragma unroll
                for (int bj = 0; bj < 2; ++bj) { const f32x4 v0 = acc[ai][bj][m][0] * gt_, v1 = acc[ai][bj][m][1] * gt_;
                    v4u w; w.x = pk2(v0[0], v0[1]); w.y = pk2(v0[2], v0[3]); w.z = pk2(v1[0], v1[1]); w.w = pk2(v1[2], v1[3]);
                    *(v4u*)(rowp + bj * 128) = w; } }
    }
};
template <class RowMap>
__device__ __forceinline__ void transpose_item_fp8(const float* W, int K, int N, unsigned char* WT, RowMap rm, float sc, LAS float* scr, int item, int lane) {
    const int nblk = N / 64, kb = item / nblk, nb_ = item % nblk, k0 = 64 * kb, n0 = 64 * nb_;
    f32x4 ld[16];
#pragma unroll
    for (int i = 0; i < 16; ++i) ld[i] = *(const f32x4*)(W + (size_t)(k0 + 4 * i + (lane >> 4)) * N + n0 + 4 * (lane & 15));
#pragma unroll
    for (int i = 0; i < 16; ++i) { LAS float* p = scr + (4 * i + (lane >> 4)) * 65 + 4 * (lane & 15); p[0] = ld[i][0]; p[1] = ld[i][1]; p[2] = ld[i][2]; p[3] = ld[i][3]; }
    asm volatile("s_waitcnt lgkmcnt(0)" ::: "memory");
    const int c = lane & 3;
#pragma unroll
    for (int j = 0; j < 4; ++j) { const int n = (lane >> 2) + 16 * j; const LAS float* s = scr + (16 * c) * 65 + n;
        v4u o;
#pragma unroll
        for (int q = 0; q < 4; ++q) o[q] = pk4_fp8(s[(4 * q) * 65] * sc, s[(4 * q + 1) * 65] * sc, s[(4 * q + 2) * 65] * sc, s[(4 * q + 3) * 65] * sc);
        *(v4u*)(WT + (size_t)rm(n0 + n) * K + k0 + 16 * c) = o; }
    asm volatile("s_waitcnt lgkmcnt(0)" ::: "memory");
}

struct EpiResidN {
    static constexpr bool PERM = false, AFTER_DRAIN = false;
    const float* base; float* out; bf16_t* Xb; float* SSP;
    __device__ __forceinline__ void operator()(const f32x4 (&acc)[2][2][4][2], const pg8::Unit& u, int wr, int wc, int fr, int fq) const {
        asm volatile("" : "+v"(fr), "+v"(fq));
        const int row0 = u.pm * 256 + wr * 64 + fr, col0 = u.pn * 256 + wc * 32 + 4 * fq;
#pragma unroll
        for (int ai = 0; ai < 2; ++ai)
#pragma unroll
            for (int m = 0; m < 4; ++m) { const size_t row = row0 + ai * 128 + m * 16; const size_t off = row * D + col0; float ss = 0.f;
#pragma unroll
                for (int bj = 0; bj < 2; ++bj)
#pragma unroll
                    for (int n = 0; n < 2; ++n) { const f32x4 b = *(const f32x4*)(base + off + bj * 128 + n * 16); const f32x4 o = b + acc[ai][bj][m][n];
                        *(f32x4*)(out + off + bj * 128 + n * 16) = o;
                        v2u w; w.x = pk2(o[0], o[1]); w.y = pk2(o[2], o[3]); *(v2u*)(Xb + off + bj * 128 + n * 16) = w;
                        ss += (o[0] * o[0] + o[1] * o[1]) + (o[2] * o[2] + o[3] * o[3]); }
                ss += __shfl_xor(ss, 16); ss += __shfl_xor(ss, 32);
                if (fq == 0) SSP[row * 16 + u.pn * 4 + wc] = ss; }
    }
};
struct EpiBf16StoreRS {
    static constexpr bool PERM = true, AFTER_DRAIN = false;
    bf16_t* O; int ldc; const float* SSP;
    __device__ __forceinline__ void operator()(const f32x4 (&acc)[2][2][4][2], const pg8::Unit& u, int wr, int wc, int fr, int fq) const {
        asm volatile("" : "+v"(fr), "+v"(fq));
        const int row0 = u.pm * 256 + wr * 64 + fr, col0 = u.pn * 256 + wc * 32 + 8 * fq;
#pragma unroll
        for (int ai = 0; ai < 2; ++ai)
#pragma unroll
            for (int m = 0; m < 4; ++m) { const size_t row = row0 + ai * 128 + m * 16;
                const f32x4* sp = (const f32x4*)(SSP + row * 16); const f32x4 s0 = sp[0], s1 = sp[1], s2 = sp[2], s3 = sp[3];
                const float ss = (((s0[0] + s0[1]) + (s0[2] + s0[3])) + ((s1[0] + s1[1]) + (s1[2] + s1[3]))) + (((s2[0] + s2[1]) + (s2[2] + s2[3])) + ((s3[0] + s3[1]) + (s3[2] + s3[3])));
                const float rs = rsqrtf(ss * (1.0f / D) + 1e-6f);
                bf16_t* rowp = O + row * ldc + col0;
#pragma unroll
                for (int bj = 0; bj < 2; ++bj) { const f32x4 v0 = acc[ai][bj][m][0] * rs, v1 = acc[ai][bj][m][1] * rs;
                    v4u w; w.x = pk2(v0[0], v0[1]); w.y = pk2(v0[2], v0[3]); w.z = pk2(v1[0], v1[1]); w.w = pk2(v1[2], v1[3]);
                    *(v4u*)(rowp + bj * 128) = w; } }
    }
};
struct MoeOrder {
    int G, c, npairs;
    int per;
    __device__ __forceinline__ bool next(int i, pg8::Unit& u) const {
        const int x = c & 7, y = c >> 3, pml = y & 7, pnq = y >> 3;
        const int epn = i * 32 + x * 4 + pnq;
        if (epn >= npairs || c >= 256) return false;
        const int e = epn / per;
        u.pm = e * 8 + pml; u.pn = epn; return true;
    }
    __device__ __forceinline__ void a_ready(const pg8::Unit&) const {}
    __device__ __forceinline__ void done(const pg8::Unit&) const {}
};

struct XattnOrder {
    int c;
    __device__ __forceinline__ bool next(int i, pg8::Unit& u) const { if (i != 0 || c >= 256) return false; u.pm = (c >> 7) * 32 + (c & 31); u.pn = (c >> 5) & 3; return true; }
    __device__ __forceinline__ void a_ready(const pg8::Unit&) const {}
    __device__ __forceinline__ void done(const pg8::Unit&) const {}
};
template <class RowMap>
__device__ __forceinline__ void transpose_item(const float* W, int K, int N, bf16_t* WT, RowMap rm, LAS float* scr, int item, int lane, const float* kscale = nullptr) {
    const int nblk = N / 64, kb = item / nblk, nb_ = item % nblk, k0 = 64 * kb, n0 = 64 * nb_;
    f32x4 ld[16];
#pragma unroll
    for (int i = 0; i < 16; ++i) ld[i] = *(const f32x4*)(W + (size_t)(k0 + 4 * i + (lane >> 4)) * N + n0 + 4 * (lane & 15));
#pragma unroll
    for (int i = 0; i < 16; ++i) { LAS float* p = scr + (4 * i + (lane >> 4)) * 65 + 4 * (lane & 15); p[0] = ld[i][0]; p[1] = ld[i][1]; p[2] = ld[i][2]; p[3] = ld[i][3]; }
    asm volatile("s_waitcnt lgkmcnt(0)" ::: "memory");
    const int c = lane & 7;
    float ksc[8];
#pragma unroll
    for (int q = 0; q < 8; ++q) ksc[q] = kscale ? kscale[k0 + 8 * c + q] : 1.0f;
#pragma unroll
    for (int j = 0; j < 8; ++j) { const int n = (lane >> 3) + 8 * j; const LAS float* s = scr + (8 * c) * 65 + n;
        v4u o; o.x = pk2(s[0 * 65] * ksc[0], s[1 * 65] * ksc[1]); o.y = pk2(s[2 * 65] * ksc[2], s[3 * 65] * ksc[3]); o.z = pk2(s[4 * 65] * ksc[4], s[5 * 65] * ksc[5]); o.w = pk2(s[6 * 65] * ksc[6], s[7 * 65] * ksc[7]);
        *(v4u*)(WT + (size_t)rm(n0 + n) * K + k0 + 8 * c) = o; }
    asm volatile("s_waitcnt lgkmcnt(0)" ::: "memory");
}

__device__ __forceinline__ void rmsnorm_rows_bf16(const float* x, const float* g, bf16_t* out, int M) {
    const int tix_ = tidx(); const int lane = tix_ & 63, gw = blockIdx.x * 8 + (tix_ >> 6), ngw = gridDim.x * 8;
    for (int m = gw; m < M; m += ngw) {
        const float4* xr = (const float4*)(x + (size_t)m * D);
        float4 v[4]; float s = 0.f;
#pragma unroll
        for (int j = 0; j < 4; ++j) { v[j] = xr[lane + 64 * j]; s += v[j].x * v[j].x + v[j].y * v[j].y + v[j].z * v[j].z + v[j].w * v[j].w; }
        const float r = rsqrtf(wave_sum(s) * (1.0f / D) + 1e-6f);
        v2u* o = (v2u*)(out + (size_t)m * D);
#pragma unroll
        for (int j = 0; j < 4; ++j) { const float4 gg = ((const float4*)g)[lane + 64 * j];
            v2u w; w.x = pk2(v[j].x * r * gg.x, v[j].y * r * gg.y); w.y = pk2(v[j].z * r * gg.z, v[j].w * r * gg.w); o[lane + 64 * j] = w; }
    }
}
__device__ __forceinline__ void rmsnorm_rows_f32(const float* x, const float* g, float* out, int M) {
    const int tix_ = tidx(); const int lane = tix_ & 63, gw = blockIdx.x * 8 + (tix_ >> 6), ngw = gridDim.x * 8;
    for (int m = gw; m < M; m += ngw) {
        const float4* xr = (const float4*)(x + (size_t)m * D);
        float4 v[4]; float s = 0.f;
#pragma unroll
        for (int j = 0; j < 4; ++j) { v[j] = xr[lane + 64 * j]; s += v[j].x * v[j].x + v[j].y * v[j].y + v[j].z * v[j].z + v[j].w * v[j].w; }
        const float r = rsqrtf(wave_sum(s) * (1.0f / D) + 1e-6f);
        float4* o = (float4*)(out + (size_t)m * D);
#pragma unroll
        for (int j = 0; j < 4; ++j) { const float4 gg = ((const float4*)g)[lane + 64 * j];
            o[lane + 64 * j] = make_float4(v[j].x * r * gg.x, v[j].y * r * gg.y, v[j].z * r * gg.z, v[j].w * r * gg.w); }
    }
}

__device__ __forceinline__ int block_exscan(int v, int* sh, int* tot) {
    const int tid = tidx(), lane = tid & 63, w = tid >> 6;
    int inc = v;
#pragma unroll
    for (int o = 1; o < 64; o <<= 1) { const int t = __shfl_up(inc, o); if (lane >= o) inc += t; }
    __syncthreads();
    if (lane == 63) sh[w] = inc;
    __syncthreads();
    int base = 0, total = 0;
#pragma unroll
    for (int i = 0; i < 8; ++i) { const int x = sh[i]; if (i < w) base += x; total += x; }
    *tot = total;
    return base + inc - v;
}


typedef short bf16x8 __attribute__((ext_vector_type(8)));
typedef float f32x16 __attribute__((ext_vector_type(16)));
constexpr int MROW = 144;
constexpr int MBUF = 64 * MROW;
__device__ __forceinline__ bf16x8 frag_rm(const LAS unsigned char* M, int row0, int k0, int fr, int fq) {
    return *(const LAS bf16x8*)(M + (row0 + fr) * MROW + (k0 + 8 * fq) * 2);
}
__device__ __forceinline__ bf16x8 frag_cm(const LAS unsigned char* M, int k0, int col0, int fr, int fq) {
    const LAS unsigned short* p = (const LAS unsigned short*)(M + (k0 + 8 * fq) * MROW + (col0 + fr) * 2);
    bf16x8 v;
#pragma unroll
    for (int j = 0; j < 8; ++j) v[j] = (short)p[j * (MROW / 2)];
    return v;
}
__device__ __forceinline__ void tile_store_bf16(LAS unsigned char* M, int m0, int n0, int fr, int fq, const f32x4& c) {
    v2u w; w.x = pk2(c[0], c[1]); w.y = pk2(c[2], c[3]);
    *(LAS v2u*)(M + (m0 + fr) * MROW + (n0 + 4 * fq) * 2) = w;
}
#define MMA16(acc, lf, rf) acc = __builtin_amdgcn_mfma_f32_16x16x32_bf16(rf, lf, acc, 0, 0, 0)

__device__ __forceinline__ void tile_store_bf16_T(LAS unsigned char* M, int m0, int n0, int fr, int fq, const f32x4& c) {
    const unsigned w0 = pk2(c[0], c[1]), w1 = pk2(c[2], c[3]);
    LAS unsigned char* p = M + (n0 + 4 * fq) * MROW + (m0 + fr) * 2;
    *(LAS unsigned short*)(p) = (unsigned short)(w0 & 0xffffu); *(LAS unsigned short*)(p + MROW) = (unsigned short)(w0 >> 16);
    *(LAS unsigned short*)(p + 2 * MROW) = (unsigned short)(w1 & 0xffffu); *(LAS unsigned short*)(p + 3 * MROW) = (unsigned short)(w1 >> 16);
}
__device__ __forceinline__ void scan_r1(const bf16_t* LWg, const bf16_t* RVg, const bf16_t* ALRg, const bf16_t* KKg, const bf16_t* KBg, const float* k_a,
                                        bf16_t* PT, bf16_t* QT, bf16_t* RH, bf16_t* YL, unsigned char* lds_raw) {
    LAS unsigned char* L = (LAS unsigned char*)lds_raw;
#define SL(k) (L + (k) * MBUF)
    LAS float* LWs = (LAS float*)(L + 14 * MBUF);
    const int tid = tidx(), lane = tid & 63, wave = tid >> 6, fr = lane & 15, fq = lane >> 4;
    const int tm = wave >> 1, tn0 = (wave & 1) * 2;
    const int m0 = tm * 16;
    const int t = tid >> 3, i0 = (tid & 7) * 8;
    v4u lw4n, r4n, v4n, kd4n, kk4n, bb4n;
#define R1_LOAD(it_) do { const int c_ = (it_) & 127, h_ = ((it_) >> 7) & 7, n_ = (it_) >> 10, dir_ = n_ >> 1, b_ = n_ & 1; \
        const int pos_ = dir_ ? (S - 1 - (c_ * 64 + t)) : (c_ * 64 + t); const size_t tok_ = (size_t)b_ * S + pos_; const size_t ch_ = (size_t)h_ * 64 + i0; \
        lw4n = *(const v4u*)(LWg + ((size_t)dir_ * T + tok_) * 512 + ch_); r4n = *(const v4u*)(RVg + tok_ * D + ch_); v4n = *(const v4u*)(RVg + tok_ * D + 512 + ch_); \
        kd4n = *(const v4u*)(KBg + tok_ * 512 + ch_); kk4n = *(const v4u*)(KKg + tok_ * 512 + ch_); bb4n = *(const v4u*)(ALRg + ((size_t)dir_ * T + tok_) * 512 + ch_); } while (0)
    if ((int)blockIdx.x < 4096) R1_LOAD((int)blockIdx.x);
    for (int item = blockIdx.x; item < 4096; item += gridDim.x) {
        const v4u lw4 = lw4n, r4 = r4n, v4 = v4n, kd4 = kd4n, kk4 = kk4n, bb4 = bb4n;
        float lw[8], Lin[8], kac[8];
        { const int h_ = (item >> 7) & 7; const f32x4 k0_ = *(const f32x4*)(k_a + h_ * 64 + i0), k1_ = *(const f32x4*)(k_a + h_ * 64 + i0 + 4);
          kac[0] = k0_[0]; kac[1] = k0_[1]; kac[2] = k0_[2]; kac[3] = k0_[3]; kac[4] = k1_[0]; kac[5] = k1_[1]; kac[6] = k1_[2]; kac[7] = k1_[3]; }
#pragma unroll
        for (int q = 0; q < 4; ++q) { lw[2 * q] = bflo(lw4[q]); lw[2 * q + 1] = bfhi(lw4[q]); }
#pragma unroll
        for (int j = 0; j < 8; ++j) { float x = lw[j];
#pragma unroll
            for (int o = 8; o < 64; o <<= 1) { const float y = __shfl_up(x, o); if (lane >= o) x += y; }
            Lin[j] = x; }
        __syncthreads();
        if (lane >= 56) {
#pragma unroll
            for (int j = 0; j < 8; ++j) LWs[64 + wave * 64 + i0 + j] = Lin[j]; }
        __syncthreads();
        {
            float off[8];
#pragma unroll
            for (int j = 0; j < 8; ++j) off[j] = 0.f;
            for (int w = 0; w < 8; ++w) { if (w < wave) {
#pragma unroll
                for (int j = 0; j < 8; ++j) off[j] += LWs[64 + w * 64 + i0 + j]; } }
#pragma unroll
            for (int j = 0; j < 8; ++j) Lin[j] += off[j];
            if (t == 63) {
#pragma unroll
                for (int j = 0; j < 8; ++j) LWs[i0 + j] = Lin[j]; }
            float at_[8], rt_[8], bt_[8], kt_[8];
#pragma unroll
            for (int q = 0; q < 4; ++q) {
#pragma unroll
                for (int e = 0; e < 2; ++e) { const int j = 2 * q + e;
                    const float ein = __expf(Lin[j]), einv = __expf(-Lin[j]), eex = __expf(Lin[j] - lw[j]);
                    const float kkv = e ? bfhi(kk4[q]) : bflo(kk4[q]), rv_ = e ? bfhi(r4[q]) : bflo(r4[q]), alr_ = e ? bfhi(bb4[q]) : bflo(bb4[q]), kraw = e ? bfhi(kd4[q]) : bflo(kd4[q]);
                    const float bbv = kkv * alr_, kdv = kraw * (1.0f + (alr_ - 1.0f) * kac[j]);
                    at_[j] = -kkv * eex; rt_[j] = rv_ * ein; bt_[j] = bbv * einv; kt_[j] = kdv * einv; }
            }
            v4u wa, wb, wk, w;
            wa.x = pk2(at_[0], at_[1]); wa.y = pk2(at_[2], at_[3]); wa.z = pk2(at_[4], at_[5]); wa.w = pk2(at_[6], at_[7]); *(LAS v4u*)(SL(0) + t * MROW + i0 * 2) = wa;
            w.x = pk2(rt_[0], rt_[1]); w.y = pk2(rt_[2], rt_[3]); w.z = pk2(rt_[4], rt_[5]); w.w = pk2(rt_[6], rt_[7]); *(LAS v4u*)(SL(2) + t * MROW + i0 * 2) = w;
            wb.x = pk2(bt_[0], bt_[1]); wb.y = pk2(bt_[2], bt_[3]); wb.z = pk2(bt_[4], bt_[5]); wb.w = pk2(bt_[6], bt_[7]); *(LAS v4u*)(SL(3) + t * MROW + i0 * 2) = wb;
            wk.x = pk2(kt_[0], kt_[1]); wk.y = pk2(kt_[2], kt_[3]); wk.z = pk2(kt_[4], kt_[5]); wk.w = pk2(kt_[6], kt_[7]); *(LAS v4u*)(SL(5) + t * MROW + i0 * 2) = wk;
#pragma unroll
            for (int q = 0; q < 4; ++q) {
                LAS unsigned char* pT = (LAS unsigned char*)0 + (i0 + 2 * q) * MROW + t * 2;
                *(LAS unsigned short*)(SL(1) + (size_t)pT) = (unsigned short)(wa[q] & 0xffffu); *(LAS unsigned short*)(SL(1) + (size_t)pT + MROW) = (unsigned short)(wa[q] >> 16);
                *(LAS unsigned short*)(SL(4) + (size_t)pT) = (unsigned short)(wb[q] & 0xffffu); *(LAS unsigned short*)(SL(4) + (size_t)pT + MROW) = (unsigned short)(wb[q] >> 16);
                *(LAS unsigned short*)(SL(6) + (size_t)pT) = (unsigned short)(wk[q] & 0xffffu); *(LAS unsigned short*)(SL(6) + (size_t)pT + MROW) = (unsigned short)(wk[q] >> 16);
                *(LAS unsigned short*)(SL(7) + (size_t)pT) = (unsigned short)(v4[q] & 0xffffu); *(LAS unsigned short*)(SL(7) + (size_t)pT + MROW) = (unsigned short)(v4[q] >> 16);
            }
        }
        if (item + (int)gridDim.x < 4096) R1_LOAD(item + (int)gridDim.x);
        __syncthreads();
        f32x4 Tacc[2];
        {
            bf16x8 la[2], lr[2];
#pragma unroll
            for (int ks = 0; ks < 2; ++ks) { la[ks] = frag_rm(SL(0), m0, 32 * ks, fr, fq); lr[ks] = frag_rm(SL(2), m0, 32 * ks, fr, fq); }
#pragma unroll
            for (int q = 0; q < 2; ++q) {
                const int n0 = (tn0 + q) * 16;
                f32x4 cab = {0.f, 0.f, 0.f, 0.f}, cak = cab, crb = cab, crk = cab;
#pragma unroll
                for (int ks = 0; ks < 2; ++ks) {
                    const bf16x8 rb_ = frag_rm(SL(3), n0, 32 * ks, fr, fq), rk_ = frag_rm(SL(5), n0, 32 * ks, fr, fq);
                    MMA16(cab, la[ks], rb_); MMA16(cak, la[ks], rk_); MMA16(crb, lr[ks], rb_); MMA16(crk, lr[ks], rk_);
                }
                const int tt = m0 + fr;
#pragma unroll
                for (int j = 0; j < 4; ++j) { const int ss = n0 + 4 * fq + j;
                    if (!(ss < tt)) { cab[j] = 0.f; cak[j] = 0.f; }
                    if (!(ss <= tt)) { crb[j] = 0.f; crk[j] = 0.f; } }
                tile_store_bf16(SL(8), m0, n0, fr, fq, cab); tile_store_bf16_T(SL(9), m0, n0, fr, fq, cab);
                tile_store_bf16(SL(10), m0, n0, fr, fq, cak);
                tile_store_bf16(SL(11), m0, n0, fr, fq, crb); tile_store_bf16(SL(12), m0, n0, fr, fq, crk);
#pragma unroll
                for (int j = 0; j < 4; ++j) cab[j] += ((n0 + 4 * fq + j) == tt) ? 1.f : 0.f;
                Tacc[q] = cab;
                tile_store_bf16(SL(13), m0, n0, fr, fq, cab);
            }
        }
        __syncthreads();
        {
            bf16x8 lk[2], ln_[2];
#pragma unroll
            for (int ks = 0; ks < 2; ++ks) { lk[ks] = frag_rm(SL(10), m0, 32 * ks, fr, fq); ln_[ks] = frag_rm(SL(8), m0, 32 * ks, fr, fq); }
#pragma unroll
            for (int q = 0; q < 2; ++q) {
                const int n0 = (tn0 + q) * 16;
                f32x4 cw = {0.f, 0.f, 0.f, 0.f}, cn = cw;
#pragma unroll
                for (int ks = 0; ks < 2; ++ks) { MMA16(cw, lk[ks], frag_rm(SL(7), n0, 32 * ks, fr, fq)); MMA16(cn, ln_[ks], frag_rm(SL(9), n0, 32 * ks, fr, fq)); }
                tile_store_bf16_T(SL(0), m0, n0, fr, fq, cw);
                tile_store_bf16(SL(3), m0, n0, fr, fq, cn); tile_store_bf16_T(SL(5), m0, n0, fr, fq, cn);
            }
        }
        __syncthreads();
#pragma unroll
        for (int k = 1; k <= 5; ++k) {
            LAS unsigned char* Nk = (k & 1) ? SL(3) : SL(8); LAS unsigned char* NkT = (k & 1) ? SL(5) : SL(9);
            LAS unsigned char* Nn = (k & 1) ? SL(8) : SL(3); LAS unsigned char* NnT = (k & 1) ? SL(9) : SL(5);
            LAS unsigned char* Tk = (k & 1) ? SL(13) : SL(10); LAS unsigned char* Tn = (k & 1) ? SL(10) : SL(13);
            bf16x8 lt[2], ln_[2];
#pragma unroll
            for (int ks = 0; ks < 2; ++ks) { lt[ks] = frag_rm(Tk, m0, 32 * ks, fr, fq); ln_[ks] = frag_rm(Nk, m0, 32 * ks, fr, fq); }
#pragma unroll
            for (int q = 0; q < 2; ++q) {
                const int n0 = (tn0 + q) * 16;
                f32x4 cn = {0.f, 0.f, 0.f, 0.f};
#pragma unroll
                for (int ks = 0; ks < 2; ++ks) { const bf16x8 rn = frag_rm(NkT, n0, 32 * ks, fr, fq); MMA16(Tacc[q], lt[ks], rn); if (k < 5) MMA16(cn, ln_[ks], rn); }
                tile_store_bf16(Tn, m0, n0, fr, fq, Tacc[q]);
                if (k < 5) { tile_store_bf16(Nn, m0, n0, fr, fq, cn); tile_store_bf16_T(NnT, m0, n0, fr, fq, cn); }
            }
            __syncthreads();
        }
        {
            bf16x8 lt[2];
#pragma unroll
            for (int ks = 0; ks < 2; ++ks) lt[ks] = frag_rm(SL(10), m0, 32 * ks, fr, fq);
#pragma unroll
            for (int q = 0; q < 2; ++q) {
                const int n0 = (tn0 + q) * 16;
                f32x4 ca = {0.f, 0.f, 0.f, 0.f}, cu = ca;
#pragma unroll
                for (int ks = 0; ks < 2; ++ks) { MMA16(ca, lt[ks], frag_rm(SL(1), n0, 32 * ks, fr, fq)); MMA16(cu, lt[ks], frag_rm(SL(0), n0, 32 * ks, fr, fq)); }
                tile_store_bf16_T(SL(8), m0, n0, fr, fq, ca); tile_store_bf16_T(SL(9), m0, n0, fr, fq, cu);
            }
        }
        __syncthreads();
        {
            bf16x8 lrb[2], lrk[2], lb[2], lkt[2];
#pragma unroll
            for (int ks = 0; ks < 2; ++ks) { lrb[ks] = frag_rm(SL(11), m0, 32 * ks, fr, fq); lrk[ks] = frag_rm(SL(12), m0, 32 * ks, fr, fq);
                lb[ks] = frag_rm(SL(4), m0, 32 * ks, fr, fq); lkt[ks] = frag_rm(SL(6), m0, 32 * ks, fr, fq); }
            const float wc = __expf(LWs[m0 + fr]);
#pragma unroll
            for (int q = 0; q < 2; ++q) {
                const int n0 = (tn0 + q) * 16;
                f32x4 crh = {0.f, 0.f, 0.f, 0.f}, cyl = crh, cp = crh, cq = crh;
#pragma unroll
                for (int ks = 0; ks < 2; ++ks) {
                    const bf16x8 ra = frag_rm(SL(8), n0, 32 * ks, fr, fq), ru = frag_rm(SL(9), n0, 32 * ks, fr, fq), rv = frag_rm(SL(7), n0, 32 * ks, fr, fq);
                    MMA16(crh, lrb[ks], ra); MMA16(cyl, lrb[ks], ru); MMA16(cyl, lrk[ks], rv);
                    MMA16(cp, lb[ks], ra); MMA16(cq, lb[ks], ru); MMA16(cq, lkt[ks], rv);
                }
                const size_t o = (size_t)item * 4096 + (size_t)(m0 + fr) * 64 + n0 + 4 * fq;
                { const LAS unsigned short* rp = (const LAS unsigned short*)(SL(2) + (m0 + fr) * MROW + (n0 + 4 * fq) * 2);
#pragma unroll
                  for (int j = 0; j < 4; ++j) crh[j] += __uint_as_float(((unsigned)rp[j]) << 16); }
                { v2u w; w.x = pk2(crh[0], crh[1]); w.y = pk2(crh[2], crh[3]); *(v2u*)(RH + o) = w; }
                { v2u w; w.x = pk2(cyl[0], cyl[1]); w.y = pk2(cyl[2], cyl[3]); *(v2u*)(YL + o) = w; }
#pragma unroll
                for (int j = 0; j < 4; ++j) { cp[j] = wc * (cp[j] + (((n0 + 4 * fq + j) == (m0 + fr)) ? 1.f : 0.f)); cq[j] *= wc; }
                { v2u w; w.x = pk2(cp[0], cp[1]); w.y = pk2(cp[2], cp[3]); *(v2u*)(PT + o) = w; }
                { v2u w; w.x = pk2(cq[0], cq[1]); w.y = pk2(cq[2], cq[3]); *(v2u*)(QT + o) = w; }
            }
        }
    }
#undef SL
}
#undef R1_LOAD

__device__ __forceinline__ bf16x8 pack_acc8(const f32x16& x, int s) {
    v4u p; p.x = pk2(x[8 * s], x[8 * s + 1]); p.y = pk2(x[8 * s + 2], x[8 * s + 3]); p.z = pk2(x[8 * s + 4], x[8 * s + 5]); p.w = pk2(x[8 * s + 6], x[8 * s + 7]);
    return __builtin_bit_cast(bf16x8, p);
}
__device__ __forceinline__ void scan_r2(const bf16_t* PT, const bf16_t* QT, bf16_t* S0, unsigned char* lds_raw) {
    LAS unsigned char* L = (LAS unsigned char*)lds_raw;
    constexpr int SLOT_B = MBUF + 8192;
    const int tid = tidx(), lane = tid & 63, wave = tid >> 6;
    const int r = lane & 31, h2 = lane >> 5, jb = wave;
    f32x16 st[2];
#pragma unroll
    for (int ib = 0; ib < 2; ++ib)
#pragma unroll
        for (int g = 0; g < 16; ++g) st[ib][g] = 0.f;
    const size_t item0 = (size_t)blockIdx.x * 128;
    v4u stage[16];
#pragma unroll
    for (int q = 0; q < 16; ++q) { const int p = tid + 512 * q, cc = p >> 10, w = p & 1023, mat = w >> 9, idx = w & 511;
        stage[q] = *(const v4u*)((mat ? QT : PT) + (item0 + cc) * 4096 + idx * 8); }
    for (int grp = 0; grp < 16; ++grp) {
        __syncthreads();
#pragma unroll
        for (int q = 0; q < 16; ++q) { const int p = tid + 512 * q, cc = p >> 10, w = p & 1023, mat = w >> 9, idx = w & 511;
            *(LAS v4u*)(L + cc * SLOT_B + (mat ? (MBUF + idx * 16) : ((idx >> 3) * MROW + (idx & 7) * 16))) = stage[q]; }
        __syncthreads();
        if (grp < 15) {
#pragma unroll
            for (int q = 0; q < 16; ++q) { const int p = tid + 512 * q, cc = p >> 10, w = p & 1023, mat = w >> 9, idx = w & 511;
                stage[q] = *(const v4u*)((mat ? QT : PT) + (item0 + (grp + 1) * 8 + cc) * 4096 + idx * 8); }
        }
        if (wave < 2) {
#pragma unroll
            for (int cc = 0; cc < 8; ++cc) {
                const size_t item = item0 + grp * 8 + cc;
                const LAS unsigned char* Pm = L + cc * SLOT_B; const LAS unsigned char* Qm = Pm + MBUF;
                bf16_t* sp = S0 + item * 4096 + (size_t)(32 * jb + r) * 64;
#pragma unroll
                for (int ib = 0; ib < 2; ++ib)
#pragma unroll
                    for (int g = 0; g < 4; ++g) { v2u w; w.x = pk2(st[ib][4 * g], st[ib][4 * g + 1]); w.y = pk2(st[ib][4 * g + 2], st[ib][4 * g + 3]); *(v2u*)(sp + 32 * ib + 8 * g + 4 * h2) = w; }
                f32x16 nw[2];
#pragma unroll
                for (int ib = 0; ib < 2; ++ib)
#pragma unroll
                    for (int g = 0; g < 16; ++g) nw[ib][g] = __uint_as_float(((unsigned)*(const LAS unsigned short*)(Qm + (32 * ib + (g & 3) + 8 * (g >> 2) + 4 * h2) * 128 + (32 * jb + r) * 2)) << 16);
#pragma unroll
                for (int kb = 0; kb < 2; ++kb)
#pragma unroll
                    for (int s2 = 0; s2 < 2; ++s2) {
                        const bf16x8 bfr = pack_acc8(st[kb], s2);
#pragma unroll
                        for (int ib = 0; ib < 2; ++ib) {
                            const LAS unsigned char* ap = Pm + (32 * ib + r) * MROW + (32 * kb + 16 * s2 + 4 * h2) * 2;
                            const v2u lo = *(const LAS v2u*)ap, hi = *(const LAS v2u*)(ap + 16);
                            v4u av; av.x = lo.x; av.y = lo.y; av.z = hi.x; av.w = hi.y;
                            nw[ib] = __builtin_amdgcn_mfma_f32_32x32x16_bf16(__builtin_bit_cast(bf16x8, av), bfr, nw[ib], 0, 0, 0);
                        }
                    }
                st[0] = nw[0]; st[1] = nw[1];
            }
        }
    }
}
__device__ __forceinline__ void scan_r3(const bf16_t* RH, const bf16_t* YL, const bf16_t* S0, const bf16_t* RVg, const bf16_t* ALRg, const bf16_t* KBg, const float* k_a, const bf16_t* Gg,
                                        const float* r_k, const float* lng, const float* lnb, bf16_t* Y) {
    const int tid = tidx(), lane = tid & 63, wave = tid >> 6, fr = lane & 15, fq = lane >> 4;
    const int tmw = wave & 3;
    for (int it2 = blockIdx.x * 2 + (wave >> 2); it2 < 2048; it2 += gridDim.x * 2) {
        const int b = it2 >> 10, h = (it2 >> 7) & 7, pc = it2 & 127;
        f32x4 acc[4];
#pragma unroll
        for (int q = 0; q < 4; ++q) acc[q] = (f32x4){0.f, 0.f, 0.f, 0.f};
#pragma unroll 1
        for (int dirn = 0; dirn < 2; ++dirn) {
            const size_t item = (size_t)((dirn * 2 + b) * 8 + h) * 128 + (dirn ? 127 - pc : pc);
            const int row = dirn ? 63 - (16 * tmw + fr) : 16 * tmw + fr;
            const bf16_t* rp = RH + item * 4096 + (size_t)row * 64;
            bf16x8 lf[2];
#pragma unroll
            for (int ks = 0; ks < 2; ++ks) lf[ks] = *(const bf16x8*)(rp + 32 * ks + 8 * fq);
#pragma unroll
            for (int q = 0; q < 4; ++q) {
                const bf16_t* sp = S0 + item * 4096 + (size_t)(16 * q + fr) * 64;
#pragma unroll
                for (int ks = 0; ks < 2; ++ks) { const bf16x8 rf = *(const bf16x8*)(sp + 32 * ks + 8 * fq); MMA16(acc[q], lf[ks], rf); }
                { const v2u yw = *(const v2u*)(YL + item * 4096 + (size_t)row * 64 + 16 * q + 4 * fq); acc[q] += (f32x4){bflo(yw.x), bfhi(yw.x), bflo(yw.y), bfhi(yw.y)}; }
            }
        }
        float sm = 0.f;
#pragma unroll
        for (int q = 0; q < 4; ++q) sm += (acc[q][0] + acc[q][1]) + (acc[q][2] + acc[q][3]);
        sm += __shfl_xor(sm, 16); sm += __shfl_xor(sm, 32);
        const float mean = sm * (1.0f / 64.f);
        float sq = 0.f;
#pragma unroll
        for (int q = 0; q < 4; ++q)
#pragma unroll
            for (int j = 0; j < 4; ++j) { const float d = acc[q][j] - mean; sq += d * d; }
        sq += __shfl_xor(sq, 16); sq += __shfl_xor(sq, 32);
        const float rstd = rsqrtf(sq * (1.0f / 64.f) + 64e-5f);
        const size_t tok = (size_t)b * S + pc * 64 + 16 * tmw + fr;
        float bon = 0.f; f32x4 vv[4];
#pragma unroll
        for (int q = 0; q < 4; ++q) {
            const int c = h * 64 + 16 * q + 4 * fq;
            const v2u rw = *(const v2u*)(RVg + tok * D + c), a0w = *(const v2u*)(ALRg + tok * 512 + c), a1w = *(const v2u*)(ALRg + ((size_t)T + tok) * 512 + c), kw = *(const v2u*)(KBg + tok * 512 + c), vw = *(const v2u*)(RVg + tok * D + 512 + c);
            const f32x4 rk4 = *(const f32x4*)(r_k + c), ka4 = *(const f32x4*)(k_a + c);
            vv[q] = (f32x4){bflo(vw.x), bfhi(vw.x), bflo(vw.y), bfhi(vw.y)};
            const float rr[4] = {bflo(rw.x), bfhi(rw.x), bflo(rw.y), bfhi(rw.y)}, kk_[4] = {bflo(kw.x), bfhi(kw.x), bflo(kw.y), bfhi(kw.y)};
            const float s01[4] = {bflo(a0w.x) + bflo(a1w.x), bfhi(a0w.x) + bfhi(a1w.x), bflo(a0w.y) + bflo(a1w.y), bfhi(a0w.y) + bfhi(a1w.y)};
#pragma unroll
            for (int j = 0; j < 4; ++j) bon += rr[j] * kk_[j] * (2.0f + (s01[j] - 2.0f) * ka4[j]) * rk4[j];
        }
        bon += __shfl_xor(bon, 16); bon += __shfl_xor(bon, 32);
#pragma unroll
        for (int q = 0; q < 4; ++q) {
            const int c = h * 64 + 16 * q + 4 * fq;
            const v2u gw_ = *(const v2u*)(Gg + tok * 512 + c); const f32x4 g4 = {bflo(gw_.x), bfhi(gw_.x), bflo(gw_.y), bfhi(gw_.y)}, lg = *(const f32x4*)(lng + c), lb = *(const f32x4*)(lnb + c);
            float o[4];
#pragma unroll
            for (int j = 0; j < 4; ++j) o[j] = ((acc[q][j] - mean) * rstd * lg[j] + lb[j] + bon * vv[q][j]) * g4[j];
            v2u w; w.x = pk2(o[0], o[1]); w.y = pk2(o[2], o[3]);
            *(v2u*)(Y + tok * D + 512 + c) = w;
        }
    }
}


__device__ __forceinline__ bf16x8 pack8(float a0, float a1, float a2, float a3, float a4, float a5, float a6, float a7) {
    v4u p; p.x = pk2(a0, a1); p.y = pk2(a2, a3); p.z = pk2(a4, a5); p.w = pk2(a6, a7);
    return __builtin_bit_cast(bf16x8, p);
}
#define MMA32(acc, af, bf_) acc = __builtin_amdgcn_mfma_f32_32x32x16_bf16(af, bf_, acc, 0, 0, 0)
__device__ __forceinline__ void xattn_mfma(const bf16_t* Qb, const bf16_t* Kb, const bf16_t* Vt, bf16_t* Y, unsigned char* lds_raw) {
    LAS unsigned char* L = (LAS unsigned char*)lds_raw;
    constexpr int KRS = 528, VRS = 520;
    const int tid = tidx(), lane = tid & 63, wave = tid >> 6, r = lane & 31, h2 = lane >> 5;
    for (int it = blockIdx.x; it < 256; it += gridDim.x) {
        const int qblk = it & 31, h = (it >> 5) & 3, b = it >> 7;
        const size_t tok = (size_t)b * S + qblk * 256 + wave * 32 + r;
        bf16x8 qf[16];
#pragma unroll
        for (int ks = 0; ks < 16; ++ks) qf[ks] = *(const bf16x8*)(Qb + tok * D + h * 256 + 16 * ks + 8 * h2);
        __syncthreads();
#pragma unroll
        for (int hf = 0; hf < 2; ++hf) {
            v4u stg[8];
#pragma unroll
            for (int q = 0; q < 8; ++q) { const int p = tid + 512 * (8 * hf + q); stg[q] = *(const v4u*)(Kb + (size_t)(b * MEM + (p >> 5)) * 1024 + h * 256 + (p & 31) * 8); }
#pragma unroll
            for (int q = 0; q < 8; ++q) { const int p = tid + 512 * (8 * hf + q); *(LAS v4u*)(L + (p >> 5) * KRS + (p & 31) * 16) = stg[q]; }
        }
        __syncthreads();
        float mx = -3.0e38f;
#pragma unroll 1
        for (int kb = 0; kb < 8; ++kb) {
            f32x16 st;
#pragma unroll
            for (int g = 0; g < 16; ++g) st[g] = 0.f;
            const LAS unsigned char* kp = L + (32 * kb + r) * KRS + 16 * h2;
#pragma unroll
            for (int ks = 0; ks < 16; ++ks) { const bf16x8 kf = *(const LAS bf16x8*)(kp + 32 * ks); MMA32(st, kf, qf[ks]); }
#pragma unroll
            for (int g = 0; g < 16; ++g) mx = fmaxf(mx, st[g]);
        }
        mx = fmaxf(mx, __shfl_xor(mx, 32));
        const float cs = 0.0625f * 1.4426950408889634f;
        float l = 0.f;
        bf16x8 pf[8][2];
#pragma unroll
        for (int kb = 0; kb < 8; ++kb) {
            f32x16 st;
#pragma unroll
            for (int g = 0; g < 16; ++g) st[g] = 0.f;
            const LAS unsigned char* kp = L + (32 * kb + r) * KRS + 16 * h2;
#pragma unroll
            for (int ks = 0; ks < 16; ++ks) { const bf16x8 kf = *(const LAS bf16x8*)(kp + 32 * ks); MMA32(st, kf, qf[ks]); }
#pragma unroll
            for (int g = 0; g < 16; ++g) { st[g] = __builtin_amdgcn_exp2f((st[g] - mx) * cs); l += st[g]; }
#pragma unroll
            for (int s2 = 0; s2 < 2; ++s2) pf[kb][s2] = pack8(st[8 * s2], st[8 * s2 + 1], st[8 * s2 + 2], st[8 * s2 + 3], st[8 * s2 + 4], st[8 * s2 + 5], st[8 * s2 + 6], st[8 * s2 + 7]);
            __builtin_amdgcn_sched_barrier(0);
        }
        l += __shfl_xor(l, 32);
        const float inv = 1.0f / l;
        __syncthreads();
#pragma unroll
        for (int hf = 0; hf < 2; ++hf) {
            v4u stg[8];
#pragma unroll
            for (int q = 0; q < 8; ++q) { const int p = tid + 512 * (8 * hf + q); stg[q] = *(const v4u*)(Vt + ((size_t)(b * 1024 + h * 256 + (p >> 5))) * 256 + (p & 31) * 8); }
#pragma unroll
            for (int q = 0; q < 8; ++q) { const int p = tid + 512 * (8 * hf + q); LAS v2u* lp = (LAS v2u*)(L + (p >> 5) * VRS + (p & 31) * 16);
                v2u a_; a_.x = stg[q].x; a_.y = stg[q].y; lp[0] = a_; a_.x = stg[q].z; a_.y = stg[q].w; lp[1] = a_; }
        }
        __syncthreads();
#pragma unroll 1
        for (int db = 0; db < 8; ++db) {
            f32x16 acc;
#pragma unroll
            for (int g = 0; g < 16; ++g) acc[g] = 0.f;
            const LAS unsigned char* vp = L + (32 * db + r) * VRS + 8 * h2;
#pragma unroll
            for (int kb = 0; kb < 8; ++kb)
#pragma unroll
                for (int s2 = 0; s2 < 2; ++s2) {
                    const v2u lo = *(const LAS v2u*)(vp + (32 * kb + 16 * s2) * 2), hi = *(const LAS v2u*)(vp + (32 * kb + 16 * s2 + 8) * 2);
                    v4u av; av.x = lo.x; av.y = lo.y; av.z = hi.x; av.w = hi.y;
                    MMA32(acc, __builtin_bit_cast(bf16x8, av), pf[kb][s2]);
                }
            int tl_ = tid; asm volatile("" : "+v"(tl_));
            bf16_t* yp = Y + ((size_t)b * S + qblk * 256 + (tl_ >> 6) * 32 + (tl_ & 31)) * D + h * 256 + 32 * db + 4 * ((tl_ >> 5) & 1);
#pragma unroll
            for (int g = 0; g < 4; ++g) { v2u w; w.x = pk2(acc[4 * g] * inv, acc[4 * g + 1] * inv); w.y = pk2(acc[4 * g + 2] * inv, acc[4 * g + 3] * inv); *(v2u*)(yp + 8 * g) = w; }
        }
    }
}
template <bool F32OUT>
__device__ __forceinline__ void combine_norm(float* X, const bf16_t* YE, const int* SLOT, const float* g, bf16_t* Hout, float* Fout) {
    const int tix_ = tidx(); const int lane = tix_ & 63, gw = blockIdx.x * 8 + (tix_ >> 6), ngw = gridDim.x * 8;
    float4 gc[4];
#pragma unroll
    for (int j = 0; j < 4; ++j) gc[j] = ((const float4*)g)[lane + 64 * j];
    for (int m = gw; m < T; m += ngw) {
        float4* xr = (float4*)(X + (size_t)m * D);
        float4 v[4];
#pragma unroll
        for (int j = 0; j < 4; ++j) v[j] = xr[lane + 64 * j];
        const int myslot = SLOT[(size_t)m * NE + (lane & 15)];
#pragma unroll
        for (int e = 0; e < 16; ++e) {
            const int row = __builtin_amdgcn_readlane(myslot, e);
            if (row >= 0) {
                const v2u* yp = (const v2u*)(YE + (size_t)row * D);
#pragma unroll
                for (int j = 0; j < 4; ++j) { const v2u w = yp[lane + 64 * j];
                    v[j].x += __uint_as_float(w.x << 16); v[j].y += __uint_as_float(w.x & 0xffff0000u); v[j].z += __uint_as_float(w.y << 16); v[j].w += __uint_as_float(w.y & 0xffff0000u); }
            }
        }
        float s = 0.f;
#pragma unroll
        for (int j = 0; j < 4; ++j) { if (!F32OUT) xr[lane + 64 * j] = v[j]; s += v[j].x * v[j].x + v[j].y * v[j].y + v[j].z * v[j].z + v[j].w * v[j].w; }
        const float r = rsqrtf(wave_sum(s) * (1.0f / D) + 1e-6f);
#pragma unroll
        for (int j = 0; j < 4; ++j) { const float4 gg = gc[j];
            if (F32OUT) ((float4*)(Fout + (size_t)m * D))[lane + 64 * j] = make_float4(v[j].x * r * gg.x, v[j].y * r * gg.y, v[j].z * r * gg.z, v[j].w * r * gg.w);
            else { v2u w; w.x = pk2(v[j].x * r * gg.x, v[j].y * r * gg.y); w.y = pk2(v[j].z * r * gg.z, v[j].w * r * gg.w); ((v2u*)(Hout + (size_t)m * D))[lane + 64 * j] = w; } }
    }
}


template <int NK, bool SINK>
__device__ __forceinline__ void attn_block(const bf16_t* Qh, const bf16_t* Kh, const bf16_t* Vh, int dd, int Lr, int b, int rho, int q0b, float sink2,
                                           bf16_t* Odst, int ostride, float* lsedst, unsigned char* lds_raw) {
    constexpr int NKEY = 256 + 64 * NK, KRS = 144, VRS = NKEY * 2 + 8;
    LAS unsigned char* Ks = (LAS unsigned char*)lds_raw; LAS unsigned char* Vs = Ks + NKEY * KRS;
    const int tid = tidx(), lane = tid & 63, wave = tid >> 6, r = lane & 31, h2 = lane >> 5;
    const int kq_base = q0b - 32 * NK;
    __syncthreads();
#pragma unroll
    for (int i = 0; i < NKEY * 8 / 512; ++i) {
        const int p = tid + 512 * i, row = p >> 3, piece = p & 7, kq = kq_base + row;
        if (kq >= 0 && kq < Lr) {
            const size_t tokk = (size_t)b * S + (size_t)kq * dd + rho;
            const v4u kx = *(const v4u*)(Kh + tokk * 64 + piece * 8), vx = *(const v4u*)(Vh + tokk * 64 + piece * 8);
            *(LAS v4u*)(Ks + row * KRS + piece * 16) = kx;
            LAS unsigned char* vp = Vs + (piece * 8) * VRS + row * 2;
#pragma unroll
            for (int e = 0; e < 4; ++e) { *(LAS unsigned short*)(vp + (2 * e) * VRS) = (unsigned short)(vx[e] & 0xffffu); *(LAS unsigned short*)(vp + (2 * e + 1) * VRS) = (unsigned short)(vx[e] >> 16); }
        }
    }
    const int q0 = q0b + 32 * wave;
    const size_t qtok = (size_t)b * S + (size_t)(q0 + r) * dd + rho;
    bf16x8 qf[4];
#pragma unroll
    for (int ks = 0; ks < 4; ++ks) qf[ks] = *(const bf16x8*)(Qh + qtok * 64 + 16 * ks + 8 * h2);
    __syncthreads();
    f32x16 o[2];
#pragma unroll
    for (int db = 0; db < 2; ++db)
#pragma unroll
        for (int g = 0; g < 16; ++g) o[db][g] = 0.f;
    float m = SINK ? sink2 : -1.0e30f, l = SINK ? 1.f : 0.f;
    const int kb_lo = max(-NK, -(q0 >> 5)), kb_hi = min(NK, (Lr - 32 - q0) >> 5);
#pragma unroll 1
    for (int kb = kb_lo; kb <= kb_hi; ++kb) {
        const int kw0 = 32 * (wave + kb + NK);
        f32x16 st;
#pragma unroll
        for (int g = 0; g < 16; ++g) st[g] = 0.f;
        const LAS unsigned char* kp = Ks + (kw0 + r) * KRS + 16 * h2;
#pragma unroll
        for (int ks = 0; ks < 4; ++ks) { const bf16x8 kf = *(const LAS bf16x8*)(kp + 32 * ks); MMA32(st, kf, qf[ks]); }
        if (kb == -NK || kb == NK) {
#pragma unroll
            for (int g = 0; g < 16; ++g) { const int cr = (g & 3) + 8 * (g >> 2) + 4 * h2; const bool ok = (kb < 0) ? (cr >= r) : (cr <= r); st[g] = ok ? st[g] : -1.0e30f; }
        }
        float bm = st[0];
#pragma unroll
        for (int g = 1; g < 16; ++g) bm = fmaxf(bm, st[g]);
        bm = fmaxf(bm, __shfl_xor(bm, 32));
        const float mn = fmaxf(m, bm), al = __builtin_amdgcn_exp2f(m - mn);
        float ls = 0.f;
#pragma unroll
        for (int g = 0; g < 16; ++g) { st[g] = __builtin_amdgcn_exp2f(st[g] - mn); ls += st[g]; }
        ls += __shfl_xor(ls, 32);
        l = l * al + ls; m = mn;
#pragma unroll
        for (int db = 0; db < 2; ++db)
#pragma unroll
            for (int g = 0; g < 16; ++g) o[db][g] *= al;
        bf16x8 pf[2];
#pragma unroll
        for (int s2 = 0; s2 < 2; ++s2) pf[s2] = pack8(st[8 * s2], st[8 * s2 + 1], st[8 * s2 + 2], st[8 * s2 + 3], st[8 * s2 + 4], st[8 * s2 + 5], st[8 * s2 + 6], st[8 * s2 + 7]);
#pragma unroll
        for (int db = 0; db < 2; ++db) {
            const LAS unsigned char* vp = Vs + (32 * db + r) * VRS + (kw0 + 4 * h2) * 2;
#pragma unroll
            for (int s2 = 0; s2 < 2; ++s2) {
                const v2u lo = *(const LAS v2u*)(vp + 32 * s2), hi = *(const LAS v2u*)(vp + 32 * s2 + 16);
                v4u av; av.x = lo.x; av.y = lo.y; av.z = hi.x; av.w = hi.y;
                MMA32(o[db], __builtin_bit_cast(bf16x8, av), pf[s2]);
            }
        }
    }
    const float inv = 1.0f / l;
#pragma unroll
    for (int db = 0; db < 2; ++db) {
        bf16_t* op = Odst + qtok * ostride + 32 * db + 4 * h2;
#pragma unroll
        for (int g = 0; g < 4; ++g) { v2u w; w.x = pk2(o[db][4 * g] * inv, o[db][4 * g + 1] * inv); w.y = pk2(o[db][4 * g + 2] * inv, o[db][4 * g + 3] * inv); *(v2u*)(op + 8 * g) = w; }
    }
    if (lsedst != nullptr && h2 == 0) lsedst[qtok * 8] = (m + __builtin_amdgcn_logf(l)) * 0.6931471805599453f;
}

__device__ __forceinline__ void attn_phase_even(const bf16_t* QhA, const bf16_t* KhA, const bf16_t* VhA, const bf16_t* QhB, const bf16_t* KhB, const bf16_t* VhB,
                                                const float* sink, bf16_t* OA, float* LSE, bf16_t* Y, unsigned char* lds_raw) {
    for (int it = blockIdx.x; it < 2048; it += gridDim.x) {
        if (it < 512) {
            const int hq = it >> 6, rem2 = it & 63, b = rem2 >> 5, q0b = (rem2 & 31) * 256, kvh = hq >> 2;
            attn_block<4, true>(QhB + (size_t)hq * T * 64, KhB + (size_t)kvh * T * 64, VhB + (size_t)kvh * T * 64, 1, S, b, 0, q0b, sink[hq] * 1.4426950408889634f,
                                Y + 512 + hq * 64, D, nullptr, lds_raw);
        } else {
            const int ita = it - 512, p = ita >> 9, rem = ita & 511, head = rem >> 6, rem2 = rem & 63, b = rem2 >> 5, rem3 = rem2 & 31;
            const int dd = p == 0 ? 1 : (p == 1 ? 4 : 16), bpr = 32 / dd, rho = rem3 / bpr, q0b = (rem3 % bpr) * 256;
            attn_block<2, false>(QhA + (size_t)head * T * 64, KhA + (size_t)head * T * 64, VhA + (size_t)head * T * 64, dd, S / dd, b, rho, q0b, 0.f,
                                 OA + (size_t)p * T * 512 + head * 64, 512, LSE + (size_t)p * T * 8 + head, lds_raw);
        }
    }
}
__device__ __forceinline__ void attn_combine(const bf16_t* OA, const float* LSE, bf16_t* Y) {
    const int gt = blockIdx.x * NTH + tidx(), ngt = gridDim.x * NTH;
    for (int i = gt; i < T * 64; i += ngt) {
        const int tok = i >> 6, head = (i >> 3) & 7, c8 = i & 7;
        const float l0 = LSE[(size_t)tok * 8 + head], l1 = LSE[((size_t)T + tok) * 8 + head], l2 = LSE[((size_t)2 * T + tok) * 8 + head];
        const float mx = fmaxf(l0, fmaxf(l1, l2));
        float w0 = __expf(l0 - mx), w1 = __expf(l1 - mx), w2 = __expf(l2 - mx);
        const float inv = 1.0f / (w0 + w1 + w2); w0 *= inv; w1 *= inv; w2 *= inv;
        const size_t off = (size_t)tok * 512 + head * 64 + c8 * 8;
        const v4u x0 = *(const v4u*)(OA + off), x1 = *(const v4u*)(OA + (size_t)T * 512 + off), x2 = *(const v4u*)(OA + (size_t)2 * T * 512 + off);
        v4u w;
#pragma unroll
        for (int q = 0; q < 4; ++q) {
            const float lo = w0 * __uint_as_float(x0[q] << 16) + w1 * __uint_as_float(x1[q] << 16) + w2 * __uint_as_float(x2[q] << 16);
            const float hi = w0 * __uint_as_float(x0[q] & 0xffff0000u) + w1 * __uint_as_float(x1[q] & 0xffff0000u) + w2 * __uint_as_float(x2[q] & 0xffff0000u);
            w[q] = pk2(lo, hi);
        }
        *(v4u*)(Y + (size_t)tok * D + head * 64 + c8 * 8) = w;
    }
}


__device__ __forceinline__ void odd_token_pass(const bf16_t* P, const float* mu, const float* k_k, const float* clg, const float* clb,
                                               bf16_t* VN, bf16_t* RV, bf16_t* KBf, bf16_t* KK, bf16_t* F5) {
    const int tix_ = tidx(); const int lane = tix_ & 63, gw = blockIdx.x * 8 + (tix_ >> 6), ngw = gridDim.x * 8;
    float2 m0c[15], m1c[15], kkc[4], lgc[4], lbc[4];
#pragma unroll
    for (int jj = 0; jj < 15; ++jj) { const int c = 2 * lane + 128 * jj; m0c[jj] = *(const float2*)(mu + c); m1c[jj] = *(const float2*)(mu + FD + c); }
#pragma unroll
    for (int jj = 0; jj < 4; ++jj) { const int c = 2 * lane + 128 * jj; kkc[jj] = *(const float2*)(k_k + c); lgc[jj] = *(const float2*)(clg + c); lbc[jj] = *(const float2*)(clb + c); }
    unsigned wcur[15], wnxt[15], wprv[15];
    for (int tok0 = gw * 8; tok0 < T; tok0 += ngw * 8)
    for (int ti = 0; ti < 8; ++ti) {
        const int tok = tok0 + ti;
        const int s = tok & (S - 1);
        const bf16_t* pr = P + (size_t)tok * ODD_PAD;
        if (ti == 0) {
#pragma unroll
            for (int jj = 0; jj < 15; ++jj) { const int c = 2 * lane + 128 * jj; wcur[jj] = *(const unsigned*)(pr + 1024 + c); wprv[jj] = s > 0 ? *(const unsigned*)(pr + 1024 + c - ODD_PAD) : 0u; }
        } else {
#pragma unroll
            for (int jj = 0; jj < 15; ++jj) { wprv[jj] = s > 0 ? wcur[jj] : 0u; wcur[jj] = wnxt[jj]; }
        }
#pragma unroll
        for (int jj = 0; jj < 15; ++jj) { const int c = 2 * lane + 128 * jj; wnxt[jj] = *(const unsigned*)(pr + 1024 + c + (tok + 1 < T ? ODD_PAD : 0)); }
        {
            float ge[8]; float sm = 0.f;
#pragma unroll
            for (int jj = 0; jj < 4; ++jj) { const unsigned w = *(const unsigned*)(pr + 512 + 2 * lane + 128 * jj);
                ge[2 * jj] = gelu_tanh(__uint_as_float(w << 16)); ge[2 * jj + 1] = gelu_tanh(__uint_as_float(w & 0xffff0000u)); sm += ge[2 * jj] + ge[2 * jj + 1]; }
            const float mean = wave_sum(sm) * (1.0f / 512.f); float sq = 0.f;
#pragma unroll
            for (int j = 0; j < 8; ++j) { const float d = ge[j] - mean; sq += d * d; }
            const float rstd = rsqrtf(wave_sum(sq) * (1.0f / 512.f) + 1e-5f);
#pragma unroll
            for (int jj = 0; jj < 4; ++jj) { const int c = 2 * lane + 128 * jj;
                *(unsigned*)(VN + (size_t)tok * 512 + c) = pk2((ge[2 * jj] - mean) * rstd * lgc[jj].x + lbc[jj].x, (ge[2 * jj + 1] - mean) * rstd * lgc[jj].y + lbc[jj].y); }
        }
#pragma unroll
        for (int jj = 0; jj < 15; ++jj) {
            const int c = 2 * lane + 128 * jj;
            const unsigned wf = wcur[jj];
            const unsigned wp = wprv[jj];
            const unsigned wn = s < S - 1 ? wnxt[jj] : 0u;
            const float2 m0 = m0c[jj], m1 = m1c[jj];
            const float f0 = __uint_as_float(wf << 16), f1 = __uint_as_float(wf & 0xffff0000u);
            const float x0 = f0 + m0.x * (__uint_as_float(wp << 16) - f0) + m1.x * (__uint_as_float(wn << 16) - f0);
            const float x1 = f1 + m0.y * (__uint_as_float(wp & 0xffff0000u) - f1) + m1.y * (__uint_as_float(wn & 0xffff0000u) - f1);
            if (jj < 4) *(unsigned*)(RV + (size_t)tok * D + c) = pk2(x0, x1);
            else if (jj < 8) {
                const int ck = c - 512;
                *(unsigned*)(KBf + (size_t)tok * 512 + ck) = pk2(x0, x1);
                const float2 kk_ = kkc[jj - 4];
                const float a0_ = x0 * kk_.x, a1_ = x1 * kk_.y;
                float ss = a0_ * a0_ + a1_ * a1_;
#pragma unroll
                for (int o = 16; o >= 1; o >>= 1) ss += __shfl_xor(ss, o);
                const float inv = 1.0f / fmaxf(sqrtf(ss), 1e-12f);
                *(unsigned*)(KK + (size_t)tok * 512 + ck) = pk2(a0_ * inv, a1_ * inv);
            }
            else if (jj < 12) *(unsigned*)(RV + (size_t)tok * D + 512 + (c - 1024)) = pk2(x0, x1);
            else if (jj == 12) *(unsigned*)(F5 + (size_t)tok * 384 + (c - 1536)) = pk2(tanhf_(x0), tanhf_(x1));
            else if (jj == 13) *(unsigned*)(F5 + (size_t)tok * 384 + 128 + (c - 1664)) = pk2(x0, x1);
            else *(unsigned*)(F5 + (size_t)tok * 384 + 256 + (c - 1792)) = pk2(sigmoidf_(x0), sigmoidf_(x1));
        }
    }
}
__device__ __forceinline__ void gating_pass(const bf16_t* VN, const bf16_t* Wsb, const float* bsp, const bf16_t* P, bf16_t* Y, unsigned char* lds_raw) {
    LAS unsigned char* L = (LAS unsigned char*)lds_raw;
    constexpr int RS = 272;
    const int tid = tidx(), lane = tid & 63, wave = tid >> 6, fr = lane & 15, fq = lane >> 4;
    for (int it = blockIdx.x; it < 512; it += gridDim.x) {
        const int g = it & 3, chunk = it >> 2;
        __syncthreads();
        { const int j = tid >> 2, q4 = tid & 3;
          const v4u* gp = (const v4u*)(VN + (size_t)(chunk * 128 + j) * 512 + g * 128 + 32 * q4);
#pragma unroll
          for (int q = 0; q < 4; ++q) { const v4u x = gp[q];
#pragma unroll
              for (int e = 0; e < 4; ++e) { const int c = 32 * q4 + 8 * q + 2 * e;
                  *(LAS unsigned short*)(L + c * RS + 2 * j) = (unsigned short)(x[e] & 0xffffu); *(LAS unsigned short*)(L + (c + 1) * RS + 2 * j) = (unsigned short)(x[e] >> 16); } } }
        __syncthreads();
        bf16x8 lf[4];
#pragma unroll
        for (int ks = 0; ks < 4; ++ks) lf[ks] = *(const bf16x8*)(Wsb + (size_t)(g * 128 + 16 * wave + fr) * 128 + 32 * ks + 8 * fq);
        const int i = 16 * wave + fr; const size_t tok = (size_t)chunk * 128 + i;
        const float bias = bsp[g * 128 + i];
#pragma unroll
        for (int tn = 0; tn < 8; ++tn) {
            f32x4 acc = {0.f, 0.f, 0.f, 0.f};
#pragma unroll
            for (int ks = 0; ks < 4; ++ks) { const bf16x8 rf = *(const LAS bf16x8*)(L + (16 * tn + fr) * RS + (32 * ks + 8 * fq) * 2); MMA16(acc, lf[ks], rf); }
            const int c = g * 128 + 16 * tn + 4 * fq;
            const v2u uw = *(const v2u*)(P + tok * ODD_PAD + c);
            const float u0 = gelu_tanh(__uint_as_float(uw.x << 16)), u1 = gelu_tanh(__uint_as_float(uw.x & 0xffff0000u)), u2 = gelu_tanh(__uint_as_float(uw.y << 16)), u3 = gelu_tanh(__uint_as_float(uw.y & 0xffff0000u));
            v2u w; w.x = pk2(u0 * (acc[0] + bias), u1 * (acc[1] + bias)); w.y = pk2(u2 * (acc[2] + bias), u3 * (acc[3] + bias));
            *(v2u*)(Y + tok * D + c) = w;
        }
    }
}


__device__ __forceinline__ void router_pass(const float* X, const float* g, const float* WRT  , float* AFF, int* SLOT, bf16_t* H, unsigned char* lds_raw) {
    const int tix_ = tidx(); const int lane = tix_ & 63, wave = tix_ >> 6, fr = lane & 15, fq = lane >> 4;
    const int pair = wave >> 1, half = wave & 1;
    f32x4 gcr[4];
#pragma unroll
    for (int j = 0; j < 4; ++j) gcr[j] = ((const f32x4*)g)[lane + 64 * j];
    LAS float* xch = (LAS float*)lds_raw + pair * 512;
    for (int tile0 = blockIdx.x * 4; tile0 < T / 16; tile0 += gridDim.x * 4) {
        const int tile = tile0 + pair;
        const float* xr = X + (size_t)(tile * 16 + fr) * D + 4 * fq + 512 * half;
        const float* wr = WRT + (size_t)fr * D + 4 * fq + 512 * half;
        f32x4 acc = {0.f, 0.f, 0.f, 0.f}; float ss = 0.f;
#pragma unroll 8
        for (int s = 0; s < 32; ++s) {
            const f32x4 xa = *(const f32x4*)(xr + 16 * s), wb = *(const f32x4*)(wr + 16 * s);
            ss += (xa[0] * xa[0] + xa[1] * xa[1]) + (xa[2] * xa[2] + xa[3] * xa[3]);
#pragma unroll
            for (int c = 0; c < 4; ++c) acc = __builtin_amdgcn_mfma_f32_16x16x4f32(xa[c], wb[c], acc, 0, 0, 0);
        }
        ss += __shfl_xor(ss, 16); ss += __shfl_xor(ss, 32);
        __syncthreads();
        { LAS float* p = xch + half * 256 + lane * 4; p[0] = acc[0]; p[1] = acc[1]; p[2] = acc[2]; p[3] = acc[3]; }
        if (fq == 0) ((LAS float*)lds_raw + 2048 + pair * 32 + half * 16)[fr] = ss;
        __syncthreads();
        { const LAS float* p = xch + (half ^ 1) * 256 + lane * 4; acc[0] += p[0]; acc[1] += p[1]; acc[2] += p[2]; acc[3] += p[3]; }
        ss += ((const LAS float*)lds_raw + 2048 + pair * 32 + (half ^ 1) * 16)[fr];
        const float rstd = rsqrtf(ss * (1.0f / D) + 1e-6f);
        {
            float aff[4];
#pragma unroll
            for (int jj = 0; jj < 4; ++jj) {
                const float lg = acc[jj] * __shfl(rstd, 4 * fq + jj);
                float mx = lg;
#pragma unroll
                for (int o = 1; o < 16; o <<= 1) mx = fmaxf(mx, __shfl_xor(mx, o));
                const float e = expf(lg - mx); float den = e;
#pragma unroll
                for (int o = 1; o < 16; o <<= 1) den += __shfl_xor(den, o);
                aff[jj] = e / den;
            }
#pragma unroll
            for (int jj = 0; jj < 4; ++jj) { const size_t o = (size_t)(tile * 16 + 4 * fq + jj) * NE + fr; if ((fq >> 1) == half) { AFF[o] = aff[jj]; SLOT[o] = -1; } }
        }
#pragma unroll 4
        for (int tt = 0; tt < 8; ++tt) {
            const int t = 8 * half + tt;
            const float rs = __shfl(rstd, t);
            const f32x4* xp = (const f32x4*)(X + (size_t)(tile * 16 + t) * D); unsigned* hp = (unsigned*)((unsigned char*)H + (size_t)(tile * 16 + t) * D);
            const float rs8 = rs * ASC8;
#pragma unroll
            for (int j = 0; j < 4; ++j) { const f32x4 v = xp[lane + 64 * j], gg = gcr[j];
                hp[lane + 64 * j] = pk4_fp8(v[0] * rs8 * gg[0], v[1] * rs8 * gg[1], v[2] * rs8 * gg[2], v[3] * rs8 * gg[3]); }
        }
    }
}


__device__ __forceinline__ void lora_pass(const bf16_t* F5, const bf16_t* WC, const float* w0, const float* a0,
                                          bf16_t* LW, bf16_t* ALR, bf16_t* G, unsigned char* lds_raw) {
    LAS unsigned char* L = (LAS unsigned char*)lds_raw;
    constexpr int ARS = 784;
    const int tid = tidx(), lane = tid & 63, wave = tid >> 6, fr = lane & 15, fq = lane >> 4;
    for (int tile = blockIdx.x; tile < T / 64; tile += gridDim.x) {
        __syncthreads();
#pragma unroll
        for (int q = 0; q < 6; ++q) { const int p = tid + 512 * q, row = p / 48, piece = p % 48;
            *(LAS v4u*)(L + row * ARS + piece * 16) = *(const v4u*)(F5 + (size_t)(tile * 64 + row) * 384 + piece * 8); }
        __syncthreads();
#pragma unroll 1
        for (int sec = 0; sec < 5; ++sec) {
            const int K0 = sec * 64, nks = sec < 4 ? 2 : 4, wstride = sec < 4 ? 64 : 128;
            const bf16_t* Wp = WC + (size_t)sec * 512 * 64 + (size_t)(64 * wave) * wstride;
#pragma unroll 1
            for (int nh = 0; nh < 2; ++nh) {
            f32x4 acc[4][2];
#pragma unroll
            for (int tm = 0; tm < 4; ++tm)
#pragma unroll
                for (int tn = 0; tn < 2; ++tn) acc[tm][tn] = (f32x4){0.f, 0.f, 0.f, 0.f};
            for (int ks = 0; ks < nks; ++ks) {
                bf16x8 lf[4], rf[2];
#pragma unroll
                for (int tm = 0; tm < 4; ++tm) lf[tm] = *(const LAS bf16x8*)(L + (16 * tm + fr) * ARS + (K0 + 32 * ks + 8 * fq) * 2);
#pragma unroll
                for (int tn = 0; tn < 2; ++tn) rf[tn] = *(const bf16x8*)(Wp + (size_t)(16 * (2 * nh + tn) + fr) * wstride + 32 * ks + 8 * fq);
#pragma unroll
                for (int tm = 0; tm < 4; ++tm)
#pragma unroll
                    for (int tn = 0; tn < 2; ++tn) MMA16(acc[tm][tn], lf[tm], rf[tn]);
            }
            f32x4 cw[2];
#pragma unroll
            for (int tn = 0; tn < 2; ++tn) {
                const int cc = 64 * wave + 16 * (2 * nh + tn) + 4 * fq;
                cw[tn] = (sec < 2) ? *(const f32x4*)(w0 + sec * 512 + cc) : ((sec < 4) ? *(const f32x4*)(a0 + (sec - 2) * 512 + cc) : (f32x4){0.f, 0.f, 0.f, 0.f});
            }
#pragma unroll
            for (int tn = 0; tn < 2; ++tn) {
                const int cc = 64 * wave + 16 * (2 * nh + tn) + 4 * fq;
#pragma unroll
                for (int tm = 0; tm < 4; ++tm) {
                    const size_t tok = (size_t)tile * 64 + 16 * tm + fr; const f32x4 v = acc[tm][tn];
                    float o[4];
                    if (sec < 2) {
#pragma unroll
                        for (int j = 0; j < 4; ++j) o[j] = -0.6065306597126334f * frcp(1.0f + __expf(-(cw[tn][j] + v[j])));
                    } else if (sec < 4) {
#pragma unroll
                        for (int j = 0; j < 4; ++j) o[j] = frcp(1.0f + __expf(-(cw[tn][j] + v[j])));
                    } else {
#pragma unroll
                        for (int j = 0; j < 4; ++j) o[j] = v[j];
                    }
                    v2u ww; ww.x = pk2(o[0], o[1]); ww.y = pk2(o[2], o[3]);
                    bf16_t* dst = sec < 2 ? (LW + ((size_t)sec * T + tok) * 512 + cc) : (sec < 4 ? (ALR + ((size_t)(sec - 2) * T + tok) * 512 + cc) : (G + tok * 512 + cc));
                    *(v2u*)dst = ww;
                }
            }
            }
        }
    }
}

#define IN(k) (lo <= (k) && (k) < hi)
#define REP_LOOP for (int rep_ = 0, nrep_ = ((ph == PROBE_PHASE) ? PROBE_REP : 1); rep_ < nrep_; ++rep_)
#define SEAM(k) do { if (IN(k) && IN((k) + 1)) xcd_barrier(bar); } while (0)
#define PROLOG \
    const int tid = tidx(), lane = tid & 63, wave = tid >> 6; \
    const int bid = blockIdx.x, nb = gridDim.x; \
    const int gw = bid * 8 + wave, ngw = nb * 8; \
    const int gt = bid * NTH + tid, ngt = nb * NTH; \
    (void)gt; (void)ngt; (void)gw; (void)ngw; (void)lane; (void)wave; \
    unsigned char* ws = a.ws; \
    const int lo = a.lo, hi = a.hi; \
    float* ldsf = (float*)lds_raw; (void)ldsf; \
    PG8_LAS unsigned char* ldsp = (PG8_LAS unsigned char*)lds_raw; (void)ldsp; \
    const float* x_in = a.in[0]; const float* mem = a.in[1]; (void)x_in; (void)mem; \
    float* ropec = (float*)(ws + WS_ROPE); float* ropes = ropec + S * 32; (void)ropec; (void)ropes; \
    float* AFF = (float*)(ws + WS_AFF); int* TOK = (int*)(ws + WS_TOK); float* GATE = (float*)(ws + WS_GATE); \
    float* X = (float*)(ws + WS_X); bf16_t* H = (bf16_t*)(ws + WS_H); bf16_t* P = (bf16_t*)(ws + WS_P); \
    bf16_t* Y = (bf16_t*)(ws + WS_Y); bf16_t* Q = (bf16_t*)(ws + WS_Q); bf16_t* KV = (bf16_t*)(ws + WS_KV); bf16_t* MN = (bf16_t*)(ws + WS_MN); \
    bf16_t* DEC = (bf16_t*)(ws + WS_DEC); bf16_t* KD = (bf16_t*)(ws + WS_KD); bf16_t* BB = (bf16_t*)(ws + WS_BB); \
    bf16_t* KK = (bf16_t*)(ws + WS_KK); bf16_t* G = (bf16_t*)(ws + WS_G); float* YS = (float*)(ws + WS_YS); \
    bf16_t* RV = (bf16_t*)(ws + WS_RV); bf16_t* VN = (bf16_t*)(ws + WS_VN); \
    bf16_t* XE = (bf16_t*)(ws + WS_XE); bf16_t* HID = (bf16_t*)(ws + WS_HID); int* SLOT = (int*)(ws + WS_SLOT); bf16_t* YE = (bf16_t*)(ws + WS_YE); (void)SLOT; (void)YE; \
    (void)AFF; (void)TOK; (void)GATE; (void)X; (void)H; (void)P; (void)Y; (void)Q; (void)KV; (void)MN; (void)DEC; (void)KD; (void)BB; (void)KK; (void)G; (void)YS; (void)RV; (void)VN; (void)XE; (void)HID;

template <class Epi>
__device__ __forceinline__ void dense_gemm(PG8_LAS unsigned char* ldsp, const bf16_t* A, const bf16_t* Bt, int M, int N, int K, const Epi& E, int cshift = 0) {
    asm volatile("" : "+s"(K));
    pg8::Gemm g{A, Bt, M, N, K}; pg8::StaticOrder So; So.init(M, N, (int)gridDim.x, (int)((blockIdx.x + cshift) % gridDim.x));
    pg8::gemm_phase<Epi, pg8::StaticOrder, false>(ldsp, g, So, E, nullptr);
}

__device__ __forceinline__ int odd_phases(const Args& a, const XcdBarrier& bar, unsigned char* lds_raw, int ph) {
    PROLOG
    if (IN(ph)) combine_norm<false>(X, YE, SLOT, a.in[6], H, nullptr);
    SEAM(ph); ++ph;
    if (IN(ph)) dense_gemm(ldsp, H, (const bf16_t*)(ws + WS_WOIN), T, ODD_PAD, D, EpiBf16Store{P, ODD_PAD, 1.0f});
    SEAM(ph); ++ph;
    if (IN(ph)) REP_LOOP {
        odd_token_pass(P, a.in[12], a.in[18], a.in[8], a.in[9], VN, RV, (bf16_t*)(ws + WS_KB), KK, (bf16_t*)(ws + WS_F5));
        asm volatile("s_waitcnt vmcnt(0)" ::: "memory");
        __syncthreads();
        lora_pass((const bf16_t*)(ws + WS_F5), (const bf16_t*)(ws + WS_WL), a.in[13], a.in[15], DEC, KD  , G, lds_raw);
    }
    SEAM(ph); ++ph;
    if (IN(ph)) REP_LOOP {
        gating_pass(VN, (const bf16_t*)(ws + WS_WSB), a.in[11], P, Y, lds_raw);
        __syncthreads();
        scan_r1(DEC, RV, KD, KK, (const bf16_t*)(ws + WS_KB), a.in[19], (bf16_t*)(ws + WS_PT), (bf16_t*)(ws + WS_QT), (bf16_t*)(ws + WS_RH), (bf16_t*)(ws + WS_YL), lds_raw);
    }
    SEAM(ph); ++ph;
    if (IN(ph)) REP_LOOP {
        if (bid < 32) scan_r2((const bf16_t*)(ws + WS_PT), (const bf16_t*)(ws + WS_QT), (bf16_t*)(ws + WS_S0), lds_raw);
        else {
            LAS float* scr = (LAS float*)((LAS unsigned char*)lds_raw + wave * 16896);
            const int gw2 = (bid - 32) * 8 + wave, ngw2 = (nb - 32) * 8;
            auto gmap = [](int n) { return (n >> 7) * 256 + (n & 127); };
            auto umap = [](int n) { return (n >> 7) * 256 + 128 + (n & 127); };
            for (int it = gw2; it < 16 * 704; it += ngw2) { const int e = it / 704, r = it % 704;
                transpose_item_fp8(a.in[31] + (size_t)(16 + e) * D * DE, D, DE, ws + WS_WGU8 + 176 * MiB + (size_t)e * 5632 * D, gmap, GUSC8, scr, r, lane); }
            for (int it = gw2; it < 16 * 704; it += ngw2) { const int e = it / 704, r = it % 704;
                transpose_item_fp8(a.in[32] + (size_t)(16 + e) * D * DE, D, DE, ws + WS_WGU8 + 176 * MiB + (size_t)e * 5632 * D, umap, GUSC8, scr, r, lane); }
        }
    }
    SEAM(ph); ++ph;
    if (IN(ph)) REP_LOOP scan_r3((const bf16_t*)(ws + WS_RH), (const bf16_t*)(ws + WS_YL), (const bf16_t*)(ws + WS_S0), RV, KD, (const bf16_t*)(ws + WS_KB), a.in[19], G, a.in[20], a.in[21], a.in[22], Y);
    SEAM(ph); ++ph;
    if (IN(ph)) dense_gemm(ldsp, Y, (const bf16_t*)(ws + WS_WOOUT), T, D, D, EpiResidN{X, X, H, (float*)(ws + WS_SSP)});
    SEAM(ph); ++ph;
    return ph;
}

template <int layer>
__device__ __forceinline__ int tail_phases(const Args& a, const XcdBarrier& bar, unsigned char* lds_raw, int ph) {
    PROLOG
    if (IN(ph)) REP_LOOP {
        int Kq = D; asm volatile("" : "+s"(Kq));
        pg8::Gemm g{H, (const bf16_t*)(ws + WS_WQ) + (size_t)layer * D * D, T, D, Kq}; XattnOrder So{(int)blockIdx.x};
        pg8::gemm_phase<EpiBf16StoreRS, XattnOrder, false>(ldsp, g, So, EpiBf16StoreRS{Q, D, (const float*)(ws + WS_SSP)}, nullptr);
        asm volatile("s_waitcnt vmcnt(0)" ::: "memory");
        __syncthreads();
        xattn_mfma(Q, KV + (size_t)layer * 1024 * 1024, KV + (size_t)layer * 1024 * 1024 + 512 * 1024, Y, lds_raw);
    }
    SEAM(ph); ++ph;
    if (IN(ph)) dense_gemm(ldsp, Y, (const bf16_t*)(ws + WS_WO) + (size_t)layer * D * D, T, D, D, EpiResid{X, X});
    SEAM(ph); ++ph;
    if (IN(ph)) REP_LOOP router_pass(X, a.in[29] + layer * D, (const float*)(ws + WS_WRT) + (size_t)layer * NE * D, AFF, SLOT, H, lds_raw);
    SEAM(ph); ++ph;
    if (IN(ph)) REP_LOOP {
        unsigned* keys = (unsigned*)ldsf;
        int* hist = (int*)(ldsf + 8192);
        int* sh = hist + 8 * 256;
        if (bid >= 32) {
            LAS float* scr = (LAS float*)((LAS unsigned char*)lds_raw + wave * 16896);
            const int gw2 = (bid - 32) * 8 + wave, ngw2 = (nb - 32) * 8;
            auto ident = [](int n) { return n; };
            if constexpr (layer == 0) {
                auto gmap = [](int n) { return (n >> 7) * 256 + (n & 127); };
                auto umap = [](int n) { return (n >> 7) * 256 + 128 + (n & 127); };
        for (int it = 4096 + gw2; it < 16 * 704; it += ngw2) { const int mt = it / 704, r = it % 704;
            if constexpr (F8L0) transpose_item_fp8(a.in[31] + (size_t)mt * D * DE, D, DE, ws + WS_WGU8 + (size_t)mt * 5632 * D, gmap, GUSC8, scr, r, lane);
            else transpose_item(a.in[31] + (size_t)mt * D * DE, D, DE, (bf16_t*)(ws + WS_WGU) + (size_t)mt * 5632 * D, gmap, scr, r, lane); }
        for (int it = gw2; it < 16 * 704; it += ngw2) { const int mt = it / 704, r = it % 704;
            if constexpr (F8L0) transpose_item_fp8(a.in[32] + (size_t)mt * D * DE, D, DE, ws + WS_WGU8 + (size_t)mt * 5632 * D, umap, GUSC8, scr, r, lane);
            else transpose_item(a.in[32] + (size_t)mt * D * DE, D, DE, (bf16_t*)(ws + WS_WGU) + (size_t)mt * 5632 * D, umap, scr, r, lane); }
            }
            for (int it = gw2; it < 16 * 704; it += ngw2) { const int mt = layer * 16 + it / 704, r = it % 704;
                if constexpr (layer == 1 || F8L0) transpose_item_fp8(a.in[33] + (size_t)mt * DE * D, DE, D, ws + WS_WD8 + (size_t)layer * 88 * MiB + (size_t)(mt - 16 * layer) * D * DE, ident, DSC8, scr, r, lane);
                else transpose_item(a.in[33] + (size_t)mt * DE * D, DE, D, (bf16_t*)(ws + WS_WD) + (size_t)mt * D * DE, ident, scr, r, lane); }
        }
        for (int be = bid; be < NB * NE && be < 32; be += nb) {
            const int b = be >> 4, e = be & 15, eb = e * 2 + b;
            __syncthreads();
            for (int s = tid; s < S; s += NTH) keys[s] = __float_as_uint(AFF[(size_t)(b * S + s) * NE + e]);
            unsigned prefix = 0u; int krem = CAP;
            for (int pass = 3; pass >= 0; --pass) {
                __syncthreads();
                for (int i = tid; i < 8 * 256; i += NTH) hist[i] = 0;
                __syncthreads();
                const unsigned hmask = pass == 3 ? 0u : (0xFFFFFFFFu << (8 * (pass + 1)));
                for (int s = tid; s < S; s += NTH) { const unsigned k = keys[s]; if ((k & hmask) == prefix) atomicAdd(&hist[wave * 256 + ((k >> (8 * pass)) & 255u)], 1); }
                __syncthreads();
                if (wave == 0) {
                    int c4[4], s4 = 0;
#pragma unroll
                    for (int j = 0; j < 4; ++j) { const int bin = 255 - (4 * lane + j); int c = 0;
#pragma unroll
                        for (int w = 0; w < 8; ++w) c += hist[w * 256 + bin];
                        c4[j] = c; s4 += c; }
                    int pre = s4;
#pragma unroll
                    for (int o = 1; o < 64; o <<= 1) { const int y = __shfl_up(pre, o); if (lane >= o) pre += y; }
                    const int excl = pre - s4;
                    if (excl < krem && krem <= pre) {
                        int cum = excl, bsel = 0, rem = 0; bool found = false;
#pragma unroll
                        for (int j = 0; j < 4; ++j) { if (!found && cum + c4[j] >= krem) { bsel = 255 - (4 * lane + j); rem = krem - cum; found = true; } if (!found) cum += c4[j]; }
                        sh[8] = bsel; sh[9] = rem;
                    }
                }
                __syncthreads();
                prefix |= ((unsigned)sh[8]) << (8 * pass); krem = sh[9];
            }
            const unsigned thr = prefix;
            int ce = 0;
            for (int i = 0; i < 16; ++i) { const unsigned k = keys[tid * 16 + i]; ce += (k == thr); }
            int tot;
            const int eqbase = block_exscan(ce, sh, &tot);
            int eqr = eqbase, cs = 0;
            for (int i = 0; i < 16; ++i) { const unsigned k = keys[tid * 16 + i]; const bool sel = (k > thr) || (k == thr && eqr < krem); eqr += (k == thr); cs += sel; }
            const int sbase = block_exscan(cs, sh, &tot);
            int slot = sbase; eqr = eqbase;
            for (int i = 0; i < 16; ++i) {
                const int s = tid * 16 + i; const unsigned k = keys[s];
                const bool sel = (k > thr) || (k == thr && eqr < krem); eqr += (k == thr);
                if (sel) { TOK[eb * CAP + slot] = b * S + s; GATE[eb * CAP + slot] = __uint_as_float(k); SLOT[(size_t)(b * S + s) * NE + e] = eb * CAP + slot; ++slot; }
            }
        }
    }
    SEAM(ph); ++ph;
    if (IN(ph)) {
        MoeOrder So{(int)gridDim.x, (int)blockIdx.x, 16 * 22, 22};
        if constexpr (layer == 1 || F8L0) {
            int Kg = D / 2; asm volatile("" : "+s"(Kg));
            pg8::Gemm g{H, (const bf16_t*)(ws + WS_WGU8 + (size_t)layer * 176 * MiB), NB * NE * CAP, NE * 5632, Kg, TOK};
            pg8::gemm_phase<EpiSiluMul8, MoeOrder, false, true, true>(ldsp, g, So, EpiSiluMul8{(unsigned char*)HID}, nullptr);
        } else {
            pg8::Gemm g{XE, (const bf16_t*)(ws + WS_WGU) + (size_t)layer * NE * 5632 * D, NB * NE * CAP, NE * 5632, D};
            pg8::gemm_phase<EpiSiluMul, MoeOrder, false>(ldsp, g, So, EpiSiluMul{HID}, nullptr);
        }
    }
    SEAM(ph); ++ph;
    if (IN(ph)) {
        MoeOrder So{(int)gridDim.x, (int)blockIdx.x, 16 * 4, 4};
        if constexpr (layer == 1 || F8L0) {
            int Kg = DE / 2; asm volatile("" : "+s"(Kg));
            pg8::Gemm g{HID, (const bf16_t*)(ws + WS_WD8 + (size_t)layer * 88 * MiB), NB * NE * CAP, NE * D, Kg};
            pg8::gemm_phase<EpiYE8, MoeOrder, false, true>(ldsp, g, So, EpiYE8{GATE, YE}, nullptr);
        } else {
            pg8::Gemm g{HID, (const bf16_t*)(ws + WS_WD) + (size_t)layer * NE * D * DE, NB * NE * CAP, NE * D, DE};
            pg8::gemm_phase<EpiYE, MoeOrder, false>(ldsp, g, So, EpiYE{GATE, YE}, nullptr);
        }
    }
    SEAM(ph); ++ph;
    return ph;
}

__global__ void __launch_bounds__(NTH, 2) mega(Args a) {
    extern __shared__ __attribute__((aligned(16))) unsigned char lds_raw[];
    unsigned* ctl = (unsigned*)(a.ws + WS_CTL);
    volatile LAS unsigned* bst = (volatile LAS unsigned*)((LAS unsigned char*)lds_raw + LDS_BAR_OFF);
    { const int t0_ = tidx(); if (t0_ < 4) bst[t0_] = 0u; }
    __syncthreads();
    XcdBarrier bar; bar.bar = ctl + CW_BAR; bar.x = 0; bar.st = bst;
    if (a.hi - a.lo > 1) bar = xcd_barrier_post(ctl + CW_BAR, bst);
    PROLOG

    int ph = 0;
    if (IN(ph)) REP_LOOP {
        for (int i = gt; i < S * 32; i += ngt) {
            const int s = i >> 5, f = i & 31;
            const float pw = (float)exp((double)((float)(2 * f) / 64.0f) * 9.210340371976184);
            const float invf = 1.0f / pw;
            const float angf = (float)s * invf;
            double xx = (double)angf;
            const double n = rint(xx * 0.15915494309189535);
            xx = (xx - n * 6.283185307179586) - n * 2.4492935982947064e-16;
            const double x2 = xx * xx;
            double cs = 1.0, sn = xx, tc = 1.0, tsn = xx;
#pragma unroll 1
            for (int k = 1; k <= 16; ++k) { tc *= -x2 / (double)((2 * k - 1) * (2 * k)); tsn *= -x2 / (double)((2 * k) * (2 * k + 1)); cs += tc; sn += tsn; }
            ropec[i] = (float)cs; ropes[i] = (float)sn;
        }
        rmsnorm_rows_bf16(x_in, a.in[2], H, T);
        rmsnorm_rows_bf16(mem, a.in[25], MN, NB * MEM); rmsnorm_rows_bf16(mem, a.in[25] + D, MN + NB * MEM * D, NB * MEM);
        LAS float* scr = (LAS float*)((LAS unsigned char*)lds_raw + wave * 16896);
        auto ident = [](int n) { return n; };
        auto emap = [](int n) { const bool il = (n < 1024) || (n >= 1536 && n < 2176); const int j = n & 63; return il ? ((n & ~63) + (j < 32 ? 2 * j : 2 * (j - 32) + 1)) : n; };
        for (int it = gw; it < 16 * 36; it += ngw) transpose_item(a.in[3], D, EVEN_IN, (bf16_t*)(ws + WS_WEIN), emap, scr, it, lane);
        for (int it = gw; it < 2 * 16 * 32; it += ngw) { const int l = it / 512, r = it % 512; transpose_item(a.in[27] + (size_t)l * D * 2048, D, 2048, (bf16_t*)(ws + WS_WKV) + (size_t)l * 2048 * D, ident, scr, r, lane); }
        { float* WRT = (float*)(ws + WS_WRT);
          for (int i = gt; i < 2 * NE * D; i += ngt) { const int l = i >> 14, e = (i >> 10) & 15, k = i & 1023; WRT[i] = a.in[29][l * D + k] * a.in[30][((size_t)l * D + k) * NE + e]; } }
        { bf16_t* Wsb = (bf16_t*)(ws + WS_WSB); const float* wsp = a.in[10];
          for (int i = gt; i < 4 * 128 * 128; i += ngt) Wsb[i] = (bf16_t)f2bf(wsp[i]);
          bf16_t* WL = (bf16_t*)(ws + WS_WL); const float *w2 = a.in[14], *a2 = a.in[16], *g2 = a.in[17];
          for (int i = gt; i < 4 * 512 * 64 + 512 * 128; i += ngt) { float v;
              if (i < 4 * 512 * 64) { const int sec = i >> 15, n = (i >> 6) & 511, k = i & 63; v = (sec < 2 ? w2 : a2)[(size_t)((sec & 1) * 64 + k) * 512 + n]; }
              else { const int j = i - 4 * 512 * 64, n = j >> 7, k = j & 127; v = g2[(size_t)k * 512 + n]; }
              WL[i] = (bf16_t)f2bf(v); } }
        auto gmap = [](int n) { return (n >> 7) * 256 + (n & 127); };
        auto umap = [](int n) { return (n >> 7) * 256 + 128 + (n & 127); };
    }
    SEAM(ph); ++ph;

    if (IN(ph)) dense_gemm(ldsp, H, (const bf16_t*)(ws + WS_WEIN), T, EVEN_IN, D,
                           EpiEven{ropec, ropes, (bf16_t*)(ws + WS_QHA), (bf16_t*)(ws + WS_KHA), (bf16_t*)(ws + WS_QHB), (bf16_t*)(ws + WS_KHB), (bf16_t*)(ws + WS_VTA), (bf16_t*)(ws + WS_VTB)});
    if (IN(ph)) {
        dense_gemm(ldsp, MN, (const bf16_t*)(ws + WS_WKV), NB * MEM, 2048, D, EpiKV{KV, KV + 512 * 1024}, 192);
        dense_gemm(ldsp, MN + NB * MEM * D, (const bf16_t*)(ws + WS_WKV) + (size_t)2048 * D, NB * MEM, 2048, D, EpiKV{KV + 1024 * 1024, KV + 1024 * 1024 + 512 * 1024}, 176);
        if (bid >= 96) {
            __syncthreads();
            LAS float* scr = (LAS float*)((LAS unsigned char*)lds_raw + wave * 16896);
            const int gw3 = (bid - 96) * 8 + wave, ngw3 = (nb - 96) * 8;
            auto ident = [](int n) { return n; };
            auto gmap = [](int n) { return (n >> 7) * 256 + (n & 127); };
        for (int it = gw3; it < 16 * 16; it += ngw3) transpose_item(a.in[5], D, D, (bf16_t*)(ws + WS_WEOUT), ident, scr, it, lane);
        for (int it = gw3; it < 16 * 46; it += ngw3) transpose_item(a.in[7], D, ODD_IN, (bf16_t*)(ws + WS_WOIN), ident, scr, it, lane);
        for (int it = gw3; it < 16 * 16; it += ngw3) transpose_item(a.in[23], D, D, (bf16_t*)(ws + WS_WOOUT), ident, scr, it, lane);
        for (int it = gw3; it < 2 * 16 * 16; it += ngw3) { const int l = it / 256, r = it % 256; transpose_item(a.in[26] + (size_t)l * D * D, D, D, (bf16_t*)(ws + WS_WQ) + (size_t)l * D * D, ident, scr, r, lane, a.in[24] + l * D); }
        for (int it = gw3; it < 2 * 16 * 16; it += ngw3) { const int l = it / 256, r = it % 256; transpose_item(a.in[28] + (size_t)l * D * D, D, D, (bf16_t*)(ws + WS_WO) + (size_t)l * D * D, ident, scr, r, lane); }
            for (int it = gw3; it < 4096; it += ngw3) { const int mt = it / 704, r = it % 704;
                if constexpr (F8L0) transpose_item_fp8(a.in[31] + (size_t)mt * D * DE, D, DE, ws + WS_WGU8 + (size_t)mt * 5632 * D, gmap, GUSC8, scr, r, lane);
                else transpose_item(a.in[31] + (size_t)mt * D * DE, D, DE, (bf16_t*)(ws + WS_WGU) + (size_t)mt * 5632 * D, gmap, scr, r, lane); }
        }
    }
    SEAM(ph); ++ph;
    if (IN(ph)) REP_LOOP attn_phase_even((const bf16_t*)(ws + WS_QHA), (const bf16_t*)(ws + WS_KHA), (const bf16_t*)(ws + WS_VTA), (const bf16_t*)(ws + WS_QHB), (const bf16_t*)(ws + WS_KHB),
                                (const bf16_t*)(ws + WS_VTB), a.in[4], (bf16_t*)(ws + WS_OA), (float*)(ws + WS_LSE), Y, lds_raw);
    SEAM(ph); ++ph;
    if (IN(ph)) REP_LOOP attn_combine((const bf16_t*)(ws + WS_OA), (const float*)(ws + WS_LSE), Y);
    SEAM(ph); ++ph;
    if (IN(ph)) dense_gemm(ldsp, Y, (const bf16_t*)(ws + WS_WEOUT), T, D, D, EpiResidN{x_in, X, H, (float*)(ws + WS_SSP)});
    SEAM(ph); ++ph;

    ph = tail_phases<0>(a, bar, lds_raw, ph);
    ph = odd_phases(a, bar, lds_raw, ph);
    ph = tail_phases<1>(a, bar, lds_raw, ph);

    if (IN(ph)) combine_norm<true>(X, YE, SLOT, a.in[34], nullptr, a.out);
    ++ph;
}
constexpr int NPHASES = 1 + 4 + 2 * 6 + 7 + 1;
#undef IN
#undef SEAM
}

extern "C" void kernel_launch(void* const* d_in, const int* in_sizes, int n_in, void* d_out, int out_size, void* d_ws, size_t ws_size, hipStream_t stream) {
    static int grid = 0;
    if (grid == 0) {
        if (n_in != 35 || out_size != T * D || ws_size < WS_END) { fprintf(stderr, "kernel_launch: unexpected shapes n_in %d out %d ws %zu (need %zu)\n", n_in, out_size, ws_size, (size_t)WS_END); grid = -1; return; }
        int dev = 0, cus = 0, per_cu = 0;
        (void)hipGetDevice(&dev); (void)hipDeviceGetAttribute(&cus, hipDeviceAttributeMultiprocessorCount, dev);
        if (hipFuncSetAttribute((const void*)mega, hipFuncAttributeMaxDynamicSharedMemorySize, LDS_BYTES) != hipSuccess) { fprintf(stderr, "hipFuncSetAttribute failed\n"); grid = -1; return; }
        if (hipOccupancyMaxActiveBlocksPerMultiprocessor(&per_cu, (const void*)mega, NTH, LDS_BYTES) != hipSuccess || per_cu < 1) fprintf(stderr, "occupancy query: %d\n", per_cu);
        (void)hipGetLastError();
        grid = cus > 0 ? cus : 256;
    }
    if (grid < 0) return;
    (void)hipMemsetAsync((char*)d_ws + WS_CTL, 0, CTL_BYTES, stream);
    Args a{};
    for (int i = 0; i < 35; ++i) a.in[i] = (const float*)d_in[i];
    a.out = (float*)d_out; a.ws = (unsigned char*)d_ws;
#if MK_MULTI
    for (int k = 0; k < NPHASES; ++k) { a.lo = k; a.hi = k + 1; hipLaunchKernelGGL(mega, dim3(grid), dim3(NTH), LDS_BYTES, stream, a); }
#else
    a.lo = 0; a.hi = NPHASES; hipLaunchKernelGGL(mega, dim3(grid), dim3(NTH), LDS_BYTES, stream, a);
#endif
}
```

```cpp
#include <hip/hip_runtime.h>
#include <cstdio>
#include <cstdint>

#ifndef PROBE_PHASE
#define PROBE_PHASE (-1)
#endif
#ifndef PROBE_REP
#define PROBE_REP 1
#endif
#ifndef MK_MULTI
#define MK_MULTI 0
#endif

__device__ __forceinline__ int tidx() { int t = threadIdx.x; asm volatile("" : "+v"(t)); return t; }
namespace pg8 {
#define PG8_LAS __attribute__((address_space(3)))
typedef unsigned short bf16_t;
typedef short bf16x8 __attribute__((ext_vector_type(8)));
typedef float f32x4 __attribute__((ext_vector_type(4)));
typedef unsigned u32x4 __attribute__((ext_vector_type(4)));
constexpr int BM = 256, BK = 64, HALF = 128, HTB = HALF * BK * 2  , STAGE_BYTES = 8 * HTB, NXCD = 8, WGM = 8;

__host__ __device__ __forceinline__ int lds_byte(int r, int c) { const int st = (r >> 4) * 2 + (c >> 5), rr = r & 15, cc = c & 31, ob = rr * 64 + cc * 2; return st * 1024 + (ob ^ (((ob >> 9) & 1) << 5)); }
__host__ __device__ __forceinline__ void stage_rc(int b, int& R, int& C) { const int st = b / 1024, sb = b % 1024, swz = sb ^ (((sb >> 9) & 1) << 5); R = (st >> 1) * 16 + swz / 64; C = (st & 1) * 32 + (swz % 64) / 2; }
__host__ __device__ __forceinline__ int perm32(int rho) { const int n = rho >> 4, i = rho & 15; return 8 * (i >> 2) + 4 * n + (i & 3); }

struct Unit { int pm, pn; };
struct Gemm { const bf16_t* A; const bf16_t* Bt; int M, N, K; const int* rowidx = nullptr; };

struct StaticOrder {
    int nM, nN, nwg, G, c;
    __host__ __device__ void init(int M, int N, int G_, int c_) { nM = M / BM; nN = N / BM; nwg = nM * nN; G = G_; c = c_; }
    __host__ __device__ bool next(int i, Unit& u) const {
        const long L = (long)i * G + c; if (L >= nwg) return false;
        int wgid = (int)L; { const int q = nwg / NXCD, r = nwg % NXCD, xcd = wgid % NXCD, off = wgid / NXCD; wgid = (xcd < r ? xcd * (q + 1) : r * (q + 1) + (xcd - r) * q) + off; }
        const int nig = WGM * nN, gid = wgid / nig, fm = gid * WGM, gsz = (nM - fm) < WGM ? (nM - fm) : WGM;
        u.pm = fm + ((wgid % nig) % gsz); u.pn = (wgid % nig) / gsz; return true;
    }
    __device__ __forceinline__ void a_ready(const Unit&) const {}
    __device__ __forceinline__ void done(const Unit&) const {}
};

typedef __bf16 bf16v2_t __attribute__((ext_vector_type(2)));
typedef float f32v2_t __attribute__((ext_vector_type(2)));
__device__ __forceinline__ unsigned cvt_pk_bf16(float lo, float hi) { const f32v2_t v = {lo, hi}; return __builtin_bit_cast(unsigned, __builtin_convertvector(v, bf16v2_t)); }
typedef int i32x8 __attribute__((ext_vector_type(8)));
template <bool F8> __device__ __forceinline__ f32x4 mma_tile(const bf16x8 (&bfr)[2], const bf16x8 (&afr)[2], f32x4 acc) {
    if constexpr (F8) {
        typedef int i32x4_ __attribute__((ext_vector_type(4)));
        const i32x4_ b0 = __builtin_bit_cast(i32x4_, bfr[0]), b1 = __builtin_bit_cast(i32x4_, bfr[1]), a0 = __builtin_bit_cast(i32x4_, afr[0]), a1 = __builtin_bit_cast(i32x4_, afr[1]);
        const i32x8 bb = {b0[0], b0[1], b0[2], b0[3], b1[0], b1[1], b1[2], b1[3]}, aa = {a0[0], a0[1], a0[2], a0[3], a1[0], a1[1], a1[2], a1[3]};
        const int sc1 = 0x7f7f7f7f;
        asm volatile("v_mfma_scale_f32_16x16x128_f8f6f4 %0, %1, %2, %0, %3, %3 op_sel_hi:[0,0,0]" : "+v"(acc) : "v"(bb), "v"(aa), "v"(sc1));
        return acc;
    } else {
        acc = __builtin_amdgcn_mfma_f32_16x16x32_bf16(bfr[0], afr[0], acc, 0, 0, 0);
        return __builtin_amdgcn_mfma_f32_16x16x32_bf16(bfr[1], afr[1], acc, 0, 0, 0);
    }
}
template <class Epi, class Sched, bool STAMP = false, bool F8 = false, bool GATHER = false>
__device__ __forceinline__ void gemm_phase(PG8_LAS unsigned char* lds, const Gemm g, const Sched& S, const Epi& E, unsigned long long* stamps) {
    const int tid = ::tidx(), wid = __builtin_amdgcn_readfirstlane(tid >> 6), lane = tid & 63, wr = wid >> 2, wc = wid & 3, fr = lane & 15, fq = lane >> 4;
    const int K = g.K, nt = K / BK;
    int ts_lo = 0, ts_hi = 0, nts = 0; const unsigned long long rt_entry = STAMP ? (unsigned long long)wall_clock64() : 0ull;
#define PG8_STAMP() do { if (STAMP && wid == 0 && nts < 64) { const unsigned long long _c = (unsigned long long)clock64(); \
        ts_lo = (lane == nts) ? (int)(unsigned)_c : ts_lo; ts_hi = (lane == nts) ? (int)(unsigned)(_c >> 32) : ts_hi; ++nts; } } while (0)
    PG8_STAMP();
    unsigned voffA[2], voffB[2]; int rA[2]; unsigned c2A[2];
#pragma unroll
    for (int i = 0; i < 2; ++i) { int R, C; stage_rc(tid * 16 + i * 8192, R, C); const int Rb = Epi::PERM ? ((R & ~31) + perm32(R & 31)) : R;
        voffA[i] = (unsigned)(R * K + C) * 2u; voffB[i] = (unsigned)(Rb * K + C) * 2u; rA[i] = R; c2A[i] = (unsigned)C * 2u; }
    unsigned gaC[2][2], gaN[2][2];
#define PG8_GATHER_OFFS(dst, pm_) do { _Pragma("unroll") for (int _h = 0; _h < 2; ++_h) _Pragma("unroll") for (int _i = 0; _i < 2; ++_i) \
        dst[_h][_i] = (unsigned)g.rowidx[(pm_) * BM + _h * HALF + rA[_i]] * (unsigned)(K * 2) + c2A[_i]; } while (0)
#define PG8_STAGE_A(bufoff, base, half, usenext) do { if constexpr (GATHER) { unsigned _v[2]; _v[0] = (usenext) ? gaN[half][0] : gaC[half][0]; _v[1] = (usenext) ? gaN[half][1] : gaC[half][1]; PG8_STAGE(bufoff, base, _v); } \
        else PG8_STAGE(bufoff, (base) + (half) * hstep, voffA); } while (0)
    const size_t kstep = (size_t)(BK * 2);
    const size_t hstep = (size_t)HALF * K * 2;
    const size_t tstep = 2 * hstep;
    const unsigned ldsw = (unsigned)wid * 1024u;
    const int aoff = lds_byte(wr * 64 + fr, fq * 8), boff = lds_byte(wc * 32 + fr, fq * 8);
#define PG8_SA(b, h) (((b) * 2 + (h)) * HTB)
#define PG8_SB(b, h) ((4 + (b) * 2 + (h)) * HTB)
#define PG8_STAGE(bufoff, gbase, voff) do { _Pragma("unroll") for (int _i = 0; _i < 2; ++_i) \
        __builtin_amdgcn_global_load_lds((const unsigned*)((const char*)(gbase) + (voff)[_i]), (PG8_LAS unsigned*)(lds + (bufoff) + ldsw + _i * 8192), 16, 0, 0); } while (0)
#define PG8_LDA(dst, b, h) do { _Pragma("unroll") for (int m = 0; m < 4; ++m) _Pragma("unroll") for (int k = 0; k < 2; ++k) dst[m][k] = *(const PG8_LAS bf16x8*)(lds + PG8_SA(b, h) + aoff + m * 2048 + k * 1024); } while (0)
#define PG8_LDB(dst, b, h) do { _Pragma("unroll") for (int n = 0; n < 2; ++n) _Pragma("unroll") for (int k = 0; k < 2; ++k) dst[n][k] = *(const PG8_LAS bf16x8*)(lds + PG8_SB(b, h) + boff + n * 2048 + k * 1024); } while (0)
#define PG8_MMA(ai, bj, At, Bt) do { __builtin_amdgcn_s_setprio(1); _Pragma("unroll") for (int m = 0; m < 4; ++m) _Pragma("unroll") for (int n = 0; n < 2; ++n) \
        acc[ai][bj][m][n] = mma_tile<F8>(Bt[n], At[m], acc[ai][bj][m][n]); __builtin_amdgcn_s_setprio(0); } while (0)
#define PG8_WAIT_V(n) asm volatile("s_waitcnt vmcnt(" #n ")" ::: "memory")
#define PG8_WAIT_L(n) asm volatile("s_waitcnt lgkmcnt(" #n ")" ::: "memory")
#define PG8_BAR __builtin_amdgcn_s_barrier()
#define PG8_SCHED __builtin_amdgcn_sched_barrier(0)
    Unit cur, nxt; int ui = 0;
    if (!S.next(0, cur)) return;
    f32x4 acc[2][2][4][2];
#pragma unroll
    for (int a = 0; a < 2; ++a)
#pragma unroll
        for (int b = 0; b < 2; ++b)
#pragma unroll
            for (int m = 0; m < 4; ++m)
#pragma unroll
                for (int n = 0; n < 2; ++n) acc[a][b][m][n] = (f32x4){0.f, 0.f, 0.f, 0.f};
    bf16x8 At[4][2], B0[2][2], B1[2][2];
    const char* cA = GATHER ? (const char*)g.A : (const char*)g.A + (size_t)cur.pm * tstep; const char* cB = (const char*)g.Bt + (size_t)cur.pn * tstep;
    if constexpr (GATHER) { PG8_GATHER_OFFS(gaC, cur.pm); _Pragma("unroll") for (int _h = 0; _h < 2; ++_h) _Pragma("unroll") for (int _i = 0; _i < 2; ++_i) gaN[_h][_i] = gaC[_h][_i]; }
    S.a_ready(cur);
    PG8_STAGE(PG8_SB(0, 0), cB, voffB); PG8_STAGE_A(PG8_SA(0, 0), cA, 0, false); PG8_STAGE(PG8_SB(0, 1), cB + hstep, voffB); PG8_STAGE_A(PG8_SA(0, 1), cA, 1, false);
    if (wr == 1) PG8_BAR;
    PG8_WAIT_V(4); PG8_BAR;
    PG8_STAGE(PG8_SB(1, 0), cB + kstep, voffB); PG8_STAGE_A(PG8_SA(1, 0), cA + kstep, 0, false); PG8_STAGE(PG8_SB(1, 1), cB + hstep + kstep, voffB);
    PG8_WAIT_V(6); PG8_BAR;
    PG8_STAMP();
    for (;;) {
        const bool has_next = S.next(ui + 1, nxt);
        const char* nA = GATHER ? (const char*)g.A : (has_next ? (const char*)g.A + (size_t)nxt.pm * tstep : cA); const char* nB = has_next ? (const char*)g.Bt + (size_t)nxt.pn * tstep : cB;
        if constexpr (GATHER) { if (has_next) PG8_GATHER_OFFS(gaN, nxt.pm); }
        for (int t = 0; t < nt; t += 2) {
            const bool last = (t == nt - 2);
            const char* a1 = cA + (size_t)(t + 1) * kstep;
            const char* a2 = last ? nA : cA + (size_t)(t + 2) * kstep; const char* b2 = last ? nB : cB + (size_t)(t + 2) * kstep;
            const char* a3 = a2 + kstep; const char* b3 = b2 + kstep;
            if (last && has_next) S.a_ready(nxt);
            PG8_LDB(B0, 0, 0); PG8_SCHED; PG8_LDA(At, 0, 0); PG8_STAGE_A(PG8_SA(1, 1), a1, 1, false);
            PG8_WAIT_L(8); PG8_BAR; PG8_WAIT_L(0); PG8_MMA(0, 0, At, B0); PG8_BAR; PG8_SCHED;
            PG8_LDB(B1, 0, 1); PG8_STAGE(PG8_SB(0, 0), b2, voffB);
            PG8_BAR; PG8_WAIT_L(0); PG8_MMA(0, 1, At, B1); PG8_BAR;
            PG8_LDA(At, 0, 1); PG8_STAGE_A(PG8_SA(0, 0), a2, 0, last);
            PG8_BAR; PG8_WAIT_L(0); PG8_MMA(1, 0, At, B0); PG8_BAR; PG8_SCHED;
            PG8_STAGE(PG8_SB(0, 1), b2 + hstep, voffB);
            PG8_WAIT_V(6); PG8_BAR; PG8_MMA(1, 1, At, B1); PG8_BAR;
            PG8_LDB(B0, 1, 0); PG8_SCHED; PG8_LDA(At, 1, 0); PG8_STAGE_A(PG8_SA(0, 1), a2, 1, last);
            PG8_WAIT_L(8); PG8_BAR; PG8_WAIT_L(0); PG8_MMA(0, 0, At, B0); PG8_BAR; PG8_SCHED;
            PG8_LDB(B1, 1, 1); PG8_STAGE(PG8_SB(1, 0), b3, voffB);
            PG8_BAR; PG8_WAIT_L(0); PG8_MMA(0, 1, At, B1); PG8_BAR;
            PG8_LDA(At, 1, 1); PG8_STAGE_A(PG8_SA(1, 0), a3, 0, last);
            PG8_BAR; PG8_WAIT_L(0); PG8_MMA(1, 0, At, B0); PG8_BAR; PG8_SCHED;
            PG8_STAGE(PG8_SB(1, 1), b3 + hstep, voffB);
            PG8_WAIT_V(6); PG8_BAR; PG8_MMA(1, 1, At, B1); PG8_BAR;
        }
        PG8_STAMP();
        if constexpr (!Epi::AFTER_DRAIN) { E(acc, cur, wr, wc, fr, fq); S.done(cur); }
        PG8_STAMP();
        if (!has_next) break;
#pragma unroll
        for (int a = 0; a < 2; ++a)
#pragma unroll
            for (int b = 0; b < 2; ++b)
#pragma unroll
                for (int m = 0; m < 4; ++m)
#pragma unroll
                    for (int n = 0; n < 2; ++n) acc[a][b][m][n] = (f32x4){0.f, 0.f, 0.f, 0.f};
        cur = nxt; cA = nA; cB = nB; ++ui;
        if constexpr (GATHER) { _Pragma("unroll") for (int _h = 0; _h < 2; ++_h) _Pragma("unroll") for (int _i = 0; _i < 2; ++_i) gaC[_h][_i] = gaN[_h][_i]; }
    }
    PG8_WAIT_V(0);
    if (wr == 0) PG8_BAR;
    PG8_BAR;
    if constexpr (Epi::AFTER_DRAIN) { E.fused(acc, cur, wr, wc, fr, fq, lds, wid, lane); S.done(cur); }
    PG8_STAMP();
    if (STAMP && wid == 0) { stamps[lane] = lane < nts ? (((unsigned long long)(unsigned)ts_hi << 32) | (unsigned)ts_lo) : 0ull;
        if (lane == 62) stamps[62] = rt_entry; if (lane == 63) stamps[63] = (unsigned long long)wall_clock64(); }
#undef PG8_STAMP
#undef PG8_SA
#undef PG8_SB
#undef PG8_STAGE
#undef PG8_STAGE_A
#undef PG8_GATHER_OFFS
#undef PG8_LDA
#undef PG8_LDB
#undef PG8_MMA
#undef PG8_WAIT_V
#undef PG8_WAIT_L
#undef PG8_BAR
#undef PG8_SCHED
}
}


namespace {
using pg8::bf16_t; using pg8::f32x4;
constexpr int D = 1024, NB = 2, S = 8192, T = NB * S;
constexpr int EVEN_IN = 2304, ODD_IN = 2944, ODD_PAD = 3072, FD = 1920;
constexpr int MEM = 256, NE = 16, CAP = 1024, DE = 2816;
constexpr int NTH = 512;
constexpr size_t MiB = 1u << 20;
constexpr size_t WS_CTL = 0, CTL_BYTES = 1 * MiB;
constexpr size_t WS_ROPE = 1 * MiB;
constexpr size_t WS_AFF = 4 * MiB;
constexpr size_t WS_TOK = 5 * MiB;
constexpr size_t WS_GATE = 6 * MiB;
constexpr size_t WS_WRT = 3 * MiB;
constexpr size_t WS_SLOT = 7 * MiB;
constexpr size_t WS_X = 8 * MiB;
constexpr size_t WS_H = 72 * MiB;
constexpr size_t WS_Y = 104 * MiB;
constexpr size_t WS_P = 136 * MiB;
constexpr size_t WS_Q = 320 * MiB;
constexpr size_t WS_KV = 384 * MiB;
constexpr size_t WS_MN = 388 * MiB;
constexpr size_t WS_SSP = 390 * MiB;
constexpr size_t WS_DEC = 392 * MiB;
constexpr size_t WS_KD = 456 * MiB;
constexpr size_t WS_BB = 520 * MiB;
constexpr size_t WS_KK = 584 * MiB;
constexpr size_t WS_G = 616 * MiB;
constexpr size_t WS_YS = 648 * MiB;
constexpr size_t WS_RV = 712 * MiB;
constexpr size_t WS_VN = 776 * MiB;
constexpr size_t WS_QHA = 136 * MiB;
constexpr size_t WS_KHA = 152 * MiB;
constexpr size_t WS_QHB = 168 * MiB;
constexpr size_t WS_KHB = 184 * MiB;
constexpr size_t WS_PVB = 188 * MiB;
constexpr size_t WS_VTA = 208 * MiB;
constexpr size_t WS_VTB = 256 * MiB;
constexpr size_t WS_OA = 260 * MiB;
constexpr size_t WS_LSE = 308 * MiB;
constexpr size_t WS_QT = 136 * MiB;
constexpr size_t WS_YL = 200 * MiB;
constexpr size_t WS_PT = 264 * MiB;
constexpr size_t WS_RH = 296 * MiB;
constexpr size_t WS_S0 = 328 * MiB;
constexpr size_t WS_XE = 136 * MiB;
constexpr size_t WS_YE = 136 * MiB;
constexpr size_t WS_HID = 200 * MiB;
constexpr size_t WS_KB = 360 * MiB;
constexpr size_t WS_F5 = 792 * MiB;
constexpr size_t WS_WSB = 804 * MiB;
constexpr size_t WS_WL = 805 * MiB;
constexpr size_t WS_WEIN = 808 * MiB;
constexpr size_t WS_WEOUT = 813 * MiB;
constexpr size_t WS_WOIN = 815 * MiB;
constexpr size_t WS_WOOUT = 821 * MiB;
constexpr size_t WS_WQ = 823 * MiB;
constexpr size_t WS_WKV = 827 * MiB;
constexpr size_t WS_WO = 835 * MiB;
constexpr size_t WS_WGU = 840 * MiB;
constexpr size_t WS_WD = 1192 * MiB;
constexpr size_t WS_WGU8 = 840 * MiB;
constexpr size_t WS_WD8 = 1192 * MiB;
constexpr size_t WS_END = 1368 * MiB;
constexpr bool F8L0 = true;
constexpr float ASC8 = 16.f, GUSC8 = 128.f, HSC8 = 4.f, DSC8 = 256.f;
constexpr int CW_BAR = 4096;

constexpr int LDS_BYTES = 147456;
constexpr int LDS_BAR_OFF = LDS_BYTES - 64;

#define LAS __attribute__((address_space(3)))
#define XB_TMO      128
#define XB_XCNT(j)  (256  + 64 * (j))
#define XB_XSUB(j)  (1280 + 64 * (j))
#define XB_XGEN(j)  (2304 + 64 * (j))
#define XB_TOP      3328
#define XB_TOPGEN   3392
#define XCD_BAR_WORDS 3456
#define XB_SPIN_CAP (1u << 22)
__device__ __forceinline__ unsigned xb_ld(unsigned* p)              { return __hip_atomic_load(p, __ATOMIC_RELAXED, __HIP_MEMORY_SCOPE_AGENT); }
__device__ __forceinline__ unsigned xb_add(unsigned* p, unsigned v) { return __hip_atomic_fetch_add(p, v, __ATOMIC_RELAXED, __HIP_MEMORY_SCOPE_AGENT); }
__device__ __forceinline__ unsigned xb_xcc_id() { return (unsigned)__builtin_amdgcn_s_getreg((3 << 11) | 20) & 0xFu; }
#define XB_SPIN(cond, bar) do { unsigned _sp = 0; while (cond) { __builtin_amdgcn_s_sleep(1); \
    if ((++_sp & 255u) == 0u) { if (xb_ld(&(bar)[XB_TMO])) break; if (_sp > XB_SPIN_CAP) { atomicAdd(&(bar)[XB_TMO], 1u); break; } } } } while (0)
struct XcdBarrier { unsigned* bar; unsigned x; volatile LAS unsigned* st; };
__device__ __forceinline__ XcdBarrier xcd_barrier_post(unsigned* bar, volatile LAS unsigned* st) {
    XcdBarrier b; b.bar = bar; b.x = xb_xcc_id(); b.st = st;
    if (threadIdx.x == 0) (void)xb_add(&bar[XB_XCNT(b.x)], 1u);
    return b;
}
__device__ __forceinline__ void xcd_barrier_complete(unsigned* bar, unsigned x, unsigned& nloc, unsigned& nx) {
    const unsigned G = gridDim.x * gridDim.y * gridDim.z;
    unsigned sum, cnt, mine, sp = 0u;
    for (;;) {
        sum = 0u; cnt = 0u; mine = 0u;
#pragma unroll
        for (unsigned j = 0; j < 16; ++j) { const unsigned c = xb_ld(&bar[XB_XCNT(j)]); sum += c; cnt += (c > 0u) ? 1u : 0u; mine = (j == x) ? c : mine; }
        if (sum == G) break;
        __builtin_amdgcn_s_sleep(1);
        if ((++sp & 255u) == 0u) { if (xb_ld(&bar[XB_TMO])) break; if (sp > XB_SPIN_CAP) { atomicAdd(&bar[XB_TMO], 1u); break; } }
    }
    nloc = mine > 0u ? mine : 1u; nx = cnt > 0u ? cnt : 1u;
}
__device__ __forceinline__ void xcd_barrier(const XcdBarrier& b) {
    asm volatile("s_waitcnt vmcnt(0)" ::: "memory");
    __syncthreads();
    if (threadIdx.x == 0) {
        unsigned* bar = b.bar;
        __builtin_amdgcn_s_waitcnt(0);
        unsigned nloc = b.st[0], nx = b.st[1];
        if (nloc == 0u) { xcd_barrier_complete(bar, b.x, nloc, nx); b.st[0] = nloc; b.st[1] = nx; }
        const unsigned old = xb_add(&bar[XB_XSUB(b.x)], 1u);
        const unsigned gen = old / nloc;
        if (old + 1u == (gen + 1u) * nloc) {
            __builtin_amdgcn_fence(__ATOMIC_RELEASE, "agent");
            asm volatile("s_waitcnt vmcnt(0)" ::: "memory");
            const unsigned og = xb_add(&bar[XB_TOP], 1u);
            const unsigned tg = og / nx;
            if (og + 1u == (tg + 1u) * nx) xb_add(&bar[XB_TOPGEN], 1u);
            else XB_SPIN(xb_ld(&bar[XB_TOPGEN]) == tg, bar);
            __builtin_amdgcn_fence(__ATOMIC_ACQUIRE, "agent");
            xb_add(&bar[XB_XGEN(b.x)], 1u);
            asm volatile("s_waitcnt vmcnt(0)" ::: "memory");
        } else {
            XB_SPIN(xb_ld(&bar[XB_XGEN(b.x)]) == gen, bar);
            __builtin_amdgcn_fence(__ATOMIC_ACQUIRE, "agent");
            asm volatile("s_waitcnt vmcnt(0)" ::: "memory");
        }
    }
    __syncthreads();
}

__device__ __forceinline__ float wave_sum(float v) {
#pragma unroll
    for (int o = 32; o >= 1; o >>= 1) v += __shfl_xor(v, o);
    return v;
}
__device__ __forceinline__ float frcp(float x) { return __builtin_amdgcn_rcpf(x); }
__device__ __forceinline__ float sigmoidf_(float x) { return frcp(1.0f + __expf(-x)); }
__device__ __forceinline__ float tanhf_(float x) { return 2.0f * sigmoidf_(2.0f * x) - 1.0f; }
__device__ __forceinline__ float gelu_tanh(float x) { return x * sigmoidf_(1.5957691216057308f * (x + 0.044715f * x * x * x)); }
__device__ __forceinline__ unsigned f2bf(float f) { unsigned u = __builtin_bit_cast(unsigned, f); return (u + 0x7fffu + ((u >> 16) & 1u)) >> 16; }
__device__ __forceinline__ unsigned pk2(float lo, float hi) { return pg8::cvt_pk_bf16(lo, hi); }
__device__ __forceinline__ float bflo(unsigned w) { return __uint_as_float(w << 16); }
__device__ __forceinline__ float bfhi(unsigned w) { return __uint_as_float(w & 0xffff0000u); }
typedef unsigned v4u __attribute__((ext_vector_type(4)));
typedef unsigned v2u __attribute__((ext_vector_type(2)));

struct Args { const float* in[35]; float* out; unsigned char* ws; int lo, hi; };

struct EpiF32Store {
    static constexpr bool PERM = false, AFTER_DRAIN = false;
    float* C; int ldc; int nvalid;
    __device__ __forceinline__ void operator()(const f32x4 (&acc)[2][2][4][2], const pg8::Unit& u, int wr, int wc, int fr, int fq) const {
        const int row0 = u.pm * 256 + wr * 64 + fr, col0 = u.pn * 256 + wc * 32 + 4 * fq;
#pragma unroll
        for (int ai = 0; ai < 2; ++ai)
#pragma unroll
            for (int m = 0; m < 4; ++m) { float* rowp = C + (size_t)(row0 + ai * 128 + m * 16) * ldc + col0;
#pragma unroll
                for (int bj = 0; bj < 2; ++bj)
#pragma unroll
                    for (int n = 0; n < 2; ++n) if (col0 + bj * 128 + n * 16 < nvalid) *(f32x4*)(rowp + bj * 128 + n * 16) = acc[ai][bj][m][n]; }
    }
};
struct EpiResid {
    static constexpr bool PERM = false, AFTER_DRAIN = false;
    const float* base; float* out;
    __device__ __forceinline__ void operator()(const f32x4 (&acc)[2][2][4][2], const pg8::Unit& u, int wr, int wc, int fr, int fq) const {
        const int row0 = u.pm * 256 + wr * 64 + fr, col0 = u.pn * 256 + wc * 32 + 4 * fq;
#pragma unroll
        for (int ai = 0; ai < 2; ++ai)
#pragma unroll
            for (int m = 0; m < 4; ++m) { const size_t off = (size_t)(row0 + ai * 128 + m * 16) * D + col0;
#pragma unroll
                for (int bj = 0; bj < 2; ++bj)
#pragma unroll
                    for (int n = 0; n < 2; ++n) { const f32x4 b = *(const f32x4*)(base + off + bj * 128 + n * 16); *(f32x4*)(out + off + bj * 128 + n * 16) = b + acc[ai][bj][m][n]; } }
    }
};
struct EpiSiluMul {
    static constexpr bool PERM = false, AFTER_DRAIN = false;
    bf16_t* HIDp;
    __device__ __forceinline__ void operator()(const f32x4 (&acc)[2][2][4][2], const pg8::Unit& u, int wr, int wc, int fr, int fq) const {
        const int pnl = u.pn % 22;
        const int row0 = u.pm * 256 + wr * 64 + fr, col0 = pnl * 128 + wc * 32 + 4 * fq;
#pragma unroll
        for (int ai = 0; ai < 2; ++ai)
#pragma unroll
            for (int m = 0; m < 4; ++m) { bf16_t* rowp = HIDp + (size_t)(row0 + ai * 128 + m * 16) * DE + col0;
#pragma unroll
                for (int n = 0; n < 2; ++n) { const f32x4 g = acc[ai][0][m][n], up = acc[ai][1][m][n]; float h[4];
#pragma unroll
                    for (int j = 0; j < 4; ++j) h[j] = g[j] * frcp(1.0f + __expf(-g[j])) * up[j];
                    v2u w; w.x = pk2(h[0], h[1]); w.y = pk2(h[2], h[3]); *(v2u*)(rowp + n * 16) = w; } }
    }
};
struct EpiYE {
    static constexpr bool PERM = true, AFTER_DRAIN = false;
    const float* GATE; bf16_t* YE;
    __device__ __forceinline__ void operator()(const f32x4 (&acc)[2][2][4][2], const pg8::Unit& u, int wr, int wc, int fr, int fq) const {
        const int pnl = u.pn & 3;
        const int row0 = u.pm * 256 + wr * 64 + fr, col0 = pnl * 256 + wc * 32 + 8 * fq;
#pragma unroll
        for (int ai = 0; ai < 2; ++ai)
#pragma unroll
            for (int m = 0; m < 4; ++m) { const int row = row0 + ai * 128 + m * 16; const float gt_ = GATE[row]; bf16_t* rowp = YE + (size_t)row * D + col0;
#pragma unroll
                for (int bj = 0; bj < 2; ++bj) { const f32x4 v0 = acc[ai][bj][m][0] * gt_, v1 = acc[ai][bj][m][1] * gt_;
                    v4u w; w.x = pg8::cvt_pk_bf16(v0[0], v0[1]); w.y = pg8::cvt_pk_bf16(v0[2], v0[3]); w.z = pg8::cvt_pk_bf16(v1[0], v1[1]); w.w = pg8::cvt_pk_bf16(v1[2], v1[3]);
                    *(v4u*)(rowp + bj * 128) = w; } }
    }
};
struct EpiBf16Store {
    static constexpr bool PERM = true, AFTER_DRAIN = false;
    bf16_t* O; int ldc; float scale;
    __device__ __forceinline__ void operator()(const f32x4 (&acc)[2][2][4][2], const pg8::Unit& u, int wr, int wc, int fr, int fq) const {
        const int row0 = u.pm * 256 + wr * 64 + fr, col0 = u.pn * 256 + wc * 32 + 8 * fq;
#pragma unroll
        for (int ai = 0; ai < 2; ++ai)
#pragma unroll
            for (int m = 0; m < 4; ++m) { bf16_t* rowp = O + (size_t)(row0 + ai * 128 + m * 16) * ldc + col0;
#pragma unroll
                for (int bj = 0; bj < 2; ++bj) { const f32x4 v0 = acc[ai][bj][m][0] * scale, v1 = acc[ai][bj][m][1] * scale;
                    v4u w; w.x = pg8::cvt_pk_bf16(v0[0], v0[1]); w.y = pg8::cvt_pk_bf16(v0[2], v0[3]); w.z = pg8::cvt_pk_bf16(v1[0], v1[1]); w.w = pg8::cvt_pk_bf16(v1[2], v1[3]);
                    *(v4u*)(rowp + bj * 128) = w; } }
    }
};
struct EpiKV {
    static constexpr bool PERM = false, AFTER_DRAIN = false;
    bf16_t* K; bf16_t* Vt;
    __device__ __forceinline__ void operator()(const f32x4 (&acc)[2][2][4][2], const pg8::Unit& u, int wr, int wc, int fr, int fq) const {
        const int row0 = u.pm * 256 + wr * 64 + fr, col0 = u.pn * 256 + wc * 32 + 4 * fq;
#pragma unroll
        for (int ai = 0; ai < 2; ++ai)
#pragma unroll
            for (int m = 0; m < 4; ++m) { const int row = row0 + ai * 128 + m * 16;
#pragma unroll
                for (int bj = 0; bj < 2; ++bj)
#pragma unroll
                    for (int n = 0; n < 2; ++n) { const int col = col0 + bj * 128 + n * 16; const f32x4 v = acc[ai][bj][m][n];
                        if (col < 1024) { v2u w; w.x = pk2(v[0], v[1]); w.y = pk2(v[2], v[3]); *(v2u*)(K + (size_t)row * 1024 + col) = w; }
                        else { const int b = row >> 8, mm = row & 255; bf16_t* vp = Vt + ((size_t)(b * 1024 + (col - 1024)) * 256 + mm);
#pragma unroll
                            for (int j = 0; j < 4; ++j) vp[(size_t)j * 256] = (bf16_t)f2bf(v[j]); } } }
    }
};

constexpr float QSCALE = 0.125f * 1.4426950408889634f;
struct EpiEven {
    static constexpr bool PERM = true, AFTER_DRAIN = false;
    const float* rc; const float* rs; bf16_t* QhA; bf16_t* KhA; bf16_t* QhB; bf16_t* KhB; bf16_t* VhA; bf16_t* VhB;
    __device__ __forceinline__ void operator()(const f32x4 (&acc)[2][2][4][2], const pg8::Unit& u, int wr, int wc, int fr, int fq) const {
        asm volatile("" : "+v"(fr), "+v"(fq));
        const int row0 = u.pm * 256 + wr * 64 + fr;
#pragma unroll
        for (int bj = 0; bj < 2; ++bj) {
            const int c0 = u.pn * 256 + bj * 128 + wc * 32 + 8 * fq;
            int kind; bf16_t* base; int stride; float sc = 1.0f;
            if (c0 < 512) { kind = 0; base = QhA + ((size_t)(c0 >> 6) * T) * 64 + (c0 & 63); stride = 64; sc = QSCALE; }
            else if (c0 < 1024) { kind = 0; base = KhA + ((size_t)((c0 - 512) >> 6) * T) * 64 + (c0 & 63); stride = 64; }
            else if (c0 < 1536) { kind = 1; base = VhA + ((size_t)((c0 - 1024) >> 6) * T) * 64 + (c0 & 63); stride = 64; }
            else if (c0 < 2048) { kind = 0; base = QhB + ((size_t)((c0 - 1536) >> 6) * T) * 64 + (c0 & 63); stride = 64; sc = QSCALE; }
            else if (c0 < 2176) { kind = 0; base = KhB + ((size_t)((c0 - 2048) >> 6) * T) * 64 + (c0 & 63); stride = 64; }
            else { kind = 1; base = VhB + ((size_t)((c0 - 2176) >> 6) * T) * 64 + (c0 & 63); stride = 64; }
            const int pi = (c0 & 63) >> 1;
#pragma unroll
            for (int ai = 0; ai < 2; ++ai)
#pragma unroll
                for (int m = 0; m < 4; ++m) {
                    const int tok = row0 + ai * 128 + m * 16;
                    const f32x4 v0 = acc[ai][bj][m][0], v1 = acc[ai][bj][m][1];
                    float y[8];
                    if (kind == 0) {
                        const int s = tok & (S - 1);
                        const f32x4 c4 = *(const f32x4*)(rc + s * 32 + pi), s4 = *(const f32x4*)(rs + s * 32 + pi);
                        y[0] = (v0[0] * c4[0] - v0[1] * s4[0]) * sc; y[1] = (v0[1] * c4[0] + v0[0] * s4[0]) * sc;
                        y[2] = (v0[2] * c4[1] - v0[3] * s4[1]) * sc; y[3] = (v0[3] * c4[1] + v0[2] * s4[1]) * sc;
                        y[4] = (v1[0] * c4[2] - v1[1] * s4[2]) * sc; y[5] = (v1[1] * c4[2] + v1[0] * s4[2]) * sc;
                        y[6] = (v1[2] * c4[3] - v1[3] * s4[3]) * sc; y[7] = (v1[3] * c4[3] + v1[2] * s4[3]) * sc;
                    } else { y[0] = v0[0]; y[1] = v0[1]; y[2] = v0[2]; y[3] = v0[3]; y[4] = v1[0]; y[5] = v1[1]; y[6] = v1[2]; y[7] = v1[3]; }
                    v4u w; w.x = pk2(y[0], y[1]); w.y = pk2(y[2], y[3]); w.z = pk2(y[4], y[5]); w.w = pk2(y[6], y[7]);
                    *(v4u*)(base + (size_t)tok * stride) = w;
                }
        }
    }
};

struct EpiLora {
    static constexpr bool PERM = false, AFTER_DRAIN = false;
    const float *w0, *a0, *k_a; const bf16_t *KB, *KK; bf16_t *LW, *KD, *BB, *G;
    __device__ __forceinline__ void operator()(const f32x4 (&acc)[2][2][4][2], const pg8::Unit& u, int wr, int wc, int fr, int fq) const {
        asm volatile("" : "+v"(fr), "+v"(fq));
        const int row0 = u.pm * 256 + wr * 64 + fr;
#pragma unroll
        for (int bj = 0; bj < 2; ++bj)
#pragma unroll
            for (int n = 0; n < 2; ++n) {
                const int c0 = u.pn * 256 + bj * 128 + wc * 32 + n * 16 + 4 * fq, sec = c0 >> 9, cc = c0 & 511;
#pragma unroll
                for (int ai = 0; ai < 2; ++ai)
#pragma unroll
                    for (int m = 0; m < 4; ++m) {
                        const size_t tok = row0 + ai * 128 + m * 16;
                        const f32x4 v = acc[ai][bj][m][n];
                        if (sec < 2) {
                            const f32x4 w = *(const f32x4*)(w0 + sec * 512 + cc); float o[4];
#pragma unroll
                            for (int j = 0; j < 4; ++j) { const float xw = -(w[j] + v[j]);
                                o[j] = -0.6065306597126334f * frcp(1.0f + __expf(xw)); }
                            v2u ww; ww.x = pk2(o[0], o[1]); ww.y = pk2(o[2], o[3]);
                            *(v2u*)(LW + ((size_t)sec * T + tok) * 512 + cc) = ww;
                        } else if (sec < 4) {
                            const int d = sec - 2;
                            const f32x4 a_ = *(const f32x4*)(a0 + d * 512 + cc), ka = *(const f32x4*)(k_a + cc);
                            const v2u kw = *(const v2u*)(KB + tok * 512 + cc), kkw = *(const v2u*)(KK + tok * 512 + cc);
                            const float kv[4] = {bflo(kw.x), bfhi(kw.x), bflo(kw.y), bfhi(kw.y)}, kk[4] = {bflo(kkw.x), bfhi(kkw.x), bflo(kkw.y), bfhi(kkw.y)};
                            float okd[4], obb[4];
#pragma unroll
                            for (int j = 0; j < 4; ++j) { const float alr = frcp(1.0f + __expf(-(a_[j] + v[j]))); okd[j] = kv[j] * (1.0f + (alr - 1.0f) * ka[j]); obb[j] = kk[j] * alr; }
                            v2u w1, w2_; w1.x = pk2(okd[0], okd[1]); w1.y = pk2(okd[2], okd[3]); w2_.x = pk2(obb[0], obb[1]); w2_.y = pk2(obb[2], obb[3]);
                            *(v2u*)(KD + ((size_t)d * T + tok) * 512 + cc) = w1; *(v2u*)(BB + ((size_t)d * T + tok) * 512 + cc) = w2_;
                        } else { v2u ww; ww.x = pk2(v[0], v[1]); ww.y = pk2(v[2], v[3]); *(v2u*)(G + tok * 512 + cc) = ww; }
                        __builtin_amdgcn_sched_barrier(0);
                    }
            }
    }
};

__device__ __forceinline__ float clamp8(float x) { return __builtin_amdgcn_fmed3f(x, -448.f, 448.f); }
__device__ __forceinline__ unsigned pk4_fp8(float a, float b, float c, float d) {
    int w = 0; w = __builtin_amdgcn_cvt_pk_fp8_f32(clamp8(a), clamp8(b), w, false); w = __builtin_amdgcn_cvt_pk_fp8_f32(clamp8(c), clamp8(d), w, true); return (unsigned)w;
}
struct EpiSiluMul8 {
    static constexpr bool PERM = true, AFTER_DRAIN = false;
    unsigned char* HIDp;
    __device__ __forceinline__ void operator()(const f32x4 (&acc)[2][2][4][2], const pg8::Unit& u, int wr, int wc, int fr, int fq) const {
        asm volatile("s_nop 7\n\ts_nop 7\n\ts_nop 7"); __builtin_amdgcn_sched_barrier(0);
        const int pnl = u.pn % 22;
        const int row0 = u.pm * 256 + wr * 64 + fr, col0 = pnl * 128 + wc * 32 + 8 * fq;
        const float s1 = 1.0f / (ASC8 * GUSC8);
#pragma unroll
        for (int ai = 0; ai < 2; ++ai)
#pragma unroll
            for (int m = 0; m < 4; ++m) { unsigned char* rowp = HIDp + (size_t)(row0 + ai * 128 + m * 16) * DE + col0; float h[8];
#pragma unroll
                for (int n = 0; n < 2; ++n) { const f32x4 g = acc[ai][0][m][n] * s1, up = acc[ai][1][m][n] * (s1 * HSC8);
#pragma unroll
                    for (int j = 0; j < 4; ++j) h[4 * n + j] = g[j] * frcp(1.0f + __expf(-g[j])) * up[j]; }
                v2u w; w.x = pk4_fp8(h[0], h[1], h[2], h[3]); w.y = pk4_fp8(h[4], h[5], h[6], h[7]);
                __builtin_nontemporal_store(w, (v2u*)rowp); }
    }
};
struct EpiYE8 {
    static constexpr bool PERM = true, AFTER_DRAIN = false;
    const float* GATE; bf16_t* YE;
    __device__ __forceinline__ void operator()(const f32x4 (&acc)[2][2][4][2], const pg8::Unit& u, int wr, int wc, int fr, int fq) const {
        asm volatile("s_nop 7\n\ts_nop 7\n\ts_nop 7"); __builtin_amdgcn_sched_barrier(0);
        const int pnl = u.pn & 3;
        const int row0 = u.pm * 256 + wr * 64 + fr, col0 = pnl * 256 + wc * 32 + 8 * fq;
#pragma unroll
        for (int ai = 0; ai < 2; ++ai)
#pragma unroll
            for (int m = 0; m < 4; ++m) { const int row = row0 + ai * 128 + m * 16; const float gt_ = GATE[row] * (1.0f / (HSC8 * DSC8)); bf16_t* rowp = YE + (size_t)row * D + col0;
#pragma unroll
                for (int bj = 0; bj < 2; ++bj) { const f32x4 v0 = acc[ai][bj][m][0] * gt_, v1 = acc[ai][bj][m][1] * gt_;
                    v4u w; w.x = pk2(v0[0], v0[1]); w.y = pk2(v0[2], v0[3]); w.z = pk2(v1[0], v1[1]); w.w = pk2(v1[2], v1[3]);
                    *(v4u*)(rowp + bj * 128) = w; } }
    }
};
template <class RowMap>
__device__ __forceinline__ void transpose_item_fp8(const float* W, int K, int N, unsigned char* WT, RowMap rm, float sc, LAS float* scr, int item, int lane) {
    const int nblk = N / 64, kb = item / nblk, nb_ = item % nblk, k0 = 64 * kb, n0 = 64 * nb_;
    f32x4 ld[16];
#pragma unroll
    for (int i = 0; i < 16; ++i) ld[i] = *(const f32x4*)(W + (size_t)(k0 + 4 * i + (lane >> 4)) * N + n0 + 4 * (lane & 15));
#pragma unroll
    for (int i = 0; i < 16; ++i) { LAS float* p = scr + (4 * i + (lane >> 4)) * 65 + 4 * (lane & 15); p[0] = ld[i][0]; p[1] = ld[i][1]; p[2] = ld[i][2]; p[3] = ld[i][3]; }
    asm volatile("s_waitcnt lgkmcnt(0)" ::: "memory");
    const int c = lane & 3;
#pragma unroll
    for (int j = 0; j < 4; ++j) { const int n = (lane >> 2) + 16 * j; const LAS float* s = scr + (16 * c) * 65 + n;
        v4u o;
#pragma unroll
        for (int q = 0; q < 4; ++q) o[q] = pk4_fp8(s[(4 * q) * 65] * sc, s[(4 * q + 1) * 65] * sc, s[(4 * q + 2) * 65] * sc, s[(4 * q + 3) * 65] * sc);
        *(v4u*)(WT + (size_t)rm(n0 + n) * K + k0 + 16 * c) = o; }
    asm volatile("s_waitcnt lgkmcnt(0)" ::: "memory");
}

struct EpiResidN {
    static constexpr bool PERM = false, AFTER_DRAIN = false;
    const float* base; float* out; bf16_t* Xb; float* SSP;
    __device__ __forceinline__ void operator()(const f32x4 (&acc)[2][2][4][2], const pg8::Unit& u, int wr, int wc, int fr, int fq) const {
        asm volatile("" : "+v"(fr), "+v"(fq));
        const int row0 = u.pm * 256 + wr * 64 + fr, col0 = u.pn * 256 + wc * 32 + 4 * fq;
#pragma unroll
        for (int ai = 0; ai < 2; ++ai)
#pragma unroll
            for (int m = 0; m < 4; ++m) { const size_t row = row0 + ai * 128 + m * 16; const size_t off = row * D + col0; float ss = 0.f;
#pragma unroll
                for (int bj = 0; bj < 2; ++bj)
#pragma unroll
                    for (int n = 0; n < 2; ++n) { const f32x4 b = *(const f32x4*)(base + off + bj * 128 + n * 16); const f32x4 o = b + acc[ai][bj][m][n];
                        *(f32x4*)(out + off + bj * 128 + n * 16) = o;
                        v2u w; w.x = pk2(o[0], o[1]); w.y = pk2(o[2], o[3]); *(v2u*)(Xb + off + bj * 128 + n * 16) = w;
                        ss += (o[0] * o[0] + o[1] * o[1]) + (o[2] * o[2] + o[3] * o[3]); }
                ss += __shfl_xor(ss, 16); ss += __shfl_xor(ss, 32);
                if (fq == 0) SSP[row * 16 + u.pn * 4 + wc] = ss; }
    }
};
struct EpiBf16StoreRS {
    static constexpr bool PERM = true, AFTER_DRAIN = false;
    bf16_t* O; int ldc; const float* SSP;
    __device__ __forceinline__ void operator()(const f32x4 (&acc)[2][2][4][2], const pg8::Unit& u, int wr, int wc, int fr, int fq) const {
        asm volatile("" : "+v"(fr), "+v"(fq));
        const int row0 = u.pm * 256 + wr * 64 + fr, col0 = u.pn * 256 + wc * 32 + 8 * fq;
#pragma unroll
        for (int ai = 0; ai < 2; ++ai)
#pragma unroll
            for (int m = 0; m < 4; ++m) { const size_t row = row0 + ai * 128 + m * 16;
                const f32x4* sp = (const f32x4*)(SSP + row * 16); const f32x4 s0 = sp[0], s1 = sp[1], s2 = sp[2], s3 = sp[3];
                const float ss = (((s0[0] + s0[1]) + (s0[2] + s0[3])) + ((s1[0] + s1[1]) + (s1[2] + s1[3]))) + (((s2[0] + s2[1]) + (s2[2] + s2[3])) + ((s3[0] + s3[1]) + (s3[2] + s3[3])));
                const float rs = rsqrtf(ss * (1.0f / D) + 1e-6f);
                bf16_t* rowp = O + row * ldc + col0;
#pragma unroll
                for (int bj = 0; bj < 2; ++bj) { const f32x4 v0 = acc[ai][bj][m][0] * rs, v1 = acc[ai][bj][m][1] * rs;
                    v4u w; w.x = pk2(v0[0], v0[1]); w.y = pk2(v0[2], v0[3]); w.z = pk2(v1[0], v1[1]); w.w = pk2(v1[2], v1[3]);
                    *(v4u*)(rowp + bj * 128) = w; } }
    }
};
struct MoeOrder {
    int G, c, npairs;
    int per;
    __device__ __forceinline__ bool next(int i, pg8::Unit& u) const {
        const int x = c & 7, y = c >> 3, pml = y & 7, pnq = y >> 3;
        const int epn = i * 32 + x * 4 + pnq;
        if (epn >= npairs || c >= 256) return false;
        const int e = epn / per;
        u.pm = e * 8 + pml; u.pn = epn; return true;
    }
    __device__ __forceinline__ void a_ready(const pg8::Unit&) const {}
    __device__ __forceinline__ void done(const pg8::Unit&) const {}
};

struct XattnOrder {
    int c;
    __device__ __forceinline__ bool next(int i, pg8::Unit& u) const { if (i != 0 || c >= 256) return false; u.pm = (c >> 7) * 32 + (c & 31); u.pn = (c >> 5) & 3; return true; }
    __device__ __forceinline__ void a_ready(const pg8::Unit&) const {}
    __device__ __forceinline__ void done(const pg8::Unit&) const {}
};
template <class RowMap>
__device__ __forceinline__ void transpose_item(const float* W, int K, int N, bf16_t* WT, RowMap rm, LAS float* scr, int item, int lane, const float* kscale = nullptr) {
    const int nblk = N / 64, kb = item / nblk, nb_ = item % nblk, k0 = 64 * kb, n0 = 64 * nb_;
    f32x4 ld[16];
#pragma unroll
    for (int i = 0; i < 16; ++i) ld[i] = *(const f32x4*)(W + (size_t)(k0 + 4 * i + (lane >> 4)) * N + n0 + 4 * (lane & 15));
#pragma unroll
    for (int i = 0; i < 16; ++i) { LAS float* p = scr + (4 * i + (lane >> 4)) * 65 + 4 * (lane & 15); p[0] = ld[i][0]; p[1] = ld[i][1]; p[2] = ld[i][2]; p[3] = ld[i][3]; }
    asm volatile("s_waitcnt lgkmcnt(0)" ::: "memory");
    const int c = lane & 7;
    float ksc[8];
#pragma unroll
    for (int q = 0; q < 8; ++q) ksc[q] = kscale ? kscale[k0 + 8 * c + q] : 1.0f;
#pragma unroll
    for (int j = 0; j < 8; ++j) { const int n = (lane >> 3) + 8 * j; const LAS float* s = scr + (8 * c) * 65 + n;
        v4u o; o.x = pk2(s[0 * 65] * ksc[0], s[1 * 65] * ksc[1]); o.y = pk2(s[2 * 65] * ksc[2], s[3 * 65] * ksc[3]); o.z = pk2(s[4 * 65] * ksc[4], s[5 * 65] * ksc[5]); o.w = pk2(s[6 * 65] * ksc[6], s[7 * 65] * ksc[7]);
        *(v4u*)(WT + (size_t)rm(n0 + n) * K + k0 + 8 * c) = o; }
    asm volatile("s_waitcnt lgkmcnt(0)" ::: "memory");
}

__device__ __forceinline__ void rmsnorm_rows_bf16(const float* x, const float* g, bf16_t* out, int M) {
    const int tix_ = tidx(); const int lane = tix_ & 63, gw = blockIdx.x * 8 + (tix_ >> 6), ngw = gridDim.x * 8;
    for (int m = gw; m < M; m += ngw) {
        const float4* xr = (const float4*)(x + (size_t)m * D);
        float4 v[4]; float s = 0.f;
#pragma unroll
        for (int j = 0; j < 4; ++j) { v[j] = xr[lane + 64 * j]; s += v[j].x * v[j].x + v[j].y * v[j].y + v[j].z * v[j].z + v[j].w * v[j].w; }
        const float r = rsqrtf(wave_sum(s) * (1.0f / D) + 1e-6f);
        v2u* o = (v2u*)(out + (size_t)m * D);
#pragma unroll
        for (int j = 0; j < 4; ++j) { const float4 gg = ((const float4*)g)[lane + 64 * j];
            v2u w; w.x = pk2(v[j].x * r * gg.x, v[j].y * r * gg.y); w.y = pk2(v[j].z * r * gg.z, v[j].w * r * gg.w); o[lane + 64 * j] = w; }
    }
}
__device__ __forceinline__ void rmsnorm_rows_f32(const float* x, const float* g, float* out, int M) {
    const int tix_ = tidx(); const int lane = tix_ & 63, gw = blockIdx.x * 8 + (tix_ >> 6), ngw = gridDim.x * 8;
    for (int m = gw; m < M; m += ngw) {
        const float4* xr = (const float4*)(x + (size_t)m * D);
        float4 v[4]; float s = 0.f;
#pragma unroll
        for (int j = 0; j < 4; ++j) { v[j] = xr[lane + 64 * j]; s += v[j].x * v[j].x + v[j].y * v[j].y + v[j].z * v[j].z + v[j].w * v[j].w; }
        const float r = rsqrtf(wave_sum(s) * (1.0f / D) + 1e-6f);
        float4* o = (float4*)(out + (size_t)m * D);
#pragma unroll
        for (int j = 0; j < 4; ++j) { const float4 gg = ((const float4*)g)[lane + 64 * j];
            o[lane + 64 * j] = make_float4(v[j].x * r * gg.x, v[j].y * r * gg.y, v[j].z * r * gg.z, v[j].w * r * gg.w); }
    }
}

__device__ __forceinline__ int block_exscan(int v, int* sh, int* tot) {
    const int tid = tidx(), lane = tid & 63, w = tid >> 6;
    int inc = v;
#pragma unroll
    for (int o = 1; o < 64; o <<= 1) { const int t = __shfl_up(inc, o); if (lane >= o) inc += t; }
    __syncthreads();
    if (lane == 63) sh[w] = inc;
    __syncthreads();
    int base = 0, total = 0;
#pragma unroll
    for (int i = 0; i < 8; ++i) { const int x = sh[i]; if (i < w) base += x; total += x; }
    *tot = total;
    return base + inc - v;
}


typedef short bf16x8 __attribute__((ext_vector_type(8)));
typedef float f32x16 __attribute__((ext_vector_type(16)));
constexpr int MROW = 144;
constexpr int MBUF = 64 * MROW;
__device__ __forceinline__ bf16x8 frag_rm(const LAS unsigned char* M, int row0, int k0, int fr, int fq) {
    return *(const LAS bf16x8*)(M + (row0 + fr) * MROW + (k0 + 8 * fq) * 2);
}
__device__ __forceinline__ bf16x8 frag_cm(const LAS unsigned char* M, int k0, int col0, int fr, int fq) {
    const LAS unsigned short* p = (const LAS unsigned short*)(M + (k0 + 8 * fq) * MROW + (col0 + fr) * 2);
    bf16x8 v;
#pragma unroll
    for (int j = 0; j < 8; ++j) v[j] = (short)p[j * (MROW / 2)];
    return v;
}
__device__ __forceinline__ void tile_store_bf16(LAS unsigned char* M, int m0, int n0, int fr, int fq, const f32x4& c) {
    v2u w; w.x = pk2(c[0], c[1]); w.y = pk2(c[2], c[3]);
    *(LAS v2u*)(M + (m0 + fr) * MROW + (n0 + 4 * fq) * 2) = w;
}
#define MMA16(acc, lf, rf) acc = __builtin_amdgcn_mfma_f32_16x16x32_bf16(rf, lf, acc, 0, 0, 0)

__device__ __forceinline__ void tile_store_bf16_T(LAS unsigned char* M, int m0, int n0, int fr, int fq, const f32x4& c) {
    const unsigned w0 = pk2(c[0], c[1]), w1 = pk2(c[2], c[3]);
    LAS unsigned char* p = M + (n0 + 4 * fq) * MROW + (m0 + fr) * 2;
    *(LAS unsigned short*)(p) = (unsigned short)(w0 & 0xffffu); *(LAS unsigned short*)(p + MROW) = (unsigned short)(w0 >> 16);
    *(LAS unsigned short*)(p + 2 * MROW) = (unsigned short)(w1 & 0xffffu); *(LAS unsigned short*)(p + 3 * MROW) = (unsigned short)(w1 >> 16);
}
__device__ __forceinline__ void scan_r1(const bf16_t* LWg, const bf16_t* RVg, const bf16_t* ALRg, const bf16_t* KKg, const bf16_t* KBg, const float* k_a,
                                        bf16_t* PT, bf16_t* QT, bf16_t* RH, bf16_t* YL, unsigned char* lds_raw) {
    LAS unsigned char* L = (LAS unsigned char*)lds_raw;
#define SL(k) (L + (k) * MBUF)
    LAS float* LWs = (LAS float*)(L + 14 * MBUF);
    const int tid = tidx(), lane = tid & 63, wave = tid >> 6, fr = lane & 15, fq = lane >> 4;
    const int tm = wave >> 1, tn0 = (wave & 1) * 2;
    const int m0 = tm * 16;
    const int t = tid >> 3, i0 = (tid & 7) * 8;
    v4u lw4n, r4n, v4n, kd4n, kk4n, bb4n;
#define R1_LOAD(it_) do { const int c_ = (it_) & 127, h_ = ((it_) >> 7) & 7, n_ = (it_) >> 10, dir_ = n_ >> 1, b_ = n_ & 1; \
        const int pos_ = dir_ ? (S - 1 - (c_ * 64 + t)) : (c_ * 64 + t); const size_t tok_ = (size_t)b_ * S + pos_; const size_t ch_ = (size_t)h_ * 64 + i0; \
        lw4n = *(const v4u*)(LWg + ((size_t)dir_ * T + tok_) * 512 + ch_); r4n = *(const v4u*)(RVg + tok_ * D + ch_); v4n = *(const v4u*)(RVg + tok_ * D + 512 + ch_); \
        kd4n = *(const v4u*)(KBg + tok_ * 512 + ch_); kk4n = *(const v4u*)(KKg + tok_ * 512 + ch_); bb4n = *(const v4u*)(ALRg + ((size_t)dir_ * T + tok_) * 512 + ch_); } while (0)
    if ((int)blockIdx.x < 4096) R1_LOAD((int)blockIdx.x);
    for (int item = blockIdx.x; item < 4096; item += gridDim.x) {
        const v4u lw4 = lw4n, r4 = r4n, v4 = v4n, kd4 = kd4n, kk4 = kk4n, bb4 = bb4n;
        float lw[8], Lin[8], kac[8];
        { const int h_ = (item >> 7) & 7; const f32x4 k0_ = *(const f32x4*)(k_a + h_ * 64 + i0), k1_ = *(const f32x4*)(k_a + h_ * 64 + i0 + 4);
          kac[0] = k0_[0]; kac[1] = k0_[1]; kac[2] = k0_[2]; kac[3] = k0_[3]; kac[4] = k1_[0]; kac[5] = k1_[1]; kac[6] = k1_[2]; kac[7] = k1_[3]; }
#pragma unroll
        for (int q = 0; q < 4; ++q) { lw[2 * q] = bflo(lw4[q]); lw[2 * q + 1] = bfhi(lw4[q]); }
#pragma unroll
        for (int j = 0; j < 8; ++j) { float x = lw[j];
#pragma unroll
            for (int o = 8; o < 64; o <<= 1) { const float y = __shfl_up(x, o); if (lane >= o) x += y; }
            Lin[j] = x; }
        __syncthreads();
        if (lane >= 56) {
#pragma unroll
            for (int j = 0; j < 8; ++j) LWs[64 + wave * 64 + i0 + j] = Lin[j]; }
        __syncthreads();
        {
            float off[8];
#pragma unroll
            for (int j = 0; j < 8; ++j) off[j] = 0.f;
            for (int w = 0; w < 8; ++w) { if (w < wave) {
#pragma unroll
                for (int j = 0; j < 8; ++j) off[j] += LWs[64 + w * 64 + i0 + j]; } }
#pragma unroll
            for (int j = 0; j < 8; ++j) Lin[j] += off[j];
            if (t == 63) {
#pragma unroll
                for (int j = 0; j < 8; ++j) LWs[i0 + j] = Lin[j]; }
            float at_[8], rt_[8], bt_[8], kt_[8];
#pragma unroll
            for (int q = 0; q < 4; ++q) {
#pragma unroll
                for (int e = 0; e < 2; ++e) { const int j = 2 * q + e;
                    const float ein = __expf(Lin[j]), einv = __expf(-Lin[j]), eex = __expf(Lin[j] - lw[j]);
                    const float kkv = e ? bfhi(kk4[q]) : bflo(kk4[q]), rv_ = e ? bfhi(r4[q]) : bflo(r4[q]), alr_ = e ? bfhi(bb4[q]) : bflo(bb4[q]), kraw = e ? bfhi(kd4[q]) : bflo(kd4[q]);
                    const float bbv = kkv * alr_, kdv = kraw * (1.0f + (alr_ - 1.0f) * kac[j]);
                    at_[j] = -kkv * eex; rt_[j] = rv_ * ein; bt_[j] = bbv * einv; kt_[j] = kdv * einv; }
            }
            v4u wa, wb, wk, w;
            wa.x = pk2(at_[0], at_[1]); wa.y = pk2(at_[2], at_[3]); wa.z = pk2(at_[4], at_[5]); wa.w = pk2(at_[6], at_[7]); *(LAS v4u*)(SL(0) + t * MROW + i0 * 2) = wa;
            w.x = pk2(rt_[0], rt_[1]); w.y = pk2(rt_[2], rt_[3]); w.z = pk2(rt_[4], rt_[5]); w.w = pk2(rt_[6], rt_[7]); *(LAS v4u*)(SL(2) + t * MROW + i0 * 2) = w;
            wb.x = pk2(bt_[0], bt_[1]); wb.y = pk2(bt_[2], bt_[3]); wb.z = pk2(bt_[4], bt_[5]); wb.w = pk2(bt_[6], bt_[7]); *(LAS v4u*)(SL(3) + t * MROW + i0 * 2) = wb;
            wk.x = pk2(kt_[0], kt_[1]); wk.y = pk2(kt_[2], kt_[3]); wk.z = pk2(kt_[4], kt_[5]); wk.w = pk2(kt_[6], kt_[7]); *(LAS v4u*)(SL(5) + t * MROW + i0 * 2) = wk;
#pragma unroll
            for (int q = 0; q < 4; ++q) {
                LAS unsigned char* pT = (LAS unsigned char*)0 + (i0 + 2 * q) * MROW + t * 2;
                *(LAS unsigned short*)(SL(1) + (size_t)pT) = (unsigned short)(wa[q] & 0xffffu); *(LAS unsigned short*)(SL(1) + (size_t)pT + MROW) = (unsigned short)(wa[q] >> 16);
                *(LAS unsigned short*)(SL(4) + (size_t)pT) = (unsigned short)(wb[q] & 0xffffu); *(LAS unsigned short*)(SL(4) + (size_t)pT + MROW) = (unsigned short)(wb[q] >> 16);
                *(LAS unsigned short*)(SL(6) + (size_t)pT) = (unsigned short)(wk[q] & 0xffffu); *(LAS unsigned short*)(SL(6) + (size_t)pT + MROW) = (unsigned short)(wk[q] >> 16);
                *(LAS unsigned short*)(SL(7) + (size_t)pT) = (unsigned short)(v4[q] & 0xffffu); *(LAS unsigned short*)(SL(7) + (size_t)pT + MROW) = (unsigned short)(v4[q] >> 16);
            }
        }
        if (item + (int)gridDim.x < 4096) R1_LOAD(item + (int)gridDim.x);
        __syncthreads();
        f32x4 Tacc[2];
        {
            bf16x8 la[2], lr[2];
#pragma unroll
            for (int ks = 0; ks < 2; ++ks) { la[ks] = frag_rm(SL(0), m0, 32 * ks, fr, fq); lr[ks] = frag_rm(SL(2), m0, 32 * ks, fr, fq); }
#pragma unroll
            for (int q = 0; q < 2; ++q) {
                const int n0 = (tn0 + q) * 16;
                f32x4 cab = {0.f, 0.f, 0.f, 0.f}, cak = cab, crb = cab, crk = cab;
#pragma unroll
                for (int ks = 0; ks < 2; ++ks) {
                    const bf16x8 rb_ = frag_rm(SL(3), n0, 32 * ks, fr, fq), rk_ = frag_rm(SL(5), n0, 32 * ks, fr, fq);
                    MMA16(cab, la[ks], rb_); MMA16(cak, la[ks], rk_); MMA16(crb, lr[ks], rb_); MMA16(crk, lr[ks], rk_);
                }
                const int tt = m0 + fr;
#pragma unroll
                for (int j = 0; j < 4; ++j) { const int ss = n0 + 4 * fq + j;
                    if (!(ss < tt)) { cab[j] = 0.f; cak[j] = 0.f; }
                    if (!(ss <= tt)) { crb[j] = 0.f; crk[j] = 0.f; } }
                tile_store_bf16(SL(8), m0, n0, fr, fq, cab); tile_store_bf16_T(SL(9), m0, n0, fr, fq, cab);
                tile_store_bf16(SL(10), m0, n0, fr, fq, cak);
                tile_store_bf16(SL(11), m0, n0, fr, fq, crb); tile_store_bf16(SL(12), m0, n0, fr, fq, crk);
#pragma unroll
                for (int j = 0; j < 4; ++j) cab[j] += ((n0 + 4 * fq + j) == tt) ? 1.f : 0.f;
                Tacc[q] = cab;
                tile_store_bf16(SL(13), m0, n0, fr, fq, cab);
            }
        }
        __syncthreads();
        {
            bf16x8 lk[2], ln_[2];
#pragma unroll
            for (int ks = 0; ks < 2; ++ks) { lk[ks] = frag_rm(SL(10), m0, 32 * ks, fr, fq); ln_[ks] = frag_rm(SL(8), m0, 32 * ks, fr, fq); }
#pragma unroll
            for (int q = 0; q < 2; ++q) {
                const int n0 = (tn0 + q) * 16;
                f32x4 cw = {0.f, 0.f, 0.f, 0.f}, cn = cw;
#pragma unroll
                for (int ks = 0; ks < 2; ++ks) { MMA16(cw, lk[ks], frag_rm(SL(7), n0, 32 * ks, fr, fq)); MMA16(cn, ln_[ks], frag_rm(SL(9), n0, 32 * ks, fr, fq)); }
                tile_store_bf16_T(SL(0), m0, n0, fr, fq, cw);
                tile_store_bf16(SL(3), m0, n0, fr, fq, cn); tile_store_bf16_T(SL(5), m0, n0, fr, fq, cn);
            }
        }
        __syncthreads();
#pragma unroll
        for (int k = 1; k <= 5; ++k) {
            LAS unsigned char* Nk = (k & 1) ? SL(3) : SL(8); LAS unsigned char* NkT = (k & 1) ? SL(5) : SL(9);
            LAS unsigned char* Nn = (k & 1) ? SL(8) : SL(3); LAS unsigned char* NnT = (k & 1) ? SL(9) : SL(5);
            LAS unsigned char* Tk = (k & 1) ? SL(13) : SL(10); LAS unsigned char* Tn = (k & 1) ? SL(10) : SL(13);
            bf16x8 lt[2], ln_[2];
#pragma unroll
            for (int ks = 0; ks < 2; ++ks) { lt[ks] = frag_rm(Tk, m0, 32 * ks, fr, fq); ln_[ks] = frag_rm(Nk, m0, 32 * ks, fr, fq); }
#pragma unroll
            for (int q = 0; q < 2; ++q) {
                const int n0 = (tn0 + q) * 16;
                f32x4 cn = {0.f, 0.f, 0.f, 0.f};
#pragma unroll
                for (int ks = 0; ks < 2; ++ks) { const bf16x8 rn = frag_rm(NkT, n0, 32 * ks, fr, fq); MMA16(Tacc[q], lt[ks], rn); if (k < 5) MMA16(cn, ln_[ks], rn); }
                tile_store_bf16(Tn, m0, n0, fr, fq, Tacc[q]);
                if (k < 5) { tile_store_bf16(Nn, m0, n0, fr, fq, cn); tile_store_bf16_T(NnT, m0, n0, fr, fq, cn); }
            }
            __syncthreads();
        }
        {
            bf16x8 lt[2];
#pragma unroll
            for (int ks = 0; ks < 2; ++ks) lt[ks] = frag_rm(SL(10), m0, 32 * ks, fr, fq);
#pragma unroll
            for (int q = 0; q < 2; ++q) {
                const int n0 = (tn0 + q) * 16;
                f32x4 ca = {0.f, 0.f, 0.f, 0.f}, cu = ca;
#pragma unroll
                for (int ks = 0; ks < 2; ++ks) { MMA16(ca, lt[ks], frag_rm(SL(1), n0, 32 * ks, fr, fq)); MMA16(cu, lt[ks], frag_rm(SL(0), n0, 32 * ks, fr, fq)); }
                tile_store_bf16_T(SL(8), m0, n0, fr, fq, ca); tile_store_bf16_T(SL(9), m0, n0, fr, fq, cu);
            }
        }
        __syncthreads();
        {
            bf16x8 lrb[2], lrk[2], lb[2], lkt[2];
#pragma unroll
            for (int ks = 0; ks < 2; ++ks) { lrb[ks] = frag_rm(SL(11), m0, 32 * ks, fr, fq); lrk[ks] = frag_rm(SL(12), m0, 32 * ks, fr, fq);
                lb[ks] = frag_rm(SL(4), m0, 32 * ks, fr, fq); lkt[ks] = frag_rm(SL(6), m0, 32 * ks, fr, fq); }
            const float wc = __expf(LWs[m0 + fr]);
#pragma unroll
            for (int q = 0; q < 2; ++q) {
                const int n0 = (tn0 + q) * 16;
                f32x4 crh = {0.f, 0.f, 0.f, 0.f}, cyl = crh, cp = crh, cq = crh;
#pragma unroll
                for (int ks = 0; ks < 2; ++ks) {
                    const bf16x8 ra = frag_rm(SL(8), n0, 32 * ks, fr, fq), ru = frag_rm(SL(9), n0, 32 * ks, fr, fq), rv = frag_rm(SL(7), n0, 32 * ks, fr, fq);
                    MMA16(crh, lrb[ks], ra); MMA16(cyl, lrb[ks], ru); MMA16(cyl, lrk[ks], rv);
                    MMA16(cp, lb[ks], ra); MMA16(cq, lb[ks], ru); MMA16(cq, lkt[ks], rv);
                }
                const size_t o = (size_t)item * 4096 + (size_t)(m0 + fr) * 64 + n0 + 4 * fq;
                { const LAS unsigned short* rp = (const LAS unsigned short*)(SL(2) + (m0 + fr) * MROW + (n0 + 4 * fq) * 2);
#pragma unroll
                  for (int j = 0; j < 4; ++j) crh[j] += __uint_as_float(((unsigned)rp[j]) << 16); }
                { v2u w; w.x = pk2(crh[0], crh[1]); w.y = pk2(crh[2], crh[3]); *(v2u*)(RH + o) = w; }
                { v2u w; w.x = pk2(cyl[0], cyl[1]); w.y = pk2(cyl[2], cyl[3]); *(v2u*)(YL + o) = w; }
#pragma unroll
                for (int j = 0; j < 4; ++j) { cp[j] = wc * (cp[j] + (((n0 + 4 * fq + j) == (m0 + fr)) ? 1.f : 0.f)); cq[j] *= wc; }
                { v2u w; w.x = pk2(cp[0], cp[1]); w.y = pk2(cp[2], cp[3]); *(v2u*)(PT + o) = w; }
                { v2u w; w.x = pk2(cq[0], cq[1]); w.y = pk2(cq[2], cq[3]); *(v2u*)(QT + o) = w; }
            }
        }
    }
#undef SL
}
#undef R1_LOAD

__device__ __forceinline__ bf16x8 pack_acc8(const f32x16& x, int s) {
    v4u p; p.x = pk2(x[8 * s], x[8 * s + 1]); p.y = pk2(x[8 * s + 2], x[8 * s + 3]); p.z = pk2(x[8 * s + 4], x[8 * s + 5]); p.w = pk2(x[8 * s + 6], x[8 * s + 7]);
    return __builtin_bit_cast(bf16x8, p);
}
__device__ __forceinline__ void scan_r2(const bf16_t* PT, const bf16_t* QT, bf16_t* S0, unsigned char* lds_raw) {
    LAS unsigned char* L = (LAS unsigned char*)lds_raw;
    constexpr int SLOT_B = MBUF + 8192;
    const int tid = tidx(), lane = tid & 63, wave = tid >> 6;
    const int r = lane & 31, h2 = lane >> 5, jb = wave;
    f32x16 st[2];
#pragma unroll
    for (int ib = 0; ib < 2; ++ib)
#pragma unroll
        for (int g = 0; g < 16; ++g) st[ib][g] = 0.f;
    const size_t item0 = (size_t)blockIdx.x * 128;
    v4u stage[16];
#pragma unroll
    for (int q = 0; q < 16; ++q) { const int p = tid + 512 * q, cc = p >> 10, w = p & 1023, mat = w >> 9, idx = w & 511;
        stage[q] = *(const v4u*)((mat ? QT : PT) + (item0 + cc) * 4096 + idx * 8); }
    for (int grp = 0; grp < 16; ++grp) {
        __syncthreads();
#pragma unroll
        for (int q = 0; q < 16; ++q) { const int p = tid + 512 * q, cc = p >> 10, w = p & 1023, mat = w >> 9, idx = w & 511;
            *(LAS v4u*)(L + cc * SLOT_B + (mat ? (MBUF + idx * 16) : ((idx >> 3) * MROW + (idx & 7) * 16))) = stage[q]; }
        __syncthreads();
        if (grp < 15) {
#pragma unroll
            for (int q = 0; q < 16; ++q) { const int p = tid + 512 * q, cc = p >> 10, w = p & 1023, mat = w >> 9, idx = w & 511;
                stage[q] = *(const v4u*)((mat ? QT : PT) + (item0 + (grp + 1) * 8 + cc) * 4096 + idx * 8); }
        }
        if (wave < 2) {
#pragma unroll
            for (int cc = 0; cc < 8; ++cc) {
                const size_t item = item0 + grp * 8 + cc;
                const LAS unsigned char* Pm = L + cc * SLOT_B; const LAS unsigned char* Qm = Pm + MBUF;
                bf16_t* sp = S0 + item * 4096 + (size_t)(32 * jb + r) * 64;
#pragma unroll
                for (int ib = 0; ib < 2; ++ib)
#pragma unroll
                    for (int g = 0; g < 4; ++g) { v2u w; w.x = pk2(st[ib][4 * g], st[ib][4 * g + 1]); w.y = pk2(st[ib][4 * g + 2], st[ib][4 * g + 3]); *(v2u*)(sp + 32 * ib + 8 * g + 4 * h2) = w; }
                f32x16 nw[2];
#pragma unroll
                for (int ib = 0; ib < 2; ++ib)
#pragma unroll
                    for (int g = 0; g < 16; ++g) nw[ib][g] = __uint_as_float(((unsigned)*(const LAS unsigned short*)(Qm + (32 * ib + (g & 3) + 8 * (g >> 2) + 4 * h2) * 128 + (32 * jb + r) * 2)) << 16);
#pragma unroll
                for (int kb = 0; kb < 2; ++kb)
#pragma unroll
                    for (int s2 = 0; s2 < 2; ++s2) {
                        const bf16x8 bfr = pack_acc8(st[kb], s2);
#pragma unroll
                        for (int ib = 0; ib < 2; ++ib) {
                            const LAS unsigned char* ap = Pm + (32 * ib + r) * MROW + (32 * kb + 16 * s2 + 4 * h2) * 2;
                            const v2u lo = *(const LAS v2u*)ap, hi = *(const LAS v2u*)(ap + 16);
                            v4u av; av.x = lo.x; av.y = lo.y; av.z = hi.x; av.w = hi.y;
                            nw[ib] = __builtin_amdgcn_mfma_f32_32x32x16_bf16(__builtin_bit_cast(bf16x8, av), bfr, nw[ib], 0, 0, 0);
                        }
                    }
                st[0] = nw[0]; st[1] = nw[1];
            }
        }
    }
}
__device__ __forceinline__ void scan_r3(const bf16_t* RH, const bf16_t* YL, const bf16_t* S0, const bf16_t* RVg, const bf16_t* ALRg, const bf16_t* KBg, const float* k_a, const bf16_t* Gg,
                                        const float* r_k, const float* lng, const float* lnb, bf16_t* Y) {
    const int tid = tidx(), lane = tid & 63, wave = tid >> 6, fr = lane & 15, fq = lane >> 4;
    const int tmw = wave & 3;
    for (int it2 = blockIdx.x * 2 + (wave >> 2); it2 < 2048; it2 += gridDim.x * 2) {
        const int b = it2 >> 10, h = (it2 >> 7) & 7, pc = it2 & 127;
        f32x4 acc[4];
#pragma unroll
        for (int q = 0; q < 4; ++q) acc[q] = (f32x4){0.f, 0.f, 0.f, 0.f};
#pragma unroll 1
        for (int dirn = 0; dirn < 2; ++dirn) {
            const size_t item = (size_t)((dirn * 2 + b) * 8 + h) * 128 + (dirn ? 127 - pc : pc);
            const int row = dirn ? 63 - (16 * tmw + fr) : 16 * tmw + fr;
            const bf16_t* rp = RH + item * 4096 + (size_t)row * 64;
            bf16x8 lf[2];
#pragma unroll
            for (int ks = 0; ks < 2; ++ks) lf[ks] = *(const bf16x8*)(rp + 32 * ks + 8 * fq);
#pragma unroll
            for (int q = 0; q < 4; ++q) {
                const bf16_t* sp = S0 + item * 4096 + (size_t)(16 * q + fr) * 64;
#pragma unroll
                for (int ks = 0; ks < 2; ++ks) { const bf16x8 rf = *(const bf16x8*)(sp + 32 * ks + 8 * fq); MMA16(acc[q], lf[ks], rf); }
                { const v2u yw = *(const v2u*)(YL + item * 4096 + (size_t)row * 64 + 16 * q + 4 * fq); acc[q] += (f32x4){bflo(yw.x), bfhi(yw.x), bflo(yw.y), bfhi(yw.y)}; }
            }
        }
        float sm = 0.f;
#pragma unroll
        for (int q = 0; q < 4; ++q) sm += (acc[q][0] + acc[q][1]) + (acc[q][2] + acc[q][3]);
        sm += __shfl_xor(sm, 16); sm += __shfl_xor(sm, 32);
        const float mean = sm * (1.0f / 64.f);
        float sq = 0.f;
#pragma unroll
        for (int q = 0; q < 4; ++q)
#pragma unroll
            for (int j = 0; j < 4; ++j) { const float d = acc[q][j] - mean; sq += d * d; }
        sq += __shfl_xor(sq, 16); sq += __shfl_xor(sq, 32);
        const float rstd = rsqrtf(sq * (1.0f / 64.f) + 64e-5f);
        const size_t tok = (size_t)b * S + pc * 64 + 16 * tmw + fr;
        float bon = 0.f; f32x4 vv[4];
#pragma unroll
        for (int q = 0; q < 4; ++q) {
            const int c = h * 64 + 16 * q + 4 * fq;
            const v2u rw = *(const v2u*)(RVg + tok * D + c), a0w = *(const v2u*)(ALRg + tok * 512 + c), a1w = *(const v2u*)(ALRg + ((size_t)T + tok) * 512 + c), kw = *(const v2u*)(KBg + tok * 512 + c), vw = *(const v2u*)(RVg + tok * D + 512 + c);
            const f32x4 rk4 = *(const f32x4*)(r_k + c), ka4 = *(const f32x4*)(k_a + c);
            vv[q] = (f32x4){bflo(vw.x), bfhi(vw.x), bflo(vw.y), bfhi(vw.y)};
            const float rr[4] = {bflo(rw.x), bfhi(rw.x), bflo(rw.y), bfhi(rw.y)}, kk_[4] = {bflo(kw.x), bfhi(kw.x), bflo(kw.y), bfhi(kw.y)};
            const float s01[4] = {bflo(a0w.x) + bflo(a1w.x), bfhi(a0w.x) + bfhi(a1w.x), bflo(a0w.y) + bflo(a1w.y), bfhi(a0w.y) + bfhi(a1w.y)};
#pragma unroll
            for (int j = 0; j < 4; ++j) bon += rr[j] * kk_[j] * (2.0f + (s01[j] - 2.0f) * ka4[j]) * rk4[j];
        }
        bon += __shfl_xor(bon, 16); bon += __shfl_xor(bon, 32);
#pragma unroll
        for (int q = 0; q < 4; ++q) {
            const int c = h * 64 + 16 * q + 4 * fq;
            const v2u gw_ = *(const v2u*)(Gg + tok * 512 + c); const f32x4 g4 = {bflo(gw_.x), bfhi(gw_.x), bflo(gw_.y), bfhi(gw_.y)}, lg = *(const f32x4*)(lng + c), lb = *(const f32x4*)(lnb + c);
            float o[4];
#pragma unroll
            for (int j = 0; j < 4; ++j) o[j] = ((acc[q][j] - mean) * rstd * lg[j] + lb[j] + bon * vv[q][j]) * g4[j];
            v2u w; w.x = pk2(o[0], o[1]); w.y = pk2(o[2], o[3]);
            *(v2u*)(Y + tok * D + 512 + c) = w;
        }
    }
}


__device__ __forceinline__ bf16x8 pack8(float a0, float a1, float a2, float a3, float a4, float a5, float a6, float a7) {
    v4u p; p.x = pk2(a0, a1); p.y = pk2(a2, a3); p.z = pk2(a4, a5); p.w = pk2(a6, a7);
    return __builtin_bit_cast(bf16x8, p);
}
#define MMA32(acc, af, bf_) acc = __builtin_amdgcn_mfma_f32_32x32x16_bf16(af, bf_, acc, 0, 0, 0)
__device__ __forceinline__ void xattn_mfma(const bf16_t* Qb, const bf16_t* Kb, const bf16_t* Vt, bf16_t* Y, unsigned char* lds_raw) {
    LAS unsigned char* L = (LAS unsigned char*)lds_raw;
    constexpr int KRS = 528, VRS = 520;
    const int tid = tidx(), lane = tid & 63, wave = tid >> 6, r = lane & 31, h2 = lane >> 5;
    for (int it = blockIdx.x; it < 256; it += gridDim.x) {
        const int qblk = it & 31, h = (it >> 5) & 3, b = it >> 7;
        const size_t tok = (size_t)b * S + qblk * 256 + wave * 32 + r;
        bf16x8 qf[16];
#pragma unroll
        for (int ks = 0; ks < 16; ++ks) qf[ks] = *(const bf16x8*)(Qb + tok * D + h * 256 + 16 * ks + 8 * h2);
        __syncthreads();
#pragma unroll
        for (int hf = 0; hf < 2; ++hf) {
            v4u stg[8];
#pragma unroll
            for (int q = 0; q < 8; ++q) { const int p = tid + 512 * (8 * hf + q); stg[q] = *(const v4u*)(Kb + (size_t)(b * MEM + (p >> 5)) * 1024 + h * 256 + (p & 31) * 8); }
#pragma unroll
            for (int q = 0; q < 8; ++q) { const int p = tid + 512 * (8 * hf + q); *(LAS v4u*)(L + (p >> 5) * KRS + (p & 31) * 16) = stg[q]; }
        }
        __syncthreads();
        float mx = -3.0e38f;
#pragma unroll 1
        for (int kb = 0; kb < 8; ++kb) {
            f32x16 st;
#pragma unroll
            for (int g = 0; g < 16; ++g) st[g] = 0.f;
            const LAS unsigned char* kp = L + (32 * kb + r) * KRS + 16 * h2;
#pragma unroll
            for (int ks = 0; ks < 16; ++ks) { const bf16x8 kf = *(const LAS bf16x8*)(kp + 32 * ks); MMA32(st, kf, qf[ks]); }
#pragma unroll
            for (int g = 0; g < 16; ++g) mx = fmaxf(mx, st[g]);
        }
        mx = fmaxf(mx, __shfl_xor(mx, 32));
        const float cs = 0.0625f * 1.4426950408889634f;
        float l = 0.f;
        bf16x8 pf[8][2];
#pragma unroll
        for (int kb = 0; kb < 8; ++kb) {
            f32x16 st;
#pragma unroll
            for (int g = 0; g < 16; ++g) st[g] = 0.f;
            const LAS unsigned char* kp = L + (32 * kb + r) * KRS + 16 * h2;
#pragma unroll
            for (int ks = 0; ks < 16; ++ks) { const bf16x8 kf = *(const LAS bf16x8*)(kp + 32 * ks); MMA32(st, kf, qf[ks]); }
#pragma unroll
            for (int g = 0; g < 16; ++g) { st[g] = __builtin_amdgcn_exp2f((st[g] - mx) * cs); l += st[g]; }
#pragma unroll
            for (int s2 = 0; s2 < 2; ++s2) pf[kb][s2] = pack8(st[8 * s2], st[8 * s2 + 1], st[8 * s2 + 2], st[8 * s2 + 3], st[8 * s2 + 4], st[8 * s2 + 5], st[8 * s2 + 6], st[8 * s2 + 7]);
            __builtin_amdgcn_sched_barrier(0);
        }
        l += __shfl_xor(l, 32);
        const float inv = 1.0f / l;
        __syncthreads();
#pragma unroll
        for (int hf = 0; hf < 2; ++hf) {
            v4u stg[8];
#pragma unroll
            for (int q = 0; q < 8; ++q) { const int p = tid + 512 * (8 * hf + q); stg[q] = *(const v4u*)(Vt + ((size_t)(b * 1024 + h * 256 + (p >> 5))) * 256 + (p & 31) * 8); }
#pragma unroll
            for (int q = 0; q < 8; ++q) { const int p = tid + 512 * (8 * hf + q); LAS v2u* lp = (LAS v2u*)(L + (p >> 5) * VRS + (p & 31) * 16);
                v2u a_; a_.x = stg[q].x; a_.y = stg[q].y; lp[0] = a_; a_.x = stg[q].z; a_.y = stg[q].w; lp[1] = a_; }
        }
        __syncthreads();
#pragma unroll 1
        for (int db = 0; db < 8; ++db) {
            f32x16 acc;
#pragma unroll
            for (int g = 0; g < 16; ++g) acc[g] = 0.f;
            const LAS unsigned char* vp = L + (32 * db + r) * VRS + 8 * h2;
#pragma unroll
            for (int kb = 0; kb < 8; ++kb)
#pragma unroll
                for (int s2 = 0; s2 < 2; ++s2) {
                    const v2u lo = *(const LAS v2u*)(vp + (32 * kb + 16 * s2) * 2), hi = *(const LAS v2u*)(vp + (32 * kb + 16 * s2 + 8) * 2);
                    v4u av; av.x = lo.x; av.y = lo.y; av.z = hi.x; av.w = hi.y;
                    MMA32(acc, __builtin_bit_cast(bf16x8, av), pf[kb][s2]);
                }
            int tl_ = tid; asm volatile("" : "+v"(tl_));
            bf16_t* yp = Y + ((size_t)b * S + qblk * 256 + (tl_ >> 6) * 32 + (tl_ & 31)) * D + h * 256 + 32 * db + 4 * ((tl_ >> 5) & 1);
#pragma unroll
            for (int g = 0; g < 4; ++g) { v2u w; w.x = pk2(acc[4 * g] * inv, acc[4 * g + 1] * inv); w.y = pk2(acc[4 * g + 2] * inv, acc[4 * g + 3] * inv); *(v2u*)(yp + 8 * g) = w; }
        }
    }
}
template <bool F32OUT>
__device__ __forceinline__ void combine_norm(float* X, const bf16_t* YE, const int* SLOT, const float* g, bf16_t* Hout, float* Fout) {
    const int tix_ = tidx(); const int lane = tix_ & 63, gw = blockIdx.x * 8 + (tix_ >> 6), ngw = gridDim.x * 8;
    float4 gc[4];
#pragma unroll
    for (int j = 0; j < 4; ++j) gc[j] = ((const float4*)g)[lane + 64 * j];
    for (int m = gw; m < T; m += ngw) {
        float4* xr = (float4*)(X + (size_t)m * D);
        float4 v[4];
#pragma unroll
        for (int j = 0; j < 4; ++j) v[j] = xr[lane + 64 * j];
        const int myslot = SLOT[(size_t)m * NE + (lane & 15)];
#pragma unroll
        for (int e = 0; e < 16; ++e) {
            const int row = __builtin_amdgcn_readlane(myslot, e);
            if (row >= 0) {
                const v2u* yp = (const v2u*)(YE + (size_t)row * D);
#pragma unroll
                for (int j = 0; j < 4; ++j) { const v2u w = yp[lane + 64 * j];
                    v[j].x += __uint_as_float(w.x << 16); v[j].y += __uint_as_float(w.x & 0xffff0000u); v[j].z += __uint_as_float(w.y << 16); v[j].w += __uint_as_float(w.y & 0xffff0000u); }
            }
        }
        float s = 0.f;
#pragma unroll
        for (int j = 0; j < 4; ++j) { if (!F32OUT) xr[lane + 64 * j] = v[j]; s += v[j].x * v[j].x + v[j].y * v[j].y + v[j].z * v[j].z + v[j].w * v[j].w; }
        const float r = rsqrtf(wave_sum(s) * (1.0f / D) + 1e-6f);
#pragma unroll
        for (int j = 0; j < 4; ++j) { const float4 gg = gc[j];
            if (F32OUT) ((float4*)(Fout + (size_t)m * D))[lane + 64 * j] = make_float4(v[j].x * r * gg.x, v[j].y * r * gg.y, v[j].z * r * gg.z, v[j].w * r * gg.w);
            else { v2u w; w.x = pk2(v[j].x * r * gg.x, v[j].y * r * gg.y); w.y = pk2(v[j].z * r * gg.z, v[j].w * r * gg.w); ((v2u*)(Hout + (size_t)m * D))[lane + 64 * j] = w; } }
    }
}


template <int NK, bool SINK>
__device__ __forceinline__ void attn_block(const bf16_t* Qh, const bf16_t* Kh, const bf16_t* Vh, int dd, int Lr, int b, int rho, int q0b, float sink2,
                                           bf16_t* Odst, int ostride, float* lsedst, unsigned char* lds_raw) {
    constexpr int NKEY = 256 + 64 * NK, KRS = 144, VRS = NKEY * 2 + 8;
    LAS unsigned char* Ks = (LAS unsigned char*)lds_raw; LAS unsigned char* Vs = Ks + NKEY * KRS;
    const int tid = tidx(), lane = tid & 63, wave = tid >> 6, r = lane & 31, h2 = lane >> 5;
    const int kq_base = q0b - 32 * NK;
    __syncthreads();
#pragma unroll
    for (int i = 0; i < NKEY * 8 / 512; ++i) {
        const int p = tid + 512 * i, row = p >> 3, piece = p & 7, kq = kq_base + row;
        if (kq >= 0 && kq < Lr) {
            const size_t tokk = (size_t)b * S + (size_t)kq * dd + rho;
            const v4u kx = *(const v4u*)(Kh + tokk * 64 + piece * 8), vx = *(const v4u*)(Vh + tokk * 64 + piece * 8);
            *(LAS v4u*)(Ks + row * KRS + piece * 16) = kx;
            LAS unsigned char* vp = Vs + (piece * 8) * VRS + row * 2;
#pragma unroll
            for (int e = 0; e < 4; ++e) { *(LAS unsigned short*)(vp + (2 * e) * VRS) = (unsigned short)(vx[e] & 0xffffu); *(LAS unsigned short*)(vp + (2 * e + 1) * VRS) = (unsigned short)(vx[e] >> 16); }
        }
    }
    const int q0 = q0b + 32 * wave;
    const size_t qtok = (size_t)b * S + (size_t)(q0 + r) * dd + rho;
    bf16x8 qf[4];
#pragma unroll
    for (int ks = 0; ks < 4; ++ks) qf[ks] = *(const bf16x8*)(Qh + qtok * 64 + 16 * ks + 8 * h2);
    __syncthreads();
    f32x16 o[2];
#pragma unroll
    for (int db = 0; db < 2; ++db)
#pragma unroll
        for (int g = 0; g < 16; ++g) o[db][g] = 0.f;
    float m = SINK ? sink2 : -1.0e30f, l = SINK ? 1.f : 0.f;
    const int kb_lo = max(-NK, -(q0 >> 5)), kb_hi = min(NK, (Lr - 32 - q0) >> 5);
#pragma unroll 1
    for (int kb = kb_lo; kb <= kb_hi; ++kb) {
        const int kw0 = 32 * (wave + kb + NK);
        f32x16 st;
#pragma unroll
        for (int g = 0; g < 16; ++g) st[g] = 0.f;
        const LAS unsigned char* kp = Ks + (kw0 + r) * KRS + 16 * h2;
#pragma unroll
        for (int ks = 0; ks < 4; ++ks) { const bf16x8 kf = *(const LAS bf16x8*)(kp + 32 * ks); MMA32(st, kf, qf[ks]); }
        if (kb == -NK || kb == NK) {
#pragma unroll
            for (int g = 0; g < 16; ++g) { const int cr = (g & 3) + 8 * (g >> 2) + 4 * h2; const bool ok = (kb < 0) ? (cr >= r) : (cr <= r); st[g] = ok ? st[g] : -1.0e30f; }
        }
        float bm = st[0];
#pragma unroll
        for (int g = 1; g < 16; ++g) bm = fmaxf(bm, st[g]);
        bm = fmaxf(bm, __shfl_xor(bm, 32));
        const float mn = fmaxf(m, bm), al = __builtin_amdgcn_exp2f(m - mn);
        float ls = 0.f;
#pragma unroll
        for (int g = 0; g < 16; ++g) { st[g] = __builtin_amdgcn_exp2f(st[g] - mn); ls += st[g]; }
        ls += __shfl_xor(ls, 32);
        l = l * al + ls; m = mn;
#pragma unroll
        for (int db = 0; db < 2; ++db)
#pragma unroll
            for (int g = 0; g < 16; ++g) o[db][g] *= al;
        bf16x8 pf[2];
#pragma unroll
        for (int s2 = 0; s2 < 2; ++s2) pf[s2] = pack8(st[8 * s2], st[8 * s2 + 1], st[8 * s2 + 2], st[8 * s2 + 3], st[8 * s2 + 4], st[8 * s2 + 5], st[8 * s2 + 6], st[8 * s2 + 7]);
#pragma unroll
        for (int db = 0; db < 2; ++db) {
            const LAS unsigned char* vp = Vs + (32 * db + r) * VRS + (kw0 + 4 * h2) * 2;
#pragma unroll
            for (int s2 = 0; s2 < 2; ++s2) {
                const v2u lo = *(const LAS v2u*)(vp + 32 * s2), hi = *(const LAS v2u*)(vp + 32 * s2 + 16);
                v4u av; av.x = lo.x; av.y = lo.y; av.z = hi.x; av.w = hi.y;
                MMA32(o[db], __builtin_bit_cast(bf16x8, av), pf[s2]);
            }
        }
    }
    const float inv = 1.0f / l;
#pragma unroll
    for (int db = 0; db < 2; ++db) {
        bf16_t* op = Odst + qtok * ostride + 32 * db + 4 * h2;
#pragma unroll
        for (int g = 0; g < 4; ++g) { v2u w; w.x = pk2(o[db][4 * g] * inv, o[db][4 * g + 1] * inv); w.y = pk2(o[db][4 * g + 2] * inv, o[db][4 * g + 3] * inv); *(v2u*)(op + 8 * g) = w; }
    }
    if (lsedst != nullptr && h2 == 0) lsedst[qtok * 8] = (m + __builtin_amdgcn_logf(l)) * 0.6931471805599453f;
}

__device__ __forceinline__ void attn_phase_even(const bf16_t* QhA, const bf16_t* KhA, const bf16_t* VhA, const bf16_t* QhB, const bf16_t* KhB, const bf16_t* VhB,
                                                const float* sink, bf16_t* OA, float* LSE, bf16_t* Y, unsigned char* lds_raw) {
    for (int it = blockIdx.x; it < 2048; it += gridDim.x) {
        if (it < 512) {
            const int hq = it >> 6, rem2 = it & 63, b = rem2 >> 5, q0b = (rem2 & 31) * 256, kvh = hq >> 2;
            attn_block<4, true>(QhB + (size_t)hq * T * 64, KhB + (size_t)kvh * T * 64, VhB + (size_t)kvh * T * 64, 1, S, b, 0, q0b, sink[hq] * 1.4426950408889634f,
                                Y + 512 + hq * 64, D, nullptr, lds_raw);
        } else {
            const int ita = it - 512, p = ita >> 9, rem = ita & 511, head = rem >> 6, rem2 = rem & 63, b = rem2 >> 5, rem3 = rem2 & 31;
            const int dd = p == 0 ? 1 : (p == 1 ? 4 : 16), bpr = 32 / dd, rho = rem3 / bpr, q0b = (rem3 % bpr) * 256;
            attn_block<2, false>(QhA + (size_t)head * T * 64, KhA + (size_t)head * T * 64, VhA + (size_t)head * T * 64, dd, S / dd, b, rho, q0b, 0.f,
                                 OA + (size_t)p * T * 512 + head * 64, 512, LSE + (size_t)p * T * 8 + head, lds_raw);
        }
    }
}
__device__ __forceinline__ void attn_combine(const bf16_t* OA, const float* LSE, bf16_t* Y) {
    const int gt = blockIdx.x * NTH + tidx(), ngt = gridDim.x * NTH;
    for (int i = gt; i < T * 64; i += ngt) {
        const int tok = i >> 6, head = (i >> 3) & 7, c8 = i & 7;
        const float l0 = LSE[(size_t)tok * 8 + head], l1 = LSE[((size_t)T + tok) * 8 + head], l2 = LSE[((size_t)2 * T + tok) * 8 + head];
        const float mx = fmaxf(l0, fmaxf(l1, l2));
        float w0 = __expf(l0 - mx), w1 = __expf(l1 - mx), w2 = __expf(l2 - mx);
        const float inv = 1.0f / (w0 + w1 + w2); w0 *= inv; w1 *= inv; w2 *= inv;
        const size_t off = (size_t)tok * 512 + head * 64 + c8 * 8;
        const v4u x0 = *(const v4u*)(OA + off), x1 = *(const v4u*)(OA + (size_t)T * 512 + off), x2 = *(const v4u*)(OA + (size_t)2 * T * 512 + off);
        v4u w;
#pragma unroll
        for (int q = 0; q < 4; ++q) {
            const float lo = w0 * __uint_as_float(x0[q] << 16) + w1 * __uint_as_float(x1[q] << 16) + w2 * __uint_as_float(x2[q] << 16);
            const float hi = w0 * __uint_as_float(x0[q] & 0xffff0000u) + w1 * __uint_as_float(x1[q] & 0xffff0000u) + w2 * __uint_as_float(x2[q] & 0xffff0000u);
            w[q] = pk2(lo, hi);
        }
        *(v4u*)(Y + (size_t)tok * D + head * 64 + c8 * 8) = w;
    }
}


__device__ __forceinline__ void odd_token_pass(const bf16_t* P, const float* mu, const float* k_k, const float* clg, const float* clb,
                                               bf16_t* VN, bf16_t* RV, bf16_t* KBf, bf16_t* KK, bf16_t* F5) {
    const int tix_ = tidx(); const int lane = tix_ & 63, gw = blockIdx.x * 8 + (tix_ >> 6), ngw = gridDim.x * 8;
    float2 m0c[15], m1c[15], kkc[4], lgc[4], lbc[4];
#pragma unroll
    for (int jj = 0; jj < 15; ++jj) { const int c = 2 * lane + 128 * jj; m0c[jj] = *(const float2*)(mu + c); m1c[jj] = *(const float2*)(mu + FD + c); }
#pragma unroll
    for (int jj = 0; jj < 4; ++jj) { const int c = 2 * lane + 128 * jj; kkc[jj] = *(const float2*)(k_k + c); lgc[jj] = *(const float2*)(clg + c); lbc[jj] = *(const float2*)(clb + c); }
    unsigned wcur[15], wnxt[15], wprv[15];
    for (int tok0 = gw * 8; tok0 < T; tok0 += ngw * 8)
    for (int ti = 0; ti < 8; ++ti) {
        const int tok = tok0 + ti;
        const int s = tok & (S - 1);
        const bf16_t* pr = P + (size_t)tok * ODD_PAD;
        if (ti == 0) {
#pragma unroll
            for (int jj = 0; jj < 15; ++jj) { const int c = 2 * lane + 128 * jj; wcur[jj] = *(const unsigned*)(pr + 1024 + c); wprv[jj] = s > 0 ? *(const unsigned*)(pr + 1024 + c - ODD_PAD) : 0u; }
        } else {
#pragma unroll
            for (int jj = 0; jj < 15; ++jj) { wprv[jj] = s > 0 ? wcur[jj] : 0u; wcur[jj] = wnxt[jj]; }
        }
#pragma unroll
        for (int jj = 0; jj < 15; ++jj) { const int c = 2 * lane + 128 * jj; wnxt[jj] = *(const unsigned*)(pr + 1024 + c + (tok + 1 < T ? ODD_PAD : 0)); }
        {
            float ge[8]; float sm = 0.f;
#pragma unroll
            for (int jj = 0; jj < 4; ++jj) { const unsigned w = *(const unsigned*)(pr + 512 + 2 * lane + 128 * jj);
                ge[2 * jj] = gelu_tanh(__uint_as_float(w << 16)); ge[2 * jj + 1] = gelu_tanh(__uint_as_float(w & 0xffff0000u)); sm += ge[2 * jj] + ge[2 * jj + 1]; }
            const float mean = wave_sum(sm) * (1.0f / 512.f); float sq = 0.f;
#pragma unroll
            for (int j = 0; j < 8; ++j) { const float d = ge[j] - mean; sq += d * d; }
            const float rstd = rsqrtf(wave_sum(sq) * (1.0f / 512.f) + 1e-5f);
#pragma unroll
            for (int jj = 0; jj < 4; ++jj) { const int c = 2 * lane + 128 * jj;
                *(unsigned*)(VN + (size_t)tok * 512 + c) = pk2((ge[2 * jj] - mean) * rstd * lgc[jj].x + lbc[jj].x, (ge[2 * jj + 1] - mean) * rstd * lgc[jj].y + lbc[jj].y); }
        }
#pragma unroll
        for (int jj = 0; jj < 15; ++jj) {
            const int c = 2 * lane + 128 * jj;
            const unsigned wf = wcur[jj];
            const unsigned wp = wprv[jj];
            const unsigned wn = s < S - 1 ? wnxt[jj] : 0u;
            const float2 m0 = m0c[jj], m1 = m1c[jj];
            const float f0 = __uint_as_float(wf << 16), f1 = __uint_as_float(wf & 0xffff0000u);
            const float x0 = f0 + m0.x * (__uint_as_float(wp << 16) - f0) + m1.x * (__uint_as_float(wn << 16) - f0);
            const float x1 = f1 + m0.y * (__uint_as_float(wp & 0xffff0000u) - f1) + m1.y * (__uint_as_float(wn & 0xffff0000u) - f1);
            if (jj < 4) *(unsigned*)(RV + (size_t)tok * D + c) = pk2(x0, x1);
            else if (jj < 8) {
                const int ck = c - 512;
                *(unsigned*)(KBf + (size_t)tok * 512 + ck) = pk2(x0, x1);
                const float2 kk_ = kkc[jj - 4];
                const float a0_ = x0 * kk_.x, a1_ = x1 * kk_.y;
                float ss = a0_ * a0_ + a1_ * a1_;
#pragma unroll
                for (int o = 16; o >= 1; o >>= 1) ss += __shfl_xor(ss, o);
                const float inv = 1.0f / fmaxf(sqrtf(ss), 1e-12f);
                *(unsigned*)(KK + (size_t)tok * 512 + ck) = pk2(a0_ * inv, a1_ * inv);
            }
            else if (jj < 12) *(unsigned*)(RV + (size_t)tok * D + 512 + (c - 1024)) = pk2(x0, x1);
            else if (jj == 12) *(unsigned*)(F5 + (size_t)tok * 384 + (c - 1536)) = pk2(tanhf_(x0), tanhf_(x1));
            else if (jj == 13) *(unsigned*)(F5 + (size_t)tok * 384 + 128 + (c - 1664)) = pk2(x0, x1);
            else *(unsigned*)(F5 + (size_t)tok * 384 + 256 + (c - 1792)) = pk2(sigmoidf_(x0), sigmoidf_(x1));
        }
    }
}
__device__ __forceinline__ void gating_pass(const bf16_t* VN, const bf16_t* Wsb, const float* bsp, const bf16_t* P, bf16_t* Y, unsigned char* lds_raw) {
    LAS unsigned char* L = (LAS unsigned char*)lds_raw;
    constexpr int RS = 272;
    const int tid = tidx(), lane = tid & 63, wave = tid >> 6, fr = lane & 15, fq = lane >> 4;
    for (int it = blockIdx.x; it < 512; it += gridDim.x) {
        const int g = it & 3, chunk = it >> 2;
        __syncthreads();
        { const int j = tid >> 2, q4 = tid & 3;
          const v4u* gp = (const v4u*)(VN + (size_t)(chunk * 128 + j) * 512 + g * 128 + 32 * q4);
#pragma unroll
          for (int q = 0; q < 4; ++q) { const v4u x = gp[q];
#pragma unroll
              for (int e = 0; e < 4; ++e) { const int c = 32 * q4 + 8 * q + 2 * e;
                  *(LAS unsigned short*)(L + c * RS + 2 * j) = (unsigned short)(x[e] & 0xffffu); *(LAS unsigned short*)(L + (c + 1) * RS + 2 * j) = (unsigned short)(x[e] >> 16); } } }
        __syncthreads();
        bf16x8 lf[4];
#pragma unroll
        for (int ks = 0; ks < 4; ++ks) lf[ks] = *(const bf16x8*)(Wsb + (size_t)(g * 128 + 16 * wave + fr) * 128 + 32 * ks + 8 * fq);
        const int i = 16 * wave + fr; const size_t tok = (size_t)chunk * 128 + i;
        const float bias = bsp[g * 128 + i];
#pragma unroll
        for (int tn = 0; tn < 8; ++tn) {
            f32x4 acc = {0.f, 0.f, 0.f, 0.f};
#pragma unroll
            for (int ks = 0; ks < 4; ++ks) { const bf16x8 rf = *(const LAS bf16x8*)(L + (16 * tn + fr) * RS + (32 * ks + 8 * fq) * 2); MMA16(acc, lf[ks], rf); }
            const int c = g * 128 + 16 * tn + 4 * fq;
            const v2u uw = *(const v2u*)(P + tok * ODD_PAD + c);
            const float u0 = gelu_tanh(__uint_as_float(uw.x << 16)), u1 = gelu_tanh(__uint_as_float(uw.x & 0xffff0000u)), u2 = gelu_tanh(__uint_as_float(uw.y << 16)), u3 = gelu_tanh(__uint_as_float(uw.y & 0xffff0000u));
            v2u w; w.x = pk2(u0 * (acc[0] + bias), u1 * (acc[1] + bias)); w.y = pk2(u2 * (acc[2] + bias), u3 * (acc[3] + bias));
            *(v2u*)(Y + tok * D + c) = w;
        }
    }
}


__device__ __forceinline__ void router_pass(const float* X, const float* g, const float* WRT  , float* AFF, int* SLOT, bf16_t* H, unsigned char* lds_raw) {
    const int tix_ = tidx(); const int lane = tix_ & 63, wave = tix_ >> 6, fr = lane & 15, fq = lane >> 4;
    const int pair = wave >> 1, half = wave & 1;
    f32x4 gcr[4];
#pragma unroll
    for (int j = 0; j < 4; ++j) gcr[j] = ((const f32x4*)g)[lane + 64 * j];
    LAS float* xch = (LAS float*)lds_raw + pair * 512;
    for (int tile0 = blockIdx.x * 4; tile0 < T / 16; tile0 += gridDim.x * 4) {
        const int tile = tile0 + pair;
        const float* xr = X + (size_t)(tile * 16 + fr) * D + 4 * fq + 512 * half;
        const float* wr = WRT + (size_t)fr * D + 4 * fq + 512 * half;
        f32x4 acc = {0.f, 0.f, 0.f, 0.f}; float ss = 0.f;
#pragma unroll 8
        for (int s = 0; s < 32; ++s) {
            const f32x4 xa = *(const f32x4*)(xr + 16 * s), wb = *(const f32x4*)(wr + 16 * s);
            ss += (xa[0] * xa[0] + xa[1] * xa[1]) + (xa[2] * xa[2] + xa[3] * xa[3]);
#pragma unroll
            for (int c = 0; c < 4; ++c) acc = __builtin_amdgcn_mfma_f32_16x16x4f32(xa[c], wb[c], acc, 0, 0, 0);
        }
        ss += __shfl_xor(ss, 16); ss += __shfl_xor(ss, 32);
        __syncthreads();
        { LAS float* p = xch + half * 256 + lane * 4; p[0] = acc[0]; p[1] = acc[1]; p[2] = acc[2]; p[3] = acc[3]; }
        if (fq == 0) ((LAS float*)lds_raw + 2048 + pair * 32 + half * 16)[fr] = ss;
        __syncthreads();
        { const LAS float* p = xch + (half ^ 1) * 256 + lane * 4; acc[0] += p[0]; acc[1] += p[1]; acc[2] += p[2]; acc[3] += p[3]; }
        ss += ((const LAS float*)lds_raw + 2048 + pair * 32 + (half ^ 1) * 16)[fr];
        const float rstd = rsqrtf(ss * (1.0f / D) + 1e-6f);
        {
            float aff[4];
#pragma unroll
            for (int jj = 0; jj < 4; ++jj) {
                const float lg = acc[jj] * __shfl(rstd, 4 * fq + jj);
                float mx = lg;
#pragma unroll
                for (int o = 1; o < 16; o <<= 1) mx = fmaxf(mx, __shfl_xor(mx, o));
                const float e = expf(lg - mx); float den = e;
#pragma unroll
                for (int o = 1; o < 16; o <<= 1) den += __shfl_xor(den, o);
                aff[jj] = e / den;
            }
#pragma unroll
            for (int jj = 0; jj < 4; ++jj) { const size_t o = (size_t)(tile * 16 + 4 * fq + jj) * NE + fr; if ((fq >> 1) == half) { AFF[o] = aff[jj]; SLOT[o] = -1; } }
        }
#pragma unroll 4
        for (int tt = 0; tt < 8; ++tt) {
            const int t = 8 * half + tt;
            const float rs = __shfl(rstd, t);
            const f32x4* xp = (const f32x4*)(X + (size_t)(tile * 16 + t) * D); unsigned* hp = (unsigned*)((unsigned char*)H + (size_t)(tile * 16 + t) * D);
            const float rs8 = rs * ASC8;
#pragma unroll
            for (int j = 0; j < 4; ++j) { const f32x4 v = xp[lane + 64 * j], gg = gcr[j];
                hp[lane + 64 * j] = pk4_fp8(v[0] * rs8 * gg[0], v[1] * rs8 * gg[1], v[2] * rs8 * gg[2], v[3] * rs8 * gg[3]); }
        }
    }
}


__device__ __forceinline__ void lora_pass(const bf16_t* F5, const bf16_t* WC, const float* w0, const float* a0,
                                          bf16_t* LW, bf16_t* ALR, bf16_t* G, unsigned char* lds_raw) {
    LAS unsigned char* L = (LAS unsigned char*)lds_raw;
    constexpr int ARS = 784;
    const int tid = tidx(), lane = tid & 63, wave = tid >> 6, fr = lane & 15, fq = lane >> 4;
    for (int tile = blockIdx.x; tile < T / 64; tile += gridDim.x) {
        __syncthreads();
#pragma unroll
        for (int q = 0; q < 6; ++q) { const int p = tid + 512 * q, row = p / 48, piece = p % 48;
            *(LAS v4u*)(L + row * ARS + piece * 16) = *(const v4u*)(F5 + (size_t)(tile * 64 + row) * 384 + piece * 8); }
        __syncthreads();
#pragma unroll 1
        for (int sec = 0; sec < 5; ++sec) {
            const int K0 = sec * 64, nks = sec < 4 ? 2 : 4, wstride = sec < 4 ? 64 : 128;
            const bf16_t* Wp = WC + (size_t)sec * 512 * 64 + (size_t)(64 * wave) * wstride;
#pragma unroll 1
            for (int nh = 0; nh < 2; ++nh) {
            f32x4 acc[4][2];
#pragma unroll
            for (int tm = 0; tm < 4; ++tm)
#pragma unroll
                for (int tn = 0; tn < 2; ++tn) acc[tm][tn] = (f32x4){0.f, 0.f, 0.f, 0.f};
            for (int ks = 0; ks < nks; ++ks) {
                bf16x8 lf[4], rf[2];
#pragma unroll
                for (int tm = 0; tm < 4; ++tm) lf[tm] = *(const LAS bf16x8*)(L + (16 * tm + fr) * ARS + (K0 + 32 * ks + 8 * fq) * 2);
#pragma unroll
                for (int tn = 0; tn < 2; ++tn) rf[tn] = *(const bf16x8*)(Wp + (size_t)(16 * (2 * nh + tn) + fr) * wstride + 32 * ks + 8 * fq);
#pragma unroll
                for (int tm = 0; tm < 4; ++tm)
#pragma unroll
                    for (int tn = 0; tn < 2; ++tn) MMA16(acc[tm][tn], lf[tm], rf[tn]);
            }
            f32x4 cw[2];
#pragma unroll
            for (int tn = 0; tn < 2; ++tn) {
                const int cc = 64 * wave + 16 * (2 * nh + tn) + 4 * fq;
                cw[tn] = (sec < 2) ? *(const f32x4*)(w0 + sec * 512 + cc) : ((sec < 4) ? *(const f32x4*)(a0 + (sec - 2) * 512 + cc) : (f32x4){0.f, 0.f, 0.f, 0.f});
            }
#pragma unroll
            for (int tn = 0; tn < 2; ++tn) {
                const int cc = 64 * wave + 16 * (2 * nh + tn) + 4 * fq;
#pragma unroll
                for (int tm = 0; tm < 4; ++tm) {
                    const size_t tok = (size_t)tile * 64 + 16 * tm + fr; const f32x4 v = acc[tm][tn];
                    float o[4];
                    if (sec < 2) {
#pragma unroll
                        for (int j = 0; j < 4; ++j) o[j] = -0.6065306597126334f * frcp(1.0f + __expf(-(cw[tn][j] + v[j])));
                    } else if (sec < 4) {
#pragma unroll
                        for (int j = 0; j < 4; ++j) o[j] = frcp(1.0f + __expf(-(cw[tn][j] + v[j])));
                    } else {
#pragma unroll
                        for (int j = 0; j < 4; ++j) o[j] = v[j];
                    }
                    v2u ww; ww.x = pk2(o[0], o[1]); ww.y = pk2(o[2], o[3]);
                    bf16_t* dst = sec < 2 ? (LW + ((size_t)sec * T + tok) * 512 + cc) : (sec < 4 ? (ALR + ((size_t)(sec - 2) * T + tok) * 512 + cc) : (G + tok * 512 + cc));
                    *(v2u*)dst = ww;
                }
            }
            }
        }
    }
}

#define IN(k) (lo <= (k) && (k) < hi)
#define REP_LOOP for (int rep_ = 0, nrep_ = ((ph == PROBE_PHASE) ? PROBE_REP : 1); rep_ < nrep_; ++rep_)
#define SEAM(k) do { if (IN(k) && IN((k) + 1)) xcd_barrier(bar); } while (0)
#define PROLOG \
    const int tid = tidx(), lane = tid & 63, wave = tid >> 6; \
    const int bid = blockIdx.x, nb = gridDim.x; \
    const int gw = bid * 8 + wave, ngw = nb * 8; \
    const int gt = bid * NTH + tid, ngt = nb * NTH; \
    (void)gt; (void)ngt; (void)gw; (void)ngw; (void)lane; (void)wave; \
    unsigned char* ws = a.ws; \
    const int lo = a.lo, hi = a.hi; \
    float* ldsf = (float*)lds_raw; (void)ldsf; \
    PG8_LAS unsigned char* ldsp = (PG8_LAS unsigned char*)lds_raw; (void)ldsp; \
    const float* x_in = a.in[0]; const float* mem = a.in[1]; (void)x_in; (void)mem; \
    float* ropec = (float*)(ws + WS_ROPE); float* ropes = ropec + S * 32; (void)ropec; (void)ropes; \
    float* AFF = (float*)(ws + WS_AFF); int* TOK = (int*)(ws + WS_TOK); float* GATE = (float*)(ws + WS_GATE); \
    float* X = (float*)(ws + WS_X); bf16_t* H = (bf16_t*)(ws + WS_H); bf16_t* P = (bf16_t*)(ws + WS_P); \
    bf16_t* Y = (bf16_t*)(ws + WS_Y); bf16_t* Q = (bf16_t*)(ws + WS_Q); bf16_t* KV = (bf16_t*)(ws + WS_KV); bf16_t* MN = (bf16_t*)(ws + WS_MN); \
    bf16_t* DEC = (bf16_t*)(ws + WS_DEC); bf16_t* KD = (bf16_t*)(ws + WS_KD); bf16_t* BB = (bf16_t*)(ws + WS_BB); \
    bf16_t* KK = (bf16_t*)(ws + WS_KK); bf16_t* G = (bf16_t*)(ws + WS_G); float* YS = (float*)(ws + WS_YS); \
    bf16_t* RV = (bf16_t*)(ws + WS_RV); bf16_t* VN = (bf16_t*)(ws + WS_VN); \
    bf16_t* XE = (bf16_t*)(ws + WS_XE); bf16_t* HID = (bf16_t*)(ws + WS_HID); int* SLOT = (int*)(ws + WS_SLOT); bf16_t* YE = (bf16_t*)(ws + WS_YE); (void)SLOT; (void)YE; \
    (void)AFF; (void)TOK; (void)GATE; (void)X; (void)H; (void)P; (void)Y; (void)Q; (void)KV; (void)MN; (void)DEC; (void)KD; (void)BB; (void)KK; (void)G; (void)YS; (void)RV; (void)VN; (void)XE; (void)HID;

template <class Epi>
__device__ __forceinline__ void dense_gemm(PG8_LAS unsigned char* ldsp, const bf16_t* A, const bf16_t* Bt, int M, int N, int K, const Epi& E, int cshift = 0) {
    asm volatile("" : "+s"(K));
    pg8::Gemm g{A, Bt, M, N, K}; pg8::StaticOrder So; So.init(M, N, (int)gridDim.x, (int)((blockIdx.x + cshift) % gridDim.x));
    pg8::gemm_phase<Epi, pg8::StaticOrder, false>(ldsp, g, So, E, nullptr);
}

__device__ __forceinline__ int odd_phases(const Args& a, const XcdBarrier& bar, unsigned char* lds_raw, int ph) {
    PROLOG
    if (IN(ph)) combine_norm<false>(X, YE, SLOT, a.in[6], H, nullptr);
    SEAM(ph); ++ph;
    if (IN(ph)) dense_gemm(ldsp, H, (const bf16_t*)(ws + WS_WOIN), T, ODD_PAD, D, EpiBf16Store{P, ODD_PAD, 1.0f});
    SEAM(ph); ++ph;
    if (IN(ph)) REP_LOOP {
        odd_token_pass(P, a.in[12], a.in[18], a.in[8], a.in[9], VN, RV, (bf16_t*)(ws + WS_KB), KK, (bf16_t*)(ws + WS_F5));
        asm volatile("s_waitcnt vmcnt(0)" ::: "memory");
        __syncthreads();
        lora_pass((const bf16_t*)(ws + WS_F5), (const bf16_t*)(ws + WS_WL), a.in[13], a.in[15], DEC, KD  , G, lds_raw);
    }
    SEAM(ph); ++ph;
    if (IN(ph)) REP_LOOP {
        gating_pass(VN, (const bf16_t*)(ws + WS_WSB), a.in[11], P, Y, lds_raw);
        __syncthreads();
        scan_r1(DEC, RV, KD, KK, (const bf16_t*)(ws + WS_KB), a.in[19], (bf16_t*)(ws + WS_PT), (bf16_t*)(ws + WS_QT), (bf16_t*)(ws + WS_RH), (bf16_t*)(ws + WS_YL), lds_raw);
    }
    SEAM(ph); ++ph;
    if (IN(ph)) REP_LOOP {
        if (bid < 32) scan_r2((const bf16_t*)(ws + WS_PT), (const bf16_t*)(ws + WS_QT), (bf16_t*)(ws + WS_S0), lds_raw);
        else {
            LAS float* scr = (LAS float*)((LAS unsigned char*)lds_raw + wave * 16896);
            const int gw2 = (bid - 32) * 8 + wave, ngw2 = (nb - 32) * 8;
            auto gmap = [](int n) { return (n >> 7) * 256 + (n & 127); };
            auto umap = [](int n) { return (n >> 7) * 256 + 128 + (n & 127); };
            for (int it = gw2; it < 16 * 704; it += ngw2) { const int e = it / 704, r = it % 704;
                transpose_item_fp8(a.in[31] + (size_t)(16 + e) * D * DE, D, DE, ws + WS_WGU8 + 176 * MiB + (size_t)e * 5632 * D, gmap, GUSC8, scr, r, lane); }
            for (int it = gw2; it < 16 * 704; it += ngw2) { const int e = it / 704, r = it % 704;
                transpose_item_fp8(a.in[32] + (size_t)(16 + e) * D * DE, D, DE, ws + WS_WGU8 + 176 * MiB + (size_t)e * 5632 * D, umap, GUSC8, scr, r, lane); }
        }
    }
    SEAM(ph); ++ph;
    if (IN(ph)) REP_LOOP scan_r3((const bf16_t*)(ws + WS_RH), (const bf16_t*)(ws + WS_YL), (const bf16_t*)(ws + WS_S0), RV, KD, (const bf16_t*)(ws + WS_KB), a.in[19], G, a.in[20], a.in[21], a.in[22], Y);
    SEAM(ph); ++ph;
    if (IN(ph)) dense_gemm(ldsp, Y, (const bf16_t*)(ws + WS_WOOUT), T, D, D, EpiResidN{X, X, H, (float*)(ws + WS_SSP)});
    SEAM(ph); ++ph;
    return ph;
}

template <int layer>
__device__ __forceinline__ int tail_phases(const Args& a, const XcdBarrier& bar, unsigned char* lds_raw, int ph) {
    PROLOG
    if (IN(ph)) REP_LOOP {
        int Kq = D; asm volatile("" : "+s"(Kq));
        pg8::Gemm g{H, (const bf16_t*)(ws + WS_WQ) + (size_t)layer * D * D, T, D, Kq}; XattnOrder So{(int)blockIdx.x};
        pg8::gemm_phase<EpiBf16StoreRS, XattnOrder, false>(ldsp, g, So, EpiBf16StoreRS{Q, D, (const float*)(ws + WS_SSP)}, nullptr);
        asm volatile("s_waitcnt vmcnt(0)" ::: "memory");
        __syncthreads();
        xattn_mfma(Q, KV + (size_t)layer * 1024 * 1024, KV + (size_t)layer * 1024 * 1024 + 512 * 1024, Y, lds_raw);
    }
    SEAM(ph); ++ph;
    if (IN(ph)) dense_gemm(ldsp, Y, (const bf16_t*)(ws + WS_WO) + (size_t)layer * D * D, T, D, D, EpiResid{X, X});
    SEAM(ph); ++ph;
    if (IN(ph)) REP_LOOP router_pass(X, a.in[29] + layer * D, (const float*)(ws + WS_WRT) + (size_t)layer * NE * D, AFF, SLOT, H, lds_raw);
    SEAM(ph); ++ph;
    if (IN(ph)) REP_LOOP {
        unsigned* keys = (unsigned*)ldsf;
        int* hist = (int*)(ldsf + 8192);
        int* sh = hist + 8 * 256;
        auto conv_items = [&](int first, int last, int w0, int nw) {
            LAS float* scr = (LAS float*)((LAS unsigned char*)lds_raw + wave * 16896);
            auto ident = [](int n) { return n; };
            auto gmap = [](int n) { return (n >> 7) * 256 + (n & 127); };
            auto umap = [](int n) { return (n >> 7) * 256 + 128 + (n & 127); };
            for (int ix = first + w0; ix < last; ix += nw) {
                if (layer == 0 && ix < 7168) { const int it = 4096 + ix, mt = it / 704, r = it % 704;
                    transpose_item_fp8(a.in[31] + (size_t)mt * D * DE, D, DE, ws + WS_WGU8 + (size_t)mt * 5632 * D, gmap, GUSC8, scr, r, lane);
                } else if (layer == 0 && ix < 18432) { const int it = ix - 7168, mt = it / 704, r = it % 704;
                    transpose_item_fp8(a.in[32] + (size_t)mt * D * DE, D, DE, ws + WS_WGU8 + (size_t)mt * 5632 * D, umap, GUSC8, scr, r, lane);
                } else { const int it = layer == 0 ? ix - 18432 : ix, mt = layer * 16 + it / 704, r = it % 704;
                    transpose_item_fp8(a.in[33] + (size_t)mt * DE * D, DE, D, ws + WS_WD8 + (size_t)layer * 88 * MiB + (size_t)(mt - 16 * layer) * D * DE, ident, DSC8, scr, r, lane);
                }
            }
        };
        constexpr int CV_TOT = layer == 0 ? 29696 : 11264, CV_P2 = layer == 0 ? 1024 : 0;
        if (bid >= 32) conv_items(0, CV_TOT - CV_P2, (bid - 32) * 8 + wave, (nb - 32) * 8);
        for (int be = bid; be < NB * NE && be < 32; be += nb) {
            const int b = be >> 4, e = be & 15, eb = e * 2 + b;
            __syncthreads();
            for (int s = tid; s < S; s += NTH) keys[s] = __float_as_uint(AFF[(size_t)(b * S + s) * NE + e]);
            unsigned prefix = 0u; int krem = CAP;
            for (int pass = 3; pass >= 0; --pass) {
                __syncthreads();
                for (int i = tid; i < 8 * 256; i += NTH) hist[i] = 0;
                __syncthreads();
                const unsigned hmask = pass == 3 ? 0u : (0xFFFFFFFFu << (8 * (pass + 1)));
                for (int s = tid; s < S; s += NTH) { const unsigned k = keys[s]; if ((k & hmask) == prefix) atomicAdd(&hist[wave * 256 + ((k >> (8 * pass)) & 255u)], 1); }
                __syncthreads();
                if (wave == 0) {
                    int c4[4], s4 = 0;
#pragma unroll
                    for (int j = 0; j < 4; ++j) { const int bin = 255 - (4 * lane + j); int c = 0;
#pragma unroll
                        for (int w = 0; w < 8; ++w) c += hist[w * 256 + bin];
                        c4[j] = c; s4 += c; }
                    int pre = s4;
#pragma unroll
                    for (int o = 1; o < 64; o <<= 1) { const int y = __shfl_up(pre, o); if (lane >= o) pre += y; }
                    const int excl = pre - s4;
                    if (excl < krem && krem <= pre) {
                        int cum = excl, bsel = 0, rem = 0; bool found = false;
#pragma unroll
                        for (int j = 0; j < 4; ++j) { if (!found && cum + c4[j] >= krem) { bsel = 255 - (4 * lane + j); rem = krem - cum; found = true; } if (!found) cum += c4[j]; }
                        sh[8] = bsel; sh[9] = rem;
                    }
                }
                __syncthreads();
                prefix |= ((unsigned)sh[8]) << (8 * pass); krem = sh[9];
            }
            const unsigned thr = prefix;
            int ce = 0;
            for (int i = 0; i < 16; ++i) { const unsigned k = keys[tid * 16 + i]; ce += (k == thr); }
            int tot;
            const int eqbase = block_exscan(ce, sh, &tot);
            int eqr = eqbase, cs = 0;
            for (int i = 0; i < 16; ++i) { const unsigned k = keys[tid * 16 + i]; const bool sel = (k > thr) || (k == thr && eqr < krem); eqr += (k == thr); cs += sel; }
            const int sbase = block_exscan(cs, sh, &tot);
            int slot = sbase; eqr = eqbase;
            for (int i = 0; i < 16; ++i) {
                const int s = tid * 16 + i; const unsigned k = keys[s];
                const bool sel = (k > thr) || (k == thr && eqr < krem); eqr += (k == thr);
                if (sel) { TOK[eb * CAP + slot] = b * S + s; GATE[eb * CAP + slot] = __uint_as_float(k); SLOT[(size_t)(b * S + s) * NE + e] = eb * CAP + slot; ++slot; }
            }
        }
        if (CV_P2 > 0 && bid < 32) { __syncthreads(); conv_items(CV_TOT - CV_P2, CV_TOT, bid * 8 + wave, 32 * 8); }
    }
    SEAM(ph); ++ph;
    if (IN(ph)) {
        MoeOrder So{(int)gridDim.x, (int)blockIdx.x, 16 * 22, 22};
        if constexpr (layer == 1 || F8L0) {
            int Kg = D / 2; asm volatile("" : "+s"(Kg));
            pg8::Gemm g{H, (const bf16_t*)(ws + WS_WGU8 + (size_t)layer * 176 * MiB), NB * NE * CAP, NE * 5632, Kg, TOK};
            pg8::gemm_phase<EpiSiluMul8, MoeOrder, false, true, true>(ldsp, g, So, EpiSiluMul8{(unsigned char*)HID}, nullptr);
        } else {
            pg8::Gemm g{XE, (const bf16_t*)(ws + WS_WGU) + (size_t)layer * NE * 5632 * D, NB * NE * CAP, NE * 5632, D};
            pg8::gemm_phase<EpiSiluMul, MoeOrder, false>(ldsp, g, So, EpiSiluMul{HID}, nullptr);
        }
    }
    SEAM(ph); ++ph;
    if (IN(ph)) {
        MoeOrder So{(int)gridDim.x, (int)blockIdx.x, 16 * 4, 4};
        if constexpr (layer == 1 || F8L0) {
            int Kg = DE / 2; asm volatile("" : "+s"(Kg));
            pg8::Gemm g{HID, (const bf16_t*)(ws + WS_WD8 + (size_t)layer * 88 * MiB), NB * NE * CAP, NE * D, Kg};
            pg8::gemm_phase<EpiYE8, MoeOrder, false, true>(ldsp, g, So, EpiYE8{GATE, YE}, nullptr);
        } else {
            pg8::Gemm g{HID, (const bf16_t*)(ws + WS_WD) + (size_t)layer * NE * D * DE, NB * NE * CAP, NE * D, DE};
            pg8::gemm_phase<EpiYE, MoeOrder, false>(ldsp, g, So, EpiYE{GATE, YE}, nullptr);
        }
    }
    SEAM(ph); ++ph;
    return ph;
}

__global__ void __launch_bounds__(NTH, 2) mega(Args a) {
    extern __shared__ __attribute__((aligned(16))) unsigned char lds_raw[];
    unsigned* ctl = (unsigned*)(a.ws + WS_CTL);
    volatile LAS unsigned* bst = (volatile LAS unsigned*)((LAS unsigned char*)lds_raw + LDS_BAR_OFF);
    { const int t0_ = tidx(); if (t0_ < 4) bst[t0_] = 0u; }
    __syncthreads();
    XcdBarrier bar; bar.bar = ctl + CW_BAR; bar.x = 0; bar.st = bst;
    if (a.hi - a.lo > 1) bar = xcd_barrier_post(ctl + CW_BAR, bst);
    PROLOG

    int ph = 0;
    if (IN(ph)) REP_LOOP {
        for (int i = gt; i < S * 32; i += ngt) {
            const int s = i >> 5, f = i & 31;
            const float pw = (float)exp((double)((float)(2 * f) / 64.0f) * 9.210340371976184);
            const float invf = 1.0f / pw;
            const float angf = (float)s * invf;
            double xx = (double)angf;
            const double n = rint(xx * 0.15915494309189535);
            xx = (xx - n * 6.283185307179586) - n * 2.4492935982947064e-16;
            const double x2 = xx * xx;
            double cs = 1.0, sn = xx, tc = 1.0, tsn = xx;
#pragma unroll 1
            for (int k = 1; k <= 16; ++k) { tc *= -x2 / (double)((2 * k - 1) * (2 * k)); tsn *= -x2 / (double)((2 * k) * (2 * k + 1)); cs += tc; sn += tsn; }
            ropec[i] = (float)cs; ropes[i] = (float)sn;
        }
        rmsnorm_rows_bf16(x_in, a.in[2], H, T);
        rmsnorm_rows_bf16(mem, a.in[25], MN, NB * MEM); rmsnorm_rows_bf16(mem, a.in[25] + D, MN + NB * MEM * D, NB * MEM);
        LAS float* scr = (LAS float*)((LAS unsigned char*)lds_raw + wave * 16896);
        auto ident = [](int n) { return n; };
        auto emap = [](int n) { const bool il = (n < 1024) || (n >= 1536 && n < 2176); const int j = n & 63; return il ? ((n & ~63) + (j < 32 ? 2 * j : 2 * (j - 32) + 1)) : n; };
        for (int it = gw; it < 16 * 36; it += ngw) transpose_item(a.in[3], D, EVEN_IN, (bf16_t*)(ws + WS_WEIN), emap, scr, it, lane);
        for (int it = gw; it < 2 * 16 * 32; it += ngw) { const int l = it / 512, r = it % 512; transpose_item(a.in[27] + (size_t)l * D * 2048, D, 2048, (bf16_t*)(ws + WS_WKV) + (size_t)l * 2048 * D, ident, scr, r, lane); }
        { float* WRT = (float*)(ws + WS_WRT);
          for (int i = gt; i < 2 * NE * D; i += ngt) { const int l = i >> 14, e = (i >> 10) & 15, k = i & 1023; WRT[i] = a.in[29][l * D + k] * a.in[30][((size_t)l * D + k) * NE + e]; } }
        { bf16_t* Wsb = (bf16_t*)(ws + WS_WSB); const float* wsp = a.in[10];
          for (int i = gt; i < 4 * 128 * 128; i += ngt) Wsb[i] = (bf16_t)f2bf(wsp[i]);
          bf16_t* WL = (bf16_t*)(ws + WS_WL); const float *w2 = a.in[14], *a2 = a.in[16], *g2 = a.in[17];
          for (int i = gt; i < 4 * 512 * 64 + 512 * 128; i += ngt) { float v;
              if (i < 4 * 512 * 64) { const int sec = i >> 15, n = (i >> 6) & 511, k = i & 63; v = (sec < 2 ? w2 : a2)[(size_t)((sec & 1) * 64 + k) * 512 + n]; }
              else { const int j = i - 4 * 512 * 64, n = j >> 7, k = j & 127; v = g2[(size_t)k * 512 + n]; }
              WL[i] = (bf16_t)f2bf(v); } }
        auto gmap = [](int n) { return (n >> 7) * 256 + (n & 127); };
        auto umap = [](int n) { return (n >> 7) * 256 + 128 + (n & 127); };
    }
    SEAM(ph); ++ph;

    if (IN(ph)) dense_gemm(ldsp, H, (const bf16_t*)(ws + WS_WEIN), T, EVEN_IN, D,
                           EpiEven{ropec, ropes, (bf16_t*)(ws + WS_QHA), (bf16_t*)(ws + WS_KHA), (bf16_t*)(ws + WS_QHB), (bf16_t*)(ws + WS_KHB), (bf16_t*)(ws + WS_VTA), (bf16_t*)(ws + WS_VTB)});
    if (IN(ph)) {
        dense_gemm(ldsp, MN, (const bf16_t*)(ws + WS_WKV), NB * MEM, 2048, D, EpiKV{KV, KV + 512 * 1024}, 192);
        dense_gemm(ldsp, MN + NB * MEM * D, (const bf16_t*)(ws + WS_WKV) + (size_t)2048 * D, NB * MEM, 2048, D, EpiKV{KV + 1024 * 1024, KV + 1024 * 1024 + 512 * 1024}, 176);
        if (bid >= 96) {
            __syncthreads();
            LAS float* scr = (LAS float*)((LAS unsigned char*)lds_raw + wave * 16896);
            const int gw3 = (bid - 96) * 8 + wave, ngw3 = (nb - 96) * 8;
            auto ident = [](int n) { return n; };
            auto gmap = [](int n) { return (n >> 7) * 256 + (n & 127); };
        for (int it = gw3; it < 16 * 16; it += ngw3) transpose_item(a.in[5], D, D, (bf16_t*)(ws + WS_WEOUT), ident, scr, it, lane);
        for (int it = gw3; it < 16 * 46; it += ngw3) transpose_item(a.in[7], D, ODD_IN, (bf16_t*)(ws + WS_WOIN), ident, scr, it, lane);
        for (int it = gw3; it < 16 * 16; it += ngw3) transpose_item(a.in[23], D, D, (bf16_t*)(ws + WS_WOOUT), ident, scr, it, lane);
        for (int it = gw3; it < 2 * 16 * 16; it += ngw3) { const int l = it / 256, r = it % 256; transpose_item(a.in[26] + (size_t)l * D * D, D, D, (bf16_t*)(ws + WS_WQ) + (size_t)l * D * D, ident, scr, r, lane, a.in[24] + l * D); }
        for (int it = gw3; it < 2 * 16 * 16; it += ngw3) { const int l = it / 256, r = it % 256; transpose_item(a.in[28] + (size_t)l * D * D, D, D, (bf16_t*)(ws + WS_WO) + (size_t)l * D * D, ident, scr, r, lane); }
            for (int it = gw3; it < 4096; it += ngw3) { const int mt = it / 704, r = it % 704;
                if constexpr (F8L0) transpose_item_fp8(a.in[31] + (size_t)mt * D * DE, D, DE, ws + WS_WGU8 + (size_t)mt * 5632 * D, gmap, GUSC8, scr, r, lane);
                else transpose_item(a.in[31] + (size_t)mt * D * DE, D, DE, (bf16_t*)(ws + WS_WGU) + (size_t)mt * 5632 * D, gmap, scr, r, lane); }
        }
    }
    SEAM(ph); ++ph;
    if (IN(ph)) REP_LOOP attn_phase_even((const bf16_t*)(ws + WS_QHA), (const bf16_t*)(ws + WS_KHA), (const bf16_t*)(ws + WS_VTA), (const bf16_t*)(ws + WS_QHB), (const bf16_t*)(ws + WS_KHB),
                                (const bf16_t*)(ws + WS_VTB), a.in[4], (bf16_t*)(ws + WS_OA), (float*)(ws + WS_LSE), Y, lds_raw);
    SEAM(ph); ++ph;
    if (IN(ph)) REP_LOOP attn_combine((const bf16_t*)(ws + WS_OA), (const float*)(ws + WS_LSE), Y);
    SEAM(ph); ++ph;
    if (IN(ph)) dense_gemm(ldsp, Y, (const bf16_t*)(ws + WS_WEOUT), T, D, D, EpiResidN{x_in, X, H, (float*)(ws + WS_SSP)});
    SEAM(ph); ++ph;

    ph = tail_phases<0>(a, bar, lds_raw, ph);
    ph = odd_phases(a, bar, lds_raw, ph);
    ph = tail_phases<1>(a, bar, lds_raw, ph);

    if (IN(ph)) combine_norm<true>(X, YE, SLOT, a.in[34], nullptr, a.out);
    ++ph;
}
constexpr int NPHASES = 1 + 4 + 2 * 6 + 7 + 1;
#undef IN
#undef SEAM
}

extern "C" void kernel_launch(void* const* d_in, const int* in_sizes, int n_in, void* d_out, int out_size, void* d_ws, size_t ws_size, hipStream_t stream) {
    static int grid = 0;
    if (grid == 0) {
        if (n_in != 35 || out_size != T * D || ws_size < WS_END) { fprintf(stderr, "kernel_launch: unexpected shapes n_in %d out %d ws %zu (need %zu)\n", n_in, out_size, ws_size, (size_t)WS_END); grid = -1; return; }
        int dev = 0, cus = 0, per_cu = 0;
        (void)hipGetDevice(&dev); (void)hipDeviceGetAttribute(&cus, hipDeviceAttributeMultiprocessorCount, dev);
        if (hipFuncSetAttribute((const void*)mega, hipFuncAttributeMaxDynamicSharedMemorySize, LDS_BYTES) != hipSuccess) { fprintf(stderr, "hipFuncSetAttribute failed\n"); grid = -1; return; }
        if (hipOccupancyMaxActiveBlocksPerMultiprocessor(&per_cu, (const void*)mega, NTH, LDS_BYTES) != hipSuccess || per_cu < 1) fprintf(stderr, "occupancy query: %d\n", per_cu);
        (void)hipGetLastError();
        grid = cus > 0 ? cus : 256;
    }
    if (grid < 0) return;
    (void)hipMemsetAsync((char*)d_ws + WS_CTL, 0, CTL_BYTES, stream);
    Args a{};
    for (int i = 0; i < 35; ++i) a.in[i] = (const float*)d_in[i];
    a.out = (float*)d_out; a.ws = (unsigned char*)d_ws;
#if MK_MULTI
    for (int k = 0; k < NPHASES; ++k) { a.lo = k; a.hi = k + 1; hipLaunchKernelGGL(mega, dim3(grid), dim3(NTH), LDS_BYTES, stream, a); }
#else
    a.lo = 0; a.hi = NPHASES; hipLaunchKernelGGL(mega, dim3(grid), dim3(NTH), LDS_BYTES, stream, a);
#endif
}
```
